# Optimizing an MI355X kernel written in HIP

```python
import jax, jax.numpy as jnp
from jax import lax
import numpy as np

D_MODEL = 1024
BATCH = 8
SEQ = 4096
DEPTH = 2

HEAD_DIM = 64
ATT_HEADS = 8
ATT_KV_HEADS = 2
ATT_GROUP = ATT_HEADS // ATT_KV_HEADS
ATT_WIDTH = ATT_HEADS * HEAD_DIM
KV_WIDTH = ATT_KV_HEADS * HEAD_DIM
WINDOW = 128
BLOCK = 128
RWKV_HEADS = 8
RWKV_WIDTH = RWKV_HEADS * HEAD_DIM
DECAY_LORA = 64
AAA_LORA = 64
MV_LORA = 32
GATE_LORA = 128
MIX_WIDTH = ATT_WIDTH + RWKV_WIDTH
ATT_IN = ATT_WIDTH + 2 * KV_WIDTH
RWKV_IN_SIZES = (RWKV_WIDTH, RWKV_WIDTH, RWKV_WIDTH, DECAY_LORA, AAA_LORA, GATE_LORA)
SHIFT_WIDTH = sum(RWKV_IN_SIZES)
IN_WIDTH = ATT_IN + SHIFT_WIDTH
D_FF = 2816
CONV_WIDTH = 3
RMS_EPS = 1e-5
LNX_EPS = 64e-5
NEG_INF = -1e30

kernel_name = "hymba_swa_sink_alibi_rwkv7_convglu"


def _split(z, sizes):
    idx = [int(i) for i in np.cumsum(sizes)[:-1]]
    return jnp.split(z, idx, axis=-1)


def rms_norm(x, g):
    xf = x.astype(jnp.float32)
    y = xf * lax.rsqrt(jnp.mean(xf * xf, axis=-1, keepdims=True) + RMS_EPS)
    return (y * g.astype(jnp.float32)).astype(x.dtype)


def alibi_slopes(n_heads):
    return 2.0 ** (-8.0 * jnp.arange(1, n_heads + 1, dtype=jnp.float32) / n_heads)


def sliding_window_attention(q, k, v, sinks):
    dt = q.dtype
    B, T, _ = q.shape
    nb = T // BLOCK
    f32 = jnp.float32
    qb = q.astype(f32).reshape(B, nb, BLOCK, ATT_KV_HEADS, ATT_GROUP, HEAD_DIM)
    kc = k.astype(f32).reshape(B, nb, BLOCK, ATT_KV_HEADS, HEAD_DIM)
    vc = v.astype(f32).reshape(B, nb, BLOCK, ATT_KV_HEADS, HEAD_DIM)
    pad = ((0, 0), (1, 0), (0, 0), (0, 0), (0, 0))
    kb = jnp.concatenate([jnp.pad(kc, pad)[:, :-1], kc], axis=2)
    vb = jnp.concatenate([jnp.pad(vc, pad)[:, :-1], vc], axis=2)
    s = jnp.einsum('bnqkgd,bnskd->bnkgqs', qb, kb) * (HEAD_DIM ** -0.5)
    qpos = jnp.arange(BLOCK)[:, None]
    kpos = jnp.arange(2 * BLOCK)[None, :]
    dist = qpos + BLOCK - kpos
    key_abs = jnp.arange(nb)[:, None, None] * BLOCK - BLOCK + kpos[None]
    valid = (dist >= 0)[None] & (dist < WINDOW)[None] & (key_abs >= 0)
    slopes = alibi_slopes(ATT_HEADS).reshape(ATT_KV_HEADS, ATT_GROUP)
    s = s - slopes[:, :, None, None] * dist.astype(f32)
    s = jnp.where(valid[None, :, None, None], s, NEG_INF)
    sink = sinks.astype(f32).reshape(ATT_KV_HEADS, ATT_GROUP)[None, None, :, :, None, None]
    m = jnp.maximum(jnp.max(s, axis=-1, keepdims=True), sink)
    p = jnp.exp(s - m)
    denom = jnp.sum(p, axis=-1, keepdims=True) + jnp.exp(sink - m)
    o = jnp.einsum('bnkgqs,bnskd->bnqkgd', p / denom, vb)
    return o.reshape(B, T, ATT_WIDTH).astype(dt)


def token_shift(u, mu):
    prev = jnp.pad(u, ((0, 0), (1, 0), (0, 0)))[:, :-1]
    return u + (prev - u) * mu


def rwkv7_time_mix(r, k, v, wd, ad, gd, w0, w2, a0, a2, g2, k_k, k_a, r_k,
                   lnx_g, lnx_b, v_first, v_mix):
    dt = r.dtype
    f32 = jnp.float32
    B, T, C = r.shape
    H, N = RWKV_HEADS, HEAD_DIM
    w = -jax.nn.softplus(-(w0 + jnp.tanh(wd) @ w2)) - 0.5
    decay = jnp.exp(-jnp.exp(w.astype(f32)))
    a = jax.nn.sigmoid(a0 + ad @ a2)
    g = jax.nn.sigmoid(gd) @ g2
    kk = (k * k_k).astype(f32).reshape(B, T, H, N)
    kk = kk / jnp.maximum(jnp.linalg.norm(kk, axis=-1, keepdims=True), 1e-12)
    kk = kk.reshape(B, T, C)
    k = k * (1 + (a - 1) * k_a)
    if v_mix is None:
        v_first = v
    else:
        v0, v1, v2 = v_mix
        v = v + (v_first - v) * jax.nn.sigmoid(v0 + (v @ v1) @ v2)

    def heads(z):
        return z.astype(f32).reshape(B, T, H, N).transpose(1, 0, 2, 3)

    xs = (heads(r), heads(decay), heads(k), heads(v), heads(-kk), heads(kk * a))

    def step(S, inp):
        r_t, w_t, k_t, v_t, a_t, b_t = inp
        sa = jnp.einsum('bhvk,bhk->bhv', S, a_t)
        S = S * w_t[:, :, None, :] + sa[..., None] * b_t[:, :, None, :] \
            + v_t[..., None] * k_t[:, :, None, :]
        return S, jnp.einsum('bhvk,bhk->bhv', S, r_t)

    S0 = jnp.zeros((B, H, N, N), f32)
    _, y = lax.scan(step, S0, xs)
    y = y.transpose(1, 0, 2, 3)
    mu = jnp.mean(y, axis=-1, keepdims=True)
    var = jnp.mean(jnp.square(y - mu), axis=-1, keepdims=True)
    y = ((y - mu) * lax.rsqrt(var + LNX_EPS)).reshape(B, T, C)
    y = y * lnx_g.astype(f32) + lnx_b.astype(f32)
    r4 = r.astype(f32).reshape(B, T, H, N)
    k4 = k.astype(f32).reshape(B, T, H, N)
    v4 = v.astype(f32).reshape(B, T, H, N)
    bonus = jnp.sum(r4 * k4 * r_k.astype(f32).reshape(H, N), axis=-1, keepdims=True) * v4
    y = (y + bonus.reshape(B, T, C)) * g.astype(f32)
    return y.astype(dt), v_first


def conv_glu_ffn(h, w_gate, w_up, conv_w, conv_b, w_down):
    T = h.shape[1]
    u = h @ w_gate
    up = jnp.pad(u, ((0, 0), (CONV_WIDTH - 1, 0), (0, 0)))
    c = conv_b + sum(conv_w[j] * up[:, j:j + T] for j in range(CONV_WIDTH))
    return (jax.nn.silu(c) * (h @ w_up)) @ w_down


def setup_inputs(seed: int = 0) -> dict:
    key = jax.random.key(seed)
    ks = iter(jax.random.split(key, 40))
    f32 = jnp.float32
    L, C, D, F = DEPTH, RWKV_WIDTH, D_MODEL, D_FF

    def nrm(shape, scale):
        return jax.random.normal(next(ks), shape, f32) * scale

    def unif(shape, lo, hi):
        return jax.random.uniform(next(ks), shape, f32, minval=lo, maxval=hi)

    return {
        "x": nrm((BATCH, SEQ, D), 1.0),
        "norm1_g": 1.0 + nrm((L, D), 0.01),
        "w_in": nrm((L, D, IN_WIDTH), D ** -0.5),
        "attn_sinks": nrm((L, ATT_HEADS), 0.5),
        "shift_mu": unif((L, SHIFT_WIDTH), 0.0, 1.0),
        "w0": unif((L, C), -5.0, 1.0),
        "w2": nrm((L, DECAY_LORA, C), 0.1),
        "a0": nrm((L, C), 0.1),
        "a2": nrm((L, AAA_LORA, C), 0.1),
        "g2": nrm((L, GATE_LORA, C), GATE_LORA ** -0.5),
        "k_k": 0.85 + nrm((L, C), 0.05),
        "k_a": 1.0 + nrm((L, C), 0.05),
        "r_k": nrm((L, C), 0.1),
        "lnx_g": 1.0 + nrm((L, C), 0.01),
        "lnx_b": nrm((L, C), 0.01),
        "v0": nrm((L - 1, C), 0.1),
        "v1": nrm((L - 1, C, MV_LORA), C ** -0.5),
        "v2": nrm((L - 1, MV_LORA, C), 0.1),
        "w_out": nrm((L, MIX_WIDTH, D), MIX_WIDTH ** -0.5),
        "norm2_g": 1.0 + nrm((L, D), 0.01),
        "ffn_w_gate": nrm((L, D, F), D ** -0.5),
        "ffn_w_up": nrm((L, D, F), D ** -0.5),
        "conv_w": nrm((L, CONV_WIDTH, F), 0.5),
        "conv_b": nrm((L, F), 0.01),
        "ffn_w_down": nrm((L, F, D), F ** -0.5),
        "final_g": 1.0 + nrm((D,), 0.01),
    }


def reference(x, norm1_g, w_in, attn_sinks, shift_mu, w0, w2, a0, a2, g2, k_k, k_a,
              r_k, lnx_g, lnx_b, v0, v1, v2, w_out, norm2_g, ffn_w_gate, ffn_w_up,
              conv_w, conv_b, ffn_w_down, final_g):
    v_first = None
    for l in range(DEPTH):
        h = rms_norm(x, norm1_g[l])
        proj = h @ w_in[l]
        q, ka, va = _split(proj[..., :ATT_IN], (ATT_WIDTH, KV_WIDTH, KV_WIDTH))
        rest = token_shift(proj[..., ATT_IN:], shift_mu[l])
        r, k, v, wd, ad, gd = _split(rest, RWKV_IN_SIZES)
        att = sliding_window_attention(q, ka, va, attn_sinks[l])
        v_mix = None if l == 0 else (v0[l - 1], v1[l - 1], v2[l - 1])
        rw, v_first = rwkv7_time_mix(r, k, v, wd, ad, gd, w0[l], w2[l], a0[l], a2[l],
                                     g2[l], k_k[l], k_a[l], r_k[l], lnx_g[l], lnx_b[l],
                                     v_first, v_mix)
        x = x + jnp.concatenate([att, rw], axis=-1) @ w_out[l]
        h = rms_norm(x, norm2_g[l])
        x = x + conv_glu_ffn(h, ffn_w_gate[l], ffn_w_up[l], conv_w[l], conv_b[l], ffn_w_down[l])
    return rms_norm(x, final_g)
```

```cpp
#include <hip/hip_runtime.h>
#include <cstdio>
#include <cstdint>

typedef unsigned short bf16_t;
typedef short bf16x8 __attribute__((ext_vector_type(8)));
typedef float f32x4 __attribute__((ext_vector_type(4)));

constexpr int BATCH = 8, SEQ = 4096, D = 1024, M = BATCH * SEQ;
constexpr int HD = 64, ATT_W = 512, KV_W = 128, C = 512, NH = 8;
constexpr int ATT_IN = 768, SHIFT_W = 1792, IN_W = 2560, FF = 2816;
constexpr int WINDOW = 128;
constexpr float RMS_EPS = 1e-5f, LNX_EPS = 64e-5f;

constexpr size_t MiB = 1u << 20;
constexpr size_t WS_CTL = 0;
constexpr size_t WS_SS = 0;
constexpr size_t CTL_BYTES = 1 * MiB;
constexpr size_t WS_W = 2 * MiB;
constexpr size_t W_IN_SZ = (size_t)IN_W * D * 2, W_OUT_SZ = (size_t)D * D * 2, W_GU_SZ = (size_t)2 * FF * D * 2, W_DN_SZ = (size_t)D * FF * 2;
constexpr size_t W_LAYER = W_IN_SZ + W_OUT_SZ + W_GU_SZ + W_DN_SZ;
constexpr size_t WS_VFIRST = 52 * MiB, WS_MIX = 84 * MiB, WS_XB = 148 * MiB, WS_PROJ = 212 * MiB;
constexpr size_t WS_SI_R = 148 * MiB, WS_SI_K = 180 * MiB, WS_SI_V = 372 * MiB, WS_SI_A = 404 * MiB, WS_SI_LD = 436 * MiB, WS_SI_G = 468 * MiB;
constexpr size_t WS_HID = 212 * MiB;
constexpr size_t WS_UTMP = 84 * MiB;
constexpr size_t WS_END = 500 * MiB;
static_assert(WS_W + 2 * W_LAYER <= WS_VFIRST, "weights fit");

__device__ __forceinline__ unsigned f2bf(float f) { unsigned u = __builtin_bit_cast(unsigned, f); return (u + 0x7fffu + ((u >> 16) & 1u)) >> 16; }
__device__ __forceinline__ float bf2f(bf16_t h) { return __builtin_bit_cast(float, (unsigned)h << 16); }
__device__ __forceinline__ float wave_sum(float v) {
#pragma unroll
    for (int o = 1; o < 64; o <<= 1) v += __shfl_xor(v, o);
    return v;
}
__device__ __forceinline__ float sigmoidf_(float x) { return 1.f / (1.f + __expf(-x)); }

__global__ void k_transpose_w(const float* __restrict__ W, int K, int N, bf16_t* __restrict__ Wt, const float* __restrict__ g, int mode) {
    __shared__ float tile[32][33];
    const int k0 = blockIdx.y * 32, n0 = blockIdx.x * 32, tx = threadIdx.x & 31, ty = threadIdx.x >> 5;
    for (int i = ty; i < 32; i += 8) { const int k = k0 + i; tile[i][tx] = W[(size_t)k * N + n0 + tx] * (g ? g[k] : 1.f); }
    __syncthreads();
    for (int i = ty; i < 32; i += 8) { const int n = n0 + i; int np = n; if (mode == 1) np = 256 * (n / 128) + (n % 128); else if (mode == 2) np = 256 * (n / 128) + 128 + (n % 128);
        Wt[(size_t)np * K + k0 + tx] = (bf16_t)f2bf(tile[tx][i]); }
}
__global__ void k_x_to_bf16(const float* __restrict__ x, bf16_t* __restrict__ xb, float* __restrict__ ss) {
    const int row = blockIdx.x * 4 + (threadIdx.x >> 6), lane = threadIdx.x & 63;
    const f32x4* xr = (const f32x4*)(x + (size_t)row * D) + lane; float s = 0.f;
#pragma unroll
    for (int j = 0; j < 4; ++j) { const f32x4 v = xr[64 * j]; s += v.x * v.x + v.y * v.y + v.z * v.z + v.w * v.w;
        unsigned long long o = (unsigned long long)(f2bf(v.x) | (f2bf(v.y) << 16)) | ((unsigned long long)(f2bf(v.z) | (f2bf(v.w) << 16)) << 32);
        ((unsigned long long*)(xb + (size_t)row * D))[lane + 64 * j] = o; }
    s = wave_sum(s); if (lane == 0) ss[row] = s;
}

struct EpArgs {
    const float* ss; float* ss_out; const float* base; float* xout; bf16_t* ob; bf16_t* ob2; int ldo; int row_off;
};
template <int MODE>
__global__ void __launch_bounds__(256) k_gemm(const bf16_t* __restrict__ A, int lda, const bf16_t* __restrict__ Bt, int ldb, int K, EpArgs e) {
    const int wid = threadIdx.x >> 6, lane = threadIdx.x & 63, fr = lane & 15, fq = lane >> 4;
    const int row0 = blockIdx.y * 64 + (wid >> 1) * 32, col0 = blockIdx.x * 64 + (wid & 1) * 32;
    f32x4 acc[2][2];
#pragma unroll
    for (int i = 0; i < 2; ++i)
#pragma unroll
        for (int j = 0; j < 2; ++j) acc[i][j] = (f32x4){0.f, 0.f, 0.f, 0.f};
    const bf16_t* ap = A + (size_t)(row0 + fr) * lda + fq * 8;
    const bf16_t* bp = Bt + (size_t)(col0 + fr) * ldb + fq * 8;
    for (int k0 = 0; k0 < K; k0 += 32) {
        bf16x8 a[2], b[2];
#pragma unroll
        for (int i = 0; i < 2; ++i) { a[i] = *(const bf16x8*)(ap + (size_t)i * 16 * lda + k0); b[i] = *(const bf16x8*)(bp + (size_t)i * 16 * ldb + k0); }
#pragma unroll
        for (int i = 0; i < 2; ++i)
#pragma unroll
            for (int j = 0; j < 2; ++j) acc[i][j] = __builtin_amdgcn_mfma_f32_16x16x32_bf16(a[i], b[j], acc[i][j], 0, 0, 0);
    }
#pragma unroll
    for (int i = 0; i < 2; ++i)
#pragma unroll
        for (int r = 0; r < 4; ++r) {
            const int row = row0 + i * 16 + fq * 4 + r;
            float rstd = 1.f;
            if (MODE == 0 || MODE == 2) rstd = rsqrtf(e.ss[row] * (1.f / D) + RMS_EPS);
            float sq = 0.f;
#pragma unroll
            for (int j = 0; j < 2; ++j) {
                const int col = col0 + j * 16 + fr; const float v = acc[i][j][r];
                if (MODE == 0) e.ob[(size_t)row * e.ldo + col] = (bf16_t)f2bf(v * rstd);
                else if (MODE == 1) { const size_t o = (size_t)row * D + col; const float x = e.base[o] + v; e.xout[o] = x; e.ob[o] = (bf16_t)f2bf(x); sq += x * x; }
                else { const int p = col >> 8, jj = col & 255; const size_t o = (size_t)(row - e.row_off) * FF + 128 * p + (jj & 127);
                    if (jj < 128) e.ob[o] = (bf16_t)f2bf(v * rstd); else e.ob2[o] = (bf16_t)f2bf(v * rstd); }
            }
            if (MODE == 1) {
                sq += __shfl_xor(sq, 1); sq += __shfl_xor(sq, 2); sq += __shfl_xor(sq, 4); sq += __shfl_xor(sq, 8);
                if (fr == 0) atomicAdd(e.ss_out + row, sq);
            }
        }
}

struct PrepArgs {
    const bf16_t* proj; const float* mu; const float* w0; const float* w2; const float* a0; const float* a2; const float* g2;
    const float* v0; const float* v1; const float* v2; bf16_t* vfirst; int layer; int pad;
    bf16_t *R, *K, *V, *A, *LD, *G;
};
__global__ void __launch_bounds__(512) k_prep(PrepArgs p) {
    __shared__ float rest[4][SHIFT_W];
    __shared__ float vlo[4][32];
    const int tid = threadIdx.x, m0 = blockIdx.x * 4;
    for (int i = tid; i < 4 * SHIFT_W; i += 512) {
        const int tk = i / SHIFT_W, c = i % SHIFT_W, m = m0 + tk, t = m % SEQ;
        const float u = bf2f(p.proj[(size_t)m * IN_W + ATT_IN + c]);
        const float up = t > 0 ? bf2f(p.proj[(size_t)(m - 1) * IN_W + ATT_IN + c]) : 0.f;
        float v = u + (up - u) * p.mu[c];
        if (c >= 1536 && c < 1600) v = tanhf(v); else if (c >= 1664) v = sigmoidf_(v);
        rest[tk][c] = v;
    }
    __syncthreads();
    if (p.layer > 0 && tid < 128) { const int tk = tid >> 5, j = tid & 31; float s = 0.f; for (int c = 0; c < C; ++c) s += rest[tk][1024 + c] * p.v1[c * 32 + j]; vlo[tk][j] = s; }
    __syncthreads();
    const int c = tid;
    float wp[4], ap[4], gp[4];
#pragma unroll
    for (int tk = 0; tk < 4; ++tk) { wp[tk] = p.w0[c]; ap[tk] = p.a0[c]; gp[tk] = 0.f; }
    for (int k = 0; k < 64; ++k) { const float w = p.w2[k * C + c], a = p.a2[k * C + c];
#pragma unroll
        for (int tk = 0; tk < 4; ++tk) { wp[tk] += rest[tk][1536 + k] * w; ap[tk] += rest[tk][1600 + k] * a; } }
    for (int k = 0; k < 128; ++k) { const float g = p.g2[k * C + c];
#pragma unroll
        for (int tk = 0; tk < 4; ++tk) gp[tk] += rest[tk][1664 + k] * g; }
#pragma unroll
    for (int tk = 0; tk < 4; ++tk) {
        const size_t o = (size_t)(m0 + tk) * C + c;
        const float x = -wp[tk];
        const float sp = fmaxf(x, 0.f) + log1pf(__expf(-fabsf(x)));
        const float wraw = -sp - 0.5f;
        const float ld = -__expf(wraw);
        const float a = sigmoidf_(ap[tk]);
        float v = rest[tk][1024 + c];
        if (p.layer == 0) p.vfirst[o] = (bf16_t)f2bf(v);
        else { float s = p.v0[c]; for (int j = 0; j < 32; ++j) s += vlo[tk][j] * p.v2[j * C + c]; const float vf = bf2f(p.vfirst[o]); v = v + (vf - v) * sigmoidf_(s); }
        p.R[o] = (bf16_t)f2bf(rest[tk][c]); p.K[o] = (bf16_t)f2bf(rest[tk][512 + c]); p.V[o] = (bf16_t)f2bf(v);
        p.A[o] = (bf16_t)f2bf(a); p.LD[o] = (bf16_t)f2bf(ld); p.G[o] = (bf16_t)f2bf(gp[tk]);
    }
}

struct ScanArgs { const bf16_t *R, *K, *V, *A, *LD, *G; const float *k_k, *k_a, *r_k, *lnx_g, *lnx_b; bf16_t* mix; };
__global__ void __launch_bounds__(64) k_scan(ScanArgs p) {
    __shared__ float vec[5][64];
    const int b = blockIdx.x >> 3, h = blockIdx.x & 7, lane = threadIdx.x, ch = h * 64 + lane;
    const float kk_c = p.k_k[ch], ka_c = p.k_a[ch], rk_c = p.r_k[ch], lg = p.lnx_g[ch], lb = p.lnx_b[ch];
    float S[64];
#pragma unroll
    for (int j = 0; j < 64; ++j) S[j] = 0.f;
    for (int t = 0; t < SEQ; ++t) {
        const size_t o = (size_t)(b * SEQ + t) * C + ch;
        const float r = bf2f(p.R[o]), k = bf2f(p.K[o]), v = bf2f(p.V[o]), a = bf2f(p.A[o]), ld = bf2f(p.LD[o]), g = bf2f(p.G[o]);
        float kk = k * kk_c; const float nrm = sqrtf(wave_sum(kk * kk)); kk = kk / fmaxf(nrm, 1e-12f);
        const float kp = k * (1.f + (a - 1.f) * ka_c);
        const float rkc = wave_sum(r * kp * rk_c);
        __syncthreads();
        vec[0][lane] = -kk; vec[1][lane] = kk * a; vec[2][lane] = __expf(ld); vec[3][lane] = kp; vec[4][lane] = r;
        __syncthreads();
        float sa = 0.f;
#pragma unroll
        for (int j = 0; j < 64; ++j) sa += S[j] * vec[0][j];
        float y = 0.f;
#pragma unroll
        for (int j = 0; j < 64; ++j) { S[j] = S[j] * vec[2][j] + sa * vec[1][j] + v * vec[3][j]; y += S[j] * vec[4][j]; }
        const float mean = wave_sum(y) * (1.f / 64.f); const float d = y - mean; const float var = wave_sum(d * d) * (1.f / 64.f);
        const float yn = d * rsqrtf(var + LNX_EPS) * lg + lb;
        p.mix[(size_t)(b * SEQ + t) * D + ATT_W + ch] = (bf16_t)f2bf((yn + rkc * v) * g);
    }
}

__global__ void __launch_bounds__(64) k_attn(const bf16_t* __restrict__ proj, const float* __restrict__ sinks, bf16_t* __restrict__ mix) {
    const int h = blockIdx.y, m = blockIdx.x * 64 + threadIdx.x, t = m % SEQ, kvh = h >> 2;
    float q[64], o[64];
    const bf16_t* qp = proj + (size_t)m * IN_W + h * 64;
#pragma unroll
    for (int d8 = 0; d8 < 8; ++d8) { const bf16x8 qv = *(const bf16x8*)(qp + d8 * 8);
#pragma unroll
        for (int e = 0; e < 8; ++e) { q[d8 * 8 + e] = bf2f((bf16_t)qv[e]) * 0.125f; o[d8 * 8 + e] = 0.f; } }
    const float slope = exp2f(-(float)(h + 1));
    float mx = sinks[h], l = 1.f;
    const int s0 = t - (WINDOW - 1) < 0 ? 0 : t - (WINDOW - 1);
    for (int s = s0; s <= t; ++s) {
        const bf16_t* kp = proj + (size_t)(m - t + s) * IN_W + ATT_W + kvh * 64; const bf16_t* vp = kp + KV_W;
        float sc = 0.f;
#pragma unroll
        for (int d8 = 0; d8 < 8; ++d8) { const bf16x8 kv = *(const bf16x8*)(kp + d8 * 8);
#pragma unroll
            for (int e = 0; e < 8; ++e) sc += q[d8 * 8 + e] * bf2f((bf16_t)kv[e]); }
        sc -= slope * (float)(t - s);
        const float mn = fmaxf(mx, sc), al = __expf(mx - mn), pe = __expf(sc - mn);
        l = l * al + pe; mx = mn;
#pragma unroll
        for (int d8 = 0; d8 < 8; ++d8) { const bf16x8 vv = *(const bf16x8*)(vp + d8 * 8);
#pragma unroll
            for (int e = 0; e < 8; ++e) o[d8 * 8 + e] = o[d8 * 8 + e] * al + pe * bf2f((bf16_t)vv[e]); }
    }
    const float inv = 1.f / l;
    bf16_t* op = mix + (size_t)m * D + h * 64;
#pragma unroll
    for (int d = 0; d < 64; ++d) op[d] = (bf16_t)f2bf(o[d] * inv);
}

__global__ void k_conv(const bf16_t* __restrict__ U, const bf16_t* __restrict__ UP, const float* __restrict__ cw, const float* __restrict__ cb, bf16_t* __restrict__ hid) {
    const size_t i = (size_t)blockIdx.x * 256 + threadIdx.x; const int t = (int)(i / FF), j = (int)(i % FF);
    const float u0 = bf2f(U[i]), u1 = t >= 1 ? bf2f(U[i - FF]) : 0.f, u2 = t >= 2 ? bf2f(U[i - 2 * FF]) : 0.f;
    const float c = cb[j] + cw[j] * u2 + cw[FF + j] * u1 + cw[2 * FF + j] * u0;
    hid[i] = (bf16_t)f2bf(c * sigmoidf_(c) * bf2f(UP[i]));
}

__global__ void k_final(float* __restrict__ x, const float* __restrict__ ss, const float* __restrict__ g) {
    const int row = blockIdx.x * 4 + (threadIdx.x >> 6), lane = threadIdx.x & 63;
    const float rstd = rsqrtf(ss[row] * (1.f / D) + RMS_EPS);
    f32x4* xr = (f32x4*)(x + (size_t)row * D) + lane; const f32x4* gr = (const f32x4*)g + lane;
#pragma unroll
    for (int j = 0; j < 4; ++j) { f32x4 v = xr[64 * j]; const f32x4 gg = gr[64 * j]; v.x *= rstd * gg.x; v.y *= rstd * gg.y; v.z *= rstd * gg.z; v.w *= rstd * gg.w; xr[64 * j] = v; }
}

extern "C" void kernel_launch(void* const* d_in, const int* in_sizes, int n_in, void* d_out, int out_size, void* d_ws, size_t ws_size, hipStream_t stream) {
    if (n_in != 26 || in_sizes[0] != M * D || out_size != M * D || ws_size < WS_END) { fprintf(stderr, "kernel_launch: unexpected shapes (n_in %d, ws %zu)\n", n_in, ws_size); return; }
    const float* x = (const float*)d_in[0]; const float* norm1_g = (const float*)d_in[1]; const float* w_in = (const float*)d_in[2]; const float* sinks = (const float*)d_in[3];
    const float* mu = (const float*)d_in[4]; const float* w0 = (const float*)d_in[5]; const float* w2 = (const float*)d_in[6]; const float* a0 = (const float*)d_in[7];
    const float* a2 = (const float*)d_in[8]; const float* g2 = (const float*)d_in[9]; const float* k_k = (const float*)d_in[10]; const float* k_a = (const float*)d_in[11];
    const float* r_k = (const float*)d_in[12]; const float* lnx_g = (const float*)d_in[13]; const float* lnx_b = (const float*)d_in[14]; const float* v0 = (const float*)d_in[15];
    const float* v1 = (const float*)d_in[16]; const float* v2 = (const float*)d_in[17]; const float* w_out = (const float*)d_in[18]; const float* norm2_g = (const float*)d_in[19];
    const float* wg = (const float*)d_in[20]; const float* wu = (const float*)d_in[21]; const float* conv_w = (const float*)d_in[22]; const float* conv_b = (const float*)d_in[23];
    const float* wd = (const float*)d_in[24]; const float* final_g = (const float*)d_in[25];
    unsigned char* ws = (unsigned char*)d_ws; float* X = (float*)d_out;
    float* ss = (float*)(ws + WS_SS);
    bf16_t* XB = (bf16_t*)(ws + WS_XB); bf16_t* PROJ = (bf16_t*)(ws + WS_PROJ); bf16_t* MIX = (bf16_t*)(ws + WS_MIX); bf16_t* HID = (bf16_t*)(ws + WS_HID); bf16_t* VF = (bf16_t*)(ws + WS_VFIRST);
    bf16_t* UT = (bf16_t*)(ws + WS_UTMP); bf16_t* UPT = UT + (size_t)SEQ * FF;
    (void)hipMemsetAsync(ws + WS_CTL, 0, CTL_BYTES, stream);
    for (int l = 0; l < 2; ++l) {
        bf16_t* wl = (bf16_t*)(ws + WS_W + l * W_LAYER); bf16_t* WinT = wl; bf16_t* WoutT = (bf16_t*)((char*)wl + W_IN_SZ); bf16_t* WguT = (bf16_t*)((char*)WoutT + W_OUT_SZ); bf16_t* WdT = (bf16_t*)((char*)WguT + W_GU_SZ);
        k_transpose_w<<<dim3(IN_W / 32, D / 32), 256, 0, stream>>>(w_in + (size_t)l * D * IN_W, D, IN_W, WinT, norm1_g + l * D, 0);
        k_transpose_w<<<dim3(D / 32, D / 32), 256, 0, stream>>>(w_out + (size_t)l * D * D, D, D, WoutT, nullptr, 0);
        k_transpose_w<<<dim3(FF / 32, D / 32), 256, 0, stream>>>(wg + (size_t)l * D * FF, D, FF, WguT, norm2_g + l * D, 1);
        k_transpose_w<<<dim3(FF / 32, D / 32), 256, 0, stream>>>(wu + (size_t)l * D * FF, D, FF, WguT, norm2_g + l * D, 2);
        k_transpose_w<<<dim3(D / 32, FF / 32), 256, 0, stream>>>(wd + (size_t)l * FF * D, FF, D, WdT, nullptr, 0);
    }
    k_x_to_bf16<<<M / 4, 256, 0, stream>>>(x, XB, ss);
    for (int l = 0; l < 2; ++l) {
        bf16_t* wl = (bf16_t*)(ws + WS_W + l * W_LAYER); bf16_t* WinT = wl; bf16_t* WoutT = (bf16_t*)((char*)wl + W_IN_SZ); bf16_t* WguT = (bf16_t*)((char*)WoutT + W_OUT_SZ); bf16_t* WdT = (bf16_t*)((char*)WguT + W_GU_SZ);
        float* ss1 = ss + (size_t)(2 * l) * M; float* ss2 = ss + (size_t)(2 * l + 1) * M; float* ss3 = ss + (size_t)(2 * l + 2) * M;
        { EpArgs e{}; e.ss = ss1; e.ob = PROJ; e.ldo = IN_W; k_gemm<0><<<dim3(IN_W / 64, M / 64), 256, 0, stream>>>(XB, D, WinT, D, D, e); }
        k_attn<<<dim3(M / 64, NH), 64, 0, stream>>>(PROJ, sinks + l * NH, MIX);
        { PrepArgs p{}; p.proj = PROJ; p.mu = mu + l * SHIFT_W; p.w0 = w0 + l * C; p.w2 = w2 + (size_t)l * 64 * C; p.a0 = a0 + l * C; p.a2 = a2 + (size_t)l * 64 * C; p.g2 = g2 + (size_t)l * 128 * C;
          p.v0 = v0; p.v1 = v1; p.v2 = v2; p.vfirst = VF; p.layer = l;
          p.R = (bf16_t*)(ws + WS_SI_R); p.K = (bf16_t*)(ws + WS_SI_K); p.V = (bf16_t*)(ws + WS_SI_V); p.A = (bf16_t*)(ws + WS_SI_A); p.LD = (bf16_t*)(ws + WS_SI_LD); p.G = (bf16_t*)(ws + WS_SI_G);
          k_prep<<<M / 4, 512, 0, stream>>>(p);
          ScanArgs s{}; s.R = p.R; s.K = p.K; s.V = p.V; s.A = p.A; s.LD = p.LD; s.G = p.G; s.k_k = k_k + l * C; s.k_a = k_a + l * C; s.r_k = r_k + l * C; s.lnx_g = lnx_g + l * C; s.lnx_b = lnx_b + l * C; s.mix = MIX;
          k_scan<<<BATCH * NH, 64, 0, stream>>>(s); }
        { EpArgs e{}; e.base = (l == 0) ? x : X; e.xout = X; e.ob = XB; e.ss_out = ss2; k_gemm<1><<<dim3(D / 64, M / 64), 256, 0, stream>>>(MIX, D, WoutT, D, D, e); }
        for (int b = 0; b < BATCH; ++b) {
            EpArgs e{}; e.ss = ss2 + (size_t)b * SEQ; e.ob = UT; e.ob2 = UPT; e.row_off = 0;
            k_gemm<2><<<dim3(2 * FF / 64, SEQ / 64), 256, 0, stream>>>(XB + (size_t)b * SEQ * D, D, WguT, D, D, e);
            k_conv<<<(unsigned)((size_t)SEQ * FF / 256), 256, 0, stream>>>(UT, UPT, conv_w + (size_t)l * 3 * FF, conv_b + (size_t)l * FF, HID + (size_t)b * SEQ * FF);
        }
        { EpArgs e{}; e.base = X; e.xout = X; e.ob = XB; e.ss_out = ss3; k_gemm<1><<<dim3(D / 64, M / 64), 256, 0, stream>>>(HID, FF, WdT, FF, FF, e); }
    }
    k_final<<<M / 4, 256, 0, stream>>>(X, ss + (size_t)4 * M, final_g);
}
```

```cpp
#include <hip/hip_runtime.h>
#include <hip/hip_cooperative_groups.h>
namespace cg = cooperative_groups;
#include <cstdio>
#include <cstdint>

typedef unsigned short bf16_t;
typedef short bf16x8 __attribute__((ext_vector_type(8)));
typedef float f32x4 __attribute__((ext_vector_type(4)));

constexpr int BATCH = 8, SEQ = 4096, D = 1024, M = BATCH * SEQ;
constexpr int HD = 64, ATT_W = 512, KV_W = 128, C = 512, NH = 8;
constexpr int ATT_IN = 768, SHIFT_W = 1792, IN_W = 2560, FF = 2816;
constexpr int WINDOW = 128;
constexpr float RMS_EPS = 1e-5f, LNX_EPS = 64e-5f;

constexpr size_t MiB = 1u << 20;
constexpr size_t WS_CTL = 0;
constexpr size_t WS_SS = 0;
constexpr size_t CTL_BYTES = 1 * MiB;
constexpr size_t WS_W = 2 * MiB;
constexpr size_t W_IN_SZ = (size_t)IN_W * D * 2, W_OUT_SZ = (size_t)D * D * 2, W_GU_SZ = (size_t)2 * FF * D * 2, W_DN_SZ = (size_t)D * FF * 2;
constexpr size_t W_LAYER = W_IN_SZ + W_OUT_SZ + W_GU_SZ + W_DN_SZ;
constexpr size_t WS_VFIRST = 52 * MiB, WS_MIX = 84 * MiB, WS_XB = 148 * MiB, WS_PROJ = 212 * MiB;
constexpr size_t WS_SI_R = 148 * MiB, WS_SI_K = 180 * MiB, WS_SI_V = 372 * MiB, WS_SI_A = 404 * MiB, WS_SI_LD = 436 * MiB, WS_SI_G = 468 * MiB;
constexpr size_t WS_HID = 212 * MiB;
constexpr size_t WS_UTMP = 84 * MiB;
constexpr size_t WS_END = 500 * MiB;
static_assert(WS_W + 2 * W_LAYER <= WS_VFIRST, "weights fit");

__device__ __forceinline__ unsigned f2bf(float f) { unsigned u = __builtin_bit_cast(unsigned, f); return (u + 0x7fffu + ((u >> 16) & 1u)) >> 16; }
__device__ __forceinline__ float bf2f(bf16_t h) { return __builtin_bit_cast(float, (unsigned)h << 16); }
__device__ __forceinline__ float wave_sum(float v) {
#pragma unroll
    for (int o = 1; o < 64; o <<= 1) v += __shfl_xor(v, o);
    return v;
}
__device__ __forceinline__ float sigmoidf_(float x) { return 1.f / (1.f + __expf(-x)); }

namespace pg8 {
#define PG8_LAS __attribute__((address_space(3)))
typedef unsigned short bf16_t;
typedef short bf16x8 __attribute__((ext_vector_type(8)));
typedef float f32x4 __attribute__((ext_vector_type(4)));
typedef unsigned u32x4 __attribute__((ext_vector_type(4)));
constexpr int BM = 256, BK = 64, HALF = 128, HTB = HALF * BK * 2  , STAGE_BYTES = 8 * HTB, NXCD = 8, WGM = 8;

__host__ __device__ __forceinline__ int lds_byte(int r, int c) { const int st = (r >> 4) * 2 + (c >> 5), rr = r & 15, cc = c & 31, ob = rr * 64 + cc * 2; return st * 1024 + (ob ^ (((ob >> 9) & 1) << 5)); }
__host__ __device__ __forceinline__ void stage_rc(int b, int& R, int& C) { const int st = b / 1024, sb = b % 1024, swz = sb ^ (((sb >> 9) & 1) << 5); R = (st >> 1) * 16 + swz / 64; C = (st & 1) * 32 + (swz % 64) / 2; }
__host__ __device__ __forceinline__ int perm32(int rho) { const int n = rho >> 4, i = rho & 15; return 8 * (i >> 2) + 4 * n + (i & 3); }

struct Unit { int pm, pn; };
struct Gemm { const bf16_t* A; const bf16_t* Bt; int M, N, K; };

struct StaticOrder {
    int nM, nN, nwg, G, c;
    __host__ __device__ void init(int M, int N, int G_, int c_) { nM = M / BM; nN = N / BM; nwg = nM * nN; G = G_; c = c_; }
    __host__ __device__ bool next(int i, Unit& u) const {
        const long L = (long)i * G + c; if (L >= nwg) return false;
        int wgid = (int)L; { const int q = nwg / NXCD, r = nwg % NXCD, xcd = wgid % NXCD, off = wgid / NXCD; wgid = (xcd < r ? xcd * (q + 1) : r * (q + 1) + (xcd - r) * q) + off; }
        const int nig = WGM * nN, gid = wgid / nig, fm = gid * WGM, gsz = (nM - fm) < WGM ? (nM - fm) : WGM;
        u.pm = fm + ((wgid % nig) % gsz); u.pn = (wgid % nig) / gsz; return true;
    }
    __device__ __forceinline__ void a_ready(const Unit&) const {}
    __device__ __forceinline__ void done(const Unit&) const {}
};
__device__ __forceinline__ unsigned cvt_pk_bf16(float lo, float hi) { unsigned r; asm volatile("v_cvt_pk_bf16_f32 %0, %1, %2" : "=v"(r) : "v"(lo), "v"(hi)); return r; }
typedef float f32x2 __attribute__((ext_vector_type(2)));
template <class Epi, class Sched, bool ALIGN_EPI = false, bool SP2 = false>
__device__ __forceinline__ void gemm_phase(PG8_LAS unsigned char* lds, const Gemm g, const Sched& S, const Epi& E) {
    int tid_ = threadIdx.x; asm volatile("" : "+v"(tid_));
    const int tid = tid_, wid = __builtin_amdgcn_readfirstlane(tid >> 6), lane = tid & 63, wr = wid >> 2, wc = wid & 3, fr = lane & 15, fq = lane >> 4;
    const int K = g.K, nt = K / BK;
    unsigned voffA[2], voffB[2];
#pragma unroll
    for (int i = 0; i < 2; ++i) { int R, C; stage_rc(tid * 16 + i * 8192, R, C); const int Rb = Epi::PERM ? ((R & ~31) + perm32(R & 31)) : R;
        voffA[i] = (unsigned)(R * K + C) * 2u; voffB[i] = (unsigned)(Rb * K + C) * 2u; }
    const size_t kstep = (size_t)(BK * 2);
    const size_t hstep = (size_t)HALF * K * 2;
    const size_t tstep = 2 * hstep;
    const unsigned ldsw = (unsigned)wid * 1024u;
    const int aoff = lds_byte(wr * 64 + fr, fq * 8), boff = lds_byte(wc * 32 + fr, fq * 8);
#define PG8_SA(b, h) (((b) * 2 + (h)) * HTB)
#define PG8_SB(b, h) ((4 + (b) * 2 + (h)) * HTB)
#define PG8_STAGE(bufoff, gbase, voff) do { _Pragma("unroll") for (int _i = 0; _i < 2; ++_i) \
        __builtin_amdgcn_global_load_lds((const unsigned*)((const char*)(gbase) + (voff)[_i]), (PG8_LAS unsigned*)(lds + (bufoff) + ldsw + _i * 8192), 16, 0, 0); } while (0)
#define PG8_LDA(dst, b, h) do { _Pragma("unroll") for (int m = 0; m < 4; ++m) _Pragma("unroll") for (int k = 0; k < 2; ++k) dst[m][k] = *(const PG8_LAS bf16x8*)(lds + PG8_SA(b, h) + aoff + m * 2048 + k * 1024); } while (0)
#define PG8_LDB(dst, b, h) do { _Pragma("unroll") for (int n = 0; n < 2; ++n) _Pragma("unroll") for (int k = 0; k < 2; ++k) dst[n][k] = *(const PG8_LAS bf16x8*)(lds + PG8_SB(b, h) + boff + n * 2048 + k * 1024); } while (0)
#define PG8_MMA(ai, bj, At, Bt) do { __builtin_amdgcn_s_setprio(1); _Pragma("unroll") for (int m = 0; m < 4; ++m) _Pragma("unroll") for (int n = 0; n < 2; ++n) _Pragma("unroll") for (int k = 0; k < 2; ++k) \
        acc[ai][bj][m][n] = __builtin_amdgcn_mfma_f32_16x16x32_bf16(Bt[n][k], At[m][k], acc[ai][bj][m][n], 0, 0, 0); __builtin_amdgcn_s_setprio(0); } while (0)
#define PG8_WAIT_V(n) asm volatile("s_waitcnt vmcnt(" #n ")" ::: "memory")
#define PG8_WAIT_L(n) asm volatile("s_waitcnt lgkmcnt(" #n ")" ::: "memory")
#define PG8_BAR __builtin_amdgcn_s_barrier()
#define PG8_SCHED __builtin_amdgcn_sched_barrier(0)
    Unit cur, nxt; int ui = 0;
    if (!S.next(0, cur)) return;
    f32x4 acc[2][2][4][2];
#pragma unroll
    for (int a = 0; a < 2; ++a)
#pragma unroll
        for (int b = 0; b < 2; ++b)
#pragma unroll
            for (int m = 0; m < 4; ++m)
#pragma unroll
                for (int n = 0; n < 2; ++n) acc[a][b][m][n] = (f32x4){0.f, 0.f, 0.f, 0.f};
    bf16x8 At[4][2], B0[2][2], B1[2][2];
    const char* cA = (const char*)g.A + (size_t)cur.pm * tstep; const char* cB = (const char*)g.Bt + (size_t)cur.pn * tstep;
    S.a_ready(cur);
    if constexpr (SP2) {
        PG8_STAGE(PG8_SB(0, 0), cB, voffB); PG8_STAGE(PG8_SB(0, 1), cB + hstep, voffB); PG8_STAGE(PG8_SA(0, 0), cA, voffA); PG8_STAGE(PG8_SA(0, 1), cA + hstep, voffA);
        if (wr == 1) PG8_BAR;
        PG8_WAIT_V(2); PG8_BAR;
        PG8_STAGE(PG8_SB(1, 0), cB + kstep, voffB); PG8_STAGE(PG8_SA(1, 0), cA + kstep, voffA); PG8_STAGE(PG8_SB(1, 1), cB + hstep + kstep, voffB);
        PG8_WAIT_V(6); PG8_BAR;
    } else {
        PG8_STAGE(PG8_SB(0, 0), cB, voffB); PG8_STAGE(PG8_SA(0, 0), cA, voffA); PG8_STAGE(PG8_SB(0, 1), cB + hstep, voffB); PG8_STAGE(PG8_SA(0, 1), cA + hstep, voffA);
        if (wr == 1) PG8_BAR;
        PG8_WAIT_V(4); PG8_BAR;
        PG8_STAGE(PG8_SB(1, 0), cB + kstep, voffB); PG8_STAGE(PG8_SA(1, 0), cA + kstep, voffA); PG8_STAGE(PG8_SB(1, 1), cB + hstep + kstep, voffB);
        PG8_WAIT_V(6); PG8_BAR;
    }
    for (;;) {
        const bool has_next = S.next(ui + 1, nxt);
        const char* nA = has_next ? (const char*)g.A + (size_t)nxt.pm * tstep : cA; const char* nB = has_next ? (const char*)g.Bt + (size_t)nxt.pn * tstep : cB;
        for (int t = 0; t < nt; t += 2) {
            const bool last = (t == nt - 2);
            const char* a1 = cA + (size_t)(t + 1) * kstep;
            const char* a2 = last ? nA : cA + (size_t)(t + 2) * kstep; const char* b2 = last ? nB : cB + (size_t)(t + 2) * kstep;
            const char* a3 = a2 + kstep; const char* b3 = b2 + kstep;
            if (last && has_next) S.a_ready(nxt);
            if constexpr (SP2) {
            PG8_LDB(B0, 0, 0); PG8_LDB(B1, 0, 1); PG8_SCHED; PG8_LDA(At, 0, 0); PG8_STAGE(PG8_SA(1, 1), a1 + hstep, voffA);
            PG8_WAIT_V(8); PG8_WAIT_L(0); PG8_BAR; PG8_MMA(0, 0, At, B0); PG8_MMA(0, 1, At, B1); PG8_BAR; PG8_SCHED;
            PG8_LDA(At, 0, 1); PG8_STAGE(PG8_SB(0, 0), b2, voffB); PG8_STAGE(PG8_SB(0, 1), b2 + hstep, voffB); PG8_STAGE(PG8_SA(0, 0), a2, voffA);
            PG8_WAIT_V(8); PG8_WAIT_L(0); PG8_BAR; PG8_MMA(1, 0, At, B0); PG8_MMA(1, 1, At, B1); PG8_BAR; PG8_SCHED;
            PG8_LDB(B0, 1, 0); PG8_LDB(B1, 1, 1); PG8_SCHED; PG8_LDA(At, 1, 0); PG8_STAGE(PG8_SA(0, 1), a2 + hstep, voffA);
            PG8_WAIT_V(8); PG8_WAIT_L(0); PG8_BAR; PG8_MMA(0, 0, At, B0); PG8_MMA(0, 1, At, B1); PG8_BAR; PG8_SCHED;
            PG8_LDA(At, 1, 1); PG8_STAGE(PG8_SB(1, 0), b3, voffB); PG8_STAGE(PG8_SB(1, 1), b3 + hstep, voffB); PG8_STAGE(PG8_SA(1, 0), a3, voffA);
            PG8_WAIT_V(8); PG8_WAIT_L(0); PG8_BAR; PG8_MMA(1, 0, At, B0); PG8_MMA(1, 1, At, B1); PG8_BAR; PG8_SCHED;
            } else {
            PG8_LDB(B0, 0, 0); PG8_SCHED; PG8_LDA(At, 0, 0); PG8_STAGE(PG8_SA(1, 1), a1 + hstep, voffA);
            PG8_WAIT_L(8); PG8_BAR; PG8_WAIT_L(0); PG8_MMA(0, 0, At, B0); PG8_BAR; PG8_SCHED;
            PG8_LDB(B1, 0, 1); PG8_STAGE(PG8_SB(0, 0), b2, voffB);
            PG8_BAR; PG8_WAIT_L(0); PG8_MMA(0, 1, At, B1); PG8_BAR;
            PG8_LDA(At, 0, 1); PG8_STAGE(PG8_SA(0, 0), a2, voffA);
            PG8_BAR; PG8_WAIT_L(0); PG8_MMA(1, 0, At, B0); PG8_BAR; PG8_SCHED;
            PG8_STAGE(PG8_SB(0, 1), b2 + hstep, voffB);
            PG8_WAIT_V(6); PG8_BAR; PG8_MMA(1, 1, At, B1); PG8_BAR;
            PG8_LDB(B0, 1, 0); PG8_SCHED; PG8_LDA(At, 1, 0); PG8_STAGE(PG8_SA(0, 1), a2 + hstep, voffA);
            PG8_WAIT_L(8); PG8_BAR; PG8_WAIT_L(0); PG8_MMA(0, 0, At, B0); PG8_BAR; PG8_SCHED;
            PG8_LDB(B1, 1, 1); PG8_STAGE(PG8_SB(1, 0), b3, voffB);
            PG8_BAR; PG8_WAIT_L(0); PG8_MMA(0, 1, At, B1); PG8_BAR;
            PG8_LDA(At, 1, 1); PG8_STAGE(PG8_SA(1, 0), a3, voffA);
            PG8_BAR; PG8_WAIT_L(0); PG8_MMA(1, 0, At, B0); PG8_BAR; PG8_SCHED;
            PG8_STAGE(PG8_SB(1, 1), b3 + hstep, voffB);
            PG8_WAIT_V(6); PG8_BAR; PG8_MMA(1, 1, At, B1); PG8_BAR;
            }
        }
        if constexpr (ALIGN_EPI) { if (wr == 0) PG8_BAR; }
        if constexpr (!Epi::AFTER_DRAIN) { E(acc, cur, wr, wc, fr, fq); S.done(cur); }
        if (!has_next) break;
#pragma unroll
        for (int a = 0; a < 2; ++a)
#pragma unroll
            for (int b = 0; b < 2; ++b)
#pragma unroll
                for (int m = 0; m < 4; ++m)
#pragma unroll
                    for (int n = 0; n < 2; ++n) acc[a][b][m][n] = (f32x4){0.f, 0.f, 0.f, 0.f};
        cur = nxt; cA = nA; cB = nB; ++ui;
        if constexpr (ALIGN_EPI) { if (wr == 1) PG8_BAR; }
    }
    PG8_WAIT_V(0);
    if constexpr (!ALIGN_EPI) { if (wr == 0) PG8_BAR; }
    PG8_BAR;
    if constexpr (Epi::AFTER_DRAIN) { E.fused(acc, cur, wr, wc, fr, fq, lds, wid, lane); S.done(cur); }
#undef PG8_SA
#undef PG8_SB
#undef PG8_STAGE
#undef PG8_LDA
#undef PG8_LDB
#undef PG8_MMA
#undef PG8_WAIT_V
#undef PG8_WAIT_L
#undef PG8_BAR
#undef PG8_SCHED
}

constexpr int DM_ = 1024; constexpr float RMS_EPS_ = 1e-5f;
__device__ __forceinline__ float rstd_of(const float* ss, int row) { return __builtin_amdgcn_rsqf(ss[row] * (1.0f / DM_) + RMS_EPS_); }
struct EpiScaleBf16 {
    static constexpr bool PERM = true, AFTER_DRAIN = false;
    bf16_t* O; int ldc; const float* ss;
    __device__ __forceinline__ void operator()(const f32x4 (&acc)[2][2][4][2], const Unit& u, int wr, int wc, int fr, int fq) const {
        const int row0 = u.pm * BM + wr * 64 + fr, col0 = u.pn * BM + wc * 32 + 8 * fq;
        float rsv[2][4];
#pragma unroll
        for (int ai = 0; ai < 2; ++ai)
#pragma unroll
            for (int m = 0; m < 4; ++m) rsv[ai][m] = ss[row0 + ai * HALF + m * 16];
#pragma unroll
        for (int ai = 0; ai < 2; ++ai)
#pragma unroll
            for (int m = 0; m < 4; ++m) { const int row = row0 + ai * HALF + m * 16; const float rs = __builtin_amdgcn_rsqf(rsv[ai][m] * (1.0f / DM_) + RMS_EPS_); bf16_t* rowp = O + (size_t)row * ldc + col0;
#pragma unroll
                for (int bj = 0; bj < 2; ++bj) { const f32x4 v0 = acc[ai][bj][m][0] * rs, v1 = acc[ai][bj][m][1] * rs;
                    u32x4 w; w.x = cvt_pk_bf16(v0[0], v0[1]); w.y = cvt_pk_bf16(v0[2], v0[3]); w.z = cvt_pk_bf16(v1[0], v1[1]); w.w = cvt_pk_bf16(v1[2], v1[3]);
                    *(u32x4*)(rowp + bj * HALF) = w; } }
    }
};
struct EpiResid {
    static constexpr bool PERM = false, AFTER_DRAIN = false;
    const float* base; float* xout; bf16_t* xb; float* ss_out;
    __device__ __forceinline__ void operator()(const f32x4 (&acc)[2][2][4][2], const Unit& u, int wr, int wc, int fr, int fq) const {
        typedef unsigned u32x2v __attribute__((ext_vector_type(2)));
        const int row0 = u.pm * BM + wr * 64 + fr, col0 = u.pn * BM + wc * 32 + 4 * fq;
#pragma unroll
        for (int ai = 0; ai < 2; ++ai)
#pragma unroll
            for (int m = 0; m < 4; ++m) { const int row = row0 + ai * HALF + m * 16; const size_t off = (size_t)row * DM_ + col0; float sq = 0.f;
#pragma unroll
                for (int bj = 0; bj < 2; ++bj)
#pragma unroll
                    for (int n = 0; n < 2; ++n) { const size_t o = off + bj * HALF + n * 16; const f32x4 x = *(const f32x4*)(base + o) + acc[ai][bj][m][n];
                        *(f32x4*)(xout + o) = x; u32x2v w; w.x = cvt_pk_bf16(x[0], x[1]); w.y = cvt_pk_bf16(x[2], x[3]); *(u32x2v*)(xb + o) = w;
                        sq += (x[0] * x[0] + x[1] * x[1]) + (x[2] * x[2] + x[3] * x[3]); }
                sq += __shfl_xor(sq, 16); sq += __shfl_xor(sq, 32);
                if (fq == 0) atomicAdd(ss_out + row, sq); }
    }
};
struct EpiGateUpTmp {
    static constexpr bool PERM = true, AFTER_DRAIN = false;
    bf16_t* U; bf16_t* UP; const float* ss; int ff;
    __device__ __forceinline__ void operator()(const f32x4 (&acc)[2][2][4][2], const Unit& u, int wr, int wc, int fr, int fq) const {
        const int row0 = u.pm * BM + wr * 64 + fr, col0 = u.pn * HALF + wc * 32 + 8 * fq;
        float rsv[2][4];
#pragma unroll
        for (int ai = 0; ai < 2; ++ai)
#pragma unroll
            for (int m = 0; m < 4; ++m) rsv[ai][m] = ss[row0 + ai * HALF + m * 16];
#pragma unroll
        for (int ai = 0; ai < 2; ++ai)
#pragma unroll
            for (int m = 0; m < 4; ++m) { const int row = row0 + ai * HALF + m * 16; const float rs = __builtin_amdgcn_rsqf(rsv[ai][m] * (1.0f / DM_) + RMS_EPS_); const size_t o = (size_t)row * ff + col0;
#pragma unroll
                for (int bj = 0; bj < 2; ++bj) { const f32x4 v0 = acc[ai][bj][m][0] * rs, v1 = acc[ai][bj][m][1] * rs;
                    u32x4 w; w.x = cvt_pk_bf16(v0[0], v0[1]); w.y = cvt_pk_bf16(v0[2], v0[3]); w.z = cvt_pk_bf16(v1[0], v1[1]); w.w = cvt_pk_bf16(v1[2], v1[3]);
                    *(u32x4*)((bj == 0 ? U : UP) + o) = w; } }
    }
};
}

#define LAS __attribute__((address_space(3)))
__device__ __forceinline__ void transpose_item(const float* __restrict__ W, int K, int N, bf16_t* __restrict__ Wt, const float* __restrict__ g, int mode, float* scr, int item, int lane) {
    const int nblk = N / 32, kb = item / nblk, nb = item % nblk, k0 = 64 * kb, n0 = 32 * nb;
    int np0 = n0; if (mode == 1) np0 = 256 * (n0 / 128) + (n0 % 128); else if (mode == 2) np0 = 256 * (n0 / 128) + 128 + (n0 % 128);
#pragma unroll 8
    for (int i = 0; i < 32; ++i) { const int kk = 2 * i + (lane >> 5); scr[kk * 33 + (lane & 31)] = W[(size_t)(k0 + kk) * N + n0 + (lane & 31)] * (g ? g[k0 + kk] : 1.f); }
    __builtin_amdgcn_fence(__ATOMIC_RELEASE, "wavefront"); __builtin_amdgcn_wave_barrier(); __builtin_amdgcn_fence(__ATOMIC_ACQUIRE, "wavefront");
    const int c = lane & 7;
#pragma unroll
    for (int j = 0; j < 4; ++j) { const int n = (lane >> 3) + 8 * j; const float* sp = scr + (8 * c) * 33 + n;
        uint4 o; o.x = f2bf(sp[0]) | (f2bf(sp[33]) << 16); o.y = f2bf(sp[2 * 33]) | (f2bf(sp[3 * 33]) << 16); o.z = f2bf(sp[4 * 33]) | (f2bf(sp[5 * 33]) << 16); o.w = f2bf(sp[6 * 33]) | (f2bf(sp[7 * 33]) << 16);
        *(uint4*)(Wt + (size_t)(np0 + n) * K + k0 + 8 * c) = o; }
    __builtin_amdgcn_fence(__ATOMIC_RELEASE, "wavefront"); __builtin_amdgcn_wave_barrier(); __builtin_amdgcn_fence(__ATOMIC_ACQUIRE, "wavefront");
}
__device__ __forceinline__ void x_row_to_bf16(const float* __restrict__ x, bf16_t* __restrict__ xb, float* __restrict__ ss, int row, int lane) {
    const f32x4* xr = (const f32x4*)(x + (size_t)row * D) + lane; float s = 0.f;
#pragma unroll
    for (int j = 0; j < 4; ++j) { const f32x4 v = xr[64 * j]; s += v.x * v.x + v.y * v.y + v.z * v.z + v.w * v.w;
        unsigned long long o = (unsigned long long)(f2bf(v.x) | (f2bf(v.y) << 16)) | ((unsigned long long)(f2bf(v.z) | (f2bf(v.w) << 16)) << 32);
        ((unsigned long long*)(xb + (size_t)row * D))[lane + 64 * j] = o; }
    s = wave_sum(s); if (lane == 0) ss[row] = s;
}

struct EpArgs {
    const float* ss; float* ss_out; const float* base; float* xout; bf16_t* ob; bf16_t* ob2; int ldo; int row_off;
};
template <int MODE>
__device__ __forceinline__ void gemm_simple(const bf16_t* __restrict__ A, int lda, const bf16_t* __restrict__ Bt, int ldb, int Mrows, int N, int K, EpArgs e, int tid) {
    const int wid = tid >> 6, lane = tid & 63, fr = lane & 15, fq = lane >> 4;
    const int ntn = N / 128, ntiles = (Mrows / 64) * ntn;
    for (int tile = blockIdx.x; tile < ntiles; tile += gridDim.x) {
    const int row0 = (tile / ntn) * 64 + (wid >> 2) * 32, col0 = (tile % ntn) * 128 + (wid & 3) * 32;
    f32x4 acc[2][2];
#pragma unroll
    for (int i = 0; i < 2; ++i)
#pragma unroll
        for (int j = 0; j < 2; ++j) acc[i][j] = (f32x4){0.f, 0.f, 0.f, 0.f};
    const bf16_t* ap = A + (size_t)(row0 + fr) * lda + fq * 8;
    const bf16_t* bp = Bt + (size_t)(col0 + fr) * ldb + fq * 8;
    for (int k0 = 0; k0 < K; k0 += 32) {
        bf16x8 a[2], b[2];
#pragma unroll
        for (int i = 0; i < 2; ++i) { a[i] = *(const bf16x8*)(ap + (size_t)i * 16 * lda + k0); b[i] = *(const bf16x8*)(bp + (size_t)i * 16 * ldb + k0); }
#pragma unroll
        for (int i = 0; i < 2; ++i)
#pragma unroll
            for (int j = 0; j < 2; ++j) acc[i][j] = __builtin_amdgcn_mfma_f32_16x16x32_bf16(a[i], b[j], acc[i][j], 0, 0, 0);
    }
#pragma unroll
    for (int i = 0; i < 2; ++i)
#pragma unroll
        for (int r = 0; r < 4; ++r) {
            const int row = row0 + i * 16 + fq * 4 + r;
            float rstd = 1.f;
            if (MODE == 0 || MODE == 2) rstd = rsqrtf(e.ss[row] * (1.f / D) + RMS_EPS);
            float sq = 0.f;
#pragma unroll
            for (int j = 0; j < 2; ++j) {
                const int col = col0 + j * 16 + fr; const float v = acc[i][j][r];
                if (MODE == 0) e.ob[(size_t)row * e.ldo + col] = (bf16_t)f2bf(v * rstd);
                else if (MODE == 1) { const size_t o = (size_t)row * D + col; const float x = e.base[o] + v; e.xout[o] = x; e.ob[o] = (bf16_t)f2bf(x); sq += x * x; }
                else { const int p = col >> 8, jj = col & 255; const size_t o = (size_t)(row - e.row_off) * FF + 128 * p + (jj & 127);
                    if (jj < 128) e.ob[o] = (bf16_t)f2bf(v * rstd); else e.ob2[o] = (bf16_t)f2bf(v * rstd); }
            }
            if (MODE == 1) {
                sq += __shfl_xor(sq, 1); sq += __shfl_xor(sq, 2); sq += __shfl_xor(sq, 4); sq += __shfl_xor(sq, 8);
                if (fr == 0) atomicAdd(e.ss_out + row, sq);
            }
        }
    }
}

struct PrepArgs {
    const bf16_t* proj; const float* mu; const float* w0; const float* w2; const float* a0; const float* a2; const float* g2;
    const float* v0; const float* v1; const float* v2; bf16_t* vfirst; int layer; int pad;
    bf16_t *R, *K, *V, *A, *LD, *G;
};
__device__ __forceinline__ void prep_group(const PrepArgs& p, float (*rest)[SHIFT_W], float (*vlo)[32], int grp, int tid) {
    const int m0 = grp * 4;
    for (int i = tid; i < 4 * SHIFT_W; i += 512) {
        const int tk = i / SHIFT_W, c = i % SHIFT_W, m = m0 + tk, t = m % SEQ;
        const float u = bf2f(p.proj[(size_t)m * IN_W + ATT_IN + c]);
        const float up = t > 0 ? bf2f(p.proj[(size_t)(m - 1) * IN_W + ATT_IN + c]) : 0.f;
        float v = u + (up - u) * p.mu[c];
        if (c >= 1536 && c < 1600) v = tanhf(v); else if (c >= 1664) v = sigmoidf_(v);
        rest[tk][c] = v;
    }
    __syncthreads();
    if (p.layer > 0 && tid < 128) { const int tk = tid >> 5, j = tid & 31; float s = 0.f; for (int c = 0; c < C; ++c) s += rest[tk][1024 + c] * p.v1[c * 32 + j]; vlo[tk][j] = s; }
    __syncthreads();
    const int c = tid;
    float wp[4], ap[4], gp[4];
#pragma unroll
    for (int tk = 0; tk < 4; ++tk) { wp[tk] = p.w0[c]; ap[tk] = p.a0[c]; gp[tk] = 0.f; }
    for (int k = 0; k < 64; ++k) { const float w = p.w2[k * C + c], a = p.a2[k * C + c];
#pragma unroll
        for (int tk = 0; tk < 4; ++tk) { wp[tk] += rest[tk][1536 + k] * w; ap[tk] += rest[tk][1600 + k] * a; } }
    for (int k = 0; k < 128; ++k) { const float g = p.g2[k * C + c];
#pragma unroll
        for (int tk = 0; tk < 4; ++tk) gp[tk] += rest[tk][1664 + k] * g; }
#pragma unroll
    for (int tk = 0; tk < 4; ++tk) {
        const size_t o = (size_t)(m0 + tk) * C + c;
        const float x = -wp[tk];
        const float sp = fmaxf(x, 0.f) + log1pf(__expf(-fabsf(x)));
        const float wraw = -sp - 0.5f;
        const float ld = -__expf(wraw);
        const float a = sigmoidf_(ap[tk]);
        float v = rest[tk][1024 + c];
        if (p.layer == 0) p.vfirst[o] = (bf16_t)f2bf(v);
        else { float s = p.v0[c]; for (int j = 0; j < 32; ++j) s += vlo[tk][j] * p.v2[j * C + c]; const float vf = bf2f(p.vfirst[o]); v = v + (vf - v) * sigmoidf_(s); }
        p.R[o] = (bf16_t)f2bf(rest[tk][c]); p.K[o] = (bf16_t)f2bf(rest[tk][512 + c]); p.V[o] = (bf16_t)f2bf(v);
        p.A[o] = (bf16_t)f2bf(a); p.LD[o] = (bf16_t)f2bf(ld); p.G[o] = (bf16_t)f2bf(gp[tk]);
    }
    __syncthreads();
}

struct ScanArgs { const bf16_t *R, *K, *V, *A, *LD, *G; const float *k_k, *k_a, *r_k, *lnx_g, *lnx_b; bf16_t* mix; };
#define WAVE_LDS_SYNC() do { __builtin_amdgcn_fence(__ATOMIC_RELEASE, "wavefront"); __builtin_amdgcn_wave_barrier(); __builtin_amdgcn_fence(__ATOMIC_ACQUIRE, "wavefront"); } while (0)
__device__ __forceinline__ void scan_chain(const ScanArgs& p, float (*vec)[64], int chain, int lane) {
    const int b = chain >> 3, h = chain & 7, ch = h * 64 + lane;
    const float kk_c = p.k_k[ch], ka_c = p.k_a[ch], rk_c = p.r_k[ch], lg = p.lnx_g[ch], lb = p.lnx_b[ch];
    float S[64];
#pragma unroll
    for (int j = 0; j < 64; ++j) S[j] = 0.f;
    for (int t = 0; t < SEQ; ++t) {
        const size_t o = (size_t)(b * SEQ + t) * C + ch;
        const float r = bf2f(p.R[o]), k = bf2f(p.K[o]), v = bf2f(p.V[o]), a = bf2f(p.A[o]), ld = bf2f(p.LD[o]), g = bf2f(p.G[o]);
        float kk = k * kk_c; const float nrm = sqrtf(wave_sum(kk * kk)); kk = kk / fmaxf(nrm, 1e-12f);
        const float kp = k * (1.f + (a - 1.f) * ka_c);
        const float rkc = wave_sum(r * kp * rk_c);
        WAVE_LDS_SYNC();
        vec[0][lane] = -kk; vec[1][lane] = kk * a; vec[2][lane] = __expf(ld); vec[3][lane] = kp; vec[4][lane] = r;
        WAVE_LDS_SYNC();
        float sa = 0.f;
#pragma unroll
        for (int j = 0; j < 64; ++j) sa += S[j] * vec[0][j];
        float y = 0.f;
#pragma unroll
        for (int j = 0; j < 64; ++j) { S[j] = S[j] * vec[2][j] + sa * vec[1][j] + v * vec[3][j]; y += S[j] * vec[4][j]; }
        const float mean = wave_sum(y) * (1.f / 64.f); const float d = y - mean; const float var = wave_sum(d * d) * (1.f / 64.f);
        const float yn = d * rsqrtf(var + LNX_EPS) * lg + lb;
        p.mix[(size_t)(b * SEQ + t) * D + ATT_W + ch] = (bf16_t)f2bf((yn + rkc * v) * g);
    }
}

__device__ __forceinline__ void attn_item(const bf16_t* __restrict__ proj, const float* __restrict__ sinks, bf16_t* __restrict__ mix, int h, int m, int half) {
    const int t = m % SEQ, kvh = h >> 2;
    float q[64], o[32];
    const bf16_t* qp = proj + (size_t)m * IN_W + h * 64;
#pragma unroll
    for (int d8 = 0; d8 < 8; ++d8) { const bf16x8 qv = *(const bf16x8*)(qp + d8 * 8);
#pragma unroll
        for (int e = 0; e < 8; ++e) q[d8 * 8 + e] = bf2f((bf16_t)qv[e]) * 0.125f; }
#pragma unroll
    for (int d = 0; d < 32; ++d) o[d] = 0.f;
    const float slope = exp2f(-(float)(h + 1));
    float mx = sinks[h], l = 1.f;
    const int s0 = t - (WINDOW - 1) < 0 ? 0 : t - (WINDOW - 1);
#pragma unroll 1
    for (int s = s0; s <= t; ++s) {
        const bf16_t* kp = proj + (size_t)(m - t + s) * IN_W + ATT_W + kvh * 64; const bf16_t* vp = kp + KV_W;
        float sc = 0.f;
#pragma unroll
        for (int d8 = 0; d8 < 8; ++d8) { const bf16x8 kv = *(const bf16x8*)(kp + d8 * 8);
#pragma unroll
            for (int e = 0; e < 8; ++e) sc += q[d8 * 8 + e] * bf2f((bf16_t)kv[e]); }
        sc -= slope * (float)(t - s);
        const float mn = fmaxf(mx, sc), al = __expf(mx - mn), pe = __expf(sc - mn);
        l = l * al + pe; mx = mn;
#pragma unroll
        for (int d8 = 0; d8 < 4; ++d8) { const bf16x8 vv = *(const bf16x8*)(vp + half * 32 + d8 * 8);
#pragma unroll
            for (int e = 0; e < 8; ++e) o[d8 * 8 + e] = o[d8 * 8 + e] * al + pe * bf2f((bf16_t)vv[e]); }
    }
    const float inv = 1.f / l;
    bf16_t* op = mix + (size_t)m * D + h * 64 + half * 32;
#pragma unroll
    for (int d = 0; d < 32; ++d) op[d] = (bf16_t)f2bf(o[d] * inv);
}

__device__ __forceinline__ void conv_item(const bf16_t* __restrict__ U, const bf16_t* __restrict__ UP, const float* __restrict__ cw, const float* __restrict__ cb, bf16_t* __restrict__ hid, size_t i) {
    const int t = (int)(i / FF), j = (int)(i % FF);
    const float u0 = bf2f(U[i]), u1 = t >= 1 ? bf2f(U[i - FF]) : 0.f, u2 = t >= 2 ? bf2f(U[i - 2 * FF]) : 0.f;
    const float c = cb[j] + cw[j] * u2 + cw[FF + j] * u1 + cw[2 * FF + j] * u0;
    hid[i] = (bf16_t)f2bf(c * sigmoidf_(c) * bf2f(UP[i]));
}

__device__ __forceinline__ void final_row(float* __restrict__ x, const float* __restrict__ ss, const float* __restrict__ g, int row, int lane) {
    const float rstd = rsqrtf(ss[row] * (1.f / D) + RMS_EPS);
    f32x4* xr = (f32x4*)(x + (size_t)row * D) + lane; const f32x4* gr = (const f32x4*)g + lane;
#pragma unroll
    for (int j = 0; j < 4; ++j) { f32x4 v = xr[64 * j]; const f32x4 gg = gr[64 * j]; v.x *= rstd * gg.x; v.y *= rstd * gg.y; v.z *= rstd * gg.z; v.w *= rstd * gg.w; xr[64 * j] = v; }
}

constexpr int NTHREADS = 512, LDS_BYTES = 147456;
struct Args { const float* in[26]; float* out; unsigned char* ws; };
__global__ void __launch_bounds__(NTHREADS, 2) mega_fwd(Args a) {
    extern __shared__ __attribute__((aligned(16))) unsigned char lds[];
    cg::grid_group grid = cg::this_grid();
#define GRID_SYNC() grid.sync()
#define LDSP ((PG8_LAS unsigned char*)lds)
#define OTID() ({ int _t = threadIdx.x; asm volatile("" : "+v"(_t)); _t; })
    const int G = gridDim.x, NGW = G * 8;
    const float* x = a.in[0]; const float* norm1_g = a.in[1]; const float* w_in = a.in[2]; const float* sinks = a.in[3];
    const float* mu = a.in[4]; const float* w0 = a.in[5]; const float* w2 = a.in[6]; const float* a0 = a.in[7];
    const float* a2 = a.in[8]; const float* g2 = a.in[9]; const float* k_k = a.in[10]; const float* k_a = a.in[11];
    const float* r_k = a.in[12]; const float* lnx_g = a.in[13]; const float* lnx_b = a.in[14]; const float* v0 = a.in[15];
    const float* v1 = a.in[16]; const float* v2 = a.in[17]; const float* w_out = a.in[18]; const float* norm2_g = a.in[19];
    const float* wg = a.in[20]; const float* wu = a.in[21]; const float* conv_w = a.in[22]; const float* conv_b = a.in[23];
    const float* wd = a.in[24]; const float* final_g = a.in[25];
    unsigned char* ws = a.ws; float* X = a.out;
    float* ss = (float*)(ws + WS_SS);
    bf16_t* XB = (bf16_t*)(ws + WS_XB); bf16_t* PROJ = (bf16_t*)(ws + WS_PROJ); bf16_t* MIX = (bf16_t*)(ws + WS_MIX); bf16_t* HID = (bf16_t*)(ws + WS_HID); bf16_t* VF = (bf16_t*)(ws + WS_VFIRST);
    bf16_t* UT = (bf16_t*)(ws + WS_UTMP); bf16_t* UPT = UT + (size_t)SEQ * FF;

    {
        const int tid = OTID(), lane = tid & 63, wave = tid >> 6, gw = blockIdx.x * 8 + wave;
        float* scr = (float*)lds + wave * (64 * 33 + 16);
        constexpr int I_IN = (D / 64) * (IN_W / 32), I_OUT = (D / 64) * (D / 32), I_G = (D / 64) * (FF / 32), I_DN = (FF / 64) * (D / 32), I_LAYER = I_IN + I_OUT + 2 * I_G + I_DN;
        for (int it = gw; it < 2 * I_LAYER; it += NGW) {
            const int l = it / I_LAYER; int r = it % I_LAYER;
            bf16_t* wl = (bf16_t*)(ws + WS_W + l * W_LAYER); bf16_t* WinT = wl; bf16_t* WoutT = (bf16_t*)((char*)wl + W_IN_SZ); bf16_t* WguT = (bf16_t*)((char*)WoutT + W_OUT_SZ); bf16_t* WdT = (bf16_t*)((char*)WguT + W_GU_SZ);
            if (r < I_IN) { transpose_item(w_in + (size_t)l * D * IN_W, D, IN_W, WinT, norm1_g + l * D, 0, scr, r, lane); continue; } r -= I_IN;
            if (r < I_OUT) { transpose_item(w_out + (size_t)l * D * D, D, D, WoutT, nullptr, 0, scr, r, lane); continue; } r -= I_OUT;
            if (r < I_G) { transpose_item(wg + (size_t)l * D * FF, D, FF, WguT, norm2_g + l * D, 1, scr, r, lane); continue; } r -= I_G;
            if (r < I_G) { transpose_item(wu + (size_t)l * D * FF, D, FF, WguT, norm2_g + l * D, 2, scr, r, lane); continue; } r -= I_G;
            transpose_item(wd + (size_t)l * FF * D, FF, D, WdT, nullptr, 0, scr, r, lane);
        }
        for (int m = gw; m < M; m += NGW) x_row_to_bf16(x, XB, ss, m, lane);
    }
    GRID_SYNC();
    for (int l = 0; l < 2; ++l) {
        bf16_t* wl = (bf16_t*)(ws + WS_W + l * W_LAYER); bf16_t* WinT = wl; bf16_t* WoutT = (bf16_t*)((char*)wl + W_IN_SZ); bf16_t* WguT = (bf16_t*)((char*)WoutT + W_OUT_SZ); bf16_t* WdT = (bf16_t*)((char*)WguT + W_GU_SZ);
        float* ss1 = ss + (size_t)(2 * l) * M; float* ss2 = ss + (size_t)(2 * l + 1) * M; float* ss3 = ss + (size_t)(2 * l + 2) * M;
        { pg8::Gemm g{XB, WinT, M, IN_W, D}; pg8::StaticOrder S; S.init(M, IN_W, G, (int)blockIdx.x); pg8::EpiScaleBf16 E{PROJ, IN_W, ss1};
          pg8::gemm_phase<pg8::EpiScaleBf16, pg8::StaticOrder, true, true>(LDSP, g, S, E); }
        GRID_SYNC();
        { const int tid = OTID();
        for (int i = blockIdx.x * NTHREADS + tid; i < M * NH * 2; i += G * NTHREADS) attn_item(PROJ, sinks + l * NH, MIX, (i / M) >> 1, i % M, (i / M) & 1); }
        PrepArgs p{}; p.proj = PROJ; p.mu = mu + l * SHIFT_W; p.w0 = w0 + l * C; p.w2 = w2 + (size_t)l * 64 * C; p.a0 = a0 + l * C; p.a2 = a2 + (size_t)l * 64 * C; p.g2 = g2 + (size_t)l * 128 * C;
        p.v0 = v0; p.v1 = v1; p.v2 = v2; p.vfirst = VF; p.layer = l;
        p.R = (bf16_t*)(ws + WS_SI_R); p.K = (bf16_t*)(ws + WS_SI_K); p.V = (bf16_t*)(ws + WS_SI_V); p.A = (bf16_t*)(ws + WS_SI_A); p.LD = (bf16_t*)(ws + WS_SI_LD); p.G = (bf16_t*)(ws + WS_SI_G);
        for (int grp = blockIdx.x; grp < M / 4; grp += G) prep_group(p, (float (*)[SHIFT_W])lds, (float (*)[32])(lds + 4 * SHIFT_W * 4), grp, OTID());
        GRID_SYNC();
        { ScanArgs s{}; s.R = p.R; s.K = p.K; s.V = p.V; s.A = p.A; s.LD = p.LD; s.G = p.G; s.k_k = k_k + l * C; s.k_a = k_a + l * C; s.r_k = r_k + l * C; s.lnx_g = lnx_g + l * C; s.lnx_b = lnx_b + l * C; s.mix = MIX;
          const int tid = OTID(); if ((tid >> 6) == 0 && (blockIdx.x & 3) == 0 && (blockIdx.x >> 2) < BATCH * NH) scan_chain(s, (float (*)[64])lds, blockIdx.x >> 2, tid & 63); }
        GRID_SYNC();
        { pg8::Gemm g{MIX, WoutT, M, D, D}; pg8::StaticOrder S; S.init(M, D, G, (int)blockIdx.x); pg8::EpiResid E{(l == 0) ? x : X, X, XB, ss2};
          pg8::gemm_phase<pg8::EpiResid, pg8::StaticOrder, true, true>(LDSP, g, S, E); }
        GRID_SYNC();
        for (int b = 0; b < BATCH; ++b) {
            { pg8::Gemm g{XB + (size_t)b * SEQ * D, WguT, SEQ, 2 * FF, D}; pg8::StaticOrder S; S.init(SEQ, 2 * FF, G, (int)blockIdx.x); pg8::EpiGateUpTmp E{UT, UPT, ss2 + (size_t)b * SEQ, FF};
              pg8::gemm_phase<pg8::EpiGateUpTmp, pg8::StaticOrder, true, true>(LDSP, g, S, E); }
            GRID_SYNC();
            { const int tid = OTID();
            for (size_t i = (size_t)blockIdx.x * NTHREADS + tid; i < (size_t)SEQ * FF; i += (size_t)G * NTHREADS) conv_item(UT, UPT, conv_w + (size_t)l * 3 * FF, conv_b + (size_t)l * FF, HID + (size_t)b * SEQ * FF, i); }
            GRID_SYNC();
        }
        { pg8::Gemm g{HID, WdT, M, D, FF}; pg8::StaticOrder S; S.init(M, D, G, (int)blockIdx.x); pg8::EpiResid E{X, X, XB, ss3};
          pg8::gemm_phase<pg8::EpiResid, pg8::StaticOrder, true, true>(LDSP, g, S, E); }
        GRID_SYNC();
    }
    { const int tid = OTID(), lane = tid & 63, gw = blockIdx.x * 8 + (tid >> 6);
    for (int m = gw; m < M; m += NGW) final_row(X, ss + (size_t)4 * M, final_g, m, lane); }
}

extern "C" void kernel_launch(void* const* d_in, const int* in_sizes, int n_in, void* d_out, int out_size, void* d_ws, size_t ws_size, hipStream_t stream) {
    static int grid = 0;
    if (grid == 0) {
        if (n_in != 26 || in_sizes[0] != M * D || out_size != M * D || ws_size < WS_END) { fprintf(stderr, "kernel_launch: unexpected shapes (n_in %d, ws %zu)\n", n_in, ws_size); grid = -1; return; }
        int dev = 0, cus = 0, per_cu = 0;
        if (hipGetDevice(&dev) != hipSuccess || hipDeviceGetAttribute(&cus, hipDeviceAttributeMultiprocessorCount, dev) != hipSuccess) { grid = -1; return; }
        if (hipFuncSetAttribute((const void*)mega_fwd, hipFuncAttributeMaxDynamicSharedMemorySize, LDS_BYTES) != hipSuccess) { fprintf(stderr, "kernel_launch: hipFuncSetAttribute failed\n"); grid = -1; return; }
        if (hipOccupancyMaxActiveBlocksPerMultiprocessor(&per_cu, (const void*)mega_fwd, NTHREADS, LDS_BYTES) != hipSuccess || per_cu < 1) { fprintf(stderr, "kernel_launch: occupancy query failed (%d)\n", per_cu); grid = -1; return; }
        grid = cus;
    }
    if (grid < 0) return;
    (void)hipMemsetAsync((unsigned char*)d_ws + WS_CTL, 0, CTL_BYTES, stream);
    Args a{};
    for (int i = 0; i < 26; ++i) a.in[i] = (const float*)d_in[i];
    a.out = (float*)d_out; a.ws = (unsigned char*)d_ws;
    void* kargs[] = {&a};
    hipError_t e = hipLaunchCooperativeKernel((const void*)mega_fwd, dim3(grid), dim3(NTHREADS), kargs, LDS_BYTES, stream);
    if (e != hipSuccess) fprintf(stderr, "kernel_launch: cooperative launch failed: %s (grid %d)\n", hipGetErrorString(e), grid);
}
```

```cpp
#include <hip/hip_runtime.h>
#include <hip/hip_cooperative_groups.h>
namespace cg = cooperative_groups;
#include <cstdio>
#include <cstdint>

typedef unsigned short bf16_t;
typedef short bf16x8 __attribute__((ext_vector_type(8)));
typedef float f32x4 __attribute__((ext_vector_type(4)));

constexpr int BATCH = 8, SEQ = 4096, D = 1024, M = BATCH * SEQ;
constexpr int HD = 64, ATT_W = 512, KV_W = 128, C = 512, NH = 8;
constexpr int ATT_IN = 768, SHIFT_W = 1792, IN_W = 2560, FF = 2816;
constexpr int WINDOW = 128;
constexpr float RMS_EPS = 1e-5f, LNX_EPS = 64e-5f;

constexpr size_t MiB = 1u << 20;
constexpr size_t WS_CTL = 0;
constexpr size_t WS_SS = 0;
constexpr size_t CTL_BYTES = 1 * MiB;
constexpr size_t WS_W = 2 * MiB;
constexpr size_t W_IN_SZ = (size_t)IN_W * D * 2, W_OUT_SZ = (size_t)D * D * 2, W_GU_SZ = (size_t)2 * FF * D * 2, W_DN_SZ = (size_t)D * FF * 2;
constexpr size_t W_LAYER = W_IN_SZ + W_OUT_SZ + W_GU_SZ + W_DN_SZ;
constexpr size_t WS_VFIRST = 52 * MiB, WS_MIX = 84 * MiB, WS_XB = 148 * MiB, WS_PROJ = 212 * MiB;
constexpr size_t WS_SI_R = 148 * MiB, WS_SI_K = 180 * MiB, WS_SI_V = 372 * MiB, WS_SI_A = 404 * MiB, WS_SI_LD = 436 * MiB, WS_SI_G = 468 * MiB;
constexpr size_t WS_HID = 212 * MiB;
constexpr size_t WS_UTMP = 84 * MiB;
constexpr size_t WS_END = 500 * MiB;
static_assert(WS_W + 2 * W_LAYER <= WS_VFIRST, "weights fit");

__device__ __forceinline__ unsigned f2bf(float f) { unsigned u = __builtin_bit_cast(unsigned, f); return (u + 0x7fffu + ((u >> 16) & 1u)) >> 16; }
__device__ __forceinline__ float bf2f(bf16_t h) { return __builtin_bit_cast(float, (unsigned)h << 16); }
__device__ __forceinline__ float wave_sum(float v) {
#pragma unroll
    for (int o = 1; o < 64; o <<= 1) v += __shfl_xor(v, o);
    return v;
}
__device__ __forceinline__ float sigmoidf_(float x) { return 1.f / (1.f + __expf(-x)); }

namespace pg8 {
#define PG8_LAS __attribute__((address_space(3)))
typedef unsigned short bf16_t;
typedef short bf16x8 __attribute__((ext_vector_type(8)));
typedef float f32x4 __attribute__((ext_vector_type(4)));
typedef unsigned u32x4 __attribute__((ext_vector_type(4)));
constexpr int BM = 256, BK = 64, HALF = 128, HTB = HALF * BK * 2  , STAGE_BYTES = 8 * HTB, NXCD = 8, WGM = 8;

__host__ __device__ __forceinline__ int lds_byte(int r, int c) { const int st = (r >> 4) * 2 + (c >> 5), rr = r & 15, cc = c & 31, ob = rr * 64 + cc * 2; return st * 1024 + (ob ^ (((ob >> 9) & 1) << 5)); }
__host__ __device__ __forceinline__ void stage_rc(int b, int& R, int& C) { const int st = b / 1024, sb = b % 1024, swz = sb ^ (((sb >> 9) & 1) << 5); R = (st >> 1) * 16 + swz / 64; C = (st & 1) * 32 + (swz % 64) / 2; }
__host__ __device__ __forceinline__ int perm32(int rho) { const int n = rho >> 4, i = rho & 15; return 8 * (i >> 2) + 4 * n + (i & 3); }

struct Unit { int pm, pn; };
struct Gemm { const bf16_t* A; const bf16_t* Bt; int M, N, K; };

struct StaticOrder {
    int nM, nN, nwg, G, c;
    __host__ __device__ void init(int M, int N, int G_, int c_) { nM = M / BM; nN = N / BM; nwg = nM * nN; G = G_; c = c_; }
    __host__ __device__ bool next(int i, Unit& u) const {
        const long L = (long)i * G + c; if (L >= nwg) return false;
        int wgid = (int)L; { const int q = nwg / NXCD, r = nwg % NXCD, xcd = wgid % NXCD, off = wgid / NXCD; wgid = (xcd < r ? xcd * (q + 1) : r * (q + 1) + (xcd - r) * q) + off; }
        const int nig = WGM * nN, gid = wgid / nig, fm = gid * WGM, gsz = (nM - fm) < WGM ? (nM - fm) : WGM;
        u.pm = fm + ((wgid % nig) % gsz); u.pn = (wgid % nig) / gsz; return true;
    }
    __device__ __forceinline__ void a_ready(const Unit&) const {}
    __device__ __forceinline__ void done(const Unit&) const {}
};
__device__ __forceinline__ unsigned cvt_pk_bf16(float lo, float hi) { unsigned r; asm volatile("v_cvt_pk_bf16_f32 %0, %1, %2" : "=v"(r) : "v"(lo), "v"(hi)); return r; }
typedef float f32x2 __attribute__((ext_vector_type(2)));
template <class Epi, class Sched, bool ALIGN_EPI = false, bool SP2 = false>
__device__ __forceinline__ void gemm_phase(PG8_LAS unsigned char* lds, const Gemm g, const Sched& S, const Epi& E) {
    int tid_ = threadIdx.x; asm volatile("" : "+v"(tid_));
    const int tid = tid_, wid = __builtin_amdgcn_readfirstlane(tid >> 6), lane = tid & 63, wr = wid >> 2, wc = wid & 3, fr = lane & 15, fq = lane >> 4;
    const int K = g.K, nt = K / BK;
    unsigned voffA[2], voffB[2];
#pragma unroll
    for (int i = 0; i < 2; ++i) { int R, C; stage_rc(tid * 16 + i * 8192, R, C); const int Rb = Epi::PERM ? ((R & ~31) + perm32(R & 31)) : R;
        voffA[i] = (unsigned)(R * K + C) * 2u; voffB[i] = (unsigned)(Rb * K + C) * 2u; }
    const size_t kstep = (size_t)(BK * 2);
    const size_t hstep = (size_t)HALF * K * 2;
    const size_t tstep = 2 * hstep;
    const unsigned ldsw = (unsigned)wid * 1024u;
    const int aoff = lds_byte(wr * 64 + fr, fq * 8), boff = lds_byte(wc * 32 + fr, fq * 8);
#define PG8_SA(b, h) (((b) * 2 + (h)) * HTB)
#define PG8_SB(b, h) ((4 + (b) * 2 + (h)) * HTB)
#define PG8_STAGE(bufoff, gbase, voff) do { _Pragma("unroll") for (int _i = 0; _i < 2; ++_i) \
        __builtin_amdgcn_global_load_lds((const unsigned*)((const char*)(gbase) + (voff)[_i]), (PG8_LAS unsigned*)(lds + (bufoff) + ldsw + _i * 8192), 16, 0, 0); } while (0)
#define PG8_LDA(dst, b, h) do { _Pragma("unroll") for (int m = 0; m < 4; ++m) _Pragma("unroll") for (int k = 0; k < 2; ++k) dst[m][k] = *(const PG8_LAS bf16x8*)(lds + PG8_SA(b, h) + aoff + m * 2048 + k * 1024); } while (0)
#define PG8_LDB(dst, b, h) do { _Pragma("unroll") for (int n = 0; n < 2; ++n) _Pragma("unroll") for (int k = 0; k < 2; ++k) dst[n][k] = *(const PG8_LAS bf16x8*)(lds + PG8_SB(b, h) + boff + n * 2048 + k * 1024); } while (0)
#define PG8_MMA(ai, bj, At, Bt) do { __builtin_amdgcn_s_setprio(1); _Pragma("unroll") for (int m = 0; m < 4; ++m) _Pragma("unroll") for (int n = 0; n < 2; ++n) _Pragma("unroll") for (int k = 0; k < 2; ++k) \
        acc[ai][bj][m][n] = __builtin_amdgcn_mfma_f32_16x16x32_bf16(Bt[n][k], At[m][k], acc[ai][bj][m][n], 0, 0, 0); __builtin_amdgcn_s_setprio(0); } while (0)
#define PG8_WAIT_V(n) asm volatile("s_waitcnt vmcnt(" #n ")" ::: "memory")
#define PG8_WAIT_L(n) asm volatile("s_waitcnt lgkmcnt(" #n ")" ::: "memory")
#define PG8_BAR __builtin_amdgcn_s_barrier()
#define PG8_SCHED __builtin_amdgcn_sched_barrier(0)
    Unit cur, nxt; int ui = 0;
    if (!S.next(0, cur)) return;
    f32x4 acc[2][2][4][2];
#pragma unroll
    for (int a = 0; a < 2; ++a)
#pragma unroll
        for (int b = 0; b < 2; ++b)
#pragma unroll
            for (int m = 0; m < 4; ++m)
#pragma unroll
                for (int n = 0; n < 2; ++n) acc[a][b][m][n] = (f32x4){0.f, 0.f, 0.f, 0.f};
    bf16x8 At[4][2], B0[2][2], B1[2][2];
    const char* cA = (const char*)g.A + (size_t)cur.pm * tstep; const char* cB = (const char*)g.Bt + (size_t)cur.pn * tstep;
    S.a_ready(cur);
    if constexpr (SP2) {
        PG8_STAGE(PG8_SB(0, 0), cB, voffB); PG8_STAGE(PG8_SB(0, 1), cB + hstep, voffB); PG8_STAGE(PG8_SA(0, 0), cA, voffA); PG8_STAGE(PG8_SA(0, 1), cA + hstep, voffA);
        if (wr == 1) PG8_BAR;
        PG8_WAIT_V(2); PG8_BAR;
        PG8_STAGE(PG8_SB(1, 0), cB + kstep, voffB); PG8_STAGE(PG8_SA(1, 0), cA + kstep, voffA); PG8_STAGE(PG8_SB(1, 1), cB + hstep + kstep, voffB);
        PG8_WAIT_V(6); PG8_BAR;
    } else {
        PG8_STAGE(PG8_SB(0, 0), cB, voffB); PG8_STAGE(PG8_SA(0, 0), cA, voffA); PG8_STAGE(PG8_SB(0, 1), cB + hstep, voffB); PG8_STAGE(PG8_SA(0, 1), cA + hstep, voffA);
        if (wr == 1) PG8_BAR;
        PG8_WAIT_V(4); PG8_BAR;
        PG8_STAGE(PG8_SB(1, 0), cB + kstep, voffB); PG8_STAGE(PG8_SA(1, 0), cA + kstep, voffA); PG8_STAGE(PG8_SB(1, 1), cB + hstep + kstep, voffB);
        PG8_WAIT_V(6); PG8_BAR;
    }
    for (;;) {
        const bool has_next = S.next(ui + 1, nxt);
        const char* nA = has_next ? (const char*)g.A + (size_t)nxt.pm * tstep : cA; const char* nB = has_next ? (const char*)g.Bt + (size_t)nxt.pn * tstep : cB;
        for (int t = 0; t < nt; t += 2) {
            const bool last = (t == nt - 2);
            const char* a1 = cA + (size_t)(t + 1) * kstep;
            const char* a2 = last ? nA : cA + (size_t)(t + 2) * kstep; const char* b2 = last ? nB : cB + (size_t)(t + 2) * kstep;
            const char* a3 = a2 + kstep; const char* b3 = b2 + kstep;
            if (last && has_next) S.a_ready(nxt);
            if constexpr (SP2) {
            PG8_LDB(B0, 0, 0); PG8_LDB(B1, 0, 1); PG8_SCHED; PG8_LDA(At, 0, 0); PG8_STAGE(PG8_SA(1, 1), a1 + hstep, voffA);
            PG8_WAIT_V(8); PG8_WAIT_L(0); PG8_BAR; PG8_MMA(0, 0, At, B0); PG8_MMA(0, 1, At, B1); PG8_BAR; PG8_SCHED;
            PG8_LDA(At, 0, 1); PG8_STAGE(PG8_SB(0, 0), b2, voffB); PG8_STAGE(PG8_SB(0, 1), b2 + hstep, voffB); PG8_STAGE(PG8_SA(0, 0), a2, voffA);
            PG8_WAIT_V(8); PG8_WAIT_L(0); PG8_BAR; PG8_MMA(1, 0, At, B0); PG8_MMA(1, 1, At, B1); PG8_BAR; PG8_SCHED;
            PG8_LDB(B0, 1, 0); PG8_LDB(B1, 1, 1); PG8_SCHED; PG8_LDA(At, 1, 0); PG8_STAGE(PG8_SA(0, 1), a2 + hstep, voffA);
            PG8_WAIT_V(8); PG8_WAIT_L(0); PG8_BAR; PG8_MMA(0, 0, At, B0); PG8_MMA(0, 1, At, B1); PG8_BAR; PG8_SCHED;
            PG8_LDA(At, 1, 1); PG8_STAGE(PG8_SB(1, 0), b3, voffB); PG8_STAGE(PG8_SB(1, 1), b3 + hstep, voffB); PG8_STAGE(PG8_SA(1, 0), a3, voffA);
            PG8_WAIT_V(8); PG8_WAIT_L(0); PG8_BAR; PG8_MMA(1, 0, At, B0); PG8_MMA(1, 1, At, B1); PG8_BAR; PG8_SCHED;
            } else {
            PG8_LDB(B0, 0, 0); PG8_SCHED; PG8_LDA(At, 0, 0); PG8_STAGE(PG8_SA(1, 1), a1 + hstep, voffA);
            PG8_WAIT_L(8); PG8_BAR; PG8_WAIT_L(0); PG8_MMA(0, 0, At, B0); PG8_BAR; PG8_SCHED;
            PG8_LDB(B1, 0, 1); PG8_STAGE(PG8_SB(0, 0), b2, voffB);
            PG8_BAR; PG8_WAIT_L(0); PG8_MMA(0, 1, At, B1); PG8_BAR;
            PG8_LDA(At, 0, 1); PG8_STAGE(PG8_SA(0, 0), a2, voffA);
            PG8_BAR; PG8_WAIT_L(0); PG8_MMA(1, 0, At, B0); PG8_BAR; PG8_SCHED;
            PG8_STAGE(PG8_SB(0, 1), b2 + hstep, voffB);
            PG8_WAIT_V(6); PG8_BAR; PG8_MMA(1, 1, At, B1); PG8_BAR;
            PG8_LDB(B0, 1, 0); PG8_SCHED; PG8_LDA(At, 1, 0); PG8_STAGE(PG8_SA(0, 1), a2 + hstep, voffA);
            PG8_WAIT_L(8); PG8_BAR; PG8_WAIT_L(0); PG8_MMA(0, 0, At, B0); PG8_BAR; PG8_SCHED;
            PG8_LDB(B1, 1, 1); PG8_STAGE(PG8_SB(1, 0), b3, voffB);
            PG8_BAR; PG8_WAIT_L(0); PG8_MMA(0, 1, At, B1); PG8_BAR;
            PG8_LDA(At, 1, 1); PG8_STAGE(PG8_SA(1, 0), a3, voffA);
            PG8_BAR; PG8_WAIT_L(0); PG8_MMA(1, 0, At, B0); PG8_BAR; PG8_SCHED;
            PG8_STAGE(PG8_SB(1, 1), b3 + hstep, voffB);
            PG8_WAIT_V(6); PG8_BAR; PG8_MMA(1, 1, At, B1); PG8_BAR;
            }
        }
        if constexpr (ALIGN_EPI) { if (wr == 0) PG8_BAR; }
        if constexpr (!Epi::AFTER_DRAIN) { E(acc, cur, wr, wc, fr, fq); S.done(cur); }
        if (!has_next) break;
#pragma unroll
        for (int a = 0; a < 2; ++a)
#pragma unroll
            for (int b = 0; b < 2; ++b)
#pragma unroll
                for (int m = 0; m < 4; ++m)
#pragma unroll
                    for (int n = 0; n < 2; ++n) acc[a][b][m][n] = (f32x4){0.f, 0.f, 0.f, 0.f};
        cur = nxt; cA = nA; cB = nB; ++ui;
        if constexpr (ALIGN_EPI) { if (wr == 1) PG8_BAR; }
    }
    PG8_WAIT_V(0);
    if constexpr (!ALIGN_EPI) { if (wr == 0) PG8_BAR; }
    PG8_BAR;
    if constexpr (Epi::AFTER_DRAIN) { E.fused(acc, cur, wr, wc, fr, fq, lds, wid, lane); S.done(cur); }
#undef PG8_SA
#undef PG8_SB
#undef PG8_STAGE
#undef PG8_LDA
#undef PG8_LDB
#undef PG8_MMA
#undef PG8_WAIT_V
#undef PG8_WAIT_L
#undef PG8_BAR
#undef PG8_SCHED
}

constexpr int DM_ = 1024; constexpr float RMS_EPS_ = 1e-5f;
__device__ __forceinline__ float rstd_of(const float* ss, int row) { return __builtin_amdgcn_rsqf(ss[row] * (1.0f / DM_) + RMS_EPS_); }
struct EpiScaleBf16 {
    static constexpr bool PERM = true, AFTER_DRAIN = false;
    bf16_t* O; int ldc; const float* ss;
    __device__ __forceinline__ void operator()(const f32x4 (&acc)[2][2][4][2], const Unit& u, int wr, int wc, int fr, int fq) const {
        const int row0 = u.pm * BM + wr * 64 + fr, col0 = u.pn * BM + wc * 32 + 8 * fq;
        float rsv[2][4];
#pragma unroll
        for (int ai = 0; ai < 2; ++ai)
#pragma unroll
            for (int m = 0; m < 4; ++m) rsv[ai][m] = ss[row0 + ai * HALF + m * 16];
#pragma unroll
        for (int ai = 0; ai < 2; ++ai)
#pragma unroll
            for (int m = 0; m < 4; ++m) { const int row = row0 + ai * HALF + m * 16; const float rs = __builtin_amdgcn_rsqf(rsv[ai][m] * (1.0f / DM_) + RMS_EPS_); bf16_t* rowp = O + (size_t)row * ldc + col0;
#pragma unroll
                for (int bj = 0; bj < 2; ++bj) { const f32x4 v0 = acc[ai][bj][m][0] * rs, v1 = acc[ai][bj][m][1] * rs;
                    u32x4 w; w.x = cvt_pk_bf16(v0[0], v0[1]); w.y = cvt_pk_bf16(v0[2], v0[3]); w.z = cvt_pk_bf16(v1[0], v1[1]); w.w = cvt_pk_bf16(v1[2], v1[3]);
                    *(u32x4*)(rowp + bj * HALF) = w; } }
    }
};
struct EpiResid {
    static constexpr bool PERM = false, AFTER_DRAIN = false;
    const float* base; float* xout; bf16_t* xb; float* ss_out;
    __device__ __forceinline__ void operator()(const f32x4 (&acc)[2][2][4][2], const Unit& u, int wr, int wc, int fr, int fq) const {
        typedef unsigned u32x2v __attribute__((ext_vector_type(2)));
        const int row0 = u.pm * BM + wr * 64 + fr, col0 = u.pn * BM + wc * 32 + 4 * fq;
#pragma unroll
        for (int ai = 0; ai < 2; ++ai)
#pragma unroll
            for (int m = 0; m < 4; ++m) { const int row = row0 + ai * HALF + m * 16; const size_t off = (size_t)row * DM_ + col0; float sq = 0.f;
#pragma unroll
                for (int bj = 0; bj < 2; ++bj)
#pragma unroll
                    for (int n = 0; n < 2; ++n) { const size_t o = off + bj * HALF + n * 16; const f32x4 x = *(const f32x4*)(base + o) + acc[ai][bj][m][n];
                        *(f32x4*)(xout + o) = x; u32x2v w; w.x = cvt_pk_bf16(x[0], x[1]); w.y = cvt_pk_bf16(x[2], x[3]); *(u32x2v*)(xb + o) = w;
                        sq += (x[0] * x[0] + x[1] * x[1]) + (x[2] * x[2] + x[3] * x[3]); }
                sq += __shfl_xor(sq, 16); sq += __shfl_xor(sq, 32);
                if (fq == 0) atomicAdd(ss_out + row, sq); }
    }
};
struct EpiGateUpTmp {
    static constexpr bool PERM = true, AFTER_DRAIN = false;
    bf16_t* U; bf16_t* UP; const float* ss; int ff;
    __device__ __forceinline__ void operator()(const f32x4 (&acc)[2][2][4][2], const Unit& u, int wr, int wc, int fr, int fq) const {
        const int row0 = u.pm * BM + wr * 64 + fr, col0 = u.pn * HALF + wc * 32 + 8 * fq;
        float rsv[2][4];
#pragma unroll
        for (int ai = 0; ai < 2; ++ai)
#pragma unroll
            for (int m = 0; m < 4; ++m) rsv[ai][m] = ss[row0 + ai * HALF + m * 16];
#pragma unroll
        for (int ai = 0; ai < 2; ++ai)
#pragma unroll
            for (int m = 0; m < 4; ++m) { const int row = row0 + ai * HALF + m * 16; const float rs = __builtin_amdgcn_rsqf(rsv[ai][m] * (1.0f / DM_) + RMS_EPS_); const size_t o = (size_t)row * ff + col0;
#pragma unroll
                for (int bj = 0; bj < 2; ++bj) { const f32x4 v0 = acc[ai][bj][m][0] * rs, v1 = acc[ai][bj][m][1] * rs;
                    u32x4 w; w.x = cvt_pk_bf16(v0[0], v0[1]); w.y = cvt_pk_bf16(v0[2], v0[3]); w.z = cvt_pk_bf16(v1[0], v1[1]); w.w = cvt_pk_bf16(v1[2], v1[3]);
                    *(u32x4*)((bj == 0 ? U : UP) + o) = w; } }
    }
};
}

#define LAS __attribute__((address_space(3)))
__device__ __forceinline__ void transpose_item(const float* __restrict__ W, int K, int N, bf16_t* __restrict__ Wt, const float* __restrict__ g, int mode, float* scr, int item, int lane) {
    const int nblk = N / 32, kb = item / nblk, nb = item % nblk, k0 = 64 * kb, n0 = 32 * nb;
    int np0 = n0; if (mode == 1) np0 = 256 * (n0 / 128) + (n0 % 128); else if (mode == 2) np0 = 256 * (n0 / 128) + 128 + (n0 % 128);
#pragma unroll 8
    for (int i = 0; i < 32; ++i) { const int kk = 2 * i + (lane >> 5); scr[kk * 33 + (lane & 31)] = W[(size_t)(k0 + kk) * N + n0 + (lane & 31)] * (g ? g[k0 + kk] : 1.f); }
    __builtin_amdgcn_fence(__ATOMIC_RELEASE, "wavefront"); __builtin_amdgcn_wave_barrier(); __builtin_amdgcn_fence(__ATOMIC_ACQUIRE, "wavefront");
    const int c = lane & 7;
#pragma unroll
    for (int j = 0; j < 4; ++j) { const int n = (lane >> 3) + 8 * j; const float* sp = scr + (8 * c) * 33 + n;
        uint4 o; o.x = f2bf(sp[0]) | (f2bf(sp[33]) << 16); o.y = f2bf(sp[2 * 33]) | (f2bf(sp[3 * 33]) << 16); o.z = f2bf(sp[4 * 33]) | (f2bf(sp[5 * 33]) << 16); o.w = f2bf(sp[6 * 33]) | (f2bf(sp[7 * 33]) << 16);
        *(uint4*)(Wt + (size_t)(np0 + n) * K + k0 + 8 * c) = o; }
    __builtin_amdgcn_fence(__ATOMIC_RELEASE, "wavefront"); __builtin_amdgcn_wave_barrier(); __builtin_amdgcn_fence(__ATOMIC_ACQUIRE, "wavefront");
}
__device__ __forceinline__ void x_row_to_bf16(const float* __restrict__ x, bf16_t* __restrict__ xb, float* __restrict__ ss, int row, int lane) {
    const f32x4* xr = (const f32x4*)(x + (size_t)row * D) + lane; float s = 0.f;
#pragma unroll
    for (int j = 0; j < 4; ++j) { const f32x4 v = xr[64 * j]; s += v.x * v.x + v.y * v.y + v.z * v.z + v.w * v.w;
        unsigned long long o = (unsigned long long)(f2bf(v.x) | (f2bf(v.y) << 16)) | ((unsigned long long)(f2bf(v.z) | (f2bf(v.w) << 16)) << 32);
        ((unsigned long long*)(xb + (size_t)row * D))[lane + 64 * j] = o; }
    s = wave_sum(s); if (lane == 0) ss[row] = s;
}

struct EpArgs {
    const float* ss; float* ss_out; const float* base; float* xout; bf16_t* ob; bf16_t* ob2; int ldo; int row_off;
};
template <int MODE>
__device__ __forceinline__ void gemm_simple(const bf16_t* __restrict__ A, int lda, const bf16_t* __restrict__ Bt, int ldb, int Mrows, int N, int K, EpArgs e, int tid) {
    const int wid = tid >> 6, lane = tid & 63, fr = lane & 15, fq = lane >> 4;
    const int ntn = N / 128, ntiles = (Mrows / 64) * ntn;
    for (int tile = blockIdx.x; tile < ntiles; tile += gridDim.x) {
    const int row0 = (tile / ntn) * 64 + (wid >> 2) * 32, col0 = (tile % ntn) * 128 + (wid & 3) * 32;
    f32x4 acc[2][2];
#pragma unroll
    for (int i = 0; i < 2; ++i)
#pragma unroll
        for (int j = 0; j < 2; ++j) acc[i][j] = (f32x4){0.f, 0.f, 0.f, 0.f};
    const bf16_t* ap = A + (size_t)(row0 + fr) * lda + fq * 8;
    const bf16_t* bp = Bt + (size_t)(col0 + fr) * ldb + fq * 8;
    for (int k0 = 0; k0 < K; k0 += 32) {
        bf16x8 a[2], b[2];
#pragma unroll
        for (int i = 0; i < 2; ++i) { a[i] = *(const bf16x8*)(ap + (size_t)i * 16 * lda + k0); b[i] = *(const bf16x8*)(bp + (size_t)i * 16 * ldb + k0); }
#pragma unroll
        for (int i = 0; i < 2; ++i)
#pragma unroll
            for (int j = 0; j < 2; ++j) acc[i][j] = __builtin_amdgcn_mfma_f32_16x16x32_bf16(a[i], b[j], acc[i][j], 0, 0, 0);
    }
#pragma unroll
    for (int i = 0; i < 2; ++i)
#pragma unroll
        for (int r = 0; r < 4; ++r) {
            const int row = row0 + i * 16 + fq * 4 + r;
            float rstd = 1.f;
            if (MODE == 0 || MODE == 2) rstd = rsqrtf(e.ss[row] * (1.f / D) + RMS_EPS);
            float sq = 0.f;
#pragma unroll
            for (int j = 0; j < 2; ++j) {
                const int col = col0 + j * 16 + fr; const float v = acc[i][j][r];
                if (MODE == 0) e.ob[(size_t)row * e.ldo + col] = (bf16_t)f2bf(v * rstd);
                else if (MODE == 1) { const size_t o = (size_t)row * D + col; const float x = e.base[o] + v; e.xout[o] = x; e.ob[o] = (bf16_t)f2bf(x); sq += x * x; }
                else { const int p = col >> 8, jj = col & 255; const size_t o = (size_t)(row - e.row_off) * FF + 128 * p + (jj & 127);
                    if (jj < 128) e.ob[o] = (bf16_t)f2bf(v * rstd); else e.ob2[o] = (bf16_t)f2bf(v * rstd); }
            }
            if (MODE == 1) {
                sq += __shfl_xor(sq, 1); sq += __shfl_xor(sq, 2); sq += __shfl_xor(sq, 4); sq += __shfl_xor(sq, 8);
                if (fr == 0) atomicAdd(e.ss_out + row, sq);
            }
        }
    }
}

struct PrepArgs {
    const bf16_t* proj; const float* mu; const float* w0; const float* w2; const float* a0; const float* a2; const float* g2;
    const float* v0; const float* v1; const float* v2; bf16_t* vfirst; int layer; int pad;
    bf16_t *R, *K, *V, *A, *LD, *G;
};
__device__ __forceinline__ void prep_group(const PrepArgs& p, float (*rest)[SHIFT_W], float (*vlo)[32], int grp, int tid) {
    const int m0 = grp * 4;
    for (int i = tid; i < 4 * SHIFT_W; i += 512) {
        const int tk = i / SHIFT_W, c = i % SHIFT_W, m = m0 + tk, t = m % SEQ;
        const float u = bf2f(p.proj[(size_t)m * IN_W + ATT_IN + c]);
        const float up = t > 0 ? bf2f(p.proj[(size_t)(m - 1) * IN_W + ATT_IN + c]) : 0.f;
        float v = u + (up - u) * p.mu[c];
        if (c >= 1536 && c < 1600) v = tanhf(v); else if (c >= 1664) v = sigmoidf_(v);
        rest[tk][c] = v;
    }
    __syncthreads();
    if (p.layer > 0 && tid < 128) { const int tk = tid >> 5, j = tid & 31; float s = 0.f; for (int c = 0; c < C; ++c) s += rest[tk][1024 + c] * p.v1[c * 32 + j]; vlo[tk][j] = s; }
    __syncthreads();
    const int c = tid;
    float wp[4], ap[4], gp[4];
#pragma unroll
    for (int tk = 0; tk < 4; ++tk) { wp[tk] = p.w0[c]; ap[tk] = p.a0[c]; gp[tk] = 0.f; }
    for (int k = 0; k < 64; ++k) { const float w = p.w2[k * C + c], a = p.a2[k * C + c];
#pragma unroll
        for (int tk = 0; tk < 4; ++tk) { wp[tk] += rest[tk][1536 + k] * w; ap[tk] += rest[tk][1600 + k] * a; } }
    for (int k = 0; k < 128; ++k) { const float g = p.g2[k * C + c];
#pragma unroll
        for (int tk = 0; tk < 4; ++tk) gp[tk] += rest[tk][1664 + k] * g; }
#pragma unroll
    for (int tk = 0; tk < 4; ++tk) {
        const size_t o = (size_t)(m0 + tk) * C + c;
        const float x = -wp[tk];
        const float sp = fmaxf(x, 0.f) + log1pf(__expf(-fabsf(x)));
        const float wraw = -sp - 0.5f;
        const float ld = -__expf(wraw);
        const float a = sigmoidf_(ap[tk]);
        float v = rest[tk][1024 + c];
        if (p.layer == 0) p.vfirst[o] = (bf16_t)f2bf(v);
        else { float s = p.v0[c]; for (int j = 0; j < 32; ++j) s += vlo[tk][j] * p.v2[j * C + c]; const float vf = bf2f(p.vfirst[o]); v = v + (vf - v) * sigmoidf_(s); }
        p.R[o] = (bf16_t)f2bf(rest[tk][c]); p.K[o] = (bf16_t)f2bf(rest[tk][512 + c]); p.V[o] = (bf16_t)f2bf(v);
        p.A[o] = (bf16_t)f2bf(a); p.LD[o] = (bf16_t)f2bf(ld); p.G[o] = (bf16_t)f2bf(gp[tk]);
    }
    __syncthreads();
}

constexpr int SC_TB = 32, SC_SLOT = 384, SC_NCH = SEQ / SC_TB;
constexpr int WS_RKC = 1 * (1 << 20);
struct ScanArgs { const bf16_t *R, *K, *V, *A, *LD, *G; const float *k_k, *k_a, *r_k, *lnx_g, *lnx_b; bf16_t* mix; float* rkc; };
template <int CTRL> __device__ __forceinline__ float dpp_mov(float x) { return __builtin_bit_cast(float, __builtin_amdgcn_update_dpp(0, __builtin_bit_cast(int, x), CTRL, 0xF, 0xF, true)); }
__device__ __forceinline__ float reduce16(float x) { x += dpp_mov<0xB1>(x); x += dpp_mov<0x4E>(x); x += dpp_mov<0x141>(x); x += dpp_mov<0x140>(x); return x; }
struct ScLdSet { bf16_t r[8], k[8], v[8], a[8], ld[8]; };
__device__ __forceinline__ void scan_item(const ScanArgs& p, float* lds, int item, int tid) {
    const int chain = item >> 2, q = item & 3, b = chain >> 3, h = chain & 7, wave = __builtin_amdgcn_readfirstlane(tid >> 6), lane = tid & 63;
    float* buf = lds;
    float* ybuf = lds + 2 * SC_TB * SC_SLOT;
    if (wave >= 4) {
        const int lw = wave - 4, ch = h * 64 + lane, lt = lw * 64 + lane;
        const float kk_c = p.k_k[ch], ka_c = p.k_a[ch], rk_c = p.r_k[ch];
        const size_t rowbase = (size_t)b * SEQ;
        ScLdSet s0, s1;
#define SC_LOAD(S, chunk) do { _Pragma("unroll") for (int i = 0; i < 8; ++i) { const size_t o = (rowbase + (size_t)(chunk) * SC_TB + lw + 4 * i) * C + ch; \
            S.r[i] = p.R[o]; S.k[i] = p.K[o]; S.v[i] = p.V[o]; S.a[i] = p.A[o]; S.ld[i] = p.LD[o]; } } while (0)
#define SC_PROC(S, chunk, bi) do { _Pragma("unroll") for (int i = 0; i < 8; ++i) { const int st = lw + 4 * i; \
            const float r = bf2f(S.r[i]), k = bf2f(S.k[i]), v = bf2f(S.v[i]), a = bf2f(S.a[i]), ld = bf2f(S.ld[i]); \
            float kk = k * kk_c; const float nrm = sqrtf(wave_sum(kk * kk)); kk = kk / fmaxf(nrm, 1e-12f); \
            const float kp = k * (1.f + (a - 1.f) * ka_c); const float rkc = wave_sum(r * kp * rk_c); \
            float* slot = buf + ((bi) * SC_TB + st) * SC_SLOT + lane; \
            slot[0] = __expf(ld); slot[64] = -kk; slot[128] = kk * a; slot[192] = kp; slot[256] = r; slot[320] = v; \
            if (q == 0 && lane == 0) p.rkc[(rowbase + (size_t)(chunk) * SC_TB + st) * 8 + h] = rkc; } } while (0)
#define SC_YOUT(chunk, bi) do { _Pragma("unroll") for (int e2 = 0; e2 < 2; ++e2) { const int e = lt + 256 * e2, st = e >> 4, rr = e & 15; \
            p.mix[(rowbase + (size_t)(chunk) * SC_TB + st) * D + ATT_W + h * 64 + 16 * q + rr] = (bf16_t)f2bf(ybuf[(bi) * SC_TB * 16 + e]); } } while (0)
        SC_LOAD(s0, 0); SC_LOAD(s1, 1); SC_PROC(s0, 0, 0);
        __syncthreads();
        for (int c = 0; c < SC_NCH; c += 2) {
            if (c + 2 < SC_NCH) SC_LOAD(s0, c + 2);
            SC_PROC(s1, c + 1, 1);
            if (c >= 1) SC_YOUT(c - 1, 1);
            __syncthreads();
            if (c + 3 < SC_NCH) SC_LOAD(s1, c + 3);
            if (c + 2 < SC_NCH) SC_PROC(s0, c + 2, 0);
            SC_YOUT(c, 0);
            __syncthreads();
        }
        SC_YOUT(SC_NCH - 1, 1);
#undef SC_LOAD
#undef SC_PROC
#undef SC_YOUT
    } else {
        const int cg4 = (lane & 15) * 4, rloc = 4 * wave + (lane >> 4);
        float S0 = 0.f, S1 = 0.f, S2 = 0.f, S3 = 0.f;
#define SC_SCAN(bi) do { const float* bp = buf + (bi) * SC_TB * SC_SLOT + cg4; const float* vp = buf + (bi) * SC_TB * SC_SLOT + 320 + 16 * q + rloc; float* yp = ((lane & 15) == 0) ? (ybuf + (bi) * SC_TB * 16 + rloc) : (ybuf + 2 * SC_TB * 16 + lane);     \
            _Pragma("unroll") for (int st = 0; st < SC_TB; ++st) { \
                const f32x4 w = *(const f32x4*)(bp + st * SC_SLOT), A = *(const f32x4*)(bp + st * SC_SLOT + 64), B = *(const f32x4*)(bp + st * SC_SLOT + 128), kp = *(const f32x4*)(bp + st * SC_SLOT + 192), r = *(const f32x4*)(bp + st * SC_SLOT + 256); \
                const float v = vp[st * SC_SLOT]; \
                float sa = (S0 * A.x + S1 * A.y) + (S2 * A.z + S3 * A.w); sa = reduce16(sa); \
                S0 = S0 * w.x + (sa * B.x + v * kp.x); S1 = S1 * w.y + (sa * B.y + v * kp.y); S2 = S2 * w.z + (sa * B.z + v * kp.z); S3 = S3 * w.w + (sa * B.w + v * kp.w); \
                float y = (S0 * r.x + S1 * r.y) + (S2 * r.z + S3 * r.w); y = reduce16(y); \
                yp[st * 16] = y; } } while (0)
        __syncthreads();
        for (int c = 0; c < SC_NCH; c += 2) { SC_SCAN(0); __syncthreads(); SC_SCAN(1); __syncthreads(); }
#undef SC_SCAN
    }
    __syncthreads();
}
__device__ __forceinline__ void scan_post(const ScanArgs& p, int idx, int lane) {
    const int m = idx >> 3, h = idx & 7, ch = h * 64 + lane; const size_t o = (size_t)m * C + ch, om = (size_t)m * D + ATT_W + ch;
    const float y = bf2f(p.mix[om]);
    const float mean = wave_sum(y) * (1.f / 64.f); const float d = y - mean; const float var = wave_sum(d * d) * (1.f / 64.f);
    const float yn = d * rsqrtf(var + LNX_EPS) * p.lnx_g[ch] + p.lnx_b[ch];
    p.mix[om] = (bf16_t)f2bf((yn + p.rkc[(size_t)m * 8 + h] * bf2f(p.V[o])) * bf2f(p.G[o]));
}

__device__ __forceinline__ void attn_item(const bf16_t* __restrict__ proj, const float* __restrict__ sinks, bf16_t* __restrict__ mix, int h, int m, int half) {
    const int t = m % SEQ, kvh = h >> 2;
    float q[64], o[32];
    const bf16_t* qp = proj + (size_t)m * IN_W + h * 64;
#pragma unroll
    for (int d8 = 0; d8 < 8; ++d8) { const bf16x8 qv = *(const bf16x8*)(qp + d8 * 8);
#pragma unroll
        for (int e = 0; e < 8; ++e) q[d8 * 8 + e] = bf2f((bf16_t)qv[e]) * 0.125f; }
#pragma unroll
    for (int d = 0; d < 32; ++d) o[d] = 0.f;
    const float slope = exp2f(-(float)(h + 1));
    float mx = sinks[h], l = 1.f;
    const int s0 = t - (WINDOW - 1) < 0 ? 0 : t - (WINDOW - 1);
#pragma unroll 1
    for (int s = s0; s <= t; ++s) {
        const bf16_t* kp = proj + (size_t)(m - t + s) * IN_W + ATT_W + kvh * 64; const bf16_t* vp = kp + KV_W;
        float sc = 0.f;
#pragma unroll
        for (int d8 = 0; d8 < 8; ++d8) { const bf16x8 kv = *(const bf16x8*)(kp + d8 * 8);
#pragma unroll
            for (int e = 0; e < 8; ++e) sc += q[d8 * 8 + e] * bf2f((bf16_t)kv[e]); }
        sc -= slope * (float)(t - s);
        const float mn = fmaxf(mx, sc), al = __expf(mx - mn), pe = __expf(sc - mn);
        l = l * al + pe; mx = mn;
#pragma unroll
        for (int d8 = 0; d8 < 4; ++d8) { const bf16x8 vv = *(const bf16x8*)(vp + half * 32 + d8 * 8);
#pragma unroll
            for (int e = 0; e < 8; ++e) o[d8 * 8 + e] = o[d8 * 8 + e] * al + pe * bf2f((bf16_t)vv[e]); }
    }
    const float inv = 1.f / l;
    bf16_t* op = mix + (size_t)m * D + h * 64 + half * 32;
#pragma unroll
    for (int d = 0; d < 32; ++d) op[d] = (bf16_t)f2bf(o[d] * inv);
}

__device__ __forceinline__ void conv_item(const bf16_t* __restrict__ U, const bf16_t* __restrict__ UP, const float* __restrict__ cw, const float* __restrict__ cb, bf16_t* __restrict__ hid, size_t i) {
    const int t = (int)(i / FF), j = (int)(i % FF);
    const float u0 = bf2f(U[i]), u1 = t >= 1 ? bf2f(U[i - FF]) : 0.f, u2 = t >= 2 ? bf2f(U[i - 2 * FF]) : 0.f;
    const float c = cb[j] + cw[j] * u2 + cw[FF + j] * u1 + cw[2 * FF + j] * u0;
    hid[i] = (bf16_t)f2bf(c * sigmoidf_(c) * bf2f(UP[i]));
}

__device__ __forceinline__ void final_row(float* __restrict__ x, const float* __restrict__ ss, const float* __restrict__ g, int row, int lane) {
    const float rstd = rsqrtf(ss[row] * (1.f / D) + RMS_EPS);
    f32x4* xr = (f32x4*)(x + (size_t)row * D) + lane; const f32x4* gr = (const f32x4*)g + lane;
#pragma unroll
    for (int j = 0; j < 4; ++j) { f32x4 v = xr[64 * j]; const f32x4 gg = gr[64 * j]; v.x *= rstd * gg.x; v.y *= rstd * gg.y; v.z *= rstd * gg.z; v.w *= rstd * gg.w; xr[64 * j] = v; }
}

constexpr int NTHREADS = 512, LDS_BYTES = 147456;
struct Args { const float* in[26]; float* out; unsigned char* ws; };
__global__ void __launch_bounds__(NTHREADS, 2) mega_fwd(Args a) {
    extern __shared__ __attribute__((aligned(16))) unsigned char lds[];
    cg::grid_group grid = cg::this_grid();
#define GRID_SYNC() grid.sync()
#define LDSP ((PG8_LAS unsigned char*)lds)
#define OTID() ({ int _t = threadIdx.x; asm volatile("" : "+v"(_t)); _t; })
    const int G = gridDim.x, NGW = G * 8;
    const float* x = a.in[0]; const float* norm1_g = a.in[1]; const float* w_in = a.in[2]; const float* sinks = a.in[3];
    const float* mu = a.in[4]; const float* w0 = a.in[5]; const float* w2 = a.in[6]; const float* a0 = a.in[7];
    const float* a2 = a.in[8]; const float* g2 = a.in[9]; const float* k_k = a.in[10]; const float* k_a = a.in[11];
    const float* r_k = a.in[12]; const float* lnx_g = a.in[13]; const float* lnx_b = a.in[14]; const float* v0 = a.in[15];
    const float* v1 = a.in[16]; const float* v2 = a.in[17]; const float* w_out = a.in[18]; const float* norm2_g = a.in[19];
    const float* wg = a.in[20]; const float* wu = a.in[21]; const float* conv_w = a.in[22]; const float* conv_b = a.in[23];
    const float* wd = a.in[24]; const float* final_g = a.in[25];
    unsigned char* ws = a.ws; float* X = a.out;
    float* ss = (float*)(ws + WS_SS);
    bf16_t* XB = (bf16_t*)(ws + WS_XB); bf16_t* PROJ = (bf16_t*)(ws + WS_PROJ); bf16_t* MIX = (bf16_t*)(ws + WS_MIX); bf16_t* HID = (bf16_t*)(ws + WS_HID); bf16_t* VF = (bf16_t*)(ws + WS_VFIRST);
    bf16_t* UT = (bf16_t*)(ws + WS_UTMP); bf16_t* UPT = UT + (size_t)SEQ * FF;

    {
        const int tid = OTID(), lane = tid & 63, wave = tid >> 6, gw = blockIdx.x * 8 + wave;
        float* scr = (float*)lds + wave * (64 * 33 + 16);
        constexpr int I_IN = (D / 64) * (IN_W / 32), I_OUT = (D / 64) * (D / 32), I_G = (D / 64) * (FF / 32), I_DN = (FF / 64) * (D / 32), I_LAYER = I_IN + I_OUT + 2 * I_G + I_DN;
        for (int it = gw; it < 2 * I_LAYER; it += NGW) {
            const int l = it / I_LAYER; int r = it % I_LAYER;
            bf16_t* wl = (bf16_t*)(ws + WS_W + l * W_LAYER); bf16_t* WinT = wl; bf16_t* WoutT = (bf16_t*)((char*)wl + W_IN_SZ); bf16_t* WguT = (bf16_t*)((char*)WoutT + W_OUT_SZ); bf16_t* WdT = (bf16_t*)((char*)WguT + W_GU_SZ);
            if (r < I_IN) { transpose_item(w_in + (size_t)l * D * IN_W, D, IN_W, WinT, norm1_g + l * D, 0, scr, r, lane); continue; } r -= I_IN;
            if (r < I_OUT) { transpose_item(w_out + (size_t)l * D * D, D, D, WoutT, nullptr, 0, scr, r, lane); continue; } r -= I_OUT;
            if (r < I_G) { transpose_item(wg + (size_t)l * D * FF, D, FF, WguT, norm2_g + l * D, 1, scr, r, lane); continue; } r -= I_G;
            if (r < I_G) { transpose_item(wu + (size_t)l * D * FF, D, FF, WguT, norm2_g + l * D, 2, scr, r, lane); continue; } r -= I_G;
            transpose_item(wd + (size_t)l * FF * D, FF, D, WdT, nullptr, 0, scr, r, lane);
        }
        for (int m = gw; m < M; m += NGW) x_row_to_bf16(x, XB, ss, m, lane);
    }
    GRID_SYNC();
    for (int l = 0; l < 2; ++l) {
        bf16_t* wl = (bf16_t*)(ws + WS_W + l * W_LAYER); bf16_t* WinT = wl; bf16_t* WoutT = (bf16_t*)((char*)wl + W_IN_SZ); bf16_t* WguT = (bf16_t*)((char*)WoutT + W_OUT_SZ); bf16_t* WdT = (bf16_t*)((char*)WguT + W_GU_SZ);
        float* ss1 = ss + (size_t)(2 * l) * M; float* ss2 = ss + (size_t)(2 * l + 1) * M; float* ss3 = ss + (size_t)(2 * l + 2) * M;
        { pg8::Gemm g{XB, WinT, M, IN_W, D}; pg8::StaticOrder S; S.init(M, IN_W, G, (int)blockIdx.x); pg8::EpiScaleBf16 E{PROJ, IN_W, ss1};
          pg8::gemm_phase<pg8::EpiScaleBf16, pg8::StaticOrder, true, true>(LDSP, g, S, E); }
        GRID_SYNC();
        { const int tid = OTID();
        for (int i = blockIdx.x * NTHREADS + tid; i < M * NH * 2; i += G * NTHREADS) attn_item(PROJ, sinks + l * NH, MIX, (i / M) >> 1, i % M, (i / M) & 1); }
        PrepArgs p{}; p.proj = PROJ; p.mu = mu + l * SHIFT_W; p.w0 = w0 + l * C; p.w2 = w2 + (size_t)l * 64 * C; p.a0 = a0 + l * C; p.a2 = a2 + (size_t)l * 64 * C; p.g2 = g2 + (size_t)l * 128 * C;
        p.v0 = v0; p.v1 = v1; p.v2 = v2; p.vfirst = VF; p.layer = l;
        p.R = (bf16_t*)(ws + WS_SI_R); p.K = (bf16_t*)(ws + WS_SI_K); p.V = (bf16_t*)(ws + WS_SI_V); p.A = (bf16_t*)(ws + WS_SI_A); p.LD = (bf16_t*)(ws + WS_SI_LD); p.G = (bf16_t*)(ws + WS_SI_G);
        for (int grp = blockIdx.x; grp < M / 4; grp += G) prep_group(p, (float (*)[SHIFT_W])lds, (float (*)[32])(lds + 4 * SHIFT_W * 4), grp, OTID());
        GRID_SYNC();
        { ScanArgs s{}; s.R = p.R; s.K = p.K; s.V = p.V; s.A = p.A; s.LD = p.LD; s.G = p.G; s.k_k = k_k + l * C; s.k_a = k_a + l * C; s.r_k = r_k + l * C; s.lnx_g = lnx_g + l * C; s.lnx_b = lnx_b + l * C; s.mix = MIX; s.rkc = (float*)(ws + WS_RKC);
          for (int item = (int)((blockIdx.x & 7) * (G >> 3) + (blockIdx.x >> 3)); item < BATCH * NH * 4; item += G) scan_item(s, (float*)lds, item, OTID());
          GRID_SYNC();
          { const int tid = OTID(), lane = tid & 63, gw = blockIdx.x * 8 + (tid >> 6); for (int idx = gw; idx < M * NH; idx += NGW) scan_post(s, idx, lane); } }
        GRID_SYNC();
        { pg8::Gemm g{MIX, WoutT, M, D, D}; pg8::StaticOrder S; S.init(M, D, G, (int)blockIdx.x); pg8::EpiResid E{(l == 0) ? x : X, X, XB, ss2};
          pg8::gemm_phase<pg8::EpiResid, pg8::StaticOrder, true, true>(LDSP, g, S, E); }
        GRID_SYNC();
        for (int b = 0; b < BATCH; ++b) {
            { pg8::Gemm g{XB + (size_t)b * SEQ * D, WguT, SEQ, 2 * FF, D}; pg8::StaticOrder S; S.init(SEQ, 2 * FF, G, (int)blockIdx.x); pg8::EpiGateUpTmp E{UT, UPT, ss2 + (size_t)b * SEQ, FF};
              pg8::gemm_phase<pg8::EpiGateUpTmp, pg8::StaticOrder, true, true>(LDSP, g, S, E); }
            GRID_SYNC();
            { const int tid = OTID();
            for (size_t i = (size_t)blockIdx.x * NTHREADS + tid; i < (size_t)SEQ * FF; i += (size_t)G * NTHREADS) conv_item(UT, UPT, conv_w + (size_t)l * 3 * FF, conv_b + (size_t)l * FF, HID + (size_t)b * SEQ * FF, i); }
            GRID_SYNC();
        }
        { pg8::Gemm g{HID, WdT, M, D, FF}; pg8::StaticOrder S; S.init(M, D, G, (int)blockIdx.x); pg8::EpiResid E{X, X, XB, ss3};
          pg8::gemm_phase<pg8::EpiResid, pg8::StaticOrder, true, true>(LDSP, g, S, E); }
        GRID_SYNC();
    }
    { const int tid = OTID(), lane = tid & 63, gw = blockIdx.x * 8 + (tid >> 6);
    for (int m = gw; m < M; m += NGW) final_row(X, ss + (size_t)4 * M, final_g, m, lane); }
}

extern "C" void kernel_launch(void* const* d_in, const int* in_sizes, int n_in, void* d_out, int out_size, void* d_ws, size_t ws_size, hipStream_t stream) {
    static int grid = 0;
    if (grid == 0) {
        if (n_in != 26 || in_sizes[0] != M * D || out_size != M * D || ws_size < WS_END) { fprintf(stderr, "kernel_launch: unexpected shapes (n_in %d, ws %zu)\n", n_in, ws_size); grid = -1; return; }
        int dev = 0, cus = 0, per_cu = 0;
        if (hipGetDevice(&dev) != hipSuccess || hipDeviceGetAttribute(&cus, hipDeviceAttributeMultiprocessorCount, dev) != hipSuccess) { grid = -1; return; }
        if (hipFuncSetAttribute((const void*)mega_fwd, hipFuncAttributeMaxDynamicSharedMemorySize, LDS_BYTES) != hipSuccess) { fprintf(stderr, "kernel_launch: hipFuncSetAttribute failed\n"); grid = -1; return; }
        if (hipOccupancyMaxActiveBlocksPerMultiprocessor(&per_cu, (const void*)mega_fwd, NTHREADS, LDS_BYTES) != hipSuccess || per_cu < 1) { fprintf(stderr, "kernel_launch: occupancy query failed (%d)\n", per_cu); grid = -1; return; }
        grid = cus;
    }
    if (grid < 0) return;
    (void)hipMemsetAsync((unsigned char*)d_ws + WS_CTL, 0, CTL_BYTES, stream);
    Args a{};
    for (int i = 0; i < 26; ++i) a.in[i] = (const float*)d_in[i];
    a.out = (float*)d_out; a.ws = (unsigned char*)d_ws;
    void* kargs[] = {&a};
    hipError_t e = hipLaunchCooperativeKernel((const void*)mega_fwd, dim3(grid), dim3(NTHREADS), kargs, LDS_BYTES, stream);
    if (e != hipSuccess) fprintf(stderr, "kernel_launch: cooperative launch failed: %s (grid %d)\n", hipGetErrorString(e), grid);
}
```

```cpp
#include <hip/hip_runtime.h>
#include <hip/hip_cooperative_groups.h>
namespace cg = cooperative_groups;
#include <cstdio>
#include <cstdint>

typedef unsigned short bf16_t;
typedef short bf16x8 __attribute__((ext_vector_type(8)));
typedef float f32x4 __attribute__((ext_vector_type(4)));

constexpr int BATCH = 8, SEQ = 4096, D = 1024, M = BATCH * SEQ;
constexpr int HD = 64, ATT_W = 512, KV_W = 128, C = 512, NH = 8;
constexpr int ATT_IN = 768, SHIFT_W = 1792, IN_W = 2560, FF = 2816;
constexpr int WINDOW = 128;
constexpr float RMS_EPS = 1e-5f, LNX_EPS = 64e-5f;

constexpr size_t MiB = 1u << 20;
constexpr size_t WS_CTL = 0;
constexpr size_t WS_SS = 0;
constexpr size_t CTL_BYTES = 1 * MiB;
constexpr size_t WS_W = 2 * MiB;
constexpr size_t W_IN_SZ = (size_t)IN_W * D * 2, W_OUT_SZ = (size_t)D * D * 2, W_GU_SZ = (size_t)2 * FF * D * 2, W_DN_SZ = (size_t)D * FF * 2;
constexpr size_t W_LAYER = W_IN_SZ + W_OUT_SZ + W_GU_SZ + W_DN_SZ;
constexpr size_t WS_VFIRST = 52 * MiB, WS_MIX = 84 * MiB, WS_XB = 148 * MiB, WS_PROJ = 212 * MiB;
constexpr size_t WS_SI_R = 148 * MiB, WS_SI_K = 180 * MiB, WS_SI_V = 372 * MiB, WS_SI_A = 404 * MiB, WS_SI_LD = 436 * MiB, WS_SI_G = 468 * MiB;
constexpr size_t WS_HID = 212 * MiB;
constexpr size_t WS_UTMP = 84 * MiB;
constexpr size_t WS_END = 500 * MiB;
static_assert(WS_W + 2 * W_LAYER <= WS_VFIRST, "weights fit");

__device__ __forceinline__ unsigned f2bf(float f) { unsigned u = __builtin_bit_cast(unsigned, f); return (u + 0x7fffu + ((u >> 16) & 1u)) >> 16; }
__device__ __forceinline__ float bf2f(bf16_t h) { return __builtin_bit_cast(float, (unsigned)h << 16); }
__device__ __forceinline__ float wave_sum(float v) {
#pragma unroll
    for (int o = 1; o < 64; o <<= 1) v += __shfl_xor(v, o);
    return v;
}
__device__ __forceinline__ float sigmoidf_(float x) { return 1.f / (1.f + __expf(-x)); }

namespace pg8 {
#define PG8_LAS __attribute__((address_space(3)))
typedef unsigned short bf16_t;
typedef short bf16x8 __attribute__((ext_vector_type(8)));
typedef float f32x4 __attribute__((ext_vector_type(4)));
typedef unsigned u32x4 __attribute__((ext_vector_type(4)));
constexpr int BM = 256, BK = 64, HALF = 128, HTB = HALF * BK * 2  , STAGE_BYTES = 8 * HTB, NXCD = 8, WGM = 8;

__host__ __device__ __forceinline__ int lds_byte(int r, int c) { const int st = (r >> 4) * 2 + (c >> 5), rr = r & 15, cc = c & 31, ob = rr * 64 + cc * 2; return st * 1024 + (ob ^ (((ob >> 9) & 1) << 5)); }
__host__ __device__ __forceinline__ void stage_rc(int b, int& R, int& C) { const int st = b / 1024, sb = b % 1024, swz = sb ^ (((sb >> 9) & 1) << 5); R = (st >> 1) * 16 + swz / 64; C = (st & 1) * 32 + (swz % 64) / 2; }
__host__ __device__ __forceinline__ int perm32(int rho) { const int n = rho >> 4, i = rho & 15; return 8 * (i >> 2) + 4 * n + (i & 3); }

struct Unit { int pm, pn; };
struct Gemm { const bf16_t* A; const bf16_t* Bt; int M, N, K; };

struct StaticOrder {
    int nM, nN, nwg, G, c;
    __host__ __device__ void init(int M, int N, int G_, int c_) { nM = M / BM; nN = N / BM; nwg = nM * nN; G = G_; c = c_; }
    __host__ __device__ bool next(int i, Unit& u) const {
        const long L = (long)i * G + c; if (L >= nwg) return false;
        int wgid = (int)L; { const int q = nwg / NXCD, r = nwg % NXCD, xcd = wgid % NXCD, off = wgid / NXCD; wgid = (xcd < r ? xcd * (q + 1) : r * (q + 1) + (xcd - r) * q) + off; }
        const int nig = WGM * nN, gid = wgid / nig, fm = gid * WGM, gsz = (nM - fm) < WGM ? (nM - fm) : WGM;
        u.pm = fm + ((wgid % nig) % gsz); u.pn = (wgid % nig) / gsz; return true;
    }
    __device__ __forceinline__ void a_ready(const Unit&) const {}
    __device__ __forceinline__ void done(const Unit&) const {}
};
__device__ __forceinline__ unsigned cvt_pk_bf16(float lo, float hi) { unsigned r; asm volatile("v_cvt_pk_bf16_f32 %0, %1, %2" : "=v"(r) : "v"(lo), "v"(hi)); return r; }
typedef float f32x2 __attribute__((ext_vector_type(2)));
template <class Epi, class Sched, bool ALIGN_EPI = false, bool SP2 = false>
__device__ __forceinline__ void gemm_phase(PG8_LAS unsigned char* lds, const Gemm g, const Sched& S, const Epi& E) {
    int tid_ = threadIdx.x; asm volatile("" : "+v"(tid_));
    const int tid = tid_, wid = __builtin_amdgcn_readfirstlane(tid >> 6), lane = tid & 63, wr = wid >> 2, wc = wid & 3, fr = lane & 15, fq = lane >> 4;
    const int K = g.K, nt = K / BK;
    unsigned voffA[2], voffB[2];
#pragma unroll
    for (int i = 0; i < 2; ++i) { int R, C; stage_rc(tid * 16 + i * 8192, R, C); const int Rb = Epi::PERM ? ((R & ~31) + perm32(R & 31)) : R;
        voffA[i] = (unsigned)(R * K + C) * 2u; voffB[i] = (unsigned)(Rb * K + C) * 2u; }
    const size_t kstep = (size_t)(BK * 2);
    const size_t hstep = (size_t)HALF * K * 2;
    const size_t tstep = 2 * hstep;
    const unsigned ldsw = (unsigned)wid * 1024u;
    const int aoff = lds_byte(wr * 64 + fr, fq * 8), boff = lds_byte(wc * 32 + fr, fq * 8);
#define PG8_SA(b, h) (((b) * 2 + (h)) * HTB)
#define PG8_SB(b, h) ((4 + (b) * 2 + (h)) * HTB)
#define PG8_STAGE(bufoff, gbase, voff) do { _Pragma("unroll") for (int _i = 0; _i < 2; ++_i) \
        __builtin_amdgcn_global_load_lds((const unsigned*)((const char*)(gbase) + (voff)[_i]), (PG8_LAS unsigned*)(lds + (bufoff) + ldsw + _i * 8192), 16, 0, 0); } while (0)
#define PG8_LDA(dst, b, h) do { _Pragma("unroll") for (int m = 0; m < 4; ++m) _Pragma("unroll") for (int k = 0; k < 2; ++k) dst[m][k] = *(const PG8_LAS bf16x8*)(lds + PG8_SA(b, h) + aoff + m * 2048 + k * 1024); } while (0)
#define PG8_LDB(dst, b, h) do { _Pragma("unroll") for (int n = 0; n < 2; ++n) _Pragma("unroll") for (int k = 0; k < 2; ++k) dst[n][k] = *(const PG8_LAS bf16x8*)(lds + PG8_SB(b, h) + boff + n * 2048 + k * 1024); } while (0)
#define PG8_MMA(ai, bj, At, Bt) do { __builtin_amdgcn_s_setprio(1); _Pragma("unroll") for (int m = 0; m < 4; ++m) _Pragma("unroll") for (int n = 0; n < 2; ++n) _Pragma("unroll") for (int k = 0; k < 2; ++k) \
        acc[ai][bj][m][n] = __builtin_amdgcn_mfma_f32_16x16x32_bf16(Bt[n][k], At[m][k], acc[ai][bj][m][n], 0, 0, 0); __builtin_amdgcn_s_setprio(0); } while (0)
#define PG8_WAIT_V(n) asm volatile("s_waitcnt vmcnt(" #n ")" ::: "memory")
#define PG8_WAIT_L(n) asm volatile("s_waitcnt lgkmcnt(" #n ")" ::: "memory")
#define PG8_BAR __builtin_amdgcn_s_barrier()
#define PG8_SCHED __builtin_amdgcn_sched_barrier(0)
    Unit cur, nxt; int ui = 0;
    if (!S.next(0, cur)) return;
    f32x4 acc[2][2][4][2];
#pragma unroll
    for (int a = 0; a < 2; ++a)
#pragma unroll
        for (int b = 0; b < 2; ++b)
#pragma unroll
            for (int m = 0; m < 4; ++m)
#pragma unroll
                for (int n = 0; n < 2; ++n) acc[a][b][m][n] = (f32x4){0.f, 0.f, 0.f, 0.f};
    bf16x8 At[4][2], B0[2][2], B1[2][2];
    const char* cA = (const char*)g.A + (size_t)cur.pm * tstep; const char* cB = (const char*)g.Bt + (size_t)cur.pn * tstep;
    S.a_ready(cur);
    if constexpr (SP2) {
        PG8_STAGE(PG8_SB(0, 0), cB, voffB); PG8_STAGE(PG8_SB(0, 1), cB + hstep, voffB); PG8_STAGE(PG8_SA(0, 0), cA, voffA); PG8_STAGE(PG8_SA(0, 1), cA + hstep, voffA);
        if (wr == 1) PG8_BAR;
        PG8_WAIT_V(2); PG8_BAR;
        PG8_STAGE(PG8_SB(1, 0), cB + kstep, voffB); PG8_STAGE(PG8_SA(1, 0), cA + kstep, voffA); PG8_STAGE(PG8_SB(1, 1), cB + hstep + kstep, voffB);
        PG8_WAIT_V(6); PG8_BAR;
    } else {
        PG8_STAGE(PG8_SB(0, 0), cB, voffB); PG8_STAGE(PG8_SA(0, 0), cA, voffA); PG8_STAGE(PG8_SB(0, 1), cB + hstep, voffB); PG8_STAGE(PG8_SA(0, 1), cA + hstep, voffA);
        if (wr == 1) PG8_BAR;
        PG8_WAIT_V(4); PG8_BAR;
        PG8_STAGE(PG8_SB(1, 0), cB + kstep, voffB); PG8_STAGE(PG8_SA(1, 0), cA + kstep, voffA); PG8_STAGE(PG8_SB(1, 1), cB + hstep + kstep, voffB);
        PG8_WAIT_V(6); PG8_BAR;
    }
    for (;;) {
        const bool has_next = S.next(ui + 1, nxt);
        const char* nA = has_next ? (const char*)g.A + (size_t)nxt.pm * tstep : cA; const char* nB = has_next ? (const char*)g.Bt + (size_t)nxt.pn * tstep : cB;
        for (int t = 0; t < nt; t += 2) {
            const bool last = (t == nt - 2);
            const char* a1 = cA + (size_t)(t + 1) * kstep;
            const char* a2 = last ? nA : cA + (size_t)(t + 2) * kstep; const char* b2 = last ? nB : cB + (size_t)(t + 2) * kstep;
            const char* a3 = a2 + kstep; const char* b3 = b2 + kstep;
            if (last && has_next) S.a_ready(nxt);
            if constexpr (SP2) {
            PG8_LDB(B0, 0, 0); PG8_LDB(B1, 0, 1); PG8_SCHED; PG8_LDA(At, 0, 0); PG8_STAGE(PG8_SA(1, 1), a1 + hstep, voffA);
            PG8_WAIT_V(8); PG8_WAIT_L(0); PG8_BAR; PG8_MMA(0, 0, At, B0); PG8_MMA(0, 1, At, B1); PG8_BAR; PG8_SCHED;
            PG8_LDA(At, 0, 1); PG8_STAGE(PG8_SB(0, 0), b2, voffB); PG8_STAGE(PG8_SB(0, 1), b2 + hstep, voffB); PG8_STAGE(PG8_SA(0, 0), a2, voffA);
            PG8_WAIT_V(8); PG8_WAIT_L(0); PG8_BAR; PG8_MMA(1, 0, At, B0); PG8_MMA(1, 1, At, B1); PG8_BAR; PG8_SCHED;
            PG8_LDB(B0, 1, 0); PG8_LDB(B1, 1, 1); PG8_SCHED; PG8_LDA(At, 1, 0); PG8_STAGE(PG8_SA(0, 1), a2 + hstep, voffA);
            PG8_WAIT_V(8); PG8_WAIT_L(0); PG8_BAR; PG8_MMA(0, 0, At, B0); PG8_MMA(0, 1, At, B1); PG8_BAR; PG8_SCHED;
            PG8_LDA(At, 1, 1); PG8_STAGE(PG8_SB(1, 0), b3, voffB); PG8_STAGE(PG8_SB(1, 1), b3 + hstep, voffB); PG8_STAGE(PG8_SA(1, 0), a3, voffA);
            PG8_WAIT_V(8); PG8_WAIT_L(0); PG8_BAR; PG8_MMA(1, 0, At, B0); PG8_MMA(1, 1, At, B1); PG8_BAR; PG8_SCHED;
            } else {
            PG8_LDB(B0, 0, 0); PG8_SCHED; PG8_LDA(At, 0, 0); PG8_STAGE(PG8_SA(1, 1), a1 + hstep, voffA);
            PG8_WAIT_L(8); PG8_BAR; PG8_WAIT_L(0); PG8_MMA(0, 0, At, B0); PG8_BAR; PG8_SCHED;
            PG8_LDB(B1, 0, 1); PG8_STAGE(PG8_SB(0, 0), b2, voffB);
            PG8_BAR; PG8_WAIT_L(0); PG8_MMA(0, 1, At, B1); PG8_BAR;
            PG8_LDA(At, 0, 1); PG8_STAGE(PG8_SA(0, 0), a2, voffA);
            PG8_BAR; PG8_WAIT_L(0); PG8_MMA(1, 0, At, B0); PG8_BAR; PG8_SCHED;
            PG8_STAGE(PG8_SB(0, 1), b2 + hstep, voffB);
            PG8_WAIT_V(6); PG8_BAR; PG8_MMA(1, 1, At, B1); PG8_BAR;
            PG8_LDB(B0, 1, 0); PG8_SCHED; PG8_LDA(At, 1, 0); PG8_STAGE(PG8_SA(0, 1), a2 + hstep, voffA);
            PG8_WAIT_L(8); PG8_BAR; PG8_WAIT_L(0); PG8_MMA(0, 0, At, B0); PG8_BAR; PG8_SCHED;
            PG8_LDB(B1, 1, 1); PG8_STAGE(PG8_SB(1, 0), b3, voffB);
            PG8_BAR; PG8_WAIT_L(0); PG8_MMA(0, 1, At, B1); PG8_BAR;
            PG8_LDA(At, 1, 1); PG8_STAGE(PG8_SA(1, 0), a3, voffA);
            PG8_BAR; PG8_WAIT_L(0); PG8_MMA(1, 0, At, B0); PG8_BAR; PG8_SCHED;
            PG8_STAGE(PG8_SB(1, 1), b3 + hstep, voffB);
            PG8_WAIT_V(6); PG8_BAR; PG8_MMA(1, 1, At, B1); PG8_BAR;
            }
        }
        if constexpr (ALIGN_EPI) { if (wr == 0) PG8_BAR; }
        if constexpr (!Epi::AFTER_DRAIN) { E(acc, cur, wr, wc, fr, fq); S.done(cur); }
        if (!has_next) break;
#pragma unroll
        for (int a = 0; a < 2; ++a)
#pragma unroll
            for (int b = 0; b < 2; ++b)
#pragma unroll
                for (int m = 0; m < 4; ++m)
#pragma unroll
                    for (int n = 0; n < 2; ++n) acc[a][b][m][n] = (f32x4){0.f, 0.f, 0.f, 0.f};
        cur = nxt; cA = nA; cB = nB; ++ui;
        if constexpr (ALIGN_EPI) { if (wr == 1) PG8_BAR; }
    }
    PG8_WAIT_V(0);
    if constexpr (!ALIGN_EPI) { if (wr == 0) PG8_BAR; }
    PG8_BAR;
    if constexpr (Epi::AFTER_DRAIN) { E.fused(acc, cur, wr, wc, fr, fq, lds, wid, lane); S.done(cur); }
#undef PG8_SA
#undef PG8_SB
#undef PG8_STAGE
#undef PG8_LDA
#undef PG8_LDB
#undef PG8_MMA
#undef PG8_WAIT_V
#undef PG8_WAIT_L
#undef PG8_BAR
#undef PG8_SCHED
}

constexpr int DM_ = 1024; constexpr float RMS_EPS_ = 1e-5f;
__device__ __forceinline__ float rstd_of(const float* ss, int row) { return __builtin_amdgcn_rsqf(ss[row] * (1.0f / DM_) + RMS_EPS_); }
struct EpiScaleBf16 {
    static constexpr bool PERM = true, AFTER_DRAIN = false;
    bf16_t* O; int ldc; const float* ss;
    __device__ __forceinline__ void operator()(const f32x4 (&acc)[2][2][4][2], const Unit& u, int wr, int wc, int fr, int fq) const {
        const int row0 = u.pm * BM + wr * 64 + fr, col0 = u.pn * BM + wc * 32 + 8 * fq;
        float rsv[2][4];
#pragma unroll
        for (int ai = 0; ai < 2; ++ai)
#pragma unroll
            for (int m = 0; m < 4; ++m) rsv[ai][m] = ss[row0 + ai * HALF + m * 16];
#pragma unroll
        for (int ai = 0; ai < 2; ++ai)
#pragma unroll
            for (int m = 0; m < 4; ++m) { const int row = row0 + ai * HALF + m * 16; const float rs = __builtin_amdgcn_rsqf(rsv[ai][m] * (1.0f / DM_) + RMS_EPS_); bf16_t* rowp = O + (size_t)row * ldc + col0;
#pragma unroll
                for (int bj = 0; bj < 2; ++bj) { const f32x4 v0 = acc[ai][bj][m][0] * rs, v1 = acc[ai][bj][m][1] * rs;
                    u32x4 w; w.x = cvt_pk_bf16(v0[0], v0[1]); w.y = cvt_pk_bf16(v0[2], v0[3]); w.z = cvt_pk_bf16(v1[0], v1[1]); w.w = cvt_pk_bf16(v1[2], v1[3]);
                    *(u32x4*)(rowp + bj * HALF) = w; } }
    }
};
struct EpiResid {
    static constexpr bool PERM = false, AFTER_DRAIN = false;
    const float* base; float* xout; bf16_t* xb; float* ss_out;
    __device__ __forceinline__ void operator()(const f32x4 (&acc)[2][2][4][2], const Unit& u, int wr, int wc, int fr, int fq) const {
        typedef unsigned u32x2v __attribute__((ext_vector_type(2)));
        const int row0 = u.pm * BM + wr * 64 + fr, col0 = u.pn * BM + wc * 32 + 4 * fq;
#pragma unroll
        for (int ai = 0; ai < 2; ++ai)
#pragma unroll
            for (int m = 0; m < 4; ++m) { const int row = row0 + ai * HALF + m * 16; const size_t off = (size_t)row * DM_ + col0; float sq = 0.f;
#pragma unroll
                for (int bj = 0; bj < 2; ++bj)
#pragma unroll
                    for (int n = 0; n < 2; ++n) { const size_t o = off + bj * HALF + n * 16; const f32x4 x = *(const f32x4*)(base + o) + acc[ai][bj][m][n];
                        *(f32x4*)(xout + o) = x; u32x2v w; w.x = cvt_pk_bf16(x[0], x[1]); w.y = cvt_pk_bf16(x[2], x[3]); *(u32x2v*)(xb + o) = w;
                        sq += (x[0] * x[0] + x[1] * x[1]) + (x[2] * x[2] + x[3] * x[3]); }
                sq += __shfl_xor(sq, 16); sq += __shfl_xor(sq, 32);
                if (fq == 0) atomicAdd(ss_out + row, sq); }
    }
};
struct EpiGateUpTmp {
    static constexpr bool PERM = true, AFTER_DRAIN = false;
    bf16_t* U; bf16_t* UP; const float* ss; int ff;
    __device__ __forceinline__ void operator()(const f32x4 (&acc)[2][2][4][2], const Unit& u, int wr, int wc, int fr, int fq) const {
        const int row0 = u.pm * BM + wr * 64 + fr, col0 = u.pn * HALF + wc * 32 + 8 * fq;
        float rsv[2][4];
#pragma unroll
        for (int ai = 0; ai < 2; ++ai)
#pragma unroll
            for (int m = 0; m < 4; ++m) rsv[ai][m] = ss[row0 + ai * HALF + m * 16];
#pragma unroll
        for (int ai = 0; ai < 2; ++ai)
#pragma unroll
            for (int m = 0; m < 4; ++m) { const int row = row0 + ai * HALF + m * 16; const float rs = __builtin_amdgcn_rsqf(rsv[ai][m] * (1.0f / DM_) + RMS_EPS_); const size_t o = (size_t)row * ff + col0;
#pragma unroll
                for (int bj = 0; bj < 2; ++bj) { const f32x4 v0 = acc[ai][bj][m][0] * rs, v1 = acc[ai][bj][m][1] * rs;
                    u32x4 w; w.x = cvt_pk_bf16(v0[0], v0[1]); w.y = cvt_pk_bf16(v0[2], v0[3]); w.z = cvt_pk_bf16(v1[0], v1[1]); w.w = cvt_pk_bf16(v1[2], v1[3]);
                    *(u32x4*)((bj == 0 ? U : UP) + o) = w; } }
    }
};
}

#define LAS __attribute__((address_space(3)))
__device__ __forceinline__ void transpose_item(const float* __restrict__ W, int K, int N, bf16_t* __restrict__ Wt, const float* __restrict__ g, int mode, float* scr, int item, int lane) {
    const int nblk = N / 32, kb = item / nblk, nb = item % nblk, k0 = 64 * kb, n0 = 32 * nb;
    int np0 = n0; if (mode == 1) np0 = 256 * (n0 / 128) + (n0 % 128); else if (mode == 2) np0 = 256 * (n0 / 128) + 128 + (n0 % 128);
#pragma unroll 8
    for (int i = 0; i < 32; ++i) { const int kk = 2 * i + (lane >> 5); scr[kk * 33 + (lane & 31)] = W[(size_t)(k0 + kk) * N + n0 + (lane & 31)] * (g ? g[k0 + kk] : 1.f); }
    __builtin_amdgcn_fence(__ATOMIC_RELEASE, "wavefront"); __builtin_amdgcn_wave_barrier(); __builtin_amdgcn_fence(__ATOMIC_ACQUIRE, "wavefront");
    const int c = lane & 7;
#pragma unroll
    for (int j = 0; j < 4; ++j) { const int n = (lane >> 3) + 8 * j; const float* sp = scr + (8 * c) * 33 + n;
        uint4 o; o.x = f2bf(sp[0]) | (f2bf(sp[33]) << 16); o.y = f2bf(sp[2 * 33]) | (f2bf(sp[3 * 33]) << 16); o.z = f2bf(sp[4 * 33]) | (f2bf(sp[5 * 33]) << 16); o.w = f2bf(sp[6 * 33]) | (f2bf(sp[7 * 33]) << 16);
        *(uint4*)(Wt + (size_t)(np0 + n) * K + k0 + 8 * c) = o; }
    __builtin_amdgcn_fence(__ATOMIC_RELEASE, "wavefront"); __builtin_amdgcn_wave_barrier(); __builtin_amdgcn_fence(__ATOMIC_ACQUIRE, "wavefront");
}
__device__ __forceinline__ void x_row_to_bf16(const float* __restrict__ x, bf16_t* __restrict__ xb, float* __restrict__ ss, int row, int lane) {
    const f32x4* xr = (const f32x4*)(x + (size_t)row * D) + lane; float s = 0.f;
#pragma unroll
    for (int j = 0; j < 4; ++j) { const f32x4 v = xr[64 * j]; s += v.x * v.x + v.y * v.y + v.z * v.z + v.w * v.w;
        unsigned long long o = (unsigned long long)(f2bf(v.x) | (f2bf(v.y) << 16)) | ((unsigned long long)(f2bf(v.z) | (f2bf(v.w) << 16)) << 32);
        ((unsigned long long*)(xb + (size_t)row * D))[lane + 64 * j] = o; }
    s = wave_sum(s); if (lane == 0) ss[row] = s;
}

struct EpArgs {
    const float* ss; float* ss_out; const float* base; float* xout; bf16_t* ob; bf16_t* ob2; int ldo; int row_off;
};
template <int MODE>
__device__ __forceinline__ void gemm_simple(const bf16_t* __restrict__ A, int lda, const bf16_t* __restrict__ Bt, int ldb, int Mrows, int N, int K, EpArgs e, int tid) {
    const int wid = tid >> 6, lane = tid & 63, fr = lane & 15, fq = lane >> 4;
    const int ntn = N / 128, ntiles = (Mrows / 64) * ntn;
    for (int tile = blockIdx.x; tile < ntiles; tile += gridDim.x) {
    const int row0 = (tile / ntn) * 64 + (wid >> 2) * 32, col0 = (tile % ntn) * 128 + (wid & 3) * 32;
    f32x4 acc[2][2];
#pragma unroll
    for (int i = 0; i < 2; ++i)
#pragma unroll
        for (int j = 0; j < 2; ++j) acc[i][j] = (f32x4){0.f, 0.f, 0.f, 0.f};
    const bf16_t* ap = A + (size_t)(row0 + fr) * lda + fq * 8;
    const bf16_t* bp = Bt + (size_t)(col0 + fr) * ldb + fq * 8;
    for (int k0 = 0; k0 < K; k0 += 32) {
        bf16x8 a[2], b[2];
#pragma unroll
        for (int i = 0; i < 2; ++i) { a[i] = *(const bf16x8*)(ap + (size_t)i * 16 * lda + k0); b[i] = *(const bf16x8*)(bp + (size_t)i * 16 * ldb + k0); }
#pragma unroll
        for (int i = 0; i < 2; ++i)
#pragma unroll
            for (int j = 0; j < 2; ++j) acc[i][j] = __builtin_amdgcn_mfma_f32_16x16x32_bf16(a[i], b[j], acc[i][j], 0, 0, 0);
    }
#pragma unroll
    for (int i = 0; i < 2; ++i)
#pragma unroll
        for (int r = 0; r < 4; ++r) {
            const int row = row0 + i * 16 + fq * 4 + r;
            float rstd = 1.f;
            if (MODE == 0 || MODE == 2) rstd = rsqrtf(e.ss[row] * (1.f / D) + RMS_EPS);
            float sq = 0.f;
#pragma unroll
            for (int j = 0; j < 2; ++j) {
                const int col = col0 + j * 16 + fr; const float v = acc[i][j][r];
                if (MODE == 0) e.ob[(size_t)row * e.ldo + col] = (bf16_t)f2bf(v * rstd);
                else if (MODE == 1) { const size_t o = (size_t)row * D + col; const float x = e.base[o] + v; e.xout[o] = x; e.ob[o] = (bf16_t)f2bf(x); sq += x * x; }
                else { const int p = col >> 8, jj = col & 255; const size_t o = (size_t)(row - e.row_off) * FF + 128 * p + (jj & 127);
                    if (jj < 128) e.ob[o] = (bf16_t)f2bf(v * rstd); else e.ob2[o] = (bf16_t)f2bf(v * rstd); }
            }
            if (MODE == 1) {
                sq += __shfl_xor(sq, 1); sq += __shfl_xor(sq, 2); sq += __shfl_xor(sq, 4); sq += __shfl_xor(sq, 8);
                if (fr == 0) atomicAdd(e.ss_out + row, sq);
            }
        }
    }
}

struct PrepArgs {
    const bf16_t* proj; const float* mu; const float* w0; const float* w2; const float* a0; const float* a2; const float* g2;
    const float* v0; const float* v1; const float* v2; bf16_t* vfirst; int layer; int pad;
    bf16_t *R, *K, *V, *A, *LD, *G;
};
__device__ __forceinline__ void prep_group(const PrepArgs& p, float (*rest)[SHIFT_W], float (*vlo)[32], int grp, int tid) {
    const int m0 = grp * 4;
    for (int i = tid; i < 4 * SHIFT_W; i += 512) {
        const int tk = i / SHIFT_W, c = i % SHIFT_W, m = m0 + tk, t = m % SEQ;
        const float u = bf2f(p.proj[(size_t)m * IN_W + ATT_IN + c]);
        const float up = t > 0 ? bf2f(p.proj[(size_t)(m - 1) * IN_W + ATT_IN + c]) : 0.f;
        float v = u + (up - u) * p.mu[c];
        if (c >= 1536 && c < 1600) v = tanhf(v); else if (c >= 1664) v = sigmoidf_(v);
        rest[tk][c] = v;
    }
    __syncthreads();
    if (p.layer > 0 && tid < 128) { const int tk = tid >> 5, j = tid & 31; float s = 0.f; for (int c = 0; c < C; ++c) s += rest[tk][1024 + c] * p.v1[c * 32 + j]; vlo[tk][j] = s; }
    __syncthreads();
    const int c = tid;
    float wp[4], ap[4], gp[4];
#pragma unroll
    for (int tk = 0; tk < 4; ++tk) { wp[tk] = p.w0[c]; ap[tk] = p.a0[c]; gp[tk] = 0.f; }
    for (int k = 0; k < 64; ++k) { const float w = p.w2[k * C + c], a = p.a2[k * C + c];
#pragma unroll
        for (int tk = 0; tk < 4; ++tk) { wp[tk] += rest[tk][1536 + k] * w; ap[tk] += rest[tk][1600 + k] * a; } }
    for (int k = 0; k < 128; ++k) { const float g = p.g2[k * C + c];
#pragma unroll
        for (int tk = 0; tk < 4; ++tk) gp[tk] += rest[tk][1664 + k] * g; }
#pragma unroll
    for (int tk = 0; tk < 4; ++tk) {
        const size_t o = (size_t)(m0 + tk) * C + c;
        const float x = -wp[tk];
        const float sp = fmaxf(x, 0.f) + log1pf(__expf(-fabsf(x)));
        const float wraw = -sp - 0.5f;
        const float ld = -__expf(wraw);
        const float a = sigmoidf_(ap[tk]);
        float v = rest[tk][1024 + c];
        if (p.layer == 0) p.vfirst[o] = (bf16_t)f2bf(v);
        else { float s = p.v0[c]; for (int j = 0; j < 32; ++j) s += vlo[tk][j] * p.v2[j * C + c]; const float vf = bf2f(p.vfirst[o]); v = v + (vf - v) * sigmoidf_(s); }
        p.R[o] = (bf16_t)f2bf(rest[tk][c]); p.K[o] = (bf16_t)f2bf(rest[tk][512 + c]); p.V[o] = (bf16_t)f2bf(v);
        p.A[o] = (bf16_t)f2bf(a); p.LD[o] = (bf16_t)f2bf(ld); p.G[o] = (bf16_t)f2bf(gp[tk]);
    }
    __syncthreads();
}

constexpr int SC_TB = 32, SC_SLOT = 384, SC_NCH = SEQ / SC_TB;
constexpr int WS_RKC = 1 * (1 << 20);
struct ScanArgs { const bf16_t *R, *K, *V, *A, *LD, *G; const float *k_k, *k_a, *r_k, *lnx_g, *lnx_b; bf16_t* mix; float* rkc; };
template <int CTRL> __device__ __forceinline__ float dpp_mov(float x) { return __builtin_bit_cast(float, __builtin_amdgcn_update_dpp(0, __builtin_bit_cast(int, x), CTRL, 0xF, 0xF, true)); }
__device__ __forceinline__ float reduce16(float x) { x += dpp_mov<0xB1>(x); x += dpp_mov<0x4E>(x); x += dpp_mov<0x141>(x); x += dpp_mov<0x140>(x); return x; }
struct ScLdSet { bf16_t r[8], k[8], v[8], a[8], ld[8]; };
__device__ __forceinline__ void scan_item(const ScanArgs& p, float* lds, int item, int tid) {
    const int chain = item >> 2, q = item & 3, b = chain >> 3, h = chain & 7, wave = __builtin_amdgcn_readfirstlane(tid >> 6), lane = tid & 63;
    float* buf = lds;
    float* ybuf = lds + 2 * SC_TB * SC_SLOT;
    if (wave >= 4) {
        const int lw = wave - 4, ch = h * 64 + lane, lt = lw * 64 + lane;
        const float kk_c = p.k_k[ch], ka_c = p.k_a[ch], rk_c = p.r_k[ch];
        const size_t rowbase = (size_t)b * SEQ;
        ScLdSet s0, s1;
#define SC_LOAD(S, chunk) do { _Pragma("unroll") for (int i = 0; i < 8; ++i) { const size_t o = (rowbase + (size_t)(chunk) * SC_TB + lw + 4 * i) * C + ch; \
            S.r[i] = p.R[o]; S.k[i] = p.K[o]; S.v[i] = p.V[o]; S.a[i] = p.A[o]; S.ld[i] = p.LD[o]; } } while (0)
#define SC_PROC(S, chunk, bi) do { _Pragma("unroll") for (int i = 0; i < 8; ++i) { const int st = lw + 4 * i; \
            const float r = bf2f(S.r[i]), k = bf2f(S.k[i]), v = bf2f(S.v[i]), a = bf2f(S.a[i]), ld = bf2f(S.ld[i]); \
            float kk = k * kk_c; const float nrm = sqrtf(wave_sum(kk * kk)); kk = kk / fmaxf(nrm, 1e-12f); \
            const float kp = k * (1.f + (a - 1.f) * ka_c); const float rkc = wave_sum(r * kp * rk_c); \
            float* slot = buf + ((bi) * SC_TB + st) * SC_SLOT + lane; \
            slot[0] = __expf(ld); slot[64] = -kk; slot[128] = kk * a; slot[192] = kp; slot[256] = r; slot[320] = v; \
            if (q == 0 && lane == 0) p.rkc[(rowbase + (size_t)(chunk) * SC_TB + st) * 8 + h] = rkc; } } while (0)
#define SC_YOUT(chunk, bi) do { _Pragma("unroll") for (int e2 = 0; e2 < 2; ++e2) { const int e = lt + 256 * e2, st = e >> 4, rr = e & 15; \
            p.mix[(rowbase + (size_t)(chunk) * SC_TB + st) * D + ATT_W + h * 64 + 16 * q + rr] = (bf16_t)f2bf(ybuf[(bi) * SC_TB * 16 + e]); } } while (0)
        SC_LOAD(s0, 0); SC_LOAD(s1, 1); SC_PROC(s0, 0, 0);
        __syncthreads();
        for (int c = 0; c < SC_NCH; c += 2) {
            if (c + 2 < SC_NCH) SC_LOAD(s0, c + 2);
            SC_PROC(s1, c + 1, 1);
            if (c >= 1) SC_YOUT(c - 1, 1);
            __syncthreads();
            if (c + 3 < SC_NCH) SC_LOAD(s1, c + 3);
            if (c + 2 < SC_NCH) SC_PROC(s0, c + 2, 0);
            SC_YOUT(c, 0);
            __syncthreads();
        }
        SC_YOUT(SC_NCH - 1, 1);
#undef SC_LOAD
#undef SC_PROC
#undef SC_YOUT
    } else {
        const int cg4 = (lane & 15) * 4, rloc = 4 * wave + (lane >> 4);
        float S0 = 0.f, S1 = 0.f, S2 = 0.f, S3 = 0.f;
#define SC_SCAN(bi) do { const float* bp = buf + (bi) * SC_TB * SC_SLOT + cg4; const float* vp = buf + (bi) * SC_TB * SC_SLOT + 320 + 16 * q + rloc; float* yp = ((lane & 15) == 0) ? (ybuf + (bi) * SC_TB * 16 + rloc) : (ybuf + 2 * SC_TB * 16 + lane);     \
            _Pragma("unroll") for (int st = 0; st < SC_TB; ++st) { \
                const f32x4 w = *(const f32x4*)(bp + st * SC_SLOT), A = *(const f32x4*)(bp + st * SC_SLOT + 64), B = *(const f32x4*)(bp + st * SC_SLOT + 128), kp = *(const f32x4*)(bp + st * SC_SLOT + 192), r = *(const f32x4*)(bp + st * SC_SLOT + 256); \
                const float v = vp[st * SC_SLOT]; \
                float sa = (S0 * A.x + S1 * A.y) + (S2 * A.z + S3 * A.w); sa = reduce16(sa); \
                S0 = S0 * w.x + (sa * B.x + v * kp.x); S1 = S1 * w.y + (sa * B.y + v * kp.y); S2 = S2 * w.z + (sa * B.z + v * kp.z); S3 = S3 * w.w + (sa * B.w + v * kp.w); \
                float y = (S0 * r.x + S1 * r.y) + (S2 * r.z + S3 * r.w); y = reduce16(y); \
                yp[st * 16] = y; } } while (0)
        __syncthreads();
        for (int c = 0; c < SC_NCH; c += 2) { SC_SCAN(0); __syncthreads(); SC_SCAN(1); __syncthreads(); }
#undef SC_SCAN
    }
    __syncthreads();
}
__device__ __forceinline__ void scan_post(const ScanArgs& p, int idx, int lane) {
    const int m = idx >> 3, h = idx & 7, ch = h * 64 + lane; const size_t o = (size_t)m * C + ch, om = (size_t)m * D + ATT_W + ch;
    const float y = bf2f(p.mix[om]);
    const float mean = wave_sum(y) * (1.f / 64.f); const float d = y - mean; const float var = wave_sum(d * d) * (1.f / 64.f);
    const float yn = d * rsqrtf(var + LNX_EPS) * p.lnx_g[ch] + p.lnx_b[ch];
    p.mix[om] = (bf16_t)f2bf((yn + p.rkc[(size_t)m * 8 + h] * bf2f(p.V[o])) * bf2f(p.G[o]));
}

typedef float f32x16 __attribute__((ext_vector_type(16)));
typedef short s16x4 __attribute__((ext_vector_type(4)));
constexpr int AT_VTS = 196;
__device__ __forceinline__ int crow(int r, int hi) { return (r & 3) + 8 * (r >> 2) + 4 * hi; }
__device__ __forceinline__ void attn_unit(const bf16_t* __restrict__ proj, const float* __restrict__ sinks, bf16_t* __restrict__ mix, bf16_t* vt, int unit, int tid) {
    const int b = unit >> 7, kvh = (unit >> 6) & 1, qb = unit & 63, Q0 = qb * 64;
    const int wave = __builtin_amdgcn_readfirstlane(tid >> 6), lane = tid & 63, c = lane & 31, hi = lane >> 5, g = wave >> 1, half = wave & 1, h = kvh * 4 + g;
    const size_t rowb = (size_t)b * SEQ;
    for (int i = tid; i < 192 * 8; i += 512) { const int kl = i >> 3, ch8 = i & 7; int key = Q0 - 128 + kl; key = key < 0 ? 0 : key;
        const bf16x8 v = *(const bf16x8*)(proj + (rowb + key) * IN_W + 640 + kvh * 64 + ch8 * 8);
#pragma unroll
        for (int e = 0; e < 8; ++e) vt[(ch8 * 8 + e) * AT_VTS + kl] = (bf16_t)v[e]; }
    __syncthreads();
    const int t0 = Q0 + 32 * half; const size_t mq = rowb + t0 + c;
    bf16x8 qf[4];
#pragma unroll
    for (int ks = 0; ks < 4; ++ks) qf[ks] = *(const bf16x8*)(proj + mq * IN_W + h * 64 + 16 * ks + 8 * hi);
    f32x16 p[5];
#pragma unroll
    for (int kb = 0; kb < 5; ++kb) { int key = t0 - 128 + 32 * kb + c; key = key < 0 ? 0 : key; const bf16_t* kp = proj + (rowb + key) * IN_W + 512 + kvh * 64 + 8 * hi;
        f32x16 acc;
#pragma unroll
        for (int r = 0; r < 16; ++r) acc[r] = 0.f;
#pragma unroll
        for (int ks = 0; ks < 4; ++ks) acc = __builtin_amdgcn_mfma_f32_32x32x16_bf16(*(const bf16x8*)(kp + 16 * ks), qf[ks], acc, 0, 0, 0);
        p[kb] = acc; }
    const float slope = exp2f(-(float)(h + 1)), sink = sinks[h];
    float mx = sink;
#pragma unroll
    for (int kb = 0; kb < 5; ++kb)
#pragma unroll
        for (int r = 0; r < 16; ++r) { const int cr = crow(r, hi), dist = c + 128 - 32 * kb - cr, key = t0 - 128 + 32 * kb + cr;
            const float sc = (dist >= 0 && dist < WINDOW && key >= 0) ? p[kb][r] * 0.125f - slope * (float)dist : -1e30f; p[kb][r] = sc; mx = fmaxf(mx, sc); }
    mx = fmaxf(mx, __shfl_xor(mx, 32));
    float l = 0.f;
#pragma unroll
    for (int kb = 0; kb < 5; ++kb)
#pragma unroll
        for (int r = 0; r < 16; ++r) { const float e = __expf(p[kb][r] - mx); p[kb][r] = e; l += e; }
    l += __shfl_xor(l, 32); l += __expf(sink - mx);
    f32x16 o[2];
#pragma unroll
    for (int d = 0; d < 2; ++d)
#pragma unroll
        for (int r = 0; r < 16; ++r) o[d][r] = 0.f;
#pragma unroll
    for (int kb = 0; kb < 5; ++kb)
#pragma unroll
        for (int s2 = 0; s2 < 2; ++s2) {
            pg8::u32x4 pw; pw.x = pg8::cvt_pk_bf16(p[kb][8 * s2 + 0], p[kb][8 * s2 + 1]); pw.y = pg8::cvt_pk_bf16(p[kb][8 * s2 + 2], p[kb][8 * s2 + 3]);
            pw.z = pg8::cvt_pk_bf16(p[kb][8 * s2 + 4], p[kb][8 * s2 + 5]); pw.w = pg8::cvt_pk_bf16(p[kb][8 * s2 + 6], p[kb][8 * s2 + 7]);
            const bf16x8 pf = __builtin_bit_cast(bf16x8, pw);
#pragma unroll
            for (int d = 0; d < 2; ++d) { const bf16_t* vp = vt + (32 * d + c) * AT_VTS + 32 * half + 32 * kb + 16 * s2 + 4 * hi;
                const s16x4 lo = *(const s16x4*)vp, hh = *(const s16x4*)(vp + 8);
                const bf16x8 vf = (bf16x8){lo[0], lo[1], lo[2], lo[3], hh[0], hh[1], hh[2], hh[3]};
                o[d] = __builtin_amdgcn_mfma_f32_32x32x16_bf16(vf, pf, o[d], 0, 0, 0); } }
    const float inv = 1.f / l;
#pragma unroll
    for (int d = 0; d < 2; ++d)
#pragma unroll
        for (int rg = 0; rg < 4; ++rg) { uint2 w; w.x = pg8::cvt_pk_bf16(o[d][4 * rg] * inv, o[d][4 * rg + 1] * inv); w.y = pg8::cvt_pk_bf16(o[d][4 * rg + 2] * inv, o[d][4 * rg + 3] * inv);
            *(uint2*)(mix + mq * D + h * 64 + 32 * d + 8 * rg + 4 * hi) = w; }
    __syncthreads();
}

__device__ __forceinline__ void conv_item(const bf16_t* __restrict__ U, const bf16_t* __restrict__ UP, const float* __restrict__ cw, const float* __restrict__ cb, bf16_t* __restrict__ hid, size_t i) {
    const int t = (int)(i / FF), j = (int)(i % FF);
    const float u0 = bf2f(U[i]), u1 = t >= 1 ? bf2f(U[i - FF]) : 0.f, u2 = t >= 2 ? bf2f(U[i - 2 * FF]) : 0.f;
    const float c = cb[j] + cw[j] * u2 + cw[FF + j] * u1 + cw[2 * FF + j] * u0;
    hid[i] = (bf16_t)f2bf(c * sigmoidf_(c) * bf2f(UP[i]));
}

__device__ __forceinline__ void final_row(float* __restrict__ x, const float* __restrict__ ss, const float* __restrict__ g, int row, int lane) {
    const float rstd = rsqrtf(ss[row] * (1.f / D) + RMS_EPS);
    f32x4* xr = (f32x4*)(x + (size_t)row * D) + lane; const f32x4* gr = (const f32x4*)g + lane;
#pragma unroll
    for (int j = 0; j < 4; ++j) { f32x4 v = xr[64 * j]; const f32x4 gg = gr[64 * j]; v.x *= rstd * gg.x; v.y *= rstd * gg.y; v.z *= rstd * gg.z; v.w *= rstd * gg.w; xr[64 * j] = v; }
}

constexpr int NTHREADS = 512, LDS_BYTES = 147456;
struct Args { const float* in[26]; float* out; unsigned char* ws; };
__global__ void __launch_bounds__(NTHREADS, 2) mega_fwd(Args a) {
    extern __shared__ __attribute__((aligned(16))) unsigned char lds[];
    cg::grid_group grid = cg::this_grid();
#define GRID_SYNC() grid.sync()
#define LDSP ((PG8_LAS unsigned char*)lds)
#define OTID() ({ int _t = threadIdx.x; asm volatile("" : "+v"(_t)); _t; })
    const int G = gridDim.x, NGW = G * 8;
    const float* x = a.in[0]; const float* norm1_g = a.in[1]; const float* w_in = a.in[2]; const float* sinks = a.in[3];
    const float* mu = a.in[4]; const float* w0 = a.in[5]; const float* w2 = a.in[6]; const float* a0 = a.in[7];
    const float* a2 = a.in[8]; const float* g2 = a.in[9]; const float* k_k = a.in[10]; const float* k_a = a.in[11];
    const float* r_k = a.in[12]; const float* lnx_g = a.in[13]; const float* lnx_b = a.in[14]; const float* v0 = a.in[15];
    const float* v1 = a.in[16]; const float* v2 = a.in[17]; const float* w_out = a.in[18]; const float* norm2_g = a.in[19];
    const float* wg = a.in[20]; const float* wu = a.in[21]; const float* conv_w = a.in[22]; const float* conv_b = a.in[23];
    const float* wd = a.in[24]; const float* final_g = a.in[25];
    unsigned char* ws = a.ws; float* X = a.out;
    float* ss = (float*)(ws + WS_SS);
    bf16_t* XB = (bf16_t*)(ws + WS_XB); bf16_t* PROJ = (bf16_t*)(ws + WS_PROJ); bf16_t* MIX = (bf16_t*)(ws + WS_MIX); bf16_t* HID = (bf16_t*)(ws + WS_HID); bf16_t* VF = (bf16_t*)(ws + WS_VFIRST);
    bf16_t* UT = (bf16_t*)(ws + WS_UTMP); bf16_t* UPT = UT + (size_t)SEQ * FF;

    {
        const int tid = OTID(), lane = tid & 63, wave = tid >> 6, gw = blockIdx.x * 8 + wave;
        float* scr = (float*)lds + wave * (64 * 33 + 16);
        constexpr int I_IN = (D / 64) * (IN_W / 32), I_OUT = (D / 64) * (D / 32), I_G = (D / 64) * (FF / 32), I_DN = (FF / 64) * (D / 32), I_LAYER = I_IN + I_OUT + 2 * I_G + I_DN;
        for (int it = gw; it < 2 * I_LAYER; it += NGW) {
            const int l = it / I_LAYER; int r = it % I_LAYER;
            bf16_t* wl = (bf16_t*)(ws + WS_W + l * W_LAYER); bf16_t* WinT = wl; bf16_t* WoutT = (bf16_t*)((char*)wl + W_IN_SZ); bf16_t* WguT = (bf16_t*)((char*)WoutT + W_OUT_SZ); bf16_t* WdT = (bf16_t*)((char*)WguT + W_GU_SZ);
            if (r < I_IN) { transpose_item(w_in + (size_t)l * D * IN_W, D, IN_W, WinT, norm1_g + l * D, 0, scr, r, lane); continue; } r -= I_IN;
            if (r < I_OUT) { transpose_item(w_out + (size_t)l * D * D, D, D, WoutT, nullptr, 0, scr, r, lane); continue; } r -= I_OUT;
            if (r < I_G) { transpose_item(wg + (size_t)l * D * FF, D, FF, WguT, norm2_g + l * D, 1, scr, r, lane); continue; } r -= I_G;
            if (r < I_G) { transpose_item(wu + (size_t)l * D * FF, D, FF, WguT, norm2_g + l * D, 2, scr, r, lane); continue; } r -= I_G;
            transpose_item(wd + (size_t)l * FF * D, FF, D, WdT, nullptr, 0, scr, r, lane);
        }
        for (int m = gw; m < M; m += NGW) x_row_to_bf16(x, XB, ss, m, lane);
    }
    GRID_SYNC();
    for (int l = 0; l < 2; ++l) {
        bf16_t* wl = (bf16_t*)(ws + WS_W + l * W_LAYER); bf16_t* WinT = wl; bf16_t* WoutT = (bf16_t*)((char*)wl + W_IN_SZ); bf16_t* WguT = (bf16_t*)((char*)WoutT + W_OUT_SZ); bf16_t* WdT = (bf16_t*)((char*)WguT + W_GU_SZ);
        float* ss1 = ss + (size_t)(2 * l) * M; float* ss2 = ss + (size_t)(2 * l + 1) * M; float* ss3 = ss + (size_t)(2 * l + 2) * M;
        { pg8::Gemm g{XB, WinT, M, IN_W, D}; pg8::StaticOrder S; S.init(M, IN_W, G, (int)blockIdx.x); pg8::EpiScaleBf16 E{PROJ, IN_W, ss1};
          pg8::gemm_phase<pg8::EpiScaleBf16, pg8::StaticOrder, true, true>(LDSP, g, S, E); }
        GRID_SYNC();
        for (int unit = blockIdx.x; unit < BATCH * 2 * (SEQ / 64); unit += G) attn_unit(PROJ, sinks + l * NH, MIX, (bf16_t*)lds, unit, OTID());
        PrepArgs p{}; p.proj = PROJ; p.mu = mu + l * SHIFT_W; p.w0 = w0 + l * C; p.w2 = w2 + (size_t)l * 64 * C; p.a0 = a0 + l * C; p.a2 = a2 + (size_t)l * 64 * C; p.g2 = g2 + (size_t)l * 128 * C;
        p.v0 = v0; p.v1 = v1; p.v2 = v2; p.vfirst = VF; p.layer = l;
        p.R = (bf16_t*)(ws + WS_SI_R); p.K = (bf16_t*)(ws + WS_SI_K); p.V = (bf16_t*)(ws + WS_SI_V); p.A = (bf16_t*)(ws + WS_SI_A); p.LD = (bf16_t*)(ws + WS_SI_LD); p.G = (bf16_t*)(ws + WS_SI_G);
        for (int grp = blockIdx.x; grp < M / 4; grp += G) prep_group(p, (float (*)[SHIFT_W])lds, (float (*)[32])(lds + 4 * SHIFT_W * 4), grp, OTID());
        GRID_SYNC();
        { ScanArgs s{}; s.R = p.R; s.K = p.K; s.V = p.V; s.A = p.A; s.LD = p.LD; s.G = p.G; s.k_k = k_k + l * C; s.k_a = k_a + l * C; s.r_k = r_k + l * C; s.lnx_g = lnx_g + l * C; s.lnx_b = lnx_b + l * C; s.mix = MIX; s.rkc = (float*)(ws + WS_RKC);
          for (int item = (int)((blockIdx.x & 7) * (G >> 3) + (blockIdx.x >> 3)); item < BATCH * NH * 4; item += G) scan_item(s, (float*)lds, item, OTID());
          GRID_SYNC();
          { const int tid = OTID(), lane = tid & 63, gw = blockIdx.x * 8 + (tid >> 6); for (int idx = gw; idx < M * NH; idx += NGW) scan_post(s, idx, lane); } }
        GRID_SYNC();
        { pg8::Gemm g{MIX, WoutT, M, D, D}; pg8::StaticOrder S; S.init(M, D, G, (int)blockIdx.x); pg8::EpiResid E{(l == 0) ? x : X, X, XB, ss2};
          pg8::gemm_phase<pg8::EpiResid, pg8::StaticOrder, true, true>(LDSP, g, S, E); }
        GRID_SYNC();
        for (int b = 0; b < BATCH; ++b) {
            { pg8::Gemm g{XB + (size_t)b * SEQ * D, WguT, SEQ, 2 * FF, D}; pg8::StaticOrder S; S.init(SEQ, 2 * FF, G, (int)blockIdx.x); pg8::EpiGateUpTmp E{UT, UPT, ss2 + (size_t)b * SEQ, FF};
              pg8::gemm_phase<pg8::EpiGateUpTmp, pg8::StaticOrder, true, true>(LDSP, g, S, E); }
            GRID_SYNC();
            { const int tid = OTID();
            for (size_t i = (size_t)blockIdx.x * NTHREADS + tid; i < (size_t)SEQ * FF; i += (size_t)G * NTHREADS) conv_item(UT, UPT, conv_w + (size_t)l * 3 * FF, conv_b + (size_t)l * FF, HID + (size_t)b * SEQ * FF, i); }
            GRID_SYNC();
        }
        { pg8::Gemm g{HID, WdT, M, D, FF}; pg8::StaticOrder S; S.init(M, D, G, (int)blockIdx.x); pg8::EpiResid E{X, X, XB, ss3};
          pg8::gemm_phase<pg8::EpiResid, pg8::StaticOrder, true, true>(LDSP, g, S, E); }
        GRID_SYNC();
    }
    { const int tid = OTID(), lane = tid & 63, gw = blockIdx.x * 8 + (tid >> 6);
    for (int m = gw; m < M; m += NGW) final_row(X, ss + (size_t)4 * M, final_g, m, lane); }
}

extern "C" void kernel_launch(void* const* d_in, const int* in_sizes, int n_in, void* d_out, int out_size, void* d_ws, size_t ws_size, hipStream_t stream) {
    static int grid = 0;
    if (grid == 0) {
        if (n_in != 26 || in_sizes[0] != M * D || out_size != M * D || ws_size < WS_END) { fprintf(stderr, "kernel_launch: unexpected shapes (n_in %d, ws %zu)\n", n_in, ws_size); grid = -1; return; }
        int dev = 0, cus = 0, per_cu = 0;
        if (hipGetDevice(&dev) != hipSuccess || hipDeviceGetAttribute(&cus, hipDeviceAttributeMultiprocessorCount, dev) != hipSuccess) { grid = -1; return; }
        if (hipFuncSetAttribute((const void*)mega_fwd, hipFuncAttributeMaxDynamicSharedMemorySize, LDS_BYTES) != hipSuccess) { fprintf(stderr, "kernel_launch: hipFuncSetAttribute failed\n"); grid = -1; return; }
        if (hipOccupancyMaxActiveBlocksPerMultiprocessor(&per_cu, (const void*)mega_fwd, NTHREADS, LDS_BYTES) != hipSuccess || per_cu < 1) { fprintf(stderr, "kernel_launch: occupancy query failed (%d)\n", per_cu); grid = -1; return; }
        grid = cus;
    }
    if (grid < 0) return;
    (void)hipMemsetAsync((unsigned char*)d_ws + WS_CTL, 0, CTL_BYTES, stream);
    Args a{};
    for (int i = 0; i < 26; ++i) a.in[i] = (const float*)d_in[i];
    a.out = (float*)d_out; a.ws = (unsigned char*)d_ws;
    void* kargs[] = {&a};
    hipError_t e = hipLaunchCooperativeKernel((const void*)mega_fwd, dim3(grid), dim3(NTHREADS), kargs, LDS_BYTES, stream);
    if (e != hipSuccess) fprintf(stderr, "kernel_launch: cooperative launch failed: %s (grid %d)\n", hipGetErrorString(e), grid);
}
```

```cpp
#include <hip/hip_runtime.h>
#include <hip/hip_cooperative_groups.h>
namespace cg = cooperative_groups;
#include <cstdio>
#include <cstdint>

typedef unsigned short bf16_t;
typedef short bf16x8 __attribute__((ext_vector_type(8)));
typedef float f32x4 __attribute__((ext_vector_type(4)));

constexpr int BATCH = 8, SEQ = 4096, D = 1024, M = BATCH * SEQ;
constexpr int HD = 64, ATT_W = 512, KV_W = 128, C = 512, NH = 8;
constexpr int ATT_IN = 768, SHIFT_W = 1792, IN_W = 2560, FF = 2816;
constexpr int WINDOW = 128;
constexpr float RMS_EPS = 1e-5f, LNX_EPS = 64e-5f;

constexpr size_t MiB = 1u << 20;
constexpr size_t WS_CTL = 0;
constexpr size_t WS_SS = 0;
constexpr size_t CTL_BYTES = 1 * MiB;
constexpr size_t WS_W = 2 * MiB;
constexpr size_t W_IN_SZ = (size_t)IN_W * D * 2, W_OUT_SZ = (size_t)D * D * 2, W_GU_SZ = (size_t)2 * FF * D * 2, W_DN_SZ = (size_t)D * FF * 2;
constexpr size_t W_LAYER = W_IN_SZ + W_OUT_SZ + W_GU_SZ + W_DN_SZ;
constexpr size_t WS_VFIRST = 52 * MiB, WS_MIX = 84 * MiB, WS_XB = 148 * MiB, WS_PROJ = 212 * MiB;
constexpr size_t WS_SI_R = 148 * MiB, WS_SI_K = 180 * MiB, WS_SI_V = 372 * MiB, WS_SI_A = 404 * MiB, WS_SI_LD = 436 * MiB, WS_SI_G = 468 * MiB;
constexpr size_t WS_HID = 212 * MiB;
constexpr size_t WS_UTMP = 84 * MiB;
constexpr size_t WS_END = 500 * MiB;
static_assert(WS_W + 2 * W_LAYER <= WS_VFIRST, "weights fit");

__device__ __forceinline__ unsigned f2bf(float f) { unsigned u = __builtin_bit_cast(unsigned, f); return (u + 0x7fffu + ((u >> 16) & 1u)) >> 16; }
__device__ __forceinline__ float bf2f(bf16_t h) { return __builtin_bit_cast(float, (unsigned)h << 16); }
__device__ __forceinline__ float wave_sum(float v) {
#pragma unroll
    for (int o = 1; o < 64; o <<= 1) v += __shfl_xor(v, o);
    return v;
}
__device__ __forceinline__ float sigmoidf_(float x) { return 1.f / (1.f + __expf(-x)); }

namespace pg8 {
#define PG8_LAS __attribute__((address_space(3)))
typedef unsigned short bf16_t;
typedef short bf16x8 __attribute__((ext_vector_type(8)));
typedef float f32x4 __attribute__((ext_vector_type(4)));
typedef unsigned u32x4 __attribute__((ext_vector_type(4)));
constexpr int BM = 256, BK = 64, HALF = 128, HTB = HALF * BK * 2  , STAGE_BYTES = 8 * HTB, NXCD = 8, WGM = 8;

__host__ __device__ __forceinline__ int lds_byte(int r, int c) { const int st = (r >> 4) * 2 + (c >> 5), rr = r & 15, cc = c & 31, ob = rr * 64 + cc * 2; return st * 1024 + (ob ^ (((ob >> 9) & 1) << 5)); }
__host__ __device__ __forceinline__ void stage_rc(int b, int& R, int& C) { const int st = b / 1024, sb = b % 1024, swz = sb ^ (((sb >> 9) & 1) << 5); R = (st >> 1) * 16 + swz / 64; C = (st & 1) * 32 + (swz % 64) / 2; }
__host__ __device__ __forceinline__ int perm32(int rho) { const int n = rho >> 4, i = rho & 15; return 8 * (i >> 2) + 4 * n + (i & 3); }

struct Unit { int pm, pn; };
struct Gemm { const bf16_t* A; const bf16_t* Bt; int M, N, K; };

struct StaticOrder {
    int nM, nN, nwg, G, c;
    __host__ __device__ void init(int M, int N, int G_, int c_) { nM = M / BM; nN = N / BM; nwg = nM * nN; G = G_; c = c_; }
    __host__ __device__ bool next(int i, Unit& u) const {
        const long L = (long)i * G + c; if (L >= nwg) return false;
        int wgid = (int)L; { const int q = nwg / NXCD, r = nwg % NXCD, xcd = wgid % NXCD, off = wgid / NXCD; wgid = (xcd < r ? xcd * (q + 1) : r * (q + 1) + (xcd - r) * q) + off; }
        const int nig = WGM * nN, gid = wgid / nig, fm = gid * WGM, gsz = (nM - fm) < WGM ? (nM - fm) : WGM;
        u.pm = fm + ((wgid % nig) % gsz); u.pn = (wgid % nig) / gsz; return true;
    }
    __device__ __forceinline__ void a_ready(const Unit&) const {}
    __device__ __forceinline__ void done(const Unit&) const {}
};
typedef float f32x2_t_ __attribute__((ext_vector_type(2))); typedef __bf16 bf16x2_t_ __attribute__((ext_vector_type(2)));
__device__ __forceinline__ unsigned cvt_pk_bf16(float lo, float hi) { const f32x2_t_ v = {lo, hi}; const bf16x2_t_ b = __builtin_convertvector(v, bf16x2_t_); return __builtin_bit_cast(unsigned, b); }
typedef float f32x2 __attribute__((ext_vector_type(2)));
template <class Epi, class Sched, bool ALIGN_EPI = false, bool SP2 = false>
__device__ __forceinline__ void gemm_phase(PG8_LAS unsigned char* lds, const Gemm g, const Sched& S, const Epi& E) {
    int tid_ = threadIdx.x; asm volatile("" : "+v"(tid_));
    const int tid = tid_, wid = __builtin_amdgcn_readfirstlane(tid >> 6), lane = tid & 63, wr = wid >> 2, wc = wid & 3, fr = lane & 15, fq = lane >> 4;
    const int K = g.K, nt = K / BK;
    unsigned voffA[2], voffB[2];
#pragma unroll
    for (int i = 0; i < 2; ++i) { int R, C; stage_rc(tid * 16 + i * 8192, R, C); const int Rb = Epi::PERM ? ((R & ~31) + perm32(R & 31)) : R;
        voffA[i] = (unsigned)(R * K + C) * 2u; voffB[i] = (unsigned)(Rb * K + C) * 2u; }
    const size_t kstep = (size_t)(BK * 2);
    const size_t hstep = (size_t)HALF * K * 2;
    const size_t tstep = 2 * hstep;
    const unsigned ldsw = (unsigned)wid * 1024u;
    const int aoff = lds_byte(wr * 64 + fr, fq * 8), boff = lds_byte(wc * 32 + fr, fq * 8);
#define PG8_SA(b, h) (((b) * 2 + (h)) * HTB)
#define PG8_SB(b, h) ((4 + (b) * 2 + (h)) * HTB)
#define PG8_STAGE(bufoff, gbase, voff) do { _Pragma("unroll") for (int _i = 0; _i < 2; ++_i) \
        __builtin_amdgcn_global_load_lds((const unsigned*)((const char*)(gbase) + (voff)[_i]), (PG8_LAS unsigned*)(lds + (bufoff) + ldsw + _i * 8192), 16, 0, 0); } while (0)
#define PG8_LDA(dst, b, h) do { _Pragma("unroll") for (int m = 0; m < 4; ++m) _Pragma("unroll") for (int k = 0; k < 2; ++k) dst[m][k] = *(const PG8_LAS bf16x8*)(lds + PG8_SA(b, h) + aoff + m * 2048 + k * 1024); } while (0)
#define PG8_LDB(dst, b, h) do { _Pragma("unroll") for (int n = 0; n < 2; ++n) _Pragma("unroll") for (int k = 0; k < 2; ++k) dst[n][k] = *(const PG8_LAS bf16x8*)(lds + PG8_SB(b, h) + boff + n * 2048 + k * 1024); } while (0)
#define PG8_MMA(ai, bj, At, Bt) do { __builtin_amdgcn_s_setprio(1); _Pragma("unroll") for (int m = 0; m < 4; ++m) _Pragma("unroll") for (int n = 0; n < 2; ++n) _Pragma("unroll") for (int k = 0; k < 2; ++k) \
        acc[ai][bj][m][n] = __builtin_amdgcn_mfma_f32_16x16x32_bf16(Bt[n][k], At[m][k], acc[ai][bj][m][n], 0, 0, 0); __builtin_amdgcn_s_setprio(0); } while (0)
#define PG8_WAIT_V(n) asm volatile("s_waitcnt vmcnt(" #n ")" ::: "memory")
#define PG8_WAIT_L(n) asm volatile("s_waitcnt lgkmcnt(" #n ")" ::: "memory")
#define PG8_BAR __builtin_amdgcn_s_barrier()
#define PG8_SCHED __builtin_amdgcn_sched_barrier(0)
    Unit cur, nxt; int ui = 0;
    if (!S.next(0, cur)) return;
    f32x4 acc[2][2][4][2];
#pragma unroll
    for (int a = 0; a < 2; ++a)
#pragma unroll
        for (int b = 0; b < 2; ++b)
#pragma unroll
            for (int m = 0; m < 4; ++m)
#pragma unroll
                for (int n = 0; n < 2; ++n) acc[a][b][m][n] = (f32x4){0.f, 0.f, 0.f, 0.f};
    bf16x8 At[4][2], B0[2][2], B1[2][2];
    const char* cA = (const char*)g.A + (size_t)cur.pm * tstep; const char* cB = (const char*)g.Bt + (size_t)cur.pn * tstep;
    S.a_ready(cur);
    if constexpr (SP2) {
        PG8_STAGE(PG8_SB(0, 0), cB, voffB); PG8_STAGE(PG8_SB(0, 1), cB + hstep, voffB); PG8_STAGE(PG8_SA(0, 0), cA, voffA); PG8_STAGE(PG8_SA(0, 1), cA + hstep, voffA);
        if (wr == 1) PG8_BAR;
        PG8_WAIT_V(2); PG8_BAR;
        PG8_STAGE(PG8_SB(1, 0), cB + kstep, voffB); PG8_STAGE(PG8_SA(1, 0), cA + kstep, voffA); PG8_STAGE(PG8_SB(1, 1), cB + hstep + kstep, voffB);
        PG8_WAIT_V(6); PG8_BAR;
    } else {
        PG8_STAGE(PG8_SB(0, 0), cB, voffB); PG8_STAGE(PG8_SA(0, 0), cA, voffA); PG8_STAGE(PG8_SB(0, 1), cB + hstep, voffB); PG8_STAGE(PG8_SA(0, 1), cA + hstep, voffA);
        if (wr == 1) PG8_BAR;
        PG8_WAIT_V(4); PG8_BAR;
        PG8_STAGE(PG8_SB(1, 0), cB + kstep, voffB); PG8_STAGE(PG8_SA(1, 0), cA + kstep, voffA); PG8_STAGE(PG8_SB(1, 1), cB + hstep + kstep, voffB);
        PG8_WAIT_V(6); PG8_BAR;
    }
    for (;;) {
        const bool has_next = S.next(ui + 1, nxt);
        const char* nA = has_next ? (const char*)g.A + (size_t)nxt.pm * tstep : cA; const char* nB = has_next ? (const char*)g.Bt + (size_t)nxt.pn * tstep : cB;
        for (int t = 0; t < nt; t += 2) {
            const bool last = (t == nt - 2);
            const char* a1 = cA + (size_t)(t + 1) * kstep;
            const char* a2 = last ? nA : cA + (size_t)(t + 2) * kstep; const char* b2 = last ? nB : cB + (size_t)(t + 2) * kstep;
            const char* a3 = a2 + kstep; const char* b3 = b2 + kstep;
            if (last && has_next) S.a_ready(nxt);
            if constexpr (SP2) {
            PG8_LDB(B0, 0, 0); PG8_LDB(B1, 0, 1); PG8_SCHED; PG8_LDA(At, 0, 0); PG8_STAGE(PG8_SA(1, 1), a1 + hstep, voffA);
            PG8_WAIT_V(8); PG8_WAIT_L(0); PG8_BAR; PG8_MMA(0, 0, At, B0); PG8_MMA(0, 1, At, B1); PG8_BAR; PG8_SCHED;
            PG8_LDA(At, 0, 1); PG8_STAGE(PG8_SB(0, 0), b2, voffB); PG8_STAGE(PG8_SB(0, 1), b2 + hstep, voffB); PG8_STAGE(PG8_SA(0, 0), a2, voffA);
            PG8_WAIT_V(8); PG8_WAIT_L(0); PG8_BAR; PG8_MMA(1, 0, At, B0); PG8_MMA(1, 1, At, B1); PG8_BAR; PG8_SCHED;
            PG8_LDB(B0, 1, 0); PG8_LDB(B1, 1, 1); PG8_SCHED; PG8_LDA(At, 1, 0); PG8_STAGE(PG8_SA(0, 1), a2 + hstep, voffA);
            PG8_WAIT_V(8); PG8_WAIT_L(0); PG8_BAR; PG8_MMA(0, 0, At, B0); PG8_MMA(0, 1, At, B1); PG8_BAR; PG8_SCHED;
            PG8_LDA(At, 1, 1); PG8_STAGE(PG8_SB(1, 0), b3, voffB); PG8_STAGE(PG8_SB(1, 1), b3 + hstep, voffB); PG8_STAGE(PG8_SA(1, 0), a3, voffA);
            PG8_WAIT_V(8); PG8_WAIT_L(0); PG8_BAR; PG8_MMA(1, 0, At, B0); PG8_MMA(1, 1, At, B1); PG8_BAR; PG8_SCHED;
            } else {
            PG8_LDB(B0, 0, 0); PG8_SCHED; PG8_LDA(At, 0, 0); PG8_STAGE(PG8_SA(1, 1), a1 + hstep, voffA);
            PG8_WAIT_L(8); PG8_BAR; PG8_WAIT_L(0); PG8_MMA(0, 0, At, B0); PG8_BAR; PG8_SCHED;
            PG8_LDB(B1, 0, 1); PG8_STAGE(PG8_SB(0, 0), b2, voffB);
            PG8_BAR; PG8_WAIT_L(0); PG8_MMA(0, 1, At, B1); PG8_BAR;
            PG8_LDA(At, 0, 1); PG8_STAGE(PG8_SA(0, 0), a2, voffA);
            PG8_BAR; PG8_WAIT_L(0); PG8_MMA(1, 0, At, B0); PG8_BAR; PG8_SCHED;
            PG8_STAGE(PG8_SB(0, 1), b2 + hstep, voffB);
            PG8_WAIT_V(6); PG8_BAR; PG8_MMA(1, 1, At, B1); PG8_BAR;
            PG8_LDB(B0, 1, 0); PG8_SCHED; PG8_LDA(At, 1, 0); PG8_STAGE(PG8_SA(0, 1), a2 + hstep, voffA);
            PG8_WAIT_L(8); PG8_BAR; PG8_WAIT_L(0); PG8_MMA(0, 0, At, B0); PG8_BAR; PG8_SCHED;
            PG8_LDB(B1, 1, 1); PG8_STAGE(PG8_SB(1, 0), b3, voffB);
            PG8_BAR; PG8_WAIT_L(0); PG8_MMA(0, 1, At, B1); PG8_BAR;
            PG8_LDA(At, 1, 1); PG8_STAGE(PG8_SA(1, 0), a3, voffA);
            PG8_BAR; PG8_WAIT_L(0); PG8_MMA(1, 0, At, B0); PG8_BAR; PG8_SCHED;
            PG8_STAGE(PG8_SB(1, 1), b3 + hstep, voffB);
            PG8_WAIT_V(6); PG8_BAR; PG8_MMA(1, 1, At, B1); PG8_BAR;
            }
        }
        if constexpr (ALIGN_EPI) { if (wr == 0) PG8_BAR; }
        if constexpr (!Epi::AFTER_DRAIN) { E(acc, cur, wr, wc, fr, fq); S.done(cur); }
        if (!has_next) break;
#pragma unroll
        for (int a = 0; a < 2; ++a)
#pragma unroll
            for (int b = 0; b < 2; ++b)
#pragma unroll
                for (int m = 0; m < 4; ++m)
#pragma unroll
                    for (int n = 0; n < 2; ++n) acc[a][b][m][n] = (f32x4){0.f, 0.f, 0.f, 0.f};
        cur = nxt; cA = nA; cB = nB; ++ui;
        if constexpr (ALIGN_EPI) { if (wr == 1) PG8_BAR; }
    }
    PG8_WAIT_V(0);
    if constexpr (!ALIGN_EPI) { if (wr == 0) PG8_BAR; }
    PG8_BAR;
    if constexpr (Epi::AFTER_DRAIN) { E.fused(acc, cur, wr, wc, fr, fq, lds, wid, lane); S.done(cur); }
#undef PG8_SA
#undef PG8_SB
#undef PG8_STAGE
#undef PG8_LDA
#undef PG8_LDB
#undef PG8_MMA
#undef PG8_WAIT_V
#undef PG8_WAIT_L
#undef PG8_BAR
#undef PG8_SCHED
}

constexpr int DM_ = 1024; constexpr float RMS_EPS_ = 1e-5f;
__device__ __forceinline__ float rstd_of(const float* ss, int row) { return __builtin_amdgcn_rsqf(ss[row] * (1.0f / DM_) + RMS_EPS_); }
struct EpiScaleBf16 {
    static constexpr bool PERM = true, AFTER_DRAIN = false;
    bf16_t* O; int ldc; const float* ss;
    __device__ __forceinline__ void operator()(const f32x4 (&acc)[2][2][4][2], const Unit& u, int wr, int wc, int fr, int fq) const {
        const int row0 = u.pm * BM + wr * 64 + fr, col0 = u.pn * BM + wc * 32 + 8 * fq;
        float rsv[2][4];
#pragma unroll
        for (int ai = 0; ai < 2; ++ai)
#pragma unroll
            for (int m = 0; m < 4; ++m) rsv[ai][m] = ss[row0 + ai * HALF + m * 16];
#pragma unroll
        for (int ai = 0; ai < 2; ++ai)
#pragma unroll
            for (int m = 0; m < 4; ++m) { const int row = row0 + ai * HALF + m * 16; const float rs = __builtin_amdgcn_rsqf(rsv[ai][m] * (1.0f / DM_) + RMS_EPS_); bf16_t* rowp = O + (size_t)row * ldc + col0;
#pragma unroll
                for (int bj = 0; bj < 2; ++bj) { const f32x4 v0 = acc[ai][bj][m][0] * rs, v1 = acc[ai][bj][m][1] * rs;
                    u32x4 w; w.x = cvt_pk_bf16(v0[0], v0[1]); w.y = cvt_pk_bf16(v0[2], v0[3]); w.z = cvt_pk_bf16(v1[0], v1[1]); w.w = cvt_pk_bf16(v1[2], v1[3]);
                    *(u32x4*)(rowp + bj * HALF) = w; } }
    }
};
struct EpiResid {
    static constexpr bool PERM = false, AFTER_DRAIN = false;
    const float* base; float* xout; bf16_t* xb; float* ss_out;
    __device__ __forceinline__ void operator()(const f32x4 (&acc)[2][2][4][2], const Unit& u, int wr, int wc, int fr, int fq) const {
        typedef unsigned u32x2v __attribute__((ext_vector_type(2)));
        const int row0 = u.pm * BM + wr * 64 + fr, col0 = u.pn * BM + wc * 32 + 4 * fq;
#pragma unroll
        for (int ai = 0; ai < 2; ++ai)
#pragma unroll
            for (int m = 0; m < 4; ++m) { const int row = row0 + ai * HALF + m * 16; const size_t off = (size_t)row * DM_ + col0; float sq = 0.f;
#pragma unroll
                for (int bj = 0; bj < 2; ++bj)
#pragma unroll
                    for (int n = 0; n < 2; ++n) { const size_t o = off + bj * HALF + n * 16; const f32x4 x = *(const f32x4*)(base + o) + acc[ai][bj][m][n];
                        *(f32x4*)(xout + o) = x; u32x2v w; w.x = cvt_pk_bf16(x[0], x[1]); w.y = cvt_pk_bf16(x[2], x[3]); *(u32x2v*)(xb + o) = w;
                        sq += (x[0] * x[0] + x[1] * x[1]) + (x[2] * x[2] + x[3] * x[3]); }
                sq += __shfl_xor(sq, 16); sq += __shfl_xor(sq, 32);
                if (fq == 0) atomicAdd(ss_out + row, sq); }
    }
};
struct EpiGateUpTmp {
    static constexpr bool PERM = true, AFTER_DRAIN = false;
    bf16_t* U; bf16_t* UP; const float* ss; int ff;
    __device__ __forceinline__ void operator()(const f32x4 (&acc)[2][2][4][2], const Unit& u, int wr, int wc, int fr, int fq) const {
        const int row0 = u.pm * BM + wr * 64 + fr, col0 = u.pn * HALF + wc * 32 + 8 * fq;
        float rsv[2][4];
#pragma unroll
        for (int ai = 0; ai < 2; ++ai)
#pragma unroll
            for (int m = 0; m < 4; ++m) rsv[ai][m] = ss[row0 + ai * HALF + m * 16];
#pragma unroll
        for (int ai = 0; ai < 2; ++ai)
#pragma unroll
            for (int m = 0; m < 4; ++m) { const int row = row0 + ai * HALF + m * 16; const float rs = __builtin_amdgcn_rsqf(rsv[ai][m] * (1.0f / DM_) + RMS_EPS_); const size_t o = (size_t)row * ff + col0;
#pragma unroll
                for (int bj = 0; bj < 2; ++bj) { const f32x4 v0 = acc[ai][bj][m][0] * rs, v1 = acc[ai][bj][m][1] * rs;
                    u32x4 w; w.x = cvt_pk_bf16(v0[0], v0[1]); w.y = cvt_pk_bf16(v0[2], v0[3]); w.z = cvt_pk_bf16(v1[0], v1[1]); w.w = cvt_pk_bf16(v1[2], v1[3]);
                    *(u32x4*)((bj == 0 ? U : UP) + o) = w; } }
    }
};
}

#define LAS __attribute__((address_space(3)))
__device__ __forceinline__ void transpose_item(const float* __restrict__ W, int K, int N, bf16_t* __restrict__ Wt, const float* __restrict__ g, int mode, float* scr, int item, int lane) {
    const int nblk = N / 32, kb = item / nblk, nb = item % nblk, k0 = 64 * kb, n0 = 32 * nb;
    int np0 = n0; if (mode == 1) np0 = 256 * (n0 / 128) + (n0 % 128); else if (mode == 2) np0 = 256 * (n0 / 128) + 128 + (n0 % 128);
#pragma unroll 8
    for (int i = 0; i < 32; ++i) { const int kk = 2 * i + (lane >> 5); scr[kk * 33 + (lane & 31)] = W[(size_t)(k0 + kk) * N + n0 + (lane & 31)] * (g ? g[k0 + kk] : 1.f); }
    __builtin_amdgcn_fence(__ATOMIC_RELEASE, "wavefront"); __builtin_amdgcn_wave_barrier(); __builtin_amdgcn_fence(__ATOMIC_ACQUIRE, "wavefront");
    const int c = lane & 7;
#pragma unroll
    for (int j = 0; j < 4; ++j) { const int n = (lane >> 3) + 8 * j; const float* sp = scr + (8 * c) * 33 + n;
        uint4 o; o.x = f2bf(sp[0]) | (f2bf(sp[33]) << 16); o.y = f2bf(sp[2 * 33]) | (f2bf(sp[3 * 33]) << 16); o.z = f2bf(sp[4 * 33]) | (f2bf(sp[5 * 33]) << 16); o.w = f2bf(sp[6 * 33]) | (f2bf(sp[7 * 33]) << 16);
        *(uint4*)(Wt + (size_t)(np0 + n) * K + k0 + 8 * c) = o; }
    __builtin_amdgcn_fence(__ATOMIC_RELEASE, "wavefront"); __builtin_amdgcn_wave_barrier(); __builtin_amdgcn_fence(__ATOMIC_ACQUIRE, "wavefront");
}
__device__ __forceinline__ void x_row_to_bf16(const float* __restrict__ x, bf16_t* __restrict__ xb, float* __restrict__ ss, int row, int lane) {
    const f32x4* xr = (const f32x4*)(x + (size_t)row * D) + lane; float s = 0.f;
#pragma unroll
    for (int j = 0; j < 4; ++j) { const f32x4 v = xr[64 * j]; s += v.x * v.x + v.y * v.y + v.z * v.z + v.w * v.w;
        unsigned long long o = (unsigned long long)(f2bf(v.x) | (f2bf(v.y) << 16)) | ((unsigned long long)(f2bf(v.z) | (f2bf(v.w) << 16)) << 32);
        ((unsigned long long*)(xb + (size_t)row * D))[lane + 64 * j] = o; }
    s = wave_sum(s); if (lane == 0) ss[row] = s;
}

struct EpArgs {
    const float* ss; float* ss_out; const float* base; float* xout; bf16_t* ob; bf16_t* ob2; int ldo; int row_off;
};
template <int MODE>
__device__ __forceinline__ void gemm_simple(const bf16_t* __restrict__ A, int lda, const bf16_t* __restrict__ Bt, int ldb, int Mrows, int N, int K, EpArgs e, int tid) {
    const int wid = tid >> 6, lane = tid & 63, fr = lane & 15, fq = lane >> 4;
    const int ntn = N / 128, ntiles = (Mrows / 64) * ntn;
    for (int tile = blockIdx.x; tile < ntiles; tile += gridDim.x) {
    const int row0 = (tile / ntn) * 64 + (wid >> 2) * 32, col0 = (tile % ntn) * 128 + (wid & 3) * 32;
    f32x4 acc[2][2];
#pragma unroll
    for (int i = 0; i < 2; ++i)
#pragma unroll
        for (int j = 0; j < 2; ++j) acc[i][j] = (f32x4){0.f, 0.f, 0.f, 0.f};
    const bf16_t* ap = A + (size_t)(row0 + fr) * lda + fq * 8;
    const bf16_t* bp = Bt + (size_t)(col0 + fr) * ldb + fq * 8;
    for (int k0 = 0; k0 < K; k0 += 32) {
        bf16x8 a[2], b[2];
#pragma unroll
        for (int i = 0; i < 2; ++i) { a[i] = *(const bf16x8*)(ap + (size_t)i * 16 * lda + k0); b[i] = *(const bf16x8*)(bp + (size_t)i * 16 * ldb + k0); }
#pragma unroll
        for (int i = 0; i < 2; ++i)
#pragma unroll
            for (int j = 0; j < 2; ++j) acc[i][j] = __builtin_amdgcn_mfma_f32_16x16x32_bf16(a[i], b[j], acc[i][j], 0, 0, 0);
    }
#pragma unroll
    for (int i = 0; i < 2; ++i)
#pragma unroll
        for (int r = 0; r < 4; ++r) {
            const int row = row0 + i * 16 + fq * 4 + r;
            float rstd = 1.f;
            if (MODE == 0 || MODE == 2) rstd = rsqrtf(e.ss[row] * (1.f / D) + RMS_EPS);
            float sq = 0.f;
#pragma unroll
            for (int j = 0; j < 2; ++j) {
                const int col = col0 + j * 16 + fr; const float v = acc[i][j][r];
                if (MODE == 0) e.ob[(size_t)row * e.ldo + col] = (bf16_t)f2bf(v * rstd);
                else if (MODE == 1) { const size_t o = (size_t)row * D + col; const float x = e.base[o] + v; e.xout[o] = x; e.ob[o] = (bf16_t)f2bf(x); sq += x * x; }
                else { const int p = col >> 8, jj = col & 255; const size_t o = (size_t)(row - e.row_off) * FF + 128 * p + (jj & 127);
                    if (jj < 128) e.ob[o] = (bf16_t)f2bf(v * rstd); else e.ob2[o] = (bf16_t)f2bf(v * rstd); }
            }
            if (MODE == 1) {
                sq += __shfl_xor(sq, 1); sq += __shfl_xor(sq, 2); sq += __shfl_xor(sq, 4); sq += __shfl_xor(sq, 8);
                if (fr == 0) atomicAdd(e.ss_out + row, sq);
            }
        }
    }
}

struct PrepArgs {
    const bf16_t* proj; const float* mu; const float* w0; const float* w2; const float* a0; const float* a2; const float* g2;
    const float* v0; const float* v1; const float* v2; bf16_t* vfirst; int layer; int pad;
    bf16_t *R, *K, *V, *A, *LD, *G;
};
__device__ __forceinline__ void prep_group(const PrepArgs& p, float (*rest)[SHIFT_W], float (*vlo)[32], int grp, int tid) {
    const int m0 = grp * 4;
    for (int i = tid; i < 4 * SHIFT_W; i += 512) {
        const int tk = i / SHIFT_W, c = i % SHIFT_W, m = m0 + tk, t = m % SEQ;
        const float u = bf2f(p.proj[(size_t)m * IN_W + ATT_IN + c]);
        const float up = t > 0 ? bf2f(p.proj[(size_t)(m - 1) * IN_W + ATT_IN + c]) : 0.f;
        float v = u + (up - u) * p.mu[c];
        if (c >= 1536 && c < 1600) v = tanhf(v); else if (c >= 1664) v = sigmoidf_(v);
        rest[tk][c] = v;
    }
    __syncthreads();
    if (p.layer > 0 && tid < 128) { const int tk = tid >> 5, j = tid & 31; float s = 0.f; for (int c = 0; c < C; ++c) s += rest[tk][1024 + c] * p.v1[c * 32 + j]; vlo[tk][j] = s; }
    __syncthreads();
    const int c = tid;
    float wp[4], ap[4], gp[4];
#pragma unroll
    for (int tk = 0; tk < 4; ++tk) { wp[tk] = p.w0[c]; ap[tk] = p.a0[c]; gp[tk] = 0.f; }
    for (int k = 0; k < 64; ++k) { const float w = p.w2[k * C + c], a = p.a2[k * C + c];
#pragma unroll
        for (int tk = 0; tk < 4; ++tk) { wp[tk] += rest[tk][1536 + k] * w; ap[tk] += rest[tk][1600 + k] * a; } }
    for (int k = 0; k < 128; ++k) { const float g = p.g2[k * C + c];
#pragma unroll
        for (int tk = 0; tk < 4; ++tk) gp[tk] += rest[tk][1664 + k] * g; }
#pragma unroll
    for (int tk = 0; tk < 4; ++tk) {
        const size_t o = (size_t)(m0 + tk) * C + c;
        const float x = -wp[tk];
        const float sp = fmaxf(x, 0.f) + log1pf(__expf(-fabsf(x)));
        const float wraw = -sp - 0.5f;
        const float ld = -__expf(wraw);
        const float a = sigmoidf_(ap[tk]);
        float v = rest[tk][1024 + c];
        if (p.layer == 0) p.vfirst[o] = (bf16_t)f2bf(v);
        else { float s = p.v0[c]; for (int j = 0; j < 32; ++j) s += vlo[tk][j] * p.v2[j * C + c]; const float vf = bf2f(p.vfirst[o]); v = v + (vf - v) * sigmoidf_(s); }
        p.R[o] = (bf16_t)f2bf(rest[tk][c]); p.K[o] = (bf16_t)f2bf(rest[tk][512 + c]); p.V[o] = (bf16_t)f2bf(v);
        p.A[o] = (bf16_t)f2bf(a); p.LD[o] = (bf16_t)f2bf(ld); p.G[o] = (bf16_t)f2bf(gp[tk]);
    }
    __syncthreads();
}

constexpr size_t WS_LORA = 50 * MiB;
constexpr size_t LORA_LAYER = 256 * 1024, WS_V1T = WS_LORA + 2 * LORA_LAYER, WS_V2T = WS_V1T + 32 * 1024;
constexpr int PR_ACT_LD = 264, PR_VLO_LD = 40, PR_SG_LD = 520, PR_ACT_OFF = 0, PR_VLO_OFF = 64 * PR_ACT_LD * 2, PR_SG_OFF = PR_VLO_OFF + 64 * PR_VLO_LD * 2;
struct Prep2Args {
    const bf16_t* proj; const float* mu; const float* w0; const float* a0; const float* v0;
    const bf16_t *W2T, *A2T, *G2T, *V1T, *V2T; bf16_t* vfirst; bf16_t *R, *K, *V, *A, *LD, *G; int layer; int pad;
};
__device__ __forceinline__ f32x4 bfx4_lo(const bf16x8 v) { return (f32x4){bf2f((bf16_t)v[0]), bf2f((bf16_t)v[1]), bf2f((bf16_t)v[2]), bf2f((bf16_t)v[3])}; }
__device__ __forceinline__ f32x4 bfx4_hi(const bf16x8 v) { return (f32x4){bf2f((bf16_t)v[4]), bf2f((bf16_t)v[5]), bf2f((bf16_t)v[6]), bf2f((bf16_t)v[7])}; }
__device__ __forceinline__ bf16x8 pack8(const f32x4 a, const f32x4 b) { pg8::u32x4 w; w.x = pg8::cvt_pk_bf16(a[0], a[1]); w.y = pg8::cvt_pk_bf16(a[2], a[3]); w.z = pg8::cvt_pk_bf16(b[0], b[1]); w.w = pg8::cvt_pk_bf16(b[2], b[3]); return __builtin_bit_cast(bf16x8, w); }
__device__ __forceinline__ void shift8(const bf16_t* __restrict__ proj, const float* __restrict__ mu, size_t m, int t, int col, int mi, f32x4& lo, f32x4& hi) {
    const bf16x8 cur = *(const bf16x8*)(proj + m * IN_W + col);
    bf16x8 prv; if (t > 0) prv = *(const bf16x8*)(proj + (m - 1) * IN_W + col); else prv = (bf16x8){0, 0, 0, 0, 0, 0, 0, 0};
    const f32x4 m0 = *(const f32x4*)(mu + mi), m1 = *(const f32x4*)(mu + mi + 4);
    const f32x4 c0 = bfx4_lo(cur), c1 = bfx4_hi(cur), p0 = bfx4_lo(prv), p1 = bfx4_hi(prv);
    lo = c0 + (p0 - c0) * m0; hi = c1 + (p1 - c1) * m1;
}
__device__ __forceinline__ void prep_tile(const Prep2Args& p, unsigned char* lds, int tile, int tid) {
    const int m0 = tile * 64, wave = __builtin_amdgcn_readfirstlane(tid >> 6), lane = tid & 63, fr = lane & 15, fq = lane >> 4;
    bf16_t* ACT = (bf16_t*)(lds + PR_ACT_OFF); bf16_t* VLO = (bf16_t*)(lds + PR_VLO_OFF); bf16_t* SG = (bf16_t*)(lds + PR_SG_OFF);
#pragma unroll
    for (int it = 0; it < 4; ++it) { const int i = tid + 512 * it, tk = i >> 5, cc = i & 31; const size_t m = (size_t)m0 + tk; const int t = (int)(m % SEQ);
        f32x4 lo, hi; shift8(p.proj, p.mu, m, t, 2304 + 8 * cc, 1536 + 8 * cc, lo, hi);
        if (cc < 8) {
#pragma unroll
            for (int e = 0; e < 4; ++e) { lo[e] = 2.f * sigmoidf_(2.f * lo[e]) - 1.f; hi[e] = 2.f * sigmoidf_(2.f * hi[e]) - 1.f; } }
        else if (cc >= 16) {
#pragma unroll
            for (int e = 0; e < 4; ++e) { lo[e] = sigmoidf_(lo[e]); hi[e] = sigmoidf_(hi[e]); } }
        *(bf16x8*)(ACT + tk * PR_ACT_LD + 8 * cc) = pack8(lo, hi); }
    if (p.layer > 0) {
        const int tb = wave >> 1, jb = wave & 1; const size_t m = (size_t)m0 + 16 * tb + fr; const int t = (int)(m % SEQ);
        f32x4 acc = (f32x4){0.f, 0.f, 0.f, 0.f};
#pragma unroll 4
        for (int ks = 0; ks < 16; ++ks) { f32x4 lo, hi; shift8(p.proj, p.mu, m, t, 1792 + 32 * ks + 8 * fq, 1024 + 32 * ks + 8 * fq, lo, hi);
            const bf16x8 wf = *(const bf16x8*)(p.V1T + (size_t)(16 * jb + fr) * C + 32 * ks + 8 * fq);
            acc = __builtin_amdgcn_mfma_f32_16x16x32_bf16(wf, pack8(lo, hi), acc, 0, 0, 0); }
        uint2 w; w.x = pg8::cvt_pk_bf16(acc[0], acc[1]); w.y = pg8::cvt_pk_bf16(acc[2], acc[3]);
        *(uint2*)(VLO + (16 * tb + fr) * PR_VLO_LD + 16 * jb + 4 * fq) = w;
    }
    __syncthreads();
    const int ch0 = 64 * wave;
#pragma unroll
    for (int arr = 0; arr < 3; ++arr) {
        const int K0 = arr == 0 ? 0 : (arr == 1 ? 64 : 128), KL = arr == 2 ? 128 : 64; const bf16_t* WT = arr == 0 ? p.W2T : (arr == 1 ? p.A2T : p.G2T);
        f32x4 acc[4][4];
#pragma unroll
        for (int tb = 0; tb < 4; ++tb)
#pragma unroll
            for (int cb = 0; cb < 4; ++cb) acc[tb][cb] = (f32x4){0.f, 0.f, 0.f, 0.f};
#pragma unroll
        for (int ks = 0; ks < KL / 32; ++ks) { bf16x8 wf[4], af[4];
#pragma unroll
            for (int cb = 0; cb < 4; ++cb) wf[cb] = *(const bf16x8*)(WT + (size_t)(ch0 + 16 * cb + fr) * KL + 32 * ks + 8 * fq);
#pragma unroll
            for (int tb = 0; tb < 4; ++tb) af[tb] = *(const bf16x8*)(ACT + (16 * tb + fr) * PR_ACT_LD + K0 + 32 * ks + 8 * fq);
#pragma unroll
            for (int tb = 0; tb < 4; ++tb)
#pragma unroll
                for (int cb = 0; cb < 4; ++cb) acc[tb][cb] = __builtin_amdgcn_mfma_f32_16x16x32_bf16(wf[cb], af[tb], acc[tb][cb], 0, 0, 0); }
        bf16_t* OUT = arr == 0 ? p.LD : (arr == 1 ? p.A : p.G);
#pragma unroll
        for (int cb = 0; cb < 4; ++cb) { const int ch = ch0 + 16 * cb + 4 * fq;
            f32x4 bias = (f32x4){0.f, 0.f, 0.f, 0.f}; if (arr == 0) bias = *(const f32x4*)(p.w0 + ch); else if (arr == 1) bias = *(const f32x4*)(p.a0 + ch);
#pragma unroll
            for (int tb = 0; tb < 4; ++tb) { f32x4 x = acc[tb][cb] + bias;
                if (arr == 0) {
#pragma unroll
                    for (int e = 0; e < 4; ++e) { const float z = -x[e]; const float sp = fmaxf(z, 0.f) + __logf(1.f + __expf(-fabsf(z))); x[e] = -__expf(-sp - 0.5f); } }
                else if (arr == 1) {
#pragma unroll
                    for (int e = 0; e < 4; ++e) x[e] = sigmoidf_(x[e]); }
                uint2 w; w.x = pg8::cvt_pk_bf16(x[0], x[1]); w.y = pg8::cvt_pk_bf16(x[2], x[3]);
                *(uint2*)(OUT + ((size_t)m0 + 16 * tb + fr) * C + ch) = w; } }
    }
    if (p.layer > 0) {
        bf16x8 af[4];
#pragma unroll
        for (int tb = 0; tb < 4; ++tb) af[tb] = *(const bf16x8*)(VLO + (16 * tb + fr) * PR_VLO_LD + 8 * fq);
#pragma unroll
        for (int cb = 0; cb < 4; ++cb) { const int ch = ch0 + 16 * cb + 4 * fq; const bf16x8 wf = *(const bf16x8*)(p.V2T + (size_t)(ch0 + 16 * cb + fr) * 32 + 8 * fq); const f32x4 bias = *(const f32x4*)(p.v0 + ch);
#pragma unroll
            for (int tb = 0; tb < 4; ++tb) { f32x4 x = __builtin_amdgcn_mfma_f32_16x16x32_bf16(wf, af[tb], (f32x4){0.f, 0.f, 0.f, 0.f}, 0, 0, 0) + bias;
                uint2 w; w.x = pg8::cvt_pk_bf16(sigmoidf_(x[0]), sigmoidf_(x[1])); w.y = pg8::cvt_pk_bf16(sigmoidf_(x[2]), sigmoidf_(x[3]));
                *(uint2*)(SG + (16 * tb + fr) * PR_SG_LD + ch) = w; } }
    }
    __syncthreads();
#pragma unroll
    for (int sec = 0; sec < 3; ++sec) { bf16_t* OUT = sec == 0 ? p.R : (sec == 1 ? p.K : p.V);
#pragma unroll 4
        for (int it = 0; it < 8; ++it) { const int i = tid + 512 * it, tk = i >> 6, cc = i & 63; const size_t m = (size_t)m0 + tk; const int t = (int)(m % SEQ);
            f32x4 lo, hi; shift8(p.proj, p.mu, m, t, 768 + 512 * sec + 8 * cc, 512 * sec + 8 * cc, lo, hi);
            const size_t o = m * C + 8 * cc;
            if (sec == 2) {
                if (p.layer == 0) *(bf16x8*)(p.vfirst + o) = pack8(lo, hi);
                else { const bf16x8 vf = *(const bf16x8*)(p.vfirst + o), sg = *(const bf16x8*)(SG + tk * PR_SG_LD + 8 * cc);
                    lo = lo + (bfx4_lo(vf) - lo) * bfx4_lo(sg); hi = hi + (bfx4_hi(vf) - hi) * bfx4_hi(sg); } }
            *(bf16x8*)(OUT + o) = pack8(lo, hi); } }
    __syncthreads();
}

constexpr int SC_TB = 32, SC_SLOT = 384, SC_NCH = SEQ / SC_TB;
constexpr int WS_RKC = 1 * (1 << 20);
struct ScanArgs { const bf16_t *R, *K, *V, *A, *LD, *G; const float *k_k, *k_a, *r_k, *lnx_g, *lnx_b; bf16_t* mix; float* rkc; };
template <int CTRL> __device__ __forceinline__ float dpp_mov(float x) { return __builtin_bit_cast(float, __builtin_amdgcn_update_dpp(0, __builtin_bit_cast(int, x), CTRL, 0xF, 0xF, true)); }
__device__ __forceinline__ float reduce16(float x) { x += dpp_mov<0xB1>(x); x += dpp_mov<0x4E>(x); x += dpp_mov<0x141>(x); x += dpp_mov<0x140>(x); return x; }
struct ScLdSet { bf16_t r[8], k[8], v[8], a[8], ld[8]; };
__device__ __forceinline__ void scan_item(const ScanArgs& p, float* lds, int item, int tid) {
    const int chain = item >> 2, q = item & 3, b = chain >> 3, h = chain & 7, wave = __builtin_amdgcn_readfirstlane(tid >> 6), lane = tid & 63;
    float* buf = lds;
    float* ybuf = lds + 2 * SC_TB * SC_SLOT;
    if (wave >= 4) {
        const int lw = wave - 4, ch = h * 64 + lane, lt = lw * 64 + lane;
        const float kk_c = p.k_k[ch], ka_c = p.k_a[ch], rk_c = p.r_k[ch];
        const size_t rowbase = (size_t)b * SEQ;
        ScLdSet s0, s1;
#define SC_LOAD(S, chunk) do { _Pragma("unroll") for (int i = 0; i < 8; ++i) { const size_t o = (rowbase + (size_t)(chunk) * SC_TB + lw + 4 * i) * C + ch; \
            S.r[i] = p.R[o]; S.k[i] = p.K[o]; S.v[i] = p.V[o]; S.a[i] = p.A[o]; S.ld[i] = p.LD[o]; } } while (0)
#define SC_PROC(S, chunk, bi) do { _Pragma("unroll") for (int i = 0; i < 8; ++i) { const int st = lw + 4 * i; \
            const float r = bf2f(S.r[i]), k = bf2f(S.k[i]), v = bf2f(S.v[i]), a = bf2f(S.a[i]), ld = bf2f(S.ld[i]); \
            float kk = k * kk_c; const float nrm = sqrtf(wave_sum(kk * kk)); kk = kk / fmaxf(nrm, 1e-12f); \
            const float kp = k * (1.f + (a - 1.f) * ka_c); const float rkc = wave_sum(r * kp * rk_c); \
            float* slot = buf + ((bi) * SC_TB + st) * SC_SLOT + lane; \
            slot[0] = __expf(ld); slot[64] = -kk; slot[128] = kk * a; slot[192] = kp; slot[256] = r; slot[320] = v; \
            if (q == 0 && lane == 0) p.rkc[(rowbase + (size_t)(chunk) * SC_TB + st) * 8 + h] = rkc; } } while (0)
#define SC_YOUT(chunk, bi) do { _Pragma("unroll") for (int e2 = 0; e2 < 2; ++e2) { const int e = lt + 256 * e2, st = e >> 4, rr = e & 15; \
            p.mix[(rowbase + (size_t)(chunk) * SC_TB + st) * D + ATT_W + h * 64 + 16 * q + rr] = (bf16_t)f2bf(ybuf[(bi) * SC_TB * 16 + e]); } } while (0)
        SC_LOAD(s0, 0); SC_LOAD(s1, 1); SC_PROC(s0, 0, 0);
        __syncthreads();
        for (int c = 0; c < SC_NCH; c += 2) {
            if (c + 2 < SC_NCH) SC_LOAD(s0, c + 2);
            SC_PROC(s1, c + 1, 1);
            if (c >= 1) SC_YOUT(c - 1, 1);
            __syncthreads();
            if (c + 3 < SC_NCH) SC_LOAD(s1, c + 3);
            if (c + 2 < SC_NCH) SC_PROC(s0, c + 2, 0);
            SC_YOUT(c, 0);
            __syncthreads();
        }
        SC_YOUT(SC_NCH - 1, 1);
#undef SC_LOAD
#undef SC_PROC
#undef SC_YOUT
    } else {
        const int cg4 = (lane & 15) * 4, rloc = 4 * wave + (lane >> 4);
        float S0 = 0.f, S1 = 0.f, S2 = 0.f, S3 = 0.f;
#define SC_SCAN(bi) do { const float* bp = buf + (bi) * SC_TB * SC_SLOT + cg4; const float* vp = buf + (bi) * SC_TB * SC_SLOT + 320 + 16 * q + rloc; float* yp = ((lane & 15) == 0) ? (ybuf + (bi) * SC_TB * 16 + rloc) : (ybuf + 2 * SC_TB * 16 + lane);     \
            _Pragma("unroll") for (int st = 0; st < SC_TB; ++st) { \
                const f32x4 w = *(const f32x4*)(bp + st * SC_SLOT), A = *(const f32x4*)(bp + st * SC_SLOT + 64), B = *(const f32x4*)(bp + st * SC_SLOT + 128), kp = *(const f32x4*)(bp + st * SC_SLOT + 192), r = *(const f32x4*)(bp + st * SC_SLOT + 256); \
                const float v = vp[st * SC_SLOT]; \
                float sa = (S0 * A.x + S1 * A.y) + (S2 * A.z + S3 * A.w); sa = reduce16(sa); \
                S0 = S0 * w.x + (sa * B.x + v * kp.x); S1 = S1 * w.y + (sa * B.y + v * kp.y); S2 = S2 * w.z + (sa * B.z + v * kp.z); S3 = S3 * w.w + (sa * B.w + v * kp.w); \
                float y = (S0 * r.x + S1 * r.y) + (S2 * r.z + S3 * r.w); y = reduce16(y); \
                yp[st * 16] = y; } } while (0)
        __syncthreads();
        for (int c = 0; c < SC_NCH; c += 2) { SC_SCAN(0); __syncthreads(); SC_SCAN(1); __syncthreads(); }
#undef SC_SCAN
    }
    __syncthreads();
}
__device__ __forceinline__ void scan_post(const ScanArgs& p, int idx, int lane) {
    const int m = idx >> 3, h = idx & 7, ch = h * 64 + lane; const size_t o = (size_t)m * C + ch, om = (size_t)m * D + ATT_W + ch;
    const float y = bf2f(p.mix[om]);
    const float mean = wave_sum(y) * (1.f / 64.f); const float d = y - mean; const float var = wave_sum(d * d) * (1.f / 64.f);
    const float yn = d * rsqrtf(var + LNX_EPS) * p.lnx_g[ch] + p.lnx_b[ch];
    p.mix[om] = (bf16_t)f2bf((yn + p.rkc[(size_t)m * 8 + h] * bf2f(p.V[o])) * bf2f(p.G[o]));
}

typedef float f32x16 __attribute__((ext_vector_type(16)));
typedef short s16x4 __attribute__((ext_vector_type(4)));
constexpr int AT_VTS = 196;
__device__ __forceinline__ int crow(int r, int hi) { return (r & 3) + 8 * (r >> 2) + 4 * hi; }
__device__ __forceinline__ void attn_unit(const bf16_t* __restrict__ proj, const float* __restrict__ sinks, bf16_t* __restrict__ mix, bf16_t* vt, int unit, int tid) {
    const int b = unit >> 7, kvh = (unit >> 6) & 1, qb = unit & 63, Q0 = qb * 64;
    const int wave = __builtin_amdgcn_readfirstlane(tid >> 6), lane = tid & 63, c = lane & 31, hi = lane >> 5, g = wave >> 1, half = wave & 1, h = kvh * 4 + g;
    const size_t rowb = (size_t)b * SEQ;
    for (int i = tid; i < 192 * 8; i += 512) { const int kl = i >> 3, ch8 = i & 7; int key = Q0 - 128 + kl; key = key < 0 ? 0 : key;
        const bf16x8 v = *(const bf16x8*)(proj + (rowb + key) * IN_W + 640 + kvh * 64 + ch8 * 8);
#pragma unroll
        for (int e = 0; e < 8; ++e) vt[(ch8 * 8 + e) * AT_VTS + kl] = (bf16_t)v[e]; }
    __syncthreads();
    const int t0 = Q0 + 32 * half; const size_t mq = rowb + t0 + c;
    bf16x8 qf[4];
#pragma unroll
    for (int ks = 0; ks < 4; ++ks) qf[ks] = *(const bf16x8*)(proj + mq * IN_W + h * 64 + 16 * ks + 8 * hi);
    f32x16 p[5];
#pragma unroll
    for (int kb = 0; kb < 5; ++kb) { int key = t0 - 128 + 32 * kb + c; key = key < 0 ? 0 : key; const bf16_t* kp = proj + (rowb + key) * IN_W + 512 + kvh * 64 + 8 * hi;
        f32x16 acc;
#pragma unroll
        for (int r = 0; r < 16; ++r) acc[r] = 0.f;
#pragma unroll
        for (int ks = 0; ks < 4; ++ks) acc = __builtin_amdgcn_mfma_f32_32x32x16_bf16(*(const bf16x8*)(kp + 16 * ks), qf[ks], acc, 0, 0, 0);
        p[kb] = acc; }
    const float slope = exp2f(-(float)(h + 1)), sink = sinks[h];
    float mx = sink;
#pragma unroll
    for (int kb = 0; kb < 5; ++kb)
#pragma unroll
        for (int r = 0; r < 16; ++r) { const int cr = crow(r, hi), dist = c + 128 - 32 * kb - cr, key = t0 - 128 + 32 * kb + cr;
            const float sc = (dist >= 0 && dist < WINDOW && key >= 0) ? p[kb][r] * 0.125f - slope * (float)dist : -1e30f; p[kb][r] = sc; mx = fmaxf(mx, sc); }
    mx = fmaxf(mx, __shfl_xor(mx, 32));
    float l = 0.f;
#pragma unroll
    for (int kb = 0; kb < 5; ++kb)
#pragma unroll
        for (int r = 0; r < 16; ++r) { const float e = __expf(p[kb][r] - mx); p[kb][r] = e; l += e; }
    l += __shfl_xor(l, 32); l += __expf(sink - mx);
    f32x16 o[2];
#pragma unroll
    for (int d = 0; d < 2; ++d)
#pragma unroll
        for (int r = 0; r < 16; ++r) o[d][r] = 0.f;
#pragma unroll
    for (int kb = 0; kb < 5; ++kb)
#pragma unroll
        for (int s2 = 0; s2 < 2; ++s2) {
            pg8::u32x4 pw; pw.x = pg8::cvt_pk_bf16(p[kb][8 * s2 + 0], p[kb][8 * s2 + 1]); pw.y = pg8::cvt_pk_bf16(p[kb][8 * s2 + 2], p[kb][8 * s2 + 3]);
            pw.z = pg8::cvt_pk_bf16(p[kb][8 * s2 + 4], p[kb][8 * s2 + 5]); pw.w = pg8::cvt_pk_bf16(p[kb][8 * s2 + 6], p[kb][8 * s2 + 7]);
            const bf16x8 pf = __builtin_bit_cast(bf16x8, pw);
#pragma unroll
            for (int d = 0; d < 2; ++d) { const bf16_t* vp = vt + (32 * d + c) * AT_VTS + 32 * half + 32 * kb + 16 * s2 + 4 * hi;
                const s16x4 lo = *(const s16x4*)vp, hh = *(const s16x4*)(vp + 8);
                const bf16x8 vf = (bf16x8){lo[0], lo[1], lo[2], lo[3], hh[0], hh[1], hh[2], hh[3]};
                o[d] = __builtin_amdgcn_mfma_f32_32x32x16_bf16(vf, pf, o[d], 0, 0, 0); } }
    const float inv = 1.f / l;
#pragma unroll
    for (int d = 0; d < 2; ++d)
#pragma unroll
        for (int rg = 0; rg < 4; ++rg) { uint2 w; w.x = pg8::cvt_pk_bf16(o[d][4 * rg] * inv, o[d][4 * rg + 1] * inv); w.y = pg8::cvt_pk_bf16(o[d][4 * rg + 2] * inv, o[d][4 * rg + 3] * inv);
            *(uint2*)(mix + mq * D + h * 64 + 32 * d + 8 * rg + 4 * hi) = w; }
    __syncthreads();
}

__device__ __forceinline__ void conv_item(const bf16_t* __restrict__ U, const bf16_t* __restrict__ UP, const float* __restrict__ cw, const float* __restrict__ cb, bf16_t* __restrict__ hid, size_t i) {
    const int t = (int)(i / FF), j = (int)(i % FF);
    const float u0 = bf2f(U[i]), u1 = t >= 1 ? bf2f(U[i - FF]) : 0.f, u2 = t >= 2 ? bf2f(U[i - 2 * FF]) : 0.f;
    const float c = cb[j] + cw[j] * u2 + cw[FF + j] * u1 + cw[2 * FF + j] * u0;
    hid[i] = (bf16_t)f2bf(c * sigmoidf_(c) * bf2f(UP[i]));
}

__device__ __forceinline__ void final_row(float* __restrict__ x, const float* __restrict__ ss, const float* __restrict__ g, int row, int lane) {
    const float rstd = rsqrtf(ss[row] * (1.f / D) + RMS_EPS);
    f32x4* xr = (f32x4*)(x + (size_t)row * D) + lane; const f32x4* gr = (const f32x4*)g + lane;
#pragma unroll
    for (int j = 0; j < 4; ++j) { f32x4 v = xr[64 * j]; const f32x4 gg = gr[64 * j]; v.x *= rstd * gg.x; v.y *= rstd * gg.y; v.z *= rstd * gg.z; v.w *= rstd * gg.w; xr[64 * j] = v; }
}

constexpr int NTHREADS = 512, LDS_BYTES = 147456;
struct Args { const float* in[26]; float* out; unsigned char* ws; };
__global__ void __launch_bounds__(NTHREADS, 2) mega_fwd(Args a) {
    extern __shared__ __attribute__((aligned(16))) unsigned char lds[];
    cg::grid_group grid = cg::this_grid();
#define GRID_SYNC() grid.sync()
#define LDSP ((PG8_LAS unsigned char*)lds)
#define OTID() ({ int _t = threadIdx.x; asm volatile("" : "+v"(_t)); _t; })
    const int G = gridDim.x, NGW = G * 8;
    const float* x = a.in[0]; const float* norm1_g = a.in[1]; const float* w_in = a.in[2]; const float* sinks = a.in[3];
    const float* mu = a.in[4]; const float* w0 = a.in[5]; const float* w2 = a.in[6]; const float* a0 = a.in[7];
    const float* a2 = a.in[8]; const float* g2 = a.in[9]; const float* k_k = a.in[10]; const float* k_a = a.in[11];
    const float* r_k = a.in[12]; const float* lnx_g = a.in[13]; const float* lnx_b = a.in[14]; const float* v0 = a.in[15];
    const float* v1 = a.in[16]; const float* v2 = a.in[17]; const float* w_out = a.in[18]; const float* norm2_g = a.in[19];
    const float* wg = a.in[20]; const float* wu = a.in[21]; const float* conv_w = a.in[22]; const float* conv_b = a.in[23];
    const float* wd = a.in[24]; const float* final_g = a.in[25];
    unsigned char* ws = a.ws; float* X = a.out;
    float* ss = (float*)(ws + WS_SS);
    bf16_t* XB = (bf16_t*)(ws + WS_XB); bf16_t* PROJ = (bf16_t*)(ws + WS_PROJ); bf16_t* MIX = (bf16_t*)(ws + WS_MIX); bf16_t* HID = (bf16_t*)(ws + WS_HID); bf16_t* VF = (bf16_t*)(ws + WS_VFIRST);
    bf16_t* UT = (bf16_t*)(ws + WS_UTMP); bf16_t* UPT = UT + (size_t)SEQ * FF;

    {
        const int tid = OTID(), lane = tid & 63, wave = tid >> 6, gw = blockIdx.x * 8 + wave;
        float* scr = (float*)lds + wave * (64 * 33 + 16);
        constexpr int I_IN = (D / 64) * (IN_W / 32), I_OUT = (D / 64) * (D / 32), I_G = (D / 64) * (FF / 32), I_DN = (FF / 64) * (D / 32), I_LAYER = I_IN + I_OUT + 2 * I_G + I_DN;
        for (int it = gw; it < 2 * I_LAYER; it += NGW) {
            const int l = it / I_LAYER; int r = it % I_LAYER;
            bf16_t* wl = (bf16_t*)(ws + WS_W + l * W_LAYER); bf16_t* WinT = wl; bf16_t* WoutT = (bf16_t*)((char*)wl + W_IN_SZ); bf16_t* WguT = (bf16_t*)((char*)WoutT + W_OUT_SZ); bf16_t* WdT = (bf16_t*)((char*)WguT + W_GU_SZ);
            if (r < I_IN) { transpose_item(w_in + (size_t)l * D * IN_W, D, IN_W, WinT, norm1_g + l * D, 0, scr, r, lane); continue; } r -= I_IN;
            if (r < I_OUT) { transpose_item(w_out + (size_t)l * D * D, D, D, WoutT, nullptr, 0, scr, r, lane); continue; } r -= I_OUT;
            if (r < I_G) { transpose_item(wg + (size_t)l * D * FF, D, FF, WguT, norm2_g + l * D, 1, scr, r, lane); continue; } r -= I_G;
            if (r < I_G) { transpose_item(wu + (size_t)l * D * FF, D, FF, WguT, norm2_g + l * D, 2, scr, r, lane); continue; } r -= I_G;
            transpose_item(wd + (size_t)l * FF * D, FF, D, WdT, nullptr, 0, scr, r, lane);
        }
        {
            constexpr int I_W2 = 1 * (C / 32), I_G2 = 2 * (C / 32), I_V1 = (C / 64) * 1, I_L = 2 * I_W2 + I_G2;
            for (int it = gw; it < 2 * I_L + I_V1; it += NGW) {
                if (it < 2 * I_L) { const int l = it / I_L; int r = it % I_L; bf16_t* base = (bf16_t*)(ws + WS_LORA + l * LORA_LAYER);
                    if (r < I_W2) { transpose_item(w2 + (size_t)l * 64 * C, 64, C, base, nullptr, 0, scr, r, lane); continue; } r -= I_W2;
                    if (r < I_W2) { transpose_item(a2 + (size_t)l * 64 * C, 64, C, base + 512 * 64, nullptr, 0, scr, r, lane); continue; } r -= I_W2;
                    transpose_item(g2 + (size_t)l * 128 * C, 128, C, base + 2 * 512 * 64, nullptr, 0, scr, r, lane); }
                else transpose_item(v1, C, 32, (bf16_t*)(ws + WS_V1T), nullptr, 0, scr, it - 2 * I_L, lane);
            }
            bf16_t* V2T = (bf16_t*)(ws + WS_V2T);
            for (int i = blockIdx.x * NTHREADS + tid; i < 32 * C; i += G * NTHREADS) { const int j = i / C, ch = i % C; V2T[ch * 32 + j] = (bf16_t)f2bf(v2[i]); }
        }
        for (int m = gw; m < M; m += NGW) x_row_to_bf16(x, XB, ss, m, lane);
    }
    GRID_SYNC();
    for (int l = 0; l < 2; ++l) {
        bf16_t* wl = (bf16_t*)(ws + WS_W + l * W_LAYER); bf16_t* WinT = wl; bf16_t* WoutT = (bf16_t*)((char*)wl + W_IN_SZ); bf16_t* WguT = (bf16_t*)((char*)WoutT + W_OUT_SZ); bf16_t* WdT = (bf16_t*)((char*)WguT + W_GU_SZ);
        float* ss1 = ss + (size_t)(2 * l) * M; float* ss2 = ss + (size_t)(2 * l + 1) * M; float* ss3 = ss + (size_t)(2 * l + 2) * M;
        { pg8::Gemm g{XB, WinT, M, IN_W, D}; pg8::StaticOrder S; S.init(M, IN_W, G, (int)blockIdx.x); pg8::EpiScaleBf16 E{PROJ, IN_W, ss1};
          pg8::gemm_phase<pg8::EpiScaleBf16, pg8::StaticOrder, true, true>(LDSP, g, S, E); }
        GRID_SYNC();
        for (int unit = blockIdx.x; unit < BATCH * 2 * (SEQ / 64); unit += G) attn_unit(PROJ, sinks + l * NH, MIX, (bf16_t*)lds, unit, OTID());
        struct { bf16_t *R, *K, *V, *A, *LD, *G; } p; p.R = (bf16_t*)(ws + WS_SI_R); p.K = (bf16_t*)(ws + WS_SI_K); p.V = (bf16_t*)(ws + WS_SI_V); p.A = (bf16_t*)(ws + WS_SI_A); p.LD = (bf16_t*)(ws + WS_SI_LD); p.G = (bf16_t*)(ws + WS_SI_G);
        { Prep2Args q{}; q.proj = PROJ; q.mu = mu + l * SHIFT_W; q.w0 = w0 + l * C; q.a0 = a0 + l * C; q.v0 = v0;
          const bf16_t* lw = (const bf16_t*)(ws + WS_LORA + l * LORA_LAYER); q.W2T = lw; q.A2T = lw + 512 * 64; q.G2T = lw + 2 * 512 * 64; q.V1T = (const bf16_t*)(ws + WS_V1T); q.V2T = (const bf16_t*)(ws + WS_V2T);
          q.vfirst = VF; q.R = p.R; q.K = p.K; q.V = p.V; q.A = p.A; q.LD = p.LD; q.G = p.G; q.layer = l;
          for (int tile = blockIdx.x; tile < M / 64; tile += G) prep_tile(q, lds, tile, OTID()); }
        GRID_SYNC();
        { ScanArgs s{}; s.R = p.R; s.K = p.K; s.V = p.V; s.A = p.A; s.LD = p.LD; s.G = p.G; s.k_k = k_k + l * C; s.k_a = k_a + l * C; s.r_k = r_k + l * C; s.lnx_g = lnx_g + l * C; s.lnx_b = lnx_b + l * C; s.mix = MIX; s.rkc = (float*)(ws + WS_RKC);
          for (int item = (int)((blockIdx.x & 7) * (G >> 3) + (blockIdx.x >> 3)); item < BATCH * NH * 4; item += G) scan_item(s, (float*)lds, item, OTID());
          GRID_SYNC();
          { const int tid = OTID(), lane = tid & 63, gw = blockIdx.x * 8 + (tid >> 6); for (int idx = gw; idx < M * NH; idx += NGW) scan_post(s, idx, lane); } }
        GRID_SYNC();
        { pg8::Gemm g{MIX, WoutT, M, D, D}; pg8::StaticOrder S; S.init(M, D, G, (int)blockIdx.x); pg8::EpiResid E{(l == 0) ? x : X, X, XB, ss2};
          pg8::gemm_phase<pg8::EpiResid, pg8::StaticOrder, true, true>(LDSP, g, S, E); }
        GRID_SYNC();
        for (int b = 0; b < BATCH; ++b) {
            { pg8::Gemm g{XB + (size_t)b * SEQ * D, WguT, SEQ, 2 * FF, D}; pg8::StaticOrder S; S.init(SEQ, 2 * FF, G, (int)blockIdx.x); pg8::EpiGateUpTmp E{UT, UPT, ss2 + (size_t)b * SEQ, FF};
              pg8::gemm_phase<pg8::EpiGateUpTmp, pg8::StaticOrder, true, true>(LDSP, g, S, E); }
            GRID_SYNC();
            { const int tid = OTID();
            for (size_t i = (size_t)blockIdx.x * NTHREADS + tid; i < (size_t)SEQ * FF; i += (size_t)G * NTHREADS) conv_item(UT, UPT, conv_w + (size_t)l * 3 * FF, conv_b + (size_t)l * FF, HID + (size_t)b * SEQ * FF, i); }
            GRID_SYNC();
        }
        { pg8::Gemm g{HID, WdT, M, D, FF}; pg8::StaticOrder S; S.init(M, D, G, (int)blockIdx.x); pg8::EpiResid E{X, X, XB, ss3};
          pg8::gemm_phase<pg8::EpiResid, pg8::StaticOrder, true, true>(LDSP, g, S, E); }
        GRID_SYNC();
    }
    { const int tid = OTID(), lane = tid & 63, gw = blockIdx.x * 8 + (tid >> 6);
    for (int m = gw; m < M; m += NGW) final_row(X, ss + (size_t)4 * M, final_g, m, lane); }
}

extern "C" void kernel_launch(void* const* d_in, const int* in_sizes, int n_in, void* d_out, int out_size, void* d_ws, size_t ws_size, hipStream_t stream) {
    static int grid = 0;
    if (grid == 0) {
        if (n_in != 26 || in_sizes[0] != M * D || out_size != M * D || ws_size < WS_END) { fprintf(stderr, "kernel_launch: unexpected shapes (n_in %d, ws %zu)\n", n_in, ws_size); grid = -1; return; }
        int dev = 0, cus = 0, per_cu = 0;
        if (hipGetDevice(&dev) != hipSuccess || hipDeviceGetAttribute(&cus, hipDeviceAttributeMultiprocessorCount, dev) != hipSuccess) { grid = -1; return; }
        if (hipFuncSetAttribute((const void*)mega_fwd, hipFuncAttributeMaxDynamicSharedMemorySize, LDS_BYTES) != hipSuccess) { fprintf(stderr, "kernel_launch: hipFuncSetAttribute failed\n"); grid = -1; return; }
        if (hipOccupancyMaxActiveBlocksPerMultiprocessor(&per_cu, (const void*)mega_fwd, NTHREADS, LDS_BYTES) != hipSuccess || per_cu < 1) { fprintf(stderr, "kernel_launch: occupancy query failed (%d)\n", per_cu); grid = -1; return; }
        grid = cus;
    }
    if (grid < 0) return;
    (void)hipMemsetAsync((unsigned char*)d_ws + WS_CTL, 0, CTL_BYTES, stream);
    Args a{};
    for (int i = 0; i < 26; ++i) a.in[i] = (const float*)d_in[i];
    a.out = (float*)d_out; a.ws = (unsigned char*)d_ws;
    void* kargs[] = {&a};
    hipError_t e = hipLaunchCooperativeKernel((const void*)mega_fwd, dim3(grid), dim3(NTHREADS), kargs, LDS_BYTES, stream);
    if (e != hipSuccess) fprintf(stderr, "kernel_launch: cooperative launch failed: %s (grid %d)\n", hipGetErrorString(e), grid);
}
```

```cpp
#include <hip/hip_runtime.h>
#include <hip/hip_cooperative_groups.h>
namespace cg = cooperative_groups;
#include <cstdio>
#include <cstdint>

typedef unsigned short bf16_t;
typedef short bf16x8 __attribute__((ext_vector_type(8)));
typedef float f32x4 __attribute__((ext_vector_type(4)));

constexpr int BATCH = 8, SEQ = 4096, D = 1024, M = BATCH * SEQ;
constexpr int HD = 64, ATT_W = 512, KV_W = 128, C = 512, NH = 8;
constexpr int ATT_IN = 768, SHIFT_W = 1792, IN_W = 2560, FF = 2816;
constexpr int WINDOW = 128;
constexpr float RMS_EPS = 1e-5f, LNX_EPS = 64e-5f;

constexpr size_t MiB = 1u << 20;
constexpr size_t WS_CTL = 0;
constexpr size_t WS_SS = 0;
constexpr size_t CTL_BYTES = 1 * MiB;
constexpr size_t WS_W = 2 * MiB;
constexpr size_t W_IN_SZ = (size_t)IN_W * D * 2, W_OUT_SZ = (size_t)D * D * 2, W_GU_SZ = (size_t)2 * FF * D * 2, W_DN_SZ = (size_t)D * FF * 2;
constexpr size_t W_LAYER = W_IN_SZ + W_OUT_SZ + W_GU_SZ + W_DN_SZ;
constexpr size_t WS_VFIRST = 52 * MiB, WS_MIX = 84 * MiB, WS_XB = 148 * MiB, WS_PROJ = 212 * MiB;
constexpr size_t WS_SI_R = 148 * MiB, WS_SI_K = 180 * MiB, WS_SI_V = 372 * MiB, WS_SI_A = 404 * MiB, WS_SI_LD = 436 * MiB, WS_SI_G = 468 * MiB;
constexpr size_t WS_HID = 212 * MiB;
constexpr size_t WS_UTMP = 84 * MiB;
constexpr size_t WS_END = 500 * MiB;
static_assert(WS_W + 2 * W_LAYER <= WS_VFIRST, "weights fit");

__device__ __forceinline__ unsigned f2bf(float f) { unsigned u = __builtin_bit_cast(unsigned, f); return (u + 0x7fffu + ((u >> 16) & 1u)) >> 16; }
__device__ __forceinline__ float bf2f(bf16_t h) { return __builtin_bit_cast(float, (unsigned)h << 16); }
__device__ __forceinline__ float wave_sum(float v) {
#pragma unroll
    for (int o = 1; o < 64; o <<= 1) v += __shfl_xor(v, o);
    return v;
}
__device__ __forceinline__ float sigmoidf_(float x) { return 1.f / (1.f + __expf(-x)); }

namespace pg8 {
#define PG8_LAS __attribute__((address_space(3)))
typedef unsigned short bf16_t;
typedef short bf16x8 __attribute__((ext_vector_type(8)));
typedef float f32x4 __attribute__((ext_vector_type(4)));
typedef unsigned u32x4 __attribute__((ext_vector_type(4)));
constexpr int BM = 256, BK = 64, HALF = 128, HTB = HALF * BK * 2  , STAGE_BYTES = 8 * HTB, NXCD = 8, WGM = 8;

__host__ __device__ __forceinline__ int lds_byte(int r, int c) { const int st = (r >> 4) * 2 + (c >> 5), rr = r & 15, cc = c & 31, ob = rr * 64 + cc * 2; return st * 1024 + (ob ^ (((ob >> 9) & 1) << 5)); }
__host__ __device__ __forceinline__ void stage_rc(int b, int& R, int& C) { const int st = b / 1024, sb = b % 1024, swz = sb ^ (((sb >> 9) & 1) << 5); R = (st >> 1) * 16 + swz / 64; C = (st & 1) * 32 + (swz % 64) / 2; }
__host__ __device__ __forceinline__ int perm32(int rho) { const int n = rho >> 4, i = rho & 15; return 8 * (i >> 2) + 4 * n + (i & 3); }

struct Unit { int pm, pn; };
struct Gemm { const bf16_t* A; const bf16_t* Bt; int M, N, K; };

struct StaticOrder {
    int nM, nN, nwg, G, c;
    __host__ __device__ void init(int M, int N, int G_, int c_) { nM = M / BM; nN = N / BM; nwg = nM * nN; G = G_; c = c_; }
    __host__ __device__ bool next(int i, Unit& u) const {
        const long L = (long)i * G + c; if (L >= nwg) return false;
        int wgid = (int)L; { const int q = nwg / NXCD, r = nwg % NXCD, xcd = wgid % NXCD, off = wgid / NXCD; wgid = (xcd < r ? xcd * (q + 1) : r * (q + 1) + (xcd - r) * q) + off; }
        const int nig = WGM * nN, gid = wgid / nig, fm = gid * WGM, gsz = (nM - fm) < WGM ? (nM - fm) : WGM;
        u.pm = fm + ((wgid % nig) % gsz); u.pn = (wgid % nig) / gsz; return true;
    }
    __device__ __forceinline__ void a_ready(const Unit&) const {}
    __device__ __forceinline__ void done(const Unit&) const {}
};
typedef float f32x2_t_ __attribute__((ext_vector_type(2))); typedef __bf16 bf16x2_t_ __attribute__((ext_vector_type(2)));
__device__ __forceinline__ unsigned cvt_pk_bf16(float lo, float hi) { const f32x2_t_ v = {lo, hi}; const bf16x2_t_ b = __builtin_convertvector(v, bf16x2_t_); return __builtin_bit_cast(unsigned, b); }
typedef float f32x2 __attribute__((ext_vector_type(2)));
template <class Epi, class Sched, bool ALIGN_EPI = false, bool SP2 = false>
__device__ __forceinline__ void gemm_phase(PG8_LAS unsigned char* lds, const Gemm g, const Sched& S, const Epi& E) {
    int tid_ = threadIdx.x; asm volatile("" : "+v"(tid_));
    const int tid = tid_, wid = __builtin_amdgcn_readfirstlane(tid >> 6), lane = tid & 63, wr = wid >> 2, wc = wid & 3, fr = lane & 15, fq = lane >> 4;
    const int K = g.K, nt = K / BK;
    unsigned voffA[2], voffB[2];
#pragma unroll
    for (int i = 0; i < 2; ++i) { int R, C; stage_rc(tid * 16 + i * 8192, R, C); const int Rb = Epi::PERM ? ((R & ~31) + perm32(R & 31)) : R;
        voffA[i] = (unsigned)(R * K + C) * 2u; voffB[i] = (unsigned)(Rb * K + C) * 2u; }
    const size_t kstep = (size_t)(BK * 2);
    const size_t hstep = (size_t)HALF * K * 2;
    const size_t tstep = 2 * hstep;
    const unsigned ldsw = (unsigned)wid * 1024u;
    const int aoff = lds_byte(wr * 64 + fr, fq * 8), boff = lds_byte(wc * 32 + fr, fq * 8);
#define PG8_SA(b, h) (((b) * 2 + (h)) * HTB)
#define PG8_SB(b, h) ((4 + (b) * 2 + (h)) * HTB)
#define PG8_STAGE(bufoff, gbase, voff) do { _Pragma("unroll") for (int _i = 0; _i < 2; ++_i) \
        __builtin_amdgcn_global_load_lds((const unsigned*)((const char*)(gbase) + (voff)[_i]), (PG8_LAS unsigned*)(lds + (bufoff) + ldsw + _i * 8192), 16, 0, 0); } while (0)
#define PG8_LDA(dst, b, h) do { _Pragma("unroll") for (int m = 0; m < 4; ++m) _Pragma("unroll") for (int k = 0; k < 2; ++k) dst[m][k] = *(const PG8_LAS bf16x8*)(lds + PG8_SA(b, h) + aoff + m * 2048 + k * 1024); } while (0)
#define PG8_LDB(dst, b, h) do { _Pragma("unroll") for (int n = 0; n < 2; ++n) _Pragma("unroll") for (int k = 0; k < 2; ++k) dst[n][k] = *(const PG8_LAS bf16x8*)(lds + PG8_SB(b, h) + boff + n * 2048 + k * 1024); } while (0)
#define PG8_MMA(ai, bj, At, Bt) do { __builtin_amdgcn_s_setprio(1); _Pragma("unroll") for (int m = 0; m < 4; ++m) _Pragma("unroll") for (int n = 0; n < 2; ++n) _Pragma("unroll") for (int k = 0; k < 2; ++k) \
        acc[ai][bj][m][n] = __builtin_amdgcn_mfma_f32_16x16x32_bf16(Bt[n][k], At[m][k], acc[ai][bj][m][n], 0, 0, 0); __builtin_amdgcn_s_setprio(0); } while (0)
#define PG8_WAIT_V(n) asm volatile("s_waitcnt vmcnt(" #n ")" ::: "memory")
#define PG8_WAIT_L(n) asm volatile("s_waitcnt lgkmcnt(" #n ")" ::: "memory")
#define PG8_BAR __builtin_amdgcn_s_barrier()
#define PG8_SCHED __builtin_amdgcn_sched_barrier(0)
    Unit cur, nxt; int ui = 0;
    if (!S.next(0, cur)) return;
    f32x4 acc[2][2][4][2];
#pragma unroll
    for (int a = 0; a < 2; ++a)
#pragma unroll
        for (int b = 0; b < 2; ++b)
#pragma unroll
            for (int m = 0; m < 4; ++m)
#pragma unroll
                for (int n = 0; n < 2; ++n) acc[a][b][m][n] = (f32x4){0.f, 0.f, 0.f, 0.f};
    bf16x8 At[4][2], B0[2][2], B1[2][2];
    const char* cA = (const char*)g.A + (size_t)cur.pm * tstep; const char* cB = (const char*)g.Bt + (size_t)cur.pn * tstep;
    S.a_ready(cur);
    if constexpr (SP2) {
        PG8_STAGE(PG8_SB(0, 0), cB, voffB); PG8_STAGE(PG8_SB(0, 1), cB + hstep, voffB); PG8_STAGE(PG8_SA(0, 0), cA, voffA); PG8_STAGE(PG8_SA(0, 1), cA + hstep, voffA);
        if (wr == 1) PG8_BAR;
        PG8_WAIT_V(2); PG8_BAR;
        PG8_STAGE(PG8_SB(1, 0), cB + kstep, voffB); PG8_STAGE(PG8_SA(1, 0), cA + kstep, voffA); PG8_STAGE(PG8_SB(1, 1), cB + hstep + kstep, voffB);
        PG8_WAIT_V(6); PG8_BAR;
    } else {
        PG8_STAGE(PG8_SB(0, 0), cB, voffB); PG8_STAGE(PG8_SA(0, 0), cA, voffA); PG8_STAGE(PG8_SB(0, 1), cB + hstep, voffB); PG8_STAGE(PG8_SA(0, 1), cA + hstep, voffA);
        if (wr == 1) PG8_BAR;
        PG8_WAIT_V(4); PG8_BAR;
        PG8_STAGE(PG8_SB(1, 0), cB + kstep, voffB); PG8_STAGE(PG8_SA(1, 0), cA + kstep, voffA); PG8_STAGE(PG8_SB(1, 1), cB + hstep + kstep, voffB);
        PG8_WAIT_V(6); PG8_BAR;
    }
    for (;;) {
        const bool has_next = S.next(ui + 1, nxt);
        const char* nA = has_next ? (const char*)g.A + (size_t)nxt.pm * tstep : cA; const char* nB = has_next ? (const char*)g.Bt + (size_t)nxt.pn * tstep : cB;
        for (int t = 0; t < nt; t += 2) {
            const bool last = (t == nt - 2);
            const char* a1 = cA + (size_t)(t + 1) * kstep;
            const char* a2 = last ? nA : cA + (size_t)(t + 2) * kstep; const char* b2 = last ? nB : cB + (size_t)(t + 2) * kstep;
            const char* a3 = a2 + kstep; const char* b3 = b2 + kstep;
            if (last && has_next) S.a_ready(nxt);
            if constexpr (SP2) {
            PG8_LDB(B0, 0, 0); PG8_LDB(B1, 0, 1); PG8_SCHED; PG8_LDA(At, 0, 0); PG8_STAGE(PG8_SA(1, 1), a1 + hstep, voffA);
            PG8_WAIT_V(8); PG8_WAIT_L(0); PG8_BAR; PG8_MMA(0, 0, At, B0); PG8_MMA(0, 1, At, B1); PG8_BAR; PG8_SCHED;
            PG8_LDA(At, 0, 1); PG8_STAGE(PG8_SB(0, 0), b2, voffB); PG8_STAGE(PG8_SB(0, 1), b2 + hstep, voffB); PG8_STAGE(PG8_SA(0, 0), a2, voffA);
            PG8_WAIT_V(8); PG8_WAIT_L(0); PG8_BAR; PG8_MMA(1, 0, At, B0); PG8_MMA(1, 1, At, B1); PG8_BAR; PG8_SCHED;
            PG8_LDB(B0, 1, 0); PG8_LDB(B1, 1, 1); PG8_SCHED; PG8_LDA(At, 1, 0); PG8_STAGE(PG8_SA(0, 1), a2 + hstep, voffA);
            PG8_WAIT_V(8); PG8_WAIT_L(0); PG8_BAR; PG8_MMA(0, 0, At, B0); PG8_MMA(0, 1, At, B1); PG8_BAR; PG8_SCHED;
            PG8_LDA(At, 1, 1); PG8_STAGE(PG8_SB(1, 0), b3, voffB); PG8_STAGE(PG8_SB(1, 1), b3 + hstep, voffB); PG8_STAGE(PG8_SA(1, 0), a3, voffA);
            PG8_WAIT_V(8); PG8_WAIT_L(0); PG8_BAR; PG8_MMA(1, 0, At, B0); PG8_MMA(1, 1, At, B1); PG8_BAR; PG8_SCHED;
            } else {
            PG8_LDB(B0, 0, 0); PG8_SCHED; PG8_LDA(At, 0, 0); PG8_STAGE(PG8_SA(1, 1), a1 + hstep, voffA);
            PG8_WAIT_L(8); PG8_BAR; PG8_WAIT_L(0); PG8_MMA(0, 0, At, B0); PG8_BAR; PG8_SCHED;
            PG8_LDB(B1, 0, 1); PG8_STAGE(PG8_SB(0, 0), b2, voffB);
            PG8_BAR; PG8_WAIT_L(0); PG8_MMA(0, 1, At, B1); PG8_BAR;
            PG8_LDA(At, 0, 1); PG8_STAGE(PG8_SA(0, 0), a2, voffA);
            PG8_BAR; PG8_WAIT_L(0); PG8_MMA(1, 0, At, B0); PG8_BAR; PG8_SCHED;
            PG8_STAGE(PG8_SB(0, 1), b2 + hstep, voffB);
            PG8_WAIT_V(6); PG8_BAR; PG8_MMA(1, 1, At, B1); PG8_BAR;
            PG8_LDB(B0, 1, 0); PG8_SCHED; PG8_LDA(At, 1, 0); PG8_STAGE(PG8_SA(0, 1), a2 + hstep, voffA);
            PG8_WAIT_L(8); PG8_BAR; PG8_WAIT_L(0); PG8_MMA(0, 0, At, B0); PG8_BAR; PG8_SCHED;
            PG8_LDB(B1, 1, 1); PG8_STAGE(PG8_SB(1, 0), b3, voffB);
            PG8_BAR; PG8_WAIT_L(0); PG8_MMA(0, 1, At, B1); PG8_BAR;
            PG8_LDA(At, 1, 1); PG8_STAGE(PG8_SA(1, 0), a3, voffA);
            PG8_BAR; PG8_WAIT_L(0); PG8_MMA(1, 0, At, B0); PG8_BAR; PG8_SCHED;
            PG8_STAGE(PG8_SB(1, 1), b3 + hstep, voffB);
            PG8_WAIT_V(6); PG8_BAR; PG8_MMA(1, 1, At, B1); PG8_BAR;
            }
        }
        if constexpr (ALIGN_EPI) { if (wr == 0) PG8_BAR; }
        if constexpr (!Epi::AFTER_DRAIN) { E(acc, cur, wr, wc, fr, fq); S.done(cur); }
        if (!has_next) break;
#pragma unroll
        for (int a = 0; a < 2; ++a)
#pragma unroll
            for (int b = 0; b < 2; ++b)
#pragma unroll
                for (int m = 0; m < 4; ++m)
#pragma unroll
                    for (int n = 0; n < 2; ++n) acc[a][b][m][n] = (f32x4){0.f, 0.f, 0.f, 0.f};
        cur = nxt; cA = nA; cB = nB; ++ui;
        if constexpr (ALIGN_EPI) { if (wr == 1) PG8_BAR; }
    }
    PG8_WAIT_V(0);
    if constexpr (!ALIGN_EPI) { if (wr == 0) PG8_BAR; }
    PG8_BAR;
    if constexpr (Epi::AFTER_DRAIN) { E.fused(acc, cur, wr, wc, fr, fq, lds, wid, lane); S.done(cur); }
#undef PG8_SA
#undef PG8_SB
#undef PG8_STAGE
#undef PG8_LDA
#undef PG8_LDB
#undef PG8_MMA
#undef PG8_WAIT_V
#undef PG8_WAIT_L
#undef PG8_BAR
#undef PG8_SCHED
}

constexpr int DM_ = 1024; constexpr float RMS_EPS_ = 1e-5f;
__device__ __forceinline__ float rstd_of(const float* ss, int row) { return __builtin_amdgcn_rsqf(ss[row] * (1.0f / DM_) + RMS_EPS_); }
struct EpiScaleBf16 {
    static constexpr bool PERM = true, AFTER_DRAIN = false;
    bf16_t* O; int ldc; const float* ss;
    __device__ __forceinline__ void operator()(const f32x4 (&acc)[2][2][4][2], const Unit& u, int wr, int wc, int fr, int fq) const {
        const int row0 = u.pm * BM + wr * 64 + fr, col0 = u.pn * BM + wc * 32 + 8 * fq;
        float rsv[2][4];
#pragma unroll
        for (int ai = 0; ai < 2; ++ai)
#pragma unroll
            for (int m = 0; m < 4; ++m) rsv[ai][m] = ss[row0 + ai * HALF + m * 16];
#pragma unroll
        for (int ai = 0; ai < 2; ++ai)
#pragma unroll
            for (int m = 0; m < 4; ++m) { const int row = row0 + ai * HALF + m * 16; const float rs = __builtin_amdgcn_rsqf(rsv[ai][m] * (1.0f / DM_) + RMS_EPS_); bf16_t* rowp = O + (size_t)row * ldc + col0;
#pragma unroll
                for (int bj = 0; bj < 2; ++bj) { const f32x4 v0 = acc[ai][bj][m][0] * rs, v1 = acc[ai][bj][m][1] * rs;
                    u32x4 w; w.x = cvt_pk_bf16(v0[0], v0[1]); w.y = cvt_pk_bf16(v0[2], v0[3]); w.z = cvt_pk_bf16(v1[0], v1[1]); w.w = cvt_pk_bf16(v1[2], v1[3]);
                    *(u32x4*)(rowp + bj * HALF) = w; } }
    }
};
struct EpiResid {
    static constexpr bool PERM = false, AFTER_DRAIN = false;
    const float* base; float* xout; bf16_t* xb; float* ss_out;
    __device__ __forceinline__ void operator()(const f32x4 (&acc)[2][2][4][2], const Unit& u, int wr, int wc, int fr, int fq) const {
        typedef unsigned u32x2v __attribute__((ext_vector_type(2)));
        const int row0 = u.pm * BM + wr * 64 + fr, col0 = u.pn * BM + wc * 32 + 4 * fq;
#pragma unroll
        for (int ai = 0; ai < 2; ++ai)
#pragma unroll
            for (int m = 0; m < 4; ++m) { const int row = row0 + ai * HALF + m * 16; const size_t off = (size_t)row * DM_ + col0; float sq = 0.f;
#pragma unroll
                for (int bj = 0; bj < 2; ++bj)
#pragma unroll
                    for (int n = 0; n < 2; ++n) { const size_t o = off + bj * HALF + n * 16; const f32x4 x = *(const f32x4*)(base + o) + acc[ai][bj][m][n];
                        *(f32x4*)(xout + o) = x; u32x2v w; w.x = cvt_pk_bf16(x[0], x[1]); w.y = cvt_pk_bf16(x[2], x[3]); *(u32x2v*)(xb + o) = w;
                        sq += (x[0] * x[0] + x[1] * x[1]) + (x[2] * x[2] + x[3] * x[3]); }
                sq += __shfl_xor(sq, 16); sq += __shfl_xor(sq, 32);
                if (fq == 0) atomicAdd(ss_out + row, sq); }
    }
};
struct EpiGateUpTmp {
    static constexpr bool PERM = true, AFTER_DRAIN = false;
    bf16_t* U; bf16_t* UP; const float* ss; int ff;
    __device__ __forceinline__ void operator()(const f32x4 (&acc)[2][2][4][2], const Unit& u, int wr, int wc, int fr, int fq) const {
        const int row0 = u.pm * BM + wr * 64 + fr, col0 = u.pn * HALF + wc * 32 + 8 * fq;
        float rsv[2][4];
#pragma unroll
        for (int ai = 0; ai < 2; ++ai)
#pragma unroll
            for (int m = 0; m < 4; ++m) rsv[ai][m] = ss[row0 + ai * HALF + m * 16];
#pragma unroll
        for (int ai = 0; ai < 2; ++ai)
#pragma unroll
            for (int m = 0; m < 4; ++m) { const int row = row0 + ai * HALF + m * 16; const float rs = __builtin_amdgcn_rsqf(rsv[ai][m] * (1.0f / DM_) + RMS_EPS_); const size_t o = (size_t)row * ff + col0;
#pragma unroll
                for (int bj = 0; bj < 2; ++bj) { const f32x4 v0 = acc[ai][bj][m][0] * rs, v1 = acc[ai][bj][m][1] * rs;
                    u32x4 w; w.x = cvt_pk_bf16(v0[0], v0[1]); w.y = cvt_pk_bf16(v0[2], v0[3]); w.z = cvt_pk_bf16(v1[0], v1[1]); w.w = cvt_pk_bf16(v1[2], v1[3]);
                    *(u32x4*)((bj == 0 ? U : UP) + o) = w; } }
    }
};
template <int CTRL> __device__ __forceinline__ float dpp1(float x) { return __builtin_bit_cast(float, __builtin_amdgcn_update_dpp(0, __builtin_bit_cast(int, x), CTRL, 0xF, 0xF, true)); }
template <int CTRL> __device__ __forceinline__ f32x4 dpp4(const f32x4 x) { return (f32x4){dpp1<CTRL>(x.x), dpp1<CTRL>(x.y), dpp1<CTRL>(x.z), dpp1<CTRL>(x.w)}; }
struct EpiConvGlu {
    static constexpr bool PERM = true, AFTER_DRAIN = false;
    bf16_t* HID; const float* ss; const float* cw; const float* cb; float* SB; PG8_LAS float* xch; int ff;
    __device__ __forceinline__ void operator()(const f32x4 (&acc)[2][2][4][2], const Unit& u, int wr, int wc, int fr, int fq) const {
        const int row0 = u.pm * BM + wr * 64 + fr, cl = wc * 32 + 8 * fq, jcol = u.pn * HALF + cl;
        float rs[2][4];
#pragma unroll
        for (int ai = 0; ai < 2; ++ai)
#pragma unroll
            for (int m = 0; m < 4; ++m) rs[ai][m] = ss[row0 + ai * HALF + m * 16];
        f32x4 w0[2], w1[2], w2[2], bb[2];
#pragma unroll
        for (int n = 0; n < 2; ++n) { w0[n] = *(const f32x4*)(cw + jcol + 4 * n); w1[n] = *(const f32x4*)(cw + ff + jcol + 4 * n); w2[n] = *(const f32x4*)(cw + 2 * ff + jcol + 4 * n); bb[n] = *(const f32x4*)(cb + jcol + 4 * n); }
#pragma unroll
        for (int ai = 0; ai < 2; ++ai)
#pragma unroll
            for (int m = 0; m < 4; ++m) rs[ai][m] = __builtin_amdgcn_rsqf(rs[ai][m] * (1.0f / DM_) + RMS_EPS_);
        if (fr >= 14) {
#pragma unroll
            for (int ai = 0; ai < 2; ++ai)
#pragma unroll
                for (int n = 0; n < 2; ++n) *(PG8_LAS f32x4*)(xch + ((2 * ai + wr) * 2 + (fr - 14)) * HALF + cl + 4 * n) = acc[ai][0][3][n] * rs[ai][3];
        }
        asm volatile("s_waitcnt lgkmcnt(0)" ::: "memory"); __builtin_amdgcn_s_barrier(); asm volatile("" ::: "memory");
        float* sbp = SB + (size_t)u.pm * 6 * ff + jcol;
#pragma unroll
        for (int ai = 0; ai < 2; ++ai) {
            const int q = 2 * ai + wr;
            f32x4 X[2];
#pragma unroll
            for (int n = 0; n < 2; ++n) { X[n] = (f32x4){0.f, 0.f, 0.f, 0.f}; if (q > 0 && fr >= 14) X[n] = *(const PG8_LAS f32x4*)(xch + ((q - 1) * 2 + (fr - 14)) * HALF + cl + 4 * n); }
#pragma unroll
            for (int m = 0; m < 4; ++m) { const int row = row0 + ai * HALF + m * 16;
                pg8::u32x4 hw;
#pragma unroll
                for (int n = 0; n < 2; ++n) {
                    const f32x4 cur = acc[ai][0][m][n] * rs[ai][m], up = acc[ai][1][m][n] * rs[ai][m];
                    const f32x4 P = (m > 0) ? acc[ai][0][m > 0 ? m - 1 : 0][n] * rs[ai][m > 0 ? m - 1 : 0] : X[n];
                    const f32x4 a1 = dpp4<0x121>(cur), b1 = dpp4<0x121>(P), a2 = dpp4<0x122>(cur), b2 = dpp4<0x122>(P);
                    f32x4 p1, p2;
#pragma unroll
                    for (int e = 0; e < 4; ++e) { p1[e] = fr == 0 ? b1[e] : a1[e]; p2[e] = fr < 2 ? b2[e] : a2[e]; }
                    const f32x4 c = bb[n] + w0[n] * p2 + w1[n] * p1 + w2[n] * cur;
                    f32x4 hv;
#pragma unroll
                    for (int e = 0; e < 4; ++e) hv[e] = c[e] * __builtin_amdgcn_rcpf(1.f + __expf(-c[e])) * up[e];
                    if (n == 0) { hw.x = cvt_pk_bf16(hv[0], hv[1]); hw.y = cvt_pk_bf16(hv[2], hv[3]); } else { hw.z = cvt_pk_bf16(hv[0], hv[1]); hw.w = cvt_pk_bf16(hv[2], hv[3]); }
                    if (q == 0 && m == 0 && fr < 2) { *(f32x4*)(sbp + (size_t)fr * ff + 4 * n) = cur; *(f32x4*)(sbp + (size_t)(2 + fr) * ff + 4 * n) = up; }
                    if (q == 3 && m == 3 && fr >= 14) *(f32x4*)(sbp + (size_t)(4 + fr - 14) * ff + 4 * n) = cur;
                }
                *(pg8::u32x4*)(HID + (size_t)row * ff + jcol) = hw; }
        }
    }
};
}

#define LAS __attribute__((address_space(3)))
__device__ __forceinline__ void transpose_item(const float* __restrict__ W, int K, int N, bf16_t* __restrict__ Wt, const float* __restrict__ g, int mode, float* scr, int item, int lane) {
    const int nblk = N / 32, kb = item / nblk, nb = item % nblk, k0 = 64 * kb, n0 = 32 * nb;
    int np0 = n0; if (mode == 1) np0 = 256 * (n0 / 128) + (n0 % 128); else if (mode == 2) np0 = 256 * (n0 / 128) + 128 + (n0 % 128);
#pragma unroll 8
    for (int i = 0; i < 32; ++i) { const int kk = 2 * i + (lane >> 5); scr[kk * 33 + (lane & 31)] = W[(size_t)(k0 + kk) * N + n0 + (lane & 31)] * (g ? g[k0 + kk] : 1.f); }
    __builtin_amdgcn_fence(__ATOMIC_RELEASE, "wavefront"); __builtin_amdgcn_wave_barrier(); __builtin_amdgcn_fence(__ATOMIC_ACQUIRE, "wavefront");
    const int c = lane & 7;
#pragma unroll
    for (int j = 0; j < 4; ++j) { const int n = (lane >> 3) + 8 * j; const float* sp = scr + (8 * c) * 33 + n;
        uint4 o; o.x = f2bf(sp[0]) | (f2bf(sp[33]) << 16); o.y = f2bf(sp[2 * 33]) | (f2bf(sp[3 * 33]) << 16); o.z = f2bf(sp[4 * 33]) | (f2bf(sp[5 * 33]) << 16); o.w = f2bf(sp[6 * 33]) | (f2bf(sp[7 * 33]) << 16);
        *(uint4*)(Wt + (size_t)(np0 + n) * K + k0 + 8 * c) = o; }
    __builtin_amdgcn_fence(__ATOMIC_RELEASE, "wavefront"); __builtin_amdgcn_wave_barrier(); __builtin_amdgcn_fence(__ATOMIC_ACQUIRE, "wavefront");
}
__device__ __forceinline__ void x_row_to_bf16(const float* __restrict__ x, bf16_t* __restrict__ xb, float* __restrict__ ss, int row, int lane) {
    const f32x4* xr = (const f32x4*)(x + (size_t)row * D) + lane; float s = 0.f;
#pragma unroll
    for (int j = 0; j < 4; ++j) { const f32x4 v = xr[64 * j]; s += v.x * v.x + v.y * v.y + v.z * v.z + v.w * v.w;
        unsigned long long o = (unsigned long long)(f2bf(v.x) | (f2bf(v.y) << 16)) | ((unsigned long long)(f2bf(v.z) | (f2bf(v.w) << 16)) << 32);
        ((unsigned long long*)(xb + (size_t)row * D))[lane + 64 * j] = o; }
    s = wave_sum(s); if (lane == 0) ss[row] = s;
}

struct EpArgs {
    const float* ss; float* ss_out; const float* base; float* xout; bf16_t* ob; bf16_t* ob2; int ldo; int row_off;
};
template <int MODE>
__device__ __forceinline__ void gemm_simple(const bf16_t* __restrict__ A, int lda, const bf16_t* __restrict__ Bt, int ldb, int Mrows, int N, int K, EpArgs e, int tid) {
    const int wid = tid >> 6, lane = tid & 63, fr = lane & 15, fq = lane >> 4;
    const int ntn = N / 128, ntiles = (Mrows / 64) * ntn;
    for (int tile = blockIdx.x; tile < ntiles; tile += gridDim.x) {
    const int row0 = (tile / ntn) * 64 + (wid >> 2) * 32, col0 = (tile % ntn) * 128 + (wid & 3) * 32;
    f32x4 acc[2][2];
#pragma unroll
    for (int i = 0; i < 2; ++i)
#pragma unroll
        for (int j = 0; j < 2; ++j) acc[i][j] = (f32x4){0.f, 0.f, 0.f, 0.f};
    const bf16_t* ap = A + (size_t)(row0 + fr) * lda + fq * 8;
    const bf16_t* bp = Bt + (size_t)(col0 + fr) * ldb + fq * 8;
    for (int k0 = 0; k0 < K; k0 += 32) {
        bf16x8 a[2], b[2];
#pragma unroll
        for (int i = 0; i < 2; ++i) { a[i] = *(const bf16x8*)(ap + (size_t)i * 16 * lda + k0); b[i] = *(const bf16x8*)(bp + (size_t)i * 16 * ldb + k0); }
#pragma unroll
        for (int i = 0; i < 2; ++i)
#pragma unroll
            for (int j = 0; j < 2; ++j) acc[i][j] = __builtin_amdgcn_mfma_f32_16x16x32_bf16(a[i], b[j], acc[i][j], 0, 0, 0);
    }
#pragma unroll
    for (int i = 0; i < 2; ++i)
#pragma unroll
        for (int r = 0; r < 4; ++r) {
            const int row = row0 + i * 16 + fq * 4 + r;
            float rstd = 1.f;
            if (MODE == 0 || MODE == 2) rstd = rsqrtf(e.ss[row] * (1.f / D) + RMS_EPS);
            float sq = 0.f;
#pragma unroll
            for (int j = 0; j < 2; ++j) {
                const int col = col0 + j * 16 + fr; const float v = acc[i][j][r];
                if (MODE == 0) e.ob[(size_t)row * e.ldo + col] = (bf16_t)f2bf(v * rstd);
                else if (MODE == 1) { const size_t o = (size_t)row * D + col; const float x = e.base[o] + v; e.xout[o] = x; e.ob[o] = (bf16_t)f2bf(x); sq += x * x; }
                else { const int p = col >> 8, jj = col & 255; const size_t o = (size_t)(row - e.row_off) * FF + 128 * p + (jj & 127);
                    if (jj < 128) e.ob[o] = (bf16_t)f2bf(v * rstd); else e.ob2[o] = (bf16_t)f2bf(v * rstd); }
            }
            if (MODE == 1) {
                sq += __shfl_xor(sq, 1); sq += __shfl_xor(sq, 2); sq += __shfl_xor(sq, 4); sq += __shfl_xor(sq, 8);
                if (fr == 0) atomicAdd(e.ss_out + row, sq);
            }
        }
    }
}

struct PrepArgs {
    const bf16_t* proj; const float* mu; const float* w0; const float* w2; const float* a0; const float* a2; const float* g2;
    const float* v0; const float* v1; const float* v2; bf16_t* vfirst; int layer; int pad;
    bf16_t *R, *K, *V, *A, *LD, *G;
};
__device__ __forceinline__ void prep_group(const PrepArgs& p, float (*rest)[SHIFT_W], float (*vlo)[32], int grp, int tid) {
    const int m0 = grp * 4;
    for (int i = tid; i < 4 * SHIFT_W; i += 512) {
        const int tk = i / SHIFT_W, c = i % SHIFT_W, m = m0 + tk, t = m % SEQ;
        const float u = bf2f(p.proj[(size_t)m * IN_W + ATT_IN + c]);
        const float up = t > 0 ? bf2f(p.proj[(size_t)(m - 1) * IN_W + ATT_IN + c]) : 0.f;
        float v = u + (up - u) * p.mu[c];
        if (c >= 1536 && c < 1600) v = tanhf(v); else if (c >= 1664) v = sigmoidf_(v);
        rest[tk][c] = v;
    }
    __syncthreads();
    if (p.layer > 0 && tid < 128) { const int tk = tid >> 5, j = tid & 31; float s = 0.f; for (int c = 0; c < C; ++c) s += rest[tk][1024 + c] * p.v1[c * 32 + j]; vlo[tk][j] = s; }
    __syncthreads();
    const int c = tid;
    float wp[4], ap[4], gp[4];
#pragma unroll
    for (int tk = 0; tk < 4; ++tk) { wp[tk] = p.w0[c]; ap[tk] = p.a0[c]; gp[tk] = 0.f; }
    for (int k = 0; k < 64; ++k) { const float w = p.w2[k * C + c], a = p.a2[k * C + c];
#pragma unroll
        for (int tk = 0; tk < 4; ++tk) { wp[tk] += rest[tk][1536 + k] * w; ap[tk] += rest[tk][1600 + k] * a; } }
    for (int k = 0; k < 128; ++k) { const float g = p.g2[k * C + c];
#pragma unroll
        for (int tk = 0; tk < 4; ++tk) gp[tk] += rest[tk][1664 + k] * g; }
#pragma unroll
    for (int tk = 0; tk < 4; ++tk) {
        const size_t o = (size_t)(m0 + tk) * C + c;
        const float x = -wp[tk];
        const float sp = fmaxf(x, 0.f) + log1pf(__expf(-fabsf(x)));
        const float wraw = -sp - 0.5f;
        const float ld = -__expf(wraw);
        const float a = sigmoidf_(ap[tk]);
        float v = rest[tk][1024 + c];
        if (p.layer == 0) p.vfirst[o] = (bf16_t)f2bf(v);
        else { float s = p.v0[c]; for (int j = 0; j < 32; ++j) s += vlo[tk][j] * p.v2[j * C + c]; const float vf = bf2f(p.vfirst[o]); v = v + (vf - v) * sigmoidf_(s); }
        p.R[o] = (bf16_t)f2bf(rest[tk][c]); p.K[o] = (bf16_t)f2bf(rest[tk][512 + c]); p.V[o] = (bf16_t)f2bf(v);
        p.A[o] = (bf16_t)f2bf(a); p.LD[o] = (bf16_t)f2bf(ld); p.G[o] = (bf16_t)f2bf(gp[tk]);
    }
    __syncthreads();
}

constexpr size_t WS_LORA = 50 * MiB;
constexpr size_t LORA_LAYER = 256 * 1024, WS_V1T = WS_LORA + 2 * LORA_LAYER, WS_V2T = WS_V1T + 32 * 1024;
constexpr int PR_ACT_LD = 264, PR_VLO_LD = 40, PR_SG_LD = 520, PR_ACT_OFF = 0, PR_VLO_OFF = 64 * PR_ACT_LD * 2, PR_SG_OFF = PR_VLO_OFF + 64 * PR_VLO_LD * 2;
struct Prep2Args {
    const bf16_t* proj; const float* mu; const float* w0; const float* a0; const float* v0;
    const bf16_t *W2T, *A2T, *G2T, *V1T, *V2T; bf16_t* vfirst; bf16_t *R, *K, *V, *A, *LD, *G; int layer; int pad;
};
__device__ __forceinline__ f32x4 bfx4_lo(const bf16x8 v) { return (f32x4){bf2f((bf16_t)v[0]), bf2f((bf16_t)v[1]), bf2f((bf16_t)v[2]), bf2f((bf16_t)v[3])}; }
__device__ __forceinline__ f32x4 bfx4_hi(const bf16x8 v) { return (f32x4){bf2f((bf16_t)v[4]), bf2f((bf16_t)v[5]), bf2f((bf16_t)v[6]), bf2f((bf16_t)v[7])}; }
__device__ __forceinline__ bf16x8 pack8(const f32x4 a, const f32x4 b) { pg8::u32x4 w; w.x = pg8::cvt_pk_bf16(a[0], a[1]); w.y = pg8::cvt_pk_bf16(a[2], a[3]); w.z = pg8::cvt_pk_bf16(b[0], b[1]); w.w = pg8::cvt_pk_bf16(b[2], b[3]); return __builtin_bit_cast(bf16x8, w); }
__device__ __forceinline__ void shift8(const bf16_t* __restrict__ proj, const float* __restrict__ mu, size_t m, int t, int col, int mi, f32x4& lo, f32x4& hi) {
    const bf16x8 cur = *(const bf16x8*)(proj + m * IN_W + col);
    bf16x8 prv; if (t > 0) prv = *(const bf16x8*)(proj + (m - 1) * IN_W + col); else prv = (bf16x8){0, 0, 0, 0, 0, 0, 0, 0};
    const f32x4 m0 = *(const f32x4*)(mu + mi), m1 = *(const f32x4*)(mu + mi + 4);
    const f32x4 c0 = bfx4_lo(cur), c1 = bfx4_hi(cur), p0 = bfx4_lo(prv), p1 = bfx4_hi(prv);
    lo = c0 + (p0 - c0) * m0; hi = c1 + (p1 - c1) * m1;
}
__device__ __forceinline__ void prep_tile(const Prep2Args& p, unsigned char* lds, int tile, int tid) {
    const int m0 = tile * 64, wave = __builtin_amdgcn_readfirstlane(tid >> 6), lane = tid & 63, fr = lane & 15, fq = lane >> 4;
    bf16_t* ACT = (bf16_t*)(lds + PR_ACT_OFF); bf16_t* VLO = (bf16_t*)(lds + PR_VLO_OFF); bf16_t* SG = (bf16_t*)(lds + PR_SG_OFF);
#pragma unroll
    for (int it = 0; it < 4; ++it) { const int i = tid + 512 * it, tk = i >> 5, cc = i & 31; const size_t m = (size_t)m0 + tk; const int t = (int)(m % SEQ);
        f32x4 lo, hi; shift8(p.proj, p.mu, m, t, 2304 + 8 * cc, 1536 + 8 * cc, lo, hi);
        if (cc < 8) {
#pragma unroll
            for (int e = 0; e < 4; ++e) { lo[e] = 2.f * sigmoidf_(2.f * lo[e]) - 1.f; hi[e] = 2.f * sigmoidf_(2.f * hi[e]) - 1.f; } }
        else if (cc >= 16) {
#pragma unroll
            for (int e = 0; e < 4; ++e) { lo[e] = sigmoidf_(lo[e]); hi[e] = sigmoidf_(hi[e]); } }
        *(bf16x8*)(ACT + tk * PR_ACT_LD + 8 * cc) = pack8(lo, hi); }
    if (p.layer > 0) {
        const int tb = wave >> 1, jb = wave & 1; const size_t m = (size_t)m0 + 16 * tb + fr; const int t = (int)(m % SEQ);
        f32x4 acc = (f32x4){0.f, 0.f, 0.f, 0.f};
#pragma unroll 4
        for (int ks = 0; ks < 16; ++ks) { f32x4 lo, hi; shift8(p.proj, p.mu, m, t, 1792 + 32 * ks + 8 * fq, 1024 + 32 * ks + 8 * fq, lo, hi);
            const bf16x8 wf = *(const bf16x8*)(p.V1T + (size_t)(16 * jb + fr) * C + 32 * ks + 8 * fq);
            acc = __builtin_amdgcn_mfma_f32_16x16x32_bf16(wf, pack8(lo, hi), acc, 0, 0, 0); }
        uint2 w; w.x = pg8::cvt_pk_bf16(acc[0], acc[1]); w.y = pg8::cvt_pk_bf16(acc[2], acc[3]);
        *(uint2*)(VLO + (16 * tb + fr) * PR_VLO_LD + 16 * jb + 4 * fq) = w;
    }
    __syncthreads();
    const int ch0 = 64 * wave;
#pragma unroll
    for (int arr = 0; arr < 3; ++arr) {
        const int K0 = arr == 0 ? 0 : (arr == 1 ? 64 : 128), KL = arr == 2 ? 128 : 64; const bf16_t* WT = arr == 0 ? p.W2T : (arr == 1 ? p.A2T : p.G2T);
        f32x4 acc[4][4];
#pragma unroll
        for (int tb = 0; tb < 4; ++tb)
#pragma unroll
            for (int cb = 0; cb < 4; ++cb) acc[tb][cb] = (f32x4){0.f, 0.f, 0.f, 0.f};
#pragma unroll
        for (int ks = 0; ks < KL / 32; ++ks) { bf16x8 wf[4], af[4];
#pragma unroll
            for (int cb = 0; cb < 4; ++cb) wf[cb] = *(const bf16x8*)(WT + (size_t)(ch0 + 16 * cb + fr) * KL + 32 * ks + 8 * fq);
#pragma unroll
            for (int tb = 0; tb < 4; ++tb) af[tb] = *(const bf16x8*)(ACT + (16 * tb + fr) * PR_ACT_LD + K0 + 32 * ks + 8 * fq);
#pragma unroll
            for (int tb = 0; tb < 4; ++tb)
#pragma unroll
                for (int cb = 0; cb < 4; ++cb) acc[tb][cb] = __builtin_amdgcn_mfma_f32_16x16x32_bf16(wf[cb], af[tb], acc[tb][cb], 0, 0, 0); }
        bf16_t* OUT = arr == 0 ? p.LD : (arr == 1 ? p.A : p.G);
#pragma unroll
        for (int cb = 0; cb < 4; ++cb) { const int ch = ch0 + 16 * cb + 4 * fq;
            f32x4 bias = (f32x4){0.f, 0.f, 0.f, 0.f}; if (arr == 0) bias = *(const f32x4*)(p.w0 + ch); else if (arr == 1) bias = *(const f32x4*)(p.a0 + ch);
#pragma unroll
            for (int tb = 0; tb < 4; ++tb) { f32x4 x = acc[tb][cb] + bias;
                if (arr == 0) {
#pragma unroll
                    for (int e = 0; e < 4; ++e) { const float z = -x[e]; const float sp = fmaxf(z, 0.f) + __logf(1.f + __expf(-fabsf(z))); x[e] = -__expf(-sp - 0.5f); } }
                else if (arr == 1) {
#pragma unroll
                    for (int e = 0; e < 4; ++e) x[e] = sigmoidf_(x[e]); }
                uint2 w; w.x = pg8::cvt_pk_bf16(x[0], x[1]); w.y = pg8::cvt_pk_bf16(x[2], x[3]);
                *(uint2*)(OUT + ((size_t)m0 + 16 * tb + fr) * C + ch) = w; } }
    }
    if (p.layer > 0) {
        bf16x8 af[4];
#pragma unroll
        for (int tb = 0; tb < 4; ++tb) af[tb] = *(const bf16x8*)(VLO + (16 * tb + fr) * PR_VLO_LD + 8 * fq);
#pragma unroll
        for (int cb = 0; cb < 4; ++cb) { const int ch = ch0 + 16 * cb + 4 * fq; const bf16x8 wf = *(const bf16x8*)(p.V2T + (size_t)(ch0 + 16 * cb + fr) * 32 + 8 * fq); const f32x4 bias = *(const f32x4*)(p.v0 + ch);
#pragma unroll
            for (int tb = 0; tb < 4; ++tb) { f32x4 x = __builtin_amdgcn_mfma_f32_16x16x32_bf16(wf, af[tb], (f32x4){0.f, 0.f, 0.f, 0.f}, 0, 0, 0) + bias;
                uint2 w; w.x = pg8::cvt_pk_bf16(sigmoidf_(x[0]), sigmoidf_(x[1])); w.y = pg8::cvt_pk_bf16(sigmoidf_(x[2]), sigmoidf_(x[3]));
                *(uint2*)(SG + (16 * tb + fr) * PR_SG_LD + ch) = w; } }
    }
    __syncthreads();
#pragma unroll
    for (int sec = 0; sec < 3; ++sec) { bf16_t* OUT = sec == 0 ? p.R : (sec == 1 ? p.K : p.V);
#pragma unroll 4
        for (int it = 0; it < 8; ++it) { const int i = tid + 512 * it, tk = i >> 6, cc = i & 63; const size_t m = (size_t)m0 + tk; const int t = (int)(m % SEQ);
            f32x4 lo, hi; shift8(p.proj, p.mu, m, t, 768 + 512 * sec + 8 * cc, 512 * sec + 8 * cc, lo, hi);
            const size_t o = m * C + 8 * cc;
            if (sec == 2) {
                if (p.layer == 0) *(bf16x8*)(p.vfirst + o) = pack8(lo, hi);
                else { const bf16x8 vf = *(const bf16x8*)(p.vfirst + o), sg = *(const bf16x8*)(SG + tk * PR_SG_LD + 8 * cc);
                    lo = lo + (bfx4_lo(vf) - lo) * bfx4_lo(sg); hi = hi + (bfx4_hi(vf) - hi) * bfx4_hi(sg); } }
            *(bf16x8*)(OUT + o) = pack8(lo, hi); } }
    __syncthreads();
}

constexpr int NTHREADS_ = 512;
constexpr int SC_TB = 32, SC_SLOT = 384, SC_NCH = SEQ / SC_TB;
constexpr int WS_RKC = 1 * (1 << 20);
struct ScanArgs { const bf16_t *R, *K, *V, *A, *LD, *G; const float *k_k, *k_a, *r_k, *lnx_g, *lnx_b; bf16_t* mix; float* rkc; };
template <int CTRL> __device__ __forceinline__ float dpp_mov(float x) { return __builtin_bit_cast(float, __builtin_amdgcn_update_dpp(0, __builtin_bit_cast(int, x), CTRL, 0xF, 0xF, true)); }
__device__ __forceinline__ float reduce16(float x) { x += dpp_mov<0xB1>(x); x += dpp_mov<0x4E>(x); x += dpp_mov<0x141>(x); x += dpp_mov<0x140>(x); return x; }
struct ScLdSet { bf16_t r[8], k[8], v[8], a[8], ld[8]; };
__device__ __forceinline__ void scan_item(const ScanArgs& p, float* lds, int item, int tid) {
    const int chain = item >> 2, q = item & 3, b = chain >> 3, h = chain & 7, wave = __builtin_amdgcn_readfirstlane(tid >> 6), lane = tid & 63;
    float* buf = lds;
    float* ybuf = lds + 2 * SC_TB * SC_SLOT;
    if (wave >= 4) {
        const int lw = wave - 4, ch = h * 64 + lane, lt = lw * 64 + lane;
        const float kk_c = p.k_k[ch], ka_c = p.k_a[ch], rk_c = p.r_k[ch];
        const size_t rowbase = (size_t)b * SEQ;
        ScLdSet s0, s1;
#define SC_LOAD(S, chunk) do { _Pragma("unroll") for (int i = 0; i < 8; ++i) { const size_t o = (rowbase + (size_t)(chunk) * SC_TB + lw + 4 * i) * C + ch; \
            S.r[i] = p.R[o]; S.k[i] = p.K[o]; S.v[i] = p.V[o]; S.a[i] = p.A[o]; S.ld[i] = p.LD[o]; } } while (0)
#define SC_PROC(S, chunk, bi) do { _Pragma("unroll") for (int i = 0; i < 8; ++i) { const int st = lw + 4 * i; \
            const float r = bf2f(S.r[i]), k = bf2f(S.k[i]), v = bf2f(S.v[i]), a = bf2f(S.a[i]), ld = bf2f(S.ld[i]); \
            float kk = k * kk_c; const float nrm = sqrtf(wave_sum(kk * kk)); kk = kk / fmaxf(nrm, 1e-12f); \
            const float kp = k * (1.f + (a - 1.f) * ka_c); const float rkc = wave_sum(r * kp * rk_c); \
            float* slot = buf + ((bi) * SC_TB + st) * SC_SLOT + lane; \
            slot[0] = __expf(ld); slot[64] = -kk; slot[128] = kk * a; slot[192] = kp; slot[256] = r; slot[320] = v; \
            if (q == 0 && lane == 0) p.rkc[(rowbase + (size_t)(chunk) * SC_TB + st) * 8 + h] = rkc; } } while (0)
#define SC_YOUT(chunk, bi) do { _Pragma("unroll") for (int e2 = 0; e2 < 2; ++e2) { const int e = lt + 256 * e2, st = e >> 4, rr = e & 15; \
            p.mix[(rowbase + (size_t)(chunk) * SC_TB + st) * D + ATT_W + h * 64 + 16 * q + rr] = (bf16_t)f2bf(ybuf[(bi) * SC_TB * 16 + e]); } } while (0)
        SC_LOAD(s0, 0); SC_LOAD(s1, 1); SC_PROC(s0, 0, 0);
        __syncthreads();
        for (int c = 0; c < SC_NCH; c += 2) {
            if (c + 2 < SC_NCH) SC_LOAD(s0, c + 2);
            SC_PROC(s1, c + 1, 1);
            if (c >= 1) SC_YOUT(c - 1, 1);
            __syncthreads();
            if (c + 3 < SC_NCH) SC_LOAD(s1, c + 3);
            if (c + 2 < SC_NCH) SC_PROC(s0, c + 2, 0);
            SC_YOUT(c, 0);
            __syncthreads();
        }
        SC_YOUT(SC_NCH - 1, 1);
#undef SC_LOAD
#undef SC_PROC
#undef SC_YOUT
    } else {
        const int cg4 = (lane & 15) * 4, rloc = 4 * wave + (lane >> 4);
        float S0 = 0.f, S1 = 0.f, S2 = 0.f, S3 = 0.f;
#define SC_SCAN(bi) do { const float* bp = buf + (bi) * SC_TB * SC_SLOT + cg4; const float* vp = buf + (bi) * SC_TB * SC_SLOT + 320 + 16 * q + rloc; float* yp = ((lane & 15) == 0) ? (ybuf + (bi) * SC_TB * 16 + rloc) : (ybuf + 2 * SC_TB * 16 + lane);     \
            _Pragma("unroll") for (int st = 0; st < SC_TB; ++st) { \
                const f32x4 w = *(const f32x4*)(bp + st * SC_SLOT), A = *(const f32x4*)(bp + st * SC_SLOT + 64), B = *(const f32x4*)(bp + st * SC_SLOT + 128), kp = *(const f32x4*)(bp + st * SC_SLOT + 192), r = *(const f32x4*)(bp + st * SC_SLOT + 256); \
                const float v = vp[st * SC_SLOT]; \
                float sa = (S0 * A.x + S1 * A.y) + (S2 * A.z + S3 * A.w); sa = reduce16(sa); \
                S0 = S0 * w.x + (sa * B.x + v * kp.x); S1 = S1 * w.y + (sa * B.y + v * kp.y); S2 = S2 * w.z + (sa * B.z + v * kp.z); S3 = S3 * w.w + (sa * B.w + v * kp.w); \
                float y = (S0 * r.x + S1 * r.y) + (S2 * r.z + S3 * r.w); y = reduce16(y); \
                yp[st * 16] = y; } } while (0)
        __syncthreads();
        for (int c = 0; c < SC_NCH; c += 2) { SC_SCAN(0); __syncthreads(); SC_SCAN(1); __syncthreads(); }
#undef SC_SCAN
    }
    __syncthreads();
}
__device__ __forceinline__ void scan_post(const ScanArgs& p, int idx, int lane) {
    const int m = idx >> 3, h = idx & 7, ch = h * 64 + lane; const size_t o = (size_t)m * C + ch, om = (size_t)m * D + ATT_W + ch;
    const float y = bf2f(p.mix[om]);
    const float mean = wave_sum(y) * (1.f / 64.f); const float d = y - mean; const float var = wave_sum(d * d) * (1.f / 64.f);
    const float yn = d * rsqrtf(var + LNX_EPS) * p.lnx_g[ch] + p.lnx_b[ch];
    p.mix[om] = (bf16_t)f2bf((yn + p.rkc[(size_t)m * 8 + h] * bf2f(p.V[o])) * bf2f(p.G[o]));
}

typedef float f32x16 __attribute__((ext_vector_type(16)));
typedef short s16x4 __attribute__((ext_vector_type(4)));
constexpr int AT_VTS = 196;
__device__ __forceinline__ int crow(int r, int hi) { return (r & 3) + 8 * (r >> 2) + 4 * hi; }
__device__ __forceinline__ void attn_unit(const bf16_t* __restrict__ proj, const float* __restrict__ sinks, bf16_t* __restrict__ mix, bf16_t* vt, int unit, int tid) {
    const int b = unit >> 7, kvh = (unit >> 6) & 1, qb = unit & 63, Q0 = qb * 64;
    const int wave = __builtin_amdgcn_readfirstlane(tid >> 6), lane = tid & 63, c = lane & 31, hi = lane >> 5, g = wave >> 1, half = wave & 1, h = kvh * 4 + g;
    const size_t rowb = (size_t)b * SEQ;
    for (int i = tid; i < 192 * 8; i += 512) { const int kl = i >> 3, ch8 = i & 7; int key = Q0 - 128 + kl; key = key < 0 ? 0 : key;
        const bf16x8 v = *(const bf16x8*)(proj + (rowb + key) * IN_W + 640 + kvh * 64 + ch8 * 8);
#pragma unroll
        for (int e = 0; e < 8; ++e) vt[(ch8 * 8 + e) * AT_VTS + kl] = (bf16_t)v[e]; }
    __syncthreads();
    const int t0 = Q0 + 32 * half; const size_t mq = rowb + t0 + c;
    bf16x8 qf[4];
#pragma unroll
    for (int ks = 0; ks < 4; ++ks) qf[ks] = *(const bf16x8*)(proj + mq * IN_W + h * 64 + 16 * ks + 8 * hi);
    f32x16 p[5];
#pragma unroll
    for (int kb = 0; kb < 5; ++kb) { int key = t0 - 128 + 32 * kb + c; key = key < 0 ? 0 : key; const bf16_t* kp = proj + (rowb + key) * IN_W + 512 + kvh * 64 + 8 * hi;
        f32x16 acc;
#pragma unroll
        for (int r = 0; r < 16; ++r) acc[r] = 0.f;
#pragma unroll
        for (int ks = 0; ks < 4; ++ks) acc = __builtin_amdgcn_mfma_f32_32x32x16_bf16(*(const bf16x8*)(kp + 16 * ks), qf[ks], acc, 0, 0, 0);
        p[kb] = acc; }
    const float slope = exp2f(-(float)(h + 1)), sink = sinks[h];
    float mx = sink;
#pragma unroll
    for (int kb = 0; kb < 5; ++kb)
#pragma unroll
        for (int r = 0; r < 16; ++r) { const int cr = crow(r, hi), dist = c + 128 - 32 * kb - cr, key = t0 - 128 + 32 * kb + cr;
            const float sc = (dist >= 0 && dist < WINDOW && key >= 0) ? p[kb][r] * 0.125f - slope * (float)dist : -1e30f; p[kb][r] = sc; mx = fmaxf(mx, sc); }
    mx = fmaxf(mx, __shfl_xor(mx, 32));
    float l = 0.f;
#pragma unroll
    for (int kb = 0; kb < 5; ++kb)
#pragma unroll
        for (int r = 0; r < 16; ++r) { const float e = __expf(p[kb][r] - mx); p[kb][r] = e; l += e; }
    l += __shfl_xor(l, 32); l += __expf(sink - mx);
    f32x16 o[2];
#pragma unroll
    for (int d = 0; d < 2; ++d)
#pragma unroll
        for (int r = 0; r < 16; ++r) o[d][r] = 0.f;
#pragma unroll
    for (int kb = 0; kb < 5; ++kb)
#pragma unroll
        for (int s2 = 0; s2 < 2; ++s2) {
            pg8::u32x4 pw; pw.x = pg8::cvt_pk_bf16(p[kb][8 * s2 + 0], p[kb][8 * s2 + 1]); pw.y = pg8::cvt_pk_bf16(p[kb][8 * s2 + 2], p[kb][8 * s2 + 3]);
            pw.z = pg8::cvt_pk_bf16(p[kb][8 * s2 + 4], p[kb][8 * s2 + 5]); pw.w = pg8::cvt_pk_bf16(p[kb][8 * s2 + 6], p[kb][8 * s2 + 7]);
            const bf16x8 pf = __builtin_bit_cast(bf16x8, pw);
#pragma unroll
            for (int d = 0; d < 2; ++d) { const bf16_t* vp = vt + (32 * d + c) * AT_VTS + 32 * half + 32 * kb + 16 * s2 + 4 * hi;
                const s16x4 lo = *(const s16x4*)vp, hh = *(const s16x4*)(vp + 8);
                const bf16x8 vf = (bf16x8){lo[0], lo[1], lo[2], lo[3], hh[0], hh[1], hh[2], hh[3]};
                o[d] = __builtin_amdgcn_mfma_f32_32x32x16_bf16(vf, pf, o[d], 0, 0, 0); } }
    const float inv = 1.f / l;
#pragma unroll
    for (int d = 0; d < 2; ++d)
#pragma unroll
        for (int rg = 0; rg < 4; ++rg) { uint2 w; w.x = pg8::cvt_pk_bf16(o[d][4 * rg] * inv, o[d][4 * rg + 1] * inv); w.y = pg8::cvt_pk_bf16(o[d][4 * rg + 2] * inv, o[d][4 * rg + 3] * inv);
            *(uint2*)(mix + mq * D + h * 64 + 32 * d + 8 * rg + 4 * hi) = w; }
    __syncthreads();
}

__device__ __forceinline__ void conv_item(const bf16_t* __restrict__ U, const bf16_t* __restrict__ UP, const float* __restrict__ cw, const float* __restrict__ cb, bf16_t* __restrict__ hid, size_t i) {
    const int t = (int)(i / FF), j = (int)(i % FF);
    const float u0 = bf2f(U[i]), u1 = t >= 1 ? bf2f(U[i - FF]) : 0.f, u2 = t >= 2 ? bf2f(U[i - 2 * FF]) : 0.f;
    const float c = cb[j] + cw[j] * u2 + cw[FF + j] * u1 + cw[2 * FF + j] * u0;
    hid[i] = (bf16_t)f2bf(c * sigmoidf_(c) * bf2f(UP[i]));
}

__device__ __forceinline__ void ffn_fixup(const float* __restrict__ SB, const float* __restrict__ cw, const float* __restrict__ cb, bf16_t* hid, int pm, int tid) {
    const float* s = SB + (size_t)pm * 6 * FF; const float* sp = SB + (size_t)(pm - 1) * 6 * FF; const bool has_prev = (pm % (SEQ / 256)) != 0;
    for (int idx = tid; idx < 2 * FF; idx += NTHREADS_) { const int rr = idx / FF, j = idx % FF;
        const float u0 = s[j], u1 = s[FF + j], ul0 = has_prev ? sp[4 * FF + j] : 0.f, ul1 = has_prev ? sp[5 * FF + j] : 0.f;
        const float c = rr == 0 ? cb[j] + cw[j] * ul0 + cw[FF + j] * ul1 + cw[2 * FF + j] * u0 : cb[j] + cw[j] * ul1 + cw[FF + j] * u0 + cw[2 * FF + j] * u1;
        hid[(size_t)(pm * 256 + rr) * FF + j] = (bf16_t)f2bf(c * sigmoidf_(c) * s[(2 + rr) * FF + j]); }
}

__device__ __forceinline__ void final_row(float* __restrict__ x, const float* __restrict__ ss, const float* __restrict__ g, int row, int lane) {
    const float rstd = rsqrtf(ss[row] * (1.f / D) + RMS_EPS);
    f32x4* xr = (f32x4*)(x + (size_t)row * D) + lane; const f32x4* gr = (const f32x4*)g + lane;
#pragma unroll
    for (int j = 0; j < 4; ++j) { f32x4 v = xr[64 * j]; const f32x4 gg = gr[64 * j]; v.x *= rstd * gg.x; v.y *= rstd * gg.y; v.z *= rstd * gg.z; v.w *= rstd * gg.w; xr[64 * j] = v; }
}

constexpr int NTHREADS = 512, LDS_BYTES = 147456;
struct Args { const float* in[26]; float* out; unsigned char* ws; };
__global__ void __launch_bounds__(NTHREADS, 2) mega_fwd(Args a) {
    extern __shared__ __attribute__((aligned(16))) unsigned char lds[];
    cg::grid_group grid = cg::this_grid();
#define GRID_SYNC() grid.sync()
#define LDSP ((PG8_LAS unsigned char*)lds)
    constexpr int XCH_OFF = 131072;
#define OTID() ({ int _t = threadIdx.x; asm volatile("" : "+v"(_t)); _t; })
    const int G = gridDim.x, NGW = G * 8;
    const float* x = a.in[0]; const float* norm1_g = a.in[1]; const float* w_in = a.in[2]; const float* sinks = a.in[3];
    const float* mu = a.in[4]; const float* w0 = a.in[5]; const float* w2 = a.in[6]; const float* a0 = a.in[7];
    const float* a2 = a.in[8]; const float* g2 = a.in[9]; const float* k_k = a.in[10]; const float* k_a = a.in[11];
    const float* r_k = a.in[12]; const float* lnx_g = a.in[13]; const float* lnx_b = a.in[14]; const float* v0 = a.in[15];
    const float* v1 = a.in[16]; const float* v2 = a.in[17]; const float* w_out = a.in[18]; const float* norm2_g = a.in[19];
    const float* wg = a.in[20]; const float* wu = a.in[21]; const float* conv_w = a.in[22]; const float* conv_b = a.in[23];
    const float* wd = a.in[24]; const float* final_g = a.in[25];
    unsigned char* ws = a.ws; float* X = a.out;
    float* ss = (float*)(ws + WS_SS);
    bf16_t* XB = (bf16_t*)(ws + WS_XB); bf16_t* PROJ = (bf16_t*)(ws + WS_PROJ); bf16_t* MIX = (bf16_t*)(ws + WS_MIX); bf16_t* HID = (bf16_t*)(ws + WS_HID); bf16_t* VF = (bf16_t*)(ws + WS_VFIRST);
    bf16_t* UT = (bf16_t*)(ws + WS_UTMP); bf16_t* UPT = UT + (size_t)SEQ * FF;

    {
        const int tid = OTID(), lane = tid & 63, wave = tid >> 6, gw = blockIdx.x * 8 + wave;
        float* scr = (float*)lds + wave * (64 * 33 + 16);
        constexpr int I_IN = (D / 64) * (IN_W / 32), I_OUT = (D / 64) * (D / 32), I_G = (D / 64) * (FF / 32), I_DN = (FF / 64) * (D / 32), I_LAYER = I_IN + I_OUT + 2 * I_G + I_DN;
        for (int it = gw; it < 2 * I_LAYER; it += NGW) {
            const int l = it / I_LAYER; int r = it % I_LAYER;
            bf16_t* wl = (bf16_t*)(ws + WS_W + l * W_LAYER); bf16_t* WinT = wl; bf16_t* WoutT = (bf16_t*)((char*)wl + W_IN_SZ); bf16_t* WguT = (bf16_t*)((char*)WoutT + W_OUT_SZ); bf16_t* WdT = (bf16_t*)((char*)WguT + W_GU_SZ);
            if (r < I_IN) { transpose_item(w_in + (size_t)l * D * IN_W, D, IN_W, WinT, norm1_g + l * D, 0, scr, r, lane); continue; } r -= I_IN;
            if (r < I_OUT) { transpose_item(w_out + (size_t)l * D * D, D, D, WoutT, nullptr, 0, scr, r, lane); continue; } r -= I_OUT;
            if (r < I_G) { transpose_item(wg + (size_t)l * D * FF, D, FF, WguT, norm2_g + l * D, 1, scr, r, lane); continue; } r -= I_G;
            if (r < I_G) { transpose_item(wu + (size_t)l * D * FF, D, FF, WguT, norm2_g + l * D, 2, scr, r, lane); continue; } r -= I_G;
            transpose_item(wd + (size_t)l * FF * D, FF, D, WdT, nullptr, 0, scr, r, lane);
        }
        {
            constexpr int I_W2 = 1 * (C / 32), I_G2 = 2 * (C / 32), I_V1 = (C / 64) * 1, I_L = 2 * I_W2 + I_G2;
            for (int it = gw; it < 2 * I_L + I_V1; it += NGW) {
                if (it < 2 * I_L) { const int l = it / I_L; int r = it % I_L; bf16_t* base = (bf16_t*)(ws + WS_LORA + l * LORA_LAYER);
                    if (r < I_W2) { transpose_item(w2 + (size_t)l * 64 * C, 64, C, base, nullptr, 0, scr, r, lane); continue; } r -= I_W2;
                    if (r < I_W2) { transpose_item(a2 + (size_t)l * 64 * C, 64, C, base + 512 * 64, nullptr, 0, scr, r, lane); continue; } r -= I_W2;
                    transpose_item(g2 + (size_t)l * 128 * C, 128, C, base + 2 * 512 * 64, nullptr, 0, scr, r, lane); }
                else transpose_item(v1, C, 32, (bf16_t*)(ws + WS_V1T), nullptr, 0, scr, it - 2 * I_L, lane);
            }
            bf16_t* V2T = (bf16_t*)(ws + WS_V2T);
            for (int i = blockIdx.x * NTHREADS + tid; i < 32 * C; i += G * NTHREADS) { const int j = i / C, ch = i % C; V2T[ch * 32 + j] = (bf16_t)f2bf(v2[i]); }
        }
        for (int m = gw; m < M; m += NGW) x_row_to_bf16(x, XB, ss, m, lane);
    }
    GRID_SYNC();
    for (int l = 0; l < 2; ++l) {
        bf16_t* wl = (bf16_t*)(ws + WS_W + l * W_LAYER); bf16_t* WinT = wl; bf16_t* WoutT = (bf16_t*)((char*)wl + W_IN_SZ); bf16_t* WguT = (bf16_t*)((char*)WoutT + W_OUT_SZ); bf16_t* WdT = (bf16_t*)((char*)WguT + W_GU_SZ);
        float* ss1 = ss + (size_t)(2 * l) * M; float* ss2 = ss + (size_t)(2 * l + 1) * M; float* ss3 = ss + (size_t)(2 * l + 2) * M;
        { pg8::Gemm g{XB, WinT, M, IN_W, D}; pg8::StaticOrder S; S.init(M, IN_W, G, (int)blockIdx.x); pg8::EpiScaleBf16 E{PROJ, IN_W, ss1};
          pg8::gemm_phase<pg8::EpiScaleBf16, pg8::StaticOrder, true, true>(LDSP, g, S, E); }
        GRID_SYNC();
        for (int unit = blockIdx.x; unit < BATCH * 2 * (SEQ / 64); unit += G) attn_unit(PROJ, sinks + l * NH, MIX, (bf16_t*)lds, unit, OTID());
        struct { bf16_t *R, *K, *V, *A, *LD, *G; } p; p.R = (bf16_t*)(ws + WS_SI_R); p.K = (bf16_t*)(ws + WS_SI_K); p.V = (bf16_t*)(ws + WS_SI_V); p.A = (bf16_t*)(ws + WS_SI_A); p.LD = (bf16_t*)(ws + WS_SI_LD); p.G = (bf16_t*)(ws + WS_SI_G);
        { Prep2Args q{}; q.proj = PROJ; q.mu = mu + l * SHIFT_W; q.w0 = w0 + l * C; q.a0 = a0 + l * C; q.v0 = v0;
          const bf16_t* lw = (const bf16_t*)(ws + WS_LORA + l * LORA_LAYER); q.W2T = lw; q.A2T = lw + 512 * 64; q.G2T = lw + 2 * 512 * 64; q.V1T = (const bf16_t*)(ws + WS_V1T); q.V2T = (const bf16_t*)(ws + WS_V2T);
          q.vfirst = VF; q.R = p.R; q.K = p.K; q.V = p.V; q.A = p.A; q.LD = p.LD; q.G = p.G; q.layer = l;
          for (int tile = blockIdx.x; tile < M / 64; tile += G) prep_tile(q, lds, tile, OTID()); }
        GRID_SYNC();
        { ScanArgs s{}; s.R = p.R; s.K = p.K; s.V = p.V; s.A = p.A; s.LD = p.LD; s.G = p.G; s.k_k = k_k + l * C; s.k_a = k_a + l * C; s.r_k = r_k + l * C; s.lnx_g = lnx_g + l * C; s.lnx_b = lnx_b + l * C; s.mix = MIX; s.rkc = (float*)(ws + WS_RKC);
          for (int item = (int)((blockIdx.x & 7) * (G >> 3) + (blockIdx.x >> 3)); item < BATCH * NH * 4; item += G) scan_item(s, (float*)lds, item, OTID());
          GRID_SYNC();
          { const int tid = OTID(), lane = tid & 63, gw = blockIdx.x * 8 + (tid >> 6); for (int idx = gw; idx < M * NH; idx += NGW) scan_post(s, idx, lane); } }
        GRID_SYNC();
        { pg8::Gemm g{MIX, WoutT, M, D, D}; pg8::StaticOrder S; S.init(M, D, G, (int)blockIdx.x); pg8::EpiResid E{(l == 0) ? x : X, X, XB, ss2};
          pg8::gemm_phase<pg8::EpiResid, pg8::StaticOrder, true, true>(LDSP, g, S, E); }
        GRID_SYNC();
        { pg8::Gemm g{XB, WguT, M, 2 * FF, D}; pg8::StaticOrder S; S.init(M, 2 * FF, G, (int)blockIdx.x);
          pg8::EpiConvGlu E{HID, ss2, conv_w + (size_t)l * 3 * FF, conv_b + (size_t)l * FF, (float*)(ws + WS_UTMP), (PG8_LAS float*)(LDSP + XCH_OFF), FF};
          pg8::gemm_phase<pg8::EpiConvGlu, pg8::StaticOrder, true, true>(LDSP, g, S, E); }
        GRID_SYNC();
        { pg8::Gemm g{HID, WdT, M, D, FF}; pg8::StaticOrder S; S.init(M, D, G, (int)blockIdx.x); pg8::EpiResid E{X, X, XB, ss3};
          { pg8::Unit u; for (int i = 0; S.next(i, u); ++i) ffn_fixup((const float*)(ws + WS_UTMP), conv_w + (size_t)l * 3 * FF, conv_b + (size_t)l * FF, HID, u.pm, OTID());
            asm volatile("s_waitcnt vmcnt(0)" ::: "memory"); __syncthreads(); }
          pg8::gemm_phase<pg8::EpiResid, pg8::StaticOrder, true, true>(LDSP, g, S, E); }
        GRID_SYNC();
    }
    { const int tid = OTID(), lane = tid & 63, gw = blockIdx.x * 8 + (tid >> 6);
    for (int m = gw; m < M; m += NGW) final_row(X, ss + (size_t)4 * M, final_g, m, lane); }
}

extern "C" void kernel_launch(void* const* d_in, const int* in_sizes, int n_in, void* d_out, int out_size, void* d_ws, size_t ws_size, hipStream_t stream) {
    static int grid = 0;
    if (grid == 0) {
        if (n_in != 26 || in_sizes[0] != M * D || out_size != M * D || ws_size < WS_END) { fprintf(stderr, "kernel_launch: unexpected shapes (n_in %d, ws %zu)\n", n_in, ws_size); grid = -1; return; }
        int dev = 0, cus = 0, per_cu = 0;
        if (hipGetDevice(&dev) != hipSuccess || hipDeviceGetAttribute(&cus, hipDeviceAttributeMultiprocessorCount, dev) != hipSuccess) { grid = -1; return; }
        if (hipFuncSetAttribute((const void*)mega_fwd, hipFuncAttributeMaxDynamicSharedMemorySize, LDS_BYTES) != hipSuccess) { fprintf(stderr, "kernel_launch: hipFuncSetAttribute failed\n"); grid = -1; return; }
        if (hipOccupancyMaxActiveBlocksPerMultiprocessor(&per_cu, (const void*)mega_fwd, NTHREADS, LDS_BYTES) != hipSuccess || per_cu < 1) { fprintf(stderr, "kernel_launch: occupancy query failed (%d)\n", per_cu); grid = -1; return; }
        grid = cus;
    }
    if (grid < 0) return;
    (void)hipMemsetAsync((unsigned char*)d_ws + WS_CTL, 0, CTL_BYTES, stream);
    Args a{};
    for (int i = 0; i < 26; ++i) a.in[i] = (const float*)d_in[i];
    a.out = (float*)d_out; a.ws = (unsigned char*)d_ws;
    void* kargs[] = {&a};
    hipError_t e = hipLaunchCooperativeKernel((const void*)mega_fwd, dim3(grid), dim3(NTHREADS), kargs, LDS_BYTES, stream);
    if (e != hipSuccess) fprintf(stderr, "kernel_launch: cooperative launch failed: %s (grid %d)\n", hipGetErrorString(e), grid);
}
```

```cpp
#include <hip/hip_runtime.h>
#include <cstdio>
#include <cstdint>

typedef unsigned short bf16_t;
typedef short bf16x8 __attribute__((ext_vector_type(8)));
typedef float f32x4 __attribute__((ext_vector_type(4)));

constexpr int BATCH = 8, SEQ = 4096, D = 1024, M = BATCH * SEQ;
constexpr int HD = 64, ATT_W = 512, KV_W = 128, C = 512, NH = 8;
constexpr int ATT_IN = 768, SHIFT_W = 1792, IN_W = 2560, FF = 2816;
constexpr int WINDOW = 128;
constexpr float RMS_EPS = 1e-5f, LNX_EPS = 64e-5f;

constexpr size_t MiB = 1u << 20;
constexpr size_t WS_CTL = 0;
constexpr size_t WS_SS = 0;
constexpr size_t CTL_BYTES = 1 * MiB;
constexpr size_t WS_BAR = 768 * 1024;
constexpr size_t WS_W = 2 * MiB;
constexpr size_t W_IN_SZ = (size_t)IN_W * D * 2, W_OUT_SZ = (size_t)D * D * 2, W_GU_SZ = (size_t)2 * FF * D * 2, W_DN_SZ = (size_t)D * FF * 2;
constexpr size_t W_LAYER = W_IN_SZ + W_OUT_SZ + W_GU_SZ + W_DN_SZ;
constexpr size_t WS_VFIRST = 52 * MiB, WS_MIX = 84 * MiB, WS_XB = 148 * MiB, WS_PROJ = 212 * MiB;
constexpr size_t WS_SI_R = 148 * MiB, WS_SI_K = 180 * MiB, WS_SI_V = 372 * MiB, WS_SI_A = 404 * MiB, WS_SI_LD = 436 * MiB, WS_SI_G = 468 * MiB;
constexpr size_t WS_HID = 212 * MiB;
constexpr size_t WS_UTMP = 84 * MiB;
constexpr size_t WS_END = 500 * MiB;
static_assert(WS_W + 2 * W_LAYER <= WS_VFIRST, "weights fit");

__device__ __forceinline__ unsigned f2bf(float f) { unsigned u = __builtin_bit_cast(unsigned, f); return (u + 0x7fffu + ((u >> 16) & 1u)) >> 16; }
__device__ __forceinline__ float bf2f(bf16_t h) { return __builtin_bit_cast(float, (unsigned)h << 16); }
__device__ __forceinline__ float wave_sum(float v) {
#pragma unroll
    for (int o = 1; o < 64; o <<= 1) v += __shfl_xor(v, o);
    return v;
}
__device__ __forceinline__ float sigmoidf_(float x) { return 1.f / (1.f + __expf(-x)); }

namespace pg8 {
#define PG8_LAS __attribute__((address_space(3)))
typedef unsigned short bf16_t;
typedef short bf16x8 __attribute__((ext_vector_type(8)));
typedef float f32x4 __attribute__((ext_vector_type(4)));
typedef unsigned u32x4 __attribute__((ext_vector_type(4)));
constexpr int BM = 256, BK = 64, HALF = 128, HTB = HALF * BK * 2  , STAGE_BYTES = 8 * HTB, NXCD = 8, WGM = 8;

__host__ __device__ __forceinline__ int lds_byte(int r, int c) { const int st = (r >> 4) * 2 + (c >> 5), rr = r & 15, cc = c & 31, ob = rr * 64 + cc * 2; return st * 1024 + (ob ^ (((ob >> 9) & 1) << 5)); }
__host__ __device__ __forceinline__ void stage_rc(int b, int& R, int& C) { const int st = b / 1024, sb = b % 1024, swz = sb ^ (((sb >> 9) & 1) << 5); R = (st >> 1) * 16 + swz / 64; C = (st & 1) * 32 + (swz % 64) / 2; }
__host__ __device__ __forceinline__ int perm32(int rho) { const int n = rho >> 4, i = rho & 15; return 8 * (i >> 2) + 4 * n + (i & 3); }

struct Unit { int pm, pn; };
struct Gemm { const bf16_t* A; const bf16_t* Bt; int M, N, K; };

struct StaticOrder {
    int nM, nN, nwg, G, c;
    __host__ __device__ void init(int M, int N, int G_, int c_) { nM = M / BM; nN = N / BM; nwg = nM * nN; G = G_; c = c_; }
    __host__ __device__ bool next(int i, Unit& u) const {
        const long L = (long)i * G + c; if (L >= nwg) return false;
        int wgid = (int)L; { const int q = nwg / NXCD, r = nwg % NXCD, xcd = wgid % NXCD, off = wgid / NXCD; wgid = (xcd < r ? xcd * (q + 1) : r * (q + 1) + (xcd - r) * q) + off; }
        const int nig = WGM * nN, gid = wgid / nig, fm = gid * WGM, gsz = (nM - fm) < WGM ? (nM - fm) : WGM;
        u.pm = fm + ((wgid % nig) % gsz); u.pn = (wgid % nig) / gsz; return true;
    }
    __device__ __forceinline__ void a_ready(const Unit&) const {}
    __device__ __forceinline__ void done(const Unit&) const {}
};
typedef float f32x2_t_ __attribute__((ext_vector_type(2))); typedef __bf16 bf16x2_t_ __attribute__((ext_vector_type(2)));
__device__ __forceinline__ unsigned cvt_pk_bf16(float lo, float hi) { const f32x2_t_ v = {lo, hi}; const bf16x2_t_ b = __builtin_convertvector(v, bf16x2_t_); return __builtin_bit_cast(unsigned, b); }
typedef float f32x2 __attribute__((ext_vector_type(2)));
template <class Epi, class Sched, bool ALIGN_EPI = false, bool SP2 = false>
__device__ __forceinline__ void gemm_phase(PG8_LAS unsigned char* lds, const Gemm g, const Sched& S, const Epi& E) {
    int tid_ = threadIdx.x; asm volatile("" : "+v"(tid_));
    const int tid = tid_, wid = __builtin_amdgcn_readfirstlane(tid >> 6), lane = tid & 63, wr = wid >> 2, wc = wid & 3, fr = lane & 15, fq = lane >> 4;
    const int K = g.K, nt = K / BK;
    unsigned voffA[2], voffB[2];
#pragma unroll
    for (int i = 0; i < 2; ++i) { int R, C; stage_rc(tid * 16 + i * 8192, R, C); const int Rb = Epi::PERM ? ((R & ~31) + perm32(R & 31)) : R;
        voffA[i] = (unsigned)(R * K + C) * 2u; voffB[i] = (unsigned)(Rb * K + C) * 2u; }
    const size_t kstep = (size_t)(BK * 2);
    const size_t hstep = (size_t)HALF * K * 2;
    const size_t tstep = 2 * hstep;
    const unsigned ldsw = (unsigned)wid * 1024u;
    const int aoff = lds_byte(wr * 64 + fr, fq * 8), boff = lds_byte(wc * 32 + fr, fq * 8);
#define PG8_SA(b, h) (((b) * 2 + (h)) * HTB)
#define PG8_SB(b, h) ((4 + (b) * 2 + (h)) * HTB)
#define PG8_STAGE(bufoff, gbase, voff) do { _Pragma("unroll") for (int _i = 0; _i < 2; ++_i) \
        __builtin_amdgcn_global_load_lds((const unsigned*)((const char*)(gbase) + (voff)[_i]), (PG8_LAS unsigned*)(lds + (bufoff) + ldsw + _i * 8192), 16, 0, 0); } while (0)
#define PG8_LDA(dst, b, h) do { _Pragma("unroll") for (int m = 0; m < 4; ++m) _Pragma("unroll") for (int k = 0; k < 2; ++k) dst[m][k] = *(const PG8_LAS bf16x8*)(lds + PG8_SA(b, h) + aoff + m * 2048 + k * 1024); } while (0)
#define PG8_LDB(dst, b, h) do { _Pragma("unroll") for (int n = 0; n < 2; ++n) _Pragma("unroll") for (int k = 0; k < 2; ++k) dst[n][k] = *(const PG8_LAS bf16x8*)(lds + PG8_SB(b, h) + boff + n * 2048 + k * 1024); } while (0)
#define PG8_MMA(ai, bj, At, Bt) do { __builtin_amdgcn_s_setprio(1); _Pragma("unroll") for (int m = 0; m < 4; ++m) _Pragma("unroll") for (int n = 0; n < 2; ++n) _Pragma("unroll") for (int k = 0; k < 2; ++k) \
        acc[ai][bj][m][n] = __builtin_amdgcn_mfma_f32_16x16x32_bf16(Bt[n][k], At[m][k], acc[ai][bj][m][n], 0, 0, 0); __builtin_amdgcn_s_setprio(0); } while (0)
#define PG8_WAIT_V(n) asm volatile("s_waitcnt vmcnt(" #n ")" ::: "memory")
#define PG8_WAIT_L(n) asm volatile("s_waitcnt lgkmcnt(" #n ")" ::: "memory")
#define PG8_BAR __builtin_amdgcn_s_barrier()
#define PG8_SCHED __builtin_amdgcn_sched_barrier(0)
    Unit cur, nxt; int ui = 0;
    if (!S.next(0, cur)) return;
    f32x4 acc[2][2][4][2];
#pragma unroll
    for (int a = 0; a < 2; ++a)
#pragma unroll
        for (int b = 0; b < 2; ++b)
#pragma unroll
            for (int m = 0; m < 4; ++m)
#pragma unroll
                for (int n = 0; n < 2; ++n) acc[a][b][m][n] = (f32x4){0.f, 0.f, 0.f, 0.f};
    bf16x8 At[4][2], B0[2][2], B1[2][2];
    const char* cA = (const char*)g.A + (size_t)cur.pm * tstep; const char* cB = (const char*)g.Bt + (size_t)cur.pn * tstep;
    S.a_ready(cur);
    if constexpr (SP2) {
        PG8_STAGE(PG8_SB(0, 0), cB, voffB); PG8_STAGE(PG8_SB(0, 1), cB + hstep, voffB); PG8_STAGE(PG8_SA(0, 0), cA, voffA); PG8_STAGE(PG8_SA(0, 1), cA + hstep, voffA);
        if (wr == 1) PG8_BAR;
        PG8_WAIT_V(2); PG8_BAR;
        PG8_STAGE(PG8_SB(1, 0), cB + kstep, voffB); PG8_STAGE(PG8_SA(1, 0), cA + kstep, voffA); PG8_STAGE(PG8_SB(1, 1), cB + hstep + kstep, voffB);
        PG8_WAIT_V(6); PG8_BAR;
    } else {
        PG8_STAGE(PG8_SB(0, 0), cB, voffB); PG8_STAGE(PG8_SA(0, 0), cA, voffA); PG8_STAGE(PG8_SB(0, 1), cB + hstep, voffB); PG8_STAGE(PG8_SA(0, 1), cA + hstep, voffA);
        if (wr == 1) PG8_BAR;
        PG8_WAIT_V(4); PG8_BAR;
        PG8_STAGE(PG8_SB(1, 0), cB + kstep, voffB); PG8_STAGE(PG8_SA(1, 0), cA + kstep, voffA); PG8_STAGE(PG8_SB(1, 1), cB + hstep + kstep, voffB);
        PG8_WAIT_V(6); PG8_BAR;
    }
    for (;;) {
        const bool has_next = S.next(ui + 1, nxt);
        const char* nA = has_next ? (const char*)g.A + (size_t)nxt.pm * tstep : cA; const char* nB = has_next ? (const char*)g.Bt + (size_t)nxt.pn * tstep : cB;
        for (int t = 0; t < nt; t += 2) {
            const bool last = (t == nt - 2);
            const char* a1 = cA + (size_t)(t + 1) * kstep;
            const char* a2 = last ? nA : cA + (size_t)(t + 2) * kstep; const char* b2 = last ? nB : cB + (size_t)(t + 2) * kstep;
            const char* a3 = a2 + kstep; const char* b3 = b2 + kstep;
            if (last && has_next) S.a_ready(nxt);
            if constexpr (SP2) {
            PG8_LDB(B0, 0, 0); PG8_LDB(B1, 0, 1); PG8_SCHED; PG8_LDA(At, 0, 0); PG8_STAGE(PG8_SA(1, 1), a1 + hstep, voffA);
            PG8_WAIT_V(8); PG8_WAIT_L(0); PG8_BAR; PG8_MMA(0, 0, At, B0); PG8_MMA(0, 1, At, B1); PG8_BAR; PG8_SCHED;
            PG8_LDA(At, 0, 1); PG8_STAGE(PG8_SB(0, 0), b2, voffB); PG8_STAGE(PG8_SB(0, 1), b2 + hstep, voffB); PG8_STAGE(PG8_SA(0, 0), a2, voffA);
            PG8_WAIT_V(8); PG8_WAIT_L(0); PG8_BAR; PG8_MMA(1, 0, At, B0); PG8_MMA(1, 1, At, B1); PG8_BAR; PG8_SCHED;
            PG8_LDB(B0, 1, 0); PG8_LDB(B1, 1, 1); PG8_SCHED; PG8_LDA(At, 1, 0); PG8_STAGE(PG8_SA(0, 1), a2 + hstep, voffA);
            PG8_WAIT_V(8); PG8_WAIT_L(0); PG8_BAR; PG8_MMA(0, 0, At, B0); PG8_MMA(0, 1, At, B1); PG8_BAR; PG8_SCHED;
            PG8_LDA(At, 1, 1); PG8_STAGE(PG8_SB(1, 0), b3, voffB); PG8_STAGE(PG8_SB(1, 1), b3 + hstep, voffB); PG8_STAGE(PG8_SA(1, 0), a3, voffA);
            PG8_WAIT_V(8); PG8_WAIT_L(0); PG8_BAR; PG8_MMA(1, 0, At, B0); PG8_MMA(1, 1, At, B1); PG8_BAR; PG8_SCHED;
            } else {
            PG8_LDB(B0, 0, 0); PG8_SCHED; PG8_LDA(At, 0, 0); PG8_STAGE(PG8_SA(1, 1), a1 + hstep, voffA);
            PG8_WAIT_L(8); PG8_BAR; PG8_WAIT_L(0); PG8_MMA(0, 0, At, B0); PG8_BAR; PG8_SCHED;
            PG8_LDB(B1, 0, 1); PG8_STAGE(PG8_SB(0, 0), b2, voffB);
            PG8_BAR; PG8_WAIT_L(0); PG8_MMA(0, 1, At, B1); PG8_BAR;
            PG8_LDA(At, 0, 1); PG8_STAGE(PG8_SA(0, 0), a2, voffA);
            PG8_BAR; PG8_WAIT_L(0); PG8_MMA(1, 0, At, B0); PG8_BAR; PG8_SCHED;
            PG8_STAGE(PG8_SB(0, 1), b2 + hstep, voffB);
            PG8_WAIT_V(6); PG8_BAR; PG8_MMA(1, 1, At, B1); PG8_BAR;
            PG8_LDB(B0, 1, 0); PG8_SCHED; PG8_LDA(At, 1, 0); PG8_STAGE(PG8_SA(0, 1), a2 + hstep, voffA);
            PG8_WAIT_L(8); PG8_BAR; PG8_WAIT_L(0); PG8_MMA(0, 0, At, B0); PG8_BAR; PG8_SCHED;
            PG8_LDB(B1, 1, 1); PG8_STAGE(PG8_SB(1, 0), b3, voffB);
            PG8_BAR; PG8_WAIT_L(0); PG8_MMA(0, 1, At, B1); PG8_BAR;
            PG8_LDA(At, 1, 1); PG8_STAGE(PG8_SA(1, 0), a3, voffA);
            PG8_BAR; PG8_WAIT_L(0); PG8_MMA(1, 0, At, B0); PG8_BAR; PG8_SCHED;
            PG8_STAGE(PG8_SB(1, 1), b3 + hstep, voffB);
            PG8_WAIT_V(6); PG8_BAR; PG8_MMA(1, 1, At, B1); PG8_BAR;
            }
        }
        if constexpr (ALIGN_EPI) { if (wr == 0) PG8_BAR; }
        if constexpr (!Epi::AFTER_DRAIN) { E(acc, cur, wr, wc, fr, fq); S.done(cur); }
        if (!has_next) break;
#pragma unroll
        for (int a = 0; a < 2; ++a)
#pragma unroll
            for (int b = 0; b < 2; ++b)
#pragma unroll
                for (int m = 0; m < 4; ++m)
#pragma unroll
                    for (int n = 0; n < 2; ++n) acc[a][b][m][n] = (f32x4){0.f, 0.f, 0.f, 0.f};
        cur = nxt; cA = nA; cB = nB; ++ui;
        if constexpr (ALIGN_EPI) { if (wr == 1) PG8_BAR; }
    }
    PG8_WAIT_V(0);
    if constexpr (!ALIGN_EPI) { if (wr == 0) PG8_BAR; }
    PG8_BAR;
    if constexpr (Epi::AFTER_DRAIN) { E.fused(acc, cur, wr, wc, fr, fq, lds, wid, lane); S.done(cur); }
#undef PG8_SA
#undef PG8_SB
#undef PG8_STAGE
#undef PG8_LDA
#undef PG8_LDB
#undef PG8_MMA
#undef PG8_WAIT_V
#undef PG8_WAIT_L
#undef PG8_BAR
#undef PG8_SCHED
}

constexpr int DM_ = 1024; constexpr float RMS_EPS_ = 1e-5f;
__device__ __forceinline__ float rstd_of(const float* ss, int row) { return __builtin_amdgcn_rsqf(ss[row] * (1.0f / DM_) + RMS_EPS_); }
struct EpiScaleBf16 {
    static constexpr bool PERM = true, AFTER_DRAIN = false;
    bf16_t* O; int ldc; const float* ss;
    __device__ __forceinline__ void operator()(const f32x4 (&acc)[2][2][4][2], const Unit& u, int wr, int wc, int fr, int fq) const {
        const int row0 = u.pm * BM + wr * 64 + fr, col0 = u.pn * BM + wc * 32 + 8 * fq;
        float rsv[2][4];
#pragma unroll
        for (int ai = 0; ai < 2; ++ai)
#pragma unroll
            for (int m = 0; m < 4; ++m) rsv[ai][m] = ss[row0 + ai * HALF + m * 16];
#pragma unroll
        for (int ai = 0; ai < 2; ++ai)
#pragma unroll
            for (int m = 0; m < 4; ++m) { const int row = row0 + ai * HALF + m * 16; const float rs = __builtin_amdgcn_rsqf(rsv[ai][m] * (1.0f / DM_) + RMS_EPS_); bf16_t* rowp = O + (size_t)row * ldc + col0;
#pragma unroll
                for (int bj = 0; bj < 2; ++bj) { const f32x4 v0 = acc[ai][bj][m][0] * rs, v1 = acc[ai][bj][m][1] * rs;
                    u32x4 w; w.x = cvt_pk_bf16(v0[0], v0[1]); w.y = cvt_pk_bf16(v0[2], v0[3]); w.z = cvt_pk_bf16(v1[0], v1[1]); w.w = cvt_pk_bf16(v1[2], v1[3]);
                    *(u32x4*)(rowp + bj * HALF) = w; } }
    }
};
struct EpiResid {
    static constexpr bool PERM = false, AFTER_DRAIN = false;
    const float* base; float* xout; bf16_t* xb; float* ss_out;
    __device__ __forceinline__ void operator()(const f32x4 (&acc)[2][2][4][2], const Unit& u, int wr, int wc, int fr, int fq) const {
        typedef unsigned u32x2v __attribute__((ext_vector_type(2)));
        const int row0 = u.pm * BM + wr * 64 + fr, col0 = u.pn * BM + wc * 32 + 4 * fq;
#pragma unroll
        for (int ai = 0; ai < 2; ++ai)
#pragma unroll
            for (int m = 0; m < 4; ++m) { const int row = row0 + ai * HALF + m * 16; const size_t off = (size_t)row * DM_ + col0; float sq = 0.f;
#pragma unroll
                for (int bj = 0; bj < 2; ++bj)
#pragma unroll
                    for (int n = 0; n < 2; ++n) { const size_t o = off + bj * HALF + n * 16; const f32x4 x = *(const f32x4*)(base + o) + acc[ai][bj][m][n];
                        *(f32x4*)(xout + o) = x; u32x2v w; w.x = cvt_pk_bf16(x[0], x[1]); w.y = cvt_pk_bf16(x[2], x[3]); *(u32x2v*)(xb + o) = w;
                        sq += (x[0] * x[0] + x[1] * x[1]) + (x[2] * x[2] + x[3] * x[3]); }
                sq += __shfl_xor(sq, 16); sq += __shfl_xor(sq, 32);
                if (fq == 0) atomicAdd(ss_out + row, sq); }
    }
};
struct EpiGateUpTmp {
    static constexpr bool PERM = true, AFTER_DRAIN = false;
    bf16_t* U; bf16_t* UP; const float* ss; int ff;
    __device__ __forceinline__ void operator()(const f32x4 (&acc)[2][2][4][2], const Unit& u, int wr, int wc, int fr, int fq) const {
        const int row0 = u.pm * BM + wr * 64 + fr, col0 = u.pn * HALF + wc * 32 + 8 * fq;
        float rsv[2][4];
#pragma unroll
        for (int ai = 0; ai < 2; ++ai)
#pragma unroll
            for (int m = 0; m < 4; ++m) rsv[ai][m] = ss[row0 + ai * HALF + m * 16];
#pragma unroll
        for (int ai = 0; ai < 2; ++ai)
#pragma unroll
            for (int m = 0; m < 4; ++m) { const int row = row0 + ai * HALF + m * 16; const float rs = __builtin_amdgcn_rsqf(rsv[ai][m] * (1.0f / DM_) + RMS_EPS_); const size_t o = (size_t)row * ff + col0;
#pragma unroll
                for (int bj = 0; bj < 2; ++bj) { const f32x4 v0 = acc[ai][bj][m][0] * rs, v1 = acc[ai][bj][m][1] * rs;
                    u32x4 w; w.x = cvt_pk_bf16(v0[0], v0[1]); w.y = cvt_pk_bf16(v0[2], v0[3]); w.z = cvt_pk_bf16(v1[0], v1[1]); w.w = cvt_pk_bf16(v1[2], v1[3]);
                    *(u32x4*)((bj == 0 ? U : UP) + o) = w; } }
    }
};
template <int CTRL> __device__ __forceinline__ float dpp1(float x) { return __builtin_bit_cast(float, __builtin_amdgcn_update_dpp(0, __builtin_bit_cast(int, x), CTRL, 0xF, 0xF, true)); }
template <int CTRL> __device__ __forceinline__ f32x4 dpp4(const f32x4 x) { return (f32x4){dpp1<CTRL>(x.x), dpp1<CTRL>(x.y), dpp1<CTRL>(x.z), dpp1<CTRL>(x.w)}; }
struct EpiConvGlu {
    static constexpr bool PERM = true, AFTER_DRAIN = false;
    bf16_t* HID; const float* ss; const float* cw; const float* cb; float* SB; PG8_LAS float* xch; int ff;
    __device__ __forceinline__ void operator()(const f32x4 (&acc)[2][2][4][2], const Unit& u, int wr, int wc, int fr, int fq) const {
        const int row0 = u.pm * BM + wr * 64 + fr, cl = wc * 32 + 8 * fq, jcol = u.pn * HALF + cl;
        float rs[2][4];
#pragma unroll
        for (int ai = 0; ai < 2; ++ai)
#pragma unroll
            for (int m = 0; m < 4; ++m) rs[ai][m] = ss[row0 + ai * HALF + m * 16];
        f32x4 w0[2], w1[2], w2[2], bb[2];
#pragma unroll
        for (int n = 0; n < 2; ++n) { w0[n] = *(const f32x4*)(cw + jcol + 4 * n); w1[n] = *(const f32x4*)(cw + ff + jcol + 4 * n); w2[n] = *(const f32x4*)(cw + 2 * ff + jcol + 4 * n); bb[n] = *(const f32x4*)(cb + jcol + 4 * n); }
#pragma unroll
        for (int ai = 0; ai < 2; ++ai)
#pragma unroll
            for (int m = 0; m < 4; ++m) rs[ai][m] = __builtin_amdgcn_rsqf(rs[ai][m] * (1.0f / DM_) + RMS_EPS_);
        if (fr >= 14) {
#pragma unroll
            for (int ai = 0; ai < 2; ++ai)
#pragma unroll
                for (int n = 0; n < 2; ++n) *(PG8_LAS f32x4*)(xch + ((2 * ai + wr) * 2 + (fr - 14)) * HALF + cl + 4 * n) = acc[ai][0][3][n] * rs[ai][3];
        }
        asm volatile("s_waitcnt lgkmcnt(0)" ::: "memory"); __builtin_amdgcn_s_barrier(); asm volatile("" ::: "memory");
        float* sbp = SB + (size_t)u.pm * 6 * ff + jcol;
#pragma unroll
        for (int ai = 0; ai < 2; ++ai) {
            const int q = 2 * ai + wr;
            f32x4 X[2];
#pragma unroll
            for (int n = 0; n < 2; ++n) { X[n] = (f32x4){0.f, 0.f, 0.f, 0.f}; if (q > 0 && fr >= 14) X[n] = *(const PG8_LAS f32x4*)(xch + ((q - 1) * 2 + (fr - 14)) * HALF + cl + 4 * n); }
#pragma unroll
            for (int m = 0; m < 4; ++m) { const int row = row0 + ai * HALF + m * 16;
                pg8::u32x4 hw;
#pragma unroll
                for (int n = 0; n < 2; ++n) {
                    const f32x4 cur = acc[ai][0][m][n] * rs[ai][m], up = acc[ai][1][m][n] * rs[ai][m];
                    const f32x4 P = (m > 0) ? acc[ai][0][m > 0 ? m - 1 : 0][n] * rs[ai][m > 0 ? m - 1 : 0] : X[n];
                    const f32x4 a1 = dpp4<0x121>(cur), b1 = dpp4<0x121>(P), a2 = dpp4<0x122>(cur), b2 = dpp4<0x122>(P);
                    f32x4 p1, p2;
#pragma unroll
                    for (int e = 0; e < 4; ++e) { p1[e] = fr == 0 ? b1[e] : a1[e]; p2[e] = fr < 2 ? b2[e] : a2[e]; }
                    const f32x4 c = bb[n] + w0[n] * p2 + w1[n] * p1 + w2[n] * cur;
                    f32x4 hv;
#pragma unroll
                    for (int e = 0; e < 4; ++e) hv[e] = c[e] * __builtin_amdgcn_rcpf(1.f + __expf(-c[e])) * up[e];
                    if (n == 0) { hw.x = cvt_pk_bf16(hv[0], hv[1]); hw.y = cvt_pk_bf16(hv[2], hv[3]); } else { hw.z = cvt_pk_bf16(hv[0], hv[1]); hw.w = cvt_pk_bf16(hv[2], hv[3]); }
                    if (q == 0 && m == 0 && fr < 2) { *(f32x4*)(sbp + (size_t)fr * ff + 4 * n) = cur; *(f32x4*)(sbp + (size_t)(2 + fr) * ff + 4 * n) = up; }
                    if (q == 3 && m == 3 && fr >= 14) *(f32x4*)(sbp + (size_t)(4 + fr - 14) * ff + 4 * n) = cur;
                }
                *(pg8::u32x4*)(HID + (size_t)row * ff + jcol) = hw; }
        }
    }
};
}

#define LAS __attribute__((address_space(3)))
__device__ __forceinline__ void transpose_item(const float* __restrict__ W, int K, int N, bf16_t* __restrict__ Wt, const float* __restrict__ g, int mode, float* scr, int item, int lane) {
    const int nblk = N / 32, kb = item / nblk, nb = item % nblk, k0 = 64 * kb, n0 = 32 * nb;
    int np0 = n0; if (mode == 1) np0 = 256 * (n0 / 128) + (n0 % 128); else if (mode == 2) np0 = 256 * (n0 / 128) + 128 + (n0 % 128);
#pragma unroll 8
    for (int i = 0; i < 32; ++i) { const int kk = 2 * i + (lane >> 5); scr[kk * 33 + (lane & 31)] = W[(size_t)(k0 + kk) * N + n0 + (lane & 31)] * (g ? g[k0 + kk] : 1.f); }
    __builtin_amdgcn_fence(__ATOMIC_RELEASE, "wavefront"); __builtin_amdgcn_wave_barrier(); __builtin_amdgcn_fence(__ATOMIC_ACQUIRE, "wavefront");
    const int c = lane & 7;
#pragma unroll
    for (int j = 0; j < 4; ++j) { const int n = (lane >> 3) + 8 * j; const float* sp = scr + (8 * c) * 33 + n;
        uint4 o; o.x = f2bf(sp[0]) | (f2bf(sp[33]) << 16); o.y = f2bf(sp[2 * 33]) | (f2bf(sp[3 * 33]) << 16); o.z = f2bf(sp[4 * 33]) | (f2bf(sp[5 * 33]) << 16); o.w = f2bf(sp[6 * 33]) | (f2bf(sp[7 * 33]) << 16);
        *(uint4*)(Wt + (size_t)(np0 + n) * K + k0 + 8 * c) = o; }
    __builtin_amdgcn_fence(__ATOMIC_RELEASE, "wavefront"); __builtin_amdgcn_wave_barrier(); __builtin_amdgcn_fence(__ATOMIC_ACQUIRE, "wavefront");
}
__device__ __forceinline__ void x_row_to_bf16(const float* __restrict__ x, bf16_t* __restrict__ xb, float* __restrict__ ss, int row, int lane) {
    const f32x4* xr = (const f32x4*)(x + (size_t)row * D) + lane; float s = 0.f;
#pragma unroll
    for (int j = 0; j < 4; ++j) { const f32x4 v = xr[64 * j]; s += v.x * v.x + v.y * v.y + v.z * v.z + v.w * v.w;
        unsigned long long o = (unsigned long long)(f2bf(v.x) | (f2bf(v.y) << 16)) | ((unsigned long long)(f2bf(v.z) | (f2bf(v.w) << 16)) << 32);
        ((unsigned long long*)(xb + (size_t)row * D))[lane + 64 * j] = o; }
    s = wave_sum(s); if (lane == 0) ss[row] = s;
}

struct EpArgs {
    const float* ss; float* ss_out; const float* base; float* xout; bf16_t* ob; bf16_t* ob2; int ldo; int row_off;
};
template <int MODE>
__device__ __forceinline__ void gemm_simple(const bf16_t* __restrict__ A, int lda, const bf16_t* __restrict__ Bt, int ldb, int Mrows, int N, int K, EpArgs e, int tid) {
    const int wid = tid >> 6, lane = tid & 63, fr = lane & 15, fq = lane >> 4;
    const int ntn = N / 128, ntiles = (Mrows / 64) * ntn;
    for (int tile = blockIdx.x; tile < ntiles; tile += gridDim.x) {
    const int row0 = (tile / ntn) * 64 + (wid >> 2) * 32, col0 = (tile % ntn) * 128 + (wid & 3) * 32;
    f32x4 acc[2][2];
#pragma unroll
    for (int i = 0; i < 2; ++i)
#pragma unroll
        for (int j = 0; j < 2; ++j) acc[i][j] = (f32x4){0.f, 0.f, 0.f, 0.f};
    const bf16_t* ap = A + (size_t)(row0 + fr) * lda + fq * 8;
    const bf16_t* bp = Bt + (size_t)(col0 + fr) * ldb + fq * 8;
    for (int k0 = 0; k0 < K; k0 += 32) {
        bf16x8 a[2], b[2];
#pragma unroll
        for (int i = 0; i < 2; ++i) { a[i] = *(const bf16x8*)(ap + (size_t)i * 16 * lda + k0); b[i] = *(const bf16x8*)(bp + (size_t)i * 16 * ldb + k0); }
#pragma unroll
        for (int i = 0; i < 2; ++i)
#pragma unroll
            for (int j = 0; j < 2; ++j) acc[i][j] = __builtin_amdgcn_mfma_f32_16x16x32_bf16(a[i], b[j], acc[i][j], 0, 0, 0);
    }
#pragma unroll
    for (int i = 0; i < 2; ++i)
#pragma unroll
        for (int r = 0; r < 4; ++r) {
            const int row = row0 + i * 16 + fq * 4 + r;
            float rstd = 1.f;
            if (MODE == 0 || MODE == 2) rstd = rsqrtf(e.ss[row] * (1.f / D) + RMS_EPS);
            float sq = 0.f;
#pragma unroll
            for (int j = 0; j < 2; ++j) {
                const int col = col0 + j * 16 + fr; const float v = acc[i][j][r];
                if (MODE == 0) e.ob[(size_t)row * e.ldo + col] = (bf16_t)f2bf(v * rstd);
                else if (MODE == 1) { const size_t o = (size_t)row * D + col; const float x = e.base[o] + v; e.xout[o] = x; e.ob[o] = (bf16_t)f2bf(x); sq += x * x; }
                else { const int p = col >> 8, jj = col & 255; const size_t o = (size_t)(row - e.row_off) * FF + 128 * p + (jj & 127);
                    if (jj < 128) e.ob[o] = (bf16_t)f2bf(v * rstd); else e.ob2[o] = (bf16_t)f2bf(v * rstd); }
            }
            if (MODE == 1) {
                sq += __shfl_xor(sq, 1); sq += __shfl_xor(sq, 2); sq += __shfl_xor(sq, 4); sq += __shfl_xor(sq, 8);
                if (fr == 0) atomicAdd(e.ss_out + row, sq);
            }
        }
    }
}

struct PrepArgs {
    const bf16_t* proj; const float* mu; const float* w0; const float* w2; const float* a0; const float* a2; const float* g2;
    const float* v0; const float* v1; const float* v2; bf16_t* vfirst; int layer; int pad;
    bf16_t *R, *K, *V, *A, *LD, *G;
};
__device__ __forceinline__ void prep_group(const PrepArgs& p, float (*rest)[SHIFT_W], float (*vlo)[32], int grp, int tid) {
    const int m0 = grp * 4;
    for (int i = tid; i < 4 * SHIFT_W; i += 512) {
        const int tk = i / SHIFT_W, c = i % SHIFT_W, m = m0 + tk, t = m % SEQ;
        const float u = bf2f(p.proj[(size_t)m * IN_W + ATT_IN + c]);
        const float up = t > 0 ? bf2f(p.proj[(size_t)(m - 1) * IN_W + ATT_IN + c]) : 0.f;
        float v = u + (up - u) * p.mu[c];
        if (c >= 1536 && c < 1600) v = tanhf(v); else if (c >= 1664) v = sigmoidf_(v);
        rest[tk][c] = v;
    }
    __syncthreads();
    if (p.layer > 0 && tid < 128) { const int tk = tid >> 5, j = tid & 31; float s = 0.f; for (int c = 0; c < C; ++c) s += rest[tk][1024 + c] * p.v1[c * 32 + j]; vlo[tk][j] = s; }
    __syncthreads();
    const int c = tid;
    float wp[4], ap[4], gp[4];
#pragma unroll
    for (int tk = 0; tk < 4; ++tk) { wp[tk] = p.w0[c]; ap[tk] = p.a0[c]; gp[tk] = 0.f; }
    for (int k = 0; k < 64; ++k) { const float w = p.w2[k * C + c], a = p.a2[k * C + c];
#pragma unroll
        for (int tk = 0; tk < 4; ++tk) { wp[tk] += rest[tk][1536 + k] * w; ap[tk] += rest[tk][1600 + k] * a; } }
    for (int k = 0; k < 128; ++k) { const float g = p.g2[k * C + c];
#pragma unroll
        for (int tk = 0; tk < 4; ++tk) gp[tk] += rest[tk][1664 + k] * g; }
#pragma unroll
    for (int tk = 0; tk < 4; ++tk) {
        const size_t o = (size_t)(m0 + tk) * C + c;
        const float x = -wp[tk];
        const float sp = fmaxf(x, 0.f) + log1pf(__expf(-fabsf(x)));
        const float wraw = -sp - 0.5f;
        const float ld = -__expf(wraw);
        const float a = sigmoidf_(ap[tk]);
        float v = rest[tk][1024 + c];
        if (p.layer == 0) p.vfirst[o] = (bf16_t)f2bf(v);
        else { float s = p.v0[c]; for (int j = 0; j < 32; ++j) s += vlo[tk][j] * p.v2[j * C + c]; const float vf = bf2f(p.vfirst[o]); v = v + (vf - v) * sigmoidf_(s); }
        p.R[o] = (bf16_t)f2bf(rest[tk][c]); p.K[o] = (bf16_t)f2bf(rest[tk][512 + c]); p.V[o] = (bf16_t)f2bf(v);
        p.A[o] = (bf16_t)f2bf(a); p.LD[o] = (bf16_t)f2bf(ld); p.G[o] = (bf16_t)f2bf(gp[tk]);
    }
    __syncthreads();
}

constexpr size_t WS_LORA = 50 * MiB;
constexpr size_t LORA_LAYER = 256 * 1024, WS_V1T = WS_LORA + 2 * LORA_LAYER, WS_V2T = WS_V1T + 32 * 1024;
constexpr int PR_ACT_LD = 264, PR_VLO_LD = 40, PR_SG_LD = 520, PR_ACT_OFF = 0, PR_VLO_OFF = 64 * PR_ACT_LD * 2, PR_SG_OFF = PR_VLO_OFF + 64 * PR_VLO_LD * 2;
struct Prep2Args {
    const bf16_t* proj; const float* mu; const float* w0; const float* a0; const float* v0;
    const bf16_t *W2T, *A2T, *G2T, *V1T, *V2T; bf16_t* vfirst; bf16_t *R, *K, *V, *A, *LD, *G; int layer; int pad;
};
__device__ __forceinline__ f32x4 bfx4_lo(const bf16x8 v) { return (f32x4){bf2f((bf16_t)v[0]), bf2f((bf16_t)v[1]), bf2f((bf16_t)v[2]), bf2f((bf16_t)v[3])}; }
__device__ __forceinline__ f32x4 bfx4_hi(const bf16x8 v) { return (f32x4){bf2f((bf16_t)v[4]), bf2f((bf16_t)v[5]), bf2f((bf16_t)v[6]), bf2f((bf16_t)v[7])}; }
__device__ __forceinline__ bf16x8 pack8(const f32x4 a, const f32x4 b) { pg8::u32x4 w; w.x = pg8::cvt_pk_bf16(a[0], a[1]); w.y = pg8::cvt_pk_bf16(a[2], a[3]); w.z = pg8::cvt_pk_bf16(b[0], b[1]); w.w = pg8::cvt_pk_bf16(b[2], b[3]); return __builtin_bit_cast(bf16x8, w); }
__device__ __forceinline__ void shift8(const bf16_t* __restrict__ proj, const float* __restrict__ mu, size_t m, int t, int col, int mi, f32x4& lo, f32x4& hi) {
    const bf16x8 cur = *(const bf16x8*)(proj + m * IN_W + col);
    bf16x8 prv; if (t > 0) prv = *(const bf16x8*)(proj + (m - 1) * IN_W + col); else prv = (bf16x8){0, 0, 0, 0, 0, 0, 0, 0};
    const f32x4 m0 = *(const f32x4*)(mu + mi), m1 = *(const f32x4*)(mu + mi + 4);
    const f32x4 c0 = bfx4_lo(cur), c1 = bfx4_hi(cur), p0 = bfx4_lo(prv), p1 = bfx4_hi(prv);
    lo = c0 + (p0 - c0) * m0; hi = c1 + (p1 - c1) * m1;
}
__device__ __forceinline__ void prep_tile(const Prep2Args& p, unsigned char* lds, int tile, int tid) {
    const int m0 = tile * 64, wave = __builtin_amdgcn_readfirstlane(tid >> 6), lane = tid & 63, fr = lane & 15, fq = lane >> 4;
    bf16_t* ACT = (bf16_t*)(lds + PR_ACT_OFF); bf16_t* VLO = (bf16_t*)(lds + PR_VLO_OFF); bf16_t* SG = (bf16_t*)(lds + PR_SG_OFF);
#pragma unroll
    for (int it = 0; it < 4; ++it) { const int i = tid + 512 * it, tk = i >> 5, cc = i & 31; const size_t m = (size_t)m0 + tk; const int t = (int)(m % SEQ);
        f32x4 lo, hi; shift8(p.proj, p.mu, m, t, 2304 + 8 * cc, 1536 + 8 * cc, lo, hi);
        if (cc < 8) {
#pragma unroll
            for (int e = 0; e < 4; ++e) { lo[e] = 2.f * sigmoidf_(2.f * lo[e]) - 1.f; hi[e] = 2.f * sigmoidf_(2.f * hi[e]) - 1.f; } }
        else if (cc >= 16) {
#pragma unroll
            for (int e = 0; e < 4; ++e) { lo[e] = sigmoidf_(lo[e]); hi[e] = sigmoidf_(hi[e]); } }
        *(bf16x8*)(ACT + tk * PR_ACT_LD + 8 * cc) = pack8(lo, hi); }
    if (p.layer > 0) {
        const int tb = wave >> 1, jb = wave & 1; const size_t m = (size_t)m0 + 16 * tb + fr; const int t = (int)(m % SEQ);
        f32x4 acc = (f32x4){0.f, 0.f, 0.f, 0.f};
#pragma unroll 4
        for (int ks = 0; ks < 16; ++ks) { f32x4 lo, hi; shift8(p.proj, p.mu, m, t, 1792 + 32 * ks + 8 * fq, 1024 + 32 * ks + 8 * fq, lo, hi);
            const bf16x8 wf = *(const bf16x8*)(p.V1T + (size_t)(16 * jb + fr) * C + 32 * ks + 8 * fq);
            acc = __builtin_amdgcn_mfma_f32_16x16x32_bf16(wf, pack8(lo, hi), acc, 0, 0, 0); }
        uint2 w; w.x = pg8::cvt_pk_bf16(acc[0], acc[1]); w.y = pg8::cvt_pk_bf16(acc[2], acc[3]);
        *(uint2*)(VLO + (16 * tb + fr) * PR_VLO_LD + 16 * jb + 4 * fq) = w;
    }
    __syncthreads();
    const int ch0 = 64 * wave;
#pragma unroll
    for (int arr = 0; arr < 3; ++arr) {
        const int K0 = arr == 0 ? 0 : (arr == 1 ? 64 : 128), KL = arr == 2 ? 128 : 64; const bf16_t* WT = arr == 0 ? p.W2T : (arr == 1 ? p.A2T : p.G2T);
        f32x4 acc[4][4];
#pragma unroll
        for (int tb = 0; tb < 4; ++tb)
#pragma unroll
            for (int cb = 0; cb < 4; ++cb) acc[tb][cb] = (f32x4){0.f, 0.f, 0.f, 0.f};
#pragma unroll
        for (int ks = 0; ks < KL / 32; ++ks) { bf16x8 wf[4], af[4];
#pragma unroll
            for (int cb = 0; cb < 4; ++cb) wf[cb] = *(const bf16x8*)(WT + (size_t)(ch0 + 16 * cb + fr) * KL + 32 * ks + 8 * fq);
#pragma unroll
            for (int tb = 0; tb < 4; ++tb) af[tb] = *(const bf16x8*)(ACT + (16 * tb + fr) * PR_ACT_LD + K0 + 32 * ks + 8 * fq);
#pragma unroll
            for (int tb = 0; tb < 4; ++tb)
#pragma unroll
                for (int cb = 0; cb < 4; ++cb) acc[tb][cb] = __builtin_amdgcn_mfma_f32_16x16x32_bf16(wf[cb], af[tb], acc[tb][cb], 0, 0, 0); }
        bf16_t* OUT = arr == 0 ? p.LD : (arr == 1 ? p.A : p.G);
#pragma unroll
        for (int cb = 0; cb < 4; ++cb) { const int ch = ch0 + 16 * cb + 4 * fq;
            f32x4 bias = (f32x4){0.f, 0.f, 0.f, 0.f}; if (arr == 0) bias = *(const f32x4*)(p.w0 + ch); else if (arr == 1) bias = *(const f32x4*)(p.a0 + ch);
#pragma unroll
            for (int tb = 0; tb < 4; ++tb) { f32x4 x = acc[tb][cb] + bias;
                if (arr == 0) {
#pragma unroll
                    for (int e = 0; e < 4; ++e) { const float z = -x[e]; const float sp = fmaxf(z, 0.f) + __logf(1.f + __expf(-fabsf(z))); x[e] = -__expf(-sp - 0.5f); } }
                else if (arr == 1) {
#pragma unroll
                    for (int e = 0; e < 4; ++e) x[e] = sigmoidf_(x[e]); }
                uint2 w; w.x = pg8::cvt_pk_bf16(x[0], x[1]); w.y = pg8::cvt_pk_bf16(x[2], x[3]);
                *(uint2*)(OUT + ((size_t)m0 + 16 * tb + fr) * C + ch) = w; } }
    }
    if (p.layer > 0) {
        bf16x8 af[4];
#pragma unroll
        for (int tb = 0; tb < 4; ++tb) af[tb] = *(const bf16x8*)(VLO + (16 * tb + fr) * PR_VLO_LD + 8 * fq);
#pragma unroll
        for (int cb = 0; cb < 4; ++cb) { const int ch = ch0 + 16 * cb + 4 * fq; const bf16x8 wf = *(const bf16x8*)(p.V2T + (size_t)(ch0 + 16 * cb + fr) * 32 + 8 * fq); const f32x4 bias = *(const f32x4*)(p.v0 + ch);
#pragma unroll
            for (int tb = 0; tb < 4; ++tb) { f32x4 x = __builtin_amdgcn_mfma_f32_16x16x32_bf16(wf, af[tb], (f32x4){0.f, 0.f, 0.f, 0.f}, 0, 0, 0) + bias;
                uint2 w; w.x = pg8::cvt_pk_bf16(sigmoidf_(x[0]), sigmoidf_(x[1])); w.y = pg8::cvt_pk_bf16(sigmoidf_(x[2]), sigmoidf_(x[3]));
                *(uint2*)(SG + (16 * tb + fr) * PR_SG_LD + ch) = w; } }
    }
    __syncthreads();
#pragma unroll
    for (int sec = 0; sec < 3; ++sec) { bf16_t* OUT = sec == 0 ? p.R : (sec == 1 ? p.K : p.V);
#pragma unroll 4
        for (int it = 0; it < 8; ++it) { const int i = tid + 512 * it, tk = i >> 6, cc = i & 63; const size_t m = (size_t)m0 + tk; const int t = (int)(m % SEQ);
            f32x4 lo, hi; shift8(p.proj, p.mu, m, t, 768 + 512 * sec + 8 * cc, 512 * sec + 8 * cc, lo, hi);
            const size_t o = m * C + 8 * cc;
            if (sec == 2) {
                if (p.layer == 0) *(bf16x8*)(p.vfirst + o) = pack8(lo, hi);
                else { const bf16x8 vf = *(const bf16x8*)(p.vfirst + o), sg = *(const bf16x8*)(SG + tk * PR_SG_LD + 8 * cc);
                    lo = lo + (bfx4_lo(vf) - lo) * bfx4_lo(sg); hi = hi + (bfx4_hi(vf) - hi) * bfx4_hi(sg); } }
            *(bf16x8*)(OUT + o) = pack8(lo, hi); } }
    __syncthreads();
}

constexpr int NTHREADS_ = 512;
constexpr int SC_TB = 32, SC_SLOT = 384, SC_NCH = SEQ / SC_TB;
constexpr int WS_RKC = 1 * (1 << 20);
struct ScanArgs { const bf16_t *R, *K, *V, *A, *LD, *G; const float *k_k, *k_a, *r_k, *lnx_g, *lnx_b; bf16_t* mix; float* rkc; };
template <int CTRL> __device__ __forceinline__ float dpp_mov(float x) { return __builtin_bit_cast(float, __builtin_amdgcn_update_dpp(0, __builtin_bit_cast(int, x), CTRL, 0xF, 0xF, true)); }
__device__ __forceinline__ float reduce16(float x) { x += dpp_mov<0xB1>(x); x += dpp_mov<0x4E>(x); x += dpp_mov<0x141>(x); x += dpp_mov<0x140>(x); return x; }
struct ScLdSet { bf16_t r[8], k[8], v[8], a[8], ld[8]; };
__device__ __forceinline__ void scan_item(const ScanArgs& p, float* lds, int item, int tid) {
    const int chain = item >> 2, q = item & 3, b = chain >> 3, h = chain & 7, wave = __builtin_amdgcn_readfirstlane(tid >> 6), lane = tid & 63;
    float* buf = lds;
    float* ybuf = lds + 2 * SC_TB * SC_SLOT;
    if (wave >= 4) {
        const int lw = wave - 4, ch = h * 64 + lane, lt = lw * 64 + lane;
        const float kk_c = p.k_k[ch], ka_c = p.k_a[ch], rk_c = p.r_k[ch];
        const size_t rowbase = (size_t)b * SEQ;
        ScLdSet s0, s1;
#define SC_LOAD(S, chunk) do { _Pragma("unroll") for (int i = 0; i < 8; ++i) { const size_t o = (rowbase + (size_t)(chunk) * SC_TB + lw + 4 * i) * C + ch; \
            S.r[i] = p.R[o]; S.k[i] = p.K[o]; S.v[i] = p.V[o]; S.a[i] = p.A[o]; S.ld[i] = p.LD[o]; } } while (0)
#define SC_PROC(S, chunk, bi) do { _Pragma("unroll") for (int i = 0; i < 8; ++i) { const int st = lw + 4 * i; \
            const float r = bf2f(S.r[i]), k = bf2f(S.k[i]), v = bf2f(S.v[i]), a = bf2f(S.a[i]), ld = bf2f(S.ld[i]); \
            float kk = k * kk_c; const float nrm = sqrtf(wave_sum(kk * kk)); kk = kk / fmaxf(nrm, 1e-12f); \
            const float kp = k * (1.f + (a - 1.f) * ka_c); const float rkc = wave_sum(r * kp * rk_c); \
            float* slot = buf + ((bi) * SC_TB + st) * SC_SLOT + lane; \
            slot[0] = __expf(ld); slot[64] = -kk; slot[128] = kk * a; slot[192] = kp; slot[256] = r; slot[320] = v; \
            if (q == 0 && lane == 0) p.rkc[(rowbase + (size_t)(chunk) * SC_TB + st) * 8 + h] = rkc; } } while (0)
#define SC_YOUT(chunk, bi) do { _Pragma("unroll") for (int e2 = 0; e2 < 2; ++e2) { const int e = lt + 256 * e2, st = e >> 4, rr = e & 15; \
            p.mix[(rowbase + (size_t)(chunk) * SC_TB + st) * D + ATT_W + h * 64 + 16 * q + rr] = (bf16_t)f2bf(ybuf[(bi) * SC_TB * 16 + e]); } } while (0)
        SC_LOAD(s0, 0); SC_LOAD(s1, 1); SC_PROC(s0, 0, 0);
        __syncthreads();
        for (int c = 0; c < SC_NCH; c += 2) {
            if (c + 2 < SC_NCH) SC_LOAD(s0, c + 2);
            SC_PROC(s1, c + 1, 1);
            if (c >= 1) SC_YOUT(c - 1, 1);
            __syncthreads();
            if (c + 3 < SC_NCH) SC_LOAD(s1, c + 3);
            if (c + 2 < SC_NCH) SC_PROC(s0, c + 2, 0);
            SC_YOUT(c, 0);
            __syncthreads();
        }
        SC_YOUT(SC_NCH - 1, 1);
#undef SC_LOAD
#undef SC_PROC
#undef SC_YOUT
    } else {
        const int cg4 = (lane & 15) * 4, rloc = 4 * wave + (lane >> 4);
        float S0 = 0.f, S1 = 0.f, S2 = 0.f, S3 = 0.f;
#define SC_SCAN(bi) do { const float* bp = buf + (bi) * SC_TB * SC_SLOT + cg4; const float* vp = buf + (bi) * SC_TB * SC_SLOT + 320 + 16 * q + rloc; float* yp = ((lane & 15) == 0) ? (ybuf + (bi) * SC_TB * 16 + rloc) : (ybuf + 2 * SC_TB * 16 + lane);     \
            _Pragma("unroll") for (int st = 0; st < SC_TB; ++st) { \
                const f32x4 w = *(const f32x4*)(bp + st * SC_SLOT), A = *(const f32x4*)(bp + st * SC_SLOT + 64), B = *(const f32x4*)(bp + st * SC_SLOT + 128), kp = *(const f32x4*)(bp + st * SC_SLOT + 192), r = *(const f32x4*)(bp + st * SC_SLOT + 256); \
                const float v = vp[st * SC_SLOT]; \
                float sa = (S0 * A.x + S1 * A.y) + (S2 * A.z + S3 * A.w); sa = reduce16(sa); \
                S0 = S0 * w.x + (sa * B.x + v * kp.x); S1 = S1 * w.y + (sa * B.y + v * kp.y); S2 = S2 * w.z + (sa * B.z + v * kp.z); S3 = S3 * w.w + (sa * B.w + v * kp.w); \
                float y = (S0 * r.x + S1 * r.y) + (S2 * r.z + S3 * r.w); y = reduce16(y); \
                yp[st * 16] = y; } } while (0)
        __syncthreads();
        for (int c = 0; c < SC_NCH; c += 2) { SC_SCAN(0); __syncthreads(); SC_SCAN(1); __syncthreads(); }
#undef SC_SCAN
    }
    __syncthreads();
}
__device__ __forceinline__ void scan_post(const ScanArgs& p, int idx, int lane) {
    const int m = idx >> 3, h = idx & 7, ch = h * 64 + lane; const size_t o = (size_t)m * C + ch, om = (size_t)m * D + ATT_W + ch;
    const float y = bf2f(p.mix[om]);
    const float mean = wave_sum(y) * (1.f / 64.f); const float d = y - mean; const float var = wave_sum(d * d) * (1.f / 64.f);
    const float yn = d * rsqrtf(var + LNX_EPS) * p.lnx_g[ch] + p.lnx_b[ch];
    p.mix[om] = (bf16_t)f2bf((yn + p.rkc[(size_t)m * 8 + h] * bf2f(p.V[o])) * bf2f(p.G[o]));
}

typedef float f32x16 __attribute__((ext_vector_type(16)));
typedef short s16x4 __attribute__((ext_vector_type(4)));
constexpr int AT_VTS = 196;
__device__ __forceinline__ int crow(int r, int hi) { return (r & 3) + 8 * (r >> 2) + 4 * hi; }
__device__ __forceinline__ void attn_unit(const bf16_t* __restrict__ proj, const float* __restrict__ sinks, bf16_t* __restrict__ mix, bf16_t* vt, int unit, int tid) {
    const int b = unit >> 7, kvh = (unit >> 6) & 1, qb = unit & 63, Q0 = qb * 64;
    const int wave = __builtin_amdgcn_readfirstlane(tid >> 6), lane = tid & 63, c = lane & 31, hi = lane >> 5, g = wave >> 1, half = wave & 1, h = kvh * 4 + g;
    const size_t rowb = (size_t)b * SEQ;
    for (int i = tid; i < 192 * 8; i += 512) { const int kl = i >> 3, ch8 = i & 7; int key = Q0 - 128 + kl; key = key < 0 ? 0 : key;
        const bf16x8 v = *(const bf16x8*)(proj + (rowb + key) * IN_W + 640 + kvh * 64 + ch8 * 8);
#pragma unroll
        for (int e = 0; e < 8; ++e) vt[(ch8 * 8 + e) * AT_VTS + kl] = (bf16_t)v[e]; }
    __syncthreads();
    const int t0 = Q0 + 32 * half; const size_t mq = rowb + t0 + c;
    bf16x8 qf[4];
#pragma unroll
    for (int ks = 0; ks < 4; ++ks) qf[ks] = *(const bf16x8*)(proj + mq * IN_W + h * 64 + 16 * ks + 8 * hi);
    f32x16 p[5];
#pragma unroll
    for (int kb = 0; kb < 5; ++kb) { int key = t0 - 128 + 32 * kb + c; key = key < 0 ? 0 : key; const bf16_t* kp = proj + (rowb + key) * IN_W + 512 + kvh * 64 + 8 * hi;
        f32x16 acc;
#pragma unroll
        for (int r = 0; r < 16; ++r) acc[r] = 0.f;
#pragma unroll
        for (int ks = 0; ks < 4; ++ks) acc = __builtin_amdgcn_mfma_f32_32x32x16_bf16(*(const bf16x8*)(kp + 16 * ks), qf[ks], acc, 0, 0, 0);
        p[kb] = acc; }
    const float slope = exp2f(-(float)(h + 1)), sink = sinks[h];
    float mx = sink;
#pragma unroll
    for (int kb = 0; kb < 5; ++kb)
#pragma unroll
        for (int r = 0; r < 16; ++r) { const int cr = crow(r, hi), dist = c + 128 - 32 * kb - cr, key = t0 - 128 + 32 * kb + cr;
            const float sc = (dist >= 0 && dist < WINDOW && key >= 0) ? p[kb][r] * 0.125f - slope * (float)dist : -1e30f; p[kb][r] = sc; mx = fmaxf(mx, sc); }
    mx = fmaxf(mx, __shfl_xor(mx, 32));
    float l = 0.f;
#pragma unroll
    for (int kb = 0; kb < 5; ++kb)
#pragma unroll
        for (int r = 0; r < 16; ++r) { const float e = __expf(p[kb][r] - mx); p[kb][r] = e; l += e; }
    l += __shfl_xor(l, 32); l += __expf(sink - mx);
    f32x16 o[2];
#pragma unroll
    for (int d = 0; d < 2; ++d)
#pragma unroll
        for (int r = 0; r < 16; ++r) o[d][r] = 0.f;
#pragma unroll
    for (int kb = 0; kb < 5; ++kb)
#pragma unroll
        for (int s2 = 0; s2 < 2; ++s2) {
            pg8::u32x4 pw; pw.x = pg8::cvt_pk_bf16(p[kb][8 * s2 + 0], p[kb][8 * s2 + 1]); pw.y = pg8::cvt_pk_bf16(p[kb][8 * s2 + 2], p[kb][8 * s2 + 3]);
            pw.z = pg8::cvt_pk_bf16(p[kb][8 * s2 + 4], p[kb][8 * s2 + 5]); pw.w = pg8::cvt_pk_bf16(p[kb][8 * s2 + 6], p[kb][8 * s2 + 7]);
            const bf16x8 pf = __builtin_bit_cast(bf16x8, pw);
#pragma unroll
            for (int d = 0; d < 2; ++d) { const bf16_t* vp = vt + (32 * d + c) * AT_VTS + 32 * half + 32 * kb + 16 * s2 + 4 * hi;
                const s16x4 lo = *(const s16x4*)vp, hh = *(const s16x4*)(vp + 8);
                const bf16x8 vf = (bf16x8){lo[0], lo[1], lo[2], lo[3], hh[0], hh[1], hh[2], hh[3]};
                o[d] = __builtin_amdgcn_mfma_f32_32x32x16_bf16(vf, pf, o[d], 0, 0, 0); } }
    const float inv = 1.f / l;
#pragma unroll
    for (int d = 0; d < 2; ++d)
#pragma unroll
        for (int rg = 0; rg < 4; ++rg) { uint2 w; w.x = pg8::cvt_pk_bf16(o[d][4 * rg] * inv, o[d][4 * rg + 1] * inv); w.y = pg8::cvt_pk_bf16(o[d][4 * rg + 2] * inv, o[d][4 * rg + 3] * inv);
            *(uint2*)(mix + mq * D + h * 64 + 32 * d + 8 * rg + 4 * hi) = w; }
    __syncthreads();
}

__device__ __forceinline__ void conv_item(const bf16_t* __restrict__ U, const bf16_t* __restrict__ UP, const float* __restrict__ cw, const float* __restrict__ cb, bf16_t* __restrict__ hid, size_t i) {
    const int t = (int)(i / FF), j = (int)(i % FF);
    const float u0 = bf2f(U[i]), u1 = t >= 1 ? bf2f(U[i - FF]) : 0.f, u2 = t >= 2 ? bf2f(U[i - 2 * FF]) : 0.f;
    const float c = cb[j] + cw[j] * u2 + cw[FF + j] * u1 + cw[2 * FF + j] * u0;
    hid[i] = (bf16_t)f2bf(c * sigmoidf_(c) * bf2f(UP[i]));
}

__device__ __forceinline__ void ffn_fixup(const float* __restrict__ SB, const float* __restrict__ cw, const float* __restrict__ cb, bf16_t* hid, int pm, int tid) {
    const float* s = SB + (size_t)pm * 6 * FF; const float* sp = SB + (size_t)(pm - 1) * 6 * FF; const bool has_prev = (pm % (SEQ / 256)) != 0;
    for (int idx = tid; idx < 2 * FF; idx += NTHREADS_) { const int rr = idx / FF, j = idx % FF;
        const float u0 = s[j], u1 = s[FF + j], ul0 = has_prev ? sp[4 * FF + j] : 0.f, ul1 = has_prev ? sp[5 * FF + j] : 0.f;
        const float c = rr == 0 ? cb[j] + cw[j] * ul0 + cw[FF + j] * ul1 + cw[2 * FF + j] * u0 : cb[j] + cw[j] * ul1 + cw[FF + j] * u0 + cw[2 * FF + j] * u1;
        hid[(size_t)(pm * 256 + rr) * FF + j] = (bf16_t)f2bf(c * sigmoidf_(c) * s[(2 + rr) * FF + j]); }
}

__device__ __forceinline__ void final_row(float* __restrict__ x, const float* __restrict__ ss, const float* __restrict__ g, int row, int lane) {
    const float rstd = rsqrtf(ss[row] * (1.f / D) + RMS_EPS);
    f32x4* xr = (f32x4*)(x + (size_t)row * D) + lane; const f32x4* gr = (const f32x4*)g + lane;
#pragma unroll
    for (int j = 0; j < 4; ++j) { f32x4 v = xr[64 * j]; const f32x4 gg = gr[64 * j]; v.x *= rstd * gg.x; v.y *= rstd * gg.y; v.z *= rstd * gg.z; v.w *= rstd * gg.w; xr[64 * j] = v; }
}

#define XB_TMO      128
#define XB_XCNT(j)  (256  + 64 * (j))
#define XB_XSUB(j)  (1280 + 64 * (j))
#define XB_XGEN(j)  (2304 + 64 * (j))
#define XB_TOP      3328
#define XB_TOPGEN   3392
#define XCD_BAR_WORDS 3456
#define XB_SPIN_CAP (1u << 18)

__device__ __forceinline__ unsigned xb_ld(unsigned* p)              { return __hip_atomic_load(p, __ATOMIC_RELAXED, __HIP_MEMORY_SCOPE_AGENT); }
__device__ __forceinline__ unsigned xb_add(unsigned* p, unsigned v) { return __hip_atomic_fetch_add(p, v, __ATOMIC_RELAXED, __HIP_MEMORY_SCOPE_AGENT); }
__device__ __forceinline__ unsigned xb_xcc_id() { return (unsigned)__builtin_amdgcn_s_getreg((3 << 11) | 20) & 0xFu; }
#define XB_SPIN(cond, bar) do { unsigned _sp = 0; while (cond) { __builtin_amdgcn_s_sleep(1); \
    if ((++_sp & 255u) == 0u) { if (xb_ld(&(bar)[XB_TMO])) break; if (_sp > XB_SPIN_CAP) { atomicAdd(&(bar)[XB_TMO], 1u); break; } } } } while (0)

struct XcdBarrier {
    unsigned* bar; unsigned x;
    volatile __attribute__((address_space(3))) unsigned* st;
};

__device__ __forceinline__ XcdBarrier xcd_barrier_post(unsigned* bar, volatile __attribute__((address_space(3))) unsigned* st) {
    XcdBarrier b; b.bar = bar; b.x = xb_xcc_id(); b.st = st;
    if (threadIdx.x == 0) (void)xb_add(&bar[XB_XCNT(b.x)], 1u);
    return b;
}
__device__ __forceinline__ void xcd_barrier_complete(unsigned* bar, unsigned x, unsigned& nloc, unsigned& nx) {
    const unsigned G = gridDim.x * gridDim.y * gridDim.z;
    unsigned sum, cnt, mine, sp = 0u;
    for (;;) {
        sum = 0u; cnt = 0u; mine = 0u;
#pragma unroll
        for (unsigned j = 0; j < 16; ++j) { const unsigned c = xb_ld(&bar[XB_XCNT(j)]); sum += c; cnt += (c > 0u) ? 1u : 0u; mine = (j == x) ? c : mine; }
        if (sum == G) break;
        __builtin_amdgcn_s_sleep(1);
        if ((++sp & 255u) == 0u) { if (xb_ld(&bar[XB_TMO])) break; if (sp > XB_SPIN_CAP) { atomicAdd(&bar[XB_TMO], 1u); break; } }
    }
    nloc = mine > 0u ? mine : 1u; nx = cnt > 0u ? cnt : 1u;
}

__device__ __forceinline__ void xcd_barrier(const XcdBarrier& b) {
    asm volatile("s_waitcnt vmcnt(0)" ::: "memory");
    __syncthreads();
    if (threadIdx.x == 0) {
        unsigned* bar = b.bar;
        __builtin_amdgcn_s_waitcnt(0);
        unsigned nloc = b.st[0], nx = b.st[1];
        if (nloc == 0u) { xcd_barrier_complete(bar, b.x, nloc, nx); b.st[0] = nloc; b.st[1] = nx; }
        const unsigned old = xb_add(&bar[XB_XSUB(b.x)], 1u);
        const unsigned gen = old / nloc;
        if (old + 1u == (gen + 1u) * nloc) {
            __builtin_amdgcn_fence(__ATOMIC_RELEASE, "agent");
            asm volatile("s_waitcnt vmcnt(0)" ::: "memory");
            const unsigned og = xb_add(&bar[XB_TOP], 1u);
            const unsigned tg = og / nx;
            if (og + 1u == (tg + 1u) * nx) xb_add(&bar[XB_TOPGEN], 1u);
            else XB_SPIN(xb_ld(&bar[XB_TOPGEN]) == tg, bar);
            __builtin_amdgcn_fence(__ATOMIC_ACQUIRE, "agent");
            xb_add(&bar[XB_XGEN(b.x)], 1u);
            asm volatile("s_waitcnt vmcnt(0)" ::: "memory");
        } else {
            XB_SPIN(xb_ld(&bar[XB_XGEN(b.x)]) == gen, bar);
            __builtin_amdgcn_fence(__ATOMIC_ACQUIRE, "agent");
            asm volatile("s_waitcnt vmcnt(0)" ::: "memory");
        }
    }
    __syncthreads();
}

constexpr int NTHREADS = 512, LDS_BYTES = 147456;
struct Args { const float* in[26]; float* out; unsigned char* ws; };
__global__ void __launch_bounds__(NTHREADS, 2) mega_fwd(Args a) {
    extern __shared__ __attribute__((aligned(16))) unsigned char lds[];
    constexpr int MISC_OFF = 131072 + 4096;
    { volatile __attribute__((address_space(3))) unsigned* misc = (volatile __attribute__((address_space(3))) unsigned*)((__attribute__((address_space(3))) unsigned char*)lds + MISC_OFF);
      if (threadIdx.x < 4) misc[threadIdx.x] = 0u; }
    __syncthreads();
    (void)xcd_barrier_post((unsigned*)(a.ws + WS_BAR), (volatile __attribute__((address_space(3))) unsigned*)((__attribute__((address_space(3))) unsigned char*)lds + MISC_OFF));
#define GRID_SYNC() do { XcdBarrier xb_; xb_.bar = (unsigned*)(a.ws + WS_BAR); xb_.x = xb_xcc_id(); xb_.st = (volatile __attribute__((address_space(3))) unsigned*)((__attribute__((address_space(3))) unsigned char*)lds + MISC_OFF); xcd_barrier(xb_); } while (0)
#define LDSP ((PG8_LAS unsigned char*)lds)
    constexpr int XCH_OFF = 131072;
#define OTID() ({ int _t = threadIdx.x; asm volatile("" : "+v"(_t)); _t; })
    const int G = gridDim.x, NGW = G * 8;
    const float* x = a.in[0]; const float* norm1_g = a.in[1]; const float* w_in = a.in[2]; const float* sinks = a.in[3];
    const float* mu = a.in[4]; const float* w0 = a.in[5]; const float* w2 = a.in[6]; const float* a0 = a.in[7];
    const float* a2 = a.in[8]; const float* g2 = a.in[9]; const float* k_k = a.in[10]; const float* k_a = a.in[11];
    const float* r_k = a.in[12]; const float* lnx_g = a.in[13]; const float* lnx_b = a.in[14]; const float* v0 = a.in[15];
    const float* v1 = a.in[16]; const float* v2 = a.in[17]; const float* w_out = a.in[18]; const float* norm2_g = a.in[19];
    const float* wg = a.in[20]; const float* wu = a.in[21]; const float* conv_w = a.in[22]; const float* conv_b = a.in[23];
    const float* wd = a.in[24]; const float* final_g = a.in[25];
    unsigned char* ws = a.ws; float* X = a.out;
    float* ss = (float*)(ws + WS_SS);
    bf16_t* XB = (bf16_t*)(ws + WS_XB); bf16_t* PROJ = (bf16_t*)(ws + WS_PROJ); bf16_t* MIX = (bf16_t*)(ws + WS_MIX); bf16_t* HID = (bf16_t*)(ws + WS_HID); bf16_t* VF = (bf16_t*)(ws + WS_VFIRST);
    bf16_t* UT = (bf16_t*)(ws + WS_UTMP); bf16_t* UPT = UT + (size_t)SEQ * FF;

    {
        const int tid = OTID(), lane = tid & 63, wave = tid >> 6, gw = blockIdx.x * 8 + wave;
        float* scr = (float*)lds + wave * (64 * 33 + 16);
        constexpr int I_IN = (D / 64) * (IN_W / 32), I_OUT = (D / 64) * (D / 32), I_G = (D / 64) * (FF / 32), I_DN = (FF / 64) * (D / 32), I_LAYER = I_IN + I_OUT + 2 * I_G + I_DN;
        for (int it = gw; it < 2 * I_LAYER; it += NGW) {
            const int l = it / I_LAYER; int r = it % I_LAYER;
            bf16_t* wl = (bf16_t*)(ws + WS_W + l * W_LAYER); bf16_t* WinT = wl; bf16_t* WoutT = (bf16_t*)((char*)wl + W_IN_SZ); bf16_t* WguT = (bf16_t*)((char*)WoutT + W_OUT_SZ); bf16_t* WdT = (bf16_t*)((char*)WguT + W_GU_SZ);
            if (r < I_IN) { transpose_item(w_in + (size_t)l * D * IN_W, D, IN_W, WinT, norm1_g + l * D, 0, scr, r, lane); continue; } r -= I_IN;
            if (r < I_OUT) { transpose_item(w_out + (size_t)l * D * D, D, D, WoutT, nullptr, 0, scr, r, lane); continue; } r -= I_OUT;
            if (r < I_G) { transpose_item(wg + (size_t)l * D * FF, D, FF, WguT, norm2_g + l * D, 1, scr, r, lane); continue; } r -= I_G;
            if (r < I_G) { transpose_item(wu + (size_t)l * D * FF, D, FF, WguT, norm2_g + l * D, 2, scr, r, lane); continue; } r -= I_G;
            transpose_item(wd + (size_t)l * FF * D, FF, D, WdT, nullptr, 0, scr, r, lane);
        }
        {
            constexpr int I_W2 = 1 * (C / 32), I_G2 = 2 * (C / 32), I_V1 = (C / 64) * 1, I_L = 2 * I_W2 + I_G2;
            for (int it = gw; it < 2 * I_L + I_V1; it += NGW) {
                if (it < 2 * I_L) { const int l = it / I_L; int r = it % I_L; bf16_t* base = (bf16_t*)(ws + WS_LORA + l * LORA_LAYER);
                    if (r < I_W2) { transpose_item(w2 + (size_t)l * 64 * C, 64, C, base, nullptr, 0, scr, r, lane); continue; } r -= I_W2;
                    if (r < I_W2) { transpose_item(a2 + (size_t)l * 64 * C, 64, C, base + 512 * 64, nullptr, 0, scr, r, lane); continue; } r -= I_W2;
                    transpose_item(g2 + (size_t)l * 128 * C, 128, C, base + 2 * 512 * 64, nullptr, 0, scr, r, lane); }
                else transpose_item(v1, C, 32, (bf16_t*)(ws + WS_V1T), nullptr, 0, scr, it - 2 * I_L, lane);
            }
            bf16_t* V2T = (bf16_t*)(ws + WS_V2T);
            for (int i = blockIdx.x * NTHREADS + tid; i < 32 * C; i += G * NTHREADS) { const int j = i / C, ch = i % C; V2T[ch * 32 + j] = (bf16_t)f2bf(v2[i]); }
        }
        for (int m = gw; m < M; m += NGW) x_row_to_bf16(x, XB, ss, m, lane);
    }
    GRID_SYNC();
    for (int l = 0; l < 2; ++l) {
        bf16_t* wl = (bf16_t*)(ws + WS_W + l * W_LAYER); bf16_t* WinT = wl; bf16_t* WoutT = (bf16_t*)((char*)wl + W_IN_SZ); bf16_t* WguT = (bf16_t*)((char*)WoutT + W_OUT_SZ); bf16_t* WdT = (bf16_t*)((char*)WguT + W_GU_SZ);
        float* ss1 = ss + (size_t)(2 * l) * M; float* ss2 = ss + (size_t)(2 * l + 1) * M; float* ss3 = ss + (size_t)(2 * l + 2) * M;
        { pg8::Gemm g{XB, WinT, M, IN_W, D}; pg8::StaticOrder S; S.init(M, IN_W, G, (int)blockIdx.x); pg8::EpiScaleBf16 E{PROJ, IN_W, ss1};
          pg8::gemm_phase<pg8::EpiScaleBf16, pg8::StaticOrder, true, true>(LDSP, g, S, E); }
        GRID_SYNC();
        for (int unit = blockIdx.x; unit < BATCH * 2 * (SEQ / 64); unit += G) attn_unit(PROJ, sinks + l * NH, MIX, (bf16_t*)lds, unit, OTID());
        struct { bf16_t *R, *K, *V, *A, *LD, *G; } p; p.R = (bf16_t*)(ws + WS_SI_R); p.K = (bf16_t*)(ws + WS_SI_K); p.V = (bf16_t*)(ws + WS_SI_V); p.A = (bf16_t*)(ws + WS_SI_A); p.LD = (bf16_t*)(ws + WS_SI_LD); p.G = (bf16_t*)(ws + WS_SI_G);
        { Prep2Args q{}; q.proj = PROJ; q.mu = mu + l * SHIFT_W; q.w0 = w0 + l * C; q.a0 = a0 + l * C; q.v0 = v0;
          const bf16_t* lw = (const bf16_t*)(ws + WS_LORA + l * LORA_LAYER); q.W2T = lw; q.A2T = lw + 512 * 64; q.G2T = lw + 2 * 512 * 64; q.V1T = (const bf16_t*)(ws + WS_V1T); q.V2T = (const bf16_t*)(ws + WS_V2T);
          q.vfirst = VF; q.R = p.R; q.K = p.K; q.V = p.V; q.A = p.A; q.LD = p.LD; q.G = p.G; q.layer = l;
          for (int tile = blockIdx.x; tile < M / 64; tile += G) prep_tile(q, lds, tile, OTID()); }
        GRID_SYNC();
        { ScanArgs s{}; s.R = p.R; s.K = p.K; s.V = p.V; s.A = p.A; s.LD = p.LD; s.G = p.G; s.k_k = k_k + l * C; s.k_a = k_a + l * C; s.r_k = r_k + l * C; s.lnx_g = lnx_g + l * C; s.lnx_b = lnx_b + l * C; s.mix = MIX; s.rkc = (float*)(ws + WS_RKC);
          for (int item = (int)((blockIdx.x & 7) * (G >> 3) + (blockIdx.x >> 3)); item < BATCH * NH * 4; item += G) scan_item(s, (float*)lds, item, OTID());
          GRID_SYNC();
          { const int tid = OTID(), lane = tid & 63, gw = blockIdx.x * 8 + (tid >> 6); for (int idx = gw; idx < M * NH; idx += NGW) scan_post(s, idx, lane); } }
        GRID_SYNC();
        { pg8::Gemm g{MIX, WoutT, M, D, D}; pg8::StaticOrder S; S.init(M, D, G, (int)blockIdx.x); pg8::EpiResid E{(l == 0) ? x : X, X, XB, ss2};
          pg8::gemm_phase<pg8::EpiResid, pg8::StaticOrder, true, true>(LDSP, g, S, E); }
        GRID_SYNC();
        { pg8::Gemm g{XB, WguT, M, 2 * FF, D}; pg8::StaticOrder S; S.init(M, 2 * FF, G, (int)blockIdx.x);
          pg8::EpiConvGlu E{HID, ss2, conv_w + (size_t)l * 3 * FF, conv_b + (size_t)l * FF, (float*)(ws + WS_UTMP), (PG8_LAS float*)(LDSP + XCH_OFF), FF};
          pg8::gemm_phase<pg8::EpiConvGlu, pg8::StaticOrder, true, true>(LDSP, g, S, E); }
        GRID_SYNC();
        { pg8::Gemm g{HID, WdT, M, D, FF}; pg8::StaticOrder S; S.init(M, D, G, (int)blockIdx.x); pg8::EpiResid E{X, X, XB, ss3};
          { pg8::Unit u; for (int i = 0; S.next(i, u); ++i) ffn_fixup((const float*)(ws + WS_UTMP), conv_w + (size_t)l * 3 * FF, conv_b + (size_t)l * FF, HID, u.pm, OTID());
            asm volatile("s_waitcnt vmcnt(0)" ::: "memory"); __syncthreads(); }
          pg8::gemm_phase<pg8::EpiResid, pg8::StaticOrder, true, true>(LDSP, g, S, E); }
        GRID_SYNC();
    }
    { const int tid = OTID(), lane = tid & 63, gw = blockIdx.x * 8 + (tid >> 6);
    for (int m = gw; m < M; m += NGW) final_row(X, ss + (size_t)4 * M, final_g, m, lane); }
}

extern "C" void kernel_launch(void* const* d_in, const int* in_sizes, int n_in, void* d_out, int out_size, void* d_ws, size_t ws_size, hipStream_t stream) {
    static int grid = 0;
    if (grid == 0) {
        if (n_in != 26 || in_sizes[0] != M * D || out_size != M * D || ws_size < WS_END) { fprintf(stderr, "kernel_launch: unexpected shapes (n_in %d, ws %zu)\n", n_in, ws_size); grid = -1; return; }
        int dev = 0, cus = 0, per_cu = 0;
        if (hipGetDevice(&dev) != hipSuccess || hipDeviceGetAttribute(&cus, hipDeviceAttributeMultiprocessorCount, dev) != hipSuccess) { grid = -1; return; }
        if (hipFuncSetAttribute((const void*)mega_fwd, hipFuncAttributeMaxDynamicSharedMemorySize, LDS_BYTES) != hipSuccess) { fprintf(stderr, "kernel_launch: hipFuncSetAttribute failed\n"); grid = -1; return; }
        if (hipOccupancyMaxActiveBlocksPerMultiprocessor(&per_cu, (const void*)mega_fwd, NTHREADS, LDS_BYTES) != hipSuccess || per_cu < 1) { fprintf(stderr, "kernel_launch: occupancy query failed (%d)\n", per_cu); grid = -1; return; }
        grid = cus;
    }
    if (grid < 0) return;
    (void)hipMemsetAsync((unsigned char*)d_ws + WS_CTL, 0, CTL_BYTES, stream);
    Args a{};
    for (int i = 0; i < 26; ++i) a.in[i] = (const float*)d_in[i];
    a.out = (float*)d_out; a.ws = (unsigned char*)d_ws;
    void* kargs[] = {&a};
    hipError_t e = hipLaunchCooperativeKernel((const void*)mega_fwd, dim3(grid), dim3(NTHREADS), kargs, LDS_BYTES, stream);
    if (e != hipSuccess) fprintf(stderr, "kernel_launch: cooperative launch failed: %s (grid %d)\n", hipGetErrorString(e), grid);
}
```

```cpp
#include <hip/hip_runtime.h>
#include <cstdio>
#include <cstdint>

typedef unsigned short bf16_t;
typedef short bf16x8 __attribute__((ext_vector_type(8)));
typedef float f32x4 __attribute__((ext_vector_type(4)));

constexpr int BATCH = 8, SEQ = 4096, D = 1024, M = BATCH * SEQ;
constexpr int HD = 64, ATT_W = 512, KV_W = 128, C = 512, NH = 8;
constexpr int ATT_IN = 768, SHIFT_W = 1792, IN_W = 2560, FF = 2816;
constexpr int WINDOW = 128;
constexpr float RMS_EPS = 1e-5f, LNX_EPS = 64e-5f;

constexpr size_t MiB = 1u << 20;
constexpr size_t WS_CTL = 0;
constexpr size_t WS_SS = 0;
constexpr size_t CTL_BYTES = 1 * MiB;
constexpr size_t WS_BAR = 768 * 1024;
constexpr size_t WS_W = 2 * MiB;
constexpr size_t W_IN_SZ = (size_t)IN_W * D * 2, W_OUT_SZ = (size_t)D * D * 2, W_GU_SZ = (size_t)2 * FF * D * 2, W_DN_SZ = (size_t)D * FF * 2;
constexpr size_t W_LAYER = W_IN_SZ + W_OUT_SZ + W_GU_SZ + W_DN_SZ;
constexpr size_t WS_VFIRST = 52 * MiB, WS_MIX = 84 * MiB, WS_XB = 148 * MiB, WS_PROJ = 212 * MiB;
constexpr size_t WS_SI_R = 148 * MiB, WS_SI_K = 180 * MiB, WS_SI_V = 372 * MiB, WS_SI_A = 404 * MiB, WS_SI_LD = 436 * MiB, WS_SI_G = 468 * MiB;
constexpr size_t WS_HID = 212 * MiB;
constexpr size_t WS_UTMP = 84 * MiB;
constexpr size_t WS_END = 500 * MiB;
static_assert(WS_W + 2 * W_LAYER <= WS_VFIRST, "weights fit");

__device__ __forceinline__ unsigned f2bf(float f) { unsigned u = __builtin_bit_cast(unsigned, f); return (u + 0x7fffu + ((u >> 16) & 1u)) >> 16; }
__device__ __forceinline__ float bf2f(bf16_t h) { return __builtin_bit_cast(float, (unsigned)h << 16); }
__device__ __forceinline__ float wave_sum(float v) {
#pragma unroll
    for (int o = 1; o < 64; o <<= 1) v += __shfl_xor(v, o);
    return v;
}
__device__ __forceinline__ float sigmoidf_(float x) { return 1.f / (1.f + __expf(-x)); }

namespace pg8 {
#define PG8_LAS __attribute__((address_space(3)))
typedef unsigned short bf16_t;
typedef short bf16x8 __attribute__((ext_vector_type(8)));
typedef float f32x4 __attribute__((ext_vector_type(4)));
typedef unsigned u32x4 __attribute__((ext_vector_type(4)));
constexpr int BM = 256, BK = 64, HALF = 128, HTB = HALF * BK * 2  , STAGE_BYTES = 8 * HTB, NXCD = 8, WGM = 8;

__host__ __device__ __forceinline__ int lds_byte(int r, int c) { const int st = (r >> 4) * 2 + (c >> 5), rr = r & 15, cc = c & 31, ob = rr * 64 + cc * 2; return st * 1024 + (ob ^ (((ob >> 9) & 1) << 5)); }
__host__ __device__ __forceinline__ void stage_rc(int b, int& R, int& C) { const int st = b / 1024, sb = b % 1024, swz = sb ^ (((sb >> 9) & 1) << 5); R = (st >> 1) * 16 + swz / 64; C = (st & 1) * 32 + (swz % 64) / 2; }
__host__ __device__ __forceinline__ int perm32(int rho) { const int n = rho >> 4, i = rho & 15; return 8 * (i >> 2) + 4 * n + (i & 3); }

struct Unit { int pm, pn; };
struct Gemm { const bf16_t* A; const bf16_t* Bt; int M, N, K; };

struct StaticOrder {
    int nM, nN, nwg, G, c;
    __host__ __device__ void init(int M, int N, int G_, int c_) { nM = M / BM; nN = N / BM; nwg = nM * nN; G = G_; c = c_; }
    __host__ __device__ bool next(int i, Unit& u) const {
        const long L = (long)i * G + c; if (L >= nwg) return false;
        int wgid = (int)L; { const int q = nwg / NXCD, r = nwg % NXCD, xcd = wgid % NXCD, off = wgid / NXCD; wgid = (xcd < r ? xcd * (q + 1) : r * (q + 1) + (xcd - r) * q) + off; }
        const int nig = WGM * nN, gid = wgid / nig, fm = gid * WGM, gsz = (nM - fm) < WGM ? (nM - fm) : WGM;
        u.pm = fm + ((wgid % nig) % gsz); u.pn = (wgid % nig) / gsz; return true;
    }
    __device__ __forceinline__ void a_ready(const Unit&) const {}
    __device__ __forceinline__ void done(const Unit&) const {}
};
typedef float f32x2_t_ __attribute__((ext_vector_type(2))); typedef __bf16 bf16x2_t_ __attribute__((ext_vector_type(2)));
__device__ __forceinline__ unsigned cvt_pk_bf16(float lo, float hi) { const f32x2_t_ v = {lo, hi}; const bf16x2_t_ b = __builtin_convertvector(v, bf16x2_t_); return __builtin_bit_cast(unsigned, b); }
typedef float f32x2 __attribute__((ext_vector_type(2)));
template <class Epi, class Sched, bool ALIGN_EPI = false, bool SP2 = false>
__device__ __forceinline__ void gemm_phase(PG8_LAS unsigned char* lds, const Gemm g, const Sched& S, const Epi& E) {
    int tid_ = threadIdx.x; asm volatile("" : "+v"(tid_));
    const int tid = tid_, wid = __builtin_amdgcn_readfirstlane(tid >> 6), lane = tid & 63, wr = wid >> 2, wc = wid & 3, fr = lane & 15, fq = lane >> 4;
    const int K = g.K, nt = K / BK;
    unsigned voffA[2], voffB[2];
#pragma unroll
    for (int i = 0; i < 2; ++i) { int R, C; stage_rc(tid * 16 + i * 8192, R, C); const int Rb = Epi::PERM ? ((R & ~31) + perm32(R & 31)) : R;
        voffA[i] = (unsigned)(R * K + C) * 2u; voffB[i] = (unsigned)(Rb * K + C) * 2u; }
    const size_t kstep = (size_t)(BK * 2);
    const size_t hstep = (size_t)HALF * K * 2;
    const size_t tstep = 2 * hstep;
    const unsigned ldsw = (unsigned)wid * 1024u;
    const int aoff = lds_byte(wr * 64 + fr, fq * 8), boff = lds_byte(wc * 32 + fr, fq * 8);
#define PG8_SA(b, h) (((b) * 2 + (h)) * HTB)
#define PG8_SB(b, h) ((4 + (b) * 2 + (h)) * HTB)
#define PG8_STAGE(bufoff, gbase, voff) do { _Pragma("unroll") for (int _i = 0; _i < 2; ++_i) \
        __builtin_amdgcn_global_load_lds((const unsigned*)((const char*)(gbase) + (voff)[_i]), (PG8_LAS unsigned*)(lds + (bufoff) + ldsw + _i * 8192), 16, 0, 0); } while (0)
#define PG8_LDA(dst, b, h) do { _Pragma("unroll") for (int m = 0; m < 4; ++m) _Pragma("unroll") for (int k = 0; k < 2; ++k) dst[m][k] = *(const PG8_LAS bf16x8*)(lds + PG8_SA(b, h) + aoff + m * 2048 + k * 1024); } while (0)
#define PG8_LDB(dst, b, h) do { _Pragma("unroll") for (int n = 0; n < 2; ++n) _Pragma("unroll") for (int k = 0; k < 2; ++k) dst[n][k] = *(const PG8_LAS bf16x8*)(lds + PG8_SB(b, h) + boff + n * 2048 + k * 1024); } while (0)
#define PG8_MMA(ai, bj, At, Bt) do { __builtin_amdgcn_s_setprio(1); _Pragma("unroll") for (int m = 0; m < 4; ++m) _Pragma("unroll") for (int n = 0; n < 2; ++n) _Pragma("unroll") for (int k = 0; k < 2; ++k) \
        acc[ai][bj][m][n] = __builtin_amdgcn_mfma_f32_16x16x32_bf16(Bt[n][k], At[m][k], acc[ai][bj][m][n], 0, 0, 0); __builtin_amdgcn_s_setprio(0); } while (0)
#define PG8_WAIT_V(n) asm volatile("s_waitcnt vmcnt(" #n ")" ::: "memory")
#define PG8_WAIT_L(n) asm volatile("s_waitcnt lgkmcnt(" #n ")" ::: "memory")
#define PG8_BAR __builtin_amdgcn_s_barrier()
#define PG8_SCHED __builtin_amdgcn_sched_barrier(0)
    Unit cur, nxt; int ui = 0;
    if (!S.next(0, cur)) return;
    f32x4 acc[2][2][4][2];
#pragma unroll
    for (int a = 0; a < 2; ++a)
#pragma unroll
        for (int b = 0; b < 2; ++b)
#pragma unroll
            for (int m = 0; m < 4; ++m)
#pragma unroll
                for (int n = 0; n < 2; ++n) acc[a][b][m][n] = (f32x4){0.f, 0.f, 0.f, 0.f};
    bf16x8 At[4][2], B0[2][2], B1[2][2];
    const char* cA = (const char*)g.A + (size_t)cur.pm * tstep; const char* cB = (const char*)g.Bt + (size_t)cur.pn * tstep;
    S.a_ready(cur);
    if constexpr (SP2) {
        PG8_STAGE(PG8_SB(0, 0), cB, voffB); PG8_STAGE(PG8_SB(0, 1), cB + hstep, voffB); PG8_STAGE(PG8_SA(0, 0), cA, voffA); PG8_STAGE(PG8_SA(0, 1), cA + hstep, voffA);
        if (wr == 1) PG8_BAR;
        PG8_WAIT_V(2); PG8_BAR;
        PG8_STAGE(PG8_SB(1, 0), cB + kstep, voffB); PG8_STAGE(PG8_SA(1, 0), cA + kstep, voffA); PG8_STAGE(PG8_SB(1, 1), cB + hstep + kstep, voffB);
        PG8_WAIT_V(6); PG8_BAR;
    } else {
        PG8_STAGE(PG8_SB(0, 0), cB, voffB); PG8_STAGE(PG8_SA(0, 0), cA, voffA); PG8_STAGE(PG8_SB(0, 1), cB + hstep, voffB); PG8_STAGE(PG8_SA(0, 1), cA + hstep, voffA);
        if (wr == 1) PG8_BAR;
        PG8_WAIT_V(4); PG8_BAR;
        PG8_STAGE(PG8_SB(1, 0), cB + kstep, voffB); PG8_STAGE(PG8_SA(1, 0), cA + kstep, voffA); PG8_STAGE(PG8_SB(1, 1), cB + hstep + kstep, voffB);
        PG8_WAIT_V(6); PG8_BAR;
    }
    for (;;) {
        const bool has_next = S.next(ui + 1, nxt);
        const char* nA = has_next ? (const char*)g.A + (size_t)nxt.pm * tstep : cA; const char* nB = has_next ? (const char*)g.Bt + (size_t)nxt.pn * tstep : cB;
        for (int t = 0; t < nt; t += 2) {
            const bool last = (t == nt - 2);
            const char* a1 = cA + (size_t)(t + 1) * kstep;
            const char* a2 = last ? nA : cA + (size_t)(t + 2) * kstep; const char* b2 = last ? nB : cB + (size_t)(t + 2) * kstep;
            const char* a3 = a2 + kstep; const char* b3 = b2 + kstep;
            if (last && has_next) S.a_ready(nxt);
            if constexpr (SP2) {
            PG8_LDB(B0, 0, 0); PG8_LDB(B1, 0, 1); PG8_SCHED; PG8_LDA(At, 0, 0); PG8_STAGE(PG8_SA(1, 1), a1 + hstep, voffA);
            PG8_WAIT_V(8); PG8_WAIT_L(0); PG8_BAR; PG8_MMA(0, 0, At, B0); PG8_MMA(0, 1, At, B1); PG8_BAR; PG8_SCHED;
            PG8_LDA(At, 0, 1); PG8_STAGE(PG8_SB(0, 0), b2, voffB); PG8_STAGE(PG8_SB(0, 1), b2 + hstep, voffB); PG8_STAGE(PG8_SA(0, 0), a2, voffA);
            PG8_WAIT_V(8); PG8_WAIT_L(0); PG8_BAR; PG8_MMA(1, 0, At, B0); PG8_MMA(1, 1, At, B1); PG8_BAR; PG8_SCHED;
            PG8_LDB(B0, 1, 0); PG8_LDB(B1, 1, 1); PG8_SCHED; PG8_LDA(At, 1, 0); PG8_STAGE(PG8_SA(0, 1), a2 + hstep, voffA);
            PG8_WAIT_V(8); PG8_WAIT_L(0); PG8_BAR; PG8_MMA(0, 0, At, B0); PG8_MMA(0, 1, At, B1); PG8_BAR; PG8_SCHED;
            PG8_LDA(At, 1, 1); PG8_STAGE(PG8_SB(1, 0), b3, voffB); PG8_STAGE(PG8_SB(1, 1), b3 + hstep, voffB); PG8_STAGE(PG8_SA(1, 0), a3, voffA);
            PG8_WAIT_V(8); PG8_WAIT_L(0); PG8_BAR; PG8_MMA(1, 0, At, B0); PG8_MMA(1, 1, At, B1); PG8_BAR; PG8_SCHED;
            } else {
            PG8_LDB(B0, 0, 0); PG8_SCHED; PG8_LDA(At, 0, 0); PG8_STAGE(PG8_SA(1, 1), a1 + hstep, voffA);
            PG8_WAIT_L(8); PG8_BAR; PG8_WAIT_L(0); PG8_MMA(0, 0, At, B0); PG8_BAR; PG8_SCHED;
            PG8_LDB(B1, 0, 1); PG8_STAGE(PG8_SB(0, 0), b2, voffB);
            PG8_BAR; PG8_WAIT_L(0); PG8_MMA(0, 1, At, B1); PG8_BAR;
            PG8_LDA(At, 0, 1); PG8_STAGE(PG8_SA(0, 0), a2, voffA);
            PG8_BAR; PG8_WAIT_L(0); PG8_MMA(1, 0, At, B0); PG8_BAR; PG8_SCHED;
            PG8_STAGE(PG8_SB(0, 1), b2 + hstep, voffB);
            PG8_WAIT_V(6); PG8_BAR; PG8_MMA(1, 1, At, B1); PG8_BAR;
            PG8_LDB(B0, 1, 0); PG8_SCHED; PG8_LDA(At, 1, 0); PG8_STAGE(PG8_SA(0, 1), a2 + hstep, voffA);
            PG8_WAIT_L(8); PG8_BAR; PG8_WAIT_L(0); PG8_MMA(0, 0, At, B0); PG8_BAR; PG8_SCHED;
            PG8_LDB(B1, 1, 1); PG8_STAGE(PG8_SB(1, 0), b3, voffB);
            PG8_BAR; PG8_WAIT_L(0); PG8_MMA(0, 1, At, B1); PG8_BAR;
            PG8_LDA(At, 1, 1); PG8_STAGE(PG8_SA(1, 0), a3, voffA);
            PG8_BAR; PG8_WAIT_L(0); PG8_MMA(1, 0, At, B0); PG8_BAR; PG8_SCHED;
            PG8_STAGE(PG8_SB(1, 1), b3 + hstep, voffB);
            PG8_WAIT_V(6); PG8_BAR; PG8_MMA(1, 1, At, B1); PG8_BAR;
            }
        }
        if constexpr (ALIGN_EPI) { if (wr == 0) PG8_BAR; }
        if constexpr (!Epi::AFTER_DRAIN) { E(acc, cur, wr, wc, fr, fq); S.done(cur); }
        if (!has_next) break;
#pragma unroll
        for (int a = 0; a < 2; ++a)
#pragma unroll
            for (int b = 0; b < 2; ++b)
#pragma unroll
                for (int m = 0; m < 4; ++m)
#pragma unroll
                    for (int n = 0; n < 2; ++n) acc[a][b][m][n] = (f32x4){0.f, 0.f, 0.f, 0.f};
        cur = nxt; cA = nA; cB = nB; ++ui;
        if constexpr (ALIGN_EPI) { if (wr == 1) PG8_BAR; }
    }
    PG8_WAIT_V(0);
    if constexpr (!ALIGN_EPI) { if (wr == 0) PG8_BAR; }
    PG8_BAR;
    if constexpr (Epi::AFTER_DRAIN) { E.fused(acc, cur, wr, wc, fr, fq, lds, wid, lane); S.done(cur); }
#undef PG8_SA
#undef PG8_SB
#undef PG8_STAGE
#undef PG8_LDA
#undef PG8_LDB
#undef PG8_MMA
#undef PG8_WAIT_V
#undef PG8_WAIT_L
#undef PG8_BAR
#undef PG8_SCHED
}

constexpr int DM_ = 1024; constexpr float RMS_EPS_ = 1e-5f;
__device__ __forceinline__ float rstd_of(const float* ss, int row) { return __builtin_amdgcn_rsqf(ss[row] * (1.0f / DM_) + RMS_EPS_); }
struct EpiScaleBf16 {
    static constexpr bool PERM = true, AFTER_DRAIN = false;
    bf16_t* O; int ldc; const float* ss;
    __device__ __forceinline__ void operator()(const f32x4 (&acc)[2][2][4][2], const Unit& u, int wr, int wc, int fr, int fq) const {
        const int row0 = u.pm * BM + wr * 64 + fr, col0 = u.pn * BM + wc * 32 + 8 * fq;
        float rsv[2][4];
#pragma unroll
        for (int ai = 0; ai < 2; ++ai)
#pragma unroll
            for (int m = 0; m < 4; ++m) rsv[ai][m] = ss[row0 + ai * HALF + m * 16];
#pragma unroll
        for (int ai = 0; ai < 2; ++ai)
#pragma unroll
            for (int m = 0; m < 4; ++m) { const int row = row0 + ai * HALF + m * 16; const float rs = __builtin_amdgcn_rsqf(rsv[ai][m] * (1.0f / DM_) + RMS_EPS_); bf16_t* rowp = O + (size_t)row * ldc + col0;
#pragma unroll
                for (int bj = 0; bj < 2; ++bj) { const f32x4 v0 = acc[ai][bj][m][0] * rs, v1 = acc[ai][bj][m][1] * rs;
                    u32x4 w; w.x = cvt_pk_bf16(v0[0], v0[1]); w.y = cvt_pk_bf16(v0[2], v0[3]); w.z = cvt_pk_bf16(v1[0], v1[1]); w.w = cvt_pk_bf16(v1[2], v1[3]);
                    *(u32x4*)(rowp + bj * HALF) = w; } }
    }
};
struct EpiResid {
    static constexpr bool PERM = false, AFTER_DRAIN = false;
    const float* base; float* xout; bf16_t* xb; float* ss_out;
    __device__ __forceinline__ void operator()(const f32x4 (&acc)[2][2][4][2], const Unit& u, int wr, int wc, int fr, int fq) const {
        typedef unsigned u32x2v __attribute__((ext_vector_type(2)));
        const int row0 = u.pm * BM + wr * 64 + fr, col0 = u.pn * BM + wc * 32 + 4 * fq;
#pragma unroll
        for (int ai = 0; ai < 2; ++ai)
#pragma unroll
            for (int m = 0; m < 4; ++m) { const int row = row0 + ai * HALF + m * 16; const size_t off = (size_t)row * DM_ + col0; float sq = 0.f;
#pragma unroll
                for (int bj = 0; bj < 2; ++bj)
#pragma unroll
                    for (int n = 0; n < 2; ++n) { const size_t o = off + bj * HALF + n * 16; const f32x4 x = *(const f32x4*)(base + o) + acc[ai][bj][m][n];
                        *(f32x4*)(xout + o) = x; u32x2v w; w.x = cvt_pk_bf16(x[0], x[1]); w.y = cvt_pk_bf16(x[2], x[3]); *(u32x2v*)(xb + o) = w;
                        sq += (x[0] * x[0] + x[1] * x[1]) + (x[2] * x[2] + x[3] * x[3]); }
                sq += __shfl_xor(sq, 16); sq += __shfl_xor(sq, 32);
                if (fq == 0) atomicAdd(ss_out + row, sq); }
    }
};
struct EpiGateUpTmp {
    static constexpr bool PERM = true, AFTER_DRAIN = false;
    bf16_t* U; bf16_t* UP; const float* ss; int ff;
    __device__ __forceinline__ void operator()(const f32x4 (&acc)[2][2][4][2], const Unit& u, int wr, int wc, int fr, int fq) const {
        const int row0 = u.pm * BM + wr * 64 + fr, col0 = u.pn * HALF + wc * 32 + 8 * fq;
        float rsv[2][4];
#pragma unroll
        for (int ai = 0; ai < 2; ++ai)
#pragma unroll
            for (int m = 0; m < 4; ++m) rsv[ai][m] = ss[row0 + ai * HALF + m * 16];
#pragma unroll
        for (int ai = 0; ai < 2; ++ai)
#pragma unroll
            for (int m = 0; m < 4; ++m) { const int row = row0 + ai * HALF + m * 16; const float rs = __builtin_amdgcn_rsqf(rsv[ai][m] * (1.0f / DM_) + RMS_EPS_); const size_t o = (size_t)row * ff + col0;
#pragma unroll
                for (int bj = 0; bj < 2; ++bj) { const f32x4 v0 = acc[ai][bj][m][0] * rs, v1 = acc[ai][bj][m][1] * rs;
                    u32x4 w; w.x = cvt_pk_bf16(v0[0], v0[1]); w.y = cvt_pk_bf16(v0[2], v0[3]); w.z = cvt_pk_bf16(v1[0], v1[1]); w.w = cvt_pk_bf16(v1[2], v1[3]);
                    *(u32x4*)((bj == 0 ? U : UP) + o) = w; } }
    }
};
template <int CTRL> __device__ __forceinline__ float dpp1(float x) { return __builtin_bit_cast(float, __builtin_amdgcn_update_dpp(0, __builtin_bit_cast(int, x), CTRL, 0xF, 0xF, true)); }
template <int CTRL> __device__ __forceinline__ f32x4 dpp4(const f32x4 x) { return (f32x4){dpp1<CTRL>(x.x), dpp1<CTRL>(x.y), dpp1<CTRL>(x.z), dpp1<CTRL>(x.w)}; }
struct EpiConvGlu {
    static constexpr bool PERM = true, AFTER_DRAIN = false;
    bf16_t* HID; const float* ss; const float* cw; const float* cb; float* SB; PG8_LAS float* xch; int ff;
    __device__ __forceinline__ void operator()(const f32x4 (&acc)[2][2][4][2], const Unit& u, int wr, int wc, int fr, int fq) const {
        const int row0 = u.pm * BM + wr * 64 + fr, cl = wc * 32 + 8 * fq, jcol = u.pn * HALF + cl;
        float rs[2][4];
#pragma unroll
        for (int ai = 0; ai < 2; ++ai)
#pragma unroll
            for (int m = 0; m < 4; ++m) rs[ai][m] = ss[row0 + ai * HALF + m * 16];
        f32x4 w0[2], w1[2], w2[2], bb[2];
#pragma unroll
        for (int n = 0; n < 2; ++n) { w0[n] = *(const f32x4*)(cw + jcol + 4 * n); w1[n] = *(const f32x4*)(cw + ff + jcol + 4 * n); w2[n] = *(const f32x4*)(cw + 2 * ff + jcol + 4 * n); bb[n] = *(const f32x4*)(cb + jcol + 4 * n); }
#pragma unroll
        for (int ai = 0; ai < 2; ++ai)
#pragma unroll
            for (int m = 0; m < 4; ++m) rs[ai][m] = __builtin_amdgcn_rsqf(rs[ai][m] * (1.0f / DM_) + RMS_EPS_);
        if (fr >= 14) {
#pragma unroll
            for (int ai = 0; ai < 2; ++ai)
#pragma unroll
                for (int n = 0; n < 2; ++n) *(PG8_LAS f32x4*)(xch + ((2 * ai + wr) * 2 + (fr - 14)) * HALF + cl + 4 * n) = acc[ai][0][3][n] * rs[ai][3];
        }
        asm volatile("s_waitcnt lgkmcnt(0)" ::: "memory"); __builtin_amdgcn_s_barrier(); asm volatile("" ::: "memory");
        float* sbp = SB + (size_t)u.pm * 6 * ff + jcol;
#pragma unroll
        for (int ai = 0; ai < 2; ++ai) {
            const int q = 2 * ai + wr;
            f32x4 X[2];
#pragma unroll
            for (int n = 0; n < 2; ++n) { X[n] = (f32x4){0.f, 0.f, 0.f, 0.f}; if (q > 0 && fr >= 14) X[n] = *(const PG8_LAS f32x4*)(xch + ((q - 1) * 2 + (fr - 14)) * HALF + cl + 4 * n); }
#pragma unroll
            for (int m = 0; m < 4; ++m) { const int row = row0 + ai * HALF + m * 16;
                pg8::u32x4 hw;
#pragma unroll
                for (int n = 0; n < 2; ++n) {
                    const f32x4 cur = acc[ai][0][m][n] * rs[ai][m], up = acc[ai][1][m][n] * rs[ai][m];
                    const f32x4 P = (m > 0) ? acc[ai][0][m > 0 ? m - 1 : 0][n] * rs[ai][m > 0 ? m - 1 : 0] : X[n];
                    const f32x4 a1 = dpp4<0x121>(cur), b1 = dpp4<0x121>(P), a2 = dpp4<0x122>(cur), b2 = dpp4<0x122>(P);
                    f32x4 p1, p2;
#pragma unroll
                    for (int e = 0; e < 4; ++e) { p1[e] = fr == 0 ? b1[e] : a1[e]; p2[e] = fr < 2 ? b2[e] : a2[e]; }
                    const f32x4 c = bb[n] + w0[n] * p2 + w1[n] * p1 + w2[n] * cur;
                    f32x4 hv;
#pragma unroll
                    for (int e = 0; e < 4; ++e) hv[e] = c[e] * __builtin_amdgcn_rcpf(1.f + __expf(-c[e])) * up[e];
                    if (n == 0) { hw.x = cvt_pk_bf16(hv[0], hv[1]); hw.y = cvt_pk_bf16(hv[2], hv[3]); } else { hw.z = cvt_pk_bf16(hv[0], hv[1]); hw.w = cvt_pk_bf16(hv[2], hv[3]); }
                    if (q == 0 && m == 0 && fr < 2) { *(f32x4*)(sbp + (size_t)fr * ff + 4 * n) = cur; *(f32x4*)(sbp + (size_t)(2 + fr) * ff + 4 * n) = up; }
                    if (q == 3 && m == 3 && fr >= 14) *(f32x4*)(sbp + (size_t)(4 + fr - 14) * ff + 4 * n) = cur;
                }
                *(pg8::u32x4*)(HID + (size_t)row * ff + jcol) = hw; }
        }
    }
};
}

#define LAS __attribute__((address_space(3)))
__device__ __forceinline__ void transpose_item(const float* __restrict__ W, int K, int N, bf16_t* __restrict__ Wt, const float* __restrict__ g, int mode, float* scr, int item, int lane) {
    const int nblk = N / 32, kb = item / nblk, nb = item % nblk, k0 = 64 * kb, n0 = 32 * nb;
    int np0 = n0; if (mode == 1) np0 = 256 * (n0 / 128) + (n0 % 128); else if (mode == 2) np0 = 256 * (n0 / 128) + 128 + (n0 % 128);
#pragma unroll 8
    for (int i = 0; i < 32; ++i) { const int kk = 2 * i + (lane >> 5); scr[kk * 33 + (lane & 31)] = W[(size_t)(k0 + kk) * N + n0 + (lane & 31)] * (g ? g[k0 + kk] : 1.f); }
    __builtin_amdgcn_fence(__ATOMIC_RELEASE, "wavefront"); __builtin_amdgcn_wave_barrier(); __builtin_amdgcn_fence(__ATOMIC_ACQUIRE, "wavefront");
    const int c = lane & 7;
#pragma unroll
    for (int j = 0; j < 4; ++j) { const int n = (lane >> 3) + 8 * j; const float* sp = scr + (8 * c) * 33 + n;
        uint4 o; o.x = f2bf(sp[0]) | (f2bf(sp[33]) << 16); o.y = f2bf(sp[2 * 33]) | (f2bf(sp[3 * 33]) << 16); o.z = f2bf(sp[4 * 33]) | (f2bf(sp[5 * 33]) << 16); o.w = f2bf(sp[6 * 33]) | (f2bf(sp[7 * 33]) << 16);
        *(uint4*)(Wt + (size_t)(np0 + n) * K + k0 + 8 * c) = o; }
    __builtin_amdgcn_fence(__ATOMIC_RELEASE, "wavefront"); __builtin_amdgcn_wave_barrier(); __builtin_amdgcn_fence(__ATOMIC_ACQUIRE, "wavefront");
}
__device__ __forceinline__ void x_row_to_bf16(const float* __restrict__ x, bf16_t* __restrict__ xb, float* __restrict__ ss, int row, int lane) {
    const f32x4* xr = (const f32x4*)(x + (size_t)row * D) + lane; float s = 0.f;
#pragma unroll
    for (int j = 0; j < 4; ++j) { const f32x4 v = xr[64 * j]; s += v.x * v.x + v.y * v.y + v.z * v.z + v.w * v.w;
        unsigned long long o = (unsigned long long)(f2bf(v.x) | (f2bf(v.y) << 16)) | ((unsigned long long)(f2bf(v.z) | (f2bf(v.w) << 16)) << 32);
        ((unsigned long long*)(xb + (size_t)row * D))[lane + 64 * j] = o; }
    s = wave_sum(s); if (lane == 0) ss[row] = s;
}

struct EpArgs {
    const float* ss; float* ss_out; const float* base; float* xout; bf16_t* ob; bf16_t* ob2; int ldo; int row_off;
};
template <int MODE>
__device__ __forceinline__ void gemm_simple(const bf16_t* __restrict__ A, int lda, const bf16_t* __restrict__ Bt, int ldb, int Mrows, int N, int K, EpArgs e, int tid) {
    const int wid = tid >> 6, lane = tid & 63, fr = lane & 15, fq = lane >> 4;
    const int ntn = N / 128, ntiles = (Mrows / 64) * ntn;
    for (int tile = blockIdx.x; tile < ntiles; tile += gridDim.x) {
    const int row0 = (tile / ntn) * 64 + (wid >> 2) * 32, col0 = (tile % ntn) * 128 + (wid & 3) * 32;
    f32x4 acc[2][2];
#pragma unroll
    for (int i = 0; i < 2; ++i)
#pragma unroll
        for (int j = 0; j < 2; ++j) acc[i][j] = (f32x4){0.f, 0.f, 0.f, 0.f};
    const bf16_t* ap = A + (size_t)(row0 + fr) * lda + fq * 8;
    const bf16_t* bp = Bt + (size_t)(col0 + fr) * ldb + fq * 8;
    for (int k0 = 0; k0 < K; k0 += 32) {
        bf16x8 a[2], b[2];
#pragma unroll
        for (int i = 0; i < 2; ++i) { a[i] = *(const bf16x8*)(ap + (size_t)i * 16 * lda + k0); b[i] = *(const bf16x8*)(bp + (size_t)i * 16 * ldb + k0); }
#pragma unroll
        for (int i = 0; i < 2; ++i)
#pragma unroll
            for (int j = 0; j < 2; ++j) acc[i][j] = __builtin_amdgcn_mfma_f32_16x16x32_bf16(a[i], b[j], acc[i][j], 0, 0, 0);
    }
#pragma unroll
    for (int i = 0; i < 2; ++i)
#pragma unroll
        for (int r = 0; r < 4; ++r) {
            const int row = row0 + i * 16 + fq * 4 + r;
            float rstd = 1.f;
            if (MODE == 0 || MODE == 2) rstd = rsqrtf(e.ss[row] * (1.f / D) + RMS_EPS);
            float sq = 0.f;
#pragma unroll
            for (int j = 0; j < 2; ++j) {
                const int col = col0 + j * 16 + fr; const float v = acc[i][j][r];
                if (MODE == 0) e.ob[(size_t)row * e.ldo + col] = (bf16_t)f2bf(v * rstd);
                else if (MODE == 1) { const size_t o = (size_t)row * D + col; const float x = e.base[o] + v; e.xout[o] = x; e.ob[o] = (bf16_t)f2bf(x); sq += x * x; }
                else { const int p = col >> 8, jj = col & 255; const size_t o = (size_t)(row - e.row_off) * FF + 128 * p + (jj & 127);
                    if (jj < 128) e.ob[o] = (bf16_t)f2bf(v * rstd); else e.ob2[o] = (bf16_t)f2bf(v * rstd); }
            }
            if (MODE == 1) {
                sq += __shfl_xor(sq, 1); sq += __shfl_xor(sq, 2); sq += __shfl_xor(sq, 4); sq += __shfl_xor(sq, 8);
                if (fr == 0) atomicAdd(e.ss_out + row, sq);
            }
        }
    }
}

struct PrepArgs {
    const bf16_t* proj; const float* mu; const float* w0; const float* w2; const float* a0; const float* a2; const float* g2;
    const float* v0; const float* v1; const float* v2; bf16_t* vfirst; int layer; int pad;
    bf16_t *R, *K, *V, *A, *LD, *G;
};
__device__ __forceinline__ void prep_group(const PrepArgs& p, float (*rest)[SHIFT_W], float (*vlo)[32], int grp, int tid) {
    const int m0 = grp * 4;
    for (int i = tid; i < 4 * SHIFT_W; i += 512) {
        const int tk = i / SHIFT_W, c = i % SHIFT_W, m = m0 + tk, t = m % SEQ;
        const float u = bf2f(p.proj[(size_t)m * IN_W + ATT_IN + c]);
        const float up = t > 0 ? bf2f(p.proj[(size_t)(m - 1) * IN_W + ATT_IN + c]) : 0.f;
        float v = u + (up - u) * p.mu[c];
        if (c >= 1536 && c < 1600) v = tanhf(v); else if (c >= 1664) v = sigmoidf_(v);
        rest[tk][c] = v;
    }
    __syncthreads();
    if (p.layer > 0 && tid < 128) { const int tk = tid >> 5, j = tid & 31; float s = 0.f; for (int c = 0; c < C; ++c) s += rest[tk][1024 + c] * p.v1[c * 32 + j]; vlo[tk][j] = s; }
    __syncthreads();
    const int c = tid;
    float wp[4], ap[4], gp[4];
#pragma unroll
    for (int tk = 0; tk < 4; ++tk) { wp[tk] = p.w0[c]; ap[tk] = p.a0[c]; gp[tk] = 0.f; }
    for (int k = 0; k < 64; ++k) { const float w = p.w2[k * C + c], a = p.a2[k * C + c];
#pragma unroll
        for (int tk = 0; tk < 4; ++tk) { wp[tk] += rest[tk][1536 + k] * w; ap[tk] += rest[tk][1600 + k] * a; } }
    for (int k = 0; k < 128; ++k) { const float g = p.g2[k * C + c];
#pragma unroll
        for (int tk = 0; tk < 4; ++tk) gp[tk] += rest[tk][1664 + k] * g; }
#pragma unroll
    for (int tk = 0; tk < 4; ++tk) {
        const size_t o = (size_t)(m0 + tk) * C + c;
        const float x = -wp[tk];
        const float sp = fmaxf(x, 0.f) + log1pf(__expf(-fabsf(x)));
        const float wraw = -sp - 0.5f;
        const float ld = -__expf(wraw);
        const float a = sigmoidf_(ap[tk]);
        float v = rest[tk][1024 + c];
        if (p.layer == 0) p.vfirst[o] = (bf16_t)f2bf(v);
        else { float s = p.v0[c]; for (int j = 0; j < 32; ++j) s += vlo[tk][j] * p.v2[j * C + c]; const float vf = bf2f(p.vfirst[o]); v = v + (vf - v) * sigmoidf_(s); }
        p.R[o] = (bf16_t)f2bf(rest[tk][c]); p.K[o] = (bf16_t)f2bf(rest[tk][512 + c]); p.V[o] = (bf16_t)f2bf(v);
        p.A[o] = (bf16_t)f2bf(a); p.LD[o] = (bf16_t)f2bf(ld); p.G[o] = (bf16_t)f2bf(gp[tk]);
    }
    __syncthreads();
}

constexpr size_t WS_LORA = 50 * MiB;
constexpr size_t LORA_LAYER = 256 * 1024, WS_V1T = WS_LORA + 2 * LORA_LAYER, WS_V2T = WS_V1T + 32 * 1024;
constexpr int PR_ACT_LD = 264, PR_VLO_LD = 40, PR_SG_LD = 520, PR_ACT_OFF = 0, PR_VLO_OFF = 64 * PR_ACT_LD * 2, PR_SG_OFF = PR_VLO_OFF + 64 * PR_VLO_LD * 2;
struct Prep2Args {
    const bf16_t* proj; const float* mu; const float* w0; const float* a0; const float* v0;
    const bf16_t *W2T, *A2T, *G2T, *V1T, *V2T; bf16_t* vfirst; bf16_t *R, *K, *V, *A, *LD, *G; int layer; int pad;
};
__device__ __forceinline__ f32x4 bfx4_lo(const bf16x8 v) { return (f32x4){bf2f((bf16_t)v[0]), bf2f((bf16_t)v[1]), bf2f((bf16_t)v[2]), bf2f((bf16_t)v[3])}; }
__device__ __forceinline__ f32x4 bfx4_hi(const bf16x8 v) { return (f32x4){bf2f((bf16_t)v[4]), bf2f((bf16_t)v[5]), bf2f((bf16_t)v[6]), bf2f((bf16_t)v[7])}; }
__device__ __forceinline__ bf16x8 pack8(const f32x4 a, const f32x4 b) { pg8::u32x4 w; w.x = pg8::cvt_pk_bf16(a[0], a[1]); w.y = pg8::cvt_pk_bf16(a[2], a[3]); w.z = pg8::cvt_pk_bf16(b[0], b[1]); w.w = pg8::cvt_pk_bf16(b[2], b[3]); return __builtin_bit_cast(bf16x8, w); }
__device__ __forceinline__ void shift8(const bf16_t* __restrict__ proj, const float* __restrict__ mu, size_t m, int t, int col, int mi, f32x4& lo, f32x4& hi) {
    const bf16x8 cur = *(const bf16x8*)(proj + m * IN_W + col);
    bf16x8 prv; if (t > 0) prv = *(const bf16x8*)(proj + (m - 1) * IN_W + col); else prv = (bf16x8){0, 0, 0, 0, 0, 0, 0, 0};
    const f32x4 m0 = *(const f32x4*)(mu + mi), m1 = *(const f32x4*)(mu + mi + 4);
    const f32x4 c0 = bfx4_lo(cur), c1 = bfx4_hi(cur), p0 = bfx4_lo(prv), p1 = bfx4_hi(prv);
    lo = c0 + (p0 - c0) * m0; hi = c1 + (p1 - c1) * m1;
}
__device__ __forceinline__ void prep_tile(const Prep2Args& p, unsigned char* lds, int tile, int tid) {
    const int m0 = tile * 64, wave = __builtin_amdgcn_readfirstlane(tid >> 6), lane = tid & 63, fr = lane & 15, fq = lane >> 4;
    bf16_t* ACT = (bf16_t*)(lds + PR_ACT_OFF); bf16_t* VLO = (bf16_t*)(lds + PR_VLO_OFF); bf16_t* SG = (bf16_t*)(lds + PR_SG_OFF);
#pragma unroll
    for (int it = 0; it < 4; ++it) { const int i = tid + 512 * it, tk = i >> 5, cc = i & 31; const size_t m = (size_t)m0 + tk; const int t = (int)(m % SEQ);
        f32x4 lo, hi; shift8(p.proj, p.mu, m, t, 2304 + 8 * cc, 1536 + 8 * cc, lo, hi);
        if (cc < 8) {
#pragma unroll
            for (int e = 0; e < 4; ++e) { lo[e] = 2.f * sigmoidf_(2.f * lo[e]) - 1.f; hi[e] = 2.f * sigmoidf_(2.f * hi[e]) - 1.f; } }
        else if (cc >= 16) {
#pragma unroll
            for (int e = 0; e < 4; ++e) { lo[e] = sigmoidf_(lo[e]); hi[e] = sigmoidf_(hi[e]); } }
        *(bf16x8*)(ACT + tk * PR_ACT_LD + 8 * cc) = pack8(lo, hi); }
    if (p.layer > 0) {
        const int tb = wave >> 1, jb = wave & 1; const size_t m = (size_t)m0 + 16 * tb + fr; const int t = (int)(m % SEQ);
        f32x4 acc = (f32x4){0.f, 0.f, 0.f, 0.f};
#pragma unroll 4
        for (int ks = 0; ks < 16; ++ks) { f32x4 lo, hi; shift8(p.proj, p.mu, m, t, 1792 + 32 * ks + 8 * fq, 1024 + 32 * ks + 8 * fq, lo, hi);
            const bf16x8 wf = *(const bf16x8*)(p.V1T + (size_t)(16 * jb + fr) * C + 32 * ks + 8 * fq);
            acc = __builtin_amdgcn_mfma_f32_16x16x32_bf16(wf, pack8(lo, hi), acc, 0, 0, 0); }
        uint2 w; w.x = pg8::cvt_pk_bf16(acc[0], acc[1]); w.y = pg8::cvt_pk_bf16(acc[2], acc[3]);
        *(uint2*)(VLO + (16 * tb + fr) * PR_VLO_LD + 16 * jb + 4 * fq) = w;
    }
    __syncthreads();
    const int ch0 = 64 * wave;
#pragma unroll
    for (int arr = 0; arr < 3; ++arr) {
        const int K0 = arr == 0 ? 0 : (arr == 1 ? 64 : 128), KL = arr == 2 ? 128 : 64; const bf16_t* WT = arr == 0 ? p.W2T : (arr == 1 ? p.A2T : p.G2T);
        f32x4 acc[4][4];
#pragma unroll
        for (int tb = 0; tb < 4; ++tb)
#pragma unroll
            for (int cb = 0; cb < 4; ++cb) acc[tb][cb] = (f32x4){0.f, 0.f, 0.f, 0.f};
#pragma unroll
        for (int ks = 0; ks < KL / 32; ++ks) { bf16x8 wf[4], af[4];
#pragma unroll
            for (int cb = 0; cb < 4; ++cb) wf[cb] = *(const bf16x8*)(WT + (size_t)(ch0 + 16 * cb + fr) * KL + 32 * ks + 8 * fq);
#pragma unroll
            for (int tb = 0; tb < 4; ++tb) af[tb] = *(const bf16x8*)(ACT + (16 * tb + fr) * PR_ACT_LD + K0 + 32 * ks + 8 * fq);
#pragma unroll
            for (int tb = 0; tb < 4; ++tb)
#pragma unroll
                for (int cb = 0; cb < 4; ++cb) acc[tb][cb] = __builtin_amdgcn_mfma_f32_16x16x32_bf16(wf[cb], af[tb], acc[tb][cb], 0, 0, 0); }
        bf16_t* OUT = arr == 0 ? p.LD : (arr == 1 ? p.A : p.G);
#pragma unroll
        for (int cb = 0; cb < 4; ++cb) { const int ch = ch0 + 16 * cb + 4 * fq;
            f32x4 bias = (f32x4){0.f, 0.f, 0.f, 0.f}; if (arr == 0) bias = *(const f32x4*)(p.w0 + ch); else if (arr == 1) bias = *(const f32x4*)(p.a0 + ch);
#pragma unroll
            for (int tb = 0; tb < 4; ++tb) { f32x4 x = acc[tb][cb] + bias;
                if (arr == 0) {
#pragma unroll
                    for (int e = 0; e < 4; ++e) { const float z = -x[e]; const float sp = fmaxf(z, 0.f) + __logf(1.f + __expf(-fabsf(z))); x[e] = -__expf(-sp - 0.5f); } }
                else if (arr == 1) {
#pragma unroll
                    for (int e = 0; e < 4; ++e) x[e] = sigmoidf_(x[e]); }
                uint2 w; w.x = pg8::cvt_pk_bf16(x[0], x[1]); w.y = pg8::cvt_pk_bf16(x[2], x[3]);
                *(uint2*)(OUT + ((size_t)m0 + 16 * tb + fr) * C + ch) = w; } }
    }
    if (p.layer > 0) {
        bf16x8 af[4];
#pragma unroll
        for (int tb = 0; tb < 4; ++tb) af[tb] = *(const bf16x8*)(VLO + (16 * tb + fr) * PR_VLO_LD + 8 * fq);
#pragma unroll
        for (int cb = 0; cb < 4; ++cb) { const int ch = ch0 + 16 * cb + 4 * fq; const bf16x8 wf = *(const bf16x8*)(p.V2T + (size_t)(ch0 + 16 * cb + fr) * 32 + 8 * fq); const f32x4 bias = *(const f32x4*)(p.v0 + ch);
#pragma unroll
            for (int tb = 0; tb < 4; ++tb) { f32x4 x = __builtin_amdgcn_mfma_f32_16x16x32_bf16(wf, af[tb], (f32x4){0.f, 0.f, 0.f, 0.f}, 0, 0, 0) + bias;
                uint2 w; w.x = pg8::cvt_pk_bf16(sigmoidf_(x[0]), sigmoidf_(x[1])); w.y = pg8::cvt_pk_bf16(sigmoidf_(x[2]), sigmoidf_(x[3]));
                *(uint2*)(SG + (16 * tb + fr) * PR_SG_LD + ch) = w; } }
    }
    __syncthreads();
#pragma unroll
    for (int sec = 0; sec < 3; ++sec) { bf16_t* OUT = sec == 0 ? p.R : (sec == 1 ? p.K : p.V);
#pragma unroll 4
        for (int it = 0; it < 8; ++it) { const int i = tid + 512 * it, tk = i >> 6, cc = i & 63; const size_t m = (size_t)m0 + tk; const int t = (int)(m % SEQ);
            f32x4 lo, hi; shift8(p.proj, p.mu, m, t, 768 + 512 * sec + 8 * cc, 512 * sec + 8 * cc, lo, hi);
            const size_t o = m * C + 8 * cc;
            if (sec == 2) {
                if (p.layer == 0) *(bf16x8*)(p.vfirst + o) = pack8(lo, hi);
                else { const bf16x8 vf = *(const bf16x8*)(p.vfirst + o), sg = *(const bf16x8*)(SG + tk * PR_SG_LD + 8 * cc);
                    lo = lo + (bfx4_lo(vf) - lo) * bfx4_lo(sg); hi = hi + (bfx4_hi(vf) - hi) * bfx4_hi(sg); } }
            *(bf16x8*)(OUT + o) = pack8(lo, hi); } }
    __syncthreads();
}

constexpr int NTHREADS_ = 512;
constexpr int SC_TB = 32, SC_SLOT = 384, SC_NCH = SEQ / SC_TB;
constexpr int WS_RKC = 1 * (1 << 20);
struct ScanArgs { const bf16_t *R, *K, *V, *A, *LD, *G; const float *k_k, *k_a, *r_k, *lnx_g, *lnx_b; bf16_t* mix; float* rkc; };
template <int CTRL> __device__ __forceinline__ float dpp_mov(float x) { return __builtin_bit_cast(float, __builtin_amdgcn_update_dpp(0, __builtin_bit_cast(int, x), CTRL, 0xF, 0xF, true)); }
__device__ __forceinline__ float reduce16(float x) { x += dpp_mov<0xB1>(x); x += dpp_mov<0x4E>(x); x += dpp_mov<0x141>(x); x += dpp_mov<0x140>(x); return x; }
__device__ __forceinline__ void scan_item(const ScanArgs& p, float* lds, int item, int tid) {
    const int chain = item >> 2, q = item & 3, b = chain >> 3, h = chain & 7, wave = __builtin_amdgcn_readfirstlane(tid >> 6), lane = tid & 63;
    float* buf = lds;
    float* ybuf = lds + 2 * SC_TB * SC_SLOT;
    if (wave >= 4) {
        const int lw = wave - 4, lt = lw * 64 + lane, cgl = lane & 15, srow = lane >> 4, ch4 = h * 64 + 4 * cgl;
        const f32x4 kk_c = *(const f32x4*)(p.k_k + ch4), ka_c = *(const f32x4*)(p.k_a + ch4), rk_c = *(const f32x4*)(p.r_k + ch4);
        const size_t rowbase = (size_t)b * SEQ;
        struct LdSet { uint2 r[2], k[2], v[2], a[2], ld[2]; } s0, s1;
#define SC_LOAD(S, chunk) do { _Pragma("unroll") for (int ps = 0; ps < 2; ++ps) { const size_t o = (rowbase + (size_t)(chunk) * SC_TB + 8 * lw + 4 * ps + srow) * C + ch4; \
            S.r[ps] = *(const uint2*)(p.R + o); S.k[ps] = *(const uint2*)(p.K + o); S.v[ps] = *(const uint2*)(p.V + o); S.a[ps] = *(const uint2*)(p.A + o); S.ld[ps] = *(const uint2*)(p.LD + o); } } while (0)
#define SC_UNPK(u) ((f32x4){__builtin_bit_cast(float, (u).x << 16), __builtin_bit_cast(float, (u).x & 0xffff0000u), __builtin_bit_cast(float, (u).y << 16), __builtin_bit_cast(float, (u).y & 0xffff0000u)})
#define SC_PROC(S, chunk, bi) do { _Pragma("unroll") for (int ps = 0; ps < 2; ++ps) { const int st = 8 * lw + 4 * ps + srow; \
            const f32x4 r = SC_UNPK(S.r[ps]), k = SC_UNPK(S.k[ps]), v = SC_UNPK(S.v[ps]), a = SC_UNPK(S.a[ps]), ld = SC_UNPK(S.ld[ps]); \
            f32x4 kk = k * kk_c; const float nrm = sqrtf(reduce16((kk.x * kk.x + kk.z * kk.z) + (kk.y * kk.y + kk.w * kk.w))); kk = kk * (1.f / fmaxf(nrm, 1e-12f)); \
            const f32x4 kp = k * ((a - 1.f) * ka_c + 1.f); const f32x4 t3 = r * kp * rk_c; const float rkc = reduce16((t3.x + t3.z) + (t3.y + t3.w)); \
            float* slot = buf + ((bi) * SC_TB + st) * SC_SLOT + 4 * cgl; \
            *(f32x4*)(slot) = (f32x4){__expf(ld.x), __expf(ld.y), __expf(ld.z), __expf(ld.w)}; *(f32x4*)(slot + 64) = -kk; *(f32x4*)(slot + 128) = kk * a; *(f32x4*)(slot + 192) = kp; *(f32x4*)(slot + 256) = r; *(f32x4*)(slot + 320) = v; \
            if (q == 0 && cgl == 0) p.rkc[(rowbase + (size_t)(chunk) * SC_TB + st) * 8 + h] = rkc; } } while (0)
#define SC_YOUT(chunk, bi) do { _Pragma("unroll") for (int e2 = 0; e2 < 2; ++e2) { const int e = lt + 256 * e2, st = e >> 4, rr = e & 15; \
            p.mix[(rowbase + (size_t)(chunk) * SC_TB + st) * D + ATT_W + h * 64 + 16 * q + rr] = (bf16_t)f2bf(ybuf[(bi) * SC_TB * 16 + e]); } } while (0)
        SC_LOAD(s0, 0); SC_LOAD(s1, 1); SC_PROC(s0, 0, 0);
        __syncthreads();
        for (int c = 0; c < SC_NCH; c += 2) {
            if (c + 2 < SC_NCH) SC_LOAD(s0, c + 2);
            SC_PROC(s1, c + 1, 1);
            if (c >= 1) SC_YOUT(c - 1, 1);
            __syncthreads();
            if (c + 3 < SC_NCH) SC_LOAD(s1, c + 3);
            if (c + 2 < SC_NCH) SC_PROC(s0, c + 2, 0);
            SC_YOUT(c, 0);
            __syncthreads();
        }
        SC_YOUT(SC_NCH - 1, 1);
#undef SC_LOAD
#undef SC_UNPK
#undef SC_PROC
#undef SC_YOUT
    } else {
        const int cg4 = (lane & 15) * 4, rloc = 4 * wave + (lane >> 4);
        f32x4 S = (f32x4){0.f, 0.f, 0.f, 0.f};
#define SC_SCAN(bi) do { const float* bp = buf + (bi) * SC_TB * SC_SLOT + cg4; const float* vp = buf + (bi) * SC_TB * SC_SLOT + 320 + 16 * q + rloc; \
            const unsigned ya = (unsigned)(size_t)(__attribute__((address_space(3))) float*)(((lane & 15) == 0) ? (ybuf + (bi) * SC_TB * 16 + rloc) : (ybuf + 2 * SC_TB * 16 + lane)); \
            f32x4 w = *(const f32x4*)(bp), A = *(const f32x4*)(bp + 64), B = *(const f32x4*)(bp + 128), kp = *(const f32x4*)(bp + 192), r = *(const f32x4*)(bp + 256); float v = vp[0]; \
            _Pragma("unroll") for (int st = 0; st < SC_TB; ++st) { \
                f32x4 wn = w, An = A, Bn = B, kpn = kp, rn = r; float vn = v; \
                if (st + 1 < SC_TB) { wn = *(const f32x4*)(bp + (st + 1) * SC_SLOT); An = *(const f32x4*)(bp + (st + 1) * SC_SLOT + 64); Bn = *(const f32x4*)(bp + (st + 1) * SC_SLOT + 128); \
                    kpn = *(const f32x4*)(bp + (st + 1) * SC_SLOT + 192); rn = *(const f32x4*)(bp + (st + 1) * SC_SLOT + 256); vn = vp[(st + 1) * SC_SLOT]; }     \
                float sa = (S.x * A.x + S.z * A.z) + (S.y * A.y + S.w * A.w); sa = reduce16(sa); \
                S = S * w + (B * sa + kp * v); \
                float y = (S.x * r.x + S.z * r.z) + (S.y * r.y + S.w * r.w); y = reduce16(y); \
                asm volatile("ds_write_b32 %0, %1 offset:%c2" :: "v"(ya), "v"(y), "i"(st * 64)); \
                w = wn; A = An; B = Bn; kp = kpn; r = rn; v = vn; } } while (0)
        __syncthreads();
        for (int c = 0; c < SC_NCH; c += 2) { SC_SCAN(0); __syncthreads(); SC_SCAN(1); __syncthreads(); }
#undef SC_SCAN
    }
    __syncthreads();
}
__device__ __forceinline__ void scan_post(const ScanArgs& p, int idx, int lane) {
    const int m = idx >> 3, h = idx & 7, ch = h * 64 + lane; const size_t o = (size_t)m * C + ch, om = (size_t)m * D + ATT_W + ch;
    const float y = bf2f(p.mix[om]);
    const float mean = wave_sum(y) * (1.f / 64.f); const float d = y - mean; const float var = wave_sum(d * d) * (1.f / 64.f);
    const float yn = d * rsqrtf(var + LNX_EPS) * p.lnx_g[ch] + p.lnx_b[ch];
    p.mix[om] = (bf16_t)f2bf((yn + p.rkc[(size_t)m * 8 + h] * bf2f(p.V[o])) * bf2f(p.G[o]));
}

typedef float f32x16 __attribute__((ext_vector_type(16)));
typedef short s16x4 __attribute__((ext_vector_type(4)));
constexpr int AT_VTS = 196;
__device__ __forceinline__ int crow(int r, int hi) { return (r & 3) + 8 * (r >> 2) + 4 * hi; }
__device__ __forceinline__ void attn_unit(const bf16_t* __restrict__ proj, const float* __restrict__ sinks, bf16_t* __restrict__ mix, bf16_t* vt, int unit, int tid) {
    const int b = unit >> 7, kvh = (unit >> 6) & 1, qb = unit & 63, Q0 = qb * 64;
    const int wave = __builtin_amdgcn_readfirstlane(tid >> 6), lane = tid & 63, c = lane & 31, hi = lane >> 5, g = wave >> 1, half = wave & 1, h = kvh * 4 + g;
    const size_t rowb = (size_t)b * SEQ;
    for (int i = tid; i < 192 * 8; i += 512) { const int kl = i >> 3, ch8 = i & 7; int key = Q0 - 128 + kl; key = key < 0 ? 0 : key;
        const bf16x8 v = *(const bf16x8*)(proj + (rowb + key) * IN_W + 640 + kvh * 64 + ch8 * 8);
#pragma unroll
        for (int e = 0; e < 8; ++e) vt[(ch8 * 8 + e) * AT_VTS + kl] = (bf16_t)v[e]; }
    __syncthreads();
    const int t0 = Q0 + 32 * half; const size_t mq = rowb + t0 + c;
    bf16x8 qf[4];
#pragma unroll
    for (int ks = 0; ks < 4; ++ks) qf[ks] = *(const bf16x8*)(proj + mq * IN_W + h * 64 + 16 * ks + 8 * hi);
    f32x16 p[5];
#pragma unroll
    for (int kb = 0; kb < 5; ++kb) { int key = t0 - 128 + 32 * kb + c; key = key < 0 ? 0 : key; const bf16_t* kp = proj + (rowb + key) * IN_W + 512 + kvh * 64 + 8 * hi;
        f32x16 acc;
#pragma unroll
        for (int r = 0; r < 16; ++r) acc[r] = 0.f;
#pragma unroll
        for (int ks = 0; ks < 4; ++ks) acc = __builtin_amdgcn_mfma_f32_32x32x16_bf16(*(const bf16x8*)(kp + 16 * ks), qf[ks], acc, 0, 0, 0);
        p[kb] = acc; }
    const float slope = exp2f(-(float)(h + 1)), sink = sinks[h];
    float mx = sink;
#pragma unroll
    for (int kb = 0; kb < 5; ++kb)
#pragma unroll
        for (int r = 0; r < 16; ++r) { const int cr = crow(r, hi), dist = c + 128 - 32 * kb - cr, key = t0 - 128 + 32 * kb + cr;
            const float sc = (dist >= 0 && dist < WINDOW && key >= 0) ? p[kb][r] * 0.125f - slope * (float)dist : -1e30f; p[kb][r] = sc; mx = fmaxf(mx, sc); }
    mx = fmaxf(mx, __shfl_xor(mx, 32));
    float l = 0.f;
#pragma unroll
    for (int kb = 0; kb < 5; ++kb)
#pragma unroll
        for (int r = 0; r < 16; ++r) { const float e = __expf(p[kb][r] - mx); p[kb][r] = e; l += e; }
    l += __shfl_xor(l, 32); l += __expf(sink - mx);
    f32x16 o[2];
#pragma unroll
    for (int d = 0; d < 2; ++d)
#pragma unroll
        for (int r = 0; r < 16; ++r) o[d][r] = 0.f;
#pragma unroll
    for (int kb = 0; kb < 5; ++kb)
#pragma unroll
        for (int s2 = 0; s2 < 2; ++s2) {
            pg8::u32x4 pw; pw.x = pg8::cvt_pk_bf16(p[kb][8 * s2 + 0], p[kb][8 * s2 + 1]); pw.y = pg8::cvt_pk_bf16(p[kb][8 * s2 + 2], p[kb][8 * s2 + 3]);
            pw.z = pg8::cvt_pk_bf16(p[kb][8 * s2 + 4], p[kb][8 * s2 + 5]); pw.w = pg8::cvt_pk_bf16(p[kb][8 * s2 + 6], p[kb][8 * s2 + 7]);
            const bf16x8 pf = __builtin_bit_cast(bf16x8, pw);
#pragma unroll
            for (int d = 0; d < 2; ++d) { const bf16_t* vp = vt + (32 * d + c) * AT_VTS + 32 * half + 32 * kb + 16 * s2 + 4 * hi;
                const s16x4 lo = *(const s16x4*)vp, hh = *(const s16x4*)(vp + 8);
                const bf16x8 vf = (bf16x8){lo[0], lo[1], lo[2], lo[3], hh[0], hh[1], hh[2], hh[3]};
                o[d] = __builtin_amdgcn_mfma_f32_32x32x16_bf16(vf, pf, o[d], 0, 0, 0); } }
    const float inv = 1.f / l;
#pragma unroll
    for (int d = 0; d < 2; ++d)
#pragma unroll
        for (int rg = 0; rg < 4; ++rg) { uint2 w; w.x = pg8::cvt_pk_bf16(o[d][4 * rg] * inv, o[d][4 * rg + 1] * inv); w.y = pg8::cvt_pk_bf16(o[d][4 * rg + 2] * inv, o[d][4 * rg + 3] * inv);
            *(uint2*)(mix + mq * D + h * 64 + 32 * d + 8 * rg + 4 * hi) = w; }
    __syncthreads();
}

__device__ __forceinline__ void conv_item(const bf16_t* __restrict__ U, const bf16_t* __restrict__ UP, const float* __restrict__ cw, const float* __restrict__ cb, bf16_t* __restrict__ hid, size_t i) {
    const int t = (int)(i / FF), j = (int)(i % FF);
    const float u0 = bf2f(U[i]), u1 = t >= 1 ? bf2f(U[i - FF]) : 0.f, u2 = t >= 2 ? bf2f(U[i - 2 * FF]) : 0.f;
    const float c = cb[j] + cw[j] * u2 + cw[FF + j] * u1 + cw[2 * FF + j] * u0;
    hid[i] = (bf16_t)f2bf(c * sigmoidf_(c) * bf2f(UP[i]));
}

__device__ __forceinline__ void ffn_fixup(const float* __restrict__ SB, const float* __restrict__ cw, const float* __restrict__ cb, bf16_t* hid, int pm, int tid) {
    const float* s = SB + (size_t)pm * 6 * FF; const float* sp = SB + (size_t)(pm - 1) * 6 * FF; const bool has_prev = (pm % (SEQ / 256)) != 0;
    for (int idx = tid; idx < 2 * FF; idx += NTHREADS_) { const int rr = idx / FF, j = idx % FF;
        const float u0 = s[j], u1 = s[FF + j], ul0 = has_prev ? sp[4 * FF + j] : 0.f, ul1 = has_prev ? sp[5 * FF + j] : 0.f;
        const float c = rr == 0 ? cb[j] + cw[j] * ul0 + cw[FF + j] * ul1 + cw[2 * FF + j] * u0 : cb[j] + cw[j] * ul1 + cw[FF + j] * u0 + cw[2 * FF + j] * u1;
        hid[(size_t)(pm * 256 + rr) * FF + j] = (bf16_t)f2bf(c * sigmoidf_(c) * s[(2 + rr) * FF + j]); }
}

__device__ __forceinline__ void final_row(float* __restrict__ x, const float* __restrict__ ss, const float* __restrict__ g, int row, int lane) {
    const float rstd = rsqrtf(ss[row] * (1.f / D) + RMS_EPS);
    f32x4* xr = (f32x4*)(x + (size_t)row * D) + lane; const f32x4* gr = (const f32x4*)g + lane;
#pragma unroll
    for (int j = 0; j < 4; ++j) { f32x4 v = xr[64 * j]; const f32x4 gg = gr[64 * j]; v.x *= rstd * gg.x; v.y *= rstd * gg.y; v.z *= rstd * gg.z; v.w *= rstd * gg.w; xr[64 * j] = v; }
}

#define XB_TMO      128
#define XB_XCNT(j)  (256  + 64 * (j))
#define XB_XSUB(j)  (1280 + 64 * (j))
#define XB_XGEN(j)  (2304 + 64 * (j))
#define XB_TOP      3328
#define XB_TOPGEN   3392
#define XCD_BAR_WORDS 3456
#define XB_SPIN_CAP (1u << 18)

__device__ __forceinline__ unsigned xb_ld(unsigned* p)              { return __hip_atomic_load(p, __ATOMIC_RELAXED, __HIP_MEMORY_SCOPE_AGENT); }
__device__ __forceinline__ unsigned xb_add(unsigned* p, unsigned v) { return __hip_atomic_fetch_add(p, v, __ATOMIC_RELAXED, __HIP_MEMORY_SCOPE_AGENT); }
__device__ __forceinline__ unsigned xb_xcc_id() { return (unsigned)__builtin_amdgcn_s_getreg((3 << 11) | 20) & 0xFu; }
#define XB_SPIN(cond, bar) do { unsigned _sp = 0; while (cond) { __builtin_amdgcn_s_sleep(1); \
    if ((++_sp & 255u) == 0u) { if (xb_ld(&(bar)[XB_TMO])) break; if (_sp > XB_SPIN_CAP) { atomicAdd(&(bar)[XB_TMO], 1u); break; } } } } while (0)

struct XcdBarrier {
    unsigned* bar; unsigned x;
    volatile __attribute__((address_space(3))) unsigned* st;
};

__device__ __forceinline__ XcdBarrier xcd_barrier_post(unsigned* bar, volatile __attribute__((address_space(3))) unsigned* st) {
    XcdBarrier b; b.bar = bar; b.x = xb_xcc_id(); b.st = st;
    if (threadIdx.x == 0) (void)xb_add(&bar[XB_XCNT(b.x)], 1u);
    return b;
}
__device__ __forceinline__ void xcd_barrier_complete(unsigned* bar, unsigned x, unsigned& nloc, unsigned& nx) {
    const unsigned G = gridDim.x * gridDim.y * gridDim.z;
    unsigned sum, cnt, mine, sp = 0u;
    for (;;) {
        sum = 0u; cnt = 0u; mine = 0u;
#pragma unroll
        for (unsigned j = 0; j < 16; ++j) { const unsigned c = xb_ld(&bar[XB_XCNT(j)]); sum += c; cnt += (c > 0u) ? 1u : 0u; mine = (j == x) ? c : mine; }
        if (sum == G) break;
        __builtin_amdgcn_s_sleep(1);
        if ((++sp & 255u) == 0u) { if (xb_ld(&bar[XB_TMO])) break; if (sp > XB_SPIN_CAP) { atomicAdd(&bar[XB_TMO], 1u); break; } }
    }
    nloc = mine > 0u ? mine : 1u; nx = cnt > 0u ? cnt : 1u;
}

__device__ __forceinline__ void xcd_barrier(const XcdBarrier& b) {
    asm volatile("s_waitcnt vmcnt(0)" ::: "memory");
    __syncthreads();
    if (threadIdx.x == 0) {
        unsigned* bar = b.bar;
        __builtin_amdgcn_s_waitcnt(0);
        unsigned nloc = b.st[0], nx = b.st[1];
        if (nloc == 0u) { xcd_barrier_complete(bar, b.x, nloc, nx); b.st[0] = nloc; b.st[1] = nx; }
        const unsigned old = xb_add(&bar[XB_XSUB(b.x)], 1u);
        const unsigned gen = old / nloc;
        if (old + 1u == (gen + 1u) * nloc) {
            __builtin_amdgcn_fence(__ATOMIC_RELEASE, "agent");
            asm volatile("s_waitcnt vmcnt(0)" ::: "memory");
            const unsigned og = xb_add(&bar[XB_TOP], 1u);
            const unsigned tg = og / nx;
            if (og + 1u == (tg + 1u) * nx) xb_add(&bar[XB_TOPGEN], 1u);
            else XB_SPIN(xb_ld(&bar[XB_TOPGEN]) == tg, bar);
            __builtin_amdgcn_fence(__ATOMIC_ACQUIRE, "agent");
            xb_add(&bar[XB_XGEN(b.x)], 1u);
            asm volatile("s_waitcnt vmcnt(0)" ::: "memory");
        } else {
            XB_SPIN(xb_ld(&bar[XB_XGEN(b.x)]) == gen, bar);
            __builtin_amdgcn_fence(__ATOMIC_ACQUIRE, "agent");
            asm volatile("s_waitcnt vmcnt(0)" ::: "memory");
        }
    }
    __syncthreads();
}

constexpr int NTHREADS = 512, LDS_BYTES = 147456;
struct Args { const float* in[26]; float* out; unsigned char* ws; };
__global__ void __launch_bounds__(NTHREADS, 2) mega_fwd(Args a) {
    extern __shared__ __attribute__((aligned(16))) unsigned char lds[];
    constexpr int MISC_OFF = 131072 + 4096;
    { volatile __attribute__((address_space(3))) unsigned* misc = (volatile __attribute__((address_space(3))) unsigned*)((__attribute__((address_space(3))) unsigned char*)lds + MISC_OFF);
      if (threadIdx.x < 4) misc[threadIdx.x] = 0u; }
    __syncthreads();
    (void)xcd_barrier_post((unsigned*)(a.ws + WS_BAR), (volatile __attribute__((address_space(3))) unsigned*)((__attribute__((address_space(3))) unsigned char*)lds + MISC_OFF));
#define GRID_SYNC() do { XcdBarrier xb_; xb_.bar = (unsigned*)(a.ws + WS_BAR); xb_.x = xb_xcc_id(); xb_.st = (volatile __attribute__((address_space(3))) unsigned*)((__attribute__((address_space(3))) unsigned char*)lds + MISC_OFF); xcd_barrier(xb_); } while (0)
#define LDSP ((PG8_LAS unsigned char*)lds)
    constexpr int XCH_OFF = 131072;
#define OTID() ({ int _t = threadIdx.x; asm volatile("" : "+v"(_t)); _t; })
    const int G = gridDim.x, NGW = G * 8;
    const float* x = a.in[0]; const float* norm1_g = a.in[1]; const float* w_in = a.in[2]; const float* sinks = a.in[3];
    const float* mu = a.in[4]; const float* w0 = a.in[5]; const float* w2 = a.in[6]; const float* a0 = a.in[7];
    const float* a2 = a.in[8]; const float* g2 = a.in[9]; const float* k_k = a.in[10]; const float* k_a = a.in[11];
    const float* r_k = a.in[12]; const float* lnx_g = a.in[13]; const float* lnx_b = a.in[14]; const float* v0 = a.in[15];
    const float* v1 = a.in[16]; const float* v2 = a.in[17]; const float* w_out = a.in[18]; const float* norm2_g = a.in[19];
    const float* wg = a.in[20]; const float* wu = a.in[21]; const float* conv_w = a.in[22]; const float* conv_b = a.in[23];
    const float* wd = a.in[24]; const float* final_g = a.in[25];
    unsigned char* ws = a.ws; float* X = a.out;
    float* ss = (float*)(ws + WS_SS);
    bf16_t* XB = (bf16_t*)(ws + WS_XB); bf16_t* PROJ = (bf16_t*)(ws + WS_PROJ); bf16_t* MIX = (bf16_t*)(ws + WS_MIX); bf16_t* HID = (bf16_t*)(ws + WS_HID); bf16_t* VF = (bf16_t*)(ws + WS_VFIRST);
    bf16_t* UT = (bf16_t*)(ws + WS_UTMP); bf16_t* UPT = UT + (size_t)SEQ * FF;

    {
        const int tid = OTID(), lane = tid & 63, wave = tid >> 6, gw = blockIdx.x * 8 + wave;
        float* scr = (float*)lds + wave * (64 * 33 + 16);
        constexpr int I_IN = (D / 64) * (IN_W / 32), I_OUT = (D / 64) * (D / 32), I_G = (D / 64) * (FF / 32), I_DN = (FF / 64) * (D / 32), I_LAYER = I_IN + I_OUT + 2 * I_G + I_DN;
        for (int it = gw; it < 2 * I_LAYER; it += NGW) {
            const int l = it / I_LAYER; int r = it % I_LAYER;
            bf16_t* wl = (bf16_t*)(ws + WS_W + l * W_LAYER); bf16_t* WinT = wl; bf16_t* WoutT = (bf16_t*)((char*)wl + W_IN_SZ); bf16_t* WguT = (bf16_t*)((char*)WoutT + W_OUT_SZ); bf16_t* WdT = (bf16_t*)((char*)WguT + W_GU_SZ);
            if (r < I_IN) { transpose_item(w_in + (size_t)l * D * IN_W, D, IN_W, WinT, norm1_g + l * D, 0, scr, r, lane); continue; } r -= I_IN;
            if (r < I_OUT) { transpose_item(w_out + (size_t)l * D * D, D, D, WoutT, nullptr, 0, scr, r, lane); continue; } r -= I_OUT;
            if (r < I_G) { transpose_item(wg + (size_t)l * D * FF, D, FF, WguT, norm2_g + l * D, 1, scr, r, lane); continue; } r -= I_G;
            if (r < I_G) { transpose_item(wu + (size_t)l * D * FF, D, FF, WguT, norm2_g + l * D, 2, scr, r, lane); continue; } r -= I_G;
            transpose_item(wd + (size_t)l * FF * D, FF, D, WdT, nullptr, 0, scr, r, lane);
        }
        {
            constexpr int I_W2 = 1 * (C / 32), I_G2 = 2 * (C / 32), I_V1 = (C / 64) * 1, I_L = 2 * I_W2 + I_G2;
            for (int it = gw; it < 2 * I_L + I_V1; it += NGW) {
                if (it < 2 * I_L) { const int l = it / I_L; int r = it % I_L; bf16_t* base = (bf16_t*)(ws + WS_LORA + l * LORA_LAYER);
                    if (r < I_W2) { transpose_item(w2 + (size_t)l * 64 * C, 64, C, base, nullptr, 0, scr, r, lane); continue; } r -= I_W2;
                    if (r < I_W2) { transpose_item(a2 + (size_t)l * 64 * C, 64, C, base + 512 * 64, nullptr, 0, scr, r, lane); continue; } r -= I_W2;
                    transpose_item(g2 + (size_t)l * 128 * C, 128, C, base + 2 * 512 * 64, nullptr, 0, scr, r, lane); }
                else transpose_item(v1, C, 32, (bf16_t*)(ws + WS_V1T), nullptr, 0, scr, it - 2 * I_L, lane);
            }
            bf16_t* V2T = (bf16_t*)(ws + WS_V2T);
            for (int i = blockIdx.x * NTHREADS + tid; i < 32 * C; i += G * NTHREADS) { const int j = i / C, ch = i % C; V2T[ch * 32 + j] = (bf16_t)f2bf(v2[i]); }
        }
        for (int m = gw; m < M; m += NGW) x_row_to_bf16(x, XB, ss, m, lane);
    }
    GRID_SYNC();
    for (int l = 0; l < 2; ++l) {
        bf16_t* wl = (bf16_t*)(ws + WS_W + l * W_LAYER); bf16_t* WinT = wl; bf16_t* WoutT = (bf16_t*)((char*)wl + W_IN_SZ); bf16_t* WguT = (bf16_t*)((char*)WoutT + W_OUT_SZ); bf16_t* WdT = (bf16_t*)((char*)WguT + W_GU_SZ);
        float* ss1 = ss + (size_t)(2 * l) * M; float* ss2 = ss + (size_t)(2 * l + 1) * M; float* ss3 = ss + (size_t)(2 * l + 2) * M;
        { pg8::Gemm g{XB, WinT, M, IN_W, D}; pg8::StaticOrder S; S.init(M, IN_W, G, (int)blockIdx.x); pg8::EpiScaleBf16 E{PROJ, IN_W, ss1};
          pg8::gemm_phase<pg8::EpiScaleBf16, pg8::StaticOrder, true, true>(LDSP, g, S, E); }
        GRID_SYNC();
        for (int unit = blockIdx.x; unit < BATCH * 2 * (SEQ / 64); unit += G) attn_unit(PROJ, sinks + l * NH, MIX, (bf16_t*)lds, unit, OTID());
        struct { bf16_t *R, *K, *V, *A, *LD, *G; } p; p.R = (bf16_t*)(ws + WS_SI_R); p.K = (bf16_t*)(ws + WS_SI_K); p.V = (bf16_t*)(ws + WS_SI_V); p.A = (bf16_t*)(ws + WS_SI_A); p.LD = (bf16_t*)(ws + WS_SI_LD); p.G = (bf16_t*)(ws + WS_SI_G);
        { Prep2Args q{}; q.proj = PROJ; q.mu = mu + l * SHIFT_W; q.w0 = w0 + l * C; q.a0 = a0 + l * C; q.v0 = v0;
          const bf16_t* lw = (const bf16_t*)(ws + WS_LORA + l * LORA_LAYER); q.W2T = lw; q.A2T = lw + 512 * 64; q.G2T = lw + 2 * 512 * 64; q.V1T = (const bf16_t*)(ws + WS_V1T); q.V2T = (const bf16_t*)(ws + WS_V2T);
          q.vfirst = VF; q.R = p.R; q.K = p.K; q.V = p.V; q.A = p.A; q.LD = p.LD; q.G = p.G; q.layer = l;
          for (int tile = blockIdx.x; tile < M / 64; tile += G) prep_tile(q, lds, tile, OTID()); }
        GRID_SYNC();
        { ScanArgs s{}; s.R = p.R; s.K = p.K; s.V = p.V; s.A = p.A; s.LD = p.LD; s.G = p.G; s.k_k = k_k + l * C; s.k_a = k_a + l * C; s.r_k = r_k + l * C; s.lnx_g = lnx_g + l * C; s.lnx_b = lnx_b + l * C; s.mix = MIX; s.rkc = (float*)(ws + WS_RKC);
          for (int item = (int)((blockIdx.x & 7) * (G >> 3) + (blockIdx.x >> 3)); item < BATCH * NH * 4; item += G) scan_item(s, (float*)lds, item, OTID());
          GRID_SYNC();
          { const int tid = OTID(), lane = tid & 63, gw = blockIdx.x * 8 + (tid >> 6); for (int idx = gw; idx < M * NH; idx += NGW) scan_post(s, idx, lane); } }
        GRID_SYNC();
        { pg8::Gemm g{MIX, WoutT, M, D, D}; pg8::StaticOrder S; S.init(M, D, G, (int)blockIdx.x); pg8::EpiResid E{(l == 0) ? x : X, X, XB, ss2};
          pg8::gemm_phase<pg8::EpiResid, pg8::StaticOrder, true, true>(LDSP, g, S, E); }
        GRID_SYNC();
        { pg8::Gemm g{XB, WguT, M, 2 * FF, D}; pg8::StaticOrder S; S.init(M, 2 * FF, G, (int)blockIdx.x);
          pg8::EpiConvGlu E{HID, ss2, conv_w + (size_t)l * 3 * FF, conv_b + (size_t)l * FF, (float*)(ws + WS_UTMP), (PG8_LAS float*)(LDSP + XCH_OFF), FF};
          pg8::gemm_phase<pg8::EpiConvGlu, pg8::StaticOrder, true, true>(LDSP, g, S, E); }
        GRID_SYNC();
        { pg8::Gemm g{HID, WdT, M, D, FF}; pg8::StaticOrder S; S.init(M, D, G, (int)blockIdx.x); pg8::EpiResid E{X, X, XB, ss3};
          { pg8::Unit u; for (int i = 0; S.next(i, u); ++i) ffn_fixup((const float*)(ws + WS_UTMP), conv_w + (size_t)l * 3 * FF, conv_b + (size_t)l * FF, HID, u.pm, OTID());
            asm volatile("s_waitcnt vmcnt(0)" ::: "memory"); __syncthreads(); }
          pg8::gemm_phase<pg8::EpiResid, pg8::StaticOrder, true, true>(LDSP, g, S, E); }
        GRID_SYNC();
    }
    { const int tid = OTID(), lane = tid & 63, gw = blockIdx.x * 8 + (tid >> 6);
    for (int m = gw; m < M; m += NGW) final_row(X, ss + (size_t)4 * M, final_g, m, lane); }
}

extern "C" void kernel_launch(void* const* d_in, const int* in_sizes, int n_in, void* d_out, int out_size, void* d_ws, size_t ws_size, hipStream_t stream) {
    static int grid = 0;
    if (grid == 0) {
        if (n_in != 26 || in_sizes[0] != M * D || out_size != M * D || ws_size < WS_END) { fprintf(stderr, "kernel_launch: unexpected shapes (n_in %d, ws %zu)\n", n_in, ws_size); grid = -1; return; }
        int dev = 0, cus = 0, per_cu = 0;
        if (hipGetDevice(&dev) != hipSuccess || hipDeviceGetAttribute(&cus, hipDeviceAttributeMultiprocessorCount, dev) != hipSuccess) { grid = -1; return; }
        if (hipFuncSetAttribute((const void*)mega_fwd, hipFuncAttributeMaxDynamicSharedMemorySize, LDS_BYTES) != hipSuccess) { fprintf(stderr, "kernel_launch: hipFuncSetAttribute failed\n"); grid = -1; return; }
        if (hipOccupancyMaxActiveBlocksPerMultiprocessor(&per_cu, (const void*)mega_fwd, NTHREADS, LDS_BYTES) != hipSuccess || per_cu < 1) { fprintf(stderr, "kernel_launch: occupancy query failed (%d)\n", per_cu); grid = -1; return; }
        grid = cus;
    }
    if (grid < 0) return;
    (void)hipMemsetAsync((unsigned char*)d_ws + WS_CTL, 0, CTL_BYTES, stream);
    Args a{};
    for (int i = 0; i < 26; ++i) a.in[i] = (const float*)d_in[i];
    a.out = (float*)d_out; a.ws = (unsigned char*)d_ws;
    void* kargs[] = {&a};
    hipError_t e = hipLaunchCooperativeKernel((const void*)mega_fwd, dim3(grid), dim3(NTHREADS), kargs, LDS_BYTES, stream);
    if (e != hipSuccess) fprintf(stderr, "kernel_launch: cooperative launch failed: %s (grid %d)\n", hipGetErrorString(e), grid);
}
```

```cpp
#include <hip/hip_runtime.h>
#include <cstdio>
#include <cstdint>

typedef unsigned short bf16_t;
typedef short bf16x8 __attribute__((ext_vector_type(8)));
typedef float f32x4 __attribute__((ext_vector_type(4)));

constexpr int BATCH = 8, SEQ = 4096, D = 1024, M = BATCH * SEQ;
constexpr int HD = 64, ATT_W = 512, KV_W = 128, C = 512, NH = 8;
constexpr int ATT_IN = 768, SHIFT_W = 1792, IN_W = 2560, FF = 2816;
constexpr int WINDOW = 128;
constexpr float RMS_EPS = 1e-5f, LNX_EPS = 64e-5f;

constexpr size_t MiB = 1u << 20;
constexpr size_t WS_CTL = 0;
typedef unsigned long long ssq_t;
__device__ __forceinline__ ssq_t ssq_fix(float s) { return (ssq_t)(s * 1048576.0f + 0.5f); }
__device__ __forceinline__ float ssq_val(ssq_t v) { return (float)v * (1.0f / 1048576.0f); }
constexpr size_t WS_SS = 0;
constexpr size_t CTL_BYTES = 2 * MiB;
constexpr size_t WS_BAR = 1536 * 1024;
constexpr size_t WS_W = 2 * MiB;
constexpr size_t W_IN_SZ = (size_t)IN_W * D * 2, W_OUT_SZ = (size_t)D * D * 2, W_GU_SZ = (size_t)2 * FF * D * 2, W_DN_SZ = (size_t)D * FF * 2;
constexpr size_t W_LAYER = W_IN_SZ + W_OUT_SZ + W_GU_SZ + W_DN_SZ;
constexpr size_t WS_VFIRST = 52 * MiB, WS_MIX = 84 * MiB, WS_XB = 148 * MiB, WS_PROJ = 212 * MiB;
constexpr size_t WS_SI_R = 148 * MiB, WS_SI_K = 180 * MiB, WS_SI_V = 372 * MiB, WS_SI_A = 404 * MiB, WS_SI_LD = 436 * MiB, WS_SI_G = 468 * MiB;
constexpr size_t WS_HID = 212 * MiB;
constexpr size_t WS_UTMP = 84 * MiB;
constexpr size_t WS_END = 500 * MiB;
static_assert(WS_W + 2 * W_LAYER <= WS_VFIRST, "weights fit");

__device__ __forceinline__ unsigned f2bf(float f) { unsigned u = __builtin_bit_cast(unsigned, f); return (u + 0x7fffu + ((u >> 16) & 1u)) >> 16; }
__device__ __forceinline__ float bf2f(bf16_t h) { return __builtin_bit_cast(float, (unsigned)h << 16); }
__device__ __forceinline__ float wave_sum(float v) {
#pragma unroll
    for (int o = 1; o < 64; o <<= 1) v += __shfl_xor(v, o);
    return v;
}
__device__ __forceinline__ float sigmoidf_(float x) { return 1.f / (1.f + __expf(-x)); }

namespace pg8 {
#define PG8_LAS __attribute__((address_space(3)))
typedef unsigned short bf16_t;
typedef short bf16x8 __attribute__((ext_vector_type(8)));
typedef float f32x4 __attribute__((ext_vector_type(4)));
typedef unsigned u32x4 __attribute__((ext_vector_type(4)));
constexpr int BM = 256, BK = 64, HALF = 128, HTB = HALF * BK * 2  , STAGE_BYTES = 8 * HTB, NXCD = 8, WGM = 8;

__host__ __device__ __forceinline__ int lds_byte(int r, int c) { const int st = (r >> 4) * 2 + (c >> 5), rr = r & 15, cc = c & 31, ob = rr * 64 + cc * 2; return st * 1024 + (ob ^ (((ob >> 9) & 1) << 5)); }
__host__ __device__ __forceinline__ void stage_rc(int b, int& R, int& C) { const int st = b / 1024, sb = b % 1024, swz = sb ^ (((sb >> 9) & 1) << 5); R = (st >> 1) * 16 + swz / 64; C = (st & 1) * 32 + (swz % 64) / 2; }
__host__ __device__ __forceinline__ int perm32(int rho) { const int n = rho >> 4, i = rho & 15; return 8 * (i >> 2) + 4 * n + (i & 3); }

struct Unit { int pm, pn; };
struct Gemm { const bf16_t* A; const bf16_t* Bt; int M, N, K; };

struct StaticOrder {
    int nM, nN, nwg, G, c;
    __host__ __device__ void init(int M, int N, int G_, int c_) { nM = M / BM; nN = N / BM; nwg = nM * nN; G = G_; c = c_; }
    __host__ __device__ bool next(int i, Unit& u) const {
        const long L = (long)i * G + c; if (L >= nwg) return false;
        int wgid = (int)L; { const int q = nwg / NXCD, r = nwg % NXCD, xcd = wgid % NXCD, off = wgid / NXCD; wgid = (xcd < r ? xcd * (q + 1) : r * (q + 1) + (xcd - r) * q) + off; }
        const int nig = WGM * nN, gid = wgid / nig, fm = gid * WGM, gsz = (nM - fm) < WGM ? (nM - fm) : WGM;
        u.pm = fm + ((wgid % nig) % gsz); u.pn = (wgid % nig) / gsz; return true;
    }
    __device__ __forceinline__ void a_ready(const Unit&) const {}
    __device__ __forceinline__ void done(const Unit&) const {}
};
typedef float f32x2_t_ __attribute__((ext_vector_type(2))); typedef __bf16 bf16x2_t_ __attribute__((ext_vector_type(2)));
__device__ __forceinline__ unsigned cvt_pk_bf16(float lo, float hi) { const f32x2_t_ v = {lo, hi}; const bf16x2_t_ b = __builtin_convertvector(v, bf16x2_t_); return __builtin_bit_cast(unsigned, b); }
typedef float f32x2 __attribute__((ext_vector_type(2)));
template <class Epi, class Sched, bool ALIGN_EPI = false, bool SP2 = false>
__device__ __forceinline__ void gemm_phase(PG8_LAS unsigned char* lds, const Gemm g, const Sched& S, const Epi& E) {
    int tid_ = threadIdx.x; asm volatile("" : "+v"(tid_));
    const int tid = tid_, wid = __builtin_amdgcn_readfirstlane(tid >> 6), lane = tid & 63, wr = wid >> 2, wc = wid & 3, fr = lane & 15, fq = lane >> 4;
    const int K = g.K, nt = K / BK;
    unsigned voffA[2], voffB[2];
#pragma unroll
    for (int i = 0; i < 2; ++i) { int R, C; stage_rc(tid * 16 + i * 8192, R, C); const int Rb = Epi::PERM ? ((R & ~31) + perm32(R & 31)) : R;
        voffA[i] = (unsigned)(R * K + C) * 2u; voffB[i] = (unsigned)(Rb * K + C) * 2u; }
    const size_t kstep = (size_t)(BK * 2);
    const size_t hstep = (size_t)HALF * K * 2;
    const size_t tstep = 2 * hstep;
    const unsigned ldsw = (unsigned)wid * 1024u;
    const int aoff = lds_byte(wr * 64 + fr, fq * 8), boff = lds_byte(wc * 32 + fr, fq * 8);
#define PG8_SA(b, h) (((b) * 2 + (h)) * HTB)
#define PG8_SB(b, h) ((4 + (b) * 2 + (h)) * HTB)
#define PG8_STAGE(bufoff, gbase, voff) do { _Pragma("unroll") for (int _i = 0; _i < 2; ++_i) \
        __builtin_amdgcn_global_load_lds((const unsigned*)((const char*)(gbase) + (voff)[_i]), (PG8_LAS unsigned*)(lds + (bufoff) + ldsw + _i * 8192), 16, 0, 0); } while (0)
#define PG8_LDA(dst, b, h) do { _Pragma("unroll") for (int m = 0; m < 4; ++m) _Pragma("unroll") for (int k = 0; k < 2; ++k) dst[m][k] = *(const PG8_LAS bf16x8*)(lds + PG8_SA(b, h) + aoff + m * 2048 + k * 1024); } while (0)
#define PG8_LDB(dst, b, h) do { _Pragma("unroll") for (int n = 0; n < 2; ++n) _Pragma("unroll") for (int k = 0; k < 2; ++k) dst[n][k] = *(const PG8_LAS bf16x8*)(lds + PG8_SB(b, h) + boff + n * 2048 + k * 1024); } while (0)
#define PG8_MMA(ai, bj, At, Bt) do { __builtin_amdgcn_s_setprio(1); _Pragma("unroll") for (int m = 0; m < 4; ++m) _Pragma("unroll") for (int n = 0; n < 2; ++n) _Pragma("unroll") for (int k = 0; k < 2; ++k) \
        acc[ai][bj][m][n] = __builtin_amdgcn_mfma_f32_16x16x32_bf16(Bt[n][k], At[m][k], acc[ai][bj][m][n], 0, 0, 0); __builtin_amdgcn_s_setprio(0); } while (0)
#define PG8_WAIT_V(n) asm volatile("s_waitcnt vmcnt(" #n ")" ::: "memory")
#define PG8_WAIT_L(n) asm volatile("s_waitcnt lgkmcnt(" #n ")" ::: "memory")
#define PG8_BAR __builtin_amdgcn_s_barrier()
#define PG8_SCHED __builtin_amdgcn_sched_barrier(0)
    Unit cur, nxt; int ui = 0;
    if (!S.next(0, cur)) return;
    f32x4 acc[2][2][4][2];
#pragma unroll
    for (int a = 0; a < 2; ++a)
#pragma unroll
        for (int b = 0; b < 2; ++b)
#pragma unroll
            for (int m = 0; m < 4; ++m)
#pragma unroll
                for (int n = 0; n < 2; ++n) acc[a][b][m][n] = (f32x4){0.f, 0.f, 0.f, 0.f};
    bf16x8 At[4][2], B0[2][2], B1[2][2];
    const char* cA = (const char*)g.A + (size_t)cur.pm * tstep; const char* cB = (const char*)g.Bt + (size_t)cur.pn * tstep;
    S.a_ready(cur);
    if constexpr (SP2) {
        PG8_STAGE(PG8_SB(0, 0), cB, voffB); PG8_STAGE(PG8_SB(0, 1), cB + hstep, voffB); PG8_STAGE(PG8_SA(0, 0), cA, voffA); PG8_STAGE(PG8_SA(0, 1), cA + hstep, voffA);
        if (wr == 1) PG8_BAR;
        PG8_WAIT_V(2); PG8_BAR;
        PG8_STAGE(PG8_SB(1, 0), cB + kstep, voffB); PG8_STAGE(PG8_SA(1, 0), cA + kstep, voffA); PG8_STAGE(PG8_SB(1, 1), cB + hstep + kstep, voffB);
        PG8_WAIT_V(6); PG8_BAR;
    } else {
        PG8_STAGE(PG8_SB(0, 0), cB, voffB); PG8_STAGE(PG8_SA(0, 0), cA, voffA); PG8_STAGE(PG8_SB(0, 1), cB + hstep, voffB); PG8_STAGE(PG8_SA(0, 1), cA + hstep, voffA);
        if (wr == 1) PG8_BAR;
        PG8_WAIT_V(4); PG8_BAR;
        PG8_STAGE(PG8_SB(1, 0), cB + kstep, voffB); PG8_STAGE(PG8_SA(1, 0), cA + kstep, voffA); PG8_STAGE(PG8_SB(1, 1), cB + hstep + kstep, voffB);
        PG8_WAIT_V(6); PG8_BAR;
    }
    for (;;) {
        const bool has_next = S.next(ui + 1, nxt);
        const char* nA = has_next ? (const char*)g.A + (size_t)nxt.pm * tstep : cA; const char* nB = has_next ? (const char*)g.Bt + (size_t)nxt.pn * tstep : cB;
        for (int t = 0; t < nt; t += 2) {
            const bool last = (t == nt - 2);
            const char* a1 = cA + (size_t)(t + 1) * kstep;
            const char* a2 = last ? nA : cA + (size_t)(t + 2) * kstep; const char* b2 = last ? nB : cB + (size_t)(t + 2) * kstep;
            const char* a3 = a2 + kstep; const char* b3 = b2 + kstep;
            if (last && has_next) S.a_ready(nxt);
            if constexpr (SP2) {
            PG8_LDB(B0, 0, 0); PG8_LDB(B1, 0, 1); PG8_SCHED; PG8_LDA(At, 0, 0); PG8_STAGE(PG8_SA(1, 1), a1 + hstep, voffA);
            PG8_WAIT_V(8); PG8_WAIT_L(0); PG8_BAR; PG8_MMA(0, 0, At, B0); PG8_MMA(0, 1, At, B1); PG8_BAR; PG8_SCHED;
            PG8_LDA(At, 0, 1); PG8_STAGE(PG8_SB(0, 0), b2, voffB); PG8_STAGE(PG8_SB(0, 1), b2 + hstep, voffB); PG8_STAGE(PG8_SA(0, 0), a2, voffA);
            PG8_WAIT_V(8); PG8_WAIT_L(0); PG8_BAR; PG8_MMA(1, 0, At, B0); PG8_MMA(1, 1, At, B1); PG8_BAR; PG8_SCHED;
            PG8_LDB(B0, 1, 0); PG8_LDB(B1, 1, 1); PG8_SCHED; PG8_LDA(At, 1, 0); PG8_STAGE(PG8_SA(0, 1), a2 + hstep, voffA);
            PG8_WAIT_V(8); PG8_WAIT_L(0); PG8_BAR; PG8_MMA(0, 0, At, B0); PG8_MMA(0, 1, At, B1); PG8_BAR; PG8_SCHED;
            PG8_LDA(At, 1, 1); PG8_STAGE(PG8_SB(1, 0), b3, voffB); PG8_STAGE(PG8_SB(1, 1), b3 + hstep, voffB); PG8_STAGE(PG8_SA(1, 0), a3, voffA);
            PG8_WAIT_V(8); PG8_WAIT_L(0); PG8_BAR; PG8_MMA(1, 0, At, B0); PG8_MMA(1, 1, At, B1); PG8_BAR; PG8_SCHED;
            } else {
            PG8_LDB(B0, 0, 0); PG8_SCHED; PG8_LDA(At, 0, 0); PG8_STAGE(PG8_SA(1, 1), a1 + hstep, voffA);
            PG8_WAIT_L(8); PG8_BAR; PG8_WAIT_L(0); PG8_MMA(0, 0, At, B0); PG8_BAR; PG8_SCHED;
            PG8_LDB(B1, 0, 1); PG8_STAGE(PG8_SB(0, 0), b2, voffB);
            PG8_BAR; PG8_WAIT_L(0); PG8_MMA(0, 1, At, B1); PG8_BAR;
            PG8_LDA(At, 0, 1); PG8_STAGE(PG8_SA(0, 0), a2, voffA);
            PG8_BAR; PG8_WAIT_L(0); PG8_MMA(1, 0, At, B0); PG8_BAR; PG8_SCHED;
            PG8_STAGE(PG8_SB(0, 1), b2 + hstep, voffB);
            PG8_WAIT_V(6); PG8_BAR; PG8_MMA(1, 1, At, B1); PG8_BAR;
            PG8_LDB(B0, 1, 0); PG8_SCHED; PG8_LDA(At, 1, 0); PG8_STAGE(PG8_SA(0, 1), a2 + hstep, voffA);
            PG8_WAIT_L(8); PG8_BAR; PG8_WAIT_L(0); PG8_MMA(0, 0, At, B0); PG8_BAR; PG8_SCHED;
            PG8_LDB(B1, 1, 1); PG8_STAGE(PG8_SB(1, 0), b3, voffB);
            PG8_BAR; PG8_WAIT_L(0); PG8_MMA(0, 1, At, B1); PG8_BAR;
            PG8_LDA(At, 1, 1); PG8_STAGE(PG8_SA(1, 0), a3, voffA);
            PG8_BAR; PG8_WAIT_L(0); PG8_MMA(1, 0, At, B0); PG8_BAR; PG8_SCHED;
            PG8_STAGE(PG8_SB(1, 1), b3 + hstep, voffB);
            PG8_WAIT_V(6); PG8_BAR; PG8_MMA(1, 1, At, B1); PG8_BAR;
            }
        }
        if constexpr (ALIGN_EPI) { if (wr == 0) PG8_BAR; }
        if constexpr (!Epi::AFTER_DRAIN) { E(acc, cur, wr, wc, fr, fq); S.done(cur); }
        if (!has_next) break;
#pragma unroll
        for (int a = 0; a < 2; ++a)
#pragma unroll
            for (int b = 0; b < 2; ++b)
#pragma unroll
                for (int m = 0; m < 4; ++m)
#pragma unroll
                    for (int n = 0; n < 2; ++n) acc[a][b][m][n] = (f32x4){0.f, 0.f, 0.f, 0.f};
        cur = nxt; cA = nA; cB = nB; ++ui;
        if constexpr (ALIGN_EPI) { if (wr == 1) PG8_BAR; }
    }
    PG8_WAIT_V(0);
    if constexpr (!ALIGN_EPI) { if (wr == 0) PG8_BAR; }
    PG8_BAR;
    if constexpr (Epi::AFTER_DRAIN) { E.fused(acc, cur, wr, wc, fr, fq, lds, wid, lane); S.done(cur); }
#undef PG8_SA
#undef PG8_SB
#undef PG8_STAGE
#undef PG8_LDA
#undef PG8_LDB
#undef PG8_MMA
#undef PG8_WAIT_V
#undef PG8_WAIT_L
#undef PG8_BAR
#undef PG8_SCHED
}

constexpr int DM_ = 1024; constexpr float RMS_EPS_ = 1e-5f;
typedef unsigned long long ssq_t;
struct EpiScaleBf16 {
    static constexpr bool PERM = true, AFTER_DRAIN = false;
    bf16_t* O; int ldc; const ssq_t* ss;
    __device__ __forceinline__ void operator()(const f32x4 (&acc)[2][2][4][2], const Unit& u, int wr, int wc, int fr, int fq) const {
        const int row0 = u.pm * BM + wr * 64 + fr, col0 = u.pn * BM + wc * 32 + 8 * fq;
        float rsv[2][4];
#pragma unroll
        for (int ai = 0; ai < 2; ++ai)
#pragma unroll
            for (int m = 0; m < 4; ++m) rsv[ai][m] = (float)ss[row0 + ai * HALF + m * 16] * (1.0f / 1048576.0f);
#pragma unroll
        for (int ai = 0; ai < 2; ++ai)
#pragma unroll
            for (int m = 0; m < 4; ++m) { const int row = row0 + ai * HALF + m * 16; const float rs = __builtin_amdgcn_rsqf(rsv[ai][m] * (1.0f / DM_) + RMS_EPS_); bf16_t* rowp = O + (size_t)row * ldc + col0;
#pragma unroll
                for (int bj = 0; bj < 2; ++bj) { const f32x4 v0 = acc[ai][bj][m][0] * rs, v1 = acc[ai][bj][m][1] * rs;
                    u32x4 w; w.x = cvt_pk_bf16(v0[0], v0[1]); w.y = cvt_pk_bf16(v0[2], v0[3]); w.z = cvt_pk_bf16(v1[0], v1[1]); w.w = cvt_pk_bf16(v1[2], v1[3]);
                    *(u32x4*)(rowp + bj * HALF) = w; } }
    }
};
struct EpiResid {
    static constexpr bool PERM = true, AFTER_DRAIN = false;
    bf16_t* xb; ssq_t* ss_out;
    __device__ __forceinline__ void operator()(const f32x4 (&acc)[2][2][4][2], const Unit& u, int wr, int wc, int fr, int fq) const {
        const int row0 = u.pm * BM + wr * 64 + fr, col0 = u.pn * BM + wc * 32 + 8 * fq;
#pragma unroll
        for (int ai = 0; ai < 2; ++ai) {
            u32x4 bs[4][2];
#pragma unroll
            for (int m = 0; m < 4; ++m)
#pragma unroll
                for (int bj = 0; bj < 2; ++bj) bs[m][bj] = *(const u32x4*)(xb + (size_t)(row0 + ai * HALF + m * 16) * DM_ + col0 + bj * HALF);
#pragma unroll
            for (int m = 0; m < 4; ++m) { const int row = row0 + ai * HALF + m * 16; bf16_t* rp = xb + (size_t)row * DM_ + col0; float sq = 0.f;
#pragma unroll
                for (int bj = 0; bj < 2; ++bj) { const u32x4 b = bs[m][bj]; u32x4 w;
#pragma unroll
                    for (int hh = 0; hh < 2; ++hh) { const unsigned b0 = hh == 0 ? b.x : b.z, b1 = hh == 0 ? b.y : b.w; const f32x4 a4 = acc[ai][bj][m][hh];
                        const float x0 = __builtin_bit_cast(float, b0 << 16) + a4[0], x1 = __builtin_bit_cast(float, b0 & 0xffff0000u) + a4[1], x2 = __builtin_bit_cast(float, b1 << 16) + a4[2], x3 = __builtin_bit_cast(float, b1 & 0xffff0000u) + a4[3];
                        const unsigned w0 = cvt_pk_bf16(x0, x1), w1 = cvt_pk_bf16(x2, x3);
                        if (hh == 0) { w.x = w0; w.y = w1; } else { w.z = w0; w.w = w1; }
                        const float r0 = __builtin_bit_cast(float, w0 << 16), r1 = __builtin_bit_cast(float, w0 & 0xffff0000u), r2 = __builtin_bit_cast(float, w1 << 16), r3 = __builtin_bit_cast(float, w1 & 0xffff0000u);
                        sq += (r0 * r0 + r1 * r1) + (r2 * r2 + r3 * r3); }
                    *(u32x4*)(rp + bj * HALF) = w; }
                sq += __shfl_xor(sq, 16); sq += __shfl_xor(sq, 32);
                if (fq == 0) atomicAdd(ss_out + row, (ssq_t)(sq * 1048576.0f + 0.5f)); }
        }
    }
};
struct EpiGateUpTmp {
    static constexpr bool PERM = true, AFTER_DRAIN = false;
    bf16_t* U; bf16_t* UP; const ssq_t* ss; int ff;
    __device__ __forceinline__ void operator()(const f32x4 (&acc)[2][2][4][2], const Unit& u, int wr, int wc, int fr, int fq) const {
        const int row0 = u.pm * BM + wr * 64 + fr, col0 = u.pn * HALF + wc * 32 + 8 * fq;
        float rsv[2][4];
#pragma unroll
        for (int ai = 0; ai < 2; ++ai)
#pragma unroll
            for (int m = 0; m < 4; ++m) rsv[ai][m] = (float)ss[row0 + ai * HALF + m * 16] * (1.0f / 1048576.0f);
#pragma unroll
        for (int ai = 0; ai < 2; ++ai)
#pragma unroll
            for (int m = 0; m < 4; ++m) { const int row = row0 + ai * HALF + m * 16; const float rs = __builtin_amdgcn_rsqf(rsv[ai][m] * (1.0f / DM_) + RMS_EPS_); const size_t o = (size_t)row * ff + col0;
#pragma unroll
                for (int bj = 0; bj < 2; ++bj) { const f32x4 v0 = acc[ai][bj][m][0] * rs, v1 = acc[ai][bj][m][1] * rs;
                    u32x4 w; w.x = cvt_pk_bf16(v0[0], v0[1]); w.y = cvt_pk_bf16(v0[2], v0[3]); w.z = cvt_pk_bf16(v1[0], v1[1]); w.w = cvt_pk_bf16(v1[2], v1[3]);
                    *(u32x4*)((bj == 0 ? U : UP) + o) = w; } }
    }
};
template <int CTRL> __device__ __forceinline__ float dpp1(float x) { return __builtin_bit_cast(float, __builtin_amdgcn_update_dpp(0, __builtin_bit_cast(int, x), CTRL, 0xF, 0xF, true)); }
template <int CTRL> __device__ __forceinline__ f32x4 dpp4(const f32x4 x) { return (f32x4){dpp1<CTRL>(x.x), dpp1<CTRL>(x.y), dpp1<CTRL>(x.z), dpp1<CTRL>(x.w)}; }
struct EpiConvGlu {
    static constexpr bool PERM = true, AFTER_DRAIN = false;
    bf16_t* HID; const ssq_t* ss; const float* cw; const float* cb; float* SB; PG8_LAS float* xch; int ff;
    __device__ __forceinline__ void operator()(const f32x4 (&acc)[2][2][4][2], const Unit& u, int wr, int wc, int fr, int fq) const {
        const int row0 = u.pm * BM + wr * 64 + fr, cl = wc * 32 + 8 * fq, jcol = u.pn * HALF + cl;
        float rs[2][4];
#pragma unroll
        for (int ai = 0; ai < 2; ++ai)
#pragma unroll
            for (int m = 0; m < 4; ++m) rs[ai][m] = (float)ss[row0 + ai * HALF + m * 16] * (1.0f / 1048576.0f);
        f32x4 w0[2], w1[2], w2[2], bb[2];
#pragma unroll
        for (int n = 0; n < 2; ++n) { w0[n] = *(const f32x4*)(cw + jcol + 4 * n); w1[n] = *(const f32x4*)(cw + ff + jcol + 4 * n); w2[n] = *(const f32x4*)(cw + 2 * ff + jcol + 4 * n); bb[n] = *(const f32x4*)(cb + jcol + 4 * n); }
#pragma unroll
        for (int ai = 0; ai < 2; ++ai)
#pragma unroll
            for (int m = 0; m < 4; ++m) rs[ai][m] = __builtin_amdgcn_rsqf(rs[ai][m] * (1.0f / DM_) + RMS_EPS_);
        if (fr >= 14) {
#pragma unroll
            for (int ai = 0; ai < 2; ++ai)
#pragma unroll
                for (int n = 0; n < 2; ++n) *(PG8_LAS f32x4*)(xch + ((2 * ai + wr) * 2 + (fr - 14)) * HALF + cl + 4 * n) = acc[ai][0][3][n] * rs[ai][3];
        }
        asm volatile("s_waitcnt lgkmcnt(0)" ::: "memory"); __builtin_amdgcn_s_barrier(); asm volatile("" ::: "memory");
        float* sbp = SB + (size_t)u.pm * 6 * ff + jcol;
#pragma unroll
        for (int ai = 0; ai < 2; ++ai) {
            const int q = 2 * ai + wr;
            f32x4 X[2];
#pragma unroll
            for (int n = 0; n < 2; ++n) { X[n] = (f32x4){0.f, 0.f, 0.f, 0.f}; if (q > 0 && fr >= 14) X[n] = *(const PG8_LAS f32x4*)(xch + ((q - 1) * 2 + (fr - 14)) * HALF + cl + 4 * n); }
#pragma unroll
            for (int m = 0; m < 4; ++m) { const int row = row0 + ai * HALF + m * 16;
                pg8::u32x4 hw;
#pragma unroll
                for (int n = 0; n < 2; ++n) {
                    const f32x4 cur = acc[ai][0][m][n] * rs[ai][m], up = acc[ai][1][m][n] * rs[ai][m];
                    const f32x4 P = (m > 0) ? acc[ai][0][m > 0 ? m - 1 : 0][n] * rs[ai][m > 0 ? m - 1 : 0] : X[n];
                    const f32x4 a1 = dpp4<0x121>(cur), b1 = dpp4<0x121>(P), a2 = dpp4<0x122>(cur), b2 = dpp4<0x122>(P);
                    f32x4 p1, p2;
#pragma unroll
                    for (int e = 0; e < 4; ++e) { p1[e] = fr == 0 ? b1[e] : a1[e]; p2[e] = fr < 2 ? b2[e] : a2[e]; }
                    const f32x4 c = bb[n] + w0[n] * p2 + w1[n] * p1 + w2[n] * cur;
                    f32x4 hv;
#pragma unroll
                    for (int e = 0; e < 4; ++e) hv[e] = c[e] * __builtin_amdgcn_rcpf(1.f + __expf(-c[e])) * up[e];
                    if (n == 0) { hw.x = cvt_pk_bf16(hv[0], hv[1]); hw.y = cvt_pk_bf16(hv[2], hv[3]); } else { hw.z = cvt_pk_bf16(hv[0], hv[1]); hw.w = cvt_pk_bf16(hv[2], hv[3]); }
                    if (q == 0 && m == 0 && fr < 2) { *(f32x4*)(sbp + (size_t)fr * ff + 4 * n) = cur; *(f32x4*)(sbp + (size_t)(2 + fr) * ff + 4 * n) = up; }
                    if (q == 3 && m == 3 && fr >= 14) *(f32x4*)(sbp + (size_t)(4 + fr - 14) * ff + 4 * n) = cur;
                }
                *(pg8::u32x4*)(HID + (size_t)row * ff + jcol) = hw; }
        }
    }
};
}

#define LAS __attribute__((address_space(3)))
__device__ __forceinline__ void transpose_item(const float* __restrict__ W, int K, int N, bf16_t* __restrict__ Wt, const float* __restrict__ g, int mode, float* scr, int item, int lane) {
    const int nblk = N / 32, kb = item / nblk, nb = item % nblk, k0 = 64 * kb, n0 = 32 * nb;
    int np0 = n0; if (mode == 1) np0 = 256 * (n0 / 128) + (n0 % 128); else if (mode == 2) np0 = 256 * (n0 / 128) + 128 + (n0 % 128);
#pragma unroll 8
    for (int i = 0; i < 32; ++i) { const int kk = 2 * i + (lane >> 5); scr[kk * 33 + (lane & 31)] = W[(size_t)(k0 + kk) * N + n0 + (lane & 31)] * (g ? g[k0 + kk] : 1.f); }
    __builtin_amdgcn_fence(__ATOMIC_RELEASE, "wavefront"); __builtin_amdgcn_wave_barrier(); __builtin_amdgcn_fence(__ATOMIC_ACQUIRE, "wavefront");
    const int c = lane & 7;
#pragma unroll
    for (int j = 0; j < 4; ++j) { const int n = (lane >> 3) + 8 * j; const float* sp = scr + (8 * c) * 33 + n;
        uint4 o; o.x = f2bf(sp[0]) | (f2bf(sp[33]) << 16); o.y = f2bf(sp[2 * 33]) | (f2bf(sp[3 * 33]) << 16); o.z = f2bf(sp[4 * 33]) | (f2bf(sp[5 * 33]) << 16); o.w = f2bf(sp[6 * 33]) | (f2bf(sp[7 * 33]) << 16);
        *(uint4*)(Wt + (size_t)(np0 + n) * K + k0 + 8 * c) = o; }
    __builtin_amdgcn_fence(__ATOMIC_RELEASE, "wavefront"); __builtin_amdgcn_wave_barrier(); __builtin_amdgcn_fence(__ATOMIC_ACQUIRE, "wavefront");
}
__device__ __forceinline__ void x_row_to_bf16(const float* __restrict__ x, bf16_t* __restrict__ xb, ssq_t* __restrict__ ss, int row, int lane) {
    const f32x4* xr = (const f32x4*)(x + (size_t)row * D) + lane; float s = 0.f;
#pragma unroll
    for (int j = 0; j < 4; ++j) { const f32x4 v = xr[64 * j]; s += v.x * v.x + v.y * v.y + v.z * v.z + v.w * v.w;
        unsigned long long o = (unsigned long long)(f2bf(v.x) | (f2bf(v.y) << 16)) | ((unsigned long long)(f2bf(v.z) | (f2bf(v.w) << 16)) << 32);
        ((unsigned long long*)(xb + (size_t)row * D))[lane + 64 * j] = o; }
    s = wave_sum(s); if (lane == 0) ss[row] = ssq_fix(s);
}

struct PrepArgs {
    const bf16_t* proj; const float* mu; const float* w0; const float* w2; const float* a0; const float* a2; const float* g2;
    const float* v0; const float* v1; const float* v2; bf16_t* vfirst; int layer; int pad;
    bf16_t *R, *K, *V, *A, *LD, *G;
};
__device__ __forceinline__ void prep_group(const PrepArgs& p, float (*rest)[SHIFT_W], float (*vlo)[32], int grp, int tid) {
    const int m0 = grp * 4;
    for (int i = tid; i < 4 * SHIFT_W; i += 512) {
        const int tk = i / SHIFT_W, c = i % SHIFT_W, m = m0 + tk, t = m % SEQ;
        const float u = bf2f(p.proj[(size_t)m * IN_W + ATT_IN + c]);
        const float up = t > 0 ? bf2f(p.proj[(size_t)(m - 1) * IN_W + ATT_IN + c]) : 0.f;
        float v = u + (up - u) * p.mu[c];
        if (c >= 1536 && c < 1600) v = tanhf(v); else if (c >= 1664) v = sigmoidf_(v);
        rest[tk][c] = v;
    }
    __syncthreads();
    if (p.layer > 0 && tid < 128) { const int tk = tid >> 5, j = tid & 31; float s = 0.f; for (int c = 0; c < C; ++c) s += rest[tk][1024 + c] * p.v1[c * 32 + j]; vlo[tk][j] = s; }
    __syncthreads();
    const int c = tid;
    float wp[4], ap[4], gp[4];
#pragma unroll
    for (int tk = 0; tk < 4; ++tk) { wp[tk] = p.w0[c]; ap[tk] = p.a0[c]; gp[tk] = 0.f; }
    for (int k = 0; k < 64; ++k) { const float w = p.w2[k * C + c], a = p.a2[k * C + c];
#pragma unroll
        for (int tk = 0; tk < 4; ++tk) { wp[tk] += rest[tk][1536 + k] * w; ap[tk] += rest[tk][1600 + k] * a; } }
    for (int k = 0; k < 128; ++k) { const float g = p.g2[k * C + c];
#pragma unroll
        for (int tk = 0; tk < 4; ++tk) gp[tk] += rest[tk][1664 + k] * g; }
#pragma unroll
    for (int tk = 0; tk < 4; ++tk) {
        const size_t o = (size_t)(m0 + tk) * C + c;
        const float x = -wp[tk];
        const float sp = fmaxf(x, 0.f) + log1pf(__expf(-fabsf(x)));
        const float wraw = -sp - 0.5f;
        const float ld = -__expf(wraw);
        const float a = sigmoidf_(ap[tk]);
        float v = rest[tk][1024 + c];
        if (p.layer == 0) p.vfirst[o] = (bf16_t)f2bf(v);
        else { float s = p.v0[c]; for (int j = 0; j < 32; ++j) s += vlo[tk][j] * p.v2[j * C + c]; const float vf = bf2f(p.vfirst[o]); v = v + (vf - v) * sigmoidf_(s); }
        p.R[o] = (bf16_t)f2bf(rest[tk][c]); p.K[o] = (bf16_t)f2bf(rest[tk][512 + c]); p.V[o] = (bf16_t)f2bf(v);
        p.A[o] = (bf16_t)f2bf(a); p.LD[o] = (bf16_t)f2bf(ld); p.G[o] = (bf16_t)f2bf(gp[tk]);
    }
    __syncthreads();
}

constexpr size_t WS_LORA = 50 * MiB;
constexpr size_t LORA_LAYER = 256 * 1024, WS_V1T = WS_LORA + 2 * LORA_LAYER, WS_V2T = WS_V1T + 32 * 1024;
constexpr int PR_ACT_LD = 264, PR_VLO_LD = 40, PR_SG_LD = 520, PR_ACT_OFF = 0, PR_VLO_OFF = 64 * PR_ACT_LD * 2, PR_SG_OFF = PR_VLO_OFF + 64 * PR_VLO_LD * 2;
struct Prep2Args {
    const bf16_t* proj; const float* mu; const float* w0; const float* a0; const float* v0;
    const bf16_t *W2T, *A2T, *G2T, *V1T, *V2T; bf16_t* vfirst; bf16_t *R, *K, *V, *A, *LD, *G; int layer; int pad;
};
__device__ __forceinline__ f32x4 bfx4_lo(const bf16x8 v) { return (f32x4){bf2f((bf16_t)v[0]), bf2f((bf16_t)v[1]), bf2f((bf16_t)v[2]), bf2f((bf16_t)v[3])}; }
__device__ __forceinline__ f32x4 bfx4_hi(const bf16x8 v) { return (f32x4){bf2f((bf16_t)v[4]), bf2f((bf16_t)v[5]), bf2f((bf16_t)v[6]), bf2f((bf16_t)v[7])}; }
__device__ __forceinline__ bf16x8 pack8(const f32x4 a, const f32x4 b) { pg8::u32x4 w; w.x = pg8::cvt_pk_bf16(a[0], a[1]); w.y = pg8::cvt_pk_bf16(a[2], a[3]); w.z = pg8::cvt_pk_bf16(b[0], b[1]); w.w = pg8::cvt_pk_bf16(b[2], b[3]); return __builtin_bit_cast(bf16x8, w); }
__device__ __forceinline__ void shift8(const bf16_t* __restrict__ proj, const float* __restrict__ mu, size_t m, int t, int col, int mi, f32x4& lo, f32x4& hi) {
    const bf16x8 cur = *(const bf16x8*)(proj + m * IN_W + col);
    bf16x8 prv; if (t > 0) prv = *(const bf16x8*)(proj + (m - 1) * IN_W + col); else prv = (bf16x8){0, 0, 0, 0, 0, 0, 0, 0};
    const f32x4 m0 = *(const f32x4*)(mu + mi), m1 = *(const f32x4*)(mu + mi + 4);
    const f32x4 c0 = bfx4_lo(cur), c1 = bfx4_hi(cur), p0 = bfx4_lo(prv), p1 = bfx4_hi(prv);
    lo = c0 + (p0 - c0) * m0; hi = c1 + (p1 - c1) * m1;
}
__device__ __forceinline__ void prep_tile(const Prep2Args& p, unsigned char* lds, int tile, int tid) {
    const int m0 = tile * 64, wave = __builtin_amdgcn_readfirstlane(tid >> 6), lane = tid & 63, fr = lane & 15, fq = lane >> 4;
    bf16_t* ACT = (bf16_t*)(lds + PR_ACT_OFF); bf16_t* VLO = (bf16_t*)(lds + PR_VLO_OFF); bf16_t* SG = (bf16_t*)(lds + PR_SG_OFF);
#pragma unroll
    for (int it = 0; it < 4; ++it) { const int i = tid + 512 * it, tk = i >> 5, cc = i & 31; const size_t m = (size_t)m0 + tk; const int t = (int)(m % SEQ);
        f32x4 lo, hi; shift8(p.proj, p.mu, m, t, 2304 + 8 * cc, 1536 + 8 * cc, lo, hi);
        if (cc < 8) {
#pragma unroll
            for (int e = 0; e < 4; ++e) { lo[e] = 2.f * sigmoidf_(2.f * lo[e]) - 1.f; hi[e] = 2.f * sigmoidf_(2.f * hi[e]) - 1.f; } }
        else if (cc >= 16) {
#pragma unroll
            for (int e = 0; e < 4; ++e) { lo[e] = sigmoidf_(lo[e]); hi[e] = sigmoidf_(hi[e]); } }
        *(bf16x8*)(ACT + tk * PR_ACT_LD + 8 * cc) = pack8(lo, hi); }
    if (p.layer > 0) {
        const int tb = wave >> 1, jb = wave & 1; const size_t m = (size_t)m0 + 16 * tb + fr; const int t = (int)(m % SEQ);
        f32x4 acc = (f32x4){0.f, 0.f, 0.f, 0.f};
#pragma unroll 4
        for (int ks = 0; ks < 16; ++ks) { f32x4 lo, hi; shift8(p.proj, p.mu, m, t, 1792 + 32 * ks + 8 * fq, 1024 + 32 * ks + 8 * fq, lo, hi);
            const bf16x8 wf = *(const bf16x8*)(p.V1T + (size_t)(16 * jb + fr) * C + 32 * ks + 8 * fq);
            acc = __builtin_amdgcn_mfma_f32_16x16x32_bf16(wf, pack8(lo, hi), acc, 0, 0, 0); }
        uint2 w; w.x = pg8::cvt_pk_bf16(acc[0], acc[1]); w.y = pg8::cvt_pk_bf16(acc[2], acc[3]);
        *(uint2*)(VLO + (16 * tb + fr) * PR_VLO_LD + 16 * jb + 4 * fq) = w;
    }
    __syncthreads();
    const int ch0 = 64 * wave;
#pragma unroll
    for (int arr = 0; arr < 3; ++arr) {
        const int K0 = arr == 0 ? 0 : (arr == 1 ? 64 : 128), KL = arr == 2 ? 128 : 64; const bf16_t* WT = arr == 0 ? p.W2T : (arr == 1 ? p.A2T : p.G2T);
        f32x4 acc[4][4];
#pragma unroll
        for (int tb = 0; tb < 4; ++tb)
#pragma unroll
            for (int cb = 0; cb < 4; ++cb) acc[tb][cb] = (f32x4){0.f, 0.f, 0.f, 0.f};
#pragma unroll
        for (int ks = 0; ks < KL / 32; ++ks) { bf16x8 wf[4], af[4];
#pragma unroll
            for (int cb = 0; cb < 4; ++cb) wf[cb] = *(const bf16x8*)(WT + (size_t)(ch0 + 16 * cb + fr) * KL + 32 * ks + 8 * fq);
#pragma unroll
            for (int tb = 0; tb < 4; ++tb) af[tb] = *(const bf16x8*)(ACT + (16 * tb + fr) * PR_ACT_LD + K0 + 32 * ks + 8 * fq);
#pragma unroll
            for (int tb = 0; tb < 4; ++tb)
#pragma unroll
                for (int cb = 0; cb < 4; ++cb) acc[tb][cb] = __builtin_amdgcn_mfma_f32_16x16x32_bf16(wf[cb], af[tb], acc[tb][cb], 0, 0, 0); }
        bf16_t* OUT = arr == 0 ? p.LD : (arr == 1 ? p.A : p.G);
#pragma unroll
        for (int cb = 0; cb < 4; ++cb) { const int ch = ch0 + 16 * cb + 4 * fq;
            f32x4 bias = (f32x4){0.f, 0.f, 0.f, 0.f}; if (arr == 0) bias = *(const f32x4*)(p.w0 + ch); else if (arr == 1) bias = *(const f32x4*)(p.a0 + ch);
#pragma unroll
            for (int tb = 0; tb < 4; ++tb) { f32x4 x = acc[tb][cb] + bias;
                if (arr == 0) {
#pragma unroll
                    for (int e = 0; e < 4; ++e) { const float z = -x[e]; const float sp = fmaxf(z, 0.f) + __logf(1.f + __expf(-fabsf(z))); x[e] = -__expf(-sp - 0.5f); } }
                else if (arr == 1) {
#pragma unroll
                    for (int e = 0; e < 4; ++e) x[e] = sigmoidf_(x[e]); }
                uint2 w; w.x = pg8::cvt_pk_bf16(x[0], x[1]); w.y = pg8::cvt_pk_bf16(x[2], x[3]);
                *(uint2*)(OUT + ((size_t)m0 + 16 * tb + fr) * C + ch) = w; } }
    }
    if (p.layer > 0) {
        bf16x8 af[4];
#pragma unroll
        for (int tb = 0; tb < 4; ++tb) af[tb] = *(const bf16x8*)(VLO + (16 * tb + fr) * PR_VLO_LD + 8 * fq);
#pragma unroll
        for (int cb = 0; cb < 4; ++cb) { const int ch = ch0 + 16 * cb + 4 * fq; const bf16x8 wf = *(const bf16x8*)(p.V2T + (size_t)(ch0 + 16 * cb + fr) * 32 + 8 * fq); const f32x4 bias = *(const f32x4*)(p.v0 + ch);
#pragma unroll
            for (int tb = 0; tb < 4; ++tb) { f32x4 x = __builtin_amdgcn_mfma_f32_16x16x32_bf16(wf, af[tb], (f32x4){0.f, 0.f, 0.f, 0.f}, 0, 0, 0) + bias;
                uint2 w; w.x = pg8::cvt_pk_bf16(sigmoidf_(x[0]), sigmoidf_(x[1])); w.y = pg8::cvt_pk_bf16(sigmoidf_(x[2]), sigmoidf_(x[3]));
                *(uint2*)(SG + (16 * tb + fr) * PR_SG_LD + ch) = w; } }
    }
    __syncthreads();
#pragma unroll
    for (int sec = 0; sec < 3; ++sec) { bf16_t* OUT = sec == 0 ? p.R : (sec == 1 ? p.K : p.V);
#pragma unroll 4
        for (int it = 0; it < 8; ++it) { const int i = tid + 512 * it, tk = i >> 6, cc = i & 63; const size_t m = (size_t)m0 + tk; const int t = (int)(m % SEQ);
            f32x4 lo, hi; shift8(p.proj, p.mu, m, t, 768 + 512 * sec + 8 * cc, 512 * sec + 8 * cc, lo, hi);
            const size_t o = m * C + 8 * cc;
            if (sec == 2) {
                if (p.layer == 0) *(bf16x8*)(p.vfirst + o) = pack8(lo, hi);
                else { const bf16x8 vf = *(const bf16x8*)(p.vfirst + o), sg = *(const bf16x8*)(SG + tk * PR_SG_LD + 8 * cc);
                    lo = lo + (bfx4_lo(vf) - lo) * bfx4_lo(sg); hi = hi + (bfx4_hi(vf) - hi) * bfx4_hi(sg); } }
            *(bf16x8*)(OUT + o) = pack8(lo, hi); } }
    __syncthreads();
}

constexpr int NTHREADS_ = 512;
constexpr int SC_TB = 32, SC_SLOT = 384, SC_NCH = SEQ / SC_TB;
constexpr size_t WS_RKC = 51 * MiB;
struct ScanArgs { const bf16_t *R, *K, *V, *A, *LD, *G; const float *k_k, *k_a, *r_k, *lnx_g, *lnx_b; bf16_t* mix; float* rkc; };
template <int CTRL> __device__ __forceinline__ float dpp_mov(float x) { return __builtin_bit_cast(float, __builtin_amdgcn_update_dpp(0, __builtin_bit_cast(int, x), CTRL, 0xF, 0xF, true)); }
__device__ __forceinline__ float reduce16(float x) { x += dpp_mov<0xB1>(x); x += dpp_mov<0x4E>(x); x += dpp_mov<0x141>(x); x += dpp_mov<0x140>(x); return x; }
__device__ __forceinline__ void scan_item(const ScanArgs& p, float* lds, int item, int tid) {
    const int chain = item >> 2, q = item & 3, b = chain >> 3, h = chain & 7, wave = __builtin_amdgcn_readfirstlane(tid >> 6), lane = tid & 63;
    float* buf = lds;
    float* ybuf = lds + 2 * SC_TB * SC_SLOT;
    if (wave >= 4) {
        const int lw = wave - 4, lt = lw * 64 + lane, cgl = lane & 15, srow = lane >> 4, ch4 = h * 64 + 4 * cgl;
        const f32x4 kk_c = *(const f32x4*)(p.k_k + ch4), ka_c = *(const f32x4*)(p.k_a + ch4), rk_c = *(const f32x4*)(p.r_k + ch4);
        const size_t rowbase = (size_t)b * SEQ;
        struct LdSet { uint2 r[2], k[2], v[2], a[2], ld[2]; } s0, s1;
#define SC_LOAD(S, chunk) do { _Pragma("unroll") for (int ps = 0; ps < 2; ++ps) { const size_t o = (rowbase + (size_t)(chunk) * SC_TB + 8 * lw + 4 * ps + srow) * C + ch4; \
            S.r[ps] = *(const uint2*)(p.R + o); S.k[ps] = *(const uint2*)(p.K + o); S.v[ps] = *(const uint2*)(p.V + o); S.a[ps] = *(const uint2*)(p.A + o); S.ld[ps] = *(const uint2*)(p.LD + o); } } while (0)
#define SC_UNPK(u) ((f32x4){__builtin_bit_cast(float, (u).x << 16), __builtin_bit_cast(float, (u).x & 0xffff0000u), __builtin_bit_cast(float, (u).y << 16), __builtin_bit_cast(float, (u).y & 0xffff0000u)})
#define SC_PROC(S, chunk, bi) do { _Pragma("unroll") for (int ps = 0; ps < 2; ++ps) { const int st = 8 * lw + 4 * ps + srow; \
            const f32x4 r = SC_UNPK(S.r[ps]), k = SC_UNPK(S.k[ps]), v = SC_UNPK(S.v[ps]), a = SC_UNPK(S.a[ps]), ld = SC_UNPK(S.ld[ps]); \
            f32x4 kk = k * kk_c; const float nrm = sqrtf(reduce16((kk.x * kk.x + kk.z * kk.z) + (kk.y * kk.y + kk.w * kk.w))); kk = kk * (1.f / fmaxf(nrm, 1e-12f)); \
            const f32x4 kp = k * ((a - 1.f) * ka_c + 1.f); const f32x4 t3 = r * kp * rk_c; const float rkc = reduce16((t3.x + t3.z) + (t3.y + t3.w)); \
            float* slot = buf + ((bi) * SC_TB + st) * SC_SLOT + 4 * cgl; \
            *(f32x4*)(slot) = (f32x4){__expf(ld.x), __expf(ld.y), __expf(ld.z), __expf(ld.w)}; *(f32x4*)(slot + 64) = -kk; *(f32x4*)(slot + 128) = kk * a; *(f32x4*)(slot + 192) = kp; *(f32x4*)(slot + 256) = r; *(f32x4*)(slot + 320) = v; \
            if (q == 0 && cgl == 0) p.rkc[(rowbase + (size_t)(chunk) * SC_TB + st) * 8 + h] = rkc; } } while (0)
#define SC_YOUT(chunk, bi) do { _Pragma("unroll") for (int e2 = 0; e2 < 2; ++e2) { const int e = lt + 256 * e2, st = e >> 4, rr = e & 15; \
            p.mix[(rowbase + (size_t)(chunk) * SC_TB + st) * D + ATT_W + h * 64 + 16 * q + rr] = (bf16_t)f2bf(ybuf[(bi) * SC_TB * 16 + e]); } } while (0)
        SC_LOAD(s0, 0); SC_LOAD(s1, 1); SC_PROC(s0, 0, 0);
        __syncthreads();
        for (int c = 0; c < SC_NCH; c += 2) {
            if (c + 2 < SC_NCH) SC_LOAD(s0, c + 2);
            SC_PROC(s1, c + 1, 1);
            if (c >= 1) SC_YOUT(c - 1, 1);
            __syncthreads();
            if (c + 3 < SC_NCH) SC_LOAD(s1, c + 3);
            if (c + 2 < SC_NCH) SC_PROC(s0, c + 2, 0);
            SC_YOUT(c, 0);
            __syncthreads();
        }
        SC_YOUT(SC_NCH - 1, 1);
#undef SC_LOAD
#undef SC_UNPK
#undef SC_PROC
#undef SC_YOUT
    } else {
        const int cg4 = (lane & 15) * 4, rloc = 4 * wave + (lane >> 4);
        f32x4 S = (f32x4){0.f, 0.f, 0.f, 0.f};
#define SC_SCAN(bi) do { const float* bp = buf + (bi) * SC_TB * SC_SLOT + cg4; const float* vp = buf + (bi) * SC_TB * SC_SLOT + 320 + 16 * q + rloc; \
            const unsigned ya = (unsigned)(size_t)(__attribute__((address_space(3))) float*)(((lane & 15) == 0) ? (ybuf + (bi) * SC_TB * 16 + rloc) : (ybuf + 2 * SC_TB * 16 + lane)); \
            f32x4 w = *(const f32x4*)(bp), A = *(const f32x4*)(bp + 64), B = *(const f32x4*)(bp + 128), kp = *(const f32x4*)(bp + 192), r = *(const f32x4*)(bp + 256); float v = vp[0]; \
            _Pragma("unroll") for (int st = 0; st < SC_TB; ++st) { \
                f32x4 wn = w, An = A, Bn = B, kpn = kp, rn = r; float vn = v; \
                if (st + 1 < SC_TB) { wn = *(const f32x4*)(bp + (st + 1) * SC_SLOT); An = *(const f32x4*)(bp + (st + 1) * SC_SLOT + 64); Bn = *(const f32x4*)(bp + (st + 1) * SC_SLOT + 128); \
                    kpn = *(const f32x4*)(bp + (st + 1) * SC_SLOT + 192); rn = *(const f32x4*)(bp + (st + 1) * SC_SLOT + 256); vn = vp[(st + 1) * SC_SLOT]; }     \
                float sa = (S.x * A.x + S.z * A.z) + (S.y * A.y + S.w * A.w); sa = reduce16(sa); \
                S = S * w + (B * sa + kp * v); \
                float y = (S.x * r.x + S.z * r.z) + (S.y * r.y + S.w * r.w); y = reduce16(y); \
                asm volatile("ds_write_b32 %0, %1 offset:%c2" :: "v"(ya), "v"(y), "i"(st * 64)); \
                w = wn; A = An; B = Bn; kp = kpn; r = rn; v = vn; } } while (0)
        __syncthreads();
        for (int c = 0; c < SC_NCH; c += 2) { SC_SCAN(0); __syncthreads(); SC_SCAN(1); __syncthreads(); }
#undef SC_SCAN
    }
    __syncthreads();
}
__device__ __forceinline__ void scan_post(const ScanArgs& p, int idx, int lane) {
    const int m = idx >> 3, h = idx & 7, ch = h * 64 + lane; const size_t o = (size_t)m * C + ch, om = (size_t)m * D + ATT_W + ch;
    const float y = bf2f(p.mix[om]);
    const float mean = wave_sum(y) * (1.f / 64.f); const float d = y - mean; const float var = wave_sum(d * d) * (1.f / 64.f);
    const float yn = d * rsqrtf(var + LNX_EPS) * p.lnx_g[ch] + p.lnx_b[ch];
    p.mix[om] = (bf16_t)f2bf((yn + p.rkc[(size_t)m * 8 + h] * bf2f(p.V[o])) * bf2f(p.G[o]));
}

typedef float f32x16 __attribute__((ext_vector_type(16)));
typedef short s16x4 __attribute__((ext_vector_type(4)));
constexpr int AT_VTS = 196;
__device__ __forceinline__ int crow(int r, int hi) { return (r & 3) + 8 * (r >> 2) + 4 * hi; }
__device__ __forceinline__ void attn_unit(const bf16_t* __restrict__ proj, const float* __restrict__ sinks, bf16_t* __restrict__ mix, bf16_t* vt, int unit, int tid) {
    const int b = unit >> 7, kvh = (unit >> 6) & 1, qb = unit & 63, Q0 = qb * 64;
    const int wave = __builtin_amdgcn_readfirstlane(tid >> 6), lane = tid & 63, c = lane & 31, hi = lane >> 5, g = wave >> 1, half = wave & 1, h = kvh * 4 + g;
    const size_t rowb = (size_t)b * SEQ;
    for (int i = tid; i < 192 * 8; i += 512) { const int kl = i >> 3, ch8 = i & 7; int key = Q0 - 128 + kl; key = key < 0 ? 0 : key;
        const bf16x8 v = *(const bf16x8*)(proj + (rowb + key) * IN_W + 640 + kvh * 64 + ch8 * 8);
#pragma unroll
        for (int e = 0; e < 8; ++e) vt[(ch8 * 8 + e) * AT_VTS + kl] = (bf16_t)v[e]; }
    __syncthreads();
    const int t0 = Q0 + 32 * half; const size_t mq = rowb + t0 + c;
    bf16x8 qf[4];
#pragma unroll
    for (int ks = 0; ks < 4; ++ks) qf[ks] = *(const bf16x8*)(proj + mq * IN_W + h * 64 + 16 * ks + 8 * hi);
    f32x16 p[5];
#pragma unroll
    for (int kb = 0; kb < 5; ++kb) { int key = t0 - 128 + 32 * kb + c; key = key < 0 ? 0 : key; const bf16_t* kp = proj + (rowb + key) * IN_W + 512 + kvh * 64 + 8 * hi;
        f32x16 acc;
#pragma unroll
        for (int r = 0; r < 16; ++r) acc[r] = 0.f;
#pragma unroll
        for (int ks = 0; ks < 4; ++ks) acc = __builtin_amdgcn_mfma_f32_32x32x16_bf16(*(const bf16x8*)(kp + 16 * ks), qf[ks], acc, 0, 0, 0);
        p[kb] = acc; }
    const float slope = exp2f(-(float)(h + 1)), sink = sinks[h];
    float mx = sink;
#pragma unroll
    for (int kb = 0; kb < 5; ++kb)
#pragma unroll
        for (int r = 0; r < 16; ++r) { const int cr = crow(r, hi), dist = c + 128 - 32 * kb - cr, key = t0 - 128 + 32 * kb + cr;
            const float sc = (dist >= 0 && dist < WINDOW && key >= 0) ? p[kb][r] * 0.125f - slope * (float)dist : -1e30f; p[kb][r] = sc; mx = fmaxf(mx, sc); }
    mx = fmaxf(mx, __shfl_xor(mx, 32));
    float l = 0.f;
#pragma unroll
    for (int kb = 0; kb < 5; ++kb)
#pragma unroll
        for (int r = 0; r < 16; ++r) { const float e = __expf(p[kb][r] - mx); p[kb][r] = e; l += e; }
    l += __shfl_xor(l, 32); l += __expf(sink - mx);
    f32x16 o[2];
#pragma unroll
    for (int d = 0; d < 2; ++d)
#pragma unroll
        for (int r = 0; r < 16; ++r) o[d][r] = 0.f;
#pragma unroll
    for (int kb = 0; kb < 5; ++kb)
#pragma unroll
        for (int s2 = 0; s2 < 2; ++s2) {
            pg8::u32x4 pw; pw.x = pg8::cvt_pk_bf16(p[kb][8 * s2 + 0], p[kb][8 * s2 + 1]); pw.y = pg8::cvt_pk_bf16(p[kb][8 * s2 + 2], p[kb][8 * s2 + 3]);
            pw.z = pg8::cvt_pk_bf16(p[kb][8 * s2 + 4], p[kb][8 * s2 + 5]); pw.w = pg8::cvt_pk_bf16(p[kb][8 * s2 + 6], p[kb][8 * s2 + 7]);
            const bf16x8 pf = __builtin_bit_cast(bf16x8, pw);
#pragma unroll
            for (int d = 0; d < 2; ++d) { const bf16_t* vp = vt + (32 * d + c) * AT_VTS + 32 * half + 32 * kb + 16 * s2 + 4 * hi;
                const s16x4 lo = *(const s16x4*)vp, hh = *(const s16x4*)(vp + 8);
                const bf16x8 vf = (bf16x8){lo[0], lo[1], lo[2], lo[3], hh[0], hh[1], hh[2], hh[3]};
                o[d] = __builtin_amdgcn_mfma_f32_32x32x16_bf16(vf, pf, o[d], 0, 0, 0); } }
    const float inv = 1.f / l;
#pragma unroll
    for (int d = 0; d < 2; ++d)
#pragma unroll
        for (int rg = 0; rg < 4; ++rg) { uint2 w; w.x = pg8::cvt_pk_bf16(o[d][4 * rg] * inv, o[d][4 * rg + 1] * inv); w.y = pg8::cvt_pk_bf16(o[d][4 * rg + 2] * inv, o[d][4 * rg + 3] * inv);
            *(uint2*)(mix + mq * D + h * 64 + 32 * d + 8 * rg + 4 * hi) = w; }
    __syncthreads();
}

__device__ __forceinline__ void conv_item(const bf16_t* __restrict__ U, const bf16_t* __restrict__ UP, const float* __restrict__ cw, const float* __restrict__ cb, bf16_t* __restrict__ hid, size_t i) {
    const int t = (int)(i / FF), j = (int)(i % FF);
    const float u0 = bf2f(U[i]), u1 = t >= 1 ? bf2f(U[i - FF]) : 0.f, u2 = t >= 2 ? bf2f(U[i - 2 * FF]) : 0.f;
    const float c = cb[j] + cw[j] * u2 + cw[FF + j] * u1 + cw[2 * FF + j] * u0;
    hid[i] = (bf16_t)f2bf(c * sigmoidf_(c) * bf2f(UP[i]));
}

__device__ __forceinline__ void ffn_fixup(const float* __restrict__ SB, const float* __restrict__ cw, const float* __restrict__ cb, bf16_t* hid, int pm, int tid) {
    const float* s = SB + (size_t)pm * 6 * FF; const float* sp = SB + (size_t)(pm - 1) * 6 * FF; const bool has_prev = (pm % (SEQ / 256)) != 0;
    for (int idx = tid; idx < 2 * FF; idx += NTHREADS_) { const int rr = idx / FF, j = idx % FF;
        const float u0 = s[j], u1 = s[FF + j], ul0 = has_prev ? sp[4 * FF + j] : 0.f, ul1 = has_prev ? sp[5 * FF + j] : 0.f;
        const float c = rr == 0 ? cb[j] + cw[j] * ul0 + cw[FF + j] * ul1 + cw[2 * FF + j] * u0 : cb[j] + cw[j] * ul1 + cw[FF + j] * u0 + cw[2 * FF + j] * u1;
        hid[(size_t)(pm * 256 + rr) * FF + j] = (bf16_t)f2bf(c * sigmoidf_(c) * s[(2 + rr) * FF + j]); }
}

__device__ __forceinline__ void final_row(const bf16_t* __restrict__ xb, float* __restrict__ out, const ssq_t* __restrict__ ss, const float* __restrict__ g, int row, int lane) {
    const float rstd = rsqrtf(ssq_val(ss[row]) * (1.f / D) + RMS_EPS);
    const bf16x8* xr = (const bf16x8*)(xb + (size_t)row * D) + lane; f32x4* orow = (f32x4*)(out + (size_t)row * D) + 2 * lane; const f32x4* gr = (const f32x4*)g + 2 * lane;
#pragma unroll
    for (int j = 0; j < 2; ++j) { const bf16x8 v = xr[64 * j]; const f32x4 g0 = gr[128 * j], g1 = gr[128 * j + 1];
        orow[128 * j] = (f32x4){bf2f((bf16_t)v[0]), bf2f((bf16_t)v[1]), bf2f((bf16_t)v[2]), bf2f((bf16_t)v[3])} * g0 * rstd;
        orow[128 * j + 1] = (f32x4){bf2f((bf16_t)v[4]), bf2f((bf16_t)v[5]), bf2f((bf16_t)v[6]), bf2f((bf16_t)v[7])} * g1 * rstd; }
}

#define XB_TMO      128
#define XB_XCNT(j)  (256  + 64 * (j))
#define XB_XSUB(j)  (1280 + 64 * (j))
#define XB_XGEN(j)  (2304 + 64 * (j))
#define XB_TOP      3328
#define XB_TOPGEN   3392
#define XCD_BAR_WORDS 3456
#define XB_SPIN_CAP (1u << 18)

__device__ __forceinline__ unsigned xb_ld(unsigned* p)              { return __hip_atomic_load(p, __ATOMIC_RELAXED, __HIP_MEMORY_SCOPE_AGENT); }
__device__ __forceinline__ unsigned xb_add(unsigned* p, unsigned v) { return __hip_atomic_fetch_add(p, v, __ATOMIC_RELAXED, __HIP_MEMORY_SCOPE_AGENT); }
__device__ __forceinline__ unsigned xb_xcc_id() { return (unsigned)__builtin_amdgcn_s_getreg((3 << 11) | 20) & 0xFu; }
#define XB_SPIN(cond, bar) do { unsigned _sp = 0; while (cond) { __builtin_amdgcn_s_sleep(1); \
    if ((++_sp & 255u) == 0u) { if (xb_ld(&(bar)[XB_TMO])) break; if (_sp > XB_SPIN_CAP) { atomicAdd(&(bar)[XB_TMO], 1u); break; } } } } while (0)

struct XcdBarrier {
    unsigned* bar; unsigned x;
    volatile __attribute__((address_space(3))) unsigned* st;
};

__device__ __forceinline__ XcdBarrier xcd_barrier_post(unsigned* bar, volatile __attribute__((address_space(3))) unsigned* st) {
    XcdBarrier b; b.bar = bar; b.x = xb_xcc_id(); b.st = st;
    if (threadIdx.x == 0) (void)xb_add(&bar[XB_XCNT(b.x)], 1u);
    return b;
}
__device__ __forceinline__ void xcd_barrier_complete(unsigned* bar, unsigned x, unsigned& nloc, unsigned& nx) {
    const unsigned G = gridDim.x * gridDim.y * gridDim.z;
    unsigned sum, cnt, mine, sp = 0u;
    for (;;) {
        sum = 0u; cnt = 0u; mine = 0u;
#pragma unroll
        for (unsigned j = 0; j < 16; ++j) { const unsigned c = xb_ld(&bar[XB_XCNT(j)]); sum += c; cnt += (c > 0u) ? 1u : 0u; mine = (j == x) ? c : mine; }
        if (sum == G) break;
        __builtin_amdgcn_s_sleep(1);
        if ((++sp & 255u) == 0u) { if (xb_ld(&bar[XB_TMO])) break; if (sp > XB_SPIN_CAP) { atomicAdd(&bar[XB_TMO], 1u); break; } }
    }
    nloc = mine > 0u ? mine : 1u; nx = cnt > 0u ? cnt : 1u;
}

__device__ __forceinline__ void xcd_barrier(const XcdBarrier& b) {
    asm volatile("s_waitcnt vmcnt(0)" ::: "memory");
    __syncthreads();
    if (threadIdx.x == 0) {
        unsigned* bar = b.bar;
        __builtin_amdgcn_s_waitcnt(0);
        unsigned nloc = b.st[0], nx = b.st[1];
        if (nloc == 0u) { xcd_barrier_complete(bar, b.x, nloc, nx); b.st[0] = nloc; b.st[1] = nx; }
        const unsigned old = xb_add(&bar[XB_XSUB(b.x)], 1u);
        const unsigned gen = old / nloc;
        if (old + 1u == (gen + 1u) * nloc) {
            __builtin_amdgcn_fence(__ATOMIC_RELEASE, "agent");
            asm volatile("s_waitcnt vmcnt(0)" ::: "memory");
            const unsigned og = xb_add(&bar[XB_TOP], 1u);
            const unsigned tg = og / nx;
            if (og + 1u == (tg + 1u) * nx) xb_add(&bar[XB_TOPGEN], 1u);
            else XB_SPIN(xb_ld(&bar[XB_TOPGEN]) == tg, bar);
            __builtin_amdgcn_fence(__ATOMIC_ACQUIRE, "agent");
            xb_add(&bar[XB_XGEN(b.x)], 1u);
            asm volatile("s_waitcnt vmcnt(0)" ::: "memory");
        } else {
            XB_SPIN(xb_ld(&bar[XB_XGEN(b.x)]) == gen, bar);
            __builtin_amdgcn_fence(__ATOMIC_ACQUIRE, "agent");
            asm volatile("s_waitcnt vmcnt(0)" ::: "memory");
        }
    }
    __syncthreads();
}

constexpr int NTHREADS = 512, LDS_BYTES = 147456;
struct Args { const float* in[26]; float* out; unsigned char* ws; };
__global__ void __launch_bounds__(NTHREADS, 2) mega_fwd(Args a) {
    extern __shared__ __attribute__((aligned(16))) unsigned char lds[];
    constexpr int MISC_OFF = 131072 + 4096;
    { volatile __attribute__((address_space(3))) unsigned* misc = (volatile __attribute__((address_space(3))) unsigned*)((__attribute__((address_space(3))) unsigned char*)lds + MISC_OFF);
      if (threadIdx.x < 4) misc[threadIdx.x] = 0u; }
    __syncthreads();
    (void)xcd_barrier_post((unsigned*)(a.ws + WS_BAR), (volatile __attribute__((address_space(3))) unsigned*)((__attribute__((address_space(3))) unsigned char*)lds + MISC_OFF));
#define GRID_SYNC() do { XcdBarrier xb_; xb_.bar = (unsigned*)(a.ws + WS_BAR); xb_.x = xb_xcc_id(); xb_.st = (volatile __attribute__((address_space(3))) unsigned*)((__attribute__((address_space(3))) unsigned char*)lds + MISC_OFF); xcd_barrier(xb_); } while (0)
#define LDSP ((PG8_LAS unsigned char*)lds)
    constexpr int XCH_OFF = 131072;
#define OTID() ({ int _t = threadIdx.x; asm volatile("" : "+v"(_t)); _t; })
    const int G = gridDim.x, NGW = G * 8;
    const float* x = a.in[0]; const float* norm1_g = a.in[1]; const float* w_in = a.in[2]; const float* sinks = a.in[3];
    const float* mu = a.in[4]; const float* w0 = a.in[5]; const float* w2 = a.in[6]; const float* a0 = a.in[7];
    const float* a2 = a.in[8]; const float* g2 = a.in[9]; const float* k_k = a.in[10]; const float* k_a = a.in[11];
    const float* r_k = a.in[12]; const float* lnx_g = a.in[13]; const float* lnx_b = a.in[14]; const float* v0 = a.in[15];
    const float* v1 = a.in[16]; const float* v2 = a.in[17]; const float* w_out = a.in[18]; const float* norm2_g = a.in[19];
    const float* wg = a.in[20]; const float* wu = a.in[21]; const float* conv_w = a.in[22]; const float* conv_b = a.in[23];
    const float* wd = a.in[24]; const float* final_g = a.in[25];
    unsigned char* ws = a.ws; float* X = a.out;
    ssq_t* ss = (ssq_t*)(ws + WS_SS);
    bf16_t* XB = (bf16_t*)(ws + WS_XB); bf16_t* PROJ = (bf16_t*)(ws + WS_PROJ); bf16_t* MIX = (bf16_t*)(ws + WS_MIX); bf16_t* HID = (bf16_t*)(ws + WS_HID); bf16_t* VF = (bf16_t*)(ws + WS_VFIRST);
    bf16_t* UT = (bf16_t*)(ws + WS_UTMP); bf16_t* UPT = UT + (size_t)SEQ * FF;

    {
        const int tid = OTID(), lane = tid & 63, wave = tid >> 6, gw = blockIdx.x * 8 + wave;
        float* scr = (float*)lds + wave * (64 * 33 + 16);
        constexpr int I_IN = (D / 64) * (IN_W / 32), I_OUT = (D / 64) * (D / 32), I_G = (D / 64) * (FF / 32), I_DN = (FF / 64) * (D / 32), I_LAYER = I_IN + I_OUT + 2 * I_G + I_DN;
        for (int it = gw; it < 2 * I_LAYER; it += NGW) {
            const int l = it / I_LAYER; int r = it % I_LAYER;
            bf16_t* wl = (bf16_t*)(ws + WS_W + l * W_LAYER); bf16_t* WinT = wl; bf16_t* WoutT = (bf16_t*)((char*)wl + W_IN_SZ); bf16_t* WguT = (bf16_t*)((char*)WoutT + W_OUT_SZ); bf16_t* WdT = (bf16_t*)((char*)WguT + W_GU_SZ);
            if (r < I_IN) { transpose_item(w_in + (size_t)l * D * IN_W, D, IN_W, WinT, norm1_g + l * D, 0, scr, r, lane); continue; } r -= I_IN;
            if (r < I_OUT) { transpose_item(w_out + (size_t)l * D * D, D, D, WoutT, nullptr, 0, scr, r, lane); continue; } r -= I_OUT;
            if (r < I_G) { transpose_item(wg + (size_t)l * D * FF, D, FF, WguT, norm2_g + l * D, 1, scr, r, lane); continue; } r -= I_G;
            if (r < I_G) { transpose_item(wu + (size_t)l * D * FF, D, FF, WguT, norm2_g + l * D, 2, scr, r, lane); continue; } r -= I_G;
            transpose_item(wd + (size_t)l * FF * D, FF, D, WdT, nullptr, 0, scr, r, lane);
        }
        {
            constexpr int I_W2 = 1 * (C / 32), I_G2 = 2 * (C / 32), I_V1 = (C / 64) * 1, I_L = 2 * I_W2 + I_G2;
            for (int it = gw; it < 2 * I_L + I_V1; it += NGW) {
                if (it < 2 * I_L) { const int l = it / I_L; int r = it % I_L; bf16_t* base = (bf16_t*)(ws + WS_LORA + l * LORA_LAYER);
                    if (r < I_W2) { transpose_item(w2 + (size_t)l * 64 * C, 64, C, base, nullptr, 0, scr, r, lane); continue; } r -= I_W2;
                    if (r < I_W2) { transpose_item(a2 + (size_t)l * 64 * C, 64, C, base + 512 * 64, nullptr, 0, scr, r, lane); continue; } r -= I_W2;
                    transpose_item(g2 + (size_t)l * 128 * C, 128, C, base + 2 * 512 * 64, nullptr, 0, scr, r, lane); }
                else transpose_item(v1, C, 32, (bf16_t*)(ws + WS_V1T), nullptr, 0, scr, it - 2 * I_L, lane);
            }
            bf16_t* V2T = (bf16_t*)(ws + WS_V2T);
            for (int i = blockIdx.x * NTHREADS + tid; i < 32 * C; i += G * NTHREADS) { const int j = i / C, ch = i % C; V2T[ch * 32 + j] = (bf16_t)f2bf(v2[i]); }
        }
        for (int m = gw; m < M; m += NGW) x_row_to_bf16(x, XB, ss, m, lane);
    }
    GRID_SYNC();
    for (int l = 0; l < 2; ++l) {
        bf16_t* wl = (bf16_t*)(ws + WS_W + l * W_LAYER); bf16_t* WinT = wl; bf16_t* WoutT = (bf16_t*)((char*)wl + W_IN_SZ); bf16_t* WguT = (bf16_t*)((char*)WoutT + W_OUT_SZ); bf16_t* WdT = (bf16_t*)((char*)WguT + W_GU_SZ);
        ssq_t* ss1 = ss + (size_t)(2 * l) * M; ssq_t* ss2 = ss + (size_t)(2 * l + 1) * M; ssq_t* ss3 = ss + (size_t)(2 * l + 2) * M;
        { pg8::Gemm g{XB, WinT, M, IN_W, D}; pg8::StaticOrder S; S.init(M, IN_W, G, (int)blockIdx.x); pg8::EpiScaleBf16 E{PROJ, IN_W, ss1};
          pg8::gemm_phase<pg8::EpiScaleBf16, pg8::StaticOrder, true, true>(LDSP, g, S, E); }
        GRID_SYNC();
        for (int unit = blockIdx.x; unit < BATCH * 2 * (SEQ / 64); unit += G) attn_unit(PROJ, sinks + l * NH, MIX, (bf16_t*)lds, unit, OTID());
        struct { bf16_t *R, *K, *V, *A, *LD, *G; } p; p.R = (bf16_t*)X; p.K = (bf16_t*)X + (size_t)M * C;     p.V = (bf16_t*)(ws + WS_SI_V); p.A = (bf16_t*)(ws + WS_SI_A); p.LD = (bf16_t*)(ws + WS_SI_LD); p.G = (bf16_t*)(ws + WS_SI_G);
        { Prep2Args q{}; q.proj = PROJ; q.mu = mu + l * SHIFT_W; q.w0 = w0 + l * C; q.a0 = a0 + l * C; q.v0 = v0;
          const bf16_t* lw = (const bf16_t*)(ws + WS_LORA + l * LORA_LAYER); q.W2T = lw; q.A2T = lw + 512 * 64; q.G2T = lw + 2 * 512 * 64; q.V1T = (const bf16_t*)(ws + WS_V1T); q.V2T = (const bf16_t*)(ws + WS_V2T);
          q.vfirst = VF; q.R = p.R; q.K = p.K; q.V = p.V; q.A = p.A; q.LD = p.LD; q.G = p.G; q.layer = l;
          for (int tile = blockIdx.x; tile < M / 64; tile += G) prep_tile(q, lds, tile, OTID()); }
        GRID_SYNC();
        { ScanArgs s{}; s.R = p.R; s.K = p.K; s.V = p.V; s.A = p.A; s.LD = p.LD; s.G = p.G; s.k_k = k_k + l * C; s.k_a = k_a + l * C; s.r_k = r_k + l * C; s.lnx_g = lnx_g + l * C; s.lnx_b = lnx_b + l * C; s.mix = MIX; s.rkc = (float*)(ws + WS_RKC);
          for (int item = (int)((blockIdx.x & 7) * (G >> 3) + (blockIdx.x >> 3)); item < BATCH * NH * 4; item += G) scan_item(s, (float*)lds, item, OTID());
          GRID_SYNC();
          { const int tid = OTID(), lane = tid & 63, gw = blockIdx.x * 8 + (tid >> 6); for (int idx = gw; idx < M * NH; idx += NGW) scan_post(s, idx, lane); } }
        GRID_SYNC();
        { pg8::Gemm g{MIX, WoutT, M, D, D}; pg8::StaticOrder S; S.init(M, D, G, (int)blockIdx.x); pg8::EpiResid E{XB, ss2};
          pg8::gemm_phase<pg8::EpiResid, pg8::StaticOrder, true, true>(LDSP, g, S, E); }
        GRID_SYNC();
        { pg8::Gemm g{XB, WguT, M, 2 * FF, D}; pg8::StaticOrder S; S.init(M, 2 * FF, G, (int)blockIdx.x);
          pg8::EpiConvGlu E{HID, ss2, conv_w + (size_t)l * 3 * FF, conv_b + (size_t)l * FF, (float*)(ws + WS_UTMP), (PG8_LAS float*)(LDSP + XCH_OFF), FF};
          pg8::gemm_phase<pg8::EpiConvGlu, pg8::StaticOrder, true, true>(LDSP, g, S, E); }
        GRID_SYNC();
        { pg8::Gemm g{HID, WdT, M, D, FF}; pg8::StaticOrder S; S.init(M, D, G, (int)blockIdx.x); pg8::EpiResid E{XB, ss3};
          { pg8::Unit u; for (int i = 0; S.next(i, u); ++i) ffn_fixup((const float*)(ws + WS_UTMP), conv_w + (size_t)l * 3 * FF, conv_b + (size_t)l * FF, HID, u.pm, OTID());
            asm volatile("s_waitcnt vmcnt(0)" ::: "memory"); __syncthreads(); }
          pg8::gemm_phase<pg8::EpiResid, pg8::StaticOrder, true, true>(LDSP, g, S, E); }
        GRID_SYNC();
    }
    { const int tid = OTID(), lane = tid & 63, gw = blockIdx.x * 8 + (tid >> 6);
    for (int m = gw; m < M; m += NGW) final_row(XB, X, ss + (size_t)4 * M, final_g, m, lane); }
}

extern "C" void kernel_launch(void* const* d_in, const int* in_sizes, int n_in, void* d_out, int out_size, void* d_ws, size_t ws_size, hipStream_t stream) {
    static int grid = 0;
    if (grid == 0) {
        if (n_in != 26 || in_sizes[0] != M * D || out_size != M * D || ws_size < WS_END) { fprintf(stderr, "kernel_launch: unexpected shapes (n_in %d, ws %zu)\n", n_in, ws_size); grid = -1; return; }
        int dev = 0, cus = 0, per_cu = 0;
        if (hipGetDevice(&dev) != hipSuccess || hipDeviceGetAttribute(&cus, hipDeviceAttributeMultiprocessorCount, dev) != hipSuccess) { grid = -1; return; }
        if (hipFuncSetAttribute((const void*)mega_fwd, hipFuncAttributeMaxDynamicSharedMemorySize, LDS_BYTES) != hipSuccess) { fprintf(stderr, "kernel_launch: hipFuncSetAttribute failed\n"); grid = -1; return; }
        if (hipOccupancyMaxActiveBlocksPerMultiprocessor(&per_cu, (const void*)mega_fwd, NTHREADS, LDS_BYTES) != hipSuccess || per_cu < 1) { fprintf(stderr, "kernel_launch: occupancy query failed (%d)\n", per_cu); grid = -1; return; }
        grid = cus;
    }
    if (grid < 0) return;
    (void)hipMemsetAsync((unsigned char*)d_ws + WS_CTL, 0, CTL_BYTES, stream);
    Args a{};
    for (int i = 0; i < 26; ++i) a.in[i] = (const float*)d_in[i];
    a.out = (float*)d_out; a.ws = (unsigned char*)d_ws;
    void* kargs[] = {&a};
    hipError_t e = hipLaunchCooperativeKernel((const void*)mega_fwd, dim3(grid), dim3(NTHREADS), kargs, LDS_BYTES, stream);
    if (e != hipSuccess) fprintf(stderr, "kernel_launch: cooperative launch failed: %s (grid %d)\n", hipGetErrorString(e), grid);
}
```

```cpp
#include <hip/hip_runtime.h>
#include <cstdio>
#include <cstdint>

typedef unsigned short bf16_t;
typedef short bf16x8 __attribute__((ext_vector_type(8)));
typedef float f32x4 __attribute__((ext_vector_type(4)));

constexpr int BATCH = 8, SEQ = 4096, D = 1024, M = BATCH * SEQ;
constexpr int HD = 64, ATT_W = 512, KV_W = 128, C = 512, NH = 8;
constexpr int ATT_IN = 768, SHIFT_W = 1792, IN_W = 2560, FF = 2816;
constexpr int WINDOW = 128;
constexpr float RMS_EPS = 1e-5f, LNX_EPS = 64e-5f;

constexpr size_t MiB = 1u << 20;
constexpr size_t WS_CTL = 0;
typedef unsigned long long ssq_t;
__device__ __forceinline__ ssq_t ssq_fix(float s) { return (ssq_t)(s * 1048576.0f + 0.5f); }
__device__ __forceinline__ float ssq_val(ssq_t v) { return (float)v * (1.0f / 1048576.0f); }
constexpr size_t WS_SS = 0;
constexpr size_t CTL_BYTES = 2 * MiB;
constexpr size_t WS_BAR = 1536 * 1024;
constexpr size_t WS_W = 2 * MiB;
constexpr size_t W_IN_SZ = (size_t)IN_W * D * 2, W_OUT_SZ = (size_t)D * D * 2, W_GU_SZ = (size_t)2 * FF * D * 2, W_DN_SZ = (size_t)D * FF * 2;
constexpr size_t W_LAYER = W_IN_SZ + W_OUT_SZ + W_GU_SZ + W_DN_SZ;
constexpr size_t WS_VFIRST = 52 * MiB, WS_MIX = 84 * MiB, WS_XB = 148 * MiB, WS_PROJ = 212 * MiB;
constexpr size_t WS_SI_R = 148 * MiB, WS_SI_K = 180 * MiB, WS_SI_V = 372 * MiB, WS_SI_A = 404 * MiB, WS_SI_LD = 436 * MiB, WS_SI_G = 468 * MiB;
constexpr size_t WS_HID = 212 * MiB;
constexpr size_t WS_UTMP = 84 * MiB;
constexpr size_t WS_END = 500 * MiB;
static_assert(WS_W + 2 * W_LAYER <= WS_VFIRST, "weights fit");

__device__ __forceinline__ unsigned f2bf(float f) { unsigned u = __builtin_bit_cast(unsigned, f); return (u + 0x7fffu + ((u >> 16) & 1u)) >> 16; }
__device__ __forceinline__ float bf2f(bf16_t h) { return __builtin_bit_cast(float, (unsigned)h << 16); }
__device__ __forceinline__ float wave_sum(float v) {
#pragma unroll
    for (int o = 1; o < 64; o <<= 1) v += __shfl_xor(v, o);
    return v;
}
__device__ __forceinline__ float sigmoidf_(float x) { return 1.f / (1.f + __expf(-x)); }

namespace pg8 {
#define PG8_LAS __attribute__((address_space(3)))
typedef unsigned short bf16_t;
typedef short bf16x8 __attribute__((ext_vector_type(8)));
typedef float f32x4 __attribute__((ext_vector_type(4)));
typedef unsigned u32x4 __attribute__((ext_vector_type(4)));
constexpr int BM = 256, BK = 64, HALF = 128, HTB = HALF * BK * 2  , STAGE_BYTES = 8 * HTB, NXCD = 8, WGM = 8;

__host__ __device__ __forceinline__ int lds_byte(int r, int c) { const int st = (r >> 4) * 2 + (c >> 5), rr = r & 15, cc = c & 31, ob = rr * 64 + cc * 2; return st * 1024 + (ob ^ (((ob >> 9) & 1) << 5)); }
__host__ __device__ __forceinline__ void stage_rc(int b, int& R, int& C) { const int st = b / 1024, sb = b % 1024, swz = sb ^ (((sb >> 9) & 1) << 5); R = (st >> 1) * 16 + swz / 64; C = (st & 1) * 32 + (swz % 64) / 2; }
__host__ __device__ __forceinline__ int perm32(int rho) { const int n = rho >> 4, i = rho & 15; return 8 * (i >> 2) + 4 * n + (i & 3); }

struct Unit { int pm, pn; };
struct Gemm { const bf16_t* A; const bf16_t* Bt; int M, N, K; };

struct StaticOrder {
    int nM, nN, nwg, G, c;
    __host__ __device__ void init(int M, int N, int G_, int c_) { nM = M / BM; nN = N / BM; nwg = nM * nN; G = G_; c = c_; }
    __host__ __device__ bool next(int i, Unit& u) const {
        const long L = (long)i * G + c; if (L >= nwg) return false;
        int wgid = (int)L; { const int q = nwg / NXCD, r = nwg % NXCD, xcd = wgid % NXCD, off = wgid / NXCD; wgid = (xcd < r ? xcd * (q + 1) : r * (q + 1) + (xcd - r) * q) + off; }
        const int nig = WGM * nN, gid = wgid / nig, fm = gid * WGM, gsz = (nM - fm) < WGM ? (nM - fm) : WGM;
        u.pm = fm + ((wgid % nig) % gsz); u.pn = (wgid % nig) / gsz; return true;
    }
    __device__ __forceinline__ void a_ready(const Unit&) const {}
    __device__ __forceinline__ void done(const Unit&) const {}
};
typedef float f32x2_t_ __attribute__((ext_vector_type(2))); typedef __bf16 bf16x2_t_ __attribute__((ext_vector_type(2)));
__device__ __forceinline__ unsigned cvt_pk_bf16(float lo, float hi) { const f32x2_t_ v = {lo, hi}; const bf16x2_t_ b = __builtin_convertvector(v, bf16x2_t_); return __builtin_bit_cast(unsigned, b); }
typedef float f32x2 __attribute__((ext_vector_type(2)));
template <class Epi, class Sched, bool ALIGN_EPI = false, bool SP2 = false>
__device__ __forceinline__ void gemm_phase(PG8_LAS unsigned char* lds, const Gemm g, const Sched& S, const Epi& E) {
    int tid_ = threadIdx.x; asm volatile("" : "+v"(tid_));
    const int tid = tid_, wid = __builtin_amdgcn_readfirstlane(tid >> 6), lane = tid & 63, wr = wid >> 2, wc = wid & 3, fr = lane & 15, fq = lane >> 4;
    const int K = g.K, nt = K / BK;
    unsigned voffA[2], voffB[2];
#pragma unroll
    for (int i = 0; i < 2; ++i) { int R, C; stage_rc(tid * 16 + i * 8192, R, C); const int Rb = Epi::PERM ? ((R & ~31) + perm32(R & 31)) : R;
        voffA[i] = (unsigned)(R * K + C) * 2u; voffB[i] = (unsigned)(Rb * K + C) * 2u; }
    const size_t kstep = (size_t)(BK * 2);
    const size_t hstep = (size_t)HALF * K * 2;
    const size_t tstep = 2 * hstep;
    const unsigned ldsw = (unsigned)wid * 1024u;
    const int aoff = lds_byte(wr * 64 + fr, fq * 8), boff = lds_byte(wc * 32 + fr, fq * 8);
#define PG8_SA(b, h) (((b) * 2 + (h)) * HTB)
#define PG8_SB(b, h) ((4 + (b) * 2 + (h)) * HTB)
#define PG8_STAGE(bufoff, gbase, voff) do { _Pragma("unroll") for (int _i = 0; _i < 2; ++_i) \
        __builtin_amdgcn_global_load_lds((const unsigned*)((const char*)(gbase) + (voff)[_i]), (PG8_LAS unsigned*)(lds + (bufoff) + ldsw + _i * 8192), 16, 0, 0); } while (0)
#define PG8_LDA(dst, b, h) do { _Pragma("unroll") for (int m = 0; m < 4; ++m) _Pragma("unroll") for (int k = 0; k < 2; ++k) dst[m][k] = *(const PG8_LAS bf16x8*)(lds + PG8_SA(b, h) + aoff + m * 2048 + k * 1024); } while (0)
#define PG8_LDB(dst, b, h) do { _Pragma("unroll") for (int n = 0; n < 2; ++n) _Pragma("unroll") for (int k = 0; k < 2; ++k) dst[n][k] = *(const PG8_LAS bf16x8*)(lds + PG8_SB(b, h) + boff + n * 2048 + k * 1024); } while (0)
#define PG8_MMA(ai, bj, At, Bt) do { __builtin_amdgcn_s_setprio(1); _Pragma("unroll") for (int m = 0; m < 4; ++m) _Pragma("unroll") for (int n = 0; n < 2; ++n) _Pragma("unroll") for (int k = 0; k < 2; ++k) \
        acc[ai][bj][m][n] = __builtin_amdgcn_mfma_f32_16x16x32_bf16(Bt[n][k], At[m][k], acc[ai][bj][m][n], 0, 0, 0); __builtin_amdgcn_s_setprio(0); } while (0)
#define PG8_WAIT_V(n) asm volatile("s_waitcnt vmcnt(" #n ")" ::: "memory")
#define PG8_WAIT_L(n) asm volatile("s_waitcnt lgkmcnt(" #n ")" ::: "memory")
#define PG8_BAR __builtin_amdgcn_s_barrier()
#define PG8_SCHED __builtin_amdgcn_sched_barrier(0)
    Unit cur, nxt; int ui = 0;
    if (!S.next(0, cur)) return;
    f32x4 acc[2][2][4][2];
#pragma unroll
    for (int a = 0; a < 2; ++a)
#pragma unroll
        for (int b = 0; b < 2; ++b)
#pragma unroll
            for (int m = 0; m < 4; ++m)
#pragma unroll
                for (int n = 0; n < 2; ++n) acc[a][b][m][n] = (f32x4){0.f, 0.f, 0.f, 0.f};
    bf16x8 At[4][2], B0[2][2], B1[2][2];
    const char* cA = (const char*)g.A + (size_t)cur.pm * tstep; const char* cB = (const char*)g.Bt + (size_t)cur.pn * tstep;
    S.a_ready(cur);
    if constexpr (SP2) {
        PG8_STAGE(PG8_SB(0, 0), cB, voffB); PG8_STAGE(PG8_SB(0, 1), cB + hstep, voffB); PG8_STAGE(PG8_SA(0, 0), cA, voffA); PG8_STAGE(PG8_SA(0, 1), cA + hstep, voffA);
        if (wr == 1) PG8_BAR;
        PG8_WAIT_V(2); PG8_BAR;
        PG8_STAGE(PG8_SB(1, 0), cB + kstep, voffB); PG8_STAGE(PG8_SA(1, 0), cA + kstep, voffA); PG8_STAGE(PG8_SB(1, 1), cB + hstep + kstep, voffB);
        PG8_WAIT_V(6); PG8_BAR;
    } else {
        PG8_STAGE(PG8_SB(0, 0), cB, voffB); PG8_STAGE(PG8_SA(0, 0), cA, voffA); PG8_STAGE(PG8_SB(0, 1), cB + hstep, voffB); PG8_STAGE(PG8_SA(0, 1), cA + hstep, voffA);
        if (wr == 1) PG8_BAR;
        PG8_WAIT_V(4); PG8_BAR;
        PG8_STAGE(PG8_SB(1, 0), cB + kstep, voffB); PG8_STAGE(PG8_SA(1, 0), cA + kstep, voffA); PG8_STAGE(PG8_SB(1, 1), cB + hstep + kstep, voffB);
        PG8_WAIT_V(6); PG8_BAR;
    }
    for (;;) {
        const bool has_next = S.next(ui + 1, nxt);
        const char* nA = has_next ? (const char*)g.A + (size_t)nxt.pm * tstep : cA; const char* nB = has_next ? (const char*)g.Bt + (size_t)nxt.pn * tstep : cB;
        for (int t = 0; t < nt; t += 2) {
            const bool last = (t == nt - 2);
            const char* a1 = cA + (size_t)(t + 1) * kstep;
            const char* a2 = last ? nA : cA + (size_t)(t + 2) * kstep; const char* b2 = last ? nB : cB + (size_t)(t + 2) * kstep;
            const char* a3 = a2 + kstep; const char* b3 = b2 + kstep;
            if (last && has_next) S.a_ready(nxt);
            if constexpr (SP2) {
            PG8_LDB(B0, 0, 0); PG8_LDB(B1, 0, 1); PG8_SCHED; PG8_LDA(At, 0, 0); PG8_STAGE(PG8_SA(1, 1), a1 + hstep, voffA);
            PG8_WAIT_V(8); PG8_WAIT_L(0); PG8_BAR; PG8_MMA(0, 0, At, B0); PG8_MMA(0, 1, At, B1); PG8_BAR; PG8_SCHED;
            PG8_LDA(At, 0, 1); PG8_STAGE(PG8_SB(0, 0), b2, voffB); PG8_STAGE(PG8_SB(0, 1), b2 + hstep, voffB); PG8_STAGE(PG8_SA(0, 0), a2, voffA);
            PG8_WAIT_V(8); PG8_WAIT_L(0); PG8_BAR; PG8_MMA(1, 0, At, B0); PG8_MMA(1, 1, At, B1); PG8_BAR; PG8_SCHED;
            PG8_LDB(B0, 1, 0); PG8_LDB(B1, 1, 1); PG8_SCHED; PG8_LDA(At, 1, 0); PG8_STAGE(PG8_SA(0, 1), a2 + hstep, voffA);
            PG8_WAIT_V(8); PG8_WAIT_L(0); PG8_BAR; PG8_MMA(0, 0, At, B0); PG8_MMA(0, 1, At, B1); PG8_BAR; PG8_SCHED;
            PG8_LDA(At, 1, 1); PG8_STAGE(PG8_SB(1, 0), b3, voffB); PG8_STAGE(PG8_SB(1, 1), b3 + hstep, voffB); PG8_STAGE(PG8_SA(1, 0), a3, voffA);
            PG8_WAIT_V(8); PG8_WAIT_L(0); PG8_BAR; PG8_MMA(1, 0, At, B0); PG8_MMA(1, 1, At, B1); PG8_BAR; PG8_SCHED;
            } else {
            PG8_LDB(B0, 0, 0); PG8_SCHED; PG8_LDA(At, 0, 0); PG8_STAGE(PG8_SA(1, 1), a1 + hstep, voffA);
            PG8_WAIT_L(8); PG8_BAR; PG8_WAIT_L(0); PG8_MMA(0, 0, At, B0); PG8_BAR; PG8_SCHED;
            PG8_LDB(B1, 0, 1); PG8_STAGE(PG8_SB(0, 0), b2, voffB);
            PG8_BAR; PG8_WAIT_L(0); PG8_MMA(0, 1, At, B1); PG8_BAR;
            PG8_LDA(At, 0, 1); PG8_STAGE(PG8_SA(0, 0), a2, voffA);
            PG8_BAR; PG8_WAIT_L(0); PG8_MMA(1, 0, At, B0); PG8_BAR; PG8_SCHED;
            PG8_STAGE(PG8_SB(0, 1), b2 + hstep, voffB);
            PG8_WAIT_V(6); PG8_BAR; PG8_MMA(1, 1, At, B1); PG8_BAR;
            PG8_LDB(B0, 1, 0); PG8_SCHED; PG8_LDA(At, 1, 0); PG8_STAGE(PG8_SA(0, 1), a2 + hstep, voffA);
            PG8_WAIT_L(8); PG8_BAR; PG8_WAIT_L(0); PG8_MMA(0, 0, At, B0); PG8_BAR; PG8_SCHED;
            PG8_LDB(B1, 1, 1); PG8_STAGE(PG8_SB(1, 0), b3, voffB);
            PG8_BAR; PG8_WAIT_L(0); PG8_MMA(0, 1, At, B1); PG8_BAR;
            PG8_LDA(At, 1, 1); PG8_STAGE(PG8_SA(1, 0), a3, voffA);
            PG8_BAR; PG8_WAIT_L(0); PG8_MMA(1, 0, At, B0); PG8_BAR; PG8_SCHED;
            PG8_STAGE(PG8_SB(1, 1), b3 + hstep, voffB);
            PG8_WAIT_V(6); PG8_BAR; PG8_MMA(1, 1, At, B1); PG8_BAR;
            }
        }
        if constexpr (ALIGN_EPI) { if (wr == 0) PG8_BAR; }
        if constexpr (!Epi::AFTER_DRAIN) { E(acc, cur, wr, wc, fr, fq); S.done(cur); }
        if (!has_next) break;
#pragma unroll
        for (int a = 0; a < 2; ++a)
#pragma unroll
            for (int b = 0; b < 2; ++b)
#pragma unroll
                for (int m = 0; m < 4; ++m)
#pragma unroll
                    for (int n = 0; n < 2; ++n) acc[a][b][m][n] = (f32x4){0.f, 0.f, 0.f, 0.f};
        cur = nxt; cA = nA; cB = nB; ++ui;
        if constexpr (ALIGN_EPI) { if (wr == 1) PG8_BAR; }
    }
    PG8_WAIT_V(0);
    if constexpr (!ALIGN_EPI) { if (wr == 0) PG8_BAR; }
    PG8_BAR;
    if constexpr (Epi::AFTER_DRAIN) { E.fused(acc, cur, wr, wc, fr, fq, lds, wid, lane); S.done(cur); }
#undef PG8_SA
#undef PG8_SB
#undef PG8_STAGE
#undef PG8_LDA
#undef PG8_LDB
#undef PG8_MMA
#undef PG8_WAIT_V
#undef PG8_WAIT_L
#undef PG8_BAR
#undef PG8_SCHED
}

constexpr int DM_ = 1024; constexpr float RMS_EPS_ = 1e-5f;
typedef unsigned long long ssq_t;
struct EpiScaleBf16 {
    static constexpr bool PERM = true, AFTER_DRAIN = false;
    bf16_t* O; int ldc; const ssq_t* ss;
    __device__ __forceinline__ void operator()(const f32x4 (&acc)[2][2][4][2], const Unit& u, int wr, int wc, int fr, int fq) const {
        const int row0 = u.pm * BM + wr * 64 + fr, col0 = u.pn * BM + wc * 32 + 8 * fq;
        float rsv[2][4];
#pragma unroll
        for (int ai = 0; ai < 2; ++ai)
#pragma unroll
            for (int m = 0; m < 4; ++m) rsv[ai][m] = (float)ss[row0 + ai * HALF + m * 16] * (1.0f / 1048576.0f);
#pragma unroll
        for (int ai = 0; ai < 2; ++ai)
#pragma unroll
            for (int m = 0; m < 4; ++m) { const int row = row0 + ai * HALF + m * 16; const float rs = __builtin_amdgcn_rsqf(rsv[ai][m] * (1.0f / DM_) + RMS_EPS_); bf16_t* rowp = O + (size_t)row * ldc + col0;
#pragma unroll
                for (int bj = 0; bj < 2; ++bj) { const f32x4 v0 = acc[ai][bj][m][0] * rs, v1 = acc[ai][bj][m][1] * rs;
                    u32x4 w; w.x = cvt_pk_bf16(v0[0], v0[1]); w.y = cvt_pk_bf16(v0[2], v0[3]); w.z = cvt_pk_bf16(v1[0], v1[1]); w.w = cvt_pk_bf16(v1[2], v1[3]);
                    *(u32x4*)(rowp + bj * HALF) = w; } }
    }
};
struct EpiResid {
    static constexpr bool PERM = true, AFTER_DRAIN = false;
    bf16_t* xb; ssq_t* ss_out;
    __device__ __forceinline__ void operator()(const f32x4 (&acc)[2][2][4][2], const Unit& u, int wr, int wc, int fr, int fq) const {
        const int row0 = u.pm * BM + wr * 64 + fr, col0 = u.pn * BM + wc * 32 + 8 * fq;
#pragma unroll
        for (int ai = 0; ai < 2; ++ai) {
            u32x4 bs[4][2];
#pragma unroll
            for (int m = 0; m < 4; ++m)
#pragma unroll
                for (int bj = 0; bj < 2; ++bj) bs[m][bj] = *(const u32x4*)(xb + (size_t)(row0 + ai * HALF + m * 16) * DM_ + col0 + bj * HALF);
#pragma unroll
            for (int m = 0; m < 4; ++m) { const int row = row0 + ai * HALF + m * 16; bf16_t* rp = xb + (size_t)row * DM_ + col0; float sq = 0.f;
#pragma unroll
                for (int bj = 0; bj < 2; ++bj) { const u32x4 b = bs[m][bj]; u32x4 w;
#pragma unroll
                    for (int hh = 0; hh < 2; ++hh) { const unsigned b0 = hh == 0 ? b.x : b.z, b1 = hh == 0 ? b.y : b.w; const f32x4 a4 = acc[ai][bj][m][hh];
                        const float x0 = __builtin_bit_cast(float, b0 << 16) + a4[0], x1 = __builtin_bit_cast(float, b0 & 0xffff0000u) + a4[1], x2 = __builtin_bit_cast(float, b1 << 16) + a4[2], x3 = __builtin_bit_cast(float, b1 & 0xffff0000u) + a4[3];
                        const unsigned w0 = cvt_pk_bf16(x0, x1), w1 = cvt_pk_bf16(x2, x3);
                        if (hh == 0) { w.x = w0; w.y = w1; } else { w.z = w0; w.w = w1; }
                        const float r0 = __builtin_bit_cast(float, w0 << 16), r1 = __builtin_bit_cast(float, w0 & 0xffff0000u), r2 = __builtin_bit_cast(float, w1 << 16), r3 = __builtin_bit_cast(float, w1 & 0xffff0000u);
                        sq += (r0 * r0 + r1 * r1) + (r2 * r2 + r3 * r3); }
                    *(u32x4*)(rp + bj * HALF) = w; }
                sq += __shfl_xor(sq, 16); sq += __shfl_xor(sq, 32);
                if (fq == 0) atomicAdd(ss_out + row, (ssq_t)(sq * 1048576.0f + 0.5f)); }
        }
    }
};
struct EpiGateUpTmp {
    static constexpr bool PERM = true, AFTER_DRAIN = false;
    bf16_t* U; bf16_t* UP; const ssq_t* ss; int ff;
    __device__ __forceinline__ void operator()(const f32x4 (&acc)[2][2][4][2], const Unit& u, int wr, int wc, int fr, int fq) const {
        const int row0 = u.pm * BM + wr * 64 + fr, col0 = u.pn * HALF + wc * 32 + 8 * fq;
        float rsv[2][4];
#pragma unroll
        for (int ai = 0; ai < 2; ++ai)
#pragma unroll
            for (int m = 0; m < 4; ++m) rsv[ai][m] = (float)ss[row0 + ai * HALF + m * 16] * (1.0f / 1048576.0f);
#pragma unroll
        for (int ai = 0; ai < 2; ++ai)
#pragma unroll
            for (int m = 0; m < 4; ++m) { const int row = row0 + ai * HALF + m * 16; const float rs = __builtin_amdgcn_rsqf(rsv[ai][m] * (1.0f / DM_) + RMS_EPS_); const size_t o = (size_t)row * ff + col0;
#pragma unroll
                for (int bj = 0; bj < 2; ++bj) { const f32x4 v0 = acc[ai][bj][m][0] * rs, v1 = acc[ai][bj][m][1] * rs;
                    u32x4 w; w.x = cvt_pk_bf16(v0[0], v0[1]); w.y = cvt_pk_bf16(v0[2], v0[3]); w.z = cvt_pk_bf16(v1[0], v1[1]); w.w = cvt_pk_bf16(v1[2], v1[3]);
                    *(u32x4*)((bj == 0 ? U : UP) + o) = w; } }
    }
};
template <int CTRL> __device__ __forceinline__ float dpp1(float x) { return __builtin_bit_cast(float, __builtin_amdgcn_update_dpp(0, __builtin_bit_cast(int, x), CTRL, 0xF, 0xF, true)); }
template <int CTRL> __device__ __forceinline__ f32x4 dpp4(const f32x4 x) { return (f32x4){dpp1<CTRL>(x.x), dpp1<CTRL>(x.y), dpp1<CTRL>(x.z), dpp1<CTRL>(x.w)}; }
struct EpiConvGlu {
    static constexpr bool PERM = true, AFTER_DRAIN = false;
    bf16_t* HID; const ssq_t* ss; const float* cw; const float* cb; float* SB; PG8_LAS float* xch; int ff;
    __device__ __forceinline__ void operator()(const f32x4 (&acc)[2][2][4][2], const Unit& u, int wr, int wc, int fr, int fq) const {
        const int row0 = u.pm * BM + wr * 64 + fr, cl = wc * 32 + 8 * fq, jcol = u.pn * HALF + cl;
        float rs[2][4];
#pragma unroll
        for (int ai = 0; ai < 2; ++ai)
#pragma unroll
            for (int m = 0; m < 4; ++m) rs[ai][m] = (float)ss[row0 + ai * HALF + m * 16] * (1.0f / 1048576.0f);
        f32x4 w0[2], w1[2], w2[2], bb[2];
#pragma unroll
        for (int n = 0; n < 2; ++n) { w0[n] = *(const f32x4*)(cw + jcol + 4 * n); w1[n] = *(const f32x4*)(cw + ff + jcol + 4 * n); w2[n] = *(const f32x4*)(cw + 2 * ff + jcol + 4 * n); bb[n] = *(const f32x4*)(cb + jcol + 4 * n); }
#pragma unroll
        for (int ai = 0; ai < 2; ++ai)
#pragma unroll
            for (int m = 0; m < 4; ++m) rs[ai][m] = __builtin_amdgcn_rsqf(rs[ai][m] * (1.0f / DM_) + RMS_EPS_);
        if (fr >= 14) {
#pragma unroll
            for (int ai = 0; ai < 2; ++ai)
#pragma unroll
                for (int n = 0; n < 2; ++n) *(PG8_LAS f32x4*)(xch + ((2 * ai + wr) * 2 + (fr - 14)) * HALF + cl + 4 * n) = acc[ai][0][3][n] * rs[ai][3];
        }
        asm volatile("s_waitcnt lgkmcnt(0)" ::: "memory"); __builtin_amdgcn_s_barrier(); asm volatile("" ::: "memory");
        float* sbp = SB + (size_t)u.pm * 6 * ff + jcol;
#pragma unroll
        for (int ai = 0; ai < 2; ++ai) {
            const int q = 2 * ai + wr;
            f32x4 X[2];
#pragma unroll
            for (int n = 0; n < 2; ++n) { X[n] = (f32x4){0.f, 0.f, 0.f, 0.f}; if (q > 0 && fr >= 14) X[n] = *(const PG8_LAS f32x4*)(xch + ((q - 1) * 2 + (fr - 14)) * HALF + cl + 4 * n); }
#pragma unroll
            for (int m = 0; m < 4; ++m) { const int row = row0 + ai * HALF + m * 16;
                pg8::u32x4 hw;
#pragma unroll
                for (int n = 0; n < 2; ++n) {
                    const f32x4 cur = acc[ai][0][m][n] * rs[ai][m], up = acc[ai][1][m][n] * rs[ai][m];
                    const f32x4 P = (m > 0) ? acc[ai][0][m > 0 ? m - 1 : 0][n] * rs[ai][m > 0 ? m - 1 : 0] : X[n];
                    const f32x4 a1 = dpp4<0x121>(cur), b1 = dpp4<0x121>(P), a2 = dpp4<0x122>(cur), b2 = dpp4<0x122>(P);
                    f32x4 p1, p2;
#pragma unroll
                    for (int e = 0; e < 4; ++e) { p1[e] = fr == 0 ? b1[e] : a1[e]; p2[e] = fr < 2 ? b2[e] : a2[e]; }
                    const f32x4 c = bb[n] + w0[n] * p2 + w1[n] * p1 + w2[n] * cur;
                    f32x4 hv;
#pragma unroll
                    for (int e = 0; e < 4; ++e) hv[e] = c[e] * __builtin_amdgcn_rcpf(1.f + __expf(-c[e])) * up[e];
                    if (n == 0) { hw.x = cvt_pk_bf16(hv[0], hv[1]); hw.y = cvt_pk_bf16(hv[2], hv[3]); } else { hw.z = cvt_pk_bf16(hv[0], hv[1]); hw.w = cvt_pk_bf16(hv[2], hv[3]); }
                    if (q == 0 && m == 0 && fr < 2) { *(f32x4*)(sbp + (size_t)fr * ff + 4 * n) = cur; *(f32x4*)(sbp + (size_t)(2 + fr) * ff + 4 * n) = up; }
                    if (q == 3 && m == 3 && fr >= 14) *(f32x4*)(sbp + (size_t)(4 + fr - 14) * ff + 4 * n) = cur;
                }
                *(pg8::u32x4*)(HID + (size_t)row * ff + jcol) = hw; }
        }
    }
};
}

#define LAS __attribute__((address_space(3)))
__device__ __forceinline__ void transpose_item(const float* __restrict__ W, int K, int N, bf16_t* __restrict__ Wt, const float* __restrict__ g, int mode, float* scr, int item, int lane) {
    const int nblk = N / 32, kb = item / nblk, nb = item % nblk, k0 = 64 * kb, n0 = 32 * nb;
    int np0 = n0; if (mode == 1) np0 = 256 * (n0 / 128) + (n0 % 128); else if (mode == 2) np0 = 256 * (n0 / 128) + 128 + (n0 % 128);
#pragma unroll 8
    for (int i = 0; i < 32; ++i) { const int kk = 2 * i + (lane >> 5); scr[kk * 33 + (lane & 31)] = W[(size_t)(k0 + kk) * N + n0 + (lane & 31)] * (g ? g[k0 + kk] : 1.f); }
    __builtin_amdgcn_fence(__ATOMIC_RELEASE, "wavefront"); __builtin_amdgcn_wave_barrier(); __builtin_amdgcn_fence(__ATOMIC_ACQUIRE, "wavefront");
    const int c = lane & 7;
#pragma unroll
    for (int j = 0; j < 4; ++j) { const int n = (lane >> 3) + 8 * j; const float* sp = scr + (8 * c) * 33 + n;
        uint4 o; o.x = f2bf(sp[0]) | (f2bf(sp[33]) << 16); o.y = f2bf(sp[2 * 33]) | (f2bf(sp[3 * 33]) << 16); o.z = f2bf(sp[4 * 33]) | (f2bf(sp[5 * 33]) << 16); o.w = f2bf(sp[6 * 33]) | (f2bf(sp[7 * 33]) << 16);
        *(uint4*)(Wt + (size_t)(np0 + n) * K + k0 + 8 * c) = o; }
    __builtin_amdgcn_fence(__ATOMIC_RELEASE, "wavefront"); __builtin_amdgcn_wave_barrier(); __builtin_amdgcn_fence(__ATOMIC_ACQUIRE, "wavefront");
}
__device__ __forceinline__ void x_row_to_bf16(const float* __restrict__ x, bf16_t* __restrict__ xb, ssq_t* __restrict__ ss, int row, int lane) {
    const f32x4* xr = (const f32x4*)(x + (size_t)row * D) + lane; float s = 0.f;
#pragma unroll
    for (int j = 0; j < 4; ++j) { const f32x4 v = xr[64 * j]; s += v.x * v.x + v.y * v.y + v.z * v.z + v.w * v.w;
        unsigned long long o = (unsigned long long)(f2bf(v.x) | (f2bf(v.y) << 16)) | ((unsigned long long)(f2bf(v.z) | (f2bf(v.w) << 16)) << 32);
        ((unsigned long long*)(xb + (size_t)row * D))[lane + 64 * j] = o; }
    s = wave_sum(s); if (lane == 0) ss[row] = ssq_fix(s);
}

struct PrepArgs {
    const bf16_t* proj; const float* mu; const float* w0; const float* w2; const float* a0; const float* a2; const float* g2;
    const float* v0; const float* v1; const float* v2; bf16_t* vfirst; int layer; int pad;
    bf16_t *R, *K, *V, *A, *LD, *G;
};
__device__ __forceinline__ void prep_group(const PrepArgs& p, float (*rest)[SHIFT_W], float (*vlo)[32], int grp, int tid) {
    const int m0 = grp * 4;
    for (int i = tid; i < 4 * SHIFT_W; i += 512) {
        const int tk = i / SHIFT_W, c = i % SHIFT_W, m = m0 + tk, t = m % SEQ;
        const float u = bf2f(p.proj[(size_t)m * IN_W + ATT_IN + c]);
        const float up = t > 0 ? bf2f(p.proj[(size_t)(m - 1) * IN_W + ATT_IN + c]) : 0.f;
        float v = u + (up - u) * p.mu[c];
        if (c >= 1536 && c < 1600) v = tanhf(v); else if (c >= 1664) v = sigmoidf_(v);
        rest[tk][c] = v;
    }
    __syncthreads();
    if (p.layer > 0 && tid < 128) { const int tk = tid >> 5, j = tid & 31; float s = 0.f; for (int c = 0; c < C; ++c) s += rest[tk][1024 + c] * p.v1[c * 32 + j]; vlo[tk][j] = s; }
    __syncthreads();
    const int c = tid;
    float wp[4], ap[4], gp[4];
#pragma unroll
    for (int tk = 0; tk < 4; ++tk) { wp[tk] = p.w0[c]; ap[tk] = p.a0[c]; gp[tk] = 0.f; }
    for (int k = 0; k < 64; ++k) { const float w = p.w2[k * C + c], a = p.a2[k * C + c];
#pragma unroll
        for (int tk = 0; tk < 4; ++tk) { wp[tk] += rest[tk][1536 + k] * w; ap[tk] += rest[tk][1600 + k] * a; } }
    for (int k = 0; k < 128; ++k) { const float g = p.g2[k * C + c];
#pragma unroll
        for (int tk = 0; tk < 4; ++tk) gp[tk] += rest[tk][1664 + k] * g; }
#pragma unroll
    for (int tk = 0; tk < 4; ++tk) {
        const size_t o = (size_t)(m0 + tk) * C + c;
        const float x = -wp[tk];
        const float sp = fmaxf(x, 0.f) + log1pf(__expf(-fabsf(x)));
        const float wraw = -sp - 0.5f;
        const float ld = -__expf(wraw);
        const float a = sigmoidf_(ap[tk]);
        float v = rest[tk][1024 + c];
        if (p.layer == 0) p.vfirst[o] = (bf16_t)f2bf(v);
        else { float s = p.v0[c]; for (int j = 0; j < 32; ++j) s += vlo[tk][j] * p.v2[j * C + c]; const float vf = bf2f(p.vfirst[o]); v = v + (vf - v) * sigmoidf_(s); }
        p.R[o] = (bf16_t)f2bf(rest[tk][c]); p.K[o] = (bf16_t)f2bf(rest[tk][512 + c]); p.V[o] = (bf16_t)f2bf(v);
        p.A[o] = (bf16_t)f2bf(a); p.LD[o] = (bf16_t)f2bf(ld); p.G[o] = (bf16_t)f2bf(gp[tk]);
    }
    __syncthreads();
}

constexpr size_t WS_LORA = 50 * MiB;
constexpr size_t LORA_LAYER = 256 * 1024, WS_V1T = WS_LORA + 2 * LORA_LAYER, WS_V2T = WS_V1T + 32 * 1024;
constexpr int PR_ACT_LD = 264, PR_VLO_LD = 40, PR_SG_LD = 520, PR_ACT_OFF = 0, PR_VLO_OFF = 64 * PR_ACT_LD * 2, PR_SG_OFF = PR_VLO_OFF + 64 * PR_VLO_LD * 2;
struct Prep2Args {
    const bf16_t* proj; const float* mu; const float* w0; const float* a0; const float* v0;
    const bf16_t *W2T, *A2T, *G2T, *V1T, *V2T; bf16_t* vfirst; bf16_t *R, *K, *V, *A, *LD, *G; int layer; int pad;
};
__device__ __forceinline__ f32x4 bfx4_lo(const bf16x8 v) { return (f32x4){bf2f((bf16_t)v[0]), bf2f((bf16_t)v[1]), bf2f((bf16_t)v[2]), bf2f((bf16_t)v[3])}; }
__device__ __forceinline__ f32x4 bfx4_hi(const bf16x8 v) { return (f32x4){bf2f((bf16_t)v[4]), bf2f((bf16_t)v[5]), bf2f((bf16_t)v[6]), bf2f((bf16_t)v[7])}; }
__device__ __forceinline__ bf16x8 pack8(const f32x4 a, const f32x4 b) { pg8::u32x4 w; w.x = pg8::cvt_pk_bf16(a[0], a[1]); w.y = pg8::cvt_pk_bf16(a[2], a[3]); w.z = pg8::cvt_pk_bf16(b[0], b[1]); w.w = pg8::cvt_pk_bf16(b[2], b[3]); return __builtin_bit_cast(bf16x8, w); }
__device__ __forceinline__ void shift8(const bf16_t* __restrict__ proj, const float* __restrict__ mu, size_t m, int t, int col, int mi, f32x4& lo, f32x4& hi) {
    const bf16x8 cur = *(const bf16x8*)(proj + m * IN_W + col);
    bf16x8 prv; if (t > 0) prv = *(const bf16x8*)(proj + (m - 1) * IN_W + col); else prv = (bf16x8){0, 0, 0, 0, 0, 0, 0, 0};
    const f32x4 m0 = *(const f32x4*)(mu + mi), m1 = *(const f32x4*)(mu + mi + 4);
    const f32x4 c0 = bfx4_lo(cur), c1 = bfx4_hi(cur), p0 = bfx4_lo(prv), p1 = bfx4_hi(prv);
    lo = c0 + (p0 - c0) * m0; hi = c1 + (p1 - c1) * m1;
}
__device__ __forceinline__ void prep_tile(const Prep2Args& p, unsigned char* lds, int tile, int tid) {
    const int m0 = tile * 64, wave = __builtin_amdgcn_readfirstlane(tid >> 6), lane = tid & 63, fr = lane & 15, fq = lane >> 4;
    bf16_t* ACT = (bf16_t*)(lds + PR_ACT_OFF); bf16_t* VLO = (bf16_t*)(lds + PR_VLO_OFF); bf16_t* SG = (bf16_t*)(lds + PR_SG_OFF);
#pragma unroll
    for (int it = 0; it < 4; ++it) { const int i = tid + 512 * it, tk = i >> 5, cc = i & 31; const size_t m = (size_t)m0 + tk; const int t = (int)(m % SEQ);
        f32x4 lo, hi; shift8(p.proj, p.mu, m, t, 2304 + 8 * cc, 1536 + 8 * cc, lo, hi);
        if (cc < 8) {
#pragma unroll
            for (int e = 0; e < 4; ++e) { lo[e] = 2.f * sigmoidf_(2.f * lo[e]) - 1.f; hi[e] = 2.f * sigmoidf_(2.f * hi[e]) - 1.f; } }
        else if (cc >= 16) {
#pragma unroll
            for (int e = 0; e < 4; ++e) { lo[e] = sigmoidf_(lo[e]); hi[e] = sigmoidf_(hi[e]); } }
        *(bf16x8*)(ACT + tk * PR_ACT_LD + 8 * cc) = pack8(lo, hi); }
    if (p.layer > 0) {
        const int tb = wave >> 1, jb = wave & 1; const size_t m = (size_t)m0 + 16 * tb + fr; const int t = (int)(m % SEQ);
        f32x4 acc = (f32x4){0.f, 0.f, 0.f, 0.f};
#pragma unroll 4
        for (int ks = 0; ks < 16; ++ks) { f32x4 lo, hi; shift8(p.proj, p.mu, m, t, 1792 + 32 * ks + 8 * fq, 1024 + 32 * ks + 8 * fq, lo, hi);
            const bf16x8 wf = *(const bf16x8*)(p.V1T + (size_t)(16 * jb + fr) * C + 32 * ks + 8 * fq);
            acc = __builtin_amdgcn_mfma_f32_16x16x32_bf16(wf, pack8(lo, hi), acc, 0, 0, 0); }
        uint2 w; w.x = pg8::cvt_pk_bf16(acc[0], acc[1]); w.y = pg8::cvt_pk_bf16(acc[2], acc[3]);
        *(uint2*)(VLO + (16 * tb + fr) * PR_VLO_LD + 16 * jb + 4 * fq) = w;
    }
    __syncthreads();
    const int ch0 = 64 * wave;
#pragma unroll
    for (int arr = 0; arr < 3; ++arr) {
        const int K0 = arr == 0 ? 0 : (arr == 1 ? 64 : 128), KL = arr == 2 ? 128 : 64; const bf16_t* WT = arr == 0 ? p.W2T : (arr == 1 ? p.A2T : p.G2T);
        f32x4 acc[4][4];
#pragma unroll
        for (int tb = 0; tb < 4; ++tb)
#pragma unroll
            for (int cb = 0; cb < 4; ++cb) acc[tb][cb] = (f32x4){0.f, 0.f, 0.f, 0.f};
#pragma unroll
        for (int ks = 0; ks < KL / 32; ++ks) { bf16x8 wf[4], af[4];
#pragma unroll
            for (int cb = 0; cb < 4; ++cb) wf[cb] = *(const bf16x8*)(WT + (size_t)(ch0 + 16 * cb + fr) * KL + 32 * ks + 8 * fq);
#pragma unroll
            for (int tb = 0; tb < 4; ++tb) af[tb] = *(const bf16x8*)(ACT + (16 * tb + fr) * PR_ACT_LD + K0 + 32 * ks + 8 * fq);
#pragma unroll
            for (int tb = 0; tb < 4; ++tb)
#pragma unroll
                for (int cb = 0; cb < 4; ++cb) acc[tb][cb] = __builtin_amdgcn_mfma_f32_16x16x32_bf16(wf[cb], af[tb], acc[tb][cb], 0, 0, 0); }
        bf16_t* OUT = arr == 0 ? p.LD : (arr == 1 ? p.A : p.G);
#pragma unroll
        for (int cb = 0; cb < 4; ++cb) { const int ch = ch0 + 16 * cb + 4 * fq;
            f32x4 bias = (f32x4){0.f, 0.f, 0.f, 0.f}; if (arr == 0) bias = *(const f32x4*)(p.w0 + ch); else if (arr == 1) bias = *(const f32x4*)(p.a0 + ch);
#pragma unroll
            for (int tb = 0; tb < 4; ++tb) { f32x4 x = acc[tb][cb] + bias;
                if (arr == 0) {
#pragma unroll
                    for (int e = 0; e < 4; ++e) { const float z = -x[e]; const float sp = fmaxf(z, 0.f) + __logf(1.f + __expf(-fabsf(z))); x[e] = -__expf(-sp - 0.5f); } }
                else if (arr == 1) {
#pragma unroll
                    for (int e = 0; e < 4; ++e) x[e] = sigmoidf_(x[e]); }
                uint2 w; w.x = pg8::cvt_pk_bf16(x[0], x[1]); w.y = pg8::cvt_pk_bf16(x[2], x[3]);
                *(uint2*)(OUT + ((size_t)m0 + 16 * tb + fr) * C + ch) = w; } }
    }
    if (p.layer > 0) {
        bf16x8 af[4];
#pragma unroll
        for (int tb = 0; tb < 4; ++tb) af[tb] = *(const bf16x8*)(VLO + (16 * tb + fr) * PR_VLO_LD + 8 * fq);
#pragma unroll
        for (int cb = 0; cb < 4; ++cb) { const int ch = ch0 + 16 * cb + 4 * fq; const bf16x8 wf = *(const bf16x8*)(p.V2T + (size_t)(ch0 + 16 * cb + fr) * 32 + 8 * fq); const f32x4 bias = *(const f32x4*)(p.v0 + ch);
#pragma unroll
            for (int tb = 0; tb < 4; ++tb) { f32x4 x = __builtin_amdgcn_mfma_f32_16x16x32_bf16(wf, af[tb], (f32x4){0.f, 0.f, 0.f, 0.f}, 0, 0, 0) + bias;
                uint2 w; w.x = pg8::cvt_pk_bf16(sigmoidf_(x[0]), sigmoidf_(x[1])); w.y = pg8::cvt_pk_bf16(sigmoidf_(x[2]), sigmoidf_(x[3]));
                *(uint2*)(SG + (16 * tb + fr) * PR_SG_LD + ch) = w; } }
    }
    __syncthreads();
#pragma unroll
    for (int sec = 0; sec < 3; ++sec) { bf16_t* OUT = sec == 0 ? p.R : (sec == 1 ? p.K : p.V);
#pragma unroll 4
        for (int it = 0; it < 8; ++it) { const int i = tid + 512 * it, tk = i >> 6, cc = i & 63; const size_t m = (size_t)m0 + tk; const int t = (int)(m % SEQ);
            f32x4 lo, hi; shift8(p.proj, p.mu, m, t, 768 + 512 * sec + 8 * cc, 512 * sec + 8 * cc, lo, hi);
            const size_t o = m * C + 8 * cc;
            if (sec == 2) {
                if (p.layer == 0) *(bf16x8*)(p.vfirst + o) = pack8(lo, hi);
                else { const bf16x8 vf = *(const bf16x8*)(p.vfirst + o), sg = *(const bf16x8*)(SG + tk * PR_SG_LD + 8 * cc);
                    lo = lo + (bfx4_lo(vf) - lo) * bfx4_lo(sg); hi = hi + (bfx4_hi(vf) - hi) * bfx4_hi(sg); } }
            *(bf16x8*)(OUT + o) = pack8(lo, hi); } }
    __syncthreads();
}

constexpr int NTHREADS_ = 512;
constexpr int SC_TB = 32, SC_SLOT = 384, SC_NCH = SEQ / SC_TB;
constexpr size_t WS_RKC = 51 * MiB;
struct ScanArgs { const bf16_t *R, *K, *V, *A, *LD, *G; const float *k_k, *k_a, *r_k, *lnx_g, *lnx_b; bf16_t* mix; float* rkc; };
template <int CTRL> __device__ __forceinline__ float dpp_mov(float x) { return __builtin_bit_cast(float, __builtin_amdgcn_update_dpp(0, __builtin_bit_cast(int, x), CTRL, 0xF, 0xF, true)); }
__device__ __forceinline__ float reduce16(float x) { x += dpp_mov<0xB1>(x); x += dpp_mov<0x4E>(x); x += dpp_mov<0x141>(x); x += dpp_mov<0x140>(x); return x; }
__device__ __forceinline__ void scan_item(const ScanArgs& p, float* lds, int item, int tid) {
    const int chain = item >> 2, q = item & 3, b = chain >> 3, h = chain & 7, wave = __builtin_amdgcn_readfirstlane(tid >> 6), lane = tid & 63;
    float* buf = lds;
    float* ybuf = lds + 2 * SC_TB * SC_SLOT;
    if (wave >= 4) {
        const int lw = wave - 4, lt = lw * 64 + lane, cgl = lane & 15, srow = lane >> 4, ch4 = h * 64 + 4 * cgl;
        const f32x4 kk_c = *(const f32x4*)(p.k_k + ch4), ka_c = *(const f32x4*)(p.k_a + ch4), rk_c = *(const f32x4*)(p.r_k + ch4);
        const size_t rowbase = (size_t)b * SEQ;
        struct LdSet { uint2 r[2], k[2], v[2], a[2], ld[2]; } s0, s1;
#define SC_LOAD(S, chunk) do { _Pragma("unroll") for (int ps = 0; ps < 2; ++ps) { const size_t o = (rowbase + (size_t)(chunk) * SC_TB + 8 * lw + 4 * ps + srow) * C + ch4; \
            S.r[ps] = *(const uint2*)(p.R + o); S.k[ps] = *(const uint2*)(p.K + o); S.v[ps] = *(const uint2*)(p.V + o); S.a[ps] = *(const uint2*)(p.A + o); S.ld[ps] = *(const uint2*)(p.LD + o); } } while (0)
#define SC_UNPK(u) ((f32x4){__builtin_bit_cast(float, (u).x << 16), __builtin_bit_cast(float, (u).x & 0xffff0000u), __builtin_bit_cast(float, (u).y << 16), __builtin_bit_cast(float, (u).y & 0xffff0000u)})
#define SC_PROC(S, chunk, bi) do { _Pragma("unroll") for (int ps = 0; ps < 2; ++ps) { const int st = 8 * lw + 4 * ps + srow; \
            const f32x4 r = SC_UNPK(S.r[ps]), k = SC_UNPK(S.k[ps]), v = SC_UNPK(S.v[ps]), a = SC_UNPK(S.a[ps]), ld = SC_UNPK(S.ld[ps]); \
            f32x4 kk = k * kk_c; const float nrm = sqrtf(reduce16((kk.x * kk.x + kk.z * kk.z) + (kk.y * kk.y + kk.w * kk.w))); kk = kk * (1.f / fmaxf(nrm, 1e-12f)); \
            const f32x4 kp = k * ((a - 1.f) * ka_c + 1.f); const f32x4 t3 = r * kp * rk_c; const float rkc = reduce16((t3.x + t3.z) + (t3.y + t3.w)); \
            float* slot = buf + ((bi) * SC_TB + st) * SC_SLOT + 4 * cgl; \
            *(f32x4*)(slot) = (f32x4){__expf(ld.x), __expf(ld.y), __expf(ld.z), __expf(ld.w)}; *(f32x4*)(slot + 64) = -kk; *(f32x4*)(slot + 128) = kk * a; *(f32x4*)(slot + 192) = kp; *(f32x4*)(slot + 256) = r; *(f32x4*)(slot + 320) = v; \
            if (q == 0 && cgl == 0) p.rkc[(rowbase + (size_t)(chunk) * SC_TB + st) * 8 + h] = rkc; } } while (0)
#define SC_YOUT(chunk, bi) do { _Pragma("unroll") for (int e2 = 0; e2 < 2; ++e2) { const int e = lt + 256 * e2, st = e >> 4, rr = e & 15; \
            p.mix[(rowbase + (size_t)(chunk) * SC_TB + st) * D + ATT_W + h * 64 + 16 * q + rr] = (bf16_t)f2bf(ybuf[(bi) * SC_TB * 16 + e]); } } while (0)
        SC_LOAD(s0, 0); SC_LOAD(s1, 1); SC_PROC(s0, 0, 0);
        __syncthreads();
        for (int c = 0; c < SC_NCH; c += 2) {
            if (c + 2 < SC_NCH) SC_LOAD(s0, c + 2);
            SC_PROC(s1, c + 1, 1);
            if (c >= 1) SC_YOUT(c - 1, 1);
            __syncthreads();
            if (c + 3 < SC_NCH) SC_LOAD(s1, c + 3);
            if (c + 2 < SC_NCH) SC_PROC(s0, c + 2, 0);
            SC_YOUT(c, 0);
            __syncthreads();
        }
        SC_YOUT(SC_NCH - 1, 1);
#undef SC_LOAD
#undef SC_UNPK
#undef SC_PROC
#undef SC_YOUT
    } else {
        const int cg4 = (lane & 15) * 4, rloc = 4 * wave + (lane >> 4);
        f32x4 S = (f32x4){0.f, 0.f, 0.f, 0.f};
#define SC_SCAN(bi) do { const float* bp = buf + (bi) * SC_TB * SC_SLOT + cg4; const float* vp = buf + (bi) * SC_TB * SC_SLOT + 320 + 16 * q + rloc; \
            const unsigned ya = (unsigned)(size_t)(__attribute__((address_space(3))) float*)(((lane & 15) == 0) ? (ybuf + (bi) * SC_TB * 16 + rloc) : (ybuf + 2 * SC_TB * 16 + lane)); \
            f32x4 w = *(const f32x4*)(bp), A = *(const f32x4*)(bp + 64), B = *(const f32x4*)(bp + 128), kp = *(const f32x4*)(bp + 192), r = *(const f32x4*)(bp + 256); float v = vp[0]; \
            _Pragma("unroll") for (int st = 0; st < SC_TB; ++st) { \
                f32x4 wn = w, An = A, Bn = B, kpn = kp, rn = r; float vn = v; \
                if (st + 1 < SC_TB) { wn = *(const f32x4*)(bp + (st + 1) * SC_SLOT); An = *(const f32x4*)(bp + (st + 1) * SC_SLOT + 64); Bn = *(const f32x4*)(bp + (st + 1) * SC_SLOT + 128); \
                    kpn = *(const f32x4*)(bp + (st + 1) * SC_SLOT + 192); rn = *(const f32x4*)(bp + (st + 1) * SC_SLOT + 256); vn = vp[(st + 1) * SC_SLOT]; }     \
                float sa = (S.x * A.x + S.z * A.z) + (S.y * A.y + S.w * A.w); sa = reduce16(sa); \
                S = S * w + (B * sa + kp * v); \
                float y = (S.x * r.x + S.z * r.z) + (S.y * r.y + S.w * r.w); y = reduce16(y); \
                asm volatile("ds_write_b32 %0, %1 offset:%c2" :: "v"(ya), "v"(y), "i"(st * 64)); \
                w = wn; A = An; B = Bn; kp = kpn; r = rn; v = vn; } } while (0)
        __syncthreads();
        for (int c = 0; c < SC_NCH; c += 2) { SC_SCAN(0); __syncthreads(); SC_SCAN(1); __syncthreads(); }
#undef SC_SCAN
    }
    __syncthreads();
}
constexpr int CK_LD = 72, CK_MAT = 64 * CK_LD * 2;
constexpr size_t WS_CKGQ = WS_PROJ, WS_CKCQ = WS_PROJ + 64 * MiB;
__device__ __forceinline__ void ck_mm(f32x4 (&acc)[2], const bf16_t* Qm, const bf16_t* P, int jb, int ib0, int fr, int fq) {
#pragma unroll
    for (int ks = 0; ks < 2; ++ks) { const bf16x8 bq = *(const bf16x8*)(Qm + (16 * jb + fr) * CK_LD + 32 * ks + 8 * fq);
#pragma unroll
        for (int ii = 0; ii < 2; ++ii) { const bf16x8 ap = *(const bf16x8*)(P + (16 * (ib0 + ii) + fr) * CK_LD + 32 * ks + 8 * fq); acc[ii] = __builtin_amdgcn_mfma_f32_16x16x32_bf16(ap, bq, acc[ii], 0, 0, 0); } }
}
__device__ __forceinline__ uint2 ck_pack4(const f32x4 v) { uint2 w; w.x = pg8::cvt_pk_bf16(v[0], v[1]); w.y = pg8::cvt_pk_bf16(v[2], v[3]); return w; }
__device__ __forceinline__ f32x4 ck_unpack4(const uint2 u) { return (f32x4){__builtin_bit_cast(float, u.x << 16), __builtin_bit_cast(float, u.x & 0xffff0000u), __builtin_bit_cast(float, u.y << 16), __builtin_bit_cast(float, u.y & 0xffff0000u)}; }
__device__ __forceinline__ void ck_precompute(const ScanArgs& p, unsigned char* lds, bf16_t* GQ, bf16_t* CQ, int unit, int tid) {
    const int chain = unit >> 6, chunk = unit & 63, b = chain >> 3, h = chain & 7, wave = __builtin_amdgcn_readfirstlane(tid >> 6), lane = tid & 63, fr = lane & 15, fq = lane >> 4, jb = wave >> 1, ib0 = 2 * (wave & 1);
    bf16_t* At = (bf16_t*)(lds + 0 * CK_MAT); bf16_t* bt = (bf16_t*)(lds + 1 * CK_MAT); bf16_t* kt = (bf16_t*)(lds + 2 * CK_MAT); bf16_t* rt = (bf16_t*)(lds + 3 * CK_MAT);
    bf16_t* AtT = (bf16_t*)(lds + 4 * CK_MAT); bf16_t* BhT = (bf16_t*)(lds + 5 * CK_MAT); bf16_t* KhT = (bf16_t*)(lds + 6 * CK_MAT); bf16_t* VT = (bf16_t*)(lds + 7 * CK_MAT);
    bf16_t* NT = (bf16_t*)(lds + 8 * CK_MAT); bf16_t* Mm = (bf16_t*)(lds + 9 * CK_MAT); bf16_t* P1 = (bf16_t*)(lds + 10 * CK_MAT); bf16_t* P2 = (bf16_t*)(lds + 11 * CK_MAT);
    bf16_t* Ta = (bf16_t*)(lds + 12 * CK_MAT); bf16_t* Tb = (bf16_t*)(lds + 13 * CK_MAT); float* WT = (float*)(lds + 14 * CK_MAT); float* GL = WT + 512;
    bf16_t* W1T = bt; bf16_t* MVT = kt; bf16_t* W2T = At;
    {
        const int ch = h * 64 + lane; const size_t row0 = (size_t)b * SEQ + chunk * 64 + 8 * wave;
        const float kk_c = p.k_k[ch], ka_c = p.k_a[ch], rk_c = p.r_k[ch];
        float r[8], kp[8], Aq[8], bq[8], v[8], ld[8], cl[8]; float run = 0.f;
#pragma unroll
        for (int i = 0; i < 8; ++i) { const size_t o = (row0 + i) * C + ch; r[i] = bf2f(p.R[o]); kp[i] = bf2f(p.K[o]); v[i] = bf2f(p.V[o]); bq[i] = bf2f(p.A[o]); ld[i] = bf2f(p.LD[o]); }
#pragma unroll
        for (int i = 0; i < 8; ++i) { const float k = kp[i], a = bq[i]; float kk = k * kk_c; const float nrm = sqrtf(wave_sum(kk * kk)); kk = kk / fmaxf(nrm, 1e-12f);
            kp[i] = k * (1.f + (a - 1.f) * ka_c); Aq[i] = -kk; bq[i] = kk * a; const float rkc = wave_sum(r[i] * kp[i] * rk_c);
            if (lane == 0) p.rkc[(row0 + i) * 8 + h] = rkc; run += ld[i]; cl[i] = run; }
        WT[wave * 64 + lane] = run;
        __syncthreads();
        float off = 0.f, csL = 0.f;
#pragma unroll
        for (int w2 = 0; w2 < 8; ++w2) { const float t = WT[w2 * 64 + lane]; csL += t; if (w2 < wave) off += t; }
        if (wave == 0) GL[lane] = __expf(csL);
        float aT[8], bhT[8], khT[8];
#pragma unroll
        for (int i = 0; i < 8; ++i) { const float cs = off + cl[i], em = __expf(cs - ld[i]), en = __expf(-cs), ep = __expf(cs), eL = __expf(csL - cs); const int tl = 8 * wave + i;
            const float at = Aq[i] * em; aT[i] = at; bhT[i] = bq[i] * eL; khT[i] = kp[i] * eL;
            At[tl * CK_LD + lane] = (bf16_t)f2bf(at); bt[tl * CK_LD + lane] = (bf16_t)f2bf(bq[i] * en); kt[tl * CK_LD + lane] = (bf16_t)f2bf(kp[i] * en); rt[tl * CK_LD + lane] = (bf16_t)f2bf(r[i] * ep); }
        *(bf16x8*)(AtT + lane * CK_LD + 8 * wave) = pack8((f32x4){aT[0], aT[1], aT[2], aT[3]}, (f32x4){aT[4], aT[5], aT[6], aT[7]});
        *(bf16x8*)(BhT + lane * CK_LD + 8 * wave) = pack8((f32x4){bhT[0], bhT[1], bhT[2], bhT[3]}, (f32x4){bhT[4], bhT[5], bhT[6], bhT[7]});
        *(bf16x8*)(KhT + lane * CK_LD + 8 * wave) = pack8((f32x4){khT[0], khT[1], khT[2], khT[3]}, (f32x4){khT[4], khT[5], khT[6], khT[7]});
        *(bf16x8*)(VT + lane * CK_LD + 8 * wave) = pack8((f32x4){v[0], v[1], v[2], v[3]}, (f32x4){v[4], v[5], v[6], v[7]});
    }
    __syncthreads();
    const int j = 16 * jb + fr; const f32x4 z4 = (f32x4){0.f, 0.f, 0.f, 0.f};
    { f32x4 aN[2] = {z4, z4}, aNT[2] = {z4, z4}, aM[2] = {z4, z4}, aP1[2] = {z4, z4}, aP2[2] = {z4, z4};
      ck_mm(aN, At, bt, jb, ib0, fr, fq); ck_mm(aNT, bt, At, jb, ib0, fr, fq); ck_mm(aM, At, kt, jb, ib0, fr, fq); ck_mm(aP1, rt, bt, jb, ib0, fr, fq); ck_mm(aP2, rt, kt, jb, ib0, fr, fq);
#pragma unroll
      for (int ii = 0; ii < 2; ++ii) { const int i0 = 16 * (ib0 + ii) + 4 * fq; f32x4 t0, nt, mm, p1, p2;
#pragma unroll
          for (int e = 0; e < 4; ++e) { const int i = i0 + e; t0[e] = (i < j ? aN[ii][e] : 0.f) + (i == j ? 1.f : 0.f); nt[e] = j < i ? aNT[ii][e] : 0.f; mm[e] = i < j ? aM[ii][e] : 0.f; p1[e] = i <= j ? aP1[ii][e] : 0.f; p2[e] = i <= j ? aP2[ii][e] : 0.f; }
          *(uint2*)(Ta + j * CK_LD + i0) = ck_pack4(t0); *(uint2*)(NT + j * CK_LD + i0) = ck_pack4(nt); *(uint2*)(Mm + j * CK_LD + i0) = ck_pack4(mm); *(uint2*)(P1 + j * CK_LD + i0) = ck_pack4(p1); *(uint2*)(P2 + j * CK_LD + i0) = ck_pack4(p2); } }
    __syncthreads();
#pragma unroll
    for (int st = 0; st < 4; ++st) { const bf16_t* src = (st & 1) ? Tb : Ta; bf16_t* dst = (st & 1) ? Ta : Tb; f32x4 a2[2] = {z4, z4}; ck_mm(a2, src, NT, jb, ib0, fr, fq);
#pragma unroll
        for (int ii = 0; ii < 2; ++ii) { const int i0 = 16 * (ib0 + ii) + 4 * fq; f32x4 t = a2[ii];
#pragma unroll
            for (int e = 0; e < 4; ++e) t[e] += (i0 + e == j) ? 1.f : 0.f;
            *(uint2*)(dst + j * CK_LD + i0) = ck_pack4(t); }
        __syncthreads(); }
    { f32x4 a1[2] = {z4, z4}, a2[2] = {z4, z4}; ck_mm(a1, AtT, Ta, jb, ib0, fr, fq); ck_mm(a2, VT, Mm, jb, ib0, fr, fq);
#pragma unroll
      for (int ii = 0; ii < 2; ++ii) { const int i0 = 16 * (ib0 + ii) + 4 * fq; *(uint2*)(W1T + j * CK_LD + i0) = ck_pack4(a1[ii]); *(uint2*)(MVT + j * CK_LD + i0) = ck_pack4(a2[ii]); } }
    __syncthreads();
    { f32x4 a1[2] = {z4, z4}; ck_mm(a1, MVT, Ta, jb, ib0, fr, fq);
#pragma unroll
      for (int ii = 0; ii < 2; ++ii) { const int i0 = 16 * (ib0 + ii) + 4 * fq; *(uint2*)(W2T + j * CK_LD + i0) = ck_pack4(a1[ii]); } }
    __syncthreads();
    { f32x4 aQ1[2] = {z4, z4}, aG[2] = {z4, z4}, aQ2[2] = {z4, z4}, aC[2] = {z4, z4};
      ck_mm(aQ1, P1, W1T, jb, ib0, fr, fq); ck_mm(aG, BhT, W1T, jb, ib0, fr, fq); ck_mm(aQ2, P1, W2T, jb, ib0, fr, fq); ck_mm(aQ2, P2, VT, jb, ib0, fr, fq); ck_mm(aC, W2T, BhT, jb, ib0, fr, fq); ck_mm(aC, VT, KhT, jb, ib0, fr, fq);
      bf16_t* gq = GQ + (size_t)unit * 8192; bf16_t* cq = CQ + (size_t)unit * 8192; const float glj = GL[j];
#pragma unroll
      for (int ii = 0; ii < 2; ++ii) { const int i0 = 16 * (ib0 + ii) + 4 * fq; f32x4 g = aG[ii];
#pragma unroll
          for (int e = 0; e < 4; ++e) g[e] += (i0 + e == j) ? glj : 0.f;
          const f32x4 q1 = aQ1[ii] + ck_unpack4(*(const uint2*)(rt + j * CK_LD + i0));
          *(uint2*)(gq + j * 64 + i0) = ck_pack4(g); *(uint2*)(gq + 4096 + j * 64 + i0) = ck_pack4(q1); *(uint2*)(cq + j * 64 + i0) = ck_pack4(aC[ii]); *(uint2*)(cq + 4096 + j * 64 + i0) = ck_pack4(aQ2[ii]); } }
    __syncthreads();
}
__device__ __forceinline__ void ck_sequential(const ScanArgs& p, unsigned char* lds, const bf16_t* GQ, const bf16_t* CQ, int item, int tid) {
    const int chain = item >> 2, q = item & 3, b = chain >> 3, h = chain & 7, wave = __builtin_amdgcn_readfirstlane(tid >> 6), lane = tid & 63, fr = lane & 15, fq = lane >> 4;
    bf16_t* OPS = (bf16_t*)lds;
    bf16_t* HT = (bf16_t*)(lds + 4 * CK_MAT);
    for (int i = tid; i < 2 * 16 * CK_LD / 2; i += NTHREADS_) ((unsigned*)HT)[i] = 0u;
    const size_t ubase = (size_t)chain * 64; const size_t rowbase = (size_t)b * SEQ;
    const int prow0 = tid >> 3, pcol = (tid & 7) * 8;
    const int aoff = wave < 4 ? (4096 + (16 * wave + fr) * 64 + 16 * q + 4 * fq) : ((16 * q + fr) * 64 + 16 * (wave - 4) + 4 * fq);
    typedef unsigned u32x2_ __attribute__((ext_vector_type(2)));
    pg8::u32x4 g0_0, g0_1, g0_2, g0_3, g1_0, g1_1, g1_2, g1_3; u32x2_ ad_0, ad_1, ad_2, ad_3;
#define CK_FETCH(slot, cc) do { const bf16_t* gq = GQ + (ubase + (cc)) * 8192; g0_##slot = *(const pg8::u32x4*)(gq + (size_t)prow0 * 64 + pcol); g1_##slot = *(const pg8::u32x4*)(gq + (size_t)(prow0 + 64) * 64 + pcol); \
        ad_##slot = *(const u32x2_*)(CQ + (ubase + (cc)) * 8192 + aoff); } while (0)
#define CK_STAGE(slot, buf) do { *(pg8::u32x4*)(OPS + (buf) * 2 * 64 * CK_LD + prow0 * CK_LD + pcol) = g0_##slot; *(pg8::u32x4*)(OPS + (buf) * 2 * 64 * CK_LD + 64 * CK_LD + prow0 * CK_LD + pcol) = g1_##slot; } while (0)
    CK_FETCH(0, 0); CK_FETCH(1, 1); CK_FETCH(2, 2); CK_FETCH(3, 3);
    CK_STAGE(0, 0);
    __syncthreads();
#define CK_STEP(cc, slot, nslot) do { const int bi = (cc) & 1; const bf16_t* Gm = OPS + bi * 2 * 64 * CK_LD; const bf16_t* Q1m = Gm + 64 * CK_LD; const bf16_t* HTc = HT + bi * 16 * CK_LD; bf16_t* HTn = HT + (bi ^ 1) * 16 * CK_LD; \
        f32x4 acc = (f32x4){0.f, 0.f, 0.f, 0.f}; \
        if (wave < 4) { _Pragma("unroll") for (int ks = 0; ks < 2; ++ks) acc = __builtin_amdgcn_mfma_f32_16x16x32_bf16(*(const bf16x8*)(HTc + fr * CK_LD + 32 * ks + 8 * fq), *(const bf16x8*)(Q1m + (16 * wave + fr) * CK_LD + 32 * ks + 8 * fq), acc, 0, 0, 0); \
            acc = acc + ck_unpack4((uint2){ad_##slot.x, ad_##slot.y}); \
            *(uint2*)(p.mix + (rowbase + (size_t)(cc) * 64 + 16 * wave + fr) * D + ATT_W + h * 64 + 16 * q + 4 * fq) = ck_pack4(acc); } \
        else { _Pragma("unroll") for (int ks = 0; ks < 2; ++ks) acc = __builtin_amdgcn_mfma_f32_16x16x32_bf16(*(const bf16x8*)(Gm + (16 * (wave - 4) + fr) * CK_LD + 32 * ks + 8 * fq), *(const bf16x8*)(HTc + fr * CK_LD + 32 * ks + 8 * fq), acc, 0, 0, 0); \
            acc = acc + ck_unpack4((uint2){ad_##slot.x, ad_##slot.y}); \
            *(uint2*)(HTn + fr * CK_LD + 16 * (wave - 4) + 4 * fq) = ck_pack4(acc); } \
        if ((cc) + 1 < 64) CK_STAGE(nslot, bi ^ 1); \
        if ((cc) + 4 < 64) CK_FETCH(slot, (cc) + 4); \
        __syncthreads(); } while (0)
    for (int c = 0; c < 64; c += 4) { CK_STEP(c, 0, 1); CK_STEP(c + 1, 1, 2); CK_STEP(c + 2, 2, 3); CK_STEP(c + 3, 3, 0); }
#undef CK_FETCH
#undef CK_STAGE
#undef CK_STEP
}

__device__ __forceinline__ void scan_post(const ScanArgs& p, int idx, int lane) {
    const int m = idx >> 3, h = idx & 7, ch = h * 64 + lane; const size_t o = (size_t)m * C + ch, om = (size_t)m * D + ATT_W + ch;
    const float y = bf2f(p.mix[om]);
    const float mean = wave_sum(y) * (1.f / 64.f); const float d = y - mean; const float var = wave_sum(d * d) * (1.f / 64.f);
    const float yn = d * rsqrtf(var + LNX_EPS) * p.lnx_g[ch] + p.lnx_b[ch];
    p.mix[om] = (bf16_t)f2bf((yn + p.rkc[(size_t)m * 8 + h] * bf2f(p.V[o])) * bf2f(p.G[o]));
}

typedef float f32x16 __attribute__((ext_vector_type(16)));
typedef short s16x4 __attribute__((ext_vector_type(4)));
constexpr int AT_VTS = 196;
__device__ __forceinline__ int crow(int r, int hi) { return (r & 3) + 8 * (r >> 2) + 4 * hi; }
__device__ __forceinline__ void attn_unit(const bf16_t* __restrict__ proj, const float* __restrict__ sinks, bf16_t* __restrict__ mix, bf16_t* vt, int unit, int tid) {
    const int b = unit >> 7, kvh = (unit >> 6) & 1, qb = unit & 63, Q0 = qb * 64;
    const int wave = __builtin_amdgcn_readfirstlane(tid >> 6), lane = tid & 63, c = lane & 31, hi = lane >> 5, g = wave >> 1, half = wave & 1, h = kvh * 4 + g;
    const size_t rowb = (size_t)b * SEQ;
    for (int i = tid; i < 192 * 8; i += 512) { const int kl = i >> 3, ch8 = i & 7; int key = Q0 - 128 + kl; key = key < 0 ? 0 : key;
        const bf16x8 v = *(const bf16x8*)(proj + (rowb + key) * IN_W + 640 + kvh * 64 + ch8 * 8);
#pragma unroll
        for (int e = 0; e < 8; ++e) vt[(ch8 * 8 + e) * AT_VTS + kl] = (bf16_t)v[e]; }
    __syncthreads();
    const int t0 = Q0 + 32 * half; const size_t mq = rowb + t0 + c;
    bf16x8 qf[4];
#pragma unroll
    for (int ks = 0; ks < 4; ++ks) qf[ks] = *(const bf16x8*)(proj + mq * IN_W + h * 64 + 16 * ks + 8 * hi);
    f32x16 p[5];
#pragma unroll
    for (int kb = 0; kb < 5; ++kb) { int key = t0 - 128 + 32 * kb + c; key = key < 0 ? 0 : key; const bf16_t* kp = proj + (rowb + key) * IN_W + 512 + kvh * 64 + 8 * hi;
        f32x16 acc;
#pragma unroll
        for (int r = 0; r < 16; ++r) acc[r] = 0.f;
#pragma unroll
        for (int ks = 0; ks < 4; ++ks) acc = __builtin_amdgcn_mfma_f32_32x32x16_bf16(*(const bf16x8*)(kp + 16 * ks), qf[ks], acc, 0, 0, 0);
        p[kb] = acc; }
    const float slope = exp2f(-(float)(h + 1)), sink = sinks[h];
    float mx = sink;
#pragma unroll
    for (int kb = 0; kb < 5; ++kb)
#pragma unroll
        for (int r = 0; r < 16; ++r) { const int cr = crow(r, hi), dist = c + 128 - 32 * kb - cr, key = t0 - 128 + 32 * kb + cr;
            const float sc = (dist >= 0 && dist < WINDOW && key >= 0) ? p[kb][r] * 0.125f - slope * (float)dist : -1e30f; p[kb][r] = sc; mx = fmaxf(mx, sc); }
    mx = fmaxf(mx, __shfl_xor(mx, 32));
    float l = 0.f;
#pragma unroll
    for (int kb = 0; kb < 5; ++kb)
#pragma unroll
        for (int r = 0; r < 16; ++r) { const float e = __expf(p[kb][r] - mx); p[kb][r] = e; l += e; }
    l += __shfl_xor(l, 32); l += __expf(sink - mx);
    f32x16 o[2];
#pragma unroll
    for (int d = 0; d < 2; ++d)
#pragma unroll
        for (int r = 0; r < 16; ++r) o[d][r] = 0.f;
#pragma unroll
    for (int kb = 0; kb < 5; ++kb)
#pragma unroll
        for (int s2 = 0; s2 < 2; ++s2) {
            pg8::u32x4 pw; pw.x = pg8::cvt_pk_bf16(p[kb][8 * s2 + 0], p[kb][8 * s2 + 1]); pw.y = pg8::cvt_pk_bf16(p[kb][8 * s2 + 2], p[kb][8 * s2 + 3]);
            pw.z = pg8::cvt_pk_bf16(p[kb][8 * s2 + 4], p[kb][8 * s2 + 5]); pw.w = pg8::cvt_pk_bf16(p[kb][8 * s2 + 6], p[kb][8 * s2 + 7]);
            const bf16x8 pf = __builtin_bit_cast(bf16x8, pw);
#pragma unroll
            for (int d = 0; d < 2; ++d) { const bf16_t* vp = vt + (32 * d + c) * AT_VTS + 32 * half + 32 * kb + 16 * s2 + 4 * hi;
                const s16x4 lo = *(const s16x4*)vp, hh = *(const s16x4*)(vp + 8);
                const bf16x8 vf = (bf16x8){lo[0], lo[1], lo[2], lo[3], hh[0], hh[1], hh[2], hh[3]};
                o[d] = __builtin_amdgcn_mfma_f32_32x32x16_bf16(vf, pf, o[d], 0, 0, 0); } }
    const float inv = 1.f / l;
#pragma unroll
    for (int d = 0; d < 2; ++d)
#pragma unroll
        for (int rg = 0; rg < 4; ++rg) { uint2 w; w.x = pg8::cvt_pk_bf16(o[d][4 * rg] * inv, o[d][4 * rg + 1] * inv); w.y = pg8::cvt_pk_bf16(o[d][4 * rg + 2] * inv, o[d][4 * rg + 3] * inv);
            *(uint2*)(mix + mq * D + h * 64 + 32 * d + 8 * rg + 4 * hi) = w; }
    __syncthreads();
}

__device__ __forceinline__ void conv_item(const bf16_t* __restrict__ U, const bf16_t* __restrict__ UP, const float* __restrict__ cw, const float* __restrict__ cb, bf16_t* __restrict__ hid, size_t i) {
    const int t = (int)(i / FF), j = (int)(i % FF);
    const float u0 = bf2f(U[i]), u1 = t >= 1 ? bf2f(U[i - FF]) : 0.f, u2 = t >= 2 ? bf2f(U[i - 2 * FF]) : 0.f;
    const float c = cb[j] + cw[j] * u2 + cw[FF + j] * u1 + cw[2 * FF + j] * u0;
    hid[i] = (bf16_t)f2bf(c * sigmoidf_(c) * bf2f(UP[i]));
}

__device__ __forceinline__ void ffn_fixup(const float* __restrict__ SB, const float* __restrict__ cw, const float* __restrict__ cb, bf16_t* hid, int pm, int tid) {
    const float* s = SB + (size_t)pm * 6 * FF; const float* sp = SB + (size_t)(pm - 1) * 6 * FF; const bool has_prev = (pm % (SEQ / 256)) != 0;
    for (int idx = tid; idx < 2 * FF; idx += NTHREADS_) { const int rr = idx / FF, j = idx % FF;
        const float u0 = s[j], u1 = s[FF + j], ul0 = has_prev ? sp[4 * FF + j] : 0.f, ul1 = has_prev ? sp[5 * FF + j] : 0.f;
        const float c = rr == 0 ? cb[j] + cw[j] * ul0 + cw[FF + j] * ul1 + cw[2 * FF + j] * u0 : cb[j] + cw[j] * ul1 + cw[FF + j] * u0 + cw[2 * FF + j] * u1;
        hid[(size_t)(pm * 256 + rr) * FF + j] = (bf16_t)f2bf(c * sigmoidf_(c) * s[(2 + rr) * FF + j]); }
}

__device__ __forceinline__ void final_row(const bf16_t* __restrict__ xb, float* __restrict__ out, const ssq_t* __restrict__ ss, const float* __restrict__ g, int row, int lane) {
    const float rstd = rsqrtf(ssq_val(ss[row]) * (1.f / D) + RMS_EPS);
    const bf16x8* xr = (const bf16x8*)(xb + (size_t)row * D) + lane; f32x4* orow = (f32x4*)(out + (size_t)row * D) + 2 * lane; const f32x4* gr = (const f32x4*)g + 2 * lane;
#pragma unroll
    for (int j = 0; j < 2; ++j) { const bf16x8 v = xr[64 * j]; const f32x4 g0 = gr[128 * j], g1 = gr[128 * j + 1];
        orow[128 * j] = (f32x4){bf2f((bf16_t)v[0]), bf2f((bf16_t)v[1]), bf2f((bf16_t)v[2]), bf2f((bf16_t)v[3])} * g0 * rstd;
        orow[128 * j + 1] = (f32x4){bf2f((bf16_t)v[4]), bf2f((bf16_t)v[5]), bf2f((bf16_t)v[6]), bf2f((bf16_t)v[7])} * g1 * rstd; }
}

#define XB_TMO      128
#define XB_XCNT(j)  (256  + 64 * (j))
#define XB_XSUB(j)  (1280 + 64 * (j))
#define XB_XGEN(j)  (2304 + 64 * (j))
#define XB_TOP      3328
#define XB_TOPGEN   3392
#define XCD_BAR_WORDS 3456
#define XB_SPIN_CAP (1u << 18)

__device__ __forceinline__ unsigned xb_ld(unsigned* p)              { return __hip_atomic_load(p, __ATOMIC_RELAXED, __HIP_MEMORY_SCOPE_AGENT); }
__device__ __forceinline__ unsigned xb_add(unsigned* p, unsigned v) { return __hip_atomic_fetch_add(p, v, __ATOMIC_RELAXED, __HIP_MEMORY_SCOPE_AGENT); }
__device__ __forceinline__ unsigned xb_xcc_id() { return (unsigned)__builtin_amdgcn_s_getreg((3 << 11) | 20) & 0xFu; }
#define XB_SPIN(cond, bar) do { unsigned _sp = 0; while (cond) { __builtin_amdgcn_s_sleep(1); \
    if ((++_sp & 255u) == 0u) { if (xb_ld(&(bar)[XB_TMO])) break; if (_sp > XB_SPIN_CAP) { atomicAdd(&(bar)[XB_TMO], 1u); break; } } } } while (0)

struct XcdBarrier {
    unsigned* bar; unsigned x;
    volatile __attribute__((address_space(3))) unsigned* st;
};

__device__ __forceinline__ XcdBarrier xcd_barrier_post(unsigned* bar, volatile __attribute__((address_space(3))) unsigned* st) {
    XcdBarrier b; b.bar = bar; b.x = xb_xcc_id(); b.st = st;
    if (threadIdx.x == 0) (void)xb_add(&bar[XB_XCNT(b.x)], 1u);
    return b;
}
__device__ __forceinline__ void xcd_barrier_complete(unsigned* bar, unsigned x, unsigned& nloc, unsigned& nx) {
    const unsigned G = gridDim.x * gridDim.y * gridDim.z;
    unsigned sum, cnt, mine, sp = 0u;
    for (;;) {
        sum = 0u; cnt = 0u; mine = 0u;
#pragma unroll
        for (unsigned j = 0; j < 16; ++j) { const unsigned c = xb_ld(&bar[XB_XCNT(j)]); sum += c; cnt += (c > 0u) ? 1u : 0u; mine = (j == x) ? c : mine; }
        if (sum == G) break;
        __builtin_amdgcn_s_sleep(1);
        if ((++sp & 255u) == 0u) { if (xb_ld(&bar[XB_TMO])) break; if (sp > XB_SPIN_CAP) { atomicAdd(&bar[XB_TMO], 1u); break; } }
    }
    nloc = mine > 0u ? mine : 1u; nx = cnt > 0u ? cnt : 1u;
}

__device__ __forceinline__ void xcd_barrier(const XcdBarrier& b) {
    asm volatile("s_waitcnt vmcnt(0)" ::: "memory");
    __syncthreads();
    if (threadIdx.x == 0) {
        unsigned* bar = b.bar;
        __builtin_amdgcn_s_waitcnt(0);
        unsigned nloc = b.st[0], nx = b.st[1];
        if (nloc == 0u) { xcd_barrier_complete(bar, b.x, nloc, nx); b.st[0] = nloc; b.st[1] = nx; }
        const unsigned old = xb_add(&bar[XB_XSUB(b.x)], 1u);
        const unsigned gen = old / nloc;
        if (old + 1u == (gen + 1u) * nloc) {
            __builtin_amdgcn_fence(__ATOMIC_RELEASE, "agent");
            asm volatile("s_waitcnt vmcnt(0)" ::: "memory");
            const unsigned og = xb_add(&bar[XB_TOP], 1u);
            const unsigned tg = og / nx;
            if (og + 1u == (tg + 1u) * nx) xb_add(&bar[XB_TOPGEN], 1u);
            else XB_SPIN(xb_ld(&bar[XB_TOPGEN]) == tg, bar);
            __builtin_amdgcn_fence(__ATOMIC_ACQUIRE, "agent");
            xb_add(&bar[XB_XGEN(b.x)], 1u);
            asm volatile("s_waitcnt vmcnt(0)" ::: "memory");
        } else {
            XB_SPIN(xb_ld(&bar[XB_XGEN(b.x)]) == gen, bar);
            __builtin_amdgcn_fence(__ATOMIC_ACQUIRE, "agent");
            asm volatile("s_waitcnt vmcnt(0)" ::: "memory");
        }
    }
    __syncthreads();
}

constexpr int NTHREADS = 512, LDS_BYTES = 147456;
struct Args { const float* in[26]; float* out; unsigned char* ws; };
__global__ void __launch_bounds__(NTHREADS, 2) mega_fwd(Args a) {
    extern __shared__ __attribute__((aligned(16))) unsigned char lds[];
    constexpr int MISC_OFF = 131072 + 4096;
    { volatile __attribute__((address_space(3))) unsigned* misc = (volatile __attribute__((address_space(3))) unsigned*)((__attribute__((address_space(3))) unsigned char*)lds + MISC_OFF);
      if (threadIdx.x < 4) misc[threadIdx.x] = 0u; }
    __syncthreads();
    (void)xcd_barrier_post((unsigned*)(a.ws + WS_BAR), (volatile __attribute__((address_space(3))) unsigned*)((__attribute__((address_space(3))) unsigned char*)lds + MISC_OFF));
#define GRID_SYNC() do { XcdBarrier xb_; xb_.bar = (unsigned*)(a.ws + WS_BAR); xb_.x = xb_xcc_id(); xb_.st = (volatile __attribute__((address_space(3))) unsigned*)((__attribute__((address_space(3))) unsigned char*)lds + MISC_OFF); xcd_barrier(xb_); } while (0)
#define LDSP ((PG8_LAS unsigned char*)lds)
    constexpr int XCH_OFF = 131072;
#define OTID() ({ int _t = threadIdx.x; asm volatile("" : "+v"(_t)); _t; })
    const int G = gridDim.x, NGW = G * 8;
    const float* x = a.in[0]; const float* norm1_g = a.in[1]; const float* w_in = a.in[2]; const float* sinks = a.in[3];
    const float* mu = a.in[4]; const float* w0 = a.in[5]; const float* w2 = a.in[6]; const float* a0 = a.in[7];
    const float* a2 = a.in[8]; const float* g2 = a.in[9]; const float* k_k = a.in[10]; const float* k_a = a.in[11];
    const float* r_k = a.in[12]; const float* lnx_g = a.in[13]; const float* lnx_b = a.in[14]; const float* v0 = a.in[15];
    const float* v1 = a.in[16]; const float* v2 = a.in[17]; const float* w_out = a.in[18]; const float* norm2_g = a.in[19];
    const float* wg = a.in[20]; const float* wu = a.in[21]; const float* conv_w = a.in[22]; const float* conv_b = a.in[23];
    const float* wd = a.in[24]; const float* final_g = a.in[25];
    unsigned char* ws = a.ws; float* X = a.out;
    ssq_t* ss = (ssq_t*)(ws + WS_SS);
    bf16_t* XB = (bf16_t*)(ws + WS_XB); bf16_t* PROJ = (bf16_t*)(ws + WS_PROJ); bf16_t* MIX = (bf16_t*)(ws + WS_MIX); bf16_t* HID = (bf16_t*)(ws + WS_HID); bf16_t* VF = (bf16_t*)(ws + WS_VFIRST);
    bf16_t* UT = (bf16_t*)(ws + WS_UTMP); bf16_t* UPT = UT + (size_t)SEQ * FF;

    {
        const int tid = OTID(), lane = tid & 63, wave = tid >> 6, gw = blockIdx.x * 8 + wave;
        float* scr = (float*)lds + wave * (64 * 33 + 16);
        constexpr int I_IN = (D / 64) * (IN_W / 32), I_OUT = (D / 64) * (D / 32), I_G = (D / 64) * (FF / 32), I_DN = (FF / 64) * (D / 32), I_LAYER = I_IN + I_OUT + 2 * I_G + I_DN;
        for (int it = gw; it < 2 * I_LAYER; it += NGW) {
            const int l = it / I_LAYER; int r = it % I_LAYER;
            bf16_t* wl = (bf16_t*)(ws + WS_W + l * W_LAYER); bf16_t* WinT = wl; bf16_t* WoutT = (bf16_t*)((char*)wl + W_IN_SZ); bf16_t* WguT = (bf16_t*)((char*)WoutT + W_OUT_SZ); bf16_t* WdT = (bf16_t*)((char*)WguT + W_GU_SZ);
            if (r < I_IN) { transpose_item(w_in + (size_t)l * D * IN_W, D, IN_W, WinT, norm1_g + l * D, 0, scr, r, lane); continue; } r -= I_IN;
            if (r < I_OUT) { transpose_item(w_out + (size_t)l * D * D, D, D, WoutT, nullptr, 0, scr, r, lane); continue; } r -= I_OUT;
            if (r < I_G) { transpose_item(wg + (size_t)l * D * FF, D, FF, WguT, norm2_g + l * D, 1, scr, r, lane); continue; } r -= I_G;
            if (r < I_G) { transpose_item(wu + (size_t)l * D * FF, D, FF, WguT, norm2_g + l * D, 2, scr, r, lane); continue; } r -= I_G;
            transpose_item(wd + (size_t)l * FF * D, FF, D, WdT, nullptr, 0, scr, r, lane);
        }
        {
            constexpr int I_W2 = 1 * (C / 32), I_G2 = 2 * (C / 32), I_V1 = (C / 64) * 1, I_L = 2 * I_W2 + I_G2;
            for (int it = gw; it < 2 * I_L + I_V1; it += NGW) {
                if (it < 2 * I_L) { const int l = it / I_L; int r = it % I_L; bf16_t* base = (bf16_t*)(ws + WS_LORA + l * LORA_LAYER);
                    if (r < I_W2) { transpose_item(w2 + (size_t)l * 64 * C, 64, C, base, nullptr, 0, scr, r, lane); continue; } r -= I_W2;
                    if (r < I_W2) { transpose_item(a2 + (size_t)l * 64 * C, 64, C, base + 512 * 64, nullptr, 0, scr, r, lane); continue; } r -= I_W2;
                    transpose_item(g2 + (size_t)l * 128 * C, 128, C, base + 2 * 512 * 64, nullptr, 0, scr, r, lane); }
                else transpose_item(v1, C, 32, (bf16_t*)(ws + WS_V1T), nullptr, 0, scr, it - 2 * I_L, lane);
            }
            bf16_t* V2T = (bf16_t*)(ws + WS_V2T);
            for (int i = blockIdx.x * NTHREADS + tid; i < 32 * C; i += G * NTHREADS) { const int j = i / C, ch = i % C; V2T[ch * 32 + j] = (bf16_t)f2bf(v2[i]); }
        }
        for (int m = gw; m < M; m += NGW) x_row_to_bf16(x, XB, ss, m, lane);
    }
    GRID_SYNC();
    for (int l = 0; l < 2; ++l) {
        bf16_t* wl = (bf16_t*)(ws + WS_W + l * W_LAYER); bf16_t* WinT = wl; bf16_t* WoutT = (bf16_t*)((char*)wl + W_IN_SZ); bf16_t* WguT = (bf16_t*)((char*)WoutT + W_OUT_SZ); bf16_t* WdT = (bf16_t*)((char*)WguT + W_GU_SZ);
        ssq_t* ss1 = ss + (size_t)(2 * l) * M; ssq_t* ss2 = ss + (size_t)(2 * l + 1) * M; ssq_t* ss3 = ss + (size_t)(2 * l + 2) * M;
        { pg8::Gemm g{XB, WinT, M, IN_W, D}; pg8::StaticOrder S; S.init(M, IN_W, G, (int)blockIdx.x); pg8::EpiScaleBf16 E{PROJ, IN_W, ss1};
          pg8::gemm_phase<pg8::EpiScaleBf16, pg8::StaticOrder, true, true>(LDSP, g, S, E); }
        GRID_SYNC();
        for (int unit = blockIdx.x; unit < BATCH * 2 * (SEQ / 64); unit += G) attn_unit(PROJ, sinks + l * NH, MIX, (bf16_t*)lds, unit, OTID());
        struct { bf16_t *R, *K, *V, *A, *LD, *G; } p; p.R = (bf16_t*)X; p.K = (bf16_t*)X + (size_t)M * C;     p.V = (bf16_t*)(ws + WS_SI_V); p.A = (bf16_t*)(ws + WS_SI_A); p.LD = (bf16_t*)(ws + WS_SI_LD); p.G = (bf16_t*)(ws + WS_SI_G);
        { Prep2Args q{}; q.proj = PROJ; q.mu = mu + l * SHIFT_W; q.w0 = w0 + l * C; q.a0 = a0 + l * C; q.v0 = v0;
          const bf16_t* lw = (const bf16_t*)(ws + WS_LORA + l * LORA_LAYER); q.W2T = lw; q.A2T = lw + 512 * 64; q.G2T = lw + 2 * 512 * 64; q.V1T = (const bf16_t*)(ws + WS_V1T); q.V2T = (const bf16_t*)(ws + WS_V2T);
          q.vfirst = VF; q.R = p.R; q.K = p.K; q.V = p.V; q.A = p.A; q.LD = p.LD; q.G = p.G; q.layer = l;
          for (int tile = blockIdx.x; tile < M / 64; tile += G) prep_tile(q, lds, tile, OTID()); }
        GRID_SYNC();
        { ScanArgs s{}; s.R = p.R; s.K = p.K; s.V = p.V; s.A = p.A; s.LD = p.LD; s.G = p.G; s.k_k = k_k + l * C; s.k_a = k_a + l * C; s.r_k = r_k + l * C; s.lnx_g = lnx_g + l * C; s.lnx_b = lnx_b + l * C; s.mix = MIX; s.rkc = (float*)(ws + WS_RKC);
          bf16_t* GQ = (bf16_t*)(ws + WS_CKGQ); bf16_t* CQ = (bf16_t*)(ws + WS_CKCQ);
          for (int unit = blockIdx.x; unit < BATCH * NH * 64; unit += G) ck_precompute(s, lds, GQ, CQ, unit, OTID());
          GRID_SYNC();
          for (int item = (int)((blockIdx.x & 7) * (G >> 3) + (blockIdx.x >> 3)); item < BATCH * NH * 4; item += G) ck_sequential(s, lds, GQ, CQ, item, OTID());
          GRID_SYNC();
          { const int tid = OTID(), lane = tid & 63, gw = blockIdx.x * 8 + (tid >> 6); for (int idx = gw; idx < M * NH; idx += NGW) scan_post(s, idx, lane); } }
        GRID_SYNC();
        { pg8::Gemm g{MIX, WoutT, M, D, D}; pg8::StaticOrder S; S.init(M, D, G, (int)blockIdx.x); pg8::EpiResid E{XB, ss2};
          pg8::gemm_phase<pg8::EpiResid, pg8::StaticOrder, true, true>(LDSP, g, S, E); }
        GRID_SYNC();
        { pg8::Gemm g{XB, WguT, M, 2 * FF, D}; pg8::StaticOrder S; S.init(M, 2 * FF, G, (int)blockIdx.x);
          pg8::EpiConvGlu E{HID, ss2, conv_w + (size_t)l * 3 * FF, conv_b + (size_t)l * FF, (float*)(ws + WS_UTMP), (PG8_LAS float*)(LDSP + XCH_OFF), FF};
          pg8::gemm_phase<pg8::EpiConvGlu, pg8::StaticOrder, true, true>(LDSP, g, S, E); }
        GRID_SYNC();
        { pg8::Gemm g{HID, WdT, M, D, FF}; pg8::StaticOrder S; S.init(M, D, G, (int)blockIdx.x); pg8::EpiResid E{XB, ss3};
          { pg8::Unit u; for (int i = 0; S.next(i, u); ++i) ffn_fixup((const float*)(ws + WS_UTMP), conv_w + (size_t)l * 3 * FF, conv_b + (size_t)l * FF, HID, u.pm, OTID());
            asm volatile("s_waitcnt vmcnt(0)" ::: "memory"); __syncthreads(); }
          pg8::gemm_phase<pg8::EpiResid, pg8::StaticOrder, true, true>(LDSP, g, S, E); }
        GRID_SYNC();
    }
    { const int tid = OTID(), lane = tid & 63, gw = blockIdx.x * 8 + (tid >> 6);
    for (int m = gw; m < M; m += NGW) final_row(XB, X, ss + (size_t)4 * M, final_g, m, lane); }
}

extern "C" void kernel_launch(void* const* d_in, const int* in_sizes, int n_in, void* d_out, int out_size, void* d_ws, size_t ws_size, hipStream_t stream) {
    static int grid = 0;
    if (grid == 0) {
        if (n_in != 26 || in_sizes[0] != M * D || out_size != M * D || ws_size < WS_END) { fprintf(stderr, "kernel_launch: unexpected shapes (n_in %d, ws %zu)\n", n_in, ws_size); grid = -1; return; }
        int dev = 0, cus = 0, per_cu = 0;
        if (hipGetDevice(&dev) != hipSuccess || hipDeviceGetAttribute(&cus, hipDeviceAttributeMultiprocessorCount, dev) != hipSuccess) { grid = -1; return; }
        if (hipFuncSetAttribute((const void*)mega_fwd, hipFuncAttributeMaxDynamicSharedMemorySize, LDS_BYTES) != hipSuccess) { fprintf(stderr, "kernel_launch: hipFuncSetAttribute failed\n"); grid = -1; return; }
        if (hipOccupancyMaxActiveBlocksPerMultiprocessor(&per_cu, (const void*)mega_fwd, NTHREADS, LDS_BYTES) != hipSuccess || per_cu < 1) { fprintf(stderr, "kernel_launch: occupancy query failed (%d)\n", per_cu); grid = -1; return; }
        grid = cus;
    }
    if (grid < 0) return;
    (void)hipMemsetAsync((unsigned char*)d_ws + WS_CTL, 0, CTL_BYTES, stream);
    Args a{};
    for (int i = 0; i < 26; ++i) a.in[i] = (const float*)d_in[i];
    a.out = (float*)d_out; a.ws = (unsigned char*)d_ws;
    void* kargs[] = {&a};
    hipError_t e = hipLaunchCooperativeKernel((const void*)mega_fwd, dim3(grid), dim3(NTHREADS), kargs, LDS_BYTES, stream);
    if (e != hipSuccess) fprintf(stderr, "kernel_launch: cooperative launch failed: %s (grid %d)\n", hipGetErrorString(e), grid);
}
```

```cpp
#include <hip/hip_runtime.h>
#include <cstdio>
#include <cstdint>

typedef unsigned short bf16_t;
typedef short bf16x8 __attribute__((ext_vector_type(8)));
typedef float f32x4 __attribute__((ext_vector_type(4)));

constexpr int BATCH = 8, SEQ = 4096, D = 1024, M = BATCH * SEQ;
constexpr int HD = 64, ATT_W = 512, KV_W = 128, C = 512, NH = 8;
constexpr int ATT_IN = 768, SHIFT_W = 1792, IN_W = 2560, FF = 2816;
constexpr int WINDOW = 128;
constexpr float RMS_EPS = 1e-5f, LNX_EPS = 64e-5f;

constexpr size_t MiB = 1u << 20;
constexpr size_t WS_CTL = 0;
typedef unsigned long long ssq_t;
__device__ __forceinline__ ssq_t ssq_fix(float s) { return (ssq_t)(s * 1048576.0f + 0.5f); }
__device__ __forceinline__ float ssq_val(ssq_t v) { return (float)v * (1.0f / 1048576.0f); }
constexpr size_t WS_SS = 0;
constexpr size_t CTL_BYTES = 2 * MiB;
constexpr size_t WS_BAR = 1536 * 1024;
constexpr size_t WS_W = 2 * MiB;
constexpr size_t W_IN_SZ = (size_t)IN_W * D * 2, W_OUT_SZ = (size_t)D * D * 2, W_GU_SZ = (size_t)2 * FF * D * 2, W_DN_SZ = (size_t)D * FF * 2;
constexpr size_t W_LAYER = W_IN_SZ + W_OUT_SZ + W_GU_SZ + W_DN_SZ;
constexpr size_t WS_VFIRST = 52 * MiB, WS_MIX = 84 * MiB, WS_XB = 148 * MiB, WS_PROJ = 212 * MiB;
constexpr size_t WS_SI_R = 148 * MiB, WS_SI_K = 180 * MiB, WS_SI_V = 372 * MiB, WS_SI_A = 404 * MiB, WS_SI_LD = 436 * MiB, WS_SI_G = 468 * MiB;
constexpr size_t WS_HID = 212 * MiB;
constexpr size_t WS_UTMP = 84 * MiB;
constexpr size_t WS_END = 500 * MiB;
static_assert(WS_W + 2 * W_LAYER <= WS_VFIRST, "weights fit");

__device__ __forceinline__ unsigned f2bf(float f) { unsigned u = __builtin_bit_cast(unsigned, f); return (u + 0x7fffu + ((u >> 16) & 1u)) >> 16; }
__device__ __forceinline__ float bf2f(bf16_t h) { return __builtin_bit_cast(float, (unsigned)h << 16); }
__device__ __forceinline__ float wave_sum(float v) {
#pragma unroll
    for (int o = 1; o < 64; o <<= 1) v += __shfl_xor(v, o);
    return v;
}
__device__ __forceinline__ float sigmoidf_(float x) { return 1.f / (1.f + __expf(-x)); }

namespace pg8 {
#define PG8_LAS __attribute__((address_space(3)))
typedef unsigned short bf16_t;
typedef short bf16x8 __attribute__((ext_vector_type(8)));
typedef float f32x4 __attribute__((ext_vector_type(4)));
typedef unsigned u32x4 __attribute__((ext_vector_type(4)));
constexpr int BM = 256, BK = 64, HALF = 128, HTB = HALF * BK * 2  , STAGE_BYTES = 8 * HTB, NXCD = 8, WGM = 8;

__host__ __device__ __forceinline__ int lds_byte(int r, int c) { const int st = (r >> 4) * 2 + (c >> 5), rr = r & 15, cc = c & 31, ob = rr * 64 + cc * 2; return st * 1024 + (ob ^ (((ob >> 9) & 1) << 5)); }
__host__ __device__ __forceinline__ void stage_rc(int b, int& R, int& C) { const int st = b / 1024, sb = b % 1024, swz = sb ^ (((sb >> 9) & 1) << 5); R = (st >> 1) * 16 + swz / 64; C = (st & 1) * 32 + (swz % 64) / 2; }
__host__ __device__ __forceinline__ int perm32(int rho) { const int n = rho >> 4, i = rho & 15; return 8 * (i >> 2) + 4 * n + (i & 3); }

struct Unit { int pm, pn; };
struct Gemm { const bf16_t* A; const bf16_t* Bt; int M, N, K; };

struct StaticOrder {
    int nM, nN, nwg, G, c;
    __host__ __device__ void init(int M, int N, int G_, int c_) { nM = M / BM; nN = N / BM; nwg = nM * nN; G = G_; c = c_; }
    __host__ __device__ bool next(int i, Unit& u) const {
        const long L = (long)i * G + c; if (L >= nwg) return false;
        int wgid = (int)L; { const int q = nwg / NXCD, r = nwg % NXCD, xcd = wgid % NXCD, off = wgid / NXCD; wgid = (xcd < r ? xcd * (q + 1) : r * (q + 1) + (xcd - r) * q) + off; }
        const int nig = WGM * nN, gid = wgid / nig, fm = gid * WGM, gsz = (nM - fm) < WGM ? (nM - fm) : WGM;
        u.pm = fm + ((wgid % nig) % gsz); u.pn = (wgid % nig) / gsz; return true;
    }
    __device__ __forceinline__ void a_ready(const Unit&) const {}
    __device__ __forceinline__ void done(const Unit&) const {}
};
typedef float f32x2_t_ __attribute__((ext_vector_type(2))); typedef __bf16 bf16x2_t_ __attribute__((ext_vector_type(2)));
__device__ __forceinline__ unsigned cvt_pk_bf16(float lo, float hi) { const f32x2_t_ v = {lo, hi}; const bf16x2_t_ b = __builtin_convertvector(v, bf16x2_t_); return __builtin_bit_cast(unsigned, b); }
typedef float f32x2 __attribute__((ext_vector_type(2)));
template <class Epi, class Sched, bool ALIGN_EPI = false, bool SP2 = false>
__device__ __forceinline__ void gemm_phase(PG8_LAS unsigned char* lds, const Gemm g, const Sched& S, const Epi& E) {
    int tid_ = threadIdx.x; asm volatile("" : "+v"(tid_));
    const int tid = tid_, wid = __builtin_amdgcn_readfirstlane(tid >> 6), lane = tid & 63, wr = wid >> 2, wc = wid & 3, fr = lane & 15, fq = lane >> 4;
    const int K = g.K, nt = K / BK;
    unsigned voffA[2], voffB[2];
#pragma unroll
    for (int i = 0; i < 2; ++i) { int R, C; stage_rc(tid * 16 + i * 8192, R, C); const int Rb = Epi::PERM ? ((R & ~31) + perm32(R & 31)) : R;
        voffA[i] = (unsigned)(R * K + C) * 2u; voffB[i] = (unsigned)(Rb * K + C) * 2u; }
    const size_t kstep = (size_t)(BK * 2);
    const size_t hstep = (size_t)HALF * K * 2;
    const size_t tstep = 2 * hstep;
    const unsigned ldsw = (unsigned)wid * 1024u;
    const int aoff = lds_byte(wr * 64 + fr, fq * 8), boff = lds_byte(wc * 32 + fr, fq * 8);
#define PG8_SA(b, h) (((b) * 2 + (h)) * HTB)
#define PG8_SB(b, h) ((4 + (b) * 2 + (h)) * HTB)
#define PG8_STAGE(bufoff, gbase, voff) do { _Pragma("unroll") for (int _i = 0; _i < 2; ++_i) \
        __builtin_amdgcn_global_load_lds((const unsigned*)((const char*)(gbase) + (voff)[_i]), (PG8_LAS unsigned*)(lds + (bufoff) + ldsw + _i * 8192), 16, 0, 0); } while (0)
#define PG8_LDA(dst, b, h) do { _Pragma("unroll") for (int m = 0; m < 4; ++m) _Pragma("unroll") for (int k = 0; k < 2; ++k) dst[m][k] = *(const PG8_LAS bf16x8*)(lds + PG8_SA(b, h) + aoff + m * 2048 + k * 1024); } while (0)
#define PG8_LDB(dst, b, h) do { _Pragma("unroll") for (int n = 0; n < 2; ++n) _Pragma("unroll") for (int k = 0; k < 2; ++k) dst[n][k] = *(const PG8_LAS bf16x8*)(lds + PG8_SB(b, h) + boff + n * 2048 + k * 1024); } while (0)
#define PG8_MMA(ai, bj, At, Bt) do { __builtin_amdgcn_s_setprio(1); _Pragma("unroll") for (int m = 0; m < 4; ++m) _Pragma("unroll") for (int n = 0; n < 2; ++n) _Pragma("unroll") for (int k = 0; k < 2; ++k) \
        acc[ai][bj][m][n] = __builtin_amdgcn_mfma_f32_16x16x32_bf16(Bt[n][k], At[m][k], acc[ai][bj][m][n], 0, 0, 0); __builtin_amdgcn_s_setprio(0); } while (0)
#define PG8_WAIT_V(n) asm volatile("s_waitcnt vmcnt(" #n ")" ::: "memory")
#define PG8_WAIT_L(n) asm volatile("s_waitcnt lgkmcnt(" #n ")" ::: "memory")
#define PG8_BAR __builtin_amdgcn_s_barrier()
#define PG8_SCHED __builtin_amdgcn_sched_barrier(0)
    Unit cur, nxt; int ui = 0;
    if (!S.next(0, cur)) return;
    f32x4 acc[2][2][4][2];
#pragma unroll
    for (int a = 0; a < 2; ++a)
#pragma unroll
        for (int b = 0; b < 2; ++b)
#pragma unroll
            for (int m = 0; m < 4; ++m)
#pragma unroll
                for (int n = 0; n < 2; ++n) acc[a][b][m][n] = (f32x4){0.f, 0.f, 0.f, 0.f};
    bf16x8 At[4][2], B0[2][2], B1[2][2];
    const char* cA = (const char*)g.A + (size_t)cur.pm * tstep; const char* cB = (const char*)g.Bt + (size_t)cur.pn * tstep;
    S.a_ready(cur);
    if constexpr (SP2) {
        PG8_STAGE(PG8_SB(0, 0), cB, voffB); PG8_STAGE(PG8_SB(0, 1), cB + hstep, voffB); PG8_STAGE(PG8_SA(0, 0), cA, voffA); PG8_STAGE(PG8_SA(0, 1), cA + hstep, voffA);
        if (wr == 1) PG8_BAR;
        PG8_WAIT_V(2); PG8_BAR;
        PG8_STAGE(PG8_SB(1, 0), cB + kstep, voffB); PG8_STAGE(PG8_SA(1, 0), cA + kstep, voffA); PG8_STAGE(PG8_SB(1, 1), cB + hstep + kstep, voffB);
        PG8_WAIT_V(6); PG8_BAR;
    } else {
        PG8_STAGE(PG8_SB(0, 0), cB, voffB); PG8_STAGE(PG8_SA(0, 0), cA, voffA); PG8_STAGE(PG8_SB(0, 1), cB + hstep, voffB); PG8_STAGE(PG8_SA(0, 1), cA + hstep, voffA);
        if (wr == 1) PG8_BAR;
        PG8_WAIT_V(4); PG8_BAR;
        PG8_STAGE(PG8_SB(1, 0), cB + kstep, voffB); PG8_STAGE(PG8_SA(1, 0), cA + kstep, voffA); PG8_STAGE(PG8_SB(1, 1), cB + hstep + kstep, voffB);
        PG8_WAIT_V(6); PG8_BAR;
    }
    for (;;) {
        const bool has_next = S.next(ui + 1, nxt);
        const char* nA = has_next ? (const char*)g.A + (size_t)nxt.pm * tstep : cA; const char* nB = has_next ? (const char*)g.Bt + (size_t)nxt.pn * tstep : cB;
        for (int t = 0; t < nt; t += 2) {
            const bool last = (t == nt - 2);
            const char* a1 = cA + (size_t)(t + 1) * kstep;
            const char* a2 = last ? nA : cA + (size_t)(t + 2) * kstep; const char* b2 = last ? nB : cB + (size_t)(t + 2) * kstep;
            const char* a3 = a2 + kstep; const char* b3 = b2 + kstep;
            if (last && has_next) S.a_ready(nxt);
            if constexpr (SP2) {
            PG8_LDB(B0, 0, 0); PG8_LDB(B1, 0, 1); PG8_SCHED; PG8_LDA(At, 0, 0); PG8_STAGE(PG8_SA(1, 1), a1 + hstep, voffA);
            PG8_WAIT_V(8); PG8_WAIT_L(0); PG8_BAR; PG8_MMA(0, 0, At, B0); PG8_MMA(0, 1, At, B1); PG8_BAR; PG8_SCHED;
            PG8_LDA(At, 0, 1); PG8_STAGE(PG8_SB(0, 0), b2, voffB); PG8_STAGE(PG8_SB(0, 1), b2 + hstep, voffB); PG8_STAGE(PG8_SA(0, 0), a2, voffA);
            PG8_WAIT_V(8); PG8_WAIT_L(0); PG8_BAR; PG8_MMA(1, 0, At, B0); PG8_MMA(1, 1, At, B1); PG8_BAR; PG8_SCHED;
            PG8_LDB(B0, 1, 0); PG8_LDB(B1, 1, 1); PG8_SCHED; PG8_LDA(At, 1, 0); PG8_STAGE(PG8_SA(0, 1), a2 + hstep, voffA);
            PG8_WAIT_V(8); PG8_WAIT_L(0); PG8_BAR; PG8_MMA(0, 0, At, B0); PG8_MMA(0, 1, At, B1); PG8_BAR; PG8_SCHED;
            PG8_LDA(At, 1, 1); PG8_STAGE(PG8_SB(1, 0), b3, voffB); PG8_STAGE(PG8_SB(1, 1), b3 + hstep, voffB); PG8_STAGE(PG8_SA(1, 0), a3, voffA);
            PG8_WAIT_V(8); PG8_WAIT_L(0); PG8_BAR; PG8_MMA(1, 0, At, B0); PG8_MMA(1, 1, At, B1); PG8_BAR; PG8_SCHED;
            } else {
            PG8_LDB(B0, 0, 0); PG8_SCHED; PG8_LDA(At, 0, 0); PG8_STAGE(PG8_SA(1, 1), a1 + hstep, voffA);
            PG8_WAIT_L(8); PG8_BAR; PG8_WAIT_L(0); PG8_MMA(0, 0, At, B0); PG8_BAR; PG8_SCHED;
            PG8_LDB(B1, 0, 1); PG8_STAGE(PG8_SB(0, 0), b2, voffB);
            PG8_BAR; PG8_WAIT_L(0); PG8_MMA(0, 1, At, B1); PG8_BAR;
            PG8_LDA(At, 0, 1); PG8_STAGE(PG8_SA(0, 0), a2, voffA);
            PG8_BAR; PG8_WAIT_L(0); PG8_MMA(1, 0, At, B0); PG8_BAR; PG8_SCHED;
            PG8_STAGE(PG8_SB(0, 1), b2 + hstep, voffB);
            PG8_WAIT_V(6); PG8_BAR; PG8_MMA(1, 1, At, B1); PG8_BAR;
            PG8_LDB(B0, 1, 0); PG8_SCHED; PG8_LDA(At, 1, 0); PG8_STAGE(PG8_SA(0, 1), a2 + hstep, voffA);
            PG8_WAIT_L(8); PG8_BAR; PG8_WAIT_L(0); PG8_MMA(0, 0, At, B0); PG8_BAR; PG8_SCHED;
            PG8_LDB(B1, 1, 1); PG8_STAGE(PG8_SB(1, 0), b3, voffB);
            PG8_BAR; PG8_WAIT_L(0); PG8_MMA(0, 1, At, B1); PG8_BAR;
            PG8_LDA(At, 1, 1); PG8_STAGE(PG8_SA(1, 0), a3, voffA);
            PG8_BAR; PG8_WAIT_L(0); PG8_MMA(1, 0, At, B0); PG8_BAR; PG8_SCHED;
            PG8_STAGE(PG8_SB(1, 1), b3 + hstep, voffB);
            PG8_WAIT_V(6); PG8_BAR; PG8_MMA(1, 1, At, B1); PG8_BAR;
            }
        }
        if constexpr (ALIGN_EPI) { if (wr == 0) PG8_BAR; }
        if constexpr (!Epi::AFTER_DRAIN) { E(acc, cur, wr, wc, fr, fq); S.done(cur); }
        if (!has_next) break;
#pragma unroll
        for (int a = 0; a < 2; ++a)
#pragma unroll
            for (int b = 0; b < 2; ++b)
#pragma unroll
                for (int m = 0; m < 4; ++m)
#pragma unroll
                    for (int n = 0; n < 2; ++n) acc[a][b][m][n] = (f32x4){0.f, 0.f, 0.f, 0.f};
        cur = nxt; cA = nA; cB = nB; ++ui;
        if constexpr (ALIGN_EPI) { if (wr == 1) PG8_BAR; }
    }
    PG8_WAIT_V(0);
    if constexpr (!ALIGN_EPI) { if (wr == 0) PG8_BAR; }
    PG8_BAR;
    if constexpr (Epi::AFTER_DRAIN) { E.fused(acc, cur, wr, wc, fr, fq, lds, wid, lane); S.done(cur); }
#undef PG8_SA
#undef PG8_SB
#undef PG8_STAGE
#undef PG8_LDA
#undef PG8_LDB
#undef PG8_MMA
#undef PG8_WAIT_V
#undef PG8_WAIT_L
#undef PG8_BAR
#undef PG8_SCHED
}

constexpr int DM_ = 1024; constexpr float RMS_EPS_ = 1e-5f;
typedef unsigned long long ssq_t;
struct EpiScaleBf16 {
    static constexpr bool PERM = true, AFTER_DRAIN = false;
    bf16_t* O; int ldc; const ssq_t* ss;
    __device__ __forceinline__ void operator()(const f32x4 (&acc)[2][2][4][2], const Unit& u, int wr, int wc, int fr, int fq) const {
        const int row0 = u.pm * BM + wr * 64 + fr, col0 = u.pn * BM + wc * 32 + 8 * fq;
        float rsv[2][4];
#pragma unroll
        for (int ai = 0; ai < 2; ++ai)
#pragma unroll
            for (int m = 0; m < 4; ++m) rsv[ai][m] = (float)ss[row0 + ai * HALF + m * 16] * (1.0f / 1048576.0f);
#pragma unroll
        for (int ai = 0; ai < 2; ++ai)
#pragma unroll
            for (int m = 0; m < 4; ++m) { const int row = row0 + ai * HALF + m * 16; const float rs = __builtin_amdgcn_rsqf(rsv[ai][m] * (1.0f / DM_) + RMS_EPS_); bf16_t* rowp = O + (size_t)row * ldc + col0;
#pragma unroll
                for (int bj = 0; bj < 2; ++bj) { const f32x4 v0 = acc[ai][bj][m][0] * rs, v1 = acc[ai][bj][m][1] * rs;
                    u32x4 w; w.x = cvt_pk_bf16(v0[0], v0[1]); w.y = cvt_pk_bf16(v0[2], v0[3]); w.z = cvt_pk_bf16(v1[0], v1[1]); w.w = cvt_pk_bf16(v1[2], v1[3]);
                    *(u32x4*)(rowp + bj * HALF) = w; } }
    }
};
struct EpiResid {
    static constexpr bool PERM = true, AFTER_DRAIN = false;
    bf16_t* xb; ssq_t* ss_out;
    __device__ __forceinline__ void operator()(const f32x4 (&acc)[2][2][4][2], const Unit& u, int wr, int wc, int fr, int fq) const {
        const int row0 = u.pm * BM + wr * 64 + fr, col0 = u.pn * BM + wc * 32 + 8 * fq;
#pragma unroll
        for (int ai = 0; ai < 2; ++ai) {
            u32x4 bs[4][2];
#pragma unroll
            for (int m = 0; m < 4; ++m)
#pragma unroll
                for (int bj = 0; bj < 2; ++bj) bs[m][bj] = *(const u32x4*)(xb + (size_t)(row0 + ai * HALF + m * 16) * DM_ + col0 + bj * HALF);
#pragma unroll
            for (int m = 0; m < 4; ++m) { const int row = row0 + ai * HALF + m * 16; bf16_t* rp = xb + (size_t)row * DM_ + col0; float sq = 0.f;
#pragma unroll
                for (int bj = 0; bj < 2; ++bj) { const u32x4 b = bs[m][bj]; u32x4 w;
#pragma unroll
                    for (int hh = 0; hh < 2; ++hh) { const unsigned b0 = hh == 0 ? b.x : b.z, b1 = hh == 0 ? b.y : b.w; const f32x4 a4 = acc[ai][bj][m][hh];
                        const float x0 = __builtin_bit_cast(float, b0 << 16) + a4[0], x1 = __builtin_bit_cast(float, b0 & 0xffff0000u) + a4[1], x2 = __builtin_bit_cast(float, b1 << 16) + a4[2], x3 = __builtin_bit_cast(float, b1 & 0xffff0000u) + a4[3];
                        const unsigned w0 = cvt_pk_bf16(x0, x1), w1 = cvt_pk_bf16(x2, x3);
                        if (hh == 0) { w.x = w0; w.y = w1; } else { w.z = w0; w.w = w1; }
                        const float r0 = __builtin_bit_cast(float, w0 << 16), r1 = __builtin_bit_cast(float, w0 & 0xffff0000u), r2 = __builtin_bit_cast(float, w1 << 16), r3 = __builtin_bit_cast(float, w1 & 0xffff0000u);
                        sq += (r0 * r0 + r1 * r1) + (r2 * r2 + r3 * r3); }
                    *(u32x4*)(rp + bj * HALF) = w; }
                sq += __shfl_xor(sq, 16); sq += __shfl_xor(sq, 32);
                if (fq == 0) atomicAdd(ss_out + row, (ssq_t)(sq * 1048576.0f + 0.5f)); }
        }
    }
};
struct EpiGateUpTmp {
    static constexpr bool PERM = true, AFTER_DRAIN = false;
    bf16_t* U; bf16_t* UP; const ssq_t* ss; int ff;
    __device__ __forceinline__ void operator()(const f32x4 (&acc)[2][2][4][2], const Unit& u, int wr, int wc, int fr, int fq) const {
        const int row0 = u.pm * BM + wr * 64 + fr, col0 = u.pn * HALF + wc * 32 + 8 * fq;
        float rsv[2][4];
#pragma unroll
        for (int ai = 0; ai < 2; ++ai)
#pragma unroll
            for (int m = 0; m < 4; ++m) rsv[ai][m] = (float)ss[row0 + ai * HALF + m * 16] * (1.0f / 1048576.0f);
#pragma unroll
        for (int ai = 0; ai < 2; ++ai)
#pragma unroll
            for (int m = 0; m < 4; ++m) { const int row = row0 + ai * HALF + m * 16; const float rs = __builtin_amdgcn_rsqf(rsv[ai][m] * (1.0f / DM_) + RMS_EPS_); const size_t o = (size_t)row * ff + col0;
#pragma unroll
                for (int bj = 0; bj < 2; ++bj) { const f32x4 v0 = acc[ai][bj][m][0] * rs, v1 = acc[ai][bj][m][1] * rs;
                    u32x4 w; w.x = cvt_pk_bf16(v0[0], v0[1]); w.y = cvt_pk_bf16(v0[2], v0[3]); w.z = cvt_pk_bf16(v1[0], v1[1]); w.w = cvt_pk_bf16(v1[2], v1[3]);
                    *(u32x4*)((bj == 0 ? U : UP) + o) = w; } }
    }
};
template <int CTRL> __device__ __forceinline__ float dpp1(float x) { return __builtin_bit_cast(float, __builtin_amdgcn_update_dpp(0, __builtin_bit_cast(int, x), CTRL, 0xF, 0xF, true)); }
template <int CTRL> __device__ __forceinline__ f32x4 dpp4(const f32x4 x) { return (f32x4){dpp1<CTRL>(x.x), dpp1<CTRL>(x.y), dpp1<CTRL>(x.z), dpp1<CTRL>(x.w)}; }
struct EpiConvGlu {
    static constexpr bool PERM = true, AFTER_DRAIN = false;
    bf16_t* HID; const ssq_t* ss; const float* cw; const float* cb; float* SB; PG8_LAS float* xch; int ff;
    __device__ __forceinline__ void operator()(const f32x4 (&acc)[2][2][4][2], const Unit& u, int wr, int wc, int fr, int fq) const {
        const int row0 = u.pm * BM + wr * 64 + fr, cl = wc * 32 + 8 * fq, jcol = u.pn * HALF + cl;
        float rs[2][4];
#pragma unroll
        for (int ai = 0; ai < 2; ++ai)
#pragma unroll
            for (int m = 0; m < 4; ++m) rs[ai][m] = (float)ss[row0 + ai * HALF + m * 16] * (1.0f / 1048576.0f);
        f32x4 w0[2], w1[2], w2[2], bb[2];
#pragma unroll
        for (int n = 0; n < 2; ++n) { w0[n] = *(const f32x4*)(cw + jcol + 4 * n); w1[n] = *(const f32x4*)(cw + ff + jcol + 4 * n); w2[n] = *(const f32x4*)(cw + 2 * ff + jcol + 4 * n); bb[n] = *(const f32x4*)(cb + jcol + 4 * n); }
#pragma unroll
        for (int ai = 0; ai < 2; ++ai)
#pragma unroll
            for (int m = 0; m < 4; ++m) rs[ai][m] = __builtin_amdgcn_rsqf(rs[ai][m] * (1.0f / DM_) + RMS_EPS_);
        if (fr >= 14) {
#pragma unroll
            for (int ai = 0; ai < 2; ++ai)
#pragma unroll
                for (int n = 0; n < 2; ++n) *(PG8_LAS f32x4*)(xch + ((2 * ai + wr) * 2 + (fr - 14)) * HALF + cl + 4 * n) = acc[ai][0][3][n] * rs[ai][3];
        }
        asm volatile("s_waitcnt lgkmcnt(0)" ::: "memory"); __builtin_amdgcn_s_barrier(); asm volatile("" ::: "memory");
        float* sbp = SB + (size_t)u.pm * 6 * ff + jcol;
#pragma unroll
        for (int ai = 0; ai < 2; ++ai) {
            const int q = 2 * ai + wr;
            f32x4 X[2];
#pragma unroll
            for (int n = 0; n < 2; ++n) { X[n] = (f32x4){0.f, 0.f, 0.f, 0.f}; if (q > 0 && fr >= 14) X[n] = *(const PG8_LAS f32x4*)(xch + ((q - 1) * 2 + (fr - 14)) * HALF + cl + 4 * n); }
#pragma unroll
            for (int m = 0; m < 4; ++m) { const int row = row0 + ai * HALF + m * 16;
                pg8::u32x4 hw;
#pragma unroll
                for (int n = 0; n < 2; ++n) {
                    const f32x4 cur = acc[ai][0][m][n] * rs[ai][m], up = acc[ai][1][m][n] * rs[ai][m];
                    const f32x4 P = (m > 0) ? acc[ai][0][m > 0 ? m - 1 : 0][n] * rs[ai][m > 0 ? m - 1 : 0] : X[n];
                    const f32x4 a1 = dpp4<0x121>(cur), b1 = dpp4<0x121>(P), a2 = dpp4<0x122>(cur), b2 = dpp4<0x122>(P);
                    f32x4 p1, p2;
#pragma unroll
                    for (int e = 0; e < 4; ++e) { p1[e] = fr == 0 ? b1[e] : a1[e]; p2[e] = fr < 2 ? b2[e] : a2[e]; }
                    const f32x4 c = bb[n] + w0[n] * p2 + w1[n] * p1 + w2[n] * cur;
                    f32x4 hv;
#pragma unroll
                    for (int e = 0; e < 4; ++e) hv[e] = c[e] * __builtin_amdgcn_rcpf(1.f + __expf(-c[e])) * up[e];
                    if (n == 0) { hw.x = cvt_pk_bf16(hv[0], hv[1]); hw.y = cvt_pk_bf16(hv[2], hv[3]); } else { hw.z = cvt_pk_bf16(hv[0], hv[1]); hw.w = cvt_pk_bf16(hv[2], hv[3]); }
                    if (q == 0 && m == 0 && fr < 2) { *(f32x4*)(sbp + (size_t)fr * ff + 4 * n) = cur; *(f32x4*)(sbp + (size_t)(2 + fr) * ff + 4 * n) = up; }
                    if (q == 3 && m == 3 && fr >= 14) *(f32x4*)(sbp + (size_t)(4 + fr - 14) * ff + 4 * n) = cur;
                }
                *(pg8::u32x4*)(HID + (size_t)row * ff + jcol) = hw; }
        }
    }
};
}

#define LAS __attribute__((address_space(3)))
__device__ __forceinline__ void transpose_item(const float* __restrict__ W, int K, int N, bf16_t* __restrict__ Wt, const float* __restrict__ g, int mode, float* scr, int item, int lane) {
    const int nblk = N / 32, kb = item / nblk, nb = item % nblk, k0 = 64 * kb, n0 = 32 * nb;
    int np0 = n0; if (mode == 1) np0 = 256 * (n0 / 128) + (n0 % 128); else if (mode == 2) np0 = 256 * (n0 / 128) + 128 + (n0 % 128);
#pragma unroll 8
    for (int i = 0; i < 32; ++i) { const int kk = 2 * i + (lane >> 5); scr[kk * 33 + (lane & 31)] = W[(size_t)(k0 + kk) * N + n0 + (lane & 31)] * (g ? g[k0 + kk] : 1.f); }
    __builtin_amdgcn_fence(__ATOMIC_RELEASE, "wavefront"); __builtin_amdgcn_wave_barrier(); __builtin_amdgcn_fence(__ATOMIC_ACQUIRE, "wavefront");
    const int c = lane & 7;
#pragma unroll
    for (int j = 0; j < 4; ++j) { const int n = (lane >> 3) + 8 * j; const float* sp = scr + (8 * c) * 33 + n;
        uint4 o; o.x = f2bf(sp[0]) | (f2bf(sp[33]) << 16); o.y = f2bf(sp[2 * 33]) | (f2bf(sp[3 * 33]) << 16); o.z = f2bf(sp[4 * 33]) | (f2bf(sp[5 * 33]) << 16); o.w = f2bf(sp[6 * 33]) | (f2bf(sp[7 * 33]) << 16);
        *(uint4*)(Wt + (size_t)(np0 + n) * K + k0 + 8 * c) = o; }
    __builtin_amdgcn_fence(__ATOMIC_RELEASE, "wavefront"); __builtin_amdgcn_wave_barrier(); __builtin_amdgcn_fence(__ATOMIC_ACQUIRE, "wavefront");
}
__device__ __forceinline__ void x_row_to_bf16(const float* __restrict__ x, bf16_t* __restrict__ xb, ssq_t* __restrict__ ss, int row, int lane) {
    const f32x4* xr = (const f32x4*)(x + (size_t)row * D) + lane; float s = 0.f;
#pragma unroll
    for (int j = 0; j < 4; ++j) { const f32x4 v = xr[64 * j]; s += v.x * v.x + v.y * v.y + v.z * v.z + v.w * v.w;
        unsigned long long o = (unsigned long long)(f2bf(v.x) | (f2bf(v.y) << 16)) | ((unsigned long long)(f2bf(v.z) | (f2bf(v.w) << 16)) << 32);
        ((unsigned long long*)(xb + (size_t)row * D))[lane + 64 * j] = o; }
    s = wave_sum(s); if (lane == 0) ss[row] = ssq_fix(s);
}

struct PrepArgs {
    const bf16_t* proj; const float* mu; const float* w0; const float* w2; const float* a0; const float* a2; const float* g2;
    const float* v0; const float* v1; const float* v2; bf16_t* vfirst; int layer; int pad;
    bf16_t *R, *K, *V, *A, *LD, *G;
};
__device__ __forceinline__ void prep_group(const PrepArgs& p, float (*rest)[SHIFT_W], float (*vlo)[32], int grp, int tid) {
    const int m0 = grp * 4;
    for (int i = tid; i < 4 * SHIFT_W; i += 512) {
        const int tk = i / SHIFT_W, c = i % SHIFT_W, m = m0 + tk, t = m % SEQ;
        const float u = bf2f(p.proj[(size_t)m * IN_W + ATT_IN + c]);
        const float up = t > 0 ? bf2f(p.proj[(size_t)(m - 1) * IN_W + ATT_IN + c]) : 0.f;
        float v = u + (up - u) * p.mu[c];
        if (c >= 1536 && c < 1600) v = tanhf(v); else if (c >= 1664) v = sigmoidf_(v);
        rest[tk][c] = v;
    }
    __syncthreads();
    if (p.layer > 0 && tid < 128) { const int tk = tid >> 5, j = tid & 31; float s = 0.f; for (int c = 0; c < C; ++c) s += rest[tk][1024 + c] * p.v1[c * 32 + j]; vlo[tk][j] = s; }
    __syncthreads();
    const int c = tid;
    float wp[4], ap[4], gp[4];
#pragma unroll
    for (int tk = 0; tk < 4; ++tk) { wp[tk] = p.w0[c]; ap[tk] = p.a0[c]; gp[tk] = 0.f; }
    for (int k = 0; k < 64; ++k) { const float w = p.w2[k * C + c], a = p.a2[k * C + c];
#pragma unroll
        for (int tk = 0; tk < 4; ++tk) { wp[tk] += rest[tk][1536 + k] * w; ap[tk] += rest[tk][1600 + k] * a; } }
    for (int k = 0; k < 128; ++k) { const float g = p.g2[k * C + c];
#pragma unroll
        for (int tk = 0; tk < 4; ++tk) gp[tk] += rest[tk][1664 + k] * g; }
#pragma unroll
    for (int tk = 0; tk < 4; ++tk) {
        const size_t o = (size_t)(m0 + tk) * C + c;
        const float x = -wp[tk];
        const float sp = fmaxf(x, 0.f) + log1pf(__expf(-fabsf(x)));
        const float wraw = -sp - 0.5f;
        const float ld = -__expf(wraw);
        const float a = sigmoidf_(ap[tk]);
        float v = rest[tk][1024 + c];
        if (p.layer == 0) p.vfirst[o] = (bf16_t)f2bf(v);
        else { float s = p.v0[c]; for (int j = 0; j < 32; ++j) s += vlo[tk][j] * p.v2[j * C + c]; const float vf = bf2f(p.vfirst[o]); v = v + (vf - v) * sigmoidf_(s); }
        p.R[o] = (bf16_t)f2bf(rest[tk][c]); p.K[o] = (bf16_t)f2bf(rest[tk][512 + c]); p.V[o] = (bf16_t)f2bf(v);
        p.A[o] = (bf16_t)f2bf(a); p.LD[o] = (bf16_t)f2bf(ld); p.G[o] = (bf16_t)f2bf(gp[tk]);
    }
    __syncthreads();
}

constexpr size_t WS_LORA = 50 * MiB;
constexpr size_t LORA_LAYER = 256 * 1024, WS_V1T = WS_LORA + 2 * LORA_LAYER, WS_V2T = WS_V1T + 32 * 1024;
constexpr int PR_ACT_LD = 264, PR_VLO_LD = 40, PR_SG_LD = 520, PR_ACT_OFF = 0, PR_VLO_OFF = 64 * PR_ACT_LD * 2, PR_SG_OFF = PR_VLO_OFF + 64 * PR_VLO_LD * 2;
struct Prep2Args {
    const bf16_t* proj; const float* mu; const float* w0; const float* a0; const float* v0;
    const bf16_t *W2T, *A2T, *G2T, *V1T, *V2T; bf16_t* vfirst; bf16_t *R, *K, *V, *A, *LD, *G; int layer; int pad;
};
__device__ __forceinline__ f32x4 bfx4_lo(const bf16x8 v) { return (f32x4){bf2f((bf16_t)v[0]), bf2f((bf16_t)v[1]), bf2f((bf16_t)v[2]), bf2f((bf16_t)v[3])}; }
__device__ __forceinline__ f32x4 bfx4_hi(const bf16x8 v) { return (f32x4){bf2f((bf16_t)v[4]), bf2f((bf16_t)v[5]), bf2f((bf16_t)v[6]), bf2f((bf16_t)v[7])}; }
__device__ __forceinline__ bf16x8 pack8(const f32x4 a, const f32x4 b) { pg8::u32x4 w; w.x = pg8::cvt_pk_bf16(a[0], a[1]); w.y = pg8::cvt_pk_bf16(a[2], a[3]); w.z = pg8::cvt_pk_bf16(b[0], b[1]); w.w = pg8::cvt_pk_bf16(b[2], b[3]); return __builtin_bit_cast(bf16x8, w); }
__device__ __forceinline__ void shift8(const bf16_t* __restrict__ proj, const float* __restrict__ mu, size_t m, int t, int col, int mi, f32x4& lo, f32x4& hi) {
    const bf16x8 cur = *(const bf16x8*)(proj + m * IN_W + col);
    bf16x8 prv; if (t > 0) prv = *(const bf16x8*)(proj + (m - 1) * IN_W + col); else prv = (bf16x8){0, 0, 0, 0, 0, 0, 0, 0};
    const f32x4 m0 = *(const f32x4*)(mu + mi), m1 = *(const f32x4*)(mu + mi + 4);
    const f32x4 c0 = bfx4_lo(cur), c1 = bfx4_hi(cur), p0 = bfx4_lo(prv), p1 = bfx4_hi(prv);
    lo = c0 + (p0 - c0) * m0; hi = c1 + (p1 - c1) * m1;
}
__device__ __forceinline__ void prep_tile(const Prep2Args& p, unsigned char* lds, int tile, int tid) {
    const int m0 = tile * 64, wave = __builtin_amdgcn_readfirstlane(tid >> 6), lane = tid & 63, fr = lane & 15, fq = lane >> 4;
    bf16_t* ACT = (bf16_t*)(lds + PR_ACT_OFF); bf16_t* VLO = (bf16_t*)(lds + PR_VLO_OFF); bf16_t* SG = (bf16_t*)(lds + PR_SG_OFF);
#pragma unroll
    for (int it = 0; it < 4; ++it) { const int i = tid + 512 * it, tk = i >> 5, cc = i & 31; const size_t m = (size_t)m0 + tk; const int t = (int)(m % SEQ);
        f32x4 lo, hi; shift8(p.proj, p.mu, m, t, 2304 + 8 * cc, 1536 + 8 * cc, lo, hi);
        if (cc < 8) {
#pragma unroll
            for (int e = 0; e < 4; ++e) { lo[e] = 2.f * sigmoidf_(2.f * lo[e]) - 1.f; hi[e] = 2.f * sigmoidf_(2.f * hi[e]) - 1.f; } }
        else if (cc >= 16) {
#pragma unroll
            for (int e = 0; e < 4; ++e) { lo[e] = sigmoidf_(lo[e]); hi[e] = sigmoidf_(hi[e]); } }
        *(bf16x8*)(ACT + tk * PR_ACT_LD + 8 * cc) = pack8(lo, hi); }
    if (p.layer > 0) {
        const int tb = wave >> 1, jb = wave & 1; const size_t m = (size_t)m0 + 16 * tb + fr; const int t = (int)(m % SEQ);
        f32x4 acc = (f32x4){0.f, 0.f, 0.f, 0.f};
#pragma unroll 4
        for (int ks = 0; ks < 16; ++ks) { f32x4 lo, hi; shift8(p.proj, p.mu, m, t, 1792 + 32 * ks + 8 * fq, 1024 + 32 * ks + 8 * fq, lo, hi);
            const bf16x8 wf = *(const bf16x8*)(p.V1T + (size_t)(16 * jb + fr) * C + 32 * ks + 8 * fq);
            acc = __builtin_amdgcn_mfma_f32_16x16x32_bf16(wf, pack8(lo, hi), acc, 0, 0, 0); }
        uint2 w; w.x = pg8::cvt_pk_bf16(acc[0], acc[1]); w.y = pg8::cvt_pk_bf16(acc[2], acc[3]);
        *(uint2*)(VLO + (16 * tb + fr) * PR_VLO_LD + 16 * jb + 4 * fq) = w;
    }
    __syncthreads();
    const int ch0 = 64 * wave;
#pragma unroll
    for (int arr = 0; arr < 3; ++arr) {
        const int K0 = arr == 0 ? 0 : (arr == 1 ? 64 : 128), KL = arr == 2 ? 128 : 64; const bf16_t* WT = arr == 0 ? p.W2T : (arr == 1 ? p.A2T : p.G2T);
        f32x4 acc[4][4];
#pragma unroll
        for (int tb = 0; tb < 4; ++tb)
#pragma unroll
            for (int cb = 0; cb < 4; ++cb) acc[tb][cb] = (f32x4){0.f, 0.f, 0.f, 0.f};
#pragma unroll
        for (int ks = 0; ks < KL / 32; ++ks) { bf16x8 wf[4], af[4];
#pragma unroll
            for (int cb = 0; cb < 4; ++cb) wf[cb] = *(const bf16x8*)(WT + (size_t)(ch0 + 16 * cb + fr) * KL + 32 * ks + 8 * fq);
#pragma unroll
            for (int tb = 0; tb < 4; ++tb) af[tb] = *(const bf16x8*)(ACT + (16 * tb + fr) * PR_ACT_LD + K0 + 32 * ks + 8 * fq);
#pragma unroll
            for (int tb = 0; tb < 4; ++tb)
#pragma unroll
                for (int cb = 0; cb < 4; ++cb) acc[tb][cb] = __builtin_amdgcn_mfma_f32_16x16x32_bf16(wf[cb], af[tb], acc[tb][cb], 0, 0, 0); }
        bf16_t* OUT = arr == 0 ? p.LD : (arr == 1 ? p.A : p.G);
#pragma unroll
        for (int cb = 0; cb < 4; ++cb) { const int ch = ch0 + 16 * cb + 4 * fq;
            f32x4 bias = (f32x4){0.f, 0.f, 0.f, 0.f}; if (arr == 0) bias = *(const f32x4*)(p.w0 + ch); else if (arr == 1) bias = *(const f32x4*)(p.a0 + ch);
#pragma unroll
            for (int tb = 0; tb < 4; ++tb) { f32x4 x = acc[tb][cb] + bias;
                if (arr == 0) {
#pragma unroll
                    for (int e = 0; e < 4; ++e) { const float z = -x[e]; const float sp = fmaxf(z, 0.f) + __logf(1.f + __expf(-fabsf(z))); x[e] = -__expf(-sp - 0.5f); } }
                else if (arr == 1) {
#pragma unroll
                    for (int e = 0; e < 4; ++e) x[e] = sigmoidf_(x[e]); }
                uint2 w; w.x = pg8::cvt_pk_bf16(x[0], x[1]); w.y = pg8::cvt_pk_bf16(x[2], x[3]);
                *(uint2*)(OUT + ((size_t)m0 + 16 * tb + fr) * C + ch) = w; } }
    }
    if (p.layer > 0) {
        bf16x8 af[4];
#pragma unroll
        for (int tb = 0; tb < 4; ++tb) af[tb] = *(const bf16x8*)(VLO + (16 * tb + fr) * PR_VLO_LD + 8 * fq);
#pragma unroll
        for (int cb = 0; cb < 4; ++cb) { const int ch = ch0 + 16 * cb + 4 * fq; const bf16x8 wf = *(const bf16x8*)(p.V2T + (size_t)(ch0 + 16 * cb + fr) * 32 + 8 * fq); const f32x4 bias = *(const f32x4*)(p.v0 + ch);
#pragma unroll
            for (int tb = 0; tb < 4; ++tb) { f32x4 x = __builtin_amdgcn_mfma_f32_16x16x32_bf16(wf, af[tb], (f32x4){0.f, 0.f, 0.f, 0.f}, 0, 0, 0) + bias;
                uint2 w; w.x = pg8::cvt_pk_bf16(sigmoidf_(x[0]), sigmoidf_(x[1])); w.y = pg8::cvt_pk_bf16(sigmoidf_(x[2]), sigmoidf_(x[3]));
                *(uint2*)(SG + (16 * tb + fr) * PR_SG_LD + ch) = w; } }
    }
    __syncthreads();
#pragma unroll
    for (int sec = 0; sec < 3; ++sec) { bf16_t* OUT = sec == 0 ? p.R : (sec == 1 ? p.K : p.V);
#pragma unroll 4
        for (int it = 0; it < 8; ++it) { const int i = tid + 512 * it, tk = i >> 6, cc = i & 63; const size_t m = (size_t)m0 + tk; const int t = (int)(m % SEQ);
            f32x4 lo, hi; shift8(p.proj, p.mu, m, t, 768 + 512 * sec + 8 * cc, 512 * sec + 8 * cc, lo, hi);
            const size_t o = m * C + 8 * cc;
            if (sec == 2) {
                if (p.layer == 0) *(bf16x8*)(p.vfirst + o) = pack8(lo, hi);
                else { const bf16x8 vf = *(const bf16x8*)(p.vfirst + o), sg = *(const bf16x8*)(SG + tk * PR_SG_LD + 8 * cc);
                    lo = lo + (bfx4_lo(vf) - lo) * bfx4_lo(sg); hi = hi + (bfx4_hi(vf) - hi) * bfx4_hi(sg); } }
            *(bf16x8*)(OUT + o) = pack8(lo, hi); } }
    __syncthreads();
}

constexpr int NTHREADS_ = 512;
constexpr int SC_TB = 32, SC_SLOT = 384, SC_NCH = SEQ / SC_TB;
constexpr size_t WS_RKC = 51 * MiB;
struct ScanArgs { const bf16_t *R, *K, *V, *A, *LD, *G; const float *k_k, *k_a, *r_k, *lnx_g, *lnx_b; bf16_t* mix; float* rkc; };
template <int CTRL> __device__ __forceinline__ float dpp_mov(float x) { return __builtin_bit_cast(float, __builtin_amdgcn_update_dpp(0, __builtin_bit_cast(int, x), CTRL, 0xF, 0xF, true)); }
__device__ __forceinline__ float reduce16(float x) { x += dpp_mov<0xB1>(x); x += dpp_mov<0x4E>(x); x += dpp_mov<0x141>(x); x += dpp_mov<0x140>(x); return x; }
__device__ __forceinline__ void scan_item(const ScanArgs& p, float* lds, int item, int tid) {
    const int chain = item >> 2, q = item & 3, b = chain >> 3, h = chain & 7, wave = __builtin_amdgcn_readfirstlane(tid >> 6), lane = tid & 63;
    float* buf = lds;
    float* ybuf = lds + 2 * SC_TB * SC_SLOT;
    if (wave >= 4) {
        const int lw = wave - 4, lt = lw * 64 + lane, cgl = lane & 15, srow = lane >> 4, ch4 = h * 64 + 4 * cgl;
        const f32x4 kk_c = *(const f32x4*)(p.k_k + ch4), ka_c = *(const f32x4*)(p.k_a + ch4), rk_c = *(const f32x4*)(p.r_k + ch4);
        const size_t rowbase = (size_t)b * SEQ;
        struct LdSet { uint2 r[2], k[2], v[2], a[2], ld[2]; } s0, s1;
#define SC_LOAD(S, chunk) do { _Pragma("unroll") for (int ps = 0; ps < 2; ++ps) { const size_t o = (rowbase + (size_t)(chunk) * SC_TB + 8 * lw + 4 * ps + srow) * C + ch4; \
            S.r[ps] = *(const uint2*)(p.R + o); S.k[ps] = *(const uint2*)(p.K + o); S.v[ps] = *(const uint2*)(p.V + o); S.a[ps] = *(const uint2*)(p.A + o); S.ld[ps] = *(const uint2*)(p.LD + o); } } while (0)
#define SC_UNPK(u) ((f32x4){__builtin_bit_cast(float, (u).x << 16), __builtin_bit_cast(float, (u).x & 0xffff0000u), __builtin_bit_cast(float, (u).y << 16), __builtin_bit_cast(float, (u).y & 0xffff0000u)})
#define SC_PROC(S, chunk, bi) do { _Pragma("unroll") for (int ps = 0; ps < 2; ++ps) { const int st = 8 * lw + 4 * ps + srow; \
            const f32x4 r = SC_UNPK(S.r[ps]), k = SC_UNPK(S.k[ps]), v = SC_UNPK(S.v[ps]), a = SC_UNPK(S.a[ps]), ld = SC_UNPK(S.ld[ps]); \
            f32x4 kk = k * kk_c; const float nrm = sqrtf(reduce16((kk.x * kk.x + kk.z * kk.z) + (kk.y * kk.y + kk.w * kk.w))); kk = kk * (1.f / fmaxf(nrm, 1e-12f)); \
            const f32x4 kp = k * ((a - 1.f) * ka_c + 1.f); const f32x4 t3 = r * kp * rk_c; const float rkc = reduce16((t3.x + t3.z) + (t3.y + t3.w)); \
            float* slot = buf + ((bi) * SC_TB + st) * SC_SLOT + 4 * cgl; \
            *(f32x4*)(slot) = (f32x4){__expf(ld.x), __expf(ld.y), __expf(ld.z), __expf(ld.w)}; *(f32x4*)(slot + 64) = -kk; *(f32x4*)(slot + 128) = kk * a; *(f32x4*)(slot + 192) = kp; *(f32x4*)(slot + 256) = r; *(f32x4*)(slot + 320) = v; \
            if (q == 0 && cgl == 0) p.rkc[(rowbase + (size_t)(chunk) * SC_TB + st) * 8 + h] = rkc; } } while (0)
#define SC_YOUT(chunk, bi) do { _Pragma("unroll") for (int e2 = 0; e2 < 2; ++e2) { const int e = lt + 256 * e2, st = e >> 4, rr = e & 15; \
            p.mix[(rowbase + (size_t)(chunk) * SC_TB + st) * D + ATT_W + h * 64 + 16 * q + rr] = (bf16_t)f2bf(ybuf[(bi) * SC_TB * 16 + e]); } } while (0)
        SC_LOAD(s0, 0); SC_LOAD(s1, 1); SC_PROC(s0, 0, 0);
        __syncthreads();
        for (int c = 0; c < SC_NCH; c += 2) {
            if (c + 2 < SC_NCH) SC_LOAD(s0, c + 2);
            SC_PROC(s1, c + 1, 1);
            if (c >= 1) SC_YOUT(c - 1, 1);
            __syncthreads();
            if (c + 3 < SC_NCH) SC_LOAD(s1, c + 3);
            if (c + 2 < SC_NCH) SC_PROC(s0, c + 2, 0);
            SC_YOUT(c, 0);
            __syncthreads();
        }
        SC_YOUT(SC_NCH - 1, 1);
#undef SC_LOAD
#undef SC_UNPK
#undef SC_PROC
#undef SC_YOUT
    } else {
        const int cg4 = (lane & 15) * 4, rloc = 4 * wave + (lane >> 4);
        f32x4 S = (f32x4){0.f, 0.f, 0.f, 0.f};
#define SC_SCAN(bi) do { const float* bp = buf + (bi) * SC_TB * SC_SLOT + cg4; const float* vp = buf + (bi) * SC_TB * SC_SLOT + 320 + 16 * q + rloc; \
            const unsigned ya = (unsigned)(size_t)(__attribute__((address_space(3))) float*)(((lane & 15) == 0) ? (ybuf + (bi) * SC_TB * 16 + rloc) : (ybuf + 2 * SC_TB * 16 + lane)); \
            f32x4 w = *(const f32x4*)(bp), A = *(const f32x4*)(bp + 64), B = *(const f32x4*)(bp + 128), kp = *(const f32x4*)(bp + 192), r = *(const f32x4*)(bp + 256); float v = vp[0]; \
            _Pragma("unroll") for (int st = 0; st < SC_TB; ++st) { \
                f32x4 wn = w, An = A, Bn = B, kpn = kp, rn = r; float vn = v; \
                if (st + 1 < SC_TB) { wn = *(const f32x4*)(bp + (st + 1) * SC_SLOT); An = *(const f32x4*)(bp + (st + 1) * SC_SLOT + 64); Bn = *(const f32x4*)(bp + (st + 1) * SC_SLOT + 128); \
                    kpn = *(const f32x4*)(bp + (st + 1) * SC_SLOT + 192); rn = *(const f32x4*)(bp + (st + 1) * SC_SLOT + 256); vn = vp[(st + 1) * SC_SLOT]; }     \
                float sa = (S.x * A.x + S.z * A.z) + (S.y * A.y + S.w * A.w); sa = reduce16(sa); \
                S = S * w + (B * sa + kp * v); \
                float y = (S.x * r.x + S.z * r.z) + (S.y * r.y + S.w * r.w); y = reduce16(y); \
                asm volatile("ds_write_b32 %0, %1 offset:%c2" :: "v"(ya), "v"(y), "i"(st * 64)); \
                w = wn; A = An; B = Bn; kp = kpn; r = rn; v = vn; } } while (0)
        __syncthreads();
        for (int c = 0; c < SC_NCH; c += 2) { SC_SCAN(0); __syncthreads(); SC_SCAN(1); __syncthreads(); }
#undef SC_SCAN
    }
    __syncthreads();
}
constexpr int CK_LD = 72, CK_MAT = 64 * CK_LD * 2;
constexpr size_t WS_CKGQ = WS_PROJ, WS_CKCQ = WS_PROJ + 64 * MiB;
__device__ __forceinline__ void ck_mm(f32x4 (&acc)[2], const bf16_t* Qm, const bf16_t* P, int jb, int ib0, int fr, int fq) {
#pragma unroll
    for (int ks = 0; ks < 2; ++ks) { const bf16x8 bq = *(const bf16x8*)(Qm + (16 * jb + fr) * CK_LD + 32 * ks + 8 * fq);
#pragma unroll
        for (int ii = 0; ii < 2; ++ii) { const bf16x8 ap = *(const bf16x8*)(P + (16 * (ib0 + ii) + fr) * CK_LD + 32 * ks + 8 * fq); acc[ii] = __builtin_amdgcn_mfma_f32_16x16x32_bf16(ap, bq, acc[ii], 0, 0, 0); } }
}
__device__ __forceinline__ uint2 ck_pack4(const f32x4 v) { uint2 w; w.x = pg8::cvt_pk_bf16(v[0], v[1]); w.y = pg8::cvt_pk_bf16(v[2], v[3]); return w; }
__device__ __forceinline__ f32x4 ck_unpack4(const uint2 u) { return (f32x4){__builtin_bit_cast(float, u.x << 16), __builtin_bit_cast(float, u.x & 0xffff0000u), __builtin_bit_cast(float, u.y << 16), __builtin_bit_cast(float, u.y & 0xffff0000u)}; }
struct CkRaw { unsigned r[8], k[8], v[8], a[8], ld[8]; };
__device__ __forceinline__ float wave_sum_dpp(float x) { x = reduce16(x); x += __shfl_xor(x, 16); x += __shfl_xor(x, 32); return x; }
__device__ __forceinline__ void ck_load(const ScanArgs& p, CkRaw& w, int unit, int tid) {
    const int chain = unit >> 6, chunk = unit & 63, b = chain >> 3, h = chain & 7, wave = tid >> 6, lane = tid & 63; const int ch = h * 64 + lane; const size_t row0 = (size_t)b * SEQ + chunk * 64 + 8 * wave;
#pragma unroll
    for (int i = 0; i < 8; ++i) { const size_t o = (row0 + i) * C + ch; w.r[i] = p.R[o]; w.k[i] = p.K[o]; w.v[i] = p.V[o]; w.a[i] = p.A[o]; w.ld[i] = p.LD[o]; }
}
__device__ __forceinline__ void ck_precompute(const ScanArgs& p, const CkRaw& raw, unsigned char* lds, bf16_t* GQ, bf16_t* CQ, int unit, int tid) {
    const int chain = unit >> 6, chunk = unit & 63, b = chain >> 3, h = chain & 7, wave = __builtin_amdgcn_readfirstlane(tid >> 6), lane = tid & 63, fr = lane & 15, fq = lane >> 4, jb = wave >> 1, ib0 = 2 * (wave & 1);
    bf16_t* At = (bf16_t*)(lds + 0 * CK_MAT); bf16_t* bt = (bf16_t*)(lds + 1 * CK_MAT); bf16_t* kt = (bf16_t*)(lds + 2 * CK_MAT); bf16_t* rt = (bf16_t*)(lds + 3 * CK_MAT);
    bf16_t* AtT = (bf16_t*)(lds + 4 * CK_MAT); bf16_t* BhT = (bf16_t*)(lds + 5 * CK_MAT); bf16_t* KhT = (bf16_t*)(lds + 6 * CK_MAT); bf16_t* VT = (bf16_t*)(lds + 7 * CK_MAT);
    bf16_t* NT = (bf16_t*)(lds + 8 * CK_MAT); bf16_t* Mm = (bf16_t*)(lds + 9 * CK_MAT); bf16_t* P1 = (bf16_t*)(lds + 10 * CK_MAT); bf16_t* P2 = (bf16_t*)(lds + 11 * CK_MAT);
    bf16_t* Ta = (bf16_t*)(lds + 12 * CK_MAT); bf16_t* Tb = (bf16_t*)(lds + 13 * CK_MAT); float* WT = (float*)(lds + 14 * CK_MAT); float* GL = WT + 512;
    bf16_t* W1T = bt; bf16_t* MVT = kt; bf16_t* W2T = At;
    {
        const int ch = h * 64 + lane; const size_t row0 = (size_t)b * SEQ + chunk * 64 + 8 * wave;
        const float kk_c = p.k_k[ch], ka_c = p.k_a[ch], rk_c = p.r_k[ch];
        float r[8], kp[8], Aq[8], bq[8], v[8], ld[8], cl[8]; float run = 0.f;
#pragma unroll
        for (int i = 0; i < 8; ++i) { r[i] = bf2f((bf16_t)raw.r[i]); kp[i] = bf2f((bf16_t)raw.k[i]); v[i] = bf2f((bf16_t)raw.v[i]); bq[i] = bf2f((bf16_t)raw.a[i]); ld[i] = bf2f((bf16_t)raw.ld[i]); }
#pragma unroll
        for (int i = 0; i < 8; ++i) { const float k = kp[i], a = bq[i]; float kk = k * kk_c; kk = kk * fminf(__builtin_amdgcn_rsqf(wave_sum_dpp(kk * kk)), 1e12f);
            kp[i] = k * (1.f + (a - 1.f) * ka_c); Aq[i] = -kk; bq[i] = kk * a; const float rkc = wave_sum_dpp(r[i] * kp[i] * rk_c);
            if (lane == 0) p.rkc[(row0 + i) * 8 + h] = rkc; run += ld[i]; cl[i] = run; }
        WT[wave * 64 + lane] = run;
        __syncthreads();
        float off = 0.f, csL = 0.f;
#pragma unroll
        for (int w2 = 0; w2 < 8; ++w2) { const float t = WT[w2 * 64 + lane]; csL += t; if (w2 < wave) off += t; }
        if (wave == 0) GL[lane] = __expf(csL);
        float aT[8], bhT[8], khT[8];
#pragma unroll
        for (int i = 0; i < 8; ++i) { const float cs = off + cl[i], em = __expf(cs - ld[i]), en = __expf(-cs), ep = __expf(cs), eL = __expf(csL - cs); const int tl = 8 * wave + i;
            const float at = Aq[i] * em; aT[i] = at; bhT[i] = bq[i] * eL; khT[i] = kp[i] * eL;
            At[tl * CK_LD + lane] = (bf16_t)f2bf(at); bt[tl * CK_LD + lane] = (bf16_t)f2bf(bq[i] * en); kt[tl * CK_LD + lane] = (bf16_t)f2bf(kp[i] * en); rt[tl * CK_LD + lane] = (bf16_t)f2bf(r[i] * ep); }
        *(bf16x8*)(AtT + lane * CK_LD + 8 * wave) = pack8((f32x4){aT[0], aT[1], aT[2], aT[3]}, (f32x4){aT[4], aT[5], aT[6], aT[7]});
        *(bf16x8*)(BhT + lane * CK_LD + 8 * wave) = pack8((f32x4){bhT[0], bhT[1], bhT[2], bhT[3]}, (f32x4){bhT[4], bhT[5], bhT[6], bhT[7]});
        *(bf16x8*)(KhT + lane * CK_LD + 8 * wave) = pack8((f32x4){khT[0], khT[1], khT[2], khT[3]}, (f32x4){khT[4], khT[5], khT[6], khT[7]});
        *(bf16x8*)(VT + lane * CK_LD + 8 * wave) = pack8((f32x4){v[0], v[1], v[2], v[3]}, (f32x4){v[4], v[5], v[6], v[7]});
    }
    __syncthreads();
    const int j = 16 * jb + fr; const f32x4 z4 = (f32x4){0.f, 0.f, 0.f, 0.f};
    { f32x4 aN[2] = {z4, z4}, aNT[2] = {z4, z4}, aM[2] = {z4, z4}, aP1[2] = {z4, z4}, aP2[2] = {z4, z4};
      ck_mm(aN, At, bt, jb, ib0, fr, fq); ck_mm(aNT, bt, At, jb, ib0, fr, fq); ck_mm(aM, At, kt, jb, ib0, fr, fq); ck_mm(aP1, rt, bt, jb, ib0, fr, fq); ck_mm(aP2, rt, kt, jb, ib0, fr, fq);
#pragma unroll
      for (int ii = 0; ii < 2; ++ii) { const int i0 = 16 * (ib0 + ii) + 4 * fq; f32x4 t0, nt, mm, p1, p2;
#pragma unroll
          for (int e = 0; e < 4; ++e) { const int i = i0 + e; t0[e] = (i < j ? aN[ii][e] : 0.f) + (i == j ? 1.f : 0.f); nt[e] = j < i ? aNT[ii][e] : 0.f; mm[e] = i < j ? aM[ii][e] : 0.f; p1[e] = i <= j ? aP1[ii][e] : 0.f; p2[e] = i <= j ? aP2[ii][e] : 0.f; }
          *(uint2*)(Ta + j * CK_LD + i0) = ck_pack4(t0); *(uint2*)(NT + j * CK_LD + i0) = ck_pack4(nt); *(uint2*)(Mm + j * CK_LD + i0) = ck_pack4(mm); *(uint2*)(P1 + j * CK_LD + i0) = ck_pack4(p1); *(uint2*)(P2 + j * CK_LD + i0) = ck_pack4(p2); } }
    __syncthreads();
#pragma unroll
    for (int st = 0; st < 3; ++st) { const bf16_t* src = (st & 1) ? Tb : Ta; bf16_t* dst = (st & 1) ? Ta : Tb; f32x4 a2[2] = {z4, z4}; ck_mm(a2, src, NT, jb, ib0, fr, fq);
#pragma unroll
        for (int ii = 0; ii < 2; ++ii) { const int i0 = 16 * (ib0 + ii) + 4 * fq; f32x4 t = a2[ii];
#pragma unroll
            for (int e = 0; e < 4; ++e) t[e] += (i0 + e == j) ? 1.f : 0.f;
            *(uint2*)(dst + j * CK_LD + i0) = ck_pack4(t); }
        __syncthreads(); }
    { f32x4 a1[2] = {z4, z4}, a2[2] = {z4, z4}; ck_mm(a1, AtT, Tb, jb, ib0, fr, fq); ck_mm(a2, VT, Mm, jb, ib0, fr, fq);
#pragma unroll
      for (int ii = 0; ii < 2; ++ii) { const int i0 = 16 * (ib0 + ii) + 4 * fq; *(uint2*)(W1T + j * CK_LD + i0) = ck_pack4(a1[ii]); *(uint2*)(MVT + j * CK_LD + i0) = ck_pack4(a2[ii]); } }
    __syncthreads();
    { f32x4 a1[2] = {z4, z4}; ck_mm(a1, MVT, Tb, jb, ib0, fr, fq);
#pragma unroll
      for (int ii = 0; ii < 2; ++ii) { const int i0 = 16 * (ib0 + ii) + 4 * fq; *(uint2*)(W2T + j * CK_LD + i0) = ck_pack4(a1[ii]); } }
    __syncthreads();
    { f32x4 aQ1[2] = {z4, z4}, aG[2] = {z4, z4}, aQ2[2] = {z4, z4}, aC[2] = {z4, z4};
      ck_mm(aQ1, P1, W1T, jb, ib0, fr, fq); ck_mm(aG, BhT, W1T, jb, ib0, fr, fq); ck_mm(aQ2, P1, W2T, jb, ib0, fr, fq); ck_mm(aQ2, P2, VT, jb, ib0, fr, fq); ck_mm(aC, W2T, BhT, jb, ib0, fr, fq); ck_mm(aC, VT, KhT, jb, ib0, fr, fq);
      bf16_t* gq = GQ + (size_t)unit * 8192; bf16_t* cq = CQ + (size_t)unit * 8192; const float glj = GL[j];
#pragma unroll
      for (int ii = 0; ii < 2; ++ii) { const int i0 = 16 * (ib0 + ii) + 4 * fq; f32x4 g = aG[ii];
#pragma unroll
          for (int e = 0; e < 4; ++e) g[e] += (i0 + e == j) ? glj : 0.f;
          const f32x4 q1 = aQ1[ii] + ck_unpack4(*(const uint2*)(rt + j * CK_LD + i0));
          *(uint2*)(gq + j * 64 + i0) = ck_pack4(g); *(uint2*)(gq + 4096 + j * 64 + i0) = ck_pack4(q1); *(uint2*)(cq + j * 64 + i0) = ck_pack4(aC[ii]); *(uint2*)(cq + 4096 + j * 64 + i0) = ck_pack4(aQ2[ii]); } }
    __syncthreads();
}
__device__ __forceinline__ void ck_sequential(const ScanArgs& p, unsigned char* lds, const bf16_t* GQ, const bf16_t* CQ, int item, int tid) {
    const int chain = item >> 2, q = item & 3, b = chain >> 3, h = chain & 7, wave = __builtin_amdgcn_readfirstlane(tid >> 6), lane = tid & 63, fr = lane & 15, fq = lane >> 4;
    bf16_t* OPS = (bf16_t*)lds;
    bf16_t* HT = (bf16_t*)(lds + 4 * CK_MAT);
    for (int i = tid; i < 2 * 16 * CK_LD / 2; i += NTHREADS_) ((unsigned*)HT)[i] = 0u;
    const size_t ubase = (size_t)chain * 64; const size_t rowbase = (size_t)b * SEQ;
    const int prow0 = tid >> 3, pcol = (tid & 7) * 8;
    const int aoff = wave < 4 ? (4096 + (16 * wave + fr) * 64 + 16 * q + 4 * fq) : ((16 * q + fr) * 64 + 16 * (wave - 4) + 4 * fq);
    typedef unsigned u32x2_ __attribute__((ext_vector_type(2)));
    pg8::u32x4 g0_0, g0_1, g0_2, g0_3, g1_0, g1_1, g1_2, g1_3; u32x2_ ad_0, ad_1, ad_2, ad_3;
#define CK_FETCH(slot, cc) do { const bf16_t* gq = GQ + (ubase + (cc)) * 8192; g0_##slot = *(const pg8::u32x4*)(gq + (size_t)prow0 * 64 + pcol); g1_##slot = *(const pg8::u32x4*)(gq + (size_t)(prow0 + 64) * 64 + pcol); \
        ad_##slot = *(const u32x2_*)(CQ + (ubase + (cc)) * 8192 + aoff); } while (0)
#define CK_STAGE(slot, buf) do { *(pg8::u32x4*)(OPS + (buf) * 2 * 64 * CK_LD + prow0 * CK_LD + pcol) = g0_##slot; *(pg8::u32x4*)(OPS + (buf) * 2 * 64 * CK_LD + 64 * CK_LD + prow0 * CK_LD + pcol) = g1_##slot; } while (0)
    CK_FETCH(0, 0); CK_FETCH(1, 1); CK_FETCH(2, 2); CK_FETCH(3, 3);
    CK_STAGE(0, 0);
    __syncthreads();
#define CK_STEP(cc, slot, nslot) do { const int bi = (cc) & 1; const bf16_t* Gm = OPS + bi * 2 * 64 * CK_LD; const bf16_t* Q1m = Gm + 64 * CK_LD; const bf16_t* HTc = HT + bi * 16 * CK_LD; bf16_t* HTn = HT + (bi ^ 1) * 16 * CK_LD; \
        f32x4 acc = (f32x4){0.f, 0.f, 0.f, 0.f}; \
        if (wave < 4) { _Pragma("unroll") for (int ks = 0; ks < 2; ++ks) acc = __builtin_amdgcn_mfma_f32_16x16x32_bf16(*(const bf16x8*)(HTc + fr * CK_LD + 32 * ks + 8 * fq), *(const bf16x8*)(Q1m + (16 * wave + fr) * CK_LD + 32 * ks + 8 * fq), acc, 0, 0, 0); \
            acc = acc + ck_unpack4((uint2){ad_##slot.x, ad_##slot.y}); \
            *(uint2*)(p.mix + (rowbase + (size_t)(cc) * 64 + 16 * wave + fr) * D + ATT_W + h * 64 + 16 * q + 4 * fq) = ck_pack4(acc); } \
        else { _Pragma("unroll") for (int ks = 0; ks < 2; ++ks) acc = __builtin_amdgcn_mfma_f32_16x16x32_bf16(*(const bf16x8*)(Gm + (16 * (wave - 4) + fr) * CK_LD + 32 * ks + 8 * fq), *(const bf16x8*)(HTc + fr * CK_LD + 32 * ks + 8 * fq), acc, 0, 0, 0); \
            acc = acc + ck_unpack4((uint2){ad_##slot.x, ad_##slot.y}); \
            *(uint2*)(HTn + fr * CK_LD + 16 * (wave - 4) + 4 * fq) = ck_pack4(acc); } \
        if ((cc) + 1 < 64) CK_STAGE(nslot, bi ^ 1); \
        if ((cc) + 4 < 64) CK_FETCH(slot, (cc) + 4); \
        __syncthreads(); } while (0)
    for (int c = 0; c < 64; c += 4) { CK_STEP(c, 0, 1); CK_STEP(c + 1, 1, 2); CK_STEP(c + 2, 2, 3); CK_STEP(c + 3, 3, 0); }
#undef CK_FETCH
#undef CK_STAGE
#undef CK_STEP
}

__device__ __forceinline__ float red8(float x) { x += dpp_mov<0xB1>(x); x += dpp_mov<0x4E>(x); x += dpp_mov<0x141>(x); return x; }
__device__ __forceinline__ void scan_post_rows(const ScanArgs& p, int m0, int lane) {
    const int ch8 = 8 * lane, hh = lane >> 3;
    const f32x4 lg0 = *(const f32x4*)(p.lnx_g + ch8), lg1 = *(const f32x4*)(p.lnx_g + ch8 + 4), lb0 = *(const f32x4*)(p.lnx_b + ch8), lb1 = *(const f32x4*)(p.lnx_b + ch8 + 4);
    bf16x8 yv[2], vv[2], gv[2]; float rk[2];
#pragma unroll
    for (int u = 0; u < 2; ++u) { const size_t m = (size_t)m0 + u; yv[u] = *(const bf16x8*)(p.mix + m * D + ATT_W + ch8); vv[u] = *(const bf16x8*)(p.V + m * C + ch8); gv[u] = *(const bf16x8*)(p.G + m * C + ch8); rk[u] = p.rkc[m * 8 + hh]; }
#pragma unroll
    for (int u = 0; u < 2; ++u) { const size_t m = (size_t)m0 + u;
        f32x4 y0 = bfx4_lo(yv[u]), y1 = bfx4_hi(yv[u]);
        const float mean = red8((y0.x + y0.y) + (y0.z + y0.w) + (y1.x + y1.y) + (y1.z + y1.w)) * (1.f / 64.f);
        y0 = y0 - mean; y1 = y1 - mean;
        const float var = red8((y0.x * y0.x + y0.y * y0.y) + (y0.z * y0.z + y0.w * y0.w) + (y1.x * y1.x + y1.y * y1.y) + (y1.z * y1.z + y1.w * y1.w)) * (1.f / 64.f);
        const float rs = rsqrtf(var + LNX_EPS);
        const f32x4 o0 = (y0 * rs * lg0 + lb0 + bfx4_lo(vv[u]) * rk[u]) * bfx4_lo(gv[u]), o1 = (y1 * rs * lg1 + lb1 + bfx4_hi(vv[u]) * rk[u]) * bfx4_hi(gv[u]);
        *(bf16x8*)(p.mix + m * D + ATT_W + ch8) = pack8(o0, o1); }
}

typedef float f32x16 __attribute__((ext_vector_type(16)));
typedef short s16x4 __attribute__((ext_vector_type(4)));
constexpr int AT_VTS = 196;
__device__ __forceinline__ int crow(int r, int hi) { return (r & 3) + 8 * (r >> 2) + 4 * hi; }
__device__ __forceinline__ void attn_unit(const bf16_t* __restrict__ proj, const float* __restrict__ sinks, bf16_t* __restrict__ mix, bf16_t* vt, int unit, int tid) {
    const int b = unit >> 7, kvh = (unit >> 6) & 1, qb = unit & 63, Q0 = qb * 64;
    const int wave = __builtin_amdgcn_readfirstlane(tid >> 6), lane = tid & 63, c = lane & 31, hi = lane >> 5, g = wave >> 1, half = wave & 1, h = kvh * 4 + g;
    const size_t rowb = (size_t)b * SEQ;
    for (int i = tid; i < 192 * 8; i += 512) { const int kl = i >> 3, ch8 = i & 7; int key = Q0 - 128 + kl; key = key < 0 ? 0 : key;
        const bf16x8 v = *(const bf16x8*)(proj + (rowb + key) * IN_W + 640 + kvh * 64 + ch8 * 8);
#pragma unroll
        for (int e = 0; e < 8; ++e) vt[(ch8 * 8 + e) * AT_VTS + kl] = (bf16_t)v[e]; }
    __syncthreads();
    const int t0 = Q0 + 32 * half; const size_t mq = rowb + t0 + c;
    bf16x8 qf[4];
#pragma unroll
    for (int ks = 0; ks < 4; ++ks) qf[ks] = *(const bf16x8*)(proj + mq * IN_W + h * 64 + 16 * ks + 8 * hi);
    f32x16 p[5];
#pragma unroll
    for (int kb = 0; kb < 5; ++kb) { int key = t0 - 128 + 32 * kb + c; key = key < 0 ? 0 : key; const bf16_t* kp = proj + (rowb + key) * IN_W + 512 + kvh * 64 + 8 * hi;
        f32x16 acc;
#pragma unroll
        for (int r = 0; r < 16; ++r) acc[r] = 0.f;
#pragma unroll
        for (int ks = 0; ks < 4; ++ks) acc = __builtin_amdgcn_mfma_f32_32x32x16_bf16(*(const bf16x8*)(kp + 16 * ks), qf[ks], acc, 0, 0, 0);
        p[kb] = acc; }
    const float slope = exp2f(-(float)(h + 1)), sink = sinks[h];
    float mx = sink;
#pragma unroll
    for (int kb = 0; kb < 5; ++kb)
#pragma unroll
        for (int r = 0; r < 16; ++r) { const int cr = crow(r, hi), dist = c + 128 - 32 * kb - cr, key = t0 - 128 + 32 * kb + cr;
            const float sc = (dist >= 0 && dist < WINDOW && key >= 0) ? p[kb][r] * 0.125f - slope * (float)dist : -1e30f; p[kb][r] = sc; mx = fmaxf(mx, sc); }
    mx = fmaxf(mx, __shfl_xor(mx, 32));
    float l = 0.f;
#pragma unroll
    for (int kb = 0; kb < 5; ++kb)
#pragma unroll
        for (int r = 0; r < 16; ++r) { const float e = __expf(p[kb][r] - mx); p[kb][r] = e; l += e; }
    l += __shfl_xor(l, 32); l += __expf(sink - mx);
    f32x16 o[2];
#pragma unroll
    for (int d = 0; d < 2; ++d)
#pragma unroll
        for (int r = 0; r < 16; ++r) o[d][r] = 0.f;
#pragma unroll
    for (int kb = 0; kb < 5; ++kb)
#pragma unroll
        for (int s2 = 0; s2 < 2; ++s2) {
            pg8::u32x4 pw; pw.x = pg8::cvt_pk_bf16(p[kb][8 * s2 + 0], p[kb][8 * s2 + 1]); pw.y = pg8::cvt_pk_bf16(p[kb][8 * s2 + 2], p[kb][8 * s2 + 3]);
            pw.z = pg8::cvt_pk_bf16(p[kb][8 * s2 + 4], p[kb][8 * s2 + 5]); pw.w = pg8::cvt_pk_bf16(p[kb][8 * s2 + 6], p[kb][8 * s2 + 7]);
            const bf16x8 pf = __builtin_bit_cast(bf16x8, pw);
#pragma unroll
            for (int d = 0; d < 2; ++d) { const bf16_t* vp = vt + (32 * d + c) * AT_VTS + 32 * half + 32 * kb + 16 * s2 + 4 * hi;
                const s16x4 lo = *(const s16x4*)vp, hh = *(const s16x4*)(vp + 8);
                const bf16x8 vf = (bf16x8){lo[0], lo[1], lo[2], lo[3], hh[0], hh[1], hh[2], hh[3]};
                o[d] = __builtin_amdgcn_mfma_f32_32x32x16_bf16(vf, pf, o[d], 0, 0, 0); } }
    const float inv = 1.f / l;
#pragma unroll
    for (int d = 0; d < 2; ++d)
#pragma unroll
        for (int rg = 0; rg < 4; ++rg) { uint2 w; w.x = pg8::cvt_pk_bf16(o[d][4 * rg] * inv, o[d][4 * rg + 1] * inv); w.y = pg8::cvt_pk_bf16(o[d][4 * rg + 2] * inv, o[d][4 * rg + 3] * inv);
            *(uint2*)(mix + mq * D + h * 64 + 32 * d + 8 * rg + 4 * hi) = w; }
    __syncthreads();
}

__device__ __forceinline__ void conv_item(const bf16_t* __restrict__ U, const bf16_t* __restrict__ UP, const float* __restrict__ cw, const float* __restrict__ cb, bf16_t* __restrict__ hid, size_t i) {
    const int t = (int)(i / FF), j = (int)(i % FF);
    const float u0 = bf2f(U[i]), u1 = t >= 1 ? bf2f(U[i - FF]) : 0.f, u2 = t >= 2 ? bf2f(U[i - 2 * FF]) : 0.f;
    const float c = cb[j] + cw[j] * u2 + cw[FF + j] * u1 + cw[2 * FF + j] * u0;
    hid[i] = (bf16_t)f2bf(c * sigmoidf_(c) * bf2f(UP[i]));
}

__device__ __forceinline__ void ffn_fixup(const float* __restrict__ SB, const float* __restrict__ cw, const float* __restrict__ cb, bf16_t* hid, int pm, int tid) {
    const float* s = SB + (size_t)pm * 6 * FF; const float* sp = SB + (size_t)(pm - 1) * 6 * FF; const bool has_prev = (pm % (SEQ / 256)) != 0;
    for (int idx = tid; idx < 2 * FF; idx += NTHREADS_) { const int rr = idx / FF, j = idx % FF;
        const float u0 = s[j], u1 = s[FF + j], ul0 = has_prev ? sp[4 * FF + j] : 0.f, ul1 = has_prev ? sp[5 * FF + j] : 0.f;
        const float c = rr == 0 ? cb[j] + cw[j] * ul0 + cw[FF + j] * ul1 + cw[2 * FF + j] * u0 : cb[j] + cw[j] * ul1 + cw[FF + j] * u0 + cw[2 * FF + j] * u1;
        hid[(size_t)(pm * 256 + rr) * FF + j] = (bf16_t)f2bf(c * sigmoidf_(c) * s[(2 + rr) * FF + j]); }
}

__device__ __forceinline__ void final_row(const bf16_t* __restrict__ xb, float* __restrict__ out, const ssq_t* __restrict__ ss, const float* __restrict__ g, int row, int lane) {
    const float rstd = rsqrtf(ssq_val(ss[row]) * (1.f / D) + RMS_EPS);
    const bf16x8* xr = (const bf16x8*)(xb + (size_t)row * D) + lane; f32x4* orow = (f32x4*)(out + (size_t)row * D) + 2 * lane; const f32x4* gr = (const f32x4*)g + 2 * lane;
#pragma unroll
    for (int j = 0; j < 2; ++j) { const bf16x8 v = xr[64 * j]; const f32x4 g0 = gr[128 * j], g1 = gr[128 * j + 1];
        orow[128 * j] = (f32x4){bf2f((bf16_t)v[0]), bf2f((bf16_t)v[1]), bf2f((bf16_t)v[2]), bf2f((bf16_t)v[3])} * g0 * rstd;
        orow[128 * j + 1] = (f32x4){bf2f((bf16_t)v[4]), bf2f((bf16_t)v[5]), bf2f((bf16_t)v[6]), bf2f((bf16_t)v[7])} * g1 * rstd; }
}

#define XB_TMO      128
#define XB_XCNT(j)  (256  + 64 * (j))
#define XB_XSUB(j)  (1280 + 64 * (j))
#define XB_XGEN(j)  (2304 + 64 * (j))
#define XB_TOP      3328
#define XB_TOPGEN   3392
#define XCD_BAR_WORDS 3456
#define XB_SPIN_CAP (1u << 18)

__device__ __forceinline__ unsigned xb_ld(unsigned* p)              { return __hip_atomic_load(p, __ATOMIC_RELAXED, __HIP_MEMORY_SCOPE_AGENT); }
__device__ __forceinline__ unsigned xb_add(unsigned* p, unsigned v) { return __hip_atomic_fetch_add(p, v, __ATOMIC_RELAXED, __HIP_MEMORY_SCOPE_AGENT); }
__device__ __forceinline__ unsigned xb_xcc_id() { return (unsigned)__builtin_amdgcn_s_getreg((3 << 11) | 20) & 0xFu; }
#define XB_SPIN(cond, bar) do { unsigned _sp = 0; while (cond) { __builtin_amdgcn_s_sleep(1); \
    if ((++_sp & 255u) == 0u) { if (xb_ld(&(bar)[XB_TMO])) break; if (_sp > XB_SPIN_CAP) { atomicAdd(&(bar)[XB_TMO], 1u); break; } } } } while (0)

struct XcdBarrier {
    unsigned* bar; unsigned x;
    volatile __attribute__((address_space(3))) unsigned* st;
};

__device__ __forceinline__ XcdBarrier xcd_barrier_post(unsigned* bar, volatile __attribute__((address_space(3))) unsigned* st) {
    XcdBarrier b; b.bar = bar; b.x = xb_xcc_id(); b.st = st;
    if (threadIdx.x == 0) (void)xb_add(&bar[XB_XCNT(b.x)], 1u);
    return b;
}
__device__ __forceinline__ void xcd_barrier_complete(unsigned* bar, unsigned x, unsigned& nloc, unsigned& nx) {
    const unsigned G = gridDim.x * gridDim.y * gridDim.z;
    unsigned sum, cnt, mine, sp = 0u;
    for (;;) {
        sum = 0u; cnt = 0u; mine = 0u;
#pragma unroll
        for (unsigned j = 0; j < 16; ++j) { const unsigned c = xb_ld(&bar[XB_XCNT(j)]); sum += c; cnt += (c > 0u) ? 1u : 0u; mine = (j == x) ? c : mine; }
        if (sum == G) break;
        __builtin_amdgcn_s_sleep(1);
        if ((++sp & 255u) == 0u) { if (xb_ld(&bar[XB_TMO])) break; if (sp > XB_SPIN_CAP) { atomicAdd(&bar[XB_TMO], 1u); break; } }
    }
    nloc = mine > 0u ? mine : 1u; nx = cnt > 0u ? cnt : 1u;
}

__device__ __forceinline__ void xcd_barrier(const XcdBarrier& b) {
    asm volatile("s_waitcnt vmcnt(0)" ::: "memory");
    __syncthreads();
    if (threadIdx.x == 0) {
        unsigned* bar = b.bar;
        __builtin_amdgcn_s_waitcnt(0);
        unsigned nloc = b.st[0], nx = b.st[1];
        if (nloc == 0u) { xcd_barrier_complete(bar, b.x, nloc, nx); b.st[0] = nloc; b.st[1] = nx; }
        const unsigned old = xb_add(&bar[XB_XSUB(b.x)], 1u);
        const unsigned gen = old / nloc;
        if (old + 1u == (gen + 1u) * nloc) {
            __builtin_amdgcn_fence(__ATOMIC_RELEASE, "agent");
            asm volatile("s_waitcnt vmcnt(0)" ::: "memory");
            const unsigned og = xb_add(&bar[XB_TOP], 1u);
            const unsigned tg = og / nx;
            if (og + 1u == (tg + 1u) * nx) xb_add(&bar[XB_TOPGEN], 1u);
            else XB_SPIN(xb_ld(&bar[XB_TOPGEN]) == tg, bar);
            __builtin_amdgcn_fence(__ATOMIC_ACQUIRE, "agent");
            xb_add(&bar[XB_XGEN(b.x)], 1u);
            asm volatile("s_waitcnt vmcnt(0)" ::: "memory");
        } else {
            XB_SPIN(xb_ld(&bar[XB_XGEN(b.x)]) == gen, bar);
            __builtin_amdgcn_fence(__ATOMIC_ACQUIRE, "agent");
            asm volatile("s_waitcnt vmcnt(0)" ::: "memory");
        }
    }
    __syncthreads();
}

constexpr int NTHREADS = 512, LDS_BYTES = 147456;
struct Args { const float* in[26]; float* out; unsigned char* ws; };
__global__ void __launch_bounds__(NTHREADS, 2) mega_fwd(Args a) {
    extern __shared__ __attribute__((aligned(16))) unsigned char lds[];
    constexpr int MISC_OFF = 131072 + 4096;
    { volatile __attribute__((address_space(3))) unsigned* misc = (volatile __attribute__((address_space(3))) unsigned*)((__attribute__((address_space(3))) unsigned char*)lds + MISC_OFF);
      if (threadIdx.x < 4) misc[threadIdx.x] = 0u; }
    __syncthreads();
    (void)xcd_barrier_post((unsigned*)(a.ws + WS_BAR), (volatile __attribute__((address_space(3))) unsigned*)((__attribute__((address_space(3))) unsigned char*)lds + MISC_OFF));
#define GRID_SYNC() do { XcdBarrier xb_; xb_.bar = (unsigned*)(a.ws + WS_BAR); xb_.x = xb_xcc_id(); xb_.st = (volatile __attribute__((address_space(3))) unsigned*)((__attribute__((address_space(3))) unsigned char*)lds + MISC_OFF); xcd_barrier(xb_); } while (0)
#define LDSP ((PG8_LAS unsigned char*)lds)
    constexpr int XCH_OFF = 131072;
#define OTID() ({ int _t = threadIdx.x; asm volatile("" : "+v"(_t)); _t; })
    const int G = gridDim.x, NGW = G * 8;
    const float* x = a.in[0]; const float* norm1_g = a.in[1]; const float* w_in = a.in[2]; const float* sinks = a.in[3];
    const float* mu = a.in[4]; const float* w0 = a.in[5]; const float* w2 = a.in[6]; const float* a0 = a.in[7];
    const float* a2 = a.in[8]; const float* g2 = a.in[9]; const float* k_k = a.in[10]; const float* k_a = a.in[11];
    const float* r_k = a.in[12]; const float* lnx_g = a.in[13]; const float* lnx_b = a.in[14]; const float* v0 = a.in[15];
    const float* v1 = a.in[16]; const float* v2 = a.in[17]; const float* w_out = a.in[18]; const float* norm2_g = a.in[19];
    const float* wg = a.in[20]; const float* wu = a.in[21]; const float* conv_w = a.in[22]; const float* conv_b = a.in[23];
    const float* wd = a.in[24]; const float* final_g = a.in[25];
    unsigned char* ws = a.ws; float* X = a.out;
    ssq_t* ss = (ssq_t*)(ws + WS_SS);
    bf16_t* XB = (bf16_t*)(ws + WS_XB); bf16_t* PROJ = (bf16_t*)(ws + WS_PROJ); bf16_t* MIX = (bf16_t*)(ws + WS_MIX); bf16_t* HID = (bf16_t*)(ws + WS_HID); bf16_t* VF = (bf16_t*)(ws + WS_VFIRST);
    bf16_t* UT = (bf16_t*)(ws + WS_UTMP); bf16_t* UPT = UT + (size_t)SEQ * FF;

    {
        const int tid = OTID(), lane = tid & 63, wave = tid >> 6, gw = blockIdx.x * 8 + wave;
        float* scr = (float*)lds + wave * (64 * 33 + 16);
        constexpr int I_IN = (D / 64) * (IN_W / 32), I_OUT = (D / 64) * (D / 32), I_G = (D / 64) * (FF / 32), I_DN = (FF / 64) * (D / 32), I_LAYER = I_IN + I_OUT + 2 * I_G + I_DN;
        for (int it = gw; it < 2 * I_LAYER; it += NGW) {
            const int l = it / I_LAYER; int r = it % I_LAYER;
            bf16_t* wl = (bf16_t*)(ws + WS_W + l * W_LAYER); bf16_t* WinT = wl; bf16_t* WoutT = (bf16_t*)((char*)wl + W_IN_SZ); bf16_t* WguT = (bf16_t*)((char*)WoutT + W_OUT_SZ); bf16_t* WdT = (bf16_t*)((char*)WguT + W_GU_SZ);
            if (r < I_IN) { transpose_item(w_in + (size_t)l * D * IN_W, D, IN_W, WinT, norm1_g + l * D, 0, scr, r, lane); continue; } r -= I_IN;
            if (r < I_OUT) { transpose_item(w_out + (size_t)l * D * D, D, D, WoutT, nullptr, 0, scr, r, lane); continue; } r -= I_OUT;
            if (r < I_G) { transpose_item(wg + (size_t)l * D * FF, D, FF, WguT, norm2_g + l * D, 1, scr, r, lane); continue; } r -= I_G;
            if (r < I_G) { transpose_item(wu + (size_t)l * D * FF, D, FF, WguT, norm2_g + l * D, 2, scr, r, lane); continue; } r -= I_G;
            transpose_item(wd + (size_t)l * FF * D, FF, D, WdT, nullptr, 0, scr, r, lane);
        }
        {
            constexpr int I_W2 = 1 * (C / 32), I_G2 = 2 * (C / 32), I_V1 = (C / 64) * 1, I_L = 2 * I_W2 + I_G2;
            for (int it = gw; it < 2 * I_L + I_V1; it += NGW) {
                if (it < 2 * I_L) { const int l = it / I_L; int r = it % I_L; bf16_t* base = (bf16_t*)(ws + WS_LORA + l * LORA_LAYER);
                    if (r < I_W2) { transpose_item(w2 + (size_t)l * 64 * C, 64, C, base, nullptr, 0, scr, r, lane); continue; } r -= I_W2;
                    if (r < I_W2) { transpose_item(a2 + (size_t)l * 64 * C, 64, C, base + 512 * 64, nullptr, 0, scr, r, lane); continue; } r -= I_W2;
                    transpose_item(g2 + (size_t)l * 128 * C, 128, C, base + 2 * 512 * 64, nullptr, 0, scr, r, lane); }
                else transpose_item(v1, C, 32, (bf16_t*)(ws + WS_V1T), nullptr, 0, scr, it - 2 * I_L, lane);
            }
            bf16_t* V2T = (bf16_t*)(ws + WS_V2T);
            for (int i = blockIdx.x * NTHREADS + tid; i < 32 * C; i += G * NTHREADS) { const int j = i / C, ch = i % C; V2T[ch * 32 + j] = (bf16_t)f2bf(v2[i]); }
        }
        for (int m = gw; m < M; m += NGW) x_row_to_bf16(x, XB, ss, m, lane);
    }
    GRID_SYNC();
    for (int l = 0; l < 2; ++l) {
        bf16_t* wl = (bf16_t*)(ws + WS_W + l * W_LAYER); bf16_t* WinT = wl; bf16_t* WoutT = (bf16_t*)((char*)wl + W_IN_SZ); bf16_t* WguT = (bf16_t*)((char*)WoutT + W_OUT_SZ); bf16_t* WdT = (bf16_t*)((char*)WguT + W_GU_SZ);
        ssq_t* ss1 = ss + (size_t)(2 * l) * M; ssq_t* ss2 = ss + (size_t)(2 * l + 1) * M; ssq_t* ss3 = ss + (size_t)(2 * l + 2) * M;
        { pg8::Gemm g{XB, WinT, M, IN_W, D}; pg8::StaticOrder S; S.init(M, IN_W, G, (int)blockIdx.x); pg8::EpiScaleBf16 E{PROJ, IN_W, ss1};
          pg8::gemm_phase<pg8::EpiScaleBf16, pg8::StaticOrder, true, true>(LDSP, g, S, E); }
        GRID_SYNC();
        for (int unit = blockIdx.x; unit < BATCH * 2 * (SEQ / 64); unit += G) attn_unit(PROJ, sinks + l * NH, MIX, (bf16_t*)lds, unit, OTID());
        struct { bf16_t *R, *K, *V, *A, *LD, *G; } p; p.R = (bf16_t*)X; p.K = (bf16_t*)X + (size_t)M * C;     p.V = (bf16_t*)(ws + WS_SI_V); p.A = (bf16_t*)(ws + WS_SI_A); p.LD = (bf16_t*)(ws + WS_SI_LD); p.G = (bf16_t*)(ws + WS_SI_G);
        { Prep2Args q{}; q.proj = PROJ; q.mu = mu + l * SHIFT_W; q.w0 = w0 + l * C; q.a0 = a0 + l * C; q.v0 = v0;
          const bf16_t* lw = (const bf16_t*)(ws + WS_LORA + l * LORA_LAYER); q.W2T = lw; q.A2T = lw + 512 * 64; q.G2T = lw + 2 * 512 * 64; q.V1T = (const bf16_t*)(ws + WS_V1T); q.V2T = (const bf16_t*)(ws + WS_V2T);
          q.vfirst = VF; q.R = p.R; q.K = p.K; q.V = p.V; q.A = p.A; q.LD = p.LD; q.G = p.G; q.layer = l;
          for (int tile = blockIdx.x; tile < M / 64; tile += G) prep_tile(q, lds, tile, OTID()); }
        GRID_SYNC();
        { ScanArgs s{}; s.R = p.R; s.K = p.K; s.V = p.V; s.A = p.A; s.LD = p.LD; s.G = p.G; s.k_k = k_k + l * C; s.k_a = k_a + l * C; s.r_k = r_k + l * C; s.lnx_g = lnx_g + l * C; s.lnx_b = lnx_b + l * C; s.mix = MIX; s.rkc = (float*)(ws + WS_RKC);
          bf16_t* GQ = (bf16_t*)(ws + WS_CKGQ); bf16_t* CQ = (bf16_t*)(ws + WS_CKCQ);
          for (int unit = blockIdx.x; unit < BATCH * NH * 64; unit += G) { CkRaw ra; ck_load(s, ra, unit, OTID()); ck_precompute(s, ra, lds, GQ, CQ, unit, OTID()); }
          GRID_SYNC();
          for (int item = (int)((blockIdx.x & 7) * (G >> 3) + (blockIdx.x >> 3)); item < BATCH * NH * 4; item += G) ck_sequential(s, lds, GQ, CQ, item, OTID());
          GRID_SYNC();
          { const int tid = OTID(), lane = tid & 63, gw = blockIdx.x * 8 + (tid >> 6); for (int m0 = 2 * gw; m0 < M; m0 += 2 * NGW) scan_post_rows(s, m0, lane); } }
        GRID_SYNC();
        { pg8::Gemm g{MIX, WoutT, M, D, D}; pg8::StaticOrder S; S.init(M, D, G, (int)blockIdx.x); pg8::EpiResid E{XB, ss2};
          pg8::gemm_phase<pg8::EpiResid, pg8::StaticOrder, true, true>(LDSP, g, S, E); }
        GRID_SYNC();
        { pg8::Gemm g{XB, WguT, M, 2 * FF, D}; pg8::StaticOrder S; S.init(M, 2 * FF, G, (int)blockIdx.x);
          pg8::EpiConvGlu E{HID, ss2, conv_w + (size_t)l * 3 * FF, conv_b + (size_t)l * FF, (float*)(ws + WS_UTMP), (PG8_LAS float*)(LDSP + XCH_OFF), FF};
          pg8::gemm_phase<pg8::EpiConvGlu, pg8::StaticOrder, true, true>(LDSP, g, S, E); }
        GRID_SYNC();
        { pg8::Gemm g{HID, WdT, M, D, FF}; pg8::StaticOrder S; S.init(M, D, G, (int)blockIdx.x); pg8::EpiResid E{XB, ss3};
          { pg8::Unit u; for (int i = 0; S.next(i, u); ++i) ffn_fixup((const float*)(ws + WS_UTMP), conv_w + (size_t)l * 3 * FF, conv_b + (size_t)l * FF, HID, u.pm, OTID());
            asm volatile("s_waitcnt vmcnt(0)" ::: "memory"); __syncthreads(); }
          pg8::gemm_phase<pg8::EpiResid, pg8::StaticOrder, true, true>(LDSP, g, S, E); }
        GRID_SYNC();
    }
    { const int tid = OTID(), lane = tid & 63, gw = blockIdx.x * 8 + (tid >> 6);
    for (int m = gw; m < M; m += NGW) final_row(XB, X, ss + (size_t)4 * M, final_g, m, lane); }
}

extern "C" void kernel_launch(void* const* d_in, const int* in_sizes, int n_in, void* d_out, int out_size, void* d_ws, size_t ws_size, hipStream_t stream) {
    static int grid = 0;
    if (grid == 0) {
        if (n_in != 26 || in_sizes[0] != M * D || out_size != M * D || ws_size < WS_END) { fprintf(stderr, "kernel_launch: unexpected shapes (n_in %d, ws %zu)\n", n_in, ws_size); grid = -1; return; }
        int dev = 0, cus = 0, per_cu = 0;
        if (hipGetDevice(&dev) != hipSuccess || hipDeviceGetAttribute(&cus, hipDeviceAttributeMultiprocessorCount, dev) != hipSuccess) { grid = -1; return; }
        if (hipFuncSetAttribute((const void*)mega_fwd, hipFuncAttributeMaxDynamicSharedMemorySize, LDS_BYTES) != hipSuccess) { fprintf(stderr, "kernel_launch: hipFuncSetAttribute failed\n"); grid = -1; return; }
        if (hipOccupancyMaxActiveBlocksPerMultiprocessor(&per_cu, (const void*)mega_fwd, NTHREADS, LDS_BYTES) != hipSuccess || per_cu < 1) { fprintf(stderr, "kernel_launch: occupancy query failed (%d)\n", per_cu); grid = -1; return; }
        grid = cus;
    }
    if (grid < 0) return;
    (void)hipMemsetAsync((unsigned char*)d_ws + WS_CTL, 0, CTL_BYTES, stream);
    Args a{};
    for (int i = 0; i < 26; ++i) a.in[i] = (const float*)d_in[i];
    a.out = (float*)d_out; a.ws = (unsigned char*)d_ws;
    void* kargs[] = {&a};
    hipError_t e = hipLaunchCooperativeKernel((const void*)mega_fwd, dim3(grid), dim3(NTHREADS), kargs, LDS_BYTES, stream);
    if (e != hipSuccess) fprintf(stderr, "kernel_launch: cooperative launch failed: %s (grid %d)\n", hipGetErrorString(e), grid);
}
```

```cpp
#include <hip/hip_runtime.h>
#include <cstdio>
#include <cstdint>

typedef unsigned short bf16_t;
typedef short bf16x8 __attribute__((ext_vector_type(8)));
typedef float f32x4 __attribute__((ext_vector_type(4)));

constexpr int BATCH = 8, SEQ = 4096, D = 1024, M = BATCH * SEQ;
constexpr int HD = 64, ATT_W = 512, KV_W = 128, C = 512, NH = 8;
constexpr int ATT_IN = 768, SHIFT_W = 1792, IN_W = 2560, FF = 2816;
constexpr int WINDOW = 128;
constexpr float RMS_EPS = 1e-5f, LNX_EPS = 64e-5f;

constexpr size_t MiB = 1u << 20;
constexpr size_t WS_CTL = 0;
typedef unsigned long long ssq_t;
__device__ __forceinline__ ssq_t ssq_fix(float s) { return (ssq_t)(s * 1048576.0f + 0.5f); }
__device__ __forceinline__ float ssq_val(ssq_t v) { return (float)v * (1.0f / 1048576.0f); }
constexpr size_t WS_SS = 0;
constexpr size_t CTL_BYTES = 2 * MiB;
constexpr size_t WS_BAR = 1536 * 1024;
constexpr size_t WS_W = 2 * MiB;
constexpr size_t W_IN_SZ = (size_t)IN_W * D * 2, W_OUT_SZ = (size_t)D * D * 2, W_GU_SZ = (size_t)2 * FF * D * 2, W_DN_SZ = (size_t)D * FF * 2;
constexpr size_t W_LAYER = W_IN_SZ + W_OUT_SZ + W_GU_SZ + W_DN_SZ;
constexpr size_t WS_VFIRST = 52 * MiB, WS_MIX = 84 * MiB, WS_XB = 148 * MiB, WS_PROJ = 212 * MiB;
constexpr size_t WS_SI_R = 148 * MiB, WS_SI_K = 180 * MiB, WS_SI_V = 372 * MiB, WS_SI_A = 404 * MiB, WS_SI_LD = 436 * MiB, WS_SI_G = 468 * MiB;
constexpr size_t WS_HID = 212 * MiB;
constexpr size_t WS_UTMP = 84 * MiB;
constexpr size_t WS_END = 500 * MiB;
static_assert(WS_W + 2 * W_LAYER <= WS_VFIRST, "weights fit");

__device__ __forceinline__ unsigned f2bf(float f) { unsigned u = __builtin_bit_cast(unsigned, f); return (u + 0x7fffu + ((u >> 16) & 1u)) >> 16; }
__device__ __forceinline__ float bf2f(bf16_t h) { return __builtin_bit_cast(float, (unsigned)h << 16); }
__device__ __forceinline__ float wave_sum(float v) {
#pragma unroll
    for (int o = 1; o < 64; o <<= 1) v += __shfl_xor(v, o);
    return v;
}
__device__ __forceinline__ float sigmoidf_(float x) { return 1.f / (1.f + __expf(-x)); }

namespace pg8 {
#define PG8_LAS __attribute__((address_space(3)))
typedef unsigned short bf16_t;
typedef short bf16x8 __attribute__((ext_vector_type(8)));
typedef float f32x4 __attribute__((ext_vector_type(4)));
typedef unsigned u32x4 __attribute__((ext_vector_type(4)));
constexpr int BM = 256, BK = 64, HALF = 128, HTB = HALF * BK * 2  , STAGE_BYTES = 8 * HTB, NXCD = 8, WGM = 8;

__host__ __device__ __forceinline__ int lds_byte(int r, int c) { const int st = (r >> 4) * 2 + (c >> 5), rr = r & 15, cc = c & 31, ob = rr * 64 + cc * 2; return st * 1024 + (ob ^ (((ob >> 9) & 1) << 5)); }
__host__ __device__ __forceinline__ void stage_rc(int b, int& R, int& C) { const int st = b / 1024, sb = b % 1024, swz = sb ^ (((sb >> 9) & 1) << 5); R = (st >> 1) * 16 + swz / 64; C = (st & 1) * 32 + (swz % 64) / 2; }
__host__ __device__ __forceinline__ int perm32(int rho) { const int n = rho >> 4, i = rho & 15; return 8 * (i >> 2) + 4 * n + (i & 3); }

struct Unit { int pm, pn; };
struct Gemm { const bf16_t* A; const bf16_t* Bt; int M, N, K; };

struct StaticOrder {
    int nM, nN, nwg, G, c;
    __host__ __device__ void init(int M, int N, int G_, int c_) { nM = M / BM; nN = N / BM; nwg = nM * nN; G = G_; c = c_; }
    __host__ __device__ bool next(int i, Unit& u) const {
        const long L = (long)i * G + c; if (L >= nwg) return false;
        int wgid = (int)L; { const int q = nwg / NXCD, r = nwg % NXCD, xcd = wgid % NXCD, off = wgid / NXCD; wgid = (xcd < r ? xcd * (q + 1) : r * (q + 1) + (xcd - r) * q) + off; }
        const int nig = WGM * nN, gid = wgid / nig, fm = gid * WGM, gsz = (nM - fm) < WGM ? (nM - fm) : WGM;
        u.pm = fm + ((wgid % nig) % gsz); u.pn = (wgid % nig) / gsz; return true;
    }
    __device__ __forceinline__ void a_ready(const Unit&) const {}
    __device__ __forceinline__ void done(const Unit&) const {}
};
typedef float f32x2_t_ __attribute__((ext_vector_type(2))); typedef __bf16 bf16x2_t_ __attribute__((ext_vector_type(2)));
__device__ __forceinline__ unsigned cvt_pk_bf16(float lo, float hi) { const f32x2_t_ v = {lo, hi}; const bf16x2_t_ b = __builtin_convertvector(v, bf16x2_t_); return __builtin_bit_cast(unsigned, b); }
typedef float f32x2 __attribute__((ext_vector_type(2)));
template <class Epi, class Sched, bool ALIGN_EPI = false, bool SP2 = false>
__device__ __forceinline__ void gemm_phase(PG8_LAS unsigned char* lds, const Gemm g, const Sched& S, const Epi& E) {
    int tid_ = threadIdx.x; asm volatile("" : "+v"(tid_));
    const int tid = tid_, wid = __builtin_amdgcn_readfirstlane(tid >> 6), lane = tid & 63, wr = wid >> 2, wc = wid & 3, fr = lane & 15, fq = lane >> 4;
    const int K = g.K, nt = K / BK;
    unsigned voffA[2], voffB[2];
#pragma unroll
    for (int i = 0; i < 2; ++i) { int R, C; stage_rc(tid * 16 + i * 8192, R, C); const int Rb = Epi::PERM ? ((R & ~31) + perm32(R & 31)) : R;
        voffA[i] = (unsigned)(R * K + C) * 2u; voffB[i] = (unsigned)(Rb * K + C) * 2u; }
    const size_t kstep = (size_t)(BK * 2);
    const size_t hstep = (size_t)HALF * K * 2;
    const size_t tstep = 2 * hstep;
    const unsigned ldsw = (unsigned)wid * 1024u;
    const int aoff = lds_byte(wr * 64 + fr, fq * 8), boff = lds_byte(wc * 32 + fr, fq * 8);
#define PG8_SA(b, h) (((b) * 2 + (h)) * HTB)
#define PG8_SB(b, h) ((4 + (b) * 2 + (h)) * HTB)
#define PG8_STAGE(bufoff, gbase, voff) do { _Pragma("unroll") for (int _i = 0; _i < 2; ++_i) \
        __builtin_amdgcn_global_load_lds((const unsigned*)((const char*)(gbase) + (voff)[_i]), (PG8_LAS unsigned*)(lds + (bufoff) + ldsw + _i * 8192), 16, 0, 0); } while (0)
#define PG8_LDA(dst, b, h) do { _Pragma("unroll") for (int m = 0; m < 4; ++m) _Pragma("unroll") for (int k = 0; k < 2; ++k) dst[m][k] = *(const PG8_LAS bf16x8*)(lds + PG8_SA(b, h) + aoff + m * 2048 + k * 1024); } while (0)
#define PG8_LDB(dst, b, h) do { _Pragma("unroll") for (int n = 0; n < 2; ++n) _Pragma("unroll") for (int k = 0; k < 2; ++k) dst[n][k] = *(const PG8_LAS bf16x8*)(lds + PG8_SB(b, h) + boff + n * 2048 + k * 1024); } while (0)
#define PG8_MMA(ai, bj, At, Bt) do { __builtin_amdgcn_s_setprio(1); _Pragma("unroll") for (int m = 0; m < 4; ++m) _Pragma("unroll") for (int n = 0; n < 2; ++n) _Pragma("unroll") for (int k = 0; k < 2; ++k) \
        acc[ai][bj][m][n] = __builtin_amdgcn_mfma_f32_16x16x32_bf16(Bt[n][k], At[m][k], acc[ai][bj][m][n], 0, 0, 0); __builtin_amdgcn_s_setprio(0); } while (0)
#define PG8_WAIT_V(n) asm volatile("s_waitcnt vmcnt(" #n ")" ::: "memory")
#define PG8_WAIT_L(n) asm volatile("s_waitcnt lgkmcnt(" #n ")" ::: "memory")
#define PG8_BAR __builtin_amdgcn_s_barrier()
#define PG8_SCHED __builtin_amdgcn_sched_barrier(0)
    Unit cur, nxt; int ui = 0;
    if (!S.next(0, cur)) return;
    f32x4 acc[2][2][4][2];
#pragma unroll
    for (int a = 0; a < 2; ++a)
#pragma unroll
        for (int b = 0; b < 2; ++b)
#pragma unroll
            for (int m = 0; m < 4; ++m)
#pragma unroll
                for (int n = 0; n < 2; ++n) acc[a][b][m][n] = (f32x4){0.f, 0.f, 0.f, 0.f};
    bf16x8 At[4][2], B0[2][2], B1[2][2];
    const char* cA = (const char*)g.A + (size_t)cur.pm * tstep; const char* cB = (const char*)g.Bt + (size_t)cur.pn * tstep;
    S.a_ready(cur);
    if constexpr (SP2) {
        PG8_STAGE(PG8_SB(0, 0), cB, voffB); PG8_STAGE(PG8_SB(0, 1), cB + hstep, voffB); PG8_STAGE(PG8_SA(0, 0), cA, voffA); PG8_STAGE(PG8_SA(0, 1), cA + hstep, voffA);
        if (wr == 1) PG8_BAR;
        PG8_WAIT_V(2); PG8_BAR;
        PG8_STAGE(PG8_SB(1, 0), cB + kstep, voffB); PG8_STAGE(PG8_SA(1, 0), cA + kstep, voffA); PG8_STAGE(PG8_SB(1, 1), cB + hstep + kstep, voffB);
        PG8_WAIT_V(6); PG8_BAR;
    } else {
        PG8_STAGE(PG8_SB(0, 0), cB, voffB); PG8_STAGE(PG8_SA(0, 0), cA, voffA); PG8_STAGE(PG8_SB(0, 1), cB + hstep, voffB); PG8_STAGE(PG8_SA(0, 1), cA + hstep, voffA);
        if (wr == 1) PG8_BAR;
        PG8_WAIT_V(4); PG8_BAR;
        PG8_STAGE(PG8_SB(1, 0), cB + kstep, voffB); PG8_STAGE(PG8_SA(1, 0), cA + kstep, voffA); PG8_STAGE(PG8_SB(1, 1), cB + hstep + kstep, voffB);
        PG8_WAIT_V(6); PG8_BAR;
    }
    for (;;) {
        const bool has_next = S.next(ui + 1, nxt);
        const char* nA = has_next ? (const char*)g.A + (size_t)nxt.pm * tstep : cA; const char* nB = has_next ? (const char*)g.Bt + (size_t)nxt.pn * tstep : cB;
        for (int t = 0; t < nt; t += 2) {
            const bool last = (t == nt - 2);
            const char* a1 = cA + (size_t)(t + 1) * kstep;
            const char* a2 = last ? nA : cA + (size_t)(t + 2) * kstep; const char* b2 = last ? nB : cB + (size_t)(t + 2) * kstep;
            const char* a3 = a2 + kstep; const char* b3 = b2 + kstep;
            if (last && has_next) S.a_ready(nxt);
            if constexpr (SP2) {
            PG8_LDB(B0, 0, 0); PG8_LDB(B1, 0, 1); PG8_SCHED; PG8_LDA(At, 0, 0); PG8_STAGE(PG8_SA(1, 1), a1 + hstep, voffA);
            PG8_WAIT_V(8); PG8_WAIT_L(0); PG8_BAR; PG8_MMA(0, 0, At, B0); PG8_MMA(0, 1, At, B1); PG8_BAR; PG8_SCHED;
            PG8_LDA(At, 0, 1); PG8_STAGE(PG8_SB(0, 0), b2, voffB); PG8_STAGE(PG8_SB(0, 1), b2 + hstep, voffB); PG8_STAGE(PG8_SA(0, 0), a2, voffA);
            PG8_WAIT_V(8); PG8_WAIT_L(0); PG8_BAR; PG8_MMA(1, 0, At, B0); PG8_MMA(1, 1, At, B1); PG8_BAR; PG8_SCHED;
            PG8_LDB(B0, 1, 0); PG8_LDB(B1, 1, 1); PG8_SCHED; PG8_LDA(At, 1, 0); PG8_STAGE(PG8_SA(0, 1), a2 + hstep, voffA);
            PG8_WAIT_V(8); PG8_WAIT_L(0); PG8_BAR; PG8_MMA(0, 0, At, B0); PG8_MMA(0, 1, At, B1); PG8_BAR; PG8_SCHED;
            PG8_LDA(At, 1, 1); PG8_STAGE(PG8_SB(1, 0), b3, voffB); PG8_STAGE(PG8_SB(1, 1), b3 + hstep, voffB); PG8_STAGE(PG8_SA(1, 0), a3, voffA);
            PG8_WAIT_V(8); PG8_WAIT_L(0); PG8_BAR; PG8_MMA(1, 0, At, B0); PG8_MMA(1, 1, At, B1); PG8_BAR; PG8_SCHED;
            } else {
            PG8_LDB(B0, 0, 0); PG8_SCHED; PG8_LDA(At, 0, 0); PG8_STAGE(PG8_SA(1, 1), a1 + hstep, voffA);
            PG8_WAIT_L(8); PG8_BAR; PG8_WAIT_L(0); PG8_MMA(0, 0, At, B0); PG8_BAR; PG8_SCHED;
            PG8_LDB(B1, 0, 1); PG8_STAGE(PG8_SB(0, 0), b2, voffB);
            PG8_BAR; PG8_WAIT_L(0); PG8_MMA(0, 1, At, B1); PG8_BAR;
            PG8_LDA(At, 0, 1); PG8_STAGE(PG8_SA(0, 0), a2, voffA);
            PG8_BAR; PG8_WAIT_L(0); PG8_MMA(1, 0, At, B0); PG8_BAR; PG8_SCHED;
            PG8_STAGE(PG8_SB(0, 1), b2 + hstep, voffB);
            PG8_WAIT_V(6); PG8_BAR; PG8_MMA(1, 1, At, B1); PG8_BAR;
            PG8_LDB(B0, 1, 0); PG8_SCHED; PG8_LDA(At, 1, 0); PG8_STAGE(PG8_SA(0, 1), a2 + hstep, voffA);
            PG8_WAIT_L(8); PG8_BAR; PG8_WAIT_L(0); PG8_MMA(0, 0, At, B0); PG8_BAR; PG8_SCHED;
            PG8_LDB(B1, 1, 1); PG8_STAGE(PG8_SB(1, 0), b3, voffB);
            PG8_BAR; PG8_WAIT_L(0); PG8_MMA(0, 1, At, B1); PG8_BAR;
            PG8_LDA(At, 1, 1); PG8_STAGE(PG8_SA(1, 0), a3, voffA);
            PG8_BAR; PG8_WAIT_L(0); PG8_MMA(1, 0, At, B0); PG8_BAR; PG8_SCHED;
            PG8_STAGE(PG8_SB(1, 1), b3 + hstep, voffB);
            PG8_WAIT_V(6); PG8_BAR; PG8_MMA(1, 1, At, B1); PG8_BAR;
            }
        }
        if constexpr (ALIGN_EPI) { if (wr == 0) PG8_BAR; }
        if constexpr (!Epi::AFTER_DRAIN) { E(acc, cur, wr, wc, fr, fq); S.done(cur); }
        if (!has_next) break;
#pragma unroll
        for (int a = 0; a < 2; ++a)
#pragma unroll
            for (int b = 0; b < 2; ++b)
#pragma unroll
                for (int m = 0; m < 4; ++m)
#pragma unroll
                    for (int n = 0; n < 2; ++n) acc[a][b][m][n] = (f32x4){0.f, 0.f, 0.f, 0.f};
        cur = nxt; cA = nA; cB = nB; ++ui;
        if constexpr (ALIGN_EPI) { if (wr == 1) PG8_BAR; }
    }
    PG8_WAIT_V(0);
    if constexpr (!ALIGN_EPI) { if (wr == 0) PG8_BAR; }
    PG8_BAR;
    if constexpr (Epi::AFTER_DRAIN) { E.fused(acc, cur, wr, wc, fr, fq, lds, wid, lane); S.done(cur); }
#undef PG8_SA
#undef PG8_SB
#undef PG8_STAGE
#undef PG8_LDA
#undef PG8_LDB
#undef PG8_MMA
#undef PG8_WAIT_V
#undef PG8_WAIT_L
#undef PG8_BAR
#undef PG8_SCHED
}

constexpr int DM_ = 1024; constexpr float RMS_EPS_ = 1e-5f;
typedef unsigned long long ssq_t;
struct EpiScaleBf16 {
    static constexpr bool PERM = true, AFTER_DRAIN = false;
    bf16_t* O; int ldc; const ssq_t* ss;
    __device__ __forceinline__ void operator()(const f32x4 (&acc)[2][2][4][2], const Unit& u, int wr, int wc, int fr, int fq) const {
        const int row0 = u.pm * BM + wr * 64 + fr, col0 = u.pn * BM + wc * 32 + 8 * fq;
        float rsv[2][4];
#pragma unroll
        for (int ai = 0; ai < 2; ++ai)
#pragma unroll
            for (int m = 0; m < 4; ++m) rsv[ai][m] = (float)ss[row0 + ai * HALF + m * 16] * (1.0f / 1048576.0f);
#pragma unroll
        for (int ai = 0; ai < 2; ++ai)
#pragma unroll
            for (int m = 0; m < 4; ++m) { const int row = row0 + ai * HALF + m * 16; const float rs = __builtin_amdgcn_rsqf(rsv[ai][m] * (1.0f / DM_) + RMS_EPS_); bf16_t* rowp = O + (size_t)row * ldc + col0;
#pragma unroll
                for (int bj = 0; bj < 2; ++bj) { const f32x4 v0 = acc[ai][bj][m][0] * rs, v1 = acc[ai][bj][m][1] * rs;
                    u32x4 w; w.x = cvt_pk_bf16(v0[0], v0[1]); w.y = cvt_pk_bf16(v0[2], v0[3]); w.z = cvt_pk_bf16(v1[0], v1[1]); w.w = cvt_pk_bf16(v1[2], v1[3]);
                    *(u32x4*)(rowp + bj * HALF) = w; } }
    }
};
struct EpiResid {
    static constexpr bool PERM = true, AFTER_DRAIN = false;
    bf16_t* xb; ssq_t* ss_out;
    __device__ __forceinline__ void operator()(const f32x4 (&acc)[2][2][4][2], const Unit& u, int wr, int wc, int fr, int fq) const {
        const int row0 = u.pm * BM + wr * 64 + fr, col0 = u.pn * BM + wc * 32 + 8 * fq;
#pragma unroll
        for (int ai = 0; ai < 2; ++ai) {
            u32x4 bs[4][2];
#pragma unroll
            for (int m = 0; m < 4; ++m)
#pragma unroll
                for (int bj = 0; bj < 2; ++bj) bs[m][bj] = *(const u32x4*)(xb + (size_t)(row0 + ai * HALF + m * 16) * DM_ + col0 + bj * HALF);
#pragma unroll
            for (int m = 0; m < 4; ++m) { const int row = row0 + ai * HALF + m * 16; bf16_t* rp = xb + (size_t)row * DM_ + col0; float sq = 0.f;
#pragma unroll
                for (int bj = 0; bj < 2; ++bj) { const u32x4 b = bs[m][bj]; u32x4 w;
#pragma unroll
                    for (int hh = 0; hh < 2; ++hh) { const unsigned b0 = hh == 0 ? b.x : b.z, b1 = hh == 0 ? b.y : b.w; const f32x4 a4 = acc[ai][bj][m][hh];
                        const float x0 = __builtin_bit_cast(float, b0 << 16) + a4[0], x1 = __builtin_bit_cast(float, b0 & 0xffff0000u) + a4[1], x2 = __builtin_bit_cast(float, b1 << 16) + a4[2], x3 = __builtin_bit_cast(float, b1 & 0xffff0000u) + a4[3];
                        const unsigned w0 = cvt_pk_bf16(x0, x1), w1 = cvt_pk_bf16(x2, x3);
                        if (hh == 0) { w.x = w0; w.y = w1; } else { w.z = w0; w.w = w1; }
                        const float r0 = __builtin_bit_cast(float, w0 << 16), r1 = __builtin_bit_cast(float, w0 & 0xffff0000u), r2 = __builtin_bit_cast(float, w1 << 16), r3 = __builtin_bit_cast(float, w1 & 0xffff0000u);
                        sq += (r0 * r0 + r1 * r1) + (r2 * r2 + r3 * r3); }
                    *(u32x4*)(rp + bj * HALF) = w; }
                sq += __shfl_xor(sq, 16); sq += __shfl_xor(sq, 32);
                if (fq == 0) atomicAdd(ss_out + row, (ssq_t)(sq * 1048576.0f + 0.5f)); }
        }
    }
};
struct EpiGateUpTmp {
    static constexpr bool PERM = true, AFTER_DRAIN = false;
    bf16_t* U; bf16_t* UP; const ssq_t* ss; int ff;
    __device__ __forceinline__ void operator()(const f32x4 (&acc)[2][2][4][2], const Unit& u, int wr, int wc, int fr, int fq) const {
        const int row0 = u.pm * BM + wr * 64 + fr, col0 = u.pn * HALF + wc * 32 + 8 * fq;
        float rsv[2][4];
#pragma unroll
        for (int ai = 0; ai < 2; ++ai)
#pragma unroll
            for (int m = 0; m < 4; ++m) rsv[ai][m] = (float)ss[row0 + ai * HALF + m * 16] * (1.0f / 1048576.0f);
#pragma unroll
        for (int ai = 0; ai < 2; ++ai)
#pragma unroll
            for (int m = 0; m < 4; ++m) { const int row = row0 + ai * HALF + m * 16; const float rs = __builtin_amdgcn_rsqf(rsv[ai][m] * (1.0f / DM_) + RMS_EPS_); const size_t o = (size_t)row * ff + col0;
#pragma unroll
                for (int bj = 0; bj < 2; ++bj) { const f32x4 v0 = acc[ai][bj][m][0] * rs, v1 = acc[ai][bj][m][1] * rs;
                    u32x4 w; w.x = cvt_pk_bf16(v0[0], v0[1]); w.y = cvt_pk_bf16(v0[2], v0[3]); w.z = cvt_pk_bf16(v1[0], v1[1]); w.w = cvt_pk_bf16(v1[2], v1[3]);
                    *(u32x4*)((bj == 0 ? U : UP) + o) = w; } }
    }
};
template <int CTRL> __device__ __forceinline__ float dpp1(float x) { return __builtin_bit_cast(float, __builtin_amdgcn_update_dpp(0, __builtin_bit_cast(int, x), CTRL, 0xF, 0xF, true)); }
template <int CTRL> __device__ __forceinline__ f32x4 dpp4(const f32x4 x) { return (f32x4){dpp1<CTRL>(x.x), dpp1<CTRL>(x.y), dpp1<CTRL>(x.z), dpp1<CTRL>(x.w)}; }
struct EpiConvGlu {
    static constexpr bool PERM = true, AFTER_DRAIN = false;
    bf16_t* HID; const ssq_t* ss; const float* cw; const float* cb; float* SB; PG8_LAS float* xch; int ff;
    __device__ __forceinline__ void operator()(const f32x4 (&acc)[2][2][4][2], const Unit& u, int wr, int wc, int fr, int fq) const {
        const int row0 = u.pm * BM + wr * 64 + fr, cl = wc * 32 + 8 * fq, jcol = u.pn * HALF + cl;
        float rs[2][4];
#pragma unroll
        for (int ai = 0; ai < 2; ++ai)
#pragma unroll
            for (int m = 0; m < 4; ++m) rs[ai][m] = (float)ss[row0 + ai * HALF + m * 16] * (1.0f / 1048576.0f);
        f32x4 w0[2], w1[2], w2[2], bb[2];
#pragma unroll
        for (int n = 0; n < 2; ++n) { w0[n] = *(const f32x4*)(cw + jcol + 4 * n); w1[n] = *(const f32x4*)(cw + ff + jcol + 4 * n); w2[n] = *(const f32x4*)(cw + 2 * ff + jcol + 4 * n); bb[n] = *(const f32x4*)(cb + jcol + 4 * n); }
#pragma unroll
        for (int ai = 0; ai < 2; ++ai)
#pragma unroll
            for (int m = 0; m < 4; ++m) rs[ai][m] = __builtin_amdgcn_rsqf(rs[ai][m] * (1.0f / DM_) + RMS_EPS_);
        if (fr >= 14) {
#pragma unroll
            for (int ai = 0; ai < 2; ++ai)
#pragma unroll
                for (int n = 0; n < 2; ++n) *(PG8_LAS f32x4*)(xch + ((2 * ai + wr) * 2 + (fr - 14)) * HALF + cl + 4 * n) = acc[ai][0][3][n] * rs[ai][3];
        }
        asm volatile("s_waitcnt lgkmcnt(0)" ::: "memory"); __builtin_amdgcn_s_barrier(); asm volatile("" ::: "memory");
        float* sbp = SB + (size_t)u.pm * 6 * ff + jcol;
#pragma unroll
        for (int ai = 0; ai < 2; ++ai) {
            const int q = 2 * ai + wr;
            f32x4 X[2];
#pragma unroll
            for (int n = 0; n < 2; ++n) { X[n] = (f32x4){0.f, 0.f, 0.f, 0.f}; if (q > 0 && fr >= 14) X[n] = *(const PG8_LAS f32x4*)(xch + ((q - 1) * 2 + (fr - 14)) * HALF + cl + 4 * n); }
#pragma unroll
            for (int m = 0; m < 4; ++m) { const int row = row0 + ai * HALF + m * 16;
                pg8::u32x4 hw;
#pragma unroll
                for (int n = 0; n < 2; ++n) {
                    const f32x4 cur = acc[ai][0][m][n] * rs[ai][m], up = acc[ai][1][m][n] * rs[ai][m];
                    const f32x4 P = (m > 0) ? acc[ai][0][m > 0 ? m - 1 : 0][n] * rs[ai][m > 0 ? m - 1 : 0] : X[n];
                    const f32x4 a1 = dpp4<0x121>(cur), b1 = dpp4<0x121>(P), a2 = dpp4<0x122>(cur), b2 = dpp4<0x122>(P);
                    f32x4 p1, p2;
#pragma unroll
                    for (int e = 0; e < 4; ++e) { p1[e] = fr == 0 ? b1[e] : a1[e]; p2[e] = fr < 2 ? b2[e] : a2[e]; }
                    const f32x4 c = bb[n] + w0[n] * p2 + w1[n] * p1 + w2[n] * cur;
                    f32x4 hv;
#pragma unroll
                    for (int e = 0; e < 4; ++e) hv[e] = c[e] * __builtin_amdgcn_rcpf(1.f + __expf(-c[e])) * up[e];
                    if (n == 0) { hw.x = cvt_pk_bf16(hv[0], hv[1]); hw.y = cvt_pk_bf16(hv[2], hv[3]); } else { hw.z = cvt_pk_bf16(hv[0], hv[1]); hw.w = cvt_pk_bf16(hv[2], hv[3]); }
                    if (q == 0 && m == 0 && fr < 2) { *(f32x4*)(sbp + (size_t)fr * ff + 4 * n) = cur; *(f32x4*)(sbp + (size_t)(2 + fr) * ff + 4 * n) = up; }
                    if (q == 3 && m == 3 && fr >= 14) *(f32x4*)(sbp + (size_t)(4 + fr - 14) * ff + 4 * n) = cur;
                }
                *(pg8::u32x4*)(HID + (size_t)row * ff + jcol) = hw; }
        }
    }
};
}

#define LAS __attribute__((address_space(3)))
__device__ __forceinline__ void transpose_item(const float* __restrict__ W, int K, int N, bf16_t* __restrict__ Wt, const float* __restrict__ g, int mode, float* scr, int item, int lane) {
    const int nblk = N / 32, kb = item / nblk, nb = item % nblk, k0 = 64 * kb, n0 = 32 * nb;
    int np0 = n0; if (mode == 1) np0 = 256 * (n0 / 128) + (n0 % 128); else if (mode == 2) np0 = 256 * (n0 / 128) + 128 + (n0 % 128);
#pragma unroll 8
    for (int i = 0; i < 32; ++i) { const int kk = 2 * i + (lane >> 5); scr[kk * 33 + (lane & 31)] = W[(size_t)(k0 + kk) * N + n0 + (lane & 31)] * (g ? g[k0 + kk] : 1.f); }
    __builtin_amdgcn_fence(__ATOMIC_RELEASE, "wavefront"); __builtin_amdgcn_wave_barrier(); __builtin_amdgcn_fence(__ATOMIC_ACQUIRE, "wavefront");
    const int c = lane & 7;
#pragma unroll
    for (int j = 0; j < 4; ++j) { const int n = (lane >> 3) + 8 * j; const float* sp = scr + (8 * c) * 33 + n;
        uint4 o; o.x = f2bf(sp[0]) | (f2bf(sp[33]) << 16); o.y = f2bf(sp[2 * 33]) | (f2bf(sp[3 * 33]) << 16); o.z = f2bf(sp[4 * 33]) | (f2bf(sp[5 * 33]) << 16); o.w = f2bf(sp[6 * 33]) | (f2bf(sp[7 * 33]) << 16);
        *(uint4*)(Wt + (size_t)(np0 + n) * K + k0 + 8 * c) = o; }
    __builtin_amdgcn_fence(__ATOMIC_RELEASE, "wavefront"); __builtin_amdgcn_wave_barrier(); __builtin_amdgcn_fence(__ATOMIC_ACQUIRE, "wavefront");
}
__device__ __forceinline__ void x_row_to_bf16(const float* __restrict__ x, bf16_t* __restrict__ xb, ssq_t* __restrict__ ss, int row, int lane) {
    const f32x4* xr = (const f32x4*)(x + (size_t)row * D) + lane; float s = 0.f;
#pragma unroll
    for (int j = 0; j < 4; ++j) { const f32x4 v = xr[64 * j]; s += v.x * v.x + v.y * v.y + v.z * v.z + v.w * v.w;
        unsigned long long o = (unsigned long long)(f2bf(v.x) | (f2bf(v.y) << 16)) | ((unsigned long long)(f2bf(v.z) | (f2bf(v.w) << 16)) << 32);
        ((unsigned long long*)(xb + (size_t)row * D))[lane + 64 * j] = o; }
    s = wave_sum(s); if (lane == 0) ss[row] = ssq_fix(s);
}

struct PrepArgs {
    const bf16_t* proj; const float* mu; const float* w0; const float* w2; const float* a0; const float* a2; const float* g2;
    const float* v0; const float* v1; const float* v2; bf16_t* vfirst; int layer; int pad;
    bf16_t *R, *K, *V, *A, *LD, *G;
};
__device__ __forceinline__ void prep_group(const PrepArgs& p, float (*rest)[SHIFT_W], float (*vlo)[32], int grp, int tid) {
    const int m0 = grp * 4;
    for (int i = tid; i < 4 * SHIFT_W; i += 512) {
        const int tk = i / SHIFT_W, c = i % SHIFT_W, m = m0 + tk, t = m % SEQ;
        const float u = bf2f(p.proj[(size_t)m * IN_W + ATT_IN + c]);
        const float up = t > 0 ? bf2f(p.proj[(size_t)(m - 1) * IN_W + ATT_IN + c]) : 0.f;
        float v = u + (up - u) * p.mu[c];
        if (c >= 1536 && c < 1600) v = tanhf(v); else if (c >= 1664) v = sigmoidf_(v);
        rest[tk][c] = v;
    }
    __syncthreads();
    if (p.layer > 0 && tid < 128) { const int tk = tid >> 5, j = tid & 31; float s = 0.f; for (int c = 0; c < C; ++c) s += rest[tk][1024 + c] * p.v1[c * 32 + j]; vlo[tk][j] = s; }
    __syncthreads();
    const int c = tid;
    float wp[4], ap[4], gp[4];
#pragma unroll
    for (int tk = 0; tk < 4; ++tk) { wp[tk] = p.w0[c]; ap[tk] = p.a0[c]; gp[tk] = 0.f; }
    for (int k = 0; k < 64; ++k) { const float w = p.w2[k * C + c], a = p.a2[k * C + c];
#pragma unroll
        for (int tk = 0; tk < 4; ++tk) { wp[tk] += rest[tk][1536 + k] * w; ap[tk] += rest[tk][1600 + k] * a; } }
    for (int k = 0; k < 128; ++k) { const float g = p.g2[k * C + c];
#pragma unroll
        for (int tk = 0; tk < 4; ++tk) gp[tk] += rest[tk][1664 + k] * g; }
#pragma unroll
    for (int tk = 0; tk < 4; ++tk) {
        const size_t o = (size_t)(m0 + tk) * C + c;
        const float x = -wp[tk];
        const float sp = fmaxf(x, 0.f) + log1pf(__expf(-fabsf(x)));
        const float wraw = -sp - 0.5f;
        const float ld = -__expf(wraw);
        const float a = sigmoidf_(ap[tk]);
        float v = rest[tk][1024 + c];
        if (p.layer == 0) p.vfirst[o] = (bf16_t)f2bf(v);
        else { float s = p.v0[c]; for (int j = 0; j < 32; ++j) s += vlo[tk][j] * p.v2[j * C + c]; const float vf = bf2f(p.vfirst[o]); v = v + (vf - v) * sigmoidf_(s); }
        p.R[o] = (bf16_t)f2bf(rest[tk][c]); p.K[o] = (bf16_t)f2bf(rest[tk][512 + c]); p.V[o] = (bf16_t)f2bf(v);
        p.A[o] = (bf16_t)f2bf(a); p.LD[o] = (bf16_t)f2bf(ld); p.G[o] = (bf16_t)f2bf(gp[tk]);
    }
    __syncthreads();
}

constexpr size_t WS_LORA = 50 * MiB;
constexpr size_t LORA_LAYER = 256 * 1024, WS_V1T = WS_LORA + 2 * LORA_LAYER, WS_V2T = WS_V1T + 32 * 1024;
constexpr int PR_ACT_LD = 264, PR_VLO_LD = 40, PR_SG_LD = 520, PR_ACT_OFF = 0, PR_VLO_OFF = 64 * PR_ACT_LD * 2, PR_SG_OFF = PR_VLO_OFF + 64 * PR_VLO_LD * 2;
struct Prep2Args {
    const bf16_t* proj; const float* mu; const float* w0; const float* a0; const float* v0;
    const bf16_t *W2T, *A2T, *G2T, *V1T, *V2T; bf16_t* vfirst; bf16_t *R, *K, *V, *A, *LD, *G; int layer; int pad;
};
__device__ __forceinline__ f32x4 bfx4_lo(const bf16x8 v) { return (f32x4){bf2f((bf16_t)v[0]), bf2f((bf16_t)v[1]), bf2f((bf16_t)v[2]), bf2f((bf16_t)v[3])}; }
__device__ __forceinline__ f32x4 bfx4_hi(const bf16x8 v) { return (f32x4){bf2f((bf16_t)v[4]), bf2f((bf16_t)v[5]), bf2f((bf16_t)v[6]), bf2f((bf16_t)v[7])}; }
__device__ __forceinline__ bf16x8 pack8(const f32x4 a, const f32x4 b) { pg8::u32x4 w; w.x = pg8::cvt_pk_bf16(a[0], a[1]); w.y = pg8::cvt_pk_bf16(a[2], a[3]); w.z = pg8::cvt_pk_bf16(b[0], b[1]); w.w = pg8::cvt_pk_bf16(b[2], b[3]); return __builtin_bit_cast(bf16x8, w); }
__device__ __forceinline__ void shift8(const bf16_t* __restrict__ proj, const float* __restrict__ mu, size_t m, int t, int col, int mi, f32x4& lo, f32x4& hi) {
    const bf16x8 cur = *(const bf16x8*)(proj + m * IN_W + col);
    bf16x8 prv; if (t > 0) prv = *(const bf16x8*)(proj + (m - 1) * IN_W + col); else prv = (bf16x8){0, 0, 0, 0, 0, 0, 0, 0};
    const f32x4 m0 = *(const f32x4*)(mu + mi), m1 = *(const f32x4*)(mu + mi + 4);
    const f32x4 c0 = bfx4_lo(cur), c1 = bfx4_hi(cur), p0 = bfx4_lo(prv), p1 = bfx4_hi(prv);
    lo = c0 + (p0 - c0) * m0; hi = c1 + (p1 - c1) * m1;
}
__device__ __forceinline__ void prep_tile(const Prep2Args& p, unsigned char* lds, int tile, int tid) {
    const int m0 = tile * 64, wave = __builtin_amdgcn_readfirstlane(tid >> 6), lane = tid & 63, fr = lane & 15, fq = lane >> 4;
    bf16_t* ACT = (bf16_t*)(lds + PR_ACT_OFF); bf16_t* VLO = (bf16_t*)(lds + PR_VLO_OFF); bf16_t* SG = (bf16_t*)(lds + PR_SG_OFF);
#pragma unroll
    for (int it = 0; it < 4; ++it) { const int i = tid + 512 * it, tk = i >> 5, cc = i & 31; const size_t m = (size_t)m0 + tk; const int t = (int)(m % SEQ);
        f32x4 lo, hi; shift8(p.proj, p.mu, m, t, 2304 + 8 * cc, 1536 + 8 * cc, lo, hi);
        if (cc < 8) {
#pragma unroll
            for (int e = 0; e < 4; ++e) { lo[e] = 2.f * sigmoidf_(2.f * lo[e]) - 1.f; hi[e] = 2.f * sigmoidf_(2.f * hi[e]) - 1.f; } }
        else if (cc >= 16) {
#pragma unroll
            for (int e = 0; e < 4; ++e) { lo[e] = sigmoidf_(lo[e]); hi[e] = sigmoidf_(hi[e]); } }
        *(bf16x8*)(ACT + tk * PR_ACT_LD + 8 * cc) = pack8(lo, hi); }
    if (p.layer > 0) {
        const int tb = wave >> 1, jb = wave & 1; const size_t m = (size_t)m0 + 16 * tb + fr; const int t = (int)(m % SEQ);
        f32x4 acc = (f32x4){0.f, 0.f, 0.f, 0.f};
#pragma unroll 4
        for (int ks = 0; ks < 16; ++ks) { f32x4 lo, hi; shift8(p.proj, p.mu, m, t, 1792 + 32 * ks + 8 * fq, 1024 + 32 * ks + 8 * fq, lo, hi);
            const bf16x8 wf = *(const bf16x8*)(p.V1T + (size_t)(16 * jb + fr) * C + 32 * ks + 8 * fq);
            acc = __builtin_amdgcn_mfma_f32_16x16x32_bf16(wf, pack8(lo, hi), acc, 0, 0, 0); }
        uint2 w; w.x = pg8::cvt_pk_bf16(acc[0], acc[1]); w.y = pg8::cvt_pk_bf16(acc[2], acc[3]);
        *(uint2*)(VLO + (16 * tb + fr) * PR_VLO_LD + 16 * jb + 4 * fq) = w;
    }
    __syncthreads();
    const int ch0 = 64 * wave;
#pragma unroll
    for (int arr = 0; arr < 3; ++arr) {
        const int K0 = arr == 0 ? 0 : (arr == 1 ? 64 : 128), KL = arr == 2 ? 128 : 64; const bf16_t* WT = arr == 0 ? p.W2T : (arr == 1 ? p.A2T : p.G2T);
        f32x4 acc[4][4];
#pragma unroll
        for (int tb = 0; tb < 4; ++tb)
#pragma unroll
            for (int cb = 0; cb < 4; ++cb) acc[tb][cb] = (f32x4){0.f, 0.f, 0.f, 0.f};
#pragma unroll
        for (int ks = 0; ks < KL / 32; ++ks) { bf16x8 wf[4], af[4];
#pragma unroll
            for (int cb = 0; cb < 4; ++cb) wf[cb] = *(const bf16x8*)(WT + (size_t)(ch0 + 16 * cb + fr) * KL + 32 * ks + 8 * fq);
#pragma unroll
            for (int tb = 0; tb < 4; ++tb) af[tb] = *(const bf16x8*)(ACT + (16 * tb + fr) * PR_ACT_LD + K0 + 32 * ks + 8 * fq);
#pragma unroll
            for (int tb = 0; tb < 4; ++tb)
#pragma unroll
                for (int cb = 0; cb < 4; ++cb) acc[tb][cb] = __builtin_amdgcn_mfma_f32_16x16x32_bf16(wf[cb], af[tb], acc[tb][cb], 0, 0, 0); }
        bf16_t* OUT = arr == 0 ? p.LD : (arr == 1 ? p.A : p.G);
#pragma unroll
        for (int cb = 0; cb < 4; ++cb) { const int ch = ch0 + 16 * cb + 4 * fq;
            f32x4 bias = (f32x4){0.f, 0.f, 0.f, 0.f}; if (arr == 0) bias = *(const f32x4*)(p.w0 + ch); else if (arr == 1) bias = *(const f32x4*)(p.a0 + ch);
#pragma unroll
            for (int tb = 0; tb < 4; ++tb) { f32x4 x = acc[tb][cb] + bias;
                if (arr == 0) {
#pragma unroll
                    for (int e = 0; e < 4; ++e) { const float z = -x[e]; const float sp = fmaxf(z, 0.f) + __logf(1.f + __expf(-fabsf(z))); x[e] = -__expf(-sp - 0.5f); } }
                else if (arr == 1) {
#pragma unroll
                    for (int e = 0; e < 4; ++e) x[e] = sigmoidf_(x[e]); }
                uint2 w; w.x = pg8::cvt_pk_bf16(x[0], x[1]); w.y = pg8::cvt_pk_bf16(x[2], x[3]);
                *(uint2*)(OUT + ((size_t)m0 + 16 * tb + fr) * C + ch) = w; } }
    }
    if (p.layer > 0) {
        bf16x8 af[4];
#pragma unroll
        for (int tb = 0; tb < 4; ++tb) af[tb] = *(const bf16x8*)(VLO + (16 * tb + fr) * PR_VLO_LD + 8 * fq);
#pragma unroll
        for (int cb = 0; cb < 4; ++cb) { const int ch = ch0 + 16 * cb + 4 * fq; const bf16x8 wf = *(const bf16x8*)(p.V2T + (size_t)(ch0 + 16 * cb + fr) * 32 + 8 * fq); const f32x4 bias = *(const f32x4*)(p.v0 + ch);
#pragma unroll
            for (int tb = 0; tb < 4; ++tb) { f32x4 x = __builtin_amdgcn_mfma_f32_16x16x32_bf16(wf, af[tb], (f32x4){0.f, 0.f, 0.f, 0.f}, 0, 0, 0) + bias;
                uint2 w; w.x = pg8::cvt_pk_bf16(sigmoidf_(x[0]), sigmoidf_(x[1])); w.y = pg8::cvt_pk_bf16(sigmoidf_(x[2]), sigmoidf_(x[3]));
                *(uint2*)(SG + (16 * tb + fr) * PR_SG_LD + ch) = w; } }
    }
    __syncthreads();
#pragma unroll
    for (int sec = 0; sec < 3; ++sec) { bf16_t* OUT = sec == 0 ? p.R : (sec == 1 ? p.K : p.V);
        bf16x8 cu[8], pv[8], vf[8];
#pragma unroll
        for (int it = 0; it < 8; ++it) { const int i = tid + 512 * it, tk = i >> 6, cc = i & 63; const size_t m = (size_t)m0 + tk; const int t = (int)(m % SEQ); const int col = 768 + 512 * sec + 8 * cc;
            cu[it] = *(const bf16x8*)(p.proj + m * IN_W + col); if (t > 0) pv[it] = *(const bf16x8*)(p.proj + (m - 1) * IN_W + col); else pv[it] = (bf16x8){0, 0, 0, 0, 0, 0, 0, 0};
            if (sec == 2 && p.layer > 0) vf[it] = *(const bf16x8*)(p.vfirst + m * C + 8 * cc); }
#pragma unroll
        for (int it = 0; it < 8; ++it) { const int i = tid + 512 * it, tk = i >> 6, cc = i & 63; const size_t m = (size_t)m0 + tk; const int mi = 512 * sec + 8 * cc;
            const f32x4 mu0 = *(const f32x4*)(p.mu + mi), mu1 = *(const f32x4*)(p.mu + mi + 4);
            const f32x4 c0 = bfx4_lo(cu[it]), c1 = bfx4_hi(cu[it]);
            f32x4 lo = c0 + (bfx4_lo(pv[it]) - c0) * mu0, hi = c1 + (bfx4_hi(pv[it]) - c1) * mu1;
            const size_t o = m * C + 8 * cc;
            if (sec == 2) {
                if (p.layer == 0) *(bf16x8*)(p.vfirst + o) = pack8(lo, hi);
                else { const bf16x8 sg = *(const bf16x8*)(SG + tk * PR_SG_LD + 8 * cc);
                    lo = lo + (bfx4_lo(vf[it]) - lo) * bfx4_lo(sg); hi = hi + (bfx4_hi(vf[it]) - hi) * bfx4_hi(sg); } }
            *(bf16x8*)(OUT + o) = pack8(lo, hi); } }
    __syncthreads();
}

constexpr int NTHREADS_ = 512;
constexpr int SC_TB = 32, SC_SLOT = 384, SC_NCH = SEQ / SC_TB;
constexpr size_t WS_RKC = 51 * MiB;
struct ScanArgs { const bf16_t *R, *K, *V, *A, *LD, *G; const float *k_k, *k_a, *r_k, *lnx_g, *lnx_b; bf16_t* mix; float* rkc; };
template <int CTRL> __device__ __forceinline__ float dpp_mov(float x) { return __builtin_bit_cast(float, __builtin_amdgcn_update_dpp(0, __builtin_bit_cast(int, x), CTRL, 0xF, 0xF, true)); }
__device__ __forceinline__ float reduce16(float x) { x += dpp_mov<0xB1>(x); x += dpp_mov<0x4E>(x); x += dpp_mov<0x141>(x); x += dpp_mov<0x140>(x); return x; }
__device__ __forceinline__ void scan_item(const ScanArgs& p, float* lds, int item, int tid) {
    const int chain = item >> 2, q = item & 3, b = chain >> 3, h = chain & 7, wave = __builtin_amdgcn_readfirstlane(tid >> 6), lane = tid & 63;
    float* buf = lds;
    float* ybuf = lds + 2 * SC_TB * SC_SLOT;
    if (wave >= 4) {
        const int lw = wave - 4, lt = lw * 64 + lane, cgl = lane & 15, srow = lane >> 4, ch4 = h * 64 + 4 * cgl;
        const f32x4 kk_c = *(const f32x4*)(p.k_k + ch4), ka_c = *(const f32x4*)(p.k_a + ch4), rk_c = *(const f32x4*)(p.r_k + ch4);
        const size_t rowbase = (size_t)b * SEQ;
        struct LdSet { uint2 r[2], k[2], v[2], a[2], ld[2]; } s0, s1;
#define SC_LOAD(S, chunk) do { _Pragma("unroll") for (int ps = 0; ps < 2; ++ps) { const size_t o = (rowbase + (size_t)(chunk) * SC_TB + 8 * lw + 4 * ps + srow) * C + ch4; \
            S.r[ps] = *(const uint2*)(p.R + o); S.k[ps] = *(const uint2*)(p.K + o); S.v[ps] = *(const uint2*)(p.V + o); S.a[ps] = *(const uint2*)(p.A + o); S.ld[ps] = *(const uint2*)(p.LD + o); } } while (0)
#define SC_UNPK(u) ((f32x4){__builtin_bit_cast(float, (u).x << 16), __builtin_bit_cast(float, (u).x & 0xffff0000u), __builtin_bit_cast(float, (u).y << 16), __builtin_bit_cast(float, (u).y & 0xffff0000u)})
#define SC_PROC(S, chunk, bi) do { _Pragma("unroll") for (int ps = 0; ps < 2; ++ps) { const int st = 8 * lw + 4 * ps + srow; \
            const f32x4 r = SC_UNPK(S.r[ps]), k = SC_UNPK(S.k[ps]), v = SC_UNPK(S.v[ps]), a = SC_UNPK(S.a[ps]), ld = SC_UNPK(S.ld[ps]); \
            f32x4 kk = k * kk_c; const float nrm = sqrtf(reduce16((kk.x * kk.x + kk.z * kk.z) + (kk.y * kk.y + kk.w * kk.w))); kk = kk * (1.f / fmaxf(nrm, 1e-12f)); \
            const f32x4 kp = k * ((a - 1.f) * ka_c + 1.f); const f32x4 t3 = r * kp * rk_c; const float rkc = reduce16((t3.x + t3.z) + (t3.y + t3.w)); \
            float* slot = buf + ((bi) * SC_TB + st) * SC_SLOT + 4 * cgl; \
            *(f32x4*)(slot) = (f32x4){__expf(ld.x), __expf(ld.y), __expf(ld.z), __expf(ld.w)}; *(f32x4*)(slot + 64) = -kk; *(f32x4*)(slot + 128) = kk * a; *(f32x4*)(slot + 192) = kp; *(f32x4*)(slot + 256) = r; *(f32x4*)(slot + 320) = v; \
            if (q == 0 && cgl == 0) p.rkc[(rowbase + (size_t)(chunk) * SC_TB + st) * 8 + h] = rkc; } } while (0)
#define SC_YOUT(chunk, bi) do { _Pragma("unroll") for (int e2 = 0; e2 < 2; ++e2) { const int e = lt + 256 * e2, st = e >> 4, rr = e & 15; \
            p.mix[(rowbase + (size_t)(chunk) * SC_TB + st) * D + ATT_W + h * 64 + 16 * q + rr] = (bf16_t)f2bf(ybuf[(bi) * SC_TB * 16 + e]); } } while (0)
        SC_LOAD(s0, 0); SC_LOAD(s1, 1); SC_PROC(s0, 0, 0);
        __syncthreads();
        for (int c = 0; c < SC_NCH; c += 2) {
            if (c + 2 < SC_NCH) SC_LOAD(s0, c + 2);
            SC_PROC(s1, c + 1, 1);
            if (c >= 1) SC_YOUT(c - 1, 1);
            __syncthreads();
            if (c + 3 < SC_NCH) SC_LOAD(s1, c + 3);
            if (c + 2 < SC_NCH) SC_PROC(s0, c + 2, 0);
            SC_YOUT(c, 0);
            __syncthreads();
        }
        SC_YOUT(SC_NCH - 1, 1);
#undef SC_LOAD
#undef SC_UNPK
#undef SC_PROC
#undef SC_YOUT
    } else {
        const int cg4 = (lane & 15) * 4, rloc = 4 * wave + (lane >> 4);
        f32x4 S = (f32x4){0.f, 0.f, 0.f, 0.f};
#define SC_SCAN(bi) do { const float* bp = buf + (bi) * SC_TB * SC_SLOT + cg4; const float* vp = buf + (bi) * SC_TB * SC_SLOT + 320 + 16 * q + rloc; \
            const unsigned ya = (unsigned)(size_t)(__attribute__((address_space(3))) float*)(((lane & 15) == 0) ? (ybuf + (bi) * SC_TB * 16 + rloc) : (ybuf + 2 * SC_TB * 16 + lane)); \
            f32x4 w = *(const f32x4*)(bp), A = *(const f32x4*)(bp + 64), B = *(const f32x4*)(bp + 128), kp = *(const f32x4*)(bp + 192), r = *(const f32x4*)(bp + 256); float v = vp[0]; \
            _Pragma("unroll") for (int st = 0; st < SC_TB; ++st) { \
                f32x4 wn = w, An = A, Bn = B, kpn = kp, rn = r; float vn = v; \
                if (st + 1 < SC_TB) { wn = *(const f32x4*)(bp + (st + 1) * SC_SLOT); An = *(const f32x4*)(bp + (st + 1) * SC_SLOT + 64); Bn = *(const f32x4*)(bp + (st + 1) * SC_SLOT + 128); \
                    kpn = *(const f32x4*)(bp + (st + 1) * SC_SLOT + 192); rn = *(const f32x4*)(bp + (st + 1) * SC_SLOT + 256); vn = vp[(st + 1) * SC_SLOT]; }     \
                float sa = (S.x * A.x + S.z * A.z) + (S.y * A.y + S.w * A.w); sa = reduce16(sa); \
                S = S * w + (B * sa + kp * v); \
                float y = (S.x * r.x + S.z * r.z) + (S.y * r.y + S.w * r.w); y = reduce16(y); \
                asm volatile("ds_write_b32 %0, %1 offset:%c2" :: "v"(ya), "v"(y), "i"(st * 64)); \
                w = wn; A = An; B = Bn; kp = kpn; r = rn; v = vn; } } while (0)
        __syncthreads();
        for (int c = 0; c < SC_NCH; c += 2) { SC_SCAN(0); __syncthreads(); SC_SCAN(1); __syncthreads(); }
#undef SC_SCAN
    }
    __syncthreads();
}
constexpr int CK_LD = 72, CK_MAT = 64 * CK_LD * 2;
constexpr size_t WS_CKGQ = WS_PROJ, WS_CKCQ = WS_PROJ + 64 * MiB;
__device__ __forceinline__ void ck_mm(f32x4 (&acc)[2], const bf16_t* Qm, const bf16_t* P, int jb, int ib0, int fr, int fq) {
#pragma unroll
    for (int ks = 0; ks < 2; ++ks) { const bf16x8 bq = *(const bf16x8*)(Qm + (16 * jb + fr) * CK_LD + 32 * ks + 8 * fq);
#pragma unroll
        for (int ii = 0; ii < 2; ++ii) { const bf16x8 ap = *(const bf16x8*)(P + (16 * (ib0 + ii) + fr) * CK_LD + 32 * ks + 8 * fq); acc[ii] = __builtin_amdgcn_mfma_f32_16x16x32_bf16(ap, bq, acc[ii], 0, 0, 0); } }
}
__device__ __forceinline__ uint2 ck_pack4(const f32x4 v) { uint2 w; w.x = pg8::cvt_pk_bf16(v[0], v[1]); w.y = pg8::cvt_pk_bf16(v[2], v[3]); return w; }
__device__ __forceinline__ f32x4 ck_unpack4(const uint2 u) { return (f32x4){__builtin_bit_cast(float, u.x << 16), __builtin_bit_cast(float, u.x & 0xffff0000u), __builtin_bit_cast(float, u.y << 16), __builtin_bit_cast(float, u.y & 0xffff0000u)}; }
struct CkRaw { unsigned r[8], k[8], v[8], a[8], ld[8]; };
__device__ __forceinline__ float wave_sum_dpp(float x) {
    x = reduce16(x); const int xi = __builtin_bit_cast(int, x);
    const float r0 = __builtin_bit_cast(float, __builtin_amdgcn_readlane(xi, 0)), r1 = __builtin_bit_cast(float, __builtin_amdgcn_readlane(xi, 16)), r2 = __builtin_bit_cast(float, __builtin_amdgcn_readlane(xi, 32)), r3 = __builtin_bit_cast(float, __builtin_amdgcn_readlane(xi, 48));
    return (r0 + r1) + (r2 + r3); }
__device__ __forceinline__ void ck_load(const ScanArgs& p, CkRaw& w, int unit, int tid) {
    const int chain = unit >> 6, chunk = unit & 63, b = chain >> 3, h = chain & 7, wave = tid >> 6, lane = tid & 63; const int ch = h * 64 + lane; const size_t row0 = (size_t)b * SEQ + chunk * 64 + 8 * wave;
#pragma unroll
    for (int i = 0; i < 8; ++i) { const size_t o = (row0 + i) * C + ch; w.r[i] = p.R[o]; w.k[i] = p.K[o]; w.v[i] = p.V[o]; w.a[i] = p.A[o]; w.ld[i] = p.LD[o]; }
}
__device__ __forceinline__ void ck_precompute(const ScanArgs& p, const CkRaw& raw, unsigned char* lds, bf16_t* GQ, bf16_t* CQ, int unit, int tid) {
    const int chain = unit >> 6, chunk = unit & 63, b = chain >> 3, h = chain & 7, wave = __builtin_amdgcn_readfirstlane(tid >> 6), lane = tid & 63, fr = lane & 15, fq = lane >> 4, jb = wave >> 1, ib0 = 2 * (wave & 1);
    bf16_t* At = (bf16_t*)(lds + 0 * CK_MAT); bf16_t* bt = (bf16_t*)(lds + 1 * CK_MAT); bf16_t* kt = (bf16_t*)(lds + 2 * CK_MAT); bf16_t* rt = (bf16_t*)(lds + 3 * CK_MAT);
    bf16_t* AtT = (bf16_t*)(lds + 4 * CK_MAT); bf16_t* BhT = (bf16_t*)(lds + 5 * CK_MAT); bf16_t* KhT = (bf16_t*)(lds + 6 * CK_MAT); bf16_t* VT = (bf16_t*)(lds + 7 * CK_MAT);
    bf16_t* NT = (bf16_t*)(lds + 8 * CK_MAT); bf16_t* Mm = (bf16_t*)(lds + 9 * CK_MAT); bf16_t* P1 = (bf16_t*)(lds + 10 * CK_MAT); bf16_t* P2 = (bf16_t*)(lds + 11 * CK_MAT);
    bf16_t* Ta = (bf16_t*)(lds + 12 * CK_MAT); bf16_t* Tb = (bf16_t*)(lds + 13 * CK_MAT); float* WT = (float*)(lds + 14 * CK_MAT); float* GL = WT + 512;
    bf16_t* W1T = bt; bf16_t* MVT = kt; bf16_t* W2T = At;
    {
        const int ch = h * 64 + lane; const size_t row0 = (size_t)b * SEQ + chunk * 64 + 8 * wave;
        const float kk_c = p.k_k[ch], ka_c = p.k_a[ch], rk_c = p.r_k[ch];
        float r[8], kp[8], Aq[8], bq[8], v[8], ld[8], cl[8]; float run = 0.f;
#pragma unroll
        for (int i = 0; i < 8; ++i) { r[i] = bf2f((bf16_t)raw.r[i]); kp[i] = bf2f((bf16_t)raw.k[i]); v[i] = bf2f((bf16_t)raw.v[i]); bq[i] = bf2f((bf16_t)raw.a[i]); ld[i] = bf2f((bf16_t)raw.ld[i]); }
#pragma unroll
        for (int i = 0; i < 8; ++i) { const float k = kp[i], a = bq[i]; float kk = k * kk_c; kk = kk * fminf(__builtin_amdgcn_rsqf(wave_sum_dpp(kk * kk)), 1e12f);
            kp[i] = k * (1.f + (a - 1.f) * ka_c); Aq[i] = -kk; bq[i] = kk * a; const float rkc = wave_sum_dpp(r[i] * kp[i] * rk_c);
            if (lane == 0) p.rkc[(row0 + i) * 8 + h] = rkc; run += ld[i]; cl[i] = run; }
        WT[wave * 64 + lane] = run;
        __syncthreads();
        float off = 0.f, csL = 0.f;
#pragma unroll
        for (int w2 = 0; w2 < 8; ++w2) { const float t = WT[w2 * 64 + lane]; csL += t; if (w2 < wave) off += t; }
        if (wave == 0) GL[lane] = __expf(csL);
        float aT[8], bhT[8], khT[8];
#pragma unroll
        for (int i = 0; i < 8; ++i) { const float cs = off + cl[i], em = __expf(cs - ld[i]), en = __expf(-cs), ep = __expf(cs), eL = __expf(csL - cs); const int tl = 8 * wave + i;
            const float at = Aq[i] * em; aT[i] = at; bhT[i] = bq[i] * eL; khT[i] = kp[i] * eL;
            At[tl * CK_LD + lane] = (bf16_t)f2bf(at); bt[tl * CK_LD + lane] = (bf16_t)f2bf(bq[i] * en); kt[tl * CK_LD + lane] = (bf16_t)f2bf(kp[i] * en); rt[tl * CK_LD + lane] = (bf16_t)f2bf(r[i] * ep); }
        *(bf16x8*)(AtT + lane * CK_LD + 8 * wave) = pack8((f32x4){aT[0], aT[1], aT[2], aT[3]}, (f32x4){aT[4], aT[5], aT[6], aT[7]});
        *(bf16x8*)(BhT + lane * CK_LD + 8 * wave) = pack8((f32x4){bhT[0], bhT[1], bhT[2], bhT[3]}, (f32x4){bhT[4], bhT[5], bhT[6], bhT[7]});
        *(bf16x8*)(KhT + lane * CK_LD + 8 * wave) = pack8((f32x4){khT[0], khT[1], khT[2], khT[3]}, (f32x4){khT[4], khT[5], khT[6], khT[7]});
        *(bf16x8*)(VT + lane * CK_LD + 8 * wave) = pack8((f32x4){v[0], v[1], v[2], v[3]}, (f32x4){v[4], v[5], v[6], v[7]});
    }
    __syncthreads();
    const int j = 16 * jb + fr; const f32x4 z4 = (f32x4){0.f, 0.f, 0.f, 0.f};
    { f32x4 aN[2] = {z4, z4}, aNT[2] = {z4, z4}, aM[2] = {z4, z4}, aP1[2] = {z4, z4}, aP2[2] = {z4, z4};
      ck_mm(aN, At, bt, jb, ib0, fr, fq); ck_mm(aNT, bt, At, jb, ib0, fr, fq); ck_mm(aM, At, kt, jb, ib0, fr, fq); ck_mm(aP1, rt, bt, jb, ib0, fr, fq); ck_mm(aP2, rt, kt, jb, ib0, fr, fq);
#pragma unroll
      for (int ii = 0; ii < 2; ++ii) { const int i0 = 16 * (ib0 + ii) + 4 * fq; f32x4 t0, nt, mm, p1, p2;
#pragma unroll
          for (int e = 0; e < 4; ++e) { const int i = i0 + e; t0[e] = (i < j ? aN[ii][e] : 0.f) + (i == j ? 1.f : 0.f); nt[e] = j < i ? aNT[ii][e] : 0.f; mm[e] = i < j ? aM[ii][e] : 0.f; p1[e] = i <= j ? aP1[ii][e] : 0.f; p2[e] = i <= j ? aP2[ii][e] : 0.f; }
          *(uint2*)(Ta + j * CK_LD + i0) = ck_pack4(t0); *(uint2*)(NT + j * CK_LD + i0) = ck_pack4(nt); *(uint2*)(Mm + j * CK_LD + i0) = ck_pack4(mm); *(uint2*)(P1 + j * CK_LD + i0) = ck_pack4(p1); *(uint2*)(P2 + j * CK_LD + i0) = ck_pack4(p2); } }
    __syncthreads();
#pragma unroll
    for (int st = 0; st < 3; ++st) { const bf16_t* src = (st & 1) ? Tb : Ta; bf16_t* dst = (st & 1) ? Ta : Tb; f32x4 a2[2] = {z4, z4}; ck_mm(a2, src, NT, jb, ib0, fr, fq);
#pragma unroll
        for (int ii = 0; ii < 2; ++ii) { const int i0 = 16 * (ib0 + ii) + 4 * fq; f32x4 t = a2[ii];
#pragma unroll
            for (int e = 0; e < 4; ++e) t[e] += (i0 + e == j) ? 1.f : 0.f;
            *(uint2*)(dst + j * CK_LD + i0) = ck_pack4(t); }
        __syncthreads(); }
    { f32x4 a1[2] = {z4, z4}, a2[2] = {z4, z4}; ck_mm(a1, AtT, Tb, jb, ib0, fr, fq); ck_mm(a2, VT, Mm, jb, ib0, fr, fq);
#pragma unroll
      for (int ii = 0; ii < 2; ++ii) { const int i0 = 16 * (ib0 + ii) + 4 * fq; *(uint2*)(W1T + j * CK_LD + i0) = ck_pack4(a1[ii]); *(uint2*)(MVT + j * CK_LD + i0) = ck_pack4(a2[ii]); } }
    __syncthreads();
    { f32x4 a1[2] = {z4, z4}; ck_mm(a1, MVT, Tb, jb, ib0, fr, fq);
#pragma unroll
      for (int ii = 0; ii < 2; ++ii) { const int i0 = 16 * (ib0 + ii) + 4 * fq; *(uint2*)(W2T + j * CK_LD + i0) = ck_pack4(a1[ii]); } }
    __syncthreads();
    { f32x4 aQ1[2] = {z4, z4}, aG[2] = {z4, z4}, aQ2[2] = {z4, z4}, aC[2] = {z4, z4};
      ck_mm(aQ1, P1, W1T, jb, ib0, fr, fq); ck_mm(aG, BhT, W1T, jb, ib0, fr, fq); ck_mm(aQ2, P1, W2T, jb, ib0, fr, fq); ck_mm(aQ2, P2, VT, jb, ib0, fr, fq); ck_mm(aC, W2T, BhT, jb, ib0, fr, fq); ck_mm(aC, VT, KhT, jb, ib0, fr, fq);
      bf16_t* gq = GQ + (size_t)unit * 8192; bf16_t* cq = CQ + (size_t)unit * 8192; const float glj = GL[j];
#pragma unroll
      for (int ii = 0; ii < 2; ++ii) { const int i0 = 16 * (ib0 + ii) + 4 * fq; f32x4 g = aG[ii];
#pragma unroll
          for (int e = 0; e < 4; ++e) g[e] += (i0 + e == j) ? glj : 0.f;
          const f32x4 q1 = aQ1[ii] + ck_unpack4(*(const uint2*)(rt + j * CK_LD + i0));
          *(uint2*)(gq + j * 64 + i0) = ck_pack4(g); *(uint2*)(gq + 4096 + j * 64 + i0) = ck_pack4(q1); *(uint2*)(cq + j * 64 + i0) = ck_pack4(aC[ii]); *(uint2*)(cq + 4096 + j * 64 + i0) = ck_pack4(aQ2[ii]); } }
    __syncthreads();
}
__device__ __forceinline__ void ck_sequential(const ScanArgs& p, unsigned char* lds, const bf16_t* GQ, const bf16_t* CQ, int item, int tid) {
    const int chain = item >> 2, q = item & 3, b = chain >> 3, h = chain & 7, wave = __builtin_amdgcn_readfirstlane(tid >> 6), lane = tid & 63, fr = lane & 15, fq = lane >> 4;
    bf16_t* OPS = (bf16_t*)lds;
    bf16_t* HT = (bf16_t*)(lds + 4 * CK_MAT);
    for (int i = tid; i < 2 * 16 * CK_LD / 2; i += NTHREADS_) ((unsigned*)HT)[i] = 0u;
    const size_t ubase = (size_t)chain * 64; const size_t rowbase = (size_t)b * SEQ;
    const int prow0 = tid >> 3, pcol = (tid & 7) * 8;
    const int aoff = wave < 4 ? (4096 + (16 * wave + fr) * 64 + 16 * q + 4 * fq) : ((16 * q + fr) * 64 + 16 * (wave - 4) + 4 * fq);
    typedef unsigned u32x2_ __attribute__((ext_vector_type(2)));
    pg8::u32x4 g0_0, g0_1, g0_2, g0_3, g1_0, g1_1, g1_2, g1_3; u32x2_ ad_0, ad_1, ad_2, ad_3;
#define CK_FETCH(slot, cc) do { const bf16_t* gq = GQ + (ubase + (cc)) * 8192; g0_##slot = *(const pg8::u32x4*)(gq + (size_t)prow0 * 64 + pcol); g1_##slot = *(const pg8::u32x4*)(gq + (size_t)(prow0 + 64) * 64 + pcol); \
        ad_##slot = *(const u32x2_*)(CQ + (ubase + (cc)) * 8192 + aoff); } while (0)
#define CK_STAGE(slot, buf) do { *(pg8::u32x4*)(OPS + (buf) * 2 * 64 * CK_LD + prow0 * CK_LD + pcol) = g0_##slot; *(pg8::u32x4*)(OPS + (buf) * 2 * 64 * CK_LD + 64 * CK_LD + prow0 * CK_LD + pcol) = g1_##slot; } while (0)
    CK_FETCH(0, 0); CK_FETCH(1, 1); CK_FETCH(2, 2); CK_FETCH(3, 3);
    CK_STAGE(0, 0);
    __syncthreads();
#define CK_STEP(cc, slot, nslot) do { const int bi = (cc) & 1; const bf16_t* Gm = OPS + bi * 2 * 64 * CK_LD; const bf16_t* Q1m = Gm + 64 * CK_LD; const bf16_t* HTc = HT + bi * 16 * CK_LD; bf16_t* HTn = HT + (bi ^ 1) * 16 * CK_LD; \
        f32x4 acc = (f32x4){0.f, 0.f, 0.f, 0.f}; \
        if (wave < 4) { _Pragma("unroll") for (int ks = 0; ks < 2; ++ks) acc = __builtin_amdgcn_mfma_f32_16x16x32_bf16(*(const bf16x8*)(HTc + fr * CK_LD + 32 * ks + 8 * fq), *(const bf16x8*)(Q1m + (16 * wave + fr) * CK_LD + 32 * ks + 8 * fq), acc, 0, 0, 0); \
            acc = acc + ck_unpack4((uint2){ad_##slot.x, ad_##slot.y}); \
            *(uint2*)(p.mix + (rowbase + (size_t)(cc) * 64 + 16 * wave + fr) * D + ATT_W + h * 64 + 16 * q + 4 * fq) = ck_pack4(acc); } \
        else { _Pragma("unroll") for (int ks = 0; ks < 2; ++ks) acc = __builtin_amdgcn_mfma_f32_16x16x32_bf16(*(const bf16x8*)(Gm + (16 * (wave - 4) + fr) * CK_LD + 32 * ks + 8 * fq), *(const bf16x8*)(HTc + fr * CK_LD + 32 * ks + 8 * fq), acc, 0, 0, 0); \
            acc = acc + ck_unpack4((uint2){ad_##slot.x, ad_##slot.y}); \
            *(uint2*)(HTn + fr * CK_LD + 16 * (wave - 4) + 4 * fq) = ck_pack4(acc); } \
        if ((cc) + 1 < 64) CK_STAGE(nslot, bi ^ 1); \
        if ((cc) + 4 < 64) CK_FETCH(slot, (cc) + 4); \
        __syncthreads(); } while (0)
    for (int c = 0; c < 64; c += 4) { CK_STEP(c, 0, 1); CK_STEP(c + 1, 1, 2); CK_STEP(c + 2, 2, 3); CK_STEP(c + 3, 3, 0); }
#undef CK_FETCH
#undef CK_STAGE
#undef CK_STEP
}

__device__ __forceinline__ float red8(float x) { x += dpp_mov<0xB1>(x); x += dpp_mov<0x4E>(x); x += dpp_mov<0x141>(x); return x; }
__device__ __forceinline__ void scan_post_rows(const ScanArgs& p, int m0, int lane) {
    const int ch8 = 8 * lane, hh = lane >> 3;
    const f32x4 lg0 = *(const f32x4*)(p.lnx_g + ch8), lg1 = *(const f32x4*)(p.lnx_g + ch8 + 4), lb0 = *(const f32x4*)(p.lnx_b + ch8), lb1 = *(const f32x4*)(p.lnx_b + ch8 + 4);
    bf16x8 yv[2], vv[2], gv[2]; float rk[2];
#pragma unroll
    for (int u = 0; u < 2; ++u) { const size_t m = (size_t)m0 + u; yv[u] = *(const bf16x8*)(p.mix + m * D + ATT_W + ch8); vv[u] = *(const bf16x8*)(p.V + m * C + ch8); gv[u] = *(const bf16x8*)(p.G + m * C + ch8); rk[u] = p.rkc[m * 8 + hh]; }
#pragma unroll
    for (int u = 0; u < 2; ++u) { const size_t m = (size_t)m0 + u;
        f32x4 y0 = bfx4_lo(yv[u]), y1 = bfx4_hi(yv[u]);
        const float mean = red8((y0.x + y0.y) + (y0.z + y0.w) + (y1.x + y1.y) + (y1.z + y1.w)) * (1.f / 64.f);
        y0 = y0 - mean; y1 = y1 - mean;
        const float var = red8((y0.x * y0.x + y0.y * y0.y) + (y0.z * y0.z + y0.w * y0.w) + (y1.x * y1.x + y1.y * y1.y) + (y1.z * y1.z + y1.w * y1.w)) * (1.f / 64.f);
        const float rs = rsqrtf(var + LNX_EPS);
        const f32x4 o0 = (y0 * rs * lg0 + lb0 + bfx4_lo(vv[u]) * rk[u]) * bfx4_lo(gv[u]), o1 = (y1 * rs * lg1 + lb1 + bfx4_hi(vv[u]) * rk[u]) * bfx4_hi(gv[u]);
        *(bf16x8*)(p.mix + m * D + ATT_W + ch8) = pack8(o0, o1); }
}

typedef float f32x16 __attribute__((ext_vector_type(16)));
typedef short s16x4 __attribute__((ext_vector_type(4)));
constexpr int AT_VTS = 196;
__device__ __forceinline__ int crow(int r, int hi) { return (r & 3) + 8 * (r >> 2) + 4 * hi; }
__device__ __forceinline__ void attn_unit(const bf16_t* __restrict__ proj, const float* __restrict__ sinks, bf16_t* __restrict__ mix, bf16_t* vt, int unit, int tid) {
    const int b = unit >> 7, kvh = (unit >> 6) & 1, qb = unit & 63, Q0 = qb * 64;
    const int wave = __builtin_amdgcn_readfirstlane(tid >> 6), lane = tid & 63, c = lane & 31, hi = lane >> 5, g = wave >> 1, half = wave & 1, h = kvh * 4 + g;
    const size_t rowb = (size_t)b * SEQ;
    for (int i = tid; i < 192 * 8; i += 512) { const int kl = i >> 3, ch8 = i & 7; int key = Q0 - 128 + kl; key = key < 0 ? 0 : key;
        const bf16x8 v = *(const bf16x8*)(proj + (rowb + key) * IN_W + 640 + kvh * 64 + ch8 * 8);
#pragma unroll
        for (int e = 0; e < 8; ++e) vt[(ch8 * 8 + e) * AT_VTS + kl] = (bf16_t)v[e]; }
    __syncthreads();
    const int t0 = Q0 + 32 * half; const size_t mq = rowb + t0 + c;
    bf16x8 qf[4];
#pragma unroll
    for (int ks = 0; ks < 4; ++ks) qf[ks] = *(const bf16x8*)(proj + mq * IN_W + h * 64 + 16 * ks + 8 * hi);
    f32x16 p[5];
#pragma unroll
    for (int kb = 0; kb < 5; ++kb) { int key = t0 - 128 + 32 * kb + c; key = key < 0 ? 0 : key; const bf16_t* kp = proj + (rowb + key) * IN_W + 512 + kvh * 64 + 8 * hi;
        f32x16 acc;
#pragma unroll
        for (int r = 0; r < 16; ++r) acc[r] = 0.f;
#pragma unroll
        for (int ks = 0; ks < 4; ++ks) acc = __builtin_amdgcn_mfma_f32_32x32x16_bf16(*(const bf16x8*)(kp + 16 * ks), qf[ks], acc, 0, 0, 0);
        p[kb] = acc; }
    const float slope = exp2f(-(float)(h + 1)), sink = sinks[h];
    float mx = sink;
#pragma unroll
    for (int kb = 0; kb < 5; ++kb)
#pragma unroll
        for (int r = 0; r < 16; ++r) { const int cr = crow(r, hi), dist = c + 128 - 32 * kb - cr, key = t0 - 128 + 32 * kb + cr;
            const float sc = (dist >= 0 && dist < WINDOW && key >= 0) ? p[kb][r] * 0.125f - slope * (float)dist : -1e30f; p[kb][r] = sc; mx = fmaxf(mx, sc); }
    mx = fmaxf(mx, __shfl_xor(mx, 32));
    float l = 0.f;
#pragma unroll
    for (int kb = 0; kb < 5; ++kb)
#pragma unroll
        for (int r = 0; r < 16; ++r) { const float e = __expf(p[kb][r] - mx); p[kb][r] = e; l += e; }
    l += __shfl_xor(l, 32); l += __expf(sink - mx);
    f32x16 o[2];
#pragma unroll
    for (int d = 0; d < 2; ++d)
#pragma unroll
        for (int r = 0; r < 16; ++r) o[d][r] = 0.f;
#pragma unroll
    for (int kb = 0; kb < 5; ++kb)
#pragma unroll
        for (int s2 = 0; s2 < 2; ++s2) {
            pg8::u32x4 pw; pw.x = pg8::cvt_pk_bf16(p[kb][8 * s2 + 0], p[kb][8 * s2 + 1]); pw.y = pg8::cvt_pk_bf16(p[kb][8 * s2 + 2], p[kb][8 * s2 + 3]);
            pw.z = pg8::cvt_pk_bf16(p[kb][8 * s2 + 4], p[kb][8 * s2 + 5]); pw.w = pg8::cvt_pk_bf16(p[kb][8 * s2 + 6], p[kb][8 * s2 + 7]);
            const bf16x8 pf = __builtin_bit_cast(bf16x8, pw);
#pragma unroll
            for (int d = 0; d < 2; ++d) { const bf16_t* vp = vt + (32 * d + c) * AT_VTS + 32 * half + 32 * kb + 16 * s2 + 4 * hi;
                const s16x4 lo = *(const s16x4*)vp, hh = *(const s16x4*)(vp + 8);
                const bf16x8 vf = (bf16x8){lo[0], lo[1], lo[2], lo[3], hh[0], hh[1], hh[2], hh[3]};
                o[d] = __builtin_amdgcn_mfma_f32_32x32x16_bf16(vf, pf, o[d], 0, 0, 0); } }
    const float inv = 1.f / l;
#pragma unroll
    for (int d = 0; d < 2; ++d)
#pragma unroll
        for (int rg = 0; rg < 4; ++rg) { uint2 w; w.x = pg8::cvt_pk_bf16(o[d][4 * rg] * inv, o[d][4 * rg + 1] * inv); w.y = pg8::cvt_pk_bf16(o[d][4 * rg + 2] * inv, o[d][4 * rg + 3] * inv);
            *(uint2*)(mix + mq * D + h * 64 + 32 * d + 8 * rg + 4 * hi) = w; }
    __syncthreads();
}

__device__ __forceinline__ void conv_item(const bf16_t* __restrict__ U, const bf16_t* __restrict__ UP, const float* __restrict__ cw, const float* __restrict__ cb, bf16_t* __restrict__ hid, size_t i) {
    const int t = (int)(i / FF), j = (int)(i % FF);
    const float u0 = bf2f(U[i]), u1 = t >= 1 ? bf2f(U[i - FF]) : 0.f, u2 = t >= 2 ? bf2f(U[i - 2 * FF]) : 0.f;
    const float c = cb[j] + cw[j] * u2 + cw[FF + j] * u1 + cw[2 * FF + j] * u0;
    hid[i] = (bf16_t)f2bf(c * sigmoidf_(c) * bf2f(UP[i]));
}

__device__ __forceinline__ void ffn_fixup(const float* __restrict__ SB, const float* __restrict__ cw, const float* __restrict__ cb, bf16_t* hid, int pm, int tid) {
    const float* s = SB + (size_t)pm * 6 * FF; const float* sp = SB + (size_t)(pm - 1) * 6 * FF; const bool has_prev = (pm % (SEQ / 256)) != 0;
    for (int idx = tid; idx < 2 * FF; idx += NTHREADS_) { const int rr = idx / FF, j = idx % FF;
        const float u0 = s[j], u1 = s[FF + j], ul0 = has_prev ? sp[4 * FF + j] : 0.f, ul1 = has_prev ? sp[5 * FF + j] : 0.f;
        const float c = rr == 0 ? cb[j] + cw[j] * ul0 + cw[FF + j] * ul1 + cw[2 * FF + j] * u0 : cb[j] + cw[j] * ul1 + cw[FF + j] * u0 + cw[2 * FF + j] * u1;
        hid[(size_t)(pm * 256 + rr) * FF + j] = (bf16_t)f2bf(c * sigmoidf_(c) * s[(2 + rr) * FF + j]); }
}

__device__ __forceinline__ void final_row(const bf16_t* __restrict__ xb, float* __restrict__ out, const ssq_t* __restrict__ ss, const float* __restrict__ g, int row, int lane) {
    const float rstd = rsqrtf(ssq_val(ss[row]) * (1.f / D) + RMS_EPS);
    const bf16x8* xr = (const bf16x8*)(xb + (size_t)row * D) + lane; f32x4* orow = (f32x4*)(out + (size_t)row * D) + 2 * lane; const f32x4* gr = (const f32x4*)g + 2 * lane;
#pragma unroll
    for (int j = 0; j < 2; ++j) { const bf16x8 v = xr[64 * j]; const f32x4 g0 = gr[128 * j], g1 = gr[128 * j + 1];
        orow[128 * j] = (f32x4){bf2f((bf16_t)v[0]), bf2f((bf16_t)v[1]), bf2f((bf16_t)v[2]), bf2f((bf16_t)v[3])} * g0 * rstd;
        orow[128 * j + 1] = (f32x4){bf2f((bf16_t)v[4]), bf2f((bf16_t)v[5]), bf2f((bf16_t)v[6]), bf2f((bf16_t)v[7])} * g1 * rstd; }
}

#define XB_TMO      128
#define XB_XCNT(j)  (256  + 64 * (j))
#define XB_XSUB(j)  (1280 + 64 * (j))
#define XB_XGEN(j)  (2304 + 64 * (j))
#define XB_TOP      3328
#define XB_TOPGEN   3392
#define XCD_BAR_WORDS 3456
#define XB_SPIN_CAP (1u << 18)

__device__ __forceinline__ unsigned xb_ld(unsigned* p)              { return __hip_atomic_load(p, __ATOMIC_RELAXED, __HIP_MEMORY_SCOPE_AGENT); }
__device__ __forceinline__ unsigned xb_add(unsigned* p, unsigned v) { return __hip_atomic_fetch_add(p, v, __ATOMIC_RELAXED, __HIP_MEMORY_SCOPE_AGENT); }
__device__ __forceinline__ unsigned xb_xcc_id() { return (unsigned)__builtin_amdgcn_s_getreg((3 << 11) | 20) & 0xFu; }
#define XB_SPIN(cond, bar) do { unsigned _sp = 0; while (cond) { __builtin_amdgcn_s_sleep(1); \
    if ((++_sp & 255u) == 0u) { if (xb_ld(&(bar)[XB_TMO])) break; if (_sp > XB_SPIN_CAP) { atomicAdd(&(bar)[XB_TMO], 1u); break; } } } } while (0)

struct XcdBarrier {
    unsigned* bar; unsigned x;
    volatile __attribute__((address_space(3))) unsigned* st;
};

__device__ __forceinline__ XcdBarrier xcd_barrier_post(unsigned* bar, volatile __attribute__((address_space(3))) unsigned* st) {
    XcdBarrier b; b.bar = bar; b.x = xb_xcc_id(); b.st = st;
    if (threadIdx.x == 0) (void)xb_add(&bar[XB_XCNT(b.x)], 1u);
    return b;
}
__device__ __forceinline__ void xcd_barrier_complete(unsigned* bar, unsigned x, unsigned& nloc, unsigned& nx) {
    const unsigned G = gridDim.x * gridDim.y * gridDim.z;
    unsigned sum, cnt, mine, sp = 0u;
    for (;;) {
        sum = 0u; cnt = 0u; mine = 0u;
#pragma unroll
        for (unsigned j = 0; j < 16; ++j) { const unsigned c = xb_ld(&bar[XB_XCNT(j)]); sum += c; cnt += (c > 0u) ? 1u : 0u; mine = (j == x) ? c : mine; }
        if (sum == G) break;
        __builtin_amdgcn_s_sleep(1);
        if ((++sp & 255u) == 0u) { if (xb_ld(&bar[XB_TMO])) break; if (sp > XB_SPIN_CAP) { atomicAdd(&bar[XB_TMO], 1u); break; } }
    }
    nloc = mine > 0u ? mine : 1u; nx = cnt > 0u ? cnt : 1u;
}

__device__ __forceinline__ void xcd_barrier(const XcdBarrier& b) {
    asm volatile("s_waitcnt vmcnt(0)" ::: "memory");
    __syncthreads();
    if (threadIdx.x == 0) {
        unsigned* bar = b.bar;
        __builtin_amdgcn_s_waitcnt(0);
        unsigned nloc = b.st[0], nx = b.st[1];
        if (nloc == 0u) { xcd_barrier_complete(bar, b.x, nloc, nx); b.st[0] = nloc; b.st[1] = nx; }
        const unsigned old = xb_add(&bar[XB_XSUB(b.x)], 1u);
        const unsigned gen = old / nloc;
        if (old + 1u == (gen + 1u) * nloc) {
            __builtin_amdgcn_fence(__ATOMIC_RELEASE, "agent");
            asm volatile("s_waitcnt vmcnt(0)" ::: "memory");
            const unsigned og = xb_add(&bar[XB_TOP], 1u);
            const unsigned tg = og / nx;
            if (og + 1u == (tg + 1u) * nx) xb_add(&bar[XB_TOPGEN], 1u);
            else XB_SPIN(xb_ld(&bar[XB_TOPGEN]) == tg, bar);
            __builtin_amdgcn_fence(__ATOMIC_ACQUIRE, "agent");
            xb_add(&bar[XB_XGEN(b.x)], 1u);
            asm volatile("s_waitcnt vmcnt(0)" ::: "memory");
        } else {
            XB_SPIN(xb_ld(&bar[XB_XGEN(b.x)]) == gen, bar);
            __builtin_amdgcn_fence(__ATOMIC_ACQUIRE, "agent");
            asm volatile("s_waitcnt vmcnt(0)" ::: "memory");
        }
    }
    __syncthreads();
}

constexpr int NTHREADS = 512, LDS_BYTES = 147456;
struct Args { const float* in[26]; float* out; unsigned char* ws; };
__global__ void __launch_bounds__(NTHREADS, 2) mega_fwd(Args a) {
    extern __shared__ __attribute__((aligned(16))) unsigned char lds[];
    constexpr int MISC_OFF = 131072 + 4096;
    { volatile __attribute__((address_space(3))) unsigned* misc = (volatile __attribute__((address_space(3))) unsigned*)((__attribute__((address_space(3))) unsigned char*)lds + MISC_OFF);
      if (threadIdx.x < 4) misc[threadIdx.x] = 0u; }
    __syncthreads();
    (void)xcd_barrier_post((unsigned*)(a.ws + WS_BAR), (volatile __attribute__((address_space(3))) unsigned*)((__attribute__((address_space(3))) unsigned char*)lds + MISC_OFF));
#define GRID_SYNC() do { XcdBarrier xb_; xb_.bar = (unsigned*)(a.ws + WS_BAR); xb_.x = xb_xcc_id(); xb_.st = (volatile __attribute__((address_space(3))) unsigned*)((__attribute__((address_space(3))) unsigned char*)lds + MISC_OFF); xcd_barrier(xb_); } while (0)
#define LDSP ((PG8_LAS unsigned char*)lds)
    constexpr int XCH_OFF = 131072;
#define OTID() ({ int _t = threadIdx.x; asm volatile("" : "+v"(_t)); _t; })
    const int G = gridDim.x, NGW = G * 8;
    const float* x = a.in[0]; const float* norm1_g = a.in[1]; const float* w_in = a.in[2]; const float* sinks = a.in[3];
    const float* mu = a.in[4]; const float* w0 = a.in[5]; const float* w2 = a.in[6]; const float* a0 = a.in[7];
    const float* a2 = a.in[8]; const float* g2 = a.in[9]; const float* k_k = a.in[10]; const float* k_a = a.in[11];
    const float* r_k = a.in[12]; const float* lnx_g = a.in[13]; const float* lnx_b = a.in[14]; const float* v0 = a.in[15];
    const float* v1 = a.in[16]; const float* v2 = a.in[17]; const float* w_out = a.in[18]; const float* norm2_g = a.in[19];
    const float* wg = a.in[20]; const float* wu = a.in[21]; const float* conv_w = a.in[22]; const float* conv_b = a.in[23];
    const float* wd = a.in[24]; const float* final_g = a.in[25];
    unsigned char* ws = a.ws; float* X = a.out;
    ssq_t* ss = (ssq_t*)(ws + WS_SS);
    bf16_t* XB = (bf16_t*)(ws + WS_XB); bf16_t* PROJ = (bf16_t*)(ws + WS_PROJ); bf16_t* MIX = (bf16_t*)(ws + WS_MIX); bf16_t* HID = (bf16_t*)(ws + WS_HID); bf16_t* VF = (bf16_t*)(ws + WS_VFIRST);
    bf16_t* UT = (bf16_t*)(ws + WS_UTMP); bf16_t* UPT = UT + (size_t)SEQ * FF;

    {
        const int tid = OTID(), lane = tid & 63, wave = tid >> 6, gw = blockIdx.x * 8 + wave;
        float* scr = (float*)lds + wave * (64 * 33 + 16);
        constexpr int I_IN = (D / 64) * (IN_W / 32), I_OUT = (D / 64) * (D / 32), I_G = (D / 64) * (FF / 32), I_DN = (FF / 64) * (D / 32), I_LAYER = I_IN + I_OUT + 2 * I_G + I_DN;
        for (int it = gw; it < 2 * I_LAYER; it += NGW) {
            const int l = it / I_LAYER; int r = it % I_LAYER;
            bf16_t* wl = (bf16_t*)(ws + WS_W + l * W_LAYER); bf16_t* WinT = wl; bf16_t* WoutT = (bf16_t*)((char*)wl + W_IN_SZ); bf16_t* WguT = (bf16_t*)((char*)WoutT + W_OUT_SZ); bf16_t* WdT = (bf16_t*)((char*)WguT + W_GU_SZ);
            if (r < I_IN) { transpose_item(w_in + (size_t)l * D * IN_W, D, IN_W, WinT, norm1_g + l * D, 0, scr, r, lane); continue; } r -= I_IN;
            if (r < I_OUT) { transpose_item(w_out + (size_t)l * D * D, D, D, WoutT, nullptr, 0, scr, r, lane); continue; } r -= I_OUT;
            if (r < I_G) { transpose_item(wg + (size_t)l * D * FF, D, FF, WguT, norm2_g + l * D, 1, scr, r, lane); continue; } r -= I_G;
            if (r < I_G) { transpose_item(wu + (size_t)l * D * FF, D, FF, WguT, norm2_g + l * D, 2, scr, r, lane); continue; } r -= I_G;
            transpose_item(wd + (size_t)l * FF * D, FF, D, WdT, nullptr, 0, scr, r, lane);
        }
        {
            constexpr int I_W2 = 1 * (C / 32), I_G2 = 2 * (C / 32), I_V1 = (C / 64) * 1, I_L = 2 * I_W2 + I_G2;
            for (int it = gw; it < 2 * I_L + I_V1; it += NGW) {
                if (it < 2 * I_L) { const int l = it / I_L; int r = it % I_L; bf16_t* base = (bf16_t*)(ws + WS_LORA + l * LORA_LAYER);
                    if (r < I_W2) { transpose_item(w2 + (size_t)l * 64 * C, 64, C, base, nullptr, 0, scr, r, lane); continue; } r -= I_W2;
                    if (r < I_W2) { transpose_item(a2 + (size_t)l * 64 * C, 64, C, base + 512 * 64, nullptr, 0, scr, r, lane); continue; } r -= I_W2;
                    transpose_item(g2 + (size_t)l * 128 * C, 128, C, base + 2 * 512 * 64, nullptr, 0, scr, r, lane); }
                else transpose_item(v1, C, 32, (bf16_t*)(ws + WS_V1T), nullptr, 0, scr, it - 2 * I_L, lane);
            }
            bf16_t* V2T = (bf16_t*)(ws + WS_V2T);
            for (int i = blockIdx.x * NTHREADS + tid; i < 32 * C; i += G * NTHREADS) { const int j = i / C, ch = i % C; V2T[ch * 32 + j] = (bf16_t)f2bf(v2[i]); }
        }
        for (int m = 4 * gw; m < M; m += 4 * NGW) {
            f32x4 xv[4][4];
#pragma unroll
            for (int u = 0; u < 4; ++u)
#pragma unroll
                for (int j = 0; j < 4; ++j) xv[u][j] = ((const f32x4*)(x + (size_t)(m + u) * D))[lane + 64 * j];
#pragma unroll
            for (int u = 0; u < 4; ++u) { float sq = 0.f;
#pragma unroll
                for (int j = 0; j < 4; ++j) { const f32x4 v = xv[u][j]; sq += v.x * v.x + v.y * v.y + v.z * v.z + v.w * v.w;
                    ((unsigned long long*)(XB + (size_t)(m + u) * D))[lane + 64 * j] = (unsigned long long)(f2bf(v.x) | (f2bf(v.y) << 16)) | ((unsigned long long)(f2bf(v.z) | (f2bf(v.w) << 16)) << 32); }
                sq = wave_sum(sq); if (lane == 0) ss[m + u] = ssq_fix(sq); } }
    }
    GRID_SYNC();
    for (int l = 0; l < 2; ++l) {
        bf16_t* wl = (bf16_t*)(ws + WS_W + l * W_LAYER); bf16_t* WinT = wl; bf16_t* WoutT = (bf16_t*)((char*)wl + W_IN_SZ); bf16_t* WguT = (bf16_t*)((char*)WoutT + W_OUT_SZ); bf16_t* WdT = (bf16_t*)((char*)WguT + W_GU_SZ);
        ssq_t* ss1 = ss + (size_t)(2 * l) * M; ssq_t* ss2 = ss + (size_t)(2 * l + 1) * M; ssq_t* ss3 = ss + (size_t)(2 * l + 2) * M;
        { pg8::Gemm g{XB, WinT, M, IN_W, D}; pg8::StaticOrder S; S.init(M, IN_W, G, (int)blockIdx.x); pg8::EpiScaleBf16 E{PROJ, IN_W, ss1};
          pg8::gemm_phase<pg8::EpiScaleBf16, pg8::StaticOrder, true, true>(LDSP, g, S, E); }
        GRID_SYNC();
        for (int unit = blockIdx.x; unit < BATCH * 2 * (SEQ / 64); unit += G) attn_unit(PROJ, sinks + l * NH, MIX, (bf16_t*)lds, unit, OTID());
        struct { bf16_t *R, *K, *V, *A, *LD, *G; } p; p.R = (bf16_t*)X; p.K = (bf16_t*)X + (size_t)M * C;     p.V = (bf16_t*)(ws + WS_SI_V); p.A = (bf16_t*)(ws + WS_SI_A); p.LD = (bf16_t*)(ws + WS_SI_LD); p.G = (bf16_t*)(ws + WS_SI_G);
        { Prep2Args q{}; q.proj = PROJ; q.mu = mu + l * SHIFT_W; q.w0 = w0 + l * C; q.a0 = a0 + l * C; q.v0 = v0;
          const bf16_t* lw = (const bf16_t*)(ws + WS_LORA + l * LORA_LAYER); q.W2T = lw; q.A2T = lw + 512 * 64; q.G2T = lw + 2 * 512 * 64; q.V1T = (const bf16_t*)(ws + WS_V1T); q.V2T = (const bf16_t*)(ws + WS_V2T);
          q.vfirst = VF; q.R = p.R; q.K = p.K; q.V = p.V; q.A = p.A; q.LD = p.LD; q.G = p.G; q.layer = l;
          for (int tile = blockIdx.x; tile < M / 64; tile += G) prep_tile(q, lds, tile, OTID()); }
        GRID_SYNC();
        { ScanArgs s{}; s.R = p.R; s.K = p.K; s.V = p.V; s.A = p.A; s.LD = p.LD; s.G = p.G; s.k_k = k_k + l * C; s.k_a = k_a + l * C; s.r_k = r_k + l * C; s.lnx_g = lnx_g + l * C; s.lnx_b = lnx_b + l * C; s.mix = MIX; s.rkc = (float*)(ws + WS_RKC);
          bf16_t* GQ = (bf16_t*)(ws + WS_CKGQ); bf16_t* CQ = (bf16_t*)(ws + WS_CKCQ);
          for (int unit = blockIdx.x; unit < BATCH * NH * 64; unit += G) { CkRaw ra; ck_load(s, ra, unit, OTID()); ck_precompute(s, ra, lds, GQ, CQ, unit, OTID()); }
          GRID_SYNC();
          for (int item = (int)((blockIdx.x & 7) * (G >> 3) + (blockIdx.x >> 3)); item < BATCH * NH * 4; item += G) ck_sequential(s, lds, GQ, CQ, item, OTID());
          GRID_SYNC();
          { const int tid = OTID(), lane = tid & 63, gw = blockIdx.x * 8 + (tid >> 6); for (int m0 = 2 * gw; m0 < M; m0 += 2 * NGW) scan_post_rows(s, m0, lane); } }
        GRID_SYNC();
        { pg8::Gemm g{MIX, WoutT, M, D, D}; pg8::StaticOrder S; S.init(M, D, G, (int)blockIdx.x); pg8::EpiResid E{XB, ss2};
          pg8::gemm_phase<pg8::EpiResid, pg8::StaticOrder, true, true>(LDSP, g, S, E); }
        GRID_SYNC();
        { pg8::Gemm g{XB, WguT, M, 2 * FF, D}; pg8::StaticOrder S; S.init(M, 2 * FF, G, (int)blockIdx.x);
          pg8::EpiConvGlu E{HID, ss2, conv_w + (size_t)l * 3 * FF, conv_b + (size_t)l * FF, (float*)(ws + WS_UTMP), (PG8_LAS float*)(LDSP + XCH_OFF), FF};
          pg8::gemm_phase<pg8::EpiConvGlu, pg8::StaticOrder, true, true>(LDSP, g, S, E); }
        GRID_SYNC();
        { pg8::Gemm g{HID, WdT, M, D, FF}; pg8::StaticOrder S; S.init(M, D, G, (int)blockIdx.x); pg8::EpiResid E{XB, ss3};
          { pg8::Unit u; for (int i = 0; S.next(i, u); ++i) ffn_fixup((const float*)(ws + WS_UTMP), conv_w + (size_t)l * 3 * FF, conv_b + (size_t)l * FF, HID, u.pm, OTID());
            asm volatile("s_waitcnt vmcnt(0)" ::: "memory"); __syncthreads(); }
          pg8::gemm_phase<pg8::EpiResid, pg8::StaticOrder, true, true>(LDSP, g, S, E); }
        GRID_SYNC();
    }
    { const int tid = OTID(), lane = tid & 63, gw = blockIdx.x * 8 + (tid >> 6);
    const f32x4 fg0 = ((const f32x4*)final_g)[2 * lane], fg1 = ((const f32x4*)final_g)[2 * lane + 1], fg2 = ((const f32x4*)final_g)[128 + 2 * lane], fg3 = ((const f32x4*)final_g)[128 + 2 * lane + 1];
    const ssq_t* ssf = ss + (size_t)4 * M;
    for (int m = 4 * gw; m < M; m += 4 * NGW) {
        bf16x8 xv[4][2]; float rs[4];
#pragma unroll
        for (int u = 0; u < 4; ++u) { xv[u][0] = ((const bf16x8*)(XB + (size_t)(m + u) * D))[lane]; xv[u][1] = ((const bf16x8*)(XB + (size_t)(m + u) * D))[64 + lane]; rs[u] = rsqrtf(ssq_val(ssf[m + u]) * (1.f / D) + RMS_EPS); }
#pragma unroll
        for (int u = 0; u < 4; ++u) { f32x4* orow = (f32x4*)(X + (size_t)(m + u) * D) + 2 * lane;
            orow[0] = bfx4_lo(xv[u][0]) * fg0 * rs[u]; orow[1] = bfx4_hi(xv[u][0]) * fg1 * rs[u]; orow[128] = bfx4_lo(xv[u][1]) * fg2 * rs[u]; orow[129] = bfx4_hi(xv[u][1]) * fg3 * rs[u]; } } }
}

extern "C" void kernel_launch(void* const* d_in, const int* in_sizes, int n_in, void* d_out, int out_size, void* d_ws, size_t ws_size, hipStream_t stream) {
    static int grid = 0;
    if (grid == 0) {
        if (n_in != 26 || in_sizes[0] != M * D || out_size != M * D || ws_size < WS_END) { fprintf(stderr, "kernel_launch: unexpected shapes (n_in %d, ws %zu)\n", n_in, ws_size); grid = -1; return; }
        int dev = 0, cus = 0, per_cu = 0;
        if (hipGetDevice(&dev) != hipSuccess || hipDeviceGetAttribute(&cus, hipDeviceAttributeMultiprocessorCount, dev) != hipSuccess) { grid = -1; return; }
        if (hipFuncSetAttribute((const void*)mega_fwd, hipFuncAttributeMaxDynamicSharedMemorySize, LDS_BYTES) != hipSuccess) { fprintf(stderr, "kernel_launch: hipFuncSetAttribute failed\n"); grid = -1; return; }
        if (hipOccupancyMaxActiveBlocksPerMultiprocessor(&per_cu, (const void*)mega_fwd, NTHREADS, LDS_BYTES) != hipSuccess || per_cu < 1) { fprintf(stderr, "kernel_launch: occupancy query failed (%d)\n", per_cu); grid = -1; return; }
        grid = cus;
    }
    if (grid < 0) return;
    (void)hipMemsetAsync((unsigned char*)d_ws + WS_CTL, 0, CTL_BYTES, stream);
    Args a{};
    for (int i = 0; i < 26; ++i) a.in[i] = (const float*)d_in[i];
    a.out = (float*)d_out; a.ws = (unsigned char*)d_ws;
    void* kargs[] = {&a};
    hipError_t e = hipLaunchCooperativeKernel((const void*)mega_fwd, dim3(grid), dim3(NTHREADS), kargs, LDS_BYTES, stream);
    if (e != hipSuccess) fprintf(stderr, "kernel_launch: cooperative launch failed: %s (grid %d)\n", hipGetErrorString(e), grid);
}
```

```cpp
#include <hip/hip_runtime.h>
#include <cstdio>
#include <cstdint>

typedef unsigned short bf16_t;
typedef short bf16x8 __attribute__((ext_vector_type(8)));
typedef float f32x4 __attribute__((ext_vector_type(4)));

constexpr int BATCH = 8, SEQ = 4096, D = 1024, M = BATCH * SEQ;
constexpr int HD = 64, ATT_W = 512, KV_W = 128, C = 512, NH = 8;
constexpr int ATT_IN = 768, SHIFT_W = 1792, IN_W = 2560, FF = 2816;
constexpr int WINDOW = 128;
constexpr float RMS_EPS = 1e-5f, LNX_EPS = 64e-5f;

constexpr size_t MiB = 1u << 20;
constexpr size_t WS_CTL = 0;
typedef unsigned long long ssq_t;
__device__ __forceinline__ ssq_t ssq_fix(float s) { return (ssq_t)(s * 1048576.0f + 0.5f); }
__device__ __forceinline__ float ssq_val(ssq_t v) { return (float)v * (1.0f / 1048576.0f); }
constexpr size_t WS_SS = 0;
constexpr size_t CTL_BYTES = 2 * MiB;
constexpr size_t WS_BAR = 1536 * 1024;
constexpr size_t WS_W = 2 * MiB;
constexpr size_t W_IN_SZ = (size_t)IN_W * D * 2, W_OUT_SZ = (size_t)D * D * 2, W_GU_SZ = (size_t)2 * FF * D * 2, W_DN_SZ = (size_t)D * FF * 2;
constexpr size_t W_LAYER = W_IN_SZ + W_OUT_SZ + W_GU_SZ + W_DN_SZ;
constexpr size_t WS_VFIRST = 52 * MiB, WS_MIX = 84 * MiB, WS_XB = 148 * MiB, WS_PROJ = 212 * MiB;
constexpr size_t WS_SI_R = 148 * MiB, WS_SI_K = 180 * MiB, WS_SI_V = 372 * MiB, WS_SI_A = 404 * MiB, WS_SI_LD = 436 * MiB, WS_SI_G = 468 * MiB;
constexpr size_t WS_HID = 212 * MiB;
constexpr size_t WS_UTMP = 84 * MiB;
constexpr size_t WS_END = 500 * MiB;
static_assert(WS_W + 2 * W_LAYER <= WS_VFIRST, "weights fit");

__device__ __forceinline__ unsigned f2bf(float f) { unsigned u = __builtin_bit_cast(unsigned, f); return (u + 0x7fffu + ((u >> 16) & 1u)) >> 16; }
__device__ __forceinline__ float bf2f(bf16_t h) { return __builtin_bit_cast(float, (unsigned)h << 16); }
__device__ __forceinline__ float wave_sum(float v) {
#pragma unroll
    for (int o = 1; o < 64; o <<= 1) v += __shfl_xor(v, o);
    return v;
}
__device__ __forceinline__ float sigmoidf_(float x) { return 1.f / (1.f + __expf(-x)); }

namespace pg8 {
#define PG8_LAS __attribute__((address_space(3)))
typedef unsigned short bf16_t;
typedef short bf16x8 __attribute__((ext_vector_type(8)));
typedef float f32x4 __attribute__((ext_vector_type(4)));
typedef unsigned u32x4 __attribute__((ext_vector_type(4)));
constexpr int BM = 256, BK = 64, HALF = 128, HTB = HALF * BK * 2  , STAGE_BYTES = 8 * HTB, NXCD = 8, WGM = 8;

__host__ __device__ __forceinline__ int lds_byte(int r, int c) { const int st = (r >> 4) * 2 + (c >> 5), rr = r & 15, cc = c & 31, ob = rr * 64 + cc * 2; return st * 1024 + (ob ^ (((ob >> 9) & 1) << 5)); }
__host__ __device__ __forceinline__ void stage_rc(int b, int& R, int& C) { const int st = b / 1024, sb = b % 1024, swz = sb ^ (((sb >> 9) & 1) << 5); R = (st >> 1) * 16 + swz / 64; C = (st & 1) * 32 + (swz % 64) / 2; }
__host__ __device__ __forceinline__ int perm32(int rho) { const int n = rho >> 4, i = rho & 15; return 8 * (i >> 2) + 4 * n + (i & 3); }

struct Unit { int pm, pn; };
struct Gemm { const bf16_t* A; const bf16_t* Bt; int M, N, K; };

struct StaticOrder {
    int nM, nN, nwg, G, c;
    __host__ __device__ void init(int M, int N, int G_, int c_) { nM = M / BM; nN = N / BM; nwg = nM * nN; G = G_; c = c_; }
    __host__ __device__ bool next(int i, Unit& u) const {
        const long L = (long)i * G + c; if (L >= nwg) return false;
        int wgid = (int)L; { const int q = nwg / NXCD, r = nwg % NXCD, xcd = wgid % NXCD, off = wgid / NXCD; wgid = (xcd < r ? xcd * (q + 1) : r * (q + 1) + (xcd - r) * q) + off; }
        const int nig = WGM * nN, gid = wgid / nig, fm = gid * WGM, gsz = (nM - fm) < WGM ? (nM - fm) : WGM;
        u.pm = fm + ((wgid % nig) % gsz); u.pn = (wgid % nig) / gsz; return true;
    }
    __device__ __forceinline__ void a_ready(const Unit&) const {}
    __device__ __forceinline__ void done(const Unit&) const {}
};
typedef float f32x2_t_ __attribute__((ext_vector_type(2))); typedef __bf16 bf16x2_t_ __attribute__((ext_vector_type(2)));
__device__ __forceinline__ unsigned cvt_pk_bf16(float lo, float hi) { const f32x2_t_ v = {lo, hi}; const bf16x2_t_ b = __builtin_convertvector(v, bf16x2_t_); return __builtin_bit_cast(unsigned, b); }
typedef float f32x2 __attribute__((ext_vector_type(2)));
template <class Epi, class Sched, bool ALIGN_EPI = false, bool SP2 = false>
__device__ __forceinline__ void gemm_phase(PG8_LAS unsigned char* lds, const Gemm g, const Sched& S, const Epi& E) {
    int tid_ = threadIdx.x; asm volatile("" : "+v"(tid_));
    const int tid = tid_, wid = __builtin_amdgcn_readfirstlane(tid >> 6), lane = tid & 63, wr = wid >> 2, wc = wid & 3, fr = lane & 15, fq = lane >> 4;
    const int K = g.K, nt = K / BK;
    unsigned voffA[2], voffB[2];
#pragma unroll
    for (int i = 0; i < 2; ++i) { int R, C; stage_rc(tid * 16 + i * 8192, R, C); const int Rb = Epi::PERM ? ((R & ~31) + perm32(R & 31)) : R;
        voffA[i] = (unsigned)(R * K + C) * 2u; voffB[i] = (unsigned)(Rb * K + C) * 2u; }
    const size_t kstep = (size_t)(BK * 2);
    const size_t hstep = (size_t)HALF * K * 2;
    const size_t tstep = 2 * hstep;
    const unsigned ldsw = (unsigned)wid * 1024u;
    const int aoff = lds_byte(wr * 64 + fr, fq * 8), boff = lds_byte(wc * 32 + fr, fq * 8);
#define PG8_SA(b, h) (((b) * 2 + (h)) * HTB)
#define PG8_SB(b, h) ((4 + (b) * 2 + (h)) * HTB)
#define PG8_STAGE(bufoff, gbase, voff) do { _Pragma("unroll") for (int _i = 0; _i < 2; ++_i) \
        __builtin_amdgcn_global_load_lds((const unsigned*)((const char*)(gbase) + (voff)[_i]), (PG8_LAS unsigned*)(lds + (bufoff) + ldsw + _i * 8192), 16, 0, 0); } while (0)
#define PG8_LDA(dst, b, h) do { _Pragma("unroll") for (int m = 0; m < 4; ++m) _Pragma("unroll") for (int k = 0; k < 2; ++k) dst[m][k] = *(const PG8_LAS bf16x8*)(lds + PG8_SA(b, h) + aoff + m * 2048 + k * 1024); } while (0)
#define PG8_LDB(dst, b, h) do { _Pragma("unroll") for (int n = 0; n < 2; ++n) _Pragma("unroll") for (int k = 0; k < 2; ++k) dst[n][k] = *(const PG8_LAS bf16x8*)(lds + PG8_SB(b, h) + boff + n * 2048 + k * 1024); } while (0)
#define PG8_MMA(ai, bj, At, Bt) do { __builtin_amdgcn_s_setprio(1); _Pragma("unroll") for (int m = 0; m < 4; ++m) _Pragma("unroll") for (int n = 0; n < 2; ++n) _Pragma("unroll") for (int k = 0; k < 2; ++k) \
        acc[ai][bj][m][n] = __builtin_amdgcn_mfma_f32_16x16x32_bf16(Bt[n][k], At[m][k], acc[ai][bj][m][n], 0, 0, 0); __builtin_amdgcn_s_setprio(0); } while (0)
#define PG8_WAIT_V(n) asm volatile("s_waitcnt vmcnt(" #n ")" ::: "memory")
#define PG8_WAIT_L(n) asm volatile("s_waitcnt lgkmcnt(" #n ")" ::: "memory")
#define PG8_BAR __builtin_amdgcn_s_barrier()
#define PG8_SCHED __builtin_amdgcn_sched_barrier(0)
    Unit cur, nxt; int ui = 0;
    if (!S.next(0, cur)) return;
    f32x4 acc[2][2][4][2];
#pragma unroll
    for (int a = 0; a < 2; ++a)
#pragma unroll
        for (int b = 0; b < 2; ++b)
#pragma unroll
            for (int m = 0; m < 4; ++m)
#pragma unroll
                for (int n = 0; n < 2; ++n) acc[a][b][m][n] = (f32x4){0.f, 0.f, 0.f, 0.f};
    bf16x8 At[4][2], B0[2][2], B1[2][2];
    const char* cA = (const char*)g.A + (size_t)cur.pm * tstep; const char* cB = (const char*)g.Bt + (size_t)cur.pn * tstep;
    S.a_ready(cur);
    if constexpr (SP2) {
        PG8_STAGE(PG8_SB(0, 0), cB, voffB); PG8_STAGE(PG8_SB(0, 1), cB + hstep, voffB); PG8_STAGE(PG8_SA(0, 0), cA, voffA); PG8_STAGE(PG8_SA(0, 1), cA + hstep, voffA);
        if (wr == 1) PG8_BAR;
        PG8_WAIT_V(2); PG8_BAR;
        PG8_STAGE(PG8_SB(1, 0), cB + kstep, voffB); PG8_STAGE(PG8_SA(1, 0), cA + kstep, voffA); PG8_STAGE(PG8_SB(1, 1), cB + hstep + kstep, voffB);
        PG8_WAIT_V(6); PG8_BAR;
    } else {
        PG8_STAGE(PG8_SB(0, 0), cB, voffB); PG8_STAGE(PG8_SA(0, 0), cA, voffA); PG8_STAGE(PG8_SB(0, 1), cB + hstep, voffB); PG8_STAGE(PG8_SA(0, 1), cA + hstep, voffA);
        if (wr == 1) PG8_BAR;
        PG8_WAIT_V(4); PG8_BAR;
        PG8_STAGE(PG8_SB(1, 0), cB + kstep, voffB); PG8_STAGE(PG8_SA(1, 0), cA + kstep, voffA); PG8_STAGE(PG8_SB(1, 1), cB + hstep + kstep, voffB);
        PG8_WAIT_V(6); PG8_BAR;
    }
    for (;;) {
        const bool has_next = S.next(ui + 1, nxt);
        const char* nA = has_next ? (const char*)g.A + (size_t)nxt.pm * tstep : cA; const char* nB = has_next ? (const char*)g.Bt + (size_t)nxt.pn * tstep : cB;
        for (int t = 0; t < nt; t += 2) {
            const bool last = (t == nt - 2);
            const char* a1 = cA + (size_t)(t + 1) * kstep;
            const char* a2 = last ? nA : cA + (size_t)(t + 2) * kstep; const char* b2 = last ? nB : cB + (size_t)(t + 2) * kstep;
            const char* a3 = a2 + kstep; const char* b3 = b2 + kstep;
            if (last && has_next) S.a_ready(nxt);
            if constexpr (SP2) {
            PG8_LDB(B0, 0, 0); PG8_LDB(B1, 0, 1); PG8_SCHED; PG8_LDA(At, 0, 0); PG8_STAGE(PG8_SA(1, 1), a1 + hstep, voffA);
            PG8_WAIT_V(8); PG8_WAIT_L(0); PG8_BAR; PG8_MMA(0, 0, At, B0); PG8_MMA(0, 1, At, B1); PG8_BAR; PG8_SCHED;
            PG8_LDA(At, 0, 1); PG8_STAGE(PG8_SB(0, 0), b2, voffB); PG8_STAGE(PG8_SB(0, 1), b2 + hstep, voffB); PG8_STAGE(PG8_SA(0, 0), a2, voffA);
            PG8_WAIT_V(8); PG8_WAIT_L(0); PG8_BAR; PG8_MMA(1, 0, At, B0); PG8_MMA(1, 1, At, B1); PG8_BAR; PG8_SCHED;
            PG8_LDB(B0, 1, 0); PG8_LDB(B1, 1, 1); PG8_SCHED; PG8_LDA(At, 1, 0); PG8_STAGE(PG8_SA(0, 1), a2 + hstep, voffA);
            PG8_WAIT_V(8); PG8_WAIT_L(0); PG8_BAR; PG8_MMA(0, 0, At, B0); PG8_MMA(0, 1, At, B1); PG8_BAR; PG8_SCHED;
            PG8_LDA(At, 1, 1); PG8_STAGE(PG8_SB(1, 0), b3, voffB); PG8_STAGE(PG8_SB(1, 1), b3 + hstep, voffB); PG8_STAGE(PG8_SA(1, 0), a3, voffA);
            PG8_WAIT_V(8); PG8_WAIT_L(0); PG8_BAR; PG8_MMA(1, 0, At, B0); PG8_MMA(1, 1, At, B1); PG8_BAR; PG8_SCHED;
            } else {
            PG8_LDB(B0, 0, 0); PG8_SCHED; PG8_LDA(At, 0, 0); PG8_STAGE(PG8_SA(1, 1), a1 + hstep, voffA);
            PG8_WAIT_L(8); PG8_BAR; PG8_WAIT_L(0); PG8_MMA(0, 0, At, B0); PG8_BAR; PG8_SCHED;
            PG8_LDB(B1, 0, 1); PG8_STAGE(PG8_SB(0, 0), b2, voffB);
            PG8_BAR; PG8_WAIT_L(0); PG8_MMA(0, 1, At, B1); PG8_BAR;
            PG8_LDA(At, 0, 1); PG8_STAGE(PG8_SA(0, 0), a2, voffA);
            PG8_BAR; PG8_WAIT_L(0); PG8_MMA(1, 0, At, B0); PG8_BAR; PG8_SCHED;
            PG8_STAGE(PG8_SB(0, 1), b2 + hstep, voffB);
            PG8_WAIT_V(6); PG8_BAR; PG8_MMA(1, 1, At, B1); PG8_BAR;
            PG8_LDB(B0, 1, 0); PG8_SCHED; PG8_LDA(At, 1, 0); PG8_STAGE(PG8_SA(0, 1), a2 + hstep, voffA);
            PG8_WAIT_L(8); PG8_BAR; PG8_WAIT_L(0); PG8_MMA(0, 0, At, B0); PG8_BAR; PG8_SCHED;
            PG8_LDB(B1, 1, 1); PG8_STAGE(PG8_SB(1, 0), b3, voffB);
            PG8_BAR; PG8_WAIT_L(0); PG8_MMA(0, 1, At, B1); PG8_BAR;
            PG8_LDA(At, 1, 1); PG8_STAGE(PG8_SA(1, 0), a3, voffA);
            PG8_BAR; PG8_WAIT_L(0); PG8_MMA(1, 0, At, B0); PG8_BAR; PG8_SCHED;
            PG8_STAGE(PG8_SB(1, 1), b3 + hstep, voffB);
            PG8_WAIT_V(6); PG8_BAR; PG8_MMA(1, 1, At, B1); PG8_BAR;
            }
        }
        if constexpr (ALIGN_EPI) { if (wr == 0) PG8_BAR; }
        if constexpr (!Epi::AFTER_DRAIN) { E(acc, cur, wr, wc, fr, fq); S.done(cur); }
        if (!has_next) break;
#pragma unroll
        for (int a = 0; a < 2; ++a)
#pragma unroll
            for (int b = 0; b < 2; ++b)
#pragma unroll
                for (int m = 0; m < 4; ++m)
#pragma unroll
                    for (int n = 0; n < 2; ++n) acc[a][b][m][n] = (f32x4){0.f, 0.f, 0.f, 0.f};
        cur = nxt; cA = nA; cB = nB; ++ui;
        if constexpr (ALIGN_EPI) { if (wr == 1) PG8_BAR; }
    }
    PG8_WAIT_V(0);
    if constexpr (!ALIGN_EPI) { if (wr == 0) PG8_BAR; }
    PG8_BAR;
    if constexpr (Epi::AFTER_DRAIN) { E.fused(acc, cur, wr, wc, fr, fq, lds, wid, lane); S.done(cur); }
#undef PG8_SA
#undef PG8_SB
#undef PG8_STAGE
#undef PG8_LDA
#undef PG8_LDB
#undef PG8_MMA
#undef PG8_WAIT_V
#undef PG8_WAIT_L
#undef PG8_BAR
#undef PG8_SCHED
}

constexpr int DM_ = 1024; constexpr float RMS_EPS_ = 1e-5f;
typedef unsigned long long ssq_t;
struct EpiScaleBf16 {
    static constexpr bool PERM = true, AFTER_DRAIN = false;
    bf16_t* O; int ldc; const ssq_t* ss;
    __device__ __forceinline__ void operator()(const f32x4 (&acc)[2][2][4][2], const Unit& u, int wr, int wc, int fr, int fq) const {
        const int row0 = u.pm * BM + wr * 64 + fr, col0 = u.pn * BM + wc * 32 + 8 * fq;
        float rsv[2][4];
#pragma unroll
        for (int ai = 0; ai < 2; ++ai)
#pragma unroll
            for (int m = 0; m < 4; ++m) rsv[ai][m] = (float)ss[row0 + ai * HALF + m * 16] * (1.0f / 1048576.0f);
#pragma unroll
        for (int ai = 0; ai < 2; ++ai)
#pragma unroll
            for (int m = 0; m < 4; ++m) { const int row = row0 + ai * HALF + m * 16; const float rs = __builtin_amdgcn_rsqf(rsv[ai][m] * (1.0f / DM_) + RMS_EPS_); bf16_t* rowp = O + (size_t)row * ldc + col0;
#pragma unroll
                for (int bj = 0; bj < 2; ++bj) { const f32x4 v0 = acc[ai][bj][m][0] * rs, v1 = acc[ai][bj][m][1] * rs;
                    u32x4 w; w.x = cvt_pk_bf16(v0[0], v0[1]); w.y = cvt_pk_bf16(v0[2], v0[3]); w.z = cvt_pk_bf16(v1[0], v1[1]); w.w = cvt_pk_bf16(v1[2], v1[3]);
                    *(u32x4*)(rowp + bj * HALF) = w; } }
    }
};
struct EpiResid {
    static constexpr bool PERM = true, AFTER_DRAIN = false;
    bf16_t* xb; ssq_t* ss_out;
    __device__ __forceinline__ void operator()(const f32x4 (&acc)[2][2][4][2], const Unit& u, int wr, int wc, int fr, int fq) const {
        const int row0 = u.pm * BM + wr * 64 + fr, col0 = u.pn * BM + wc * 32 + 8 * fq;
#pragma unroll
        for (int ai = 0; ai < 2; ++ai) {
            u32x4 bs[4][2];
#pragma unroll
            for (int m = 0; m < 4; ++m)
#pragma unroll
                for (int bj = 0; bj < 2; ++bj) bs[m][bj] = *(const u32x4*)(xb + (size_t)(row0 + ai * HALF + m * 16) * DM_ + col0 + bj * HALF);
#pragma unroll
            for (int m = 0; m < 4; ++m) { const int row = row0 + ai * HALF + m * 16; bf16_t* rp = xb + (size_t)row * DM_ + col0; float sq = 0.f;
#pragma unroll
                for (int bj = 0; bj < 2; ++bj) { const u32x4 b = bs[m][bj]; u32x4 w;
#pragma unroll
                    for (int hh = 0; hh < 2; ++hh) { const unsigned b0 = hh == 0 ? b.x : b.z, b1 = hh == 0 ? b.y : b.w; const f32x4 a4 = acc[ai][bj][m][hh];
                        const float x0 = __builtin_bit_cast(float, b0 << 16) + a4[0], x1 = __builtin_bit_cast(float, b0 & 0xffff0000u) + a4[1], x2 = __builtin_bit_cast(float, b1 << 16) + a4[2], x3 = __builtin_bit_cast(float, b1 & 0xffff0000u) + a4[3];
                        const unsigned w0 = cvt_pk_bf16(x0, x1), w1 = cvt_pk_bf16(x2, x3);
                        if (hh == 0) { w.x = w0; w.y = w1; } else { w.z = w0; w.w = w1; }
                        const float r0 = __builtin_bit_cast(float, w0 << 16), r1 = __builtin_bit_cast(float, w0 & 0xffff0000u), r2 = __builtin_bit_cast(float, w1 << 16), r3 = __builtin_bit_cast(float, w1 & 0xffff0000u);
                        sq += (r0 * r0 + r1 * r1) + (r2 * r2 + r3 * r3); }
                    *(u32x4*)(rp + bj * HALF) = w; }
                sq += __shfl_xor(sq, 16); sq += __shfl_xor(sq, 32);
                if (fq == 0) atomicAdd(ss_out + row, (ssq_t)(sq * 1048576.0f + 0.5f)); }
        }
    }
};
struct EpiGateUpTmp {
    static constexpr bool PERM = true, AFTER_DRAIN = false;
    bf16_t* U; bf16_t* UP; const ssq_t* ss; int ff;
    __device__ __forceinline__ void operator()(const f32x4 (&acc)[2][2][4][2], const Unit& u, int wr, int wc, int fr, int fq) const {
        const int row0 = u.pm * BM + wr * 64 + fr, col0 = u.pn * HALF + wc * 32 + 8 * fq;
        float rsv[2][4];
#pragma unroll
        for (int ai = 0; ai < 2; ++ai)
#pragma unroll
            for (int m = 0; m < 4; ++m) rsv[ai][m] = (float)ss[row0 + ai * HALF + m * 16] * (1.0f / 1048576.0f);
#pragma unroll
        for (int ai = 0; ai < 2; ++ai)
#pragma unroll
            for (int m = 0; m < 4; ++m) { const int row = row0 + ai * HALF + m * 16; const float rs = __builtin_amdgcn_rsqf(rsv[ai][m] * (1.0f / DM_) + RMS_EPS_); const size_t o = (size_t)row * ff + col0;
#pragma unroll
                for (int bj = 0; bj < 2; ++bj) { const f32x4 v0 = acc[ai][bj][m][0] * rs, v1 = acc[ai][bj][m][1] * rs;
                    u32x4 w; w.x = cvt_pk_bf16(v0[0], v0[1]); w.y = cvt_pk_bf16(v0[2], v0[3]); w.z = cvt_pk_bf16(v1[0], v1[1]); w.w = cvt_pk_bf16(v1[2], v1[3]);
                    *(u32x4*)((bj == 0 ? U : UP) + o) = w; } }
    }
};
template <int CTRL> __device__ __forceinline__ float dpp1(float x) { return __builtin_bit_cast(float, __builtin_amdgcn_update_dpp(0, __builtin_bit_cast(int, x), CTRL, 0xF, 0xF, true)); }
template <int CTRL> __device__ __forceinline__ f32x4 dpp4(const f32x4 x) { return (f32x4){dpp1<CTRL>(x.x), dpp1<CTRL>(x.y), dpp1<CTRL>(x.z), dpp1<CTRL>(x.w)}; }
struct EpiConvGlu {
    static constexpr bool PERM = true, AFTER_DRAIN = false;
    bf16_t* HID; const ssq_t* ss; const float* cw; const float* cb; float* SB; PG8_LAS float* xch; int ff;
    __device__ __forceinline__ void operator()(const f32x4 (&acc)[2][2][4][2], const Unit& u, int wr, int wc, int fr, int fq) const {
        const int row0 = u.pm * BM + wr * 64 + fr, cl = wc * 32 + 8 * fq, jcol = u.pn * HALF + cl;
        float rs[2][4];
#pragma unroll
        for (int ai = 0; ai < 2; ++ai)
#pragma unroll
            for (int m = 0; m < 4; ++m) rs[ai][m] = (float)ss[row0 + ai * HALF + m * 16] * (1.0f / 1048576.0f);
        f32x4 w0[2], w1[2], w2[2], bb[2];
#pragma unroll
        for (int n = 0; n < 2; ++n) { w0[n] = *(const f32x4*)(cw + jcol + 4 * n); w1[n] = *(const f32x4*)(cw + ff + jcol + 4 * n); w2[n] = *(const f32x4*)(cw + 2 * ff + jcol + 4 * n); bb[n] = *(const f32x4*)(cb + jcol + 4 * n); }
#pragma unroll
        for (int ai = 0; ai < 2; ++ai)
#pragma unroll
            for (int m = 0; m < 4; ++m) rs[ai][m] = __builtin_amdgcn_rsqf(rs[ai][m] * (1.0f / DM_) + RMS_EPS_);
        if (fr >= 14) {
#pragma unroll
            for (int ai = 0; ai < 2; ++ai)
#pragma unroll
                for (int n = 0; n < 2; ++n) *(PG8_LAS f32x4*)(xch + ((2 * ai + wr) * 2 + (fr - 14)) * HALF + cl + 4 * n) = acc[ai][0][3][n] * rs[ai][3];
        }
        asm volatile("s_waitcnt lgkmcnt(0)" ::: "memory"); __builtin_amdgcn_s_barrier(); asm volatile("" ::: "memory");
        float* sbp = SB + (size_t)u.pm * 6 * ff + jcol;
#pragma unroll
        for (int ai = 0; ai < 2; ++ai) {
            const int q = 2 * ai + wr;
            f32x4 X[2];
#pragma unroll
            for (int n = 0; n < 2; ++n) { X[n] = (f32x4){0.f, 0.f, 0.f, 0.f}; if (q > 0 && fr >= 14) X[n] = *(const PG8_LAS f32x4*)(xch + ((q - 1) * 2 + (fr - 14)) * HALF + cl + 4 * n); }
#pragma unroll
            for (int m = 0; m < 4; ++m) { const int row = row0 + ai * HALF + m * 16;
                pg8::u32x4 hw;
#pragma unroll
                for (int n = 0; n < 2; ++n) {
                    const f32x4 cur = acc[ai][0][m][n] * rs[ai][m], up = acc[ai][1][m][n] * rs[ai][m];
                    const f32x4 P = (m > 0) ? acc[ai][0][m > 0 ? m - 1 : 0][n] * rs[ai][m > 0 ? m - 1 : 0] : X[n];
                    const f32x4 a1 = dpp4<0x121>(cur), b1 = dpp4<0x121>(P), a2 = dpp4<0x122>(cur), b2 = dpp4<0x122>(P);
                    f32x4 p1, p2;
#pragma unroll
                    for (int e = 0; e < 4; ++e) { p1[e] = fr == 0 ? b1[e] : a1[e]; p2[e] = fr < 2 ? b2[e] : a2[e]; }
                    const f32x4 c = bb[n] + w0[n] * p2 + w1[n] * p1 + w2[n] * cur;
                    f32x4 hv;
#pragma unroll
                    for (int e = 0; e < 4; ++e) hv[e] = c[e] * __builtin_amdgcn_rcpf(1.f + __expf(-c[e])) * up[e];
                    if (n == 0) { hw.x = cvt_pk_bf16(hv[0], hv[1]); hw.y = cvt_pk_bf16(hv[2], hv[3]); } else { hw.z = cvt_pk_bf16(hv[0], hv[1]); hw.w = cvt_pk_bf16(hv[2], hv[3]); }
                    if (q == 0 && m == 0 && fr < 2) { *(f32x4*)(sbp + (size_t)fr * ff + 4 * n) = cur; *(f32x4*)(sbp + (size_t)(2 + fr) * ff + 4 * n) = up; }
                    if (q == 3 && m == 3 && fr >= 14) *(f32x4*)(sbp + (size_t)(4 + fr - 14) * ff + 4 * n) = cur;
                }
                *(pg8::u32x4*)(HID + (size_t)row * ff + jcol) = hw; }
        }
    }
};
}

#define LAS __attribute__((address_space(3)))
__device__ __forceinline__ void transpose_item(const float* __restrict__ W, int K, int N, bf16_t* __restrict__ Wt, const float* __restrict__ g, int mode, float* scr, int item, int lane) {
    const int nblk = N / 32, kb = item / nblk, nb = item % nblk, k0 = 64 * kb, n0 = 32 * nb;
    int np0 = n0; if (mode == 1) np0 = 256 * (n0 / 128) + (n0 % 128); else if (mode == 2) np0 = 256 * (n0 / 128) + 128 + (n0 % 128);
#pragma unroll 8
    for (int i = 0; i < 32; ++i) { const int kk = 2 * i + (lane >> 5); scr[kk * 33 + (lane & 31)] = W[(size_t)(k0 + kk) * N + n0 + (lane & 31)] * (g ? g[k0 + kk] : 1.f); }
    __builtin_amdgcn_fence(__ATOMIC_RELEASE, "wavefront"); __builtin_amdgcn_wave_barrier(); __builtin_amdgcn_fence(__ATOMIC_ACQUIRE, "wavefront");
    const int c = lane & 7;
#pragma unroll
    for (int j = 0; j < 4; ++j) { const int n = (lane >> 3) + 8 * j; const float* sp = scr + (8 * c) * 33 + n;
        uint4 o; o.x = f2bf(sp[0]) | (f2bf(sp[33]) << 16); o.y = f2bf(sp[2 * 33]) | (f2bf(sp[3 * 33]) << 16); o.z = f2bf(sp[4 * 33]) | (f2bf(sp[5 * 33]) << 16); o.w = f2bf(sp[6 * 33]) | (f2bf(sp[7 * 33]) << 16);
        *(uint4*)(Wt + (size_t)(np0 + n) * K + k0 + 8 * c) = o; }
    __builtin_amdgcn_fence(__ATOMIC_RELEASE, "wavefront"); __builtin_amdgcn_wave_barrier(); __builtin_amdgcn_fence(__ATOMIC_ACQUIRE, "wavefront");
}
__device__ __forceinline__ void x_row_to_bf16(const float* __restrict__ x, bf16_t* __restrict__ xb, ssq_t* __restrict__ ss, int row, int lane) {
    const f32x4* xr = (const f32x4*)(x + (size_t)row * D) + lane; float s = 0.f;
#pragma unroll
    for (int j = 0; j < 4; ++j) { const f32x4 v = xr[64 * j]; s += v.x * v.x + v.y * v.y + v.z * v.z + v.w * v.w;
        unsigned long long o = (unsigned long long)(f2bf(v.x) | (f2bf(v.y) << 16)) | ((unsigned long long)(f2bf(v.z) | (f2bf(v.w) << 16)) << 32);
        ((unsigned long long*)(xb + (size_t)row * D))[lane + 64 * j] = o; }
    s = wave_sum(s); if (lane == 0) ss[row] = ssq_fix(s);
}

struct PrepArgs {
    const bf16_t* proj; const float* mu; const float* w0; const float* w2; const float* a0; const float* a2; const float* g2;
    const float* v0; const float* v1; const float* v2; bf16_t* vfirst; int layer; int pad;
    bf16_t *R, *K, *V, *A, *LD, *G;
};
__device__ __forceinline__ void prep_group(const PrepArgs& p, float (*rest)[SHIFT_W], float (*vlo)[32], int grp, int tid) {
    const int m0 = grp * 4;
    for (int i = tid; i < 4 * SHIFT_W; i += 512) {
        const int tk = i / SHIFT_W, c = i % SHIFT_W, m = m0 + tk, t = m % SEQ;
        const float u = bf2f(p.proj[(size_t)m * IN_W + ATT_IN + c]);
        const float up = t > 0 ? bf2f(p.proj[(size_t)(m - 1) * IN_W + ATT_IN + c]) : 0.f;
        float v = u + (up - u) * p.mu[c];
        if (c >= 1536 && c < 1600) v = tanhf(v); else if (c >= 1664) v = sigmoidf_(v);
        rest[tk][c] = v;
    }
    __syncthreads();
    if (p.layer > 0 && tid < 128) { const int tk = tid >> 5, j = tid & 31; float s = 0.f; for (int c = 0; c < C; ++c) s += rest[tk][1024 + c] * p.v1[c * 32 + j]; vlo[tk][j] = s; }
    __syncthreads();
    const int c = tid;
    float wp[4], ap[4], gp[4];
#pragma unroll
    for (int tk = 0; tk < 4; ++tk) { wp[tk] = p.w0[c]; ap[tk] = p.a0[c]; gp[tk] = 0.f; }
    for (int k = 0; k < 64; ++k) { const float w = p.w2[k * C + c], a = p.a2[k * C + c];
#pragma unroll
        for (int tk = 0; tk < 4; ++tk) { wp[tk] += rest[tk][1536 + k] * w; ap[tk] += rest[tk][1600 + k] * a; } }
    for (int k = 0; k < 128; ++k) { const float g = p.g2[k * C + c];
#pragma unroll
        for (int tk = 0; tk < 4; ++tk) gp[tk] += rest[tk][1664 + k] * g; }
#pragma unroll
    for (int tk = 0; tk < 4; ++tk) {
        const size_t o = (size_t)(m0 + tk) * C + c;
        const float x = -wp[tk];
        const float sp = fmaxf(x, 0.f) + log1pf(__expf(-fabsf(x)));
        const float wraw = -sp - 0.5f;
        const float ld = -__expf(wraw);
        const float a = sigmoidf_(ap[tk]);
        float v = rest[tk][1024 + c];
        if (p.layer == 0) p.vfirst[o] = (bf16_t)f2bf(v);
        else { float s = p.v0[c]; for (int j = 0; j < 32; ++j) s += vlo[tk][j] * p.v2[j * C + c]; const float vf = bf2f(p.vfirst[o]); v = v + (vf - v) * sigmoidf_(s); }
        p.R[o] = (bf16_t)f2bf(rest[tk][c]); p.K[o] = (bf16_t)f2bf(rest[tk][512 + c]); p.V[o] = (bf16_t)f2bf(v);
        p.A[o] = (bf16_t)f2bf(a); p.LD[o] = (bf16_t)f2bf(ld); p.G[o] = (bf16_t)f2bf(gp[tk]);
    }
    __syncthreads();
}

constexpr size_t WS_LORA = 50 * MiB;
constexpr size_t LORA_LAYER = 256 * 1024, WS_V1T = WS_LORA + 2 * LORA_LAYER, WS_V2T = WS_V1T + 32 * 1024;
constexpr int PR_ACT_LD = 264, PR_VLO_LD = 40, PR_SG_LD = 520, PR_ACT_OFF = 0, PR_VLO_OFF = 64 * PR_ACT_LD * 2, PR_SG_OFF = PR_VLO_OFF + 64 * PR_VLO_LD * 2;
struct Prep2Args {
    const bf16_t* proj; const float* mu; const float* w0; const float* a0; const float* v0;
    const bf16_t *W2T, *A2T, *G2T, *V1T, *V2T; bf16_t* vfirst; bf16_t *R, *K, *V, *A, *LD, *G; int layer; int pad;
};
__device__ __forceinline__ f32x4 bfx4_lo(const bf16x8 v) { return (f32x4){bf2f((bf16_t)v[0]), bf2f((bf16_t)v[1]), bf2f((bf16_t)v[2]), bf2f((bf16_t)v[3])}; }
__device__ __forceinline__ f32x4 bfx4_hi(const bf16x8 v) { return (f32x4){bf2f((bf16_t)v[4]), bf2f((bf16_t)v[5]), bf2f((bf16_t)v[6]), bf2f((bf16_t)v[7])}; }
__device__ __forceinline__ bf16x8 pack8(const f32x4 a, const f32x4 b) { pg8::u32x4 w; w.x = pg8::cvt_pk_bf16(a[0], a[1]); w.y = pg8::cvt_pk_bf16(a[2], a[3]); w.z = pg8::cvt_pk_bf16(b[0], b[1]); w.w = pg8::cvt_pk_bf16(b[2], b[3]); return __builtin_bit_cast(bf16x8, w); }
__device__ __forceinline__ void shift8(const bf16_t* __restrict__ proj, const float* __restrict__ mu, size_t m, int t, int col, int mi, f32x4& lo, f32x4& hi) {
    const bf16x8 cur = *(const bf16x8*)(proj + m * IN_W + col);
    bf16x8 prv; if (t > 0) prv = *(const bf16x8*)(proj + (m - 1) * IN_W + col); else prv = (bf16x8){0, 0, 0, 0, 0, 0, 0, 0};
    const f32x4 m0 = *(const f32x4*)(mu + mi), m1 = *(const f32x4*)(mu + mi + 4);
    const f32x4 c0 = bfx4_lo(cur), c1 = bfx4_hi(cur), p0 = bfx4_lo(prv), p1 = bfx4_hi(prv);
    lo = c0 + (p0 - c0) * m0; hi = c1 + (p1 - c1) * m1;
}
__device__ __forceinline__ void prep_tile(const Prep2Args& p, unsigned char* lds, int tile, int tid) {
    const int m0 = tile * 64, wave = __builtin_amdgcn_readfirstlane(tid >> 6), lane = tid & 63, fr = lane & 15, fq = lane >> 4;
    bf16_t* ACT = (bf16_t*)(lds + PR_ACT_OFF); bf16_t* VLO = (bf16_t*)(lds + PR_VLO_OFF); bf16_t* SG = (bf16_t*)(lds + PR_SG_OFF);
#pragma unroll
    for (int it = 0; it < 4; ++it) { const int i = tid + 512 * it, tk = i >> 5, cc = i & 31; const size_t m = (size_t)m0 + tk; const int t = (int)(m % SEQ);
        f32x4 lo, hi; shift8(p.proj, p.mu, m, t, 2304 + 8 * cc, 1536 + 8 * cc, lo, hi);
        if (cc < 8) {
#pragma unroll
            for (int e = 0; e < 4; ++e) { lo[e] = 2.f * sigmoidf_(2.f * lo[e]) - 1.f; hi[e] = 2.f * sigmoidf_(2.f * hi[e]) - 1.f; } }
        else if (cc >= 16) {
#pragma unroll
            for (int e = 0; e < 4; ++e) { lo[e] = sigmoidf_(lo[e]); hi[e] = sigmoidf_(hi[e]); } }
        *(bf16x8*)(ACT + tk * PR_ACT_LD + 8 * cc) = pack8(lo, hi); }
    if (p.layer > 0) {
        const int tb = wave >> 1, jb = wave & 1; const size_t m = (size_t)m0 + 16 * tb + fr; const int t = (int)(m % SEQ);
        f32x4 acc = (f32x4){0.f, 0.f, 0.f, 0.f};
#pragma unroll 4
        for (int ks = 0; ks < 16; ++ks) { f32x4 lo, hi; shift8(p.proj, p.mu, m, t, 1792 + 32 * ks + 8 * fq, 1024 + 32 * ks + 8 * fq, lo, hi);
            const bf16x8 wf = *(const bf16x8*)(p.V1T + (size_t)(16 * jb + fr) * C + 32 * ks + 8 * fq);
            acc = __builtin_amdgcn_mfma_f32_16x16x32_bf16(wf, pack8(lo, hi), acc, 0, 0, 0); }
        uint2 w; w.x = pg8::cvt_pk_bf16(acc[0], acc[1]); w.y = pg8::cvt_pk_bf16(acc[2], acc[3]);
        *(uint2*)(VLO + (16 * tb + fr) * PR_VLO_LD + 16 * jb + 4 * fq) = w;
    }
    __syncthreads();
    const int ch0 = 64 * wave;
#pragma unroll
    for (int arr = 0; arr < 3; ++arr) {
        const int K0 = arr == 0 ? 0 : (arr == 1 ? 64 : 128), KL = arr == 2 ? 128 : 64; const bf16_t* WT = arr == 0 ? p.W2T : (arr == 1 ? p.A2T : p.G2T);
        f32x4 acc[4][4];
#pragma unroll
        for (int tb = 0; tb < 4; ++tb)
#pragma unroll
            for (int cb = 0; cb < 4; ++cb) acc[tb][cb] = (f32x4){0.f, 0.f, 0.f, 0.f};
#pragma unroll
        for (int ks = 0; ks < KL / 32; ++ks) { bf16x8 wf[4], af[4];
#pragma unroll
            for (int cb = 0; cb < 4; ++cb) wf[cb] = *(const bf16x8*)(WT + (size_t)(ch0 + 16 * cb + fr) * KL + 32 * ks + 8 * fq);
#pragma unroll
            for (int tb = 0; tb < 4; ++tb) af[tb] = *(const bf16x8*)(ACT + (16 * tb + fr) * PR_ACT_LD + K0 + 32 * ks + 8 * fq);
#pragma unroll
            for (int tb = 0; tb < 4; ++tb)
#pragma unroll
                for (int cb = 0; cb < 4; ++cb) acc[tb][cb] = __builtin_amdgcn_mfma_f32_16x16x32_bf16(wf[cb], af[tb], acc[tb][cb], 0, 0, 0); }
        bf16_t* OUT = arr == 0 ? p.LD : (arr == 1 ? p.A : p.G);
#pragma unroll
        for (int cb = 0; cb < 4; ++cb) { const int ch = ch0 + 16 * cb + 4 * fq;
            f32x4 bias = (f32x4){0.f, 0.f, 0.f, 0.f}; if (arr == 0) bias = *(const f32x4*)(p.w0 + ch); else if (arr == 1) bias = *(const f32x4*)(p.a0 + ch);
#pragma unroll
            for (int tb = 0; tb < 4; ++tb) { f32x4 x = acc[tb][cb] + bias;
                if (arr == 0) {
#pragma unroll
                    for (int e = 0; e < 4; ++e) { const float z = -x[e]; const float sp = fmaxf(z, 0.f) + __logf(1.f + __expf(-fabsf(z))); x[e] = -__expf(-sp - 0.5f); } }
                else if (arr == 1) {
#pragma unroll
                    for (int e = 0; e < 4; ++e) x[e] = sigmoidf_(x[e]); }
                uint2 w; w.x = pg8::cvt_pk_bf16(x[0], x[1]); w.y = pg8::cvt_pk_bf16(x[2], x[3]);
                *(uint2*)(OUT + ((size_t)m0 + 16 * tb + fr) * C + ch) = w; } }
    }
    if (p.layer > 0) {
        bf16x8 af[4];
#pragma unroll
        for (int tb = 0; tb < 4; ++tb) af[tb] = *(const bf16x8*)(VLO + (16 * tb + fr) * PR_VLO_LD + 8 * fq);
#pragma unroll
        for (int cb = 0; cb < 4; ++cb) { const int ch = ch0 + 16 * cb + 4 * fq; const bf16x8 wf = *(const bf16x8*)(p.V2T + (size_t)(ch0 + 16 * cb + fr) * 32 + 8 * fq); const f32x4 bias = *(const f32x4*)(p.v0 + ch);
#pragma unroll
            for (int tb = 0; tb < 4; ++tb) { f32x4 x = __builtin_amdgcn_mfma_f32_16x16x32_bf16(wf, af[tb], (f32x4){0.f, 0.f, 0.f, 0.f}, 0, 0, 0) + bias;
                uint2 w; w.x = pg8::cvt_pk_bf16(sigmoidf_(x[0]), sigmoidf_(x[1])); w.y = pg8::cvt_pk_bf16(sigmoidf_(x[2]), sigmoidf_(x[3]));
                *(uint2*)(SG + (16 * tb + fr) * PR_SG_LD + ch) = w; } }
    }
    __syncthreads();
#pragma unroll
    for (int sec = 0; sec < 3; ++sec) { bf16_t* OUT = sec == 0 ? p.R : (sec == 1 ? p.K : p.V);
        bf16x8 cu[8], pv[8], vf[8];
#pragma unroll
        for (int it = 0; it < 8; ++it) { const int i = tid + 512 * it, tk = i >> 6, cc = i & 63; const size_t m = (size_t)m0 + tk; const int t = (int)(m % SEQ); const int col = 768 + 512 * sec + 8 * cc;
            cu[it] = *(const bf16x8*)(p.proj + m * IN_W + col); if (t > 0) pv[it] = *(const bf16x8*)(p.proj + (m - 1) * IN_W + col); else pv[it] = (bf16x8){0, 0, 0, 0, 0, 0, 0, 0};
            if (sec == 2 && p.layer > 0) vf[it] = *(const bf16x8*)(p.vfirst + m * C + 8 * cc); }
#pragma unroll
        for (int it = 0; it < 8; ++it) { const int i = tid + 512 * it, tk = i >> 6, cc = i & 63; const size_t m = (size_t)m0 + tk; const int mi = 512 * sec + 8 * cc;
            const f32x4 mu0 = *(const f32x4*)(p.mu + mi), mu1 = *(const f32x4*)(p.mu + mi + 4);
            const f32x4 c0 = bfx4_lo(cu[it]), c1 = bfx4_hi(cu[it]);
            f32x4 lo = c0 + (bfx4_lo(pv[it]) - c0) * mu0, hi = c1 + (bfx4_hi(pv[it]) - c1) * mu1;
            const size_t o = m * C + 8 * cc;
            if (sec == 2) {
                if (p.layer == 0) *(bf16x8*)(p.vfirst + o) = pack8(lo, hi);
                else { const bf16x8 sg = *(const bf16x8*)(SG + tk * PR_SG_LD + 8 * cc);
                    lo = lo + (bfx4_lo(vf[it]) - lo) * bfx4_lo(sg); hi = hi + (bfx4_hi(vf[it]) - hi) * bfx4_hi(sg); } }
            *(bf16x8*)(OUT + o) = pack8(lo, hi); } }
    __syncthreads();
}

constexpr int NTHREADS_ = 512;
constexpr int SC_TB = 32, SC_SLOT = 384, SC_NCH = SEQ / SC_TB;
constexpr size_t WS_RKC = 51 * MiB;
struct ScanArgs { const bf16_t *R, *K, *V, *A, *LD, *G; const float *k_k, *k_a, *r_k, *lnx_g, *lnx_b; bf16_t* mix; float* rkc; };
template <int CTRL> __device__ __forceinline__ float dpp_mov(float x) { return __builtin_bit_cast(float, __builtin_amdgcn_update_dpp(0, __builtin_bit_cast(int, x), CTRL, 0xF, 0xF, true)); }
__device__ __forceinline__ float reduce16(float x) { x += dpp_mov<0xB1>(x); x += dpp_mov<0x4E>(x); x += dpp_mov<0x141>(x); x += dpp_mov<0x140>(x); return x; }
__device__ __forceinline__ void scan_item(const ScanArgs& p, float* lds, int item, int tid) {
    const int chain = item >> 2, q = item & 3, b = chain >> 3, h = chain & 7, wave = __builtin_amdgcn_readfirstlane(tid >> 6), lane = tid & 63;
    float* buf = lds;
    float* ybuf = lds + 2 * SC_TB * SC_SLOT;
    if (wave >= 4) {
        const int lw = wave - 4, lt = lw * 64 + lane, cgl = lane & 15, srow = lane >> 4, ch4 = h * 64 + 4 * cgl;
        const f32x4 kk_c = *(const f32x4*)(p.k_k + ch4), ka_c = *(const f32x4*)(p.k_a + ch4), rk_c = *(const f32x4*)(p.r_k + ch4);
        const size_t rowbase = (size_t)b * SEQ;
        struct LdSet { uint2 r[2], k[2], v[2], a[2], ld[2]; } s0, s1;
#define SC_LOAD(S, chunk) do { _Pragma("unroll") for (int ps = 0; ps < 2; ++ps) { const size_t o = (rowbase + (size_t)(chunk) * SC_TB + 8 * lw + 4 * ps + srow) * C + ch4; \
            S.r[ps] = *(const uint2*)(p.R + o); S.k[ps] = *(const uint2*)(p.K + o); S.v[ps] = *(const uint2*)(p.V + o); S.a[ps] = *(const uint2*)(p.A + o); S.ld[ps] = *(const uint2*)(p.LD + o); } } while (0)
#define SC_UNPK(u) ((f32x4){__builtin_bit_cast(float, (u).x << 16), __builtin_bit_cast(float, (u).x & 0xffff0000u), __builtin_bit_cast(float, (u).y << 16), __builtin_bit_cast(float, (u).y & 0xffff0000u)})
#define SC_PROC(S, chunk, bi) do { _Pragma("unroll") for (int ps = 0; ps < 2; ++ps) { const int st = 8 * lw + 4 * ps + srow; \
            const f32x4 r = SC_UNPK(S.r[ps]), k = SC_UNPK(S.k[ps]), v = SC_UNPK(S.v[ps]), a = SC_UNPK(S.a[ps]), ld = SC_UNPK(S.ld[ps]); \
            f32x4 kk = k * kk_c; const float nrm = sqrtf(reduce16((kk.x * kk.x + kk.z * kk.z) + (kk.y * kk.y + kk.w * kk.w))); kk = kk * (1.f / fmaxf(nrm, 1e-12f)); \
            const f32x4 kp = k * ((a - 1.f) * ka_c + 1.f); const f32x4 t3 = r * kp * rk_c; const float rkc = reduce16((t3.x + t3.z) + (t3.y + t3.w)); \
            float* slot = buf + ((bi) * SC_TB + st) * SC_SLOT + 4 * cgl; \
            *(f32x4*)(slot) = (f32x4){__expf(ld.x), __expf(ld.y), __expf(ld.z), __expf(ld.w)}; *(f32x4*)(slot + 64) = -kk; *(f32x4*)(slot + 128) = kk * a; *(f32x4*)(slot + 192) = kp; *(f32x4*)(slot + 256) = r; *(f32x4*)(slot + 320) = v; \
            if (q == 0 && cgl == 0) p.rkc[(rowbase + (size_t)(chunk) * SC_TB + st) * 8 + h] = rkc; } } while (0)
#define SC_YOUT(chunk, bi) do { _Pragma("unroll") for (int e2 = 0; e2 < 2; ++e2) { const int e = lt + 256 * e2, st = e >> 4, rr = e & 15; \
            p.mix[(rowbase + (size_t)(chunk) * SC_TB + st) * D + ATT_W + h * 64 + 16 * q + rr] = (bf16_t)f2bf(ybuf[(bi) * SC_TB * 16 + e]); } } while (0)
        SC_LOAD(s0, 0); SC_LOAD(s1, 1); SC_PROC(s0, 0, 0);
        __syncthreads();
        for (int c = 0; c < SC_NCH; c += 2) {
            if (c + 2 < SC_NCH) SC_LOAD(s0, c + 2);
            SC_PROC(s1, c + 1, 1);
            if (c >= 1) SC_YOUT(c - 1, 1);
            __syncthreads();
            if (c + 3 < SC_NCH) SC_LOAD(s1, c + 3);
            if (c + 2 < SC_NCH) SC_PROC(s0, c + 2, 0);
            SC_YOUT(c, 0);
            __syncthreads();
        }
        SC_YOUT(SC_NCH - 1, 1);
#undef SC_LOAD
#undef SC_UNPK
#undef SC_PROC
#undef SC_YOUT
    } else {
        const int cg4 = (lane & 15) * 4, rloc = 4 * wave + (lane >> 4);
        f32x4 S = (f32x4){0.f, 0.f, 0.f, 0.f};
#define SC_SCAN(bi) do { const float* bp = buf + (bi) * SC_TB * SC_SLOT + cg4; const float* vp = buf + (bi) * SC_TB * SC_SLOT + 320 + 16 * q + rloc; \
            const unsigned ya = (unsigned)(size_t)(__attribute__((address_space(3))) float*)(((lane & 15) == 0) ? (ybuf + (bi) * SC_TB * 16 + rloc) : (ybuf + 2 * SC_TB * 16 + lane)); \
            f32x4 w = *(const f32x4*)(bp), A = *(const f32x4*)(bp + 64), B = *(const f32x4*)(bp + 128), kp = *(const f32x4*)(bp + 192), r = *(const f32x4*)(bp + 256); float v = vp[0]; \
            _Pragma("unroll") for (int st = 0; st < SC_TB; ++st) { \
                f32x4 wn = w, An = A, Bn = B, kpn = kp, rn = r; float vn = v; \
                if (st + 1 < SC_TB) { wn = *(const f32x4*)(bp + (st + 1) * SC_SLOT); An = *(const f32x4*)(bp + (st + 1) * SC_SLOT + 64); Bn = *(const f32x4*)(bp + (st + 1) * SC_SLOT + 128); \
                    kpn = *(const f32x4*)(bp + (st + 1) * SC_SLOT + 192); rn = *(const f32x4*)(bp + (st + 1) * SC_SLOT + 256); vn = vp[(st + 1) * SC_SLOT]; }     \
                float sa = (S.x * A.x + S.z * A.z) + (S.y * A.y + S.w * A.w); sa = reduce16(sa); \
                S = S * w + (B * sa + kp * v); \
                float y = (S.x * r.x + S.z * r.z) + (S.y * r.y + S.w * r.w); y = reduce16(y); \
                asm volatile("ds_write_b32 %0, %1 offset:%c2" :: "v"(ya), "v"(y), "i"(st * 64)); \
                w = wn; A = An; B = Bn; kp = kpn; r = rn; v = vn; } } while (0)
        __syncthreads();
        for (int c = 0; c < SC_NCH; c += 2) { SC_SCAN(0); __syncthreads(); SC_SCAN(1); __syncthreads(); }
#undef SC_SCAN
    }
    __syncthreads();
}
constexpr int CK_LD = 72, CK_MAT = 64 * CK_LD * 2;
constexpr size_t WS_TSCR = WS_SI_A, TSCR_WG = 4 * 64 * C * 2;
__device__ __forceinline__ void ck_mm(f32x4 (&acc)[2], const bf16_t* Qm, const bf16_t* P, int jb, int ib0, int fr, int fq) {
#pragma unroll
    for (int ks = 0; ks < 2; ++ks) { const bf16x8 bq = *(const bf16x8*)(Qm + (16 * jb + fr) * CK_LD + 32 * ks + 8 * fq);
#pragma unroll
        for (int ii = 0; ii < 2; ++ii) { const bf16x8 ap = *(const bf16x8*)(P + (16 * (ib0 + ii) + fr) * CK_LD + 32 * ks + 8 * fq); acc[ii] = __builtin_amdgcn_mfma_f32_16x16x32_bf16(ap, bq, acc[ii], 0, 0, 0); } }
}
__device__ __forceinline__ uint2 ck_pack4(const f32x4 v) { uint2 w; w.x = pg8::cvt_pk_bf16(v[0], v[1]); w.y = pg8::cvt_pk_bf16(v[2], v[3]); return w; }
__device__ __forceinline__ f32x4 ck_unpack4(const uint2 u) { return (f32x4){__builtin_bit_cast(float, u.x << 16), __builtin_bit_cast(float, u.x & 0xffff0000u), __builtin_bit_cast(float, u.y << 16), __builtin_bit_cast(float, u.y & 0xffff0000u)}; }
struct CkRaw { unsigned r[8], k[8], v[8], a[8], ld[8]; };
__device__ __forceinline__ float wave_sum_dpp(float x) {
    x = reduce16(x); const int xi = __builtin_bit_cast(int, x);
    const float r0 = __builtin_bit_cast(float, __builtin_amdgcn_readlane(xi, 0)), r1 = __builtin_bit_cast(float, __builtin_amdgcn_readlane(xi, 16)), r2 = __builtin_bit_cast(float, __builtin_amdgcn_readlane(xi, 32)), r3 = __builtin_bit_cast(float, __builtin_amdgcn_readlane(xi, 48));
    return (r0 + r1) + (r2 + r3); }
__device__ __forceinline__ void ck_load(const ScanArgs& p, CkRaw& w, int unit, int tid) {
    const int chain = unit >> 6, chunk = unit & 63, b = chain >> 3, h = chain & 7, wave = tid >> 6, lane = tid & 63; const int ch = h * 64 + lane; const size_t row0 = (size_t)b * SEQ + chunk * 64 + 8 * wave;
#pragma unroll
    for (int i = 0; i < 8; ++i) { const size_t o = (row0 + i) * C + ch; w.r[i] = p.R[o]; w.k[i] = p.K[o]; w.v[i] = p.V[o]; w.a[i] = p.A[o]; w.ld[i] = p.LD[o]; }
}
__device__ __forceinline__ void ck_precompute(const ScanArgs& p, const CkRaw& raw, unsigned char* lds, bf16_t* GQ, bf16_t* CQ, int unit, int tid) {
    const int chain = unit >> 6, chunk = unit & 63, b = chain >> 3, h = chain & 7, wave = __builtin_amdgcn_readfirstlane(tid >> 6), lane = tid & 63, fr = lane & 15, fq = lane >> 4, jb = wave >> 1, ib0 = 2 * (wave & 1);
    bf16_t* At = (bf16_t*)(lds + 0 * CK_MAT); bf16_t* bt = (bf16_t*)(lds + 1 * CK_MAT); bf16_t* kt = (bf16_t*)(lds + 2 * CK_MAT); bf16_t* rt = (bf16_t*)(lds + 3 * CK_MAT);
    bf16_t* AtT = (bf16_t*)(lds + 4 * CK_MAT); bf16_t* BhT = (bf16_t*)(lds + 5 * CK_MAT); bf16_t* KhT = (bf16_t*)(lds + 6 * CK_MAT); bf16_t* VT = (bf16_t*)(lds + 7 * CK_MAT);
    bf16_t* NT = (bf16_t*)(lds + 8 * CK_MAT); bf16_t* Mm = (bf16_t*)(lds + 9 * CK_MAT); bf16_t* P1 = (bf16_t*)(lds + 10 * CK_MAT); bf16_t* P2 = (bf16_t*)(lds + 11 * CK_MAT);
    bf16_t* Ta = (bf16_t*)(lds + 12 * CK_MAT); bf16_t* Tb = (bf16_t*)(lds + 13 * CK_MAT); float* WT = (float*)(lds + 14 * CK_MAT); float* GL = WT + 512;
    bf16_t* W1T = bt; bf16_t* MVT = kt; bf16_t* W2T = At;
    {
        const int ch = h * 64 + lane; const size_t row0 = (size_t)b * SEQ + chunk * 64 + 8 * wave;
        const float kk_c = p.k_k[ch], ka_c = p.k_a[ch], rk_c = p.r_k[ch];
        float r[8], kp[8], Aq[8], bq[8], v[8], ld[8], cl[8]; float run = 0.f;
#pragma unroll
        for (int i = 0; i < 8; ++i) { r[i] = bf2f((bf16_t)raw.r[i]); kp[i] = bf2f((bf16_t)raw.k[i]); v[i] = bf2f((bf16_t)raw.v[i]); bq[i] = bf2f((bf16_t)raw.a[i]); ld[i] = bf2f((bf16_t)raw.ld[i]); }
#pragma unroll
        for (int i = 0; i < 8; ++i) { const float k = kp[i], a = bq[i]; float kk = k * kk_c; kk = kk * fminf(__builtin_amdgcn_rsqf(wave_sum_dpp(kk * kk)), 1e12f);
            kp[i] = k * (1.f + (a - 1.f) * ka_c); Aq[i] = -kk; bq[i] = kk * a; const float rkc = wave_sum_dpp(r[i] * kp[i] * rk_c);
            if (lane == 0) p.rkc[(row0 + i) * 8 + h] = rkc; run += ld[i]; cl[i] = run; }
        WT[wave * 64 + lane] = run;
        __syncthreads();
        float off = 0.f, csL = 0.f;
#pragma unroll
        for (int w2 = 0; w2 < 8; ++w2) { const float t = WT[w2 * 64 + lane]; csL += t; if (w2 < wave) off += t; }
        if (wave == 0) GL[lane] = __expf(csL);
        float aT[8], bhT[8], khT[8];
#pragma unroll
        for (int i = 0; i < 8; ++i) { const float cs = off + cl[i], em = __expf(cs - ld[i]), en = __expf(-cs), ep = __expf(cs), eL = __expf(csL - cs); const int tl = 8 * wave + i;
            const float at = Aq[i] * em; aT[i] = at; bhT[i] = bq[i] * eL; khT[i] = kp[i] * eL;
            At[tl * CK_LD + lane] = (bf16_t)f2bf(at); bt[tl * CK_LD + lane] = (bf16_t)f2bf(bq[i] * en); kt[tl * CK_LD + lane] = (bf16_t)f2bf(kp[i] * en); rt[tl * CK_LD + lane] = (bf16_t)f2bf(r[i] * ep); }
        *(bf16x8*)(AtT + lane * CK_LD + 8 * wave) = pack8((f32x4){aT[0], aT[1], aT[2], aT[3]}, (f32x4){aT[4], aT[5], aT[6], aT[7]});
        *(bf16x8*)(BhT + lane * CK_LD + 8 * wave) = pack8((f32x4){bhT[0], bhT[1], bhT[2], bhT[3]}, (f32x4){bhT[4], bhT[5], bhT[6], bhT[7]});
        *(bf16x8*)(KhT + lane * CK_LD + 8 * wave) = pack8((f32x4){khT[0], khT[1], khT[2], khT[3]}, (f32x4){khT[4], khT[5], khT[6], khT[7]});
        *(bf16x8*)(VT + lane * CK_LD + 8 * wave) = pack8((f32x4){v[0], v[1], v[2], v[3]}, (f32x4){v[4], v[5], v[6], v[7]});
    }
    __syncthreads();
    const int j = 16 * jb + fr; const f32x4 z4 = (f32x4){0.f, 0.f, 0.f, 0.f};
    { f32x4 aN[2] = {z4, z4}, aNT[2] = {z4, z4}, aM[2] = {z4, z4}, aP1[2] = {z4, z4}, aP2[2] = {z4, z4};
      ck_mm(aN, At, bt, jb, ib0, fr, fq); ck_mm(aNT, bt, At, jb, ib0, fr, fq); ck_mm(aM, At, kt, jb, ib0, fr, fq); ck_mm(aP1, rt, bt, jb, ib0, fr, fq); ck_mm(aP2, rt, kt, jb, ib0, fr, fq);
#pragma unroll
      for (int ii = 0; ii < 2; ++ii) { const int i0 = 16 * (ib0 + ii) + 4 * fq; f32x4 t0, nt, mm, p1, p2;
#pragma unroll
          for (int e = 0; e < 4; ++e) { const int i = i0 + e; t0[e] = (i < j ? aN[ii][e] : 0.f) + (i == j ? 1.f : 0.f); nt[e] = j < i ? aNT[ii][e] : 0.f; mm[e] = i < j ? aM[ii][e] : 0.f; p1[e] = i <= j ? aP1[ii][e] : 0.f; p2[e] = i <= j ? aP2[ii][e] : 0.f; }
          *(uint2*)(Ta + j * CK_LD + i0) = ck_pack4(t0); *(uint2*)(NT + j * CK_LD + i0) = ck_pack4(nt); *(uint2*)(Mm + j * CK_LD + i0) = ck_pack4(mm); *(uint2*)(P1 + j * CK_LD + i0) = ck_pack4(p1); *(uint2*)(P2 + j * CK_LD + i0) = ck_pack4(p2); } }
    __syncthreads();
#pragma unroll
    for (int st = 0; st < 3; ++st) { const bf16_t* src = (st & 1) ? Tb : Ta; bf16_t* dst = (st & 1) ? Ta : Tb; f32x4 a2[2] = {z4, z4}; ck_mm(a2, src, NT, jb, ib0, fr, fq);
#pragma unroll
        for (int ii = 0; ii < 2; ++ii) { const int i0 = 16 * (ib0 + ii) + 4 * fq; f32x4 t = a2[ii];
#pragma unroll
            for (int e = 0; e < 4; ++e) t[e] += (i0 + e == j) ? 1.f : 0.f;
            *(uint2*)(dst + j * CK_LD + i0) = ck_pack4(t); }
        __syncthreads(); }
    { f32x4 a1[2] = {z4, z4}, a2[2] = {z4, z4}; ck_mm(a1, AtT, Tb, jb, ib0, fr, fq); ck_mm(a2, VT, Mm, jb, ib0, fr, fq);
#pragma unroll
      for (int ii = 0; ii < 2; ++ii) { const int i0 = 16 * (ib0 + ii) + 4 * fq; *(uint2*)(W1T + j * CK_LD + i0) = ck_pack4(a1[ii]); *(uint2*)(MVT + j * CK_LD + i0) = ck_pack4(a2[ii]); } }
    __syncthreads();
    { f32x4 a1[2] = {z4, z4}; ck_mm(a1, MVT, Tb, jb, ib0, fr, fq);
#pragma unroll
      for (int ii = 0; ii < 2; ++ii) { const int i0 = 16 * (ib0 + ii) + 4 * fq; *(uint2*)(W2T + j * CK_LD + i0) = ck_pack4(a1[ii]); } }
    __syncthreads();
    { f32x4 aQ1[2] = {z4, z4}, aG[2] = {z4, z4}, aQ2[2] = {z4, z4}, aC[2] = {z4, z4};
      ck_mm(aQ1, P1, W1T, jb, ib0, fr, fq); ck_mm(aG, BhT, W1T, jb, ib0, fr, fq); ck_mm(aQ2, P1, W2T, jb, ib0, fr, fq); ck_mm(aQ2, P2, VT, jb, ib0, fr, fq); ck_mm(aC, W2T, BhT, jb, ib0, fr, fq); ck_mm(aC, VT, KhT, jb, ib0, fr, fq);
      bf16_t* gq = GQ + (size_t)unit * 8192; bf16_t* cq = CQ + (size_t)unit * 8192; const float glj = GL[j];
#pragma unroll
      for (int ii = 0; ii < 2; ++ii) { const int i0 = 16 * (ib0 + ii) + 4 * fq; f32x4 g = aG[ii];
#pragma unroll
          for (int e = 0; e < 4; ++e) g[e] += (i0 + e == j) ? glj : 0.f;
          const f32x4 q1 = aQ1[ii] + ck_unpack4(*(const uint2*)(rt + j * CK_LD + i0));
          *(uint2*)(gq + j * 64 + i0) = ck_pack4(g); *(uint2*)(gq + 4096 + j * 64 + i0) = ck_pack4(q1); *(uint2*)(cq + j * 64 + i0) = ck_pack4(aC[ii]); *(uint2*)(cq + 4096 + j * 64 + i0) = ck_pack4(aQ2[ii]); } }
    __syncthreads();
}
__device__ __forceinline__ void ck_sequential(const ScanArgs& p, unsigned char* lds, const bf16_t* GQ, const bf16_t* CQ, int item, int tid) {
    const int chain = item >> 2, q = item & 3, b = chain >> 3, h = chain & 7, wave = __builtin_amdgcn_readfirstlane(tid >> 6), lane = tid & 63, fr = lane & 15, fq = lane >> 4;
    bf16_t* OPS = (bf16_t*)lds;
    bf16_t* HT = (bf16_t*)(lds + 4 * CK_MAT);
    for (int i = tid; i < 2 * 16 * CK_LD / 2; i += NTHREADS_) ((unsigned*)HT)[i] = 0u;
    const size_t ubase = (size_t)chain * 64; const size_t rowbase = (size_t)b * SEQ;
    const int prow0 = tid >> 3, pcol = (tid & 7) * 8;
    const int aoff = wave < 4 ? (4096 + (16 * wave + fr) * 64 + 16 * q + 4 * fq) : ((16 * q + fr) * 64 + 16 * (wave - 4) + 4 * fq);
    typedef unsigned u32x2_ __attribute__((ext_vector_type(2)));
    pg8::u32x4 g0_0, g0_1, g0_2, g0_3, g1_0, g1_1, g1_2, g1_3; u32x2_ ad_0, ad_1, ad_2, ad_3;
#define CK_FETCH(slot, cc) do { const bf16_t* gq = GQ + (ubase + (cc)) * 8192; g0_##slot = *(const pg8::u32x4*)(gq + (size_t)prow0 * 64 + pcol); g1_##slot = *(const pg8::u32x4*)(gq + (size_t)(prow0 + 64) * 64 + pcol); \
        ad_##slot = *(const u32x2_*)(CQ + (ubase + (cc)) * 8192 + aoff); } while (0)
#define CK_STAGE(slot, buf) do { *(pg8::u32x4*)(OPS + (buf) * 2 * 64 * CK_LD + prow0 * CK_LD + pcol) = g0_##slot; *(pg8::u32x4*)(OPS + (buf) * 2 * 64 * CK_LD + 64 * CK_LD + prow0 * CK_LD + pcol) = g1_##slot; } while (0)
    CK_FETCH(0, 0); CK_FETCH(1, 1); CK_FETCH(2, 2); CK_FETCH(3, 3);
    CK_STAGE(0, 0);
    __syncthreads();
#define CK_STEP(cc, slot, nslot) do { const int bi = (cc) & 1; const bf16_t* Gm = OPS + bi * 2 * 64 * CK_LD; const bf16_t* Q1m = Gm + 64 * CK_LD; const bf16_t* HTc = HT + bi * 16 * CK_LD; bf16_t* HTn = HT + (bi ^ 1) * 16 * CK_LD; \
        f32x4 acc = (f32x4){0.f, 0.f, 0.f, 0.f}; \
        if (wave < 4) { _Pragma("unroll") for (int ks = 0; ks < 2; ++ks) acc = __builtin_amdgcn_mfma_f32_16x16x32_bf16(*(const bf16x8*)(HTc + fr * CK_LD + 32 * ks + 8 * fq), *(const bf16x8*)(Q1m + (16 * wave + fr) * CK_LD + 32 * ks + 8 * fq), acc, 0, 0, 0); \
            acc = acc + ck_unpack4((uint2){ad_##slot.x, ad_##slot.y}); \
            *(uint2*)(p.mix + (rowbase + (size_t)(cc) * 64 + 16 * wave + fr) * D + ATT_W + h * 64 + 16 * q + 4 * fq) = ck_pack4(acc); } \
        else { _Pragma("unroll") for (int ks = 0; ks < 2; ++ks) acc = __builtin_amdgcn_mfma_f32_16x16x32_bf16(*(const bf16x8*)(Gm + (16 * (wave - 4) + fr) * CK_LD + 32 * ks + 8 * fq), *(const bf16x8*)(HTc + fr * CK_LD + 32 * ks + 8 * fq), acc, 0, 0, 0); \
            acc = acc + ck_unpack4((uint2){ad_##slot.x, ad_##slot.y}); \
            *(uint2*)(HTn + fr * CK_LD + 16 * (wave - 4) + 4 * fq) = ck_pack4(acc); } \
        if ((cc) + 1 < 64) CK_STAGE(nslot, bi ^ 1); \
        if ((cc) + 4 < 64) CK_FETCH(slot, (cc) + 4); \
        __syncthreads(); } while (0)
    for (int c = 0; c < 64; c += 4) { CK_STEP(c, 0, 1); CK_STEP(c + 1, 1, 2); CK_STEP(c + 2, 2, 3); CK_STEP(c + 3, 3, 0); }
#undef CK_FETCH
#undef CK_STAGE
#undef CK_STEP
}

__device__ __forceinline__ float red8(float x) { x += dpp_mov<0xB1>(x); x += dpp_mov<0x4E>(x); x += dpp_mov<0x141>(x); return x; }
__device__ __forceinline__ void scan_post_rows(const ScanArgs& p, int m0, int lane) {
    const int ch8 = 8 * lane, hh = lane >> 3;
    const f32x4 lg0 = *(const f32x4*)(p.lnx_g + ch8), lg1 = *(const f32x4*)(p.lnx_g + ch8 + 4), lb0 = *(const f32x4*)(p.lnx_b + ch8), lb1 = *(const f32x4*)(p.lnx_b + ch8 + 4);
    bf16x8 yv[2], vv[2], gv[2]; float rk[2];
#pragma unroll
    for (int u = 0; u < 2; ++u) { const size_t m = (size_t)m0 + u; yv[u] = *(const bf16x8*)(p.mix + m * D + ATT_W + ch8); vv[u] = *(const bf16x8*)(p.V + m * C + ch8); gv[u] = *(const bf16x8*)(p.G + m * C + ch8); rk[u] = p.rkc[m * 8 + hh]; }
#pragma unroll
    for (int u = 0; u < 2; ++u) { const size_t m = (size_t)m0 + u;
        f32x4 y0 = bfx4_lo(yv[u]), y1 = bfx4_hi(yv[u]);
        const float mean = red8((y0.x + y0.y) + (y0.z + y0.w) + (y1.x + y1.y) + (y1.z + y1.w)) * (1.f / 64.f);
        y0 = y0 - mean; y1 = y1 - mean;
        const float var = red8((y0.x * y0.x + y0.y * y0.y) + (y0.z * y0.z + y0.w * y0.w) + (y1.x * y1.x + y1.y * y1.y) + (y1.z * y1.z + y1.w * y1.w)) * (1.f / 64.f);
        const float rs = rsqrtf(var + LNX_EPS);
        const f32x4 o0 = (y0 * rs * lg0 + lb0 + bfx4_lo(vv[u]) * rk[u]) * bfx4_lo(gv[u]), o1 = (y1 * rs * lg1 + lb1 + bfx4_hi(vv[u]) * rk[u]) * bfx4_hi(gv[u]);
        *(bf16x8*)(p.mix + m * D + ATT_W + ch8) = pack8(o0, o1); }
}

typedef float f32x16 __attribute__((ext_vector_type(16)));
typedef short s16x4 __attribute__((ext_vector_type(4)));
constexpr int AT_VTS = 196;
__device__ __forceinline__ int crow(int r, int hi) { return (r & 3) + 8 * (r >> 2) + 4 * hi; }
__device__ __forceinline__ void attn_unit(const bf16_t* __restrict__ proj, const float* __restrict__ sinks, bf16_t* __restrict__ mix, bf16_t* vt, int unit, int tid) {
    const int b = unit >> 7, kvh = (unit >> 6) & 1, qb = unit & 63, Q0 = qb * 64;
    const int wave = __builtin_amdgcn_readfirstlane(tid >> 6), lane = tid & 63, c = lane & 31, hi = lane >> 5, g = wave >> 1, half = wave & 1, h = kvh * 4 + g;
    const size_t rowb = (size_t)b * SEQ;
    for (int i = tid; i < 192 * 8; i += 512) { const int kl = i >> 3, ch8 = i & 7; int key = Q0 - 128 + kl; key = key < 0 ? 0 : key;
        const bf16x8 v = *(const bf16x8*)(proj + (rowb + key) * IN_W + 640 + kvh * 64 + ch8 * 8);
#pragma unroll
        for (int e = 0; e < 8; ++e) vt[(ch8 * 8 + e) * AT_VTS + kl] = (bf16_t)v[e]; }
    __syncthreads();
    const int t0 = Q0 + 32 * half; const size_t mq = rowb + t0 + c;
    bf16x8 qf[4];
#pragma unroll
    for (int ks = 0; ks < 4; ++ks) qf[ks] = *(const bf16x8*)(proj + mq * IN_W + h * 64 + 16 * ks + 8 * hi);
    f32x16 p[5];
#pragma unroll
    for (int kb = 0; kb < 5; ++kb) { int key = t0 - 128 + 32 * kb + c; key = key < 0 ? 0 : key; const bf16_t* kp = proj + (rowb + key) * IN_W + 512 + kvh * 64 + 8 * hi;
        f32x16 acc;
#pragma unroll
        for (int r = 0; r < 16; ++r) acc[r] = 0.f;
#pragma unroll
        for (int ks = 0; ks < 4; ++ks) acc = __builtin_amdgcn_mfma_f32_32x32x16_bf16(*(const bf16x8*)(kp + 16 * ks), qf[ks], acc, 0, 0, 0);
        p[kb] = acc; }
    const float slope = exp2f(-(float)(h + 1)), sink = sinks[h];
    float mx = sink;
#pragma unroll
    for (int kb = 0; kb < 5; ++kb)
#pragma unroll
        for (int r = 0; r < 16; ++r) { const int cr = crow(r, hi), dist = c + 128 - 32 * kb - cr, key = t0 - 128 + 32 * kb + cr;
            const float sc = (dist >= 0 && dist < WINDOW && key >= 0) ? p[kb][r] * 0.125f - slope * (float)dist : -1e30f; p[kb][r] = sc; mx = fmaxf(mx, sc); }
    mx = fmaxf(mx, __shfl_xor(mx, 32));
    float l = 0.f;
#pragma unroll
    for (int kb = 0; kb < 5; ++kb)
#pragma unroll
        for (int r = 0; r < 16; ++r) { const float e = __expf(p[kb][r] - mx); p[kb][r] = e; l += e; }
    l += __shfl_xor(l, 32); l += __expf(sink - mx);
    f32x16 o[2];
#pragma unroll
    for (int d = 0; d < 2; ++d)
#pragma unroll
        for (int r = 0; r < 16; ++r) o[d][r] = 0.f;
#pragma unroll
    for (int kb = 0; kb < 5; ++kb)
#pragma unroll
        for (int s2 = 0; s2 < 2; ++s2) {
            pg8::u32x4 pw; pw.x = pg8::cvt_pk_bf16(p[kb][8 * s2 + 0], p[kb][8 * s2 + 1]); pw.y = pg8::cvt_pk_bf16(p[kb][8 * s2 + 2], p[kb][8 * s2 + 3]);
            pw.z = pg8::cvt_pk_bf16(p[kb][8 * s2 + 4], p[kb][8 * s2 + 5]); pw.w = pg8::cvt_pk_bf16(p[kb][8 * s2 + 6], p[kb][8 * s2 + 7]);
            const bf16x8 pf = __builtin_bit_cast(bf16x8, pw);
#pragma unroll
            for (int d = 0; d < 2; ++d) { const bf16_t* vp = vt + (32 * d + c) * AT_VTS + 32 * half + 32 * kb + 16 * s2 + 4 * hi;
                const s16x4 lo = *(const s16x4*)vp, hh = *(const s16x4*)(vp + 8);
                const bf16x8 vf = (bf16x8){lo[0], lo[1], lo[2], lo[3], hh[0], hh[1], hh[2], hh[3]};
                o[d] = __builtin_amdgcn_mfma_f32_32x32x16_bf16(vf, pf, o[d], 0, 0, 0); } }
    const float inv = 1.f / l;
#pragma unroll
    for (int d = 0; d < 2; ++d)
#pragma unroll
        for (int rg = 0; rg < 4; ++rg) { uint2 w; w.x = pg8::cvt_pk_bf16(o[d][4 * rg] * inv, o[d][4 * rg + 1] * inv); w.y = pg8::cvt_pk_bf16(o[d][4 * rg + 2] * inv, o[d][4 * rg + 3] * inv);
            *(uint2*)(mix + mq * D + h * 64 + 32 * d + 8 * rg + 4 * hi) = w; }
    __syncthreads();
}

__device__ __forceinline__ void conv_item(const bf16_t* __restrict__ U, const bf16_t* __restrict__ UP, const float* __restrict__ cw, const float* __restrict__ cb, bf16_t* __restrict__ hid, size_t i) {
    const int t = (int)(i / FF), j = (int)(i % FF);
    const float u0 = bf2f(U[i]), u1 = t >= 1 ? bf2f(U[i - FF]) : 0.f, u2 = t >= 2 ? bf2f(U[i - 2 * FF]) : 0.f;
    const float c = cb[j] + cw[j] * u2 + cw[FF + j] * u1 + cw[2 * FF + j] * u0;
    hid[i] = (bf16_t)f2bf(c * sigmoidf_(c) * bf2f(UP[i]));
}

__device__ __forceinline__ void ffn_fixup(const float* __restrict__ SB, const float* __restrict__ cw, const float* __restrict__ cb, bf16_t* hid, int pm, int tid) {
    const float* s = SB + (size_t)pm * 6 * FF; const float* sp = SB + (size_t)(pm - 1) * 6 * FF; const bool has_prev = (pm % (SEQ / 256)) != 0;
    for (int idx = tid; idx < 2 * FF; idx += NTHREADS_) { const int rr = idx / FF, j = idx % FF;
        const float u0 = s[j], u1 = s[FF + j], ul0 = has_prev ? sp[4 * FF + j] : 0.f, ul1 = has_prev ? sp[5 * FF + j] : 0.f;
        const float c = rr == 0 ? cb[j] + cw[j] * ul0 + cw[FF + j] * ul1 + cw[2 * FF + j] * u0 : cb[j] + cw[j] * ul1 + cw[FF + j] * u0 + cw[2 * FF + j] * u1;
        hid[(size_t)(pm * 256 + rr) * FF + j] = (bf16_t)f2bf(c * sigmoidf_(c) * s[(2 + rr) * FF + j]); }
}

__device__ __forceinline__ void final_row(const bf16_t* __restrict__ xb, float* __restrict__ out, const ssq_t* __restrict__ ss, const float* __restrict__ g, int row, int lane) {
    const float rstd = rsqrtf(ssq_val(ss[row]) * (1.f / D) + RMS_EPS);
    const bf16x8* xr = (const bf16x8*)(xb + (size_t)row * D) + lane; f32x4* orow = (f32x4*)(out + (size_t)row * D) + 2 * lane; const f32x4* gr = (const f32x4*)g + 2 * lane;
#pragma unroll
    for (int j = 0; j < 2; ++j) { const bf16x8 v = xr[64 * j]; const f32x4 g0 = gr[128 * j], g1 = gr[128 * j + 1];
        orow[128 * j] = (f32x4){bf2f((bf16_t)v[0]), bf2f((bf16_t)v[1]), bf2f((bf16_t)v[2]), bf2f((bf16_t)v[3])} * g0 * rstd;
        orow[128 * j + 1] = (f32x4){bf2f((bf16_t)v[4]), bf2f((bf16_t)v[5]), bf2f((bf16_t)v[6]), bf2f((bf16_t)v[7])} * g1 * rstd; }
}

#define XB_TMO      128
#define XB_XCNT(j)  (256  + 64 * (j))
#define XB_XSUB(j)  (1280 + 64 * (j))
#define XB_XGEN(j)  (2304 + 64 * (j))
#define XB_TOP      3328
#define XB_TOPGEN   3392
#define XCD_BAR_WORDS 3456
#define XB_SPIN_CAP (1u << 18)

__device__ __forceinline__ unsigned xb_ld(unsigned* p)              { return __hip_atomic_load(p, __ATOMIC_RELAXED, __HIP_MEMORY_SCOPE_AGENT); }
__device__ __forceinline__ unsigned xb_add(unsigned* p, unsigned v) { return __hip_atomic_fetch_add(p, v, __ATOMIC_RELAXED, __HIP_MEMORY_SCOPE_AGENT); }
__device__ __forceinline__ unsigned xb_xcc_id() { return (unsigned)__builtin_amdgcn_s_getreg((3 << 11) | 20) & 0xFu; }
#define XB_SPIN(cond, bar) do { unsigned _sp = 0; while (cond) { __builtin_amdgcn_s_sleep(1); \
    if ((++_sp & 255u) == 0u) { if (xb_ld(&(bar)[XB_TMO])) break; if (_sp > XB_SPIN_CAP) { atomicAdd(&(bar)[XB_TMO], 1u); break; } } } } while (0)

struct XcdBarrier {
    unsigned* bar; unsigned x;
    volatile __attribute__((address_space(3))) unsigned* st;
};

__device__ __forceinline__ XcdBarrier xcd_barrier_post(unsigned* bar, volatile __attribute__((address_space(3))) unsigned* st) {
    XcdBarrier b; b.bar = bar; b.x = xb_xcc_id(); b.st = st;
    if (threadIdx.x == 0) (void)xb_add(&bar[XB_XCNT(b.x)], 1u);
    return b;
}
__device__ __forceinline__ void xcd_barrier_complete(unsigned* bar, unsigned x, unsigned& nloc, unsigned& nx) {
    const unsigned G = gridDim.x * gridDim.y * gridDim.z;
    unsigned sum, cnt, mine, sp = 0u;
    for (;;) {
        sum = 0u; cnt = 0u; mine = 0u;
#pragma unroll
        for (unsigned j = 0; j < 16; ++j) { const unsigned c = xb_ld(&bar[XB_XCNT(j)]); sum += c; cnt += (c > 0u) ? 1u : 0u; mine = (j == x) ? c : mine; }
        if (sum == G) break;
        __builtin_amdgcn_s_sleep(1);
        if ((++sp & 255u) == 0u) { if (xb_ld(&bar[XB_TMO])) break; if (sp > XB_SPIN_CAP) { atomicAdd(&bar[XB_TMO], 1u); break; } }
    }
    nloc = mine > 0u ? mine : 1u; nx = cnt > 0u ? cnt : 1u;
}

__device__ __forceinline__ void xcd_barrier(const XcdBarrier& b) {
    asm volatile("s_waitcnt vmcnt(0)" ::: "memory");
    __syncthreads();
    if (threadIdx.x == 0) {
        unsigned* bar = b.bar;
        __builtin_amdgcn_s_waitcnt(0);
        unsigned nloc = b.st[0], nx = b.st[1];
        if (nloc == 0u) { xcd_barrier_complete(bar, b.x, nloc, nx); b.st[0] = nloc; b.st[1] = nx; }
        const unsigned old = xb_add(&bar[XB_XSUB(b.x)], 1u);
        const unsigned gen = old / nloc;
        if (old + 1u == (gen + 1u) * nloc) {
            __builtin_amdgcn_fence(__ATOMIC_RELEASE, "agent");
            asm volatile("s_waitcnt vmcnt(0)" ::: "memory");
            const unsigned og = xb_add(&bar[XB_TOP], 1u);
            const unsigned tg = og / nx;
            if (og + 1u == (tg + 1u) * nx) xb_add(&bar[XB_TOPGEN], 1u);
            else XB_SPIN(xb_ld(&bar[XB_TOPGEN]) == tg, bar);
            __builtin_amdgcn_fence(__ATOMIC_ACQUIRE, "agent");
            xb_add(&bar[XB_XGEN(b.x)], 1u);
            asm volatile("s_waitcnt vmcnt(0)" ::: "memory");
        } else {
            XB_SPIN(xb_ld(&bar[XB_XGEN(b.x)]) == gen, bar);
            __builtin_amdgcn_fence(__ATOMIC_ACQUIRE, "agent");
            asm volatile("s_waitcnt vmcnt(0)" ::: "memory");
        }
    }
    __syncthreads();
}

constexpr int NTHREADS = 512, LDS_BYTES = 147456;
struct Args { const float* in[26]; float* out; unsigned char* ws; };
__global__ void __launch_bounds__(NTHREADS, 2) mega_fwd(Args a) {
    extern __shared__ __attribute__((aligned(16))) unsigned char lds[];
    constexpr int MISC_OFF = 131072 + 4096;
    { volatile __attribute__((address_space(3))) unsigned* misc = (volatile __attribute__((address_space(3))) unsigned*)((__attribute__((address_space(3))) unsigned char*)lds + MISC_OFF);
      if (threadIdx.x < 4) misc[threadIdx.x] = 0u; }
    __syncthreads();
    (void)xcd_barrier_post((unsigned*)(a.ws + WS_BAR), (volatile __attribute__((address_space(3))) unsigned*)((__attribute__((address_space(3))) unsigned char*)lds + MISC_OFF));
#define GRID_SYNC() do { XcdBarrier xb_; xb_.bar = (unsigned*)(a.ws + WS_BAR); xb_.x = xb_xcc_id(); xb_.st = (volatile __attribute__((address_space(3))) unsigned*)((__attribute__((address_space(3))) unsigned char*)lds + MISC_OFF); xcd_barrier(xb_); } while (0)
#define LDSP ((PG8_LAS unsigned char*)lds)
    constexpr int XCH_OFF = 131072;
#define OTID() ({ int _t = threadIdx.x; asm volatile("" : "+v"(_t)); _t; })
    const int G = gridDim.x, NGW = G * 8;
    const float* x = a.in[0]; const float* norm1_g = a.in[1]; const float* w_in = a.in[2]; const float* sinks = a.in[3];
    const float* mu = a.in[4]; const float* w0 = a.in[5]; const float* w2 = a.in[6]; const float* a0 = a.in[7];
    const float* a2 = a.in[8]; const float* g2 = a.in[9]; const float* k_k = a.in[10]; const float* k_a = a.in[11];
    const float* r_k = a.in[12]; const float* lnx_g = a.in[13]; const float* lnx_b = a.in[14]; const float* v0 = a.in[15];
    const float* v1 = a.in[16]; const float* v2 = a.in[17]; const float* w_out = a.in[18]; const float* norm2_g = a.in[19];
    const float* wg = a.in[20]; const float* wu = a.in[21]; const float* conv_w = a.in[22]; const float* conv_b = a.in[23];
    const float* wd = a.in[24]; const float* final_g = a.in[25];
    unsigned char* ws = a.ws; float* X = a.out;
    ssq_t* ss = (ssq_t*)(ws + WS_SS);
    bf16_t* XB = (bf16_t*)(ws + WS_XB); bf16_t* PROJ = (bf16_t*)(ws + WS_PROJ); bf16_t* MIX = (bf16_t*)(ws + WS_MIX); bf16_t* HID = (bf16_t*)(ws + WS_HID); bf16_t* VF = (bf16_t*)(ws + WS_VFIRST);
    bf16_t* UT = (bf16_t*)(ws + WS_UTMP); bf16_t* UPT = UT + (size_t)SEQ * FF;

    {
        const int tid = OTID(), lane = tid & 63, wave = tid >> 6, gw = blockIdx.x * 8 + wave;
        float* scr = (float*)lds + wave * (64 * 33 + 16);
        constexpr int I_IN = (D / 64) * (IN_W / 32), I_OUT = (D / 64) * (D / 32), I_G = (D / 64) * (FF / 32), I_DN = (FF / 64) * (D / 32), I_LAYER = I_IN + I_OUT + 2 * I_G + I_DN;
        for (int it = gw; it < 2 * I_LAYER; it += NGW) {
            const int l = it / I_LAYER; int r = it % I_LAYER;
            bf16_t* wl = (bf16_t*)(ws + WS_W + l * W_LAYER); bf16_t* WinT = wl; bf16_t* WoutT = (bf16_t*)((char*)wl + W_IN_SZ); bf16_t* WguT = (bf16_t*)((char*)WoutT + W_OUT_SZ); bf16_t* WdT = (bf16_t*)((char*)WguT + W_GU_SZ);
            if (r < I_IN) { transpose_item(w_in + (size_t)l * D * IN_W, D, IN_W, WinT, norm1_g + l * D, 0, scr, r, lane); continue; } r -= I_IN;
            if (r < I_OUT) { transpose_item(w_out + (size_t)l * D * D, D, D, WoutT, nullptr, 0, scr, r, lane); continue; } r -= I_OUT;
            if (r < I_G) { transpose_item(wg + (size_t)l * D * FF, D, FF, WguT, norm2_g + l * D, 1, scr, r, lane); continue; } r -= I_G;
            if (r < I_G) { transpose_item(wu + (size_t)l * D * FF, D, FF, WguT, norm2_g + l * D, 2, scr, r, lane); continue; } r -= I_G;
            transpose_item(wd + (size_t)l * FF * D, FF, D, WdT, nullptr, 0, scr, r, lane);
        }
        {
            constexpr int I_W2 = 1 * (C / 32), I_G2 = 2 * (C / 32), I_V1 = (C / 64) * 1, I_L = 2 * I_W2 + I_G2;
            for (int it = gw; it < 2 * I_L + I_V1; it += NGW) {
                if (it < 2 * I_L) { const int l = it / I_L; int r = it % I_L; bf16_t* base = (bf16_t*)(ws + WS_LORA + l * LORA_LAYER);
                    if (r < I_W2) { transpose_item(w2 + (size_t)l * 64 * C, 64, C, base, nullptr, 0, scr, r, lane); continue; } r -= I_W2;
                    if (r < I_W2) { transpose_item(a2 + (size_t)l * 64 * C, 64, C, base + 512 * 64, nullptr, 0, scr, r, lane); continue; } r -= I_W2;
                    transpose_item(g2 + (size_t)l * 128 * C, 128, C, base + 2 * 512 * 64, nullptr, 0, scr, r, lane); }
                else transpose_item(v1, C, 32, (bf16_t*)(ws + WS_V1T), nullptr, 0, scr, it - 2 * I_L, lane);
            }
            bf16_t* V2T = (bf16_t*)(ws + WS_V2T);
            for (int i = blockIdx.x * NTHREADS + tid; i < 32 * C; i += G * NTHREADS) { const int j = i / C, ch = i % C; V2T[ch * 32 + j] = (bf16_t)f2bf(v2[i]); }
        }
        for (int m = 4 * gw; m < M; m += 4 * NGW) {
            f32x4 xv[4][4];
#pragma unroll
            for (int u = 0; u < 4; ++u)
#pragma unroll
                for (int j = 0; j < 4; ++j) xv[u][j] = ((const f32x4*)(x + (size_t)(m + u) * D))[lane + 64 * j];
#pragma unroll
            for (int u = 0; u < 4; ++u) { float sq = 0.f;
#pragma unroll
                for (int j = 0; j < 4; ++j) { const f32x4 v = xv[u][j]; sq += v.x * v.x + v.y * v.y + v.z * v.z + v.w * v.w;
                    ((unsigned long long*)(XB + (size_t)(m + u) * D))[lane + 64 * j] = (unsigned long long)(f2bf(v.x) | (f2bf(v.y) << 16)) | ((unsigned long long)(f2bf(v.z) | (f2bf(v.w) << 16)) << 32); }
                sq = wave_sum(sq); if (lane == 0) ss[m + u] = ssq_fix(sq); } }
    }
    GRID_SYNC();
    for (int l = 0; l < 2; ++l) {
        bf16_t* wl = (bf16_t*)(ws + WS_W + l * W_LAYER); bf16_t* WinT = wl; bf16_t* WoutT = (bf16_t*)((char*)wl + W_IN_SZ); bf16_t* WguT = (bf16_t*)((char*)WoutT + W_OUT_SZ); bf16_t* WdT = (bf16_t*)((char*)WguT + W_GU_SZ);
        ssq_t* ss1 = ss + (size_t)(2 * l) * M; ssq_t* ss2 = ss + (size_t)(2 * l + 1) * M; ssq_t* ss3 = ss + (size_t)(2 * l + 2) * M;
        { pg8::Gemm g{XB, WinT, M, IN_W, D}; pg8::StaticOrder S; S.init(M, IN_W, G, (int)blockIdx.x); pg8::EpiScaleBf16 E{PROJ, IN_W, ss1};
          pg8::gemm_phase<pg8::EpiScaleBf16, pg8::StaticOrder, true, true>(LDSP, g, S, E); }
        GRID_SYNC();
        for (int unit = blockIdx.x; unit < BATCH * 2 * (SEQ / 64); unit += G) attn_unit(PROJ, sinks + l * NH, MIX, (bf16_t*)lds, unit, OTID());
        struct { bf16_t *V, *G; } p; p.V = (bf16_t*)(ws + WS_SI_V); p.G = (bf16_t*)(ws + WS_SI_G);
        bf16_t* GQ = (bf16_t*)X; bf16_t* CQ = GQ + (size_t)BATCH * NH * 64 * 8192;
        ScanArgs s{}; s.V = p.V; s.G = p.G; s.k_k = k_k + l * C; s.k_a = k_a + l * C; s.r_k = r_k + l * C; s.lnx_g = lnx_g + l * C; s.lnx_b = lnx_b + l * C; s.mix = MIX; s.rkc = (float*)(ws + WS_RKC);
        { bf16_t* scr = (bf16_t*)(ws + WS_TSCR + (size_t)blockIdx.x * TSCR_WG);
          for (int tile = blockIdx.x; tile < M / 64; tile += G) {
              const size_t moff = (size_t)tile * 64 * C;
              Prep2Args q{}; q.proj = PROJ; q.mu = mu + l * SHIFT_W; q.w0 = w0 + l * C; q.a0 = a0 + l * C; q.v0 = v0;
              const bf16_t* lw = (const bf16_t*)(ws + WS_LORA + l * LORA_LAYER); q.W2T = lw; q.A2T = lw + 512 * 64; q.G2T = lw + 2 * 512 * 64; q.V1T = (const bf16_t*)(ws + WS_V1T); q.V2T = (const bf16_t*)(ws + WS_V2T);
              q.vfirst = VF; q.R = scr - moff; q.K = scr + 64 * C - moff; q.A = scr + 2 * 64 * C - moff; q.LD = scr + 3 * 64 * C - moff; q.V = p.V; q.G = p.G; q.layer = l;
              prep_tile(q, lds, tile, OTID());
              asm volatile("s_waitcnt vmcnt(0)" ::: "memory"); __syncthreads();
              if (threadIdx.x == 0) { __builtin_amdgcn_fence(__ATOMIC_ACQUIRE, "agent"); asm volatile("s_waitcnt vmcnt(0)" ::: "memory"); }
              __syncthreads();
              s.R = q.R; s.K = q.K; s.A = q.A; s.LD = q.LD;
              const int bb = tile >> 6, chunk = tile & 63;
              for (int hh = 0; hh < NH; ++hh) { const int unit = ((bb * NH + hh) << 6) + chunk; CkRaw ra; ck_load(s, ra, unit, OTID()); ck_precompute(s, ra, lds, GQ, CQ, unit, OTID()); } } }
        GRID_SYNC();
        for (int item = (int)((blockIdx.x & 7) * (G >> 3) + (blockIdx.x >> 3)); item < BATCH * NH * 4; item += G) ck_sequential(s, lds, GQ, CQ, item, OTID());
        GRID_SYNC();
        { const int tid = OTID(), lane = tid & 63, gw = blockIdx.x * 8 + (tid >> 6); for (int m0 = 2 * gw; m0 < M; m0 += 2 * NGW) scan_post_rows(s, m0, lane); }
        GRID_SYNC();
        { pg8::Gemm g{MIX, WoutT, M, D, D}; pg8::StaticOrder S; S.init(M, D, G, (int)blockIdx.x); pg8::EpiResid E{XB, ss2};
          pg8::gemm_phase<pg8::EpiResid, pg8::StaticOrder, true, true>(LDSP, g, S, E); }
        GRID_SYNC();
        { pg8::Gemm g{XB, WguT, M, 2 * FF, D}; pg8::StaticOrder S; S.init(M, 2 * FF, G, (int)blockIdx.x);
          pg8::EpiConvGlu E{HID, ss2, conv_w + (size_t)l * 3 * FF, conv_b + (size_t)l * FF, (float*)(ws + WS_UTMP), (PG8_LAS float*)(LDSP + XCH_OFF), FF};
          pg8::gemm_phase<pg8::EpiConvGlu, pg8::StaticOrder, true, true>(LDSP, g, S, E); }
        GRID_SYNC();
        { pg8::Gemm g{HID, WdT, M, D, FF}; pg8::StaticOrder S; S.init(M, D, G, (int)blockIdx.x); pg8::EpiResid E{XB, ss3};
          { pg8::Unit u; for (int i = 0; S.next(i, u); ++i) ffn_fixup((const float*)(ws + WS_UTMP), conv_w + (size_t)l * 3 * FF, conv_b + (size_t)l * FF, HID, u.pm, OTID());
            asm volatile("s_waitcnt vmcnt(0)" ::: "memory"); __syncthreads(); }
          pg8::gemm_phase<pg8::EpiResid, pg8::StaticOrder, true, true>(LDSP, g, S, E); }
        GRID_SYNC();
    }
    { const int tid = OTID(), lane = tid & 63, gw = blockIdx.x * 8 + (tid >> 6);
    const f32x4 fg0 = ((const f32x4*)final_g)[2 * lane], fg1 = ((const f32x4*)final_g)[2 * lane + 1], fg2 = ((const f32x4*)final_g)[128 + 2 * lane], fg3 = ((const f32x4*)final_g)[128 + 2 * lane + 1];
    const ssq_t* ssf = ss + (size_t)4 * M;
    for (int m = 4 * gw; m < M; m += 4 * NGW) {
        bf16x8 xv[4][2]; float rs[4];
#pragma unroll
        for (int u = 0; u < 4; ++u) { xv[u][0] = ((const bf16x8*)(XB + (size_t)(m + u) * D))[lane]; xv[u][1] = ((const bf16x8*)(XB + (size_t)(m + u) * D))[64 + lane]; rs[u] = rsqrtf(ssq_val(ssf[m + u]) * (1.f / D) + RMS_EPS); }
#pragma unroll
        for (int u = 0; u < 4; ++u) { f32x4* orow = (f32x4*)(X + (size_t)(m + u) * D) + 2 * lane;
            orow[0] = bfx4_lo(xv[u][0]) * fg0 * rs[u]; orow[1] = bfx4_hi(xv[u][0]) * fg1 * rs[u]; orow[128] = bfx4_lo(xv[u][1]) * fg2 * rs[u]; orow[129] = bfx4_hi(xv[u][1]) * fg3 * rs[u]; } } }
}

extern "C" void kernel_launch(void* const* d_in, const int* in_sizes, int n_in, void* d_out, int out_size, void* d_ws, size_t ws_size, hipStream_t stream) {
    static int grid = 0;
    if (grid == 0) {
        if (n_in != 26 || in_sizes[0] != M * D || out_size != M * D || ws_size < WS_END) { fprintf(stderr, "kernel_launch: unexpected shapes (n_in %d, ws %zu)\n", n_in, ws_size); grid = -1; return; }
        int dev = 0, cus = 0, per_cu = 0;
        if (hipGetDevice(&dev) != hipSuccess || hipDeviceGetAttribute(&cus, hipDeviceAttributeMultiprocessorCount, dev) != hipSuccess) { grid = -1; return; }
        if (hipFuncSetAttribute((const void*)mega_fwd, hipFuncAttributeMaxDynamicSharedMemorySize, LDS_BYTES) != hipSuccess) { fprintf(stderr, "kernel_launch: hipFuncSetAttribute failed\n"); grid = -1; return; }
        if (hipOccupancyMaxActiveBlocksPerMultiprocessor(&per_cu, (const void*)mega_fwd, NTHREADS, LDS_BYTES) != hipSuccess || per_cu < 1) { fprintf(stderr, "kernel_launch: occupancy query failed (%d)\n", per_cu); grid = -1; return; }
        grid = cus;
    }
    if (grid < 0) return;
    (void)hipMemsetAsync((unsigned char*)d_ws + WS_CTL, 0, CTL_BYTES, stream);
    Args a{};
    for (int i = 0; i < 26; ++i) a.in[i] = (const float*)d_in[i];
    a.out = (float*)d_out; a.ws = (unsigned char*)d_ws;
    void* kargs[] = {&a};
    hipError_t e = hipLaunchCooperativeKernel((const void*)mega_fwd, dim3(grid), dim3(NTHREADS), kargs, LDS_BYTES, stream);
    if (e != hipSuccess) fprintf(stderr, "kernel_launch: cooperative launch failed: %s (grid %d)\n", hipGetErrorString(e), grid);
}
```

```cpp
#include <hip/hip_runtime.h>
#include <cstdio>
#include <cstdint>

typedef unsigned short bf16_t;
typedef short bf16x8 __attribute__((ext_vector_type(8)));
typedef float f32x4 __attribute__((ext_vector_type(4)));

constexpr int BATCH = 8, SEQ = 4096, D = 1024, M = BATCH * SEQ;
constexpr int HD = 64, ATT_W = 512, KV_W = 128, C = 512, NH = 8;
constexpr int ATT_IN = 768, SHIFT_W = 1792, IN_W = 2560, FF = 2816;
constexpr int WINDOW = 128;
constexpr float RMS_EPS = 1e-5f, LNX_EPS = 64e-5f;

constexpr size_t MiB = 1u << 20;
constexpr size_t WS_CTL = 0;
typedef unsigned long long ssq_t;
__device__ __forceinline__ ssq_t ssq_fix(float s) { return (ssq_t)(s * 1048576.0f + 0.5f); }
__device__ __forceinline__ float ssq_val(ssq_t v) { return (float)v * (1.0f / 1048576.0f); }
constexpr size_t WS_SS = 0;
constexpr size_t CTL_BYTES = 2 * MiB;
constexpr size_t WS_BAR = 1536 * 1024;
constexpr size_t WS_W = 2 * MiB;
constexpr size_t W_IN_SZ = (size_t)IN_W * D * 2, W_OUT_SZ = (size_t)D * D * 2, W_GU_SZ = (size_t)2 * FF * D * 2, W_DN_SZ = (size_t)D * FF * 2;
constexpr size_t W_LAYER = W_IN_SZ + W_OUT_SZ + W_GU_SZ + W_DN_SZ;
constexpr size_t WS_VFIRST = 52 * MiB, WS_MIX = 84 * MiB, WS_XB = 148 * MiB, WS_PROJ = 212 * MiB;
constexpr size_t WS_SI_R = 148 * MiB, WS_SI_K = 180 * MiB, WS_SI_V = 372 * MiB, WS_SI_A = 404 * MiB, WS_SI_LD = 436 * MiB, WS_SI_G = 468 * MiB;
constexpr size_t WS_HID = 212 * MiB;
constexpr size_t WS_UTMP = 84 * MiB;
constexpr size_t WS_END = 500 * MiB;
static_assert(WS_W + 2 * W_LAYER <= WS_VFIRST, "weights fit");

__device__ __forceinline__ unsigned f2bf(float f) { unsigned u = __builtin_bit_cast(unsigned, f); return (u + 0x7fffu + ((u >> 16) & 1u)) >> 16; }
__device__ __forceinline__ float bf2f(bf16_t h) { return __builtin_bit_cast(float, (unsigned)h << 16); }
__device__ __forceinline__ float wave_sum(float v) {
#pragma unroll
    for (int o = 1; o < 64; o <<= 1) v += __shfl_xor(v, o);
    return v;
}
__device__ __forceinline__ float sigmoidf_(float x) { return 1.f / (1.f + __expf(-x)); }

namespace pg8 {
#define PG8_LAS __attribute__((address_space(3)))
typedef unsigned short bf16_t;
typedef short bf16x8 __attribute__((ext_vector_type(8)));
typedef float f32x4 __attribute__((ext_vector_type(4)));
typedef unsigned u32x4 __attribute__((ext_vector_type(4)));
constexpr int BM = 256, BK = 64, HALF = 128, HTB = HALF * BK * 2  , STAGE_BYTES = 8 * HTB, NXCD = 8, WGM = 8;

__host__ __device__ __forceinline__ int lds_byte(int r, int c) { const int st = (r >> 4) * 2 + (c >> 5), rr = r & 15, cc = c & 31, ob = rr * 64 + cc * 2; return st * 1024 + (ob ^ (((ob >> 9) & 1) << 5)); }
__host__ __device__ __forceinline__ void stage_rc(int b, int& R, int& C) { const int st = b / 1024, sb = b % 1024, swz = sb ^ (((sb >> 9) & 1) << 5); R = (st >> 1) * 16 + swz / 64; C = (st & 1) * 32 + (swz % 64) / 2; }
__host__ __device__ __forceinline__ int perm32(int rho) { const int n = rho >> 4, i = rho & 15; return 8 * (i >> 2) + 4 * n + (i & 3); }

struct Unit { int pm, pn; };
struct Gemm { const bf16_t* A; const bf16_t* Bt; int M, N, K; };

struct StaticOrder {
    int nM, nN, nwg, G, c;
    __host__ __device__ void init(int M, int N, int G_, int c_) { nM = M / BM; nN = N / BM; nwg = nM * nN; G = G_; c = c_; }
    __host__ __device__ bool next(int i, Unit& u) const {
        const long L = (long)i * G + c; if (L >= nwg) return false;
        int wgid = (int)L; { const int q = nwg / NXCD, r = nwg % NXCD, xcd = wgid % NXCD, off = wgid / NXCD; wgid = (xcd < r ? xcd * (q + 1) : r * (q + 1) + (xcd - r) * q) + off; }
        const int nig = WGM * nN, gid = wgid / nig, fm = gid * WGM, gsz = (nM - fm) < WGM ? (nM - fm) : WGM;
        u.pm = fm + ((wgid % nig) % gsz); u.pn = (wgid % nig) / gsz; return true;
    }
    __device__ __forceinline__ void a_ready(const Unit&) const {}
    __device__ __forceinline__ void done(const Unit&) const {}
};
typedef float f32x2_t_ __attribute__((ext_vector_type(2))); typedef __bf16 bf16x2_t_ __attribute__((ext_vector_type(2)));
__device__ __forceinline__ unsigned cvt_pk_bf16(float lo, float hi) { const f32x2_t_ v = {lo, hi}; const bf16x2_t_ b = __builtin_convertvector(v, bf16x2_t_); return __builtin_bit_cast(unsigned, b); }
typedef float f32x2 __attribute__((ext_vector_type(2)));
template <class Epi, class Sched, bool ALIGN_EPI = false, bool SP2 = false>
__device__ __forceinline__ void gemm_phase(PG8_LAS unsigned char* lds, const Gemm g, const Sched& S, const Epi& E) {
    int tid_ = threadIdx.x; asm volatile("" : "+v"(tid_));
    const int tid = tid_, wid = __builtin_amdgcn_readfirstlane(tid >> 6), lane = tid & 63, wr = wid >> 2, wc = wid & 3, fr = lane & 15, fq = lane >> 4;
    const int K = g.K, nt = K / BK;
    unsigned voffA[2], voffB[2];
#pragma unroll
    for (int i = 0; i < 2; ++i) { int R, C; stage_rc(tid * 16 + i * 8192, R, C); const int Rb = Epi::PERM ? ((R & ~31) + perm32(R & 31)) : R;
        voffA[i] = (unsigned)(R * K + C) * 2u; voffB[i] = (unsigned)(Rb * K + C) * 2u; }
    const size_t kstep = (size_t)(BK * 2);
    const size_t hstep = (size_t)HALF * K * 2;
    const size_t tstep = 2 * hstep;
    const unsigned ldsw = (unsigned)wid * 1024u;
    const int aoff = lds_byte(wr * 64 + fr, fq * 8), boff = lds_byte(wc * 32 + fr, fq * 8);
#define PG8_SA(b, h) (((b) * 2 + (h)) * HTB)
#define PG8_SB(b, h) ((4 + (b) * 2 + (h)) * HTB)
#define PG8_STAGE(bufoff, gbase, voff) do { _Pragma("unroll") for (int _i = 0; _i < 2; ++_i) \
        __builtin_amdgcn_global_load_lds((const unsigned*)((const char*)(gbase) + (voff)[_i]), (PG8_LAS unsigned*)(lds + (bufoff) + ldsw + _i * 8192), 16, 0, 0); } while (0)
#define PG8_LDA(dst, b, h) do { _Pragma("unroll") for (int m = 0; m < 4; ++m) _Pragma("unroll") for (int k = 0; k < 2; ++k) dst[m][k] = *(const PG8_LAS bf16x8*)(lds + PG8_SA(b, h) + aoff + m * 2048 + k * 1024); } while (0)
#define PG8_LDB(dst, b, h) do { _Pragma("unroll") for (int n = 0; n < 2; ++n) _Pragma("unroll") for (int k = 0; k < 2; ++k) dst[n][k] = *(const PG8_LAS bf16x8*)(lds + PG8_SB(b, h) + boff + n * 2048 + k * 1024); } while (0)
#define PG8_MMA(ai, bj, At, Bt) do { __builtin_amdgcn_s_setprio(1); _Pragma("unroll") for (int m = 0; m < 4; ++m) _Pragma("unroll") for (int n = 0; n < 2; ++n) _Pragma("unroll") for (int k = 0; k < 2; ++k) \
        acc[ai][bj][m][n] = __builtin_amdgcn_mfma_f32_16x16x32_bf16(Bt[n][k], At[m][k], acc[ai][bj][m][n], 0, 0, 0); __builtin_amdgcn_s_setprio(0); } while (0)
#define PG8_WAIT_V(n) asm volatile("s_waitcnt vmcnt(" #n ")" ::: "memory")
#define PG8_WAIT_L(n) asm volatile("s_waitcnt lgkmcnt(" #n ")" ::: "memory")
#define PG8_BAR __builtin_amdgcn_s_barrier()
#define PG8_SCHED __builtin_amdgcn_sched_barrier(0)
    Unit cur, nxt; int ui = 0;
    if (!S.next(0, cur)) return;
    f32x4 acc[2][2][4][2];
#pragma unroll
    for (int a = 0; a < 2; ++a)
#pragma unroll
        for (int b = 0; b < 2; ++b)
#pragma unroll
            for (int m = 0; m < 4; ++m)
#pragma unroll
                for (int n = 0; n < 2; ++n) acc[a][b][m][n] = (f32x4){0.f, 0.f, 0.f, 0.f};
    bf16x8 At[4][2], B0[2][2], B1[2][2];
    const char* cA = (const char*)g.A + (size_t)cur.pm * tstep; const char* cB = (const char*)g.Bt + (size_t)cur.pn * tstep;
    S.a_ready(cur);
    if constexpr (SP2) {
        PG8_STAGE(PG8_SB(0, 0), cB, voffB); PG8_STAGE(PG8_SB(0, 1), cB + hstep, voffB); PG8_STAGE(PG8_SA(0, 0), cA, voffA); PG8_STAGE(PG8_SA(0, 1), cA + hstep, voffA);
        if (wr == 1) PG8_BAR;
        PG8_WAIT_V(2); PG8_BAR;
        PG8_STAGE(PG8_SB(1, 0), cB + kstep, voffB); PG8_STAGE(PG8_SA(1, 0), cA + kstep, voffA); PG8_STAGE(PG8_SB(1, 1), cB + hstep + kstep, voffB);
        PG8_WAIT_V(6); PG8_BAR;
    } else {
        PG8_STAGE(PG8_SB(0, 0), cB, voffB); PG8_STAGE(PG8_SA(0, 0), cA, voffA); PG8_STAGE(PG8_SB(0, 1), cB + hstep, voffB); PG8_STAGE(PG8_SA(0, 1), cA + hstep, voffA);
        if (wr == 1) PG8_BAR;
        PG8_WAIT_V(4); PG8_BAR;
        PG8_STAGE(PG8_SB(1, 0), cB + kstep, voffB); PG8_STAGE(PG8_SA(1, 0), cA + kstep, voffA); PG8_STAGE(PG8_SB(1, 1), cB + hstep + kstep, voffB);
        PG8_WAIT_V(6); PG8_BAR;
    }
    for (;;) {
        const bool has_next = S.next(ui + 1, nxt);
        const char* nA = has_next ? (const char*)g.A + (size_t)nxt.pm * tstep : cA; const char* nB = has_next ? (const char*)g.Bt + (size_t)nxt.pn * tstep : cB;
        for (int t = 0; t < nt; t += 2) {
            const bool last = (t == nt - 2);
            const char* a1 = cA + (size_t)(t + 1) * kstep;
            const char* a2 = last ? nA : cA + (size_t)(t + 2) * kstep; const char* b2 = last ? nB : cB + (size_t)(t + 2) * kstep;
            const char* a3 = a2 + kstep; const char* b3 = b2 + kstep;
            if (last && has_next) S.a_ready(nxt);
            if constexpr (SP2) {
            PG8_LDB(B0, 0, 0); PG8_LDB(B1, 0, 1); PG8_SCHED; PG8_LDA(At, 0, 0); PG8_STAGE(PG8_SA(1, 1), a1 + hstep, voffA);
            PG8_WAIT_V(8); PG8_WAIT_L(0); PG8_BAR; PG8_MMA(0, 0, At, B0); PG8_MMA(0, 1, At, B1); PG8_BAR; PG8_SCHED;
            PG8_LDA(At, 0, 1); PG8_STAGE(PG8_SB(0, 0), b2, voffB); PG8_STAGE(PG8_SB(0, 1), b2 + hstep, voffB); PG8_STAGE(PG8_SA(0, 0), a2, voffA);
            PG8_WAIT_V(8); PG8_WAIT_L(0); PG8_BAR; PG8_MMA(1, 0, At, B0); PG8_MMA(1, 1, At, B1); PG8_BAR; PG8_SCHED;
            PG8_LDB(B0, 1, 0); PG8_LDB(B1, 1, 1); PG8_SCHED; PG8_LDA(At, 1, 0); PG8_STAGE(PG8_SA(0, 1), a2 + hstep, voffA);
            PG8_WAIT_V(8); PG8_WAIT_L(0); PG8_BAR; PG8_MMA(0, 0, At, B0); PG8_MMA(0, 1, At, B1); PG8_BAR; PG8_SCHED;
            PG8_LDA(At, 1, 1); PG8_STAGE(PG8_SB(1, 0), b3, voffB); PG8_STAGE(PG8_SB(1, 1), b3 + hstep, voffB); PG8_STAGE(PG8_SA(1, 0), a3, voffA);
            PG8_WAIT_V(8); PG8_WAIT_L(0); PG8_BAR; PG8_MMA(1, 0, At, B0); PG8_MMA(1, 1, At, B1); PG8_BAR; PG8_SCHED;
            } else {
            PG8_LDB(B0, 0, 0); PG8_SCHED; PG8_LDA(At, 0, 0); PG8_STAGE(PG8_SA(1, 1), a1 + hstep, voffA);
            PG8_WAIT_L(8); PG8_BAR; PG8_WAIT_L(0); PG8_MMA(0, 0, At, B0); PG8_BAR; PG8_SCHED;
            PG8_LDB(B1, 0, 1); PG8_STAGE(PG8_SB(0, 0), b2, voffB);
            PG8_BAR; PG8_WAIT_L(0); PG8_MMA(0, 1, At, B1); PG8_BAR;
            PG8_LDA(At, 0, 1); PG8_STAGE(PG8_SA(0, 0), a2, voffA);
            PG8_BAR; PG8_WAIT_L(0); PG8_MMA(1, 0, At, B0); PG8_BAR; PG8_SCHED;
            PG8_STAGE(PG8_SB(0, 1), b2 + hstep, voffB);
            PG8_WAIT_V(6); PG8_BAR; PG8_MMA(1, 1, At, B1); PG8_BAR;
            PG8_LDB(B0, 1, 0); PG8_SCHED; PG8_LDA(At, 1, 0); PG8_STAGE(PG8_SA(0, 1), a2 + hstep, voffA);
            PG8_WAIT_L(8); PG8_BAR; PG8_WAIT_L(0); PG8_MMA(0, 0, At, B0); PG8_BAR; PG8_SCHED;
            PG8_LDB(B1, 1, 1); PG8_STAGE(PG8_SB(1, 0), b3, voffB);
            PG8_BAR; PG8_WAIT_L(0); PG8_MMA(0, 1, At, B1); PG8_BAR;
            PG8_LDA(At, 1, 1); PG8_STAGE(PG8_SA(1, 0), a3, voffA);
            PG8_BAR; PG8_WAIT_L(0); PG8_MMA(1, 0, At, B0); PG8_BAR; PG8_SCHED;
            PG8_STAGE(PG8_SB(1, 1), b3 + hstep, voffB);
            PG8_WAIT_V(6); PG8_BAR; PG8_MMA(1, 1, At, B1); PG8_BAR;
            }
        }
        if constexpr (ALIGN_EPI) { if (wr == 0) PG8_BAR; }
        if constexpr (!Epi::AFTER_DRAIN) { E(acc, cur, wr, wc, fr, fq); S.done(cur); }
        if (!has_next) break;
#pragma unroll
        for (int a = 0; a < 2; ++a)
#pragma unroll
            for (int b = 0; b < 2; ++b)
#pragma unroll
                for (int m = 0; m < 4; ++m)
#pragma unroll
                    for (int n = 0; n < 2; ++n) acc[a][b][m][n] = (f32x4){0.f, 0.f, 0.f, 0.f};
        cur = nxt; cA = nA; cB = nB; ++ui;
        if constexpr (ALIGN_EPI) { if (wr == 1) PG8_BAR; }
    }
    PG8_WAIT_V(0);
    if constexpr (!ALIGN_EPI) { if (wr == 0) PG8_BAR; }
    PG8_BAR;
    if constexpr (Epi::AFTER_DRAIN) { E.fused(acc, cur, wr, wc, fr, fq, lds, wid, lane); S.done(cur); }
#undef PG8_SA
#undef PG8_SB
#undef PG8_STAGE
#undef PG8_LDA
#undef PG8_LDB
#undef PG8_MMA
#undef PG8_WAIT_V
#undef PG8_WAIT_L
#undef PG8_BAR
#undef PG8_SCHED
}

constexpr int DM_ = 1024; constexpr float RMS_EPS_ = 1e-5f;
typedef unsigned long long ssq_t;
struct EpiScaleBf16 {
    static constexpr bool PERM = true, AFTER_DRAIN = false;
    bf16_t* O; int ldc; const ssq_t* ss;
    __device__ __forceinline__ void operator()(const f32x4 (&acc)[2][2][4][2], const Unit& u, int wr, int wc, int fr, int fq) const {
        const int row0 = u.pm * BM + wr * 64 + fr, col0 = u.pn * BM + wc * 32 + 8 * fq;
        float rsv[2][4];
#pragma unroll
        for (int ai = 0; ai < 2; ++ai)
#pragma unroll
            for (int m = 0; m < 4; ++m) rsv[ai][m] = (float)ss[row0 + ai * HALF + m * 16] * (1.0f / 1048576.0f);
#pragma unroll
        for (int ai = 0; ai < 2; ++ai)
#pragma unroll
            for (int m = 0; m < 4; ++m) { const int row = row0 + ai * HALF + m * 16; const float rs = __builtin_amdgcn_rsqf(rsv[ai][m] * (1.0f / DM_) + RMS_EPS_); bf16_t* rowp = O + (size_t)row * ldc + col0;
#pragma unroll
                for (int bj = 0; bj < 2; ++bj) { const f32x4 v0 = acc[ai][bj][m][0] * rs, v1 = acc[ai][bj][m][1] * rs;
                    u32x4 w; w.x = cvt_pk_bf16(v0[0], v0[1]); w.y = cvt_pk_bf16(v0[2], v0[3]); w.z = cvt_pk_bf16(v1[0], v1[1]); w.w = cvt_pk_bf16(v1[2], v1[3]);
                    *(u32x4*)(rowp + bj * HALF) = w; } }
    }
};
struct EpiResid {
    static constexpr bool PERM = true, AFTER_DRAIN = false;
    bf16_t* xb; ssq_t* ss_out;
    __device__ __forceinline__ void operator()(const f32x4 (&acc)[2][2][4][2], const Unit& u, int wr, int wc, int fr, int fq) const {
        const int row0 = u.pm * BM + wr * 64 + fr, col0 = u.pn * BM + wc * 32 + 8 * fq;
#pragma unroll
        for (int ai = 0; ai < 2; ++ai) {
            u32x4 bs[4][2];
#pragma unroll
            for (int m = 0; m < 4; ++m)
#pragma unroll
                for (int bj = 0; bj < 2; ++bj) bs[m][bj] = *(const u32x4*)(xb + (size_t)(row0 + ai * HALF + m * 16) * DM_ + col0 + bj * HALF);
#pragma unroll
            for (int m = 0; m < 4; ++m) { const int row = row0 + ai * HALF + m * 16; bf16_t* rp = xb + (size_t)row * DM_ + col0; float sq = 0.f;
#pragma unroll
                for (int bj = 0; bj < 2; ++bj) { const u32x4 b = bs[m][bj]; u32x4 w;
#pragma unroll
                    for (int hh = 0; hh < 2; ++hh) { const unsigned b0 = hh == 0 ? b.x : b.z, b1 = hh == 0 ? b.y : b.w; const f32x4 a4 = acc[ai][bj][m][hh];
                        const float x0 = __builtin_bit_cast(float, b0 << 16) + a4[0], x1 = __builtin_bit_cast(float, b0 & 0xffff0000u) + a4[1], x2 = __builtin_bit_cast(float, b1 << 16) + a4[2], x3 = __builtin_bit_cast(float, b1 & 0xffff0000u) + a4[3];
                        const unsigned w0 = cvt_pk_bf16(x0, x1), w1 = cvt_pk_bf16(x2, x3);
                        if (hh == 0) { w.x = w0; w.y = w1; } else { w.z = w0; w.w = w1; }
                        const float r0 = __builtin_bit_cast(float, w0 << 16), r1 = __builtin_bit_cast(float, w0 & 0xffff0000u), r2 = __builtin_bit_cast(float, w1 << 16), r3 = __builtin_bit_cast(float, w1 & 0xffff0000u);
                        sq += (r0 * r0 + r1 * r1) + (r2 * r2 + r3 * r3); }
                    *(u32x4*)(rp + bj * HALF) = w; }
                sq += __shfl_xor(sq, 16); sq += __shfl_xor(sq, 32);
                if (fq == 0) atomicAdd(ss_out + row, (ssq_t)(sq * 1048576.0f + 0.5f)); }
        }
    }
};
template <int CTRL> __device__ __forceinline__ float dpp1(float x) { return __builtin_bit_cast(float, __builtin_amdgcn_update_dpp(0, __builtin_bit_cast(int, x), CTRL, 0xF, 0xF, true)); }
template <int CTRL> __device__ __forceinline__ f32x4 dpp4(const f32x4 x) { return (f32x4){dpp1<CTRL>(x.x), dpp1<CTRL>(x.y), dpp1<CTRL>(x.z), dpp1<CTRL>(x.w)}; }
struct EpiConvGlu {
    static constexpr bool PERM = true, AFTER_DRAIN = false;
    bf16_t* HID; const ssq_t* ss; const float* cw; const float* cb; float* SB; PG8_LAS float* xch; int ff;
    __device__ __forceinline__ void operator()(const f32x4 (&acc)[2][2][4][2], const Unit& u, int wr, int wc, int fr, int fq) const {
        const int row0 = u.pm * BM + wr * 64 + fr, cl = wc * 32 + 8 * fq, jcol = u.pn * HALF + cl;
        float rs[2][4];
#pragma unroll
        for (int ai = 0; ai < 2; ++ai)
#pragma unroll
            for (int m = 0; m < 4; ++m) rs[ai][m] = (float)ss[row0 + ai * HALF + m * 16] * (1.0f / 1048576.0f);
        f32x4 w0[2], w1[2], w2[2], bb[2];
#pragma unroll
        for (int n = 0; n < 2; ++n) { w0[n] = *(const f32x4*)(cw + jcol + 4 * n); w1[n] = *(const f32x4*)(cw + ff + jcol + 4 * n); w2[n] = *(const f32x4*)(cw + 2 * ff + jcol + 4 * n); bb[n] = *(const f32x4*)(cb + jcol + 4 * n); }
#pragma unroll
        for (int ai = 0; ai < 2; ++ai)
#pragma unroll
            for (int m = 0; m < 4; ++m) rs[ai][m] = __builtin_amdgcn_rsqf(rs[ai][m] * (1.0f / DM_) + RMS_EPS_);
        if (fr >= 14) {
#pragma unroll
            for (int ai = 0; ai < 2; ++ai)
#pragma unroll
                for (int n = 0; n < 2; ++n) *(PG8_LAS f32x4*)(xch + ((2 * ai + wr) * 2 + (fr - 14)) * HALF + cl + 4 * n) = acc[ai][0][3][n] * rs[ai][3];
        }
        asm volatile("s_waitcnt lgkmcnt(0)" ::: "memory"); __builtin_amdgcn_s_barrier(); asm volatile("" ::: "memory");
        float* sbp = SB + (size_t)u.pm * 6 * ff + jcol;
#pragma unroll
        for (int ai = 0; ai < 2; ++ai) {
            const int q = 2 * ai + wr;
            f32x4 X[2];
#pragma unroll
            for (int n = 0; n < 2; ++n) { X[n] = (f32x4){0.f, 0.f, 0.f, 0.f}; if (q > 0 && fr >= 14) X[n] = *(const PG8_LAS f32x4*)(xch + ((q - 1) * 2 + (fr - 14)) * HALF + cl + 4 * n); }
            f32x4 prevg[2] = {X[0], X[1]};
#pragma unroll
            for (int m = 0; m < 4; ++m) { const int row = row0 + ai * HALF + m * 16;
                pg8::u32x4 hw;
#pragma unroll
                for (int n = 0; n < 2; ++n) {
                    const f32x4 cur = acc[ai][0][m][n] * rs[ai][m], up = acc[ai][1][m][n] * rs[ai][m];
                    const f32x4 P = prevg[n]; prevg[n] = cur;
                    f32x4 z1, z2;
#pragma unroll
                    for (int e = 0; e < 4; ++e) { z1[e] = fr == 15 ? P[e] : cur[e]; z2[e] = fr >= 14 ? P[e] : cur[e]; }
                    const f32x4 p1 = dpp4<0x121>(z1), p2 = dpp4<0x122>(z2);
                    const f32x4 c = bb[n] + w0[n] * p2 + w1[n] * p1 + w2[n] * cur;
                    f32x4 hv;
#pragma unroll
                    for (int e = 0; e < 4; ++e) hv[e] = c[e] * __builtin_amdgcn_rcpf(1.f + __expf(-c[e])) * up[e];
                    if (n == 0) { hw.x = cvt_pk_bf16(hv[0], hv[1]); hw.y = cvt_pk_bf16(hv[2], hv[3]); } else { hw.z = cvt_pk_bf16(hv[0], hv[1]); hw.w = cvt_pk_bf16(hv[2], hv[3]); }
                    if (q == 0 && m == 0 && fr < 2) { *(f32x4*)(sbp + (size_t)fr * ff + 4 * n) = cur; *(f32x4*)(sbp + (size_t)(2 + fr) * ff + 4 * n) = up; }
                    if (q == 3 && m == 3 && fr >= 14) *(f32x4*)(sbp + (size_t)(4 + fr - 14) * ff + 4 * n) = cur;
                }
                *(pg8::u32x4*)(HID + (size_t)row * ff + jcol) = hw; }
        }
    }
};
}

#define LAS __attribute__((address_space(3)))
__device__ __forceinline__ void transpose_item(const float* __restrict__ W, int K, int N, bf16_t* __restrict__ Wt, const float* __restrict__ g, int mode, float* scr, int item, int lane) {
    const int nblk = N / 32, kb = item / nblk, nb = item % nblk, k0 = 64 * kb, n0 = 32 * nb;
    int np0 = n0; if (mode == 1) np0 = 256 * (n0 / 128) + (n0 % 128); else if (mode == 2) np0 = 256 * (n0 / 128) + 128 + (n0 % 128);
#pragma unroll 8
    for (int i = 0; i < 32; ++i) { const int kk = 2 * i + (lane >> 5); scr[kk * 33 + (lane & 31)] = W[(size_t)(k0 + kk) * N + n0 + (lane & 31)] * (g ? g[k0 + kk] : 1.f); }
    __builtin_amdgcn_fence(__ATOMIC_RELEASE, "wavefront"); __builtin_amdgcn_wave_barrier(); __builtin_amdgcn_fence(__ATOMIC_ACQUIRE, "wavefront");
    const int c = lane & 7;
#pragma unroll
    for (int j = 0; j < 4; ++j) { const int n = (lane >> 3) + 8 * j; const float* sp = scr + (8 * c) * 33 + n;
        uint4 o; o.x = f2bf(sp[0]) | (f2bf(sp[33]) << 16); o.y = f2bf(sp[2 * 33]) | (f2bf(sp[3 * 33]) << 16); o.z = f2bf(sp[4 * 33]) | (f2bf(sp[5 * 33]) << 16); o.w = f2bf(sp[6 * 33]) | (f2bf(sp[7 * 33]) << 16);
        *(uint4*)(Wt + (size_t)(np0 + n) * K + k0 + 8 * c) = o; }
    __builtin_amdgcn_fence(__ATOMIC_RELEASE, "wavefront"); __builtin_amdgcn_wave_barrier(); __builtin_amdgcn_fence(__ATOMIC_ACQUIRE, "wavefront");
}
constexpr size_t WS_LORA = 50 * MiB;
constexpr size_t LORA_LAYER = 256 * 1024, WS_V1T = WS_LORA + 2 * LORA_LAYER, WS_V2T = WS_V1T + 32 * 1024;
constexpr int PR_ACT_LD = 264, PR_VLO_LD = 40, PR_SG_LD = 520, PR_ACT_OFF = 0, PR_VLO_OFF = 64 * PR_ACT_LD * 2, PR_SG_OFF = PR_VLO_OFF + 64 * PR_VLO_LD * 2;
struct Prep2Args {
    const bf16_t* proj; const float* mu; const float* w0; const float* a0; const float* v0;
    const bf16_t *W2T, *A2T, *G2T, *V1T, *V2T; bf16_t* vfirst; bf16_t *R, *K, *V, *A, *LD, *G; int layer; int pad;
};
__device__ __forceinline__ f32x4 bfx4_lo(const bf16x8 v) { return (f32x4){bf2f((bf16_t)v[0]), bf2f((bf16_t)v[1]), bf2f((bf16_t)v[2]), bf2f((bf16_t)v[3])}; }
__device__ __forceinline__ f32x4 bfx4_hi(const bf16x8 v) { return (f32x4){bf2f((bf16_t)v[4]), bf2f((bf16_t)v[5]), bf2f((bf16_t)v[6]), bf2f((bf16_t)v[7])}; }
__device__ __forceinline__ bf16x8 pack8(const f32x4 a, const f32x4 b) { pg8::u32x4 w; w.x = pg8::cvt_pk_bf16(a[0], a[1]); w.y = pg8::cvt_pk_bf16(a[2], a[3]); w.z = pg8::cvt_pk_bf16(b[0], b[1]); w.w = pg8::cvt_pk_bf16(b[2], b[3]); return __builtin_bit_cast(bf16x8, w); }
__device__ __forceinline__ void shift8(const bf16_t* __restrict__ proj, const float* __restrict__ mu, size_t m, int t, int col, int mi, f32x4& lo, f32x4& hi) {
    const bf16x8 cur = *(const bf16x8*)(proj + m * IN_W + col);
    bf16x8 prv; if (t > 0) prv = *(const bf16x8*)(proj + (m - 1) * IN_W + col); else prv = (bf16x8){0, 0, 0, 0, 0, 0, 0, 0};
    const f32x4 m0 = *(const f32x4*)(mu + mi), m1 = *(const f32x4*)(mu + mi + 4);
    const f32x4 c0 = bfx4_lo(cur), c1 = bfx4_hi(cur), p0 = bfx4_lo(prv), p1 = bfx4_hi(prv);
    lo = c0 + (p0 - c0) * m0; hi = c1 + (p1 - c1) * m1;
}
__device__ __forceinline__ void prep_tile(const Prep2Args& p, unsigned char* lds, int tile, int tid) {
    const int m0 = tile * 64, wave = __builtin_amdgcn_readfirstlane(tid >> 6), lane = tid & 63, fr = lane & 15, fq = lane >> 4;
    bf16_t* ACT = (bf16_t*)(lds + PR_ACT_OFF); bf16_t* VLO = (bf16_t*)(lds + PR_VLO_OFF); bf16_t* SG = (bf16_t*)(lds + PR_SG_OFF);
#pragma unroll
    for (int it = 0; it < 4; ++it) { const int i = tid + 512 * it, tk = i >> 5, cc = i & 31; const size_t m = (size_t)m0 + tk; const int t = (int)(m % SEQ);
        f32x4 lo, hi; shift8(p.proj, p.mu, m, t, 2304 + 8 * cc, 1536 + 8 * cc, lo, hi);
        if (cc < 8) {
#pragma unroll
            for (int e = 0; e < 4; ++e) { lo[e] = 2.f * sigmoidf_(2.f * lo[e]) - 1.f; hi[e] = 2.f * sigmoidf_(2.f * hi[e]) - 1.f; } }
        else if (cc >= 16) {
#pragma unroll
            for (int e = 0; e < 4; ++e) { lo[e] = sigmoidf_(lo[e]); hi[e] = sigmoidf_(hi[e]); } }
        *(bf16x8*)(ACT + tk * PR_ACT_LD + 8 * cc) = pack8(lo, hi); }
    if (p.layer > 0) {
        const int tb = wave >> 1, jb = wave & 1; const size_t m = (size_t)m0 + 16 * tb + fr; const int t = (int)(m % SEQ);
        f32x4 acc = (f32x4){0.f, 0.f, 0.f, 0.f};
#pragma unroll 4
        for (int ks = 0; ks < 16; ++ks) { f32x4 lo, hi; shift8(p.proj, p.mu, m, t, 1792 + 32 * ks + 8 * fq, 1024 + 32 * ks + 8 * fq, lo, hi);
            const bf16x8 wf = *(const bf16x8*)(p.V1T + (size_t)(16 * jb + fr) * C + 32 * ks + 8 * fq);
            acc = __builtin_amdgcn_mfma_f32_16x16x32_bf16(wf, pack8(lo, hi), acc, 0, 0, 0); }
        uint2 w; w.x = pg8::cvt_pk_bf16(acc[0], acc[1]); w.y = pg8::cvt_pk_bf16(acc[2], acc[3]);
        *(uint2*)(VLO + (16 * tb + fr) * PR_VLO_LD + 16 * jb + 4 * fq) = w;
    }
    __syncthreads();
    const int ch0 = 64 * wave;
#pragma unroll
    for (int arr = 0; arr < 3; ++arr) {
        const int K0 = arr == 0 ? 0 : (arr == 1 ? 64 : 128), KL = arr == 2 ? 128 : 64; const bf16_t* WT = arr == 0 ? p.W2T : (arr == 1 ? p.A2T : p.G2T);
        f32x4 acc[4][4];
#pragma unroll
        for (int tb = 0; tb < 4; ++tb)
#pragma unroll
            for (int cb = 0; cb < 4; ++cb) acc[tb][cb] = (f32x4){0.f, 0.f, 0.f, 0.f};
#pragma unroll
        for (int ks = 0; ks < KL / 32; ++ks) { bf16x8 wf[4], af[4];
#pragma unroll
            for (int cb = 0; cb < 4; ++cb) wf[cb] = *(const bf16x8*)(WT + (size_t)(ch0 + 16 * cb + fr) * KL + 32 * ks + 8 * fq);
#pragma unroll
            for (int tb = 0; tb < 4; ++tb) af[tb] = *(const bf16x8*)(ACT + (16 * tb + fr) * PR_ACT_LD + K0 + 32 * ks + 8 * fq);
#pragma unroll
            for (int tb = 0; tb < 4; ++tb)
#pragma unroll
                for (int cb = 0; cb < 4; ++cb) acc[tb][cb] = __builtin_amdgcn_mfma_f32_16x16x32_bf16(wf[cb], af[tb], acc[tb][cb], 0, 0, 0); }
        bf16_t* OUT = arr == 0 ? p.LD : (arr == 1 ? p.A : p.G);
#pragma unroll
        for (int cb = 0; cb < 4; ++cb) { const int ch = ch0 + 16 * cb + 4 * fq;
            f32x4 bias = (f32x4){0.f, 0.f, 0.f, 0.f}; if (arr == 0) bias = *(const f32x4*)(p.w0 + ch); else if (arr == 1) bias = *(const f32x4*)(p.a0 + ch);
#pragma unroll
            for (int tb = 0; tb < 4; ++tb) { f32x4 x = acc[tb][cb] + bias;
                if (arr == 0) {
#pragma unroll
                    for (int e = 0; e < 4; ++e) { const float z = -x[e]; const float sp = fmaxf(z, 0.f) + __logf(1.f + __expf(-fabsf(z))); x[e] = -__expf(-sp - 0.5f); } }
                else if (arr == 1) {
#pragma unroll
                    for (int e = 0; e < 4; ++e) x[e] = sigmoidf_(x[e]); }
                uint2 w; w.x = pg8::cvt_pk_bf16(x[0], x[1]); w.y = pg8::cvt_pk_bf16(x[2], x[3]);
                *(uint2*)(OUT + ((size_t)m0 + 16 * tb + fr) * C + ch) = w; } }
    }
    if (p.layer > 0) {
        bf16x8 af[4];
#pragma unroll
        for (int tb = 0; tb < 4; ++tb) af[tb] = *(const bf16x8*)(VLO + (16 * tb + fr) * PR_VLO_LD + 8 * fq);
#pragma unroll
        for (int cb = 0; cb < 4; ++cb) { const int ch = ch0 + 16 * cb + 4 * fq; const bf16x8 wf = *(const bf16x8*)(p.V2T + (size_t)(ch0 + 16 * cb + fr) * 32 + 8 * fq); const f32x4 bias = *(const f32x4*)(p.v0 + ch);
#pragma unroll
            for (int tb = 0; tb < 4; ++tb) { f32x4 x = __builtin_amdgcn_mfma_f32_16x16x32_bf16(wf, af[tb], (f32x4){0.f, 0.f, 0.f, 0.f}, 0, 0, 0) + bias;
                uint2 w; w.x = pg8::cvt_pk_bf16(sigmoidf_(x[0]), sigmoidf_(x[1])); w.y = pg8::cvt_pk_bf16(sigmoidf_(x[2]), sigmoidf_(x[3]));
                *(uint2*)(SG + (16 * tb + fr) * PR_SG_LD + ch) = w; } }
    }
    __syncthreads();
#pragma unroll
    for (int sec = 0; sec < 3; ++sec) { bf16_t* OUT = sec == 0 ? p.R : (sec == 1 ? p.K : p.V);
        bf16x8 cu[8], pv[8], vf[8];
#pragma unroll
        for (int it = 0; it < 8; ++it) { const int i = tid + 512 * it, tk = i >> 6, cc = i & 63; const size_t m = (size_t)m0 + tk; const int t = (int)(m % SEQ); const int col = 768 + 512 * sec + 8 * cc;
            cu[it] = *(const bf16x8*)(p.proj + m * IN_W + col); if (t > 0) pv[it] = *(const bf16x8*)(p.proj + (m - 1) * IN_W + col); else pv[it] = (bf16x8){0, 0, 0, 0, 0, 0, 0, 0};
            if (sec == 2 && p.layer > 0) vf[it] = *(const bf16x8*)(p.vfirst + m * C + 8 * cc); }
#pragma unroll
        for (int it = 0; it < 8; ++it) { const int i = tid + 512 * it, tk = i >> 6, cc = i & 63; const size_t m = (size_t)m0 + tk; const int mi = 512 * sec + 8 * cc;
            const f32x4 mu0 = *(const f32x4*)(p.mu + mi), mu1 = *(const f32x4*)(p.mu + mi + 4);
            const f32x4 c0 = bfx4_lo(cu[it]), c1 = bfx4_hi(cu[it]);
            f32x4 lo = c0 + (bfx4_lo(pv[it]) - c0) * mu0, hi = c1 + (bfx4_hi(pv[it]) - c1) * mu1;
            const size_t o = m * C + 8 * cc;
            if (sec == 2) {
                if (p.layer == 0) *(bf16x8*)(p.vfirst + o) = pack8(lo, hi);
                else { const bf16x8 sg = *(const bf16x8*)(SG + tk * PR_SG_LD + 8 * cc);
                    lo = lo + (bfx4_lo(vf[it]) - lo) * bfx4_lo(sg); hi = hi + (bfx4_hi(vf[it]) - hi) * bfx4_hi(sg); } }
            *(bf16x8*)(OUT + o) = pack8(lo, hi); } }
    __syncthreads();
}

constexpr int NTHREADS_ = 512;
constexpr int SC_TB = 32, SC_SLOT = 384, SC_NCH = SEQ / SC_TB;
constexpr size_t WS_RKC = 51 * MiB;
struct ScanArgs { const bf16_t *R, *K, *V, *A, *LD, *G; const float *k_k, *k_a, *r_k, *lnx_g, *lnx_b; bf16_t* mix; float* rkc; };
template <int CTRL> __device__ __forceinline__ float dpp_mov(float x) { return __builtin_bit_cast(float, __builtin_amdgcn_update_dpp(0, __builtin_bit_cast(int, x), CTRL, 0xF, 0xF, true)); }
__device__ __forceinline__ float reduce16(float x) { x += dpp_mov<0xB1>(x); x += dpp_mov<0x4E>(x); x += dpp_mov<0x141>(x); x += dpp_mov<0x140>(x); return x; }
constexpr int CK_LD = 72, CK_MAT = 64 * CK_LD * 2;
constexpr size_t WS_TSCR = WS_SI_A, TSCR_WG = 4 * 64 * C * 2;
__device__ __forceinline__ void ck_mm(f32x4 (&acc)[2], const bf16_t* Qm, const bf16_t* P, int jb, int ib0, int fr, int fq) {
#pragma unroll
    for (int ks = 0; ks < 2; ++ks) { const bf16x8 bq = *(const bf16x8*)(Qm + (16 * jb + fr) * CK_LD + 32 * ks + 8 * fq);
#pragma unroll
        for (int ii = 0; ii < 2; ++ii) { const bf16x8 ap = *(const bf16x8*)(P + (16 * (ib0 + ii) + fr) * CK_LD + 32 * ks + 8 * fq); acc[ii] = __builtin_amdgcn_mfma_f32_16x16x32_bf16(ap, bq, acc[ii], 0, 0, 0); } }
}
__device__ __forceinline__ uint2 ck_pack4(const f32x4 v) { uint2 w; w.x = pg8::cvt_pk_bf16(v[0], v[1]); w.y = pg8::cvt_pk_bf16(v[2], v[3]); return w; }
__device__ __forceinline__ f32x4 ck_unpack4(const uint2 u) { return (f32x4){__builtin_bit_cast(float, u.x << 16), __builtin_bit_cast(float, u.x & 0xffff0000u), __builtin_bit_cast(float, u.y << 16), __builtin_bit_cast(float, u.y & 0xffff0000u)}; }
struct CkRaw { unsigned r[8], k[8], v[8], a[8], ld[8]; };
__device__ __forceinline__ float wave_sum_dpp(float x) {
    x = reduce16(x); const int xi = __builtin_bit_cast(int, x);
    const float r0 = __builtin_bit_cast(float, __builtin_amdgcn_readlane(xi, 0)), r1 = __builtin_bit_cast(float, __builtin_amdgcn_readlane(xi, 16)), r2 = __builtin_bit_cast(float, __builtin_amdgcn_readlane(xi, 32)), r3 = __builtin_bit_cast(float, __builtin_amdgcn_readlane(xi, 48));
    return (r0 + r1) + (r2 + r3); }
__device__ __forceinline__ void ck_load(const ScanArgs& p, CkRaw& w, int unit, int tid) {
    const int chain = unit >> 6, chunk = unit & 63, b = chain >> 3, h = chain & 7, wave = tid >> 6, lane = tid & 63; const int ch = h * 64 + lane; const size_t row0 = (size_t)b * SEQ + chunk * 64 + 8 * wave;
#pragma unroll
    for (int i = 0; i < 8; ++i) { const size_t o = (row0 + i) * C + ch; w.r[i] = p.R[o]; w.k[i] = p.K[o]; w.v[i] = p.V[o]; w.a[i] = p.A[o]; w.ld[i] = p.LD[o]; }
}
__device__ __forceinline__ void ck_precompute(const ScanArgs& p, const CkRaw& raw, unsigned char* lds, bf16_t* GQ, bf16_t* CQ, int unit, int tid) {
    const int chain = unit >> 6, chunk = unit & 63, b = chain >> 3, h = chain & 7, wave = __builtin_amdgcn_readfirstlane(tid >> 6), lane = tid & 63, fr = lane & 15, fq = lane >> 4, jb = wave >> 1, ib0 = 2 * (wave & 1);
    bf16_t* At = (bf16_t*)(lds + 0 * CK_MAT); bf16_t* bt = (bf16_t*)(lds + 1 * CK_MAT); bf16_t* kt = (bf16_t*)(lds + 2 * CK_MAT); bf16_t* rt = (bf16_t*)(lds + 3 * CK_MAT);
    bf16_t* AtT = (bf16_t*)(lds + 4 * CK_MAT); bf16_t* BhT = (bf16_t*)(lds + 5 * CK_MAT); bf16_t* KhT = (bf16_t*)(lds + 6 * CK_MAT); bf16_t* VT = (bf16_t*)(lds + 7 * CK_MAT);
    bf16_t* NT = (bf16_t*)(lds + 8 * CK_MAT); bf16_t* Mm = (bf16_t*)(lds + 9 * CK_MAT); bf16_t* P1 = (bf16_t*)(lds + 10 * CK_MAT); bf16_t* P2 = (bf16_t*)(lds + 11 * CK_MAT);
    bf16_t* Ta = (bf16_t*)(lds + 12 * CK_MAT); bf16_t* Tb = (bf16_t*)(lds + 13 * CK_MAT); float* WT = (float*)(lds + 14 * CK_MAT); float* GL = WT + 512;
    bf16_t* W1T = bt; bf16_t* MVT = kt; bf16_t* W2T = At;
    {
        const int ch = h * 64 + lane; const size_t row0 = (size_t)b * SEQ + chunk * 64 + 8 * wave;
        const float kk_c = p.k_k[ch], ka_c = p.k_a[ch], rk_c = p.r_k[ch];
        float r[8], kp[8], Aq[8], bq[8], v[8], ld[8], cl[8]; float run = 0.f;
#pragma unroll
        for (int i = 0; i < 8; ++i) { r[i] = bf2f((bf16_t)raw.r[i]); kp[i] = bf2f((bf16_t)raw.k[i]); v[i] = bf2f((bf16_t)raw.v[i]); bq[i] = bf2f((bf16_t)raw.a[i]); ld[i] = bf2f((bf16_t)raw.ld[i]); }
#pragma unroll
        for (int i = 0; i < 8; ++i) { const float k = kp[i], a = bq[i]; float kk = k * kk_c; kk = kk * fminf(__builtin_amdgcn_rsqf(wave_sum_dpp(kk * kk)), 1e12f);
            kp[i] = k * (1.f + (a - 1.f) * ka_c); Aq[i] = -kk; bq[i] = kk * a; const float rkc = wave_sum_dpp(r[i] * kp[i] * rk_c);
            if (lane == 0) p.rkc[(row0 + i) * 8 + h] = rkc; run += ld[i]; cl[i] = run; }
        WT[wave * 64 + lane] = run;
        __syncthreads();
        float off = 0.f, csL = 0.f;
#pragma unroll
        for (int w2 = 0; w2 < 8; ++w2) { const float t = WT[w2 * 64 + lane]; csL += t; if (w2 < wave) off += t; }
        if (wave == 0) GL[lane] = __expf(csL);
        float aT[8], bhT[8], khT[8];
#pragma unroll
        for (int i = 0; i < 8; ++i) { const float cs = off + cl[i], em = __expf(cs - ld[i]), en = __expf(-cs), ep = __expf(cs), eL = __expf(csL - cs); const int tl = 8 * wave + i;
            const float at = Aq[i] * em; aT[i] = at; bhT[i] = bq[i] * eL; khT[i] = kp[i] * eL;
            At[tl * CK_LD + lane] = (bf16_t)f2bf(at); bt[tl * CK_LD + lane] = (bf16_t)f2bf(bq[i] * en); kt[tl * CK_LD + lane] = (bf16_t)f2bf(kp[i] * en); rt[tl * CK_LD + lane] = (bf16_t)f2bf(r[i] * ep); }
        *(bf16x8*)(AtT + lane * CK_LD + 8 * wave) = pack8((f32x4){aT[0], aT[1], aT[2], aT[3]}, (f32x4){aT[4], aT[5], aT[6], aT[7]});
        *(bf16x8*)(BhT + lane * CK_LD + 8 * wave) = pack8((f32x4){bhT[0], bhT[1], bhT[2], bhT[3]}, (f32x4){bhT[4], bhT[5], bhT[6], bhT[7]});
        *(bf16x8*)(KhT + lane * CK_LD + 8 * wave) = pack8((f32x4){khT[0], khT[1], khT[2], khT[3]}, (f32x4){khT[4], khT[5], khT[6], khT[7]});
        *(bf16x8*)(VT + lane * CK_LD + 8 * wave) = pack8((f32x4){v[0], v[1], v[2], v[3]}, (f32x4){v[4], v[5], v[6], v[7]});
    }
    __syncthreads();
    const int j = 16 * jb + fr; const f32x4 z4 = (f32x4){0.f, 0.f, 0.f, 0.f};
    { f32x4 aN[2] = {z4, z4}, aNT[2] = {z4, z4}, aM[2] = {z4, z4}, aP1[2] = {z4, z4}, aP2[2] = {z4, z4};
      ck_mm(aN, At, bt, jb, ib0, fr, fq); ck_mm(aNT, bt, At, jb, ib0, fr, fq); ck_mm(aM, At, kt, jb, ib0, fr, fq); ck_mm(aP1, rt, bt, jb, ib0, fr, fq); ck_mm(aP2, rt, kt, jb, ib0, fr, fq);
#pragma unroll
      for (int ii = 0; ii < 2; ++ii) { const int i0 = 16 * (ib0 + ii) + 4 * fq; f32x4 t0, nt, mm, p1, p2;
#pragma unroll
          for (int e = 0; e < 4; ++e) { const int i = i0 + e; t0[e] = (i < j ? aN[ii][e] : 0.f) + (i == j ? 1.f : 0.f); nt[e] = j < i ? aNT[ii][e] : 0.f; mm[e] = i < j ? aM[ii][e] : 0.f; p1[e] = i <= j ? aP1[ii][e] : 0.f; p2[e] = i <= j ? aP2[ii][e] : 0.f; }
          *(uint2*)(Ta + j * CK_LD + i0) = ck_pack4(t0); *(uint2*)(NT + j * CK_LD + i0) = ck_pack4(nt); *(uint2*)(Mm + j * CK_LD + i0) = ck_pack4(mm); *(uint2*)(P1 + j * CK_LD + i0) = ck_pack4(p1); *(uint2*)(P2 + j * CK_LD + i0) = ck_pack4(p2); } }
    __syncthreads();
#pragma unroll
    for (int st = 0; st < 3; ++st) { const bf16_t* src = (st & 1) ? Tb : Ta; bf16_t* dst = (st & 1) ? Ta : Tb; f32x4 a2[2] = {z4, z4}; ck_mm(a2, src, NT, jb, ib0, fr, fq);
#pragma unroll
        for (int ii = 0; ii < 2; ++ii) { const int i0 = 16 * (ib0 + ii) + 4 * fq; f32x4 t = a2[ii];
#pragma unroll
            for (int e = 0; e < 4; ++e) t[e] += (i0 + e == j) ? 1.f : 0.f;
            *(uint2*)(dst + j * CK_LD + i0) = ck_pack4(t); }
        __syncthreads(); }
    { f32x4 a1[2] = {z4, z4}, a2[2] = {z4, z4}; ck_mm(a1, AtT, Tb, jb, ib0, fr, fq); ck_mm(a2, VT, Mm, jb, ib0, fr, fq);
#pragma unroll
      for (int ii = 0; ii < 2; ++ii) { const int i0 = 16 * (ib0 + ii) + 4 * fq; *(uint2*)(W1T + j * CK_LD + i0) = ck_pack4(a1[ii]); *(uint2*)(MVT + j * CK_LD + i0) = ck_pack4(a2[ii]); } }
    __syncthreads();
    { f32x4 a1[2] = {z4, z4}; ck_mm(a1, MVT, Tb, jb, ib0, fr, fq);
#pragma unroll
      for (int ii = 0; ii < 2; ++ii) { const int i0 = 16 * (ib0 + ii) + 4 * fq; *(uint2*)(W2T + j * CK_LD + i0) = ck_pack4(a1[ii]); } }
    __syncthreads();
    { f32x4 aQ1[2] = {z4, z4}, aG[2] = {z4, z4}, aQ2[2] = {z4, z4}, aC[2] = {z4, z4};
      ck_mm(aQ1, P1, W1T, jb, ib0, fr, fq); ck_mm(aG, BhT, W1T, jb, ib0, fr, fq); ck_mm(aQ2, P1, W2T, jb, ib0, fr, fq); ck_mm(aQ2, P2, VT, jb, ib0, fr, fq); ck_mm(aC, W2T, BhT, jb, ib0, fr, fq); ck_mm(aC, VT, KhT, jb, ib0, fr, fq);
      bf16_t* gq = GQ + (size_t)unit * 8192; bf16_t* cq = CQ + (size_t)unit * 8192; const float glj = GL[j];
#pragma unroll
      for (int ii = 0; ii < 2; ++ii) { const int i0 = 16 * (ib0 + ii) + 4 * fq; f32x4 g = aG[ii];
#pragma unroll
          for (int e = 0; e < 4; ++e) g[e] += (i0 + e == j) ? glj : 0.f;
          const f32x4 q1 = aQ1[ii] + ck_unpack4(*(const uint2*)(rt + j * CK_LD + i0));
          *(uint2*)(gq + j * 64 + i0) = ck_pack4(g); *(uint2*)(gq + 4096 + j * 64 + i0) = ck_pack4(q1); *(uint2*)(cq + j * 64 + i0) = ck_pack4(aC[ii]); *(uint2*)(cq + 4096 + j * 64 + i0) = ck_pack4(aQ2[ii]); } }
    __syncthreads();
}
__device__ __forceinline__ void ck_sequential(const ScanArgs& p, unsigned char* lds, const bf16_t* GQ, const bf16_t* CQ, int item, int tid) {
    const int chain = item >> 2, q = item & 3, b = chain >> 3, h = chain & 7, wave = __builtin_amdgcn_readfirstlane(tid >> 6), lane = tid & 63, fr = lane & 15, fq = lane >> 4;
    bf16_t* OPS = (bf16_t*)lds;
    bf16_t* HT = (bf16_t*)(lds + 4 * CK_MAT);
    for (int i = tid; i < 2 * 16 * CK_LD / 2; i += NTHREADS_) ((unsigned*)HT)[i] = 0u;
    const size_t ubase = (size_t)chain * 64; const size_t rowbase = (size_t)b * SEQ;
    const int prow0 = tid >> 3, pcol = (tid & 7) * 8;
    const int aoff = wave < 4 ? (4096 + (16 * wave + fr) * 64 + 16 * q + 4 * fq) : ((16 * q + fr) * 64 + 16 * (wave - 4) + 4 * fq);
    typedef unsigned u32x2_ __attribute__((ext_vector_type(2)));
    pg8::u32x4 g0_0, g0_1, g0_2, g0_3, g1_0, g1_1, g1_2, g1_3; u32x2_ ad_0, ad_1, ad_2, ad_3;
#define CK_FETCH(slot, cc) do { const bf16_t* gq = GQ + (ubase + (cc)) * 8192; g0_##slot = *(const pg8::u32x4*)(gq + (size_t)prow0 * 64 + pcol); g1_##slot = *(const pg8::u32x4*)(gq + (size_t)(prow0 + 64) * 64 + pcol); \
        ad_##slot = *(const u32x2_*)(CQ + (ubase + (cc)) * 8192 + aoff); } while (0)
#define CK_STAGE(slot, buf) do { *(pg8::u32x4*)(OPS + (buf) * 2 * 64 * CK_LD + prow0 * CK_LD + pcol) = g0_##slot; *(pg8::u32x4*)(OPS + (buf) * 2 * 64 * CK_LD + 64 * CK_LD + prow0 * CK_LD + pcol) = g1_##slot; } while (0)
    CK_FETCH(0, 0); CK_FETCH(1, 1); CK_FETCH(2, 2); CK_FETCH(3, 3);
    CK_STAGE(0, 0);
    __syncthreads();
#define CK_STEP(cc, slot, nslot) do { const int bi = (cc) & 1; const bf16_t* Gm = OPS + bi * 2 * 64 * CK_LD; const bf16_t* Q1m = Gm + 64 * CK_LD; const bf16_t* HTc = HT + bi * 16 * CK_LD; bf16_t* HTn = HT + (bi ^ 1) * 16 * CK_LD; \
        f32x4 acc = (f32x4){0.f, 0.f, 0.f, 0.f}; \
        if (wave < 4) { _Pragma("unroll") for (int ks = 0; ks < 2; ++ks) acc = __builtin_amdgcn_mfma_f32_16x16x32_bf16(*(const bf16x8*)(HTc + fr * CK_LD + 32 * ks + 8 * fq), *(const bf16x8*)(Q1m + (16 * wave + fr) * CK_LD + 32 * ks + 8 * fq), acc, 0, 0, 0); \
            acc = acc + ck_unpack4((uint2){ad_##slot.x, ad_##slot.y}); \
            *(uint2*)(p.mix + (rowbase + (size_t)(cc) * 64 + 16 * wave + fr) * D + ATT_W + h * 64 + 16 * q + 4 * fq) = ck_pack4(acc); } \
        else { _Pragma("unroll") for (int ks = 0; ks < 2; ++ks) acc = __builtin_amdgcn_mfma_f32_16x16x32_bf16(*(const bf16x8*)(Gm + (16 * (wave - 4) + fr) * CK_LD + 32 * ks + 8 * fq), *(const bf16x8*)(HTc + fr * CK_LD + 32 * ks + 8 * fq), acc, 0, 0, 0); \
            acc = acc + ck_unpack4((uint2){ad_##slot.x, ad_##slot.y}); \
            *(uint2*)(HTn + fr * CK_LD + 16 * (wave - 4) + 4 * fq) = ck_pack4(acc); } \
        if ((cc) + 1 < 64) CK_STAGE(nslot, bi ^ 1); \
        if ((cc) + 4 < 64) CK_FETCH(slot, (cc) + 4); \
        __syncthreads(); } while (0)
    for (int c = 0; c < 64; c += 4) { CK_STEP(c, 0, 1); CK_STEP(c + 1, 1, 2); CK_STEP(c + 2, 2, 3); CK_STEP(c + 3, 3, 0); }
#undef CK_FETCH
#undef CK_STAGE
#undef CK_STEP
}

__device__ __forceinline__ float red8(float x) { x += dpp_mov<0xB1>(x); x += dpp_mov<0x4E>(x); x += dpp_mov<0x141>(x); return x; }
__device__ __forceinline__ void scan_post_rows(const ScanArgs& p, int m0, int lane) {
    const int ch8 = 8 * lane, hh = lane >> 3;
    const f32x4 lg0 = *(const f32x4*)(p.lnx_g + ch8), lg1 = *(const f32x4*)(p.lnx_g + ch8 + 4), lb0 = *(const f32x4*)(p.lnx_b + ch8), lb1 = *(const f32x4*)(p.lnx_b + ch8 + 4);
    bf16x8 yv[2], vv[2], gv[2]; float rk[2];
#pragma unroll
    for (int u = 0; u < 2; ++u) { const size_t m = (size_t)m0 + u; yv[u] = *(const bf16x8*)(p.mix + m * D + ATT_W + ch8); vv[u] = *(const bf16x8*)(p.V + m * C + ch8); gv[u] = *(const bf16x8*)(p.G + m * C + ch8); rk[u] = p.rkc[m * 8 + hh]; }
#pragma unroll
    for (int u = 0; u < 2; ++u) { const size_t m = (size_t)m0 + u;
        f32x4 y0 = bfx4_lo(yv[u]), y1 = bfx4_hi(yv[u]);
        const float mean = red8((y0.x + y0.y) + (y0.z + y0.w) + (y1.x + y1.y) + (y1.z + y1.w)) * (1.f / 64.f);
        y0 = y0 - mean; y1 = y1 - mean;
        const float var = red8((y0.x * y0.x + y0.y * y0.y) + (y0.z * y0.z + y0.w * y0.w) + (y1.x * y1.x + y1.y * y1.y) + (y1.z * y1.z + y1.w * y1.w)) * (1.f / 64.f);
        const float rs = rsqrtf(var + LNX_EPS);
        const f32x4 o0 = (y0 * rs * lg0 + lb0 + bfx4_lo(vv[u]) * rk[u]) * bfx4_lo(gv[u]), o1 = (y1 * rs * lg1 + lb1 + bfx4_hi(vv[u]) * rk[u]) * bfx4_hi(gv[u]);
        *(bf16x8*)(p.mix + m * D + ATT_W + ch8) = pack8(o0, o1); }
}

typedef float f32x16 __attribute__((ext_vector_type(16)));
typedef short s16x4 __attribute__((ext_vector_type(4)));
constexpr int AT_VTS = 196;
__device__ __forceinline__ int crow(int r, int hi) { return (r & 3) + 8 * (r >> 2) + 4 * hi; }
__device__ __forceinline__ void attn_unit(const bf16_t* __restrict__ proj, const float* __restrict__ sinks, bf16_t* __restrict__ mix, bf16_t* vt, int unit, int tid) {
    const int b = unit >> 7, kvh = (unit >> 6) & 1, qb = unit & 63, Q0 = qb * 64;
    const int wave = __builtin_amdgcn_readfirstlane(tid >> 6), lane = tid & 63, c = lane & 31, hi = lane >> 5, g = wave >> 1, half = wave & 1, h = kvh * 4 + g;
    const size_t rowb = (size_t)b * SEQ;
    for (int i = tid; i < 192 * 8; i += 512) { const int kl = i >> 3, ch8 = i & 7; int key = Q0 - 128 + kl; key = key < 0 ? 0 : key;
        const bf16x8 v = *(const bf16x8*)(proj + (rowb + key) * IN_W + 640 + kvh * 64 + ch8 * 8);
#pragma unroll
        for (int e = 0; e < 8; ++e) vt[(ch8 * 8 + e) * AT_VTS + kl] = (bf16_t)v[e]; }
    __syncthreads();
    const int t0 = Q0 + 32 * half; const size_t mq = rowb + t0 + c;
    bf16x8 qf[4];
#pragma unroll
    for (int ks = 0; ks < 4; ++ks) qf[ks] = *(const bf16x8*)(proj + mq * IN_W + h * 64 + 16 * ks + 8 * hi);
    f32x16 p[5];
#pragma unroll
    for (int kb = 0; kb < 5; ++kb) { int key = t0 - 128 + 32 * kb + c; key = key < 0 ? 0 : key; const bf16_t* kp = proj + (rowb + key) * IN_W + 512 + kvh * 64 + 8 * hi;
        f32x16 acc;
#pragma unroll
        for (int r = 0; r < 16; ++r) acc[r] = 0.f;
#pragma unroll
        for (int ks = 0; ks < 4; ++ks) acc = __builtin_amdgcn_mfma_f32_32x32x16_bf16(*(const bf16x8*)(kp + 16 * ks), qf[ks], acc, 0, 0, 0);
        p[kb] = acc; }
    const float slope = exp2f(-(float)(h + 1)), sink = sinks[h];
    float mx = sink;
#pragma unroll
    for (int kb = 0; kb < 5; ++kb)
#pragma unroll
        for (int r = 0; r < 16; ++r) { const int cr = crow(r, hi), dist = c + 128 - 32 * kb - cr, key = t0 - 128 + 32 * kb + cr;
            const float sc = (dist >= 0 && dist < WINDOW && key >= 0) ? p[kb][r] * 0.125f - slope * (float)dist : -1e30f; p[kb][r] = sc; mx = fmaxf(mx, sc); }
    mx = fmaxf(mx, __shfl_xor(mx, 32));
    float l = 0.f;
#pragma unroll
    for (int kb = 0; kb < 5; ++kb)
#pragma unroll
        for (int r = 0; r < 16; ++r) { const float e = __expf(p[kb][r] - mx); p[kb][r] = e; l += e; }
    l += __shfl_xor(l, 32); l += __expf(sink - mx);
    f32x16 o[2];
#pragma unroll
    for (int d = 0; d < 2; ++d)
#pragma unroll
        for (int r = 0; r < 16; ++r) o[d][r] = 0.f;
#pragma unroll
    for (int kb = 0; kb < 5; ++kb)
#pragma unroll
        for (int s2 = 0; s2 < 2; ++s2) {
            pg8::u32x4 pw; pw.x = pg8::cvt_pk_bf16(p[kb][8 * s2 + 0], p[kb][8 * s2 + 1]); pw.y = pg8::cvt_pk_bf16(p[kb][8 * s2 + 2], p[kb][8 * s2 + 3]);
            pw.z = pg8::cvt_pk_bf16(p[kb][8 * s2 + 4], p[kb][8 * s2 + 5]); pw.w = pg8::cvt_pk_bf16(p[kb][8 * s2 + 6], p[kb][8 * s2 + 7]);
            const bf16x8 pf = __builtin_bit_cast(bf16x8, pw);
#pragma unroll
            for (int d = 0; d < 2; ++d) { const bf16_t* vp = vt + (32 * d + c) * AT_VTS + 32 * half + 32 * kb + 16 * s2 + 4 * hi;
                const s16x4 lo = *(const s16x4*)vp, hh = *(const s16x4*)(vp + 8);
                const bf16x8 vf = (bf16x8){lo[0], lo[1], lo[2], lo[3], hh[0], hh[1], hh[2], hh[3]};
                o[d] = __builtin_amdgcn_mfma_f32_32x32x16_bf16(vf, pf, o[d], 0, 0, 0); } }
    const float inv = 1.f / l;
#pragma unroll
    for (int d = 0; d < 2; ++d)
#pragma unroll
        for (int rg = 0; rg < 4; ++rg) { uint2 w; w.x = pg8::cvt_pk_bf16(o[d][4 * rg] * inv, o[d][4 * rg + 1] * inv); w.y = pg8::cvt_pk_bf16(o[d][4 * rg + 2] * inv, o[d][4 * rg + 3] * inv);
            *(uint2*)(mix + mq * D + h * 64 + 32 * d + 8 * rg + 4 * hi) = w; }
    __syncthreads();
}

__device__ __forceinline__ void ffn_fixup(const float* __restrict__ SB, const float* __restrict__ cw, const float* __restrict__ cb, bf16_t* hid, int pm, int tid) {
    const float* s = SB + (size_t)pm * 6 * FF; const float* sp = SB + (size_t)(pm - 1) * 6 * FF; const bool has_prev = (pm % (SEQ / 256)) != 0;
    for (int idx = tid; idx < 2 * FF; idx += NTHREADS_) { const int rr = idx / FF, j = idx % FF;
        const float u0 = s[j], u1 = s[FF + j], ul0 = has_prev ? sp[4 * FF + j] : 0.f, ul1 = has_prev ? sp[5 * FF + j] : 0.f;
        const float c = rr == 0 ? cb[j] + cw[j] * ul0 + cw[FF + j] * ul1 + cw[2 * FF + j] * u0 : cb[j] + cw[j] * ul1 + cw[FF + j] * u0 + cw[2 * FF + j] * u1;
        hid[(size_t)(pm * 256 + rr) * FF + j] = (bf16_t)f2bf(c * sigmoidf_(c) * s[(2 + rr) * FF + j]); }
}

#define XB_TMO      128
#define XB_XCNT(j)  (256  + 64 * (j))
#define XB_XSUB(j)  (1280 + 64 * (j))
#define XB_XGEN(j)  (2304 + 64 * (j))
#define XB_TOP      3328
#define XB_TOPGEN   3392
#define XCD_BAR_WORDS 3456
#define XB_SPIN_CAP (1u << 18)

__device__ __forceinline__ unsigned xb_ld(unsigned* p)              { return __hip_atomic_load(p, __ATOMIC_RELAXED, __HIP_MEMORY_SCOPE_AGENT); }
__device__ __forceinline__ unsigned xb_add(unsigned* p, unsigned v) { return __hip_atomic_fetch_add(p, v, __ATOMIC_RELAXED, __HIP_MEMORY_SCOPE_AGENT); }
__device__ __forceinline__ unsigned xb_xcc_id() { return (unsigned)__builtin_amdgcn_s_getreg((3 << 11) | 20) & 0xFu; }
#define XB_SPIN(cond, bar) do { unsigned _sp = 0; while (cond) { __builtin_amdgcn_s_sleep(1); \
    if ((++_sp & 255u) == 0u) { if (xb_ld(&(bar)[XB_TMO])) break; if (_sp > XB_SPIN_CAP) { atomicAdd(&(bar)[XB_TMO], 1u); break; } } } } while (0)

struct XcdBarrier {
    unsigned* bar; unsigned x;
    volatile __attribute__((address_space(3))) unsigned* st;
};

__device__ __forceinline__ XcdBarrier xcd_barrier_post(unsigned* bar, volatile __attribute__((address_space(3))) unsigned* st) {
    XcdBarrier b; b.bar = bar; b.x = xb_xcc_id(); b.st = st;
    if (threadIdx.x == 0) (void)xb_add(&bar[XB_XCNT(b.x)], 1u);
    return b;
}
__device__ __forceinline__ void xcd_barrier_complete(unsigned* bar, unsigned x, unsigned& nloc, unsigned& nx) {
    const unsigned G = gridDim.x * gridDim.y * gridDim.z;
    unsigned sum, cnt, mine, sp = 0u;
    for (;;) {
        sum = 0u; cnt = 0u; mine = 0u;
#pragma unroll
        for (unsigned j = 0; j < 16; ++j) { const unsigned c = xb_ld(&bar[XB_XCNT(j)]); sum += c; cnt += (c > 0u) ? 1u : 0u; mine = (j == x) ? c : mine; }
        if (sum == G) break;
        __builtin_amdgcn_s_sleep(1);
        if ((++sp & 255u) == 0u) { if (xb_ld(&bar[XB_TMO])) break; if (sp > XB_SPIN_CAP) { atomicAdd(&bar[XB_TMO], 1u); break; } }
    }
    nloc = mine > 0u ? mine : 1u; nx = cnt > 0u ? cnt : 1u;
}

__device__ __forceinline__ void xcd_barrier(const XcdBarrier& b) {
    asm volatile("s_waitcnt vmcnt(0)" ::: "memory");
    __syncthreads();
    if (threadIdx.x == 0) {
        unsigned* bar = b.bar;
        __builtin_amdgcn_s_waitcnt(0);
        unsigned nloc = b.st[0], nx = b.st[1];
        if (nloc == 0u) { xcd_barrier_complete(bar, b.x, nloc, nx); b.st[0] = nloc; b.st[1] = nx; }
        const unsigned old = xb_add(&bar[XB_XSUB(b.x)], 1u);
        const unsigned gen = old / nloc;
        if (old + 1u == (gen + 1u) * nloc) {
            __builtin_amdgcn_fence(__ATOMIC_RELEASE, "agent");
            asm volatile("s_waitcnt vmcnt(0)" ::: "memory");
            const unsigned og = xb_add(&bar[XB_TOP], 1u);
            const unsigned tg = og / nx;
            if (og + 1u == (tg + 1u) * nx) xb_add(&bar[XB_TOPGEN], 1u);
            else XB_SPIN(xb_ld(&bar[XB_TOPGEN]) == tg, bar);
            __builtin_amdgcn_fence(__ATOMIC_ACQUIRE, "agent");
            xb_add(&bar[XB_XGEN(b.x)], 1u);
            asm volatile("s_waitcnt vmcnt(0)" ::: "memory");
        } else {
            XB_SPIN(xb_ld(&bar[XB_XGEN(b.x)]) == gen, bar);
            __builtin_amdgcn_fence(__ATOMIC_ACQUIRE, "agent");
            asm volatile("s_waitcnt vmcnt(0)" ::: "memory");
        }
    }
    __syncthreads();
}

constexpr int NTHREADS = 512, LDS_BYTES = 147456;
struct Args { const float* in[26]; float* out; unsigned char* ws; };
__global__ void __launch_bounds__(NTHREADS, 2) mega_fwd(Args a) {
    extern __shared__ __attribute__((aligned(16))) unsigned char lds[];
    constexpr int MISC_OFF = 131072 + 4096;
    { volatile __attribute__((address_space(3))) unsigned* misc = (volatile __attribute__((address_space(3))) unsigned*)((__attribute__((address_space(3))) unsigned char*)lds + MISC_OFF);
      if (threadIdx.x < 4) misc[threadIdx.x] = 0u; }
    __syncthreads();
    (void)xcd_barrier_post((unsigned*)(a.ws + WS_BAR), (volatile __attribute__((address_space(3))) unsigned*)((__attribute__((address_space(3))) unsigned char*)lds + MISC_OFF));
#define GRID_SYNC() do { XcdBarrier xb_; xb_.bar = (unsigned*)(a.ws + WS_BAR); xb_.x = xb_xcc_id(); xb_.st = (volatile __attribute__((address_space(3))) unsigned*)((__attribute__((address_space(3))) unsigned char*)lds + MISC_OFF); xcd_barrier(xb_); } while (0)
#define LDSP ((PG8_LAS unsigned char*)lds)
    constexpr int XCH_OFF = 131072;
#define OTID() ({ int _t = threadIdx.x; asm volatile("" : "+v"(_t)); _t; })
    const int G = gridDim.x, NGW = G * 8;
    const float* x = a.in[0]; const float* norm1_g = a.in[1]; const float* w_in = a.in[2]; const float* sinks = a.in[3];
    const float* mu = a.in[4]; const float* w0 = a.in[5]; const float* w2 = a.in[6]; const float* a0 = a.in[7];
    const float* a2 = a.in[8]; const float* g2 = a.in[9]; const float* k_k = a.in[10]; const float* k_a = a.in[11];
    const float* r_k = a.in[12]; const float* lnx_g = a.in[13]; const float* lnx_b = a.in[14]; const float* v0 = a.in[15];
    const float* v1 = a.in[16]; const float* v2 = a.in[17]; const float* w_out = a.in[18]; const float* norm2_g = a.in[19];
    const float* wg = a.in[20]; const float* wu = a.in[21]; const float* conv_w = a.in[22]; const float* conv_b = a.in[23];
    const float* wd = a.in[24]; const float* final_g = a.in[25];
    unsigned char* ws = a.ws; float* X = a.out;
    ssq_t* ss = (ssq_t*)(ws + WS_SS);
    bf16_t* XB = (bf16_t*)(ws + WS_XB); bf16_t* PROJ = (bf16_t*)(ws + WS_PROJ); bf16_t* MIX = (bf16_t*)(ws + WS_MIX); bf16_t* HID = (bf16_t*)(ws + WS_HID); bf16_t* VF = (bf16_t*)(ws + WS_VFIRST);
    bf16_t* UT = (bf16_t*)(ws + WS_UTMP); bf16_t* UPT = UT + (size_t)SEQ * FF;

    {
        const int tid = OTID(), lane = tid & 63, wave = tid >> 6, gw = blockIdx.x * 8 + wave;
        float* scr = (float*)lds + wave * (64 * 33 + 16);
        constexpr int I_IN = (D / 64) * (IN_W / 32), I_OUT = (D / 64) * (D / 32), I_G = (D / 64) * (FF / 32), I_DN = (FF / 64) * (D / 32), I_LAYER = I_IN + I_OUT + 2 * I_G + I_DN;
        for (int it = gw; it < 2 * I_LAYER; it += NGW) {
            const int l = it / I_LAYER; int r = it % I_LAYER;
            bf16_t* wl = (bf16_t*)(ws + WS_W + l * W_LAYER); bf16_t* WinT = wl; bf16_t* WoutT = (bf16_t*)((char*)wl + W_IN_SZ); bf16_t* WguT = (bf16_t*)((char*)WoutT + W_OUT_SZ); bf16_t* WdT = (bf16_t*)((char*)WguT + W_GU_SZ);
            if (r < I_IN) { transpose_item(w_in + (size_t)l * D * IN_W, D, IN_W, WinT, norm1_g + l * D, 0, scr, r, lane); continue; } r -= I_IN;
            if (r < I_OUT) { transpose_item(w_out + (size_t)l * D * D, D, D, WoutT, nullptr, 0, scr, r, lane); continue; } r -= I_OUT;
            if (r < I_G) { transpose_item(wg + (size_t)l * D * FF, D, FF, WguT, norm2_g + l * D, 1, scr, r, lane); continue; } r -= I_G;
            if (r < I_G) { transpose_item(wu + (size_t)l * D * FF, D, FF, WguT, norm2_g + l * D, 2, scr, r, lane); continue; } r -= I_G;
            transpose_item(wd + (size_t)l * FF * D, FF, D, WdT, nullptr, 0, scr, r, lane);
        }
        {
            constexpr int I_W2 = 1 * (C / 32), I_G2 = 2 * (C / 32), I_V1 = (C / 64) * 1, I_L = 2 * I_W2 + I_G2;
            for (int it = gw; it < 2 * I_L + I_V1; it += NGW) {
                if (it < 2 * I_L) { const int l = it / I_L; int r = it % I_L; bf16_t* base = (bf16_t*)(ws + WS_LORA + l * LORA_LAYER);
                    if (r < I_W2) { transpose_item(w2 + (size_t)l * 64 * C, 64, C, base, nullptr, 0, scr, r, lane); continue; } r -= I_W2;
                    if (r < I_W2) { transpose_item(a2 + (size_t)l * 64 * C, 64, C, base + 512 * 64, nullptr, 0, scr, r, lane); continue; } r -= I_W2;
                    transpose_item(g2 + (size_t)l * 128 * C, 128, C, base + 2 * 512 * 64, nullptr, 0, scr, r, lane); }
                else transpose_item(v1, C, 32, (bf16_t*)(ws + WS_V1T), nullptr, 0, scr, it - 2 * I_L, lane);
            }
            bf16_t* V2T = (bf16_t*)(ws + WS_V2T);
            for (int i = blockIdx.x * NTHREADS + tid; i < 32 * C; i += G * NTHREADS) { const int j = i / C, ch = i % C; V2T[ch * 32 + j] = (bf16_t)f2bf(v2[i]); }
        }
        for (int m = 4 * gw; m < M; m += 4 * NGW) {
            f32x4 xv[4][4];
#pragma unroll
            for (int u = 0; u < 4; ++u)
#pragma unroll
                for (int j = 0; j < 4; ++j) xv[u][j] = ((const f32x4*)(x + (size_t)(m + u) * D))[lane + 64 * j];
#pragma unroll
            for (int u = 0; u < 4; ++u) { float sq = 0.f;
#pragma unroll
                for (int j = 0; j < 4; ++j) { const f32x4 v = xv[u][j]; sq += v.x * v.x + v.y * v.y + v.z * v.z + v.w * v.w;
                    ((unsigned long long*)(XB + (size_t)(m + u) * D))[lane + 64 * j] = (unsigned long long)(f2bf(v.x) | (f2bf(v.y) << 16)) | ((unsigned long long)(f2bf(v.z) | (f2bf(v.w) << 16)) << 32); }
                sq = wave_sum(sq); if (lane == 0) ss[m + u] = ssq_fix(sq); } }
    }
    GRID_SYNC();
    for (int l = 0; l < 2; ++l) {
        bf16_t* wl = (bf16_t*)(ws + WS_W + l * W_LAYER); bf16_t* WinT = wl; bf16_t* WoutT = (bf16_t*)((char*)wl + W_IN_SZ); bf16_t* WguT = (bf16_t*)((char*)WoutT + W_OUT_SZ); bf16_t* WdT = (bf16_t*)((char*)WguT + W_GU_SZ);
        ssq_t* ss1 = ss + (size_t)(2 * l) * M; ssq_t* ss2 = ss + (size_t)(2 * l + 1) * M; ssq_t* ss3 = ss + (size_t)(2 * l + 2) * M;
        { pg8::Gemm g{XB, WinT, M, IN_W, D}; pg8::StaticOrder S; S.init(M, IN_W, G, (int)blockIdx.x); pg8::EpiScaleBf16 E{PROJ, IN_W, ss1};
          pg8::gemm_phase<pg8::EpiScaleBf16, pg8::StaticOrder, true, true>(LDSP, g, S, E); }
        GRID_SYNC();
        for (int unit = blockIdx.x; unit < BATCH * 2 * (SEQ / 64); unit += G) attn_unit(PROJ, sinks + l * NH, MIX, (bf16_t*)lds, unit, OTID());
        struct { bf16_t *V, *G; } p; p.V = (bf16_t*)(ws + WS_SI_V); p.G = (bf16_t*)(ws + WS_SI_G);
        bf16_t* GQ = (bf16_t*)X; bf16_t* CQ = GQ + (size_t)BATCH * NH * 64 * 8192;
        ScanArgs s{}; s.V = p.V; s.G = p.G; s.k_k = k_k + l * C; s.k_a = k_a + l * C; s.r_k = r_k + l * C; s.lnx_g = lnx_g + l * C; s.lnx_b = lnx_b + l * C; s.mix = MIX; s.rkc = (float*)(ws + WS_RKC);
        { bf16_t* scr = (bf16_t*)(ws + WS_TSCR + (size_t)blockIdx.x * TSCR_WG);
          for (int tile = blockIdx.x; tile < M / 64; tile += G) {
              const size_t moff = (size_t)tile * 64 * C;
              Prep2Args q{}; q.proj = PROJ; q.mu = mu + l * SHIFT_W; q.w0 = w0 + l * C; q.a0 = a0 + l * C; q.v0 = v0;
              const bf16_t* lw = (const bf16_t*)(ws + WS_LORA + l * LORA_LAYER); q.W2T = lw; q.A2T = lw + 512 * 64; q.G2T = lw + 2 * 512 * 64; q.V1T = (const bf16_t*)(ws + WS_V1T); q.V2T = (const bf16_t*)(ws + WS_V2T);
              q.vfirst = VF; q.R = scr - moff; q.K = scr + 64 * C - moff; q.A = scr + 2 * 64 * C - moff; q.LD = scr + 3 * 64 * C - moff; q.V = p.V; q.G = p.G; q.layer = l;
              prep_tile(q, lds, tile, OTID());
              asm volatile("s_waitcnt vmcnt(0)" ::: "memory"); __syncthreads();
              if (threadIdx.x == 0) { __builtin_amdgcn_fence(__ATOMIC_ACQUIRE, "agent"); asm volatile("s_waitcnt vmcnt(0)" ::: "memory"); }
              __syncthreads();
              s.R = q.R; s.K = q.K; s.A = q.A; s.LD = q.LD;
              const int bb = tile >> 6, chunk = tile & 63;
              for (int hh = 0; hh < NH; ++hh) { const int unit = ((bb * NH + hh) << 6) + chunk; CkRaw ra; ck_load(s, ra, unit, OTID()); ck_precompute(s, ra, lds, GQ, CQ, unit, OTID()); } } }
        GRID_SYNC();
        for (int item = (int)((blockIdx.x & 7) * (G >> 3) + (blockIdx.x >> 3)); item < BATCH * NH * 4; item += G) ck_sequential(s, lds, GQ, CQ, item, OTID());
        GRID_SYNC();
        { const int tid = OTID(), lane = tid & 63, gw = blockIdx.x * 8 + (tid >> 6); for (int m0 = 2 * gw; m0 < M; m0 += 2 * NGW) scan_post_rows(s, m0, lane); }
        GRID_SYNC();
        { pg8::Gemm g{MIX, WoutT, M, D, D}; pg8::StaticOrder S; S.init(M, D, G, (int)blockIdx.x); pg8::EpiResid E{XB, ss2};
          pg8::gemm_phase<pg8::EpiResid, pg8::StaticOrder, true, true>(LDSP, g, S, E); }
        GRID_SYNC();
        { pg8::Gemm g{XB, WguT, M, 2 * FF, D}; pg8::StaticOrder S; S.init(M, 2 * FF, G, (int)blockIdx.x);
          pg8::EpiConvGlu E{HID, ss2, conv_w + (size_t)l * 3 * FF, conv_b + (size_t)l * FF, (float*)(ws + WS_UTMP), (PG8_LAS float*)(LDSP + XCH_OFF), FF};
          pg8::gemm_phase<pg8::EpiConvGlu, pg8::StaticOrder, true, true>(LDSP, g, S, E); }
        GRID_SYNC();
        { pg8::Gemm g{HID, WdT, M, D, FF}; pg8::StaticOrder S; S.init(M, D, G, (int)blockIdx.x); pg8::EpiResid E{XB, ss3};
          { pg8::Unit u; for (int i = 0; S.next(i, u); ++i) ffn_fixup((const float*)(ws + WS_UTMP), conv_w + (size_t)l * 3 * FF, conv_b + (size_t)l * FF, HID, u.pm, OTID());
            asm volatile("s_waitcnt vmcnt(0)" ::: "memory"); __syncthreads(); }
          pg8::gemm_phase<pg8::EpiResid, pg8::StaticOrder, true, true>(LDSP, g, S, E); }
        GRID_SYNC();
    }
    { const int tid = OTID(), lane = tid & 63, gw = blockIdx.x * 8 + (tid >> 6);
    const f32x4 fg0 = ((const f32x4*)final_g)[2 * lane], fg1 = ((const f32x4*)final_g)[2 * lane + 1], fg2 = ((const f32x4*)final_g)[128 + 2 * lane], fg3 = ((const f32x4*)final_g)[128 + 2 * lane + 1];
    const ssq_t* ssf = ss + (size_t)4 * M;
    for (int m = 4 * gw; m < M; m += 4 * NGW) {
        bf16x8 xv[4][2]; float rs[4];
#pragma unroll
        for (int u = 0; u < 4; ++u) { xv[u][0] = ((const bf16x8*)(XB + (size_t)(m + u) * D))[lane]; xv[u][1] = ((const bf16x8*)(XB + (size_t)(m + u) * D))[64 + lane]; rs[u] = rsqrtf(ssq_val(ssf[m + u]) * (1.f / D) + RMS_EPS); }
#pragma unroll
        for (int u = 0; u < 4; ++u) { f32x4* orow = (f32x4*)(X + (size_t)(m + u) * D) + 2 * lane;
            orow[0] = bfx4_lo(xv[u][0]) * fg0 * rs[u]; orow[1] = bfx4_hi(xv[u][0]) * fg1 * rs[u]; orow[128] = bfx4_lo(xv[u][1]) * fg2 * rs[u]; orow[129] = bfx4_hi(xv[u][1]) * fg3 * rs[u]; } } }
}

extern "C" void kernel_launch(void* const* d_in, const int* in_sizes, int n_in, void* d_out, int out_size, void* d_ws, size_t ws_size, hipStream_t stream) {
    static int grid = 0;
    if (grid == 0) {
        if (n_in != 26 || in_sizes[0] != M * D || out_size != M * D || ws_size < WS_END) { fprintf(stderr, "kernel_launch: unexpected shapes (n_in %d, ws %zu)\n", n_in, ws_size); grid = -1; return; }
        int dev = 0, cus = 0, per_cu = 0;
        if (hipGetDevice(&dev) != hipSuccess || hipDeviceGetAttribute(&cus, hipDeviceAttributeMultiprocessorCount, dev) != hipSuccess) { grid = -1; return; }
        if (hipFuncSetAttribute((const void*)mega_fwd, hipFuncAttributeMaxDynamicSharedMemorySize, LDS_BYTES) != hipSuccess) { fprintf(stderr, "kernel_launch: hipFuncSetAttribute failed\n"); grid = -1; return; }
        if (hipOccupancyMaxActiveBlocksPerMultiprocessor(&per_cu, (const void*)mega_fwd, NTHREADS, LDS_BYTES) != hipSuccess || per_cu < 1) { fprintf(stderr, "kernel_launch: occupancy query failed (%d)\n", per_cu); grid = -1; return; }
        grid = cus;
    }
    if (grid < 0) return;
    (void)hipMemsetAsync((unsigned char*)d_ws + WS_CTL, 0, CTL_BYTES, stream);
    Args a{};
    for (int i = 0; i < 26; ++i) a.in[i] = (const float*)d_in[i];
    a.out = (float*)d_out; a.ws = (unsigned char*)d_ws;
    void* kargs[] = {&a};
    hipError_t e = hipLaunchCooperativeKernel((const void*)mega_fwd, dim3(grid), dim3(NTHREADS), kargs, LDS_BYTES, stream);
    if (e != hipSuccess) fprintf(stderr, "kernel_launch: cooperative launch failed: %s (grid %d)\n", hipGetErrorString(e), grid);
}
```

```cpp
#include <hip/hip_runtime.h>
#include <cstdio>
#include <cstdint>

typedef unsigned short bf16_t;
typedef short bf16x8 __attribute__((ext_vector_type(8)));
typedef float f32x4 __attribute__((ext_vector_type(4)));

constexpr int BATCH = 8, SEQ = 4096, D = 1024, M = BATCH * SEQ;
constexpr int HD = 64, ATT_W = 512, KV_W = 128, C = 512, NH = 8;
constexpr int ATT_IN = 768, SHIFT_W = 1792, IN_W = 2560, FF = 2816;
constexpr int WINDOW = 128;
constexpr float RMS_EPS = 1e-5f, LNX_EPS = 64e-5f;

constexpr size_t MiB = 1u << 20;
constexpr size_t WS_CTL = 0;
typedef unsigned long long ssq_t;
__device__ __forceinline__ ssq_t ssq_fix(float s) { return (ssq_t)(s * 1048576.0f + 0.5f); }
__device__ __forceinline__ float ssq_val(ssq_t v) { return (float)v * (1.0f / 1048576.0f); }
constexpr size_t WS_SS = 0;
constexpr size_t CTL_BYTES = 2 * MiB;
constexpr size_t WS_FCNT = 1792 * 1024;
constexpr size_t WS_BAR = 1536 * 1024;
constexpr size_t WS_W = 2 * MiB;
constexpr size_t W_IN_SZ = (size_t)IN_W * D * 2, W_OUT_SZ = (size_t)D * D * 2, W_GU_SZ = (size_t)2 * FF * D * 2, W_DN_SZ = (size_t)D * FF * 2;
constexpr size_t W_LAYER = W_IN_SZ + W_OUT_SZ + W_GU_SZ + W_DN_SZ;
constexpr size_t WS_VFIRST = 52 * MiB, WS_MIX = 84 * MiB, WS_XB = 148 * MiB, WS_PROJ = 212 * MiB;
constexpr size_t WS_SI_R = 148 * MiB, WS_SI_K = 180 * MiB, WS_SI_V = 372 * MiB, WS_SI_A = 404 * MiB, WS_SI_LD = 436 * MiB, WS_SI_G = 468 * MiB;
constexpr size_t WS_HID = 212 * MiB;
constexpr size_t WS_UTMP = 84 * MiB;
constexpr size_t WS_END = 500 * MiB;
static_assert(WS_W + 2 * W_LAYER <= WS_VFIRST, "weights fit");

__device__ __forceinline__ unsigned f2bf(float f) { unsigned u = __builtin_bit_cast(unsigned, f); return (u + 0x7fffu + ((u >> 16) & 1u)) >> 16; }
__device__ __forceinline__ float bf2f(bf16_t h) { return __builtin_bit_cast(float, (unsigned)h << 16); }
__device__ __forceinline__ float wave_sum(float v) {
#pragma unroll
    for (int o = 1; o < 64; o <<= 1) v += __shfl_xor(v, o);
    return v;
}
#define LDS_BARRIER() do { asm volatile("s_waitcnt lgkmcnt(0)" ::: "memory"); __builtin_amdgcn_s_barrier(); asm volatile("" ::: "memory"); } while (0)
__device__ __forceinline__ float sigmoidf_(float x) { return __builtin_amdgcn_rcpf(1.f + __expf(-x)); }

namespace pg8 {
#define PG8_LAS __attribute__((address_space(3)))
typedef unsigned short bf16_t;
typedef short bf16x8 __attribute__((ext_vector_type(8)));
typedef float f32x4 __attribute__((ext_vector_type(4)));
typedef unsigned u32x4 __attribute__((ext_vector_type(4)));
constexpr int BM = 256, BK = 64, HALF = 128, HTB = HALF * BK * 2  , STAGE_BYTES = 8 * HTB, NXCD = 8, WGM = 8;

__host__ __device__ __forceinline__ int lds_byte(int r, int c) { const int st = (r >> 4) * 2 + (c >> 5), rr = r & 15, cc = c & 31, ob = rr * 64 + cc * 2; return st * 1024 + (ob ^ (((ob >> 9) & 1) << 5)); }
__host__ __device__ __forceinline__ void stage_rc(int b, int& R, int& C) { const int st = b / 1024, sb = b % 1024, swz = sb ^ (((sb >> 9) & 1) << 5); R = (st >> 1) * 16 + swz / 64; C = (st & 1) * 32 + (swz % 64) / 2; }
__host__ __device__ __forceinline__ int perm32(int rho) { const int n = rho >> 4, i = rho & 15; return 8 * (i >> 2) + 4 * n + (i & 3); }

struct Unit { int pm, pn; };
struct Gemm { const bf16_t* A; const bf16_t* Bt; int M, N, K; };

struct StaticOrder {
    int nM, nN, nwg, G, c;
    __host__ __device__ void init(int M, int N, int G_, int c_) { nM = M / BM; nN = N / BM; nwg = nM * nN; G = G_; c = c_; }
    __host__ __device__ bool next(int i, Unit& u) const {
        const long L = (long)i * G + c; if (L >= nwg) return false;
        int wgid = (int)L; { const int q = nwg / NXCD, r = nwg % NXCD, xcd = wgid % NXCD, off = wgid / NXCD; wgid = (xcd < r ? xcd * (q + 1) : r * (q + 1) + (xcd - r) * q) + off; }
        const int nig = WGM * nN, gid = wgid / nig, fm = gid * WGM, gsz = (nM - fm) < WGM ? (nM - fm) : WGM;
        u.pm = fm + ((wgid % nig) % gsz); u.pn = (wgid % nig) / gsz; return true;
    }
    __device__ __forceinline__ void a_ready(const Unit&) const {}
    __device__ __forceinline__ void done(const Unit&) const {}
};
typedef float f32x2_t_ __attribute__((ext_vector_type(2))); typedef __bf16 bf16x2_t_ __attribute__((ext_vector_type(2)));
__device__ __forceinline__ unsigned cvt_pk_bf16(float lo, float hi) { const f32x2_t_ v = {lo, hi}; const bf16x2_t_ b = __builtin_convertvector(v, bf16x2_t_); return __builtin_bit_cast(unsigned, b); }
typedef float f32x2 __attribute__((ext_vector_type(2)));
template <class Epi, class Sched, bool ALIGN_EPI = false, bool SP2 = false>
__device__ __forceinline__ void gemm_phase(PG8_LAS unsigned char* lds, const Gemm g, const Sched& S, const Epi& E) {
    int tid_ = threadIdx.x; asm volatile("" : "+v"(tid_));
    const int tid = tid_, wid = __builtin_amdgcn_readfirstlane(tid >> 6), lane = tid & 63, wr = wid >> 2, wc = wid & 3, fr = lane & 15, fq = lane >> 4;
    const int K = g.K, nt = K / BK;
    unsigned voffA[2], voffB[2];
#pragma unroll
    for (int i = 0; i < 2; ++i) { int R, C; stage_rc(tid * 16 + i * 8192, R, C); const int Rb = (R >> 5) * 64 + (Epi::PERM ? perm32(R & 31) : (R & 31));
        voffA[i] = (unsigned)(R * K + C) * 2u; voffB[i] = (unsigned)(Rb * K + C) * 2u; }
    const size_t kstep = (size_t)(BK * 2);
    const size_t hstep = (size_t)HALF * K * 2;
    const size_t tstep = 2 * hstep;
    const size_t hstepB = (size_t)32 * K * 2;
    const unsigned ldsw = (unsigned)wid * 1024u;
    const int aoff = lds_byte(wr * 64 + fr, fq * 8), boff = lds_byte(wc * 32 + fr, fq * 8);
#define PG8_SA(b, h) (((b) * 2 + (h)) * HTB)
#define PG8_SB(b, h) ((4 + (b) * 2 + (h)) * HTB)
#define PG8_STAGE(bufoff, gbase, voff) do { _Pragma("unroll") for (int _i = 0; _i < 2; ++_i) \
        __builtin_amdgcn_global_load_lds((const unsigned*)((const char*)(gbase) + (voff)[_i]), (PG8_LAS unsigned*)(lds + (bufoff) + ldsw + _i * 8192), 16, 0, 0); } while (0)
#define PG8_LDA(dst, b, h) do { _Pragma("unroll") for (int m = 0; m < 4; ++m) _Pragma("unroll") for (int k = 0; k < 2; ++k) dst[m][k] = *(const PG8_LAS bf16x8*)(lds + PG8_SA(b, h) + aoff + m * 2048 + k * 1024); } while (0)
#define PG8_LDB(dst, b, h) do { _Pragma("unroll") for (int n = 0; n < 2; ++n) _Pragma("unroll") for (int k = 0; k < 2; ++k) dst[n][k] = *(const PG8_LAS bf16x8*)(lds + PG8_SB(b, h) + boff + n * 2048 + k * 1024); } while (0)
#define PG8_MMA(ai, bj, At, Bt) do { __builtin_amdgcn_s_setprio(1); _Pragma("unroll") for (int m = 0; m < 4; ++m) _Pragma("unroll") for (int n = 0; n < 2; ++n) _Pragma("unroll") for (int k = 0; k < 2; ++k) \
        acc[ai][bj][m][n] = __builtin_amdgcn_mfma_f32_16x16x32_bf16(Bt[n][k], At[m][k], acc[ai][bj][m][n], 0, 0, 0); __builtin_amdgcn_s_setprio(0); } while (0)
#define PG8_WAIT_V(n) asm volatile("s_waitcnt vmcnt(" #n ")" ::: "memory")
#define PG8_WAIT_L(n) asm volatile("s_waitcnt lgkmcnt(" #n ")" ::: "memory")
#define PG8_BAR __builtin_amdgcn_s_barrier()
#define PG8_SCHED __builtin_amdgcn_sched_barrier(0)
    Unit cur, nxt; int ui = 0;
    if (!S.next(0, cur)) return;
    f32x4 acc[2][2][4][2];
#pragma unroll
    for (int a = 0; a < 2; ++a)
#pragma unroll
        for (int b = 0; b < 2; ++b)
#pragma unroll
            for (int m = 0; m < 4; ++m)
#pragma unroll
                for (int n = 0; n < 2; ++n) acc[a][b][m][n] = (f32x4){0.f, 0.f, 0.f, 0.f};
    bf16x8 At[4][2], B0[2][2], B1[2][2];
    const char* cA = (const char*)g.A + (size_t)cur.pm * tstep; const char* cB = (const char*)g.Bt + (size_t)cur.pn * tstep;
    S.a_ready(cur);
    if constexpr (SP2) {
        PG8_STAGE(PG8_SB(0, 0), cB, voffB); PG8_STAGE(PG8_SB(0, 1), cB + hstepB, voffB); PG8_STAGE(PG8_SA(0, 0), cA, voffA); PG8_STAGE(PG8_SA(0, 1), cA + hstep, voffA);
        if (wr == 1) PG8_BAR;
        PG8_WAIT_V(2); PG8_BAR;
        PG8_STAGE(PG8_SB(1, 0), cB + kstep, voffB); PG8_STAGE(PG8_SA(1, 0), cA + kstep, voffA); PG8_STAGE(PG8_SB(1, 1), cB + hstepB + kstep, voffB);
        PG8_WAIT_V(6); PG8_BAR;
    } else {
        PG8_STAGE(PG8_SB(0, 0), cB, voffB); PG8_STAGE(PG8_SA(0, 0), cA, voffA); PG8_STAGE(PG8_SB(0, 1), cB + hstepB, voffB); PG8_STAGE(PG8_SA(0, 1), cA + hstep, voffA);
        if (wr == 1) PG8_BAR;
        PG8_WAIT_V(4); PG8_BAR;
        PG8_STAGE(PG8_SB(1, 0), cB + kstep, voffB); PG8_STAGE(PG8_SA(1, 0), cA + kstep, voffA); PG8_STAGE(PG8_SB(1, 1), cB + hstepB + kstep, voffB);
        PG8_WAIT_V(6); PG8_BAR;
    }
    for (;;) {
        const bool has_next = S.next(ui + 1, nxt);
        const char* nA = has_next ? (const char*)g.A + (size_t)nxt.pm * tstep : cA; const char* nB = has_next ? (const char*)g.Bt + (size_t)nxt.pn * tstep : cB;
        for (int t = 0; t < nt; t += 2) {
            const bool last = (t == nt - 2);
            const char* a1 = cA + (size_t)(t + 1) * kstep;
            const char* a2 = last ? nA : cA + (size_t)(t + 2) * kstep; const char* b2 = last ? nB : cB + (size_t)(t + 2) * kstep;
            const char* a3 = a2 + kstep; const char* b3 = b2 + kstep;
            if (last && has_next) S.a_ready(nxt);
            if constexpr (SP2) {
            PG8_LDB(B0, 0, 0); PG8_LDB(B1, 0, 1); PG8_SCHED; PG8_LDA(At, 0, 0); PG8_STAGE(PG8_SA(1, 1), a1 + hstep, voffA);
            PG8_WAIT_V(8); PG8_WAIT_L(0); PG8_BAR; PG8_MMA(0, 0, At, B0); PG8_MMA(0, 1, At, B1); PG8_BAR; PG8_SCHED;
            PG8_LDA(At, 0, 1); PG8_STAGE(PG8_SB(0, 0), b2, voffB); PG8_STAGE(PG8_SB(0, 1), b2 + hstepB, voffB); PG8_STAGE(PG8_SA(0, 0), a2, voffA);
            PG8_WAIT_V(8); PG8_WAIT_L(0); PG8_BAR; PG8_MMA(1, 0, At, B0); PG8_MMA(1, 1, At, B1); PG8_BAR; PG8_SCHED;
            PG8_LDB(B0, 1, 0); PG8_LDB(B1, 1, 1); PG8_SCHED; PG8_LDA(At, 1, 0); PG8_STAGE(PG8_SA(0, 1), a2 + hstep, voffA);
            PG8_WAIT_V(8); PG8_WAIT_L(0); PG8_BAR; PG8_MMA(0, 0, At, B0); PG8_MMA(0, 1, At, B1); PG8_BAR; PG8_SCHED;
            PG8_LDA(At, 1, 1); PG8_STAGE(PG8_SB(1, 0), b3, voffB); PG8_STAGE(PG8_SB(1, 1), b3 + hstepB, voffB); PG8_STAGE(PG8_SA(1, 0), a3, voffA);
            PG8_WAIT_V(8); PG8_WAIT_L(0); PG8_BAR; PG8_MMA(1, 0, At, B0); PG8_MMA(1, 1, At, B1); PG8_BAR; PG8_SCHED;
            } else {
            PG8_LDB(B0, 0, 0); PG8_SCHED; PG8_LDA(At, 0, 0); PG8_STAGE(PG8_SA(1, 1), a1 + hstep, voffA);
            PG8_WAIT_L(8); PG8_BAR; PG8_WAIT_L(0); PG8_MMA(0, 0, At, B0); PG8_BAR; PG8_SCHED;
            PG8_LDB(B1, 0, 1); PG8_STAGE(PG8_SB(0, 0), b2, voffB);
            PG8_BAR; PG8_WAIT_L(0); PG8_MMA(0, 1, At, B1); PG8_BAR;
            PG8_LDA(At, 0, 1); PG8_STAGE(PG8_SA(0, 0), a2, voffA);
            PG8_BAR; PG8_WAIT_L(0); PG8_MMA(1, 0, At, B0); PG8_BAR; PG8_SCHED;
            PG8_STAGE(PG8_SB(0, 1), b2 + hstepB, voffB);
            PG8_WAIT_V(6); PG8_BAR; PG8_MMA(1, 1, At, B1); PG8_BAR;
            PG8_LDB(B0, 1, 0); PG8_SCHED; PG8_LDA(At, 1, 0); PG8_STAGE(PG8_SA(0, 1), a2 + hstep, voffA);
            PG8_WAIT_L(8); PG8_BAR; PG8_WAIT_L(0); PG8_MMA(0, 0, At, B0); PG8_BAR; PG8_SCHED;
            PG8_LDB(B1, 1, 1); PG8_STAGE(PG8_SB(1, 0), b3, voffB);
            PG8_BAR; PG8_WAIT_L(0); PG8_MMA(0, 1, At, B1); PG8_BAR;
            PG8_LDA(At, 1, 1); PG8_STAGE(PG8_SA(1, 0), a3, voffA);
            PG8_BAR; PG8_WAIT_L(0); PG8_MMA(1, 0, At, B0); PG8_BAR; PG8_SCHED;
            PG8_STAGE(PG8_SB(1, 1), b3 + hstepB, voffB);
            PG8_WAIT_V(6); PG8_BAR; PG8_MMA(1, 1, At, B1); PG8_BAR;
            }
        }
        if constexpr (ALIGN_EPI) { if (wr == 0) PG8_BAR; }
        if constexpr (!Epi::AFTER_DRAIN) { E(acc, cur, wr, wc, fr, fq); S.done(cur); }
        if (!has_next) break;
#pragma unroll
        for (int a = 0; a < 2; ++a)
#pragma unroll
            for (int b = 0; b < 2; ++b)
#pragma unroll
                for (int m = 0; m < 4; ++m)
#pragma unroll
                    for (int n = 0; n < 2; ++n) acc[a][b][m][n] = (f32x4){0.f, 0.f, 0.f, 0.f};
        cur = nxt; cA = nA; cB = nB; ++ui;
        if constexpr (ALIGN_EPI) { if (wr == 1) PG8_BAR; }
    }
    PG8_WAIT_V(0);
    if constexpr (!ALIGN_EPI) { if (wr == 0) PG8_BAR; }
    PG8_BAR;
    if constexpr (Epi::AFTER_DRAIN) { E.fused(acc, cur, wr, wc, fr, fq, lds, wid, lane); S.done(cur); }
#undef PG8_SA
#undef PG8_SB
#undef PG8_STAGE
#undef PG8_LDA
#undef PG8_LDB
#undef PG8_MMA
#undef PG8_WAIT_V
#undef PG8_WAIT_L
#undef PG8_BAR
#undef PG8_SCHED
}

constexpr int DM_ = 1024; constexpr float RMS_EPS_ = 1e-5f;
typedef unsigned long long ssq_t;
struct EpiScaleBf16 {
    static constexpr bool PERM = true, AFTER_DRAIN = false;
    bf16_t* O; int ldc; const ssq_t* ss;
    __device__ __forceinline__ void operator()(const f32x4 (&acc)[2][2][4][2], const Unit& u, int wr, int wc, int fr, int fq) const {
        const int row0 = u.pm * BM + wr * 64 + fr, col0 = u.pn * BM + wc * 64 + 8 * fq;
        float rsv[2][4];
#pragma unroll
        for (int ai = 0; ai < 2; ++ai)
#pragma unroll
            for (int m = 0; m < 4; ++m) rsv[ai][m] = (float)ss[row0 + ai * HALF + m * 16] * (1.0f / 1048576.0f);
#pragma unroll
        for (int ai = 0; ai < 2; ++ai)
#pragma unroll
            for (int m = 0; m < 4; ++m) { const int row = row0 + ai * HALF + m * 16; const float rs = __builtin_amdgcn_rsqf(rsv[ai][m] * (1.0f / DM_) + RMS_EPS_); bf16_t* rowp = O + (size_t)row * ldc + col0;
#pragma unroll
                for (int bj = 0; bj < 2; ++bj) { const f32x4 v0 = acc[ai][bj][m][0] * rs, v1 = acc[ai][bj][m][1] * rs;
                    u32x4 w; w.x = cvt_pk_bf16(v0[0], v0[1]); w.y = cvt_pk_bf16(v0[2], v0[3]); w.z = cvt_pk_bf16(v1[0], v1[1]); w.w = cvt_pk_bf16(v1[2], v1[3]);
                    *(u32x4*)(rowp + bj * 32) = w; } }
    }
};
struct EpiResid {
    static constexpr bool PERM = true, AFTER_DRAIN = false;
    bf16_t* xb; ssq_t* ss_out;
    __device__ __forceinline__ void operator()(const f32x4 (&acc)[2][2][4][2], const Unit& u, int wr, int wc, int fr, int fq) const {
        const int row0 = u.pm * BM + wr * 64 + fr, col0 = u.pn * BM + wc * 64 + 8 * fq;
#pragma unroll
        for (int ai = 0; ai < 2; ++ai) {
            u32x4 bs[4][2];
#pragma unroll
            for (int m = 0; m < 4; ++m)
#pragma unroll
                for (int bj = 0; bj < 2; ++bj) bs[m][bj] = *(const u32x4*)(xb + (size_t)(row0 + ai * HALF + m * 16) * DM_ + col0 + bj * 32);
#pragma unroll
            for (int m = 0; m < 4; ++m) { const int row = row0 + ai * HALF + m * 16; bf16_t* rp = xb + (size_t)row * DM_ + col0; float sq = 0.f;
#pragma unroll
                for (int bj = 0; bj < 2; ++bj) { const u32x4 b = bs[m][bj]; u32x4 w;
#pragma unroll
                    for (int hh = 0; hh < 2; ++hh) { const unsigned b0 = hh == 0 ? b.x : b.z, b1 = hh == 0 ? b.y : b.w; const f32x4 a4 = acc[ai][bj][m][hh];
                        const float x0 = __builtin_bit_cast(float, b0 << 16) + a4[0], x1 = __builtin_bit_cast(float, b0 & 0xffff0000u) + a4[1], x2 = __builtin_bit_cast(float, b1 << 16) + a4[2], x3 = __builtin_bit_cast(float, b1 & 0xffff0000u) + a4[3];
                        const unsigned w0 = cvt_pk_bf16(x0, x1), w1 = cvt_pk_bf16(x2, x3);
                        if (hh == 0) { w.x = w0; w.y = w1; } else { w.z = w0; w.w = w1; }
                        const float r0 = __builtin_bit_cast(float, w0 << 16), r1 = __builtin_bit_cast(float, w0 & 0xffff0000u), r2 = __builtin_bit_cast(float, w1 << 16), r3 = __builtin_bit_cast(float, w1 & 0xffff0000u);
                        sq += (r0 * r0 + r1 * r1) + (r2 * r2 + r3 * r3); }
                    *(u32x4*)(rp + bj * 32) = w; }
                sq += __shfl_xor(sq, 16); sq += __shfl_xor(sq, 32);
                if (fq == 0) atomicAdd(ss_out + row, (ssq_t)(sq * 1048576.0f + 0.5f)); }
        }
    }
};
struct EpiResidFinal {
    static constexpr bool PERM = true, AFTER_DRAIN = false;
    const bf16_t* xb; ssq_t* ss_out; unsigned* cnt; const float* g; float* out;
    __device__ __forceinline__ void operator()(f32x4 (&acc)[2][2][4][2], const Unit& u, int wr, int wc, int fr, int fq) const {
        const int row0 = u.pm * BM + wr * 64 + fr, col0 = u.pn * BM + wc * 64 + 8 * fq;
#pragma unroll
        for (int ai = 0; ai < 2; ++ai) {
            u32x4 bs[4][2];
#pragma unroll
            for (int m = 0; m < 4; ++m)
#pragma unroll
                for (int bj = 0; bj < 2; ++bj) bs[m][bj] = *(const u32x4*)(xb + (size_t)(row0 + ai * HALF + m * 16) * DM_ + col0 + bj * 32);
#pragma unroll
            for (int m = 0; m < 4; ++m) { const int row = row0 + ai * HALF + m * 16; float sq = 0.f;
#pragma unroll
                for (int bj = 0; bj < 2; ++bj) { const u32x4 b = bs[m][bj];
#pragma unroll
                    for (int hh = 0; hh < 2; ++hh) { const unsigned b0 = hh == 0 ? b.x : b.z, b1 = hh == 0 ? b.y : b.w; const f32x4 a4 = acc[ai][bj][m][hh];
                        const float x0 = __builtin_bit_cast(float, b0 << 16) + a4[0], x1 = __builtin_bit_cast(float, b0 & 0xffff0000u) + a4[1], x2 = __builtin_bit_cast(float, b1 << 16) + a4[2], x3 = __builtin_bit_cast(float, b1 & 0xffff0000u) + a4[3];
                        const unsigned w0 = cvt_pk_bf16(x0, x1), w1 = cvt_pk_bf16(x2, x3);
                        const float r0 = __builtin_bit_cast(float, w0 << 16), r1 = __builtin_bit_cast(float, w0 & 0xffff0000u), r2 = __builtin_bit_cast(float, w1 << 16), r3 = __builtin_bit_cast(float, w1 & 0xffff0000u);
                        acc[ai][bj][m][hh] = (f32x4){r0, r1, r2, r3};
                        sq += (r0 * r0 + r1 * r1) + (r2 * r2 + r3 * r3); } }
                sq += __shfl_xor(sq, 16); sq += __shfl_xor(sq, 32);
                if (fq == 0) atomicAdd(ss_out + row, (ssq_t)(sq * 1048576.0f + 0.5f)); }
        }
        asm volatile("s_waitcnt vmcnt(0)" ::: "memory"); __builtin_amdgcn_s_barrier(); asm volatile("" ::: "memory");
        if (wr == 0 && wc == 0 && fr == 0 && fq == 0) {
            (void)__hip_atomic_fetch_add(cnt + u.pm, 1u, __ATOMIC_RELAXED, __HIP_MEMORY_SCOPE_AGENT);
            for (unsigned sp = 0; __hip_atomic_load(cnt + u.pm, __ATOMIC_RELAXED, __HIP_MEMORY_SCOPE_AGENT) < 4u && sp < (1u << 22); ++sp) __builtin_amdgcn_s_sleep(2);
        }
        asm volatile("s_waitcnt vmcnt(0)" ::: "memory"); __builtin_amdgcn_s_barrier(); asm volatile("" ::: "memory");
        f32x4 gv[2][2];
#pragma unroll
        for (int bj = 0; bj < 2; ++bj)
#pragma unroll
            for (int hh = 0; hh < 2; ++hh) gv[bj][hh] = *(const f32x4*)(g + col0 + bj * 32 + 4 * hh);
#pragma unroll
        for (int ai = 0; ai < 2; ++ai)
#pragma unroll
            for (int m = 0; m < 4; ++m) { const int row = row0 + ai * HALF + m * 16;
                const ssq_t sv = __hip_atomic_load(ss_out + row, __ATOMIC_RELAXED, __HIP_MEMORY_SCOPE_AGENT);
                const float rs = __builtin_amdgcn_rsqf((float)sv * (1.0f / 1048576.0f) * (1.0f / DM_) + RMS_EPS_); float* op = out + (size_t)row * DM_ + col0;
#pragma unroll
                for (int bj = 0; bj < 2; ++bj)
#pragma unroll
                    for (int hh = 0; hh < 2; ++hh) *(f32x4*)(op + bj * 32 + 4 * hh) = acc[ai][bj][m][hh] * gv[bj][hh] * rs; }
    }
};
template <int CTRL> __device__ __forceinline__ float dpp1(float x) { return __builtin_bit_cast(float, __builtin_amdgcn_update_dpp(0, __builtin_bit_cast(int, x), CTRL, 0xF, 0xF, true)); }
template <int CTRL> __device__ __forceinline__ f32x4 dpp4(const f32x4 x) { return (f32x4){dpp1<CTRL>(x.x), dpp1<CTRL>(x.y), dpp1<CTRL>(x.z), dpp1<CTRL>(x.w)}; }
struct EpiConvGlu {
    static constexpr bool PERM = true, AFTER_DRAIN = false;
    bf16_t* HID; const ssq_t* ss; const float* cw; const float* cb; float* SB; PG8_LAS float* xch; int ff;
    __device__ __forceinline__ void operator()(const f32x4 (&acc)[2][2][4][2], const Unit& u, int wr, int wc, int fr, int fq) const {
        const int row0 = u.pm * BM + wr * 64 + fr, cl = wc * 32 + 8 * fq, jcol = u.pn * HALF + cl;
        float rs[2][4];
#pragma unroll
        for (int ai = 0; ai < 2; ++ai)
#pragma unroll
            for (int m = 0; m < 4; ++m) rs[ai][m] = (float)ss[row0 + ai * HALF + m * 16] * (1.0f / 1048576.0f);
        f32x4 w0[2], w1[2], w2[2], bb[2];
#pragma unroll
        for (int n = 0; n < 2; ++n) { w0[n] = *(const f32x4*)(cw + jcol + 4 * n); w1[n] = *(const f32x4*)(cw + ff + jcol + 4 * n); w2[n] = *(const f32x4*)(cw + 2 * ff + jcol + 4 * n); bb[n] = *(const f32x4*)(cb + jcol + 4 * n); }
#pragma unroll
        for (int ai = 0; ai < 2; ++ai)
#pragma unroll
            for (int m = 0; m < 4; ++m) rs[ai][m] = __builtin_amdgcn_rsqf(rs[ai][m] * (1.0f / DM_) + RMS_EPS_);
        if (fr >= 14) {
#pragma unroll
            for (int ai = 0; ai < 2; ++ai)
#pragma unroll
                for (int n = 0; n < 2; ++n) *(PG8_LAS f32x4*)(xch + ((2 * ai + wr) * 2 + (fr - 14)) * HALF + cl + 4 * n) = acc[ai][0][3][n] * rs[ai][3];
        }
        asm volatile("s_waitcnt lgkmcnt(0)" ::: "memory"); __builtin_amdgcn_s_barrier(); asm volatile("" ::: "memory");
        float* sbp = SB + (size_t)u.pm * 6 * ff + jcol;
#pragma unroll
        for (int ai = 0; ai < 2; ++ai) {
            const int q = 2 * ai + wr;
            f32x4 X[2];
#pragma unroll
            for (int n = 0; n < 2; ++n) { X[n] = (f32x4){0.f, 0.f, 0.f, 0.f}; if (q > 0 && fr >= 14) X[n] = *(const PG8_LAS f32x4*)(xch + ((q - 1) * 2 + (fr - 14)) * HALF + cl + 4 * n); }
            f32x4 prevg[2] = {X[0], X[1]};
#pragma unroll
            for (int m = 0; m < 4; ++m) { const int row = row0 + ai * HALF + m * 16;
                pg8::u32x4 hw;
#pragma unroll
                for (int n = 0; n < 2; ++n) {
                    const f32x4 cur = acc[ai][0][m][n] * rs[ai][m], up = acc[ai][1][m][n] * rs[ai][m];
                    const f32x4 P = prevg[n]; prevg[n] = cur;
                    f32x4 z1, z2;
#pragma unroll
                    for (int e = 0; e < 4; ++e) { z1[e] = fr == 15 ? P[e] : cur[e]; z2[e] = fr >= 14 ? P[e] : cur[e]; }
                    const f32x4 p1 = dpp4<0x121>(z1), p2 = dpp4<0x122>(z2);
                    const f32x4 c = bb[n] + w0[n] * p2 + w1[n] * p1 + w2[n] * cur;
                    f32x4 hv;
#pragma unroll
                    for (int e = 0; e < 4; ++e) hv[e] = c[e] * __builtin_amdgcn_rcpf(1.f + __expf(-c[e])) * up[e];
                    if (n == 0) { hw.x = cvt_pk_bf16(hv[0], hv[1]); hw.y = cvt_pk_bf16(hv[2], hv[3]); } else { hw.z = cvt_pk_bf16(hv[0], hv[1]); hw.w = cvt_pk_bf16(hv[2], hv[3]); }
                    if (q == 0 && m == 0 && fr < 2) { *(f32x4*)(sbp + (size_t)fr * ff + 4 * n) = cur; *(f32x4*)(sbp + (size_t)(2 + fr) * ff + 4 * n) = up; }
                    if (q == 3 && m == 3 && fr >= 14) *(f32x4*)(sbp + (size_t)(4 + fr - 14) * ff + 4 * n) = cur;
                }
                *(pg8::u32x4*)(HID + (size_t)row * ff + jcol) = hw; }
        }
    }
};
}

#define LAS __attribute__((address_space(3)))
__device__ __forceinline__ void transpose_item(const float* __restrict__ W, int K, int N, bf16_t* __restrict__ Wt, const float* __restrict__ g, int mode, float* scr, int item, int lane, bool gcompl = false) {
    const int nblk = N / 32, kb = item / nblk, nb = item % nblk, k0 = 64 * kb, n0 = 32 * nb;
    int np0 = n0; if (mode != 0) np0 = 256 * (n0 / 128) + 64 * ((n0 % 128) / 32) + (mode == 2 ? 32 : 0);
    f32x4 wv[8];
#pragma unroll
    for (int i = 0; i < 8; ++i) wv[i] = *(const f32x4*)(W + (size_t)(k0 + (lane >> 3) + 8 * i) * N + n0 + (lane & 7) * 4);
#pragma unroll
    for (int i = 0; i < 8; ++i) { const int kk = (lane >> 3) + 8 * i; const float gs = g ? (gcompl ? 1.f - g[k0 + kk] : g[k0 + kk]) : 1.f; float* d = scr + kk * 33 + (lane & 7) * 4; d[0] = wv[i].x * gs; d[1] = wv[i].y * gs; d[2] = wv[i].z * gs; d[3] = wv[i].w * gs; }
    __builtin_amdgcn_fence(__ATOMIC_RELEASE, "wavefront"); __builtin_amdgcn_wave_barrier(); __builtin_amdgcn_fence(__ATOMIC_ACQUIRE, "wavefront");
    const int c = lane & 7;
#pragma unroll
    for (int j = 0; j < 4; ++j) { const int n = (lane >> 3) + 8 * j; const float* sp = scr + (8 * c) * 33 + n;
        uint4 o; o.x = f2bf(sp[0]) | (f2bf(sp[33]) << 16); o.y = f2bf(sp[2 * 33]) | (f2bf(sp[3 * 33]) << 16); o.z = f2bf(sp[4 * 33]) | (f2bf(sp[5 * 33]) << 16); o.w = f2bf(sp[6 * 33]) | (f2bf(sp[7 * 33]) << 16);
        *(uint4*)(Wt + (size_t)(np0 + n) * K + k0 + 8 * c) = o; }
    __builtin_amdgcn_fence(__ATOMIC_RELEASE, "wavefront"); __builtin_amdgcn_wave_barrier(); __builtin_amdgcn_fence(__ATOMIC_ACQUIRE, "wavefront");
}
constexpr size_t WS_LORA = 50 * MiB;
constexpr size_t LORA_LAYER = 256 * 1024, WS_V1T = WS_LORA + 2 * LORA_LAYER, WS_V1B = WS_V1T + 32 * 1024, WS_V2T = WS_V1B + 32 * 1024;
constexpr int PR_ACT_LD = 264, PR_VLO_LD = 40, PR_SG_LD = 520, PR_ACT_OFF = 0, PR_VLO_OFF = 64 * PR_ACT_LD * 2, PR_SG_OFF = PR_VLO_OFF + 64 * PR_VLO_LD * 2;
constexpr int PR_STG_OFF = PR_SG_OFF + 64 * PR_SG_LD * 2, PR_STG_WAVE = 16 * 144;
struct Prep2Args {
    const bf16_t* proj; const float* mu; const float* w0; const float* a0; const float* v0;
    const bf16_t *W2T, *A2T, *G2T, *V1T, *V1B, *V2T; bf16_t* vfirst; bf16_t *V, *A, *G; unsigned short* CS; int layer; int pad;
};
__device__ __forceinline__ f32x4 bfx4_lo(const bf16x8 v) { return (f32x4){bf2f((bf16_t)v[0]), bf2f((bf16_t)v[1]), bf2f((bf16_t)v[2]), bf2f((bf16_t)v[3])}; }
__device__ __forceinline__ f32x4 bfx4_hi(const bf16x8 v) { return (f32x4){bf2f((bf16_t)v[4]), bf2f((bf16_t)v[5]), bf2f((bf16_t)v[6]), bf2f((bf16_t)v[7])}; }
__device__ __forceinline__ bf16x8 pack8(const f32x4 a, const f32x4 b) { pg8::u32x4 w; w.x = pg8::cvt_pk_bf16(a[0], a[1]); w.y = pg8::cvt_pk_bf16(a[2], a[3]); w.z = pg8::cvt_pk_bf16(b[0], b[1]); w.w = pg8::cvt_pk_bf16(b[2], b[3]); return __builtin_bit_cast(bf16x8, w); }
template <int CTRL> __device__ __forceinline__ float dpp_mov(float x) { return __builtin_bit_cast(float, __builtin_amdgcn_update_dpp(0, __builtin_bit_cast(int, x), CTRL, 0xF, 0xF, true)); }
__device__ __forceinline__ float reduce16(float x) { x += dpp_mov<0xB1>(x); x += dpp_mov<0x4E>(x); x += dpp_mov<0x141>(x); x += dpp_mov<0x140>(x); return x; }
__device__ __forceinline__ float red8(float x) { x += dpp_mov<0xB1>(x); x += dpp_mov<0x4E>(x); x += dpp_mov<0x141>(x); return x; }
__device__ __forceinline__ float scan16(float x) { x += dpp_mov<0x111>(x); x += dpp_mov<0x112>(x); x += dpp_mov<0x114>(x); x += dpp_mov<0x118>(x); return x; }
constexpr float CS_SCALE = 1638.0f;
__device__ __forceinline__ void shift8(const bf16_t* __restrict__ proj, const float* __restrict__ mu, size_t m, int t, int col, int mi, f32x4& lo, f32x4& hi) {
    const bf16x8 cur = *(const bf16x8*)(proj + m * IN_W + col);
    bf16x8 prv; if (t > 0) prv = *(const bf16x8*)(proj + (m - 1) * IN_W + col); else prv = (bf16x8){0, 0, 0, 0, 0, 0, 0, 0};
    const f32x4 m0 = *(const f32x4*)(mu + mi), m1 = *(const f32x4*)(mu + mi + 4);
    const f32x4 c0 = bfx4_lo(cur), c1 = bfx4_hi(cur), p0 = bfx4_lo(prv), p1 = bfx4_hi(prv);
    lo = c0 + (p0 - c0) * m0; hi = c1 + (p1 - c1) * m1;
}
__device__ __forceinline__ void prep_tile(const Prep2Args& p, unsigned char* lds, int tile, int tid) {
    const int m0 = tile * 64, wave = __builtin_amdgcn_readfirstlane(tid >> 6), lane = tid & 63, fr = lane & 15, fq = lane >> 4;
    bf16_t* ACT = (bf16_t*)(lds + PR_ACT_OFF); bf16_t* VLO = (bf16_t*)(lds + PR_VLO_OFF); bf16_t* SG = (bf16_t*)(lds + PR_SG_OFF);
    { bf16x8 cu[4], pv[4]; f32x4 mu0[4], mu1[4];
#pragma unroll
      for (int it = 0; it < 4; ++it) { const int i = tid + 512 * it, tk = i >> 5, cc = i & 31; const size_t m = (size_t)m0 + tk; const int t = (int)(m % SEQ);
          cu[it] = *(const bf16x8*)(p.proj + m * IN_W + 2304 + 8 * cc); if (t > 0) pv[it] = *(const bf16x8*)(p.proj + (m - 1) * IN_W + 2304 + 8 * cc); else pv[it] = (bf16x8){0, 0, 0, 0, 0, 0, 0, 0};
          mu0[it] = *(const f32x4*)(p.mu + 1536 + 8 * cc); mu1[it] = *(const f32x4*)(p.mu + 1536 + 8 * cc + 4); }
#pragma unroll
      for (int it = 0; it < 4; ++it) { const int i = tid + 512 * it, tk = i >> 5, cc = i & 31;
          const f32x4 c0 = bfx4_lo(cu[it]), c1 = bfx4_hi(cu[it]); f32x4 lo = c0 + (bfx4_lo(pv[it]) - c0) * mu0[it], hi = c1 + (bfx4_hi(pv[it]) - c1) * mu1[it];
          if (cc < 8) {
#pragma unroll
              for (int e = 0; e < 4; ++e) { lo[e] = 2.f * sigmoidf_(2.f * lo[e]) - 1.f; hi[e] = 2.f * sigmoidf_(2.f * hi[e]) - 1.f; } }
          else if (cc >= 16) {
#pragma unroll
              for (int e = 0; e < 4; ++e) { lo[e] = sigmoidf_(lo[e]); hi[e] = sigmoidf_(hi[e]); } }
          *(bf16x8*)(ACT + tk * PR_ACT_LD + 8 * cc) = pack8(lo, hi); } }
    if (p.layer > 0) {
        const int tb = wave >> 1, jb = wave & 1; const size_t m = (size_t)m0 + 16 * tb + fr; const int t = (int)(m % SEQ);
        f32x4 acc = (f32x4){0.f, 0.f, 0.f, 0.f};
#pragma unroll
        for (int bt4 = 0; bt4 < 4; ++bt4) { bf16x8 cu[4], pv[4], wa[4], wb[4];
#pragma unroll
            for (int k4 = 0; k4 < 4; ++k4) { const int ko = 32 * (4 * bt4 + k4) + 8 * fq;
                cu[k4] = *(const bf16x8*)(p.proj + m * IN_W + 1792 + ko); if (t > 0) pv[k4] = *(const bf16x8*)(p.proj + (m - 1) * IN_W + 1792 + ko); else pv[k4] = (bf16x8){0, 0, 0, 0, 0, 0, 0, 0};
                wa[k4] = *(const bf16x8*)(p.V1T + (size_t)(16 * jb + fr) * C + ko); wb[k4] = *(const bf16x8*)(p.V1B + (size_t)(16 * jb + fr) * C + ko); }
#pragma unroll
            for (int k4 = 0; k4 < 4; ++k4) { acc = __builtin_amdgcn_mfma_f32_16x16x32_bf16(wa[k4], cu[k4], acc, 0, 0, 0); acc = __builtin_amdgcn_mfma_f32_16x16x32_bf16(wb[k4], pv[k4], acc, 0, 0, 0); } }
        uint2 w; w.x = pg8::cvt_pk_bf16(acc[0], acc[1]); w.y = pg8::cvt_pk_bf16(acc[2], acc[3]);
        *(uint2*)(VLO + (16 * tb + fr) * PR_VLO_LD + 16 * jb + 4 * fq) = w;
    }
    __syncthreads();
    const int ch0 = 64 * wave;
    if (p.layer > 0) {
        bf16x8 af[4], wf[4]; f32x4 bias[4];
#pragma unroll
        for (int cb = 0; cb < 4; ++cb) { wf[cb] = *(const bf16x8*)(p.V2T + (size_t)(ch0 + 16 * cb + fr) * 32 + 8 * fq); bias[cb] = *(const f32x4*)(p.v0 + ch0 + 16 * cb + 4 * fq); }
#pragma unroll
        for (int tb = 0; tb < 4; ++tb) af[tb] = *(const bf16x8*)(VLO + (16 * tb + fr) * PR_VLO_LD + 8 * fq);
#pragma unroll
        for (int cb = 0; cb < 4; ++cb) { const int ch = ch0 + 16 * cb + 4 * fq;
#pragma unroll
            for (int tb = 0; tb < 4; ++tb) { f32x4 x = __builtin_amdgcn_mfma_f32_16x16x32_bf16(wf[cb], af[tb], (f32x4){0.f, 0.f, 0.f, 0.f}, 0, 0, 0) + bias[cb];
                uint2 w; w.x = pg8::cvt_pk_bf16(sigmoidf_(x[0]), sigmoidf_(x[1])); w.y = pg8::cvt_pk_bf16(sigmoidf_(x[2]), sigmoidf_(x[3]));
                *(uint2*)(SG + (16 * tb + fr) * PR_SG_LD + ch) = w; } }
    }
    {
        f32x4 bw[4], ba[4];
#pragma unroll
        for (int cb = 0; cb < 4; ++cb) { bw[cb] = *(const f32x4*)(p.w0 + ch0 + 16 * cb + 4 * fq); ba[cb] = *(const f32x4*)(p.a0 + ch0 + 16 * cb + 4 * fq); }
        bf16x8 wA[2][4], wB[2][4], wC[4][4];
#define PR_LOADW(wf, WT, KL) _Pragma("unroll") for (int ks = 0; ks < (KL) / 32; ++ks) { _Pragma("unroll") for (int cb = 0; cb < 4; ++cb) wf[ks][cb] = *(const bf16x8*)((WT) + (size_t)(ch0 + 16 * cb + fr) * (KL) + 32 * ks + 8 * fq); }
#define PR_MMA(wf, K0, KL) { _Pragma("unroll") for (int tb = 0; tb < 4; ++tb) { _Pragma("unroll") for (int cb = 0; cb < 4; ++cb) acc[tb][cb] = (f32x4){0.f, 0.f, 0.f, 0.f}; } \
            _Pragma("unroll") for (int ks = 0; ks < (KL) / 32; ++ks) { bf16x8 af[4]; \
                _Pragma("unroll") for (int tb = 0; tb < 4; ++tb) af[tb] = *(const bf16x8*)(ACT + (16 * tb + fr) * PR_ACT_LD + (K0) + 32 * ks + 8 * fq); \
                _Pragma("unroll") for (int tb = 0; tb < 4; ++tb) { _Pragma("unroll") for (int cb = 0; cb < 4; ++cb) acc[tb][cb] = __builtin_amdgcn_mfma_f32_16x16x32_bf16(wf[ks][cb], af[tb], acc[tb][cb], 0, 0, 0); } } }
        f32x4 acc[4][4];
        unsigned char* stg = lds + PR_STG_OFF + wave * PR_STG_WAVE; const int st_w = fr * 144 + 8 * fq, l8 = lane & 7, lr = lane >> 3;
#define PR_WFENCE() { __builtin_amdgcn_fence(__ATOMIC_RELEASE, "wavefront"); __builtin_amdgcn_wave_barrier(); __builtin_amdgcn_fence(__ATOMIC_ACQUIRE, "wavefront"); }
#define PR_FLUSH(OUTP, TB) { PR_WFENCE() _Pragma("unroll") for (int i_ = 0; i_ < 2; ++i_) { const int row_ = lr + 8 * i_; const pg8::u32x4 v_ = *(const pg8::u32x4*)(stg + row_ * 144 + l8 * 16); \
            *(pg8::u32x4*)((OUTP) + ((size_t)m0 + 16 * (TB) + row_) * C + ch0 + l8 * 8) = v_; } PR_WFENCE() }
        PR_LOADW(wA, p.W2T, 64)
        PR_MMA(wA, 0, 64)
        PR_LOADW(wB, p.A2T, 64)
        { f32x4 run[4];
#pragma unroll
          for (int cb = 0; cb < 4; ++cb) run[cb] = (f32x4){0.f, 0.f, 0.f, 0.f};
#pragma unroll
          for (int tb = 0; tb < 4; ++tb) {
#pragma unroll
            for (int cb = 0; cb < 4; ++cb) { f32x4 x = acc[tb][cb] + bw[cb];
#pragma unroll
                for (int e = 0; e < 4; ++e) x[e] = -0.60653065971f * sigmoidf_(x[e]);
                f32x4 s, tot; s.x = scan16(x.x); s.y = scan16(x.y); s.z = scan16(x.z); s.w = scan16(x.w);
                tot.x = reduce16(x.x); tot.y = reduce16(x.y); tot.z = reduce16(x.z); tot.w = reduce16(x.w);
                const f32x4 cq = (s + run[cb]) * -CS_SCALE + 0.5f;
                uint2 w; w.x = (unsigned)fminf(cq.x, 65535.f) | ((unsigned)fminf(cq.y, 65535.f) << 16); w.y = (unsigned)fminf(cq.z, 65535.f) | ((unsigned)fminf(cq.w, 65535.f) << 16);
                *(uint2*)(stg + st_w + 32 * cb) = w; run[cb] = run[cb] + tot; }
            PR_FLUSH(p.CS, tb) } }
        PR_MMA(wB, 64, 64)
        PR_LOADW(wC, p.G2T, 128)
#pragma unroll
        for (int tb = 0; tb < 4; ++tb) {
#pragma unroll
            for (int cb = 0; cb < 4; ++cb) { f32x4 x = acc[tb][cb] + ba[cb];
#pragma unroll
                for (int e = 0; e < 4; ++e) x[e] = sigmoidf_(x[e]);
                uint2 w; w.x = pg8::cvt_pk_bf16(x[0], x[1]); w.y = pg8::cvt_pk_bf16(x[2], x[3]);
                *(uint2*)(stg + st_w + 32 * cb) = w; }
            PR_FLUSH(p.A, tb) }
        PR_MMA(wC, 128, 128)
#pragma unroll
        for (int tb = 0; tb < 4; ++tb) {
#pragma unroll
            for (int cb = 0; cb < 4; ++cb) { const f32x4 x = acc[tb][cb];
                uint2 w; w.x = pg8::cvt_pk_bf16(x[0], x[1]); w.y = pg8::cvt_pk_bf16(x[2], x[3]);
                *(uint2*)(stg + st_w + 32 * cb) = w; }
            PR_FLUSH(p.G, tb) }
#undef PR_FLUSH
#undef PR_WFENCE
#undef PR_LOADW
#undef PR_MMA
    }
    __syncthreads();
    {
        const int cc = tid & 63;
        bf16x8 cu[8], pv[8], vf[8]; const f32x4 mu0 = *(const f32x4*)(p.mu + 1024 + 8 * cc), mu1 = *(const f32x4*)(p.mu + 1024 + 8 * cc + 4);
#pragma unroll
        for (int it = 0; it < 8; ++it) { const int tk = (tid >> 6) + 8 * it; const size_t m = (size_t)m0 + tk; const int t = (int)(m % SEQ); const int col = 768 + 1024 + 8 * cc;
            cu[it] = *(const bf16x8*)(p.proj + m * IN_W + col); if (t > 0) pv[it] = *(const bf16x8*)(p.proj + (m - 1) * IN_W + col); else pv[it] = (bf16x8){0, 0, 0, 0, 0, 0, 0, 0};
            if (p.layer > 0) vf[it] = *(const bf16x8*)(p.vfirst + m * C + 8 * cc); }
#pragma unroll
        for (int it = 0; it < 8; ++it) { const int tk = (tid >> 6) + 8 * it; const size_t m = (size_t)m0 + tk;
            const f32x4 c0 = bfx4_lo(cu[it]), c1 = bfx4_hi(cu[it]);
            f32x4 lo = c0 + (bfx4_lo(pv[it]) - c0) * mu0, hi = c1 + (bfx4_hi(pv[it]) - c1) * mu1;
            const size_t o = m * C + 8 * cc;
            if (p.layer == 0) *(bf16x8*)(p.vfirst + o) = pack8(lo, hi);
            else { const bf16x8 sg = *(const bf16x8*)(SG + tk * PR_SG_LD + 8 * cc);
                lo = lo + (bfx4_lo(vf[it]) - lo) * bfx4_lo(sg); hi = hi + (bfx4_hi(vf[it]) - hi) * bfx4_hi(sg); }
            *(bf16x8*)(p.V + o) = pack8(lo, hi); }
    }
}

constexpr int NTHREADS_ = 512;
constexpr int SC_TB = 32, SC_SLOT = 384, SC_NCH = SEQ / SC_TB;
constexpr size_t WS_RKC = 51 * MiB;
struct ScanArgs { const bf16_t *proj, *V, *A, *G; const unsigned short* CS; const float *k_k, *k_a, *r_k, *lnx_g, *lnx_b; bf16_t* mix; float* rkc; };
constexpr int CK_LD = 72, CK_MAT = 64 * CK_LD * 2;
constexpr size_t WS_TSCR = WS_SI_A, TSCR_WG = 4 * 64 * C * 2;
__device__ __forceinline__ void ck_mm(f32x4 (&acc)[2], const bf16_t* Qm, const bf16_t* P, int jb, int ib0, int fr, int fq) {
#pragma unroll
    for (int ks = 0; ks < 2; ++ks) { const bf16x8 bq = *(const bf16x8*)(Qm + (16 * jb + fr) * CK_LD + 32 * ks + 8 * fq);
#pragma unroll
        for (int ii = 0; ii < 2; ++ii) { const bf16x8 ap = *(const bf16x8*)(P + (16 * (ib0 + ii) + fr) * CK_LD + 32 * ks + 8 * fq); acc[ii] = __builtin_amdgcn_mfma_f32_16x16x32_bf16(ap, bq, acc[ii], 0, 0, 0); } }
}
typedef short ck_s16x4 __attribute__((ext_vector_type(4)));
__device__ __forceinline__ bf16x8 ck_tr_frag(const bf16_t* X, int colbase, int ks, int lane) {
    const bf16_t* a0 = X + (32 * ks + 8 * (lane >> 4) + ((lane & 15) >> 2)) * CK_LD + colbase + 4 * (lane & 3);
    const ck_s16x4 lo = __builtin_amdgcn_ds_read_tr16_b64_v4i16((__attribute__((address_space(3))) ck_s16x4*)a0), hi = __builtin_amdgcn_ds_read_tr16_b64_v4i16((__attribute__((address_space(3))) ck_s16x4*)(a0 + 4 * CK_LD));
    return (bf16x8){lo[0], lo[1], lo[2], lo[3], hi[0], hi[1], hi[2], hi[3]};
}
template <bool TQ, bool TP> __device__ __forceinline__ void ck_mm_t(f32x4 (&acc)[2], const bf16_t* Qm, const bf16_t* P, int jb, int ib0, int fr, int fq) {
    const int lane = fq * 16 + fr;
#pragma unroll
    for (int ks = 0; ks < 2; ++ks) { const bf16x8 bq = TQ ? ck_tr_frag(Qm, 16 * jb, ks, lane) : *(const bf16x8*)(Qm + (16 * jb + fr) * CK_LD + 32 * ks + 8 * fq);
#pragma unroll
        for (int ii = 0; ii < 2; ++ii) { const bf16x8 ap = TP ? ck_tr_frag(P, 16 * (ib0 + ii), ks, lane) : *(const bf16x8*)(P + (16 * (ib0 + ii) + fr) * CK_LD + 32 * ks + 8 * fq); acc[ii] = __builtin_amdgcn_mfma_f32_16x16x32_bf16(ap, bq, acc[ii], 0, 0, 0); } }
}
__device__ __forceinline__ uint2 ck_pack4(const f32x4 v) { uint2 w; w.x = pg8::cvt_pk_bf16(v[0], v[1]); w.y = pg8::cvt_pk_bf16(v[2], v[3]); return w; }
__device__ __forceinline__ f32x4 ck_unpack4(const uint2 u) { return (f32x4){__builtin_bit_cast(float, u.x << 16), __builtin_bit_cast(float, u.x & 0xffff0000u), __builtin_bit_cast(float, u.y << 16), __builtin_bit_cast(float, u.y & 0xffff0000u)}; }
struct CkRaw { bf16x8 rc, rp, kc, kp, v, a, cs, cp, cl; };
__device__ __forceinline__ float wave_sum_dpp(float x) {
    x = reduce16(x); const int xi = __builtin_bit_cast(int, x);
    const float r0 = __builtin_bit_cast(float, __builtin_amdgcn_readlane(xi, 0)), r1 = __builtin_bit_cast(float, __builtin_amdgcn_readlane(xi, 16)), r2 = __builtin_bit_cast(float, __builtin_amdgcn_readlane(xi, 32)), r3 = __builtin_bit_cast(float, __builtin_amdgcn_readlane(xi, 48));
    return (r0 + r1) + (r2 + r3); }
__device__ __forceinline__ void ck_load(const ScanArgs& p, CkRaw& w, int unit, int tid) {
    const int chain = unit >> 6, chunk = unit & 63, b = chain >> 3, h = chain & 7, tk = tid >> 3, hc = h * 64 + (tid & 7) * 8;
    const size_t row = (size_t)b * SEQ + chunk * 64 + tk, o = row * C + hc;
    const bf16_t* pr = p.proj + row * IN_W + 768 + hc; const bf16x8 z8 = (bf16x8){0, 0, 0, 0, 0, 0, 0, 0};
    w.rc = *(const bf16x8*)pr; w.kc = *(const bf16x8*)(pr + 512);
    if (chunk * 64 + tk > 0) { w.rp = *(const bf16x8*)(pr - IN_W); w.kp = *(const bf16x8*)(pr - IN_W + 512); } else { w.rp = z8; w.kp = z8; }
    w.v = *(const bf16x8*)(p.V + o); w.a = *(const bf16x8*)(p.A + o);
    w.cs = *(const bf16x8*)(p.CS + o); if (tk > 0) w.cp = *(const bf16x8*)(p.CS + o - C); else w.cp = z8;
    w.cl = *(const bf16x8*)(p.CS + (row - tk + 63) * C + hc);
}
__device__ __forceinline__ f32x4 csq_lo(const bf16x8 v) { return (f32x4){(float)(unsigned short)v[0], (float)(unsigned short)v[1], (float)(unsigned short)v[2], (float)(unsigned short)v[3]} * (-1.f / CS_SCALE); }
__device__ __forceinline__ f32x4 csq_hi(const bf16x8 v) { return (f32x4){(float)(unsigned short)v[4], (float)(unsigned short)v[5], (float)(unsigned short)v[6], (float)(unsigned short)v[7]} * (-1.f / CS_SCALE); }
__device__ __forceinline__ f32x4 exp4(const f32x4 v) { return (f32x4){__expf(v[0]), __expf(v[1]), __expf(v[2]), __expf(v[3])}; }
constexpr int CK_CONST_OFF = 136192;
__device__ __forceinline__ void ck_precompute(const ScanArgs& p, const CkRaw& raw, CkRaw& nxt, int next_unit, unsigned char* lds, bf16_t* GQ, bf16_t* CQ, int unit, int tid) {
    const int chain = unit >> 6, chunk = unit & 63, b = chain >> 3, h = chain & 7, wave = __builtin_amdgcn_readfirstlane(tid >> 6), lane = tid & 63, fr = lane & 15, fq = lane >> 4, jb = wave >> 1, ib0 = 2 * (wave & 1);
    bf16_t* At = (bf16_t*)(lds + 0 * CK_MAT); bf16_t* bt = (bf16_t*)(lds + 1 * CK_MAT); bf16_t* kt = (bf16_t*)(lds + 2 * CK_MAT); bf16_t* rt = (bf16_t*)(lds + 3 * CK_MAT);
    bf16_t* AtT = (bf16_t*)(lds + 4 * CK_MAT); bf16_t* BhT = (bf16_t*)(lds + 5 * CK_MAT); bf16_t* KhT = (bf16_t*)(lds + 6 * CK_MAT); bf16_t* VT = (bf16_t*)(lds + 7 * CK_MAT);
    bf16_t* NT = (bf16_t*)(lds + 8 * CK_MAT); bf16_t* Mm = (bf16_t*)(lds + 9 * CK_MAT); bf16_t* P1 = (bf16_t*)(lds + 10 * CK_MAT); bf16_t* P2 = (bf16_t*)(lds + 11 * CK_MAT);
    bf16_t* Ta = (bf16_t*)(lds + 12 * CK_MAT); bf16_t* Tb = (bf16_t*)(lds + 13 * CK_MAT); float* WT = (float*)(lds + 14 * CK_MAT); float* GL = WT + 512;
    bf16_t* W1T = bt; bf16_t* MVT = kt; bf16_t* W2T = At;
    {
        const int tk = tid >> 3, c8 = (tid & 7) * 8, ro = tk * CK_LD + c8;
        bf16_t* BhR = BhT; bf16_t* KhR = KhT; bf16_t* VR = VT;
        const float* KC = (const float*)(lds + CK_CONST_OFF) + h * 64 + c8;
        const f32x4 kc0 = *(const f32x4*)KC, kc1 = *(const f32x4*)(KC + 4), ac0 = *(const f32x4*)(KC + 512), ac1 = *(const f32x4*)(KC + 516), rc0 = *(const f32x4*)(KC + 1024), rc1 = *(const f32x4*)(KC + 1028), mu0 = *(const f32x4*)(KC + 1536), mu1 = *(const f32x4*)(KC + 1540);
        const f32x4 mk0 = *(const f32x4*)(KC + 2048), mk1 = *(const f32x4*)(KC + 2052);
        const f32x4 x0 = bfx4_lo(raw.rc), x1 = bfx4_hi(raw.rc); const f32x4 r0 = x0 + (bfx4_lo(raw.rp) - x0) * mu0, r1 = x1 + (bfx4_hi(raw.rp) - x1) * mu1;
        const f32x4 y0 = bfx4_lo(raw.kc), y1 = bfx4_hi(raw.kc); const f32x4 k0 = y0 + (bfx4_lo(raw.kp) - y0) * mk0, k1 = y1 + (bfx4_hi(raw.kp) - y1) * mk1;
        const f32x4 a0 = bfx4_lo(raw.a), a1 = bfx4_hi(raw.a);
        const f32x4 c0 = csq_lo(raw.cs), c1 = csq_hi(raw.cs), p0 = csq_lo(raw.cp), p1 = csq_hi(raw.cp), l0 = csq_lo(raw.cl), l1 = csq_hi(raw.cl);
        f32x4 q0 = k0 * kc0, q1 = k1 * kc1;
        const f32x4 qq = q0 * q0 + q1 * q1; const float nrm = red8((qq.x + qq.y) + (qq.z + qq.w));
        const float inv = fminf(__builtin_amdgcn_rsqf(nrm), 1e12f); q0 = q0 * inv; q1 = q1 * inv;
        const f32x4 kp0 = k0 * (1.f + (a0 - 1.f) * ac0), kp1 = k1 * (1.f + (a1 - 1.f) * ac1);
        const f32x4 rr = r0 * kp0 * rc0 + r1 * kp1 * rc1; const float rkc = red8((rr.x + rr.y) + (rr.z + rr.w));
        if ((tid & 7) == 0) p.rkc[((size_t)b * SEQ + chunk * 64 + tk) * 8 + h] = rkc;
        const f32x4 em0 = exp4(p0), em1 = exp4(p1), en0 = exp4(-c0), en1 = exp4(-c1), ep0 = exp4(c0), ep1 = exp4(c1), eL0 = exp4(l0 - c0), eL1 = exp4(l1 - c1);
        const f32x4 b0 = q0 * a0, b1 = q1 * a1;
        *(bf16x8*)(At + ro) = pack8(-q0 * em0, -q1 * em1); *(bf16x8*)(bt + ro) = pack8(b0 * en0, b1 * en1); *(bf16x8*)(kt + ro) = pack8(kp0 * en0, kp1 * en1); *(bf16x8*)(rt + ro) = pack8(r0 * ep0, r1 * ep1);
        *(bf16x8*)(BhR + ro) = pack8(b0 * eL0, b1 * eL1); *(bf16x8*)(KhR + ro) = pack8(kp0 * eL0, kp1 * eL1); *(bf16x8*)(VR + ro) = raw.v;
        if (tk == 0) { *(f32x4*)(GL + c8) = exp4(l0); *(f32x4*)(GL + c8 + 4) = exp4(l1); }
    }
    __syncthreads();
    const int j = 16 * jb + fr; const f32x4 z4 = (f32x4){0.f, 0.f, 0.f, 0.f};
    { f32x4 aN[2] = {z4, z4}, aM[2] = {z4, z4}, aP1[2] = {z4, z4}, aP2[2] = {z4, z4};
      ck_mm(aN, At, bt, jb, ib0, fr, fq); ck_mm(aM, At, kt, jb, ib0, fr, fq); ck_mm(aP1, rt, bt, jb, ib0, fr, fq); ck_mm(aP2, rt, kt, jb, ib0, fr, fq);
#pragma unroll
      for (int ii = 0; ii < 2; ++ii) { const int i0 = 16 * (ib0 + ii) + 4 * fq; f32x4 t0, nt, mm, p1, p2;
#pragma unroll
          for (int e = 0; e < 4; ++e) { const int i = i0 + e; nt[e] = i < j ? aN[ii][e] : 0.f; t0[e] = nt[e] + (i == j ? 1.f : 0.f); mm[e] = i < j ? aM[ii][e] : 0.f; p1[e] = i <= j ? aP1[ii][e] : 0.f; p2[e] = i <= j ? aP2[ii][e] : 0.f; }
          *(uint2*)(Ta + j * CK_LD + i0) = ck_pack4(t0); *(uint2*)(NT + j * CK_LD + i0) = ck_pack4(nt); *(uint2*)(Mm + j * CK_LD + i0) = ck_pack4(mm); *(uint2*)(P1 + j * CK_LD + i0) = ck_pack4(p1); *(uint2*)(P2 + j * CK_LD + i0) = ck_pack4(p2); } }
    __syncthreads();
#pragma unroll
    for (int st = 0; st < 3; ++st) { const bf16_t* src = (st & 1) ? Tb : Ta; bf16_t* dst = (st & 1) ? Ta : Tb; f32x4 a2[2] = {z4, z4}; ck_mm_t<false, true>(a2, src, NT, jb, ib0, fr, fq);
#pragma unroll
        for (int ii = 0; ii < 2; ++ii) { const int i0 = 16 * (ib0 + ii) + 4 * fq; f32x4 t = a2[ii];
#pragma unroll
            for (int e = 0; e < 4; ++e) t[e] += (i0 + e == j) ? 1.f : 0.f;
            *(uint2*)(dst + j * CK_LD + i0) = ck_pack4(t); }
        __syncthreads(); }
    { f32x4 a1[2] = {z4, z4}, a2[2] = {z4, z4}; ck_mm_t<true, false>(a1, At, Tb, jb, ib0, fr, fq); ck_mm_t<true, false>(a2, VT, Mm, jb, ib0, fr, fq);
#pragma unroll
      for (int ii = 0; ii < 2; ++ii) { const int i0 = 16 * (ib0 + ii) + 4 * fq; *(uint2*)(W1T + j * CK_LD + i0) = ck_pack4(a1[ii]); *(uint2*)(MVT + j * CK_LD + i0) = ck_pack4(a2[ii]); } }
    __syncthreads();
    { f32x4 a1[2] = {z4, z4}; ck_mm(a1, MVT, Tb, jb, ib0, fr, fq);
#pragma unroll
      for (int ii = 0; ii < 2; ++ii) { const int i0 = 16 * (ib0 + ii) + 4 * fq; *(uint2*)(W2T + j * CK_LD + i0) = ck_pack4(a1[ii]); } }
    __syncthreads();
    ck_load(p, nxt, next_unit, tid);
    { f32x4 aQ1[2] = {z4, z4}, aG[2] = {z4, z4}, aQ2[2] = {z4, z4}, aC[2] = {z4, z4};
      ck_mm(aQ1, P1, W1T, jb, ib0, fr, fq); ck_mm_t<true, false>(aG, BhT, W1T, jb, ib0, fr, fq); ck_mm(aQ2, P1, W2T, jb, ib0, fr, fq); ck_mm_t<false, true>(aQ2, P2, VT, jb, ib0, fr, fq); ck_mm_t<false, true>(aC, W2T, BhT, jb, ib0, fr, fq); ck_mm_t<true, true>(aC, VT, KhT, jb, ib0, fr, fq);
      bf16_t* gq = GQ + (size_t)unit * 8192; bf16_t* cq = CQ + (size_t)unit * 8192; const float glj = GL[j];
#pragma unroll
      for (int ii = 0; ii < 2; ++ii) { const int i0 = 16 * (ib0 + ii) + 4 * fq; f32x4 g = aG[ii];
#pragma unroll
          for (int e = 0; e < 4; ++e) g[e] += (i0 + e == j) ? glj : 0.f;
          const f32x4 q1 = aQ1[ii] + ck_unpack4(*(const uint2*)(rt + j * CK_LD + i0));
          *(uint2*)(AtT + j * CK_LD + i0) = ck_pack4(g); *(uint2*)(NT + j * CK_LD + i0) = ck_pack4(q1); *(uint2*)(Mm + j * CK_LD + i0) = ck_pack4(aC[ii]); *(uint2*)(Ta + j * CK_LD + i0) = ck_pack4(aQ2[ii]); }
      __syncthreads();
      { const int row = tid >> 3, c8 = (tid & 7) * 8, lo_ = row * CK_LD + c8, go_ = row * 64 + c8;
        const pg8::u32x4 v0 = *(const pg8::u32x4*)(AtT + lo_), v1 = *(const pg8::u32x4*)(NT + lo_), v2 = *(const pg8::u32x4*)(Mm + lo_), v3 = *(const pg8::u32x4*)(Ta + lo_);
        *(pg8::u32x4*)(gq + go_) = v0; *(pg8::u32x4*)(gq + 4096 + go_) = v1; *(pg8::u32x4*)(cq + go_) = v2; *(pg8::u32x4*)(cq + 4096 + go_) = v3; } }
    if (next_unit == unit) __syncthreads();
}
__device__ __forceinline__ void ck_sequential(const ScanArgs& p, unsigned char* lds, const bf16_t* GQ, const bf16_t* CQ, int item, int tid) {
    const int chain = item >> 2, q = item & 3, b = chain >> 3, h = chain & 7, wave = __builtin_amdgcn_readfirstlane(tid >> 6), lane = tid & 63, fr = lane & 15, fq = lane >> 4;
    bf16_t* OPS = (bf16_t*)lds;
    bf16_t* HT = (bf16_t*)(lds + 4 * CK_MAT);
    for (int i = tid; i < 2 * 16 * CK_LD / 2; i += NTHREADS_) ((unsigned*)HT)[i] = 0u;
    const size_t ubase = (size_t)chain * 64; const size_t rowbase = (size_t)b * SEQ;
    const int prow0 = tid >> 3, pcol = (tid & 7) * 8;
    const int aoff = wave < 4 ? (4096 + (16 * wave + fr) * 64 + 16 * q + 4 * fq) : ((16 * q + fr) * 64 + 16 * (wave - 4) + 4 * fq);
    typedef unsigned u32x2_ __attribute__((ext_vector_type(2)));
    pg8::u32x4 g0_0, g0_1, g0_2, g0_3, g0_4, g0_5, g0_6, g0_7, g1_0, g1_1, g1_2, g1_3, g1_4, g1_5, g1_6, g1_7; u32x2_ ad_0, ad_1, ad_2, ad_3, ad_4, ad_5, ad_6, ad_7;
#define CK_FETCH(slot, cc) do { const int c_ = (cc) < 64 ? (cc) : 63;     \
        const bf16_t* gq = GQ + (ubase + c_) * 8192; g0_##slot = *(const pg8::u32x4*)(gq + (size_t)prow0 * 64 + pcol); g1_##slot = *(const pg8::u32x4*)(gq + (size_t)(prow0 + 64) * 64 + pcol); \
        ad_##slot = *(const u32x2_*)(CQ + (ubase + c_) * 8192 + aoff); } while (0)
#define CK_STAGE(slot, buf) do { *(pg8::u32x4*)(OPS + (buf) * 2 * 64 * CK_LD + prow0 * CK_LD + pcol) = g0_##slot; *(pg8::u32x4*)(OPS + (buf) * 2 * 64 * CK_LD + 64 * CK_LD + prow0 * CK_LD + pcol) = g1_##slot; } while (0)
    CK_FETCH(0, 0); CK_FETCH(1, 1); CK_FETCH(2, 2); CK_FETCH(3, 3); CK_FETCH(4, 4); CK_FETCH(5, 5); CK_FETCH(6, 6); CK_FETCH(7, 7);
    CK_STAGE(0, 0);
    __syncthreads();
#define CK_STEP(cc, slot, nslot) do { const int bi = (cc) & 1; const bf16_t* Gm = OPS + bi * 2 * 64 * CK_LD; const bf16_t* Q1m = Gm + 64 * CK_LD; const bf16_t* HTc = HT + bi * 16 * CK_LD; bf16_t* HTn = HT + (bi ^ 1) * 16 * CK_LD; \
        f32x4 acc = (f32x4){0.f, 0.f, 0.f, 0.f}; \
        if (wave < 4) { _Pragma("unroll") for (int ks = 0; ks < 2; ++ks) acc = __builtin_amdgcn_mfma_f32_16x16x32_bf16(*(const bf16x8*)(HTc + fr * CK_LD + 32 * ks + 8 * fq), *(const bf16x8*)(Q1m + (16 * wave + fr) * CK_LD + 32 * ks + 8 * fq), acc, 0, 0, 0); \
            acc = acc + ck_unpack4((uint2){ad_##slot.x, ad_##slot.y}); \
            *(uint2*)(p.mix + (rowbase + (size_t)(cc) * 64 + 16 * wave + fr) * D + ATT_W + h * 64 + 16 * q + 4 * fq) = ck_pack4(acc); } \
        else { _Pragma("unroll") for (int ks = 0; ks < 2; ++ks) acc = __builtin_amdgcn_mfma_f32_16x16x32_bf16(*(const bf16x8*)(Gm + (16 * (wave - 4) + fr) * CK_LD + 32 * ks + 8 * fq), *(const bf16x8*)(HTc + fr * CK_LD + 32 * ks + 8 * fq), acc, 0, 0, 0); \
            acc = acc + ck_unpack4((uint2){ad_##slot.x, ad_##slot.y}); \
            *(uint2*)(HTn + fr * CK_LD + 16 * (wave - 4) + 4 * fq) = ck_pack4(acc); } \
        CK_STAGE(nslot, bi ^ 1); \
        CK_FETCH(slot, (cc) + 8); \
        __syncthreads(); } while (0)
    for (int c = 0; c < 64; c += 8) { CK_STEP(c, 0, 1); CK_STEP(c + 1, 1, 2); CK_STEP(c + 2, 2, 3); CK_STEP(c + 3, 3, 4); CK_STEP(c + 4, 4, 5); CK_STEP(c + 5, 5, 6); CK_STEP(c + 6, 6, 7); CK_STEP(c + 7, 7, 0); }
#undef CK_FETCH
#undef CK_STAGE
#undef CK_STEP
}

struct PostRaw { bf16x8 y0, y1, v0, v1, g0, g1; float rk0, rk1; };
__device__ __forceinline__ void scan_post_load(const ScanArgs& p, PostRaw& w, int m0, int lane) {
    const int ch8 = 8 * lane, hh = lane >> 3; const size_t m = (size_t)m0;
    w.y0 = *(const bf16x8*)(p.mix + m * D + ATT_W + ch8); w.v0 = *(const bf16x8*)(p.V + m * C + ch8); w.g0 = *(const bf16x8*)(p.G + m * C + ch8); w.rk0 = p.rkc[m * 8 + hh];
    w.y1 = *(const bf16x8*)(p.mix + (m + 1) * D + ATT_W + ch8); w.v1 = *(const bf16x8*)(p.V + (m + 1) * C + ch8); w.g1 = *(const bf16x8*)(p.G + (m + 1) * C + ch8); w.rk1 = p.rkc[(m + 1) * 8 + hh];
}
__device__ __forceinline__ void scan_post_row(const ScanArgs& p, const bf16x8 yv, const bf16x8 vv, const bf16x8 gv, const float rk, const f32x4 lg0, const f32x4 lg1, const f32x4 lb0, const f32x4 lb1, size_t m, int ch8) {
    f32x4 y0 = bfx4_lo(yv), y1 = bfx4_hi(yv);
    const float mean = red8((y0.x + y0.y) + (y0.z + y0.w) + (y1.x + y1.y) + (y1.z + y1.w)) * (1.f / 64.f);
    y0 = y0 - mean; y1 = y1 - mean;
    const float var = red8((y0.x * y0.x + y0.y * y0.y) + (y0.z * y0.z + y0.w * y0.w) + (y1.x * y1.x + y1.y * y1.y) + (y1.z * y1.z + y1.w * y1.w)) * (1.f / 64.f);
    const float rs = rsqrtf(var + LNX_EPS);
    const f32x4 o0 = (y0 * rs * lg0 + lb0 + bfx4_lo(vv) * rk) * bfx4_lo(gv), o1 = (y1 * rs * lg1 + lb1 + bfx4_hi(vv) * rk) * bfx4_hi(gv);
    *(bf16x8*)(p.mix + m * D + ATT_W + ch8) = pack8(o0, o1);
}
__device__ __forceinline__ void scan_post_wave(const ScanArgs& p, int gw, int ngw, int lane) {
    const int ch8 = 8 * lane;
    const f32x4 lg0 = *(const f32x4*)(p.lnx_g + ch8), lg1 = *(const f32x4*)(p.lnx_g + ch8 + 4), lb0 = *(const f32x4*)(p.lnx_b + ch8), lb1 = *(const f32x4*)(p.lnx_b + ch8 + 4);
    int m0 = 2 * gw; if (m0 >= M) return;
    PostRaw cur; scan_post_load(p, cur, m0, lane);
    for (; m0 < M; m0 += 2 * ngw) { PostRaw nxt = cur; if (m0 + 2 * ngw < M) scan_post_load(p, nxt, m0 + 2 * ngw, lane);
        scan_post_row(p, cur.y0, cur.v0, cur.g0, cur.rk0, lg0, lg1, lb0, lb1, (size_t)m0, ch8); scan_post_row(p, cur.y1, cur.v1, cur.g1, cur.rk1, lg0, lg1, lb0, lb1, (size_t)m0 + 1, ch8);
        cur = nxt; }
}

typedef float f32x16 __attribute__((ext_vector_type(16)));
typedef short s16x4 __attribute__((ext_vector_type(4)));
constexpr int AT_VLD = 96;
__device__ __forceinline__ int crow(int r, int hi) { return (r & 3) + 8 * (r >> 2) + 4 * hi; }
constexpr int AT_KLD = 72;
__device__ __forceinline__ void attn_phase(const bf16_t* __restrict__ proj, const float* __restrict__ sinks, bf16_t* __restrict__ mix, unsigned char* lds, int G, int tid) {
    bf16_t* ks_ = (bf16_t*)lds; bf16_t* vs_ = (bf16_t*)(lds + 192 * AT_KLD * 2);
    constexpr int AT_BUF = 192 * AT_KLD * 2 + 192 * AT_VLD * 2; int ub = 0;
    const int g = __builtin_amdgcn_readfirstlane(tid >> 7), half = __builtin_amdgcn_readfirstlane((tid >> 6) & 1);
    constexpr int NU = BATCH * 2 * (SEQ / 64);
    bf16x8 pk0, pk1, pk2, pv0, pv1, pv2, pq0, pq1, pq2, pq3;
#define AT_PIECE(it, kdst, vdst, un) do { const int i_ = tq + 512 * (it), kl_ = i_ >> 3, ch8_ = i_ & 7; int key_ = ((un) & 63) * 64 - 128 + kl_; key_ = key_ < 0 ? 0 : key_;     \
        const bf16_t* rp_ = proj + ((size_t)((un) >> 7) * SEQ + key_) * IN_W + 512 + (((un) >> 6) & 1) * 64 + ch8_ * 8; kdst = *(const bf16x8*)rp_; vdst = *(const bf16x8*)(rp_ + KV_W); } while (0)
#define AT_FETCH(un) do { AT_PIECE(0, pk0, pv0, un); AT_PIECE(1, pk1, pv1, un); AT_PIECE(2, pk2, pv2, un); \
        { const int l_ = tq & 63; const bf16_t* qp_ = proj + ((size_t)((un) >> 7) * SEQ + ((un) & 63) * 64 + 32 * half + (l_ & 31)) * IN_W + ((((un) >> 6) & 1) * 4 + g) * 64 + 8 * (l_ >> 5); \
          pq0 = *(const bf16x8*)qp_; pq1 = *(const bf16x8*)(qp_ + 16); pq2 = *(const bf16x8*)(qp_ + 32); pq3 = *(const bf16x8*)(qp_ + 48); } } while (0)
#define AT_STAGE(it, ksrc, vsrc) do { const int i_ = tq + 512 * (it), kl_ = i_ >> 3, ch8_ = i_ & 7; *(bf16x8*)(ks_ + kl_ * AT_KLD + ch8_ * 8) = ksrc; *(bf16x8*)(vs_ + kl_ * AT_VLD + ch8_ * 8) = vsrc; } while (0)
    int tq = tid; int unit = blockIdx.x; if (unit < NU) AT_FETCH(unit);
    for (; unit < NU; unit += G) {
        const int b = unit >> 7, kvh = (unit >> 6) & 1, qb = unit & 63, Q0 = qb * 64, h = kvh * 4 + g; const size_t rowb = (size_t)b * SEQ;
        asm volatile("" : "+v"(tq));
        const int lane = tq & 63, c = lane & 31, hi = lane >> 5;
        ks_ = (bf16_t*)(lds + ub * AT_BUF); vs_ = ks_ + 192 * AT_KLD; ub ^= 1;
        AT_STAGE(0, pk0, pv0); AT_STAGE(1, pk1, pv1); AT_STAGE(2, pk2, pv2);
        const bf16x8 qf[4] = {pq0, pq1, pq2, pq3};
        __syncthreads();
        if (unit + G < NU) AT_FETCH(unit + G);
        const int t0 = Q0 + 32 * half; const size_t mq = rowb + t0 + c;
        f32x16 p[5];
#pragma unroll
        for (int kb = 0; kb < 5; ++kb) { const bf16_t* kp = ks_ + (32 * half + 32 * kb + c) * AT_KLD + 8 * hi;
            f32x16 acc;
#pragma unroll
            for (int r = 0; r < 16; ++r) acc[r] = 0.f;
#pragma unroll
            for (int ks = 0; ks < 4; ++ks) acc = __builtin_amdgcn_mfma_f32_32x32x16_bf16(*(const bf16x8*)(kp + 16 * ks), qf[ks], acc, 0, 0, 0);
            p[kb] = acc; }
        const float slope = exp2f(-(float)(h + 1)) * 1.44269504089f, sink = sinks[h] * 1.44269504089f;
        float mx = sink;
        const float bl = -slope * (float)(c + 128 - 4 * hi);
        const bool seq_start = (t0 < 128);
#pragma unroll
        for (int kb = 0; kb < 5; ++kb)
#pragma unroll
            for (int r = 0; r < 16; ++r) { const int cr0 = (r & 3) + 8 * (r >> 2), cr = cr0 + 4 * hi;
                float sc = p[kb][r] * (0.125f * 1.44269504089f) + (bl + slope * (float)(32 * kb + cr0));
                if (kb == 0) sc = (cr > c) ? sc : -1e30f;
                if (kb == 4) sc = (cr <= c) ? sc : -1e30f;
                if (seq_start) sc = (t0 - 128 + 32 * kb + cr >= 0) ? sc : -1e30f;
                p[kb][r] = sc; mx = fmaxf(mx, sc); }
        mx = fmaxf(mx, __shfl_xor(mx, 32));
        float l = 0.f;
#pragma unroll
        for (int kb = 0; kb < 5; ++kb)
#pragma unroll
            for (int r = 0; r < 16; ++r) { const float e = __builtin_amdgcn_exp2f(p[kb][r] - mx); p[kb][r] = e; l += e; }
        l += __shfl_xor(l, 32); l += __builtin_amdgcn_exp2f(sink - mx);
        f32x16 o[2];
#pragma unroll
        for (int d = 0; d < 2; ++d)
#pragma unroll
            for (int r = 0; r < 16; ++r) o[d][r] = 0.f;
#pragma unroll
        for (int kb = 0; kb < 5; ++kb)
#pragma unroll
            for (int s2 = 0; s2 < 2; ++s2) {
                pg8::u32x4 pw; pw.x = pg8::cvt_pk_bf16(p[kb][8 * s2 + 0], p[kb][8 * s2 + 1]); pw.y = pg8::cvt_pk_bf16(p[kb][8 * s2 + 2], p[kb][8 * s2 + 3]);
                pw.z = pg8::cvt_pk_bf16(p[kb][8 * s2 + 4], p[kb][8 * s2 + 5]); pw.w = pg8::cvt_pk_bf16(p[kb][8 * s2 + 6], p[kb][8 * s2 + 7]);
                const bf16x8 pf = __builtin_bit_cast(bf16x8, pw);
#pragma unroll
                for (int d = 0; d < 2; ++d) {
                    const bf16_t* vp = vs_ + (32 * half + 32 * kb + 16 * s2 + 4 * hi + ((lane & 15) >> 2)) * AT_VLD + 32 * d + 16 * ((lane >> 4) & 1) + 4 * (lane & 3);
                    const s16x4 lo = __builtin_amdgcn_ds_read_tr16_b64_v4i16((__attribute__((address_space(3))) s16x4*)vp), hh = __builtin_amdgcn_ds_read_tr16_b64_v4i16((__attribute__((address_space(3))) s16x4*)(vp + 8 * AT_VLD));
                    const bf16x8 vf = (bf16x8){lo[0], lo[1], lo[2], lo[3], hh[0], hh[1], hh[2], hh[3]};
                    o[d] = __builtin_amdgcn_mfma_f32_32x32x16_bf16(vf, pf, o[d], 0, 0, 0); } }
        const float inv = __builtin_amdgcn_rcpf(l);
#pragma unroll
        for (int d = 0; d < 2; ++d)
#pragma unroll
            for (int rp = 0; rp < 2; ++rp) {
                unsigned ax = pg8::cvt_pk_bf16(o[d][8 * rp] * inv, o[d][8 * rp + 1] * inv), ay = pg8::cvt_pk_bf16(o[d][8 * rp + 2] * inv, o[d][8 * rp + 3] * inv);
                unsigned bx = pg8::cvt_pk_bf16(o[d][8 * rp + 4] * inv, o[d][8 * rp + 5] * inv), by = pg8::cvt_pk_bf16(o[d][8 * rp + 6] * inv, o[d][8 * rp + 7] * inv);
                const auto r0 = __builtin_amdgcn_permlane32_swap(ax, bx, false, false); const auto r1 = __builtin_amdgcn_permlane32_swap(ay, by, false, false);
                pg8::u32x4 w; w.x = r0[0]; w.y = r1[0]; w.z = r0[1]; w.w = r1[1];
                *(pg8::u32x4*)(mix + mq * D + h * 64 + 32 * d + 16 * rp + 8 * hi) = w; }
    }
    __syncthreads();
#undef AT_PIECE
#undef AT_FETCH
#undef AT_STAGE
}

__device__ __forceinline__ void ffn_fixup(const float* __restrict__ SB, const float* __restrict__ cw, const float* __restrict__ cb, bf16_t* hid, int pm, int tid) {
    pm = __builtin_amdgcn_readfirstlane(pm);
    const float* s = SB + (size_t)pm * 6 * FF; const float* sp = SB + (size_t)(pm - 1) * 6 * FF; const bool has_prev = (pm % (SEQ / 256)) != 0;
    static_assert(2 * FF == 11 * NTHREADS_, "ffn_fixup: 11 items per thread");
    float u0[11], u1[11], ul0[11], ul1[11], w0[11], w1[11], w2[11], bb[11], up[11];
#pragma unroll
    for (int it = 0; it < 11; ++it) { const int idx = tid + NTHREADS_ * it, rr = idx >= FF ? 1 : 0, j = idx - rr * FF;
        u0[it] = s[j]; u1[it] = s[FF + j]; ul0[it] = has_prev ? sp[4 * FF + j] : 0.f; ul1[it] = has_prev ? sp[5 * FF + j] : 0.f;
        w0[it] = cw[j]; w1[it] = cw[FF + j]; w2[it] = cw[2 * FF + j]; bb[it] = cb[j]; up[it] = s[(2 + rr) * FF + j]; }
#pragma unroll
    for (int it = 0; it < 11; ++it) { const int idx = tid + NTHREADS_ * it, rr = idx >= FF ? 1 : 0, j = idx - rr * FF;
        const float c = rr == 0 ? bb[it] + w0[it] * ul0[it] + w1[it] * ul1[it] + w2[it] * u0[it] : bb[it] + w0[it] * ul1[it] + w1[it] * u0[it] + w2[it] * u1[it];
        hid[(size_t)(pm * 256 + rr) * FF + j] = (bf16_t)f2bf(c * sigmoidf_(c) * up[it]); }
}

#define XB_TMO      128
#define XB_XCNT(j)  (256  + 64 * (j))
#define XB_XSUB(j)  (1280 + 64 * (j))
#define XB_XGEN(j)  (2304 + 64 * (j))
#define XB_TOP      3328
#define XB_TOPGEN   3392
#define XCD_BAR_WORDS 3456
#define XB_SPIN_CAP (1u << 18)

__device__ __forceinline__ unsigned xb_ld(unsigned* p)              { return __hip_atomic_load(p, __ATOMIC_RELAXED, __HIP_MEMORY_SCOPE_AGENT); }
__device__ __forceinline__ unsigned xb_add(unsigned* p, unsigned v) { return __hip_atomic_fetch_add(p, v, __ATOMIC_RELAXED, __HIP_MEMORY_SCOPE_AGENT); }
__device__ __forceinline__ unsigned xb_xcc_id() { return (unsigned)__builtin_amdgcn_s_getreg((3 << 11) | 20) & 0xFu; }
#define XB_SPIN(cond, bar) do { unsigned _sp = 0; while (cond) { __builtin_amdgcn_s_sleep(1); \
    if ((++_sp & 255u) == 0u) { if (xb_ld(&(bar)[XB_TMO])) break; if (_sp > XB_SPIN_CAP) { atomicAdd(&(bar)[XB_TMO], 1u); break; } } } } while (0)

struct XcdBarrier {
    unsigned* bar; unsigned x;
    volatile __attribute__((address_space(3))) unsigned* st;
};

__device__ __forceinline__ XcdBarrier xcd_barrier_post(unsigned* bar, volatile __attribute__((address_space(3))) unsigned* st) {
    XcdBarrier b; b.bar = bar; b.x = xb_xcc_id(); b.st = st;
    if (threadIdx.x == 0) (void)xb_add(&bar[XB_XCNT(b.x)], 1u);
    return b;
}
__device__ __forceinline__ void xcd_barrier_complete(unsigned* bar, unsigned x, unsigned& nloc, unsigned& nx) {
    const unsigned G = gridDim.x * gridDim.y * gridDim.z;
    unsigned sum, cnt, mine, sp = 0u;
    for (;;) {
        sum = 0u; cnt = 0u; mine = 0u;
#pragma unroll
        for (unsigned j = 0; j < 16; ++j) { const unsigned c = xb_ld(&bar[XB_XCNT(j)]); sum += c; cnt += (c > 0u) ? 1u : 0u; mine = (j == x) ? c : mine; }
        if (sum == G) break;
        __builtin_amdgcn_s_sleep(1);
        if ((++sp & 255u) == 0u) { if (xb_ld(&bar[XB_TMO])) break; if (sp > XB_SPIN_CAP) { atomicAdd(&bar[XB_TMO], 1u); break; } }
    }
    nloc = mine > 0u ? mine : 1u; nx = cnt > 0u ? cnt : 1u;
}

__device__ __forceinline__ void xcd_barrier(const XcdBarrier& b) {
    asm volatile("s_waitcnt vmcnt(0)" ::: "memory");
    __syncthreads();
    if (threadIdx.x == 0) {
        unsigned* bar = b.bar;
        __builtin_amdgcn_s_waitcnt(0);
        unsigned nloc = b.st[0], nx = b.st[1];
        if (nloc == 0u) { xcd_barrier_complete(bar, b.x, nloc, nx); b.st[0] = nloc; b.st[1] = nx; }
        const unsigned old = xb_add(&bar[XB_XSUB(b.x)], 1u);
        const unsigned gen = old / nloc;
        if (old + 1u == (gen + 1u) * nloc) {
            __builtin_amdgcn_fence(__ATOMIC_RELEASE, "agent");
            asm volatile("s_waitcnt vmcnt(0)" ::: "memory");
            const unsigned og = xb_add(&bar[XB_TOP], 1u);
            const unsigned tg = og / nx;
            if (og + 1u == (tg + 1u) * nx) xb_add(&bar[XB_TOPGEN], 1u);
            else XB_SPIN(xb_ld(&bar[XB_TOPGEN]) == tg, bar);
            __builtin_amdgcn_fence(__ATOMIC_ACQUIRE, "agent");
            xb_add(&bar[XB_XGEN(b.x)], 1u);
            asm volatile("s_waitcnt vmcnt(0)" ::: "memory");
        } else {
            XB_SPIN(xb_ld(&bar[XB_XGEN(b.x)]) == gen, bar);
            __builtin_amdgcn_fence(__ATOMIC_ACQUIRE, "agent");
            asm volatile("s_waitcnt vmcnt(0)" ::: "memory");
        }
    }
    __syncthreads();
}

constexpr int NTHREADS = 512, LDS_BYTES = 147456;
struct Args { const float* in[26]; float* out; unsigned char* ws; };
__global__ void __launch_bounds__(NTHREADS, 2) mega_fwd(Args a) {
    extern __shared__ __attribute__((aligned(16))) unsigned char lds[];
    constexpr int MISC_OFF = 131072 + 4096;
    { volatile __attribute__((address_space(3))) unsigned* misc = (volatile __attribute__((address_space(3))) unsigned*)((__attribute__((address_space(3))) unsigned char*)lds + MISC_OFF);
      if (threadIdx.x < 4) misc[threadIdx.x] = 0u; }
    __syncthreads();
    (void)xcd_barrier_post((unsigned*)(a.ws + WS_BAR), (volatile __attribute__((address_space(3))) unsigned*)((__attribute__((address_space(3))) unsigned char*)lds + MISC_OFF));
#define GRID_SYNC() do { XcdBarrier xb_; xb_.bar = (unsigned*)(a.ws + WS_BAR); xb_.x = xb_xcc_id(); xb_.st = (volatile __attribute__((address_space(3))) unsigned*)((__attribute__((address_space(3))) unsigned char*)lds + MISC_OFF); xcd_barrier(xb_); } while (0)
#define LDSP ((PG8_LAS unsigned char*)lds)
    constexpr int XCH_OFF = 131072;
#define OTID() ({ int _t = threadIdx.x; asm volatile("" : "+v"(_t)); _t; })
    const int G = gridDim.x, NGW = G * 8;
    const float* x = a.in[0]; const float* norm1_g = a.in[1]; const float* w_in = a.in[2]; const float* sinks = a.in[3];
    const float* mu = a.in[4]; const float* w0 = a.in[5]; const float* w2 = a.in[6]; const float* a0 = a.in[7];
    const float* a2 = a.in[8]; const float* g2 = a.in[9]; const float* k_k = a.in[10]; const float* k_a = a.in[11];
    const float* r_k = a.in[12]; const float* lnx_g = a.in[13]; const float* lnx_b = a.in[14]; const float* v0 = a.in[15];
    const float* v1 = a.in[16]; const float* v2 = a.in[17]; const float* w_out = a.in[18]; const float* norm2_g = a.in[19];
    const float* wg = a.in[20]; const float* wu = a.in[21]; const float* conv_w = a.in[22]; const float* conv_b = a.in[23];
    const float* wd = a.in[24]; const float* final_g = a.in[25];
    unsigned char* ws = a.ws; float* X = a.out;
    ssq_t* ss = (ssq_t*)(ws + WS_SS);
    bf16_t* XB = (bf16_t*)(ws + WS_XB); bf16_t* PROJ = (bf16_t*)(ws + WS_PROJ); bf16_t* MIX = (bf16_t*)(ws + WS_MIX); bf16_t* HID = (bf16_t*)(ws + WS_HID); bf16_t* VF = (bf16_t*)(ws + WS_VFIRST);
    bf16_t* UT = (bf16_t*)(ws + WS_UTMP); bf16_t* UPT = UT + (size_t)SEQ * FF;

    {
        const int tid = OTID(), lane = tid & 63, wave = tid >> 6, gw = blockIdx.x * 8 + wave;
        float* scr = (float*)lds + wave * (64 * 33 + 16);
        constexpr int I_IN = (D / 64) * (IN_W / 32), I_OUT = (D / 64) * (D / 32), I_G = (D / 64) * (FF / 32), I_DN = (FF / 64) * (D / 32), I_LAYER = I_IN + I_OUT + 2 * I_G + I_DN;
        for (int it = gw; it < 2 * I_LAYER; it += NGW) {
            const int l = it / I_LAYER; int r = it % I_LAYER;
            bf16_t* wl = (bf16_t*)(ws + WS_W + l * W_LAYER); bf16_t* WinT = wl; bf16_t* WoutT = (bf16_t*)((char*)wl + W_IN_SZ); bf16_t* WguT = (bf16_t*)((char*)WoutT + W_OUT_SZ); bf16_t* WdT = (bf16_t*)((char*)WguT + W_GU_SZ);
            if (r < I_IN) { transpose_item(w_in + (size_t)l * D * IN_W, D, IN_W, WinT, norm1_g + l * D, 0, scr, r, lane); continue; } r -= I_IN;
            if (r < I_OUT) { transpose_item(w_out + (size_t)l * D * D, D, D, WoutT, nullptr, 0, scr, r, lane); continue; } r -= I_OUT;
            if (r < I_G) { transpose_item(wg + (size_t)l * D * FF, D, FF, WguT, norm2_g + l * D, 1, scr, r, lane); continue; } r -= I_G;
            if (r < I_G) { transpose_item(wu + (size_t)l * D * FF, D, FF, WguT, norm2_g + l * D, 2, scr, r, lane); continue; } r -= I_G;
            transpose_item(wd + (size_t)l * FF * D, FF, D, WdT, nullptr, 0, scr, r, lane);
        }
        {
            constexpr int I_W2 = 1 * (C / 32), I_G2 = 2 * (C / 32), I_V1 = (C / 64) * 1, I_L = 2 * I_W2 + I_G2;
            const float* mu_v1 = a.in[4] + SHIFT_W + 1024;
            for (int it = gw; it < 2 * I_L + 2 * I_V1; it += NGW) {
                if (it < 2 * I_L) { const int l = it / I_L; int r = it % I_L; bf16_t* base = (bf16_t*)(ws + WS_LORA + l * LORA_LAYER);
                    if (r < I_W2) { transpose_item(w2 + (size_t)l * 64 * C, 64, C, base, nullptr, 0, scr, r, lane); continue; } r -= I_W2;
                    if (r < I_W2) { transpose_item(a2 + (size_t)l * 64 * C, 64, C, base + 512 * 64, nullptr, 0, scr, r, lane); continue; } r -= I_W2;
                    transpose_item(g2 + (size_t)l * 128 * C, 128, C, base + 2 * 512 * 64, nullptr, 0, scr, r, lane); }
                else if (it < 2 * I_L + I_V1) transpose_item(v1, C, 32, (bf16_t*)(ws + WS_V1T), mu_v1, 0, scr, it - 2 * I_L, lane, true);
                else transpose_item(v1, C, 32, (bf16_t*)(ws + WS_V1B), mu_v1, 0, scr, it - 2 * I_L - I_V1, lane, false);
            }
            bf16_t* V2T = (bf16_t*)(ws + WS_V2T);
            for (int i = blockIdx.x * NTHREADS + tid; i < 32 * C; i += G * NTHREADS) { const int j = i / C, ch = i % C; V2T[ch * 32 + j] = (bf16_t)f2bf(v2[i]); }
        }
        for (int m = 4 * gw; m < M; m += 4 * NGW) {
            f32x4 xv[4][4];
#pragma unroll
            for (int u = 0; u < 4; ++u)
#pragma unroll
                for (int j = 0; j < 4; ++j) xv[u][j] = ((const f32x4*)(x + (size_t)(m + u) * D))[lane + 64 * j];
#pragma unroll
            for (int u = 0; u < 4; ++u) { float sq = 0.f;
#pragma unroll
                for (int j = 0; j < 4; ++j) { const f32x4 v = xv[u][j]; sq += v.x * v.x + v.y * v.y + v.z * v.z + v.w * v.w;
                    ((unsigned long long*)(XB + (size_t)(m + u) * D))[lane + 64 * j] = (unsigned long long)(f2bf(v.x) | (f2bf(v.y) << 16)) | ((unsigned long long)(f2bf(v.z) | (f2bf(v.w) << 16)) << 32); }
                sq = wave_sum(sq); if (lane == 0) ss[m + u] = ssq_fix(sq); } }
    }
    GRID_SYNC();
    for (int l = 0; l < 2; ++l) {
        bf16_t* wl = (bf16_t*)(ws + WS_W + l * W_LAYER); bf16_t* WinT = wl; bf16_t* WoutT = (bf16_t*)((char*)wl + W_IN_SZ); bf16_t* WguT = (bf16_t*)((char*)WoutT + W_OUT_SZ); bf16_t* WdT = (bf16_t*)((char*)WguT + W_GU_SZ);
        ssq_t* ss1 = ss + (size_t)(2 * l) * M; ssq_t* ss2 = ss + (size_t)(2 * l + 1) * M; ssq_t* ss3 = ss + (size_t)(2 * l + 2) * M;
        { pg8::Gemm g{XB, WinT, M, IN_W, D}; pg8::StaticOrder S; S.init(M, IN_W, G, (int)blockIdx.x); pg8::EpiScaleBf16 E{PROJ, IN_W, ss1};
          pg8::gemm_phase<pg8::EpiScaleBf16, pg8::StaticOrder, true, true>(LDSP, g, S, E); }
        GRID_SYNC();
        { float* KC = (float*)(lds + CK_CONST_OFF); const int t_ = OTID(); KC[t_] = (k_k + l * C)[t_]; KC[512 + t_] = (k_a + l * C)[t_]; KC[1024 + t_] = (r_k + l * C)[t_]; KC[1536 + t_] = (mu + l * SHIFT_W)[t_]; KC[2048 + t_] = (mu + l * SHIFT_W)[512 + t_]; __syncthreads(); }
        attn_phase(PROJ, sinks + l * NH, MIX, lds, G, OTID());
        struct { bf16_t *V, *G; } p; p.V = (bf16_t*)(ws + WS_SI_V); p.G = (bf16_t*)(ws + WS_SI_G);
        bf16_t* GQ = (bf16_t*)X; bf16_t* CQ = GQ + (size_t)BATCH * NH * 64 * 8192;
        ScanArgs s{}; s.proj = PROJ; s.V = p.V; s.G = p.G; s.k_k = k_k + l * C; s.k_a = k_a + l * C; s.r_k = r_k + l * C; s.lnx_g = lnx_g + l * C; s.lnx_b = lnx_b + l * C; s.mix = MIX; s.rkc = (float*)(ws + WS_RKC);
        { bf16_t* scr = (bf16_t*)(ws + WS_TSCR + (size_t)blockIdx.x * TSCR_WG);
          for (int tile = blockIdx.x; tile < M / 64; tile += G) {
              const size_t moff = (size_t)tile * 64 * C;
              Prep2Args q{}; q.proj = PROJ; q.mu = mu + l * SHIFT_W; q.w0 = w0 + l * C; q.a0 = a0 + l * C; q.v0 = v0;
              const bf16_t* lw = (const bf16_t*)(ws + WS_LORA + l * LORA_LAYER); q.W2T = lw; q.A2T = lw + 512 * 64; q.G2T = lw + 2 * 512 * 64; q.V1T = (const bf16_t*)(ws + WS_V1T); q.V1B = (const bf16_t*)(ws + WS_V1B); q.V2T = (const bf16_t*)(ws + WS_V2T);
              q.vfirst = VF; q.A = scr - moff; q.CS = (unsigned short*)(scr + 64 * C) - moff; q.V = p.V; q.G = p.G; q.layer = l;
              prep_tile(q, lds, tile, OTID());
              asm volatile("s_waitcnt vmcnt(0)" ::: "memory"); __syncthreads();
              if (threadIdx.x == 0) { __builtin_amdgcn_fence(__ATOMIC_ACQUIRE, "agent"); asm volatile("s_waitcnt vmcnt(0)" ::: "memory"); }
              __syncthreads();
              s.A = q.A; s.CS = q.CS;
              const int bb = tile >> 6, chunk = tile & 63;
              CkRaw cur; ck_load(s, cur, ((bb * NH) << 6) + chunk, OTID());
#define CK_UNIT(hh_) do { const int unit = ((bb * NH + (hh_)) << 6) + chunk; CkRaw nxt = cur; ck_precompute(s, cur, nxt, (hh_) + 1 < NH ? unit + 64 : unit, lds, GQ, CQ, unit, OTID()); cur = nxt; } while (0)
              CK_UNIT(0);
              for (int hh = 1; hh < NH; ++hh) CK_UNIT(hh);
#undef CK_UNIT
          } }
        GRID_SYNC();
        for (int item = (int)((blockIdx.x & 7) * (G >> 3) + (blockIdx.x >> 3)); item < BATCH * NH * 4; item += G) ck_sequential(s, lds, GQ, CQ, item, OTID());
        GRID_SYNC();
        { const int tid = OTID(), lane = tid & 63, gw = blockIdx.x * 8 + (tid >> 6); scan_post_wave(s, gw, NGW, lane); }
        GRID_SYNC();
        { pg8::Gemm g{MIX, WoutT, M, D, D}; pg8::StaticOrder S; S.init(M, D, G, (int)blockIdx.x); pg8::EpiResid E{XB, ss2};
          pg8::gemm_phase<pg8::EpiResid, pg8::StaticOrder, true, true>(LDSP, g, S, E); }
        GRID_SYNC();
        { pg8::Gemm g{XB, WguT, M, 2 * FF, D}; pg8::StaticOrder S; S.init(M, 2 * FF, G, (int)blockIdx.x);
          pg8::EpiConvGlu E{HID, ss2, conv_w + (size_t)l * 3 * FF, conv_b + (size_t)l * FF, (float*)(ws + WS_UTMP), (PG8_LAS float*)(LDSP + XCH_OFF), FF};
          pg8::gemm_phase<pg8::EpiConvGlu, pg8::StaticOrder, true, true>(LDSP, g, S, E); }
        GRID_SYNC();
        { pg8::Gemm g{HID, WdT, M, D, FF}; pg8::StaticOrder S; S.init(M, D, G, (int)blockIdx.x);
          { pg8::Unit u; for (int i = 0; S.next(i, u); ++i) ffn_fixup((const float*)(ws + WS_UTMP), conv_w + (size_t)l * 3 * FF, conv_b + (size_t)l * FF, HID, u.pm, OTID());
            asm volatile("s_waitcnt vmcnt(0)" ::: "memory"); __syncthreads(); }
          if (l == 0) { pg8::EpiResid E{XB, ss3}; pg8::gemm_phase<pg8::EpiResid, pg8::StaticOrder, true, true>(LDSP, g, S, E); }
          else { pg8::EpiResidFinal E{XB, ss3, (unsigned*)(ws + WS_FCNT), final_g, X};
                 pg8::gemm_phase<pg8::EpiResidFinal, pg8::StaticOrder, true, true>(LDSP, g, S, E); } }
        if (l == 0) GRID_SYNC();
    }
}

extern "C" void kernel_launch(void* const* d_in, const int* in_sizes, int n_in, void* d_out, int out_size, void* d_ws, size_t ws_size, hipStream_t stream) {
    static int grid = 0;
    if (grid == 0) {
        if (n_in != 26 || in_sizes[0] != M * D || out_size != M * D || ws_size < WS_END) { fprintf(stderr, "kernel_launch: unexpected shapes (n_in %d, ws %zu)\n", n_in, ws_size); grid = -1; return; }
        int dev = 0, cus = 0, per_cu = 0;
        if (hipGetDevice(&dev) != hipSuccess || hipDeviceGetAttribute(&cus, hipDeviceAttributeMultiprocessorCount, dev) != hipSuccess) { grid = -1; return; }
        if (hipFuncSetAttribute((const void*)mega_fwd, hipFuncAttributeMaxDynamicSharedMemorySize, LDS_BYTES) != hipSuccess) { fprintf(stderr, "kernel_launch: hipFuncSetAttribute failed\n"); grid = -1; return; }
        if (hipOccupancyMaxActiveBlocksPerMultiprocessor(&per_cu, (const void*)mega_fwd, NTHREADS, LDS_BYTES) != hipSuccess || per_cu < 1) { fprintf(stderr, "kernel_launch: occupancy query failed (%d)\n", per_cu); grid = -1; return; }
        grid = cus;
    }
    if (grid < 0) return;
    (void)hipMemsetAsync((unsigned char*)d_ws + WS_CTL, 0, CTL_BYTES, stream);
    Args a{};
    for (int i = 0; i < 26; ++i) a.in[i] = (const float*)d_in[i];
    a.out = (float*)d_out; a.ws = (unsigned char*)d_ws;
    void* kargs[] = {&a};
    hipError_t e = hipLaunchCooperativeKernel((const void*)mega_fwd, dim3(grid), dim3(NTHREADS), kargs, LDS_BYTES, stream);
    if (e != hipSuccess) fprintf(stderr, "kernel_launch: cooperative launch failed: %s (grid %d)\n", hipGetErrorString(e), grid);
}
```

```cpp
#include <hip/hip_runtime.h>
#include <cstdio>
#include <cstdint>

typedef unsigned short bf16_t;
typedef short bf16x8 __attribute__((ext_vector_type(8)));
typedef float f32x4 __attribute__((ext_vector_type(4)));

constexpr int BATCH = 8, SEQ = 4096, D = 1024, M = BATCH * SEQ;
constexpr int HD = 64, ATT_W = 512, KV_W = 128, C = 512, NH = 8;
constexpr int ATT_IN = 768, SHIFT_W = 1792, IN_W = 2560, FF = 2816;
constexpr int WINDOW = 128;
constexpr float RMS_EPS = 1e-5f, LNX_EPS = 64e-5f;

constexpr size_t MiB = 1u << 20;
constexpr size_t WS_CTL = 0;
typedef unsigned long long ssq_t;
__device__ __forceinline__ ssq_t ssq_fix(float s) { return (ssq_t)(s * 1048576.0f + 0.5f); }
__device__ __forceinline__ float ssq_val(ssq_t v) { return (float)v * (1.0f / 1048576.0f); }
constexpr size_t WS_SS = 0;
constexpr size_t CTL_BYTES = 2 * MiB;
constexpr size_t WS_FCNT = 1792 * 1024;
constexpr size_t WS_BAR = 1536 * 1024;
constexpr size_t WS_W = 2 * MiB;
constexpr size_t W_IN_SZ = (size_t)IN_W * D * 2, W_OUT_SZ = (size_t)D * D * 2, W_GU_SZ = (size_t)2 * FF * D * 2, W_DN_SZ = (size_t)D * FF * 2;
constexpr size_t W_LAYER = W_IN_SZ + W_OUT_SZ + W_GU_SZ + W_DN_SZ;
constexpr size_t WS_VFIRST = 52 * MiB, WS_MIX = 84 * MiB, WS_XB = 148 * MiB, WS_PROJ = 212 * MiB;
constexpr size_t WS_SI_R = 148 * MiB, WS_SI_K = 180 * MiB, WS_SI_V = 372 * MiB, WS_SI_A = 404 * MiB, WS_SI_LD = 436 * MiB, WS_SI_G = 468 * MiB;
constexpr size_t WS_HID = 212 * MiB;
constexpr size_t WS_UTMP = 84 * MiB;
constexpr size_t WS_END = 500 * MiB;
static_assert(WS_W + 2 * W_LAYER <= WS_VFIRST, "weights fit");

__device__ __forceinline__ unsigned f2bf(float f) { unsigned u = __builtin_bit_cast(unsigned, f); return (u + 0x7fffu + ((u >> 16) & 1u)) >> 16; }
__device__ __forceinline__ float bf2f(bf16_t h) { return __builtin_bit_cast(float, (unsigned)h << 16); }
__device__ __forceinline__ float wave_sum(float v) {
#pragma unroll
    for (int o = 1; o < 64; o <<= 1) v += __shfl_xor(v, o);
    return v;
}
#define LDS_BARRIER() do { asm volatile("s_waitcnt lgkmcnt(0)" ::: "memory"); __builtin_amdgcn_s_barrier(); asm volatile("" ::: "memory"); } while (0)
__device__ __forceinline__ float sigmoidf_(float x) { return __builtin_amdgcn_rcpf(1.f + __expf(-x)); }

namespace pg8 {
#define PG8_LAS __attribute__((address_space(3)))
typedef unsigned short bf16_t;
typedef short bf16x8 __attribute__((ext_vector_type(8)));
typedef float f32x4 __attribute__((ext_vector_type(4)));
typedef unsigned u32x4 __attribute__((ext_vector_type(4)));
constexpr int BM = 256, BK = 64, HALF = 128, HTB = HALF * BK * 2  , STAGE_BYTES = 8 * HTB, NXCD = 8, WGM = 8;

__host__ __device__ __forceinline__ int lds_byte(int r, int c) { const int st = (r >> 4) * 2 + (c >> 5), rr = r & 15, cc = c & 31, ob = rr * 64 + cc * 2; return st * 1024 + (ob ^ (((ob >> 9) & 1) << 5)); }
__host__ __device__ __forceinline__ void stage_rc(int b, int& R, int& C) { const int st = b / 1024, sb = b % 1024, swz = sb ^ (((sb >> 9) & 1) << 5); R = (st >> 1) * 16 + swz / 64; C = (st & 1) * 32 + (swz % 64) / 2; }
__host__ __device__ __forceinline__ int perm32(int rho) { const int n = rho >> 4, i = rho & 15; return 8 * (i >> 2) + 4 * n + (i & 3); }

struct Unit { int pm, pn; };
struct Gemm { const bf16_t* A; const bf16_t* Bt; int M, N, K; };

struct StaticOrder {
    int nM, nN, nwg, G, c;
    __host__ __device__ void init(int M, int N, int G_, int c_) { nM = M / BM; nN = N / BM; nwg = nM * nN; G = G_; c = c_; }
    __host__ __device__ bool next(int i, Unit& u) const {
        const long L = (long)i * G + c; if (L >= nwg) return false;
        int wgid = (int)L; { const int q = nwg / NXCD, r = nwg % NXCD, xcd = wgid % NXCD, off = wgid / NXCD; wgid = (xcd < r ? xcd * (q + 1) : r * (q + 1) + (xcd - r) * q) + off; }
        const int nig = WGM * nN, gid = wgid / nig, fm = gid * WGM, gsz = (nM - fm) < WGM ? (nM - fm) : WGM;
        u.pm = fm + ((wgid % nig) % gsz); u.pn = (wgid % nig) / gsz; return true;
    }
    __device__ __forceinline__ void a_ready(const Unit&) const {}
    __device__ __forceinline__ void done(const Unit&) const {}
};
typedef float f32x2_t_ __attribute__((ext_vector_type(2))); typedef __bf16 bf16x2_t_ __attribute__((ext_vector_type(2)));
__device__ __forceinline__ unsigned cvt_pk_bf16(float lo, float hi) { const f32x2_t_ v = {lo, hi}; const bf16x2_t_ b = __builtin_convertvector(v, bf16x2_t_); return __builtin_bit_cast(unsigned, b); }
typedef float f32x2 __attribute__((ext_vector_type(2)));
template <class Epi, class Sched, bool ALIGN_EPI = false, bool SP2 = false>
__device__ __forceinline__ void gemm_phase(PG8_LAS unsigned char* lds, const Gemm g, const Sched& S, const Epi& E) {
    int tid_ = threadIdx.x; asm volatile("" : "+v"(tid_));
    const int tid = tid_, wid = __builtin_amdgcn_readfirstlane(tid >> 6), lane = tid & 63, wr = wid >> 2, wc = wid & 3, fr = lane & 15, fq = lane >> 4;
    const int K = g.K, nt = K / BK;
    unsigned voffA[2], voffB[2];
#pragma unroll
    for (int i = 0; i < 2; ++i) { int R, C; stage_rc(tid * 16 + i * 8192, R, C); const int Rb = (R >> 5) * 64 + (Epi::PERM ? perm32(R & 31) : (R & 31));
        voffA[i] = (unsigned)(R * K + C) * 2u; voffB[i] = (unsigned)(Rb * K + C) * 2u; }
    const size_t kstep = (size_t)(BK * 2);
    const size_t hstep = (size_t)HALF * K * 2;
    const size_t tstep = 2 * hstep;
    const size_t hstepB = (size_t)32 * K * 2;
    const unsigned ldsw = (unsigned)wid * 1024u;
    const int aoff = lds_byte(wr * 64 + fr, fq * 8), boff = lds_byte(wc * 32 + fr, fq * 8);
#define PG8_SA(b, h) (((b) * 2 + (h)) * HTB)
#define PG8_SB(b, h) ((4 + (b) * 2 + (h)) * HTB)
#define PG8_STAGE(bufoff, gbase, voff) do { _Pragma("unroll") for (int _i = 0; _i < 2; ++_i) \
        __builtin_amdgcn_global_load_lds((const unsigned*)((const char*)(gbase) + (voff)[_i]), (PG8_LAS unsigned*)(lds + (bufoff) + ldsw + _i * 8192), 16, 0, 0); } while (0)
#define PG8_LDA(dst, b, h) do { _Pragma("unroll") for (int m = 0; m < 4; ++m) _Pragma("unroll") for (int k = 0; k < 2; ++k) dst[m][k] = *(const PG8_LAS bf16x8*)(lds + PG8_SA(b, h) + aoff + m * 2048 + k * 1024); } while (0)
#define PG8_LDB(dst, b, h) do { _Pragma("unroll") for (int n = 0; n < 2; ++n) _Pragma("unroll") for (int k = 0; k < 2; ++k) dst[n][k] = *(const PG8_LAS bf16x8*)(lds + PG8_SB(b, h) + boff + n * 2048 + k * 1024); } while (0)
#define PG8_MMA(ai, bj, At, Bt) do { __builtin_amdgcn_s_setprio(1); _Pragma("unroll") for (int m = 0; m < 4; ++m) _Pragma("unroll") for (int n = 0; n < 2; ++n) _Pragma("unroll") for (int k = 0; k < 2; ++k) \
        acc[ai][bj][m][n] = __builtin_amdgcn_mfma_f32_16x16x32_bf16(Bt[n][k], At[m][k], acc[ai][bj][m][n], 0, 0, 0); __builtin_amdgcn_s_setprio(0); } while (0)
#define PG8_WAIT_V(n) asm volatile("s_waitcnt vmcnt(" #n ")" ::: "memory")
#define PG8_WAIT_L(n) asm volatile("s_waitcnt lgkmcnt(" #n ")" ::: "memory")
#define PG8_BAR __builtin_amdgcn_s_barrier()
#define PG8_SCHED __builtin_amdgcn_sched_barrier(0)
    Unit cur, nxt; int ui = 0;
    if (!S.next(0, cur)) return;
    f32x4 acc[2][2][4][2];
#pragma unroll
    for (int a = 0; a < 2; ++a)
#pragma unroll
        for (int b = 0; b < 2; ++b)
#pragma unroll
            for (int m = 0; m < 4; ++m)
#pragma unroll
                for (int n = 0; n < 2; ++n) acc[a][b][m][n] = (f32x4){0.f, 0.f, 0.f, 0.f};
    bf16x8 At[4][2], B0[2][2], B1[2][2];
    const char* cA = (const char*)g.A + (size_t)cur.pm * tstep; const char* cB = (const char*)g.Bt + (size_t)cur.pn * tstep;
    S.a_ready(cur);
    if constexpr (SP2) {
        PG8_STAGE(PG8_SB(0, 0), cB, voffB); PG8_STAGE(PG8_SB(0, 1), cB + hstepB, voffB); PG8_STAGE(PG8_SA(0, 0), cA, voffA); PG8_STAGE(PG8_SA(0, 1), cA + hstep, voffA);
        if (wr == 1) PG8_BAR;
        PG8_WAIT_V(2); PG8_BAR;
        PG8_STAGE(PG8_SB(1, 0), cB + kstep, voffB); PG8_STAGE(PG8_SA(1, 0), cA + kstep, voffA); PG8_STAGE(PG8_SB(1, 1), cB + hstepB + kstep, voffB);
        PG8_WAIT_V(6); PG8_BAR;
    } else {
        PG8_STAGE(PG8_SB(0, 0), cB, voffB); PG8_STAGE(PG8_SA(0, 0), cA, voffA); PG8_STAGE(PG8_SB(0, 1), cB + hstepB, voffB); PG8_STAGE(PG8_SA(0, 1), cA + hstep, voffA);
        if (wr == 1) PG8_BAR;
        PG8_WAIT_V(4); PG8_BAR;
        PG8_STAGE(PG8_SB(1, 0), cB + kstep, voffB); PG8_STAGE(PG8_SA(1, 0), cA + kstep, voffA); PG8_STAGE(PG8_SB(1, 1), cB + hstepB + kstep, voffB);
        PG8_WAIT_V(6); PG8_BAR;
    }
    for (;;) {
        const bool has_next = S.next(ui + 1, nxt);
        const char* nA = has_next ? (const char*)g.A + (size_t)nxt.pm * tstep : cA; const char* nB = has_next ? (const char*)g.Bt + (size_t)nxt.pn * tstep : cB;
        for (int t = 0; t < nt; t += 2) {
            const bool last = (t == nt - 2);
            const char* a1 = cA + (size_t)(t + 1) * kstep;
            const char* a2 = last ? nA : cA + (size_t)(t + 2) * kstep; const char* b2 = last ? nB : cB + (size_t)(t + 2) * kstep;
            const char* a3 = a2 + kstep; const char* b3 = b2 + kstep;
            if (last && has_next) S.a_ready(nxt);
            if constexpr (SP2) {
            PG8_LDB(B0, 0, 0); PG8_LDB(B1, 0, 1); PG8_SCHED; PG8_LDA(At, 0, 0); PG8_STAGE(PG8_SA(1, 1), a1 + hstep, voffA);
            PG8_WAIT_V(8); PG8_WAIT_L(0); PG8_BAR; PG8_MMA(0, 0, At, B0); PG8_MMA(0, 1, At, B1); PG8_BAR; PG8_SCHED;
            PG8_LDA(At, 0, 1); PG8_STAGE(PG8_SB(0, 0), b2, voffB); PG8_STAGE(PG8_SB(0, 1), b2 + hstepB, voffB); PG8_STAGE(PG8_SA(0, 0), a2, voffA);
            PG8_WAIT_V(8); PG8_WAIT_L(0); PG8_BAR; PG8_MMA(1, 0, At, B0); PG8_MMA(1, 1, At, B1); PG8_BAR; PG8_SCHED;
            PG8_LDB(B0, 1, 0); PG8_LDB(B1, 1, 1); PG8_SCHED; PG8_LDA(At, 1, 0); PG8_STAGE(PG8_SA(0, 1), a2 + hstep, voffA);
            PG8_WAIT_V(8); PG8_WAIT_L(0); PG8_BAR; PG8_MMA(0, 0, At, B0); PG8_MMA(0, 1, At, B1); PG8_BAR; PG8_SCHED;
            PG8_LDA(At, 1, 1); PG8_STAGE(PG8_SB(1, 0), b3, voffB); PG8_STAGE(PG8_SB(1, 1), b3 + hstepB, voffB); PG8_STAGE(PG8_SA(1, 0), a3, voffA);
            PG8_WAIT_V(8); PG8_WAIT_L(0); PG8_BAR; PG8_MMA(1, 0, At, B0); PG8_MMA(1, 1, At, B1); PG8_BAR; PG8_SCHED;
            } else {
            PG8_LDB(B0, 0, 0); PG8_SCHED; PG8_LDA(At, 0, 0); PG8_STAGE(PG8_SA(1, 1), a1 + hstep, voffA);
            PG8_WAIT_L(8); PG8_BAR; PG8_WAIT_L(0); PG8_MMA(0, 0, At, B0); PG8_BAR; PG8_SCHED;
            PG8_LDB(B1, 0, 1); PG8_STAGE(PG8_SB(0, 0), b2, voffB);
            PG8_BAR; PG8_WAIT_L(0); PG8_MMA(0, 1, At, B1); PG8_BAR;
            PG8_LDA(At, 0, 1); PG8_STAGE(PG8_SA(0, 0), a2, voffA);
            PG8_BAR; PG8_WAIT_L(0); PG8_MMA(1, 0, At, B0); PG8_BAR; PG8_SCHED;
            PG8_STAGE(PG8_SB(0, 1), b2 + hstepB, voffB);
            PG8_WAIT_V(6); PG8_BAR; PG8_MMA(1, 1, At, B1); PG8_BAR;
            PG8_LDB(B0, 1, 0); PG8_SCHED; PG8_LDA(At, 1, 0); PG8_STAGE(PG8_SA(0, 1), a2 + hstep, voffA);
            PG8_WAIT_L(8); PG8_BAR; PG8_WAIT_L(0); PG8_MMA(0, 0, At, B0); PG8_BAR; PG8_SCHED;
            PG8_LDB(B1, 1, 1); PG8_STAGE(PG8_SB(1, 0), b3, voffB);
            PG8_BAR; PG8_WAIT_L(0); PG8_MMA(0, 1, At, B1); PG8_BAR;
            PG8_LDA(At, 1, 1); PG8_STAGE(PG8_SA(1, 0), a3, voffA);
            PG8_BAR; PG8_WAIT_L(0); PG8_MMA(1, 0, At, B0); PG8_BAR; PG8_SCHED;
            PG8_STAGE(PG8_SB(1, 1), b3 + hstepB, voffB);
            PG8_WAIT_V(6); PG8_BAR; PG8_MMA(1, 1, At, B1); PG8_BAR;
            }
        }
        if constexpr (ALIGN_EPI) { if (wr == 0) PG8_BAR; }
        if constexpr (!Epi::AFTER_DRAIN) { E(acc, cur, wr, wc, fr, fq); S.done(cur); }
        if (!has_next) break;
#pragma unroll
        for (int a = 0; a < 2; ++a)
#pragma unroll
            for (int b = 0; b < 2; ++b)
#pragma unroll
                for (int m = 0; m < 4; ++m)
#pragma unroll
                    for (int n = 0; n < 2; ++n) acc[a][b][m][n] = (f32x4){0.f, 0.f, 0.f, 0.f};
        cur = nxt; cA = nA; cB = nB; ++ui;
        if constexpr (ALIGN_EPI) { if (wr == 1) PG8_BAR; }
    }
    PG8_WAIT_V(0);
    if constexpr (!ALIGN_EPI) { if (wr == 0) PG8_BAR; }
    PG8_BAR;
    if constexpr (Epi::AFTER_DRAIN) { E.fused(acc, cur, wr, wc, fr, fq, lds, wid, lane); S.done(cur); }
#undef PG8_SA
#undef PG8_SB
#undef PG8_STAGE
#undef PG8_LDA
#undef PG8_LDB
#undef PG8_MMA
#undef PG8_WAIT_V
#undef PG8_WAIT_L
#undef PG8_BAR
#undef PG8_SCHED
}

constexpr int DM_ = 1024; constexpr float RMS_EPS_ = 1e-5f;
typedef unsigned long long ssq_t;
struct EpiScaleBf16 {
    static constexpr bool PERM = true, AFTER_DRAIN = false;
    bf16_t* O; int ldc; const ssq_t* ss;
    __device__ __forceinline__ void operator()(const f32x4 (&acc)[2][2][4][2], const Unit& u, int wr, int wc, int fr, int fq) const {
        const int row0 = u.pm * BM + wr * 64 + fr, col0 = u.pn * BM + wc * 64 + 8 * fq;
        float rsv[2][4];
#pragma unroll
        for (int ai = 0; ai < 2; ++ai)
#pragma unroll
            for (int m = 0; m < 4; ++m) rsv[ai][m] = (float)ss[row0 + ai * HALF + m * 16] * (1.0f / 1048576.0f);
#pragma unroll
        for (int ai = 0; ai < 2; ++ai)
#pragma unroll
            for (int m = 0; m < 4; ++m) { const int row = row0 + ai * HALF + m * 16; const float rs = __builtin_amdgcn_rsqf(rsv[ai][m] * (1.0f / DM_) + RMS_EPS_); bf16_t* rowp = O + (size_t)row * ldc + col0;
#pragma unroll
                for (int bj = 0; bj < 2; ++bj) { const f32x4 v0 = acc[ai][bj][m][0] * rs, v1 = acc[ai][bj][m][1] * rs;
                    u32x4 w; w.x = cvt_pk_bf16(v0[0], v0[1]); w.y = cvt_pk_bf16(v0[2], v0[3]); w.z = cvt_pk_bf16(v1[0], v1[1]); w.w = cvt_pk_bf16(v1[2], v1[3]);
                    *(u32x4*)(rowp + bj * 32) = w; } }
    }
};
struct EpiResid {
    static constexpr bool PERM = true, AFTER_DRAIN = false;
    bf16_t* xb; ssq_t* ss_out;
    __device__ __forceinline__ void operator()(const f32x4 (&acc)[2][2][4][2], const Unit& u, int wr, int wc, int fr, int fq) const {
        const int row0 = u.pm * BM + wr * 64 + fr, col0 = u.pn * BM + wc * 64 + 8 * fq;
#pragma unroll
        for (int ai = 0; ai < 2; ++ai) {
            u32x4 bs[4][2];
#pragma unroll
            for (int m = 0; m < 4; ++m)
#pragma unroll
                for (int bj = 0; bj < 2; ++bj) bs[m][bj] = *(const u32x4*)(xb + (size_t)(row0 + ai * HALF + m * 16) * DM_ + col0 + bj * 32);
#pragma unroll
            for (int m = 0; m < 4; ++m) { const int row = row0 + ai * HALF + m * 16; bf16_t* rp = xb + (size_t)row * DM_ + col0; float sq = 0.f;
#pragma unroll
                for (int bj = 0; bj < 2; ++bj) { const u32x4 b = bs[m][bj]; u32x4 w;
#pragma unroll
                    for (int hh = 0; hh < 2; ++hh) { const unsigned b0 = hh == 0 ? b.x : b.z, b1 = hh == 0 ? b.y : b.w; const f32x4 a4 = acc[ai][bj][m][hh];
                        const float x0 = __builtin_bit_cast(float, b0 << 16) + a4[0], x1 = __builtin_bit_cast(float, b0 & 0xffff0000u) + a4[1], x2 = __builtin_bit_cast(float, b1 << 16) + a4[2], x3 = __builtin_bit_cast(float, b1 & 0xffff0000u) + a4[3];
                        const unsigned w0 = cvt_pk_bf16(x0, x1), w1 = cvt_pk_bf16(x2, x3);
                        if (hh == 0) { w.x = w0; w.y = w1; } else { w.z = w0; w.w = w1; }
                        const float r0 = __builtin_bit_cast(float, w0 << 16), r1 = __builtin_bit_cast(float, w0 & 0xffff0000u), r2 = __builtin_bit_cast(float, w1 << 16), r3 = __builtin_bit_cast(float, w1 & 0xffff0000u);
                        sq += (r0 * r0 + r1 * r1) + (r2 * r2 + r3 * r3); }
                    *(u32x4*)(rp + bj * 32) = w; }
                sq += __shfl_xor(sq, 16); sq += __shfl_xor(sq, 32);
                if (fq == 0) atomicAdd(ss_out + row, (ssq_t)(sq * 1048576.0f + 0.5f)); }
        }
    }
};
struct EpiResidFinal {
    static constexpr bool PERM = true, AFTER_DRAIN = false;
    const bf16_t* xb; ssq_t* ss_out; unsigned* cnt; const float* g; float* out;
    __device__ __forceinline__ void operator()(f32x4 (&acc)[2][2][4][2], const Unit& u, int wr, int wc, int fr, int fq) const {
        const int row0 = u.pm * BM + wr * 64 + fr, col0 = u.pn * BM + wc * 64 + 8 * fq;
#pragma unroll
        for (int ai = 0; ai < 2; ++ai) {
            u32x4 bs[4][2];
#pragma unroll
            for (int m = 0; m < 4; ++m)
#pragma unroll
                for (int bj = 0; bj < 2; ++bj) bs[m][bj] = *(const u32x4*)(xb + (size_t)(row0 + ai * HALF + m * 16) * DM_ + col0 + bj * 32);
#pragma unroll
            for (int m = 0; m < 4; ++m) { const int row = row0 + ai * HALF + m * 16; float sq = 0.f;
#pragma unroll
                for (int bj = 0; bj < 2; ++bj) { const u32x4 b = bs[m][bj];
#pragma unroll
                    for (int hh = 0; hh < 2; ++hh) { const unsigned b0 = hh == 0 ? b.x : b.z, b1 = hh == 0 ? b.y : b.w; const f32x4 a4 = acc[ai][bj][m][hh];
                        const float x0 = __builtin_bit_cast(float, b0 << 16) + a4[0], x1 = __builtin_bit_cast(float, b0 & 0xffff0000u) + a4[1], x2 = __builtin_bit_cast(float, b1 << 16) + a4[2], x3 = __builtin_bit_cast(float, b1 & 0xffff0000u) + a4[3];
                        const unsigned w0 = cvt_pk_bf16(x0, x1), w1 = cvt_pk_bf16(x2, x3);
                        const float r0 = __builtin_bit_cast(float, w0 << 16), r1 = __builtin_bit_cast(float, w0 & 0xffff0000u), r2 = __builtin_bit_cast(float, w1 << 16), r3 = __builtin_bit_cast(float, w1 & 0xffff0000u);
                        acc[ai][bj][m][hh] = (f32x4){r0, r1, r2, r3};
                        sq += (r0 * r0 + r1 * r1) + (r2 * r2 + r3 * r3); } }
                sq += __shfl_xor(sq, 16); sq += __shfl_xor(sq, 32);
                if (fq == 0) atomicAdd(ss_out + row, (ssq_t)(sq * 1048576.0f + 0.5f)); }
        }
        asm volatile("s_waitcnt vmcnt(0)" ::: "memory"); __builtin_amdgcn_s_barrier(); asm volatile("" ::: "memory");
        if (wr == 0 && wc == 0 && fr == 0 && fq == 0) {
            (void)__hip_atomic_fetch_add(cnt + u.pm, 1u, __ATOMIC_RELAXED, __HIP_MEMORY_SCOPE_AGENT);
            for (unsigned sp = 0; __hip_atomic_load(cnt + u.pm, __ATOMIC_RELAXED, __HIP_MEMORY_SCOPE_AGENT) < 4u && sp < (1u << 22); ++sp) __builtin_amdgcn_s_sleep(2);
        }
        asm volatile("s_waitcnt vmcnt(0)" ::: "memory"); __builtin_amdgcn_s_barrier(); asm volatile("" ::: "memory");
        f32x4 gv[2][2];
#pragma unroll
        for (int bj = 0; bj < 2; ++bj)
#pragma unroll
            for (int hh = 0; hh < 2; ++hh) gv[bj][hh] = *(const f32x4*)(g + col0 + bj * 32 + 4 * hh);
#pragma unroll
        for (int ai = 0; ai < 2; ++ai)
#pragma unroll
            for (int m = 0; m < 4; ++m) { const int row = row0 + ai * HALF + m * 16;
                const ssq_t sv = __hip_atomic_load(ss_out + row, __ATOMIC_RELAXED, __HIP_MEMORY_SCOPE_AGENT);
                const float rs = __builtin_amdgcn_rsqf((float)sv * (1.0f / 1048576.0f) * (1.0f / DM_) + RMS_EPS_); float* op = out + (size_t)row * DM_ + col0;
#pragma unroll
                for (int bj = 0; bj < 2; ++bj)
#pragma unroll
                    for (int hh = 0; hh < 2; ++hh) *(f32x4*)(op + bj * 32 + 4 * hh) = acc[ai][bj][m][hh] * gv[bj][hh] * rs; }
    }
};
template <int CTRL> __device__ __forceinline__ float dpp1(float x) { return __builtin_bit_cast(float, __builtin_amdgcn_update_dpp(0, __builtin_bit_cast(int, x), CTRL, 0xF, 0xF, true)); }
template <int CTRL> __device__ __forceinline__ f32x4 dpp4(const f32x4 x) { return (f32x4){dpp1<CTRL>(x.x), dpp1<CTRL>(x.y), dpp1<CTRL>(x.z), dpp1<CTRL>(x.w)}; }
struct EpiConvGlu {
    static constexpr bool PERM = true, AFTER_DRAIN = false;
    bf16_t* HID; const ssq_t* ss; const float* cw; const float* cb; float* SB; PG8_LAS float* xch; int ff;
    __device__ __forceinline__ void operator()(const f32x4 (&acc)[2][2][4][2], const Unit& u, int wr, int wc, int fr, int fq) const {
        const int row0 = u.pm * BM + wr * 64 + fr, cl = wc * 32 + 8 * fq, jcol = u.pn * HALF + cl;
        float rs[2][4];
#pragma unroll
        for (int ai = 0; ai < 2; ++ai)
#pragma unroll
            for (int m = 0; m < 4; ++m) rs[ai][m] = (float)ss[row0 + ai * HALF + m * 16] * (1.0f / 1048576.0f);
        f32x4 w0[2], w1[2], w2[2], bb[2];
#pragma unroll
        for (int n = 0; n < 2; ++n) { w0[n] = *(const f32x4*)(cw + jcol + 4 * n); w1[n] = *(const f32x4*)(cw + ff + jcol + 4 * n); w2[n] = *(const f32x4*)(cw + 2 * ff + jcol + 4 * n); bb[n] = *(const f32x4*)(cb + jcol + 4 * n); }
#pragma unroll
        for (int ai = 0; ai < 2; ++ai)
#pragma unroll
            for (int m = 0; m < 4; ++m) rs[ai][m] = __builtin_amdgcn_rsqf(rs[ai][m] * (1.0f / DM_) + RMS_EPS_);
        if (fr >= 14) {
#pragma unroll
            for (int ai = 0; ai < 2; ++ai)
#pragma unroll
                for (int n = 0; n < 2; ++n) *(PG8_LAS f32x4*)(xch + ((2 * ai + wr) * 2 + (fr - 14)) * HALF + cl + 4 * n) = acc[ai][0][3][n] * rs[ai][3];
        }
        asm volatile("s_waitcnt lgkmcnt(0)" ::: "memory"); __builtin_amdgcn_s_barrier(); asm volatile("" ::: "memory");
        float* sbp = SB + (size_t)u.pm * 6 * ff + jcol;
#pragma unroll
        for (int ai = 0; ai < 2; ++ai) {
            const int q = 2 * ai + wr;
            f32x4 X[2];
#pragma unroll
            for (int n = 0; n < 2; ++n) { X[n] = (f32x4){0.f, 0.f, 0.f, 0.f}; if (q > 0 && fr >= 14) X[n] = *(const PG8_LAS f32x4*)(xch + ((q - 1) * 2 + (fr - 14)) * HALF + cl + 4 * n); }
            f32x4 prevg[2] = {X[0], X[1]};
#pragma unroll
            for (int m = 0; m < 4; ++m) { const int row = row0 + ai * HALF + m * 16;
                pg8::u32x4 hw;
#pragma unroll
                for (int n = 0; n < 2; ++n) {
                    const f32x4 cur = acc[ai][0][m][n] * rs[ai][m], up = acc[ai][1][m][n] * rs[ai][m];
                    const f32x4 P = prevg[n]; prevg[n] = cur;
                    f32x4 z1, z2;
#pragma unroll
                    for (int e = 0; e < 4; ++e) { z1[e] = fr == 15 ? P[e] : cur[e]; z2[e] = fr >= 14 ? P[e] : cur[e]; }
                    const f32x4 p1 = dpp4<0x121>(z1), p2 = dpp4<0x122>(z2);
                    const f32x4 c = bb[n] + w0[n] * p2 + w1[n] * p1 + w2[n] * cur;
                    f32x4 hv;
#pragma unroll
                    for (int e = 0; e < 4; ++e) hv[e] = c[e] * __builtin_amdgcn_rcpf(1.f + __expf(-c[e])) * up[e];
                    if (n == 0) { hw.x = cvt_pk_bf16(hv[0], hv[1]); hw.y = cvt_pk_bf16(hv[2], hv[3]); } else { hw.z = cvt_pk_bf16(hv[0], hv[1]); hw.w = cvt_pk_bf16(hv[2], hv[3]); }
                    if (q == 0 && m == 0 && fr < 2) { *(f32x4*)(sbp + (size_t)fr * ff + 4 * n) = cur; *(f32x4*)(sbp + (size_t)(2 + fr) * ff + 4 * n) = up; }
                    if (q == 3 && m == 3 && fr >= 14) *(f32x4*)(sbp + (size_t)(4 + fr - 14) * ff + 4 * n) = cur;
                }
                *(pg8::u32x4*)(HID + (size_t)row * ff + jcol) = hw; }
        }
    }
};
}

#define LAS __attribute__((address_space(3)))
__device__ __forceinline__ void transpose_item(const float* __restrict__ W, int K, int N, bf16_t* __restrict__ Wt, const float* __restrict__ g, int mode, float* scr, int item, int lane, bool gcompl = false) {
    const int nblk = N / 32, kb = item / nblk, nb = item % nblk, k0 = 64 * kb, n0 = 32 * nb;
    int np0 = n0; if (mode != 0) np0 = 256 * (n0 / 128) + 64 * ((n0 % 128) / 32) + (mode == 2 ? 32 : 0);
    f32x4 wv[8];
#pragma unroll
    for (int i = 0; i < 8; ++i) wv[i] = *(const f32x4*)(W + (size_t)(k0 + (lane >> 3) + 8 * i) * N + n0 + (lane & 7) * 4);
#pragma unroll
    for (int i = 0; i < 8; ++i) { const int kk = (lane >> 3) + 8 * i; const float gs = g ? (gcompl ? 1.f - g[k0 + kk] : g[k0 + kk]) : 1.f; float* d = scr + kk * 33 + (lane & 7) * 4; d[0] = wv[i].x * gs; d[1] = wv[i].y * gs; d[2] = wv[i].z * gs; d[3] = wv[i].w * gs; }
    __builtin_amdgcn_fence(__ATOMIC_RELEASE, "wavefront"); __builtin_amdgcn_wave_barrier(); __builtin_amdgcn_fence(__ATOMIC_ACQUIRE, "wavefront");
    const int c = lane & 7;
#pragma unroll
    for (int j = 0; j < 4; ++j) { const int n = (lane >> 3) + 8 * j; const float* sp = scr + (8 * c) * 33 + n;
        uint4 o; o.x = f2bf(sp[0]) | (f2bf(sp[33]) << 16); o.y = f2bf(sp[2 * 33]) | (f2bf(sp[3 * 33]) << 16); o.z = f2bf(sp[4 * 33]) | (f2bf(sp[5 * 33]) << 16); o.w = f2bf(sp[6 * 33]) | (f2bf(sp[7 * 33]) << 16);
        *(uint4*)(Wt + (size_t)(np0 + n) * K + k0 + 8 * c) = o; }
    __builtin_amdgcn_fence(__ATOMIC_RELEASE, "wavefront"); __builtin_amdgcn_wave_barrier(); __builtin_amdgcn_fence(__ATOMIC_ACQUIRE, "wavefront");
}
constexpr size_t WS_LORA = 50 * MiB;
constexpr size_t LORA_LAYER = 256 * 1024, WS_V1T = WS_LORA + 2 * LORA_LAYER, WS_V1B = WS_V1T + 32 * 1024, WS_V2T = WS_V1B + 32 * 1024;
constexpr int PR_ACT_LD = 264, PR_VLO_LD = 40, PR_SG_LD = 520, PR_ACT_OFF = 0, PR_VLO_OFF = 64 * PR_ACT_LD * 2, PR_SG_OFF = PR_VLO_OFF + 64 * PR_VLO_LD * 2;
constexpr int PR_STG_OFF = PR_SG_OFF + 64 * PR_SG_LD * 2, PR_STG_WAVE = 16 * 144;
struct Prep2Args {
    const bf16_t* proj; const float* mu; const float* w0; const float* a0; const float* v0;
    const bf16_t *W2T, *A2T, *G2T, *V1T, *V1B, *V2T; bf16_t* vfirst; bf16_t *V, *A, *G; unsigned short* CS; int layer; int pad;
};
__device__ __forceinline__ f32x4 bfx4_lo(const bf16x8 v) { return (f32x4){bf2f((bf16_t)v[0]), bf2f((bf16_t)v[1]), bf2f((bf16_t)v[2]), bf2f((bf16_t)v[3])}; }
__device__ __forceinline__ f32x4 bfx4_hi(const bf16x8 v) { return (f32x4){bf2f((bf16_t)v[4]), bf2f((bf16_t)v[5]), bf2f((bf16_t)v[6]), bf2f((bf16_t)v[7])}; }
__device__ __forceinline__ bf16x8 pack8(const f32x4 a, const f32x4 b) { pg8::u32x4 w; w.x = pg8::cvt_pk_bf16(a[0], a[1]); w.y = pg8::cvt_pk_bf16(a[2], a[3]); w.z = pg8::cvt_pk_bf16(b[0], b[1]); w.w = pg8::cvt_pk_bf16(b[2], b[3]); return __builtin_bit_cast(bf16x8, w); }
template <int CTRL> __device__ __forceinline__ float dpp_mov(float x) { return __builtin_bit_cast(float, __builtin_amdgcn_update_dpp(0, __builtin_bit_cast(int, x), CTRL, 0xF, 0xF, true)); }
__device__ __forceinline__ float reduce16(float x) { x += dpp_mov<0xB1>(x); x += dpp_mov<0x4E>(x); x += dpp_mov<0x141>(x); x += dpp_mov<0x140>(x); return x; }
__device__ __forceinline__ float red8(float x) { x += dpp_mov<0xB1>(x); x += dpp_mov<0x4E>(x); x += dpp_mov<0x141>(x); return x; }
__device__ __forceinline__ float scan16(float x) { x += dpp_mov<0x111>(x); x += dpp_mov<0x112>(x); x += dpp_mov<0x114>(x); x += dpp_mov<0x118>(x); return x; }
constexpr float CS_SCALE = 1638.0f;
__device__ __forceinline__ void shift8(const bf16_t* __restrict__ proj, const float* __restrict__ mu, size_t m, int t, int col, int mi, f32x4& lo, f32x4& hi) {
    const bf16x8 cur = *(const bf16x8*)(proj + m * IN_W + col);
    bf16x8 prv; if (t > 0) prv = *(const bf16x8*)(proj + (m - 1) * IN_W + col); else prv = (bf16x8){0, 0, 0, 0, 0, 0, 0, 0};
    const f32x4 m0 = *(const f32x4*)(mu + mi), m1 = *(const f32x4*)(mu + mi + 4);
    const f32x4 c0 = bfx4_lo(cur), c1 = bfx4_hi(cur), p0 = bfx4_lo(prv), p1 = bfx4_hi(prv);
    lo = c0 + (p0 - c0) * m0; hi = c1 + (p1 - c1) * m1;
}
__device__ __forceinline__ void prep_tile(const Prep2Args& p, unsigned char* lds, int tile, int tid) {
    const int m0 = tile * 64, wave = __builtin_amdgcn_readfirstlane(tid >> 6), lane = tid & 63, fr = lane & 15, fq = lane >> 4;
    bf16_t* ACT = (bf16_t*)(lds + PR_ACT_OFF); bf16_t* VLO = (bf16_t*)(lds + PR_VLO_OFF); bf16_t* SG = (bf16_t*)(lds + PR_SG_OFF);
    { bf16x8 cu[4], pv[4]; f32x4 mu0[4], mu1[4];
#pragma unroll
      for (int it = 0; it < 4; ++it) { const int i = tid + 512 * it, tk = i >> 5, cc = i & 31; const size_t m = (size_t)m0 + tk; const int t = (int)(m % SEQ);
          cu[it] = *(const bf16x8*)(p.proj + m * IN_W + 2304 + 8 * cc); if (t > 0) pv[it] = *(const bf16x8*)(p.proj + (m - 1) * IN_W + 2304 + 8 * cc); else pv[it] = (bf16x8){0, 0, 0, 0, 0, 0, 0, 0};
          mu0[it] = *(const f32x4*)(p.mu + 1536 + 8 * cc); mu1[it] = *(const f32x4*)(p.mu + 1536 + 8 * cc + 4); }
#pragma unroll
      for (int it = 0; it < 4; ++it) { const int i = tid + 512 * it, tk = i >> 5, cc = i & 31;
          const f32x4 c0 = bfx4_lo(cu[it]), c1 = bfx4_hi(cu[it]); f32x4 lo = c0 + (bfx4_lo(pv[it]) - c0) * mu0[it], hi = c1 + (bfx4_hi(pv[it]) - c1) * mu1[it];
          if (cc < 8) {
#pragma unroll
              for (int e = 0; e < 4; ++e) { lo[e] = 2.f * sigmoidf_(2.f * lo[e]) - 1.f; hi[e] = 2.f * sigmoidf_(2.f * hi[e]) - 1.f; } }
          else if (cc >= 16) {
#pragma unroll
              for (int e = 0; e < 4; ++e) { lo[e] = sigmoidf_(lo[e]); hi[e] = sigmoidf_(hi[e]); } }
          *(bf16x8*)(ACT + tk * PR_ACT_LD + 8 * cc) = pack8(lo, hi); } }
    if (p.layer > 0) {
        const int tb = wave >> 1, jb = wave & 1; const size_t m = (size_t)m0 + 16 * tb + fr; const int t = (int)(m % SEQ);
        f32x4 acc = (f32x4){0.f, 0.f, 0.f, 0.f};
#pragma unroll
        for (int bt4 = 0; bt4 < 4; ++bt4) { bf16x8 cu[4], pv[4], wa[4], wb[4];
#pragma unroll
            for (int k4 = 0; k4 < 4; ++k4) { const int ko = 32 * (4 * bt4 + k4) + 8 * fq;
                cu[k4] = *(const bf16x8*)(p.proj + m * IN_W + 1792 + ko); if (t > 0) pv[k4] = *(const bf16x8*)(p.proj + (m - 1) * IN_W + 1792 + ko); else pv[k4] = (bf16x8){0, 0, 0, 0, 0, 0, 0, 0};
                wa[k4] = *(const bf16x8*)(p.V1T + (size_t)(16 * jb + fr) * C + ko); wb[k4] = *(const bf16x8*)(p.V1B + (size_t)(16 * jb + fr) * C + ko); }
#pragma unroll
            for (int k4 = 0; k4 < 4; ++k4) { acc = __builtin_amdgcn_mfma_f32_16x16x32_bf16(wa[k4], cu[k4], acc, 0, 0, 0); acc = __builtin_amdgcn_mfma_f32_16x16x32_bf16(wb[k4], pv[k4], acc, 0, 0, 0); } }
        uint2 w; w.x = pg8::cvt_pk_bf16(acc[0], acc[1]); w.y = pg8::cvt_pk_bf16(acc[2], acc[3]);
        *(uint2*)(VLO + (16 * tb + fr) * PR_VLO_LD + 16 * jb + 4 * fq) = w;
    }
    __syncthreads();
    const int ch0 = 64 * wave;
    if (p.layer > 0) {
        bf16x8 af[4], wf[4]; f32x4 bias[4];
#pragma unroll
        for (int cb = 0; cb < 4; ++cb) { wf[cb] = *(const bf16x8*)(p.V2T + (size_t)(ch0 + 16 * cb + fr) * 32 + 8 * fq); bias[cb] = *(const f32x4*)(p.v0 + ch0 + 16 * cb + 4 * fq); }
#pragma unroll
        for (int tb = 0; tb < 4; ++tb) af[tb] = *(const bf16x8*)(VLO + (16 * tb + fr) * PR_VLO_LD + 8 * fq);
#pragma unroll
        for (int cb = 0; cb < 4; ++cb) { const int ch = ch0 + 16 * cb + 4 * fq;
#pragma unroll
            for (int tb = 0; tb < 4; ++tb) { f32x4 x = __builtin_amdgcn_mfma_f32_16x16x32_bf16(wf[cb], af[tb], (f32x4){0.f, 0.f, 0.f, 0.f}, 0, 0, 0) + bias[cb];
                uint2 w; w.x = pg8::cvt_pk_bf16(sigmoidf_(x[0]), sigmoidf_(x[1])); w.y = pg8::cvt_pk_bf16(sigmoidf_(x[2]), sigmoidf_(x[3]));
                *(uint2*)(SG + (16 * tb + fr) * PR_SG_LD + ch) = w; } }
    }
    {
        f32x4 bw[4], ba[4];
#pragma unroll
        for (int cb = 0; cb < 4; ++cb) { bw[cb] = *(const f32x4*)(p.w0 + ch0 + 16 * cb + 4 * fq); ba[cb] = *(const f32x4*)(p.a0 + ch0 + 16 * cb + 4 * fq); }
        bf16x8 wA[2][4], wB[2][4], wC[4][4];
#define PR_LOADW(wf, WT, KL) _Pragma("unroll") for (int ks = 0; ks < (KL) / 32; ++ks) { _Pragma("unroll") for (int cb = 0; cb < 4; ++cb) wf[ks][cb] = *(const bf16x8*)((WT) + (size_t)(ch0 + 16 * cb + fr) * (KL) + 32 * ks + 8 * fq); }
#define PR_MMA(wf, K0, KL) { _Pragma("unroll") for (int tb = 0; tb < 4; ++tb) { _Pragma("unroll") for (int cb = 0; cb < 4; ++cb) acc[tb][cb] = (f32x4){0.f, 0.f, 0.f, 0.f}; } \
            _Pragma("unroll") for (int ks = 0; ks < (KL) / 32; ++ks) { bf16x8 af[4]; \
                _Pragma("unroll") for (int tb = 0; tb < 4; ++tb) af[tb] = *(const bf16x8*)(ACT + (16 * tb + fr) * PR_ACT_LD + (K0) + 32 * ks + 8 * fq); \
                _Pragma("unroll") for (int tb = 0; tb < 4; ++tb) { _Pragma("unroll") for (int cb = 0; cb < 4; ++cb) acc[tb][cb] = __builtin_amdgcn_mfma_f32_16x16x32_bf16(wf[ks][cb], af[tb], acc[tb][cb], 0, 0, 0); } } }
        f32x4 acc[4][4];
        unsigned char* stg = lds + PR_STG_OFF + wave * PR_STG_WAVE; const int st_w = fr * 144 + 8 * fq, l8 = lane & 7, lr = lane >> 3;
#define PR_WFENCE() { __builtin_amdgcn_fence(__ATOMIC_RELEASE, "wavefront"); __builtin_amdgcn_wave_barrier(); __builtin_amdgcn_fence(__ATOMIC_ACQUIRE, "wavefront"); }
#define PR_FLUSH(OUTP, TB) { PR_WFENCE() _Pragma("unroll") for (int i_ = 0; i_ < 2; ++i_) { const int row_ = lr + 8 * i_; const pg8::u32x4 v_ = *(const pg8::u32x4*)(stg + row_ * 144 + l8 * 16); \
            *(pg8::u32x4*)((OUTP) + ((size_t)m0 + 16 * (TB) + row_) * C + ch0 + l8 * 8) = v_; } PR_WFENCE() }
        PR_LOADW(wA, p.W2T, 64)
        PR_MMA(wA, 0, 64)
        PR_LOADW(wB, p.A2T, 64)
        { f32x4 run[4];
#pragma unroll
          for (int cb = 0; cb < 4; ++cb) run[cb] = (f32x4){0.f, 0.f, 0.f, 0.f};
#pragma unroll
          for (int tb = 0; tb < 4; ++tb) {
#pragma unroll
            for (int cb = 0; cb < 4; ++cb) { f32x4 x = acc[tb][cb] + bw[cb];
#pragma unroll
                for (int e = 0; e < 4; ++e) x[e] = -0.60653065971f * sigmoidf_(x[e]);
                f32x4 s, tot; s.x = scan16(x.x); s.y = scan16(x.y); s.z = scan16(x.z); s.w = scan16(x.w);
                tot.x = reduce16(x.x); tot.y = reduce16(x.y); tot.z = reduce16(x.z); tot.w = reduce16(x.w);
                const f32x4 cq = (s + run[cb]) * -CS_SCALE + 0.5f;
                uint2 w; w.x = (unsigned)fminf(cq.x, 65535.f) | ((unsigned)fminf(cq.y, 65535.f) << 16); w.y = (unsigned)fminf(cq.z, 65535.f) | ((unsigned)fminf(cq.w, 65535.f) << 16);
                *(uint2*)(stg + st_w + 32 * cb) = w; run[cb] = run[cb] + tot; }
            PR_FLUSH(p.CS, tb) } }
        PR_MMA(wB, 64, 64)
        PR_LOADW(wC, p.G2T, 128)
#pragma unroll
        for (int tb = 0; tb < 4; ++tb) {
#pragma unroll
            for (int cb = 0; cb < 4; ++cb) { f32x4 x = acc[tb][cb] + ba[cb];
#pragma unroll
                for (int e = 0; e < 4; ++e) x[e] = sigmoidf_(x[e]);
                uint2 w; w.x = pg8::cvt_pk_bf16(x[0], x[1]); w.y = pg8::cvt_pk_bf16(x[2], x[3]);
                *(uint2*)(stg + st_w + 32 * cb) = w; }
            PR_FLUSH(p.A, tb) }
        PR_MMA(wC, 128, 128)
#pragma unroll
        for (int tb = 0; tb < 4; ++tb) {
#pragma unroll
            for (int cb = 0; cb < 4; ++cb) { const f32x4 x = acc[tb][cb];
                uint2 w; w.x = pg8::cvt_pk_bf16(x[0], x[1]); w.y = pg8::cvt_pk_bf16(x[2], x[3]);
                *(uint2*)(stg + st_w + 32 * cb) = w; }
            PR_FLUSH(p.G, tb) }
#undef PR_FLUSH
#undef PR_WFENCE
#undef PR_LOADW
#undef PR_MMA
    }
    __syncthreads();
    {
        const int cc = tid & 63;
        bf16x8 cu[8], pv[8], vf[8]; const f32x4 mu0 = *(const f32x4*)(p.mu + 1024 + 8 * cc), mu1 = *(const f32x4*)(p.mu + 1024 + 8 * cc + 4);
#pragma unroll
        for (int it = 0; it < 8; ++it) { const int tk = (tid >> 6) + 8 * it; const size_t m = (size_t)m0 + tk; const int t = (int)(m % SEQ); const int col = 768 + 1024 + 8 * cc;
            cu[it] = *(const bf16x8*)(p.proj + m * IN_W + col); if (t > 0) pv[it] = *(const bf16x8*)(p.proj + (m - 1) * IN_W + col); else pv[it] = (bf16x8){0, 0, 0, 0, 0, 0, 0, 0};
            if (p.layer > 0) vf[it] = *(const bf16x8*)(p.vfirst + m * C + 8 * cc); }
#pragma unroll
        for (int it = 0; it < 8; ++it) { const int tk = (tid >> 6) + 8 * it; const size_t m = (size_t)m0 + tk;
            const f32x4 c0 = bfx4_lo(cu[it]), c1 = bfx4_hi(cu[it]);
            f32x4 lo = c0 + (bfx4_lo(pv[it]) - c0) * mu0, hi = c1 + (bfx4_hi(pv[it]) - c1) * mu1;
            const size_t o = m * C + 8 * cc;
            if (p.layer == 0) *(bf16x8*)(p.vfirst + o) = pack8(lo, hi);
            else { const bf16x8 sg = *(const bf16x8*)(SG + tk * PR_SG_LD + 8 * cc);
                lo = lo + (bfx4_lo(vf[it]) - lo) * bfx4_lo(sg); hi = hi + (bfx4_hi(vf[it]) - hi) * bfx4_hi(sg); }
            *(bf16x8*)(p.V + o) = pack8(lo, hi); }
    }
    __syncthreads();
}

constexpr int NTHREADS_ = 512;
constexpr int SC_TB = 32, SC_SLOT = 384, SC_NCH = SEQ / SC_TB;
constexpr size_t WS_RKC = 51 * MiB;
struct ScanArgs { const bf16_t *proj, *V, *A, *G; const unsigned short* CS; const float *k_k, *k_a, *r_k, *lnx_g, *lnx_b; bf16_t* mix; float* rkc; };
constexpr int CK_LD = 72, CK_MAT = 64 * CK_LD * 2;
constexpr size_t WS_TSCR = WS_SI_A, TSCR_WG = 4 * 64 * C * 2;
__device__ __forceinline__ void ck_mm(f32x4 (&acc)[2], const bf16_t* Qm, const bf16_t* P, int jb, int ib0, int fr, int fq) {
#pragma unroll
    for (int ks = 0; ks < 2; ++ks) { const bf16x8 bq = *(const bf16x8*)(Qm + (16 * jb + fr) * CK_LD + 32 * ks + 8 * fq);
#pragma unroll
        for (int ii = 0; ii < 2; ++ii) { const bf16x8 ap = *(const bf16x8*)(P + (16 * (ib0 + ii) + fr) * CK_LD + 32 * ks + 8 * fq); acc[ii] = __builtin_amdgcn_mfma_f32_16x16x32_bf16(ap, bq, acc[ii], 0, 0, 0); } }
}
typedef short ck_s16x4 __attribute__((ext_vector_type(4)));
__device__ __forceinline__ bf16x8 ck_tr_frag(const bf16_t* X, int colbase, int ks, int lane) {
    const bf16_t* a0 = X + (32 * ks + 8 * (lane >> 4) + ((lane & 15) >> 2)) * CK_LD + colbase + 4 * (lane & 3);
    const ck_s16x4 lo = __builtin_amdgcn_ds_read_tr16_b64_v4i16((__attribute__((address_space(3))) ck_s16x4*)a0), hi = __builtin_amdgcn_ds_read_tr16_b64_v4i16((__attribute__((address_space(3))) ck_s16x4*)(a0 + 4 * CK_LD));
    return (bf16x8){lo[0], lo[1], lo[2], lo[3], hi[0], hi[1], hi[2], hi[3]};
}
template <bool TQ, bool TP> __device__ __forceinline__ void ck_mm_t(f32x4 (&acc)[2], const bf16_t* Qm, const bf16_t* P, int jb, int ib0, int fr, int fq) {
    const int lane = fq * 16 + fr;
#pragma unroll
    for (int ks = 0; ks < 2; ++ks) { const bf16x8 bq = TQ ? ck_tr_frag(Qm, 16 * jb, ks, lane) : *(const bf16x8*)(Qm + (16 * jb + fr) * CK_LD + 32 * ks + 8 * fq);
#pragma unroll
        for (int ii = 0; ii < 2; ++ii) { const bf16x8 ap = TP ? ck_tr_frag(P, 16 * (ib0 + ii), ks, lane) : *(const bf16x8*)(P + (16 * (ib0 + ii) + fr) * CK_LD + 32 * ks + 8 * fq); acc[ii] = __builtin_amdgcn_mfma_f32_16x16x32_bf16(ap, bq, acc[ii], 0, 0, 0); } }
}
__device__ __forceinline__ uint2 ck_pack4(const f32x4 v) { uint2 w; w.x = pg8::cvt_pk_bf16(v[0], v[1]); w.y = pg8::cvt_pk_bf16(v[2], v[3]); return w; }
__device__ __forceinline__ f32x4 ck_unpack4(const uint2 u) { return (f32x4){__builtin_bit_cast(float, u.x << 16), __builtin_bit_cast(float, u.x & 0xffff0000u), __builtin_bit_cast(float, u.y << 16), __builtin_bit_cast(float, u.y & 0xffff0000u)}; }
struct CkRaw { bf16x8 rc, rp, kc, kp, v, a, cs, cp, cl; };
__device__ __forceinline__ float wave_sum_dpp(float x) {
    x = reduce16(x); const int xi = __builtin_bit_cast(int, x);
    const float r0 = __builtin_bit_cast(float, __builtin_amdgcn_readlane(xi, 0)), r1 = __builtin_bit_cast(float, __builtin_amdgcn_readlane(xi, 16)), r2 = __builtin_bit_cast(float, __builtin_amdgcn_readlane(xi, 32)), r3 = __builtin_bit_cast(float, __builtin_amdgcn_readlane(xi, 48));
    return (r0 + r1) + (r2 + r3); }
__device__ __forceinline__ void ck_load(const ScanArgs& p, CkRaw& w, int unit, int tid) {
    const int chain = unit >> 6, chunk = unit & 63, b = chain >> 3, h = chain & 7, tk = tid >> 3, hc = h * 64 + (tid & 7) * 8;
    const size_t row = (size_t)b * SEQ + chunk * 64 + tk, o = row * C + hc;
    const bf16_t* pr = p.proj + row * IN_W + 768 + hc; const bf16x8 z8 = (bf16x8){0, 0, 0, 0, 0, 0, 0, 0};
    w.rc = *(const bf16x8*)pr; w.kc = *(const bf16x8*)(pr + 512);
    if (chunk * 64 + tk > 0) { w.rp = *(const bf16x8*)(pr - IN_W); w.kp = *(const bf16x8*)(pr - IN_W + 512); } else { w.rp = z8; w.kp = z8; }
    w.v = *(const bf16x8*)(p.V + o); w.a = *(const bf16x8*)(p.A + o);
    w.cs = *(const bf16x8*)(p.CS + o); if (tk > 0) w.cp = *(const bf16x8*)(p.CS + o - C); else w.cp = z8;
    w.cl = *(const bf16x8*)(p.CS + (row - tk + 63) * C + hc);
}
__device__ __forceinline__ f32x4 csq_lo(const bf16x8 v) { return (f32x4){(float)(unsigned short)v[0], (float)(unsigned short)v[1], (float)(unsigned short)v[2], (float)(unsigned short)v[3]} * (-1.f / CS_SCALE); }
__device__ __forceinline__ f32x4 csq_hi(const bf16x8 v) { return (f32x4){(float)(unsigned short)v[4], (float)(unsigned short)v[5], (float)(unsigned short)v[6], (float)(unsigned short)v[7]} * (-1.f / CS_SCALE); }
__device__ __forceinline__ f32x4 exp4(const f32x4 v) { return (f32x4){__expf(v[0]), __expf(v[1]), __expf(v[2]), __expf(v[3])}; }
constexpr int CK_CONST_OFF = 136192;
__device__ __forceinline__ void ck_precompute(const ScanArgs& p, const CkRaw& raw, CkRaw& nxt, int next_unit, unsigned char* lds, bf16_t* GQ, bf16_t* CQ, int unit, int tid) {
    const int chain = unit >> 6, chunk = unit & 63, b = chain >> 3, h = chain & 7, wave = __builtin_amdgcn_readfirstlane(tid >> 6), lane = tid & 63, fr = lane & 15, fq = lane >> 4, jb = wave >> 1, ib0 = 2 * (wave & 1);
    bf16_t* At = (bf16_t*)(lds + 0 * CK_MAT); bf16_t* bt = (bf16_t*)(lds + 1 * CK_MAT); bf16_t* kt = (bf16_t*)(lds + 2 * CK_MAT); bf16_t* rt = (bf16_t*)(lds + 3 * CK_MAT);
    bf16_t* AtT = (bf16_t*)(lds + 4 * CK_MAT); bf16_t* BhT = (bf16_t*)(lds + 5 * CK_MAT); bf16_t* KhT = (bf16_t*)(lds + 6 * CK_MAT); bf16_t* VT = (bf16_t*)(lds + 7 * CK_MAT);
    bf16_t* NT = (bf16_t*)(lds + 8 * CK_MAT); bf16_t* Mm = (bf16_t*)(lds + 9 * CK_MAT); bf16_t* P1 = (bf16_t*)(lds + 10 * CK_MAT); bf16_t* P2 = (bf16_t*)(lds + 11 * CK_MAT);
    bf16_t* Ta = (bf16_t*)(lds + 12 * CK_MAT); bf16_t* Tb = (bf16_t*)(lds + 13 * CK_MAT); float* WT = (float*)(lds + 14 * CK_MAT); float* GL = WT + 512;
    bf16_t* W1T = bt; bf16_t* MVT = kt; bf16_t* W2T = At;
    {
        const int tk = tid >> 3, c8 = (tid & 7) * 8, ro = tk * CK_LD + c8;
        bf16_t* BhR = BhT; bf16_t* KhR = KhT; bf16_t* VR = VT;
        const float* KC = (const float*)(lds + CK_CONST_OFF) + h * 64 + c8;
        const f32x4 kc0 = *(const f32x4*)KC, kc1 = *(const f32x4*)(KC + 4), ac0 = *(const f32x4*)(KC + 512), ac1 = *(const f32x4*)(KC + 516), rc0 = *(const f32x4*)(KC + 1024), rc1 = *(const f32x4*)(KC + 1028), mu0 = *(const f32x4*)(KC + 1536), mu1 = *(const f32x4*)(KC + 1540);
        const f32x4 mk0 = *(const f32x4*)(KC + 2048), mk1 = *(const f32x4*)(KC + 2052);
        const f32x4 x0 = bfx4_lo(raw.rc), x1 = bfx4_hi(raw.rc); const f32x4 r0 = x0 + (bfx4_lo(raw.rp) - x0) * mu0, r1 = x1 + (bfx4_hi(raw.rp) - x1) * mu1;
        const f32x4 y0 = bfx4_lo(raw.kc), y1 = bfx4_hi(raw.kc); const f32x4 k0 = y0 + (bfx4_lo(raw.kp) - y0) * mk0, k1 = y1 + (bfx4_hi(raw.kp) - y1) * mk1;
        const f32x4 a0 = bfx4_lo(raw.a), a1 = bfx4_hi(raw.a);
        const f32x4 c0 = csq_lo(raw.cs), c1 = csq_hi(raw.cs), p0 = csq_lo(raw.cp), p1 = csq_hi(raw.cp), l0 = csq_lo(raw.cl), l1 = csq_hi(raw.cl);
        f32x4 q0 = k0 * kc0, q1 = k1 * kc1;
        const f32x4 qq = q0 * q0 + q1 * q1; const float nrm = red8((qq.x + qq.y) + (qq.z + qq.w));
        const float inv = fminf(__builtin_amdgcn_rsqf(nrm), 1e12f); q0 = q0 * inv; q1 = q1 * inv;
        const f32x4 kp0 = k0 * (1.f + (a0 - 1.f) * ac0), kp1 = k1 * (1.f + (a1 - 1.f) * ac1);
        const f32x4 rr = r0 * kp0 * rc0 + r1 * kp1 * rc1; const float rkc = red8((rr.x + rr.y) + (rr.z + rr.w));
        if ((tid & 7) == 0) p.rkc[((size_t)b * SEQ + chunk * 64 + tk) * 8 + h] = rkc;
        const f32x4 em0 = exp4(p0), em1 = exp4(p1), en0 = exp4(-c0), en1 = exp4(-c1), ep0 = exp4(c0), ep1 = exp4(c1), eL0 = exp4(l0 - c0), eL1 = exp4(l1 - c1);
        const f32x4 b0 = q0 * a0, b1 = q1 * a1;
        *(bf16x8*)(At + ro) = pack8(-q0 * em0, -q1 * em1); *(bf16x8*)(bt + ro) = pack8(b0 * en0, b1 * en1); *(bf16x8*)(kt + ro) = pack8(kp0 * en0, kp1 * en1); *(bf16x8*)(rt + ro) = pack8(r0 * ep0, r1 * ep1);
        *(bf16x8*)(BhR + ro) = pack8(b0 * eL0, b1 * eL1); *(bf16x8*)(KhR + ro) = pack8(kp0 * eL0, kp1 * eL1); *(bf16x8*)(VR + ro) = raw.v;
        if (tk == 0) { *(f32x4*)(GL + c8) = exp4(l0); *(f32x4*)(GL + c8 + 4) = exp4(l1); }
    }
    __syncthreads();
    const int j = 16 * jb + fr; const f32x4 z4 = (f32x4){0.f, 0.f, 0.f, 0.f};
    { f32x4 aN[2] = {z4, z4}, aM[2] = {z4, z4}, aP1[2] = {z4, z4}, aP2[2] = {z4, z4};
      ck_mm(aN, At, bt, jb, ib0, fr, fq); ck_mm(aM, At, kt, jb, ib0, fr, fq); ck_mm(aP1, rt, bt, jb, ib0, fr, fq); ck_mm(aP2, rt, kt, jb, ib0, fr, fq);
#pragma unroll
      for (int ii = 0; ii < 2; ++ii) { const int i0 = 16 * (ib0 + ii) + 4 * fq; f32x4 t0, nt, mm, p1, p2;
#pragma unroll
          for (int e = 0; e < 4; ++e) { const int i = i0 + e; nt[e] = i < j ? aN[ii][e] : 0.f; t0[e] = nt[e] + (i == j ? 1.f : 0.f); mm[e] = i < j ? aM[ii][e] : 0.f; p1[e] = i <= j ? aP1[ii][e] : 0.f; p2[e] = i <= j ? aP2[ii][e] : 0.f; }
          *(uint2*)(Ta + j * CK_LD + i0) = ck_pack4(t0); *(uint2*)(NT + j * CK_LD + i0) = ck_pack4(nt); *(uint2*)(Mm + j * CK_LD + i0) = ck_pack4(mm); *(uint2*)(P1 + j * CK_LD + i0) = ck_pack4(p1); *(uint2*)(P2 + j * CK_LD + i0) = ck_pack4(p2); } }
    __syncthreads();
#pragma unroll
    for (int st = 0; st < 3; ++st) { const bf16_t* src = (st & 1) ? Tb : Ta; bf16_t* dst = (st & 1) ? Ta : Tb; f32x4 a2[2] = {z4, z4}; ck_mm_t<false, true>(a2, src, NT, jb, ib0, fr, fq);
#pragma unroll
        for (int ii = 0; ii < 2; ++ii) { const int i0 = 16 * (ib0 + ii) + 4 * fq; f32x4 t = a2[ii];
#pragma unroll
            for (int e = 0; e < 4; ++e) t[e] += (i0 + e == j) ? 1.f : 0.f;
            *(uint2*)(dst + j * CK_LD + i0) = ck_pack4(t); }
        __syncthreads(); }
    { f32x4 a1[2] = {z4, z4}, a2[2] = {z4, z4}; ck_mm_t<true, false>(a1, At, Tb, jb, ib0, fr, fq); ck_mm_t<true, false>(a2, VT, Mm, jb, ib0, fr, fq);
#pragma unroll
      for (int ii = 0; ii < 2; ++ii) { const int i0 = 16 * (ib0 + ii) + 4 * fq; *(uint2*)(W1T + j * CK_LD + i0) = ck_pack4(a1[ii]); *(uint2*)(MVT + j * CK_LD + i0) = ck_pack4(a2[ii]); } }
    __syncthreads();
    { f32x4 a1[2] = {z4, z4}; ck_mm(a1, MVT, Tb, jb, ib0, fr, fq);
#pragma unroll
      for (int ii = 0; ii < 2; ++ii) { const int i0 = 16 * (ib0 + ii) + 4 * fq; *(uint2*)(W2T + j * CK_LD + i0) = ck_pack4(a1[ii]); } }
    __syncthreads();
    ck_load(p, nxt, next_unit, tid);
    { f32x4 aQ1[2] = {z4, z4}, aG[2] = {z4, z4}, aQ2[2] = {z4, z4}, aC[2] = {z4, z4};
      ck_mm(aQ1, P1, W1T, jb, ib0, fr, fq); ck_mm_t<true, false>(aG, BhT, W1T, jb, ib0, fr, fq); ck_mm(aQ2, P1, W2T, jb, ib0, fr, fq); ck_mm_t<false, true>(aQ2, P2, VT, jb, ib0, fr, fq); ck_mm_t<false, true>(aC, W2T, BhT, jb, ib0, fr, fq); ck_mm_t<true, true>(aC, VT, KhT, jb, ib0, fr, fq);
      bf16_t* gq = GQ + (size_t)unit * 8192; bf16_t* cq = CQ + (size_t)unit * 8192; const float glj = GL[j];
#pragma unroll
      for (int ii = 0; ii < 2; ++ii) { const int i0 = 16 * (ib0 + ii) + 4 * fq; f32x4 g = aG[ii];
#pragma unroll
          for (int e = 0; e < 4; ++e) g[e] += (i0 + e == j) ? glj : 0.f;
          const f32x4 q1 = aQ1[ii] + ck_unpack4(*(const uint2*)(rt + j * CK_LD + i0));
          *(uint2*)(AtT + j * CK_LD + i0) = ck_pack4(g); *(uint2*)(NT + j * CK_LD + i0) = ck_pack4(q1); *(uint2*)(Mm + j * CK_LD + i0) = ck_pack4(aC[ii]); *(uint2*)(Ta + j * CK_LD + i0) = ck_pack4(aQ2[ii]); }
      __syncthreads();
      { const int row = tid >> 3, c8 = (tid & 7) * 8, lo_ = row * CK_LD + c8, go_ = row * 64 + c8;
        const pg8::u32x4 v0 = *(const pg8::u32x4*)(AtT + lo_), v1 = *(const pg8::u32x4*)(NT + lo_), v2 = *(const pg8::u32x4*)(Mm + lo_), v3 = *(const pg8::u32x4*)(Ta + lo_);
        *(pg8::u32x4*)(gq + go_) = v0; *(pg8::u32x4*)(gq + 4096 + go_) = v1; { const int bo_ = (c8 >> 4) * 1024 + row * 16 + (c8 & 15);
          *(pg8::u32x4*)(cq + bo_) = v2; *(pg8::u32x4*)(cq + 4096 + bo_) = v3; } } }
    if (next_unit == unit) __syncthreads();
}
__device__ __forceinline__ void ck_sequential(const ScanArgs& p, unsigned char* lds, const bf16_t* GQ, const bf16_t* CQ, int item, int tid) {
    const int chain = item >> 2, q = item & 3, b = chain >> 3, h = chain & 7, wave = __builtin_amdgcn_readfirstlane(tid >> 6), lane = tid & 63, fr = lane & 15, fq = lane >> 4;
    bf16_t* OPS = (bf16_t*)lds;
    bf16_t* HT = (bf16_t*)(lds + 4 * CK_MAT);
    for (int i = tid; i < 2 * 16 * CK_LD / 2; i += NTHREADS_) ((unsigned*)HT)[i] = 0u;
    const size_t ubase = (size_t)chain * 64; const size_t rowbase = (size_t)b * SEQ;
    const int prow0 = tid >> 3, pcol = (tid & 7) * 8;
    const int aoff = wave < 4 ? (4096 + q * 1024 + (16 * wave + fr) * 16 + 4 * fq) : ((wave - 4) * 1024 + (16 * q + fr) * 16 + 4 * fq);
    typedef unsigned u32x2_ __attribute__((ext_vector_type(2)));
    pg8::u32x4 g0_0, g0_1, g0_2, g0_3, g0_4, g0_5, g0_6, g0_7, g1_0, g1_1, g1_2, g1_3, g1_4, g1_5, g1_6, g1_7; u32x2_ ad_0, ad_1, ad_2, ad_3, ad_4, ad_5, ad_6, ad_7;
#define CK_FETCH(slot, cc) do { const int c_ = (cc) < 64 ? (cc) : 63;     \
        const bf16_t* gq = GQ + (ubase + c_) * 8192; g0_##slot = *(const pg8::u32x4*)(gq + (size_t)prow0 * 64 + pcol); g1_##slot = *(const pg8::u32x4*)(gq + (size_t)(prow0 + 64) * 64 + pcol); \
        ad_##slot = *(const u32x2_*)(CQ + (ubase + c_) * 8192 + aoff); } while (0)
#define CK_STAGE(slot, buf) do { *(pg8::u32x4*)(OPS + (buf) * 2 * 64 * CK_LD + prow0 * CK_LD + pcol) = g0_##slot; *(pg8::u32x4*)(OPS + (buf) * 2 * 64 * CK_LD + 64 * CK_LD + prow0 * CK_LD + pcol) = g1_##slot; } while (0)
    CK_FETCH(0, 0); CK_FETCH(1, 1); CK_FETCH(2, 2); CK_FETCH(3, 3); CK_FETCH(4, 4); CK_FETCH(5, 5); CK_FETCH(6, 6); CK_FETCH(7, 7);
    CK_STAGE(0, 0);
    __syncthreads();
#define CK_STEP(cc, slot, nslot) do { const int bi = (cc) & 1; const bf16_t* Gm = OPS + bi * 2 * 64 * CK_LD; const bf16_t* Q1m = Gm + 64 * CK_LD; const bf16_t* HTc = HT + bi * 16 * CK_LD; bf16_t* HTn = HT + (bi ^ 1) * 16 * CK_LD; \
        f32x4 acc = (f32x4){0.f, 0.f, 0.f, 0.f}; \
        if (wave < 4) { _Pragma("unroll") for (int ks = 0; ks < 2; ++ks) acc = __builtin_amdgcn_mfma_f32_16x16x32_bf16(*(const bf16x8*)(HTc + fr * CK_LD + 32 * ks + 8 * fq), *(const bf16x8*)(Q1m + (16 * wave + fr) * CK_LD + 32 * ks + 8 * fq), acc, 0, 0, 0); \
            acc = acc + ck_unpack4((uint2){ad_##slot.x, ad_##slot.y}); \
            *(uint2*)(p.mix + (rowbase + (size_t)(cc) * 64 + 16 * wave + fr) * D + ATT_W + h * 64 + 16 * q + 4 * fq) = ck_pack4(acc); } \
        else { _Pragma("unroll") for (int ks = 0; ks < 2; ++ks) acc = __builtin_amdgcn_mfma_f32_16x16x32_bf16(*(const bf16x8*)(Gm + (16 * (wave - 4) + fr) * CK_LD + 32 * ks + 8 * fq), *(const bf16x8*)(HTc + fr * CK_LD + 32 * ks + 8 * fq), acc, 0, 0, 0); \
            acc = acc + ck_unpack4((uint2){ad_##slot.x, ad_##slot.y}); \
            *(uint2*)(HTn + fr * CK_LD + 16 * (wave - 4) + 4 * fq) = ck_pack4(acc); } \
        CK_STAGE(nslot, bi ^ 1); \
        CK_FETCH(slot, (cc) + 8); \
        __syncthreads(); } while (0)
    for (int c = 0; c < 64; c += 8) { CK_STEP(c, 0, 1); CK_STEP(c + 1, 1, 2); CK_STEP(c + 2, 2, 3); CK_STEP(c + 3, 3, 4); CK_STEP(c + 4, 4, 5); CK_STEP(c + 5, 5, 6); CK_STEP(c + 6, 6, 7); CK_STEP(c + 7, 7, 0); }
#undef CK_FETCH
#undef CK_STAGE
#undef CK_STEP
}

struct PostRaw { bf16x8 y0, y1, v0, v1, g0, g1; float rk0, rk1; };
__device__ __forceinline__ void scan_post_load(const ScanArgs& p, PostRaw& w, int m0, int lane) {
    const int ch8 = 8 * lane, hh = lane >> 3; const size_t m = (size_t)m0;
    w.y0 = *(const bf16x8*)(p.mix + m * D + ATT_W + ch8); w.v0 = *(const bf16x8*)(p.V + m * C + ch8); w.g0 = *(const bf16x8*)(p.G + m * C + ch8); w.rk0 = p.rkc[m * 8 + hh];
    w.y1 = *(const bf16x8*)(p.mix + (m + 1) * D + ATT_W + ch8); w.v1 = *(const bf16x8*)(p.V + (m + 1) * C + ch8); w.g1 = *(const bf16x8*)(p.G + (m + 1) * C + ch8); w.rk1 = p.rkc[(m + 1) * 8 + hh];
}
__device__ __forceinline__ void scan_post_row(const ScanArgs& p, const bf16x8 yv, const bf16x8 vv, const bf16x8 gv, const float rk, const f32x4 lg0, const f32x4 lg1, const f32x4 lb0, const f32x4 lb1, size_t m, int ch8) {
    f32x4 y0 = bfx4_lo(yv), y1 = bfx4_hi(yv);
    const float mean = red8((y0.x + y0.y) + (y0.z + y0.w) + (y1.x + y1.y) + (y1.z + y1.w)) * (1.f / 64.f);
    y0 = y0 - mean; y1 = y1 - mean;
    const float var = red8((y0.x * y0.x + y0.y * y0.y) + (y0.z * y0.z + y0.w * y0.w) + (y1.x * y1.x + y1.y * y1.y) + (y1.z * y1.z + y1.w * y1.w)) * (1.f / 64.f);
    const float rs = rsqrtf(var + LNX_EPS);
    const f32x4 o0 = (y0 * rs * lg0 + lb0 + bfx4_lo(vv) * rk) * bfx4_lo(gv), o1 = (y1 * rs * lg1 + lb1 + bfx4_hi(vv) * rk) * bfx4_hi(gv);
    *(bf16x8*)(p.mix + m * D + ATT_W + ch8) = pack8(o0, o1);
}
__device__ __forceinline__ void scan_post_wave(const ScanArgs& p, int gw, int ngw, int lane) {
    const int ch8 = 8 * lane;
    const f32x4 lg0 = *(const f32x4*)(p.lnx_g + ch8), lg1 = *(const f32x4*)(p.lnx_g + ch8 + 4), lb0 = *(const f32x4*)(p.lnx_b + ch8), lb1 = *(const f32x4*)(p.lnx_b + ch8 + 4);
    int m0 = 2 * gw; if (m0 >= M) return;
    PostRaw cur; scan_post_load(p, cur, m0, lane);
    for (; m0 < M; m0 += 2 * ngw) { PostRaw nxt = cur; if (m0 + 2 * ngw < M) scan_post_load(p, nxt, m0 + 2 * ngw, lane);
        scan_post_row(p, cur.y0, cur.v0, cur.g0, cur.rk0, lg0, lg1, lb0, lb1, (size_t)m0, ch8); scan_post_row(p, cur.y1, cur.v1, cur.g1, cur.rk1, lg0, lg1, lb0, lb1, (size_t)m0 + 1, ch8);
        cur = nxt; }
}

typedef float f32x16 __attribute__((ext_vector_type(16)));
typedef short s16x4 __attribute__((ext_vector_type(4)));
constexpr int AT_VLD = 96;
__device__ __forceinline__ int crow(int r, int hi) { return (r & 3) + 8 * (r >> 2) + 4 * hi; }
constexpr int AT_KLD = 72;
__device__ __forceinline__ void attn_phase(const bf16_t* __restrict__ proj, const float* __restrict__ sinks, bf16_t* __restrict__ mix, unsigned char* lds, int G, int tid) {
    bf16_t* ks_ = (bf16_t*)lds; bf16_t* vs_ = (bf16_t*)(lds + 192 * AT_KLD * 2);
    const int g = __builtin_amdgcn_readfirstlane(tid >> 7), half = __builtin_amdgcn_readfirstlane((tid >> 6) & 1);
    constexpr int NU = BATCH * 2 * (SEQ / 64);
    bf16x8 pk0, pk1, pk2, pv0, pv1, pv2, pq0, pq1, pq2, pq3;
#define AT_PIECE(it, kdst, vdst, un) do { const int i_ = tq + 512 * (it), kl_ = i_ >> 3, ch8_ = i_ & 7; int key_ = ((un) & 63) * 64 - 128 + kl_; key_ = key_ < 0 ? 0 : key_;     \
        const bf16_t* rp_ = proj + ((size_t)((un) >> 7) * SEQ + key_) * IN_W + 512 + (((un) >> 6) & 1) * 64 + ch8_ * 8; kdst = *(const bf16x8*)rp_; vdst = *(const bf16x8*)(rp_ + KV_W); } while (0)
#define AT_FETCH(un) do { AT_PIECE(0, pk0, pv0, un); AT_PIECE(1, pk1, pv1, un); AT_PIECE(2, pk2, pv2, un); \
        { const int l_ = tq & 63; const bf16_t* qp_ = proj + ((size_t)((un) >> 7) * SEQ + ((un) & 63) * 64 + 32 * half + (l_ & 31)) * IN_W + ((((un) >> 6) & 1) * 4 + g) * 64 + 8 * (l_ >> 5); \
          pq0 = *(const bf16x8*)qp_; pq1 = *(const bf16x8*)(qp_ + 16); pq2 = *(const bf16x8*)(qp_ + 32); pq3 = *(const bf16x8*)(qp_ + 48); } } while (0)
#define AT_STAGE(it, ksrc, vsrc) do { const int i_ = tq + 512 * (it), kl_ = i_ >> 3, ch8_ = i_ & 7; *(bf16x8*)(ks_ + kl_ * AT_KLD + ch8_ * 8) = ksrc; *(bf16x8*)(vs_ + kl_ * AT_VLD + ch8_ * 8) = vsrc; } while (0)
    int tq = tid; int unit = blockIdx.x; if (unit < NU) AT_FETCH(unit);
    for (; unit < NU; unit += G) {
        const int b = unit >> 7, kvh = (unit >> 6) & 1, qb = unit & 63, Q0 = qb * 64, h = kvh * 4 + g; const size_t rowb = (size_t)b * SEQ;
        asm volatile("" : "+v"(tq));
        const int lane = tq & 63, c = lane & 31, hi = lane >> 5;
        AT_STAGE(0, pk0, pv0); AT_STAGE(1, pk1, pv1); AT_STAGE(2, pk2, pv2);
        const bf16x8 qf[4] = {pq0, pq1, pq2, pq3};
        __syncthreads();
        if (unit + G < NU) AT_FETCH(unit + G);
        const int t0 = Q0 + 32 * half; const size_t mq = rowb + t0 + c;
        f32x16 p[5];
#pragma unroll
        for (int kb = 0; kb < 5; ++kb) { const bf16_t* kp = ks_ + (32 * half + 32 * kb + c) * AT_KLD + 8 * hi;
            f32x16 acc;
#pragma unroll
            for (int r = 0; r < 16; ++r) acc[r] = 0.f;
#pragma unroll
            for (int ks = 0; ks < 4; ++ks) acc = __builtin_amdgcn_mfma_f32_32x32x16_bf16(*(const bf16x8*)(kp + 16 * ks), qf[ks], acc, 0, 0, 0);
            p[kb] = acc; }
        const float slope = exp2f(-(float)(h + 1)) * 1.44269504089f, sink = sinks[h] * 1.44269504089f;
        float mx = sink;
        const float bl = -slope * (float)(c + 128 - 4 * hi);
        const bool seq_start = (t0 < 128);
#pragma unroll
        for (int kb = 0; kb < 5; ++kb)
#pragma unroll
            for (int r = 0; r < 16; ++r) { const int cr0 = (r & 3) + 8 * (r >> 2), cr = cr0 + 4 * hi;
                float sc = p[kb][r] * (0.125f * 1.44269504089f) + (bl + slope * (float)(32 * kb + cr0));
                if (kb == 0) sc = (cr > c) ? sc : -1e30f;
                if (kb == 4) sc = (cr <= c) ? sc : -1e30f;
                if (seq_start) sc = (t0 - 128 + 32 * kb + cr >= 0) ? sc : -1e30f;
                p[kb][r] = sc; mx = fmaxf(mx, sc); }
        mx = fmaxf(mx, __shfl_xor(mx, 32));
        float l = 0.f;
#pragma unroll
        for (int kb = 0; kb < 5; ++kb)
#pragma unroll
            for (int r = 0; r < 16; ++r) { const float e = __builtin_amdgcn_exp2f(p[kb][r] - mx); p[kb][r] = e; l += e; }
        l += __shfl_xor(l, 32); l += __builtin_amdgcn_exp2f(sink - mx);
        f32x16 o[2];
#pragma unroll
        for (int d = 0; d < 2; ++d)
#pragma unroll
            for (int r = 0; r < 16; ++r) o[d][r] = 0.f;
#pragma unroll
        for (int kb = 0; kb < 5; ++kb)
#pragma unroll
            for (int s2 = 0; s2 < 2; ++s2) {
                pg8::u32x4 pw; pw.x = pg8::cvt_pk_bf16(p[kb][8 * s2 + 0], p[kb][8 * s2 + 1]); pw.y = pg8::cvt_pk_bf16(p[kb][8 * s2 + 2], p[kb][8 * s2 + 3]);
                pw.z = pg8::cvt_pk_bf16(p[kb][8 * s2 + 4], p[kb][8 * s2 + 5]); pw.w = pg8::cvt_pk_bf16(p[kb][8 * s2 + 6], p[kb][8 * s2 + 7]);
                const bf16x8 pf = __builtin_bit_cast(bf16x8, pw);
#pragma unroll
                for (int d = 0; d < 2; ++d) {
                    const bf16_t* vp = vs_ + (32 * half + 32 * kb + 16 * s2 + 4 * hi + ((lane & 15) >> 2)) * AT_VLD + 32 * d + 16 * ((lane >> 4) & 1) + 4 * (lane & 3);
                    const s16x4 lo = __builtin_amdgcn_ds_read_tr16_b64_v4i16((__attribute__((address_space(3))) s16x4*)vp), hh = __builtin_amdgcn_ds_read_tr16_b64_v4i16((__attribute__((address_space(3))) s16x4*)(vp + 8 * AT_VLD));
                    const bf16x8 vf = (bf16x8){lo[0], lo[1], lo[2], lo[3], hh[0], hh[1], hh[2], hh[3]};
                    o[d] = __builtin_amdgcn_mfma_f32_32x32x16_bf16(vf, pf, o[d], 0, 0, 0); } }
        const float inv = __builtin_amdgcn_rcpf(l);
#pragma unroll
        for (int d = 0; d < 2; ++d)
#pragma unroll
            for (int rp = 0; rp < 2; ++rp) {
                unsigned ax = pg8::cvt_pk_bf16(o[d][8 * rp] * inv, o[d][8 * rp + 1] * inv), ay = pg8::cvt_pk_bf16(o[d][8 * rp + 2] * inv, o[d][8 * rp + 3] * inv);
                unsigned bx = pg8::cvt_pk_bf16(o[d][8 * rp + 4] * inv, o[d][8 * rp + 5] * inv), by = pg8::cvt_pk_bf16(o[d][8 * rp + 6] * inv, o[d][8 * rp + 7] * inv);
                const auto r0 = __builtin_amdgcn_permlane32_swap(ax, bx, false, false); const auto r1 = __builtin_amdgcn_permlane32_swap(ay, by, false, false);
                pg8::u32x4 w; w.x = r0[0]; w.y = r1[0]; w.z = r0[1]; w.w = r1[1];
                *(pg8::u32x4*)(mix + mq * D + h * 64 + 32 * d + 16 * rp + 8 * hi) = w; }
        __syncthreads();
    }
#undef AT_PIECE
#undef AT_FETCH
#undef AT_STAGE
}

__device__ __forceinline__ void ffn_fixup(const float* __restrict__ SB, const float* __restrict__ cw, const float* __restrict__ cb, bf16_t* hid, int pm, int tid) {
    pm = __builtin_amdgcn_readfirstlane(pm);
    const float* s = SB + (size_t)pm * 6 * FF; const float* sp = SB + (size_t)(pm - 1) * 6 * FF; const bool has_prev = (pm % (SEQ / 256)) != 0;
    static_assert(2 * FF == 11 * NTHREADS_, "ffn_fixup: 11 items per thread");
    float u0[11], u1[11], ul0[11], ul1[11], w0[11], w1[11], w2[11], bb[11], up[11];
#pragma unroll
    for (int it = 0; it < 11; ++it) { const int idx = tid + NTHREADS_ * it, rr = idx >= FF ? 1 : 0, j = idx - rr * FF;
        u0[it] = s[j]; u1[it] = s[FF + j]; ul0[it] = has_prev ? sp[4 * FF + j] : 0.f; ul1[it] = has_prev ? sp[5 * FF + j] : 0.f;
        w0[it] = cw[j]; w1[it] = cw[FF + j]; w2[it] = cw[2 * FF + j]; bb[it] = cb[j]; up[it] = s[(2 + rr) * FF + j]; }
#pragma unroll
    for (int it = 0; it < 11; ++it) { const int idx = tid + NTHREADS_ * it, rr = idx >= FF ? 1 : 0, j = idx - rr * FF;
        const float c = rr == 0 ? bb[it] + w0[it] * ul0[it] + w1[it] * ul1[it] + w2[it] * u0[it] : bb[it] + w0[it] * ul1[it] + w1[it] * u0[it] + w2[it] * u1[it];
        hid[(size_t)(pm * 256 + rr) * FF + j] = (bf16_t)f2bf(c * sigmoidf_(c) * up[it]); }
}

#define XB_TMO      128
#define XB_XCNT(j)  (256  + 64 * (j))
#define XB_XSUB(j)  (1280 + 64 * (j))
#define XB_XGEN(j)  (2304 + 64 * (j))
#define XB_TOP      3328
#define XB_TOPGEN   3392
#define XCD_BAR_WORDS 3456
#define XB_SPIN_CAP (1u << 18)

__device__ __forceinline__ unsigned xb_ld(unsigned* p)              { return __hip_atomic_load(p, __ATOMIC_RELAXED, __HIP_MEMORY_SCOPE_AGENT); }
__device__ __forceinline__ unsigned xb_add(unsigned* p, unsigned v) { return __hip_atomic_fetch_add(p, v, __ATOMIC_RELAXED, __HIP_MEMORY_SCOPE_AGENT); }
__device__ __forceinline__ unsigned xb_xcc_id() { return (unsigned)__builtin_amdgcn_s_getreg((3 << 11) | 20) & 0xFu; }
#define XB_SPIN(cond, bar) do { unsigned _sp = 0; while (cond) { __builtin_amdgcn_s_sleep(1); \
    if ((++_sp & 255u) == 0u) { if (xb_ld(&(bar)[XB_TMO])) break; if (_sp > XB_SPIN_CAP) { atomicAdd(&(bar)[XB_TMO], 1u); break; } } } } while (0)

struct XcdBarrier {
    unsigned* bar; unsigned x;
    volatile __attribute__((address_space(3))) unsigned* st;
};

__device__ __forceinline__ XcdBarrier xcd_barrier_post(unsigned* bar, volatile __attribute__((address_space(3))) unsigned* st) {
    XcdBarrier b; b.bar = bar; b.x = xb_xcc_id(); b.st = st;
    if (threadIdx.x == 0) (void)xb_add(&bar[XB_XCNT(b.x)], 1u);
    return b;
}
__device__ __forceinline__ void xcd_barrier_complete(unsigned* bar, unsigned x, unsigned& nloc, unsigned& nx) {
    const unsigned G = gridDim.x * gridDim.y * gridDim.z;
    unsigned sum, cnt, mine, sp = 0u;
    for (;;) {
        sum = 0u; cnt = 0u; mine = 0u;
#pragma unroll
        for (unsigned j = 0; j < 16; ++j) { const unsigned c = xb_ld(&bar[XB_XCNT(j)]); sum += c; cnt += (c > 0u) ? 1u : 0u; mine = (j == x) ? c : mine; }
        if (sum == G) break;
        __builtin_amdgcn_s_sleep(1);
        if ((++sp & 255u) == 0u) { if (xb_ld(&bar[XB_TMO])) break; if (sp > XB_SPIN_CAP) { atomicAdd(&bar[XB_TMO], 1u); break; } }
    }
    nloc = mine > 0u ? mine : 1u; nx = cnt > 0u ? cnt : 1u;
}

__device__ __forceinline__ void xcd_barrier(const XcdBarrier& b) {
    asm volatile("s_waitcnt vmcnt(0)" ::: "memory");
    __syncthreads();
    if (threadIdx.x == 0) {
        unsigned* bar = b.bar;
        __builtin_amdgcn_s_waitcnt(0);
        unsigned nloc = b.st[0], nx = b.st[1];
        if (nloc == 0u) { xcd_barrier_complete(bar, b.x, nloc, nx); b.st[0] = nloc; b.st[1] = nx; }
        const unsigned old = xb_add(&bar[XB_XSUB(b.x)], 1u);
        const unsigned gen = old / nloc;
        if (old + 1u == (gen + 1u) * nloc) {
            __builtin_amdgcn_fence(__ATOMIC_RELEASE, "agent");
            asm volatile("s_waitcnt vmcnt(0)" ::: "memory");
            const unsigned og = xb_add(&bar[XB_TOP], 1u);
            const unsigned tg = og / nx;
            if (og + 1u == (tg + 1u) * nx) xb_add(&bar[XB_TOPGEN], 1u);
            else XB_SPIN(xb_ld(&bar[XB_TOPGEN]) == tg, bar);
            __builtin_amdgcn_fence(__ATOMIC_ACQUIRE, "agent");
            xb_add(&bar[XB_XGEN(b.x)], 1u);
            asm volatile("s_waitcnt vmcnt(0)" ::: "memory");
        } else {
            XB_SPIN(xb_ld(&bar[XB_XGEN(b.x)]) == gen, bar);
            __builtin_amdgcn_fence(__ATOMIC_ACQUIRE, "agent");
            asm volatile("s_waitcnt vmcnt(0)" ::: "memory");
        }
    }
    __syncthreads();
}

constexpr int NTHREADS = 512, LDS_BYTES = 147456;
struct Args { const float* in[26]; float* out; unsigned char* ws; };
__global__ void __launch_bounds__(NTHREADS, 2) mega_fwd(Args a) {
    extern __shared__ __attribute__((aligned(16))) unsigned char lds[];
    constexpr int MISC_OFF = 131072 + 4096;
    { volatile __attribute__((address_space(3))) unsigned* misc = (volatile __attribute__((address_space(3))) unsigned*)((__attribute__((address_space(3))) unsigned char*)lds + MISC_OFF);
      if (threadIdx.x < 4) misc[threadIdx.x] = 0u; }
    __syncthreads();
    (void)xcd_barrier_post((unsigned*)(a.ws + WS_BAR), (volatile __attribute__((address_space(3))) unsigned*)((__attribute__((address_space(3))) unsigned char*)lds + MISC_OFF));
#define GRID_SYNC() do { XcdBarrier xb_; xb_.bar = (unsigned*)(a.ws + WS_BAR); xb_.x = xb_xcc_id(); xb_.st = (volatile __attribute__((address_space(3))) unsigned*)((__attribute__((address_space(3))) unsigned char*)lds + MISC_OFF); xcd_barrier(xb_); } while (0)
#define LDSP ((PG8_LAS unsigned char*)lds)
    constexpr int XCH_OFF = 131072;
#define OTID() ({ int _t = threadIdx.x; asm volatile("" : "+v"(_t)); _t; })
    const int G = gridDim.x, NGW = G * 8;
    const float* x = a.in[0]; const float* norm1_g = a.in[1]; const float* w_in = a.in[2]; const float* sinks = a.in[3];
    const float* mu = a.in[4]; const float* w0 = a.in[5]; const float* w2 = a.in[6]; const float* a0 = a.in[7];
    const float* a2 = a.in[8]; const float* g2 = a.in[9]; const float* k_k = a.in[10]; const float* k_a = a.in[11];
    const float* r_k = a.in[12]; const float* lnx_g = a.in[13]; const float* lnx_b = a.in[14]; const float* v0 = a.in[15];
    const float* v1 = a.in[16]; const float* v2 = a.in[17]; const float* w_out = a.in[18]; const float* norm2_g = a.in[19];
    const float* wg = a.in[20]; const float* wu = a.in[21]; const float* conv_w = a.in[22]; const float* conv_b = a.in[23];
    const float* wd = a.in[24]; const float* final_g = a.in[25];
    unsigned char* ws = a.ws; float* X = a.out;
    ssq_t* ss = (ssq_t*)(ws + WS_SS);
    bf16_t* XB = (bf16_t*)(ws + WS_XB); bf16_t* PROJ = (bf16_t*)(ws + WS_PROJ); bf16_t* MIX = (bf16_t*)(ws + WS_MIX); bf16_t* HID = (bf16_t*)(ws + WS_HID); bf16_t* VF = (bf16_t*)(ws + WS_VFIRST);
    bf16_t* UT = (bf16_t*)(ws + WS_UTMP); bf16_t* UPT = UT + (size_t)SEQ * FF;

    {
        const int tid = OTID(), lane = tid & 63, wave = tid >> 6, gw = blockIdx.x * 8 + wave;
        float* scr = (float*)lds + wave * (64 * 33 + 16);
        constexpr int I_IN = (D / 64) * (IN_W / 32), I_OUT = (D / 64) * (D / 32), I_G = (D / 64) * (FF / 32), I_DN = (FF / 64) * (D / 32), I_LAYER = I_IN + I_OUT + 2 * I_G + I_DN;
        for (int it = gw; it < 2 * I_LAYER; it += NGW) {
            const int l = it / I_LAYER; int r = it % I_LAYER;
            bf16_t* wl = (bf16_t*)(ws + WS_W + l * W_LAYER); bf16_t* WinT = wl; bf16_t* WoutT = (bf16_t*)((char*)wl + W_IN_SZ); bf16_t* WguT = (bf16_t*)((char*)WoutT + W_OUT_SZ); bf16_t* WdT = (bf16_t*)((char*)WguT + W_GU_SZ);
            if (r < I_IN) { transpose_item(w_in + (size_t)l * D * IN_W, D, IN_W, WinT, norm1_g + l * D, 0, scr, r, lane); continue; } r -= I_IN;
            if (r < I_OUT) { transpose_item(w_out + (size_t)l * D * D, D, D, WoutT, nullptr, 0, scr, r, lane); continue; } r -= I_OUT;
            if (r < I_G) { transpose_item(wg + (size_t)l * D * FF, D, FF, WguT, norm2_g + l * D, 1, scr, r, lane); continue; } r -= I_G;
            if (r < I_G) { transpose_item(wu + (size_t)l * D * FF, D, FF, WguT, norm2_g + l * D, 2, scr, r, lane); continue; } r -= I_G;
            transpose_item(wd + (size_t)l * FF * D, FF, D, WdT, nullptr, 0, scr, r, lane);
        }
        {
            constexpr int I_W2 = 1 * (C / 32), I_G2 = 2 * (C / 32), I_V1 = (C / 64) * 1, I_L = 2 * I_W2 + I_G2;
            const float* mu_v1 = a.in[4] + SHIFT_W + 1024;
            for (int it = gw; it < 2 * I_L + 2 * I_V1; it += NGW) {
                if (it < 2 * I_L) { const int l = it / I_L; int r = it % I_L; bf16_t* base = (bf16_t*)(ws + WS_LORA + l * LORA_LAYER);
                    if (r < I_W2) { transpose_item(w2 + (size_t)l * 64 * C, 64, C, base, nullptr, 0, scr, r, lane); continue; } r -= I_W2;
                    if (r < I_W2) { transpose_item(a2 + (size_t)l * 64 * C, 64, C, base + 512 * 64, nullptr, 0, scr, r, lane); continue; } r -= I_W2;
                    transpose_item(g2 + (size_t)l * 128 * C, 128, C, base + 2 * 512 * 64, nullptr, 0, scr, r, lane); }
                else if (it < 2 * I_L + I_V1) transpose_item(v1, C, 32, (bf16_t*)(ws + WS_V1T), mu_v1, 0, scr, it - 2 * I_L, lane, true);
                else transpose_item(v1, C, 32, (bf16_t*)(ws + WS_V1B), mu_v1, 0, scr, it - 2 * I_L - I_V1, lane, false);
            }
            bf16_t* V2T = (bf16_t*)(ws + WS_V2T);
            for (int i = blockIdx.x * NTHREADS + tid; i < 32 * C; i += G * NTHREADS) { const int j = i / C, ch = i % C; V2T[ch * 32 + j] = (bf16_t)f2bf(v2[i]); }
        }
        for (int m = 4 * gw; m < M; m += 4 * NGW) {
            f32x4 xv[4][4];
#pragma unroll
            for (int u = 0; u < 4; ++u)
#pragma unroll
                for (int j = 0; j < 4; ++j) xv[u][j] = ((const f32x4*)(x + (size_t)(m + u) * D))[lane + 64 * j];
#pragma unroll
            for (int u = 0; u < 4; ++u) { float sq = 0.f;
#pragma unroll
                for (int j = 0; j < 4; ++j) { const f32x4 v = xv[u][j]; sq += v.x * v.x + v.y * v.y + v.z * v.z + v.w * v.w;
                    ((unsigned long long*)(XB + (size_t)(m + u) * D))[lane + 64 * j] = (unsigned long long)(f2bf(v.x) | (f2bf(v.y) << 16)) | ((unsigned long long)(f2bf(v.z) | (f2bf(v.w) << 16)) << 32); }
                sq = wave_sum(sq); if (lane == 0) ss[m + u] = ssq_fix(sq); } }
    }
    GRID_SYNC();
    for (int l = 0; l < 2; ++l) {
        bf16_t* wl = (bf16_t*)(ws + WS_W + l * W_LAYER); bf16_t* WinT = wl; bf16_t* WoutT = (bf16_t*)((char*)wl + W_IN_SZ); bf16_t* WguT = (bf16_t*)((char*)WoutT + W_OUT_SZ); bf16_t* WdT = (bf16_t*)((char*)WguT + W_GU_SZ);
        ssq_t* ss1 = ss + (size_t)(2 * l) * M; ssq_t* ss2 = ss + (size_t)(2 * l + 1) * M; ssq_t* ss3 = ss + (size_t)(2 * l + 2) * M;
        { pg8::Gemm g{XB, WinT, M, IN_W, D}; pg8::StaticOrder S; S.init(M, IN_W, G, (int)blockIdx.x); pg8::EpiScaleBf16 E{PROJ, IN_W, ss1};
          pg8::gemm_phase<pg8::EpiScaleBf16, pg8::StaticOrder, true, true>(LDSP, g, S, E); }
        GRID_SYNC();
        { float* KC = (float*)(lds + CK_CONST_OFF); const int t_ = OTID(); KC[t_] = (k_k + l * C)[t_]; KC[512 + t_] = (k_a + l * C)[t_]; KC[1024 + t_] = (r_k + l * C)[t_]; KC[1536 + t_] = (mu + l * SHIFT_W)[t_]; KC[2048 + t_] = (mu + l * SHIFT_W)[512 + t_]; __syncthreads(); }
        attn_phase(PROJ, sinks + l * NH, MIX, lds, G, OTID());
        struct { bf16_t *V, *G; } p; p.V = (bf16_t*)(ws + WS_SI_V); p.G = (bf16_t*)(ws + WS_SI_G);
        bf16_t* GQ = (bf16_t*)X; bf16_t* CQ = GQ + (size_t)BATCH * NH * 64 * 8192;
        ScanArgs s{}; s.proj = PROJ; s.V = p.V; s.G = p.G; s.k_k = k_k + l * C; s.k_a = k_a + l * C; s.r_k = r_k + l * C; s.lnx_g = lnx_g + l * C; s.lnx_b = lnx_b + l * C; s.mix = MIX; s.rkc = (float*)(ws + WS_RKC);
        { bf16_t* scr = (bf16_t*)(ws + WS_TSCR + (size_t)blockIdx.x * TSCR_WG);
          for (int tile = blockIdx.x; tile < M / 64; tile += G) {
              const size_t moff = (size_t)tile * 64 * C;
              Prep2Args q{}; q.proj = PROJ; q.mu = mu + l * SHIFT_W; q.w0 = w0 + l * C; q.a0 = a0 + l * C; q.v0 = v0;
              const bf16_t* lw = (const bf16_t*)(ws + WS_LORA + l * LORA_LAYER); q.W2T = lw; q.A2T = lw + 512 * 64; q.G2T = lw + 2 * 512 * 64; q.V1T = (const bf16_t*)(ws + WS_V1T); q.V1B = (const bf16_t*)(ws + WS_V1B); q.V2T = (const bf16_t*)(ws + WS_V2T);
              q.vfirst = VF; q.A = scr - moff; q.CS = (unsigned short*)(scr + 64 * C) - moff; q.V = p.V; q.G = p.G; q.layer = l;
              prep_tile(q, lds, tile, OTID());
              asm volatile("s_waitcnt vmcnt(0)" ::: "memory"); __syncthreads();
              if (threadIdx.x == 0) { __builtin_amdgcn_fence(__ATOMIC_ACQUIRE, "agent"); asm volatile("s_waitcnt vmcnt(0)" ::: "memory"); }
              __syncthreads();
              s.A = q.A; s.CS = q.CS;
              const int bb = tile >> 6, chunk = tile & 63;
              CkRaw cur; ck_load(s, cur, ((bb * NH) << 6) + chunk, OTID());
#define CK_UNIT(hh_) do { const int unit = ((bb * NH + (hh_)) << 6) + chunk; CkRaw nxt = cur; ck_precompute(s, cur, nxt, (hh_) + 1 < NH ? unit + 64 : unit, lds, GQ, CQ, unit, OTID()); cur = nxt; } while (0)
              CK_UNIT(0);
              for (int hh = 1; hh < NH; ++hh) CK_UNIT(hh);
#undef CK_UNIT
          } }
        GRID_SYNC();
        for (int item = (int)((blockIdx.x & 7) * (G >> 3) + (blockIdx.x >> 3)); item < BATCH * NH * 4; item += G) ck_sequential(s, lds, GQ, CQ, item, OTID());
        GRID_SYNC();
        { const int tid = OTID(), lane = tid & 63, gw = blockIdx.x * 8 + (tid >> 6); scan_post_wave(s, gw, NGW, lane); }
        GRID_SYNC();
        { pg8::Gemm g{MIX, WoutT, M, D, D}; pg8::StaticOrder S; S.init(M, D, G, (int)blockIdx.x); pg8::EpiResid E{XB, ss2};
          pg8::gemm_phase<pg8::EpiResid, pg8::StaticOrder, true, true>(LDSP, g, S, E); }
        GRID_SYNC();
        { pg8::Gemm g{XB, WguT, M, 2 * FF, D}; pg8::StaticOrder S; S.init(M, 2 * FF, G, (int)blockIdx.x);
          pg8::EpiConvGlu E{HID, ss2, conv_w + (size_t)l * 3 * FF, conv_b + (size_t)l * FF, (float*)(ws + WS_UTMP), (PG8_LAS float*)(LDSP + XCH_OFF), FF};
          pg8::gemm_phase<pg8::EpiConvGlu, pg8::StaticOrder, true, true>(LDSP, g, S, E); }
        GRID_SYNC();
        { pg8::Gemm g{HID, WdT, M, D, FF}; pg8::StaticOrder S; S.init(M, D, G, (int)blockIdx.x);
          { pg8::Unit u; for (int i = 0; S.next(i, u); ++i) ffn_fixup((const float*)(ws + WS_UTMP), conv_w + (size_t)l * 3 * FF, conv_b + (size_t)l * FF, HID, u.pm, OTID());
            asm volatile("s_waitcnt vmcnt(0)" ::: "memory"); __syncthreads(); }
          if (l == 0) { pg8::EpiResid E{XB, ss3}; pg8::gemm_phase<pg8::EpiResid, pg8::StaticOrder, true, true>(LDSP, g, S, E); }
          else { pg8::EpiResidFinal E{XB, ss3, (unsigned*)(ws + WS_FCNT), final_g, X};
                 pg8::gemm_phase<pg8::EpiResidFinal, pg8::StaticOrder, true, true>(LDSP, g, S, E); } }
        if (l == 0) GRID_SYNC();
    }
}

extern "C" void kernel_launch(void* const* d_in, const int* in_sizes, int n_in, void* d_out, int out_size, void* d_ws, size_t ws_size, hipStream_t stream) {
    static int grid = 0;
    if (grid == 0) {
        if (n_in != 26 || in_sizes[0] != M * D || out_size != M * D || ws_size < WS_END) { fprintf(stderr, "kernel_launch: unexpected shapes (n_in %d, ws %zu)\n", n_in, ws_size); grid = -1; return; }
        int dev = 0, cus = 0, per_cu = 0;
        if (hipGetDevice(&dev) != hipSuccess || hipDeviceGetAttribute(&cus, hipDeviceAttributeMultiprocessorCount, dev) != hipSuccess) { grid = -1; return; }
        if (hipFuncSetAttribute((const void*)mega_fwd, hipFuncAttributeMaxDynamicSharedMemorySize, LDS_BYTES) != hipSuccess) { fprintf(stderr, "kernel_launch: hipFuncSetAttribute failed\n"); grid = -1; return; }
        if (hipOccupancyMaxActiveBlocksPerMultiprocessor(&per_cu, (const void*)mega_fwd, NTHREADS, LDS_BYTES) != hipSuccess || per_cu < 1) { fprintf(stderr, "kernel_launch: occupancy query failed (%d)\n", per_cu); grid = -1; return; }
        grid = cus;
    }
    if (grid < 0) return;
    (void)hipMemsetAsync((unsigned char*)d_ws + WS_CTL, 0, CTL_BYTES, stream);
    Args a{};
    for (int i = 0; i < 26; ++i) a.in[i] = (const float*)d_in[i];
    a.out = (float*)d_out; a.ws = (unsigned char*)d_ws;
    void* kargs[] = {&a};
    hipError_t e = hipLaunchCooperativeKernel((const void*)mega_fwd, dim3(grid), dim3(NTHREADS), kargs, LDS_BYTES, stream);
    if (e != hipSuccess) fprintf(stderr, "kernel_launch: cooperative launch failed: %s (grid %d)\n", hipGetErrorString(e), grid);
}
```

```cpp
#include <hip/hip_runtime.h>
#include <cstdio>
#include <cstdint>

typedef unsigned short bf16_t;
typedef short bf16x8 __attribute__((ext_vector_type(8)));
typedef float f32x4 __attribute__((ext_vector_type(4)));

constexpr int BATCH = 8, SEQ = 4096, D = 1024, M = BATCH * SEQ;
constexpr int HD = 64, ATT_W = 512, KV_W = 128, C = 512, NH = 8;
constexpr int ATT_IN = 768, SHIFT_W = 1792, IN_W = 2560, FF = 2816;
constexpr int WINDOW = 128;
constexpr float RMS_EPS = 1e-5f, LNX_EPS = 64e-5f;

constexpr size_t MiB = 1u << 20;
constexpr size_t WS_CTL = 0;
typedef unsigned long long ssq_t;
__device__ __forceinline__ ssq_t ssq_fix(float s) { return (ssq_t)(s * 1048576.0f + 0.5f); }
__device__ __forceinline__ float ssq_val(ssq_t v) { return (float)v * (1.0f / 1048576.0f); }
constexpr size_t WS_SS = 0;
constexpr size_t CTL_BYTES = 2 * MiB;
constexpr size_t WS_FCNT = 1792 * 1024;
constexpr size_t WS_BAR = 1536 * 1024;
constexpr size_t WS_W = 2 * MiB;
constexpr size_t W_IN_SZ = (size_t)IN_W * D * 2, W_OUT_SZ = (size_t)D * D * 2, W_GU_SZ = (size_t)2 * FF * D * 2, W_DN_SZ = (size_t)D * FF * 2;
constexpr size_t W_LAYER = W_IN_SZ + W_OUT_SZ + W_GU_SZ + W_DN_SZ;
constexpr size_t WS_VFIRST = 52 * MiB, WS_MIX = 84 * MiB, WS_XB = 148 * MiB, WS_PROJ = 212 * MiB;
constexpr size_t WS_SI_R = 148 * MiB, WS_SI_K = 180 * MiB, WS_SI_V = 372 * MiB, WS_SI_A = 404 * MiB, WS_SI_LD = 436 * MiB, WS_SI_G = 468 * MiB;
constexpr size_t WS_HID = 212 * MiB;
constexpr size_t WS_UTMP = 84 * MiB;
constexpr size_t WS_END = 500 * MiB;
static_assert(WS_W + 2 * W_LAYER <= WS_VFIRST, "weights fit");

__device__ __forceinline__ unsigned f2bf(float f) { unsigned u = __builtin_bit_cast(unsigned, f); return (u + 0x7fffu + ((u >> 16) & 1u)) >> 16; }
__device__ __forceinline__ float bf2f(bf16_t h) { return __builtin_bit_cast(float, (unsigned)h << 16); }
__device__ __forceinline__ float wave_sum(float v) {
#pragma unroll
    for (int o = 1; o < 64; o <<= 1) v += __shfl_xor(v, o);
    return v;
}
#define LDS_BARRIER() do { asm volatile("s_waitcnt lgkmcnt(0)" ::: "memory"); __builtin_amdgcn_s_barrier(); asm volatile("" ::: "memory"); } while (0)
__device__ __forceinline__ float sigmoidf_(float x) { return __builtin_amdgcn_rcpf(1.f + __expf(-x)); }

namespace pg8 {
#define PG8_LAS __attribute__((address_space(3)))
typedef unsigned short bf16_t;
typedef short bf16x8 __attribute__((ext_vector_type(8)));
typedef float f32x4 __attribute__((ext_vector_type(4)));
typedef unsigned u32x4 __attribute__((ext_vector_type(4)));
constexpr int BM = 256, BK = 64, HALF = 128, HTB = HALF * BK * 2  , STAGE_BYTES = 8 * HTB, NXCD = 8, WGM = 8;

__host__ __device__ __forceinline__ int lds_byte(int r, int c) { const int st = (r >> 4) * 2 + (c >> 5), rr = r & 15, cc = c & 31, ob = rr * 64 + cc * 2; return st * 1024 + (ob ^ (((ob >> 9) & 1) << 5)); }
__host__ __device__ __forceinline__ void stage_rc(int b, int& R, int& C) { const int st = b / 1024, sb = b % 1024, swz = sb ^ (((sb >> 9) & 1) << 5); R = (st >> 1) * 16 + swz / 64; C = (st & 1) * 32 + (swz % 64) / 2; }
__host__ __device__ __forceinline__ int perm32(int rho) { const int n = rho >> 4, i = rho & 15; return 8 * (i >> 2) + 4 * n + (i & 3); }

struct Unit { int pm, pn; };
struct Gemm { const bf16_t* A; const bf16_t* Bt; int M, N, K; };

struct StaticOrder {
    int nM, nN, nwg, G, c;
    __host__ __device__ void init(int M, int N, int G_, int c_) { nM = M / BM; nN = N / BM; nwg = nM * nN; G = G_; c = c_; }
    __host__ __device__ bool next(int i, Unit& u) const {
        const long L = (long)i * G + c; if (L >= nwg) return false;
        int wgid = (int)L; { const int q = nwg / NXCD, r = nwg % NXCD, xcd = wgid % NXCD, off = wgid / NXCD; wgid = (xcd < r ? xcd * (q + 1) : r * (q + 1) + (xcd - r) * q) + off; }
        const int nig = WGM * nN, gid = wgid / nig, fm = gid * WGM, gsz = (nM - fm) < WGM ? (nM - fm) : WGM;
        u.pm = fm + ((wgid % nig) % gsz); u.pn = (wgid % nig) / gsz; return true;
    }
    __device__ __forceinline__ void a_ready(const Unit&) const {}
    __device__ __forceinline__ void done(const Unit&) const {}
};
typedef float f32x2_t_ __attribute__((ext_vector_type(2))); typedef __bf16 bf16x2_t_ __attribute__((ext_vector_type(2)));
__device__ __forceinline__ unsigned cvt_pk_bf16(float lo, float hi) { const f32x2_t_ v = {lo, hi}; const bf16x2_t_ b = __builtin_convertvector(v, bf16x2_t_); return __builtin_bit_cast(unsigned, b); }
typedef float f32x2 __attribute__((ext_vector_type(2)));
template <class Epi, class Sched, bool ALIGN_EPI = false, bool SP2 = false>
__device__ __forceinline__ void gemm_phase(PG8_LAS unsigned char* lds, const Gemm g, const Sched& S, const Epi& E) {
    int tid_ = threadIdx.x; asm volatile("" : "+v"(tid_));
    const int tid = tid_, wid = __builtin_amdgcn_readfirstlane(tid >> 6), lane = tid & 63, wr = wid >> 2, wc = wid & 3, fr = lane & 15, fq = lane >> 4;
    const int K = g.K, nt = K / BK;
    unsigned voffA[2], voffB[2];
#pragma unroll
    for (int i = 0; i < 2; ++i) { int R, C; stage_rc(tid * 16 + i * 8192, R, C); const int Rb = (R >> 5) * 64 + (Epi::PERM ? perm32(R & 31) : (R & 31));
        voffA[i] = (unsigned)(R * K + C) * 2u; voffB[i] = (unsigned)(Rb * K + C) * 2u; }
    const size_t kstep = (size_t)(BK * 2);
    const size_t hstep = (size_t)HALF * K * 2;
    const size_t tstep = 2 * hstep;
    const size_t hstepB = (size_t)32 * K * 2;
    const unsigned ldsw = (unsigned)wid * 1024u;
    const int aoff = lds_byte(wr * 64 + fr, fq * 8), boff = lds_byte(wc * 32 + fr, fq * 8);
#define PG8_SA(b, h) (((b) * 2 + (h)) * HTB)
#define PG8_SB(b, h) ((4 + (b) * 2 + (h)) * HTB)
#define PG8_STAGE(bufoff, gbase, voff) do { _Pragma("unroll") for (int _i = 0; _i < 2; ++_i) \
        __builtin_amdgcn_global_load_lds((const unsigned*)((const char*)(gbase) + (voff)[_i]), (PG8_LAS unsigned*)(lds + (bufoff) + ldsw + _i * 8192), 16, 0, 0); } while (0)
#define PG8_LDA(dst, b, h) do { _Pragma("unroll") for (int m = 0; m < 4; ++m) _Pragma("unroll") for (int k = 0; k < 2; ++k) dst[m][k] = *(const PG8_LAS bf16x8*)(lds + PG8_SA(b, h) + aoff + m * 2048 + k * 1024); } while (0)
#define PG8_LDB(dst, b, h) do { _Pragma("unroll") for (int n = 0; n < 2; ++n) _Pragma("unroll") for (int k = 0; k < 2; ++k) dst[n][k] = *(const PG8_LAS bf16x8*)(lds + PG8_SB(b, h) + boff + n * 2048 + k * 1024); } while (0)
#define PG8_MMA(ai, bj, At, Bt) do { __builtin_amdgcn_s_setprio(1); _Pragma("unroll") for (int m = 0; m < 4; ++m) _Pragma("unroll") for (int n = 0; n < 2; ++n) _Pragma("unroll") for (int k = 0; k < 2; ++k) \
        acc[ai][bj][m][n] = __builtin_amdgcn_mfma_f32_16x16x32_bf16(Bt[n][k], At[m][k], acc[ai][bj][m][n], 0, 0, 0); __builtin_amdgcn_s_setprio(0); } while (0)
#define PG8_WAIT_V(n) asm volatile("s_waitcnt vmcnt(" #n ")" ::: "memory")
#define PG8_WAIT_L(n) asm volatile("s_waitcnt lgkmcnt(" #n ")" ::: "memory")
#define PG8_BAR __builtin_amdgcn_s_barrier()
#define PG8_SCHED __builtin_amdgcn_sched_barrier(0)
    Unit cur, nxt; int ui = 0;
    if (!S.next(0, cur)) return;
    f32x4 acc[2][2][4][2];
#pragma unroll
    for (int a = 0; a < 2; ++a)
#pragma unroll
        for (int b = 0; b < 2; ++b)
#pragma unroll
            for (int m = 0; m < 4; ++m)
#pragma unroll
                for (int n = 0; n < 2; ++n) acc[a][b][m][n] = (f32x4){0.f, 0.f, 0.f, 0.f};
    bf16x8 At[4][2], B0[2][2], B1[2][2];
    const char* cA = (const char*)g.A + (size_t)cur.pm * tstep; const char* cB = (const char*)g.Bt + (size_t)cur.pn * tstep;
    S.a_ready(cur);
    if constexpr (SP2) {
        PG8_STAGE(PG8_SB(0, 0), cB, voffB); PG8_STAGE(PG8_SB(0, 1), cB + hstepB, voffB); PG8_STAGE(PG8_SA(0, 0), cA, voffA); PG8_STAGE(PG8_SA(0, 1), cA + hstep, voffA);
        if (wr == 1) PG8_BAR;
        PG8_WAIT_V(2); PG8_BAR;
        PG8_STAGE(PG8_SB(1, 0), cB + kstep, voffB); PG8_STAGE(PG8_SA(1, 0), cA + kstep, voffA); PG8_STAGE(PG8_SB(1, 1), cB + hstepB + kstep, voffB);
        PG8_WAIT_V(6); PG8_BAR;
    } else {
        PG8_STAGE(PG8_SB(0, 0), cB, voffB); PG8_STAGE(PG8_SA(0, 0), cA, voffA); PG8_STAGE(PG8_SB(0, 1), cB + hstepB, voffB); PG8_STAGE(PG8_SA(0, 1), cA + hstep, voffA);
        if (wr == 1) PG8_BAR;
        PG8_WAIT_V(4); PG8_BAR;
        PG8_STAGE(PG8_SB(1, 0), cB + kstep, voffB); PG8_STAGE(PG8_SA(1, 0), cA + kstep, voffA); PG8_STAGE(PG8_SB(1, 1), cB + hstepB + kstep, voffB);
        PG8_WAIT_V(6); PG8_BAR;
    }
    for (;;) {
        const bool has_next = S.next(ui + 1, nxt);
        const char* nA = has_next ? (const char*)g.A + (size_t)nxt.pm * tstep : cA; const char* nB = has_next ? (const char*)g.Bt + (size_t)nxt.pn * tstep : cB;
        for (int t = 0; t < nt; t += 2) {
            const bool last = (t == nt - 2);
            const char* a1 = cA + (size_t)(t + 1) * kstep;
            const char* a2 = last ? nA : cA + (size_t)(t + 2) * kstep; const char* b2 = last ? nB : cB + (size_t)(t + 2) * kstep;
            const char* a3 = a2 + kstep; const char* b3 = b2 + kstep;
            if (last && has_next) S.a_ready(nxt);
            if constexpr (SP2) {
            PG8_LDB(B0, 0, 0); PG8_LDB(B1, 0, 1); PG8_SCHED; PG8_LDA(At, 0, 0); PG8_STAGE(PG8_SA(1, 1), a1 + hstep, voffA);
            PG8_WAIT_V(8); PG8_WAIT_L(0); PG8_BAR; PG8_MMA(0, 0, At, B0); PG8_MMA(0, 1, At, B1); PG8_BAR; PG8_SCHED;
            PG8_LDA(At, 0, 1); PG8_STAGE(PG8_SB(0, 0), b2, voffB); PG8_STAGE(PG8_SB(0, 1), b2 + hstepB, voffB); PG8_STAGE(PG8_SA(0, 0), a2, voffA);
            PG8_WAIT_V(8); PG8_WAIT_L(0); PG8_BAR; PG8_MMA(1, 0, At, B0); PG8_MMA(1, 1, At, B1); PG8_BAR; PG8_SCHED;
            PG8_LDB(B0, 1, 0); PG8_LDB(B1, 1, 1); PG8_SCHED; PG8_LDA(At, 1, 0); PG8_STAGE(PG8_SA(0, 1), a2 + hstep, voffA);
            PG8_WAIT_V(8); PG8_WAIT_L(0); PG8_BAR; PG8_MMA(0, 0, At, B0); PG8_MMA(0, 1, At, B1); PG8_BAR; PG8_SCHED;
            PG8_LDA(At, 1, 1); PG8_STAGE(PG8_SB(1, 0), b3, voffB); PG8_STAGE(PG8_SB(1, 1), b3 + hstepB, voffB); PG8_STAGE(PG8_SA(1, 0), a3, voffA);
            PG8_WAIT_V(8); PG8_WAIT_L(0); PG8_BAR; PG8_MMA(1, 0, At, B0); PG8_MMA(1, 1, At, B1); PG8_BAR; PG8_SCHED;
            } else {
            PG8_LDB(B0, 0, 0); PG8_SCHED; PG8_LDA(At, 0, 0); PG8_STAGE(PG8_SA(1, 1), a1 + hstep, voffA);
            PG8_WAIT_L(8); PG8_BAR; PG8_WAIT_L(0); PG8_MMA(0, 0, At, B0); PG8_BAR; PG8_SCHED;
            PG8_LDB(B1, 0, 1); PG8_STAGE(PG8_SB(0, 0), b2, voffB);
            PG8_BAR; PG8_WAIT_L(0); PG8_MMA(0, 1, At, B1); PG8_BAR;
            PG8_LDA(At, 0, 1); PG8_STAGE(PG8_SA(0, 0), a2, voffA);
            PG8_BAR; PG8_WAIT_L(0); PG8_MMA(1, 0, At, B0); PG8_BAR; PG8_SCHED;
            PG8_STAGE(PG8_SB(0, 1), b2 + hstepB, voffB);
            PG8_WAIT_V(6); PG8_BAR; PG8_MMA(1, 1, At, B1); PG8_BAR;
            PG8_LDB(B0, 1, 0); PG8_SCHED; PG8_LDA(At, 1, 0); PG8_STAGE(PG8_SA(0, 1), a2 + hstep, voffA);
            PG8_WAIT_L(8); PG8_BAR; PG8_WAIT_L(0); PG8_MMA(0, 0, At, B0); PG8_BAR; PG8_SCHED;
            PG8_LDB(B1, 1, 1); PG8_STAGE(PG8_SB(1, 0), b3, voffB);
            PG8_BAR; PG8_WAIT_L(0); PG8_MMA(0, 1, At, B1); PG8_BAR;
            PG8_LDA(At, 1, 1); PG8_STAGE(PG8_SA(1, 0), a3, voffA);
            PG8_BAR; PG8_WAIT_L(0); PG8_MMA(1, 0, At, B0); PG8_BAR; PG8_SCHED;
            PG8_STAGE(PG8_SB(1, 1), b3 + hstepB, voffB);
            PG8_WAIT_V(6); PG8_BAR; PG8_MMA(1, 1, At, B1); PG8_BAR;
            }
        }
        if constexpr (ALIGN_EPI) { if (wr == 0) PG8_BAR; }
        if constexpr (!Epi::AFTER_DRAIN) { E(acc, cur, wr, wc, fr, fq); S.done(cur); }
        if (!has_next) break;
#pragma unroll
        for (int a = 0; a < 2; ++a)
#pragma unroll
            for (int b = 0; b < 2; ++b)
#pragma unroll
                for (int m = 0; m < 4; ++m)
#pragma unroll
                    for (int n = 0; n < 2; ++n) acc[a][b][m][n] = (f32x4){0.f, 0.f, 0.f, 0.f};
        cur = nxt; cA = nA; cB = nB; ++ui;
        if constexpr (ALIGN_EPI) { if (wr == 1) PG8_BAR; }
    }
    PG8_WAIT_V(0);
    if constexpr (!ALIGN_EPI) { if (wr == 0) PG8_BAR; }
    PG8_BAR;
    if constexpr (Epi::AFTER_DRAIN) { E.fused(acc, cur, wr, wc, fr, fq, lds, wid, lane); S.done(cur); }
#undef PG8_SA
#undef PG8_SB
#undef PG8_STAGE
#undef PG8_LDA
#undef PG8_LDB
#undef PG8_MMA
#undef PG8_WAIT_V
#undef PG8_WAIT_L
#undef PG8_BAR
#undef PG8_SCHED
}

constexpr int DM_ = 1024; constexpr float RMS_EPS_ = 1e-5f;
typedef unsigned long long ssq_t;
struct EpiScaleBf16 {
    static constexpr bool PERM = true, AFTER_DRAIN = false;
    bf16_t* O; int ldc; const ssq_t* ss;
    __device__ __forceinline__ void operator()(const f32x4 (&acc)[2][2][4][2], const Unit& u, int wr, int wc, int fr, int fq) const {
        const int row0 = u.pm * BM + wr * 64 + fr, col0 = u.pn * BM + wc * 64 + 8 * fq;
        float rsv[2][4];
#pragma unroll
        for (int ai = 0; ai < 2; ++ai)
#pragma unroll
            for (int m = 0; m < 4; ++m) rsv[ai][m] = (float)ss[row0 + ai * HALF + m * 16] * (1.0f / 1048576.0f);
#pragma unroll
        for (int ai = 0; ai < 2; ++ai)
#pragma unroll
            for (int m = 0; m < 4; ++m) { const int row = row0 + ai * HALF + m * 16; const float rs = __builtin_amdgcn_rsqf(rsv[ai][m] * (1.0f / DM_) + RMS_EPS_); bf16_t* rowp = O + (size_t)row * ldc + col0;
#pragma unroll
                for (int bj = 0; bj < 2; ++bj) { const f32x4 v0 = acc[ai][bj][m][0] * rs, v1 = acc[ai][bj][m][1] * rs;
                    u32x4 w; w.x = cvt_pk_bf16(v0[0], v0[1]); w.y = cvt_pk_bf16(v0[2], v0[3]); w.z = cvt_pk_bf16(v1[0], v1[1]); w.w = cvt_pk_bf16(v1[2], v1[3]);
                    *(u32x4*)(rowp + bj * 32) = w; } }
    }
};
struct EpiResid {
    static constexpr bool PERM = true, AFTER_DRAIN = false;
    bf16_t* xb; ssq_t* ss_out;
    __device__ __forceinline__ void operator()(const f32x4 (&acc)[2][2][4][2], const Unit& u, int wr, int wc, int fr, int fq) const {
        const int row0 = u.pm * BM + wr * 64 + fr, col0 = u.pn * BM + wc * 64 + 8 * fq;
#pragma unroll
        for (int ai = 0; ai < 2; ++ai) {
            u32x4 bs[4][2];
#pragma unroll
            for (int m = 0; m < 4; ++m)
#pragma unroll
                for (int bj = 0; bj < 2; ++bj) bs[m][bj] = *(const u32x4*)(xb + (size_t)(row0 + ai * HALF + m * 16) * DM_ + col0 + bj * 32);
#pragma unroll
            for (int m = 0; m < 4; ++m) { const int row = row0 + ai * HALF + m * 16; bf16_t* rp = xb + (size_t)row * DM_ + col0; float sq = 0.f;
#pragma unroll
                for (int bj = 0; bj < 2; ++bj) { const u32x4 b = bs[m][bj]; u32x4 w;
#pragma unroll
                    for (int hh = 0; hh < 2; ++hh) { const unsigned b0 = hh == 0 ? b.x : b.z, b1 = hh == 0 ? b.y : b.w; const f32x4 a4 = acc[ai][bj][m][hh];
                        const float x0 = __builtin_bit_cast(float, b0 << 16) + a4[0], x1 = __builtin_bit_cast(float, b0 & 0xffff0000u) + a4[1], x2 = __builtin_bit_cast(float, b1 << 16) + a4[2], x3 = __builtin_bit_cast(float, b1 & 0xffff0000u) + a4[3];
                        const unsigned w0 = cvt_pk_bf16(x0, x1), w1 = cvt_pk_bf16(x2, x3);
                        if (hh == 0) { w.x = w0; w.y = w1; } else { w.z = w0; w.w = w1; }
                        const float r0 = __builtin_bit_cast(float, w0 << 16), r1 = __builtin_bit_cast(float, w0 & 0xffff0000u), r2 = __builtin_bit_cast(float, w1 << 16), r3 = __builtin_bit_cast(float, w1 & 0xffff0000u);
                        sq += (r0 * r0 + r1 * r1) + (r2 * r2 + r3 * r3); }
                    *(u32x4*)(rp + bj * 32) = w; }
                sq += __shfl_xor(sq, 16); sq += __shfl_xor(sq, 32);
                if (fq == 0) atomicAdd(ss_out + row, (ssq_t)(sq * 1048576.0f + 0.5f)); }
        }
    }
};
struct EpiResidFinal {
    static constexpr bool PERM = true, AFTER_DRAIN = false;
    const bf16_t* xb; ssq_t* ss_out; unsigned* cnt; const float* g; float* out;
    __device__ __forceinline__ void operator()(f32x4 (&acc)[2][2][4][2], const Unit& u, int wr, int wc, int fr, int fq) const {
        const int row0 = u.pm * BM + wr * 64 + fr, col0 = u.pn * BM + wc * 64 + 8 * fq;
#pragma unroll
        for (int ai = 0; ai < 2; ++ai) {
            u32x4 bs[4][2];
#pragma unroll
            for (int m = 0; m < 4; ++m)
#pragma unroll
                for (int bj = 0; bj < 2; ++bj) bs[m][bj] = *(const u32x4*)(xb + (size_t)(row0 + ai * HALF + m * 16) * DM_ + col0 + bj * 32);
#pragma unroll
            for (int m = 0; m < 4; ++m) { const int row = row0 + ai * HALF + m * 16; float sq = 0.f;
#pragma unroll
                for (int bj = 0; bj < 2; ++bj) { const u32x4 b = bs[m][bj];
#pragma unroll
                    for (int hh = 0; hh < 2; ++hh) { const unsigned b0 = hh == 0 ? b.x : b.z, b1 = hh == 0 ? b.y : b.w; const f32x4 a4 = acc[ai][bj][m][hh];
                        const float x0 = __builtin_bit_cast(float, b0 << 16) + a4[0], x1 = __builtin_bit_cast(float, b0 & 0xffff0000u) + a4[1], x2 = __builtin_bit_cast(float, b1 << 16) + a4[2], x3 = __builtin_bit_cast(float, b1 & 0xffff0000u) + a4[3];
                        const unsigned w0 = cvt_pk_bf16(x0, x1), w1 = cvt_pk_bf16(x2, x3);
                        const float r0 = __builtin_bit_cast(float, w0 << 16), r1 = __builtin_bit_cast(float, w0 & 0xffff0000u), r2 = __builtin_bit_cast(float, w1 << 16), r3 = __builtin_bit_cast(float, w1 & 0xffff0000u);
                        acc[ai][bj][m][hh] = (f32x4){r0, r1, r2, r3};
                        sq += (r0 * r0 + r1 * r1) + (r2 * r2 + r3 * r3); } }
                sq += __shfl_xor(sq, 16); sq += __shfl_xor(sq, 32);
                if (fq == 0) atomicAdd(ss_out + row, (ssq_t)(sq * 1048576.0f + 0.5f)); }
        }
        asm volatile("s_waitcnt vmcnt(0)" ::: "memory"); __builtin_amdgcn_s_barrier(); asm volatile("" ::: "memory");
        if (wr == 0 && wc == 0 && fr == 0 && fq == 0) {
            (void)__hip_atomic_fetch_add(cnt + u.pm, 1u, __ATOMIC_RELAXED, __HIP_MEMORY_SCOPE_AGENT);
            for (unsigned sp = 0; __hip_atomic_load(cnt + u.pm, __ATOMIC_RELAXED, __HIP_MEMORY_SCOPE_AGENT) < 4u && sp < (1u << 22); ++sp) __builtin_amdgcn_s_sleep(2);
        }
        asm volatile("s_waitcnt vmcnt(0)" ::: "memory"); __builtin_amdgcn_s_barrier(); asm volatile("" ::: "memory");
        f32x4 gv[2][2];
#pragma unroll
        for (int bj = 0; bj < 2; ++bj)
#pragma unroll
            for (int hh = 0; hh < 2; ++hh) gv[bj][hh] = *(const f32x4*)(g + col0 + bj * 32 + 4 * hh);
#pragma unroll
        for (int ai = 0; ai < 2; ++ai)
#pragma unroll
            for (int m = 0; m < 4; ++m) { const int row = row0 + ai * HALF + m * 16;
                const ssq_t sv = __hip_atomic_load(ss_out + row, __ATOMIC_RELAXED, __HIP_MEMORY_SCOPE_AGENT);
                const float rs = __builtin_amdgcn_rsqf((float)sv * (1.0f / 1048576.0f) * (1.0f / DM_) + RMS_EPS_); float* op = out + (size_t)row * DM_ + col0;
#pragma unroll
                for (int bj = 0; bj < 2; ++bj)
#pragma unroll
                    for (int hh = 0; hh < 2; ++hh) *(f32x4*)(op + bj * 32 + 4 * hh) = acc[ai][bj][m][hh] * gv[bj][hh] * rs; }
    }
};
template <int CTRL> __device__ __forceinline__ float dpp1(float x) { return __builtin_bit_cast(float, __builtin_amdgcn_update_dpp(0, __builtin_bit_cast(int, x), CTRL, 0xF, 0xF, true)); }
template <int CTRL> __device__ __forceinline__ f32x4 dpp4(const f32x4 x) { return (f32x4){dpp1<CTRL>(x.x), dpp1<CTRL>(x.y), dpp1<CTRL>(x.z), dpp1<CTRL>(x.w)}; }
struct EpiConvGlu {
    static constexpr bool PERM = true, AFTER_DRAIN = false;
    bf16_t* HID; const ssq_t* ss; const float* cw; const float* cb; float* SB; PG8_LAS float* xch; int ff;
    __device__ __forceinline__ void operator()(const f32x4 (&acc)[2][2][4][2], const Unit& u, int wr, int wc, int fr, int fq) const {
        const int row0 = u.pm * BM + wr * 64 + fr, cl = wc * 32 + 8 * fq, jcol = u.pn * HALF + cl;
        float rs[2][4];
#pragma unroll
        for (int ai = 0; ai < 2; ++ai)
#pragma unroll
            for (int m = 0; m < 4; ++m) rs[ai][m] = (float)ss[row0 + ai * HALF + m * 16] * (1.0f / 1048576.0f);
        f32x4 w0[2], w1[2], w2[2], bb[2];
#pragma unroll
        for (int n = 0; n < 2; ++n) { w0[n] = *(const f32x4*)(cw + jcol + 4 * n); w1[n] = *(const f32x4*)(cw + ff + jcol + 4 * n); w2[n] = *(const f32x4*)(cw + 2 * ff + jcol + 4 * n); bb[n] = *(const f32x4*)(cb + jcol + 4 * n); }
#pragma unroll
        for (int ai = 0; ai < 2; ++ai)
#pragma unroll
            for (int m = 0; m < 4; ++m) rs[ai][m] = __builtin_amdgcn_rsqf(rs[ai][m] * (1.0f / DM_) + RMS_EPS_);
        if (fr >= 14) {
#pragma unroll
            for (int ai = 0; ai < 2; ++ai)
#pragma unroll
                for (int n = 0; n < 2; ++n) *(PG8_LAS f32x4*)(xch + ((2 * ai + wr) * 2 + (fr - 14)) * HALF + cl + 4 * n) = acc[ai][0][3][n] * rs[ai][3];
        }
        asm volatile("s_waitcnt lgkmcnt(0)" ::: "memory"); __builtin_amdgcn_s_barrier(); asm volatile("" ::: "memory");
        float* sbp = SB + (size_t)u.pm * 6 * ff + jcol;
#pragma unroll
        for (int ai = 0; ai < 2; ++ai) {
            const int q = 2 * ai + wr;
            f32x4 X[2];
#pragma unroll
            for (int n = 0; n < 2; ++n) { X[n] = (f32x4){0.f, 0.f, 0.f, 0.f}; if (q > 0 && fr >= 14) X[n] = *(const PG8_LAS f32x4*)(xch + ((q - 1) * 2 + (fr - 14)) * HALF + cl + 4 * n); }
            f32x4 prevg[2] = {X[0], X[1]};
#pragma unroll
            for (int m = 0; m < 4; ++m) { const int row = row0 + ai * HALF + m * 16;
                pg8::u32x4 hw;
#pragma unroll
                for (int n = 0; n < 2; ++n) {
                    const f32x4 cur = acc[ai][0][m][n] * rs[ai][m], up = acc[ai][1][m][n] * rs[ai][m];
                    const f32x4 P = prevg[n]; prevg[n] = cur;
                    f32x4 z1, z2;
#pragma unroll
                    for (int e = 0; e < 4; ++e) { z1[e] = fr == 15 ? P[e] : cur[e]; z2[e] = fr >= 14 ? P[e] : cur[e]; }
                    const f32x4 p1 = dpp4<0x121>(z1), p2 = dpp4<0x122>(z2);
                    const f32x4 c = bb[n] + w0[n] * p2 + w1[n] * p1 + w2[n] * cur;
                    f32x4 hv;
#pragma unroll
                    for (int e = 0; e < 4; ++e) hv[e] = c[e] * __builtin_amdgcn_rcpf(1.f + __expf(-c[e])) * up[e];
                    if (n == 0) { hw.x = cvt_pk_bf16(hv[0], hv[1]); hw.y = cvt_pk_bf16(hv[2], hv[3]); } else { hw.z = cvt_pk_bf16(hv[0], hv[1]); hw.w = cvt_pk_bf16(hv[2], hv[3]); }
                    if (q == 0 && m == 0 && fr < 2) { *(f32x4*)(sbp + (size_t)fr * ff + 4 * n) = cur; *(f32x4*)(sbp + (size_t)(2 + fr) * ff + 4 * n) = up; }
                    if (q == 3 && m == 3 && fr >= 14) *(f32x4*)(sbp + (size_t)(4 + fr - 14) * ff + 4 * n) = cur;
                }
                *(pg8::u32x4*)(HID + (size_t)row * ff + jcol) = hw; }
        }
    }
};
}

#define LAS __attribute__((address_space(3)))
__device__ __forceinline__ void transpose_item(const float* __restrict__ W, int K, int N, bf16_t* __restrict__ Wt, const float* __restrict__ g, int mode, float* scr, int item, int lane, bool gcompl = false) {
    const int nblk = N / 32, kb = item / nblk, nb = item % nblk, k0 = 64 * kb, n0 = 32 * nb;
    int np0 = n0; if (mode != 0) np0 = 256 * (n0 / 128) + 64 * ((n0 % 128) / 32) + (mode == 2 ? 32 : 0);
    f32x4 wv[8];
#pragma unroll
    for (int i = 0; i < 8; ++i) wv[i] = *(const f32x4*)(W + (size_t)(k0 + (lane >> 3) + 8 * i) * N + n0 + (lane & 7) * 4);
#pragma unroll
    for (int i = 0; i < 8; ++i) { const int kk = (lane >> 3) + 8 * i; const float gs = g ? (gcompl ? 1.f - g[k0 + kk] : g[k0 + kk]) : 1.f; float* d = scr + kk * 33 + (lane & 7) * 4; d[0] = wv[i].x * gs; d[1] = wv[i].y * gs; d[2] = wv[i].z * gs; d[3] = wv[i].w * gs; }
    __builtin_amdgcn_fence(__ATOMIC_RELEASE, "wavefront"); __builtin_amdgcn_wave_barrier(); __builtin_amdgcn_fence(__ATOMIC_ACQUIRE, "wavefront");
    const int c = lane & 7;
#pragma unroll
    for (int j = 0; j < 4; ++j) { const int n = (lane >> 3) + 8 * j; const float* sp = scr + (8 * c) * 33 + n;
        uint4 o; o.x = f2bf(sp[0]) | (f2bf(sp[33]) << 16); o.y = f2bf(sp[2 * 33]) | (f2bf(sp[3 * 33]) << 16); o.z = f2bf(sp[4 * 33]) | (f2bf(sp[5 * 33]) << 16); o.w = f2bf(sp[6 * 33]) | (f2bf(sp[7 * 33]) << 16);
        *(uint4*)(Wt + (size_t)(np0 + n) * K + k0 + 8 * c) = o; }
    __builtin_amdgcn_fence(__ATOMIC_RELEASE, "wavefront"); __builtin_amdgcn_wave_barrier(); __builtin_amdgcn_fence(__ATOMIC_ACQUIRE, "wavefront");
}
constexpr size_t WS_LORA = 50 * MiB;
constexpr size_t LORA_LAYER = 256 * 1024, WS_V1T = WS_LORA + 2 * LORA_LAYER, WS_V1B = WS_V1T + 32 * 1024, WS_V2T = WS_V1B + 32 * 1024;
constexpr int PR_ACT_LD = 264, PR_VLO_LD = 40, PR_SG_LD = 520, PR_ACT_OFF = 0, PR_VLO_OFF = 64 * PR_ACT_LD * 2, PR_SG_OFF = PR_VLO_OFF + 64 * PR_VLO_LD * 2;
constexpr int PR_STG_OFF = PR_SG_OFF + 64 * PR_SG_LD * 2, PR_STG_WAVE = 16 * 144;
struct Prep2Args {
    const bf16_t* proj; const float* mu; const float* w0; const float* a0; const float* v0;
    const bf16_t *W2T, *A2T, *G2T, *V1T, *V1B, *V2T; bf16_t* vfirst; bf16_t *V, *A, *G; unsigned short* CS; int layer; int pad;
};
__device__ __forceinline__ f32x4 bfx4_lo(const bf16x8 v) { return (f32x4){bf2f((bf16_t)v[0]), bf2f((bf16_t)v[1]), bf2f((bf16_t)v[2]), bf2f((bf16_t)v[3])}; }
__device__ __forceinline__ f32x4 bfx4_hi(const bf16x8 v) { return (f32x4){bf2f((bf16_t)v[4]), bf2f((bf16_t)v[5]), bf2f((bf16_t)v[6]), bf2f((bf16_t)v[7])}; }
__device__ __forceinline__ bf16x8 pack8(const f32x4 a, const f32x4 b) { pg8::u32x4 w; w.x = pg8::cvt_pk_bf16(a[0], a[1]); w.y = pg8::cvt_pk_bf16(a[2], a[3]); w.z = pg8::cvt_pk_bf16(b[0], b[1]); w.w = pg8::cvt_pk_bf16(b[2], b[3]); return __builtin_bit_cast(bf16x8, w); }
template <int CTRL> __device__ __forceinline__ float dpp_mov(float x) { return __builtin_bit_cast(float, __builtin_amdgcn_update_dpp(0, __builtin_bit_cast(int, x), CTRL, 0xF, 0xF, true)); }
__device__ __forceinline__ float reduce16(float x) { x += dpp_mov<0xB1>(x); x += dpp_mov<0x4E>(x); x += dpp_mov<0x141>(x); x += dpp_mov<0x140>(x); return x; }
__device__ __forceinline__ float red8(float x) { x += dpp_mov<0xB1>(x); x += dpp_mov<0x4E>(x); x += dpp_mov<0x141>(x); return x; }
__device__ __forceinline__ float scan16(float x) { x += dpp_mov<0x111>(x); x += dpp_mov<0x112>(x); x += dpp_mov<0x114>(x); x += dpp_mov<0x118>(x); return x; }
constexpr float CS_SCALE = 1638.0f;
__device__ __forceinline__ void shift8(const bf16_t* __restrict__ proj, const float* __restrict__ mu, size_t m, int t, int col, int mi, f32x4& lo, f32x4& hi) {
    const bf16x8 cur = *(const bf16x8*)(proj + m * IN_W + col);
    bf16x8 prv; if (t > 0) prv = *(const bf16x8*)(proj + (m - 1) * IN_W + col); else prv = (bf16x8){0, 0, 0, 0, 0, 0, 0, 0};
    const f32x4 m0 = *(const f32x4*)(mu + mi), m1 = *(const f32x4*)(mu + mi + 4);
    const f32x4 c0 = bfx4_lo(cur), c1 = bfx4_hi(cur), p0 = bfx4_lo(prv), p1 = bfx4_hi(prv);
    lo = c0 + (p0 - c0) * m0; hi = c1 + (p1 - c1) * m1;
}
__device__ __forceinline__ void prep_tile(const Prep2Args& p, unsigned char* lds, int tile, int tid) {
    const int m0 = tile * 64, wave = __builtin_amdgcn_readfirstlane(tid >> 6), lane = tid & 63, fr = lane & 15, fq = lane >> 4;
    bf16_t* ACT = (bf16_t*)(lds + PR_ACT_OFF); bf16_t* VLO = (bf16_t*)(lds + PR_VLO_OFF); bf16_t* SG = (bf16_t*)(lds + PR_SG_OFF);
    { bf16x8 cu[4], pv[4]; f32x4 mu0[4], mu1[4];
#pragma unroll
      for (int it = 0; it < 4; ++it) { const int i = tid + 512 * it, tk = i >> 5, cc = i & 31; const size_t m = (size_t)m0 + tk; const int t = (int)(m % SEQ);
          cu[it] = *(const bf16x8*)(p.proj + m * IN_W + 2304 + 8 * cc); if (t > 0) pv[it] = *(const bf16x8*)(p.proj + (m - 1) * IN_W + 2304 + 8 * cc); else pv[it] = (bf16x8){0, 0, 0, 0, 0, 0, 0, 0};
          mu0[it] = *(const f32x4*)(p.mu + 1536 + 8 * cc); mu1[it] = *(const f32x4*)(p.mu + 1536 + 8 * cc + 4); }
#pragma unroll
      for (int it = 0; it < 4; ++it) { const int i = tid + 512 * it, tk = i >> 5, cc = i & 31;
          const f32x4 c0 = bfx4_lo(cu[it]), c1 = bfx4_hi(cu[it]); f32x4 lo = c0 + (bfx4_lo(pv[it]) - c0) * mu0[it], hi = c1 + (bfx4_hi(pv[it]) - c1) * mu1[it];
          if (cc < 8) {
#pragma unroll
              for (int e = 0; e < 4; ++e) { lo[e] = 2.f * sigmoidf_(2.f * lo[e]) - 1.f; hi[e] = 2.f * sigmoidf_(2.f * hi[e]) - 1.f; } }
          else if (cc >= 16) {
#pragma unroll
              for (int e = 0; e < 4; ++e) { lo[e] = sigmoidf_(lo[e]); hi[e] = sigmoidf_(hi[e]); } }
          *(bf16x8*)(ACT + tk * PR_ACT_LD + 8 * cc) = pack8(lo, hi); } }
    if (p.layer > 0) {
        const int tb = wave >> 1, jb = wave & 1; const size_t m = (size_t)m0 + 16 * tb + fr; const int t = (int)(m % SEQ);
        f32x4 acc = (f32x4){0.f, 0.f, 0.f, 0.f};
#pragma unroll
        for (int bt4 = 0; bt4 < 4; ++bt4) { bf16x8 cu[4], pv[4], wa[4], wb[4];
#pragma unroll
            for (int k4 = 0; k4 < 4; ++k4) { const int ko = 32 * (4 * bt4 + k4) + 8 * fq;
                cu[k4] = *(const bf16x8*)(p.proj + m * IN_W + 1792 + ko); if (t > 0) pv[k4] = *(const bf16x8*)(p.proj + (m - 1) * IN_W + 1792 + ko); else pv[k4] = (bf16x8){0, 0, 0, 0, 0, 0, 0, 0};
                wa[k4] = *(const bf16x8*)(p.V1T + (size_t)(16 * jb + fr) * C + ko); wb[k4] = *(const bf16x8*)(p.V1B + (size_t)(16 * jb + fr) * C + ko); }
#pragma unroll
            for (int k4 = 0; k4 < 4; ++k4) { acc = __builtin_amdgcn_mfma_f32_16x16x32_bf16(wa[k4], cu[k4], acc, 0, 0, 0); acc = __builtin_amdgcn_mfma_f32_16x16x32_bf16(wb[k4], pv[k4], acc, 0, 0, 0); } }
        uint2 w; w.x = pg8::cvt_pk_bf16(acc[0], acc[1]); w.y = pg8::cvt_pk_bf16(acc[2], acc[3]);
        *(uint2*)(VLO + (16 * tb + fr) * PR_VLO_LD + 16 * jb + 4 * fq) = w;
    }
    __syncthreads();
    const int ch0 = 64 * wave;
    if (p.layer > 0) {
        bf16x8 af[4], wf[4]; f32x4 bias[4];
#pragma unroll
        for (int cb = 0; cb < 4; ++cb) { wf[cb] = *(const bf16x8*)(p.V2T + (size_t)(ch0 + 16 * cb + fr) * 32 + 8 * fq); bias[cb] = *(const f32x4*)(p.v0 + ch0 + 16 * cb + 4 * fq); }
#pragma unroll
        for (int tb = 0; tb < 4; ++tb) af[tb] = *(const bf16x8*)(VLO + (16 * tb + fr) * PR_VLO_LD + 8 * fq);
#pragma unroll
        for (int cb = 0; cb < 4; ++cb) { const int ch = ch0 + 16 * cb + 4 * fq;
#pragma unroll
            for (int tb = 0; tb < 4; ++tb) { f32x4 x = __builtin_amdgcn_mfma_f32_16x16x32_bf16(wf[cb], af[tb], (f32x4){0.f, 0.f, 0.f, 0.f}, 0, 0, 0) + bias[cb];
                uint2 w; w.x = pg8::cvt_pk_bf16(sigmoidf_(x[0]), sigmoidf_(x[1])); w.y = pg8::cvt_pk_bf16(sigmoidf_(x[2]), sigmoidf_(x[3]));
                *(uint2*)(SG + (16 * tb + fr) * PR_SG_LD + ch) = w; } }
    }
    {
        f32x4 bw[4], ba[4];
#pragma unroll
        for (int cb = 0; cb < 4; ++cb) { bw[cb] = *(const f32x4*)(p.w0 + ch0 + 16 * cb + 4 * fq); ba[cb] = *(const f32x4*)(p.a0 + ch0 + 16 * cb + 4 * fq); }
        bf16x8 wA[2][4], wB[2][4], wC[4][4];
#define PR_LOADW(wf, WT, KL) _Pragma("unroll") for (int ks = 0; ks < (KL) / 32; ++ks) { _Pragma("unroll") for (int cb = 0; cb < 4; ++cb) wf[ks][cb] = *(const bf16x8*)((WT) + (size_t)(ch0 + 16 * cb + fr) * (KL) + 32 * ks + 8 * fq); }
#define PR_MMA(wf, K0, KL) { _Pragma("unroll") for (int tb = 0; tb < 4; ++tb) { _Pragma("unroll") for (int cb = 0; cb < 4; ++cb) acc[tb][cb] = (f32x4){0.f, 0.f, 0.f, 0.f}; } \
            _Pragma("unroll") for (int ks = 0; ks < (KL) / 32; ++ks) { bf16x8 af[4]; \
                _Pragma("unroll") for (int tb = 0; tb < 4; ++tb) af[tb] = *(const bf16x8*)(ACT + (16 * tb + fr) * PR_ACT_LD + (K0) + 32 * ks + 8 * fq); \
                _Pragma("unroll") for (int tb = 0; tb < 4; ++tb) { _Pragma("unroll") for (int cb = 0; cb < 4; ++cb) acc[tb][cb] = __builtin_amdgcn_mfma_f32_16x16x32_bf16(wf[ks][cb], af[tb], acc[tb][cb], 0, 0, 0); } } }
        f32x4 acc[4][4];
        unsigned char* stg = lds + PR_STG_OFF + wave * PR_STG_WAVE; const int st_w = fr * 144 + 8 * fq, l8 = lane & 7, lr = lane >> 3;
#define PR_WFENCE() { __builtin_amdgcn_fence(__ATOMIC_RELEASE, "wavefront"); __builtin_amdgcn_wave_barrier(); __builtin_amdgcn_fence(__ATOMIC_ACQUIRE, "wavefront"); }
#define PR_FLUSH(OUTP, TB) { PR_WFENCE() _Pragma("unroll") for (int i_ = 0; i_ < 2; ++i_) { const int row_ = lr + 8 * i_; const pg8::u32x4 v_ = *(const pg8::u32x4*)(stg + row_ * 144 + l8 * 16); \
            *(pg8::u32x4*)((OUTP) + ((size_t)m0 + 16 * (TB) + row_) * C + ch0 + l8 * 8) = v_; } PR_WFENCE() }
        PR_LOADW(wA, p.W2T, 64)
        PR_MMA(wA, 0, 64)
        PR_LOADW(wB, p.A2T, 64)
        { f32x4 run[4];
#pragma unroll
          for (int cb = 0; cb < 4; ++cb) run[cb] = (f32x4){0.f, 0.f, 0.f, 0.f};
#pragma unroll
          for (int tb = 0; tb < 4; ++tb) {
#pragma unroll
            for (int cb = 0; cb < 4; ++cb) { f32x4 x = acc[tb][cb] + bw[cb];
#pragma unroll
                for (int e = 0; e < 4; ++e) x[e] = -0.60653065971f * sigmoidf_(x[e]);
                f32x4 s, tot; s.x = scan16(x.x); s.y = scan16(x.y); s.z = scan16(x.z); s.w = scan16(x.w);
                tot.x = reduce16(x.x); tot.y = reduce16(x.y); tot.z = reduce16(x.z); tot.w = reduce16(x.w);
                const f32x4 cq = (s + run[cb]) * -CS_SCALE + 0.5f;
                uint2 w; w.x = (unsigned)fminf(cq.x, 65535.f) | ((unsigned)fminf(cq.y, 65535.f) << 16); w.y = (unsigned)fminf(cq.z, 65535.f) | ((unsigned)fminf(cq.w, 65535.f) << 16);
                *(uint2*)(stg + st_w + 32 * cb) = w; run[cb] = run[cb] + tot; }
            PR_FLUSH(p.CS, tb) } }
        PR_MMA(wB, 64, 64)
        PR_LOADW(wC, p.G2T, 128)
#pragma unroll
        for (int tb = 0; tb < 4; ++tb) {
#pragma unroll
            for (int cb = 0; cb < 4; ++cb) { f32x4 x = acc[tb][cb] + ba[cb];
#pragma unroll
                for (int e = 0; e < 4; ++e) x[e] = sigmoidf_(x[e]);
                uint2 w; w.x = pg8::cvt_pk_bf16(x[0], x[1]); w.y = pg8::cvt_pk_bf16(x[2], x[3]);
                *(uint2*)(stg + st_w + 32 * cb) = w; }
            PR_FLUSH(p.A, tb) }
        PR_MMA(wC, 128, 128)
#pragma unroll
        for (int tb = 0; tb < 4; ++tb) {
#pragma unroll
            for (int cb = 0; cb < 4; ++cb) { const f32x4 x = acc[tb][cb];
                uint2 w; w.x = pg8::cvt_pk_bf16(x[0], x[1]); w.y = pg8::cvt_pk_bf16(x[2], x[3]);
                *(uint2*)(stg + st_w + 32 * cb) = w; }
            PR_FLUSH(p.G, tb) }
#undef PR_FLUSH
#undef PR_WFENCE
#undef PR_LOADW
#undef PR_MMA
    }
    __syncthreads();
    {
        const int cc = tid & 63;
        bf16x8 cu[8], pv[8], vf[8]; const f32x4 mu0 = *(const f32x4*)(p.mu + 1024 + 8 * cc), mu1 = *(const f32x4*)(p.mu + 1024 + 8 * cc + 4);
#pragma unroll
        for (int it = 0; it < 8; ++it) { const int tk = (tid >> 6) + 8 * it; const size_t m = (size_t)m0 + tk; const int t = (int)(m % SEQ); const int col = 768 + 1024 + 8 * cc;
            cu[it] = *(const bf16x8*)(p.proj + m * IN_W + col); if (t > 0) pv[it] = *(const bf16x8*)(p.proj + (m - 1) * IN_W + col); else pv[it] = (bf16x8){0, 0, 0, 0, 0, 0, 0, 0};
            if (p.layer > 0) vf[it] = *(const bf16x8*)(p.vfirst + m * C + 8 * cc); }
#pragma unroll
        for (int it = 0; it < 8; ++it) { const int tk = (tid >> 6) + 8 * it; const size_t m = (size_t)m0 + tk;
            const f32x4 c0 = bfx4_lo(cu[it]), c1 = bfx4_hi(cu[it]);
            f32x4 lo = c0 + (bfx4_lo(pv[it]) - c0) * mu0, hi = c1 + (bfx4_hi(pv[it]) - c1) * mu1;
            const size_t o = m * C + 8 * cc;
            if (p.layer == 0) *(bf16x8*)(p.vfirst + o) = pack8(lo, hi);
            else { const bf16x8 sg = *(const bf16x8*)(SG + tk * PR_SG_LD + 8 * cc);
                lo = lo + (bfx4_lo(vf[it]) - lo) * bfx4_lo(sg); hi = hi + (bfx4_hi(vf[it]) - hi) * bfx4_hi(sg); }
            *(bf16x8*)(p.V + o) = pack8(lo, hi); }
    }
    __syncthreads();
}

constexpr int NTHREADS_ = 512;
constexpr int SC_TB = 32, SC_SLOT = 384, SC_NCH = SEQ / SC_TB;
constexpr size_t WS_RKC = 51 * MiB;
struct ScanArgs { const bf16_t *proj, *V, *A, *G; const unsigned short* CS; const float *k_k, *k_a, *r_k, *lnx_g, *lnx_b; bf16_t* mix; float* rkc; bf16_t* yt; };
constexpr int CK_LD = 72, CK_MAT = 64 * CK_LD * 2;
constexpr size_t WS_YT = WS_SI_LD;
constexpr size_t WS_TSCR = WS_SI_A, TSCR_WG = 2 * 64 * C * 2;
__device__ __forceinline__ void ck_mm(f32x4 (&acc)[2], const bf16_t* Qm, const bf16_t* P, int jb, int ib0, int fr, int fq) {
#pragma unroll
    for (int ks = 0; ks < 2; ++ks) { const bf16x8 bq = *(const bf16x8*)(Qm + (16 * jb + fr) * CK_LD + 32 * ks + 8 * fq);
#pragma unroll
        for (int ii = 0; ii < 2; ++ii) { const bf16x8 ap = *(const bf16x8*)(P + (16 * (ib0 + ii) + fr) * CK_LD + 32 * ks + 8 * fq); acc[ii] = __builtin_amdgcn_mfma_f32_16x16x32_bf16(ap, bq, acc[ii], 0, 0, 0); } }
}
typedef short ck_s16x4 __attribute__((ext_vector_type(4)));
__device__ __forceinline__ bf16x8 ck_tr_frag(const bf16_t* X, int colbase, int ks, int lane) {
    const bf16_t* a0 = X + (32 * ks + 8 * (lane >> 4) + ((lane & 15) >> 2)) * CK_LD + colbase + 4 * (lane & 3);
    const ck_s16x4 lo = __builtin_amdgcn_ds_read_tr16_b64_v4i16((__attribute__((address_space(3))) ck_s16x4*)a0), hi = __builtin_amdgcn_ds_read_tr16_b64_v4i16((__attribute__((address_space(3))) ck_s16x4*)(a0 + 4 * CK_LD));
    return (bf16x8){lo[0], lo[1], lo[2], lo[3], hi[0], hi[1], hi[2], hi[3]};
}
template <bool TQ, bool TP> __device__ __forceinline__ void ck_mm_t(f32x4 (&acc)[2], const bf16_t* Qm, const bf16_t* P, int jb, int ib0, int fr, int fq) {
    const int lane = fq * 16 + fr;
#pragma unroll
    for (int ks = 0; ks < 2; ++ks) { const bf16x8 bq = TQ ? ck_tr_frag(Qm, 16 * jb, ks, lane) : *(const bf16x8*)(Qm + (16 * jb + fr) * CK_LD + 32 * ks + 8 * fq);
#pragma unroll
        for (int ii = 0; ii < 2; ++ii) { const bf16x8 ap = TP ? ck_tr_frag(P, 16 * (ib0 + ii), ks, lane) : *(const bf16x8*)(P + (16 * (ib0 + ii) + fr) * CK_LD + 32 * ks + 8 * fq); acc[ii] = __builtin_amdgcn_mfma_f32_16x16x32_bf16(ap, bq, acc[ii], 0, 0, 0); } }
}
__device__ __forceinline__ uint2 ck_pack4(const f32x4 v) { uint2 w; w.x = pg8::cvt_pk_bf16(v[0], v[1]); w.y = pg8::cvt_pk_bf16(v[2], v[3]); return w; }
__device__ __forceinline__ f32x4 ck_unpack4(const uint2 u) { return (f32x4){__builtin_bit_cast(float, u.x << 16), __builtin_bit_cast(float, u.x & 0xffff0000u), __builtin_bit_cast(float, u.y << 16), __builtin_bit_cast(float, u.y & 0xffff0000u)}; }
struct CkRaw { bf16x8 rc, rp, kc, kp, v, a, cs, cp, cl; };
__device__ __forceinline__ float wave_sum_dpp(float x) {
    x = reduce16(x); const int xi = __builtin_bit_cast(int, x);
    const float r0 = __builtin_bit_cast(float, __builtin_amdgcn_readlane(xi, 0)), r1 = __builtin_bit_cast(float, __builtin_amdgcn_readlane(xi, 16)), r2 = __builtin_bit_cast(float, __builtin_amdgcn_readlane(xi, 32)), r3 = __builtin_bit_cast(float, __builtin_amdgcn_readlane(xi, 48));
    return (r0 + r1) + (r2 + r3); }
__device__ __forceinline__ void ck_load(const ScanArgs& p, CkRaw& w, int unit, int tid) {
    const int chain = unit >> 6, chunk = unit & 63, b = chain >> 3, h = chain & 7, tk = tid >> 3, hc = h * 64 + (tid & 7) * 8;
    const size_t row = (size_t)b * SEQ + chunk * 64 + tk, o = row * C + hc;
    const bf16_t* pr = p.proj + row * IN_W + 768 + hc; const bf16x8 z8 = (bf16x8){0, 0, 0, 0, 0, 0, 0, 0};
    w.rc = *(const bf16x8*)pr; w.kc = *(const bf16x8*)(pr + 512);
    if (chunk * 64 + tk > 0) { w.rp = *(const bf16x8*)(pr - IN_W); w.kp = *(const bf16x8*)(pr - IN_W + 512); } else { w.rp = z8; w.kp = z8; }
    w.v = *(const bf16x8*)(p.V + o); w.a = *(const bf16x8*)(p.A + o);
    w.cs = *(const bf16x8*)(p.CS + o); if (tk > 0) w.cp = *(const bf16x8*)(p.CS + o - C); else w.cp = z8;
    w.cl = *(const bf16x8*)(p.CS + (row - tk + 63) * C + hc);
}
__device__ __forceinline__ f32x4 csq_lo(const bf16x8 v) { return (f32x4){(float)(unsigned short)v[0], (float)(unsigned short)v[1], (float)(unsigned short)v[2], (float)(unsigned short)v[3]} * (-1.f / CS_SCALE); }
__device__ __forceinline__ f32x4 csq_hi(const bf16x8 v) { return (f32x4){(float)(unsigned short)v[4], (float)(unsigned short)v[5], (float)(unsigned short)v[6], (float)(unsigned short)v[7]} * (-1.f / CS_SCALE); }
__device__ __forceinline__ f32x4 exp4(const f32x4 v) { return (f32x4){__expf(v[0]), __expf(v[1]), __expf(v[2]), __expf(v[3])}; }
constexpr int CK_CONST_OFF = 136192;
__device__ __forceinline__ void ck_precompute(const ScanArgs& p, const CkRaw& raw, CkRaw& nxt, int next_unit, unsigned char* lds, bf16_t* GQ, bf16_t* CQ, int unit, int tid) {
    const int chain = unit >> 6, chunk = unit & 63, b = chain >> 3, h = chain & 7, wave = __builtin_amdgcn_readfirstlane(tid >> 6), lane = tid & 63, fr = lane & 15, fq = lane >> 4, jb = wave >> 1, ib0 = 2 * (wave & 1);
    bf16_t* At = (bf16_t*)(lds + 0 * CK_MAT); bf16_t* bt = (bf16_t*)(lds + 1 * CK_MAT); bf16_t* kt = (bf16_t*)(lds + 2 * CK_MAT); bf16_t* rt = (bf16_t*)(lds + 3 * CK_MAT);
    bf16_t* AtT = (bf16_t*)(lds + 4 * CK_MAT); bf16_t* BhT = (bf16_t*)(lds + 5 * CK_MAT); bf16_t* KhT = (bf16_t*)(lds + 6 * CK_MAT); bf16_t* VT = (bf16_t*)(lds + 7 * CK_MAT);
    bf16_t* NT = (bf16_t*)(lds + 8 * CK_MAT); bf16_t* Mm = (bf16_t*)(lds + 9 * CK_MAT); bf16_t* P1 = (bf16_t*)(lds + 10 * CK_MAT); bf16_t* P2 = (bf16_t*)(lds + 11 * CK_MAT);
    bf16_t* Ta = (bf16_t*)(lds + 12 * CK_MAT); bf16_t* Tb = (bf16_t*)(lds + 13 * CK_MAT); float* WT = (float*)(lds + 14 * CK_MAT); float* GL = WT + 512;
    bf16_t* W1T = bt; bf16_t* MVT = kt; bf16_t* W2T = At;
    {
        const int tk = tid >> 3, c8 = (tid & 7) * 8, ro = tk * CK_LD + c8;
        bf16_t* BhR = BhT; bf16_t* KhR = KhT; bf16_t* VR = VT;
        const float* KC = (const float*)(lds + CK_CONST_OFF) + h * 64 + c8;
        const f32x4 kc0 = *(const f32x4*)KC, kc1 = *(const f32x4*)(KC + 4), ac0 = *(const f32x4*)(KC + 512), ac1 = *(const f32x4*)(KC + 516), rc0 = *(const f32x4*)(KC + 1024), rc1 = *(const f32x4*)(KC + 1028), mu0 = *(const f32x4*)(KC + 1536), mu1 = *(const f32x4*)(KC + 1540);
        const f32x4 mk0 = *(const f32x4*)(KC + 2048), mk1 = *(const f32x4*)(KC + 2052);
        const f32x4 x0 = bfx4_lo(raw.rc), x1 = bfx4_hi(raw.rc); const f32x4 r0 = x0 + (bfx4_lo(raw.rp) - x0) * mu0, r1 = x1 + (bfx4_hi(raw.rp) - x1) * mu1;
        const f32x4 y0 = bfx4_lo(raw.kc), y1 = bfx4_hi(raw.kc); const f32x4 k0 = y0 + (bfx4_lo(raw.kp) - y0) * mk0, k1 = y1 + (bfx4_hi(raw.kp) - y1) * mk1;
        const f32x4 a0 = bfx4_lo(raw.a), a1 = bfx4_hi(raw.a);
        const f32x4 c0 = csq_lo(raw.cs), c1 = csq_hi(raw.cs), p0 = csq_lo(raw.cp), p1 = csq_hi(raw.cp), l0 = csq_lo(raw.cl), l1 = csq_hi(raw.cl);
        f32x4 q0 = k0 * kc0, q1 = k1 * kc1;
        const f32x4 qq = q0 * q0 + q1 * q1; const float nrm = red8((qq.x + qq.y) + (qq.z + qq.w));
        const float inv = fminf(__builtin_amdgcn_rsqf(nrm), 1e12f); q0 = q0 * inv; q1 = q1 * inv;
        const f32x4 kp0 = k0 * (1.f + (a0 - 1.f) * ac0), kp1 = k1 * (1.f + (a1 - 1.f) * ac1);
        const f32x4 rr = r0 * kp0 * rc0 + r1 * kp1 * rc1; const float rkc = red8((rr.x + rr.y) + (rr.z + rr.w));
        if ((tid & 7) == 0) p.rkc[((size_t)b * SEQ + chunk * 64 + tk) * 8 + h] = rkc;
        const f32x4 em0 = exp4(p0), em1 = exp4(p1), en0 = exp4(-c0), en1 = exp4(-c1), ep0 = exp4(c0), ep1 = exp4(c1), eL0 = exp4(l0 - c0), eL1 = exp4(l1 - c1);
        const f32x4 b0 = q0 * a0, b1 = q1 * a1;
        *(bf16x8*)(At + ro) = pack8(-q0 * em0, -q1 * em1); *(bf16x8*)(bt + ro) = pack8(b0 * en0, b1 * en1); *(bf16x8*)(kt + ro) = pack8(kp0 * en0, kp1 * en1); *(bf16x8*)(rt + ro) = pack8(r0 * ep0, r1 * ep1);
        *(bf16x8*)(BhR + ro) = pack8(b0 * eL0, b1 * eL1); *(bf16x8*)(KhR + ro) = pack8(kp0 * eL0, kp1 * eL1); *(bf16x8*)(VR + ro) = raw.v;
        if (tk == 0) { *(f32x4*)(GL + c8) = exp4(l0); *(f32x4*)(GL + c8 + 4) = exp4(l1); }
    }
    __syncthreads();
    const int j = 16 * jb + fr; const f32x4 z4 = (f32x4){0.f, 0.f, 0.f, 0.f};
    { f32x4 aN[2] = {z4, z4}, aM[2] = {z4, z4}, aP1[2] = {z4, z4}, aP2[2] = {z4, z4};
      ck_mm(aN, At, bt, jb, ib0, fr, fq); ck_mm(aM, At, kt, jb, ib0, fr, fq); ck_mm(aP1, rt, bt, jb, ib0, fr, fq); ck_mm(aP2, rt, kt, jb, ib0, fr, fq);
#pragma unroll
      for (int ii = 0; ii < 2; ++ii) { const int i0 = 16 * (ib0 + ii) + 4 * fq; f32x4 t0, nt, mm, p1, p2;
#pragma unroll
          for (int e = 0; e < 4; ++e) { const int i = i0 + e; nt[e] = i < j ? aN[ii][e] : 0.f; t0[e] = nt[e] + (i == j ? 1.f : 0.f); mm[e] = i < j ? aM[ii][e] : 0.f; p1[e] = i <= j ? aP1[ii][e] : 0.f; p2[e] = i <= j ? aP2[ii][e] : 0.f; }
          *(uint2*)(Ta + j * CK_LD + i0) = ck_pack4(t0); *(uint2*)(NT + j * CK_LD + i0) = ck_pack4(nt); *(uint2*)(Mm + j * CK_LD + i0) = ck_pack4(mm); *(uint2*)(P1 + j * CK_LD + i0) = ck_pack4(p1); *(uint2*)(P2 + j * CK_LD + i0) = ck_pack4(p2); } }
    __syncthreads();
#pragma unroll
    for (int st = 0; st < 3; ++st) { const bf16_t* src = (st & 1) ? Tb : Ta; bf16_t* dst = (st & 1) ? Ta : Tb; f32x4 a2[2] = {z4, z4}; ck_mm_t<false, true>(a2, src, NT, jb, ib0, fr, fq);
#pragma unroll
        for (int ii = 0; ii < 2; ++ii) { const int i0 = 16 * (ib0 + ii) + 4 * fq; f32x4 t = a2[ii];
#pragma unroll
            for (int e = 0; e < 4; ++e) t[e] += (i0 + e == j) ? 1.f : 0.f;
            *(uint2*)(dst + j * CK_LD + i0) = ck_pack4(t); }
        __syncthreads(); }
    { f32x4 a1[2] = {z4, z4}, a2[2] = {z4, z4}; ck_mm_t<true, false>(a1, At, Tb, jb, ib0, fr, fq); ck_mm_t<true, false>(a2, VT, Mm, jb, ib0, fr, fq);
#pragma unroll
      for (int ii = 0; ii < 2; ++ii) { const int i0 = 16 * (ib0 + ii) + 4 * fq; *(uint2*)(W1T + j * CK_LD + i0) = ck_pack4(a1[ii]); *(uint2*)(MVT + j * CK_LD + i0) = ck_pack4(a2[ii]); } }
    __syncthreads();
    { f32x4 a1[2] = {z4, z4}; ck_mm(a1, MVT, Tb, jb, ib0, fr, fq);
#pragma unroll
      for (int ii = 0; ii < 2; ++ii) { const int i0 = 16 * (ib0 + ii) + 4 * fq; *(uint2*)(W2T + j * CK_LD + i0) = ck_pack4(a1[ii]); } }
    __syncthreads();
    ck_load(p, nxt, next_unit, tid);
    { f32x4 aQ1[2] = {z4, z4}, aG[2] = {z4, z4}, aQ2[2] = {z4, z4}, aC[2] = {z4, z4};
      ck_mm(aQ1, P1, W1T, jb, ib0, fr, fq); ck_mm_t<true, false>(aG, BhT, W1T, jb, ib0, fr, fq); ck_mm(aQ2, P1, W2T, jb, ib0, fr, fq); ck_mm_t<false, true>(aQ2, P2, VT, jb, ib0, fr, fq); ck_mm_t<false, true>(aC, W2T, BhT, jb, ib0, fr, fq); ck_mm_t<true, true>(aC, VT, KhT, jb, ib0, fr, fq);
      bf16_t* gq = GQ + (size_t)unit * 8192; bf16_t* cq = CQ + (size_t)unit * 8192; const float glj = GL[j];
#pragma unroll
      for (int ii = 0; ii < 2; ++ii) { const int i0 = 16 * (ib0 + ii) + 4 * fq; f32x4 g = aG[ii];
#pragma unroll
          for (int e = 0; e < 4; ++e) g[e] += (i0 + e == j) ? glj : 0.f;
          const f32x4 q1 = aQ1[ii] + ck_unpack4(*(const uint2*)(rt + j * CK_LD + i0));
          *(uint2*)(AtT + j * CK_LD + i0) = ck_pack4(g); *(uint2*)(NT + j * CK_LD + i0) = ck_pack4(q1); *(uint2*)(Mm + j * CK_LD + i0) = ck_pack4(aC[ii]); *(uint2*)(Ta + j * CK_LD + i0) = ck_pack4(aQ2[ii]); }
      __syncthreads();
      { const int row = tid >> 3, c8 = (tid & 7) * 8, lo_ = row * CK_LD + c8, go_ = row * 64 + c8;
        const pg8::u32x4 v0 = *(const pg8::u32x4*)(AtT + lo_), v1 = *(const pg8::u32x4*)(NT + lo_), v2 = *(const pg8::u32x4*)(Mm + lo_), v3 = *(const pg8::u32x4*)(Ta + lo_);
        *(pg8::u32x4*)(gq + go_) = v0; *(pg8::u32x4*)(gq + 4096 + go_) = v1; { const int bo_ = (c8 >> 4) * 1024 + row * 16 + (c8 & 15);
          *(pg8::u32x4*)(cq + bo_) = v2; *(pg8::u32x4*)(cq + 4096 + bo_) = v3; } } }
    if (next_unit == unit) __syncthreads();
}
__device__ __forceinline__ void ck_sequential(const ScanArgs& p, unsigned char* lds, const bf16_t* GQ, const bf16_t* CQ, int item, int tid) {
    const int chain = item >> 2, q = item & 3, b = chain >> 3, h = chain & 7, wave = __builtin_amdgcn_readfirstlane(tid >> 6), lane = tid & 63, fr = lane & 15, fq = lane >> 4;
    bf16_t* OPS = (bf16_t*)lds;
    bf16_t* HT = (bf16_t*)(lds + 4 * CK_MAT);
    for (int i = tid; i < 2 * 16 * CK_LD / 2; i += NTHREADS_) ((unsigned*)HT)[i] = 0u;
    const size_t ubase = (size_t)chain * 64; const size_t rowbase = (size_t)b * SEQ;
    const int prow0 = tid >> 3, pcol = (tid & 7) * 8;
    const int aoff = wave < 4 ? (4096 + q * 1024 + (16 * wave + fr) * 16 + 4 * fq) : ((wave - 4) * 1024 + (16 * q + fr) * 16 + 4 * fq);
    typedef unsigned u32x2_ __attribute__((ext_vector_type(2)));
    pg8::u32x4 g0_0, g0_1, g0_2, g0_3, g0_4, g0_5, g0_6, g0_7, g1_0, g1_1, g1_2, g1_3, g1_4, g1_5, g1_6, g1_7; u32x2_ ad_0, ad_1, ad_2, ad_3, ad_4, ad_5, ad_6, ad_7;
#define CK_FETCH(slot, cc) do { const int c_ = (cc) < 64 ? (cc) : 63;     \
        const bf16_t* gq = GQ + (ubase + c_) * 8192; g0_##slot = *(const pg8::u32x4*)(gq + (size_t)prow0 * 64 + pcol); g1_##slot = *(const pg8::u32x4*)(gq + (size_t)(prow0 + 64) * 64 + pcol); \
        ad_##slot = *(const u32x2_*)(CQ + (ubase + c_) * 8192 + aoff); } while (0)
#define CK_STAGE(slot, buf) do { *(pg8::u32x4*)(OPS + (buf) * 2 * 64 * CK_LD + prow0 * CK_LD + pcol) = g0_##slot; *(pg8::u32x4*)(OPS + (buf) * 2 * 64 * CK_LD + 64 * CK_LD + prow0 * CK_LD + pcol) = g1_##slot; } while (0)
    CK_FETCH(0, 0); CK_FETCH(1, 1); CK_FETCH(2, 2); CK_FETCH(3, 3); CK_FETCH(4, 4); CK_FETCH(5, 5); CK_FETCH(6, 6); CK_FETCH(7, 7);
    CK_STAGE(0, 0);
    __syncthreads();
#define CK_STEP(cc, slot, nslot) do { const int bi = (cc) & 1; const bf16_t* Gm = OPS + bi * 2 * 64 * CK_LD; const bf16_t* Q1m = Gm + 64 * CK_LD; const bf16_t* HTc = HT + bi * 16 * CK_LD; bf16_t* HTn = HT + (bi ^ 1) * 16 * CK_LD; \
        f32x4 acc = (f32x4){0.f, 0.f, 0.f, 0.f}; \
        if (wave < 4) { _Pragma("unroll") for (int ks = 0; ks < 2; ++ks) acc = __builtin_amdgcn_mfma_f32_16x16x32_bf16(*(const bf16x8*)(HTc + fr * CK_LD + 32 * ks + 8 * fq), *(const bf16x8*)(Q1m + (16 * wave + fr) * CK_LD + 32 * ks + 8 * fq), acc, 0, 0, 0); \
            acc = acc + ck_unpack4((uint2){ad_##slot.x, ad_##slot.y}); \
            *(uint2*)(p.yt + ((((size_t)chain * 64 + (cc)) * 4 + q) * 64 + 16 * wave + fr) * 16 + 4 * fq) = ck_pack4(acc); } \
        else { _Pragma("unroll") for (int ks = 0; ks < 2; ++ks) acc = __builtin_amdgcn_mfma_f32_16x16x32_bf16(*(const bf16x8*)(Gm + (16 * (wave - 4) + fr) * CK_LD + 32 * ks + 8 * fq), *(const bf16x8*)(HTc + fr * CK_LD + 32 * ks + 8 * fq), acc, 0, 0, 0); \
            acc = acc + ck_unpack4((uint2){ad_##slot.x, ad_##slot.y}); \
            *(uint2*)(HTn + fr * CK_LD + 16 * (wave - 4) + 4 * fq) = ck_pack4(acc); } \
        CK_STAGE(nslot, bi ^ 1); \
        CK_FETCH(slot, (cc) + 8); \
        __syncthreads(); } while (0)
    for (int c = 0; c < 64; c += 8) { CK_STEP(c, 0, 1); CK_STEP(c + 1, 1, 2); CK_STEP(c + 2, 2, 3); CK_STEP(c + 3, 3, 4); CK_STEP(c + 4, 4, 5); CK_STEP(c + 5, 5, 6); CK_STEP(c + 6, 6, 7); CK_STEP(c + 7, 7, 0); }
#undef CK_FETCH
#undef CK_STAGE
#undef CK_STEP
}

struct PostRaw { bf16x8 y, v, g; float rk; f32x4 lg0, lg1, lb0, lb1; };
__device__ __forceinline__ void scan_post_load(const ScanArgs& p, PostRaw& w, int item, int lane) {
    const int tg = item & 7, chunk = (item >> 3) & 63, chain = item >> 9, b = chain >> 3, h = chain & 7, tl = lane >> 3, j = lane & 7, t = 8 * tg + tl;
    const size_t m = (size_t)b * SEQ + chunk * 64 + t;
    w.y = *(const bf16x8*)(p.yt + ((((size_t)chain * 64 + chunk) * 4 + (j >> 1)) * 64 + t) * 16 + (j & 1) * 8);
    w.v = *(const bf16x8*)(p.V + m * C + h * 64 + 8 * j); w.g = *(const bf16x8*)(p.G + m * C + h * 64 + 8 * j); w.rk = p.rkc[m * 8 + h];
    const float* lp = p.lnx_g + h * 64 + 8 * j; const float* bp = p.lnx_b + h * 64 + 8 * j;
    w.lg0 = *(const f32x4*)lp; w.lg1 = *(const f32x4*)(lp + 4); w.lb0 = *(const f32x4*)bp; w.lb1 = *(const f32x4*)(bp + 4);
}
__device__ __forceinline__ void scan_post_item(const ScanArgs& p, const PostRaw& w, int item, int lane) {
    const int tg = item & 7, chunk = (item >> 3) & 63, chain = item >> 9, b = chain >> 3, h = chain & 7, tl = lane >> 3, j = lane & 7;
    const size_t m = (size_t)b * SEQ + chunk * 64 + 8 * tg + tl;
    f32x4 y0 = bfx4_lo(w.y), y1 = bfx4_hi(w.y);
    const float mean = red8((y0.x + y0.y) + (y0.z + y0.w) + (y1.x + y1.y) + (y1.z + y1.w)) * (1.f / 64.f);
    y0 = y0 - mean; y1 = y1 - mean;
    const float var = red8((y0.x * y0.x + y0.y * y0.y) + (y0.z * y0.z + y0.w * y0.w) + (y1.x * y1.x + y1.y * y1.y) + (y1.z * y1.z + y1.w * y1.w)) * (1.f / 64.f);
    const float rs = rsqrtf(var + LNX_EPS);
    const f32x4 o0 = (y0 * rs * w.lg0 + w.lb0 + bfx4_lo(w.v) * w.rk) * bfx4_lo(w.g), o1 = (y1 * rs * w.lg1 + w.lb1 + bfx4_hi(w.v) * w.rk) * bfx4_hi(w.g);
    *(bf16x8*)(p.mix + m * D + ATT_W + h * 64 + 8 * j) = pack8(o0, o1);
}
__device__ __forceinline__ void scan_post_wave(const ScanArgs& p, int gw, int ngw, int lane) {
    constexpr int NITEM = BATCH * NH * 64 * 8;
    int item = gw; if (item >= NITEM) return;
    PostRaw cur; scan_post_load(p, cur, item, lane);
    for (; item < NITEM; item += ngw) { PostRaw nxt = cur; if (item + ngw < NITEM) scan_post_load(p, nxt, item + ngw, lane);
        scan_post_item(p, cur, item, lane); cur = nxt; }
}

typedef float f32x16 __attribute__((ext_vector_type(16)));
typedef short s16x4 __attribute__((ext_vector_type(4)));
constexpr int AT_VLD = 96;
__device__ __forceinline__ int crow(int r, int hi) { return (r & 3) + 8 * (r >> 2) + 4 * hi; }
constexpr int AT_KLD = 72;
__device__ __forceinline__ void attn_phase(const bf16_t* __restrict__ proj, const float* __restrict__ sinks, bf16_t* __restrict__ mix, unsigned char* lds, int G, int tid) {
    bf16_t* ks_ = (bf16_t*)lds; bf16_t* vs_ = (bf16_t*)(lds + 192 * AT_KLD * 2);
    const int g = __builtin_amdgcn_readfirstlane(tid >> 7), half = __builtin_amdgcn_readfirstlane((tid >> 6) & 1);
    constexpr int NU = BATCH * 2 * (SEQ / 64);
    bf16x8 pk0, pk1, pk2, pv0, pv1, pv2, pq0, pq1, pq2, pq3;
#define AT_PIECE(it, kdst, vdst, un) do { const int i_ = tq + 512 * (it), kl_ = i_ >> 3, ch8_ = i_ & 7; int key_ = ((un) & 63) * 64 - 128 + kl_; key_ = key_ < 0 ? 0 : key_;     \
        const bf16_t* rp_ = proj + ((size_t)((un) >> 7) * SEQ + key_) * IN_W + 512 + (((un) >> 6) & 1) * 64 + ch8_ * 8; kdst = *(const bf16x8*)rp_; vdst = *(const bf16x8*)(rp_ + KV_W); } while (0)
#define AT_FETCH(un) do { AT_PIECE(0, pk0, pv0, un); AT_PIECE(1, pk1, pv1, un); AT_PIECE(2, pk2, pv2, un); \
        { const int l_ = tq & 63; const bf16_t* qp_ = proj + ((size_t)((un) >> 7) * SEQ + ((un) & 63) * 64 + 32 * half + (l_ & 31)) * IN_W + ((((un) >> 6) & 1) * 4 + g) * 64 + 8 * (l_ >> 5); \
          pq0 = *(const bf16x8*)qp_; pq1 = *(const bf16x8*)(qp_ + 16); pq2 = *(const bf16x8*)(qp_ + 32); pq3 = *(const bf16x8*)(qp_ + 48); } } while (0)
#define AT_STAGE(it, ksrc, vsrc) do { const int i_ = tq + 512 * (it), kl_ = i_ >> 3, ch8_ = i_ & 7; *(bf16x8*)(ks_ + kl_ * AT_KLD + ch8_ * 8) = ksrc; *(bf16x8*)(vs_ + kl_ * AT_VLD + ch8_ * 8) = vsrc; } while (0)
    int tq = tid; int unit = blockIdx.x; if (unit < NU) AT_FETCH(unit);
    for (; unit < NU; unit += G) {
        const int b = unit >> 7, kvh = (unit >> 6) & 1, qb = unit & 63, Q0 = qb * 64, h = kvh * 4 + g; const size_t rowb = (size_t)b * SEQ;
        asm volatile("" : "+v"(tq));
        const int lane = tq & 63, c = lane & 31, hi = lane >> 5;
        AT_STAGE(0, pk0, pv0); AT_STAGE(1, pk1, pv1); AT_STAGE(2, pk2, pv2);
        const bf16x8 qf[4] = {pq0, pq1, pq2, pq3};
        __syncthreads();
        if (unit + G < NU) AT_FETCH(unit + G);
        const int t0 = Q0 + 32 * half; const size_t mq = rowb + t0 + c;
        f32x16 p[5];
#pragma unroll
        for (int kb = 0; kb < 5; ++kb) { const bf16_t* kp = ks_ + (32 * half + 32 * kb + c) * AT_KLD + 8 * hi;
            f32x16 acc;
#pragma unroll
            for (int r = 0; r < 16; ++r) acc[r] = 0.f;
#pragma unroll
            for (int ks = 0; ks < 4; ++ks) acc = __builtin_amdgcn_mfma_f32_32x32x16_bf16(*(const bf16x8*)(kp + 16 * ks), qf[ks], acc, 0, 0, 0);
            p[kb] = acc; }
        const float slope = exp2f(-(float)(h + 1)) * 1.44269504089f, sink = sinks[h] * 1.44269504089f;
        float mx = sink;
        const float bl = -slope * (float)(c + 128 - 4 * hi);
        const bool seq_start = (t0 < 128);
#pragma unroll
        for (int kb = 0; kb < 5; ++kb)
#pragma unroll
            for (int r = 0; r < 16; ++r) { const int cr0 = (r & 3) + 8 * (r >> 2), cr = cr0 + 4 * hi;
                float sc = p[kb][r] * (0.125f * 1.44269504089f) + (bl + slope * (float)(32 * kb + cr0));
                if (kb == 0) sc = (cr > c) ? sc : -1e30f;
                if (kb == 4) sc = (cr <= c) ? sc : -1e30f;
                if (seq_start) sc = (t0 - 128 + 32 * kb + cr >= 0) ? sc : -1e30f;
                p[kb][r] = sc; mx = fmaxf(mx, sc); }
        mx = fmaxf(mx, __shfl_xor(mx, 32));
        float l = 0.f;
#pragma unroll
        for (int kb = 0; kb < 5; ++kb)
#pragma unroll
            for (int r = 0; r < 16; ++r) { const float e = __builtin_amdgcn_exp2f(p[kb][r] - mx); p[kb][r] = e; l += e; }
        l += __shfl_xor(l, 32); l += __builtin_amdgcn_exp2f(sink - mx);
        f32x16 o[2];
#pragma unroll
        for (int d = 0; d < 2; ++d)
#pragma unroll
            for (int r = 0; r < 16; ++r) o[d][r] = 0.f;
#pragma unroll
        for (int kb = 0; kb < 5; ++kb)
#pragma unroll
            for (int s2 = 0; s2 < 2; ++s2) {
                pg8::u32x4 pw; pw.x = pg8::cvt_pk_bf16(p[kb][8 * s2 + 0], p[kb][8 * s2 + 1]); pw.y = pg8::cvt_pk_bf16(p[kb][8 * s2 + 2], p[kb][8 * s2 + 3]);
                pw.z = pg8::cvt_pk_bf16(p[kb][8 * s2 + 4], p[kb][8 * s2 + 5]); pw.w = pg8::cvt_pk_bf16(p[kb][8 * s2 + 6], p[kb][8 * s2 + 7]);
                const bf16x8 pf = __builtin_bit_cast(bf16x8, pw);
#pragma unroll
                for (int d = 0; d < 2; ++d) {
                    const bf16_t* vp = vs_ + (32 * half + 32 * kb + 16 * s2 + 4 * hi + ((lane & 15) >> 2)) * AT_VLD + 32 * d + 16 * ((lane >> 4) & 1) + 4 * (lane & 3);
                    const s16x4 lo = __builtin_amdgcn_ds_read_tr16_b64_v4i16((__attribute__((address_space(3))) s16x4*)vp), hh = __builtin_amdgcn_ds_read_tr16_b64_v4i16((__attribute__((address_space(3))) s16x4*)(vp + 8 * AT_VLD));
                    const bf16x8 vf = (bf16x8){lo[0], lo[1], lo[2], lo[3], hh[0], hh[1], hh[2], hh[3]};
                    o[d] = __builtin_amdgcn_mfma_f32_32x32x16_bf16(vf, pf, o[d], 0, 0, 0); } }
        const float inv = __builtin_amdgcn_rcpf(l);
#pragma unroll
        for (int d = 0; d < 2; ++d)
#pragma unroll
            for (int rp = 0; rp < 2; ++rp) {
                unsigned ax = pg8::cvt_pk_bf16(o[d][8 * rp] * inv, o[d][8 * rp + 1] * inv), ay = pg8::cvt_pk_bf16(o[d][8 * rp + 2] * inv, o[d][8 * rp + 3] * inv);
                unsigned bx = pg8::cvt_pk_bf16(o[d][8 * rp + 4] * inv, o[d][8 * rp + 5] * inv), by = pg8::cvt_pk_bf16(o[d][8 * rp + 6] * inv, o[d][8 * rp + 7] * inv);
                const auto r0 = __builtin_amdgcn_permlane32_swap(ax, bx, false, false); const auto r1 = __builtin_amdgcn_permlane32_swap(ay, by, false, false);
                pg8::u32x4 w; w.x = r0[0]; w.y = r1[0]; w.z = r0[1]; w.w = r1[1];
                *(pg8::u32x4*)(mix + mq * D + h * 64 + 32 * d + 16 * rp + 8 * hi) = w; }
        __syncthreads();
    }
#undef AT_PIECE
#undef AT_FETCH
#undef AT_STAGE
}

__device__ __forceinline__ void ffn_fixup(const float* __restrict__ SB, const float* __restrict__ cw, const float* __restrict__ cb, bf16_t* hid, int pm, int tid) {
    pm = __builtin_amdgcn_readfirstlane(pm);
    const float* s = SB + (size_t)pm * 6 * FF; const float* sp = SB + (size_t)(pm - 1) * 6 * FF; const bool has_prev = (pm % (SEQ / 256)) != 0;
    static_assert(2 * FF == 11 * NTHREADS_, "ffn_fixup: 11 items per thread");
    float u0[11], u1[11], ul0[11], ul1[11], w0[11], w1[11], w2[11], bb[11], up[11];
#pragma unroll
    for (int it = 0; it < 11; ++it) { const int idx = tid + NTHREADS_ * it, rr = idx >= FF ? 1 : 0, j = idx - rr * FF;
        u0[it] = s[j]; u1[it] = s[FF + j]; ul0[it] = has_prev ? sp[4 * FF + j] : 0.f; ul1[it] = has_prev ? sp[5 * FF + j] : 0.f;
        w0[it] = cw[j]; w1[it] = cw[FF + j]; w2[it] = cw[2 * FF + j]; bb[it] = cb[j]; up[it] = s[(2 + rr) * FF + j]; }
#pragma unroll
    for (int it = 0; it < 11; ++it) { const int idx = tid + NTHREADS_ * it, rr = idx >= FF ? 1 : 0, j = idx - rr * FF;
        const float c = rr == 0 ? bb[it] + w0[it] * ul0[it] + w1[it] * ul1[it] + w2[it] * u0[it] : bb[it] + w0[it] * ul1[it] + w1[it] * u0[it] + w2[it] * u1[it];
        hid[(size_t)(pm * 256 + rr) * FF + j] = (bf16_t)f2bf(c * sigmoidf_(c) * up[it]); }
}

#define XB_TMO      128
#define XB_XCNT(j)  (256  + 64 * (j))
#define XB_XSUB(j)  (1280 + 64 * (j))
#define XB_XGEN(j)  (2304 + 64 * (j))
#define XB_TOP      3328
#define XB_TOPGEN   3392
#define XCD_BAR_WORDS 3456
#define XB_SPIN_CAP (1u << 18)

__device__ __forceinline__ unsigned xb_ld(unsigned* p)              { return __hip_atomic_load(p, __ATOMIC_RELAXED, __HIP_MEMORY_SCOPE_AGENT); }
__device__ __forceinline__ unsigned xb_add(unsigned* p, unsigned v) { return __hip_atomic_fetch_add(p, v, __ATOMIC_RELAXED, __HIP_MEMORY_SCOPE_AGENT); }
__device__ __forceinline__ unsigned xb_xcc_id() { return (unsigned)__builtin_amdgcn_s_getreg((3 << 11) | 20) & 0xFu; }
#define XB_SPIN(cond, bar) do { unsigned _sp = 0; while (cond) { __builtin_amdgcn_s_sleep(1); \
    if ((++_sp & 255u) == 0u) { if (xb_ld(&(bar)[XB_TMO])) break; if (_sp > XB_SPIN_CAP) { atomicAdd(&(bar)[XB_TMO], 1u); break; } } } } while (0)

struct XcdBarrier {
    unsigned* bar; unsigned x;
    volatile __attribute__((address_space(3))) unsigned* st;
};

__device__ __forceinline__ XcdBarrier xcd_barrier_post(unsigned* bar, volatile __attribute__((address_space(3))) unsigned* st) {
    XcdBarrier b; b.bar = bar; b.x = xb_xcc_id(); b.st = st;
    if (threadIdx.x == 0) (void)xb_add(&bar[XB_XCNT(b.x)], 1u);
    return b;
}
__device__ __forceinline__ void xcd_barrier_complete(unsigned* bar, unsigned x, unsigned& nloc, unsigned& nx) {
    const unsigned G = gridDim.x * gridDim.y * gridDim.z;
    unsigned sum, cnt, mine, sp = 0u;
    for (;;) {
        sum = 0u; cnt = 0u; mine = 0u;
#pragma unroll
        for (unsigned j = 0; j < 16; ++j) { const unsigned c = xb_ld(&bar[XB_XCNT(j)]); sum += c; cnt += (c > 0u) ? 1u : 0u; mine = (j == x) ? c : mine; }
        if (sum == G) break;
        __builtin_amdgcn_s_sleep(1);
        if ((++sp & 255u) == 0u) { if (xb_ld(&bar[XB_TMO])) break; if (sp > XB_SPIN_CAP) { atomicAdd(&bar[XB_TMO], 1u); break; } }
    }
    nloc = mine > 0u ? mine : 1u; nx = cnt > 0u ? cnt : 1u;
}

__device__ __forceinline__ void xcd_barrier(const XcdBarrier& b) {
    asm volatile("s_waitcnt vmcnt(0)" ::: "memory");
    __syncthreads();
    if (threadIdx.x == 0) {
        unsigned* bar = b.bar;
        __builtin_amdgcn_s_waitcnt(0);
        unsigned nloc = b.st[0], nx = b.st[1];
        if (nloc == 0u) { xcd_barrier_complete(bar, b.x, nloc, nx); b.st[0] = nloc; b.st[1] = nx; }
        const unsigned old = xb_add(&bar[XB_XSUB(b.x)], 1u);
        const unsigned gen = old / nloc;
        if (old + 1u == (gen + 1u) * nloc) {
            __builtin_amdgcn_fence(__ATOMIC_RELEASE, "agent");
            asm volatile("s_waitcnt vmcnt(0)" ::: "memory");
            const unsigned og = xb_add(&bar[XB_TOP], 1u);
            const unsigned tg = og / nx;
            if (og + 1u == (tg + 1u) * nx) xb_add(&bar[XB_TOPGEN], 1u);
            else XB_SPIN(xb_ld(&bar[XB_TOPGEN]) == tg, bar);
            __builtin_amdgcn_fence(__ATOMIC_ACQUIRE, "agent");
            xb_add(&bar[XB_XGEN(b.x)], 1u);
            asm volatile("s_waitcnt vmcnt(0)" ::: "memory");
        } else {
            XB_SPIN(xb_ld(&bar[XB_XGEN(b.x)]) == gen, bar);
            __builtin_amdgcn_fence(__ATOMIC_ACQUIRE, "agent");
            asm volatile("s_waitcnt vmcnt(0)" ::: "memory");
        }
    }
    __syncthreads();
}

constexpr int NTHREADS = 512, LDS_BYTES = 147456;
struct Args { const float* in[26]; float* out; unsigned char* ws; };
__global__ void __launch_bounds__(NTHREADS, 2) mega_fwd(Args a) {
    extern __shared__ __attribute__((aligned(16))) unsigned char lds[];
    constexpr int MISC_OFF = 131072 + 4096;
    { volatile __attribute__((address_space(3))) unsigned* misc = (volatile __attribute__((address_space(3))) unsigned*)((__attribute__((address_space(3))) unsigned char*)lds + MISC_OFF);
      if (threadIdx.x < 4) misc[threadIdx.x] = 0u; }
    __syncthreads();
    (void)xcd_barrier_post((unsigned*)(a.ws + WS_BAR), (volatile __attribute__((address_space(3))) unsigned*)((__attribute__((address_space(3))) unsigned char*)lds + MISC_OFF));
#define GRID_SYNC() do { XcdBarrier xb_; xb_.bar = (unsigned*)(a.ws + WS_BAR); xb_.x = xb_xcc_id(); xb_.st = (volatile __attribute__((address_space(3))) unsigned*)((__attribute__((address_space(3))) unsigned char*)lds + MISC_OFF); xcd_barrier(xb_); } while (0)
#define LDSP ((PG8_LAS unsigned char*)lds)
    constexpr int XCH_OFF = 131072;
#define OTID() ({ int _t = threadIdx.x; asm volatile("" : "+v"(_t)); _t; })
    const int G = gridDim.x, NGW = G * 8;
    const float* x = a.in[0]; const float* norm1_g = a.in[1]; const float* w_in = a.in[2]; const float* sinks = a.in[3];
    const float* mu = a.in[4]; const float* w0 = a.in[5]; const float* w2 = a.in[6]; const float* a0 = a.in[7];
    const float* a2 = a.in[8]; const float* g2 = a.in[9]; const float* k_k = a.in[10]; const float* k_a = a.in[11];
    const float* r_k = a.in[12]; const float* lnx_g = a.in[13]; const float* lnx_b = a.in[14]; const float* v0 = a.in[15];
    const float* v1 = a.in[16]; const float* v2 = a.in[17]; const float* w_out = a.in[18]; const float* norm2_g = a.in[19];
    const float* wg = a.in[20]; const float* wu = a.in[21]; const float* conv_w = a.in[22]; const float* conv_b = a.in[23];
    const float* wd = a.in[24]; const float* final_g = a.in[25];
    unsigned char* ws = a.ws; float* X = a.out;
    ssq_t* ss = (ssq_t*)(ws + WS_SS);
    bf16_t* XB = (bf16_t*)(ws + WS_XB); bf16_t* PROJ = (bf16_t*)(ws + WS_PROJ); bf16_t* MIX = (bf16_t*)(ws + WS_MIX); bf16_t* HID = (bf16_t*)(ws + WS_HID); bf16_t* VF = (bf16_t*)(ws + WS_VFIRST);
    bf16_t* UT = (bf16_t*)(ws + WS_UTMP); bf16_t* UPT = UT + (size_t)SEQ * FF;

    {
        const int tid = OTID(), lane = tid & 63, wave = tid >> 6, gw = blockIdx.x * 8 + wave;
        float* scr = (float*)lds + wave * (64 * 33 + 16);
        constexpr int I_IN = (D / 64) * (IN_W / 32), I_OUT = (D / 64) * (D / 32), I_G = (D / 64) * (FF / 32), I_DN = (FF / 64) * (D / 32), I_LAYER = I_IN + I_OUT + 2 * I_G + I_DN;
        for (int it = gw; it < 2 * I_LAYER; it += NGW) {
            const int l = it / I_LAYER; int r = it % I_LAYER;
            bf16_t* wl = (bf16_t*)(ws + WS_W + l * W_LAYER); bf16_t* WinT = wl; bf16_t* WoutT = (bf16_t*)((char*)wl + W_IN_SZ); bf16_t* WguT = (bf16_t*)((char*)WoutT + W_OUT_SZ); bf16_t* WdT = (bf16_t*)((char*)WguT + W_GU_SZ);
            if (r < I_IN) { transpose_item(w_in + (size_t)l * D * IN_W, D, IN_W, WinT, norm1_g + l * D, 0, scr, r, lane); continue; } r -= I_IN;
            if (r < I_OUT) { transpose_item(w_out + (size_t)l * D * D, D, D, WoutT, nullptr, 0, scr, r, lane); continue; } r -= I_OUT;
            if (r < I_G) { transpose_item(wg + (size_t)l * D * FF, D, FF, WguT, norm2_g + l * D, 1, scr, r, lane); continue; } r -= I_G;
            if (r < I_G) { transpose_item(wu + (size_t)l * D * FF, D, FF, WguT, norm2_g + l * D, 2, scr, r, lane); continue; } r -= I_G;
            transpose_item(wd + (size_t)l * FF * D, FF, D, WdT, nullptr, 0, scr, r, lane);
        }
        {
            constexpr int I_W2 = 1 * (C / 32), I_G2 = 2 * (C / 32), I_V1 = (C / 64) * 1, I_L = 2 * I_W2 + I_G2;
            const float* mu_v1 = a.in[4] + SHIFT_W + 1024;
            for (int it = gw; it < 2 * I_L + 2 * I_V1; it += NGW) {
                if (it < 2 * I_L) { const int l = it / I_L; int r = it % I_L; bf16_t* base = (bf16_t*)(ws + WS_LORA + l * LORA_LAYER);
                    if (r < I_W2) { transpose_item(w2 + (size_t)l * 64 * C, 64, C, base, nullptr, 0, scr, r, lane); continue; } r -= I_W2;
                    if (r < I_W2) { transpose_item(a2 + (size_t)l * 64 * C, 64, C, base + 512 * 64, nullptr, 0, scr, r, lane); continue; } r -= I_W2;
                    transpose_item(g2 + (size_t)l * 128 * C, 128, C, base + 2 * 512 * 64, nullptr, 0, scr, r, lane); }
                else if (it < 2 * I_L + I_V1) transpose_item(v1, C, 32, (bf16_t*)(ws + WS_V1T), mu_v1, 0, scr, it - 2 * I_L, lane, true);
                else transpose_item(v1, C, 32, (bf16_t*)(ws + WS_V1B), mu_v1, 0, scr, it - 2 * I_L - I_V1, lane, false);
            }
            bf16_t* V2T = (bf16_t*)(ws + WS_V2T);
            for (int i = blockIdx.x * NTHREADS + tid; i < 32 * C; i += G * NTHREADS) { const int j = i / C, ch = i % C; V2T[ch * 32 + j] = (bf16_t)f2bf(v2[i]); }
        }
        for (int m = 4 * gw; m < M; m += 4 * NGW) {
            f32x4 xv[4][4];
#pragma unroll
            for (int u = 0; u < 4; ++u)
#pragma unroll
                for (int j = 0; j < 4; ++j) xv[u][j] = ((const f32x4*)(x + (size_t)(m + u) * D))[lane + 64 * j];
#pragma unroll
            for (int u = 0; u < 4; ++u) { float sq = 0.f;
#pragma unroll
                for (int j = 0; j < 4; ++j) { const f32x4 v = xv[u][j]; sq += v.x * v.x + v.y * v.y + v.z * v.z + v.w * v.w;
                    ((unsigned long long*)(XB + (size_t)(m + u) * D))[lane + 64 * j] = (unsigned long long)(f2bf(v.x) | (f2bf(v.y) << 16)) | ((unsigned long long)(f2bf(v.z) | (f2bf(v.w) << 16)) << 32); }
                sq = wave_sum(sq); if (lane == 0) ss[m + u] = ssq_fix(sq); } }
    }
    GRID_SYNC();
    for (int l = 0; l < 2; ++l) {
        bf16_t* wl = (bf16_t*)(ws + WS_W + l * W_LAYER); bf16_t* WinT = wl; bf16_t* WoutT = (bf16_t*)((char*)wl + W_IN_SZ); bf16_t* WguT = (bf16_t*)((char*)WoutT + W_OUT_SZ); bf16_t* WdT = (bf16_t*)((char*)WguT + W_GU_SZ);
        ssq_t* ss1 = ss + (size_t)(2 * l) * M; ssq_t* ss2 = ss + (size_t)(2 * l + 1) * M; ssq_t* ss3 = ss + (size_t)(2 * l + 2) * M;
        { pg8::Gemm g{XB, WinT, M, IN_W, D}; pg8::StaticOrder S; S.init(M, IN_W, G, (int)blockIdx.x); pg8::EpiScaleBf16 E{PROJ, IN_W, ss1};
          pg8::gemm_phase<pg8::EpiScaleBf16, pg8::StaticOrder, true, true>(LDSP, g, S, E); }
        GRID_SYNC();
        { float* KC = (float*)(lds + CK_CONST_OFF); const int t_ = OTID(); KC[t_] = (k_k + l * C)[t_]; KC[512 + t_] = (k_a + l * C)[t_]; KC[1024 + t_] = (r_k + l * C)[t_]; KC[1536 + t_] = (mu + l * SHIFT_W)[t_]; KC[2048 + t_] = (mu + l * SHIFT_W)[512 + t_]; __syncthreads(); }
        attn_phase(PROJ, sinks + l * NH, MIX, lds, G, OTID());
        struct { bf16_t *V, *G; } p; p.V = (bf16_t*)(ws + WS_SI_V); p.G = (bf16_t*)(ws + WS_SI_G);
        bf16_t* GQ = (bf16_t*)X; bf16_t* CQ = GQ + (size_t)BATCH * NH * 64 * 8192;
        ScanArgs s{}; s.yt = (bf16_t*)(ws + WS_YT); s.proj = PROJ; s.V = p.V; s.G = p.G; s.k_k = k_k + l * C; s.k_a = k_a + l * C; s.r_k = r_k + l * C; s.lnx_g = lnx_g + l * C; s.lnx_b = lnx_b + l * C; s.mix = MIX; s.rkc = (float*)(ws + WS_RKC);
        { bf16_t* scr = (bf16_t*)(ws + WS_TSCR + (size_t)blockIdx.x * TSCR_WG);
          for (int tile = blockIdx.x; tile < M / 64; tile += G) {
              const size_t moff = (size_t)tile * 64 * C;
              Prep2Args q{}; q.proj = PROJ; q.mu = mu + l * SHIFT_W; q.w0 = w0 + l * C; q.a0 = a0 + l * C; q.v0 = v0;
              const bf16_t* lw = (const bf16_t*)(ws + WS_LORA + l * LORA_LAYER); q.W2T = lw; q.A2T = lw + 512 * 64; q.G2T = lw + 2 * 512 * 64; q.V1T = (const bf16_t*)(ws + WS_V1T); q.V1B = (const bf16_t*)(ws + WS_V1B); q.V2T = (const bf16_t*)(ws + WS_V2T);
              q.vfirst = VF; q.A = scr - moff; q.CS = (unsigned short*)(scr + 64 * C) - moff; q.V = p.V; q.G = p.G; q.layer = l;
              prep_tile(q, lds, tile, OTID());
              asm volatile("s_waitcnt vmcnt(0)" ::: "memory"); __syncthreads();
              if (threadIdx.x == 0) { __builtin_amdgcn_fence(__ATOMIC_ACQUIRE, "agent"); asm volatile("s_waitcnt vmcnt(0)" ::: "memory"); }
              __syncthreads();
              s.A = q.A; s.CS = q.CS;
              const int bb = tile >> 6, chunk = tile & 63;
              CkRaw cur; ck_load(s, cur, ((bb * NH) << 6) + chunk, OTID());
#define CK_UNIT(hh_) do { const int unit = ((bb * NH + (hh_)) << 6) + chunk; CkRaw nxt = cur; ck_precompute(s, cur, nxt, (hh_) + 1 < NH ? unit + 64 : unit, lds, GQ, CQ, unit, OTID()); cur = nxt; } while (0)
              CK_UNIT(0);
              for (int hh = 1; hh < NH; ++hh) CK_UNIT(hh);
#undef CK_UNIT
          } }
        GRID_SYNC();
        for (int item = (int)((blockIdx.x & 7) * (G >> 3) + (blockIdx.x >> 3)); item < BATCH * NH * 4; item += G) ck_sequential(s, lds, GQ, CQ, item, OTID());
        GRID_SYNC();
        { const int tid = OTID(), lane = tid & 63, gw = blockIdx.x * 8 + (tid >> 6); scan_post_wave(s, gw, NGW, lane); }
        GRID_SYNC();
        { pg8::Gemm g{MIX, WoutT, M, D, D}; pg8::StaticOrder S; S.init(M, D, G, (int)blockIdx.x); pg8::EpiResid E{XB, ss2};
          pg8::gemm_phase<pg8::EpiResid, pg8::StaticOrder, true, true>(LDSP, g, S, E); }
        GRID_SYNC();
        { pg8::Gemm g{XB, WguT, M, 2 * FF, D}; pg8::StaticOrder S; S.init(M, 2 * FF, G, (int)blockIdx.x);
          pg8::EpiConvGlu E{HID, ss2, conv_w + (size_t)l * 3 * FF, conv_b + (size_t)l * FF, (float*)(ws + WS_UTMP), (PG8_LAS float*)(LDSP + XCH_OFF), FF};
          pg8::gemm_phase<pg8::EpiConvGlu, pg8::StaticOrder, true, true>(LDSP, g, S, E); }
        GRID_SYNC();
        { pg8::Gemm g{HID, WdT, M, D, FF}; pg8::StaticOrder S; S.init(M, D, G, (int)blockIdx.x);
          { pg8::Unit u; for (int i = 0; S.next(i, u); ++i) ffn_fixup((const float*)(ws + WS_UTMP), conv_w + (size_t)l * 3 * FF, conv_b + (size_t)l * FF, HID, u.pm, OTID());
            asm volatile("s_waitcnt vmcnt(0)" ::: "memory"); __syncthreads(); }
          if (l == 0) { pg8::EpiResid E{XB, ss3}; pg8::gemm_phase<pg8::EpiResid, pg8::StaticOrder, true, true>(LDSP, g, S, E); }
          else { pg8::EpiResidFinal E{XB, ss3, (unsigned*)(ws + WS_FCNT), final_g, X};
                 pg8::gemm_phase<pg8::EpiResidFinal, pg8::StaticOrder, true, true>(LDSP, g, S, E); } }
        if (l == 0) GRID_SYNC();
    }
}

extern "C" void kernel_launch(void* const* d_in, const int* in_sizes, int n_in, void* d_out, int out_size, void* d_ws, size_t ws_size, hipStream_t stream) {
    static int grid = 0;
    if (grid == 0) {
        if (n_in != 26 || in_sizes[0] != M * D || out_size != M * D || ws_size < WS_END) { fprintf(stderr, "kernel_launch: unexpected shapes (n_in %d, ws %zu)\n", n_in, ws_size); grid = -1; return; }
        int dev = 0, cus = 0, per_cu = 0;
        if (hipGetDevice(&dev) != hipSuccess || hipDeviceGetAttribute(&cus, hipDeviceAttributeMultiprocessorCount, dev) != hipSuccess) { grid = -1; return; }
        if (hipFuncSetAttribute((const void*)mega_fwd, hipFuncAttributeMaxDynamicSharedMemorySize, LDS_BYTES) != hipSuccess) { fprintf(stderr, "kernel_launch: hipFuncSetAttribute failed\n"); grid = -1; return; }
        if (hipOccupancyMaxActiveBlocksPerMultiprocessor(&per_cu, (const void*)mega_fwd, NTHREADS, LDS_BYTES) != hipSuccess || per_cu < 1) { fprintf(stderr, "kernel_launch: occupancy query failed (%d)\n", per_cu); grid = -1; return; }
        grid = cus;
    }
    if (grid < 0) return;
    (void)hipMemsetAsync((unsigned char*)d_ws + WS_CTL, 0, CTL_BYTES, stream);
    Args a{};
    for (int i = 0; i < 26; ++i) a.in[i] = (const float*)d_in[i];
    a.out = (float*)d_out; a.ws = (unsigned char*)d_ws;
    void* kargs[] = {&a};
    hipError_t e = hipLaunchCooperativeKernel((const void*)mega_fwd, dim3(grid), dim3(NTHREADS), kargs, LDS_BYTES, stream);
    if (e != hipSuccess) fprintf(stderr, "kernel_launch: cooperative launch failed: %s (grid %d)\n", hipGetErrorString(e), grid);
}
```

```cpp
#include <hip/hip_runtime.h>
#include <cstdio>
#include <cstdint>

typedef unsigned short bf16_t;
typedef short bf16x8 __attribute__((ext_vector_type(8)));
typedef float f32x4 __attribute__((ext_vector_type(4)));

constexpr int BATCH = 8, SEQ = 4096, D = 1024, M = BATCH * SEQ;
constexpr int HD = 64, ATT_W = 512, KV_W = 128, C = 512, NH = 8;
constexpr int ATT_IN = 768, SHIFT_W = 1792, IN_W = 2560, FF = 2816;
constexpr int WINDOW = 128;
constexpr float RMS_EPS = 1e-5f, LNX_EPS = 64e-5f;

constexpr size_t MiB = 1u << 20;
constexpr size_t WS_CTL = 0;
typedef unsigned long long ssq_t;
__device__ __forceinline__ ssq_t ssq_fix(float s) { return (ssq_t)(s * 1048576.0f + 0.5f); }
__device__ __forceinline__ float ssq_val(ssq_t v) { return (float)v * (1.0f / 1048576.0f); }
constexpr size_t WS_SS = 0;
constexpr size_t CTL_BYTES = 2 * MiB;
constexpr size_t WS_FCNT = 1792 * 1024;
constexpr size_t WS_BAR = 1536 * 1024;
constexpr size_t WS_W = 2 * MiB;
constexpr size_t W_IN_SZ = (size_t)IN_W * D * 2, W_OUT_SZ = (size_t)D * D * 2, W_GU_SZ = (size_t)2 * FF * D * 2, W_DN_SZ = (size_t)D * FF * 2;
constexpr size_t W_LAYER = W_IN_SZ + W_OUT_SZ + W_GU_SZ + W_DN_SZ;
constexpr size_t WS_VFIRST = 52 * MiB, WS_MIX = 84 * MiB, WS_XB = 148 * MiB, WS_PROJ = 212 * MiB;
constexpr size_t WS_SI_R = 148 * MiB, WS_SI_K = 180 * MiB, WS_SI_V = 372 * MiB, WS_SI_A = 404 * MiB, WS_SI_LD = 436 * MiB, WS_SI_G = 468 * MiB;
constexpr size_t WS_HID = 212 * MiB;
constexpr size_t WS_UTMP = 84 * MiB;
constexpr size_t WS_END = 500 * MiB;
static_assert(WS_W + 2 * W_LAYER <= WS_VFIRST, "weights fit");

__device__ __forceinline__ unsigned f2bf(float f) { unsigned u = __builtin_bit_cast(unsigned, f); return (u + 0x7fffu + ((u >> 16) & 1u)) >> 16; }
__device__ __forceinline__ float bf2f(bf16_t h) { return __builtin_bit_cast(float, (unsigned)h << 16); }
__device__ __forceinline__ float wave_sum(float v) {
#pragma unroll
    for (int o = 1; o < 64; o <<= 1) v += __shfl_xor(v, o);
    return v;
}
#define LDS_BARRIER() do { asm volatile("s_waitcnt lgkmcnt(0)" ::: "memory"); __builtin_amdgcn_s_barrier(); asm volatile("" ::: "memory"); } while (0)
__device__ __forceinline__ float sigmoidf_(float x) { return __builtin_amdgcn_rcpf(1.f + __expf(-x)); }

namespace pg8 {
#define PG8_LAS __attribute__((address_space(3)))
typedef unsigned short bf16_t;
typedef short bf16x8 __attribute__((ext_vector_type(8)));
typedef float f32x4 __attribute__((ext_vector_type(4)));
typedef unsigned u32x4 __attribute__((ext_vector_type(4)));
constexpr int BM = 256, BK = 64, HALF = 128, HTB = HALF * BK * 2  , STAGE_BYTES = 8 * HTB, NXCD = 8, WGM = 8;

__host__ __device__ __forceinline__ int lds_byte(int r, int c) { const int st = (r >> 4) * 2 + (c >> 5), rr = r & 15, cc = c & 31, ob = rr * 64 + cc * 2; return st * 1024 + (ob ^ (((ob >> 9) & 1) << 5)); }
__host__ __device__ __forceinline__ void stage_rc(int b, int& R, int& C) { const int st = b / 1024, sb = b % 1024, swz = sb ^ (((sb >> 9) & 1) << 5); R = (st >> 1) * 16 + swz / 64; C = (st & 1) * 32 + (swz % 64) / 2; }
__host__ __device__ __forceinline__ int perm32(int rho) { const int n = rho >> 4, i = rho & 15; return 8 * (i >> 2) + 4 * n + (i & 3); }

struct Unit { int pm, pn; };
struct Gemm { const bf16_t* A; const bf16_t* Bt; int M, N, K; };

struct StaticOrder {
    int nM, nN, nwg, G, c;
    __host__ __device__ void init(int M, int N, int G_, int c_) { nM = M / BM; nN = N / BM; nwg = nM * nN; G = G_; c = c_; }
    __host__ __device__ bool next(int i, Unit& u) const {
        const long L = (long)i * G + c; if (L >= nwg) return false;
        int wgid = (int)L; { const int q = nwg / NXCD, r = nwg % NXCD, xcd = wgid % NXCD, off = wgid / NXCD; wgid = (xcd < r ? xcd * (q + 1) : r * (q + 1) + (xcd - r) * q) + off; }
        const int nig = WGM * nN, gid = wgid / nig, fm = gid * WGM, gsz = (nM - fm) < WGM ? (nM - fm) : WGM;
        u.pm = fm + ((wgid % nig) % gsz); u.pn = (wgid % nig) / gsz; return true;
    }
    __device__ __forceinline__ void a_ready(const Unit&) const {}
    __device__ __forceinline__ void done(const Unit&) const {}
};
typedef float f32x2_t_ __attribute__((ext_vector_type(2))); typedef __bf16 bf16x2_t_ __attribute__((ext_vector_type(2)));
__device__ __forceinline__ unsigned cvt_pk_bf16(float lo, float hi) { const f32x2_t_ v = {lo, hi}; const bf16x2_t_ b = __builtin_convertvector(v, bf16x2_t_); return __builtin_bit_cast(unsigned, b); }
typedef float f32x2 __attribute__((ext_vector_type(2)));
template <class Epi, class Sched, bool ALIGN_EPI = false, bool SP2 = false>
__device__ __forceinline__ void gemm_phase(PG8_LAS unsigned char* lds, const Gemm g, const Sched& S, const Epi& E) {
    int tid_ = threadIdx.x; asm volatile("" : "+v"(tid_));
    const int tid = tid_, wid = __builtin_amdgcn_readfirstlane(tid >> 6), lane = tid & 63, wr = wid >> 2, wc = wid & 3, fr = lane & 15, fq = lane >> 4;
    const int K = g.K, nt = K / BK;
    unsigned voffA[2], voffB[2];
#pragma unroll
    for (int i = 0; i < 2; ++i) { int R, C; stage_rc(tid * 16 + i * 8192, R, C); const int Rb = (R >> 5) * 64 + (Epi::PERM ? perm32(R & 31) : (R & 31));
        voffA[i] = (unsigned)(R * K + C) * 2u; voffB[i] = (unsigned)(Rb * K + C) * 2u; }
    const size_t kstep = (size_t)(BK * 2);
    const size_t hstep = (size_t)HALF * K * 2;
    const size_t tstep = 2 * hstep;
    const size_t hstepB = (size_t)32 * K * 2;
    const unsigned ldsw = (unsigned)wid * 1024u;
    const int aoff = lds_byte(wr * 64 + fr, fq * 8), boff = lds_byte(wc * 32 + fr, fq * 8);
#define PG8_SA(b, h) (((b) * 2 + (h)) * HTB)
#define PG8_SB(b, h) ((4 + (b) * 2 + (h)) * HTB)
#define PG8_STAGE(bufoff, gbase, voff) do { _Pragma("unroll") for (int _i = 0; _i < 2; ++_i) \
        __builtin_amdgcn_global_load_lds((const unsigned*)((const char*)(gbase) + (voff)[_i]), (PG8_LAS unsigned*)(lds + (bufoff) + ldsw + _i * 8192), 16, 0, 0); } while (0)
#define PG8_LDA(dst, b, h) do { _Pragma("unroll") for (int m = 0; m < 4; ++m) _Pragma("unroll") for (int k = 0; k < 2; ++k) dst[m][k] = *(const PG8_LAS bf16x8*)(lds + PG8_SA(b, h) + aoff + m * 2048 + k * 1024); } while (0)
#define PG8_LDB(dst, b, h) do { _Pragma("unroll") for (int n = 0; n < 2; ++n) _Pragma("unroll") for (int k = 0; k < 2; ++k) dst[n][k] = *(const PG8_LAS bf16x8*)(lds + PG8_SB(b, h) + boff + n * 2048 + k * 1024); } while (0)
#define PG8_MMA(ai, bj, At, Bt) do { __builtin_amdgcn_s_setprio(1); _Pragma("unroll") for (int m = 0; m < 4; ++m) _Pragma("unroll") for (int n = 0; n < 2; ++n) _Pragma("unroll") for (int k = 0; k < 2; ++k) \
        acc[ai][bj][m][n] = __builtin_amdgcn_mfma_f32_16x16x32_bf16(Bt[n][k], At[m][k], acc[ai][bj][m][n], 0, 0, 0); __builtin_amdgcn_s_setprio(0); } while (0)
#define PG8_WAIT_V(n) asm volatile("s_waitcnt vmcnt(" #n ")" ::: "memory")
#define PG8_WAIT_L(n) asm volatile("s_waitcnt lgkmcnt(" #n ")" ::: "memory")
#define PG8_BAR __builtin_amdgcn_s_barrier()
#define PG8_SCHED __builtin_amdgcn_sched_barrier(0)
    Unit cur, nxt; int ui = 0;
    if (!S.next(0, cur)) return;
    f32x4 acc[2][2][4][2];
#pragma unroll
    for (int a = 0; a < 2; ++a)
#pragma unroll
        for (int b = 0; b < 2; ++b)
#pragma unroll
            for (int m = 0; m < 4; ++m)
#pragma unroll
                for (int n = 0; n < 2; ++n) acc[a][b][m][n] = (f32x4){0.f, 0.f, 0.f, 0.f};
    bf16x8 At[4][2], B0[2][2], B1[2][2];
    const char* cA = (const char*)g.A + (size_t)cur.pm * tstep; const char* cB = (const char*)g.Bt + (size_t)cur.pn * tstep;
    S.a_ready(cur);
    if constexpr (SP2) {
        PG8_STAGE(PG8_SB(0, 0), cB, voffB); PG8_STAGE(PG8_SB(0, 1), cB + hstepB, voffB); PG8_STAGE(PG8_SA(0, 0), cA, voffA); PG8_STAGE(PG8_SA(0, 1), cA + hstep, voffA);
        if (wr == 1) PG8_BAR;
        PG8_WAIT_V(2); PG8_BAR;
        PG8_STAGE(PG8_SB(1, 0), cB + kstep, voffB); PG8_STAGE(PG8_SA(1, 0), cA + kstep, voffA); PG8_STAGE(PG8_SB(1, 1), cB + hstepB + kstep, voffB);
        PG8_WAIT_V(6); PG8_BAR;
    } else {
        PG8_STAGE(PG8_SB(0, 0), cB, voffB); PG8_STAGE(PG8_SA(0, 0), cA, voffA); PG8_STAGE(PG8_SB(0, 1), cB + hstepB, voffB); PG8_STAGE(PG8_SA(0, 1), cA + hstep, voffA);
        if (wr == 1) PG8_BAR;
        PG8_WAIT_V(4); PG8_BAR;
        PG8_STAGE(PG8_SB(1, 0), cB + kstep, voffB); PG8_STAGE(PG8_SA(1, 0), cA + kstep, voffA); PG8_STAGE(PG8_SB(1, 1), cB + hstepB + kstep, voffB);
        PG8_WAIT_V(6); PG8_BAR;
    }
    for (;;) {
        const bool has_next = S.next(ui + 1, nxt);
        const char* nA = has_next ? (const char*)g.A + (size_t)nxt.pm * tstep : cA; const char* nB = has_next ? (const char*)g.Bt + (size_t)nxt.pn * tstep : cB;
        for (int t = 0; t < nt; t += 2) {
            const bool last = (t == nt - 2);
            const char* a1 = cA + (size_t)(t + 1) * kstep;
            const char* a2 = last ? nA : cA + (size_t)(t + 2) * kstep; const char* b2 = last ? nB : cB + (size_t)(t + 2) * kstep;
            const char* a3 = a2 + kstep; const char* b3 = b2 + kstep;
            if (last && has_next) S.a_ready(nxt);
            if constexpr (SP2) {
            PG8_LDB(B0, 0, 0); PG8_LDB(B1, 0, 1); PG8_SCHED; PG8_LDA(At, 0, 0); PG8_STAGE(PG8_SA(1, 1), a1 + hstep, voffA);
            PG8_WAIT_V(8); PG8_WAIT_L(0); PG8_BAR; PG8_MMA(0, 0, At, B0); PG8_MMA(0, 1, At, B1); PG8_BAR; PG8_SCHED;
            PG8_LDA(At, 0, 1); PG8_STAGE(PG8_SB(0, 0), b2, voffB); PG8_STAGE(PG8_SB(0, 1), b2 + hstepB, voffB); PG8_STAGE(PG8_SA(0, 0), a2, voffA);
            PG8_WAIT_V(8); PG8_WAIT_L(0); PG8_BAR; PG8_MMA(1, 0, At, B0); PG8_MMA(1, 1, At, B1); PG8_BAR; PG8_SCHED;
            PG8_LDB(B0, 1, 0); PG8_LDB(B1, 1, 1); PG8_SCHED; PG8_LDA(At, 1, 0); PG8_STAGE(PG8_SA(0, 1), a2 + hstep, voffA);
            PG8_WAIT_V(8); PG8_WAIT_L(0); PG8_BAR; PG8_MMA(0, 0, At, B0); PG8_MMA(0, 1, At, B1); PG8_BAR; PG8_SCHED;
            PG8_LDA(At, 1, 1); PG8_STAGE(PG8_SB(1, 0), b3, voffB); PG8_STAGE(PG8_SB(1, 1), b3 + hstepB, voffB); PG8_STAGE(PG8_SA(1, 0), a3, voffA);
            PG8_WAIT_V(8); PG8_WAIT_L(0); PG8_BAR; PG8_MMA(1, 0, At, B0); PG8_MMA(1, 1, At, B1); PG8_BAR; PG8_SCHED;
            } else {
            PG8_LDB(B0, 0, 0); PG8_SCHED; PG8_LDA(At, 0, 0); PG8_STAGE(PG8_SA(1, 1), a1 + hstep, voffA);
            PG8_WAIT_L(8); PG8_BAR; PG8_WAIT_L(0); PG8_MMA(0, 0, At, B0); PG8_BAR; PG8_SCHED;
            PG8_LDB(B1, 0, 1); PG8_STAGE(PG8_SB(0, 0), b2, voffB);
            PG8_BAR; PG8_WAIT_L(0); PG8_MMA(0, 1, At, B1); PG8_BAR;
            PG8_LDA(At, 0, 1); PG8_STAGE(PG8_SA(0, 0), a2, voffA);
            PG8_BAR; PG8_WAIT_L(0); PG8_MMA(1, 0, At, B0); PG8_BAR; PG8_SCHED;
            PG8_STAGE(PG8_SB(0, 1), b2 + hstepB, voffB);
            PG8_WAIT_V(6); PG8_BAR; PG8_MMA(1, 1, At, B1); PG8_BAR;
            PG8_LDB(B0, 1, 0); PG8_SCHED; PG8_LDA(At, 1, 0); PG8_STAGE(PG8_SA(0, 1), a2 + hstep, voffA);
            PG8_WAIT_L(8); PG8_BAR; PG8_WAIT_L(0); PG8_MMA(0, 0, At, B0); PG8_BAR; PG8_SCHED;
            PG8_LDB(B1, 1, 1); PG8_STAGE(PG8_SB(1, 0), b3, voffB);
            PG8_BAR; PG8_WAIT_L(0); PG8_MMA(0, 1, At, B1); PG8_BAR;
            PG8_LDA(At, 1, 1); PG8_STAGE(PG8_SA(1, 0), a3, voffA);
            PG8_BAR; PG8_WAIT_L(0); PG8_MMA(1, 0, At, B0); PG8_BAR; PG8_SCHED;
            PG8_STAGE(PG8_SB(1, 1), b3 + hstepB, voffB);
            PG8_WAIT_V(6); PG8_BAR; PG8_MMA(1, 1, At, B1); PG8_BAR;
            }
        }
        if constexpr (ALIGN_EPI) { if (wr == 0) PG8_BAR; }
        if constexpr (!Epi::AFTER_DRAIN) { E(acc, cur, wr, wc, fr, fq); S.done(cur); }
        if (!has_next) break;
#pragma unroll
        for (int a = 0; a < 2; ++a)
#pragma unroll
            for (int b = 0; b < 2; ++b)
#pragma unroll
                for (int m = 0; m < 4; ++m)
#pragma unroll
                    for (int n = 0; n < 2; ++n) acc[a][b][m][n] = (f32x4){0.f, 0.f, 0.f, 0.f};
        cur = nxt; cA = nA; cB = nB; ++ui;
        if constexpr (ALIGN_EPI) { if (wr == 1) PG8_BAR; }
    }
    PG8_WAIT_V(0);
    if constexpr (!ALIGN_EPI) { if (wr == 0) PG8_BAR; }
    PG8_BAR;
    if constexpr (Epi::AFTER_DRAIN) { E.fused(acc, cur, wr, wc, fr, fq, lds, wid, lane); S.done(cur); }
#undef PG8_SA
#undef PG8_SB
#undef PG8_STAGE
#undef PG8_LDA
#undef PG8_LDB
#undef PG8_MMA
#undef PG8_WAIT_V
#undef PG8_WAIT_L
#undef PG8_BAR
#undef PG8_SCHED
}

constexpr int DM_ = 1024; constexpr float RMS_EPS_ = 1e-5f;
typedef unsigned long long ssq_t;
struct EpiScaleBf16 {
    static constexpr bool PERM = true, AFTER_DRAIN = false;
    bf16_t* O; int ldc; const ssq_t* ss;
    __device__ __forceinline__ void operator()(const f32x4 (&acc)[2][2][4][2], const Unit& u, int wr, int wc, int fr, int fq) const {
        const int row0 = u.pm * BM + wr * 64 + fr, col0 = u.pn * BM + wc * 64 + 8 * fq;
        float rsv[2][4];
#pragma unroll
        for (int ai = 0; ai < 2; ++ai)
#pragma unroll
            for (int m = 0; m < 4; ++m) rsv[ai][m] = (float)ss[row0 + ai * HALF + m * 16] * (1.0f / 1048576.0f);
#pragma unroll
        for (int ai = 0; ai < 2; ++ai)
#pragma unroll
            for (int m = 0; m < 4; ++m) { const int row = row0 + ai * HALF + m * 16; const float rs = __builtin_amdgcn_rsqf(rsv[ai][m] * (1.0f / DM_) + RMS_EPS_); bf16_t* rowp = O + (size_t)row * ldc + col0;
#pragma unroll
                for (int bj = 0; bj < 2; ++bj) { const f32x4 v0 = acc[ai][bj][m][0] * rs, v1 = acc[ai][bj][m][1] * rs;
                    u32x4 w; w.x = cvt_pk_bf16(v0[0], v0[1]); w.y = cvt_pk_bf16(v0[2], v0[3]); w.z = cvt_pk_bf16(v1[0], v1[1]); w.w = cvt_pk_bf16(v1[2], v1[3]);
                    *(u32x4*)(rowp + bj * 32) = w; } }
    }
};
struct EpiResid {
    static constexpr bool PERM = true, AFTER_DRAIN = false;
    bf16_t* xb; ssq_t* ss_out;
    __device__ __forceinline__ void operator()(const f32x4 (&acc)[2][2][4][2], const Unit& u, int wr, int wc, int fr, int fq) const {
        const int row0 = u.pm * BM + wr * 64 + fr, col0 = u.pn * BM + wc * 64 + 8 * fq;
#pragma unroll
        for (int ai = 0; ai < 2; ++ai) {
            u32x4 bs[4][2];
#pragma unroll
            for (int m = 0; m < 4; ++m)
#pragma unroll
                for (int bj = 0; bj < 2; ++bj) bs[m][bj] = *(const u32x4*)(xb + (size_t)(row0 + ai * HALF + m * 16) * DM_ + col0 + bj * 32);
#pragma unroll
            for (int m = 0; m < 4; ++m) { const int row = row0 + ai * HALF + m * 16; bf16_t* rp = xb + (size_t)row * DM_ + col0; float sq = 0.f;
#pragma unroll
                for (int bj = 0; bj < 2; ++bj) { const u32x4 b = bs[m][bj]; u32x4 w;
#pragma unroll
                    for (int hh = 0; hh < 2; ++hh) { const unsigned b0 = hh == 0 ? b.x : b.z, b1 = hh == 0 ? b.y : b.w; const f32x4 a4 = acc[ai][bj][m][hh];
                        const float x0 = __builtin_bit_cast(float, b0 << 16) + a4[0], x1 = __builtin_bit_cast(float, b0 & 0xffff0000u) + a4[1], x2 = __builtin_bit_cast(float, b1 << 16) + a4[2], x3 = __builtin_bit_cast(float, b1 & 0xffff0000u) + a4[3];
                        const unsigned w0 = cvt_pk_bf16(x0, x1), w1 = cvt_pk_bf16(x2, x3);
                        if (hh == 0) { w.x = w0; w.y = w1; } else { w.z = w0; w.w = w1; }
                        const float r0 = __builtin_bit_cast(float, w0 << 16), r1 = __builtin_bit_cast(float, w0 & 0xffff0000u), r2 = __builtin_bit_cast(float, w1 << 16), r3 = __builtin_bit_cast(float, w1 & 0xffff0000u);
                        sq += (r0 * r0 + r1 * r1) + (r2 * r2 + r3 * r3); }
                    *(u32x4*)(rp + bj * 32) = w; }
                sq += __shfl_xor(sq, 16); sq += __shfl_xor(sq, 32);
                if (fq == 0) atomicAdd(ss_out + row, (ssq_t)(sq * 1048576.0f + 0.5f)); }
        }
    }
};
struct EpiResidFinal {
    static constexpr bool PERM = true, AFTER_DRAIN = false;
    const bf16_t* xb; ssq_t* ss_out; unsigned* cnt; const float* g; float* out;
    __device__ __forceinline__ void operator()(f32x4 (&acc)[2][2][4][2], const Unit& u, int wr, int wc, int fr, int fq) const {
        const int row0 = u.pm * BM + wr * 64 + fr, col0 = u.pn * BM + wc * 64 + 8 * fq;
#pragma unroll
        for (int ai = 0; ai < 2; ++ai) {
            u32x4 bs[4][2];
#pragma unroll
            for (int m = 0; m < 4; ++m)
#pragma unroll
                for (int bj = 0; bj < 2; ++bj) bs[m][bj] = *(const u32x4*)(xb + (size_t)(row0 + ai * HALF + m * 16) * DM_ + col0 + bj * 32);
#pragma unroll
            for (int m = 0; m < 4; ++m) { const int row = row0 + ai * HALF + m * 16; float sq = 0.f;
#pragma unroll
                for (int bj = 0; bj < 2; ++bj) { const u32x4 b = bs[m][bj];
#pragma unroll
                    for (int hh = 0; hh < 2; ++hh) { const unsigned b0 = hh == 0 ? b.x : b.z, b1 = hh == 0 ? b.y : b.w; const f32x4 a4 = acc[ai][bj][m][hh];
                        const float x0 = __builtin_bit_cast(float, b0 << 16) + a4[0], x1 = __builtin_bit_cast(float, b0 & 0xffff0000u) + a4[1], x2 = __builtin_bit_cast(float, b1 << 16) + a4[2], x3 = __builtin_bit_cast(float, b1 & 0xffff0000u) + a4[3];
                        const unsigned w0 = cvt_pk_bf16(x0, x1), w1 = cvt_pk_bf16(x2, x3);
                        const float r0 = __builtin_bit_cast(float, w0 << 16), r1 = __builtin_bit_cast(float, w0 & 0xffff0000u), r2 = __builtin_bit_cast(float, w1 << 16), r3 = __builtin_bit_cast(float, w1 & 0xffff0000u);
                        acc[ai][bj][m][hh] = (f32x4){r0, r1, r2, r3};
                        sq += (r0 * r0 + r1 * r1) + (r2 * r2 + r3 * r3); } }
                sq += __shfl_xor(sq, 16); sq += __shfl_xor(sq, 32);
                if (fq == 0) atomicAdd(ss_out + row, (ssq_t)(sq * 1048576.0f + 0.5f)); }
        }
        asm volatile("s_waitcnt vmcnt(0)" ::: "memory"); __builtin_amdgcn_s_barrier(); asm volatile("" ::: "memory");
        if (wr == 0 && wc == 0 && fr == 0 && fq == 0) {
            (void)__hip_atomic_fetch_add(cnt + u.pm, 1u, __ATOMIC_RELAXED, __HIP_MEMORY_SCOPE_AGENT);
            for (unsigned sp = 0; __hip_atomic_load(cnt + u.pm, __ATOMIC_RELAXED, __HIP_MEMORY_SCOPE_AGENT) < 4u && sp < (1u << 22); ++sp) __builtin_amdgcn_s_sleep(2);
        }
        asm volatile("s_waitcnt vmcnt(0)" ::: "memory"); __builtin_amdgcn_s_barrier(); asm volatile("" ::: "memory");
        f32x4 gv[2][2];
#pragma unroll
        for (int bj = 0; bj < 2; ++bj)
#pragma unroll
            for (int hh = 0; hh < 2; ++hh) gv[bj][hh] = *(const f32x4*)(g + col0 + bj * 32 + 4 * hh);
#pragma unroll
        for (int ai = 0; ai < 2; ++ai)
#pragma unroll
            for (int m = 0; m < 4; ++m) { const int row = row0 + ai * HALF + m * 16;
                const ssq_t sv = __hip_atomic_load(ss_out + row, __ATOMIC_RELAXED, __HIP_MEMORY_SCOPE_AGENT);
                const float rs = __builtin_amdgcn_rsqf((float)sv * (1.0f / 1048576.0f) * (1.0f / DM_) + RMS_EPS_); float* op = out + (size_t)row * DM_ + col0;
#pragma unroll
                for (int bj = 0; bj < 2; ++bj)
#pragma unroll
                    for (int hh = 0; hh < 2; ++hh) *(f32x4*)(op + bj * 32 + 4 * hh) = acc[ai][bj][m][hh] * gv[bj][hh] * rs; }
    }
};
template <int CTRL> __device__ __forceinline__ float dpp1(float x) { return __builtin_bit_cast(float, __builtin_amdgcn_update_dpp(0, __builtin_bit_cast(int, x), CTRL, 0xF, 0xF, true)); }
template <int CTRL> __device__ __forceinline__ f32x4 dpp4(const f32x4 x) { return (f32x4){dpp1<CTRL>(x.x), dpp1<CTRL>(x.y), dpp1<CTRL>(x.z), dpp1<CTRL>(x.w)}; }
struct EpiConvGlu {
    static constexpr bool PERM = true, AFTER_DRAIN = false;
    bf16_t* HID; const ssq_t* ss; const float* cw; const float* cb; float* SB; PG8_LAS float* xch; int ff;
    __device__ __forceinline__ void operator()(const f32x4 (&acc)[2][2][4][2], const Unit& u, int wr, int wc, int fr, int fq) const {
        const int row0 = u.pm * BM + wr * 64 + fr, cl = wc * 32 + 8 * fq, jcol = u.pn * HALF + cl;
        float rs[2][4];
#pragma unroll
        for (int ai = 0; ai < 2; ++ai)
#pragma unroll
            for (int m = 0; m < 4; ++m) rs[ai][m] = (float)ss[row0 + ai * HALF + m * 16] * (1.0f / 1048576.0f);
        f32x4 w0[2], w1[2], w2[2], bb[2];
#pragma unroll
        for (int n = 0; n < 2; ++n) { w0[n] = *(const f32x4*)(cw + jcol + 4 * n); w1[n] = *(const f32x4*)(cw + ff + jcol + 4 * n); w2[n] = *(const f32x4*)(cw + 2 * ff + jcol + 4 * n); bb[n] = *(const f32x4*)(cb + jcol + 4 * n); }
#pragma unroll
        for (int ai = 0; ai < 2; ++ai)
#pragma unroll
            for (int m = 0; m < 4; ++m) rs[ai][m] = __builtin_amdgcn_rsqf(rs[ai][m] * (1.0f / DM_) + RMS_EPS_);
        if (fr >= 14) {
#pragma unroll
            for (int ai = 0; ai < 2; ++ai)
#pragma unroll
                for (int n = 0; n < 2; ++n) *(PG8_LAS f32x4*)(xch + ((2 * ai + wr) * 2 + (fr - 14)) * HALF + cl + 4 * n) = acc[ai][0][3][n] * rs[ai][3];
        }
        asm volatile("s_waitcnt lgkmcnt(0)" ::: "memory"); __builtin_amdgcn_s_barrier(); asm volatile("" ::: "memory");
        float* sbp = SB + (size_t)u.pm * 6 * ff + jcol;
#pragma unroll
        for (int ai = 0; ai < 2; ++ai) {
            const int q = 2 * ai + wr;
            f32x4 X[2];
#pragma unroll
            for (int n = 0; n < 2; ++n) { X[n] = (f32x4){0.f, 0.f, 0.f, 0.f}; if (q > 0 && fr >= 14) X[n] = *(const PG8_LAS f32x4*)(xch + ((q - 1) * 2 + (fr - 14)) * HALF + cl + 4 * n); }
            f32x4 prevg[2] = {X[0], X[1]};
#pragma unroll
            for (int m = 0; m < 4; ++m) { const int row = row0 + ai * HALF + m * 16;
                pg8::u32x4 hw;
#pragma unroll
                for (int n = 0; n < 2; ++n) {
                    const f32x4 cur = acc[ai][0][m][n] * rs[ai][m], up = acc[ai][1][m][n] * rs[ai][m];
                    const f32x4 P = prevg[n]; prevg[n] = cur;
                    f32x4 z1, z2;
#pragma unroll
                    for (int e = 0; e < 4; ++e) { z1[e] = fr == 15 ? P[e] : cur[e]; z2[e] = fr >= 14 ? P[e] : cur[e]; }
                    const f32x4 p1 = dpp4<0x121>(z1), p2 = dpp4<0x122>(z2);
                    const f32x4 c = bb[n] + w0[n] * p2 + w1[n] * p1 + w2[n] * cur;
                    f32x4 hv;
#pragma unroll
                    for (int e = 0; e < 4; ++e) hv[e] = c[e] * __builtin_amdgcn_rcpf(1.f + __expf(-c[e])) * up[e];
                    if (n == 0) { hw.x = cvt_pk_bf16(hv[0], hv[1]); hw.y = cvt_pk_bf16(hv[2], hv[3]); } else { hw.z = cvt_pk_bf16(hv[0], hv[1]); hw.w = cvt_pk_bf16(hv[2], hv[3]); }
                    if (q == 0 && m == 0 && fr < 2) { *(f32x4*)(sbp + (size_t)fr * ff + 4 * n) = cur; *(f32x4*)(sbp + (size_t)(2 + fr) * ff + 4 * n) = up; }
                    if (q == 3 && m == 3 && fr >= 14) *(f32x4*)(sbp + (size_t)(4 + fr - 14) * ff + 4 * n) = cur;
                }
                *(pg8::u32x4*)(HID + (size_t)row * ff + jcol) = hw; }
        }
    }
};
}

#define LAS __attribute__((address_space(3)))
__device__ __forceinline__ void transpose_item(const float* __restrict__ W, int K, int N, bf16_t* __restrict__ Wt, const float* __restrict__ g, int mode, float* scr, int item, int lane, bool gcompl = false) {
    const int nblk = N / 32, kb = item / nblk, nb = item % nblk, k0 = 64 * kb, n0 = 32 * nb;
    int np0 = n0; if (mode != 0) np0 = 256 * (n0 / 128) + 64 * ((n0 % 128) / 32) + (mode == 2 ? 32 : 0);
    f32x4 wv[8];
#pragma unroll
    for (int i = 0; i < 8; ++i) wv[i] = *(const f32x4*)(W + (size_t)(k0 + (lane >> 3) + 8 * i) * N + n0 + (lane & 7) * 4);
#pragma unroll
    for (int i = 0; i < 8; ++i) { const int kk = (lane >> 3) + 8 * i; const float gs = g ? (gcompl ? 1.f - g[k0 + kk] : g[k0 + kk]) : 1.f; float* d = scr + kk * 33 + (lane & 7) * 4; d[0] = wv[i].x * gs; d[1] = wv[i].y * gs; d[2] = wv[i].z * gs; d[3] = wv[i].w * gs; }
    __builtin_amdgcn_fence(__ATOMIC_RELEASE, "wavefront"); __builtin_amdgcn_wave_barrier(); __builtin_amdgcn_fence(__ATOMIC_ACQUIRE, "wavefront");
    const int c = lane & 7;
#pragma unroll
    for (int j = 0; j < 4; ++j) { const int n = (lane >> 3) + 8 * j; const float* sp = scr + (8 * c) * 33 + n;
        uint4 o; o.x = f2bf(sp[0]) | (f2bf(sp[33]) << 16); o.y = f2bf(sp[2 * 33]) | (f2bf(sp[3 * 33]) << 16); o.z = f2bf(sp[4 * 33]) | (f2bf(sp[5 * 33]) << 16); o.w = f2bf(sp[6 * 33]) | (f2bf(sp[7 * 33]) << 16);
        *(uint4*)(Wt + (size_t)(np0 + n) * K + k0 + 8 * c) = o; }
    __builtin_amdgcn_fence(__ATOMIC_RELEASE, "wavefront"); __builtin_amdgcn_wave_barrier(); __builtin_amdgcn_fence(__ATOMIC_ACQUIRE, "wavefront");
}
constexpr size_t WS_LORA = 50 * MiB;
constexpr size_t LORA_LAYER = 256 * 1024, WS_V1T = WS_LORA + 2 * LORA_LAYER, WS_V1B = WS_V1T + 32 * 1024, WS_V2T = WS_V1B + 32 * 1024;
constexpr int PR_ACT_LD = 264, PR_VLO_LD = 40, PR_SG_LD = 520, PR_ACT_OFF = 0, PR_VLO_OFF = 64 * PR_ACT_LD * 2, PR_SG_OFF = PR_VLO_OFF + 64 * PR_VLO_LD * 2;
constexpr int PR_STG_OFF = PR_SG_OFF + 64 * PR_SG_LD * 2, PR_STG_WAVE = 16 * 144;
struct Prep2Args {
    const bf16_t* proj; const float* mu; const float* w0; const float* a0; const float* v0;
    const bf16_t *W2T, *A2T, *G2T, *V1T, *V1B, *V2T; bf16_t* vfirst; bf16_t *V, *A, *G; unsigned short* CS; int layer; int pad;
};
__device__ __forceinline__ f32x4 bfx4_lo(const bf16x8 v) { return (f32x4){bf2f((bf16_t)v[0]), bf2f((bf16_t)v[1]), bf2f((bf16_t)v[2]), bf2f((bf16_t)v[3])}; }
__device__ __forceinline__ f32x4 bfx4_hi(const bf16x8 v) { return (f32x4){bf2f((bf16_t)v[4]), bf2f((bf16_t)v[5]), bf2f((bf16_t)v[6]), bf2f((bf16_t)v[7])}; }
__device__ __forceinline__ bf16x8 pack8(const f32x4 a, const f32x4 b) { pg8::u32x4 w; w.x = pg8::cvt_pk_bf16(a[0], a[1]); w.y = pg8::cvt_pk_bf16(a[2], a[3]); w.z = pg8::cvt_pk_bf16(b[0], b[1]); w.w = pg8::cvt_pk_bf16(b[2], b[3]); return __builtin_bit_cast(bf16x8, w); }
template <int CTRL> __device__ __forceinline__ float dpp_mov(float x) { return __builtin_bit_cast(float, __builtin_amdgcn_update_dpp(0, __builtin_bit_cast(int, x), CTRL, 0xF, 0xF, true)); }
__device__ __forceinline__ float reduce16(float x) { x += dpp_mov<0xB1>(x); x += dpp_mov<0x4E>(x); x += dpp_mov<0x141>(x); x += dpp_mov<0x140>(x); return x; }
__device__ __forceinline__ float red8(float x) { x += dpp_mov<0xB1>(x); x += dpp_mov<0x4E>(x); x += dpp_mov<0x141>(x); return x; }
__device__ __forceinline__ float scan16(float x) { x += dpp_mov<0x111>(x); x += dpp_mov<0x112>(x); x += dpp_mov<0x114>(x); x += dpp_mov<0x118>(x); return x; }
constexpr float CS_SCALE = 1638.0f;
__device__ __forceinline__ void shift8(const bf16_t* __restrict__ proj, const float* __restrict__ mu, size_t m, int t, int col, int mi, f32x4& lo, f32x4& hi) {
    const bf16x8 cur = *(const bf16x8*)(proj + m * IN_W + col);
    bf16x8 prv; if (t > 0) prv = *(const bf16x8*)(proj + (m - 1) * IN_W + col); else prv = (bf16x8){0, 0, 0, 0, 0, 0, 0, 0};
    const f32x4 m0 = *(const f32x4*)(mu + mi), m1 = *(const f32x4*)(mu + mi + 4);
    const f32x4 c0 = bfx4_lo(cur), c1 = bfx4_hi(cur), p0 = bfx4_lo(prv), p1 = bfx4_hi(prv);
    lo = c0 + (p0 - c0) * m0; hi = c1 + (p1 - c1) * m1;
}
__device__ __forceinline__ void prep_tile(const Prep2Args& p, unsigned char* lds, int tile, int tid) {
    const int m0 = tile * 64, wave = __builtin_amdgcn_readfirstlane(tid >> 6), lane = tid & 63, fr = lane & 15, fq = lane >> 4;
    bf16_t* ACT = (bf16_t*)(lds + PR_ACT_OFF); bf16_t* VLO = (bf16_t*)(lds + PR_VLO_OFF); bf16_t* SG = (bf16_t*)(lds + PR_SG_OFF);
    { bf16x8 cu[4], pv[4]; f32x4 mu0[4], mu1[4];
#pragma unroll
      for (int it = 0; it < 4; ++it) { const int i = tid + 512 * it, tk = i >> 5, cc = i & 31; const size_t m = (size_t)m0 + tk; const int t = (int)(m % SEQ);
          cu[it] = *(const bf16x8*)(p.proj + m * IN_W + 2304 + 8 * cc); if (t > 0) pv[it] = *(const bf16x8*)(p.proj + (m - 1) * IN_W + 2304 + 8 * cc); else pv[it] = (bf16x8){0, 0, 0, 0, 0, 0, 0, 0};
          mu0[it] = *(const f32x4*)(p.mu + 1536 + 8 * cc); mu1[it] = *(const f32x4*)(p.mu + 1536 + 8 * cc + 4); }
#pragma unroll
      for (int it = 0; it < 4; ++it) { const int i = tid + 512 * it, tk = i >> 5, cc = i & 31;
          const f32x4 c0 = bfx4_lo(cu[it]), c1 = bfx4_hi(cu[it]); f32x4 lo = c0 + (bfx4_lo(pv[it]) - c0) * mu0[it], hi = c1 + (bfx4_hi(pv[it]) - c1) * mu1[it];
          if (cc < 8) {
#pragma unroll
              for (int e = 0; e < 4; ++e) { lo[e] = 2.f * sigmoidf_(2.f * lo[e]) - 1.f; hi[e] = 2.f * sigmoidf_(2.f * hi[e]) - 1.f; } }
          else if (cc >= 16) {
#pragma unroll
              for (int e = 0; e < 4; ++e) { lo[e] = sigmoidf_(lo[e]); hi[e] = sigmoidf_(hi[e]); } }
          *(bf16x8*)(ACT + tk * PR_ACT_LD + 8 * cc) = pack8(lo, hi); } }
    if (p.layer > 0) {
        unsigned char* VS = lds + PR_SG_OFF; float* PS = (float*)(lds + PR_STG_OFF);
        const bool seq0 = (m0 % SEQ) == 0;
#pragma unroll
        for (int it = 0; it < 9; ++it) { const int pidx = tid + 512 * it; if (pidx < 65 * 64) { const int r = pidx >> 6, g = pidx & 63;
                bf16x8 v = (bf16x8){0, 0, 0, 0, 0, 0, 0, 0}; if (r > 0 || !seq0) v = *(const bf16x8*)(p.proj + ((size_t)m0 - 1 + r) * IN_W + 1792 + g * 8);
                *(bf16x8*)(VS + r * 1024 + ((g ^ (r & 7)) << 4)) = v; } }
        const int jb = wave & 1, kq = wave >> 1;
        bf16x8 wa[4], wb[4];
#pragma unroll
        for (int ks = 0; ks < 4; ++ks) { const int ko = 128 * kq + 32 * ks + 8 * fq; wa[ks] = *(const bf16x8*)(p.V1T + (size_t)(16 * jb + fr) * C + ko); wb[ks] = *(const bf16x8*)(p.V1B + (size_t)(16 * jb + fr) * C + ko); }
        __syncthreads();
        f32x4 acc[4];
#pragma unroll
        for (int tb = 0; tb < 4; ++tb) { acc[tb] = (f32x4){0.f, 0.f, 0.f, 0.f};
#pragma unroll
            for (int ks = 0; ks < 4; ++ks) { const int g = 4 * (4 * kq + ks) + fq, rp = 16 * tb + fr, rc = rp + 1;
                const bf16x8 cu = *(const bf16x8*)(VS + rc * 1024 + ((g ^ (rc & 7)) << 4)), pv = *(const bf16x8*)(VS + rp * 1024 + ((g ^ (rp & 7)) << 4));
                acc[tb] = __builtin_amdgcn_mfma_f32_16x16x32_bf16(wa[ks], cu, acc[tb], 0, 0, 0); acc[tb] = __builtin_amdgcn_mfma_f32_16x16x32_bf16(wb[ks], pv, acc[tb], 0, 0, 0); } }
        if (kq > 0) {
#pragma unroll
            for (int tb = 0; tb < 4; ++tb) *(f32x4*)(PS + ((kq - 1) * 64 + 16 * tb + fr) * 32 + 16 * jb + 4 * fq) = acc[tb]; }
        __syncthreads();
        if (kq == 0) {
#pragma unroll
            for (int tb = 0; tb < 4; ++tb) { const float* pp = PS + (16 * tb + fr) * 32 + 16 * jb + 4 * fq;
                const f32x4 s = acc[tb] + *(const f32x4*)pp + *(const f32x4*)(pp + 64 * 32) + *(const f32x4*)(pp + 2 * 64 * 32);
                uint2 w; w.x = pg8::cvt_pk_bf16(s[0], s[1]); w.y = pg8::cvt_pk_bf16(s[2], s[3]);
                *(uint2*)(VLO + (16 * tb + fr) * PR_VLO_LD + 16 * jb + 4 * fq) = w; } }
    }
    __syncthreads();
    const int ch0 = 64 * wave;
    if (p.layer > 0) {
        bf16x8 af[4], wf[4]; f32x4 bias[4];
#pragma unroll
        for (int cb = 0; cb < 4; ++cb) { wf[cb] = *(const bf16x8*)(p.V2T + (size_t)(ch0 + 16 * cb + fr) * 32 + 8 * fq); bias[cb] = *(const f32x4*)(p.v0 + ch0 + 16 * cb + 4 * fq); }
#pragma unroll
        for (int tb = 0; tb < 4; ++tb) af[tb] = *(const bf16x8*)(VLO + (16 * tb + fr) * PR_VLO_LD + 8 * fq);
#pragma unroll
        for (int cb = 0; cb < 4; ++cb) { const int ch = ch0 + 16 * cb + 4 * fq;
#pragma unroll
            for (int tb = 0; tb < 4; ++tb) { f32x4 x = __builtin_amdgcn_mfma_f32_16x16x32_bf16(wf[cb], af[tb], (f32x4){0.f, 0.f, 0.f, 0.f}, 0, 0, 0) + bias[cb];
                uint2 w; w.x = pg8::cvt_pk_bf16(sigmoidf_(x[0]), sigmoidf_(x[1])); w.y = pg8::cvt_pk_bf16(sigmoidf_(x[2]), sigmoidf_(x[3]));
                *(uint2*)(SG + (16 * tb + fr) * PR_SG_LD + ch) = w; } }
    }
    {
        f32x4 bw[4], ba[4];
#pragma unroll
        for (int cb = 0; cb < 4; ++cb) { bw[cb] = *(const f32x4*)(p.w0 + ch0 + 16 * cb + 4 * fq); ba[cb] = *(const f32x4*)(p.a0 + ch0 + 16 * cb + 4 * fq); }
        bf16x8 wA[2][4], wB[2][4], wC[4][4];
#define PR_LOADW(wf, WT, KL) _Pragma("unroll") for (int ks = 0; ks < (KL) / 32; ++ks) { _Pragma("unroll") for (int cb = 0; cb < 4; ++cb) wf[ks][cb] = *(const bf16x8*)((WT) + (size_t)(ch0 + 16 * cb + fr) * (KL) + 32 * ks + 8 * fq); }
#define PR_MMA(wf, K0, KL) { _Pragma("unroll") for (int tb = 0; tb < 4; ++tb) { _Pragma("unroll") for (int cb = 0; cb < 4; ++cb) acc[tb][cb] = (f32x4){0.f, 0.f, 0.f, 0.f}; } \
            _Pragma("unroll") for (int ks = 0; ks < (KL) / 32; ++ks) { bf16x8 af[4]; \
                _Pragma("unroll") for (int tb = 0; tb < 4; ++tb) af[tb] = *(const bf16x8*)(ACT + (16 * tb + fr) * PR_ACT_LD + (K0) + 32 * ks + 8 * fq); \
                _Pragma("unroll") for (int tb = 0; tb < 4; ++tb) { _Pragma("unroll") for (int cb = 0; cb < 4; ++cb) acc[tb][cb] = __builtin_amdgcn_mfma_f32_16x16x32_bf16(wf[ks][cb], af[tb], acc[tb][cb], 0, 0, 0); } } }
        f32x4 acc[4][4];
        unsigned char* stg = lds + PR_STG_OFF + wave * PR_STG_WAVE; const int st_w = fr * 144 + 8 * fq, l8 = lane & 7, lr = lane >> 3;
#define PR_WFENCE() { __builtin_amdgcn_fence(__ATOMIC_RELEASE, "wavefront"); __builtin_amdgcn_wave_barrier(); __builtin_amdgcn_fence(__ATOMIC_ACQUIRE, "wavefront"); }
#define PR_FLUSH(OUTP, TB) { PR_WFENCE() _Pragma("unroll") for (int i_ = 0; i_ < 2; ++i_) { const int row_ = lr + 8 * i_; const pg8::u32x4 v_ = *(const pg8::u32x4*)(stg + row_ * 144 + l8 * 16); \
            *(pg8::u32x4*)((OUTP) + ((size_t)m0 + 16 * (TB) + row_) * C + ch0 + l8 * 8) = v_; } PR_WFENCE() }
        PR_LOADW(wA, p.W2T, 64)
        PR_MMA(wA, 0, 64)
        PR_LOADW(wB, p.A2T, 64)
        { f32x4 run[4];
#pragma unroll
          for (int cb = 0; cb < 4; ++cb) run[cb] = (f32x4){0.f, 0.f, 0.f, 0.f};
#pragma unroll
          for (int tb = 0; tb < 4; ++tb) {
#pragma unroll
            for (int cb = 0; cb < 4; ++cb) { f32x4 x = acc[tb][cb] + bw[cb];
#pragma unroll
                for (int e = 0; e < 4; ++e) x[e] = -0.60653065971f * sigmoidf_(x[e]);
                f32x4 s, tot; s.x = scan16(x.x); s.y = scan16(x.y); s.z = scan16(x.z); s.w = scan16(x.w);
                tot.x = reduce16(x.x); tot.y = reduce16(x.y); tot.z = reduce16(x.z); tot.w = reduce16(x.w);
                const f32x4 cq = (s + run[cb]) * -CS_SCALE + 0.5f;
                uint2 w; w.x = (unsigned)fminf(cq.x, 65535.f) | ((unsigned)fminf(cq.y, 65535.f) << 16); w.y = (unsigned)fminf(cq.z, 65535.f) | ((unsigned)fminf(cq.w, 65535.f) << 16);
                *(uint2*)(stg + st_w + 32 * cb) = w; run[cb] = run[cb] + tot; }
            PR_FLUSH(p.CS, tb) } }
        PR_MMA(wB, 64, 64)
        PR_LOADW(wC, p.G2T, 128)
#pragma unroll
        for (int tb = 0; tb < 4; ++tb) {
#pragma unroll
            for (int cb = 0; cb < 4; ++cb) { f32x4 x = acc[tb][cb] + ba[cb];
#pragma unroll
                for (int e = 0; e < 4; ++e) x[e] = sigmoidf_(x[e]);
                uint2 w; w.x = pg8::cvt_pk_bf16(x[0], x[1]); w.y = pg8::cvt_pk_bf16(x[2], x[3]);
                *(uint2*)(stg + st_w + 32 * cb) = w; }
            PR_FLUSH(p.A, tb) }
        PR_MMA(wC, 128, 128)
#pragma unroll
        for (int tb = 0; tb < 4; ++tb) {
#pragma unroll
            for (int cb = 0; cb < 4; ++cb) { const f32x4 x = acc[tb][cb];
                uint2 w; w.x = pg8::cvt_pk_bf16(x[0], x[1]); w.y = pg8::cvt_pk_bf16(x[2], x[3]);
                *(uint2*)(stg + st_w + 32 * cb) = w; }
            PR_FLUSH(p.G, tb) }
#undef PR_FLUSH
#undef PR_WFENCE
#undef PR_LOADW
#undef PR_MMA
    }
    __syncthreads();
    {
        const int cc = tid & 63;
        bf16x8 cu[8], pv[8], vf[8]; const f32x4 mu0 = *(const f32x4*)(p.mu + 1024 + 8 * cc), mu1 = *(const f32x4*)(p.mu + 1024 + 8 * cc + 4);
#pragma unroll
        for (int it = 0; it < 8; ++it) { const int tk = (tid >> 6) + 8 * it; const size_t m = (size_t)m0 + tk; const int t = (int)(m % SEQ); const int col = 768 + 1024 + 8 * cc;
            cu[it] = *(const bf16x8*)(p.proj + m * IN_W + col); if (t > 0) pv[it] = *(const bf16x8*)(p.proj + (m - 1) * IN_W + col); else pv[it] = (bf16x8){0, 0, 0, 0, 0, 0, 0, 0};
            if (p.layer > 0) vf[it] = *(const bf16x8*)(p.vfirst + m * C + 8 * cc); }
#pragma unroll
        for (int it = 0; it < 8; ++it) { const int tk = (tid >> 6) + 8 * it; const size_t m = (size_t)m0 + tk;
            const f32x4 c0 = bfx4_lo(cu[it]), c1 = bfx4_hi(cu[it]);
            f32x4 lo = c0 + (bfx4_lo(pv[it]) - c0) * mu0, hi = c1 + (bfx4_hi(pv[it]) - c1) * mu1;
            const size_t o = m * C + 8 * cc;
            if (p.layer == 0) *(bf16x8*)(p.vfirst + o) = pack8(lo, hi);
            else { const bf16x8 sg = *(const bf16x8*)(SG + tk * PR_SG_LD + 8 * cc);
                lo = lo + (bfx4_lo(vf[it]) - lo) * bfx4_lo(sg); hi = hi + (bfx4_hi(vf[it]) - hi) * bfx4_hi(sg); }
            *(bf16x8*)(p.V + o) = pack8(lo, hi); }
    }
    __syncthreads();
}

constexpr int NTHREADS_ = 512;
constexpr int SC_TB = 32, SC_SLOT = 384, SC_NCH = SEQ / SC_TB;
constexpr size_t WS_RKC = 51 * MiB;
struct ScanArgs { const bf16_t *proj, *V, *A, *G; const unsigned short* CS; const float *k_k, *k_a, *r_k, *lnx_g, *lnx_b; bf16_t* mix; float* rkc; bf16_t* yt; };
constexpr int CK_LD = 72, CK_MAT = 64 * CK_LD * 2;
constexpr size_t WS_YT = WS_SI_LD;
constexpr size_t WS_TSCR = WS_SI_A, TSCR_WG = 2 * 64 * C * 2;
__device__ __forceinline__ void ck_mm(f32x4 (&acc)[2], const bf16_t* Qm, const bf16_t* P, int jb, int ib0, int fr, int fq) {
#pragma unroll
    for (int ks = 0; ks < 2; ++ks) { const bf16x8 bq = *(const bf16x8*)(Qm + (16 * jb + fr) * CK_LD + 32 * ks + 8 * fq);
#pragma unroll
        for (int ii = 0; ii < 2; ++ii) { const bf16x8 ap = *(const bf16x8*)(P + (16 * (ib0 + ii) + fr) * CK_LD + 32 * ks + 8 * fq); acc[ii] = __builtin_amdgcn_mfma_f32_16x16x32_bf16(ap, bq, acc[ii], 0, 0, 0); } }
}
typedef short ck_s16x4 __attribute__((ext_vector_type(4)));
__device__ __forceinline__ bf16x8 ck_tr_frag(const bf16_t* X, int colbase, int ks, int lane) {
    const bf16_t* a0 = X + (32 * ks + 8 * (lane >> 4) + ((lane & 15) >> 2)) * CK_LD + colbase + 4 * (lane & 3);
    const ck_s16x4 lo = __builtin_amdgcn_ds_read_tr16_b64_v4i16((__attribute__((address_space(3))) ck_s16x4*)a0), hi = __builtin_amdgcn_ds_read_tr16_b64_v4i16((__attribute__((address_space(3))) ck_s16x4*)(a0 + 4 * CK_LD));
    return (bf16x8){lo[0], lo[1], lo[2], lo[3], hi[0], hi[1], hi[2], hi[3]};
}
template <bool TQ, bool TP> __device__ __forceinline__ void ck_mm_t(f32x4 (&acc)[2], const bf16_t* Qm, const bf16_t* P, int jb, int ib0, int fr, int fq) {
    const int lane = fq * 16 + fr;
#pragma unroll
    for (int ks = 0; ks < 2; ++ks) { const bf16x8 bq = TQ ? ck_tr_frag(Qm, 16 * jb, ks, lane) : *(const bf16x8*)(Qm + (16 * jb + fr) * CK_LD + 32 * ks + 8 * fq);
#pragma unroll
        for (int ii = 0; ii < 2; ++ii) { const bf16x8 ap = TP ? ck_tr_frag(P, 16 * (ib0 + ii), ks, lane) : *(const bf16x8*)(P + (16 * (ib0 + ii) + fr) * CK_LD + 32 * ks + 8 * fq); acc[ii] = __builtin_amdgcn_mfma_f32_16x16x32_bf16(ap, bq, acc[ii], 0, 0, 0); } }
}
__device__ __forceinline__ uint2 ck_pack4(const f32x4 v) { uint2 w; w.x = pg8::cvt_pk_bf16(v[0], v[1]); w.y = pg8::cvt_pk_bf16(v[2], v[3]); return w; }
__device__ __forceinline__ f32x4 ck_unpack4(const uint2 u) { return (f32x4){__builtin_bit_cast(float, u.x << 16), __builtin_bit_cast(float, u.x & 0xffff0000u), __builtin_bit_cast(float, u.y << 16), __builtin_bit_cast(float, u.y & 0xffff0000u)}; }
struct CkRaw { bf16x8 rc, rp, kc, kp, v, a, cs, cp, cl; };
__device__ __forceinline__ float wave_sum_dpp(float x) {
    x = reduce16(x); const int xi = __builtin_bit_cast(int, x);
    const float r0 = __builtin_bit_cast(float, __builtin_amdgcn_readlane(xi, 0)), r1 = __builtin_bit_cast(float, __builtin_amdgcn_readlane(xi, 16)), r2 = __builtin_bit_cast(float, __builtin_amdgcn_readlane(xi, 32)), r3 = __builtin_bit_cast(float, __builtin_amdgcn_readlane(xi, 48));
    return (r0 + r1) + (r2 + r3); }
__device__ __forceinline__ void ck_load(const ScanArgs& p, CkRaw& w, int unit, int tid) {
    const int chain = unit >> 6, chunk = unit & 63, b = chain >> 3, h = chain & 7, tk = tid >> 3, hc = h * 64 + (tid & 7) * 8;
    const size_t row = (size_t)b * SEQ + chunk * 64 + tk, o = row * C + hc;
    const bf16_t* pr = p.proj + row * IN_W + 768 + hc; const bf16x8 z8 = (bf16x8){0, 0, 0, 0, 0, 0, 0, 0};
    w.rc = *(const bf16x8*)pr; w.kc = *(const bf16x8*)(pr + 512);
    if (chunk * 64 + tk > 0) { w.rp = *(const bf16x8*)(pr - IN_W); w.kp = *(const bf16x8*)(pr - IN_W + 512); } else { w.rp = z8; w.kp = z8; }
    w.v = *(const bf16x8*)(p.V + o); w.a = *(const bf16x8*)(p.A + o);
    w.cs = *(const bf16x8*)(p.CS + o); if (tk > 0) w.cp = *(const bf16x8*)(p.CS + o - C); else w.cp = z8;
    w.cl = *(const bf16x8*)(p.CS + (row - tk + 63) * C + hc);
}
__device__ __forceinline__ f32x4 csq_lo(const bf16x8 v) { return (f32x4){(float)(unsigned short)v[0], (float)(unsigned short)v[1], (float)(unsigned short)v[2], (float)(unsigned short)v[3]} * (-1.f / CS_SCALE); }
__device__ __forceinline__ f32x4 csq_hi(const bf16x8 v) { return (f32x4){(float)(unsigned short)v[4], (float)(unsigned short)v[5], (float)(unsigned short)v[6], (float)(unsigned short)v[7]} * (-1.f / CS_SCALE); }
__device__ __forceinline__ f32x4 exp4(const f32x4 v) { return (f32x4){__expf(v[0]), __expf(v[1]), __expf(v[2]), __expf(v[3])}; }
constexpr int CK_CONST_OFF = 136192;
__device__ __forceinline__ void ck_precompute(const ScanArgs& p, const CkRaw& raw, CkRaw& nxt, int next_unit, unsigned char* lds, bf16_t* GQ, bf16_t* CQ, int unit, int tid) {
    const int chain = unit >> 6, chunk = unit & 63, b = chain >> 3, h = chain & 7, wave = __builtin_amdgcn_readfirstlane(tid >> 6), lane = tid & 63, fr = lane & 15, fq = lane >> 4, jb = wave >> 1, ib0 = 2 * (wave & 1);
    bf16_t* At = (bf16_t*)(lds + 0 * CK_MAT); bf16_t* bt = (bf16_t*)(lds + 1 * CK_MAT); bf16_t* kt = (bf16_t*)(lds + 2 * CK_MAT); bf16_t* rt = (bf16_t*)(lds + 3 * CK_MAT);
    bf16_t* AtT = (bf16_t*)(lds + 4 * CK_MAT); bf16_t* BhT = (bf16_t*)(lds + 5 * CK_MAT); bf16_t* KhT = (bf16_t*)(lds + 6 * CK_MAT); bf16_t* VT = (bf16_t*)(lds + 7 * CK_MAT);
    bf16_t* NT = (bf16_t*)(lds + 8 * CK_MAT); bf16_t* Mm = (bf16_t*)(lds + 9 * CK_MAT); bf16_t* P1 = (bf16_t*)(lds + 10 * CK_MAT); bf16_t* P2 = (bf16_t*)(lds + 11 * CK_MAT);
    bf16_t* Ta = (bf16_t*)(lds + 12 * CK_MAT); bf16_t* Tb = (bf16_t*)(lds + 13 * CK_MAT); float* WT = (float*)(lds + 14 * CK_MAT); float* GL = WT + 512;
    bf16_t* W1T = bt; bf16_t* MVT = kt; bf16_t* W2T = At;
    {
        const int tk = tid >> 3, c8 = (tid & 7) * 8, ro = tk * CK_LD + c8;
        bf16_t* BhR = BhT; bf16_t* KhR = KhT; bf16_t* VR = VT;
        const float* KC = (const float*)(lds + CK_CONST_OFF) + h * 64 + c8;
        const f32x4 kc0 = *(const f32x4*)KC, kc1 = *(const f32x4*)(KC + 4), ac0 = *(const f32x4*)(KC + 512), ac1 = *(const f32x4*)(KC + 516), rc0 = *(const f32x4*)(KC + 1024), rc1 = *(const f32x4*)(KC + 1028), mu0 = *(const f32x4*)(KC + 1536), mu1 = *(const f32x4*)(KC + 1540);
        const f32x4 mk0 = *(const f32x4*)(KC + 2048), mk1 = *(const f32x4*)(KC + 2052);
        const f32x4 x0 = bfx4_lo(raw.rc), x1 = bfx4_hi(raw.rc); const f32x4 r0 = x0 + (bfx4_lo(raw.rp) - x0) * mu0, r1 = x1 + (bfx4_hi(raw.rp) - x1) * mu1;
        const f32x4 y0 = bfx4_lo(raw.kc), y1 = bfx4_hi(raw.kc); const f32x4 k0 = y0 + (bfx4_lo(raw.kp) - y0) * mk0, k1 = y1 + (bfx4_hi(raw.kp) - y1) * mk1;
        const f32x4 a0 = bfx4_lo(raw.a), a1 = bfx4_hi(raw.a);
        const f32x4 c0 = csq_lo(raw.cs), c1 = csq_hi(raw.cs), p0 = csq_lo(raw.cp), p1 = csq_hi(raw.cp), l0 = csq_lo(raw.cl), l1 = csq_hi(raw.cl);
        f32x4 q0 = k0 * kc0, q1 = k1 * kc1;
        const f32x4 qq = q0 * q0 + q1 * q1; const float nrm = red8((qq.x + qq.y) + (qq.z + qq.w));
        const float inv = fminf(__builtin_amdgcn_rsqf(nrm), 1e12f); q0 = q0 * inv; q1 = q1 * inv;
        const f32x4 kp0 = k0 * (1.f + (a0 - 1.f) * ac0), kp1 = k1 * (1.f + (a1 - 1.f) * ac1);
        const f32x4 rr = r0 * kp0 * rc0 + r1 * kp1 * rc1; const float rkc = red8((rr.x + rr.y) + (rr.z + rr.w));
        if ((tid & 7) == 0) p.rkc[((size_t)b * SEQ + chunk * 64 + tk) * 8 + h] = rkc;
        const f32x4 em0 = exp4(p0), em1 = exp4(p1), en0 = exp4(-c0), en1 = exp4(-c1), ep0 = exp4(c0), ep1 = exp4(c1), eL0 = exp4(l0 - c0), eL1 = exp4(l1 - c1);
        const f32x4 b0 = q0 * a0, b1 = q1 * a1;
        *(bf16x8*)(At + ro) = pack8(-q0 * em0, -q1 * em1); *(bf16x8*)(bt + ro) = pack8(b0 * en0, b1 * en1); *(bf16x8*)(kt + ro) = pack8(kp0 * en0, kp1 * en1); *(bf16x8*)(rt + ro) = pack8(r0 * ep0, r1 * ep1);
        *(bf16x8*)(BhR + ro) = pack8(b0 * eL0, b1 * eL1); *(bf16x8*)(KhR + ro) = pack8(kp0 * eL0, kp1 * eL1); *(bf16x8*)(VR + ro) = raw.v;
        if (tk == 0) { *(f32x4*)(GL + c8) = exp4(l0); *(f32x4*)(GL + c8 + 4) = exp4(l1); }
    }
    __syncthreads();
    const int j = 16 * jb + fr; const f32x4 z4 = (f32x4){0.f, 0.f, 0.f, 0.f};
    { f32x4 aN[2] = {z4, z4}, aM[2] = {z4, z4}, aP1[2] = {z4, z4}, aP2[2] = {z4, z4};
      ck_mm(aN, At, bt, jb, ib0, fr, fq); ck_mm(aM, At, kt, jb, ib0, fr, fq); ck_mm(aP1, rt, bt, jb, ib0, fr, fq); ck_mm(aP2, rt, kt, jb, ib0, fr, fq);
#pragma unroll
      for (int ii = 0; ii < 2; ++ii) { const int i0 = 16 * (ib0 + ii) + 4 * fq; f32x4 t0, nt, mm, p1, p2;
#pragma unroll
          for (int e = 0; e < 4; ++e) { const int i = i0 + e; nt[e] = i < j ? aN[ii][e] : 0.f; t0[e] = nt[e] + (i == j ? 1.f : 0.f); mm[e] = i < j ? aM[ii][e] : 0.f; p1[e] = i <= j ? aP1[ii][e] : 0.f; p2[e] = i <= j ? aP2[ii][e] : 0.f; }
          *(uint2*)(Ta + j * CK_LD + i0) = ck_pack4(t0); *(uint2*)(NT + j * CK_LD + i0) = ck_pack4(nt); *(uint2*)(Mm + j * CK_LD + i0) = ck_pack4(mm); *(uint2*)(P1 + j * CK_LD + i0) = ck_pack4(p1); *(uint2*)(P2 + j * CK_LD + i0) = ck_pack4(p2); } }
    __syncthreads();
#pragma unroll
    for (int st = 0; st < 3; ++st) { const bf16_t* src = (st & 1) ? Tb : Ta; bf16_t* dst = (st & 1) ? Ta : Tb; f32x4 a2[2] = {z4, z4}; ck_mm_t<false, true>(a2, src, NT, jb, ib0, fr, fq);
#pragma unroll
        for (int ii = 0; ii < 2; ++ii) { const int i0 = 16 * (ib0 + ii) + 4 * fq; f32x4 t = a2[ii];
#pragma unroll
            for (int e = 0; e < 4; ++e) t[e] += (i0 + e == j) ? 1.f : 0.f;
            *(uint2*)(dst + j * CK_LD + i0) = ck_pack4(t); }
        __syncthreads(); }
    { f32x4 a1[2] = {z4, z4}, a2[2] = {z4, z4}; ck_mm_t<true, false>(a1, At, Tb, jb, ib0, fr, fq); ck_mm_t<true, false>(a2, VT, Mm, jb, ib0, fr, fq);
#pragma unroll
      for (int ii = 0; ii < 2; ++ii) { const int i0 = 16 * (ib0 + ii) + 4 * fq; *(uint2*)(W1T + j * CK_LD + i0) = ck_pack4(a1[ii]); *(uint2*)(MVT + j * CK_LD + i0) = ck_pack4(a2[ii]); } }
    __syncthreads();
    { f32x4 a1[2] = {z4, z4}; ck_mm(a1, MVT, Tb, jb, ib0, fr, fq);
#pragma unroll
      for (int ii = 0; ii < 2; ++ii) { const int i0 = 16 * (ib0 + ii) + 4 * fq; *(uint2*)(W2T + j * CK_LD + i0) = ck_pack4(a1[ii]); } }
    __syncthreads();
    ck_load(p, nxt, next_unit, tid);
    { f32x4 aQ1[2] = {z4, z4}, aG[2] = {z4, z4}, aQ2[2] = {z4, z4}, aC[2] = {z4, z4};
      ck_mm(aQ1, P1, W1T, jb, ib0, fr, fq); ck_mm_t<true, false>(aG, BhT, W1T, jb, ib0, fr, fq); ck_mm(aQ2, P1, W2T, jb, ib0, fr, fq); ck_mm_t<false, true>(aQ2, P2, VT, jb, ib0, fr, fq); ck_mm_t<false, true>(aC, W2T, BhT, jb, ib0, fr, fq); ck_mm_t<true, true>(aC, VT, KhT, jb, ib0, fr, fq);
      bf16_t* gq = GQ + (size_t)unit * 8192; bf16_t* cq = CQ + (size_t)unit * 8192; const float glj = GL[j];
#pragma unroll
      for (int ii = 0; ii < 2; ++ii) { const int i0 = 16 * (ib0 + ii) + 4 * fq; f32x4 g = aG[ii];
#pragma unroll
          for (int e = 0; e < 4; ++e) g[e] += (i0 + e == j) ? glj : 0.f;
          const f32x4 q1 = aQ1[ii] + ck_unpack4(*(const uint2*)(rt + j * CK_LD + i0));
          *(uint2*)(AtT + j * CK_LD + i0) = ck_pack4(g); *(uint2*)(NT + j * CK_LD + i0) = ck_pack4(q1); *(uint2*)(Mm + j * CK_LD + i0) = ck_pack4(aC[ii]); *(uint2*)(Ta + j * CK_LD + i0) = ck_pack4(aQ2[ii]); }
      __syncthreads();
      { const int row = tid >> 3, c8 = (tid & 7) * 8, lo_ = row * CK_LD + c8, go_ = row * 64 + c8;
        const pg8::u32x4 v0 = *(const pg8::u32x4*)(AtT + lo_), v1 = *(const pg8::u32x4*)(NT + lo_), v2 = *(const pg8::u32x4*)(Mm + lo_), v3 = *(const pg8::u32x4*)(Ta + lo_);
        *(pg8::u32x4*)(gq + go_) = v0; *(pg8::u32x4*)(gq + 4096 + go_) = v1; { const int bo_ = (c8 >> 4) * 1024 + row * 16 + (c8 & 15);
          *(pg8::u32x4*)(cq + bo_) = v2; *(pg8::u32x4*)(cq + 4096 + bo_) = v3; } } }
    if (next_unit == unit) __syncthreads();
}
__device__ __forceinline__ void ck_sequential(const ScanArgs& p, unsigned char* lds, const bf16_t* GQ, const bf16_t* CQ, int item, int tid) {
    const int chain = item >> 2, q = item & 3, b = chain >> 3, h = chain & 7, wave = __builtin_amdgcn_readfirstlane(tid >> 6), lane = tid & 63, fr = lane & 15, fq = lane >> 4;
    bf16_t* OPS = (bf16_t*)lds;
    bf16_t* HT = (bf16_t*)(lds + 4 * CK_MAT);
    for (int i = tid; i < 2 * 16 * CK_LD / 2; i += NTHREADS_) ((unsigned*)HT)[i] = 0u;
    const size_t ubase = (size_t)chain * 64; const size_t rowbase = (size_t)b * SEQ;
    const int prow0 = tid >> 3, pcol = (tid & 7) * 8;
    const int aoff = wave < 4 ? (4096 + q * 1024 + (16 * wave + fr) * 16 + 4 * fq) : ((wave - 4) * 1024 + (16 * q + fr) * 16 + 4 * fq);
    typedef unsigned u32x2_ __attribute__((ext_vector_type(2)));
    pg8::u32x4 g0_0, g0_1, g0_2, g0_3, g0_4, g0_5, g0_6, g0_7, g1_0, g1_1, g1_2, g1_3, g1_4, g1_5, g1_6, g1_7; u32x2_ ad_0, ad_1, ad_2, ad_3, ad_4, ad_5, ad_6, ad_7;
#define CK_FETCH(slot, cc) do { const int c_ = (cc) < 64 ? (cc) : 63;     \
        const bf16_t* gq = GQ + (ubase + c_) * 8192; g0_##slot = *(const pg8::u32x4*)(gq + (size_t)prow0 * 64 + pcol); g1_##slot = *(const pg8::u32x4*)(gq + (size_t)(prow0 + 64) * 64 + pcol); \
        ad_##slot = *(const u32x2_*)(CQ + (ubase + c_) * 8192 + aoff); } while (0)
#define CK_STAGE(slot, buf) do { *(pg8::u32x4*)(OPS + (buf) * 2 * 64 * CK_LD + prow0 * CK_LD + pcol) = g0_##slot; *(pg8::u32x4*)(OPS + (buf) * 2 * 64 * CK_LD + 64 * CK_LD + prow0 * CK_LD + pcol) = g1_##slot; } while (0)
    CK_FETCH(0, 0); CK_FETCH(1, 1); CK_FETCH(2, 2); CK_FETCH(3, 3); CK_FETCH(4, 4); CK_FETCH(5, 5); CK_FETCH(6, 6); CK_FETCH(7, 7);
    CK_STAGE(0, 0);
    __syncthreads();
#define CK_STEP(cc, slot, nslot) do { const int bi = (cc) & 1; const bf16_t* Gm = OPS + bi * 2 * 64 * CK_LD; const bf16_t* Q1m = Gm + 64 * CK_LD; const bf16_t* HTc = HT + bi * 16 * CK_LD; bf16_t* HTn = HT + (bi ^ 1) * 16 * CK_LD; \
        f32x4 acc = (f32x4){0.f, 0.f, 0.f, 0.f}; \
        if (wave < 4) { _Pragma("unroll") for (int ks = 0; ks < 2; ++ks) acc = __builtin_amdgcn_mfma_f32_16x16x32_bf16(*(const bf16x8*)(HTc + fr * CK_LD + 32 * ks + 8 * fq), *(const bf16x8*)(Q1m + (16 * wave + fr) * CK_LD + 32 * ks + 8 * fq), acc, 0, 0, 0); \
            acc = acc + ck_unpack4((uint2){ad_##slot.x, ad_##slot.y}); \
            *(uint2*)(p.yt + ((((size_t)chain * 64 + (cc)) * 4 + q) * 64 + 16 * wave + fr) * 16 + 4 * fq) = ck_pack4(acc); } \
        else { _Pragma("unroll") for (int ks = 0; ks < 2; ++ks) acc = __builtin_amdgcn_mfma_f32_16x16x32_bf16(*(const bf16x8*)(Gm + (16 * (wave - 4) + fr) * CK_LD + 32 * ks + 8 * fq), *(const bf16x8*)(HTc + fr * CK_LD + 32 * ks + 8 * fq), acc, 0, 0, 0); \
            acc = acc + ck_unpack4((uint2){ad_##slot.x, ad_##slot.y}); \
            *(uint2*)(HTn + fr * CK_LD + 16 * (wave - 4) + 4 * fq) = ck_pack4(acc); } \
        CK_STAGE(nslot, bi ^ 1); \
        CK_FETCH(slot, (cc) + 8); \
        __syncthreads(); } while (0)
    for (int c = 0; c < 64; c += 8) { CK_STEP(c, 0, 1); CK_STEP(c + 1, 1, 2); CK_STEP(c + 2, 2, 3); CK_STEP(c + 3, 3, 4); CK_STEP(c + 4, 4, 5); CK_STEP(c + 5, 5, 6); CK_STEP(c + 6, 6, 7); CK_STEP(c + 7, 7, 0); }
#undef CK_FETCH
#undef CK_STAGE
#undef CK_STEP
}

struct PostRaw { bf16x8 y, v, g; float rk; f32x4 lg0, lg1, lb0, lb1; };
__device__ __forceinline__ void scan_post_load(const ScanArgs& p, PostRaw& w, int item, int lane) {
    const int tg = item & 7, chunk = (item >> 3) & 63, chain = item >> 9, b = chain >> 3, h = chain & 7, tl = lane >> 3, j = lane & 7, t = 8 * tg + tl;
    const size_t m = (size_t)b * SEQ + chunk * 64 + t;
    w.y = *(const bf16x8*)(p.yt + ((((size_t)chain * 64 + chunk) * 4 + (j >> 1)) * 64 + t) * 16 + (j & 1) * 8);
    w.v = *(const bf16x8*)(p.V + m * C + h * 64 + 8 * j); w.g = *(const bf16x8*)(p.G + m * C + h * 64 + 8 * j); w.rk = p.rkc[m * 8 + h];
    const float* lp = p.lnx_g + h * 64 + 8 * j; const float* bp = p.lnx_b + h * 64 + 8 * j;
    w.lg0 = *(const f32x4*)lp; w.lg1 = *(const f32x4*)(lp + 4); w.lb0 = *(const f32x4*)bp; w.lb1 = *(const f32x4*)(bp + 4);
}
__device__ __forceinline__ void scan_post_item(const ScanArgs& p, const PostRaw& w, int item, int lane) {
    const int tg = item & 7, chunk = (item >> 3) & 63, chain = item >> 9, b = chain >> 3, h = chain & 7, tl = lane >> 3, j = lane & 7;
    const size_t m = (size_t)b * SEQ + chunk * 64 + 8 * tg + tl;
    f32x4 y0 = bfx4_lo(w.y), y1 = bfx4_hi(w.y);
    const float mean = red8((y0.x + y0.y) + (y0.z + y0.w) + (y1.x + y1.y) + (y1.z + y1.w)) * (1.f / 64.f);
    y0 = y0 - mean; y1 = y1 - mean;
    const float var = red8((y0.x * y0.x + y0.y * y0.y) + (y0.z * y0.z + y0.w * y0.w) + (y1.x * y1.x + y1.y * y1.y) + (y1.z * y1.z + y1.w * y1.w)) * (1.f / 64.f);
    const float rs = rsqrtf(var + LNX_EPS);
    const f32x4 o0 = (y0 * rs * w.lg0 + w.lb0 + bfx4_lo(w.v) * w.rk) * bfx4_lo(w.g), o1 = (y1 * rs * w.lg1 + w.lb1 + bfx4_hi(w.v) * w.rk) * bfx4_hi(w.g);
    *(bf16x8*)(p.mix + m * D + ATT_W + h * 64 + 8 * j) = pack8(o0, o1);
}
__device__ __forceinline__ void scan_post_wave(const ScanArgs& p, int gw, int ngw, int lane) {
    constexpr int NITEM = BATCH * NH * 64 * 8;
    int item = gw; if (item >= NITEM) return;
    PostRaw cur; scan_post_load(p, cur, item, lane);
    for (; item < NITEM; item += ngw) { PostRaw nxt = cur; if (item + ngw < NITEM) scan_post_load(p, nxt, item + ngw, lane);
        scan_post_item(p, cur, item, lane); cur = nxt; }
}

typedef float f32x16 __attribute__((ext_vector_type(16)));
typedef short s16x4 __attribute__((ext_vector_type(4)));
constexpr int AT_VLD = 96;
__device__ __forceinline__ int crow(int r, int hi) { return (r & 3) + 8 * (r >> 2) + 4 * hi; }
constexpr int AT_KLD = 72;
__device__ __forceinline__ void attn_phase(const bf16_t* __restrict__ proj, const float* __restrict__ sinks, bf16_t* __restrict__ mix, unsigned char* lds, int G, int tid) {
    bf16_t* ks_ = (bf16_t*)lds; bf16_t* vs_ = (bf16_t*)(lds + 192 * AT_KLD * 2);
    const int g = __builtin_amdgcn_readfirstlane(tid >> 7), half = __builtin_amdgcn_readfirstlane((tid >> 6) & 1);
    constexpr int NU = BATCH * 2 * (SEQ / 64);
    bf16x8 pk0, pk1, pk2, pv0, pv1, pv2, pq0, pq1, pq2, pq3;
#define AT_PIECE(it, kdst, vdst, un) do { const int i_ = tq + 512 * (it), kl_ = i_ >> 3, ch8_ = i_ & 7; int key_ = ((un) & 63) * 64 - 128 + kl_; key_ = key_ < 0 ? 0 : key_;     \
        const bf16_t* rp_ = proj + ((size_t)((un) >> 7) * SEQ + key_) * IN_W + 512 + (((un) >> 6) & 1) * 64 + ch8_ * 8; kdst = *(const bf16x8*)rp_; vdst = *(const bf16x8*)(rp_ + KV_W); } while (0)
#define AT_FETCH(un) do { AT_PIECE(0, pk0, pv0, un); AT_PIECE(1, pk1, pv1, un); AT_PIECE(2, pk2, pv2, un); \
        { const int l_ = tq & 63; const bf16_t* qp_ = proj + ((size_t)((un) >> 7) * SEQ + ((un) & 63) * 64 + 32 * half + (l_ & 31)) * IN_W + ((((un) >> 6) & 1) * 4 + g) * 64 + 8 * (l_ >> 5); \
          pq0 = *(const bf16x8*)qp_; pq1 = *(const bf16x8*)(qp_ + 16); pq2 = *(const bf16x8*)(qp_ + 32); pq3 = *(const bf16x8*)(qp_ + 48); } } while (0)
#define AT_STAGE(it, ksrc, vsrc) do { const int i_ = tq + 512 * (it), kl_ = i_ >> 3, ch8_ = i_ & 7; *(bf16x8*)(ks_ + kl_ * AT_KLD + ch8_ * 8) = ksrc; *(bf16x8*)(vs_ + kl_ * AT_VLD + ch8_ * 8) = vsrc; } while (0)
    int tq = tid; int unit = blockIdx.x; if (unit < NU) AT_FETCH(unit);
    for (; unit < NU; unit += G) {
        const int b = unit >> 7, kvh = (unit >> 6) & 1, qb = unit & 63, Q0 = qb * 64, h = kvh * 4 + g; const size_t rowb = (size_t)b * SEQ;
        asm volatile("" : "+v"(tq));
        const int lane = tq & 63, c = lane & 31, hi = lane >> 5;
        AT_STAGE(0, pk0, pv0); AT_STAGE(1, pk1, pv1); AT_STAGE(2, pk2, pv2);
        const bf16x8 qf[4] = {pq0, pq1, pq2, pq3};
        __syncthreads();
        if (unit + G < NU) AT_FETCH(unit + G);
        const int t0 = Q0 + 32 * half; const size_t mq = rowb + t0 + c;
        f32x16 p[5];
#pragma unroll
        for (int kb = 0; kb < 5; ++kb) { const bf16_t* kp = ks_ + (32 * half + 32 * kb + c) * AT_KLD + 8 * hi;
            f32x16 acc;
#pragma unroll
            for (int r = 0; r < 16; ++r) acc[r] = 0.f;
#pragma unroll
            for (int ks = 0; ks < 4; ++ks) acc = __builtin_amdgcn_mfma_f32_32x32x16_bf16(*(const bf16x8*)(kp + 16 * ks), qf[ks], acc, 0, 0, 0);
            p[kb] = acc; }
        const float slope = exp2f(-(float)(h + 1)) * 1.44269504089f, sink = sinks[h] * 1.44269504089f;
        float mx = sink;
        const float bl = -slope * (float)(c + 128 - 4 * hi);
        const bool seq_start = (t0 < 128);
#pragma unroll
        for (int kb = 0; kb < 5; ++kb)
#pragma unroll
            for (int r = 0; r < 16; ++r) { const int cr0 = (r & 3) + 8 * (r >> 2), cr = cr0 + 4 * hi;
                float sc = p[kb][r] * (0.125f * 1.44269504089f) + (bl + slope * (float)(32 * kb + cr0));
                if (kb == 0) sc = (cr > c) ? sc : -1e30f;
                if (kb == 4) sc = (cr <= c) ? sc : -1e30f;
                if (seq_start) sc = (t0 - 128 + 32 * kb + cr >= 0) ? sc : -1e30f;
                p[kb][r] = sc; mx = fmaxf(mx, sc); }
        mx = fmaxf(mx, __shfl_xor(mx, 32));
        float l = 0.f;
#pragma unroll
        for (int kb = 0; kb < 5; ++kb)
#pragma unroll
            for (int r = 0; r < 16; ++r) { const float e = __builtin_amdgcn_exp2f(p[kb][r] - mx); p[kb][r] = e; l += e; }
        l += __shfl_xor(l, 32); l += __builtin_amdgcn_exp2f(sink - mx);
        f32x16 o[2];
#pragma unroll
        for (int d = 0; d < 2; ++d)
#pragma unroll
            for (int r = 0; r < 16; ++r) o[d][r] = 0.f;
#pragma unroll
        for (int kb = 0; kb < 5; ++kb)
#pragma unroll
            for (int s2 = 0; s2 < 2; ++s2) {
                pg8::u32x4 pw; pw.x = pg8::cvt_pk_bf16(p[kb][8 * s2 + 0], p[kb][8 * s2 + 1]); pw.y = pg8::cvt_pk_bf16(p[kb][8 * s2 + 2], p[kb][8 * s2 + 3]);
                pw.z = pg8::cvt_pk_bf16(p[kb][8 * s2 + 4], p[kb][8 * s2 + 5]); pw.w = pg8::cvt_pk_bf16(p[kb][8 * s2 + 6], p[kb][8 * s2 + 7]);
                const bf16x8 pf = __builtin_bit_cast(bf16x8, pw);
#pragma unroll
                for (int d = 0; d < 2; ++d) {
                    const bf16_t* vp = vs_ + (32 * half + 32 * kb + 16 * s2 + 4 * hi + ((lane & 15) >> 2)) * AT_VLD + 32 * d + 16 * ((lane >> 4) & 1) + 4 * (lane & 3);
                    const s16x4 lo = __builtin_amdgcn_ds_read_tr16_b64_v4i16((__attribute__((address_space(3))) s16x4*)vp), hh = __builtin_amdgcn_ds_read_tr16_b64_v4i16((__attribute__((address_space(3))) s16x4*)(vp + 8 * AT_VLD));
                    const bf16x8 vf = (bf16x8){lo[0], lo[1], lo[2], lo[3], hh[0], hh[1], hh[2], hh[3]};
                    o[d] = __builtin_amdgcn_mfma_f32_32x32x16_bf16(vf, pf, o[d], 0, 0, 0); } }
        const float inv = __builtin_amdgcn_rcpf(l);
#pragma unroll
        for (int d = 0; d < 2; ++d)
#pragma unroll
            for (int rp = 0; rp < 2; ++rp) {
                unsigned ax = pg8::cvt_pk_bf16(o[d][8 * rp] * inv, o[d][8 * rp + 1] * inv), ay = pg8::cvt_pk_bf16(o[d][8 * rp + 2] * inv, o[d][8 * rp + 3] * inv);
                unsigned bx = pg8::cvt_pk_bf16(o[d][8 * rp + 4] * inv, o[d][8 * rp + 5] * inv), by = pg8::cvt_pk_bf16(o[d][8 * rp + 6] * inv, o[d][8 * rp + 7] * inv);
                const auto r0 = __builtin_amdgcn_permlane32_swap(ax, bx, false, false); const auto r1 = __builtin_amdgcn_permlane32_swap(ay, by, false, false);
                pg8::u32x4 w; w.x = r0[0]; w.y = r1[0]; w.z = r0[1]; w.w = r1[1];
                *(pg8::u32x4*)(mix + mq * D + h * 64 + 32 * d + 16 * rp + 8 * hi) = w; }
        __syncthreads();
    }
#undef AT_PIECE
#undef AT_FETCH
#undef AT_STAGE
}

__device__ __forceinline__ void ffn_fixup(const float* __restrict__ SB, const float* __restrict__ cw, const float* __restrict__ cb, bf16_t* hid, int pm, int tid) {
    pm = __builtin_amdgcn_readfirstlane(pm);
    const float* s = SB + (size_t)pm * 6 * FF; const float* sp = SB + (size_t)(pm - 1) * 6 * FF; const bool has_prev = (pm % (SEQ / 256)) != 0;
    static_assert(2 * FF == 11 * NTHREADS_, "ffn_fixup: 11 items per thread");
    float u0[11], u1[11], ul0[11], ul1[11], w0[11], w1[11], w2[11], bb[11], up[11];
#pragma unroll
    for (int it = 0; it < 11; ++it) { const int idx = tid + NTHREADS_ * it, rr = idx >= FF ? 1 : 0, j = idx - rr * FF;
        u0[it] = s[j]; u1[it] = s[FF + j]; ul0[it] = has_prev ? sp[4 * FF + j] : 0.f; ul1[it] = has_prev ? sp[5 * FF + j] : 0.f;
        w0[it] = cw[j]; w1[it] = cw[FF + j]; w2[it] = cw[2 * FF + j]; bb[it] = cb[j]; up[it] = s[(2 + rr) * FF + j]; }
#pragma unroll
    for (int it = 0; it < 11; ++it) { const int idx = tid + NTHREADS_ * it, rr = idx >= FF ? 1 : 0, j = idx - rr * FF;
        const float c = rr == 0 ? bb[it] + w0[it] * ul0[it] + w1[it] * ul1[it] + w2[it] * u0[it] : bb[it] + w0[it] * ul1[it] + w1[it] * u0[it] + w2[it] * u1[it];
        hid[(size_t)(pm * 256 + rr) * FF + j] = (bf16_t)f2bf(c * sigmoidf_(c) * up[it]); }
}

#define XB_TMO      128
#define XB_XCNT(j)  (256  + 64 * (j))
#define XB_XSUB(j)  (1280 + 64 * (j))
#define XB_XGEN(j)  (2304 + 64 * (j))
#define XB_TOP      3328
#define XB_TOPGEN   3392
#define XCD_BAR_WORDS 3456
#define XB_SPIN_CAP (1u << 18)

__device__ __forceinline__ unsigned xb_ld(unsigned* p)              { return __hip_atomic_load(p, __ATOMIC_RELAXED, __HIP_MEMORY_SCOPE_AGENT); }
__device__ __forceinline__ unsigned xb_add(unsigned* p, unsigned v) { return __hip_atomic_fetch_add(p, v, __ATOMIC_RELAXED, __HIP_MEMORY_SCOPE_AGENT); }
__device__ __forceinline__ unsigned xb_xcc_id() { return (unsigned)__builtin_amdgcn_s_getreg((3 << 11) | 20) & 0xFu; }
#define XB_SPIN(cond, bar) do { unsigned _sp = 0; while (cond) { __builtin_amdgcn_s_sleep(1); \
    if ((++_sp & 255u) == 0u) { if (xb_ld(&(bar)[XB_TMO])) break; if (_sp > XB_SPIN_CAP) { atomicAdd(&(bar)[XB_TMO], 1u); break; } } } } while (0)

struct XcdBarrier {
    unsigned* bar; unsigned x;
    volatile __attribute__((address_space(3))) unsigned* st;
};

__device__ __forceinline__ XcdBarrier xcd_barrier_post(unsigned* bar, volatile __attribute__((address_space(3))) unsigned* st) {
    XcdBarrier b; b.bar = bar; b.x = xb_xcc_id(); b.st = st;
    if (threadIdx.x == 0) (void)xb_add(&bar[XB_XCNT(b.x)], 1u);
    return b;
}
__device__ __forceinline__ void xcd_barrier_complete(unsigned* bar, unsigned x, unsigned& nloc, unsigned& nx) {
    const unsigned G = gridDim.x * gridDim.y * gridDim.z;
    unsigned sum, cnt, mine, sp = 0u;
    for (;;) {
        sum = 0u; cnt = 0u; mine = 0u;
#pragma unroll
        for (unsigned j = 0; j < 16; ++j) { const unsigned c = xb_ld(&bar[XB_XCNT(j)]); sum += c; cnt += (c > 0u) ? 1u : 0u; mine = (j == x) ? c : mine; }
        if (sum == G) break;
        __builtin_amdgcn_s_sleep(1);
        if ((++sp & 255u) == 0u) { if (xb_ld(&bar[XB_TMO])) break; if (sp > XB_SPIN_CAP) { atomicAdd(&bar[XB_TMO], 1u); break; } }
    }
    nloc = mine > 0u ? mine : 1u; nx = cnt > 0u ? cnt : 1u;
}

__device__ __forceinline__ void xcd_barrier(const XcdBarrier& b) {
    asm volatile("s_waitcnt vmcnt(0)" ::: "memory");
    __syncthreads();
    if (threadIdx.x == 0) {
        unsigned* bar = b.bar;
        __builtin_amdgcn_s_waitcnt(0);
        unsigned nloc = b.st[0], nx = b.st[1];
        if (nloc == 0u) { xcd_barrier_complete(bar, b.x, nloc, nx); b.st[0] = nloc; b.st[1] = nx; }
        const unsigned old = xb_add(&bar[XB_XSUB(b.x)], 1u);
        const unsigned gen = old / nloc;
        if (old + 1u == (gen + 1u) * nloc) {
            __builtin_amdgcn_fence(__ATOMIC_RELEASE, "agent");
            asm volatile("s_waitcnt vmcnt(0)" ::: "memory");
            const unsigned og = xb_add(&bar[XB_TOP], 1u);
            const unsigned tg = og / nx;
            if (og + 1u == (tg + 1u) * nx) xb_add(&bar[XB_TOPGEN], 1u);
            else XB_SPIN(xb_ld(&bar[XB_TOPGEN]) == tg, bar);
            __builtin_amdgcn_fence(__ATOMIC_ACQUIRE, "agent");
            xb_add(&bar[XB_XGEN(b.x)], 1u);
            asm volatile("s_waitcnt vmcnt(0)" ::: "memory");
        } else {
            XB_SPIN(xb_ld(&bar[XB_XGEN(b.x)]) == gen, bar);
            __builtin_amdgcn_fence(__ATOMIC_ACQUIRE, "agent");
            asm volatile("s_waitcnt vmcnt(0)" ::: "memory");
        }
    }
    __syncthreads();
}

constexpr int NTHREADS = 512, LDS_BYTES = 147456;
struct Args { const float* in[26]; float* out; unsigned char* ws; };
__global__ void __launch_bounds__(NTHREADS, 2) mega_fwd(Args a) {
    extern __shared__ __attribute__((aligned(16))) unsigned char lds[];
    constexpr int MISC_OFF = 131072 + 4096;
    { volatile __attribute__((address_space(3))) unsigned* misc = (volatile __attribute__((address_space(3))) unsigned*)((__attribute__((address_space(3))) unsigned char*)lds + MISC_OFF);
      if (threadIdx.x < 4) misc[threadIdx.x] = 0u; }
    __syncthreads();
    (void)xcd_barrier_post((unsigned*)(a.ws + WS_BAR), (volatile __attribute__((address_space(3))) unsigned*)((__attribute__((address_space(3))) unsigned char*)lds + MISC_OFF));
#define GRID_SYNC() do { XcdBarrier xb_; xb_.bar = (unsigned*)(a.ws + WS_BAR); xb_.x = xb_xcc_id(); xb_.st = (volatile __attribute__((address_space(3))) unsigned*)((__attribute__((address_space(3))) unsigned char*)lds + MISC_OFF); xcd_barrier(xb_); } while (0)
#define LDSP ((PG8_LAS unsigned char*)lds)
    constexpr int XCH_OFF = 131072;
#define OTID() ({ int _t = threadIdx.x; asm volatile("" : "+v"(_t)); _t; })
    const int G = gridDim.x, NGW = G * 8;
    const float* x = a.in[0]; const float* norm1_g = a.in[1]; const float* w_in = a.in[2]; const float* sinks = a.in[3];
    const float* mu = a.in[4]; const float* w0 = a.in[5]; const float* w2 = a.in[6]; const float* a0 = a.in[7];
    const float* a2 = a.in[8]; const float* g2 = a.in[9]; const float* k_k = a.in[10]; const float* k_a = a.in[11];
    const float* r_k = a.in[12]; const float* lnx_g = a.in[13]; const float* lnx_b = a.in[14]; const float* v0 = a.in[15];
    const float* v1 = a.in[16]; const float* v2 = a.in[17]; const float* w_out = a.in[18]; const float* norm2_g = a.in[19];
    const float* wg = a.in[20]; const float* wu = a.in[21]; const float* conv_w = a.in[22]; const float* conv_b = a.in[23];
    const float* wd = a.in[24]; const float* final_g = a.in[25];
    unsigned char* ws = a.ws; float* X = a.out;
    ssq_t* ss = (ssq_t*)(ws + WS_SS);
    bf16_t* XB = (bf16_t*)(ws + WS_XB); bf16_t* PROJ = (bf16_t*)(ws + WS_PROJ); bf16_t* MIX = (bf16_t*)(ws + WS_MIX); bf16_t* HID = (bf16_t*)(ws + WS_HID); bf16_t* VF = (bf16_t*)(ws + WS_VFIRST);
    bf16_t* UT = (bf16_t*)(ws + WS_UTMP); bf16_t* UPT = UT + (size_t)SEQ * FF;

    {
        const int tid = OTID(), lane = tid & 63, wave = tid >> 6, gw = blockIdx.x * 8 + wave;
        float* scr = (float*)lds + wave * (64 * 33 + 16);
        constexpr int I_IN = (D / 64) * (IN_W / 32), I_OUT = (D / 64) * (D / 32), I_G = (D / 64) * (FF / 32), I_DN = (FF / 64) * (D / 32), I_LAYER = I_IN + I_OUT + 2 * I_G + I_DN;
        for (int it = gw; it < 2 * I_LAYER; it += NGW) {
            const int l = it / I_LAYER; int r = it % I_LAYER;
            bf16_t* wl = (bf16_t*)(ws + WS_W + l * W_LAYER); bf16_t* WinT = wl; bf16_t* WoutT = (bf16_t*)((char*)wl + W_IN_SZ); bf16_t* WguT = (bf16_t*)((char*)WoutT + W_OUT_SZ); bf16_t* WdT = (bf16_t*)((char*)WguT + W_GU_SZ);
            if (r < I_IN) { transpose_item(w_in + (size_t)l * D * IN_W, D, IN_W, WinT, norm1_g + l * D, 0, scr, r, lane); continue; } r -= I_IN;
            if (r < I_OUT) { transpose_item(w_out + (size_t)l * D * D, D, D, WoutT, nullptr, 0, scr, r, lane); continue; } r -= I_OUT;
            if (r < I_G) { transpose_item(wg + (size_t)l * D * FF, D, FF, WguT, norm2_g + l * D, 1, scr, r, lane); continue; } r -= I_G;
            if (r < I_G) { transpose_item(wu + (size_t)l * D * FF, D, FF, WguT, norm2_g + l * D, 2, scr, r, lane); continue; } r -= I_G;
            transpose_item(wd + (size_t)l * FF * D, FF, D, WdT, nullptr, 0, scr, r, lane);
        }
        {
            constexpr int I_W2 = 1 * (C / 32), I_G2 = 2 * (C / 32), I_V1 = (C / 64) * 1, I_L = 2 * I_W2 + I_G2;
            const float* mu_v1 = a.in[4] + SHIFT_W + 1024;
            for (int it = gw; it < 2 * I_L + 2 * I_V1; it += NGW) {
                if (it < 2 * I_L) { const int l = it / I_L; int r = it % I_L; bf16_t* base = (bf16_t*)(ws + WS_LORA + l * LORA_LAYER);
                    if (r < I_W2) { transpose_item(w2 + (size_t)l * 64 * C, 64, C, base, nullptr, 0, scr, r, lane); continue; } r -= I_W2;
                    if (r < I_W2) { transpose_item(a2 + (size_t)l * 64 * C, 64, C, base + 512 * 64, nullptr, 0, scr, r, lane); continue; } r -= I_W2;
                    transpose_item(g2 + (size_t)l * 128 * C, 128, C, base + 2 * 512 * 64, nullptr, 0, scr, r, lane); }
                else if (it < 2 * I_L + I_V1) transpose_item(v1, C, 32, (bf16_t*)(ws + WS_V1T), mu_v1, 0, scr, it - 2 * I_L, lane, true);
                else transpose_item(v1, C, 32, (bf16_t*)(ws + WS_V1B), mu_v1, 0, scr, it - 2 * I_L - I_V1, lane, false);
            }
            bf16_t* V2T = (bf16_t*)(ws + WS_V2T);
            for (int i = blockIdx.x * NTHREADS + tid; i < 32 * C; i += G * NTHREADS) { const int j = i / C, ch = i % C; V2T[ch * 32 + j] = (bf16_t)f2bf(v2[i]); }
        }
        for (int m = 4 * gw; m < M; m += 4 * NGW) {
            f32x4 xv[4][4];
#pragma unroll
            for (int u = 0; u < 4; ++u)
#pragma unroll
                for (int j = 0; j < 4; ++j) xv[u][j] = ((const f32x4*)(x + (size_t)(m + u) * D))[lane + 64 * j];
#pragma unroll
            for (int u = 0; u < 4; ++u) { float sq = 0.f;
#pragma unroll
                for (int j = 0; j < 4; ++j) { const f32x4 v = xv[u][j]; sq += v.x * v.x + v.y * v.y + v.z * v.z + v.w * v.w;
                    ((unsigned long long*)(XB + (size_t)(m + u) * D))[lane + 64 * j] = (unsigned long long)(f2bf(v.x) | (f2bf(v.y) << 16)) | ((unsigned long long)(f2bf(v.z) | (f2bf(v.w) << 16)) << 32); }
                sq = wave_sum(sq); if (lane == 0) ss[m + u] = ssq_fix(sq); } }
    }
    GRID_SYNC();
    for (int l = 0; l < 2; ++l) {
        bf16_t* wl = (bf16_t*)(ws + WS_W + l * W_LAYER); bf16_t* WinT = wl; bf16_t* WoutT = (bf16_t*)((char*)wl + W_IN_SZ); bf16_t* WguT = (bf16_t*)((char*)WoutT + W_OUT_SZ); bf16_t* WdT = (bf16_t*)((char*)WguT + W_GU_SZ);
        ssq_t* ss1 = ss + (size_t)(2 * l) * M; ssq_t* ss2 = ss + (size_t)(2 * l + 1) * M; ssq_t* ss3 = ss + (size_t)(2 * l + 2) * M;
        { pg8::Gemm g{XB, WinT, M, IN_W, D}; pg8::StaticOrder S; S.init(M, IN_W, G, (int)blockIdx.x); pg8::EpiScaleBf16 E{PROJ, IN_W, ss1};
          pg8::gemm_phase<pg8::EpiScaleBf16, pg8::StaticOrder, true, true>(LDSP, g, S, E); }
        GRID_SYNC();
        { float* KC = (float*)(lds + CK_CONST_OFF); const int t_ = OTID(); KC[t_] = (k_k + l * C)[t_]; KC[512 + t_] = (k_a + l * C)[t_]; KC[1024 + t_] = (r_k + l * C)[t_]; KC[1536 + t_] = (mu + l * SHIFT_W)[t_]; KC[2048 + t_] = (mu + l * SHIFT_W)[512 + t_]; __syncthreads(); }
        attn_phase(PROJ, sinks + l * NH, MIX, lds, G, OTID());
        struct { bf16_t *V, *G; } p; p.V = (bf16_t*)(ws + WS_SI_V); p.G = (bf16_t*)(ws + WS_SI_G);
        bf16_t* GQ = (bf16_t*)X; bf16_t* CQ = GQ + (size_t)BATCH * NH * 64 * 8192;
        ScanArgs s{}; s.yt = (bf16_t*)(ws + WS_YT); s.proj = PROJ; s.V = p.V; s.G = p.G; s.k_k = k_k + l * C; s.k_a = k_a + l * C; s.r_k = r_k + l * C; s.lnx_g = lnx_g + l * C; s.lnx_b = lnx_b + l * C; s.mix = MIX; s.rkc = (float*)(ws + WS_RKC);
        { bf16_t* scr = (bf16_t*)(ws + WS_TSCR + (size_t)blockIdx.x * TSCR_WG);
          for (int tile = blockIdx.x; tile < M / 64; tile += G) {
              const size_t moff = (size_t)tile * 64 * C;
              Prep2Args q{}; q.proj = PROJ; q.mu = mu + l * SHIFT_W; q.w0 = w0 + l * C; q.a0 = a0 + l * C; q.v0 = v0;
              const bf16_t* lw = (const bf16_t*)(ws + WS_LORA + l * LORA_LAYER); q.W2T = lw; q.A2T = lw + 512 * 64; q.G2T = lw + 2 * 512 * 64; q.V1T = (const bf16_t*)(ws + WS_V1T); q.V1B = (const bf16_t*)(ws + WS_V1B); q.V2T = (const bf16_t*)(ws + WS_V2T);
              q.vfirst = VF; q.A = scr - moff; q.CS = (unsigned short*)(scr + 64 * C) - moff; q.V = p.V; q.G = p.G; q.layer = l;
              prep_tile(q, lds, tile, OTID());
              asm volatile("s_waitcnt vmcnt(0)" ::: "memory"); __syncthreads();
              if (threadIdx.x == 0) { __builtin_amdgcn_fence(__ATOMIC_ACQUIRE, "agent"); asm volatile("s_waitcnt vmcnt(0)" ::: "memory"); }
              __syncthreads();
              s.A = q.A; s.CS = q.CS;
              const int bb = tile >> 6, chunk = tile & 63;
              CkRaw cur; ck_load(s, cur, ((bb * NH) << 6) + chunk, OTID());
#define CK_UNIT(hh_) do { const int unit = ((bb * NH + (hh_)) << 6) + chunk; CkRaw nxt = cur; ck_precompute(s, cur, nxt, (hh_) + 1 < NH ? unit + 64 : unit, lds, GQ, CQ, unit, OTID()); cur = nxt; } while (0)
              CK_UNIT(0);
              for (int hh = 1; hh < NH; ++hh) CK_UNIT(hh);
#undef CK_UNIT
          } }
        GRID_SYNC();
        for (int item = (int)((blockIdx.x & 7) * (G >> 3) + (blockIdx.x >> 3)); item < BATCH * NH * 4; item += G) ck_sequential(s, lds, GQ, CQ, item, OTID());
        GRID_SYNC();
        { const int tid = OTID(), lane = tid & 63, gw = blockIdx.x * 8 + (tid >> 6); scan_post_wave(s, gw, NGW, lane); }
        GRID_SYNC();
        { pg8::Gemm g{MIX, WoutT, M, D, D}; pg8::StaticOrder S; S.init(M, D, G, (int)blockIdx.x); pg8::EpiResid E{XB, ss2};
          pg8::gemm_phase<pg8::EpiResid, pg8::StaticOrder, true, true>(LDSP, g, S, E); }
        GRID_SYNC();
        { pg8::Gemm g{XB, WguT, M, 2 * FF, D}; pg8::StaticOrder S; S.init(M, 2 * FF, G, (int)blockIdx.x);
          pg8::EpiConvGlu E{HID, ss2, conv_w + (size_t)l * 3 * FF, conv_b + (size_t)l * FF, (float*)(ws + WS_UTMP), (PG8_LAS float*)(LDSP + XCH_OFF), FF};
          pg8::gemm_phase<pg8::EpiConvGlu, pg8::StaticOrder, true, true>(LDSP, g, S, E); }
        GRID_SYNC();
        { pg8::Gemm g{HID, WdT, M, D, FF}; pg8::StaticOrder S; S.init(M, D, G, (int)blockIdx.x);
          { pg8::Unit u; for (int i = 0; S.next(i, u); ++i) ffn_fixup((const float*)(ws + WS_UTMP), conv_w + (size_t)l * 3 * FF, conv_b + (size_t)l * FF, HID, u.pm, OTID());
            asm volatile("s_waitcnt vmcnt(0)" ::: "memory"); __syncthreads(); }
          if (l == 0) { pg8::EpiResid E{XB, ss3}; pg8::gemm_phase<pg8::EpiResid, pg8::StaticOrder, true, true>(LDSP, g, S, E); }
          else { pg8::EpiResidFinal E{XB, ss3, (unsigned*)(ws + WS_FCNT), final_g, X};
                 pg8::gemm_phase<pg8::EpiResidFinal, pg8::StaticOrder, true, true>(LDSP, g, S, E); } }
        if (l == 0) GRID_SYNC();
    }
}

extern "C" void kernel_launch(void* const* d_in, const int* in_sizes, int n_in, void* d_out, int out_size, void* d_ws, size_t ws_size, hipStream_t stream) {
    static int grid = 0;
    if (grid == 0) {
        if (n_in != 26 || in_sizes[0] != M * D || out_size != M * D || ws_size < WS_END) { fprintf(stderr, "kernel_launch: unexpected shapes (n_in %d, ws %zu)\n", n_in, ws_size); grid = -1; return; }
        int dev = 0, cus = 0, per_cu = 0;
        if (hipGetDevice(&dev) != hipSuccess || hipDeviceGetAttribute(&cus, hipDeviceAttributeMultiprocessorCount, dev) != hipSuccess) { grid = -1; return; }
        if (hipFuncSetAttribute((const void*)mega_fwd, hipFuncAttributeMaxDynamicSharedMemorySize, LDS_BYTES) != hipSuccess) { fprintf(stderr, "kernel_launch: hipFuncSetAttribute failed\n"); grid = -1; return; }
        if (hipOccupancyMaxActiveBlocksPerMultiprocessor(&per_cu, (const void*)mega_fwd, NTHREADS, LDS_BYTES) != hipSuccess || per_cu < 1) { fprintf(stderr, "kernel_launch: occupancy query failed (%d)\n", per_cu); grid = -1; return; }
        grid = cus;
    }
    if (grid < 0) return;
    (void)hipMemsetAsync((unsigned char*)d_ws + WS_CTL, 0, CTL_BYTES, stream);
    Args a{};
    for (int i = 0; i < 26; ++i) a.in[i] = (const float*)d_in[i];
    a.out = (float*)d_out; a.ws = (unsigned char*)d_ws;
    void* kargs[] = {&a};
    hipError_t e = hipLaunchCooperativeKernel((const void*)mega_fwd, dim3(grid), dim3(NTHREADS), kargs, LDS_BYTES, stream);
    if (e != hipSuccess) fprintf(stderr, "kernel_launch: cooperative launch failed: %s (grid %d)\n", hipGetErrorString(e), grid);
}
```

```cpp
#include <hip/hip_runtime.h>
#include <cstdio>
#include <cstdint>

typedef unsigned short bf16_t;
typedef short bf16x8 __attribute__((ext_vector_type(8)));
typedef float f32x4 __attribute__((ext_vector_type(4)));

constexpr int BATCH = 8, SEQ = 4096, D = 1024, M = BATCH * SEQ;
constexpr int HD = 64, ATT_W = 512, KV_W = 128, C = 512, NH = 8;
constexpr int ATT_IN = 768, SHIFT_W = 1792, IN_W = 2560, FF = 2816;
constexpr int WINDOW = 128;
constexpr float RMS_EPS = 1e-5f, LNX_EPS = 64e-5f;

constexpr size_t MiB = 1u << 20;
constexpr size_t WS_CTL = 0;
typedef unsigned long long ssq_t;
__device__ __forceinline__ ssq_t ssq_fix(float s) { return (ssq_t)(s * 1048576.0f + 0.5f); }
__device__ __forceinline__ float ssq_val(ssq_t v) { return (float)v * (1.0f / 1048576.0f); }
constexpr size_t WS_SS = 0;
constexpr size_t CTL_BYTES = 2 * MiB;
constexpr size_t WS_FCNT = 1792 * 1024;
constexpr size_t WS_BAR = 1536 * 1024;
constexpr size_t WS_W = 2 * MiB;
constexpr size_t W_IN_SZ = (size_t)IN_W * D * 2, W_OUT_SZ = (size_t)D * D * 2, W_GU_SZ = (size_t)2 * FF * D * 2, W_DN_SZ = (size_t)D * FF * 2;
constexpr size_t W_LAYER = W_IN_SZ + W_OUT_SZ + W_GU_SZ + W_DN_SZ;
constexpr size_t WS_VFIRST = 52 * MiB, WS_MIX = 84 * MiB, WS_XB = 148 * MiB, WS_PROJ = 212 * MiB;
constexpr size_t WS_SI_R = 148 * MiB, WS_SI_K = 180 * MiB, WS_SI_V = 372 * MiB, WS_SI_A = 404 * MiB, WS_SI_LD = 436 * MiB, WS_SI_G = 468 * MiB;
constexpr size_t WS_HID = 212 * MiB;
constexpr size_t WS_UTMP = 84 * MiB;
constexpr size_t WS_END = 500 * MiB;
static_assert(WS_W + 2 * W_LAYER <= WS_VFIRST, "weights fit");

__device__ __forceinline__ unsigned f2bf(float f) { unsigned u = __builtin_bit_cast(unsigned, f); return (u + 0x7fffu + ((u >> 16) & 1u)) >> 16; }
__device__ __forceinline__ float bf2f(bf16_t h) { return __builtin_bit_cast(float, (unsigned)h << 16); }
__device__ __forceinline__ float wave_sum(float v) {
#pragma unroll
    for (int o = 1; o < 64; o <<= 1) v += __shfl_xor(v, o);
    return v;
}
#define LDS_BARRIER() do { asm volatile("s_waitcnt lgkmcnt(0)" ::: "memory"); __builtin_amdgcn_s_barrier(); asm volatile("" ::: "memory"); } while (0)
__device__ __forceinline__ float sigmoidf_(float x) { return __builtin_amdgcn_rcpf(1.f + __expf(-x)); }

namespace pg8 {
#define PG8_LAS __attribute__((address_space(3)))
typedef unsigned short bf16_t;
typedef short bf16x8 __attribute__((ext_vector_type(8)));
typedef float f32x4 __attribute__((ext_vector_type(4)));
typedef unsigned u32x4 __attribute__((ext_vector_type(4)));
constexpr int BM = 256, BK = 64, HALF = 128, HTB = HALF * BK * 2  , STAGE_BYTES = 8 * HTB, NXCD = 8, WGM = 8;

__host__ __device__ __forceinline__ int lds_byte(int r, int c) { const int st = (r >> 4) * 2 + (c >> 5), rr = r & 15, cc = c & 31, ob = rr * 64 + cc * 2; return st * 1024 + (ob ^ (((ob >> 9) & 1) << 5)); }
__host__ __device__ __forceinline__ void stage_rc(int b, int& R, int& C) { const int st = b / 1024, sb = b % 1024, swz = sb ^ (((sb >> 9) & 1) << 5); R = (st >> 1) * 16 + swz / 64; C = (st & 1) * 32 + (swz % 64) / 2; }
__host__ __device__ __forceinline__ int perm32(int rho) { const int n = rho >> 4, i = rho & 15; return 8 * (i >> 2) + 4 * n + (i & 3); }

struct Unit { int pm, pn; };
struct Gemm { const bf16_t* A; const bf16_t* Bt; int M, N, K; };

struct StaticOrder {
    int nM, nN, nwg, G, c;
    __host__ __device__ void init(int M, int N, int G_, int c_) { nM = M / BM; nN = N / BM; nwg = nM * nN; G = G_; c = c_; }
    __host__ __device__ bool next(int i, Unit& u) const {
        const long L = (long)i * G + c; if (L >= nwg) return false;
        int wgid = (int)L; { const int q = nwg / NXCD, r = nwg % NXCD, xcd = wgid % NXCD, off = wgid / NXCD; wgid = (xcd < r ? xcd * (q + 1) : r * (q + 1) + (xcd - r) * q) + off; }
        const int nig = WGM * nN, gid = wgid / nig, fm = gid * WGM, gsz = (nM - fm) < WGM ? (nM - fm) : WGM;
        u.pm = fm + ((wgid % nig) % gsz); u.pn = (wgid % nig) / gsz; return true;
    }
    __device__ __forceinline__ void a_ready(const Unit&) const {}
    __device__ __forceinline__ void done(const Unit&) const {}
};
typedef float f32x2_t_ __attribute__((ext_vector_type(2))); typedef __bf16 bf16x2_t_ __attribute__((ext_vector_type(2)));
__device__ __forceinline__ unsigned cvt_pk_bf16(float lo, float hi) { const f32x2_t_ v = {lo, hi}; const bf16x2_t_ b = __builtin_convertvector(v, bf16x2_t_); return __builtin_bit_cast(unsigned, b); }
typedef float f32x2 __attribute__((ext_vector_type(2)));
template <class Epi, class Sched, bool ALIGN_EPI = false, bool SP2 = false>
__device__ __forceinline__ void gemm_phase(PG8_LAS unsigned char* lds, const Gemm g, const Sched& S, const Epi& E) {
    int tid_ = threadIdx.x; asm volatile("" : "+v"(tid_));
    const int tid = tid_, wid = __builtin_amdgcn_readfirstlane(tid >> 6), lane = tid & 63, wr = wid >> 2, wc = wid & 3, fr = lane & 15, fq = lane >> 4;
    const int K = g.K, nt = K / BK;
    unsigned voffA[2], voffB[2];
#pragma unroll
    for (int i = 0; i < 2; ++i) { int R, C; stage_rc(tid * 16 + i * 8192, R, C); const int Rb = (R >> 5) * 64 + (Epi::PERM ? perm32(R & 31) : (R & 31));
        voffA[i] = (unsigned)(R * K + C) * 2u; voffB[i] = (unsigned)(Rb * K + C) * 2u; }
    const size_t kstep = (size_t)(BK * 2);
    const size_t hstep = (size_t)HALF * K * 2;
    const size_t tstep = 2 * hstep;
    const size_t hstepB = (size_t)32 * K * 2;
    const unsigned ldsw = (unsigned)wid * 1024u;
    const int aoff = lds_byte(wr * 64 + fr, fq * 8), boff = lds_byte(wc * 32 + fr, fq * 8);
#define PG8_SA(b, h) (((b) * 2 + (h)) * HTB)
#define PG8_SB(b, h) ((4 + (b) * 2 + (h)) * HTB)
#define PG8_STAGE(bufoff, gbase, voff) do { _Pragma("unroll") for (int _i = 0; _i < 2; ++_i) \
        __builtin_amdgcn_global_load_lds((const unsigned*)((const char*)(gbase) + (voff)[_i]), (PG8_LAS unsigned*)(lds + (bufoff) + ldsw + _i * 8192), 16, 0, 0); } while (0)
#define PG8_LDA(dst, b, h) do { _Pragma("unroll") for (int m = 0; m < 4; ++m) _Pragma("unroll") for (int k = 0; k < 2; ++k) dst[m][k] = *(const PG8_LAS bf16x8*)(lds + PG8_SA(b, h) + aoff + m * 2048 + k * 1024); } while (0)
#define PG8_LDB(dst, b, h) do { _Pragma("unroll") for (int n = 0; n < 2; ++n) _Pragma("unroll") for (int k = 0; k < 2; ++k) dst[n][k] = *(const PG8_LAS bf16x8*)(lds + PG8_SB(b, h) + boff + n * 2048 + k * 1024); } while (0)
#define PG8_MMA(ai, bj, At, Bt) do { __builtin_amdgcn_s_setprio(1); _Pragma("unroll") for (int m = 0; m < 4; ++m) _Pragma("unroll") for (int n = 0; n < 2; ++n) _Pragma("unroll") for (int k = 0; k < 2; ++k) \
        acc[ai][bj][m][n] = __builtin_amdgcn_mfma_f32_16x16x32_bf16(Bt[n][k], At[m][k], acc[ai][bj][m][n], 0, 0, 0); __builtin_amdgcn_s_setprio(0); } while (0)
#define PG8_WAIT_V(n) asm volatile("s_waitcnt vmcnt(" #n ")" ::: "memory")
#define PG8_WAIT_L(n) asm volatile("s_waitcnt lgkmcnt(" #n ")" ::: "memory")
#define PG8_BAR __builtin_amdgcn_s_barrier()
#define PG8_SCHED __builtin_amdgcn_sched_barrier(0)
    Unit cur, nxt; int ui = 0;
    if (!S.next(0, cur)) return;
    f32x4 acc[2][2][4][2];
#pragma unroll
    for (int a = 0; a < 2; ++a)
#pragma unroll
        for (int b = 0; b < 2; ++b)
#pragma unroll
            for (int m = 0; m < 4; ++m)
#pragma unroll
                for (int n = 0; n < 2; ++n) acc[a][b][m][n] = (f32x4){0.f, 0.f, 0.f, 0.f};
    bf16x8 At[4][2], B0[2][2], B1[2][2];
    const char* cA = (const char*)g.A + (size_t)cur.pm * tstep; const char* cB = (const char*)g.Bt + (size_t)cur.pn * tstep;
    S.a_ready(cur);
    if constexpr (SP2) {
        PG8_STAGE(PG8_SB(0, 0), cB, voffB); PG8_STAGE(PG8_SB(0, 1), cB + hstepB, voffB); PG8_STAGE(PG8_SA(0, 0), cA, voffA); PG8_STAGE(PG8_SA(0, 1), cA + hstep, voffA);
        if (wr == 1) PG8_BAR;
        PG8_WAIT_V(2); PG8_BAR;
        PG8_STAGE(PG8_SB(1, 0), cB + kstep, voffB); PG8_STAGE(PG8_SA(1, 0), cA + kstep, voffA); PG8_STAGE(PG8_SB(1, 1), cB + hstepB + kstep, voffB);
        PG8_WAIT_V(6); PG8_BAR;
    } else {
        PG8_STAGE(PG8_SB(0, 0), cB, voffB); PG8_STAGE(PG8_SA(0, 0), cA, voffA); PG8_STAGE(PG8_SB(0, 1), cB + hstepB, voffB); PG8_STAGE(PG8_SA(0, 1), cA + hstep, voffA);
        if (wr == 1) PG8_BAR;
        PG8_WAIT_V(4); PG8_BAR;
        PG8_STAGE(PG8_SB(1, 0), cB + kstep, voffB); PG8_STAGE(PG8_SA(1, 0), cA + kstep, voffA); PG8_STAGE(PG8_SB(1, 1), cB + hstepB + kstep, voffB);
        PG8_WAIT_V(6); PG8_BAR;
    }
    for (;;) {
        const bool has_next = S.next(ui + 1, nxt);
        const char* nA = has_next ? (const char*)g.A + (size_t)nxt.pm * tstep : cA; const char* nB = has_next ? (const char*)g.Bt + (size_t)nxt.pn * tstep : cB;
        for (int t = 0; t < nt; t += 2) {
            const bool last = (t == nt - 2);
            const char* a1 = cA + (size_t)(t + 1) * kstep;
            const char* a2 = last ? nA : cA + (size_t)(t + 2) * kstep; const char* b2 = last ? nB : cB + (size_t)(t + 2) * kstep;
            const char* a3 = a2 + kstep; const char* b3 = b2 + kstep;
            if (last && has_next) S.a_ready(nxt);
            if constexpr (SP2) {
            PG8_LDB(B0, 0, 0); PG8_LDB(B1, 0, 1); PG8_SCHED; PG8_LDA(At, 0, 0); PG8_STAGE(PG8_SA(1, 1), a1 + hstep, voffA);
            PG8_WAIT_V(8); PG8_WAIT_L(0); PG8_BAR; PG8_MMA(0, 0, At, B0); PG8_MMA(0, 1, At, B1); PG8_BAR; PG8_SCHED;
            PG8_LDA(At, 0, 1); PG8_STAGE(PG8_SB(0, 0), b2, voffB); PG8_STAGE(PG8_SB(0, 1), b2 + hstepB, voffB); PG8_STAGE(PG8_SA(0, 0), a2, voffA);
            PG8_WAIT_V(8); PG8_WAIT_L(0); PG8_BAR; PG8_MMA(1, 0, At, B0); PG8_MMA(1, 1, At, B1); PG8_BAR; PG8_SCHED;
            PG8_LDB(B0, 1, 0); PG8_LDB(B1, 1, 1); PG8_SCHED; PG8_LDA(At, 1, 0); PG8_STAGE(PG8_SA(0, 1), a2 + hstep, voffA);
            PG8_WAIT_V(8); PG8_WAIT_L(0); PG8_BAR; PG8_MMA(0, 0, At, B0); PG8_MMA(0, 1, At, B1); PG8_BAR; PG8_SCHED;
            PG8_LDA(At, 1, 1); PG8_STAGE(PG8_SB(1, 0), b3, voffB); PG8_STAGE(PG8_SB(1, 1), b3 + hstepB, voffB); PG8_STAGE(PG8_SA(1, 0), a3, voffA);
            PG8_WAIT_V(8); PG8_WAIT_L(0); PG8_BAR; PG8_MMA(1, 0, At, B0); PG8_MMA(1, 1, At, B1); PG8_BAR; PG8_SCHED;
            } else {
            PG8_LDB(B0, 0, 0); PG8_SCHED; PG8_LDA(At, 0, 0); PG8_STAGE(PG8_SA(1, 1), a1 + hstep, voffA);
            PG8_WAIT_L(8); PG8_BAR; PG8_WAIT_L(0); PG8_MMA(0, 0, At, B0); PG8_BAR; PG8_SCHED;
            PG8_LDB(B1, 0, 1); PG8_STAGE(PG8_SB(0, 0), b2, voffB);
            PG8_BAR; PG8_WAIT_L(0); PG8_MMA(0, 1, At, B1); PG8_BAR;
            PG8_LDA(At, 0, 1); PG8_STAGE(PG8_SA(0, 0), a2, voffA);
            PG8_BAR; PG8_WAIT_L(0); PG8_MMA(1, 0, At, B0); PG8_BAR; PG8_SCHED;
            PG8_STAGE(PG8_SB(0, 1), b2 + hstepB, voffB);
            PG8_WAIT_V(6); PG8_BAR; PG8_MMA(1, 1, At, B1); PG8_BAR;
            PG8_LDB(B0, 1, 0); PG8_SCHED; PG8_LDA(At, 1, 0); PG8_STAGE(PG8_SA(0, 1), a2 + hstep, voffA);
            PG8_WAIT_L(8); PG8_BAR; PG8_WAIT_L(0); PG8_MMA(0, 0, At, B0); PG8_BAR; PG8_SCHED;
            PG8_LDB(B1, 1, 1); PG8_STAGE(PG8_SB(1, 0), b3, voffB);
            PG8_BAR; PG8_WAIT_L(0); PG8_MMA(0, 1, At, B1); PG8_BAR;
            PG8_LDA(At, 1, 1); PG8_STAGE(PG8_SA(1, 0), a3, voffA);
            PG8_BAR; PG8_WAIT_L(0); PG8_MMA(1, 0, At, B0); PG8_BAR; PG8_SCHED;
            PG8_STAGE(PG8_SB(1, 1), b3 + hstepB, voffB);
            PG8_WAIT_V(6); PG8_BAR; PG8_MMA(1, 1, At, B1); PG8_BAR;
            }
        }
        if constexpr (ALIGN_EPI) { if (wr == 0) PG8_BAR; }
        if constexpr (!Epi::AFTER_DRAIN) { E(acc, cur, wr, wc, fr, fq); S.done(cur); }
        if (!has_next) break;
#pragma unroll
        for (int a = 0; a < 2; ++a)
#pragma unroll
            for (int b = 0; b < 2; ++b)
#pragma unroll
                for (int m = 0; m < 4; ++m)
#pragma unroll
                    for (int n = 0; n < 2; ++n) acc[a][b][m][n] = (f32x4){0.f, 0.f, 0.f, 0.f};
        cur = nxt; cA = nA; cB = nB; ++ui;
        if constexpr (ALIGN_EPI) { if (wr == 1) PG8_BAR; }
    }
    PG8_WAIT_V(0);
    if constexpr (!ALIGN_EPI) { if (wr == 0) PG8_BAR; }
    PG8_BAR;
    if constexpr (Epi::AFTER_DRAIN) { E.fused(acc, cur, wr, wc, fr, fq, lds, wid, lane); S.done(cur); }
#undef PG8_SA
#undef PG8_SB
#undef PG8_STAGE
#undef PG8_LDA
#undef PG8_LDB
#undef PG8_MMA
#undef PG8_WAIT_V
#undef PG8_WAIT_L
#undef PG8_BAR
#undef PG8_SCHED
}

constexpr int DM_ = 1024; constexpr float RMS_EPS_ = 1e-5f;
typedef unsigned long long ssq_t;
struct EpiScaleBf16 {
    static constexpr bool PERM = true, AFTER_DRAIN = false;
    bf16_t* O; int ldc; const ssq_t* ss;
    __device__ __forceinline__ void operator()(const f32x4 (&acc)[2][2][4][2], const Unit& u, int wr, int wc, int fr, int fq) const {
        const int row0 = u.pm * BM + wr * 64 + fr, col0 = u.pn * BM + wc * 64 + 8 * fq;
        float rsv[2][4];
#pragma unroll
        for (int ai = 0; ai < 2; ++ai)
#pragma unroll
            for (int m = 0; m < 4; ++m) rsv[ai][m] = (float)ss[row0 + ai * HALF + m * 16] * (1.0f / 1048576.0f);
#pragma unroll
        for (int ai = 0; ai < 2; ++ai)
#pragma unroll
            for (int m = 0; m < 4; ++m) { const int row = row0 + ai * HALF + m * 16; const float rs = __builtin_amdgcn_rsqf(rsv[ai][m] * (1.0f / DM_) + RMS_EPS_); bf16_t* rowp = O + (size_t)row * ldc + col0;
#pragma unroll
                for (int bj = 0; bj < 2; ++bj) { const f32x4 v0 = acc[ai][bj][m][0] * rs, v1 = acc[ai][bj][m][1] * rs;
                    u32x4 w; w.x = cvt_pk_bf16(v0[0], v0[1]); w.y = cvt_pk_bf16(v0[2], v0[3]); w.z = cvt_pk_bf16(v1[0], v1[1]); w.w = cvt_pk_bf16(v1[2], v1[3]);
                    *(u32x4*)(rowp + bj * 32) = w; } }
    }
};
struct EpiResid {
    static constexpr bool PERM = true, AFTER_DRAIN = false;
    bf16_t* xb; ssq_t* ss_out;
    __device__ __forceinline__ void operator()(const f32x4 (&acc)[2][2][4][2], const Unit& u, int wr, int wc, int fr, int fq) const {
        const int row0 = u.pm * BM + wr * 64 + fr, col0 = u.pn * BM + wc * 64 + 8 * fq;
#pragma unroll
        for (int ai = 0; ai < 2; ++ai) {
            u32x4 bs[4][2];
#pragma unroll
            for (int m = 0; m < 4; ++m)
#pragma unroll
                for (int bj = 0; bj < 2; ++bj) bs[m][bj] = *(const u32x4*)(xb + (size_t)(row0 + ai * HALF + m * 16) * DM_ + col0 + bj * 32);
#pragma unroll
            for (int m = 0; m < 4; ++m) { const int row = row0 + ai * HALF + m * 16; bf16_t* rp = xb + (size_t)row * DM_ + col0; float sq = 0.f;
#pragma unroll
                for (int bj = 0; bj < 2; ++bj) { const u32x4 b = bs[m][bj]; u32x4 w;
#pragma unroll
                    for (int hh = 0; hh < 2; ++hh) { const unsigned b0 = hh == 0 ? b.x : b.z, b1 = hh == 0 ? b.y : b.w; const f32x4 a4 = acc[ai][bj][m][hh];
                        const float x0 = __builtin_bit_cast(float, b0 << 16) + a4[0], x1 = __builtin_bit_cast(float, b0 & 0xffff0000u) + a4[1], x2 = __builtin_bit_cast(float, b1 << 16) + a4[2], x3 = __builtin_bit_cast(float, b1 & 0xffff0000u) + a4[3];
                        const unsigned w0 = cvt_pk_bf16(x0, x1), w1 = cvt_pk_bf16(x2, x3);
                        if (hh == 0) { w.x = w0; w.y = w1; } else { w.z = w0; w.w = w1; }
                        const float r0 = __builtin_bit_cast(float, w0 << 16), r1 = __builtin_bit_cast(float, w0 & 0xffff0000u), r2 = __builtin_bit_cast(float, w1 << 16), r3 = __builtin_bit_cast(float, w1 & 0xffff0000u);
                        sq += (r0 * r0 + r1 * r1) + (r2 * r2 + r3 * r3); }
                    *(u32x4*)(rp + bj * 32) = w; }
                sq += __shfl_xor(sq, 16); sq += __shfl_xor(sq, 32);
                if (fq == 0) atomicAdd(ss_out + row, (ssq_t)(sq * 1048576.0f + 0.5f)); }
        }
    }
};
struct EpiResidFinal {
    static constexpr bool PERM = true, AFTER_DRAIN = false;
    const bf16_t* xb; ssq_t* ss_out; unsigned* cnt; const float* g; float* out;
    __device__ __forceinline__ void operator()(f32x4 (&acc)[2][2][4][2], const Unit& u, int wr, int wc, int fr, int fq) const {
        const int row0 = u.pm * BM + wr * 64 + fr, col0 = u.pn * BM + wc * 64 + 8 * fq;
#pragma unroll
        for (int ai = 0; ai < 2; ++ai) {
            u32x4 bs[4][2];
#pragma unroll
            for (int m = 0; m < 4; ++m)
#pragma unroll
                for (int bj = 0; bj < 2; ++bj) bs[m][bj] = *(const u32x4*)(xb + (size_t)(row0 + ai * HALF + m * 16) * DM_ + col0 + bj * 32);
#pragma unroll
            for (int m = 0; m < 4; ++m) { const int row = row0 + ai * HALF + m * 16; float sq = 0.f;
#pragma unroll
                for (int bj = 0; bj < 2; ++bj) { const u32x4 b = bs[m][bj];
#pragma unroll
                    for (int hh = 0; hh < 2; ++hh) { const unsigned b0 = hh == 0 ? b.x : b.z, b1 = hh == 0 ? b.y : b.w; const f32x4 a4 = acc[ai][bj][m][hh];
                        const float x0 = __builtin_bit_cast(float, b0 << 16) + a4[0], x1 = __builtin_bit_cast(float, b0 & 0xffff0000u) + a4[1], x2 = __builtin_bit_cast(float, b1 << 16) + a4[2], x3 = __builtin_bit_cast(float, b1 & 0xffff0000u) + a4[3];
                        const unsigned w0 = cvt_pk_bf16(x0, x1), w1 = cvt_pk_bf16(x2, x3);
                        const float r0 = __builtin_bit_cast(float, w0 << 16), r1 = __builtin_bit_cast(float, w0 & 0xffff0000u), r2 = __builtin_bit_cast(float, w1 << 16), r3 = __builtin_bit_cast(float, w1 & 0xffff0000u);
                        acc[ai][bj][m][hh] = (f32x4){r0, r1, r2, r3};
                        sq += (r0 * r0 + r1 * r1) + (r2 * r2 + r3 * r3); } }
                sq += __shfl_xor(sq, 16); sq += __shfl_xor(sq, 32);
                if (fq == 0) atomicAdd(ss_out + row, (ssq_t)(sq * 1048576.0f + 0.5f)); }
        }
        asm volatile("s_waitcnt vmcnt(0)" ::: "memory"); __builtin_amdgcn_s_barrier(); asm volatile("" ::: "memory");
        if (wr == 0 && wc == 0 && fr == 0 && fq == 0) {
            (void)__hip_atomic_fetch_add(cnt + u.pm, 1u, __ATOMIC_RELAXED, __HIP_MEMORY_SCOPE_AGENT);
            for (unsigned sp = 0; __hip_atomic_load(cnt + u.pm, __ATOMIC_RELAXED, __HIP_MEMORY_SCOPE_AGENT) < 4u && sp < (1u << 22); ++sp) __builtin_amdgcn_s_sleep(2);
        }
        asm volatile("s_waitcnt vmcnt(0)" ::: "memory"); __builtin_amdgcn_s_barrier(); asm volatile("" ::: "memory");
        f32x4 gv[2][2];
#pragma unroll
        for (int bj = 0; bj < 2; ++bj)
#pragma unroll
            for (int hh = 0; hh < 2; ++hh) gv[bj][hh] = *(const f32x4*)(g + col0 + bj * 32 + 4 * hh);
#pragma unroll
        for (int ai = 0; ai < 2; ++ai)
#pragma unroll
            for (int m = 0; m < 4; ++m) { const int row = row0 + ai * HALF + m * 16;
                const ssq_t sv = __hip_atomic_load(ss_out + row, __ATOMIC_RELAXED, __HIP_MEMORY_SCOPE_AGENT);
                const float rs = __builtin_amdgcn_rsqf((float)sv * (1.0f / 1048576.0f) * (1.0f / DM_) + RMS_EPS_); float* op = out + (size_t)row * DM_ + col0;
#pragma unroll
                for (int bj = 0; bj < 2; ++bj)
#pragma unroll
                    for (int hh = 0; hh < 2; ++hh) *(f32x4*)(op + bj * 32 + 4 * hh) = acc[ai][bj][m][hh] * gv[bj][hh] * rs; }
    }
};
template <int CTRL> __device__ __forceinline__ float dpp1(float x) { return __builtin_bit_cast(float, __builtin_amdgcn_update_dpp(0, __builtin_bit_cast(int, x), CTRL, 0xF, 0xF, true)); }
template <int CTRL> __device__ __forceinline__ f32x4 dpp4(const f32x4 x) { return (f32x4){dpp1<CTRL>(x.x), dpp1<CTRL>(x.y), dpp1<CTRL>(x.z), dpp1<CTRL>(x.w)}; }
struct EpiConvGlu {
    static constexpr bool PERM = true, AFTER_DRAIN = false;
    bf16_t* HID; const ssq_t* ss; const float* cw; const float* cb; float* SB; PG8_LAS float* xch; int ff;
    __device__ __forceinline__ void operator()(const f32x4 (&acc)[2][2][4][2], const Unit& u, int wr, int wc, int fr, int fq) const {
        const int row0 = u.pm * BM + wr * 64 + fr, cl = wc * 32 + 8 * fq, jcol = u.pn * HALF + cl;
        float rs[2][4];
#pragma unroll
        for (int ai = 0; ai < 2; ++ai)
#pragma unroll
            for (int m = 0; m < 4; ++m) rs[ai][m] = (float)ss[row0 + ai * HALF + m * 16] * (1.0f / 1048576.0f);
        f32x4 w0[2], w1[2], w2[2], bb[2];
#pragma unroll
        for (int n = 0; n < 2; ++n) { w0[n] = *(const f32x4*)(cw + jcol + 4 * n); w1[n] = *(const f32x4*)(cw + ff + jcol + 4 * n); w2[n] = *(const f32x4*)(cw + 2 * ff + jcol + 4 * n); bb[n] = *(const f32x4*)(cb + jcol + 4 * n); }
#pragma unroll
        for (int ai = 0; ai < 2; ++ai)
#pragma unroll
            for (int m = 0; m < 4; ++m) rs[ai][m] = __builtin_amdgcn_rsqf(rs[ai][m] * (1.0f / DM_) + RMS_EPS_);
        if (fr >= 14) {
#pragma unroll
            for (int ai = 0; ai < 2; ++ai)
#pragma unroll
                for (int n = 0; n < 2; ++n) *(PG8_LAS f32x4*)(xch + ((2 * ai + wr) * 2 + (fr - 14)) * HALF + cl + 4 * n) = acc[ai][0][3][n] * rs[ai][3];
        }
        asm volatile("s_waitcnt lgkmcnt(0)" ::: "memory"); __builtin_amdgcn_s_barrier(); asm volatile("" ::: "memory");
        float* sbp = SB + (size_t)u.pm * 6 * ff + jcol;
#pragma unroll
        for (int ai = 0; ai < 2; ++ai) {
            const int q = 2 * ai + wr;
            f32x4 X[2];
#pragma unroll
            for (int n = 0; n < 2; ++n) { X[n] = (f32x4){0.f, 0.f, 0.f, 0.f}; if (q > 0 && fr >= 14) X[n] = *(const PG8_LAS f32x4*)(xch + ((q - 1) * 2 + (fr - 14)) * HALF + cl + 4 * n); }
            f32x4 prevg[2] = {X[0], X[1]};
#pragma unroll
            for (int m = 0; m < 4; ++m) { const int row = row0 + ai * HALF + m * 16;
                pg8::u32x4 hw;
#pragma unroll
                for (int n = 0; n < 2; ++n) {
                    const f32x4 cur = acc[ai][0][m][n] * rs[ai][m], up = acc[ai][1][m][n] * rs[ai][m];
                    const f32x4 P = prevg[n]; prevg[n] = cur;
                    f32x4 z1, z2;
#pragma unroll
                    for (int e = 0; e < 4; ++e) { z1[e] = fr == 15 ? P[e] : cur[e]; z2[e] = fr >= 14 ? P[e] : cur[e]; }
                    const f32x4 p1 = dpp4<0x121>(z1), p2 = dpp4<0x122>(z2);
                    const f32x4 c = bb[n] + w0[n] * p2 + w1[n] * p1 + w2[n] * cur;
                    f32x4 hv;
#pragma unroll
                    for (int e = 0; e < 4; ++e) hv[e] = c[e] * __builtin_amdgcn_rcpf(1.f + __expf(-c[e])) * up[e];
                    if (n == 0) { hw.x = cvt_pk_bf16(hv[0], hv[1]); hw.y = cvt_pk_bf16(hv[2], hv[3]); } else { hw.z = cvt_pk_bf16(hv[0], hv[1]); hw.w = cvt_pk_bf16(hv[2], hv[3]); }
                    if (q == 0 && m == 0 && fr < 2) { *(f32x4*)(sbp + (size_t)fr * ff + 4 * n) = cur; *(f32x4*)(sbp + (size_t)(2 + fr) * ff + 4 * n) = up; }
                    if (q == 3 && m == 3 && fr >= 14) *(f32x4*)(sbp + (size_t)(4 + fr - 14) * ff + 4 * n) = cur;
                }
                *(pg8::u32x4*)(HID + (size_t)row * ff + jcol) = hw; }
        }
    }
};
}

#define LAS __attribute__((address_space(3)))
__device__ __forceinline__ void transpose_item(const float* __restrict__ W, int K, int N, bf16_t* __restrict__ Wt, const float* __restrict__ g, int mode, float* scr, int item, int lane, bool gcompl = false) {
    const int nblk = N / 32, kb = item / nblk, nb = item % nblk, k0 = 64 * kb, n0 = 32 * nb;
    int np0 = n0; if (mode != 0) np0 = 256 * (n0 / 128) + 64 * ((n0 % 128) / 32) + (mode == 2 ? 32 : 0);
    f32x4 wv[8];
#pragma unroll
    for (int i = 0; i < 8; ++i) wv[i] = *(const f32x4*)(W + (size_t)(k0 + (lane >> 3) + 8 * i) * N + n0 + (lane & 7) * 4);
#pragma unroll
    for (int i = 0; i < 8; ++i) { const int kk = (lane >> 3) + 8 * i; const float gs = g ? (gcompl ? 1.f - g[k0 + kk] : g[k0 + kk]) : 1.f; float* d = scr + kk * 33 + (lane & 7) * 4; d[0] = wv[i].x * gs; d[1] = wv[i].y * gs; d[2] = wv[i].z * gs; d[3] = wv[i].w * gs; }
    __builtin_amdgcn_fence(__ATOMIC_RELEASE, "wavefront"); __builtin_amdgcn_wave_barrier(); __builtin_amdgcn_fence(__ATOMIC_ACQUIRE, "wavefront");
    const int c = lane & 7;
#pragma unroll
    for (int j = 0; j < 4; ++j) { const int n = (lane >> 3) + 8 * j; const float* sp = scr + (8 * c) * 33 + n;
        uint4 o; o.x = f2bf(sp[0]) | (f2bf(sp[33]) << 16); o.y = f2bf(sp[2 * 33]) | (f2bf(sp[3 * 33]) << 16); o.z = f2bf(sp[4 * 33]) | (f2bf(sp[5 * 33]) << 16); o.w = f2bf(sp[6 * 33]) | (f2bf(sp[7 * 33]) << 16);
        *(uint4*)(Wt + (size_t)(np0 + n) * K + k0 + 8 * c) = o; }
    __builtin_amdgcn_fence(__ATOMIC_RELEASE, "wavefront"); __builtin_amdgcn_wave_barrier(); __builtin_amdgcn_fence(__ATOMIC_ACQUIRE, "wavefront");
}
constexpr size_t WS_LORA = 50 * MiB;
constexpr size_t LORA_LAYER = 256 * 1024, WS_V1T = WS_LORA + 2 * LORA_LAYER, WS_V1B = WS_V1T + 32 * 1024, WS_V2T = WS_V1B + 32 * 1024;
constexpr int PR_ACT_LD = 264, PR_VLO_LD = 40, PR_SG_LD = 520, PR_ACT_OFF = 0, PR_VLO_OFF = 64 * PR_ACT_LD * 2, PR_SG_OFF = PR_VLO_OFF + 64 * PR_VLO_LD * 2;
constexpr int PR_STG_OFF = PR_SG_OFF + 64 * PR_SG_LD * 2, PR_STG_WAVE = 16 * 144;
struct Prep2Args {
    const bf16_t* proj; const float* mu; const float* w0; const float* a0; const float* v0;
    const bf16_t *W2T, *A2T, *G2T, *V1T, *V1B, *V2T; bf16_t* vfirst; bf16_t *V, *A, *G; unsigned short* CS; int layer; int pad;
};
__device__ __forceinline__ f32x4 bfx4_lo(const bf16x8 v) { return (f32x4){bf2f((bf16_t)v[0]), bf2f((bf16_t)v[1]), bf2f((bf16_t)v[2]), bf2f((bf16_t)v[3])}; }
__device__ __forceinline__ f32x4 bfx4_hi(const bf16x8 v) { return (f32x4){bf2f((bf16_t)v[4]), bf2f((bf16_t)v[5]), bf2f((bf16_t)v[6]), bf2f((bf16_t)v[7])}; }
__device__ __forceinline__ bf16x8 pack8(const f32x4 a, const f32x4 b) { pg8::u32x4 w; w.x = pg8::cvt_pk_bf16(a[0], a[1]); w.y = pg8::cvt_pk_bf16(a[2], a[3]); w.z = pg8::cvt_pk_bf16(b[0], b[1]); w.w = pg8::cvt_pk_bf16(b[2], b[3]); return __builtin_bit_cast(bf16x8, w); }
template <int CTRL> __device__ __forceinline__ float dpp_mov(float x) { return __builtin_bit_cast(float, __builtin_amdgcn_update_dpp(0, __builtin_bit_cast(int, x), CTRL, 0xF, 0xF, true)); }
__device__ __forceinline__ float reduce16(float x) { x += dpp_mov<0xB1>(x); x += dpp_mov<0x4E>(x); x += dpp_mov<0x141>(x); x += dpp_mov<0x140>(x); return x; }
__device__ __forceinline__ float red8(float x) { x += dpp_mov<0xB1>(x); x += dpp_mov<0x4E>(x); x += dpp_mov<0x141>(x); return x; }
__device__ __forceinline__ float scan16(float x) { x += dpp_mov<0x111>(x); x += dpp_mov<0x112>(x); x += dpp_mov<0x114>(x); x += dpp_mov<0x118>(x); return x; }
constexpr float CS_SCALE = 1638.0f;
__device__ __forceinline__ void shift8(const bf16_t* __restrict__ proj, const float* __restrict__ mu, size_t m, int t, int col, int mi, f32x4& lo, f32x4& hi) {
    const bf16x8 cur = *(const bf16x8*)(proj + m * IN_W + col);
    bf16x8 prv; if (t > 0) prv = *(const bf16x8*)(proj + (m - 1) * IN_W + col); else prv = (bf16x8){0, 0, 0, 0, 0, 0, 0, 0};
    const f32x4 m0 = *(const f32x4*)(mu + mi), m1 = *(const f32x4*)(mu + mi + 4);
    const f32x4 c0 = bfx4_lo(cur), c1 = bfx4_hi(cur), p0 = bfx4_lo(prv), p1 = bfx4_hi(prv);
    lo = c0 + (p0 - c0) * m0; hi = c1 + (p1 - c1) * m1;
}
__device__ __forceinline__ void prep_tile(const Prep2Args& p, unsigned char* lds, int tile, int tid) {
    const int m0 = tile * 64, wave = __builtin_amdgcn_readfirstlane(tid >> 6), lane = tid & 63, fr = lane & 15, fq = lane >> 4;
    bf16_t* ACT = (bf16_t*)(lds + PR_ACT_OFF); bf16_t* VLO = (bf16_t*)(lds + PR_VLO_OFF); bf16_t* SG = (bf16_t*)(lds + PR_SG_OFF);
    { bf16x8 cu[4], pv[4]; f32x4 mu0[4], mu1[4];
#pragma unroll
      for (int it = 0; it < 4; ++it) { const int i = tid + 512 * it, tk = i >> 5, cc = i & 31; const size_t m = (size_t)m0 + tk; const int t = (int)(m % SEQ);
          cu[it] = *(const bf16x8*)(p.proj + m * IN_W + 2304 + 8 * cc); if (t > 0) pv[it] = *(const bf16x8*)(p.proj + (m - 1) * IN_W + 2304 + 8 * cc); else pv[it] = (bf16x8){0, 0, 0, 0, 0, 0, 0, 0};
          mu0[it] = *(const f32x4*)(p.mu + 1536 + 8 * cc); mu1[it] = *(const f32x4*)(p.mu + 1536 + 8 * cc + 4); }
#pragma unroll
      for (int it = 0; it < 4; ++it) { const int i = tid + 512 * it, tk = i >> 5, cc = i & 31;
          const f32x4 c0 = bfx4_lo(cu[it]), c1 = bfx4_hi(cu[it]); f32x4 lo = c0 + (bfx4_lo(pv[it]) - c0) * mu0[it], hi = c1 + (bfx4_hi(pv[it]) - c1) * mu1[it];
          if (cc < 8) {
#pragma unroll
              for (int e = 0; e < 4; ++e) { lo[e] = 2.f * sigmoidf_(2.f * lo[e]) - 1.f; hi[e] = 2.f * sigmoidf_(2.f * hi[e]) - 1.f; } }
          else if (cc >= 16) {
#pragma unroll
              for (int e = 0; e < 4; ++e) { lo[e] = sigmoidf_(lo[e]); hi[e] = sigmoidf_(hi[e]); } }
          *(bf16x8*)(ACT + tk * PR_ACT_LD + 8 * cc) = pack8(lo, hi); } }
    if (p.layer > 0) {
        unsigned char* VS = lds + PR_SG_OFF; float* PS = (float*)(lds + PR_STG_OFF);
        const bool seq0 = (m0 % SEQ) == 0;
#pragma unroll
        for (int it = 0; it < 9; ++it) { const int pidx = tid + 512 * it; if (pidx < 65 * 64) { const int r = pidx >> 6, g = pidx & 63;
                bf16x8 v = (bf16x8){0, 0, 0, 0, 0, 0, 0, 0}; if (r > 0 || !seq0) v = *(const bf16x8*)(p.proj + ((size_t)m0 - 1 + r) * IN_W + 1792 + g * 8);
                *(bf16x8*)(VS + r * 1024 + ((g ^ (r & 7)) << 4)) = v; } }
        const int jb = wave & 1, kq = wave >> 1;
        bf16x8 wa[4], wb[4];
#pragma unroll
        for (int ks = 0; ks < 4; ++ks) { const int ko = 128 * kq + 32 * ks + 8 * fq; wa[ks] = *(const bf16x8*)(p.V1T + (size_t)(16 * jb + fr) * C + ko); wb[ks] = *(const bf16x8*)(p.V1B + (size_t)(16 * jb + fr) * C + ko); }
        __syncthreads();
        f32x4 acc[4];
#pragma unroll
        for (int tb = 0; tb < 4; ++tb) { acc[tb] = (f32x4){0.f, 0.f, 0.f, 0.f};
#pragma unroll
            for (int ks = 0; ks < 4; ++ks) { const int g = 4 * (4 * kq + ks) + fq, rp = 16 * tb + fr, rc = rp + 1;
                const bf16x8 cu = *(const bf16x8*)(VS + rc * 1024 + ((g ^ (rc & 7)) << 4)), pv = *(const bf16x8*)(VS + rp * 1024 + ((g ^ (rp & 7)) << 4));
                acc[tb] = __builtin_amdgcn_mfma_f32_16x16x32_bf16(wa[ks], cu, acc[tb], 0, 0, 0); acc[tb] = __builtin_amdgcn_mfma_f32_16x16x32_bf16(wb[ks], pv, acc[tb], 0, 0, 0); } }
        if (kq > 0) {
#pragma unroll
            for (int tb = 0; tb < 4; ++tb) *(f32x4*)(PS + ((kq - 1) * 64 + 16 * tb + fr) * 32 + 16 * jb + 4 * fq) = acc[tb]; }
        __syncthreads();
        if (kq == 0) {
#pragma unroll
            for (int tb = 0; tb < 4; ++tb) { const float* pp = PS + (16 * tb + fr) * 32 + 16 * jb + 4 * fq;
                const f32x4 s = acc[tb] + *(const f32x4*)pp + *(const f32x4*)(pp + 64 * 32) + *(const f32x4*)(pp + 2 * 64 * 32);
                uint2 w; w.x = pg8::cvt_pk_bf16(s[0], s[1]); w.y = pg8::cvt_pk_bf16(s[2], s[3]);
                *(uint2*)(VLO + (16 * tb + fr) * PR_VLO_LD + 16 * jb + 4 * fq) = w; } }
    }
    __syncthreads();
    const int ch0 = 64 * wave;
    if (p.layer > 0) {
        bf16x8 af[4], wf[4]; f32x4 bias[4];
#pragma unroll
        for (int cb = 0; cb < 4; ++cb) { wf[cb] = *(const bf16x8*)(p.V2T + (size_t)(ch0 + 16 * cb + fr) * 32 + 8 * fq); bias[cb] = *(const f32x4*)(p.v0 + ch0 + 16 * cb + 4 * fq); }
#pragma unroll
        for (int tb = 0; tb < 4; ++tb) af[tb] = *(const bf16x8*)(VLO + (16 * tb + fr) * PR_VLO_LD + 8 * fq);
#pragma unroll
        for (int cb = 0; cb < 4; ++cb) { const int ch = ch0 + 16 * cb + 4 * fq;
#pragma unroll
            for (int tb = 0; tb < 4; ++tb) { f32x4 x = __builtin_amdgcn_mfma_f32_16x16x32_bf16(wf[cb], af[tb], (f32x4){0.f, 0.f, 0.f, 0.f}, 0, 0, 0) + bias[cb];
                uint2 w; w.x = pg8::cvt_pk_bf16(sigmoidf_(x[0]), sigmoidf_(x[1])); w.y = pg8::cvt_pk_bf16(sigmoidf_(x[2]), sigmoidf_(x[3]));
                *(uint2*)(SG + (16 * tb + fr) * PR_SG_LD + ch) = w; } }
    }
    {
        f32x4 bw[4], ba[4];
#pragma unroll
        for (int cb = 0; cb < 4; ++cb) { bw[cb] = *(const f32x4*)(p.w0 + ch0 + 16 * cb + 4 * fq); ba[cb] = *(const f32x4*)(p.a0 + ch0 + 16 * cb + 4 * fq); }
        bf16x8 wA[2][4], wB[2][4], wC[4][4];
#define PR_LOADW(wf, WT, KL) _Pragma("unroll") for (int ks = 0; ks < (KL) / 32; ++ks) { _Pragma("unroll") for (int cb = 0; cb < 4; ++cb) wf[ks][cb] = *(const bf16x8*)((WT) + (size_t)(ch0 + 16 * cb + fr) * (KL) + 32 * ks + 8 * fq); }
#define PR_MMA(wf, K0, KL) { _Pragma("unroll") for (int tb = 0; tb < 4; ++tb) { _Pragma("unroll") for (int cb = 0; cb < 4; ++cb) acc[tb][cb] = (f32x4){0.f, 0.f, 0.f, 0.f}; } \
            _Pragma("unroll") for (int ks = 0; ks < (KL) / 32; ++ks) { bf16x8 af[4]; \
                _Pragma("unroll") for (int tb = 0; tb < 4; ++tb) af[tb] = *(const bf16x8*)(ACT + (16 * tb + fr) * PR_ACT_LD + (K0) + 32 * ks + 8 * fq); \
                _Pragma("unroll") for (int tb = 0; tb < 4; ++tb) { _Pragma("unroll") for (int cb = 0; cb < 4; ++cb) acc[tb][cb] = __builtin_amdgcn_mfma_f32_16x16x32_bf16(wf[ks][cb], af[tb], acc[tb][cb], 0, 0, 0); } } }
        f32x4 acc[4][4];
        unsigned char* stg = lds + PR_STG_OFF + wave * PR_STG_WAVE; const int st_w = fr * 144 + 8 * fq, l8 = lane & 7, lr = lane >> 3;
#define PR_WFENCE() { __builtin_amdgcn_fence(__ATOMIC_RELEASE, "wavefront"); __builtin_amdgcn_wave_barrier(); __builtin_amdgcn_fence(__ATOMIC_ACQUIRE, "wavefront"); }
#define PR_FLUSH(OUTP, TB) { PR_WFENCE() _Pragma("unroll") for (int i_ = 0; i_ < 2; ++i_) { const int row_ = lr + 8 * i_; const pg8::u32x4 v_ = *(const pg8::u32x4*)(stg + row_ * 144 + l8 * 16); \
            *(pg8::u32x4*)((OUTP) + ((size_t)m0 + 16 * (TB) + row_) * C + ch0 + l8 * 8) = v_; } PR_WFENCE() }
        PR_LOADW(wA, p.W2T, 64)
        PR_MMA(wA, 0, 64)
        PR_LOADW(wB, p.A2T, 64)
        { f32x4 run[4];
#pragma unroll
          for (int cb = 0; cb < 4; ++cb) run[cb] = (f32x4){0.f, 0.f, 0.f, 0.f};
#pragma unroll
          for (int tb = 0; tb < 4; ++tb) {
#pragma unroll
            for (int cb = 0; cb < 4; ++cb) { f32x4 x = acc[tb][cb] + bw[cb];
#pragma unroll
                for (int e = 0; e < 4; ++e) x[e] = -0.60653065971f * sigmoidf_(x[e]);
                f32x4 s, tot; s.x = scan16(x.x); s.y = scan16(x.y); s.z = scan16(x.z); s.w = scan16(x.w);
                tot.x = reduce16(x.x); tot.y = reduce16(x.y); tot.z = reduce16(x.z); tot.w = reduce16(x.w);
                const f32x4 cq = (s + run[cb]) * -CS_SCALE + 0.5f;
                uint2 w; w.x = (unsigned)fminf(cq.x, 65535.f) | ((unsigned)fminf(cq.y, 65535.f) << 16); w.y = (unsigned)fminf(cq.z, 65535.f) | ((unsigned)fminf(cq.w, 65535.f) << 16);
                *(uint2*)(stg + st_w + 32 * cb) = w; run[cb] = run[cb] + tot; }
            PR_FLUSH(p.CS, tb) } }
        PR_MMA(wB, 64, 64)
        PR_LOADW(wC, p.G2T, 128)
#pragma unroll
        for (int tb = 0; tb < 4; ++tb) {
#pragma unroll
            for (int cb = 0; cb < 4; ++cb) { f32x4 x = acc[tb][cb] + ba[cb];
#pragma unroll
                for (int e = 0; e < 4; ++e) x[e] = sigmoidf_(x[e]);
                uint2 w; w.x = pg8::cvt_pk_bf16(x[0], x[1]); w.y = pg8::cvt_pk_bf16(x[2], x[3]);
                *(uint2*)(stg + st_w + 32 * cb) = w; }
            PR_FLUSH(p.A, tb) }
        PR_MMA(wC, 128, 128)
#pragma unroll
        for (int tb = 0; tb < 4; ++tb) {
#pragma unroll
            for (int cb = 0; cb < 4; ++cb) { const f32x4 x = acc[tb][cb];
                uint2 w; w.x = pg8::cvt_pk_bf16(x[0], x[1]); w.y = pg8::cvt_pk_bf16(x[2], x[3]);
                *(uint2*)(stg + st_w + 32 * cb) = w; }
            PR_FLUSH(p.G, tb) }
#undef PR_FLUSH
#undef PR_WFENCE
#undef PR_LOADW
#undef PR_MMA
    }
    __syncthreads();
    {
        const int cc = tid & 63;
        bf16x8 cu[8], pv[8], vf[8]; const f32x4 mu0 = *(const f32x4*)(p.mu + 1024 + 8 * cc), mu1 = *(const f32x4*)(p.mu + 1024 + 8 * cc + 4);
#pragma unroll
        for (int it = 0; it < 8; ++it) { const int tk = (tid >> 6) + 8 * it; const size_t m = (size_t)m0 + tk; const int t = (int)(m % SEQ); const int col = 768 + 1024 + 8 * cc;
            cu[it] = *(const bf16x8*)(p.proj + m * IN_W + col); if (t > 0) pv[it] = *(const bf16x8*)(p.proj + (m - 1) * IN_W + col); else pv[it] = (bf16x8){0, 0, 0, 0, 0, 0, 0, 0};
            if (p.layer > 0) vf[it] = *(const bf16x8*)(p.vfirst + m * C + 8 * cc); }
#pragma unroll
        for (int it = 0; it < 8; ++it) { const int tk = (tid >> 6) + 8 * it; const size_t m = (size_t)m0 + tk;
            const f32x4 c0 = bfx4_lo(cu[it]), c1 = bfx4_hi(cu[it]);
            f32x4 lo = c0 + (bfx4_lo(pv[it]) - c0) * mu0, hi = c1 + (bfx4_hi(pv[it]) - c1) * mu1;
            const size_t o = m * C + 8 * cc;
            if (p.layer == 0) *(bf16x8*)(p.vfirst + o) = pack8(lo, hi);
            else { const bf16x8 sg = *(const bf16x8*)(SG + tk * PR_SG_LD + 8 * cc);
                lo = lo + (bfx4_lo(vf[it]) - lo) * bfx4_lo(sg); hi = hi + (bfx4_hi(vf[it]) - hi) * bfx4_hi(sg); }
            *(bf16x8*)(p.V + o) = pack8(lo, hi); }
    }
    __syncthreads();
}

constexpr int NTHREADS_ = 512;
constexpr int SC_TB = 32, SC_SLOT = 384, SC_NCH = SEQ / SC_TB;
constexpr size_t WS_RKC = 51 * MiB;
struct ScanArgs { const bf16_t *proj, *V, *A, *G; const unsigned short* CS; const float *k_k, *k_a, *r_k, *lnx_g, *lnx_b; bf16_t* mix; float* rkc; bf16_t* yt; };
constexpr int CK_LD = 72, CK_MAT = 64 * CK_LD * 2;
constexpr size_t WS_YT = WS_SI_LD;
constexpr size_t WS_TSCR = WS_SI_A, TSCR_WG = 2 * 64 * C * 2;
__device__ __forceinline__ void ck_mm(f32x4 (&acc)[2], const bf16_t* Qm, const bf16_t* P, int jb, int ib0, int fr, int fq) {
#pragma unroll
    for (int ks = 0; ks < 2; ++ks) { const bf16x8 bq = *(const bf16x8*)(Qm + (16 * jb + fr) * CK_LD + 32 * ks + 8 * fq);
#pragma unroll
        for (int ii = 0; ii < 2; ++ii) { const bf16x8 ap = *(const bf16x8*)(P + (16 * (ib0 + ii) + fr) * CK_LD + 32 * ks + 8 * fq); acc[ii] = __builtin_amdgcn_mfma_f32_16x16x32_bf16(ap, bq, acc[ii], 0, 0, 0); } }
}
typedef short ck_s16x4 __attribute__((ext_vector_type(4)));
__device__ __forceinline__ bf16x8 ck_tr_frag(const bf16_t* X, int colbase, int ks, int lane) {
    const bf16_t* a0 = X + (32 * ks + 8 * (lane >> 4) + ((lane & 15) >> 2)) * CK_LD + colbase + 4 * (lane & 3);
    const ck_s16x4 lo = __builtin_amdgcn_ds_read_tr16_b64_v4i16((__attribute__((address_space(3))) ck_s16x4*)a0), hi = __builtin_amdgcn_ds_read_tr16_b64_v4i16((__attribute__((address_space(3))) ck_s16x4*)(a0 + 4 * CK_LD));
    return (bf16x8){lo[0], lo[1], lo[2], lo[3], hi[0], hi[1], hi[2], hi[3]};
}
template <bool TQ, bool TP> __device__ __forceinline__ void ck_mm_t(f32x4 (&acc)[2], const bf16_t* Qm, const bf16_t* P, int jb, int ib0, int fr, int fq) {
    const int lane = fq * 16 + fr;
#pragma unroll
    for (int ks = 0; ks < 2; ++ks) { const bf16x8 bq = TQ ? ck_tr_frag(Qm, 16 * jb, ks, lane) : *(const bf16x8*)(Qm + (16 * jb + fr) * CK_LD + 32 * ks + 8 * fq);
#pragma unroll
        for (int ii = 0; ii < 2; ++ii) { const bf16x8 ap = TP ? ck_tr_frag(P, 16 * (ib0 + ii), ks, lane) : *(const bf16x8*)(P + (16 * (ib0 + ii) + fr) * CK_LD + 32 * ks + 8 * fq); acc[ii] = __builtin_amdgcn_mfma_f32_16x16x32_bf16(ap, bq, acc[ii], 0, 0, 0); } }
}
__device__ __forceinline__ uint2 ck_pack4(const f32x4 v) { uint2 w; w.x = pg8::cvt_pk_bf16(v[0], v[1]); w.y = pg8::cvt_pk_bf16(v[2], v[3]); return w; }
__device__ __forceinline__ f32x4 ck_unpack4(const uint2 u) { return (f32x4){__builtin_bit_cast(float, u.x << 16), __builtin_bit_cast(float, u.x & 0xffff0000u), __builtin_bit_cast(float, u.y << 16), __builtin_bit_cast(float, u.y & 0xffff0000u)}; }
struct CkRaw { bf16x8 rc, rp, kc, kp, v, a, cs, cp, cl; };
__device__ __forceinline__ float wave_sum_dpp(float x) {
    x = reduce16(x); const int xi = __builtin_bit_cast(int, x);
    const float r0 = __builtin_bit_cast(float, __builtin_amdgcn_readlane(xi, 0)), r1 = __builtin_bit_cast(float, __builtin_amdgcn_readlane(xi, 16)), r2 = __builtin_bit_cast(float, __builtin_amdgcn_readlane(xi, 32)), r3 = __builtin_bit_cast(float, __builtin_amdgcn_readlane(xi, 48));
    return (r0 + r1) + (r2 + r3); }
__device__ __forceinline__ void ck_load(const ScanArgs& p, CkRaw& w, int unit, int tid) {
    const int chain = unit >> 6, chunk = unit & 63, b = chain >> 3, h = chain & 7, tk = tid >> 3, hc = h * 64 + (tid & 7) * 8;
    const size_t row = (size_t)b * SEQ + chunk * 64 + tk, o = row * C + hc;
    const bf16_t* pr = p.proj + row * IN_W + 768 + hc; const bf16x8 z8 = (bf16x8){0, 0, 0, 0, 0, 0, 0, 0};
    w.rc = *(const bf16x8*)pr; w.kc = *(const bf16x8*)(pr + 512);
    { const int t8 = tk & 7; const bool has = (chunk * 64 + tk - t8) > 0; const bf16_t* pp = pr - (size_t)(t8 + (has ? 1 : 0)) * IN_W;
      const bf16x8 a_ = *(const bf16x8*)pp, b_ = *(const bf16x8*)(pp + 512); w.rp = has ? a_ : z8; w.kp = has ? b_ : z8; }
    w.v = *(const bf16x8*)(p.V + o); w.a = *(const bf16x8*)(p.A + o);
    w.cs = *(const bf16x8*)(p.CS + o); { const int t8 = tk & 7; const bool has = (tk - t8) > 0; const bf16x8 c_ = *(const bf16x8*)(p.CS + o - (size_t)(t8 + (has ? 1 : 0)) * C); w.cp = has ? c_ : z8; }
    w.cl = *(const bf16x8*)(p.CS + (row - tk + 63) * C + hc);
}
__device__ __forceinline__ f32x4 csq_lo(const bf16x8 v) { return (f32x4){(float)(unsigned short)v[0], (float)(unsigned short)v[1], (float)(unsigned short)v[2], (float)(unsigned short)v[3]} * (-1.f / CS_SCALE); }
__device__ __forceinline__ f32x4 csq_hi(const bf16x8 v) { return (f32x4){(float)(unsigned short)v[4], (float)(unsigned short)v[5], (float)(unsigned short)v[6], (float)(unsigned short)v[7]} * (-1.f / CS_SCALE); }
__device__ __forceinline__ f32x4 exp4(const f32x4 v) { return (f32x4){__expf(v[0]), __expf(v[1]), __expf(v[2]), __expf(v[3])}; }
constexpr int CK_CONST_OFF = 136192;
__device__ __forceinline__ void ck_precompute(const ScanArgs& p, const CkRaw& raw, CkRaw& nxt, int next_unit, unsigned char* lds, bf16_t* GQ, bf16_t* CQ, int unit, int tid) {
    const int chain = unit >> 6, chunk = unit & 63, b = chain >> 3, h = chain & 7, wave = __builtin_amdgcn_readfirstlane(tid >> 6), lane = tid & 63, fr = lane & 15, fq = lane >> 4, jb = wave >> 1, ib0 = 2 * (wave & 1);
    bf16_t* At = (bf16_t*)(lds + 0 * CK_MAT); bf16_t* bt = (bf16_t*)(lds + 1 * CK_MAT); bf16_t* kt = (bf16_t*)(lds + 2 * CK_MAT); bf16_t* rt = (bf16_t*)(lds + 3 * CK_MAT);
    bf16_t* AtT = (bf16_t*)(lds + 4 * CK_MAT); bf16_t* BhT = (bf16_t*)(lds + 5 * CK_MAT); bf16_t* KhT = (bf16_t*)(lds + 6 * CK_MAT); bf16_t* VT = (bf16_t*)(lds + 7 * CK_MAT);
    bf16_t* NT = (bf16_t*)(lds + 8 * CK_MAT); bf16_t* Mm = (bf16_t*)(lds + 9 * CK_MAT); bf16_t* P1 = (bf16_t*)(lds + 10 * CK_MAT); bf16_t* P2 = (bf16_t*)(lds + 11 * CK_MAT);
    bf16_t* Ta = (bf16_t*)(lds + 12 * CK_MAT); bf16_t* Tb = (bf16_t*)(lds + 13 * CK_MAT); float* WT = (float*)(lds + 14 * CK_MAT); float* GL = WT + 512;
    bf16_t* W1T = bt; bf16_t* MVT = kt; bf16_t* W2T = At;
    {
        const int tk = tid >> 3, c8 = (tid & 7) * 8, ro = tk * CK_LD + c8;
        bf16_t* BhR = BhT; bf16_t* KhR = KhT; bf16_t* VR = VT;
        const float* KC = (const float*)(lds + CK_CONST_OFF) + h * 64 + c8;
        const f32x4 kc0 = *(const f32x4*)KC, kc1 = *(const f32x4*)(KC + 4), ac0 = *(const f32x4*)(KC + 512), ac1 = *(const f32x4*)(KC + 516), rc0 = *(const f32x4*)(KC + 1024), rc1 = *(const f32x4*)(KC + 1028), mu0 = *(const f32x4*)(KC + 1536), mu1 = *(const f32x4*)(KC + 1540);
        const f32x4 mk0 = *(const f32x4*)(KC + 2048), mk1 = *(const f32x4*)(KC + 2052);
        bf16x8 prv_r, prv_k, prv_c;
        { const bool first = (lane >> 3) == 0; pg8::u32x4 a_ = __builtin_bit_cast(pg8::u32x4, raw.rc), b_ = __builtin_bit_cast(pg8::u32x4, raw.kc), c_ = __builtin_bit_cast(pg8::u32x4, raw.cs);
          a_.x = __shfl_up((int)a_.x, 8); a_.y = __shfl_up((int)a_.y, 8); a_.z = __shfl_up((int)a_.z, 8); a_.w = __shfl_up((int)a_.w, 8);
          b_.x = __shfl_up((int)b_.x, 8); b_.y = __shfl_up((int)b_.y, 8); b_.z = __shfl_up((int)b_.z, 8); b_.w = __shfl_up((int)b_.w, 8);
          c_.x = __shfl_up((int)c_.x, 8); c_.y = __shfl_up((int)c_.y, 8); c_.z = __shfl_up((int)c_.z, 8); c_.w = __shfl_up((int)c_.w, 8);
          prv_r = first ? raw.rp : __builtin_bit_cast(bf16x8, a_); prv_k = first ? raw.kp : __builtin_bit_cast(bf16x8, b_); prv_c = first ? raw.cp : __builtin_bit_cast(bf16x8, c_); }
        const f32x4 x0 = bfx4_lo(raw.rc), x1 = bfx4_hi(raw.rc); const f32x4 r0 = x0 + (bfx4_lo(prv_r) - x0) * mu0, r1 = x1 + (bfx4_hi(prv_r) - x1) * mu1;
        const f32x4 y0 = bfx4_lo(raw.kc), y1 = bfx4_hi(raw.kc); const f32x4 k0 = y0 + (bfx4_lo(prv_k) - y0) * mk0, k1 = y1 + (bfx4_hi(prv_k) - y1) * mk1;
        const f32x4 a0 = bfx4_lo(raw.a), a1 = bfx4_hi(raw.a);
        const f32x4 c0 = csq_lo(raw.cs), c1 = csq_hi(raw.cs), p0 = csq_lo(prv_c), p1 = csq_hi(prv_c), l0 = csq_lo(raw.cl), l1 = csq_hi(raw.cl);
        f32x4 q0 = k0 * kc0, q1 = k1 * kc1;
        const f32x4 qq = q0 * q0 + q1 * q1; const float nrm = red8((qq.x + qq.y) + (qq.z + qq.w));
        const float inv = fminf(__builtin_amdgcn_rsqf(nrm), 1e12f); q0 = q0 * inv; q1 = q1 * inv;
        const f32x4 kp0 = k0 * (1.f + (a0 - 1.f) * ac0), kp1 = k1 * (1.f + (a1 - 1.f) * ac1);
        const f32x4 rr = r0 * kp0 * rc0 + r1 * kp1 * rc1; const float rkc = red8((rr.x + rr.y) + (rr.z + rr.w));
        if ((tid & 7) == 0) p.rkc[((size_t)b * SEQ + chunk * 64 + tk) * 8 + h] = rkc;
        const f32x4 em0 = exp4(p0), em1 = exp4(p1), en0 = exp4(-c0), en1 = exp4(-c1), ep0 = exp4(c0), ep1 = exp4(c1), eL0 = exp4(l0 - c0), eL1 = exp4(l1 - c1);
        const f32x4 b0 = q0 * a0, b1 = q1 * a1;
        *(bf16x8*)(At + ro) = pack8(-q0 * em0, -q1 * em1); *(bf16x8*)(bt + ro) = pack8(b0 * en0, b1 * en1); *(bf16x8*)(kt + ro) = pack8(kp0 * en0, kp1 * en1); *(bf16x8*)(rt + ro) = pack8(r0 * ep0, r1 * ep1);
        *(bf16x8*)(BhR + ro) = pack8(b0 * eL0, b1 * eL1); *(bf16x8*)(KhR + ro) = pack8(kp0 * eL0, kp1 * eL1); *(bf16x8*)(VR + ro) = raw.v;
        if (tk == 0) { *(f32x4*)(GL + c8) = exp4(l0); *(f32x4*)(GL + c8 + 4) = exp4(l1); }
    }
    __syncthreads();
    const int j = 16 * jb + fr; const f32x4 z4 = (f32x4){0.f, 0.f, 0.f, 0.f};
    { f32x4 aN[2] = {z4, z4}, aM[2] = {z4, z4}, aP1[2] = {z4, z4}, aP2[2] = {z4, z4};
      ck_mm(aN, At, bt, jb, ib0, fr, fq); ck_mm(aM, At, kt, jb, ib0, fr, fq); ck_mm(aP1, rt, bt, jb, ib0, fr, fq); ck_mm(aP2, rt, kt, jb, ib0, fr, fq);
#pragma unroll
      for (int ii = 0; ii < 2; ++ii) { const int i0 = 16 * (ib0 + ii) + 4 * fq; f32x4 t0, nt, mm, p1, p2;
#pragma unroll
          for (int e = 0; e < 4; ++e) { const int i = i0 + e; nt[e] = i < j ? aN[ii][e] : 0.f; t0[e] = nt[e] + (i == j ? 1.f : 0.f); mm[e] = i < j ? aM[ii][e] : 0.f; p1[e] = i <= j ? aP1[ii][e] : 0.f; p2[e] = i <= j ? aP2[ii][e] : 0.f; }
          *(uint2*)(Ta + j * CK_LD + i0) = ck_pack4(t0); *(uint2*)(NT + j * CK_LD + i0) = ck_pack4(nt); *(uint2*)(Mm + j * CK_LD + i0) = ck_pack4(mm); *(uint2*)(P1 + j * CK_LD + i0) = ck_pack4(p1); *(uint2*)(P2 + j * CK_LD + i0) = ck_pack4(p2); } }
    __syncthreads();
#pragma unroll
    for (int st = 0; st < 3; ++st) { const bf16_t* src = (st & 1) ? Tb : Ta; bf16_t* dst = (st & 1) ? Ta : Tb; f32x4 a2[2] = {z4, z4}; ck_mm_t<false, true>(a2, src, NT, jb, ib0, fr, fq);
#pragma unroll
        for (int ii = 0; ii < 2; ++ii) { const int i0 = 16 * (ib0 + ii) + 4 * fq; f32x4 t = a2[ii];
#pragma unroll
            for (int e = 0; e < 4; ++e) t[e] += (i0 + e == j) ? 1.f : 0.f;
            *(uint2*)(dst + j * CK_LD + i0) = ck_pack4(t); }
        __syncthreads(); }
    { f32x4 a1[2] = {z4, z4}, a2[2] = {z4, z4}; ck_mm_t<true, false>(a1, At, Tb, jb, ib0, fr, fq); ck_mm_t<true, false>(a2, VT, Mm, jb, ib0, fr, fq);
#pragma unroll
      for (int ii = 0; ii < 2; ++ii) { const int i0 = 16 * (ib0 + ii) + 4 * fq; *(uint2*)(W1T + j * CK_LD + i0) = ck_pack4(a1[ii]); *(uint2*)(MVT + j * CK_LD + i0) = ck_pack4(a2[ii]); } }
    __syncthreads();
    { f32x4 a1[2] = {z4, z4}; ck_mm(a1, MVT, Tb, jb, ib0, fr, fq);
#pragma unroll
      for (int ii = 0; ii < 2; ++ii) { const int i0 = 16 * (ib0 + ii) + 4 * fq; *(uint2*)(W2T + j * CK_LD + i0) = ck_pack4(a1[ii]); } }
    __syncthreads();
    ck_load(p, nxt, next_unit, tid);
    { f32x4 aQ1[2] = {z4, z4}, aG[2] = {z4, z4}, aQ2[2] = {z4, z4}, aC[2] = {z4, z4};
      ck_mm(aQ1, P1, W1T, jb, ib0, fr, fq); ck_mm_t<true, false>(aG, BhT, W1T, jb, ib0, fr, fq); ck_mm(aQ2, P1, W2T, jb, ib0, fr, fq); ck_mm_t<false, true>(aQ2, P2, VT, jb, ib0, fr, fq); ck_mm_t<false, true>(aC, W2T, BhT, jb, ib0, fr, fq); ck_mm_t<true, true>(aC, VT, KhT, jb, ib0, fr, fq);
      bf16_t* gq = GQ + (size_t)unit * 8192; bf16_t* cq = CQ + (size_t)unit * 8192; const float glj = GL[j];
#pragma unroll
      for (int ii = 0; ii < 2; ++ii) { const int i0 = 16 * (ib0 + ii) + 4 * fq; f32x4 g = aG[ii];
#pragma unroll
          for (int e = 0; e < 4; ++e) g[e] += (i0 + e == j) ? glj : 0.f;
          const f32x4 q1 = aQ1[ii] + ck_unpack4(*(const uint2*)(rt + j * CK_LD + i0));
          *(uint2*)(AtT + j * CK_LD + i0) = ck_pack4(g); *(uint2*)(NT + j * CK_LD + i0) = ck_pack4(q1); *(uint2*)(Mm + j * CK_LD + i0) = ck_pack4(aC[ii]); *(uint2*)(Ta + j * CK_LD + i0) = ck_pack4(aQ2[ii]); }
      __syncthreads();
      { const int row = tid >> 3, c8 = (tid & 7) * 8, lo_ = row * CK_LD + c8, go_ = row * 64 + c8;
        const pg8::u32x4 v0 = *(const pg8::u32x4*)(AtT + lo_), v1 = *(const pg8::u32x4*)(NT + lo_), v2 = *(const pg8::u32x4*)(Mm + lo_), v3 = *(const pg8::u32x4*)(Ta + lo_);
        *(pg8::u32x4*)(gq + go_) = v0; *(pg8::u32x4*)(gq + 4096 + go_) = v1; { const int bo_ = (c8 >> 4) * 1024 + row * 16 + (c8 & 15);
          *(pg8::u32x4*)(cq + bo_) = v2; *(pg8::u32x4*)(cq + 4096 + bo_) = v3; } } }
    if (next_unit == unit) __syncthreads();
}
__device__ __forceinline__ void ck_sequential(const ScanArgs& p, unsigned char* lds, const bf16_t* GQ, const bf16_t* CQ, int item, int tid) {
    const int chain = item >> 2, q = item & 3, b = chain >> 3, h = chain & 7, wave = __builtin_amdgcn_readfirstlane(tid >> 6), lane = tid & 63, fr = lane & 15, fq = lane >> 4;
    bf16_t* OPS = (bf16_t*)lds;
    bf16_t* HT = (bf16_t*)(lds + 4 * CK_MAT);
    for (int i = tid; i < 2 * 16 * CK_LD / 2; i += NTHREADS_) ((unsigned*)HT)[i] = 0u;
    const size_t ubase = (size_t)chain * 64; const size_t rowbase = (size_t)b * SEQ;
    const int prow0 = tid >> 3, pcol = (tid & 7) * 8;
    const int aoff = wave < 4 ? (4096 + q * 1024 + (16 * wave + fr) * 16 + 4 * fq) : ((wave - 4) * 1024 + (16 * q + fr) * 16 + 4 * fq);
    typedef unsigned u32x2_ __attribute__((ext_vector_type(2)));
    pg8::u32x4 g0_0, g0_1, g0_2, g0_3, g0_4, g0_5, g0_6, g0_7, g1_0, g1_1, g1_2, g1_3, g1_4, g1_5, g1_6, g1_7; u32x2_ ad_0, ad_1, ad_2, ad_3, ad_4, ad_5, ad_6, ad_7;
#define CK_FETCH(slot, cc) do { const int c_ = (cc) < 64 ? (cc) : 63;     \
        const bf16_t* gq = GQ + (ubase + c_) * 8192; g0_##slot = *(const pg8::u32x4*)(gq + (size_t)prow0 * 64 + pcol); g1_##slot = *(const pg8::u32x4*)(gq + (size_t)(prow0 + 64) * 64 + pcol); \
        ad_##slot = *(const u32x2_*)(CQ + (ubase + c_) * 8192 + aoff); } while (0)
#define CK_STAGE(slot, buf) do { *(pg8::u32x4*)(OPS + (buf) * 2 * 64 * CK_LD + prow0 * CK_LD + pcol) = g0_##slot; *(pg8::u32x4*)(OPS + (buf) * 2 * 64 * CK_LD + 64 * CK_LD + prow0 * CK_LD + pcol) = g1_##slot; } while (0)
    CK_FETCH(0, 0); CK_FETCH(1, 1); CK_FETCH(2, 2); CK_FETCH(3, 3); CK_FETCH(4, 4); CK_FETCH(5, 5); CK_FETCH(6, 6); CK_FETCH(7, 7);
    CK_STAGE(0, 0);
    __syncthreads();
#define CK_STEP(cc, slot, nslot) do { const int bi = (cc) & 1; const bf16_t* Gm = OPS + bi * 2 * 64 * CK_LD; const bf16_t* Q1m = Gm + 64 * CK_LD; const bf16_t* HTc = HT + bi * 16 * CK_LD; bf16_t* HTn = HT + (bi ^ 1) * 16 * CK_LD; \
        f32x4 acc = (f32x4){0.f, 0.f, 0.f, 0.f}; \
        if (wave < 4) { _Pragma("unroll") for (int ks = 0; ks < 2; ++ks) acc = __builtin_amdgcn_mfma_f32_16x16x32_bf16(*(const bf16x8*)(HTc + fr * CK_LD + 32 * ks + 8 * fq), *(const bf16x8*)(Q1m + (16 * wave + fr) * CK_LD + 32 * ks + 8 * fq), acc, 0, 0, 0); \
            acc = acc + ck_unpack4((uint2){ad_##slot.x, ad_##slot.y}); \
            *(uint2*)(p.yt + ((((size_t)chain * 64 + (cc)) * 4 + q) * 64 + 16 * wave + fr) * 16 + 4 * fq) = ck_pack4(acc); } \
        else { _Pragma("unroll") for (int ks = 0; ks < 2; ++ks) acc = __builtin_amdgcn_mfma_f32_16x16x32_bf16(*(const bf16x8*)(Gm + (16 * (wave - 4) + fr) * CK_LD + 32 * ks + 8 * fq), *(const bf16x8*)(HTc + fr * CK_LD + 32 * ks + 8 * fq), acc, 0, 0, 0); \
            acc = acc + ck_unpack4((uint2){ad_##slot.x, ad_##slot.y}); \
            *(uint2*)(HTn + fr * CK_LD + 16 * (wave - 4) + 4 * fq) = ck_pack4(acc); } \
        CK_STAGE(nslot, bi ^ 1); \
        CK_FETCH(slot, (cc) + 8); \
        __syncthreads(); } while (0)
    for (int c = 0; c < 64; c += 8) { CK_STEP(c, 0, 1); CK_STEP(c + 1, 1, 2); CK_STEP(c + 2, 2, 3); CK_STEP(c + 3, 3, 4); CK_STEP(c + 4, 4, 5); CK_STEP(c + 5, 5, 6); CK_STEP(c + 6, 6, 7); CK_STEP(c + 7, 7, 0); }
#undef CK_FETCH
#undef CK_STAGE
#undef CK_STEP
}

struct PostRaw { bf16x8 y, v, g; float rk; f32x4 lg0, lg1, lb0, lb1; };
__device__ __forceinline__ void scan_post_load(const ScanArgs& p, PostRaw& w, int item, int lane) {
    const int tg = item & 7, chunk = (item >> 3) & 63, chain = item >> 9, b = chain >> 3, h = chain & 7, tl = lane >> 3, j = lane & 7, t = 8 * tg + tl;
    const size_t m = (size_t)b * SEQ + chunk * 64 + t;
    w.y = *(const bf16x8*)(p.yt + ((((size_t)chain * 64 + chunk) * 4 + (j >> 1)) * 64 + t) * 16 + (j & 1) * 8);
    w.v = *(const bf16x8*)(p.V + m * C + h * 64 + 8 * j); w.g = *(const bf16x8*)(p.G + m * C + h * 64 + 8 * j); w.rk = p.rkc[m * 8 + h];
    const float* lp = p.lnx_g + h * 64 + 8 * j; const float* bp = p.lnx_b + h * 64 + 8 * j;
    w.lg0 = *(const f32x4*)lp; w.lg1 = *(const f32x4*)(lp + 4); w.lb0 = *(const f32x4*)bp; w.lb1 = *(const f32x4*)(bp + 4);
}
__device__ __forceinline__ void scan_post_item(const ScanArgs& p, const PostRaw& w, int item, int lane) {
    const int tg = item & 7, chunk = (item >> 3) & 63, chain = item >> 9, b = chain >> 3, h = chain & 7, tl = lane >> 3, j = lane & 7;
    const size_t m = (size_t)b * SEQ + chunk * 64 + 8 * tg + tl;
    f32x4 y0 = bfx4_lo(w.y), y1 = bfx4_hi(w.y);
    const float mean = red8((y0.x + y0.y) + (y0.z + y0.w) + (y1.x + y1.y) + (y1.z + y1.w)) * (1.f / 64.f);
    y0 = y0 - mean; y1 = y1 - mean;
    const float var = red8((y0.x * y0.x + y0.y * y0.y) + (y0.z * y0.z + y0.w * y0.w) + (y1.x * y1.x + y1.y * y1.y) + (y1.z * y1.z + y1.w * y1.w)) * (1.f / 64.f);
    const float rs = rsqrtf(var + LNX_EPS);
    const f32x4 o0 = (y0 * rs * w.lg0 + w.lb0 + bfx4_lo(w.v) * w.rk) * bfx4_lo(w.g), o1 = (y1 * rs * w.lg1 + w.lb1 + bfx4_hi(w.v) * w.rk) * bfx4_hi(w.g);
    *(bf16x8*)(p.mix + m * D + ATT_W + h * 64 + 8 * j) = pack8(o0, o1);
}
__device__ __forceinline__ void scan_post_wave(const ScanArgs& p, int gw, int ngw, int lane) {
    constexpr int NITEM = BATCH * NH * 64 * 8;
    int item = gw; if (item >= NITEM) return;
    PostRaw cur; scan_post_load(p, cur, item, lane);
    for (; item < NITEM; item += ngw) { PostRaw nxt = cur; if (item + ngw < NITEM) scan_post_load(p, nxt, item + ngw, lane);
        scan_post_item(p, cur, item, lane); cur = nxt; }
}

typedef float f32x16 __attribute__((ext_vector_type(16)));
typedef short s16x4 __attribute__((ext_vector_type(4)));
constexpr int AT_VLD = 96;
__device__ __forceinline__ int crow(int r, int hi) { return (r & 3) + 8 * (r >> 2) + 4 * hi; }
constexpr int AT_KLD = 72;
__device__ __forceinline__ void attn_phase(const bf16_t* __restrict__ proj, const float* __restrict__ sinks, bf16_t* __restrict__ mix, unsigned char* lds, int G, int tid) {
    bf16_t* ks_ = (bf16_t*)lds; bf16_t* vs_ = (bf16_t*)(lds + 192 * AT_KLD * 2);
    const int g = __builtin_amdgcn_readfirstlane(tid >> 7), half = __builtin_amdgcn_readfirstlane((tid >> 6) & 1);
    constexpr int NU = BATCH * 2 * (SEQ / 64);
    bf16x8 pk0, pk1, pk2, pv0, pv1, pv2, pq0, pq1, pq2, pq3;
#define AT_PIECE(it, kdst, vdst, un) do { const int i_ = tq + 512 * (it), kl_ = i_ >> 3, ch8_ = i_ & 7; int key_ = ((un) & 63) * 64 - 128 + kl_; key_ = key_ < 0 ? 0 : key_;     \
        const bf16_t* rp_ = proj + ((size_t)((un) >> 7) * SEQ + key_) * IN_W + 512 + (((un) >> 6) & 1) * 64 + ch8_ * 8; kdst = *(const bf16x8*)rp_; vdst = *(const bf16x8*)(rp_ + KV_W); } while (0)
#define AT_FETCH(un) do { AT_PIECE(0, pk0, pv0, un); AT_PIECE(1, pk1, pv1, un); AT_PIECE(2, pk2, pv2, un); \
        { const int l_ = tq & 63; const bf16_t* qp_ = proj + ((size_t)((un) >> 7) * SEQ + ((un) & 63) * 64 + 32 * half + (l_ & 31)) * IN_W + ((((un) >> 6) & 1) * 4 + g) * 64 + 8 * (l_ >> 5); \
          pq0 = *(const bf16x8*)qp_; pq1 = *(const bf16x8*)(qp_ + 16); pq2 = *(const bf16x8*)(qp_ + 32); pq3 = *(const bf16x8*)(qp_ + 48); } } while (0)
#define AT_STAGE(it, ksrc, vsrc) do { const int i_ = tq + 512 * (it), kl_ = i_ >> 3, ch8_ = i_ & 7; *(bf16x8*)(ks_ + kl_ * AT_KLD + ch8_ * 8) = ksrc; *(bf16x8*)(vs_ + kl_ * AT_VLD + ch8_ * 8) = vsrc; } while (0)
    int tq = tid; int unit = blockIdx.x; if (unit < NU) AT_FETCH(unit);
    for (; unit < NU; unit += G) {
        const int b = unit >> 7, kvh = (unit >> 6) & 1, qb = unit & 63, Q0 = qb * 64, h = kvh * 4 + g; const size_t rowb = (size_t)b * SEQ;
        asm volatile("" : "+v"(tq));
        const int lane = tq & 63, c = lane & 31, hi = lane >> 5;
        AT_STAGE(0, pk0, pv0); AT_STAGE(1, pk1, pv1); AT_STAGE(2, pk2, pv2);
        const bf16x8 qf[4] = {pq0, pq1, pq2, pq3};
        __syncthreads();
        if (unit + G < NU) AT_FETCH(unit + G);
        const int t0 = Q0 + 32 * half; const size_t mq = rowb + t0 + c;
        f32x16 p[5];
#pragma unroll
        for (int kb = 0; kb < 5; ++kb) { const bf16_t* kp = ks_ + (32 * half + 32 * kb + c) * AT_KLD + 8 * hi;
            f32x16 acc;
#pragma unroll
            for (int r = 0; r < 16; ++r) acc[r] = 0.f;
#pragma unroll
            for (int ks = 0; ks < 4; ++ks) acc = __builtin_amdgcn_mfma_f32_32x32x16_bf16(*(const bf16x8*)(kp + 16 * ks), qf[ks], acc, 0, 0, 0);
            p[kb] = acc; }
        const float slope = exp2f(-(float)(h + 1)) * 1.44269504089f, sink = sinks[h] * 1.44269504089f;
        float mx = sink;
        const float bl = -slope * (float)(c + 128 - 4 * hi);
        const bool seq_start = (t0 < 128);
#pragma unroll
        for (int kb = 0; kb < 5; ++kb)
#pragma unroll
            for (int r = 0; r < 16; ++r) { const int cr0 = (r & 3) + 8 * (r >> 2), cr = cr0 + 4 * hi;
                float sc = p[kb][r] * (0.125f * 1.44269504089f) + (bl + slope * (float)(32 * kb + cr0));
                if (kb == 0) sc = (cr > c) ? sc : -1e30f;
                if (kb == 4) sc = (cr <= c) ? sc : -1e30f;
                if (seq_start) sc = (t0 - 128 + 32 * kb + cr >= 0) ? sc : -1e30f;
                p[kb][r] = sc; mx = fmaxf(mx, sc); }
        mx = fmaxf(mx, __shfl_xor(mx, 32));
        float l = 0.f;
#pragma unroll
        for (int kb = 0; kb < 5; ++kb)
#pragma unroll
            for (int r = 0; r < 16; ++r) { const float e = __builtin_amdgcn_exp2f(p[kb][r] - mx); p[kb][r] = e; l += e; }
        l += __shfl_xor(l, 32); l += __builtin_amdgcn_exp2f(sink - mx);
        f32x16 o[2];
#pragma unroll
        for (int d = 0; d < 2; ++d)
#pragma unroll
            for (int r = 0; r < 16; ++r) o[d][r] = 0.f;
#pragma unroll
        for (int kb = 0; kb < 5; ++kb)
#pragma unroll
            for (int s2 = 0; s2 < 2; ++s2) {
                pg8::u32x4 pw; pw.x = pg8::cvt_pk_bf16(p[kb][8 * s2 + 0], p[kb][8 * s2 + 1]); pw.y = pg8::cvt_pk_bf16(p[kb][8 * s2 + 2], p[kb][8 * s2 + 3]);
                pw.z = pg8::cvt_pk_bf16(p[kb][8 * s2 + 4], p[kb][8 * s2 + 5]); pw.w = pg8::cvt_pk_bf16(p[kb][8 * s2 + 6], p[kb][8 * s2 + 7]);
                const bf16x8 pf = __builtin_bit_cast(bf16x8, pw);
#pragma unroll
                for (int d = 0; d < 2; ++d) {
                    const bf16_t* vp = vs_ + (32 * half + 32 * kb + 16 * s2 + 4 * hi + ((lane & 15) >> 2)) * AT_VLD + 32 * d + 16 * ((lane >> 4) & 1) + 4 * (lane & 3);
                    const s16x4 lo = __builtin_amdgcn_ds_read_tr16_b64_v4i16((__attribute__((address_space(3))) s16x4*)vp), hh = __builtin_amdgcn_ds_read_tr16_b64_v4i16((__attribute__((address_space(3))) s16x4*)(vp + 8 * AT_VLD));
                    const bf16x8 vf = (bf16x8){lo[0], lo[1], lo[2], lo[3], hh[0], hh[1], hh[2], hh[3]};
                    o[d] = __builtin_amdgcn_mfma_f32_32x32x16_bf16(vf, pf, o[d], 0, 0, 0); } }
        const float inv = __builtin_amdgcn_rcpf(l);
#pragma unroll
        for (int d = 0; d < 2; ++d)
#pragma unroll
            for (int rp = 0; rp < 2; ++rp) {
                unsigned ax = pg8::cvt_pk_bf16(o[d][8 * rp] * inv, o[d][8 * rp + 1] * inv), ay = pg8::cvt_pk_bf16(o[d][8 * rp + 2] * inv, o[d][8 * rp + 3] * inv);
                unsigned bx = pg8::cvt_pk_bf16(o[d][8 * rp + 4] * inv, o[d][8 * rp + 5] * inv), by = pg8::cvt_pk_bf16(o[d][8 * rp + 6] * inv, o[d][8 * rp + 7] * inv);
                const auto r0 = __builtin_amdgcn_permlane32_swap(ax, bx, false, false); const auto r1 = __builtin_amdgcn_permlane32_swap(ay, by, false, false);
                pg8::u32x4 w; w.x = r0[0]; w.y = r1[0]; w.z = r0[1]; w.w = r1[1];
                *(pg8::u32x4*)(mix + mq * D + h * 64 + 32 * d + 16 * rp + 8 * hi) = w; }
        __syncthreads();
    }
#undef AT_PIECE
#undef AT_FETCH
#undef AT_STAGE
}

__device__ __forceinline__ void ffn_fixup(const float* __restrict__ SB, const float* __restrict__ cw, const float* __restrict__ cb, bf16_t* hid, int pm, int tid) {
    pm = __builtin_amdgcn_readfirstlane(pm);
    const float* s = SB + (size_t)pm * 6 * FF; const float* sp = SB + (size_t)(pm - 1) * 6 * FF; const bool has_prev = (pm % (SEQ / 256)) != 0;
    static_assert(2 * FF == 11 * NTHREADS_, "ffn_fixup: 11 items per thread");
    float u0[11], u1[11], ul0[11], ul1[11], w0[11], w1[11], w2[11], bb[11], up[11];
#pragma unroll
    for (int it = 0; it < 11; ++it) { const int idx = tid + NTHREADS_ * it, rr = idx >= FF ? 1 : 0, j = idx - rr * FF;
        u0[it] = s[j]; u1[it] = s[FF + j]; ul0[it] = has_prev ? sp[4 * FF + j] : 0.f; ul1[it] = has_prev ? sp[5 * FF + j] : 0.f;
        w0[it] = cw[j]; w1[it] = cw[FF + j]; w2[it] = cw[2 * FF + j]; bb[it] = cb[j]; up[it] = s[(2 + rr) * FF + j]; }
#pragma unroll
    for (int it = 0; it < 11; ++it) { const int idx = tid + NTHREADS_ * it, rr = idx >= FF ? 1 : 0, j = idx - rr * FF;
        const float c = rr == 0 ? bb[it] + w0[it] * ul0[it] + w1[it] * ul1[it] + w2[it] * u0[it] : bb[it] + w0[it] * ul1[it] + w1[it] * u0[it] + w2[it] * u1[it];
        hid[(size_t)(pm * 256 + rr) * FF + j] = (bf16_t)f2bf(c * sigmoidf_(c) * up[it]); }
}

#define XB_TMO      128
#define XB_XCNT(j)  (256  + 64 * (j))
#define XB_XSUB(j)  (1280 + 64 * (j))
#define XB_XGEN(j)  (2304 + 64 * (j))
#define XB_TOP      3328
#define XB_TOPGEN   3392
#define XCD_BAR_WORDS 3456
#define XB_SPIN_CAP (1u << 18)

__device__ __forceinline__ unsigned xb_ld(unsigned* p)              { return __hip_atomic_load(p, __ATOMIC_RELAXED, __HIP_MEMORY_SCOPE_AGENT); }
__device__ __forceinline__ unsigned xb_add(unsigned* p, unsigned v) { return __hip_atomic_fetch_add(p, v, __ATOMIC_RELAXED, __HIP_MEMORY_SCOPE_AGENT); }
__device__ __forceinline__ unsigned xb_xcc_id() { return (unsigned)__builtin_amdgcn_s_getreg((3 << 11) | 20) & 0xFu; }
#define XB_SPIN(cond, bar) do { unsigned _sp = 0; while (cond) { __builtin_amdgcn_s_sleep(1); \
    if ((++_sp & 255u) == 0u) { if (xb_ld(&(bar)[XB_TMO])) break; if (_sp > XB_SPIN_CAP) { atomicAdd(&(bar)[XB_TMO], 1u); break; } } } } while (0)

struct XcdBarrier {
    unsigned* bar; unsigned x;
    volatile __attribute__((address_space(3))) unsigned* st;
};

__device__ __forceinline__ XcdBarrier xcd_barrier_post(unsigned* bar, volatile __attribute__((address_space(3))) unsigned* st) {
    XcdBarrier b; b.bar = bar; b.x = xb_xcc_id(); b.st = st;
    if (threadIdx.x == 0) (void)xb_add(&bar[XB_XCNT(b.x)], 1u);
    return b;
}
__device__ __forceinline__ void xcd_barrier_complete(unsigned* bar, unsigned x, unsigned& nloc, unsigned& nx) {
    const unsigned G = gridDim.x * gridDim.y * gridDim.z;
    unsigned sum, cnt, mine, sp = 0u;
    for (;;) {
        sum = 0u; cnt = 0u; mine = 0u;
#pragma unroll
        for (unsigned j = 0; j < 16; ++j) { const unsigned c = xb_ld(&bar[XB_XCNT(j)]); sum += c; cnt += (c > 0u) ? 1u : 0u; mine = (j == x) ? c : mine; }
        if (sum == G) break;
        __builtin_amdgcn_s_sleep(1);
        if ((++sp & 255u) == 0u) { if (xb_ld(&bar[XB_TMO])) break; if (sp > XB_SPIN_CAP) { atomicAdd(&bar[XB_TMO], 1u); break; } }
    }
    nloc = mine > 0u ? mine : 1u; nx = cnt > 0u ? cnt : 1u;
}

__device__ __forceinline__ void xcd_barrier(const XcdBarrier& b) {
    asm volatile("s_waitcnt vmcnt(0)" ::: "memory");
    __syncthreads();
    if (threadIdx.x == 0) {
        unsigned* bar = b.bar;
        __builtin_amdgcn_s_waitcnt(0);
        unsigned nloc = b.st[0], nx = b.st[1];
        if (nloc == 0u) { xcd_barrier_complete(bar, b.x, nloc, nx); b.st[0] = nloc; b.st[1] = nx; }
        const unsigned old = xb_add(&bar[XB_XSUB(b.x)], 1u);
        const unsigned gen = old / nloc;
        if (old + 1u == (gen + 1u) * nloc) {
            __builtin_amdgcn_fence(__ATOMIC_RELEASE, "agent");
            asm volatile("s_waitcnt vmcnt(0)" ::: "memory");
            const unsigned og = xb_add(&bar[XB_TOP], 1u);
            const unsigned tg = og / nx;
            if (og + 1u == (tg + 1u) * nx) xb_add(&bar[XB_TOPGEN], 1u);
            else XB_SPIN(xb_ld(&bar[XB_TOPGEN]) == tg, bar);
            __builtin_amdgcn_fence(__ATOMIC_ACQUIRE, "agent");
            xb_add(&bar[XB_XGEN(b.x)], 1u);
            asm volatile("s_waitcnt vmcnt(0)" ::: "memory");
        } else {
            XB_SPIN(xb_ld(&bar[XB_XGEN(b.x)]) == gen, bar);
            __builtin_amdgcn_fence(__ATOMIC_ACQUIRE, "agent");
            asm volatile("s_waitcnt vmcnt(0)" ::: "memory");
        }
    }
    __syncthreads();
}

constexpr int NTHREADS = 512, LDS_BYTES = 147456;
struct Args { const float* in[26]; float* out; unsigned char* ws; };
__global__ void __launch_bounds__(NTHREADS, 2) mega_fwd(Args a) {
    extern __shared__ __attribute__((aligned(16))) unsigned char lds[];
    constexpr int MISC_OFF = 131072 + 4096;
    { volatile __attribute__((address_space(3))) unsigned* misc = (volatile __attribute__((address_space(3))) unsigned*)((__attribute__((address_space(3))) unsigned char*)lds + MISC_OFF);
      if (threadIdx.x < 4) misc[threadIdx.x] = 0u; }
    __syncthreads();
    (void)xcd_barrier_post((unsigned*)(a.ws + WS_BAR), (volatile __attribute__((address_space(3))) unsigned*)((__attribute__((address_space(3))) unsigned char*)lds + MISC_OFF));
#define GRID_SYNC() do { XcdBarrier xb_; xb_.bar = (unsigned*)(a.ws + WS_BAR); xb_.x = xb_xcc_id(); xb_.st = (volatile __attribute__((address_space(3))) unsigned*)((__attribute__((address_space(3))) unsigned char*)lds + MISC_OFF); xcd_barrier(xb_); } while (0)
#define LDSP ((PG8_LAS unsigned char*)lds)
    constexpr int XCH_OFF = 131072;
#define OTID() ({ int _t = threadIdx.x; asm volatile("" : "+v"(_t)); _t; })
    const int G = gridDim.x, NGW = G * 8;
    const float* x = a.in[0]; const float* norm1_g = a.in[1]; const float* w_in = a.in[2]; const float* sinks = a.in[3];
    const float* mu = a.in[4]; const float* w0 = a.in[5]; const float* w2 = a.in[6]; const float* a0 = a.in[7];
    const float* a2 = a.in[8]; const float* g2 = a.in[9]; const float* k_k = a.in[10]; const float* k_a = a.in[11];
    const float* r_k = a.in[12]; const float* lnx_g = a.in[13]; const float* lnx_b = a.in[14]; const float* v0 = a.in[15];
    const float* v1 = a.in[16]; const float* v2 = a.in[17]; const float* w_out = a.in[18]; const float* norm2_g = a.in[19];
    const float* wg = a.in[20]; const float* wu = a.in[21]; const float* conv_w = a.in[22]; const float* conv_b = a.in[23];
    const float* wd = a.in[24]; const float* final_g = a.in[25];
    unsigned char* ws = a.ws; float* X = a.out;
    ssq_t* ss = (ssq_t*)(ws + WS_SS);
    bf16_t* XB = (bf16_t*)(ws + WS_XB); bf16_t* PROJ = (bf16_t*)(ws + WS_PROJ); bf16_t* MIX = (bf16_t*)(ws + WS_MIX); bf16_t* HID = (bf16_t*)(ws + WS_HID); bf16_t* VF = (bf16_t*)(ws + WS_VFIRST);
    bf16_t* UT = (bf16_t*)(ws + WS_UTMP); bf16_t* UPT = UT + (size_t)SEQ * FF;

    {
        const int tid = OTID(), lane = tid & 63, wave = tid >> 6, gw = blockIdx.x * 8 + wave;
        float* scr = (float*)lds + wave * (64 * 33 + 16);
        constexpr int I_IN = (D / 64) * (IN_W / 32), I_OUT = (D / 64) * (D / 32), I_G = (D / 64) * (FF / 32), I_DN = (FF / 64) * (D / 32), I_LAYER = I_IN + I_OUT + 2 * I_G + I_DN;
        for (int it = gw; it < 2 * I_LAYER; it += NGW) {
            const int l = it / I_LAYER; int r = it % I_LAYER;
            bf16_t* wl = (bf16_t*)(ws + WS_W + l * W_LAYER); bf16_t* WinT = wl; bf16_t* WoutT = (bf16_t*)((char*)wl + W_IN_SZ); bf16_t* WguT = (bf16_t*)((char*)WoutT + W_OUT_SZ); bf16_t* WdT = (bf16_t*)((char*)WguT + W_GU_SZ);
            if (r < I_IN) { transpose_item(w_in + (size_t)l * D * IN_W, D, IN_W, WinT, norm1_g + l * D, 0, scr, r, lane); continue; } r -= I_IN;
            if (r < I_OUT) { transpose_item(w_out + (size_t)l * D * D, D, D, WoutT, nullptr, 0, scr, r, lane); continue; } r -= I_OUT;
            if (r < I_G) { transpose_item(wg + (size_t)l * D * FF, D, FF, WguT, norm2_g + l * D, 1, scr, r, lane); continue; } r -= I_G;
            if (r < I_G) { transpose_item(wu + (size_t)l * D * FF, D, FF, WguT, norm2_g + l * D, 2, scr, r, lane); continue; } r -= I_G;
            transpose_item(wd + (size_t)l * FF * D, FF, D, WdT, nullptr, 0, scr, r, lane);
        }
        {
            constexpr int I_W2 = 1 * (C / 32), I_G2 = 2 * (C / 32), I_V1 = (C / 64) * 1, I_L = 2 * I_W2 + I_G2;
            const float* mu_v1 = a.in[4] + SHIFT_W + 1024;
            for (int it = gw; it < 2 * I_L + 2 * I_V1; it += NGW) {
                if (it < 2 * I_L) { const int l = it / I_L; int r = it % I_L; bf16_t* base = (bf16_t*)(ws + WS_LORA + l * LORA_LAYER);
                    if (r < I_W2) { transpose_item(w2 + (size_t)l * 64 * C, 64, C, base, nullptr, 0, scr, r, lane); continue; } r -= I_W2;
                    if (r < I_W2) { transpose_item(a2 + (size_t)l * 64 * C, 64, C, base + 512 * 64, nullptr, 0, scr, r, lane); continue; } r -= I_W2;
                    transpose_item(g2 + (size_t)l * 128 * C, 128, C, base + 2 * 512 * 64, nullptr, 0, scr, r, lane); }
                else if (it < 2 * I_L + I_V1) transpose_item(v1, C, 32, (bf16_t*)(ws + WS_V1T), mu_v1, 0, scr, it - 2 * I_L, lane, true);
                else transpose_item(v1, C, 32, (bf16_t*)(ws + WS_V1B), mu_v1, 0, scr, it - 2 * I_L - I_V1, lane, false);
            }
            bf16_t* V2T = (bf16_t*)(ws + WS_V2T);
            for (int i = blockIdx.x * NTHREADS + tid; i < 32 * C; i += G * NTHREADS) { const int j = i / C, ch = i % C; V2T[ch * 32 + j] = (bf16_t)f2bf(v2[i]); }
        }
        for (int m = 4 * gw; m < M; m += 4 * NGW) {
            f32x4 xv[4][4];
#pragma unroll
            for (int u = 0; u < 4; ++u)
#pragma unroll
                for (int j = 0; j < 4; ++j) xv[u][j] = ((const f32x4*)(x + (size_t)(m + u) * D))[lane + 64 * j];
#pragma unroll
            for (int u = 0; u < 4; ++u) { float sq = 0.f;
#pragma unroll
                for (int j = 0; j < 4; ++j) { const f32x4 v = xv[u][j]; sq += v.x * v.x + v.y * v.y + v.z * v.z + v.w * v.w;
                    ((unsigned long long*)(XB + (size_t)(m + u) * D))[lane + 64 * j] = (unsigned long long)(f2bf(v.x) | (f2bf(v.y) << 16)) | ((unsigned long long)(f2bf(v.z) | (f2bf(v.w) << 16)) << 32); }
                sq = wave_sum(sq); if (lane == 0) ss[m + u] = ssq_fix(sq); } }
    }
    GRID_SYNC();
    for (int l = 0; l < 2; ++l) {
        bf16_t* wl = (bf16_t*)(ws + WS_W + l * W_LAYER); bf16_t* WinT = wl; bf16_t* WoutT = (bf16_t*)((char*)wl + W_IN_SZ); bf16_t* WguT = (bf16_t*)((char*)WoutT + W_OUT_SZ); bf16_t* WdT = (bf16_t*)((char*)WguT + W_GU_SZ);
        ssq_t* ss1 = ss + (size_t)(2 * l) * M; ssq_t* ss2 = ss + (size_t)(2 * l + 1) * M; ssq_t* ss3 = ss + (size_t)(2 * l + 2) * M;
        { pg8::Gemm g{XB, WinT, M, IN_W, D}; pg8::StaticOrder S; S.init(M, IN_W, G, (int)blockIdx.x); pg8::EpiScaleBf16 E{PROJ, IN_W, ss1};
          pg8::gemm_phase<pg8::EpiScaleBf16, pg8::StaticOrder, true, true>(LDSP, g, S, E); }
        GRID_SYNC();
        { float* KC = (float*)(lds + CK_CONST_OFF); const int t_ = OTID(); KC[t_] = (k_k + l * C)[t_]; KC[512 + t_] = (k_a + l * C)[t_]; KC[1024 + t_] = (r_k + l * C)[t_]; KC[1536 + t_] = (mu + l * SHIFT_W)[t_]; KC[2048 + t_] = (mu + l * SHIFT_W)[512 + t_]; __syncthreads(); }
        attn_phase(PROJ, sinks + l * NH, MIX, lds, G, OTID());
        struct { bf16_t *V, *G; } p; p.V = (bf16_t*)(ws + WS_SI_V); p.G = (bf16_t*)(ws + WS_SI_G);
        bf16_t* GQ = (bf16_t*)X; bf16_t* CQ = GQ + (size_t)BATCH * NH * 64 * 8192;
        ScanArgs s{}; s.yt = (bf16_t*)(ws + WS_YT); s.proj = PROJ; s.V = p.V; s.G = p.G; s.k_k = k_k + l * C; s.k_a = k_a + l * C; s.r_k = r_k + l * C; s.lnx_g = lnx_g + l * C; s.lnx_b = lnx_b + l * C; s.mix = MIX; s.rkc = (float*)(ws + WS_RKC);
        { bf16_t* scr = (bf16_t*)(ws + WS_TSCR + (size_t)blockIdx.x * TSCR_WG);
          for (int tile = blockIdx.x; tile < M / 64; tile += G) {
              const size_t moff = (size_t)tile * 64 * C;
              Prep2Args q{}; q.proj = PROJ; q.mu = mu + l * SHIFT_W; q.w0 = w0 + l * C; q.a0 = a0 + l * C; q.v0 = v0;
              const bf16_t* lw = (const bf16_t*)(ws + WS_LORA + l * LORA_LAYER); q.W2T = lw; q.A2T = lw + 512 * 64; q.G2T = lw + 2 * 512 * 64; q.V1T = (const bf16_t*)(ws + WS_V1T); q.V1B = (const bf16_t*)(ws + WS_V1B); q.V2T = (const bf16_t*)(ws + WS_V2T);
              q.vfirst = VF; q.A = scr - moff; q.CS = (unsigned short*)(scr + 64 * C) - moff; q.V = p.V; q.G = p.G; q.layer = l;
              prep_tile(q, lds, tile, OTID());
              asm volatile("s_waitcnt vmcnt(0)" ::: "memory"); __syncthreads();
              if (threadIdx.x == 0) { __builtin_amdgcn_fence(__ATOMIC_ACQUIRE, "agent"); asm volatile("s_waitcnt vmcnt(0)" ::: "memory"); }
              __syncthreads();
              s.A = q.A; s.CS = q.CS;
              const int bb = tile >> 6, chunk = tile & 63;
              CkRaw cur; ck_load(s, cur, ((bb * NH) << 6) + chunk, OTID());
#define CK_UNIT(hh_) do { const int unit = ((bb * NH + (hh_)) << 6) + chunk; CkRaw nxt = cur; ck_precompute(s, cur, nxt, (hh_) + 1 < NH ? unit + 64 : unit, lds, GQ, CQ, unit, OTID()); cur = nxt; } while (0)
              CK_UNIT(0);
              for (int hh = 1; hh < NH; ++hh) CK_UNIT(hh);
#undef CK_UNIT
          } }
        GRID_SYNC();
        for (int item = (int)((blockIdx.x & 7) * (G >> 3) + (blockIdx.x >> 3)); item < BATCH * NH * 4; item += G) ck_sequential(s, lds, GQ, CQ, item, OTID());
        GRID_SYNC();
        { const int tid = OTID(), lane = tid & 63, gw = blockIdx.x * 8 + (tid >> 6); scan_post_wave(s, gw, NGW, lane); }
        GRID_SYNC();
        { pg8::Gemm g{MIX, WoutT, M, D, D}; pg8::StaticOrder S; S.init(M, D, G, (int)blockIdx.x); pg8::EpiResid E{XB, ss2};
          pg8::gemm_phase<pg8::EpiResid, pg8::StaticOrder, true, true>(LDSP, g, S, E); }
        GRID_SYNC();
        { pg8::Gemm g{XB, WguT, M, 2 * FF, D}; pg8::StaticOrder S; S.init(M, 2 * FF, G, (int)blockIdx.x);
          pg8::EpiConvGlu E{HID, ss2, conv_w + (size_t)l * 3 * FF, conv_b + (size_t)l * FF, (float*)(ws + WS_UTMP), (PG8_LAS float*)(LDSP + XCH_OFF), FF};
          pg8::gemm_phase<pg8::EpiConvGlu, pg8::StaticOrder, true, true>(LDSP, g, S, E); }
        GRID_SYNC();
        { pg8::Gemm g{HID, WdT, M, D, FF}; pg8::StaticOrder S; S.init(M, D, G, (int)blockIdx.x);
          { pg8::Unit u; for (int i = 0; S.next(i, u); ++i) ffn_fixup((const float*)(ws + WS_UTMP), conv_w + (size_t)l * 3 * FF, conv_b + (size_t)l * FF, HID, u.pm, OTID());
            asm volatile("s_waitcnt vmcnt(0)" ::: "memory"); __syncthreads(); }
          if (l == 0) { pg8::EpiResid E{XB, ss3}; pg8::gemm_phase<pg8::EpiResid, pg8::StaticOrder, true, true>(LDSP, g, S, E); }
          else { pg8::EpiResidFinal E{XB, ss3, (unsigned*)(ws + WS_FCNT), final_g, X};
                 pg8::gemm_phase<pg8::EpiResidFinal, pg8::StaticOrder, true, true>(LDSP, g, S, E); } }
        if (l == 0) GRID_SYNC();
    }
}

extern "C" void kernel_launch(void* const* d_in, const int* in_sizes, int n_in, void* d_out, int out_size, void* d_ws, size_t ws_size, hipStream_t stream) {
    static int grid = 0;
    if (grid == 0) {
        if (n_in != 26 || in_sizes[0] != M * D || out_size != M * D || ws_size < WS_END) { fprintf(stderr, "kernel_launch: unexpected shapes (n_in %d, ws %zu)\n", n_in, ws_size); grid = -1; return; }
        int dev = 0, cus = 0, per_cu = 0;
        if (hipGetDevice(&dev) != hipSuccess || hipDeviceGetAttribute(&cus, hipDeviceAttributeMultiprocessorCount, dev) != hipSuccess) { grid = -1; return; }
        if (hipFuncSetAttribute((const void*)mega_fwd, hipFuncAttributeMaxDynamicSharedMemorySize, LDS_BYTES) != hipSuccess) { fprintf(stderr, "kernel_launch: hipFuncSetAttribute failed\n"); grid = -1; return; }
        if (hipOccupancyMaxActiveBlocksPerMultiprocessor(&per_cu, (const void*)mega_fwd, NTHREADS, LDS_BYTES) != hipSuccess || per_cu < 1) { fprintf(stderr, "kernel_launch: occupancy query failed (%d)\n", per_cu); grid = -1; return; }
        grid = cus;
    }
    if (grid < 0) return;
    (void)hipMemsetAsync((unsigned char*)d_ws + WS_CTL, 0, CTL_BYTES, stream);
    Args a{};
    for (int i = 0; i < 26; ++i) a.in[i] = (const float*)d_in[i];
    a.out = (float*)d_out; a.ws = (unsigned char*)d_ws;
    void* kargs[] = {&a};
    hipError_t e = hipLaunchCooperativeKernel((const void*)mega_fwd, dim3(grid), dim3(NTHREADS), kargs, LDS_BYTES, stream);
    if (e != hipSuccess) fprintf(stderr, "kernel_launch: cooperative launch failed: %s (grid %d)\n", hipGetErrorString(e), grid);
}
```

```cpp
#include <hip/hip_runtime.h>
#include <cstdio>
#include <cstdint>

typedef unsigned short bf16_t;
typedef short bf16x8 __attribute__((ext_vector_type(8)));
typedef float f32x4 __attribute__((ext_vector_type(4)));

constexpr int BATCH = 8, SEQ = 4096, D = 1024, M = BATCH * SEQ;
constexpr int HD = 64, ATT_W = 512, KV_W = 128, C = 512, NH = 8;
constexpr int ATT_IN = 768, SHIFT_W = 1792, IN_W = 2560, FF = 2816;
constexpr int WINDOW = 128;
constexpr float RMS_EPS = 1e-5f, LNX_EPS = 64e-5f;

constexpr size_t MiB = 1u << 20;
constexpr size_t WS_CTL = 0;
typedef unsigned long long ssq_t;
__device__ __forceinline__ ssq_t ssq_fix(float s) { return (ssq_t)(s * 1048576.0f + 0.5f); }
__device__ __forceinline__ float ssq_val(ssq_t v) { return (float)v * (1.0f / 1048576.0f); }
constexpr size_t WS_SS = 0;
constexpr size_t CTL_BYTES = 2 * MiB;
constexpr size_t WS_FCNT = 1792 * 1024;
constexpr size_t WS_BAR = 1536 * 1024;
constexpr size_t WS_W = 2 * MiB;
constexpr size_t W_IN_SZ = (size_t)IN_W * D * 2, W_OUT_SZ = (size_t)D * D * 2, W_GU_SZ = (size_t)2 * FF * D * 2, W_DN_SZ = (size_t)D * FF * 2;
constexpr size_t W_LAYER = W_IN_SZ + W_OUT_SZ + W_GU_SZ + W_DN_SZ;
constexpr size_t WS_VFIRST = 52 * MiB, WS_MIX = 84 * MiB, WS_XB = 148 * MiB, WS_PROJ = 212 * MiB;
constexpr size_t WS_SI_R = 148 * MiB, WS_SI_K = 180 * MiB, WS_SI_V = 372 * MiB, WS_SI_A = 404 * MiB, WS_SI_LD = 436 * MiB, WS_SI_G = 468 * MiB;
constexpr size_t WS_HID = 212 * MiB;
constexpr size_t WS_UTMP = 84 * MiB;
constexpr size_t WS_END = 500 * MiB;
static_assert(WS_W + 2 * W_LAYER <= WS_VFIRST, "weights fit");

__device__ __forceinline__ unsigned f2bf(float f) { unsigned u = __builtin_bit_cast(unsigned, f); return (u + 0x7fffu + ((u >> 16) & 1u)) >> 16; }
__device__ __forceinline__ float bf2f(bf16_t h) { return __builtin_bit_cast(float, (unsigned)h << 16); }
__device__ __forceinline__ float wave_sum(float v) {
#pragma unroll
    for (int o = 1; o < 64; o <<= 1) v += __shfl_xor(v, o);
    return v;
}
#define LDS_BARRIER() do { asm volatile("s_waitcnt lgkmcnt(0)" ::: "memory"); __builtin_amdgcn_s_barrier(); asm volatile("" ::: "memory"); } while (0)
__device__ __forceinline__ float sigmoidf_(float x) { return __builtin_amdgcn_rcpf(1.f + __expf(-x)); }

namespace pg8 {
#define PG8_LAS __attribute__((address_space(3)))
typedef unsigned short bf16_t;
typedef short bf16x8 __attribute__((ext_vector_type(8)));
typedef float f32x4 __attribute__((ext_vector_type(4)));
typedef unsigned u32x4 __attribute__((ext_vector_type(4)));
constexpr int BM = 256, BK = 64, HALF = 128, HTB = HALF * BK * 2  , STAGE_BYTES = 8 * HTB, NXCD = 8, WGM = 8;

__host__ __device__ __forceinline__ int lds_byte(int r, int c) { const int st = (r >> 4) * 2 + (c >> 5), rr = r & 15, cc = c & 31, ob = rr * 64 + cc * 2; return st * 1024 + (ob ^ (((ob >> 9) & 1) << 5)); }
__host__ __device__ __forceinline__ void stage_rc(int b, int& R, int& C) { const int st = b / 1024, sb = b % 1024, swz = sb ^ (((sb >> 9) & 1) << 5); R = (st >> 1) * 16 + swz / 64; C = (st & 1) * 32 + (swz % 64) / 2; }
__host__ __device__ __forceinline__ int perm32(int rho) { const int n = rho >> 4, i = rho & 15; return 8 * (i >> 2) + 4 * n + (i & 3); }

struct Unit { int pm, pn; };
struct Gemm { const bf16_t* A; const bf16_t* Bt; int M, N, K; };

struct StaticOrder {
    int nM, nN, nwg, G, c;
    __host__ __device__ void init(int M, int N, int G_, int c_) { nM = M / BM; nN = N / BM; nwg = nM * nN; G = G_; c = c_; }
    __host__ __device__ bool next(int i, Unit& u) const {
        const long L = (long)i * G + c; if (L >= nwg) return false;
        int wgid = (int)L; { const int q = nwg / NXCD, r = nwg % NXCD, xcd = wgid % NXCD, off = wgid / NXCD; wgid = (xcd < r ? xcd * (q + 1) : r * (q + 1) + (xcd - r) * q) + off; }
        const int nig = WGM * nN, gid = wgid / nig, fm = gid * WGM, gsz = (nM - fm) < WGM ? (nM - fm) : WGM;
        u.pm = fm + ((wgid % nig) % gsz); u.pn = (wgid % nig) / gsz; return true;
    }
    __device__ __forceinline__ void a_ready(const Unit&) const {}
    __device__ __forceinline__ void done(const Unit&) const {}
};
typedef float f32x2_t_ __attribute__((ext_vector_type(2))); typedef __bf16 bf16x2_t_ __attribute__((ext_vector_type(2)));
__device__ __forceinline__ unsigned cvt_pk_bf16(float lo, float hi) { const f32x2_t_ v = {lo, hi}; const bf16x2_t_ b = __builtin_convertvector(v, bf16x2_t_); return __builtin_bit_cast(unsigned, b); }
typedef float f32x2 __attribute__((ext_vector_type(2)));
template <class Epi, class Sched, bool ALIGN_EPI = false, bool SP2 = false>
__device__ __forceinline__ void gemm_phase(PG8_LAS unsigned char* lds, const Gemm g, const Sched& S, const Epi& E) {
    int tid_ = threadIdx.x; asm volatile("" : "+v"(tid_));
    const int tid = tid_, wid = __builtin_amdgcn_readfirstlane(tid >> 6), lane = tid & 63, wr = wid >> 2, wc = wid & 3, fr = lane & 15, fq = lane >> 4;
    const int K = g.K, nt = K / BK;
    unsigned voffA[2], voffB[2];
#pragma unroll
    for (int i = 0; i < 2; ++i) { int R, C; stage_rc(tid * 16 + i * 8192, R, C); const int Rb = (R >> 5) * 64 + (Epi::PERM ? perm32(R & 31) : (R & 31));
        voffA[i] = (unsigned)(R * K + C) * 2u; voffB[i] = (unsigned)(Rb * K + C) * 2u; }
    const size_t kstep = (size_t)(BK * 2);
    const size_t hstep = (size_t)HALF * K * 2;
    const size_t tstep = 2 * hstep;
    const size_t hstepB = (size_t)32 * K * 2;
    const unsigned ldsw = (unsigned)wid * 1024u;
    const int aoff = lds_byte(wr * 64 + fr, fq * 8), boff = lds_byte(wc * 32 + fr, fq * 8);
#define PG8_SA(b, h) (((b) * 2 + (h)) * HTB)
#define PG8_SB(b, h) ((4 + (b) * 2 + (h)) * HTB)
#define PG8_STAGE(bufoff, gbase, voff) do { _Pragma("unroll") for (int _i = 0; _i < 2; ++_i) \
        __builtin_amdgcn_global_load_lds((const unsigned*)((const char*)(gbase) + (voff)[_i]), (PG8_LAS unsigned*)(lds + (bufoff) + ldsw + _i * 8192), 16, 0, 0); } while (0)
#define PG8_LDA(dst, b, h) do { _Pragma("unroll") for (int m = 0; m < 4; ++m) _Pragma("unroll") for (int k = 0; k < 2; ++k) dst[m][k] = *(const PG8_LAS bf16x8*)(lds + PG8_SA(b, h) + aoff + m * 2048 + k * 1024); } while (0)
#define PG8_LDB(dst, b, h) do { _Pragma("unroll") for (int n = 0; n < 2; ++n) _Pragma("unroll") for (int k = 0; k < 2; ++k) dst[n][k] = *(const PG8_LAS bf16x8*)(lds + PG8_SB(b, h) + boff + n * 2048 + k * 1024); } while (0)
#define PG8_MMA(ai, bj, At, Bt) do { __builtin_amdgcn_s_setprio(1); _Pragma("unroll") for (int m = 0; m < 4; ++m) _Pragma("unroll") for (int n = 0; n < 2; ++n) _Pragma("unroll") for (int k = 0; k < 2; ++k) \
        acc[ai][bj][m][n] = __builtin_amdgcn_mfma_f32_16x16x32_bf16(Bt[n][k], At[m][k], acc[ai][bj][m][n], 0, 0, 0); __builtin_amdgcn_s_setprio(0); } while (0)
#define PG8_WAIT_V(n) asm volatile("s_waitcnt vmcnt(" #n ")" ::: "memory")
#define PG8_WAIT_L(n) asm volatile("s_waitcnt lgkmcnt(" #n ")" ::: "memory")
#define PG8_BAR __builtin_amdgcn_s_barrier()
#define PG8_SCHED __builtin_amdgcn_sched_barrier(0)
    Unit cur, nxt; int ui = 0;
    if (!S.next(0, cur)) return;
    f32x4 acc[2][2][4][2];
#pragma unroll
    for (int a = 0; a < 2; ++a)
#pragma unroll
        for (int b = 0; b < 2; ++b)
#pragma unroll
            for (int m = 0; m < 4; ++m)
#pragma unroll
                for (int n = 0; n < 2; ++n) acc[a][b][m][n] = (f32x4){0.f, 0.f, 0.f, 0.f};
    bf16x8 At[4][2], B0[2][2], B1[2][2];
    const char* cA = (const char*)g.A + (size_t)cur.pm * tstep; const char* cB = (const char*)g.Bt + (size_t)cur.pn * tstep;
    S.a_ready(cur);
    if constexpr (SP2) {
        PG8_STAGE(PG8_SB(0, 0), cB, voffB); PG8_STAGE(PG8_SB(0, 1), cB + hstepB, voffB); PG8_STAGE(PG8_SA(0, 0), cA, voffA); PG8_STAGE(PG8_SA(0, 1), cA + hstep, voffA);
        if (wr == 1) PG8_BAR;
        PG8_WAIT_V(2); PG8_BAR;
        PG8_STAGE(PG8_SB(1, 0), cB + kstep, voffB); PG8_STAGE(PG8_SA(1, 0), cA + kstep, voffA); PG8_STAGE(PG8_SB(1, 1), cB + hstepB + kstep, voffB);
        PG8_WAIT_V(6); PG8_BAR;
    } else {
        PG8_STAGE(PG8_SB(0, 0), cB, voffB); PG8_STAGE(PG8_SA(0, 0), cA, voffA); PG8_STAGE(PG8_SB(0, 1), cB + hstepB, voffB); PG8_STAGE(PG8_SA(0, 1), cA + hstep, voffA);
        if (wr == 1) PG8_BAR;
        PG8_WAIT_V(4); PG8_BAR;
        PG8_STAGE(PG8_SB(1, 0), cB + kstep, voffB); PG8_STAGE(PG8_SA(1, 0), cA + kstep, voffA); PG8_STAGE(PG8_SB(1, 1), cB + hstepB + kstep, voffB);
        PG8_WAIT_V(6); PG8_BAR;
    }
    for (;;) {
        const bool has_next = S.next(ui + 1, nxt);
        const char* nA = has_next ? (const char*)g.A + (size_t)nxt.pm * tstep : cA; const char* nB = has_next ? (const char*)g.Bt + (size_t)nxt.pn * tstep : cB;
        for (int t = 0; t < nt; t += 2) {
            const bool last = (t == nt - 2);
            const char* a1 = cA + (size_t)(t + 1) * kstep;
            const char* a2 = last ? nA : cA + (size_t)(t + 2) * kstep; const char* b2 = last ? nB : cB + (size_t)(t + 2) * kstep;
            const char* a3 = a2 + kstep; const char* b3 = b2 + kstep;
            if (last && has_next) S.a_ready(nxt);
            if constexpr (SP2) {
            PG8_LDB(B0, 0, 0); PG8_LDB(B1, 0, 1); PG8_SCHED; PG8_LDA(At, 0, 0); PG8_STAGE(PG8_SA(1, 1), a1 + hstep, voffA);
            PG8_WAIT_V(8); PG8_WAIT_L(0); PG8_BAR; PG8_MMA(0, 0, At, B0); PG8_MMA(0, 1, At, B1); PG8_BAR; PG8_SCHED;
            PG8_LDA(At, 0, 1); PG8_STAGE(PG8_SB(0, 0), b2, voffB); PG8_STAGE(PG8_SB(0, 1), b2 + hstepB, voffB); PG8_STAGE(PG8_SA(0, 0), a2, voffA);
            PG8_WAIT_V(8); PG8_WAIT_L(0); PG8_BAR; PG8_MMA(1, 0, At, B0); PG8_MMA(1, 1, At, B1); PG8_BAR; PG8_SCHED;
            PG8_LDB(B0, 1, 0); PG8_LDB(B1, 1, 1); PG8_SCHED; PG8_LDA(At, 1, 0); PG8_STAGE(PG8_SA(0, 1), a2 + hstep, voffA);
            PG8_WAIT_V(8); PG8_WAIT_L(0); PG8_BAR; PG8_MMA(0, 0, At, B0); PG8_MMA(0, 1, At, B1); PG8_BAR; PG8_SCHED;
            PG8_LDA(At, 1, 1); PG8_STAGE(PG8_SB(1, 0), b3, voffB); PG8_STAGE(PG8_SB(1, 1), b3 + hstepB, voffB); PG8_STAGE(PG8_SA(1, 0), a3, voffA);
            PG8_WAIT_V(8); PG8_WAIT_L(0); PG8_BAR; PG8_MMA(1, 0, At, B0); PG8_MMA(1, 1, At, B1); PG8_BAR; PG8_SCHED;
            } else {
            PG8_LDB(B0, 0, 0); PG8_SCHED; PG8_LDA(At, 0, 0); PG8_STAGE(PG8_SA(1, 1), a1 + hstep, voffA);
            PG8_WAIT_L(8); PG8_BAR; PG8_WAIT_L(0); PG8_MMA(0, 0, At, B0); PG8_BAR; PG8_SCHED;
            PG8_LDB(B1, 0, 1); PG8_STAGE(PG8_SB(0, 0), b2, voffB);
            PG8_BAR; PG8_WAIT_L(0); PG8_MMA(0, 1, At, B1); PG8_BAR;
            PG8_LDA(At, 0, 1); PG8_STAGE(PG8_SA(0, 0), a2, voffA);
            PG8_BAR; PG8_WAIT_L(0); PG8_MMA(1, 0, At, B0); PG8_BAR; PG8_SCHED;
            PG8_STAGE(PG8_SB(0, 1), b2 + hstepB, voffB);
            PG8_WAIT_V(6); PG8_BAR; PG8_MMA(1, 1, At, B1); PG8_BAR;
            PG8_LDB(B0, 1, 0); PG8_SCHED; PG8_LDA(At, 1, 0); PG8_STAGE(PG8_SA(0, 1), a2 + hstep, voffA);
            PG8_WAIT_L(8); PG8_BAR; PG8_WAIT_L(0); PG8_MMA(0, 0, At, B0); PG8_BAR; PG8_SCHED;
            PG8_LDB(B1, 1, 1); PG8_STAGE(PG8_SB(1, 0), b3, voffB);
            PG8_BAR; PG8_WAIT_L(0); PG8_MMA(0, 1, At, B1); PG8_BAR;
            PG8_LDA(At, 1, 1); PG8_STAGE(PG8_SA(1, 0), a3, voffA);
            PG8_BAR; PG8_WAIT_L(0); PG8_MMA(1, 0, At, B0); PG8_BAR; PG8_SCHED;
            PG8_STAGE(PG8_SB(1, 1), b3 + hstepB, voffB);
            PG8_WAIT_V(6); PG8_BAR; PG8_MMA(1, 1, At, B1); PG8_BAR;
            }
        }
        if constexpr (ALIGN_EPI) { if (wr == 0) PG8_BAR; }
        if constexpr (!Epi::AFTER_DRAIN) { E(acc, cur, wr, wc, fr, fq); S.done(cur); }
        if (!has_next) break;
#pragma unroll
        for (int a = 0; a < 2; ++a)
#pragma unroll
            for (int b = 0; b < 2; ++b)
#pragma unroll
                for (int m = 0; m < 4; ++m)
#pragma unroll
                    for (int n = 0; n < 2; ++n) acc[a][b][m][n] = (f32x4){0.f, 0.f, 0.f, 0.f};
        cur = nxt; cA = nA; cB = nB; ++ui;
        if constexpr (ALIGN_EPI) { if (wr == 1) PG8_BAR; }
    }
    PG8_WAIT_V(0);
    if constexpr (!ALIGN_EPI) { if (wr == 0) PG8_BAR; }
    PG8_BAR;
    if constexpr (Epi::AFTER_DRAIN) { E.fused(acc, cur, wr, wc, fr, fq, lds, wid, lane); S.done(cur); }
#undef PG8_SA
#undef PG8_SB
#undef PG8_STAGE
#undef PG8_LDA
#undef PG8_LDB
#undef PG8_MMA
#undef PG8_WAIT_V
#undef PG8_WAIT_L
#undef PG8_BAR
#undef PG8_SCHED
}

constexpr int DM_ = 1024; constexpr float RMS_EPS_ = 1e-5f;
typedef unsigned long long ssq_t;
struct EpiScaleBf16 {
    static constexpr bool PERM = true, AFTER_DRAIN = false;
    bf16_t* O; int ldc; const ssq_t* ss;
    __device__ __forceinline__ void operator()(const f32x4 (&acc)[2][2][4][2], const Unit& u, int wr, int wc, int fr, int fq) const {
        const int row0 = u.pm * BM + wr * 64 + fr, col0 = u.pn * BM + wc * 64 + 8 * fq;
        float rsv[2][4];
#pragma unroll
        for (int ai = 0; ai < 2; ++ai)
#pragma unroll
            for (int m = 0; m < 4; ++m) rsv[ai][m] = (float)ss[row0 + ai * HALF + m * 16] * (1.0f / 1048576.0f);
#pragma unroll
        for (int ai = 0; ai < 2; ++ai)
#pragma unroll
            for (int m = 0; m < 4; ++m) { const int row = row0 + ai * HALF + m * 16; const float rs = __builtin_amdgcn_rsqf(rsv[ai][m] * (1.0f / DM_) + RMS_EPS_); bf16_t* rowp = O + (size_t)row * ldc + col0;
#pragma unroll
                for (int bj = 0; bj < 2; ++bj) { const f32x4 v0 = acc[ai][bj][m][0] * rs, v1 = acc[ai][bj][m][1] * rs;
                    u32x4 w; w.x = cvt_pk_bf16(v0[0], v0[1]); w.y = cvt_pk_bf16(v0[2], v0[3]); w.z = cvt_pk_bf16(v1[0], v1[1]); w.w = cvt_pk_bf16(v1[2], v1[3]);
                    *(u32x4*)(rowp + bj * 32) = w; } }
    }
};
struct EpiResid {
    static constexpr bool PERM = true, AFTER_DRAIN = false;
    bf16_t* xb; ssq_t* ss_out;
    __device__ __forceinline__ void operator()(const f32x4 (&acc)[2][2][4][2], const Unit& u, int wr, int wc, int fr, int fq) const {
        const int row0 = u.pm * BM + wr * 64 + fr, col0 = u.pn * BM + wc * 64 + 8 * fq;
#pragma unroll
        for (int ai = 0; ai < 2; ++ai) {
            u32x4 bs[4][2];
#pragma unroll
            for (int m = 0; m < 4; ++m)
#pragma unroll
                for (int bj = 0; bj < 2; ++bj) bs[m][bj] = *(const u32x4*)(xb + (size_t)(row0 + ai * HALF + m * 16) * DM_ + col0 + bj * 32);
#pragma unroll
            for (int m = 0; m < 4; ++m) { const int row = row0 + ai * HALF + m * 16; bf16_t* rp = xb + (size_t)row * DM_ + col0; float sq = 0.f;
#pragma unroll
                for (int bj = 0; bj < 2; ++bj) { const u32x4 b = bs[m][bj]; u32x4 w;
#pragma unroll
                    for (int hh = 0; hh < 2; ++hh) { const unsigned b0 = hh == 0 ? b.x : b.z, b1 = hh == 0 ? b.y : b.w; const f32x4 a4 = acc[ai][bj][m][hh];
                        const float x0 = __builtin_bit_cast(float, b0 << 16) + a4[0], x1 = __builtin_bit_cast(float, b0 & 0xffff0000u) + a4[1], x2 = __builtin_bit_cast(float, b1 << 16) + a4[2], x3 = __builtin_bit_cast(float, b1 & 0xffff0000u) + a4[3];
                        const unsigned w0 = cvt_pk_bf16(x0, x1), w1 = cvt_pk_bf16(x2, x3);
                        if (hh == 0) { w.x = w0; w.y = w1; } else { w.z = w0; w.w = w1; }
                        const float r0 = __builtin_bit_cast(float, w0 << 16), r1 = __builtin_bit_cast(float, w0 & 0xffff0000u), r2 = __builtin_bit_cast(float, w1 << 16), r3 = __builtin_bit_cast(float, w1 & 0xffff0000u);
                        sq += (r0 * r0 + r1 * r1) + (r2 * r2 + r3 * r3); }
                    *(u32x4*)(rp + bj * 32) = w; }
                sq += __shfl_xor(sq, 16); sq += __shfl_xor(sq, 32);
                if (fq == 0) atomicAdd(ss_out + row, (ssq_t)(sq * 1048576.0f + 0.5f)); }
        }
    }
};
struct EpiResidFinal {
    static constexpr bool PERM = true, AFTER_DRAIN = false;
    const bf16_t* xb; ssq_t* ss_out; unsigned* cnt; const float* g; float* out;
    __device__ __forceinline__ void operator()(f32x4 (&acc)[2][2][4][2], const Unit& u, int wr, int wc, int fr, int fq) const {
        const int row0 = u.pm * BM + wr * 64 + fr, col0 = u.pn * BM + wc * 64 + 8 * fq;
#pragma unroll
        for (int ai = 0; ai < 2; ++ai) {
            u32x4 bs[4][2];
#pragma unroll
            for (int m = 0; m < 4; ++m)
#pragma unroll
                for (int bj = 0; bj < 2; ++bj) bs[m][bj] = *(const u32x4*)(xb + (size_t)(row0 + ai * HALF + m * 16) * DM_ + col0 + bj * 32);
#pragma unroll
            for (int m = 0; m < 4; ++m) { const int row = row0 + ai * HALF + m * 16; float sq = 0.f;
#pragma unroll
                for (int bj = 0; bj < 2; ++bj) { const u32x4 b = bs[m][bj];
#pragma unroll
                    for (int hh = 0; hh < 2; ++hh) { const unsigned b0 = hh == 0 ? b.x : b.z, b1 = hh == 0 ? b.y : b.w; const f32x4 a4 = acc[ai][bj][m][hh];
                        const float x0 = __builtin_bit_cast(float, b0 << 16) + a4[0], x1 = __builtin_bit_cast(float, b0 & 0xffff0000u) + a4[1], x2 = __builtin_bit_cast(float, b1 << 16) + a4[2], x3 = __builtin_bit_cast(float, b1 & 0xffff0000u) + a4[3];
                        const unsigned w0 = cvt_pk_bf16(x0, x1), w1 = cvt_pk_bf16(x2, x3);
                        const float r0 = __builtin_bit_cast(float, w0 << 16), r1 = __builtin_bit_cast(float, w0 & 0xffff0000u), r2 = __builtin_bit_cast(float, w1 << 16), r3 = __builtin_bit_cast(float, w1 & 0xffff0000u);
                        acc[ai][bj][m][hh] = (f32x4){r0, r1, r2, r3};
                        sq += (r0 * r0 + r1 * r1) + (r2 * r2 + r3 * r3); } }
                sq += __shfl_xor(sq, 16); sq += __shfl_xor(sq, 32);
                if (fq == 0) atomicAdd(ss_out + row, (ssq_t)(sq * 1048576.0f + 0.5f)); }
        }
        asm volatile("s_waitcnt vmcnt(0)" ::: "memory"); __builtin_amdgcn_s_barrier(); asm volatile("" ::: "memory");
        if (wr == 0 && wc == 0 && fr == 0 && fq == 0) {
            (void)__hip_atomic_fetch_add(cnt + u.pm, 1u, __ATOMIC_RELAXED, __HIP_MEMORY_SCOPE_AGENT);
            for (unsigned sp = 0; __hip_atomic_load(cnt + u.pm, __ATOMIC_RELAXED, __HIP_MEMORY_SCOPE_AGENT) < 4u && sp < (1u << 22); ++sp) __builtin_amdgcn_s_sleep(2);
        }
        asm volatile("s_waitcnt vmcnt(0)" ::: "memory"); __builtin_amdgcn_s_barrier(); asm volatile("" ::: "memory");
        f32x4 gv[2][2];
#pragma unroll
        for (int bj = 0; bj < 2; ++bj)
#pragma unroll
            for (int hh = 0; hh < 2; ++hh) gv[bj][hh] = *(const f32x4*)(g + col0 + bj * 32 + 4 * hh);
#pragma unroll
        for (int ai = 0; ai < 2; ++ai)
#pragma unroll
            for (int m = 0; m < 4; ++m) { const int row = row0 + ai * HALF + m * 16;
                const ssq_t sv = __hip_atomic_load(ss_out + row, __ATOMIC_RELAXED, __HIP_MEMORY_SCOPE_AGENT);
                const float rs = __builtin_amdgcn_rsqf((float)sv * (1.0f / 1048576.0f) * (1.0f / DM_) + RMS_EPS_); float* op = out + (size_t)row * DM_ + col0;
#pragma unroll
                for (int bj = 0; bj < 2; ++bj)
#pragma unroll
                    for (int hh = 0; hh < 2; ++hh) *(f32x4*)(op + bj * 32 + 4 * hh) = acc[ai][bj][m][hh] * gv[bj][hh] * rs; }
    }
};
template <int CTRL> __device__ __forceinline__ float dpp1(float x) { return __builtin_bit_cast(float, __builtin_amdgcn_update_dpp(0, __builtin_bit_cast(int, x), CTRL, 0xF, 0xF, true)); }
template <int CTRL> __device__ __forceinline__ f32x4 dpp4(const f32x4 x) { return (f32x4){dpp1<CTRL>(x.x), dpp1<CTRL>(x.y), dpp1<CTRL>(x.z), dpp1<CTRL>(x.w)}; }
struct EpiConvGlu {
    static constexpr bool PERM = true, AFTER_DRAIN = false;
    bf16_t* HID; const ssq_t* ss; const float* cw; const float* cb; float* SB; PG8_LAS float* xch; int ff;
    __device__ __forceinline__ void operator()(const f32x4 (&acc)[2][2][4][2], const Unit& u, int wr, int wc, int fr, int fq) const {
        const int row0 = u.pm * BM + wr * 64 + fr, cl = wc * 32 + 8 * fq, jcol = u.pn * HALF + cl;
        float rs[2][4];
#pragma unroll
        for (int ai = 0; ai < 2; ++ai)
#pragma unroll
            for (int m = 0; m < 4; ++m) rs[ai][m] = (float)ss[row0 + ai * HALF + m * 16] * (1.0f / 1048576.0f);
        f32x4 w0[2], w1[2], w2[2], bb[2];
#pragma unroll
        for (int n = 0; n < 2; ++n) { w0[n] = *(const f32x4*)(cw + jcol + 4 * n); w1[n] = *(const f32x4*)(cw + ff + jcol + 4 * n); w2[n] = *(const f32x4*)(cw + 2 * ff + jcol + 4 * n); bb[n] = *(const f32x4*)(cb + jcol + 4 * n); }
#pragma unroll
        for (int ai = 0; ai < 2; ++ai)
#pragma unroll
            for (int m = 0; m < 4; ++m) rs[ai][m] = __builtin_amdgcn_rsqf(rs[ai][m] * (1.0f / DM_) + RMS_EPS_);
        if (fr >= 14) {
#pragma unroll
            for (int ai = 0; ai < 2; ++ai)
#pragma unroll
                for (int n = 0; n < 2; ++n) *(PG8_LAS f32x4*)(xch + ((2 * ai + wr) * 2 + (fr - 14)) * HALF + cl + 4 * n) = acc[ai][0][3][n] * rs[ai][3];
        }
        asm volatile("s_waitcnt lgkmcnt(0)" ::: "memory"); __builtin_amdgcn_s_barrier(); asm volatile("" ::: "memory");
        float* sbp = SB + (size_t)u.pm * 6 * ff + jcol;
#pragma unroll
        for (int ai = 0; ai < 2; ++ai) {
            const int q = 2 * ai + wr;
            f32x4 X[2];
#pragma unroll
            for (int n = 0; n < 2; ++n) { X[n] = (f32x4){0.f, 0.f, 0.f, 0.f}; if (q > 0 && fr >= 14) X[n] = *(const PG8_LAS f32x4*)(xch + ((q - 1) * 2 + (fr - 14)) * HALF + cl + 4 * n); }
            f32x4 prevg[2] = {X[0], X[1]};
#pragma unroll
            for (int m = 0; m < 4; ++m) { const int row = row0 + ai * HALF + m * 16;
                pg8::u32x4 hw;
#pragma unroll
                for (int n = 0; n < 2; ++n) {
                    const f32x4 cur = acc[ai][0][m][n] * rs[ai][m], up = acc[ai][1][m][n] * rs[ai][m];
                    const f32x4 P = prevg[n]; prevg[n] = cur;
                    f32x4 z1, z2;
#pragma unroll
                    for (int e = 0; e < 4; ++e) { z1[e] = fr == 15 ? P[e] : cur[e]; z2[e] = fr >= 14 ? P[e] : cur[e]; }
                    const f32x4 p1 = dpp4<0x121>(z1), p2 = dpp4<0x122>(z2);
                    const f32x4 c = bb[n] + w0[n] * p2 + w1[n] * p1 + w2[n] * cur;
                    f32x4 hv;
#pragma unroll
                    for (int e = 0; e < 4; ++e) hv[e] = c[e] * __builtin_amdgcn_rcpf(1.f + __expf(-c[e])) * up[e];
                    if (n == 0) { hw.x = cvt_pk_bf16(hv[0], hv[1]); hw.y = cvt_pk_bf16(hv[2], hv[3]); } else { hw.z = cvt_pk_bf16(hv[0], hv[1]); hw.w = cvt_pk_bf16(hv[2], hv[3]); }
                    if (q == 0 && m == 0 && fr < 2) { *(f32x4*)(sbp + (size_t)fr * ff + 4 * n) = cur; *(f32x4*)(sbp + (size_t)(2 + fr) * ff + 4 * n) = up; }
                    if (q == 3 && m == 3 && fr >= 14) *(f32x4*)(sbp + (size_t)(4 + fr - 14) * ff + 4 * n) = cur;
                }
                *(pg8::u32x4*)(HID + (size_t)row * ff + jcol) = hw; }
        }
    }
};
}

#define LAS __attribute__((address_space(3)))
__device__ __forceinline__ void transpose_item(const float* __restrict__ W, int K, int N, bf16_t* __restrict__ Wt, const float* __restrict__ g, int mode, float* scr, int item, int lane, bool gcompl = false) {
    const int nblk = N / 32, kb = item / nblk, nb = item % nblk, k0 = 64 * kb, n0 = 32 * nb;
    int np0 = n0; if (mode != 0) np0 = 256 * (n0 / 128) + 64 * ((n0 % 128) / 32) + (mode == 2 ? 32 : 0);
    f32x4 wv[8];
#pragma unroll
    for (int i = 0; i < 8; ++i) wv[i] = *(const f32x4*)(W + (size_t)(k0 + (lane >> 3) + 8 * i) * N + n0 + (lane & 7) * 4);
#pragma unroll
    for (int i = 0; i < 8; ++i) { const int kk = (lane >> 3) + 8 * i; const float gs = g ? (gcompl ? 1.f - g[k0 + kk] : g[k0 + kk]) : 1.f; float* d = scr + kk * 33 + (lane & 7) * 4; d[0] = wv[i].x * gs; d[1] = wv[i].y * gs; d[2] = wv[i].z * gs; d[3] = wv[i].w * gs; }
    __builtin_amdgcn_fence(__ATOMIC_RELEASE, "wavefront"); __builtin_amdgcn_wave_barrier(); __builtin_amdgcn_fence(__ATOMIC_ACQUIRE, "wavefront");
    const int c = lane & 7;
#pragma unroll
    for (int j = 0; j < 4; ++j) { const int n = (lane >> 3) + 8 * j; const float* sp = scr + (8 * c) * 33 + n;
        uint4 o; o.x = f2bf(sp[0]) | (f2bf(sp[33]) << 16); o.y = f2bf(sp[2 * 33]) | (f2bf(sp[3 * 33]) << 16); o.z = f2bf(sp[4 * 33]) | (f2bf(sp[5 * 33]) << 16); o.w = f2bf(sp[6 * 33]) | (f2bf(sp[7 * 33]) << 16);
        *(uint4*)(Wt + (size_t)(np0 + n) * K + k0 + 8 * c) = o; }
    __builtin_amdgcn_fence(__ATOMIC_RELEASE, "wavefront"); __builtin_amdgcn_wave_barrier(); __builtin_amdgcn_fence(__ATOMIC_ACQUIRE, "wavefront");
}
constexpr size_t WS_LORA = 50 * MiB;
constexpr size_t LORA_LAYER = 256 * 1024, WS_V1T = WS_LORA + 2 * LORA_LAYER, WS_V1B = WS_V1T + 32 * 1024, WS_V2T = WS_V1B + 32 * 1024;
constexpr int PR_ACT_LD = 264, PR_VLO_LD = 40, PR_SG_LD = 520, PR_ACT_OFF = 0, PR_VLO_OFF = 64 * PR_ACT_LD * 2, PR_SG_OFF = PR_VLO_OFF + 64 * PR_VLO_LD * 2;
constexpr int PR_STG_OFF = PR_SG_OFF + 64 * PR_SG_LD * 2, PR_STG_WAVE = 16 * 144;
struct Prep2Args {
    const bf16_t* proj; const float* mu; const float* w0; const float* a0; const float* v0;
    const bf16_t *W2T, *A2T, *G2T, *V1T, *V1B, *V2T; bf16_t* vfirst; bf16_t *V, *A, *G; unsigned short* CS; int layer; int pad;
};
__device__ __forceinline__ f32x4 bfx4_lo(const bf16x8 v) { return (f32x4){bf2f((bf16_t)v[0]), bf2f((bf16_t)v[1]), bf2f((bf16_t)v[2]), bf2f((bf16_t)v[3])}; }
__device__ __forceinline__ f32x4 bfx4_hi(const bf16x8 v) { return (f32x4){bf2f((bf16_t)v[4]), bf2f((bf16_t)v[5]), bf2f((bf16_t)v[6]), bf2f((bf16_t)v[7])}; }
__device__ __forceinline__ bf16x8 pack8(const f32x4 a, const f32x4 b) { pg8::u32x4 w; w.x = pg8::cvt_pk_bf16(a[0], a[1]); w.y = pg8::cvt_pk_bf16(a[2], a[3]); w.z = pg8::cvt_pk_bf16(b[0], b[1]); w.w = pg8::cvt_pk_bf16(b[2], b[3]); return __builtin_bit_cast(bf16x8, w); }
template <int CTRL> __device__ __forceinline__ float dpp_mov(float x) { return __builtin_bit_cast(float, __builtin_amdgcn_update_dpp(0, __builtin_bit_cast(int, x), CTRL, 0xF, 0xF, true)); }
__device__ __forceinline__ float reduce16(float x) { x += dpp_mov<0xB1>(x); x += dpp_mov<0x4E>(x); x += dpp_mov<0x141>(x); x += dpp_mov<0x140>(x); return x; }
__device__ __forceinline__ float red8(float x) { x += dpp_mov<0xB1>(x); x += dpp_mov<0x4E>(x); x += dpp_mov<0x141>(x); return x; }
__device__ __forceinline__ float scan16(float x) { x += dpp_mov<0x111>(x); x += dpp_mov<0x112>(x); x += dpp_mov<0x114>(x); x += dpp_mov<0x118>(x); return x; }
constexpr float CS_SCALE = 1638.0f;
__device__ __forceinline__ void shift8(const bf16_t* __restrict__ proj, const float* __restrict__ mu, size_t m, int t, int col, int mi, f32x4& lo, f32x4& hi) {
    const bf16x8 cur = *(const bf16x8*)(proj + m * IN_W + col);
    bf16x8 prv; if (t > 0) prv = *(const bf16x8*)(proj + (m - 1) * IN_W + col); else prv = (bf16x8){0, 0, 0, 0, 0, 0, 0, 0};
    const f32x4 m0 = *(const f32x4*)(mu + mi), m1 = *(const f32x4*)(mu + mi + 4);
    const f32x4 c0 = bfx4_lo(cur), c1 = bfx4_hi(cur), p0 = bfx4_lo(prv), p1 = bfx4_hi(prv);
    lo = c0 + (p0 - c0) * m0; hi = c1 + (p1 - c1) * m1;
}
__device__ __forceinline__ void prep_tile(const Prep2Args& p, unsigned char* lds, int tile, int tid) {
    const int m0 = tile * 64, wave = __builtin_amdgcn_readfirstlane(tid >> 6), lane = tid & 63, fr = lane & 15, fq = lane >> 4;
    bf16_t* ACT = (bf16_t*)(lds + PR_ACT_OFF); bf16_t* VLO = (bf16_t*)(lds + PR_VLO_OFF); bf16_t* SG = (bf16_t*)(lds + PR_SG_OFF);
    { bf16x8 cu[4], pv[4]; f32x4 mu0[4], mu1[4];
#pragma unroll
      for (int it = 0; it < 4; ++it) { const int tk = 4 * (tid >> 5) + it, cc = tid & 31; const size_t m = (size_t)m0 + tk;
          cu[it] = *(const bf16x8*)(p.proj + m * IN_W + 2304 + 8 * cc);
          mu0[it] = *(const f32x4*)(p.mu + 1536 + 8 * cc); mu1[it] = *(const f32x4*)(p.mu + 1536 + 8 * cc + 4); }
      { const size_t m = (size_t)m0 + 4 * (tid >> 5); const int cc = tid & 31; if ((int)(m % SEQ) > 0) pv[0] = *(const bf16x8*)(p.proj + (m - 1) * IN_W + 2304 + 8 * cc); else pv[0] = (bf16x8){0, 0, 0, 0, 0, 0, 0, 0};
        pv[1] = cu[0]; pv[2] = cu[1]; pv[3] = cu[2]; }
#pragma unroll
      for (int it = 0; it < 4; ++it) { const int tk = 4 * (tid >> 5) + it, cc = tid & 31;
          const f32x4 c0 = bfx4_lo(cu[it]), c1 = bfx4_hi(cu[it]); f32x4 lo = c0 + (bfx4_lo(pv[it]) - c0) * mu0[it], hi = c1 + (bfx4_hi(pv[it]) - c1) * mu1[it];
          if (cc < 8) {
#pragma unroll
              for (int e = 0; e < 4; ++e) { lo[e] = 2.f * sigmoidf_(2.f * lo[e]) - 1.f; hi[e] = 2.f * sigmoidf_(2.f * hi[e]) - 1.f; } }
          else if (cc >= 16) {
#pragma unroll
              for (int e = 0; e < 4; ++e) { lo[e] = sigmoidf_(lo[e]); hi[e] = sigmoidf_(hi[e]); } }
          *(bf16x8*)(ACT + tk * PR_ACT_LD + 8 * cc) = pack8(lo, hi); } }
    if (p.layer > 0) {
        unsigned char* VS = lds + PR_SG_OFF; float* PS = (float*)(lds + PR_STG_OFF);
        const bool seq0 = (m0 % SEQ) == 0;
#pragma unroll
        for (int it = 0; it < 9; ++it) { const int pidx = tid + 512 * it; if (pidx < 65 * 64) { const int r = pidx >> 6, g = pidx & 63;
                bf16x8 v = (bf16x8){0, 0, 0, 0, 0, 0, 0, 0}; if (r > 0 || !seq0) v = *(const bf16x8*)(p.proj + ((size_t)m0 - 1 + r) * IN_W + 1792 + g * 8);
                *(bf16x8*)(VS + r * 1024 + ((g ^ (r & 7)) << 4)) = v; } }
        const int jb = wave & 1, kq = wave >> 1;
        bf16x8 wa[4], wb[4];
#pragma unroll
        for (int ks = 0; ks < 4; ++ks) { const int ko = 128 * kq + 32 * ks + 8 * fq; wa[ks] = *(const bf16x8*)(p.V1T + (size_t)(16 * jb + fr) * C + ko); wb[ks] = *(const bf16x8*)(p.V1B + (size_t)(16 * jb + fr) * C + ko); }
        __syncthreads();
        f32x4 acc[4];
#pragma unroll
        for (int tb = 0; tb < 4; ++tb) { acc[tb] = (f32x4){0.f, 0.f, 0.f, 0.f};
#pragma unroll
            for (int ks = 0; ks < 4; ++ks) { const int g = 4 * (4 * kq + ks) + fq, rp = 16 * tb + fr, rc = rp + 1;
                const bf16x8 cu = *(const bf16x8*)(VS + rc * 1024 + ((g ^ (rc & 7)) << 4)), pv = *(const bf16x8*)(VS + rp * 1024 + ((g ^ (rp & 7)) << 4));
                acc[tb] = __builtin_amdgcn_mfma_f32_16x16x32_bf16(wa[ks], cu, acc[tb], 0, 0, 0); acc[tb] = __builtin_amdgcn_mfma_f32_16x16x32_bf16(wb[ks], pv, acc[tb], 0, 0, 0); } }
        if (kq > 0) {
#pragma unroll
            for (int tb = 0; tb < 4; ++tb) *(f32x4*)(PS + ((kq - 1) * 64 + 16 * tb + fr) * 32 + 16 * jb + 4 * fq) = acc[tb]; }
        __syncthreads();
        if (kq == 0) {
#pragma unroll
            for (int tb = 0; tb < 4; ++tb) { const float* pp = PS + (16 * tb + fr) * 32 + 16 * jb + 4 * fq;
                const f32x4 s = acc[tb] + *(const f32x4*)pp + *(const f32x4*)(pp + 64 * 32) + *(const f32x4*)(pp + 2 * 64 * 32);
                uint2 w; w.x = pg8::cvt_pk_bf16(s[0], s[1]); w.y = pg8::cvt_pk_bf16(s[2], s[3]);
                *(uint2*)(VLO + (16 * tb + fr) * PR_VLO_LD + 16 * jb + 4 * fq) = w; } }
    }
    __syncthreads();
    const int ch0 = 64 * wave;
    if (p.layer > 0) {
        bf16x8 af[4], wf[4]; f32x4 bias[4];
#pragma unroll
        for (int cb = 0; cb < 4; ++cb) { wf[cb] = *(const bf16x8*)(p.V2T + (size_t)(ch0 + 16 * cb + fr) * 32 + 8 * fq); bias[cb] = *(const f32x4*)(p.v0 + ch0 + 16 * cb + 4 * fq); }
#pragma unroll
        for (int tb = 0; tb < 4; ++tb) af[tb] = *(const bf16x8*)(VLO + (16 * tb + fr) * PR_VLO_LD + 8 * fq);
#pragma unroll
        for (int cb = 0; cb < 4; ++cb) { const int ch = ch0 + 16 * cb + 4 * fq;
#pragma unroll
            for (int tb = 0; tb < 4; ++tb) { f32x4 x = __builtin_amdgcn_mfma_f32_16x16x32_bf16(wf[cb], af[tb], (f32x4){0.f, 0.f, 0.f, 0.f}, 0, 0, 0) + bias[cb];
                uint2 w; w.x = pg8::cvt_pk_bf16(sigmoidf_(x[0]), sigmoidf_(x[1])); w.y = pg8::cvt_pk_bf16(sigmoidf_(x[2]), sigmoidf_(x[3]));
                *(uint2*)(SG + (16 * tb + fr) * PR_SG_LD + ch) = w; } }
    }
    {
        f32x4 bw[4], ba[4];
#pragma unroll
        for (int cb = 0; cb < 4; ++cb) { bw[cb] = *(const f32x4*)(p.w0 + ch0 + 16 * cb + 4 * fq); ba[cb] = *(const f32x4*)(p.a0 + ch0 + 16 * cb + 4 * fq); }
        bf16x8 wA[2][4], wB[2][4], wC[4][4];
#define PR_LOADW(wf, WT, KL) _Pragma("unroll") for (int ks = 0; ks < (KL) / 32; ++ks) { _Pragma("unroll") for (int cb = 0; cb < 4; ++cb) wf[ks][cb] = *(const bf16x8*)((WT) + (size_t)(ch0 + 16 * cb + fr) * (KL) + 32 * ks + 8 * fq); }
#define PR_MMA(wf, K0, KL) { _Pragma("unroll") for (int tb = 0; tb < 4; ++tb) { _Pragma("unroll") for (int cb = 0; cb < 4; ++cb) acc[tb][cb] = (f32x4){0.f, 0.f, 0.f, 0.f}; } \
            _Pragma("unroll") for (int ks = 0; ks < (KL) / 32; ++ks) { bf16x8 af[4]; \
                _Pragma("unroll") for (int tb = 0; tb < 4; ++tb) af[tb] = *(const bf16x8*)(ACT + (16 * tb + fr) * PR_ACT_LD + (K0) + 32 * ks + 8 * fq); \
                _Pragma("unroll") for (int tb = 0; tb < 4; ++tb) { _Pragma("unroll") for (int cb = 0; cb < 4; ++cb) acc[tb][cb] = __builtin_amdgcn_mfma_f32_16x16x32_bf16(wf[ks][cb], af[tb], acc[tb][cb], 0, 0, 0); } } }
        f32x4 acc[4][4];
        unsigned char* stg = lds + PR_STG_OFF + wave * PR_STG_WAVE; const int st_w = fr * 144 + 8 * fq, l8 = lane & 7, lr = lane >> 3;
#define PR_WFENCE() { __builtin_amdgcn_fence(__ATOMIC_RELEASE, "wavefront"); __builtin_amdgcn_wave_barrier(); __builtin_amdgcn_fence(__ATOMIC_ACQUIRE, "wavefront"); }
#define PR_FLUSH(OUTP, TB) { PR_WFENCE() _Pragma("unroll") for (int i_ = 0; i_ < 2; ++i_) { const int row_ = lr + 8 * i_; const pg8::u32x4 v_ = *(const pg8::u32x4*)(stg + row_ * 144 + l8 * 16); \
            *(pg8::u32x4*)((OUTP) + ((size_t)m0 + 16 * (TB) + row_) * C + ch0 + l8 * 8) = v_; } PR_WFENCE() }
        PR_LOADW(wA, p.W2T, 64)
        PR_MMA(wA, 0, 64)
        PR_LOADW(wB, p.A2T, 64)
        { f32x4 run[4];
#pragma unroll
          for (int cb = 0; cb < 4; ++cb) run[cb] = (f32x4){0.f, 0.f, 0.f, 0.f};
#pragma unroll
          for (int tb = 0; tb < 4; ++tb) {
#pragma unroll
            for (int cb = 0; cb < 4; ++cb) { f32x4 x = acc[tb][cb] + bw[cb];
#pragma unroll
                for (int e = 0; e < 4; ++e) x[e] = -0.60653065971f * sigmoidf_(x[e]);
                f32x4 s, tot; s.x = scan16(x.x); s.y = scan16(x.y); s.z = scan16(x.z); s.w = scan16(x.w);
                tot.x = reduce16(x.x); tot.y = reduce16(x.y); tot.z = reduce16(x.z); tot.w = reduce16(x.w);
                const f32x4 cq = (s + run[cb]) * -CS_SCALE + 0.5f;
                uint2 w; w.x = (unsigned)fminf(cq.x, 65535.f) | ((unsigned)fminf(cq.y, 65535.f) << 16); w.y = (unsigned)fminf(cq.z, 65535.f) | ((unsigned)fminf(cq.w, 65535.f) << 16);
                *(uint2*)(stg + st_w + 32 * cb) = w; run[cb] = run[cb] + tot; }
            PR_FLUSH(p.CS, tb) } }
        PR_MMA(wB, 64, 64)
        PR_LOADW(wC, p.G2T, 128)
#pragma unroll
        for (int tb = 0; tb < 4; ++tb) {
#pragma unroll
            for (int cb = 0; cb < 4; ++cb) { f32x4 x = acc[tb][cb] + ba[cb];
#pragma unroll
                for (int e = 0; e < 4; ++e) x[e] = sigmoidf_(x[e]);
                uint2 w; w.x = pg8::cvt_pk_bf16(x[0], x[1]); w.y = pg8::cvt_pk_bf16(x[2], x[3]);
                *(uint2*)(stg + st_w + 32 * cb) = w; }
            PR_FLUSH(p.A, tb) }
        PR_MMA(wC, 128, 128)
#pragma unroll
        for (int tb = 0; tb < 4; ++tb) {
#pragma unroll
            for (int cb = 0; cb < 4; ++cb) { const f32x4 x = acc[tb][cb];
                uint2 w; w.x = pg8::cvt_pk_bf16(x[0], x[1]); w.y = pg8::cvt_pk_bf16(x[2], x[3]);
                *(uint2*)(stg + st_w + 32 * cb) = w; }
            PR_FLUSH(p.G, tb) }
#undef PR_FLUSH
#undef PR_WFENCE
#undef PR_LOADW
#undef PR_MMA
    }
    __syncthreads();
    {
        const int cc = tid & 63;
        bf16x8 cu[8], pv[8], vf[8]; const f32x4 mu0 = *(const f32x4*)(p.mu + 1024 + 8 * cc), mu1 = *(const f32x4*)(p.mu + 1024 + 8 * cc + 4);
#pragma unroll
        for (int it = 0; it < 8; ++it) { const int tk = 8 * (tid >> 6) + it; const size_t m = (size_t)m0 + tk; const int col = 768 + 1024 + 8 * cc;
            cu[it] = *(const bf16x8*)(p.proj + m * IN_W + col);
            if (p.layer > 0) vf[it] = *(const bf16x8*)(p.vfirst + m * C + 8 * cc); }
        { const size_t m = (size_t)m0 + 8 * (tid >> 6); if ((int)(m % SEQ) > 0) pv[0] = *(const bf16x8*)(p.proj + (m - 1) * IN_W + 768 + 1024 + 8 * cc); else pv[0] = (bf16x8){0, 0, 0, 0, 0, 0, 0, 0};
#pragma unroll
          for (int it = 1; it < 8; ++it) pv[it] = cu[it - 1]; }
#pragma unroll
        for (int it = 0; it < 8; ++it) { const int tk = 8 * (tid >> 6) + it; const size_t m = (size_t)m0 + tk;
            const f32x4 c0 = bfx4_lo(cu[it]), c1 = bfx4_hi(cu[it]);
            f32x4 lo = c0 + (bfx4_lo(pv[it]) - c0) * mu0, hi = c1 + (bfx4_hi(pv[it]) - c1) * mu1;
            const size_t o = m * C + 8 * cc;
            if (p.layer == 0) *(bf16x8*)(p.vfirst + o) = pack8(lo, hi);
            else { const bf16x8 sg = *(const bf16x8*)(SG + tk * PR_SG_LD + 8 * cc);
                lo = lo + (bfx4_lo(vf[it]) - lo) * bfx4_lo(sg); hi = hi + (bfx4_hi(vf[it]) - hi) * bfx4_hi(sg); }
            *(bf16x8*)(p.V + o) = pack8(lo, hi); }
    }
    __syncthreads();
}

constexpr int NTHREADS_ = 512;
constexpr int SC_TB = 32, SC_SLOT = 384, SC_NCH = SEQ / SC_TB;
constexpr size_t WS_RKC = 51 * MiB;
struct ScanArgs { const bf16_t *proj, *V, *A, *G; const unsigned short* CS; const float *k_k, *k_a, *r_k, *lnx_g, *lnx_b; bf16_t* mix; float* rkc; bf16_t* yt; };
constexpr int CK_LD = 72, CK_MAT = 64 * CK_LD * 2;
constexpr size_t WS_YT = WS_SI_LD;
constexpr size_t WS_TSCR = WS_SI_A, TSCR_WG = 2 * 64 * C * 2;
__device__ __forceinline__ void ck_mm(f32x4 (&acc)[2], const bf16_t* Qm, const bf16_t* P, int jb, int ib0, int fr, int fq) {
#pragma unroll
    for (int ks = 0; ks < 2; ++ks) { const bf16x8 bq = *(const bf16x8*)(Qm + (16 * jb + fr) * CK_LD + 32 * ks + 8 * fq);
#pragma unroll
        for (int ii = 0; ii < 2; ++ii) { const bf16x8 ap = *(const bf16x8*)(P + (16 * (ib0 + ii) + fr) * CK_LD + 32 * ks + 8 * fq); acc[ii] = __builtin_amdgcn_mfma_f32_16x16x32_bf16(ap, bq, acc[ii], 0, 0, 0); } }
}
typedef short ck_s16x4 __attribute__((ext_vector_type(4)));
__device__ __forceinline__ bf16x8 ck_tr_frag(const bf16_t* X, int colbase, int ks, int lane) {
    const bf16_t* a0 = X + (32 * ks + 8 * (lane >> 4) + ((lane & 15) >> 2)) * CK_LD + colbase + 4 * (lane & 3);
    const ck_s16x4 lo = __builtin_amdgcn_ds_read_tr16_b64_v4i16((__attribute__((address_space(3))) ck_s16x4*)a0), hi = __builtin_amdgcn_ds_read_tr16_b64_v4i16((__attribute__((address_space(3))) ck_s16x4*)(a0 + 4 * CK_LD));
    return (bf16x8){lo[0], lo[1], lo[2], lo[3], hi[0], hi[1], hi[2], hi[3]};
}
template <bool TQ, bool TP> __device__ __forceinline__ void ck_mm_t(f32x4 (&acc)[2], const bf16_t* Qm, const bf16_t* P, int jb, int ib0, int fr, int fq) {
    const int lane = fq * 16 + fr;
#pragma unroll
    for (int ks = 0; ks < 2; ++ks) { const bf16x8 bq = TQ ? ck_tr_frag(Qm, 16 * jb, ks, lane) : *(const bf16x8*)(Qm + (16 * jb + fr) * CK_LD + 32 * ks + 8 * fq);
#pragma unroll
        for (int ii = 0; ii < 2; ++ii) { const bf16x8 ap = TP ? ck_tr_frag(P, 16 * (ib0 + ii), ks, lane) : *(const bf16x8*)(P + (16 * (ib0 + ii) + fr) * CK_LD + 32 * ks + 8 * fq); acc[ii] = __builtin_amdgcn_mfma_f32_16x16x32_bf16(ap, bq, acc[ii], 0, 0, 0); } }
}
__device__ __forceinline__ uint2 ck_pack4(const f32x4 v) { uint2 w; w.x = pg8::cvt_pk_bf16(v[0], v[1]); w.y = pg8::cvt_pk_bf16(v[2], v[3]); return w; }
__device__ __forceinline__ f32x4 ck_unpack4(const uint2 u) { return (f32x4){__builtin_bit_cast(float, u.x << 16), __builtin_bit_cast(float, u.x & 0xffff0000u), __builtin_bit_cast(float, u.y << 16), __builtin_bit_cast(float, u.y & 0xffff0000u)}; }
struct CkRaw { bf16x8 rc, rp, kc, kp, v, a, cs, cp, cl; };
__device__ __forceinline__ float wave_sum_dpp(float x) {
    x = reduce16(x); const int xi = __builtin_bit_cast(int, x);
    const float r0 = __builtin_bit_cast(float, __builtin_amdgcn_readlane(xi, 0)), r1 = __builtin_bit_cast(float, __builtin_amdgcn_readlane(xi, 16)), r2 = __builtin_bit_cast(float, __builtin_amdgcn_readlane(xi, 32)), r3 = __builtin_bit_cast(float, __builtin_amdgcn_readlane(xi, 48));
    return (r0 + r1) + (r2 + r3); }
__device__ __forceinline__ void ck_load(const ScanArgs& p, CkRaw& w, int unit, int tid) {
    const int chain = unit >> 6, chunk = unit & 63, b = chain >> 3, h = chain & 7, tk = tid >> 3, hc = h * 64 + (tid & 7) * 8;
    const size_t row = (size_t)b * SEQ + chunk * 64 + tk, o = row * C + hc;
    const bf16_t* pr = p.proj + row * IN_W + 768 + hc; const bf16x8 z8 = (bf16x8){0, 0, 0, 0, 0, 0, 0, 0};
    w.rc = *(const bf16x8*)pr; w.kc = *(const bf16x8*)(pr + 512);
    { const int t8 = tk & 7; const bool has = (chunk * 64 + tk - t8) > 0; const bf16_t* pp = pr - (size_t)(t8 + (has ? 1 : 0)) * IN_W;
      const bf16x8 a_ = *(const bf16x8*)pp, b_ = *(const bf16x8*)(pp + 512); w.rp = has ? a_ : z8; w.kp = has ? b_ : z8; }
    w.v = *(const bf16x8*)(p.V + o); w.a = *(const bf16x8*)(p.A + o);
    w.cs = *(const bf16x8*)(p.CS + o); { const int t8 = tk & 7; const bool has = (tk - t8) > 0; const bf16x8 c_ = *(const bf16x8*)(p.CS + o - (size_t)(t8 + (has ? 1 : 0)) * C); w.cp = has ? c_ : z8; }
    w.cl = *(const bf16x8*)(p.CS + (row - tk + 63) * C + hc);
}
__device__ __forceinline__ f32x4 csq_lo(const bf16x8 v) { return (f32x4){(float)(unsigned short)v[0], (float)(unsigned short)v[1], (float)(unsigned short)v[2], (float)(unsigned short)v[3]} * (-1.f / CS_SCALE); }
__device__ __forceinline__ f32x4 csq_hi(const bf16x8 v) { return (f32x4){(float)(unsigned short)v[4], (float)(unsigned short)v[5], (float)(unsigned short)v[6], (float)(unsigned short)v[7]} * (-1.f / CS_SCALE); }
__device__ __forceinline__ f32x4 exp4(const f32x4 v) { return (f32x4){__expf(v[0]), __expf(v[1]), __expf(v[2]), __expf(v[3])}; }
constexpr int CK_CONST_OFF = 136192;
__device__ __forceinline__ void ck_precompute(const ScanArgs& p, const CkRaw& raw, CkRaw& nxt, int next_unit, unsigned char* lds, bf16_t* GQ, bf16_t* CQ, int unit, int tid) {
    const int chain = unit >> 6, chunk = unit & 63, b = chain >> 3, h = chain & 7, wave = __builtin_amdgcn_readfirstlane(tid >> 6), lane = tid & 63, fr = lane & 15, fq = lane >> 4, jb = wave >> 1, ib0 = 2 * (wave & 1);
    bf16_t* At = (bf16_t*)(lds + 0 * CK_MAT); bf16_t* bt = (bf16_t*)(lds + 1 * CK_MAT); bf16_t* kt = (bf16_t*)(lds + 2 * CK_MAT); bf16_t* rt = (bf16_t*)(lds + 3 * CK_MAT);
    bf16_t* AtT = (bf16_t*)(lds + 4 * CK_MAT); bf16_t* BhT = (bf16_t*)(lds + 5 * CK_MAT); bf16_t* KhT = (bf16_t*)(lds + 6 * CK_MAT); bf16_t* VT = (bf16_t*)(lds + 7 * CK_MAT);
    bf16_t* NT = (bf16_t*)(lds + 8 * CK_MAT); bf16_t* Mm = (bf16_t*)(lds + 9 * CK_MAT); bf16_t* P1 = (bf16_t*)(lds + 10 * CK_MAT); bf16_t* P2 = (bf16_t*)(lds + 11 * CK_MAT);
    bf16_t* Ta = (bf16_t*)(lds + 12 * CK_MAT); bf16_t* Tb = (bf16_t*)(lds + 13 * CK_MAT); float* WT = (float*)(lds + 14 * CK_MAT); float* GL = WT + 512;
    bf16_t* W1T = bt; bf16_t* MVT = kt; bf16_t* W2T = At;
    {
        const int tk = tid >> 3, c8 = (tid & 7) * 8, ro = tk * CK_LD + c8;
        bf16_t* BhR = BhT; bf16_t* KhR = KhT; bf16_t* VR = VT;
        const float* KC = (const float*)(lds + CK_CONST_OFF) + h * 64 + c8;
        const f32x4 kc0 = *(const f32x4*)KC, kc1 = *(const f32x4*)(KC + 4), ac0 = *(const f32x4*)(KC + 512), ac1 = *(const f32x4*)(KC + 516), rc0 = *(const f32x4*)(KC + 1024), rc1 = *(const f32x4*)(KC + 1028), mu0 = *(const f32x4*)(KC + 1536), mu1 = *(const f32x4*)(KC + 1540);
        const f32x4 mk0 = *(const f32x4*)(KC + 2048), mk1 = *(const f32x4*)(KC + 2052);
        bf16x8 prv_r, prv_k, prv_c;
        { const bool first = (lane >> 3) == 0; pg8::u32x4 a_ = __builtin_bit_cast(pg8::u32x4, raw.rc), b_ = __builtin_bit_cast(pg8::u32x4, raw.kc), c_ = __builtin_bit_cast(pg8::u32x4, raw.cs);
          a_.x = __shfl_up((int)a_.x, 8); a_.y = __shfl_up((int)a_.y, 8); a_.z = __shfl_up((int)a_.z, 8); a_.w = __shfl_up((int)a_.w, 8);
          b_.x = __shfl_up((int)b_.x, 8); b_.y = __shfl_up((int)b_.y, 8); b_.z = __shfl_up((int)b_.z, 8); b_.w = __shfl_up((int)b_.w, 8);
          c_.x = __shfl_up((int)c_.x, 8); c_.y = __shfl_up((int)c_.y, 8); c_.z = __shfl_up((int)c_.z, 8); c_.w = __shfl_up((int)c_.w, 8);
          prv_r = first ? raw.rp : __builtin_bit_cast(bf16x8, a_); prv_k = first ? raw.kp : __builtin_bit_cast(bf16x8, b_); prv_c = first ? raw.cp : __builtin_bit_cast(bf16x8, c_); }
        const f32x4 x0 = bfx4_lo(raw.rc), x1 = bfx4_hi(raw.rc); const f32x4 r0 = x0 + (bfx4_lo(prv_r) - x0) * mu0, r1 = x1 + (bfx4_hi(prv_r) - x1) * mu1;
        const f32x4 y0 = bfx4_lo(raw.kc), y1 = bfx4_hi(raw.kc); const f32x4 k0 = y0 + (bfx4_lo(prv_k) - y0) * mk0, k1 = y1 + (bfx4_hi(prv_k) - y1) * mk1;
        const f32x4 a0 = bfx4_lo(raw.a), a1 = bfx4_hi(raw.a);
        const f32x4 c0 = csq_lo(raw.cs), c1 = csq_hi(raw.cs), p0 = csq_lo(prv_c), p1 = csq_hi(prv_c), l0 = csq_lo(raw.cl), l1 = csq_hi(raw.cl);
        f32x4 q0 = k0 * kc0, q1 = k1 * kc1;
        const f32x4 qq = q0 * q0 + q1 * q1; const float nrm = red8((qq.x + qq.y) + (qq.z + qq.w));
        const float inv = fminf(__builtin_amdgcn_rsqf(nrm), 1e12f); q0 = q0 * inv; q1 = q1 * inv;
        const f32x4 kp0 = k0 * (1.f + (a0 - 1.f) * ac0), kp1 = k1 * (1.f + (a1 - 1.f) * ac1);
        const f32x4 rr = r0 * kp0 * rc0 + r1 * kp1 * rc1; const float rkc = red8((rr.x + rr.y) + (rr.z + rr.w));
        if ((tid & 7) == 0) p.rkc[((size_t)b * SEQ + chunk * 64 + tk) * 8 + h] = rkc;
        const f32x4 em0 = exp4(p0), em1 = exp4(p1), en0 = exp4(-c0), en1 = exp4(-c1), ep0 = exp4(c0), ep1 = exp4(c1), eL0 = exp4(l0 - c0), eL1 = exp4(l1 - c1);
        const f32x4 b0 = q0 * a0, b1 = q1 * a1;
        *(bf16x8*)(At + ro) = pack8(-q0 * em0, -q1 * em1); *(bf16x8*)(bt + ro) = pack8(b0 * en0, b1 * en1); *(bf16x8*)(kt + ro) = pack8(kp0 * en0, kp1 * en1); *(bf16x8*)(rt + ro) = pack8(r0 * ep0, r1 * ep1);
        *(bf16x8*)(BhR + ro) = pack8(b0 * eL0, b1 * eL1); *(bf16x8*)(KhR + ro) = pack8(kp0 * eL0, kp1 * eL1); *(bf16x8*)(VR + ro) = raw.v;
        if (tk == 0) { *(f32x4*)(GL + c8) = exp4(l0); *(f32x4*)(GL + c8 + 4) = exp4(l1); }
    }
    __syncthreads();
    const int j = 16 * jb + fr; const f32x4 z4 = (f32x4){0.f, 0.f, 0.f, 0.f};
    { f32x4 aN[2] = {z4, z4}, aM[2] = {z4, z4}, aP1[2] = {z4, z4}, aP2[2] = {z4, z4};
      ck_mm(aN, At, bt, jb, ib0, fr, fq); ck_mm(aM, At, kt, jb, ib0, fr, fq); ck_mm(aP1, rt, bt, jb, ib0, fr, fq); ck_mm(aP2, rt, kt, jb, ib0, fr, fq);
#pragma unroll
      for (int ii = 0; ii < 2; ++ii) { const int i0 = 16 * (ib0 + ii) + 4 * fq; f32x4 t0, nt, mm, p1, p2;
#pragma unroll
          for (int e = 0; e < 4; ++e) { const int i = i0 + e; nt[e] = i < j ? aN[ii][e] : 0.f; t0[e] = nt[e] + (i == j ? 1.f : 0.f); mm[e] = i < j ? aM[ii][e] : 0.f; p1[e] = i <= j ? aP1[ii][e] : 0.f; p2[e] = i <= j ? aP2[ii][e] : 0.f; }
          *(uint2*)(Ta + j * CK_LD + i0) = ck_pack4(t0); *(uint2*)(NT + j * CK_LD + i0) = ck_pack4(nt); *(uint2*)(Mm + j * CK_LD + i0) = ck_pack4(mm); *(uint2*)(P1 + j * CK_LD + i0) = ck_pack4(p1); *(uint2*)(P2 + j * CK_LD + i0) = ck_pack4(p2); } }
    __syncthreads();
#pragma unroll
    for (int st = 0; st < 3; ++st) { const bf16_t* src = (st & 1) ? Tb : Ta; bf16_t* dst = (st & 1) ? Ta : Tb; f32x4 a2[2] = {z4, z4}; ck_mm_t<false, true>(a2, src, NT, jb, ib0, fr, fq);
#pragma unroll
        for (int ii = 0; ii < 2; ++ii) { const int i0 = 16 * (ib0 + ii) + 4 * fq; f32x4 t = a2[ii];
#pragma unroll
            for (int e = 0; e < 4; ++e) t[e] += (i0 + e == j) ? 1.f : 0.f;
            *(uint2*)(dst + j * CK_LD + i0) = ck_pack4(t); }
        __syncthreads(); }
    { f32x4 a1[2] = {z4, z4}, a2[2] = {z4, z4}; ck_mm_t<true, false>(a1, At, Tb, jb, ib0, fr, fq); ck_mm_t<true, false>(a2, VT, Mm, jb, ib0, fr, fq);
#pragma unroll
      for (int ii = 0; ii < 2; ++ii) { const int i0 = 16 * (ib0 + ii) + 4 * fq; *(uint2*)(W1T + j * CK_LD + i0) = ck_pack4(a1[ii]); *(uint2*)(MVT + j * CK_LD + i0) = ck_pack4(a2[ii]); } }
    __syncthreads();
    { f32x4 a1[2] = {z4, z4}; ck_mm(a1, MVT, Tb, jb, ib0, fr, fq);
#pragma unroll
      for (int ii = 0; ii < 2; ++ii) { const int i0 = 16 * (ib0 + ii) + 4 * fq; *(uint2*)(W2T + j * CK_LD + i0) = ck_pack4(a1[ii]); } }
    __syncthreads();
    ck_load(p, nxt, next_unit, tid);
    { f32x4 aQ1[2] = {z4, z4}, aG[2] = {z4, z4}, aQ2[2] = {z4, z4}, aC[2] = {z4, z4};
      ck_mm(aQ1, P1, W1T, jb, ib0, fr, fq); ck_mm_t<true, false>(aG, BhT, W1T, jb, ib0, fr, fq); ck_mm(aQ2, P1, W2T, jb, ib0, fr, fq); ck_mm_t<false, true>(aQ2, P2, VT, jb, ib0, fr, fq); ck_mm_t<false, true>(aC, W2T, BhT, jb, ib0, fr, fq); ck_mm_t<true, true>(aC, VT, KhT, jb, ib0, fr, fq);
      bf16_t* gq = GQ + (size_t)unit * 8192; bf16_t* cq = CQ + (size_t)unit * 8192; const float glj = GL[j];
#pragma unroll
      for (int ii = 0; ii < 2; ++ii) { const int i0 = 16 * (ib0 + ii) + 4 * fq; f32x4 g = aG[ii];
#pragma unroll
          for (int e = 0; e < 4; ++e) g[e] += (i0 + e == j) ? glj : 0.f;
          const f32x4 q1 = aQ1[ii] + ck_unpack4(*(const uint2*)(rt + j * CK_LD + i0));
          *(uint2*)(AtT + j * CK_LD + i0) = ck_pack4(g); *(uint2*)(NT + j * CK_LD + i0) = ck_pack4(q1); *(uint2*)(Mm + j * CK_LD + i0) = ck_pack4(aC[ii]); *(uint2*)(Ta + j * CK_LD + i0) = ck_pack4(aQ2[ii]); }
      __syncthreads();
      { const int row = tid >> 3, c8 = (tid & 7) * 8, lo_ = row * CK_LD + c8, go_ = row * 64 + c8;
        const pg8::u32x4 v0 = *(const pg8::u32x4*)(AtT + lo_), v1 = *(const pg8::u32x4*)(NT + lo_), v2 = *(const pg8::u32x4*)(Mm + lo_), v3 = *(const pg8::u32x4*)(Ta + lo_);
        *(pg8::u32x4*)(gq + go_) = v0; *(pg8::u32x4*)(gq + 4096 + go_) = v1; { const int bo_ = (c8 >> 4) * 1024 + row * 16 + (c8 & 15);
          *(pg8::u32x4*)(cq + bo_) = v2; *(pg8::u32x4*)(cq + 4096 + bo_) = v3; } } }
    if (next_unit == unit) __syncthreads();
}
__device__ __forceinline__ void ck_sequential(const ScanArgs& p, unsigned char* lds, const bf16_t* GQ, const bf16_t* CQ, int item, int tid) {
    const int chain = item >> 2, q = item & 3, b = chain >> 3, h = chain & 7, wave = __builtin_amdgcn_readfirstlane(tid >> 6), lane = tid & 63, fr = lane & 15, fq = lane >> 4;
    bf16_t* OPS = (bf16_t*)lds;
    bf16_t* HT = (bf16_t*)(lds + 4 * CK_MAT);
    for (int i = tid; i < 2 * 16 * CK_LD / 2; i += NTHREADS_) ((unsigned*)HT)[i] = 0u;
    const size_t ubase = (size_t)chain * 64; const size_t rowbase = (size_t)b * SEQ;
    const int prow0 = tid >> 3, pcol = (tid & 7) * 8;
    const int aoff = wave < 4 ? (4096 + q * 1024 + (16 * wave + fr) * 16 + 4 * fq) : ((wave - 4) * 1024 + (16 * q + fr) * 16 + 4 * fq);
    typedef unsigned u32x2_ __attribute__((ext_vector_type(2)));
    pg8::u32x4 g0_0, g0_1, g0_2, g0_3, g0_4, g0_5, g0_6, g0_7, g1_0, g1_1, g1_2, g1_3, g1_4, g1_5, g1_6, g1_7; u32x2_ ad_0, ad_1, ad_2, ad_3, ad_4, ad_5, ad_6, ad_7;
#define CK_FETCH(slot, cc) do { const int c_ = (cc) < 64 ? (cc) : 63;     \
        const bf16_t* gq = GQ + (ubase + c_) * 8192; g0_##slot = *(const pg8::u32x4*)(gq + (size_t)prow0 * 64 + pcol); g1_##slot = *(const pg8::u32x4*)(gq + (size_t)(prow0 + 64) * 64 + pcol); \
        ad_##slot = *(const u32x2_*)(CQ + (ubase + c_) * 8192 + aoff); } while (0)
#define CK_STAGE(slot, buf) do { *(pg8::u32x4*)(OPS + (buf) * 2 * 64 * CK_LD + prow0 * CK_LD + pcol) = g0_##slot; *(pg8::u32x4*)(OPS + (buf) * 2 * 64 * CK_LD + 64 * CK_LD + prow0 * CK_LD + pcol) = g1_##slot; } while (0)
    CK_FETCH(0, 0); CK_FETCH(1, 1); CK_FETCH(2, 2); CK_FETCH(3, 3); CK_FETCH(4, 4); CK_FETCH(5, 5); CK_FETCH(6, 6); CK_FETCH(7, 7);
    CK_STAGE(0, 0);
    __syncthreads();
#define CK_STEP(cc, slot, nslot) do { const int bi = (cc) & 1; const bf16_t* Gm = OPS + bi * 2 * 64 * CK_LD; const bf16_t* Q1m = Gm + 64 * CK_LD; const bf16_t* HTc = HT + bi * 16 * CK_LD; bf16_t* HTn = HT + (bi ^ 1) * 16 * CK_LD; \
        f32x4 acc = (f32x4){0.f, 0.f, 0.f, 0.f}; \
        if (wave < 4) { _Pragma("unroll") for (int ks = 0; ks < 2; ++ks) acc = __builtin_amdgcn_mfma_f32_16x16x32_bf16(*(const bf16x8*)(HTc + fr * CK_LD + 32 * ks + 8 * fq), *(const bf16x8*)(Q1m + (16 * wave + fr) * CK_LD + 32 * ks + 8 * fq), acc, 0, 0, 0); \
            acc = acc + ck_unpack4((uint2){ad_##slot.x, ad_##slot.y}); \
            *(uint2*)(p.yt + ((((size_t)chain * 64 + (cc)) * 4 + q) * 64 + 16 * wave + fr) * 16 + 4 * fq) = ck_pack4(acc); } \
        else { _Pragma("unroll") for (int ks = 0; ks < 2; ++ks) acc = __builtin_amdgcn_mfma_f32_16x16x32_bf16(*(const bf16x8*)(Gm + (16 * (wave - 4) + fr) * CK_LD + 32 * ks + 8 * fq), *(const bf16x8*)(HTc + fr * CK_LD + 32 * ks + 8 * fq), acc, 0, 0, 0); \
            acc = acc + ck_unpack4((uint2){ad_##slot.x, ad_##slot.y}); \
            *(uint2*)(HTn + fr * CK_LD + 16 * (wave - 4) + 4 * fq) = ck_pack4(acc); } \
        CK_STAGE(nslot, bi ^ 1); \
        CK_FETCH(slot, (cc) + 8); \
        __syncthreads(); } while (0)
    for (int c = 0; c < 64; c += 8) { CK_STEP(c, 0, 1); CK_STEP(c + 1, 1, 2); CK_STEP(c + 2, 2, 3); CK_STEP(c + 3, 3, 4); CK_STEP(c + 4, 4, 5); CK_STEP(c + 5, 5, 6); CK_STEP(c + 6, 6, 7); CK_STEP(c + 7, 7, 0); }
#undef CK_FETCH
#undef CK_STAGE
#undef CK_STEP
}

struct PostRaw { bf16x8 y, v, g; float rk; f32x4 lg0, lg1, lb0, lb1; };
__device__ __forceinline__ void scan_post_load(const ScanArgs& p, PostRaw& w, int item, int lane) {
    const int tg = item & 7, chunk = (item >> 3) & 63, chain = item >> 9, b = chain >> 3, h = chain & 7, tl = lane >> 3, j = lane & 7, t = 8 * tg + tl;
    const size_t m = (size_t)b * SEQ + chunk * 64 + t;
    w.y = *(const bf16x8*)(p.yt + ((((size_t)chain * 64 + chunk) * 4 + (j >> 1)) * 64 + t) * 16 + (j & 1) * 8);
    w.v = *(const bf16x8*)(p.V + m * C + h * 64 + 8 * j); w.g = *(const bf16x8*)(p.G + m * C + h * 64 + 8 * j); w.rk = p.rkc[m * 8 + h];
    const float* lp = p.lnx_g + h * 64 + 8 * j; const float* bp = p.lnx_b + h * 64 + 8 * j;
    w.lg0 = *(const f32x4*)lp; w.lg1 = *(const f32x4*)(lp + 4); w.lb0 = *(const f32x4*)bp; w.lb1 = *(const f32x4*)(bp + 4);
}
__device__ __forceinline__ void scan_post_item(const ScanArgs& p, const PostRaw& w, int item, int lane) {
    const int tg = item & 7, chunk = (item >> 3) & 63, chain = item >> 9, b = chain >> 3, h = chain & 7, tl = lane >> 3, j = lane & 7;
    const size_t m = (size_t)b * SEQ + chunk * 64 + 8 * tg + tl;
    f32x4 y0 = bfx4_lo(w.y), y1 = bfx4_hi(w.y);
    const float mean = red8((y0.x + y0.y) + (y0.z + y0.w) + (y1.x + y1.y) + (y1.z + y1.w)) * (1.f / 64.f);
    y0 = y0 - mean; y1 = y1 - mean;
    const float var = red8((y0.x * y0.x + y0.y * y0.y) + (y0.z * y0.z + y0.w * y0.w) + (y1.x * y1.x + y1.y * y1.y) + (y1.z * y1.z + y1.w * y1.w)) * (1.f / 64.f);
    const float rs = rsqrtf(var + LNX_EPS);
    const f32x4 o0 = (y0 * rs * w.lg0 + w.lb0 + bfx4_lo(w.v) * w.rk) * bfx4_lo(w.g), o1 = (y1 * rs * w.lg1 + w.lb1 + bfx4_hi(w.v) * w.rk) * bfx4_hi(w.g);
    *(bf16x8*)(p.mix + m * D + ATT_W + h * 64 + 8 * j) = pack8(o0, o1);
}
__device__ __forceinline__ void scan_post_wave(const ScanArgs& p, int gw, int ngw, int lane) {
    constexpr int NITEM = BATCH * NH * 64 * 8;
    int item = gw; if (item >= NITEM) return;
    PostRaw cur; scan_post_load(p, cur, item, lane);
    for (; item < NITEM; item += ngw) { PostRaw nxt = cur; if (item + ngw < NITEM) scan_post_load(p, nxt, item + ngw, lane);
        scan_post_item(p, cur, item, lane); cur = nxt; }
}

typedef float f32x16 __attribute__((ext_vector_type(16)));
typedef short s16x4 __attribute__((ext_vector_type(4)));
constexpr int AT_VLD = 96;
__device__ __forceinline__ int crow(int r, int hi) { return (r & 3) + 8 * (r >> 2) + 4 * hi; }
constexpr int AT_KLD = 72;
__device__ __forceinline__ void attn_phase(const bf16_t* __restrict__ proj, const float* __restrict__ sinks, bf16_t* __restrict__ mix, unsigned char* lds, int G, int tid) {
    bf16_t* ks_ = (bf16_t*)lds; bf16_t* vs_ = (bf16_t*)(lds + 192 * AT_KLD * 2);
    const int g = __builtin_amdgcn_readfirstlane(tid >> 7), half = __builtin_amdgcn_readfirstlane((tid >> 6) & 1);
    constexpr int NU = BATCH * 2 * (SEQ / 64);
    bf16x8 pk0, pk1, pk2, pv0, pv1, pv2, pq0, pq1, pq2, pq3;
#define AT_PIECE(it, kdst, vdst, un) do { const int i_ = tq + 512 * (it), kl_ = i_ >> 3, ch8_ = i_ & 7; int key_ = ((un) & 63) * 64 - 128 + kl_; key_ = key_ < 0 ? 0 : key_;     \
        const bf16_t* rp_ = proj + ((size_t)((un) >> 7) * SEQ + key_) * IN_W + 512 + (((un) >> 6) & 1) * 64 + ch8_ * 8; kdst = *(const bf16x8*)rp_; vdst = *(const bf16x8*)(rp_ + KV_W); } while (0)
#define AT_FETCH(un) do { AT_PIECE(0, pk0, pv0, un); AT_PIECE(1, pk1, pv1, un); AT_PIECE(2, pk2, pv2, un); \
        { const int l_ = tq & 63; const bf16_t* qp_ = proj + ((size_t)((un) >> 7) * SEQ + ((un) & 63) * 64 + 32 * half + (l_ & 31)) * IN_W + ((((un) >> 6) & 1) * 4 + g) * 64 + 8 * (l_ >> 5); \
          pq0 = *(const bf16x8*)qp_; pq1 = *(const bf16x8*)(qp_ + 16); pq2 = *(const bf16x8*)(qp_ + 32); pq3 = *(const bf16x8*)(qp_ + 48); } } while (0)
#define AT_STAGE(it, ksrc, vsrc) do { const int i_ = tq + 512 * (it), kl_ = i_ >> 3, ch8_ = i_ & 7; *(bf16x8*)(ks_ + kl_ * AT_KLD + ch8_ * 8) = ksrc; *(bf16x8*)(vs_ + kl_ * AT_VLD + ch8_ * 8) = vsrc; } while (0)
    int tq = tid; int unit = blockIdx.x; if (unit < NU) AT_FETCH(unit);
    for (; unit < NU; unit += G) {
        const int b = unit >> 7, kvh = (unit >> 6) & 1, qb = unit & 63, Q0 = qb * 64, h = kvh * 4 + g; const size_t rowb = (size_t)b * SEQ;
        asm volatile("" : "+v"(tq));
        const int lane = tq & 63, c = lane & 31, hi = lane >> 5;
        AT_STAGE(0, pk0, pv0); AT_STAGE(1, pk1, pv1); AT_STAGE(2, pk2, pv2);
        const bf16x8 qf[4] = {pq0, pq1, pq2, pq3};
        __syncthreads();
        if (unit + G < NU) AT_FETCH(unit + G);
        const int t0 = Q0 + 32 * half; const size_t mq = rowb + t0 + c;
        f32x16 p[5];
#pragma unroll
        for (int kb = 0; kb < 5; ++kb) { const bf16_t* kp = ks_ + (32 * half + 32 * kb + c) * AT_KLD + 8 * hi;
            f32x16 acc;
#pragma unroll
            for (int r = 0; r < 16; ++r) acc[r] = 0.f;
#pragma unroll
            for (int ks = 0; ks < 4; ++ks) acc = __builtin_amdgcn_mfma_f32_32x32x16_bf16(*(const bf16x8*)(kp + 16 * ks), qf[ks], acc, 0, 0, 0);
            p[kb] = acc; }
        const float slope = exp2f(-(float)(h + 1)) * 1.44269504089f, sink = sinks[h] * 1.44269504089f;
        float mx = sink;
        const float bl = -slope * (float)(c + 128 - 4 * hi);
        const bool seq_start = (t0 < 128);
#pragma unroll
        for (int kb = 0; kb < 5; ++kb)
#pragma unroll
            for (int r = 0; r < 16; ++r) { const int cr0 = (r & 3) + 8 * (r >> 2), cr = cr0 + 4 * hi;
                float sc = p[kb][r] * (0.125f * 1.44269504089f) + (bl + slope * (float)(32 * kb + cr0));
                if (kb == 0) sc = (cr > c) ? sc : -1e30f;
                if (kb == 4) sc = (cr <= c) ? sc : -1e30f;
                if (seq_start) sc = (t0 - 128 + 32 * kb + cr >= 0) ? sc : -1e30f;
                p[kb][r] = sc; mx = fmaxf(mx, sc); }
        mx = fmaxf(mx, __shfl_xor(mx, 32));
        float l = 0.f;
#pragma unroll
        for (int kb = 0; kb < 5; ++kb)
#pragma unroll
            for (int r = 0; r < 16; ++r) { const float e = __builtin_amdgcn_exp2f(p[kb][r] - mx); p[kb][r] = e; l += e; }
        l += __shfl_xor(l, 32); l += __builtin_amdgcn_exp2f(sink - mx);
        f32x16 o[2];
#pragma unroll
        for (int d = 0; d < 2; ++d)
#pragma unroll
            for (int r = 0; r < 16; ++r) o[d][r] = 0.f;
#pragma unroll
        for (int kb = 0; kb < 5; ++kb)
#pragma unroll
            for (int s2 = 0; s2 < 2; ++s2) {
                pg8::u32x4 pw; pw.x = pg8::cvt_pk_bf16(p[kb][8 * s2 + 0], p[kb][8 * s2 + 1]); pw.y = pg8::cvt_pk_bf16(p[kb][8 * s2 + 2], p[kb][8 * s2 + 3]);
                pw.z = pg8::cvt_pk_bf16(p[kb][8 * s2 + 4], p[kb][8 * s2 + 5]); pw.w = pg8::cvt_pk_bf16(p[kb][8 * s2 + 6], p[kb][8 * s2 + 7]);
                const bf16x8 pf = __builtin_bit_cast(bf16x8, pw);
#pragma unroll
                for (int d = 0; d < 2; ++d) {
                    const bf16_t* vp = vs_ + (32 * half + 32 * kb + 16 * s2 + 4 * hi + ((lane & 15) >> 2)) * AT_VLD + 32 * d + 16 * ((lane >> 4) & 1) + 4 * (lane & 3);
                    const s16x4 lo = __builtin_amdgcn_ds_read_tr16_b64_v4i16((__attribute__((address_space(3))) s16x4*)vp), hh = __builtin_amdgcn_ds_read_tr16_b64_v4i16((__attribute__((address_space(3))) s16x4*)(vp + 8 * AT_VLD));
                    const bf16x8 vf = (bf16x8){lo[0], lo[1], lo[2], lo[3], hh[0], hh[1], hh[2], hh[3]};
                    o[d] = __builtin_amdgcn_mfma_f32_32x32x16_bf16(vf, pf, o[d], 0, 0, 0); } }
        const float inv = __builtin_amdgcn_rcpf(l);
#pragma unroll
        for (int d = 0; d < 2; ++d)
#pragma unroll
            for (int rp = 0; rp < 2; ++rp) {
                unsigned ax = pg8::cvt_pk_bf16(o[d][8 * rp] * inv, o[d][8 * rp + 1] * inv), ay = pg8::cvt_pk_bf16(o[d][8 * rp + 2] * inv, o[d][8 * rp + 3] * inv);
                unsigned bx = pg8::cvt_pk_bf16(o[d][8 * rp + 4] * inv, o[d][8 * rp + 5] * inv), by = pg8::cvt_pk_bf16(o[d][8 * rp + 6] * inv, o[d][8 * rp + 7] * inv);
                const auto r0 = __builtin_amdgcn_permlane32_swap(ax, bx, false, false); const auto r1 = __builtin_amdgcn_permlane32_swap(ay, by, false, false);
                pg8::u32x4 w; w.x = r0[0]; w.y = r1[0]; w.z = r0[1]; w.w = r1[1];
                *(pg8::u32x4*)(mix + mq * D + h * 64 + 32 * d + 16 * rp + 8 * hi) = w; }
        __syncthreads();
    }
#undef AT_PIECE
#undef AT_FETCH
#undef AT_STAGE
}

__device__ __forceinline__ void ffn_fixup(const float* __restrict__ SB, const float* __restrict__ cw, const float* __restrict__ cb, bf16_t* hid, int pm, int tid) {
    pm = __builtin_amdgcn_readfirstlane(pm);
    const float* s = SB + (size_t)pm * 6 * FF; const float* sp = SB + (size_t)(pm - 1) * 6 * FF; const bool has_prev = (pm % (SEQ / 256)) != 0;
    static_assert(2 * FF == 11 * NTHREADS_, "ffn_fixup: 11 items per thread");
    float u0[11], u1[11], ul0[11], ul1[11], w0[11], w1[11], w2[11], bb[11], up[11];
#pragma unroll
    for (int it = 0; it < 11; ++it) { const int idx = tid + NTHREADS_ * it, rr = idx >= FF ? 1 : 0, j = idx - rr * FF;
        u0[it] = s[j]; u1[it] = s[FF + j]; ul0[it] = has_prev ? sp[4 * FF + j] : 0.f; ul1[it] = has_prev ? sp[5 * FF + j] : 0.f;
        w0[it] = cw[j]; w1[it] = cw[FF + j]; w2[it] = cw[2 * FF + j]; bb[it] = cb[j]; up[it] = s[(2 + rr) * FF + j]; }
#pragma unroll
    for (int it = 0; it < 11; ++it) { const int idx = tid + NTHREADS_ * it, rr = idx >= FF ? 1 : 0, j = idx - rr * FF;
        const float c = rr == 0 ? bb[it] + w0[it] * ul0[it] + w1[it] * ul1[it] + w2[it] * u0[it] : bb[it] + w0[it] * ul1[it] + w1[it] * u0[it] + w2[it] * u1[it];
        hid[(size_t)(pm * 256 + rr) * FF + j] = (bf16_t)f2bf(c * sigmoidf_(c) * up[it]); }
}

#define XB_TMO      128
#define XB_XCNT(j)  (256  + 64 * (j))
#define XB_XSUB(j)  (1280 + 64 * (j))
#define XB_XGEN(j)  (2304 + 64 * (j))
#define XB_TOP      3328
#define XB_TOPGEN   3392
#define XCD_BAR_WORDS 3456
#define XB_SPIN_CAP (1u << 18)

__device__ __forceinline__ unsigned xb_ld(unsigned* p)              { return __hip_atomic_load(p, __ATOMIC_RELAXED, __HIP_MEMORY_SCOPE_AGENT); }
__device__ __forceinline__ unsigned xb_add(unsigned* p, unsigned v) { return __hip_atomic_fetch_add(p, v, __ATOMIC_RELAXED, __HIP_MEMORY_SCOPE_AGENT); }
__device__ __forceinline__ unsigned xb_xcc_id() { return (unsigned)__builtin_amdgcn_s_getreg((3 << 11) | 20) & 0xFu; }
#define XB_SPIN(cond, bar) do { unsigned _sp = 0; while (cond) { __builtin_amdgcn_s_sleep(1); \
    if ((++_sp & 255u) == 0u) { if (xb_ld(&(bar)[XB_TMO])) break; if (_sp > XB_SPIN_CAP) { atomicAdd(&(bar)[XB_TMO], 1u); break; } } } } while (0)

struct XcdBarrier {
    unsigned* bar; unsigned x;
    volatile __attribute__((address_space(3))) unsigned* st;
};

__device__ __forceinline__ XcdBarrier xcd_barrier_post(unsigned* bar, volatile __attribute__((address_space(3))) unsigned* st) {
    XcdBarrier b; b.bar = bar; b.x = xb_xcc_id(); b.st = st;
    if (threadIdx.x == 0) (void)xb_add(&bar[XB_XCNT(b.x)], 1u);
    return b;
}
__device__ __forceinline__ void xcd_barrier_complete(unsigned* bar, unsigned x, unsigned& nloc, unsigned& nx) {
    const unsigned G = gridDim.x * gridDim.y * gridDim.z;
    unsigned sum, cnt, mine, sp = 0u;
    for (;;) {
        sum = 0u; cnt = 0u; mine = 0u;
#pragma unroll
        for (unsigned j = 0; j < 16; ++j) { const unsigned c = xb_ld(&bar[XB_XCNT(j)]); sum += c; cnt += (c > 0u) ? 1u : 0u; mine = (j == x) ? c : mine; }
        if (sum == G) break;
        __builtin_amdgcn_s_sleep(1);
        if ((++sp & 255u) == 0u) { if (xb_ld(&bar[XB_TMO])) break; if (sp > XB_SPIN_CAP) { atomicAdd(&bar[XB_TMO], 1u); break; } }
    }
    nloc = mine > 0u ? mine : 1u; nx = cnt > 0u ? cnt : 1u;
}

__device__ __forceinline__ void xcd_barrier(const XcdBarrier& b) {
    asm volatile("s_waitcnt vmcnt(0)" ::: "memory");
    __syncthreads();
    if (threadIdx.x == 0) {
        unsigned* bar = b.bar;
        __builtin_amdgcn_s_waitcnt(0);
        unsigned nloc = b.st[0], nx = b.st[1];
        if (nloc == 0u) { xcd_barrier_complete(bar, b.x, nloc, nx); b.st[0] = nloc; b.st[1] = nx; }
        const unsigned old = xb_add(&bar[XB_XSUB(b.x)], 1u);
        const unsigned gen = old / nloc;
        if (old + 1u == (gen + 1u) * nloc) {
            __builtin_amdgcn_fence(__ATOMIC_RELEASE, "agent");
            asm volatile("s_waitcnt vmcnt(0)" ::: "memory");
            const unsigned og = xb_add(&bar[XB_TOP], 1u);
            const unsigned tg = og / nx;
            if (og + 1u == (tg + 1u) * nx) xb_add(&bar[XB_TOPGEN], 1u);
            else XB_SPIN(xb_ld(&bar[XB_TOPGEN]) == tg, bar);
            __builtin_amdgcn_fence(__ATOMIC_ACQUIRE, "agent");
            xb_add(&bar[XB_XGEN(b.x)], 1u);
            asm volatile("s_waitcnt vmcnt(0)" ::: "memory");
        } else {
            XB_SPIN(xb_ld(&bar[XB_XGEN(b.x)]) == gen, bar);
            __builtin_amdgcn_fence(__ATOMIC_ACQUIRE, "agent");
            asm volatile("s_waitcnt vmcnt(0)" ::: "memory");
        }
    }
    __syncthreads();
}

constexpr int NTHREADS = 512, LDS_BYTES = 147456;
struct Args { const float* in[26]; float* out; unsigned char* ws; };
__global__ void __launch_bounds__(NTHREADS, 2) mega_fwd(Args a) {
    extern __shared__ __attribute__((aligned(16))) unsigned char lds[];
    constexpr int MISC_OFF = 131072 + 4096;
    { volatile __attribute__((address_space(3))) unsigned* misc = (volatile __attribute__((address_space(3))) unsigned*)((__attribute__((address_space(3))) unsigned char*)lds + MISC_OFF);
      if (threadIdx.x < 4) misc[threadIdx.x] = 0u; }
    __syncthreads();
    (void)xcd_barrier_post((unsigned*)(a.ws + WS_BAR), (volatile __attribute__((address_space(3))) unsigned*)((__attribute__((address_space(3))) unsigned char*)lds + MISC_OFF));
#define GRID_SYNC() do { XcdBarrier xb_; xb_.bar = (unsigned*)(a.ws + WS_BAR); xb_.x = xb_xcc_id(); xb_.st = (volatile __attribute__((address_space(3))) unsigned*)((__attribute__((address_space(3))) unsigned char*)lds + MISC_OFF); xcd_barrier(xb_); } while (0)
#define LDSP ((PG8_LAS unsigned char*)lds)
    constexpr int XCH_OFF = 131072;
#define OTID() ({ int _t = threadIdx.x; asm volatile("" : "+v"(_t)); _t; })
    const int G = gridDim.x, NGW = G * 8;
    const float* x = a.in[0]; const float* norm1_g = a.in[1]; const float* w_in = a.in[2]; const float* sinks = a.in[3];
    const float* mu = a.in[4]; const float* w0 = a.in[5]; const float* w2 = a.in[6]; const float* a0 = a.in[7];
    const float* a2 = a.in[8]; const float* g2 = a.in[9]; const float* k_k = a.in[10]; const float* k_a = a.in[11];
    const float* r_k = a.in[12]; const float* lnx_g = a.in[13]; const float* lnx_b = a.in[14]; const float* v0 = a.in[15];
    const float* v1 = a.in[16]; const float* v2 = a.in[17]; const float* w_out = a.in[18]; const float* norm2_g = a.in[19];
    const float* wg = a.in[20]; const float* wu = a.in[21]; const float* conv_w = a.in[22]; const float* conv_b = a.in[23];
    const float* wd = a.in[24]; const float* final_g = a.in[25];
    unsigned char* ws = a.ws; float* X = a.out;
    ssq_t* ss = (ssq_t*)(ws + WS_SS);
    bf16_t* XB = (bf16_t*)(ws + WS_XB); bf16_t* PROJ = (bf16_t*)(ws + WS_PROJ); bf16_t* MIX = (bf16_t*)(ws + WS_MIX); bf16_t* HID = (bf16_t*)(ws + WS_HID); bf16_t* VF = (bf16_t*)(ws + WS_VFIRST);
    bf16_t* UT = (bf16_t*)(ws + WS_UTMP); bf16_t* UPT = UT + (size_t)SEQ * FF;

    {
        const int tid = OTID(), lane = tid & 63, wave = tid >> 6, gw = blockIdx.x * 8 + wave;
        float* scr = (float*)lds + wave * (64 * 33 + 16);
        constexpr int I_IN = (D / 64) * (IN_W / 32), I_OUT = (D / 64) * (D / 32), I_G = (D / 64) * (FF / 32), I_DN = (FF / 64) * (D / 32), I_LAYER = I_IN + I_OUT + 2 * I_G + I_DN;
        for (int it = gw; it < 2 * I_LAYER; it += NGW) {
            const int l = it / I_LAYER; int r = it % I_LAYER;
            bf16_t* wl = (bf16_t*)(ws + WS_W + l * W_LAYER); bf16_t* WinT = wl; bf16_t* WoutT = (bf16_t*)((char*)wl + W_IN_SZ); bf16_t* WguT = (bf16_t*)((char*)WoutT + W_OUT_SZ); bf16_t* WdT = (bf16_t*)((char*)WguT + W_GU_SZ);
            if (r < I_IN) { transpose_item(w_in + (size_t)l * D * IN_W, D, IN_W, WinT, norm1_g + l * D, 0, scr, r, lane); continue; } r -= I_IN;
            if (r < I_OUT) { transpose_item(w_out + (size_t)l * D * D, D, D, WoutT, nullptr, 0, scr, r, lane); continue; } r -= I_OUT;
            if (r < I_G) { transpose_item(wg + (size_t)l * D * FF, D, FF, WguT, norm2_g + l * D, 1, scr, r, lane); continue; } r -= I_G;
            if (r < I_G) { transpose_item(wu + (size_t)l * D * FF, D, FF, WguT, norm2_g + l * D, 2, scr, r, lane); continue; } r -= I_G;
            transpose_item(wd + (size_t)l * FF * D, FF, D, WdT, nullptr, 0, scr, r, lane);
        }
        {
            constexpr int I_W2 = 1 * (C / 32), I_G2 = 2 * (C / 32), I_V1 = (C / 64) * 1, I_L = 2 * I_W2 + I_G2;
            const float* mu_v1 = a.in[4] + SHIFT_W + 1024;
            for (int it = gw; it < 2 * I_L + 2 * I_V1; it += NGW) {
                if (it < 2 * I_L) { const int l = it / I_L; int r = it % I_L; bf16_t* base = (bf16_t*)(ws + WS_LORA + l * LORA_LAYER);
                    if (r < I_W2) { transpose_item(w2 + (size_t)l * 64 * C, 64, C, base, nullptr, 0, scr, r, lane); continue; } r -= I_W2;
                    if (r < I_W2) { transpose_item(a2 + (size_t)l * 64 * C, 64, C, base + 512 * 64, nullptr, 0, scr, r, lane); continue; } r -= I_W2;
                    transpose_item(g2 + (size_t)l * 128 * C, 128, C, base + 2 * 512 * 64, nullptr, 0, scr, r, lane); }
                else if (it < 2 * I_L + I_V1) transpose_item(v1, C, 32, (bf16_t*)(ws + WS_V1T), mu_v1, 0, scr, it - 2 * I_L, lane, true);
                else transpose_item(v1, C, 32, (bf16_t*)(ws + WS_V1B), mu_v1, 0, scr, it - 2 * I_L - I_V1, lane, false);
            }
            bf16_t* V2T = (bf16_t*)(ws + WS_V2T);
            for (int i = blockIdx.x * NTHREADS + tid; i < 32 * C; i += G * NTHREADS) { const int j = i / C, ch = i % C; V2T[ch * 32 + j] = (bf16_t)f2bf(v2[i]); }
        }
        for (int m = 4 * gw; m < M; m += 4 * NGW) {
            f32x4 xv[4][4];
#pragma unroll
            for (int u = 0; u < 4; ++u)
#pragma unroll
                for (int j = 0; j < 4; ++j) xv[u][j] = ((const f32x4*)(x + (size_t)(m + u) * D))[lane + 64 * j];
#pragma unroll
            for (int u = 0; u < 4; ++u) { float sq = 0.f;
#pragma unroll
                for (int j = 0; j < 4; ++j) { const f32x4 v = xv[u][j]; sq += v.x * v.x + v.y * v.y + v.z * v.z + v.w * v.w;
                    ((unsigned long long*)(XB + (size_t)(m + u) * D))[lane + 64 * j] = (unsigned long long)(f2bf(v.x) | (f2bf(v.y) << 16)) | ((unsigned long long)(f2bf(v.z) | (f2bf(v.w) << 16)) << 32); }
                sq = wave_sum(sq); if (lane == 0) ss[m + u] = ssq_fix(sq); } }
    }
    GRID_SYNC();
    for (int l = 0; l < 2; ++l) {
        bf16_t* wl = (bf16_t*)(ws + WS_W + l * W_LAYER); bf16_t* WinT = wl; bf16_t* WoutT = (bf16_t*)((char*)wl + W_IN_SZ); bf16_t* WguT = (bf16_t*)((char*)WoutT + W_OUT_SZ); bf16_t* WdT = (bf16_t*)((char*)WguT + W_GU_SZ);
        ssq_t* ss1 = ss + (size_t)(2 * l) * M; ssq_t* ss2 = ss + (size_t)(2 * l + 1) * M; ssq_t* ss3 = ss + (size_t)(2 * l + 2) * M;
        { pg8::Gemm g{XB, WinT, M, IN_W, D}; pg8::StaticOrder S; S.init(M, IN_W, G, (int)blockIdx.x); pg8::EpiScaleBf16 E{PROJ, IN_W, ss1};
          pg8::gemm_phase<pg8::EpiScaleBf16, pg8::StaticOrder, true, true>(LDSP, g, S, E); }
        GRID_SYNC();
        { float* KC = (float*)(lds + CK_CONST_OFF); const int t_ = OTID(); KC[t_] = (k_k + l * C)[t_]; KC[512 + t_] = (k_a + l * C)[t_]; KC[1024 + t_] = (r_k + l * C)[t_]; KC[1536 + t_] = (mu + l * SHIFT_W)[t_]; KC[2048 + t_] = (mu + l * SHIFT_W)[512 + t_]; __syncthreads(); }
        attn_phase(PROJ, sinks + l * NH, MIX, lds, G, OTID());
        struct { bf16_t *V, *G; } p; p.V = (bf16_t*)(ws + WS_SI_V); p.G = (bf16_t*)(ws + WS_SI_G);
        bf16_t* GQ = (bf16_t*)X; bf16_t* CQ = GQ + (size_t)BATCH * NH * 64 * 8192;
        ScanArgs s{}; s.yt = (bf16_t*)(ws + WS_YT); s.proj = PROJ; s.V = p.V; s.G = p.G; s.k_k = k_k + l * C; s.k_a = k_a + l * C; s.r_k = r_k + l * C; s.lnx_g = lnx_g + l * C; s.lnx_b = lnx_b + l * C; s.mix = MIX; s.rkc = (float*)(ws + WS_RKC);
        { bf16_t* scr = (bf16_t*)(ws + WS_TSCR + (size_t)blockIdx.x * TSCR_WG);
          for (int tile = blockIdx.x; tile < M / 64; tile += G) {
              const size_t moff = (size_t)tile * 64 * C;
              Prep2Args q{}; q.proj = PROJ; q.mu = mu + l * SHIFT_W; q.w0 = w0 + l * C; q.a0 = a0 + l * C; q.v0 = v0;
              const bf16_t* lw = (const bf16_t*)(ws + WS_LORA + l * LORA_LAYER); q.W2T = lw; q.A2T = lw + 512 * 64; q.G2T = lw + 2 * 512 * 64; q.V1T = (const bf16_t*)(ws + WS_V1T); q.V1B = (const bf16_t*)(ws + WS_V1B); q.V2T = (const bf16_t*)(ws + WS_V2T);
              q.vfirst = VF; q.A = scr - moff; q.CS = (unsigned short*)(scr + 64 * C) - moff; q.V = p.V; q.G = p.G; q.layer = l;
              prep_tile(q, lds, tile, OTID());
              asm volatile("s_waitcnt vmcnt(0)" ::: "memory"); __syncthreads();
              if (threadIdx.x == 0) { __builtin_amdgcn_fence(__ATOMIC_ACQUIRE, "agent"); asm volatile("s_waitcnt vmcnt(0)" ::: "memory"); }
              __syncthreads();
              s.A = q.A; s.CS = q.CS;
              const int bb = tile >> 6, chunk = tile & 63;
              CkRaw cur; ck_load(s, cur, ((bb * NH) << 6) + chunk, OTID());
#define CK_UNIT(hh_) do { const int unit = ((bb * NH + (hh_)) << 6) + chunk; CkRaw nxt = cur; ck_precompute(s, cur, nxt, (hh_) + 1 < NH ? unit + 64 : unit, lds, GQ, CQ, unit, OTID()); cur = nxt; } while (0)
              CK_UNIT(0);
              for (int hh = 1; hh < NH; ++hh) CK_UNIT(hh);
#undef CK_UNIT
          } }
        GRID_SYNC();
        for (int item = (int)((blockIdx.x & 7) * (G >> 3) + (blockIdx.x >> 3)); item < BATCH * NH * 4; item += G) ck_sequential(s, lds, GQ, CQ, item, OTID());
        GRID_SYNC();
        { const int tid = OTID(), lane = tid & 63, gw = blockIdx.x * 8 + (tid >> 6); scan_post_wave(s, gw, NGW, lane); }
        GRID_SYNC();
        { pg8::Gemm g{MIX, WoutT, M, D, D}; pg8::StaticOrder S; S.init(M, D, G, (int)blockIdx.x); pg8::EpiResid E{XB, ss2};
          pg8::gemm_phase<pg8::EpiResid, pg8::StaticOrder, true, true>(LDSP, g, S, E); }
        GRID_SYNC();
        { pg8::Gemm g{XB, WguT, M, 2 * FF, D}; pg8::StaticOrder S; S.init(M, 2 * FF, G, (int)blockIdx.x);
          pg8::EpiConvGlu E{HID, ss2, conv_w + (size_t)l * 3 * FF, conv_b + (size_t)l * FF, (float*)(ws + WS_UTMP), (PG8_LAS float*)(LDSP + XCH_OFF), FF};
          pg8::gemm_phase<pg8::EpiConvGlu, pg8::StaticOrder, true, true>(LDSP, g, S, E); }
        GRID_SYNC();
        { pg8::Gemm g{HID, WdT, M, D, FF}; pg8::StaticOrder S; S.init(M, D, G, (int)blockIdx.x);
          { pg8::Unit u; for (int i = 0; S.next(i, u); ++i) ffn_fixup((const float*)(ws + WS_UTMP), conv_w + (size_t)l * 3 * FF, conv_b + (size_t)l * FF, HID, u.pm, OTID());
            asm volatile("s_waitcnt vmcnt(0)" ::: "memory"); __syncthreads(); }
          if (l == 0) { pg8::EpiResid E{XB, ss3}; pg8::gemm_phase<pg8::EpiResid, pg8::StaticOrder, true, true>(LDSP, g, S, E); }
          else { pg8::EpiResidFinal E{XB, ss3, (unsigned*)(ws + WS_FCNT), final_g, X};
                 pg8::gemm_phase<pg8::EpiResidFinal, pg8::StaticOrder, true, true>(LDSP, g, S, E); } }
        if (l == 0) GRID_SYNC();
    }
}

extern "C" void kernel_launch(void* const* d_in, const int* in_sizes, int n_in, void* d_out, int out_size, void* d_ws, size_t ws_size, hipStream_t stream) {
    static int grid = 0;
    if (grid == 0) {
        if (n_in != 26 || in_sizes[0] != M * D || out_size != M * D || ws_size < WS_END) { fprintf(stderr, "kernel_launch: unexpected shapes (n_in %d, ws %zu)\n", n_in, ws_size); grid = -1; return; }
        int dev = 0, cus = 0, per_cu = 0;
        if (hipGetDevice(&dev) != hipSuccess || hipDeviceGetAttribute(&cus, hipDeviceAttributeMultiprocessorCount, dev) != hipSuccess) { grid = -1; return; }
        if (hipFuncSetAttribute((const void*)mega_fwd, hipFuncAttributeMaxDynamicSharedMemorySize, LDS_BYTES) != hipSuccess) { fprintf(stderr, "kernel_launch: hipFuncSetAttribute failed\n"); grid = -1; return; }
        if (hipOccupancyMaxActiveBlocksPerMultiprocessor(&per_cu, (const void*)mega_fwd, NTHREADS, LDS_BYTES) != hipSuccess || per_cu < 1) { fprintf(stderr, "kernel_launch: occupancy query failed (%d)\n", per_cu); grid = -1; return; }
        grid = cus;
    }
    if (grid < 0) return;
    (void)hipMemsetAsync((unsigned char*)d_ws + WS_CTL, 0, CTL_BYTES, stream);
    Args a{};
    for (int i = 0; i < 26; ++i) a.in[i] = (const float*)d_in[i];
    a.out = (float*)d_out; a.ws = (unsigned char*)d_ws;
    void* kargs[] = {&a};
    hipError_t e = hipLaunchCooperativeKernel((const void*)mega_fwd, dim3(grid), dim3(NTHREADS), kargs, LDS_BYTES, stream);
    if (e != hipSuccess) fprintf(stderr, "kernel_launch: cooperative launch failed: %s (grid %d)\n", hipGetErrorString(e), grid);
}
```

```cpp
#include <hip/hip_runtime.h>
#include <cstdio>
#include <cstdint>

typedef unsigned short bf16_t;
typedef short bf16x8 __attribute__((ext_vector_type(8)));
typedef float f32x4 __attribute__((ext_vector_type(4)));

constexpr int BATCH = 8, SEQ = 4096, D = 1024, M = BATCH * SEQ;
constexpr int HD = 64, ATT_W = 512, KV_W = 128, C = 512, NH = 8;
constexpr int ATT_IN = 768, SHIFT_W = 1792, IN_W = 2560, FF = 2816;
constexpr int WINDOW = 128;
constexpr float RMS_EPS = 1e-5f, LNX_EPS = 64e-5f;

constexpr size_t MiB = 1u << 20;
constexpr size_t WS_CTL = 0;
typedef unsigned long long ssq_t;
__device__ __forceinline__ ssq_t ssq_fix(float s) { return (ssq_t)(s * 1048576.0f + 0.5f); }
__device__ __forceinline__ float ssq_val(ssq_t v) { return (float)v * (1.0f / 1048576.0f); }
constexpr size_t WS_SS = 0;
constexpr size_t CTL_BYTES = 2 * MiB;
constexpr size_t WS_FCNT = 1792 * 1024;
constexpr size_t WS_BAR = 1536 * 1024;
constexpr size_t WS_W = 2 * MiB;
constexpr size_t W_IN_SZ = (size_t)IN_W * D * 2, W_OUT_SZ = (size_t)D * D * 2, W_GU_SZ = (size_t)2 * FF * D * 2, W_DN_SZ = (size_t)D * FF * 2;
constexpr size_t W_LAYER = W_IN_SZ + W_OUT_SZ + W_GU_SZ + W_DN_SZ;
constexpr size_t WS_VFIRST = 52 * MiB, WS_MIX = 84 * MiB, WS_XB = 148 * MiB, WS_PROJ = 212 * MiB;
constexpr size_t WS_SI_R = 148 * MiB, WS_SI_K = 180 * MiB, WS_SI_V = 372 * MiB, WS_SI_A = 404 * MiB, WS_SI_LD = 436 * MiB, WS_SI_G = 468 * MiB;
constexpr size_t WS_HID = 212 * MiB;
constexpr size_t WS_UTMP = 84 * MiB;
constexpr size_t WS_END = 500 * MiB;
static_assert(WS_W + 2 * W_LAYER <= WS_VFIRST, "weights fit");

__device__ __forceinline__ unsigned f2bf(float f) { unsigned u = __builtin_bit_cast(unsigned, f); return (u + 0x7fffu + ((u >> 16) & 1u)) >> 16; }
__device__ __forceinline__ float bf2f(bf16_t h) { return __builtin_bit_cast(float, (unsigned)h << 16); }
__device__ __forceinline__ float wave_sum(float v) {
#pragma unroll
    for (int o = 1; o < 64; o <<= 1) v += __shfl_xor(v, o);
    return v;
}
#define LDS_BARRIER() do { asm volatile("s_waitcnt lgkmcnt(0)" ::: "memory"); __builtin_amdgcn_s_barrier(); asm volatile("" ::: "memory"); } while (0)
__device__ __forceinline__ float sigmoidf_(float x) { return __builtin_amdgcn_rcpf(1.f + __expf(-x)); }

namespace pg8 {
#define PG8_LAS __attribute__((address_space(3)))
typedef unsigned short bf16_t;
typedef short bf16x8 __attribute__((ext_vector_type(8)));
typedef float f32x4 __attribute__((ext_vector_type(4)));
typedef unsigned u32x4 __attribute__((ext_vector_type(4)));
constexpr int BM = 256, BK = 64, HALF = 128, HTB = HALF * BK * 2  , STAGE_BYTES = 8 * HTB, NXCD = 8, WGM = 8;

__host__ __device__ __forceinline__ int lds_byte(int r, int c) { const int st = (r >> 4) * 2 + (c >> 5), rr = r & 15, cc = c & 31, ob = rr * 64 + cc * 2; return st * 1024 + (ob ^ (((ob >> 9) & 1) << 5)); }
__host__ __device__ __forceinline__ void stage_rc(int b, int& R, int& C) { const int st = b / 1024, sb = b % 1024, swz = sb ^ (((sb >> 9) & 1) << 5); R = (st >> 1) * 16 + swz / 64; C = (st & 1) * 32 + (swz % 64) / 2; }
__host__ __device__ __forceinline__ int perm32(int rho) { const int n = rho >> 4, i = rho & 15; return 8 * (i >> 2) + 4 * n + (i & 3); }

struct Unit { int pm, pn; };
struct Gemm { const bf16_t* A; const bf16_t* Bt; int M, N, K; };

struct StaticOrder {
    int nM, nN, nwg, G, c;
    __host__ __device__ void init(int M, int N, int G_, int c_) { nM = M / BM; nN = N / BM; nwg = nM * nN; G = G_; c = c_; }
    __host__ __device__ bool next(int i, Unit& u) const {
        const long L = (long)i * G + c; if (L >= nwg) return false;
        int wgid = (int)L; { const int q = nwg / NXCD, r = nwg % NXCD, xcd = wgid % NXCD, off = wgid / NXCD; wgid = (xcd < r ? xcd * (q + 1) : r * (q + 1) + (xcd - r) * q) + off; }
        const int nig = WGM * nN, gid = wgid / nig, fm = gid * WGM, gsz = (nM - fm) < WGM ? (nM - fm) : WGM;
        u.pm = fm + ((wgid % nig) % gsz); u.pn = (wgid % nig) / gsz; return true;
    }
    __device__ __forceinline__ void a_ready(const Unit&) const {}
    __device__ __forceinline__ void done(const Unit&) const {}
};
typedef float f32x2_t_ __attribute__((ext_vector_type(2))); typedef __bf16 bf16x2_t_ __attribute__((ext_vector_type(2)));
__device__ __forceinline__ unsigned cvt_pk_bf16(float lo, float hi) { const f32x2_t_ v = {lo, hi}; const bf16x2_t_ b = __builtin_convertvector(v, bf16x2_t_); return __builtin_bit_cast(unsigned, b); }
typedef float f32x2 __attribute__((ext_vector_type(2)));
template <class Epi, class Sched, bool ALIGN_EPI = false, bool SP2 = false>
__device__ __forceinline__ void gemm_phase(PG8_LAS unsigned char* lds, const Gemm g, const Sched& S, const Epi& E) {
    int tid_ = threadIdx.x; asm volatile("" : "+v"(tid_));
    const int tid = tid_, wid = __builtin_amdgcn_readfirstlane(tid >> 6), lane = tid & 63, wr = wid >> 2, wc = wid & 3, fr = lane & 15, fq = lane >> 4;
    const int K = g.K, nt = K / BK;
    unsigned voffA[2], voffB[2];
#pragma unroll
    for (int i = 0; i < 2; ++i) { int R, C; stage_rc(tid * 16 + i * 8192, R, C); const int Rb = (R >> 5) * 64 + (Epi::PERM ? perm32(R & 31) : (R & 31));
        voffA[i] = (unsigned)(R * K + C) * 2u; voffB[i] = (unsigned)(Rb * K + C) * 2u; }
    const size_t kstep = (size_t)(BK * 2);
    const size_t hstep = (size_t)HALF * K * 2;
    const size_t tstep = 2 * hstep;
    const size_t hstepB = (size_t)32 * K * 2;
    const unsigned ldsw = (unsigned)wid * 1024u;
    const int aoff = lds_byte(wr * 64 + fr, fq * 8), boff = lds_byte(wc * 32 + fr, fq * 8);
#define PG8_SA(b, h) (((b) * 2 + (h)) * HTB)
#define PG8_SB(b, h) ((4 + (b) * 2 + (h)) * HTB)
#define PG8_STAGE(bufoff, gbase, voff) do { _Pragma("unroll") for (int _i = 0; _i < 2; ++_i) \
        __builtin_amdgcn_global_load_lds((const unsigned*)((const char*)(gbase) + (voff)[_i]), (PG8_LAS unsigned*)(lds + (bufoff) + ldsw + _i * 8192), 16, 0, 0); } while (0)
#define PG8_LDA(dst, b, h) do { _Pragma("unroll") for (int m = 0; m < 4; ++m) _Pragma("unroll") for (int k = 0; k < 2; ++k) dst[m][k] = *(const PG8_LAS bf16x8*)(lds + PG8_SA(b, h) + aoff + m * 2048 + k * 1024); } while (0)
#define PG8_LDB(dst, b, h) do { _Pragma("unroll") for (int n = 0; n < 2; ++n) _Pragma("unroll") for (int k = 0; k < 2; ++k) dst[n][k] = *(const PG8_LAS bf16x8*)(lds + PG8_SB(b, h) + boff + n * 2048 + k * 1024); } while (0)
#define PG8_MMA(ai, bj, At, Bt) do { __builtin_amdgcn_s_setprio(1); _Pragma("unroll") for (int m = 0; m < 4; ++m) _Pragma("unroll") for (int n = 0; n < 2; ++n) _Pragma("unroll") for (int k = 0; k < 2; ++k) \
        acc[ai][bj][m][n] = __builtin_amdgcn_mfma_f32_16x16x32_bf16(Bt[n][k], At[m][k], acc[ai][bj][m][n], 0, 0, 0); __builtin_amdgcn_s_setprio(0); } while (0)
#define PG8_WAIT_V(n) asm volatile("s_waitcnt vmcnt(" #n ")" ::: "memory")
#define PG8_WAIT_L(n) asm volatile("s_waitcnt lgkmcnt(" #n ")" ::: "memory")
#define PG8_BAR __builtin_amdgcn_s_barrier()
#define PG8_SCHED __builtin_amdgcn_sched_barrier(0)
    Unit cur, nxt; int ui = 0;
    if (!S.next(0, cur)) return;
    f32x4 acc[2][2][4][2];
#pragma unroll
    for (int a = 0; a < 2; ++a)
#pragma unroll
        for (int b = 0; b < 2; ++b)
#pragma unroll
            for (int m = 0; m < 4; ++m)
#pragma unroll
                for (int n = 0; n < 2; ++n) acc[a][b][m][n] = (f32x4){0.f, 0.f, 0.f, 0.f};
    bf16x8 At[4][2], B0[2][2], B1[2][2];
    const char* cA = (const char*)g.A + (size_t)cur.pm * tstep; const char* cB = (const char*)g.Bt + (size_t)cur.pn * tstep;
    if constexpr (Epi::HAS_PRE) E.pre(lds, cur, 0, wid, lane);
    S.a_ready(cur);
    if constexpr (SP2) {
        PG8_STAGE(PG8_SB(0, 0), cB, voffB); PG8_STAGE(PG8_SB(0, 1), cB + hstepB, voffB); PG8_STAGE(PG8_SA(0, 0), cA, voffA); PG8_STAGE(PG8_SA(0, 1), cA + hstep, voffA);
        if (wr == 1) PG8_BAR;
        PG8_WAIT_V(2); PG8_BAR;
        PG8_STAGE(PG8_SB(1, 0), cB + kstep, voffB); PG8_STAGE(PG8_SA(1, 0), cA + kstep, voffA); PG8_STAGE(PG8_SB(1, 1), cB + hstepB + kstep, voffB);
        PG8_WAIT_V(6); PG8_BAR;
    } else {
        PG8_STAGE(PG8_SB(0, 0), cB, voffB); PG8_STAGE(PG8_SA(0, 0), cA, voffA); PG8_STAGE(PG8_SB(0, 1), cB + hstepB, voffB); PG8_STAGE(PG8_SA(0, 1), cA + hstep, voffA);
        if (wr == 1) PG8_BAR;
        PG8_WAIT_V(4); PG8_BAR;
        PG8_STAGE(PG8_SB(1, 0), cB + kstep, voffB); PG8_STAGE(PG8_SA(1, 0), cA + kstep, voffA); PG8_STAGE(PG8_SB(1, 1), cB + hstepB + kstep, voffB);
        PG8_WAIT_V(6); PG8_BAR;
    }
    for (;;) {
        const bool has_next = S.next(ui + 1, nxt);
        const char* nA = has_next ? (const char*)g.A + (size_t)nxt.pm * tstep : cA; const char* nB = has_next ? (const char*)g.Bt + (size_t)nxt.pn * tstep : cB;
        for (int t = 0; t < nt; t += 2) {
            const bool last = (t == nt - 2);
            const char* a1 = cA + (size_t)(t + 1) * kstep;
            const char* a2 = last ? nA : cA + (size_t)(t + 2) * kstep; const char* b2 = last ? nB : cB + (size_t)(t + 2) * kstep;
            const char* a3 = a2 + kstep; const char* b3 = b2 + kstep;
            if (last && has_next) S.a_ready(nxt);
            if constexpr (SP2) {
            PG8_LDB(B0, 0, 0); PG8_LDB(B1, 0, 1); PG8_SCHED; PG8_LDA(At, 0, 0); PG8_STAGE(PG8_SA(1, 1), a1 + hstep, voffA);
            PG8_WAIT_V(8); PG8_WAIT_L(0); PG8_BAR; PG8_MMA(0, 0, At, B0); PG8_MMA(0, 1, At, B1); PG8_BAR; PG8_SCHED;
            PG8_LDA(At, 0, 1); PG8_STAGE(PG8_SB(0, 0), b2, voffB); PG8_STAGE(PG8_SB(0, 1), b2 + hstepB, voffB); PG8_STAGE(PG8_SA(0, 0), a2, voffA);
            PG8_WAIT_V(8); PG8_WAIT_L(0); PG8_BAR; PG8_MMA(1, 0, At, B0); PG8_MMA(1, 1, At, B1); PG8_BAR; PG8_SCHED;
            PG8_LDB(B0, 1, 0); PG8_LDB(B1, 1, 1); PG8_SCHED; PG8_LDA(At, 1, 0); PG8_STAGE(PG8_SA(0, 1), a2 + hstep, voffA);
            PG8_WAIT_V(8); PG8_WAIT_L(0); PG8_BAR; PG8_MMA(0, 0, At, B0); PG8_MMA(0, 1, At, B1); PG8_BAR; PG8_SCHED;
            PG8_LDA(At, 1, 1); PG8_STAGE(PG8_SB(1, 0), b3, voffB); PG8_STAGE(PG8_SB(1, 1), b3 + hstepB, voffB); PG8_STAGE(PG8_SA(1, 0), a3, voffA);
            PG8_WAIT_V(8); PG8_WAIT_L(0); PG8_BAR; PG8_MMA(1, 0, At, B0); PG8_MMA(1, 1, At, B1); PG8_BAR; PG8_SCHED;
            } else {
            PG8_LDB(B0, 0, 0); PG8_SCHED; PG8_LDA(At, 0, 0); PG8_STAGE(PG8_SA(1, 1), a1 + hstep, voffA);
            PG8_WAIT_L(8); PG8_BAR; PG8_WAIT_L(0); PG8_MMA(0, 0, At, B0); PG8_BAR; PG8_SCHED;
            PG8_LDB(B1, 0, 1); PG8_STAGE(PG8_SB(0, 0), b2, voffB);
            PG8_BAR; PG8_WAIT_L(0); PG8_MMA(0, 1, At, B1); PG8_BAR;
            PG8_LDA(At, 0, 1); PG8_STAGE(PG8_SA(0, 0), a2, voffA);
            PG8_BAR; PG8_WAIT_L(0); PG8_MMA(1, 0, At, B0); PG8_BAR; PG8_SCHED;
            PG8_STAGE(PG8_SB(0, 1), b2 + hstepB, voffB);
            PG8_WAIT_V(6); PG8_BAR; PG8_MMA(1, 1, At, B1); PG8_BAR;
            PG8_LDB(B0, 1, 0); PG8_SCHED; PG8_LDA(At, 1, 0); PG8_STAGE(PG8_SA(0, 1), a2 + hstep, voffA);
            PG8_WAIT_L(8); PG8_BAR; PG8_WAIT_L(0); PG8_MMA(0, 0, At, B0); PG8_BAR; PG8_SCHED;
            PG8_LDB(B1, 1, 1); PG8_STAGE(PG8_SB(1, 0), b3, voffB);
            PG8_BAR; PG8_WAIT_L(0); PG8_MMA(0, 1, At, B1); PG8_BAR;
            PG8_LDA(At, 1, 1); PG8_STAGE(PG8_SA(1, 0), a3, voffA);
            PG8_BAR; PG8_WAIT_L(0); PG8_MMA(1, 0, At, B0); PG8_BAR; PG8_SCHED;
            PG8_STAGE(PG8_SB(1, 1), b3 + hstepB, voffB);
            PG8_WAIT_V(6); PG8_BAR; PG8_MMA(1, 1, At, B1); PG8_BAR;
            }
        }
        if constexpr (ALIGN_EPI) { if (wr == 0) PG8_BAR; }
        if constexpr (Epi::HAS_PRE) { if (has_next) E.pre(lds, nxt, (ui + 1) & 1, wid, lane); E(acc, cur, wr, wc, fr, fq, lds, ui & 1); S.done(cur); }
        else if constexpr (!Epi::AFTER_DRAIN) { E(acc, cur, wr, wc, fr, fq); S.done(cur); }
        if (!has_next) break;
#pragma unroll
        for (int a = 0; a < 2; ++a)
#pragma unroll
            for (int b = 0; b < 2; ++b)
#pragma unroll
                for (int m = 0; m < 4; ++m)
#pragma unroll
                    for (int n = 0; n < 2; ++n) acc[a][b][m][n] = (f32x4){0.f, 0.f, 0.f, 0.f};
        cur = nxt; cA = nA; cB = nB; ++ui;
        if constexpr (ALIGN_EPI) { if (wr == 1) PG8_BAR; }
    }
    PG8_WAIT_V(0);
    if constexpr (!ALIGN_EPI) { if (wr == 0) PG8_BAR; }
    PG8_BAR;
    if constexpr (Epi::AFTER_DRAIN) { E.fused(acc, cur, wr, wc, fr, fq, lds, wid, lane); S.done(cur); }
#undef PG8_SA
#undef PG8_SB
#undef PG8_STAGE
#undef PG8_LDA
#undef PG8_LDB
#undef PG8_MMA
#undef PG8_WAIT_V
#undef PG8_WAIT_L
#undef PG8_BAR
#undef PG8_SCHED
}

constexpr int DM_ = 1024; constexpr float RMS_EPS_ = 1e-5f;
typedef unsigned long long ssq_t;
struct EpiScaleBf16 {
    static constexpr bool PERM = true, AFTER_DRAIN = false, HAS_PRE = true;
    static constexpr int PRE_OFF = 136192;
    bf16_t* O; int ldc; const ssq_t* ss;
    __device__ __forceinline__ void pre(PG8_LAS unsigned char* lds, const Unit& u, int buf, int wid, int lane) const {
        if (wid < 2) __builtin_amdgcn_global_load_lds((const unsigned*)(ss + (size_t)u.pm * BM + (wid * 64 + lane) * 2), (PG8_LAS unsigned*)(lds + PRE_OFF + buf * 2048 + wid * 1024), 16, 0, 0);
    }
    __device__ __forceinline__ void operator()(const f32x4 (&acc)[2][2][4][2], const Unit& u, int wr, int wc, int fr, int fq, PG8_LAS unsigned char* lds, int buf) const {
        const int row0 = u.pm * BM + wr * 64 + fr, col0 = u.pn * BM + wc * 64 + 8 * fq;
        PG8_LAS const unsigned char* img = lds + PRE_OFF + buf * 2048;
        float rsv[2][4];
#pragma unroll
        for (int ai = 0; ai < 2; ++ai)
#pragma unroll
            for (int m = 0; m < 4; ++m) rsv[ai][m] = (float)*(PG8_LAS const ssq_t*)(img + 8 * (wr * 64 + fr + ai * HALF + m * 16)) * (1.0f / 1048576.0f);
#pragma unroll
        for (int ai = 0; ai < 2; ++ai)
#pragma unroll
            for (int m = 0; m < 4; ++m) { const int row = row0 + ai * HALF + m * 16; const float rs = __builtin_amdgcn_rsqf(rsv[ai][m] * (1.0f / DM_) + RMS_EPS_);
                u32x4 w[2];
#pragma unroll
                for (int bj = 0; bj < 2; ++bj) { const f32x4 v0 = acc[ai][bj][m][0] * rs, v1 = acc[ai][bj][m][1] * rs;
                    w[bj].x = cvt_pk_bf16(v0[0], v0[1]); w[bj].y = cvt_pk_bf16(v0[2], v0[3]); w[bj].z = cvt_pk_bf16(v1[0], v1[1]); w[bj].w = cvt_pk_bf16(v1[2], v1[3]); }
                const bool odd = (fr & 1) != 0; const u32x4 snd = odd ? w[0] : w[1];
                u32x4 rcv; rcv.x = (unsigned)__builtin_amdgcn_update_dpp(0, (int)snd.x, 0xB1, 0xF, 0xF, true); rcv.y = (unsigned)__builtin_amdgcn_update_dpp(0, (int)snd.y, 0xB1, 0xF, 0xF, true);
                rcv.z = (unsigned)__builtin_amdgcn_update_dpp(0, (int)snd.z, 0xB1, 0xF, 0xF, true); rcv.w = (unsigned)__builtin_amdgcn_update_dpp(0, (int)snd.w, 0xB1, 0xF, 0xF, true);
                const u32x4 dA = odd ? rcv : w[0], dB = odd ? w[1] : rcv;
                bf16_t* rowp = O + (size_t)(row - (odd ? 1 : 0)) * ldc + col0 + (odd ? 32 : 0);
                *(u32x4*)rowp = dA; *(u32x4*)(rowp + ldc) = dB; }
    }
};
struct EpiResid {
    static constexpr bool PERM = true, AFTER_DRAIN = false, HAS_PRE = false;
    bf16_t* xb; ssq_t* ss_out;
    __device__ __forceinline__ void operator()(const f32x4 (&acc)[2][2][4][2], const Unit& u, int wr, int wc, int fr, int fq) const {
        const int row0 = u.pm * BM + wr * 64 + fr, col0 = u.pn * BM + wc * 64 + 8 * fq;
        u32x4 bs[4][2], wv[2][4][2]; float sqv[2][4];
        const bool odd = (fr & 1) != 0; const size_t pbase = (size_t)(row0 - (odd ? 1 : 0)) * DM_ + col0 + (odd ? 32 : 0);
#define PG8_SWAP4(d, s_) do { (d).x = (unsigned)__builtin_amdgcn_update_dpp(0, (int)(s_).x, 0xB1, 0xF, 0xF, true); (d).y = (unsigned)__builtin_amdgcn_update_dpp(0, (int)(s_).y, 0xB1, 0xF, 0xF, true); \
        (d).z = (unsigned)__builtin_amdgcn_update_dpp(0, (int)(s_).z, 0xB1, 0xF, 0xF, true); (d).w = (unsigned)__builtin_amdgcn_update_dpp(0, (int)(s_).w, 0xB1, 0xF, 0xF, true); } while (0)
#define PG8_RESID_LOAD(ai) _Pragma("unroll") for (int m = 0; m < 4; ++m) { const bf16_t* lp_ = xb + pbase + (size_t)((ai) * HALF + m * 16) * DM_; bs[m][0] = *(const u32x4*)lp_; bs[m][1] = *(const u32x4*)(lp_ + DM_); }
#define PG8_RESID_STORE(ai) _Pragma("unroll") for (int m = 0; m < 4; ++m) { const u32x4 snd_ = odd ? wv[ai][m][0] : wv[ai][m][1]; u32x4 rcv_; PG8_SWAP4(rcv_, snd_); bf16_t* sp_ = xb + pbase + (size_t)((ai) * HALF + m * 16) * DM_; \
            *(u32x4*)sp_ = odd ? rcv_ : wv[ai][m][0]; *(u32x4*)(sp_ + DM_) = odd ? wv[ai][m][1] : rcv_; }
#define PG8_RESID_MATH(ai) _Pragma("unroll") for (int m = 0; m < 4; ++m) { float sq = 0.f; \
            const u32x4 snd_ = odd ? bs[m][0] : bs[m][1]; u32x4 rcv_; PG8_SWAP4(rcv_, snd_); const u32x4 own0_ = odd ? rcv_ : bs[m][0], own1_ = odd ? bs[m][1] : rcv_;     \
            _Pragma("unroll") for (int bj = 0; bj < 2; ++bj) { const u32x4 b = bj == 0 ? own0_ : own1_; u32x4 w; \
                _Pragma("unroll") for (int hh = 0; hh < 2; ++hh) { const unsigned b0 = hh == 0 ? b.x : b.z, b1 = hh == 0 ? b.y : b.w; const f32x4 a4 = acc[ai][bj][m][hh]; \
                    const float x0 = __builtin_bit_cast(float, b0 << 16) + a4[0], x1 = __builtin_bit_cast(float, b0 & 0xffff0000u) + a4[1], x2 = __builtin_bit_cast(float, b1 << 16) + a4[2], x3 = __builtin_bit_cast(float, b1 & 0xffff0000u) + a4[3]; \
                    const unsigned w0 = cvt_pk_bf16(x0, x1), w1 = cvt_pk_bf16(x2, x3); \
                    if (hh == 0) { w.x = w0; w.y = w1; } else { w.z = w0; w.w = w1; } \
                    const float r0 = __builtin_bit_cast(float, w0 << 16), r1 = __builtin_bit_cast(float, w0 & 0xffff0000u), r2 = __builtin_bit_cast(float, w1 << 16), r3 = __builtin_bit_cast(float, w1 & 0xffff0000u); \
                    sq += (r0 * r0 + r1 * r1) + (r2 * r2 + r3 * r3); } \
                wv[ai][m][bj] = w; } \
            sq += __shfl_xor(sq, 16); sq += __shfl_xor(sq, 32); sqv[ai][m] = sq; }
        PG8_RESID_LOAD(0); PG8_RESID_MATH(0); PG8_RESID_LOAD(1); PG8_RESID_STORE(0); PG8_RESID_MATH(1); PG8_RESID_STORE(1);
#undef PG8_RESID_LOAD
#undef PG8_SWAP4
#undef PG8_RESID_STORE
#undef PG8_RESID_MATH
        if (fq == 0) {
#pragma unroll
            for (int ai = 0; ai < 2; ++ai)
#pragma unroll
                for (int m = 0; m < 4; ++m) atomicAdd(ss_out + row0 + ai * HALF + m * 16, (ssq_t)(sqv[ai][m] * 1048576.0f + 0.5f)); }
    }
};
struct EpiResidFinal {
    static constexpr bool PERM = true, AFTER_DRAIN = false, HAS_PRE = false;
    const bf16_t* xb; ssq_t* ss_out; unsigned* cnt; const float* g; float* out;
    __device__ __forceinline__ void operator()(f32x4 (&acc)[2][2][4][2], const Unit& u, int wr, int wc, int fr, int fq) const {
        const int row0 = u.pm * BM + wr * 64 + fr, col0 = u.pn * BM + wc * 64 + 8 * fq;
#pragma unroll
        for (int ai = 0; ai < 2; ++ai) {
            u32x4 bs[4][2];
            const bool oddl = (fr & 1) != 0; const size_t pbase = (size_t)(row0 - (oddl ? 1 : 0)) * DM_ + col0 + (oddl ? 32 : 0);
#pragma unroll
            for (int m = 0; m < 4; ++m) { const bf16_t* lp_ = xb + pbase + (size_t)(ai * HALF + m * 16) * DM_; bs[m][0] = *(const u32x4*)lp_; bs[m][1] = *(const u32x4*)(lp_ + DM_); }
#pragma unroll
            for (int m = 0; m < 4; ++m) { const int row = row0 + ai * HALF + m * 16; float sq = 0.f;
                const u32x4 snd_ = oddl ? bs[m][0] : bs[m][1]; u32x4 rcv_;
                rcv_.x = (unsigned)__builtin_amdgcn_update_dpp(0, (int)snd_.x, 0xB1, 0xF, 0xF, true); rcv_.y = (unsigned)__builtin_amdgcn_update_dpp(0, (int)snd_.y, 0xB1, 0xF, 0xF, true);
                rcv_.z = (unsigned)__builtin_amdgcn_update_dpp(0, (int)snd_.z, 0xB1, 0xF, 0xF, true); rcv_.w = (unsigned)__builtin_amdgcn_update_dpp(0, (int)snd_.w, 0xB1, 0xF, 0xF, true);
                const u32x4 own0_ = oddl ? rcv_ : bs[m][0], own1_ = oddl ? bs[m][1] : rcv_;
#pragma unroll
                for (int bj = 0; bj < 2; ++bj) { const u32x4 b = bj == 0 ? own0_ : own1_;
#pragma unroll
                    for (int hh = 0; hh < 2; ++hh) { const unsigned b0 = hh == 0 ? b.x : b.z, b1 = hh == 0 ? b.y : b.w; const f32x4 a4 = acc[ai][bj][m][hh];
                        const float x0 = __builtin_bit_cast(float, b0 << 16) + a4[0], x1 = __builtin_bit_cast(float, b0 & 0xffff0000u) + a4[1], x2 = __builtin_bit_cast(float, b1 << 16) + a4[2], x3 = __builtin_bit_cast(float, b1 & 0xffff0000u) + a4[3];
                        const unsigned w0 = cvt_pk_bf16(x0, x1), w1 = cvt_pk_bf16(x2, x3);
                        const float r0 = __builtin_bit_cast(float, w0 << 16), r1 = __builtin_bit_cast(float, w0 & 0xffff0000u), r2 = __builtin_bit_cast(float, w1 << 16), r3 = __builtin_bit_cast(float, w1 & 0xffff0000u);
                        acc[ai][bj][m][hh] = (f32x4){r0, r1, r2, r3};
                        sq += (r0 * r0 + r1 * r1) + (r2 * r2 + r3 * r3); } }
                sq += __shfl_xor(sq, 16); sq += __shfl_xor(sq, 32);
                if (fq == 0) atomicAdd(ss_out + row, (ssq_t)(sq * 1048576.0f + 0.5f)); }
        }
        asm volatile("s_waitcnt vmcnt(0)" ::: "memory"); __builtin_amdgcn_s_barrier(); asm volatile("" ::: "memory");
        if (wr == 0 && wc == 0 && fr == 0 && fq == 0) {
            (void)__hip_atomic_fetch_add(cnt + u.pm, 1u, __ATOMIC_RELAXED, __HIP_MEMORY_SCOPE_AGENT);
            for (unsigned sp = 0; __hip_atomic_load(cnt + u.pm, __ATOMIC_RELAXED, __HIP_MEMORY_SCOPE_AGENT) < 4u && sp < (1u << 22); ++sp) __builtin_amdgcn_s_sleep(2);
        }
        asm volatile("s_waitcnt vmcnt(0)" ::: "memory"); __builtin_amdgcn_s_barrier(); asm volatile("" ::: "memory");
        f32x4 gv[2][2];
#pragma unroll
        for (int bj = 0; bj < 2; ++bj)
#pragma unroll
            for (int hh = 0; hh < 2; ++hh) gv[bj][hh] = *(const f32x4*)(g + col0 + bj * 32 + 4 * hh);
#pragma unroll
        for (int ai = 0; ai < 2; ++ai)
#pragma unroll
            for (int m = 0; m < 4; ++m) { const int row = row0 + ai * HALF + m * 16;
                const ssq_t sv = __hip_atomic_load(ss_out + row, __ATOMIC_RELAXED, __HIP_MEMORY_SCOPE_AGENT);
                const float rs = __builtin_amdgcn_rsqf((float)sv * (1.0f / 1048576.0f) * (1.0f / DM_) + RMS_EPS_);
                const bool odd = (fr & 1) != 0; float* op = out + (size_t)(row - (odd ? 1 : 0)) * DM_ + col0 + (odd ? 4 : 0);
#pragma unroll
                for (int bj = 0; bj < 2; ++bj) { const f32x4 v0 = acc[ai][bj][m][0] * gv[bj][0] * rs, v1 = acc[ai][bj][m][1] * gv[bj][1] * rs; const u32x4 snd = __builtin_bit_cast(u32x4, odd ? v0 : v1); u32x4 rcu;
                    rcu.x = (unsigned)__builtin_amdgcn_update_dpp(0, (int)snd.x, 0xB1, 0xF, 0xF, true); rcu.y = (unsigned)__builtin_amdgcn_update_dpp(0, (int)snd.y, 0xB1, 0xF, 0xF, true);
                    rcu.z = (unsigned)__builtin_amdgcn_update_dpp(0, (int)snd.z, 0xB1, 0xF, 0xF, true); rcu.w = (unsigned)__builtin_amdgcn_update_dpp(0, (int)snd.w, 0xB1, 0xF, 0xF, true);
                    const f32x4 rcv = __builtin_bit_cast(f32x4, rcu);
                    __builtin_nontemporal_store(odd ? rcv : v0, (f32x4*)(op + bj * 32)); __builtin_nontemporal_store(odd ? v1 : rcv, (f32x4*)(op + bj * 32 + DM_)); } }
    }
};
template <int CTRL> __device__ __forceinline__ float dpp1(float x) { return __builtin_bit_cast(float, __builtin_amdgcn_update_dpp(0, __builtin_bit_cast(int, x), CTRL, 0xF, 0xF, true)); }
template <int CTRL> __device__ __forceinline__ f32x4 dpp4(const f32x4 x) { return (f32x4){dpp1<CTRL>(x.x), dpp1<CTRL>(x.y), dpp1<CTRL>(x.z), dpp1<CTRL>(x.w)}; }
struct EpiConvGlu {
    static constexpr bool PERM = true, AFTER_DRAIN = false, HAS_PRE = true;
    static constexpr int PRE_OFF = 136192;
    bf16_t* HID; const ssq_t* ss; const float* cw; const float* cb; float* SB; PG8_LAS float* xch; int ff;
    __device__ __forceinline__ void pre(PG8_LAS unsigned char* lds, const Unit& u, int buf, int wid, int lane) const {
        if (wid < 4) { const int pc = wid * 64 + lane; const char* src;
            if (wid < 2) { const int r_ = pc >> 5; src = (const char*)((r_ < 3 ? cw + (size_t)r_ * ff : cb) + u.pn * HALF + (pc & 31) * 4); }
            else src = (const char*)(ss + (size_t)u.pm * BM + (pc - 128) * 2);
            __builtin_amdgcn_global_load_lds((const unsigned*)src, (PG8_LAS unsigned*)(lds + PRE_OFF + buf * 4096 + wid * 1024), 16, 0, 0); }
    }
    __device__ __forceinline__ void operator()(const f32x4 (&acc)[2][2][4][2], const Unit& u, int wr, int wc, int fr, int fq, PG8_LAS unsigned char* lds, int buf) const {
        const int row0 = u.pm * BM + wr * 64 + fr, cl = wc * 32 + 8 * fq, jcol = u.pn * HALF + cl;
        PG8_LAS const unsigned char* img = lds + PRE_OFF + buf * 4096;
        float rs[2][4];
#pragma unroll
        for (int ai = 0; ai < 2; ++ai)
#pragma unroll
            for (int m = 0; m < 4; ++m) rs[ai][m] = (float)*(PG8_LAS const ssq_t*)(img + 2048 + 8 * (wr * 64 + fr + ai * HALF + m * 16)) * (1.0f / 1048576.0f);
        f32x4 w0[2], w1[2], w2[2], bb[2];
#pragma unroll
        for (int n = 0; n < 2; ++n) { w0[n] = *(PG8_LAS const f32x4*)(img + 4 * (cl + 4 * n)); w1[n] = *(PG8_LAS const f32x4*)(img + 512 + 4 * (cl + 4 * n)); w2[n] = *(PG8_LAS const f32x4*)(img + 1024 + 4 * (cl + 4 * n)); bb[n] = *(PG8_LAS const f32x4*)(img + 1536 + 4 * (cl + 4 * n)); }
#pragma unroll
        for (int ai = 0; ai < 2; ++ai)
#pragma unroll
            for (int m = 0; m < 4; ++m) rs[ai][m] = __builtin_amdgcn_rsqf(rs[ai][m] * (1.0f / DM_) + RMS_EPS_);
        if (fr >= 14) {
#pragma unroll
            for (int ai = 0; ai < 2; ++ai)
#pragma unroll
                for (int n = 0; n < 2; ++n) *(PG8_LAS f32x4*)(xch + ((2 * ai + wr) * 2 + (fr - 14)) * HALF + cl + 4 * n) = acc[ai][0][3][n] * rs[ai][3];
        }
        asm volatile("s_waitcnt lgkmcnt(0)" ::: "memory"); __builtin_amdgcn_s_barrier(); asm volatile("" ::: "memory");
        float* sbp = SB + (size_t)u.pm * 6 * ff + jcol;
#pragma unroll
        for (int ai = 0; ai < 2; ++ai) {
            const int q = 2 * ai + wr;
            f32x4 X[2];
#pragma unroll
            for (int n = 0; n < 2; ++n) { X[n] = (f32x4){0.f, 0.f, 0.f, 0.f}; if (q > 0 && fr >= 14) X[n] = *(const PG8_LAS f32x4*)(xch + ((q - 1) * 2 + (fr - 14)) * HALF + cl + 4 * n); }
            f32x4 prevg[2] = {X[0], X[1]};
#pragma unroll
            for (int m = 0; m < 4; ++m) { const int row = row0 + ai * HALF + m * 16;
                pg8::u32x4 hw;
#pragma unroll
                for (int n = 0; n < 2; ++n) {
                    const f32x4 cur = acc[ai][0][m][n] * rs[ai][m], up = acc[ai][1][m][n] * rs[ai][m];
                    const f32x4 P = prevg[n]; prevg[n] = cur;
                    f32x4 z1, z2;
#pragma unroll
                    for (int e = 0; e < 4; ++e) { z1[e] = fr == 15 ? P[e] : cur[e]; z2[e] = fr >= 14 ? P[e] : cur[e]; }
                    const f32x4 p1 = dpp4<0x121>(z1), p2 = dpp4<0x122>(z2);
                    const f32x4 c = bb[n] + w0[n] * p2 + w1[n] * p1 + w2[n] * cur;
                    f32x4 hv;
#pragma unroll
                    for (int e = 0; e < 4; ++e) hv[e] = c[e] * __builtin_amdgcn_rcpf(1.f + __expf(-c[e])) * up[e];
                    if (n == 0) { hw.x = cvt_pk_bf16(hv[0], hv[1]); hw.y = cvt_pk_bf16(hv[2], hv[3]); } else { hw.z = cvt_pk_bf16(hv[0], hv[1]); hw.w = cvt_pk_bf16(hv[2], hv[3]); }
                }
                *(pg8::u32x4*)(HID + (size_t)row * ff + jcol) = hw; }
        }
        if (wr == 0 && fr < 2) {
#pragma unroll
            for (int n = 0; n < 2; ++n) { *(f32x4*)(sbp + (size_t)fr * ff + 4 * n) = acc[0][0][0][n] * rs[0][0]; *(f32x4*)(sbp + (size_t)(2 + fr) * ff + 4 * n) = acc[0][1][0][n] * rs[0][0]; } }
        if (wr == 1 && fr >= 14) {
#pragma unroll
            for (int n = 0; n < 2; ++n) *(f32x4*)(sbp + (size_t)(4 + fr - 14) * ff + 4 * n) = acc[1][0][3][n] * rs[1][3]; }
    }
};
}

#define LAS __attribute__((address_space(3)))
__device__ __forceinline__ void transpose_item(const float* __restrict__ W, int K, int N, bf16_t* __restrict__ Wt, const float* __restrict__ g, int mode, float* scr, int item, int lane, bool gcompl = false) {
    const int nblk = N / 32, kb = item / nblk, nb = item % nblk, k0 = 64 * kb, n0 = 32 * nb;
    int np0 = n0; if (mode != 0) np0 = 256 * (n0 / 128) + 64 * ((n0 % 128) / 32) + (mode == 2 ? 32 : 0);
    f32x4 wv[8];
#pragma unroll
    for (int i = 0; i < 8; ++i) wv[i] = __builtin_nontemporal_load((const f32x4*)(W + (size_t)(k0 + (lane >> 3) + 8 * i) * N + n0 + (lane & 7) * 4));
#pragma unroll
    for (int i = 0; i < 8; ++i) { const int kk = (lane >> 3) + 8 * i; const float gs = g ? (gcompl ? 1.f - g[k0 + kk] : g[k0 + kk]) : 1.f; float* d = scr + kk * 33 + (lane & 7) * 4; d[0] = wv[i].x * gs; d[1] = wv[i].y * gs; d[2] = wv[i].z * gs; d[3] = wv[i].w * gs; }
    __builtin_amdgcn_fence(__ATOMIC_RELEASE, "wavefront"); __builtin_amdgcn_wave_barrier(); __builtin_amdgcn_fence(__ATOMIC_ACQUIRE, "wavefront");
    const int c = lane & 7;
#pragma unroll
    for (int j = 0; j < 4; ++j) { const int n = (lane >> 3) + 8 * j; const float* sp = scr + (8 * c) * 33 + n;
        uint4 o; o.x = f2bf(sp[0]) | (f2bf(sp[33]) << 16); o.y = f2bf(sp[2 * 33]) | (f2bf(sp[3 * 33]) << 16); o.z = f2bf(sp[4 * 33]) | (f2bf(sp[5 * 33]) << 16); o.w = f2bf(sp[6 * 33]) | (f2bf(sp[7 * 33]) << 16);
        __builtin_nontemporal_store((pg8::u32x4){o.x, o.y, o.z, o.w}, (pg8::u32x4*)(Wt + (size_t)(np0 + n) * K + k0 + 8 * c)); }
    __builtin_amdgcn_fence(__ATOMIC_RELEASE, "wavefront"); __builtin_amdgcn_wave_barrier(); __builtin_amdgcn_fence(__ATOMIC_ACQUIRE, "wavefront");
}
constexpr size_t WS_LORA = 50 * MiB;
constexpr size_t LORA_LAYER = 256 * 1024, WS_V1T = WS_LORA + 2 * LORA_LAYER, WS_V1B = WS_V1T + 32 * 1024, WS_V2T = WS_V1B + 32 * 1024;
constexpr int PR_ACT_LD = 264, PR_VLO_LD = 40, PR_SG_LD = 520, PR_ACT_OFF = 0, PR_VLO_OFF = 64 * PR_ACT_LD * 2, PR_SG_OFF = PR_VLO_OFF + 64 * PR_VLO_LD * 2;
constexpr int PR_STG_OFF = PR_SG_OFF + 64 * PR_SG_LD * 2, PR_STG_WAVE = 16 * 144;
struct Prep2Args {
    const bf16_t* proj; const float* mu; const float* w0; const float* a0; const float* v0;
    const bf16_t *W2T, *A2T, *G2T, *V1T, *V1B, *V2T; bf16_t* vfirst; bf16_t *V, *A, *G; unsigned short* CS; int layer; int pad;
};
__device__ __forceinline__ f32x4 bfx4_lo(const bf16x8 v) { return (f32x4){bf2f((bf16_t)v[0]), bf2f((bf16_t)v[1]), bf2f((bf16_t)v[2]), bf2f((bf16_t)v[3])}; }
__device__ __forceinline__ f32x4 bfx4_hi(const bf16x8 v) { return (f32x4){bf2f((bf16_t)v[4]), bf2f((bf16_t)v[5]), bf2f((bf16_t)v[6]), bf2f((bf16_t)v[7])}; }
__device__ __forceinline__ bf16x8 pack8(const f32x4 a, const f32x4 b) { pg8::u32x4 w; w.x = pg8::cvt_pk_bf16(a[0], a[1]); w.y = pg8::cvt_pk_bf16(a[2], a[3]); w.z = pg8::cvt_pk_bf16(b[0], b[1]); w.w = pg8::cvt_pk_bf16(b[2], b[3]); return __builtin_bit_cast(bf16x8, w); }
template <int CTRL> __device__ __forceinline__ float dpp_mov(float x) { return __builtin_bit_cast(float, __builtin_amdgcn_update_dpp(0, __builtin_bit_cast(int, x), CTRL, 0xF, 0xF, true)); }
__device__ __forceinline__ float reduce16(float x) { x += dpp_mov<0xB1>(x); x += dpp_mov<0x4E>(x); x += dpp_mov<0x141>(x); x += dpp_mov<0x140>(x); return x; }
__device__ __forceinline__ float red8(float x) { x += dpp_mov<0xB1>(x); x += dpp_mov<0x4E>(x); x += dpp_mov<0x141>(x); return x; }
__device__ __forceinline__ float scan16(float x) { x += dpp_mov<0x111>(x); x += dpp_mov<0x112>(x); x += dpp_mov<0x114>(x); x += dpp_mov<0x118>(x); return x; }
constexpr float CS_SCALE = 1638.0f;
__device__ __forceinline__ void shift8(const bf16_t* __restrict__ proj, const float* __restrict__ mu, size_t m, int t, int col, int mi, f32x4& lo, f32x4& hi) {
    const bf16x8 cur = *(const bf16x8*)(proj + m * IN_W + col);
    bf16x8 prv; if (t > 0) prv = *(const bf16x8*)(proj + (m - 1) * IN_W + col); else prv = (bf16x8){0, 0, 0, 0, 0, 0, 0, 0};
    const f32x4 m0 = *(const f32x4*)(mu + mi), m1 = *(const f32x4*)(mu + mi + 4);
    const f32x4 c0 = bfx4_lo(cur), c1 = bfx4_hi(cur), p0 = bfx4_lo(prv), p1 = bfx4_hi(prv);
    lo = c0 + (p0 - c0) * m0; hi = c1 + (p1 - c1) * m1;
}
__device__ __forceinline__ void prep_tile(const Prep2Args& p, unsigned char* lds, int tile, int tid) {
    const int m0 = tile * 64, wave = __builtin_amdgcn_readfirstlane(tid >> 6), lane = tid & 63, fr = lane & 15, fq = lane >> 4;
    bf16_t* ACT = (bf16_t*)(lds + PR_ACT_OFF); bf16_t* VLO = (bf16_t*)(lds + PR_VLO_OFF); bf16_t* SG = (bf16_t*)(lds + PR_SG_OFF);
    { bf16x8 cu[4], pv[4]; f32x4 mu0[4], mu1[4];
#pragma unroll
      for (int it = 0; it < 4; ++it) { const int tk = 4 * (tid >> 5) + it, cc = tid & 31; const size_t m = (size_t)m0 + tk;
          cu[it] = __builtin_nontemporal_load((const bf16x8*)(p.proj + m * IN_W + 2304 + 8 * cc));
          mu0[it] = *(const f32x4*)(p.mu + 1536 + 8 * cc); mu1[it] = *(const f32x4*)(p.mu + 1536 + 8 * cc + 4); }
      { const size_t m = (size_t)m0 + 4 * (tid >> 5); const int cc = tid & 31; if ((int)(m % SEQ) > 0) pv[0] = *(const bf16x8*)(p.proj + (m - 1) * IN_W + 2304 + 8 * cc); else pv[0] = (bf16x8){0, 0, 0, 0, 0, 0, 0, 0};
        pv[1] = cu[0]; pv[2] = cu[1]; pv[3] = cu[2]; }
#pragma unroll
      for (int it = 0; it < 4; ++it) { const int tk = 4 * (tid >> 5) + it, cc = tid & 31;
          const f32x4 c0 = bfx4_lo(cu[it]), c1 = bfx4_hi(cu[it]); f32x4 lo = c0 + (bfx4_lo(pv[it]) - c0) * mu0[it], hi = c1 + (bfx4_hi(pv[it]) - c1) * mu1[it];
          if (cc < 8) {
#pragma unroll
              for (int e = 0; e < 4; ++e) { lo[e] = 2.f * sigmoidf_(2.f * lo[e]) - 1.f; hi[e] = 2.f * sigmoidf_(2.f * hi[e]) - 1.f; } }
          else if (cc >= 16) {
#pragma unroll
              for (int e = 0; e < 4; ++e) { lo[e] = sigmoidf_(lo[e]); hi[e] = sigmoidf_(hi[e]); } }
          *(bf16x8*)(ACT + tk * PR_ACT_LD + 8 * cc) = pack8(lo, hi); } }
    if (p.layer > 0) {
        unsigned char* VS = lds + PR_SG_OFF; float* PS = (float*)(lds + PR_STG_OFF);
        const bool seq0 = (m0 % SEQ) == 0;
#pragma unroll
        for (int it = 0; it < 9; ++it) { const int pidx = tid + 512 * it; if (pidx < 65 * 64) { const int r = pidx >> 6, g = pidx & 63;
                bf16x8 v = (bf16x8){0, 0, 0, 0, 0, 0, 0, 0}; if (r > 0 || !seq0) v = *(const bf16x8*)(p.proj + ((size_t)m0 - 1 + r) * IN_W + 1792 + g * 8);
                *(bf16x8*)(VS + r * 1024 + ((g ^ (r & 7)) << 4)) = v; } }
        const int jb = wave & 1, kq = wave >> 1;
        bf16x8 wa[4], wb[4];
#pragma unroll
        for (int ks = 0; ks < 4; ++ks) { const int ko = 128 * kq + 32 * ks + 8 * fq; wa[ks] = *(const bf16x8*)(p.V1T + (size_t)(16 * jb + fr) * C + ko); wb[ks] = *(const bf16x8*)(p.V1B + (size_t)(16 * jb + fr) * C + ko); }
        __syncthreads();
        f32x4 acc[4];
#pragma unroll
        for (int tb = 0; tb < 4; ++tb) { acc[tb] = (f32x4){0.f, 0.f, 0.f, 0.f};
#pragma unroll
            for (int ks = 0; ks < 4; ++ks) { const int g = 4 * (4 * kq + ks) + fq, rp = 16 * tb + fr, rc = rp + 1;
                const bf16x8 cu = *(const bf16x8*)(VS + rc * 1024 + ((g ^ (rc & 7)) << 4)), pv = *(const bf16x8*)(VS + rp * 1024 + ((g ^ (rp & 7)) << 4));
                acc[tb] = __builtin_amdgcn_mfma_f32_16x16x32_bf16(wa[ks], cu, acc[tb], 0, 0, 0); acc[tb] = __builtin_amdgcn_mfma_f32_16x16x32_bf16(wb[ks], pv, acc[tb], 0, 0, 0); } }
        if (kq > 0) {
#pragma unroll
            for (int tb = 0; tb < 4; ++tb) *(f32x4*)(PS + ((kq - 1) * 64 + 16 * tb + fr) * 32 + 16 * jb + 4 * fq) = acc[tb]; }
        __syncthreads();
        if (kq == 0) {
#pragma unroll
            for (int tb = 0; tb < 4; ++tb) { const float* pp = PS + (16 * tb + fr) * 32 + 16 * jb + 4 * fq;
                const f32x4 s = acc[tb] + *(const f32x4*)pp + *(const f32x4*)(pp + 64 * 32) + *(const f32x4*)(pp + 2 * 64 * 32);
                uint2 w; w.x = pg8::cvt_pk_bf16(s[0], s[1]); w.y = pg8::cvt_pk_bf16(s[2], s[3]);
                *(uint2*)(VLO + (16 * tb + fr) * PR_VLO_LD + 16 * jb + 4 * fq) = w; } }
    }
    __syncthreads();
    const int ch0 = 64 * wave;
    if (p.layer > 0) {
        bf16x8 af[4], wf[4]; f32x4 bias[4];
#pragma unroll
        for (int cb = 0; cb < 4; ++cb) { wf[cb] = *(const bf16x8*)(p.V2T + (size_t)(ch0 + 16 * cb + fr) * 32 + 8 * fq); bias[cb] = *(const f32x4*)(p.v0 + ch0 + 16 * cb + 4 * fq); }
#pragma unroll
        for (int tb = 0; tb < 4; ++tb) af[tb] = *(const bf16x8*)(VLO + (16 * tb + fr) * PR_VLO_LD + 8 * fq);
#pragma unroll
        for (int cb = 0; cb < 4; ++cb) { const int ch = ch0 + 16 * cb + 4 * fq;
#pragma unroll
            for (int tb = 0; tb < 4; ++tb) { f32x4 x = __builtin_amdgcn_mfma_f32_16x16x32_bf16(wf[cb], af[tb], (f32x4){0.f, 0.f, 0.f, 0.f}, 0, 0, 0) + bias[cb];
                uint2 w; w.x = pg8::cvt_pk_bf16(sigmoidf_(x[0]), sigmoidf_(x[1])); w.y = pg8::cvt_pk_bf16(sigmoidf_(x[2]), sigmoidf_(x[3]));
                *(uint2*)(SG + (16 * tb + fr) * PR_SG_LD + ch) = w; } }
    }
    {
        f32x4 bw[4], ba[4];
#pragma unroll
        for (int cb = 0; cb < 4; ++cb) { bw[cb] = *(const f32x4*)(p.w0 + ch0 + 16 * cb + 4 * fq); ba[cb] = *(const f32x4*)(p.a0 + ch0 + 16 * cb + 4 * fq); }
        bf16x8 wA[2][4], wB[2][4], wC[4][4];
#define PR_LOADW(wf, WT, KL) _Pragma("unroll") for (int ks = 0; ks < (KL) / 32; ++ks) { _Pragma("unroll") for (int cb = 0; cb < 4; ++cb) wf[ks][cb] = *(const bf16x8*)((WT) + (size_t)(ch0 + 16 * cb + fr) * (KL) + 32 * ks + 8 * fq); }
#define PR_MMA(wf, K0, KL) { _Pragma("unroll") for (int tb = 0; tb < 4; ++tb) { _Pragma("unroll") for (int cb = 0; cb < 4; ++cb) acc[tb][cb] = (f32x4){0.f, 0.f, 0.f, 0.f}; } \
            _Pragma("unroll") for (int ks = 0; ks < (KL) / 32; ++ks) { bf16x8 af[4]; \
                _Pragma("unroll") for (int tb = 0; tb < 4; ++tb) af[tb] = *(const bf16x8*)(ACT + (16 * tb + fr) * PR_ACT_LD + (K0) + 32 * ks + 8 * fq); \
                _Pragma("unroll") for (int tb = 0; tb < 4; ++tb) { _Pragma("unroll") for (int cb = 0; cb < 4; ++cb) acc[tb][cb] = __builtin_amdgcn_mfma_f32_16x16x32_bf16(wf[ks][cb], af[tb], acc[tb][cb], 0, 0, 0); } } }
        f32x4 acc[4][4];
        unsigned char* stg = lds + PR_STG_OFF + wave * PR_STG_WAVE; const int st_w = fr * 144 + 8 * fq, l8 = lane & 7, lr = lane >> 3;
#define PR_WFENCE() { __builtin_amdgcn_fence(__ATOMIC_RELEASE, "wavefront"); __builtin_amdgcn_wave_barrier(); __builtin_amdgcn_fence(__ATOMIC_ACQUIRE, "wavefront"); }
#define PR_FLUSH(OUTP, TB) { PR_WFENCE() _Pragma("unroll") for (int i_ = 0; i_ < 2; ++i_) { const int row_ = lr + 8 * i_; const pg8::u32x4 v_ = *(const pg8::u32x4*)(stg + row_ * 144 + l8 * 16); \
            *(pg8::u32x4*)((OUTP) + ((size_t)m0 + 16 * (TB) + row_) * C + ch0 + l8 * 8) = v_; } PR_WFENCE() }
        PR_LOADW(wA, p.W2T, 64)
        PR_MMA(wA, 0, 64)
        PR_LOADW(wB, p.A2T, 64)
        { f32x4 run[4];
#pragma unroll
          for (int cb = 0; cb < 4; ++cb) run[cb] = (f32x4){0.f, 0.f, 0.f, 0.f};
#pragma unroll
          for (int tb = 0; tb < 4; ++tb) {
#pragma unroll
            for (int cb = 0; cb < 4; ++cb) { f32x4 x = acc[tb][cb] + bw[cb];
#pragma unroll
                for (int e = 0; e < 4; ++e) x[e] = -0.60653065971f * sigmoidf_(x[e]);
                f32x4 s, tot; s.x = scan16(x.x); s.y = scan16(x.y); s.z = scan16(x.z); s.w = scan16(x.w);
                tot.x = reduce16(x.x); tot.y = reduce16(x.y); tot.z = reduce16(x.z); tot.w = reduce16(x.w);
                const f32x4 cq = (s + run[cb]) * -CS_SCALE + 0.5f;
                uint2 w; w.x = (unsigned)fminf(cq.x, 65535.f) | ((unsigned)fminf(cq.y, 65535.f) << 16); w.y = (unsigned)fminf(cq.z, 65535.f) | ((unsigned)fminf(cq.w, 65535.f) << 16);
                *(uint2*)(stg + st_w + 32 * cb) = w; run[cb] = run[cb] + tot; }
            PR_FLUSH(p.CS, tb) } }
        PR_MMA(wB, 64, 64)
        PR_LOADW(wC, p.G2T, 128)
#pragma unroll
        for (int tb = 0; tb < 4; ++tb) {
#pragma unroll
            for (int cb = 0; cb < 4; ++cb) { f32x4 x = acc[tb][cb] + ba[cb];
#pragma unroll
                for (int e = 0; e < 4; ++e) x[e] = sigmoidf_(x[e]);
                uint2 w; w.x = pg8::cvt_pk_bf16(x[0], x[1]); w.y = pg8::cvt_pk_bf16(x[2], x[3]);
                *(uint2*)(stg + st_w + 32 * cb) = w; }
            PR_FLUSH(p.A, tb) }
        PR_MMA(wC, 128, 128)
#pragma unroll
        for (int tb = 0; tb < 4; ++tb) {
#pragma unroll
            for (int cb = 0; cb < 4; ++cb) { const f32x4 x = acc[tb][cb];
                uint2 w; w.x = pg8::cvt_pk_bf16(x[0], x[1]); w.y = pg8::cvt_pk_bf16(x[2], x[3]);
                *(uint2*)(stg + st_w + 32 * cb) = w; }
            PR_FLUSH(p.G, tb) }
#undef PR_FLUSH
#undef PR_WFENCE
#undef PR_LOADW
#undef PR_MMA
    }
    __syncthreads();
    {
        const int cc = tid & 63;
        bf16x8 cu[8], pv[8], vf[8]; const f32x4 mu0 = *(const f32x4*)(p.mu + 1024 + 8 * cc), mu1 = *(const f32x4*)(p.mu + 1024 + 8 * cc + 4);
#pragma unroll
        for (int it = 0; it < 8; ++it) { const int tk = 8 * (tid >> 6) + it; const size_t m = (size_t)m0 + tk; const int col = 768 + 1024 + 8 * cc;
            cu[it] = __builtin_nontemporal_load((const bf16x8*)(p.proj + m * IN_W + col));
            if (p.layer > 0) vf[it] = __builtin_nontemporal_load((const bf16x8*)(p.vfirst + m * C + 8 * cc)); }
        { const size_t m = (size_t)m0 + 8 * (tid >> 6); if ((int)(m % SEQ) > 0) pv[0] = *(const bf16x8*)(p.proj + (m - 1) * IN_W + 768 + 1024 + 8 * cc); else pv[0] = (bf16x8){0, 0, 0, 0, 0, 0, 0, 0};
#pragma unroll
          for (int it = 1; it < 8; ++it) pv[it] = cu[it - 1]; }
#pragma unroll
        for (int it = 0; it < 8; ++it) { const int tk = 8 * (tid >> 6) + it; const size_t m = (size_t)m0 + tk;
            const f32x4 c0 = bfx4_lo(cu[it]), c1 = bfx4_hi(cu[it]);
            f32x4 lo = c0 + (bfx4_lo(pv[it]) - c0) * mu0, hi = c1 + (bfx4_hi(pv[it]) - c1) * mu1;
            const size_t o = m * C + 8 * cc;
            if (p.layer == 0) { }
            else { const bf16x8 sg = *(const bf16x8*)(SG + tk * PR_SG_LD + 8 * cc);
                lo = lo + (bfx4_lo(vf[it]) - lo) * bfx4_lo(sg); hi = hi + (bfx4_hi(vf[it]) - hi) * bfx4_hi(sg); }
            *(bf16x8*)(p.V + o) = pack8(lo, hi); }
    }
    __syncthreads();
}

constexpr int NTHREADS_ = 512;
constexpr int SC_TB = 32, SC_SLOT = 384, SC_NCH = SEQ / SC_TB;
constexpr size_t WS_RKC = 51 * MiB;
struct ScanArgs { const bf16_t *proj, *V, *A, *G; const unsigned short* CS; const float *k_k, *k_a, *r_k, *lnx_g, *lnx_b; bf16_t* mix; float* rkc; bf16_t* yt; };
constexpr int CK_LD = 72, CK_MAT = 64 * CK_LD * 2;
constexpr size_t WS_YT = WS_SI_LD;
constexpr size_t WS_TSCR = WS_SI_A, TSCR_WG = 2 * 64 * C * 2;
__device__ __forceinline__ void ck_mm(f32x4 (&acc)[2], const bf16_t* Qm, const bf16_t* P, int jb, int ib0, int fr, int fq) {
#pragma unroll
    for (int ks = 0; ks < 2; ++ks) { const bf16x8 bq = *(const bf16x8*)(Qm + (16 * jb + fr) * CK_LD + 32 * ks + 8 * fq);
#pragma unroll
        for (int ii = 0; ii < 2; ++ii) { const bf16x8 ap = *(const bf16x8*)(P + (16 * (ib0 + ii) + fr) * CK_LD + 32 * ks + 8 * fq); acc[ii] = __builtin_amdgcn_mfma_f32_16x16x32_bf16(ap, bq, acc[ii], 0, 0, 0); } }
}
typedef short ck_s16x4 __attribute__((ext_vector_type(4)));
__device__ __forceinline__ bf16x8 ck_tr_frag(const bf16_t* X, int colbase, int ks, int lane) {
    const bf16_t* a0 = X + (32 * ks + 8 * (lane >> 4) + ((lane & 15) >> 2)) * CK_LD + colbase + 4 * (lane & 3);
    const ck_s16x4 lo = __builtin_amdgcn_ds_read_tr16_b64_v4i16((__attribute__((address_space(3))) ck_s16x4*)a0), hi = __builtin_amdgcn_ds_read_tr16_b64_v4i16((__attribute__((address_space(3))) ck_s16x4*)(a0 + 4 * CK_LD));
    return (bf16x8){lo[0], lo[1], lo[2], lo[3], hi[0], hi[1], hi[2], hi[3]};
}
template <bool TQ, bool TP> __device__ __forceinline__ void ck_mm_t(f32x4 (&acc)[2], const bf16_t* Qm, const bf16_t* P, int jb, int ib0, int fr, int fq) {
    const int lane = fq * 16 + fr;
#pragma unroll
    for (int ks = 0; ks < 2; ++ks) { const bf16x8 bq = TQ ? ck_tr_frag(Qm, 16 * jb, ks, lane) : *(const bf16x8*)(Qm + (16 * jb + fr) * CK_LD + 32 * ks + 8 * fq);
#pragma unroll
        for (int ii = 0; ii < 2; ++ii) { const bf16x8 ap = TP ? ck_tr_frag(P, 16 * (ib0 + ii), ks, lane) : *(const bf16x8*)(P + (16 * (ib0 + ii) + fr) * CK_LD + 32 * ks + 8 * fq); acc[ii] = __builtin_amdgcn_mfma_f32_16x16x32_bf16(ap, bq, acc[ii], 0, 0, 0); } }
}
__device__ __forceinline__ uint2 ck_pack4(const f32x4 v) { uint2 w; w.x = pg8::cvt_pk_bf16(v[0], v[1]); w.y = pg8::cvt_pk_bf16(v[2], v[3]); return w; }
__device__ __forceinline__ f32x4 ck_unpack4(const uint2 u) { return (f32x4){__builtin_bit_cast(float, u.x << 16), __builtin_bit_cast(float, u.x & 0xffff0000u), __builtin_bit_cast(float, u.y << 16), __builtin_bit_cast(float, u.y & 0xffff0000u)}; }
struct CkRaw { bf16x8 rc, rp, kc, kp, v, a, cs, cp, cl; };
__device__ __forceinline__ float wave_sum_dpp(float x) {
    x = reduce16(x); const int xi = __builtin_bit_cast(int, x);
    const float r0 = __builtin_bit_cast(float, __builtin_amdgcn_readlane(xi, 0)), r1 = __builtin_bit_cast(float, __builtin_amdgcn_readlane(xi, 16)), r2 = __builtin_bit_cast(float, __builtin_amdgcn_readlane(xi, 32)), r3 = __builtin_bit_cast(float, __builtin_amdgcn_readlane(xi, 48));
    return (r0 + r1) + (r2 + r3); }
template <bool RK = true, bool REST = true>
__device__ __forceinline__ void ck_load(const ScanArgs& p, CkRaw& w, int unit, int tid) {
    const int chain = unit >> 6, chunk = unit & 63, b = chain >> 3, h = chain & 7, tk = tid >> 3, hc = h * 64 + (tid & 7) * 8;
    const size_t row = (size_t)b * SEQ + chunk * 64 + tk, o = row * C + hc;
    const bf16_t* pr = p.proj + row * IN_W + 768 + hc; const bf16x8 z8 = (bf16x8){0, 0, 0, 0, 0, 0, 0, 0};
    if constexpr (RK) {
    w.rc = __builtin_nontemporal_load((const bf16x8*)pr); w.kc = __builtin_nontemporal_load((const bf16x8*)(pr + 512));
    { const int t8 = tk & 7; const bool has = (chunk * 64 + tk - t8) > 0; const bf16_t* pp = pr - (size_t)(t8 + (has ? 1 : 0)) * IN_W;
      const bf16x8 a_ = *(const bf16x8*)pp, b_ = *(const bf16x8*)(pp + 512); w.rp = has ? a_ : z8; w.kp = has ? b_ : z8; }
    }
    if constexpr (REST) {
    w.v = *(const bf16x8*)(p.V + o); w.a = __builtin_nontemporal_load((const bf16x8*)(p.A + o));
    w.cs = __builtin_nontemporal_load((const bf16x8*)(p.CS + o)); { const int t8 = tk & 7; const bool has = (tk - t8) > 0; const bf16x8 c_ = *(const bf16x8*)(p.CS + o - (size_t)(t8 + (has ? 1 : 0)) * C); w.cp = has ? c_ : z8; }
    w.cl = *(const bf16x8*)(p.CS + (row - tk + 63) * C + hc);
    }
}
__device__ __forceinline__ f32x4 csq_lo(const bf16x8 v) { return (f32x4){(float)(unsigned short)v[0], (float)(unsigned short)v[1], (float)(unsigned short)v[2], (float)(unsigned short)v[3]} * (-1.4426950408889634f / CS_SCALE); }
__device__ __forceinline__ f32x4 csq_hi(const bf16x8 v) { return (f32x4){(float)(unsigned short)v[4], (float)(unsigned short)v[5], (float)(unsigned short)v[6], (float)(unsigned short)v[7]} * (-1.4426950408889634f / CS_SCALE); }
__device__ __forceinline__ f32x4 exp4(const f32x4 v) { return (f32x4){__builtin_amdgcn_exp2f(v[0]), __builtin_amdgcn_exp2f(v[1]), __builtin_amdgcn_exp2f(v[2]), __builtin_amdgcn_exp2f(v[3])}; }
constexpr int CK_CONST_OFF = 136192;
__device__ __forceinline__ void ck_precompute(const ScanArgs& p, const CkRaw& raw, CkRaw& nxt, int next_unit, unsigned char* lds, bf16_t* GQ, bf16_t* CQ, int unit, int tid) {
    const int chain = unit >> 6, chunk = unit & 63, b = chain >> 3, h = chain & 7, wave = __builtin_amdgcn_readfirstlane(tid >> 6), lane = tid & 63, fr = lane & 15, fq = lane >> 4, jb = wave >> 1, ib0 = 2 * (wave & 1);
    bf16_t* At = (bf16_t*)(lds + 0 * CK_MAT); bf16_t* bt = (bf16_t*)(lds + 1 * CK_MAT); bf16_t* kt = (bf16_t*)(lds + 2 * CK_MAT); bf16_t* rt = (bf16_t*)(lds + 3 * CK_MAT);
    bf16_t* AtT = (bf16_t*)(lds + 4 * CK_MAT); bf16_t* BhT = (bf16_t*)(lds + 5 * CK_MAT); bf16_t* KhT = (bf16_t*)(lds + 6 * CK_MAT); bf16_t* VT = (bf16_t*)(lds + 7 * CK_MAT);
    bf16_t* NT = (bf16_t*)(lds + 8 * CK_MAT); bf16_t* Mm = (bf16_t*)(lds + 9 * CK_MAT); bf16_t* P1 = (bf16_t*)(lds + 10 * CK_MAT); bf16_t* P2 = (bf16_t*)(lds + 11 * CK_MAT);
    bf16_t* Ta = (bf16_t*)(lds + 12 * CK_MAT); bf16_t* Tb = (bf16_t*)(lds + 13 * CK_MAT); float* WT = (float*)(lds + 14 * CK_MAT); float* GL = WT + 512;
    bf16_t* W1T = bt; bf16_t* MVT = kt; bf16_t* W2T = Ta;
    {
        const int tk = tid >> 3, c8 = (tid & 7) * 8, ro = tk * CK_LD + c8;
        bf16_t* BhR = BhT; bf16_t* KhR = KhT; bf16_t* VR = VT;
        const float* KC = (const float*)(lds + CK_CONST_OFF) + h * 64 + c8;
        const f32x4 kc0 = *(const f32x4*)KC, kc1 = *(const f32x4*)(KC + 4), ac0 = *(const f32x4*)(KC + 512), ac1 = *(const f32x4*)(KC + 516), rc0 = *(const f32x4*)(KC + 1024), rc1 = *(const f32x4*)(KC + 1028), mu0 = *(const f32x4*)(KC + 1536), mu1 = *(const f32x4*)(KC + 1540);
        const f32x4 mk0 = *(const f32x4*)(KC + 2048), mk1 = *(const f32x4*)(KC + 2052);
        bf16x8 prv_r, prv_k, prv_c;
        { const bool first = (lane >> 3) == 0; pg8::u32x4 a_ = __builtin_bit_cast(pg8::u32x4, raw.rc), b_ = __builtin_bit_cast(pg8::u32x4, raw.kc), c_ = __builtin_bit_cast(pg8::u32x4, raw.cs);
          a_.x = __shfl_up((int)a_.x, 8); a_.y = __shfl_up((int)a_.y, 8); a_.z = __shfl_up((int)a_.z, 8); a_.w = __shfl_up((int)a_.w, 8);
          b_.x = __shfl_up((int)b_.x, 8); b_.y = __shfl_up((int)b_.y, 8); b_.z = __shfl_up((int)b_.z, 8); b_.w = __shfl_up((int)b_.w, 8);
          c_.x = __shfl_up((int)c_.x, 8); c_.y = __shfl_up((int)c_.y, 8); c_.z = __shfl_up((int)c_.z, 8); c_.w = __shfl_up((int)c_.w, 8);
          prv_r = first ? raw.rp : __builtin_bit_cast(bf16x8, a_); prv_k = first ? raw.kp : __builtin_bit_cast(bf16x8, b_); prv_c = first ? raw.cp : __builtin_bit_cast(bf16x8, c_); }
        const f32x4 x0 = bfx4_lo(raw.rc), x1 = bfx4_hi(raw.rc); const f32x4 r0 = x0 + (bfx4_lo(prv_r) - x0) * mu0, r1 = x1 + (bfx4_hi(prv_r) - x1) * mu1;
        const f32x4 y0 = bfx4_lo(raw.kc), y1 = bfx4_hi(raw.kc); const f32x4 k0 = y0 + (bfx4_lo(prv_k) - y0) * mk0, k1 = y1 + (bfx4_hi(prv_k) - y1) * mk1;
        const f32x4 a0 = bfx4_lo(raw.a), a1 = bfx4_hi(raw.a);
        const f32x4 c0 = csq_lo(raw.cs), c1 = csq_hi(raw.cs), p0 = csq_lo(prv_c), p1 = csq_hi(prv_c), l0 = csq_lo(raw.cl), l1 = csq_hi(raw.cl);
        f32x4 q0 = k0 * kc0, q1 = k1 * kc1;
        const f32x4 qq = q0 * q0 + q1 * q1; const float nrm = red8((qq.x + qq.y) + (qq.z + qq.w));
        const float inv = fminf(__builtin_amdgcn_rsqf(nrm), 1e12f); q0 = q0 * inv; q1 = q1 * inv;
        const f32x4 kp0 = k0 * (1.f + (a0 - 1.f) * ac0), kp1 = k1 * (1.f + (a1 - 1.f) * ac1);
        const f32x4 rr = r0 * kp0 * rc0 + r1 * kp1 * rc1; const float rkc = red8((rr.x + rr.y) + (rr.z + rr.w));
        const f32x4 em0 = exp4(p0), em1 = exp4(p1), en0 = exp4(-c0), en1 = exp4(-c1), ep0 = exp4(c0), ep1 = exp4(c1), eL0 = exp4(l0 - c0), eL1 = exp4(l1 - c1);
        const f32x4 b0 = q0 * a0, b1 = q1 * a1;
        *(bf16x8*)(At + ro) = pack8(-q0 * em0, -q1 * em1); *(bf16x8*)(bt + ro) = pack8(b0 * en0, b1 * en1); *(bf16x8*)(kt + ro) = pack8(kp0 * en0, kp1 * en1); *(bf16x8*)(rt + ro) = pack8(r0 * ep0, r1 * ep1);
        *(bf16x8*)(BhR + ro) = pack8(b0 * eL0, b1 * eL1); *(bf16x8*)(KhR + ro) = pack8(kp0 * eL0, kp1 * eL1); *(bf16x8*)(VR + ro) = raw.v;
        if (tk == 0) { *(f32x4*)(GL + c8) = exp4(l0); *(f32x4*)(GL + c8 + 4) = exp4(l1); }
        if ((tid & 7) == 0) p.rkc[((size_t)b * SEQ + chunk * 64 + tk) * 8 + h] = rkc;
    }
    __syncthreads();
    const int j = 16 * jb + fr; const f32x4 z4 = (f32x4){0.f, 0.f, 0.f, 0.f};
    { f32x4 aN[2] = {z4, z4}, aM[2] = {z4, z4}, aP1[2] = {z4, z4}, aP2[2] = {z4, z4};
      ck_mm(aN, At, bt, jb, ib0, fr, fq); ck_mm(aM, At, kt, jb, ib0, fr, fq); ck_mm(aP1, rt, bt, jb, ib0, fr, fq); ck_mm(aP2, rt, kt, jb, ib0, fr, fq);
#pragma unroll
      for (int ii = 0; ii < 2; ++ii) { const int i0 = 16 * (ib0 + ii) + 4 * fq; f32x4 nt, mm, p1, p2;
#pragma unroll
          for (int e = 0; e < 4; ++e) { const int i = i0 + e; nt[e] = i < j ? aN[ii][e] : 0.f; mm[e] = i < j ? aM[ii][e] : 0.f; p1[e] = i <= j ? aP1[ii][e] : 0.f; p2[e] = i <= j ? aP2[ii][e] : 0.f; }
          *(uint2*)(NT + j * CK_LD + i0) = ck_pack4(nt); *(uint2*)(Mm + j * CK_LD + i0) = ck_pack4(mm); *(uint2*)(P1 + j * CK_LD + i0) = ck_pack4(p1); *(uint2*)(P2 + j * CK_LD + i0) = ck_pack4(p2); } }
    __syncthreads();
    { f32x4 a2[2] = {z4, z4}, a3[2] = {z4, z4}; ck_mm_t<false, true>(a2, NT, NT, jb, ib0, fr, fq); ck_mm_t<true, false>(a3, VT, Mm, jb, ib0, fr, fq);
#pragma unroll
      for (int ii = 0; ii < 2; ++ii) { const int i0 = 16 * (ib0 + ii) + 4 * fq; const f32x4 sv = a2[ii] + ck_unpack4(*(const uint2*)(NT + j * CK_LD + i0));
          *(uint2*)(Ta + j * CK_LD + i0) = ck_pack4(a2[ii]); *(uint2*)(AtT + j * CK_LD + i0) = ck_pack4(sv); *(uint2*)(MVT + j * CK_LD + i0) = ck_pack4(a3[ii]); } }
    __syncthreads();
    { f32x4 a2[2] = {z4, z4}; ck_mm_t<false, true>(a2, AtT, Ta, jb, ib0, fr, fq);
#pragma unroll
      for (int ii = 0; ii < 2; ++ii) { const int i0 = 16 * (ib0 + ii) + 4 * fq; f32x4 t = a2[ii] + ck_unpack4(*(const uint2*)(AtT + j * CK_LD + i0));
#pragma unroll
          for (int e = 0; e < 4; ++e) t[e] += (i0 + e == j) ? 1.f : 0.f;
          *(uint2*)(Tb + j * CK_LD + i0) = ck_pack4(t); } }
    __syncthreads();
    { f32x4 a1[2] = {z4, z4}, a2[2] = {z4, z4}; ck_mm_t<true, false>(a1, At, Tb, jb, ib0, fr, fq); ck_mm(a2, MVT, Tb, jb, ib0, fr, fq);
#pragma unroll
      for (int ii = 0; ii < 2; ++ii) { const int i0 = 16 * (ib0 + ii) + 4 * fq; *(uint2*)(W1T + j * CK_LD + i0) = ck_pack4(a1[ii]); *(uint2*)(W2T + j * CK_LD + i0) = ck_pack4(a2[ii]); } }
    __syncthreads();
    ck_load(p, nxt, next_unit, tid);
    { f32x4 aQ1[2] = {z4, z4}, aG[2] = {z4, z4}, aQ2[2] = {z4, z4}, aC[2] = {z4, z4};
      ck_mm(aQ1, P1, W1T, jb, ib0, fr, fq); ck_mm_t<true, false>(aG, BhT, W1T, jb, ib0, fr, fq); ck_mm(aQ2, P1, W2T, jb, ib0, fr, fq); ck_mm_t<false, true>(aQ2, P2, VT, jb, ib0, fr, fq); ck_mm_t<false, true>(aC, W2T, BhT, jb, ib0, fr, fq); ck_mm_t<true, true>(aC, VT, KhT, jb, ib0, fr, fq);
      bf16_t* gq = GQ + (size_t)unit * 8192; bf16_t* cq = CQ + (size_t)unit * 8192; const float glj = GL[j];
#pragma unroll
      for (int ii = 0; ii < 2; ++ii) { const int i0 = 16 * (ib0 + ii) + 4 * fq; f32x4 g = aG[ii];
#pragma unroll
          for (int e = 0; e < 4; ++e) g[e] += (i0 + e == j) ? glj : 0.f;
          const f32x4 q1 = aQ1[ii] + ck_unpack4(*(const uint2*)(rt + j * CK_LD + i0));
          *(uint2*)(AtT + j * CK_LD + i0) = ck_pack4(g); *(uint2*)(NT + j * CK_LD + i0) = ck_pack4(q1); *(uint2*)(Mm + j * CK_LD + i0) = ck_pack4(aC[ii]); *(uint2*)(Tb + j * CK_LD + i0) = ck_pack4(aQ2[ii]); }
      __syncthreads();
      { const int row = tid >> 3, c8 = (tid & 7) * 8, lo_ = row * CK_LD + c8, go_ = row * 64 + c8;
        const pg8::u32x4 v0 = *(const pg8::u32x4*)(AtT + lo_), v1 = *(const pg8::u32x4*)(NT + lo_), v2 = *(const pg8::u32x4*)(Mm + lo_), v3 = *(const pg8::u32x4*)(Tb + lo_);
        __builtin_nontemporal_store(v0, (pg8::u32x4*)(gq + go_)); __builtin_nontemporal_store(v1, (pg8::u32x4*)(gq + 4096 + go_));     { const int bo_ = (c8 >> 4) * 1024 + row * 16 + (c8 & 15);
          __builtin_nontemporal_store(v2, (pg8::u32x4*)(cq + bo_)); __builtin_nontemporal_store(v3, (pg8::u32x4*)(cq + 4096 + bo_)); } } }
    if (next_unit == unit) __syncthreads();
}
__device__ __forceinline__ void ck_sequential(const ScanArgs& p, unsigned char* lds, const bf16_t* GQ, const bf16_t* CQ, int item, int tid) {
    const int chain = item >> 2, q = item & 3, b = chain >> 3, h = chain & 7, wave = __builtin_amdgcn_readfirstlane(tid >> 6), lane = tid & 63, fr = lane & 15, fq = lane >> 4;
    bf16_t* OPS = (bf16_t*)lds;
    bf16_t* HT = (bf16_t*)(lds + 4 * CK_MAT);
    for (int i = tid; i < 2 * 16 * CK_LD / 2; i += NTHREADS_) ((unsigned*)HT)[i] = 0u;
    const size_t ubase = (size_t)chain * 64; const size_t rowbase = (size_t)b * SEQ;
    const int prow0 = tid >> 3, pcol = (tid & 7) * 8;
    const int aoff = wave < 4 ? (4096 + q * 1024 + (16 * wave + fr) * 16 + 4 * fq) : ((wave - 4) * 1024 + (16 * q + fr) * 16 + 4 * fq);
    typedef unsigned u32x2_ __attribute__((ext_vector_type(2)));
    pg8::u32x4 g0_0, g0_1, g0_2, g0_3, g0_4, g0_5, g0_6, g0_7, g1_0, g1_1, g1_2, g1_3, g1_4, g1_5, g1_6, g1_7; u32x2_ ad_0, ad_1, ad_2, ad_3, ad_4, ad_5, ad_6, ad_7;
#define CK_FETCH(slot, cc) do { const int c_ = (cc) < 64 ? (cc) : 63;     \
        const bf16_t* gq = GQ + (ubase + c_) * 8192; g0_##slot = *(const pg8::u32x4*)(gq + (size_t)prow0 * 64 + pcol); g1_##slot = *(const pg8::u32x4*)(gq + (size_t)(prow0 + 64) * 64 + pcol); \
        ad_##slot = __builtin_nontemporal_load((const u32x2_*)(CQ + (ubase + c_) * 8192 + aoff)); } while (0)
#define CK_STAGE(slot, buf) do { *(pg8::u32x4*)(OPS + (buf) * 2 * 64 * CK_LD + prow0 * CK_LD + pcol) = g0_##slot; *(pg8::u32x4*)(OPS + (buf) * 2 * 64 * CK_LD + 64 * CK_LD + prow0 * CK_LD + pcol) = g1_##slot; } while (0)
    CK_FETCH(0, 0); CK_FETCH(1, 1); CK_FETCH(2, 2); CK_FETCH(3, 3); CK_FETCH(4, 4); CK_FETCH(5, 5); CK_FETCH(6, 6); CK_FETCH(7, 7);
    CK_STAGE(0, 0);
    __syncthreads();
#define CK_STEP(cc, slot, nslot) do { const int bi = (cc) & 1; const bf16_t* Gm = OPS + bi * 2 * 64 * CK_LD; const bf16_t* Q1m = Gm + 64 * CK_LD; const bf16_t* HTc = HT + bi * 16 * CK_LD; bf16_t* HTn = HT + (bi ^ 1) * 16 * CK_LD; \
        f32x4 acc = (f32x4){0.f, 0.f, 0.f, 0.f}; \
        if (wave < 4) { _Pragma("unroll") for (int ks = 0; ks < 2; ++ks) acc = __builtin_amdgcn_mfma_f32_16x16x32_bf16(*(const bf16x8*)(HTc + fr * CK_LD + 32 * ks + 8 * fq), *(const bf16x8*)(Q1m + (16 * wave + fr) * CK_LD + 32 * ks + 8 * fq), acc, 0, 0, 0); \
            acc = acc + ck_unpack4((uint2){ad_##slot.x, ad_##slot.y}); \
            *(uint2*)(p.yt + ((((size_t)chain * 64 + (cc)) * 4 + q) * 64 + 16 * wave + fr) * 16 + 4 * fq) = ck_pack4(acc); } \
        else { _Pragma("unroll") for (int ks = 0; ks < 2; ++ks) acc = __builtin_amdgcn_mfma_f32_16x16x32_bf16(*(const bf16x8*)(Gm + (16 * (wave - 4) + fr) * CK_LD + 32 * ks + 8 * fq), *(const bf16x8*)(HTc + fr * CK_LD + 32 * ks + 8 * fq), acc, 0, 0, 0); \
            acc = acc + ck_unpack4((uint2){ad_##slot.x, ad_##slot.y}); \
            *(uint2*)(HTn + fr * CK_LD + 16 * (wave - 4) + 4 * fq) = ck_pack4(acc); } \
        CK_STAGE(nslot, bi ^ 1); \
        CK_FETCH(slot, (cc) + 8); \
        __syncthreads(); } while (0)
    for (int c = 0; c < 64; c += 8) { CK_STEP(c, 0, 1); CK_STEP(c + 1, 1, 2); CK_STEP(c + 2, 2, 3); CK_STEP(c + 3, 3, 4); CK_STEP(c + 4, 4, 5); CK_STEP(c + 5, 5, 6); CK_STEP(c + 6, 6, 7); CK_STEP(c + 7, 7, 0); }
#undef CK_FETCH
#undef CK_STAGE
#undef CK_STEP
}

struct PostRaw { bf16x8 y, v, g; float rk; };
__device__ __forceinline__ void scan_post_load(const ScanArgs& p, PostRaw& w, int item, int lane) {
    const int tg = item & 7, chunk = (item >> 3) & 63, chain = item >> 9, b = chain >> 3, h = chain & 7, tl = lane >> 3, j = lane & 7, t = 8 * tg + tl;
    const size_t m = (size_t)b * SEQ + chunk * 64 + t;
    w.y = __builtin_nontemporal_load((const bf16x8*)(p.yt + ((((size_t)chain * 64 + chunk) * 4 + (j >> 1)) * 64 + t) * 16 + (j & 1) * 8));
    w.v = __builtin_nontemporal_load((const bf16x8*)(p.V + m * C + h * 64 + 8 * j)); w.g = __builtin_nontemporal_load((const bf16x8*)(p.G + m * C + h * 64 + 8 * j)); w.rk = p.rkc[m * 8 + h];
}
__device__ __forceinline__ void scan_post_item(const ScanArgs& p, const PostRaw& w, int item, int lane, const float* LGB) {
    const int tg = item & 7, chunk = (item >> 3) & 63, chain = item >> 9, b = chain >> 3, h = chain & 7, tl = lane >> 3, j = lane & 7;
    const size_t m = (size_t)b * SEQ + chunk * 64 + 8 * tg + tl;
    f32x4 y0 = bfx4_lo(w.y), y1 = bfx4_hi(w.y);
    const float mean = red8((y0.x + y0.y) + (y0.z + y0.w) + (y1.x + y1.y) + (y1.z + y1.w)) * (1.f / 64.f);
    y0 = y0 - mean; y1 = y1 - mean;
    const float var = red8((y0.x * y0.x + y0.y * y0.y) + (y0.z * y0.z + y0.w * y0.w) + (y1.x * y1.x + y1.y * y1.y) + (y1.z * y1.z + y1.w * y1.w)) * (1.f / 64.f);
    const float rs = rsqrtf(var + LNX_EPS);
    const float* lp = LGB + h * 64 + 8 * j; const f32x4 lg0 = *(const f32x4*)lp, lg1 = *(const f32x4*)(lp + 4), lb0 = *(const f32x4*)(lp + 512), lb1 = *(const f32x4*)(lp + 516);
    const f32x4 o0 = (y0 * rs * lg0 + lb0 + bfx4_lo(w.v) * w.rk) * bfx4_lo(w.g), o1 = (y1 * rs * lg1 + lb1 + bfx4_hi(w.v) * w.rk) * bfx4_hi(w.g);
    *(bf16x8*)(p.mix + m * D + ATT_W + h * 64 + 8 * j) = pack8(o0, o1);
}
__device__ __forceinline__ void scan_post_wave(const ScanArgs& p, int gw, int ngw, int lane, const float* LGB) {
    constexpr int NITEM = BATCH * NH * 64 * 8;
    int item = gw; if (item >= NITEM) return;
    PostRaw cur; scan_post_load(p, cur, item, lane);
    for (; item < NITEM; item += ngw) { PostRaw nxt; scan_post_load(p, nxt, item + ngw < NITEM ? item + ngw : item, lane);
        scan_post_item(p, cur, item, lane, LGB); cur = nxt; }
}

typedef float f32x16 __attribute__((ext_vector_type(16)));
typedef short s16x4 __attribute__((ext_vector_type(4)));
constexpr int AT_VLD = 96;
__device__ __forceinline__ int crow(int r, int hi) { return (r & 3) + 8 * (r >> 2) + 4 * hi; }
constexpr int AT_KLD = 72;
__device__ __forceinline__ void attn_phase(const bf16_t* __restrict__ proj, const float* __restrict__ sinks, bf16_t* __restrict__ mix, unsigned char* lds, int G, int tid) {
    bf16_t* ks_ = (bf16_t*)lds; bf16_t* vs_ = (bf16_t*)(lds + 192 * AT_KLD * 2);
    const int g = __builtin_amdgcn_readfirstlane(tid >> 7), half = __builtin_amdgcn_readfirstlane((tid >> 6) & 1);
    constexpr int NU = BATCH * 2 * (SEQ / 64);
    bf16x8 pk0, pk1, pk2, pv0, pv1, pv2, pq0, pq1, pq2, pq3;
#define AT_PIECE(it, kdst, vdst, un) do { const int i_ = tq + 512 * (it), kl_ = i_ >> 3, ch8_ = i_ & 7; int key_ = ((un) & 63) * 64 - 128 + kl_; key_ = key_ < 0 ? 0 : key_;     \
        const bf16_t* rp_ = proj + ((size_t)((un) >> 7) * SEQ + key_) * IN_W + 512 + (((un) >> 6) & 1) * 64 + ch8_ * 8; kdst = *(const bf16x8*)rp_; vdst = *(const bf16x8*)(rp_ + KV_W); } while (0)
#define AT_FETCH(un) do { AT_PIECE(0, pk0, pv0, un); AT_PIECE(1, pk1, pv1, un); AT_PIECE(2, pk2, pv2, un); \
        { const int l_ = tq & 63; const bf16_t* qp_ = proj + ((size_t)((un) >> 7) * SEQ + ((un) & 63) * 64 + 32 * half + (l_ & 31)) * IN_W + ((((un) >> 6) & 1) * 4 + g) * 64 + 8 * (l_ >> 5); \
          pq0 = __builtin_nontemporal_load((const bf16x8*)qp_); pq1 = __builtin_nontemporal_load((const bf16x8*)(qp_ + 16)); pq2 = __builtin_nontemporal_load((const bf16x8*)(qp_ + 32)); pq3 = __builtin_nontemporal_load((const bf16x8*)(qp_ + 48)); } } while (0)
#define AT_STAGE(it, ksrc, vsrc) do { const int i_ = tq + 512 * (it), kl_ = i_ >> 3, ch8_ = i_ & 7; *(bf16x8*)(ks_ + kl_ * AT_KLD + ch8_ * 8) = ksrc; *(bf16x8*)(vs_ + kl_ * AT_VLD + ch8_ * 8) = vsrc; } while (0)
    int tq = tid; int unit = blockIdx.x; if (unit < NU) AT_FETCH(unit);
    for (; unit < NU; unit += G) {
        const int b = unit >> 7, kvh = (unit >> 6) & 1, qb = unit & 63, Q0 = qb * 64, h = kvh * 4 + g; const size_t rowb = (size_t)b * SEQ;
        asm volatile("" : "+v"(tq));
        const int lane = tq & 63, c = lane & 31, hi = lane >> 5;
        AT_STAGE(0, pk0, pv0); AT_STAGE(1, pk1, pv1); AT_STAGE(2, pk2, pv2);
        const bf16x8 qf[4] = {pq0, pq1, pq2, pq3};
        __syncthreads();
        if (unit + G < NU) AT_FETCH(unit + G);
        const int t0 = Q0 + 32 * half; const size_t mq = rowb + t0 + c;
        f32x16 p[5];
#pragma unroll
        for (int kb = 0; kb < 5; ++kb) { const bf16_t* kp = ks_ + (32 * half + 32 * kb + c) * AT_KLD + 8 * hi;
            f32x16 acc;
#pragma unroll
            for (int r = 0; r < 16; ++r) acc[r] = 0.f;
#pragma unroll
            for (int ks = 0; ks < 4; ++ks) acc = __builtin_amdgcn_mfma_f32_32x32x16_bf16(*(const bf16x8*)(kp + 16 * ks), qf[ks], acc, 0, 0, 0);
            p[kb] = acc; }
        const float slope = exp2f(-(float)(h + 1)) * 1.44269504089f, sink = sinks[h] * 1.44269504089f;
        float mx = sink;
        const float bl = -slope * (float)(c + 128 - 4 * hi);
        const bool seq_start = (t0 < 128);
#pragma unroll
        for (int kb = 0; kb < 5; ++kb)
#pragma unroll
            for (int r = 0; r < 16; ++r) { const int cr0 = (r & 3) + 8 * (r >> 2), cr = cr0 + 4 * hi;
                float sc = p[kb][r] * (0.125f * 1.44269504089f) + (bl + slope * (float)(32 * kb + cr0));
                if (kb == 0) sc = (cr > c) ? sc : -1e30f;
                if (kb == 4) sc = (cr <= c) ? sc : -1e30f;
                if (seq_start) sc = (t0 - 128 + 32 * kb + cr >= 0) ? sc : -1e30f;
                p[kb][r] = sc; mx = fmaxf(mx, sc); }
        mx = fmaxf(mx, __shfl_xor(mx, 32));
        float l = 0.f;
#pragma unroll
        for (int kb = 0; kb < 5; ++kb)
#pragma unroll
            for (int r = 0; r < 16; ++r) { const float e = __builtin_amdgcn_exp2f(p[kb][r] - mx); p[kb][r] = e; l += e; }
        l += __shfl_xor(l, 32); l += __builtin_amdgcn_exp2f(sink - mx);
        f32x16 o[2];
#pragma unroll
        for (int d = 0; d < 2; ++d)
#pragma unroll
            for (int r = 0; r < 16; ++r) o[d][r] = 0.f;
#pragma unroll
        for (int kb = 0; kb < 5; ++kb)
#pragma unroll
            for (int s2 = 0; s2 < 2; ++s2) {
                pg8::u32x4 pw; pw.x = pg8::cvt_pk_bf16(p[kb][8 * s2 + 0], p[kb][8 * s2 + 1]); pw.y = pg8::cvt_pk_bf16(p[kb][8 * s2 + 2], p[kb][8 * s2 + 3]);
                pw.z = pg8::cvt_pk_bf16(p[kb][8 * s2 + 4], p[kb][8 * s2 + 5]); pw.w = pg8::cvt_pk_bf16(p[kb][8 * s2 + 6], p[kb][8 * s2 + 7]);
                const bf16x8 pf = __builtin_bit_cast(bf16x8, pw);
#pragma unroll
                for (int d = 0; d < 2; ++d) {
                    const bf16_t* vp = vs_ + (32 * half + 32 * kb + 16 * s2 + 4 * hi + ((lane & 15) >> 2)) * AT_VLD + 32 * d + 16 * ((lane >> 4) & 1) + 4 * (lane & 3);
                    const s16x4 lo = __builtin_amdgcn_ds_read_tr16_b64_v4i16((__attribute__((address_space(3))) s16x4*)vp), hh = __builtin_amdgcn_ds_read_tr16_b64_v4i16((__attribute__((address_space(3))) s16x4*)(vp + 8 * AT_VLD));
                    const bf16x8 vf = (bf16x8){lo[0], lo[1], lo[2], lo[3], hh[0], hh[1], hh[2], hh[3]};
                    o[d] = __builtin_amdgcn_mfma_f32_32x32x16_bf16(vf, pf, o[d], 0, 0, 0); } }
        const float inv = __builtin_amdgcn_rcpf(l);
#pragma unroll
        for (int d = 0; d < 2; ++d)
#pragma unroll
            for (int rp = 0; rp < 2; ++rp) {
                unsigned ax = pg8::cvt_pk_bf16(o[d][8 * rp] * inv, o[d][8 * rp + 1] * inv), ay = pg8::cvt_pk_bf16(o[d][8 * rp + 2] * inv, o[d][8 * rp + 3] * inv);
                unsigned bx = pg8::cvt_pk_bf16(o[d][8 * rp + 4] * inv, o[d][8 * rp + 5] * inv), by = pg8::cvt_pk_bf16(o[d][8 * rp + 6] * inv, o[d][8 * rp + 7] * inv);
                const auto r0 = __builtin_amdgcn_permlane32_swap(ax, bx, false, false); const auto r1 = __builtin_amdgcn_permlane32_swap(ay, by, false, false);
                pg8::u32x4 w; w.x = r0[0]; w.y = r1[0]; w.z = r0[1]; w.w = r1[1];
                *(pg8::u32x4*)(mix + mq * D + h * 64 + 32 * d + 16 * rp + 8 * hi) = w; }
        __syncthreads();
    }
#undef AT_PIECE
#undef AT_FETCH
#undef AT_STAGE
}

__device__ __forceinline__ void ffn_fixup(const float* __restrict__ SB, const float* __restrict__ cw, const float* __restrict__ cb, bf16_t* hid, int pm, int tid) {
    pm = __builtin_amdgcn_readfirstlane(pm);
    const float* s = SB + (size_t)pm * 6 * FF; const float* sp = SB + (size_t)(pm - 1) * 6 * FF; const bool has_prev = (pm % (SEQ / 256)) != 0;
    static_assert(2 * FF == 11 * NTHREADS_, "ffn_fixup: 11 items per thread");
    float u0[11], u1[11], ul0[11], ul1[11], w0[11], w1[11], w2[11], bb[11], up[11];
#pragma unroll
    for (int it = 0; it < 11; ++it) { const int idx = tid + NTHREADS_ * it, rr = idx >= FF ? 1 : 0, j = idx - rr * FF;
        u0[it] = s[j]; u1[it] = s[FF + j]; ul0[it] = has_prev ? sp[4 * FF + j] : 0.f; ul1[it] = has_prev ? sp[5 * FF + j] : 0.f;
        w0[it] = cw[j]; w1[it] = cw[FF + j]; w2[it] = cw[2 * FF + j]; bb[it] = cb[j]; up[it] = s[(2 + rr) * FF + j]; }
#pragma unroll
    for (int it = 0; it < 11; ++it) { const int idx = tid + NTHREADS_ * it, rr = idx >= FF ? 1 : 0, j = idx - rr * FF;
        const float c = rr == 0 ? bb[it] + w0[it] * ul0[it] + w1[it] * ul1[it] + w2[it] * u0[it] : bb[it] + w0[it] * ul1[it] + w1[it] * u0[it] + w2[it] * u1[it];
        hid[(size_t)(pm * 256 + rr) * FF + j] = (bf16_t)f2bf(c * sigmoidf_(c) * up[it]); }
}

#define XB_TMO      128
#define XB_XCNT(j)  (256  + 64 * (j))
#define XB_XSUB(j)  (1280 + 64 * (j))
#define XB_XGEN(j)  (2304 + 64 * (j))
#define XB_TOP      3328
#define XB_TOPGEN   3392
#define XCD_BAR_WORDS 3456
#define XB_SPIN_CAP (1u << 18)

__device__ __forceinline__ unsigned xb_ld(unsigned* p)              { return __hip_atomic_load(p, __ATOMIC_RELAXED, __HIP_MEMORY_SCOPE_AGENT); }
__device__ __forceinline__ unsigned xb_add(unsigned* p, unsigned v) { return __hip_atomic_fetch_add(p, v, __ATOMIC_RELAXED, __HIP_MEMORY_SCOPE_AGENT); }
__device__ __forceinline__ unsigned xb_xcc_id() { return (unsigned)__builtin_amdgcn_s_getreg((3 << 11) | 20) & 0xFu; }
#define XB_SPIN(cond, bar) do { unsigned _sp = 0; while (cond) { __builtin_amdgcn_s_sleep(1); \
    if ((++_sp & 255u) == 0u) { if (xb_ld(&(bar)[XB_TMO])) break; if (_sp > XB_SPIN_CAP) { atomicAdd(&(bar)[XB_TMO], 1u); break; } } } } while (0)

struct XcdBarrier {
    unsigned* bar; unsigned x;
    volatile __attribute__((address_space(3))) unsigned* st;
};

__device__ __forceinline__ XcdBarrier xcd_barrier_post(unsigned* bar, volatile __attribute__((address_space(3))) unsigned* st) {
    XcdBarrier b; b.bar = bar; b.x = xb_xcc_id(); b.st = st;
    if (threadIdx.x == 0) (void)xb_add(&bar[XB_XCNT(b.x)], 1u);
    return b;
}
__device__ __forceinline__ void xcd_barrier_complete(unsigned* bar, unsigned x, unsigned& nloc, unsigned& nx) {
    const unsigned G = gridDim.x * gridDim.y * gridDim.z;
    unsigned sum, cnt, mine, sp = 0u;
    for (;;) {
        sum = 0u; cnt = 0u; mine = 0u;
#pragma unroll
        for (unsigned j = 0; j < 16; ++j) { const unsigned c = xb_ld(&bar[XB_XCNT(j)]); sum += c; cnt += (c > 0u) ? 1u : 0u; mine = (j == x) ? c : mine; }
        if (sum == G) break;
        __builtin_amdgcn_s_sleep(1);
        if ((++sp & 255u) == 0u) { if (xb_ld(&bar[XB_TMO])) break; if (sp > XB_SPIN_CAP) { atomicAdd(&bar[XB_TMO], 1u); break; } }
    }
    nloc = mine > 0u ? mine : 1u; nx = cnt > 0u ? cnt : 1u;
}

__device__ __forceinline__ void xcd_barrier(const XcdBarrier& b) {
    asm volatile("s_waitcnt vmcnt(0)" ::: "memory");
    __syncthreads();
    if (threadIdx.x == 0) {
        unsigned* bar = b.bar;
        __builtin_amdgcn_s_waitcnt(0);
        unsigned nloc = b.st[0], nx = b.st[1];
        if (nloc == 0u) { xcd_barrier_complete(bar, b.x, nloc, nx); b.st[0] = nloc; b.st[1] = nx; }
        const unsigned old = xb_add(&bar[XB_XSUB(b.x)], 1u);
        const unsigned gen = old / nloc;
        if (old + 1u == (gen + 1u) * nloc) {
            __builtin_amdgcn_fence(__ATOMIC_RELEASE, "agent");
            asm volatile("s_waitcnt vmcnt(0)" ::: "memory");
            const unsigned og = xb_add(&bar[XB_TOP], 1u);
            const unsigned tg = og / nx;
            if (og + 1u == (tg + 1u) * nx) xb_add(&bar[XB_TOPGEN], 1u);
            else XB_SPIN(xb_ld(&bar[XB_TOPGEN]) == tg, bar);
            __builtin_amdgcn_fence(__ATOMIC_ACQUIRE, "agent");
            xb_add(&bar[XB_XGEN(b.x)], 1u);
            asm volatile("s_waitcnt vmcnt(0)" ::: "memory");
        } else {
            XB_SPIN(xb_ld(&bar[XB_XGEN(b.x)]) == gen, bar);
            __builtin_amdgcn_fence(__ATOMIC_ACQUIRE, "agent");
            asm volatile("s_waitcnt vmcnt(0)" ::: "memory");
        }
    }
    __syncthreads();
}

constexpr int NTHREADS = 512, LDS_BYTES = 147456;
struct Args { const float* in[26]; float* out; unsigned char* ws; };
__global__ void __launch_bounds__(NTHREADS, 2) mega_fwd(Args a) {
    extern __shared__ __attribute__((aligned(16))) unsigned char lds[];
    constexpr int MISC_OFF = 131072 + 4096;
    { volatile __attribute__((address_space(3))) unsigned* misc = (volatile __attribute__((address_space(3))) unsigned*)((__attribute__((address_space(3))) unsigned char*)lds + MISC_OFF);
      if (threadIdx.x < 4) misc[threadIdx.x] = 0u; }
    __syncthreads();
    (void)xcd_barrier_post((unsigned*)(a.ws + WS_BAR), (volatile __attribute__((address_space(3))) unsigned*)((__attribute__((address_space(3))) unsigned char*)lds + MISC_OFF));
#define GRID_SYNC() do { XcdBarrier xb_; xb_.bar = (unsigned*)(a.ws + WS_BAR); xb_.x = xb_xcc_id(); xb_.st = (volatile __attribute__((address_space(3))) unsigned*)((__attribute__((address_space(3))) unsigned char*)lds + MISC_OFF); xcd_barrier(xb_); } while (0)
#define LDSP ((PG8_LAS unsigned char*)lds)
    constexpr int XCH_OFF = 131072;
#define OTID() ({ int _t = threadIdx.x; asm volatile("" : "+v"(_t)); _t; })
    const int G = gridDim.x, NGW = G * 8;
    const float* x = a.in[0]; const float* norm1_g = a.in[1]; const float* w_in = a.in[2]; const float* sinks = a.in[3];
    const float* mu = a.in[4]; const float* w0 = a.in[5]; const float* w2 = a.in[6]; const float* a0 = a.in[7];
    const float* a2 = a.in[8]; const float* g2 = a.in[9]; const float* k_k = a.in[10]; const float* k_a = a.in[11];
    const float* r_k = a.in[12]; const float* lnx_g = a.in[13]; const float* lnx_b = a.in[14]; const float* v0 = a.in[15];
    const float* v1 = a.in[16]; const float* v2 = a.in[17]; const float* w_out = a.in[18]; const float* norm2_g = a.in[19];
    const float* wg = a.in[20]; const float* wu = a.in[21]; const float* conv_w = a.in[22]; const float* conv_b = a.in[23];
    const float* wd = a.in[24]; const float* final_g = a.in[25];
    unsigned char* ws = a.ws; float* X = a.out;
    ssq_t* ss = (ssq_t*)(ws + WS_SS);
    bf16_t* XB = (bf16_t*)(ws + WS_XB); bf16_t* PROJ = (bf16_t*)(ws + WS_PROJ); bf16_t* MIX = (bf16_t*)(ws + WS_MIX); bf16_t* HID = (bf16_t*)(ws + WS_HID); bf16_t* VF = (bf16_t*)(ws + WS_VFIRST);
    bf16_t* UT = (bf16_t*)(ws + WS_UTMP); bf16_t* UPT = UT + (size_t)SEQ * FF;

    {
        const int tid = OTID(), lane = tid & 63, wave = tid >> 6, gw = blockIdx.x * 8 + wave;
        float* scr = (float*)lds + wave * (64 * 33 + 16);
        constexpr int I_IN = (D / 64) * (IN_W / 32), I_OUT = (D / 64) * (D / 32), I_G = (D / 64) * (FF / 32), I_DN = (FF / 64) * (D / 32), I_LAYER = I_IN + I_OUT + 2 * I_G + I_DN;
        for (int it = gw; it < 2 * I_LAYER; it += NGW) {
            const int l = it / I_LAYER; int r = it % I_LAYER;
            bf16_t* wl = (bf16_t*)(ws + WS_W + l * W_LAYER); bf16_t* WinT = wl; bf16_t* WoutT = (bf16_t*)((char*)wl + W_IN_SZ); bf16_t* WguT = (bf16_t*)((char*)WoutT + W_OUT_SZ); bf16_t* WdT = (bf16_t*)((char*)WguT + W_GU_SZ);
            if (r < I_IN) { transpose_item(w_in + (size_t)l * D * IN_W, D, IN_W, WinT, norm1_g + l * D, 0, scr, r, lane); continue; } r -= I_IN;
            if (r < I_OUT) { transpose_item(w_out + (size_t)l * D * D, D, D, WoutT, nullptr, 0, scr, r, lane); continue; } r -= I_OUT;
            if (r < I_G) { transpose_item(wg + (size_t)l * D * FF, D, FF, WguT, norm2_g + l * D, 1, scr, r, lane); continue; } r -= I_G;
            if (r < I_G) { transpose_item(wu + (size_t)l * D * FF, D, FF, WguT, norm2_g + l * D, 2, scr, r, lane); continue; } r -= I_G;
            transpose_item(wd + (size_t)l * FF * D, FF, D, WdT, nullptr, 0, scr, r, lane);
        }
        {
            constexpr int I_W2 = 1 * (C / 32), I_G2 = 2 * (C / 32), I_V1 = (C / 64) * 1, I_L = 2 * I_W2 + I_G2;
            const float* mu_v1 = a.in[4] + SHIFT_W + 1024;
            for (int it = gw; it < 2 * I_L + 2 * I_V1; it += NGW) {
                if (it < 2 * I_L) { const int l = it / I_L; int r = it % I_L; bf16_t* base = (bf16_t*)(ws + WS_LORA + l * LORA_LAYER);
                    if (r < I_W2) { transpose_item(w2 + (size_t)l * 64 * C, 64, C, base, nullptr, 0, scr, r, lane); continue; } r -= I_W2;
                    if (r < I_W2) { transpose_item(a2 + (size_t)l * 64 * C, 64, C, base + 512 * 64, nullptr, 0, scr, r, lane); continue; } r -= I_W2;
                    transpose_item(g2 + (size_t)l * 128 * C, 128, C, base + 2 * 512 * 64, nullptr, 0, scr, r, lane); }
                else if (it < 2 * I_L + I_V1) transpose_item(v1, C, 32, (bf16_t*)(ws + WS_V1T), mu_v1, 0, scr, it - 2 * I_L, lane, true);
                else transpose_item(v1, C, 32, (bf16_t*)(ws + WS_V1B), mu_v1, 0, scr, it - 2 * I_L - I_V1, lane, false);
            }
            bf16_t* V2T = (bf16_t*)(ws + WS_V2T);
            for (int i = blockIdx.x * NTHREADS + tid; i < 32 * C; i += G * NTHREADS) { const int j = i / C, ch = i % C; V2T[ch * 32 + j] = (bf16_t)f2bf(v2[i]); }
        }
        for (int m = 4 * gw; m < M; m += 4 * NGW) {
            f32x4 xv[4][4];
#pragma unroll
            for (int u = 0; u < 4; ++u)
#pragma unroll
                for (int j = 0; j < 4; ++j) xv[u][j] = __builtin_nontemporal_load(((const f32x4*)(x + (size_t)(m + u) * D)) + lane + 64 * j);
#pragma unroll
            for (int u = 0; u < 4; ++u) { float sq = 0.f;
#pragma unroll
                for (int j = 0; j < 4; ++j) { const f32x4 v = xv[u][j]; sq += v.x * v.x + v.y * v.y + v.z * v.z + v.w * v.w;
                    ((unsigned long long*)(XB + (size_t)(m + u) * D))[lane + 64 * j] = (unsigned long long)(f2bf(v.x) | (f2bf(v.y) << 16)) | ((unsigned long long)(f2bf(v.z) | (f2bf(v.w) << 16)) << 32); }
                sq = wave_sum(sq); if (lane == 0) ss[m + u] = ssq_fix(sq); } }
    }
    GRID_SYNC();
    for (int l = 0; l < 2; ++l) {
        bf16_t* wl = (bf16_t*)(ws + WS_W + l * W_LAYER); bf16_t* WinT = wl; bf16_t* WoutT = (bf16_t*)((char*)wl + W_IN_SZ); bf16_t* WguT = (bf16_t*)((char*)WoutT + W_OUT_SZ); bf16_t* WdT = (bf16_t*)((char*)WguT + W_GU_SZ);
        ssq_t* ss1 = ss + (size_t)(2 * l) * M; ssq_t* ss2 = ss + (size_t)(2 * l + 1) * M; ssq_t* ss3 = ss + (size_t)(2 * l + 2) * M;
        { pg8::Gemm g{XB, WinT, M, IN_W, D}; pg8::StaticOrder S; S.init(M, IN_W, G, (int)blockIdx.x); pg8::EpiScaleBf16 E{PROJ, IN_W, ss1};
          pg8::gemm_phase<pg8::EpiScaleBf16, pg8::StaticOrder, true, true>(LDSP, g, S, E); }
        GRID_SYNC();
        { float* KC = (float*)(lds + CK_CONST_OFF); const int t_ = OTID(); KC[t_] = (k_k + l * C)[t_]; KC[512 + t_] = (k_a + l * C)[t_]; KC[1024 + t_] = (r_k + l * C)[t_]; KC[1536 + t_] = (mu + l * SHIFT_W)[t_]; KC[2048 + t_] = (mu + l * SHIFT_W)[512 + t_]; __syncthreads(); }
        attn_phase(PROJ, sinks + l * NH, MIX, lds, G, OTID());
        struct { bf16_t *V, *G; } p; p.V = (bf16_t*)(ws + WS_SI_V); p.G = (bf16_t*)(ws + WS_SI_G);
        bf16_t* GQ = (bf16_t*)X; bf16_t* CQ = GQ + (size_t)BATCH * NH * 64 * 8192;
        ScanArgs s{}; s.yt = (bf16_t*)(ws + WS_YT); s.proj = PROJ; s.V = (l == 0 ? VF : p.V); s.G = p.G; s.k_k = k_k + l * C; s.k_a = k_a + l * C; s.r_k = r_k + l * C; s.lnx_g = lnx_g + l * C; s.lnx_b = lnx_b + l * C; s.mix = MIX; s.rkc = (float*)(ws + WS_RKC);
        { bf16_t* scr = (bf16_t*)(ws + WS_TSCR + (size_t)blockIdx.x * TSCR_WG);
          for (int tile = blockIdx.x; tile < M / 64; tile += G) {
              const size_t moff = (size_t)tile * 64 * C;
              Prep2Args q{}; q.proj = PROJ; q.mu = mu + l * SHIFT_W; q.w0 = w0 + l * C; q.a0 = a0 + l * C; q.v0 = v0;
              const bf16_t* lw = (const bf16_t*)(ws + WS_LORA + l * LORA_LAYER); q.W2T = lw; q.A2T = lw + 512 * 64; q.G2T = lw + 2 * 512 * 64; q.V1T = (const bf16_t*)(ws + WS_V1T); q.V1B = (const bf16_t*)(ws + WS_V1B); q.V2T = (const bf16_t*)(ws + WS_V2T);
              q.vfirst = VF; q.A = scr - moff; q.CS = (unsigned short*)(scr + 64 * C) - moff; q.V = (l == 0 ? VF : p.V); q.G = p.G; q.layer = l;
              prep_tile(q, lds, tile, OTID());
              const int bb = tile >> 6, chunk = tile & 63;
              CkRaw cur; ck_load<true, false>(s, cur, ((bb * NH) << 6) + chunk, OTID());
              asm volatile("s_waitcnt vmcnt(0)" ::: "memory"); __syncthreads();
              if (threadIdx.x == 0) { __builtin_amdgcn_fence(__ATOMIC_ACQUIRE, "agent"); asm volatile("s_waitcnt vmcnt(0)" ::: "memory"); }
              __syncthreads();
              s.A = q.A; s.CS = q.CS;
              ck_load<false, true>(s, cur, ((bb * NH) << 6) + chunk, OTID());
#define CK_UNIT(hh_) do { const int unit = ((bb * NH + (hh_)) << 6) + chunk; CkRaw nxt = cur; ck_precompute(s, cur, nxt, (hh_) + 1 < NH ? unit + 64 : unit, lds, GQ, CQ, unit, OTID()); cur = nxt; } while (0)
              CK_UNIT(0);
              for (int hh = 1; hh < NH; ++hh) CK_UNIT(hh);
#undef CK_UNIT
          } }
        GRID_SYNC();
        for (int item = (int)((blockIdx.x & 7) * (G >> 3) + (blockIdx.x >> 3)); item < BATCH * NH * 4; item += G) ck_sequential(s, lds, GQ, CQ, item, OTID());
        GRID_SYNC();
        { const int tid = OTID(), lane = tid & 63, gw = blockIdx.x * 8 + (tid >> 6); float* LGB = (float*)lds; LGB[tid] = s.lnx_g[tid]; LGB[512 + tid] = s.lnx_b[tid]; __syncthreads();
          scan_post_wave(s, gw, NGW, lane, LGB); }
        GRID_SYNC();
        { pg8::Gemm g{MIX, WoutT, M, D, D}; pg8::StaticOrder S; S.init(M, D, G, (int)blockIdx.x); pg8::EpiResid E{XB, ss2};
          pg8::gemm_phase<pg8::EpiResid, pg8::StaticOrder, true, true>(LDSP, g, S, E); }
        GRID_SYNC();
        { pg8::Gemm g{XB, WguT, M, 2 * FF, D}; pg8::StaticOrder S; S.init(M, 2 * FF, G, (int)blockIdx.x);
          pg8::EpiConvGlu E{HID, ss2, conv_w + (size_t)l * 3 * FF, conv_b + (size_t)l * FF, (float*)(ws + WS_UTMP), (PG8_LAS float*)(LDSP + XCH_OFF), FF};
          pg8::gemm_phase<pg8::EpiConvGlu, pg8::StaticOrder, true, true>(LDSP, g, S, E); }
        GRID_SYNC();
        { pg8::Gemm g{HID, WdT, M, D, FF}; pg8::StaticOrder S; S.init(M, D, G, (int)blockIdx.x);
          { pg8::Unit u; for (int i = 0; S.next(i, u); ++i) ffn_fixup((const float*)(ws + WS_UTMP), conv_w + (size_t)l * 3 * FF, conv_b + (size_t)l * FF, HID, u.pm, OTID());
            asm volatile("s_waitcnt vmcnt(0)" ::: "memory"); __syncthreads(); }
          if (l == 0) { pg8::EpiResid E{XB, ss3}; pg8::gemm_phase<pg8::EpiResid, pg8::StaticOrder, true, true>(LDSP, g, S, E); }
          else { pg8::EpiResidFinal E{XB, ss3, (unsigned*)(ws + WS_FCNT), final_g, X};
                 pg8::gemm_phase<pg8::EpiResidFinal, pg8::StaticOrder, true, true>(LDSP, g, S, E); } }
        if (l == 0) GRID_SYNC();
    }
}

extern "C" void kernel_launch(void* const* d_in, const int* in_sizes, int n_in, void* d_out, int out_size, void* d_ws, size_t ws_size, hipStream_t stream) {
    static int grid = 0;
    if (grid == 0) {
        if (n_in != 26 || in_sizes[0] != M * D || out_size != M * D || ws_size < WS_END) { fprintf(stderr, "kernel_launch: unexpected shapes (n_in %d, ws %zu)\n", n_in, ws_size); grid = -1; return; }
        int dev = 0, cus = 0, per_cu = 0;
        if (hipGetDevice(&dev) != hipSuccess || hipDeviceGetAttribute(&cus, hipDeviceAttributeMultiprocessorCount, dev) != hipSuccess) { grid = -1; return; }
        if (hipFuncSetAttribute((const void*)mega_fwd, hipFuncAttributeMaxDynamicSharedMemorySize, LDS_BYTES) != hipSuccess) { fprintf(stderr, "kernel_launch: hipFuncSetAttribute failed\n"); grid = -1; return; }
        if (hipOccupancyMaxActiveBlocksPerMultiprocessor(&per_cu, (const void*)mega_fwd, NTHREADS, LDS_BYTES) != hipSuccess || per_cu < 1) { fprintf(stderr, "kernel_launch: occupancy query failed (%d)\n", per_cu); grid = -1; return; }
        grid = cus;
    }
    if (grid < 0) return;
    (void)hipMemsetAsync((unsigned char*)d_ws + WS_CTL, 0, CTL_BYTES, stream);
    Args a{};
    for (int i = 0; i < 26; ++i) a.in[i] = (const float*)d_in[i];
    a.out = (float*)d_out; a.ws = (unsigned char*)d_ws;
    void* kargs[] = {&a};
    hipError_t e = hipLaunchCooperativeKernel((const void*)mega_fwd, dim3(grid), dim3(NTHREADS), kargs, LDS_BYTES, stream);
    if (e != hipSuccess) fprintf(stderr, "kernel_launch: cooperative launch failed: %s (grid %d)\n", hipGetErrorString(e), grid);
}
```
